# Optimizing an MI355X kernel written in HIP

```python
import jax, jax.numpy as jnp
from jax import lax
import numpy as np

D_MODEL = 1024
BATCH = 16
SEQ = 2048
DEPTH = 1

RWKV_HEAD_DIM = 64
RWKV_WIDTH = D_MODEL // 2
RWKV_HEADS = RWKV_WIDTH // RWKV_HEAD_DIM
W_LORA = 64
A_LORA = 64
G_LORA = 128
RWKV_GN_EPS = RWKV_HEAD_DIM * 1e-5
N_DIRECTIONS = 2
ATT_HEAD_DIM = 64
ATT_WIDTH = D_MODEL // 2
ATT_HEADS = ATT_WIDTH // ATT_HEAD_DIM
ATT_KV_HEADS = 2
ATT_GROUP = ATT_HEADS // ATT_KV_HEADS
KV_WIDTH = ATT_KV_HEADS * ATT_HEAD_DIM
WINDOW = 128
BLOCK = 128
ROPE_THETA = 500000.0
ROT_DIM = ATT_HEAD_DIM // 4
N_BRANCHES = 2
N_EXPERTS = 16
EXPERT_FF = D_MODEL
CAPACITY_FACTOR = 2
NORM_EPS = 1e-6

RWKV_COLS = 3 * RWKV_WIDTH + N_DIRECTIONS * W_LORA + N_DIRECTIONS * A_LORA + G_LORA
IN_COLS = RWKV_COLS + ATT_WIDTH + 2 * KV_WIDTH + N_BRANCHES * D_MODEL

kernel_name = 'hybrid_rwkv7_swa_ecmoe_block'


def rms_norm(x, g):
    xf = x.astype(jnp.float32)
    y = xf * lax.rsqrt(jnp.mean(xf * xf, axis=-1, keepdims=True) + NORM_EPS)
    return (y * g.astype(jnp.float32)).astype(x.dtype)


def centred_token_shift(z, mu_prev, mu_next):
    z_prev = jnp.pad(z[:, :-1], ((0, 0), (1, 0), (0, 0)))
    z_next = jnp.pad(z[:, 1:], ((0, 0), (0, 1), (0, 0)))
    return z + mu_prev * (z_prev - z) + mu_next * (z_next - z)


def rwkv7_scan(r, w, k, v, a, b, reverse):
    B, T, H, N = r.shape

    def step(S, inp):
        r_t, w_t, k_t, v_t, a_t, b_t = inp
        sa = jnp.einsum('bhij,bhj->bhi', S, a_t)
        S = (S * w_t[:, :, None, :] + sa[..., None] * b_t[:, :, None, :]
             + v_t[..., None] * k_t[:, :, None, :])
        y = jnp.einsum('bhij,bhj->bhi', S, r_t)
        return S, y

    xs = tuple(jnp.moveaxis(t, 1, 0) for t in (r, w, k, v, a, b))
    S0 = jnp.zeros((B, H, N, N), jnp.float32)
    _, y = lax.scan(step, S0, xs, reverse=reverse)
    return jnp.moveaxis(y, 0, 1)


def rwkv7_branch(z, w0, w2, a0, a2, g2, k_k, k_a, r_k, gn_w, gn_b):
    B, T, _ = z.shape
    H, N, RW = RWKV_HEADS, RWKV_HEAD_DIM, RWKV_WIDTH
    f32 = jnp.float32
    splits = [RW, 2 * RW, 3 * RW, 3 * RW + N_DIRECTIONS * W_LORA,
              3 * RW + N_DIRECTIONS * (W_LORA + A_LORA)]
    r, k, v, wd, ad, gd = jnp.split(z.astype(f32), splits, axis=-1)
    wd = wd.reshape(B, T, N_DIRECTIONS, W_LORA)
    ad = ad.reshape(B, T, N_DIRECTIONS, A_LORA)
    w = -jax.nn.softplus(-(w0.astype(f32) + jnp.einsum('btdl,dlc->btdc', jnp.tanh(wd), w2.astype(f32)))) - 0.5
    decay = jnp.exp(-jnp.exp(w))
    a = jax.nn.sigmoid(a0.astype(f32) + jnp.einsum('btdl,dlc->btdc', ad, a2.astype(f32)))
    g = jax.nn.sigmoid(gd) @ g2.astype(f32)

    def heads(t):
        return t.reshape(B, T, H, N)

    kk = heads(k * k_k.astype(f32))
    kk = kk / jnp.maximum(jnp.sqrt(jnp.sum(kk * kk, axis=-1, keepdims=True)), 1e-12)
    ys = []
    ks = []
    for d, rev in ((0, False), (1, True)):
        a_d = a[:, :, d]
        k_d = k * (1.0 + (a_d - 1.0) * k_a.astype(f32))
        ys.append(rwkv7_scan(heads(r), heads(decay[:, :, d]), heads(k_d), heads(v),
                             -kk, kk * heads(a_d), rev))
        ks.append(k_d)
    y = ys[0] + ys[1]
    mu = jnp.mean(y, axis=-1, keepdims=True)
    var = jnp.mean(jnp.square(y - mu), axis=-1, keepdims=True)
    y = ((y - mu) * lax.rsqrt(var + RWKV_GN_EPS)).reshape(B, T, RW) * gn_w.astype(f32) + gn_b.astype(f32)
    bonus = jnp.sum(heads(r) * heads(ks[0] + ks[1]) * r_k.astype(f32), axis=-1, keepdims=True) * heads(v)
    y = (y + bonus.reshape(B, T, RW)) * g
    return y.astype(z.dtype)


def partial_rope(x, cos, sin):
    half = ROT_DIM // 2
    x1 = x[..., :half]
    x2 = x[..., half:ROT_DIM]
    return jnp.concatenate([x1 * cos - x2 * sin, x2 * cos + x1 * sin, x[..., ROT_DIM:]], axis=-1)


def window_attention(q, k, v, sink):
    B, T, _, hd = q.shape
    nb = T // BLOCK
    qb = q.reshape(B, nb, BLOCK, ATT_KV_HEADS, ATT_GROUP, hd)

    def band(t):
        tp = jnp.pad(t, ((0, 0), (BLOCK, BLOCK), (0, 0), (0, 0))).reshape(B, nb + 2, BLOCK, ATT_KV_HEADS, hd)
        return jnp.concatenate([tp[:, :-2], tp[:, 1:-1], tp[:, 2:]], axis=2)

    kb = band(k)
    vb = band(v)
    s = jnp.einsum('bnqkgd,bnskd->bnkgqs', qb, kb).astype(jnp.float32) * (hd ** -0.5)
    blk = jnp.arange(nb)[:, None, None] * BLOCK
    qpos = blk + jnp.arange(BLOCK)[None, :, None]
    kpos = blk - BLOCK + jnp.arange(3 * BLOCK)[None, None, :]
    valid = (jnp.abs(kpos - qpos) <= WINDOW) & (kpos >= 0) & (kpos < T)
    s = jnp.where(valid[None, :, None, None], s, -jnp.inf)
    sk = sink.astype(jnp.float32).reshape(1, 1, ATT_KV_HEADS, ATT_GROUP, 1, 1)
    m = jnp.maximum(jnp.max(s, axis=-1, keepdims=True), sk)
    p = jnp.exp(s - m)
    denom = jnp.sum(p, axis=-1, keepdims=True) + jnp.exp(sk - m)
    o = jnp.einsum('bnkgqs,bnskd->bnqkgd', (p / denom).astype(v.dtype), vb)
    return o.reshape(B, T, ATT_HEADS * hd)


def expert_choice_moe(u, w_router, w_gate, w_up, w_down):
    B, T, D = u.shape
    cap = CAPACITY_FACTOR * T // N_EXPERTS
    aff = jax.nn.softmax(jnp.einsum('btd,de->bte', u, w_router).astype(jnp.float32), axis=-1)
    top_aff, top_idx = lax.top_k(jnp.swapaxes(aff, 1, 2), cap)
    bidx = jnp.arange(B)[:, None, None]
    xe = u[bidx, top_idx]
    h = jax.nn.silu(jnp.einsum('becd,edf->becf', xe, w_gate)) * jnp.einsum('becd,edf->becf', xe, w_up)
    ye = jnp.einsum('becf,efd->becd', h, w_down) * top_aff[..., None].astype(u.dtype)
    return jnp.zeros_like(u).at[bidx, top_idx].add(ye)


def setup_inputs(seed: int = 0) -> dict:
    key = jax.random.key(seed)
    ks = jax.random.split(key, 32)
    f32 = jnp.float32
    L, D, RW, E, F = DEPTH, D_MODEL, RWKV_WIDTH, N_EXPERTS, EXPERT_FF

    def nrm(k, shape, scale):
        return jax.random.normal(k, shape, f32) * scale

    return {
        'x': nrm(ks[0], (BATCH, SEQ, D), 1.0),
        'c': nrm(ks[1], (BATCH, D), 1.0),
        'positions': jnp.broadcast_to(jnp.arange(SEQ, dtype=jnp.int32)[None, :], (BATCH, SEQ)),
        'w_ada': nrm(ks[2], (L, D, 6 * D), 0.5 * D ** -0.5),
        'b_ada': nrm(ks[3], (L, 6 * D), 0.02),
        'norm1_g': 1.0 + nrm(ks[4], (L, D), 0.05),
        'w_in': nrm(ks[5], (L, D, IN_COLS), D ** -0.5),
        'mu_prev': jax.random.uniform(ks[6], (L, RWKV_COLS), f32, 0.0, 0.5),
        'mu_next': jax.random.uniform(ks[7], (L, RWKV_COLS), f32, 0.0, 0.5),
        'rwkv_w0': -2.0 + nrm(ks[8], (L, N_DIRECTIONS, RW), 1.0),
        'rwkv_w2': nrm(ks[9], (L, N_DIRECTIONS, W_LORA, RW), 0.5 * W_LORA ** -0.5),
        'rwkv_a0': nrm(ks[10], (L, N_DIRECTIONS, RW), 0.1),
        'rwkv_a2': nrm(ks[11], (L, N_DIRECTIONS, A_LORA, RW), 0.5 * A_LORA ** -0.5),
        'rwkv_g2': nrm(ks[12], (L, G_LORA, RW), G_LORA ** -0.5),
        'rwkv_k_k': 0.85 + nrm(ks[13], (L, RW), 0.05),
        'rwkv_k_a': 1.0 + nrm(ks[14], (L, RW), 0.05),
        'rwkv_r_k': nrm(ks[15], (L, RWKV_HEADS, RWKV_HEAD_DIM), 0.1),
        'rwkv_gn_w': 1.0 + nrm(ks[16], (L, RW), 0.05),
        'rwkv_gn_b': nrm(ks[17], (L, RW), 0.02),
        'q_norm_g': 1.0 + nrm(ks[18], (L, ATT_HEAD_DIM), 0.05),
        'k_norm_g': 1.0 + nrm(ks[19], (L, ATT_HEAD_DIM), 0.05),
        'attn_sink': nrm(ks[20], (L, ATT_HEADS), 1.0),
        'p_rwkv': nrm(ks[21], (L, RW, D), RW ** -0.5),
        'p_attn': nrm(ks[22], (L, ATT_WIDTH, D), ATT_WIDTH ** -0.5),
        'w_out': nrm(ks[23], (L, D, D), D ** -0.5),
        'norm2_g': 1.0 + nrm(ks[24], (L, D), 0.05),
        'w_router': nrm(ks[25], (L, D, E), D ** -0.5),
        'w_gate': nrm(ks[26], (L, E, D, F), D ** -0.5),
        'w_up': nrm(ks[27], (L, E, D, F), D ** -0.5),
        'w_down': nrm(ks[28], (L, E, F, D), F ** -0.5),
    }


def reference(x, c, positions, w_ada, b_ada, norm1_g, w_in, mu_prev, mu_next,
              rwkv_w0, rwkv_w2, rwkv_a0, rwkv_a2, rwkv_g2, rwkv_k_k, rwkv_k_a, rwkv_r_k,
              rwkv_gn_w, rwkv_gn_b, q_norm_g, k_norm_g, attn_sink, p_rwkv, p_attn, w_out,
              norm2_g, w_router, w_gate, w_up, w_down):
    B, T, D = x.shape
    hd = ATT_HEAD_DIM
    inv_freq = ROPE_THETA ** (-jnp.arange(0, ROT_DIM, 2, dtype=jnp.float32) / ROT_DIM)
    ang = positions.astype(jnp.float32)[..., None] * inv_freq
    cos = jnp.cos(ang)[:, :, None, :].astype(x.dtype)
    sin = jnp.sin(ang)[:, :, None, :].astype(x.dtype)
    col_splits = [RWKV_COLS, RWKV_COLS + ATT_WIDTH, RWKV_COLS + ATT_WIDTH + KV_WIDTH,
                  RWKV_COLS + ATT_WIDTH + 2 * KV_WIDTH]
    c_act = jax.nn.silu(c)

    for l in range(DEPTH):
        mod = jnp.einsum('bd,de->be', c_act, w_ada[l]) + b_ada[l]
        sh1, sc1, gt1, sh2, sc2, gt2 = jnp.split(mod[:, None, :], 6, axis=-1)

        u = rms_norm(x, norm1_g[l]) * (1.0 + sc1) + sh1
        z = u @ w_in[l]
        z_rwkv, q, k, v, gate_logits = jnp.split(z, col_splits, axis=-1)

        z_rwkv = centred_token_shift(z_rwkv, mu_prev[l], mu_next[l])
        y_a = rwkv7_branch(z_rwkv, rwkv_w0[l], rwkv_w2[l], rwkv_a0[l], rwkv_a2[l], rwkv_g2[l],
                           rwkv_k_k[l], rwkv_k_a[l], rwkv_r_k[l], rwkv_gn_w[l], rwkv_gn_b[l]) @ p_rwkv[l]

        q = partial_rope(rms_norm(q.reshape(B, T, ATT_HEADS, hd), q_norm_g[l]), cos, sin)
        k = partial_rope(rms_norm(k.reshape(B, T, ATT_KV_HEADS, hd), k_norm_g[l]), cos, sin)
        v = v.reshape(B, T, ATT_KV_HEADS, hd)
        y_b = window_attention(q, k, v, attn_sink[l]) @ p_attn[l]

        g_a, g_b = jnp.split(jax.nn.sigmoid(gate_logits), N_BRANCHES, axis=-1)
        x = x + gt1 * ((g_a * y_a + g_b * y_b) @ w_out[l])

        u2 = rms_norm(x, norm2_g[l]) * (1.0 + sc2) + sh2
        x = x + gt2 * expert_choice_moe(u2, w_router[l], w_gate[l], w_up[l], w_down[l])
    return x
```

```cpp
#include <hip/hip_runtime.h>
#include <cstdio>
#include <cstdint>
#include <cmath>
namespace pg8 {
#define PG8_LAS __attribute__((address_space(3)))
typedef unsigned short bf16_t;
typedef short bf16x8 __attribute__((ext_vector_type(8)));
typedef float f32x4 __attribute__((ext_vector_type(4)));
typedef unsigned u32x4 __attribute__((ext_vector_type(4)));
constexpr int BM = 256, BK = 64, HALF = 128, HTB = HALF * BK * 2  , STAGE_BYTES = 8 * HTB, NXCD = 8, WGM = 8;

__host__ __device__ __forceinline__ int lds_byte(int r, int c) { const int st = (r >> 4) * 2 + (c >> 5), rr = r & 15, cc = c & 31, ob = rr * 64 + cc * 2; return st * 1024 + (ob ^ (((ob >> 9) & 1) << 5)); }
__host__ __device__ __forceinline__ void stage_rc(int b, int& R, int& C) { const int st = b / 1024, sb = b % 1024, swz = sb ^ (((sb >> 9) & 1) << 5); R = (st >> 1) * 16 + swz / 64; C = (st & 1) * 32 + (swz % 64) / 2; }
__host__ __device__ __forceinline__ int perm32(int rho) { const int n = rho >> 4, i = rho & 15; return 8 * (i >> 2) + 4 * n + (i & 3); }

struct Unit { int pm, pn; };
struct Gemm { const bf16_t* A; const bf16_t* Bt; int M, N, K; };

struct StaticOrder {
    int nM, nN, nwg, G, c;
    __host__ __device__ void init(int M, int N, int G_, int c_) { nM = M / BM; nN = N / BM; nwg = nM * nN; G = G_; c = c_; }
    __host__ __device__ bool next(int i, Unit& u) const {
        const long L = (long)i * G + c; if (L >= nwg) return false;
        int wgid = (int)L; { const int q = nwg / NXCD, r = nwg % NXCD, xcd = wgid % NXCD, off = wgid / NXCD; wgid = (xcd < r ? xcd * (q + 1) : r * (q + 1) + (xcd - r) * q) + off; }
        const int nig = WGM * nN, gid = wgid / nig, fm = gid * WGM, gsz = (nM - fm) < WGM ? (nM - fm) : WGM;
        u.pm = fm + ((wgid % nig) % gsz); u.pn = (wgid % nig) / gsz; return true;
    }
    __device__ __forceinline__ void a_ready(const Unit&) const {}
    __device__ __forceinline__ void done(const Unit&) const {}
};

__device__ __forceinline__ unsigned cvt_pk_bf16(float lo, float hi) { unsigned r; asm volatile("v_cvt_pk_bf16_f32 %0, %1, %2" : "=v"(r) : "v"(lo), "v"(hi)); return r; }
typedef float f32x2 __attribute__((ext_vector_type(2)));
template <class Epi, class Sched, bool ALIGN_EPI = false, bool SP2 = false>
__device__ __forceinline__ void gemm_phase(PG8_LAS unsigned char* lds, const Gemm g, const Sched& S, const Epi& E) {
    int tid_ = threadIdx.x; asm volatile("" : "+v"(tid_));
    const int tid = tid_, wid = __builtin_amdgcn_readfirstlane(tid >> 6), lane = tid & 63, wr = wid >> 2, wc = wid & 3, fr = lane & 15, fq = lane >> 4;
    const int K = g.K, nt = K / BK;
    unsigned voffA[2], voffB[2];
#pragma unroll
    for (int i = 0; i < 2; ++i) { int R, C; stage_rc(tid * 16 + i * 8192, R, C); const int Rb = Epi::PERM ? ((R & ~31) + perm32(R & 31)) : R;
        voffA[i] = (unsigned)(R * K + C) * 2u; voffB[i] = (unsigned)(Rb * K + C) * 2u; }
    const size_t kstep = (size_t)(BK * 2);
    const size_t hstep = (size_t)HALF * K * 2;
    const size_t tstep = 2 * hstep;
    const unsigned ldsw = (unsigned)wid * 1024u;
    const int aoff = lds_byte(wr * 64 + fr, fq * 8), boff = lds_byte(wc * 32 + fr, fq * 8);
#define PG8_SA(b, h) (((b) * 2 + (h)) * HTB)
#define PG8_SB(b, h) ((4 + (b) * 2 + (h)) * HTB)
#define PG8_STAGE(bufoff, gbase, voff) do { _Pragma("unroll") for (int _i = 0; _i < 2; ++_i) \
        __builtin_amdgcn_global_load_lds((const unsigned*)((const char*)(gbase) + (voff)[_i]), (PG8_LAS unsigned*)(lds + (bufoff) + ldsw + _i * 8192), 16, 0, 0); } while (0)
#define PG8_LDA(dst, b, h) do { _Pragma("unroll") for (int m = 0; m < 4; ++m) _Pragma("unroll") for (int k = 0; k < 2; ++k) dst[m][k] = *(const PG8_LAS bf16x8*)(lds + PG8_SA(b, h) + aoff + m * 2048 + k * 1024); } while (0)
#define PG8_LDB(dst, b, h) do { _Pragma("unroll") for (int n = 0; n < 2; ++n) _Pragma("unroll") for (int k = 0; k < 2; ++k) dst[n][k] = *(const PG8_LAS bf16x8*)(lds + PG8_SB(b, h) + boff + n * 2048 + k * 1024); } while (0)
#define PG8_MMA(ai, bj, At, Bt) do { __builtin_amdgcn_s_setprio(1); _Pragma("unroll") for (int m = 0; m < 4; ++m) _Pragma("unroll") for (int n = 0; n < 2; ++n) _Pragma("unroll") for (int k = 0; k < 2; ++k) \
        acc[ai][bj][m][n] = __builtin_amdgcn_mfma_f32_16x16x32_bf16(Bt[n][k], At[m][k], acc[ai][bj][m][n], 0, 0, 0); __builtin_amdgcn_s_setprio(0); } while (0)
#define PG8_WAIT_V(n) asm volatile("s_waitcnt vmcnt(" #n ")" ::: "memory")
#define PG8_WAIT_L(n) asm volatile("s_waitcnt lgkmcnt(" #n ")" ::: "memory")
#define PG8_BAR __builtin_amdgcn_s_barrier()
#define PG8_SCHED __builtin_amdgcn_sched_barrier(0)
    Unit cur, nxt; int ui = 0;
    if (!S.next(0, cur)) return;
    f32x4 acc[2][2][4][2];
#pragma unroll
    for (int a = 0; a < 2; ++a)
#pragma unroll
        for (int b = 0; b < 2; ++b)
#pragma unroll
            for (int m = 0; m < 4; ++m)
#pragma unroll
                for (int n = 0; n < 2; ++n) acc[a][b][m][n] = (f32x4){0.f, 0.f, 0.f, 0.f};
    bf16x8 At[4][2], B0[2][2], B1[2][2];
    const char* cA = (const char*)g.A + (size_t)cur.pm * tstep; const char* cB = (const char*)g.Bt + (size_t)cur.pn * tstep;
    S.a_ready(cur);
    if constexpr (SP2) {
        PG8_STAGE(PG8_SB(0, 0), cB, voffB); PG8_STAGE(PG8_SB(0, 1), cB + hstep, voffB); PG8_STAGE(PG8_SA(0, 0), cA, voffA); PG8_STAGE(PG8_SA(0, 1), cA + hstep, voffA);
        if (wr == 1) PG8_BAR;
        PG8_WAIT_V(2); PG8_BAR;
        PG8_STAGE(PG8_SB(1, 0), cB + kstep, voffB); PG8_STAGE(PG8_SA(1, 0), cA + kstep, voffA); PG8_STAGE(PG8_SB(1, 1), cB + hstep + kstep, voffB);
        PG8_WAIT_V(6); PG8_BAR;
    } else {
        PG8_STAGE(PG8_SB(0, 0), cB, voffB); PG8_STAGE(PG8_SA(0, 0), cA, voffA); PG8_STAGE(PG8_SB(0, 1), cB + hstep, voffB); PG8_STAGE(PG8_SA(0, 1), cA + hstep, voffA);
        if (wr == 1) PG8_BAR;
        PG8_WAIT_V(4); PG8_BAR;
        PG8_STAGE(PG8_SB(1, 0), cB + kstep, voffB); PG8_STAGE(PG8_SA(1, 0), cA + kstep, voffA); PG8_STAGE(PG8_SB(1, 1), cB + hstep + kstep, voffB);
        PG8_WAIT_V(6); PG8_BAR;
    }
    for (;;) {
        const bool has_next = S.next(ui + 1, nxt);
        const char* nA = has_next ? (const char*)g.A + (size_t)nxt.pm * tstep : cA; const char* nB = has_next ? (const char*)g.Bt + (size_t)nxt.pn * tstep : cB;
        for (int t = 0; t < nt; t += 2) {
            const bool last = (t == nt - 2);
            const char* a1 = cA + (size_t)(t + 1) * kstep;
            const char* a2 = last ? nA : cA + (size_t)(t + 2) * kstep; const char* b2 = last ? nB : cB + (size_t)(t + 2) * kstep;
            const char* a3 = a2 + kstep; const char* b3 = b2 + kstep;
            if (last && has_next) S.a_ready(nxt);
            if constexpr (SP2) {
            PG8_LDB(B0, 0, 0); PG8_LDB(B1, 0, 1); PG8_SCHED; PG8_LDA(At, 0, 0); PG8_STAGE(PG8_SA(1, 1), a1 + hstep, voffA);
            PG8_WAIT_V(8); PG8_WAIT_L(0); PG8_BAR; PG8_MMA(0, 0, At, B0); PG8_MMA(0, 1, At, B1); PG8_BAR; PG8_SCHED;
            PG8_LDA(At, 0, 1); PG8_STAGE(PG8_SB(0, 0), b2, voffB); PG8_STAGE(PG8_SB(0, 1), b2 + hstep, voffB); PG8_STAGE(PG8_SA(0, 0), a2, voffA);
            PG8_WAIT_V(8); PG8_WAIT_L(0); PG8_BAR; PG8_MMA(1, 0, At, B0); PG8_MMA(1, 1, At, B1); PG8_BAR; PG8_SCHED;
            PG8_LDB(B0, 1, 0); PG8_LDB(B1, 1, 1); PG8_SCHED; PG8_LDA(At, 1, 0); PG8_STAGE(PG8_SA(0, 1), a2 + hstep, voffA);
            PG8_WAIT_V(8); PG8_WAIT_L(0); PG8_BAR; PG8_MMA(0, 0, At, B0); PG8_MMA(0, 1, At, B1); PG8_BAR; PG8_SCHED;
            PG8_LDA(At, 1, 1); PG8_STAGE(PG8_SB(1, 0), b3, voffB); PG8_STAGE(PG8_SB(1, 1), b3 + hstep, voffB); PG8_STAGE(PG8_SA(1, 0), a3, voffA);
            PG8_WAIT_V(8); PG8_WAIT_L(0); PG8_BAR; PG8_MMA(1, 0, At, B0); PG8_MMA(1, 1, At, B1); PG8_BAR; PG8_SCHED;
            } else {
            PG8_LDB(B0, 0, 0); PG8_SCHED; PG8_LDA(At, 0, 0); PG8_STAGE(PG8_SA(1, 1), a1 + hstep, voffA);
            PG8_WAIT_L(8); PG8_BAR; PG8_WAIT_L(0); PG8_MMA(0, 0, At, B0); PG8_BAR; PG8_SCHED;
            PG8_LDB(B1, 0, 1); PG8_STAGE(PG8_SB(0, 0), b2, voffB);
            PG8_BAR; PG8_WAIT_L(0); PG8_MMA(0, 1, At, B1); PG8_BAR;
            PG8_LDA(At, 0, 1); PG8_STAGE(PG8_SA(0, 0), a2, voffA);
            PG8_BAR; PG8_WAIT_L(0); PG8_MMA(1, 0, At, B0); PG8_BAR; PG8_SCHED;
            PG8_STAGE(PG8_SB(0, 1), b2 + hstep, voffB);
            PG8_WAIT_V(6); PG8_BAR; PG8_MMA(1, 1, At, B1); PG8_BAR;
            PG8_LDB(B0, 1, 0); PG8_SCHED; PG8_LDA(At, 1, 0); PG8_STAGE(PG8_SA(0, 1), a2 + hstep, voffA);
            PG8_WAIT_L(8); PG8_BAR; PG8_WAIT_L(0); PG8_MMA(0, 0, At, B0); PG8_BAR; PG8_SCHED;
            PG8_LDB(B1, 1, 1); PG8_STAGE(PG8_SB(1, 0), b3, voffB);
            PG8_BAR; PG8_WAIT_L(0); PG8_MMA(0, 1, At, B1); PG8_BAR;
            PG8_LDA(At, 1, 1); PG8_STAGE(PG8_SA(1, 0), a3, voffA);
            PG8_BAR; PG8_WAIT_L(0); PG8_MMA(1, 0, At, B0); PG8_BAR; PG8_SCHED;
            PG8_STAGE(PG8_SB(1, 1), b3 + hstep, voffB);
            PG8_WAIT_V(6); PG8_BAR; PG8_MMA(1, 1, At, B1); PG8_BAR;
            }
        }
        if constexpr (ALIGN_EPI) { if (wr == 0) PG8_BAR; }
        if constexpr (!Epi::AFTER_DRAIN) { E(acc, cur, wr, wc, fr, fq); S.done(cur); }
        if (!has_next) break;
#pragma unroll
        for (int a = 0; a < 2; ++a)
#pragma unroll
            for (int b = 0; b < 2; ++b)
#pragma unroll
                for (int m = 0; m < 4; ++m)
#pragma unroll
                    for (int n = 0; n < 2; ++n) acc[a][b][m][n] = (f32x4){0.f, 0.f, 0.f, 0.f};
        cur = nxt; cA = nA; cB = nB; ++ui;
        if constexpr (ALIGN_EPI) { if (wr == 1) PG8_BAR; }
    }
    PG8_WAIT_V(0);
    if constexpr (!ALIGN_EPI) { if (wr == 0) PG8_BAR; }
    PG8_BAR;
    if constexpr (Epi::AFTER_DRAIN) { E.fused(acc, cur, wr, wc, fr, fq, lds, wid, lane); S.done(cur); }
#undef PG8_SA
#undef PG8_SB
#undef PG8_STAGE
#undef PG8_LDA
#undef PG8_LDB
#undef PG8_MMA
#undef PG8_WAIT_V
#undef PG8_WAIT_L
#undef PG8_BAR
#undef PG8_SCHED
}
}

#ifndef ONE_LAUNCH
#define ONE_LAUNCH 0
#endif
constexpr int NB = 16, T = 2048, D = 1024, M = NB * T;
constexpr int NZ = 4736, NZP = 4864;
constexpr int RW = 512, NE = 16, CAP = 256, ME = NE * NB * CAP;
constexpr int ZR = 0, ZK = 512, ZV = 1024, ZWD = 1536, ZAD = 1664, ZGD = 1792, ZQ = 1920, ZKA = 2432, ZVA = 2560, ZGA = 2688, ZGB = 3712;
constexpr int NWAVES = 8, NPHASE = 14;
constexpr size_t MiB = 1u << 20;
constexpr size_t WS_CTL = 0, CTL_ZERO_BYTES = 64 * 1024;
constexpr size_t WS_MOD = 1 * MiB, WS_BONUS = 2 * MiB, WS_AFF = 4 * MiB, WS_SELAFF = 6 * MiB, WS_SLOT = 7 * MiB, WS_G2T = 9 * MiB;
constexpr size_t WS_WINT = 10 * MiB, WS_PRT = 20 * MiB, WS_PAT = 21 * MiB, WS_WOT = 22 * MiB, WS_SGD = 24 * MiB;
constexpr size_t WS_XN = 40 * MiB;
constexpr size_t WS_OATT = 104 * MiB;
constexpr size_t WS_G = 136 * MiB;
constexpr size_t WS_Z = 168 * MiB;
constexpr size_t WS_WGUT = 104 * MiB;
constexpr size_t WS_WDT = 168 * MiB;
constexpr size_t WS_XE = 200 * MiB;
constexpr size_t WS_H = 328 * MiB;
constexpr size_t WS_END = 464 * MiB;
constexpr int CW_BAR = 4096;
constexpr int RING_BYTES = 131072, LDSCTL_OFF = RING_BYTES, MISC_OFF = LDSCTL_OFF + 320, LDS_BYTES = 147456;

#define GAS __attribute__((address_space(1)))
#define LAS __attribute__((address_space(3)))
typedef unsigned short bf16;
typedef unsigned v4u __attribute__((ext_vector_type(4)));
typedef float f32x4 __attribute__((ext_vector_type(4)));
typedef short bf16x8 __attribute__((ext_vector_type(8)));
typedef GAS unsigned gu32;
typedef GAS unsigned long long gu64;
#define RLX_AGENT __ATOMIC_RELAXED, __HIP_MEMORY_SCOPE_AGENT
#define LDS_WAIT() asm volatile("s_waitcnt lgkmcnt(0)" ::: "memory")
#define VM_WAIT() asm volatile("s_waitcnt vmcnt(0)" ::: "memory")
__device__ __forceinline__ unsigned long long rt() { return __builtin_amdgcn_s_memrealtime(); }
__device__ __forceinline__ unsigned f2bf(float f) { unsigned u = __builtin_bit_cast(unsigned, f); return (u + 0x7fffu + ((u >> 16) & 1u)) >> 16; }
__device__ __forceinline__ unsigned pk2(float lo, float hi) { return f2bf(lo) | (f2bf(hi) << 16); }

#define XB_TMO      128
#define XB_XCNT(j)  (256  + 64 * (j))
#define XB_XSUB(j)  (1280 + 64 * (j))
#define XB_XGEN(j)  (2304 + 64 * (j))
#define XB_TOP      3328
#define XB_TOPGEN   3392
#define XCD_BAR_WORDS 3456
#define XB_SPIN_CAP (1u << 18)

__device__ __forceinline__ unsigned xb_ld(unsigned* p)              { return __hip_atomic_load(p, __ATOMIC_RELAXED, __HIP_MEMORY_SCOPE_AGENT); }
__device__ __forceinline__ unsigned xb_add(unsigned* p, unsigned v) { return __hip_atomic_fetch_add(p, v, __ATOMIC_RELAXED, __HIP_MEMORY_SCOPE_AGENT); }
__device__ __forceinline__ unsigned xb_xcc_id() { return (unsigned)__builtin_amdgcn_s_getreg((3 << 11) | 20) & 0xFu; }
#define XB_SPIN(cond, bar) do { unsigned _sp = 0; while (cond) { __builtin_amdgcn_s_sleep(1); \
    if ((++_sp & 255u) == 0u) { if (xb_ld(&(bar)[XB_TMO])) break; if (_sp > XB_SPIN_CAP) { atomicAdd(&(bar)[XB_TMO], 1u); break; } } } } while (0)

struct XcdBarrier {
    unsigned* bar; unsigned x;
    volatile LAS unsigned* st;
};

__device__ __forceinline__ XcdBarrier xcd_barrier_post(unsigned* bar, volatile LAS unsigned* st) {
    XcdBarrier b; b.bar = bar; b.x = xb_xcc_id(); b.st = st;
    if (threadIdx.x == 0) (void)xb_add(&bar[XB_XCNT(b.x)], 1u);
    return b;
}
__device__ __forceinline__ void xcd_barrier_complete(unsigned* bar, unsigned x, unsigned& nloc, unsigned& nx) {
    const unsigned G = gridDim.x * gridDim.y * gridDim.z;
    unsigned sum, cnt, mine, sp = 0u;
    for (;;) {
        sum = 0u; cnt = 0u; mine = 0u;
#pragma unroll
        for (unsigned j = 0; j < 16; ++j) { const unsigned c = xb_ld(&bar[XB_XCNT(j)]); sum += c; cnt += (c > 0u) ? 1u : 0u; mine = (j == x) ? c : mine; }
        if (sum == G) break;
        __builtin_amdgcn_s_sleep(1);
        if ((++sp & 255u) == 0u) { if (xb_ld(&bar[XB_TMO])) break; if (sp > XB_SPIN_CAP) { atomicAdd(&bar[XB_TMO], 1u); break; } }
    }
    nloc = mine > 0u ? mine : 1u; nx = cnt > 0u ? cnt : 1u;
}

__device__ __forceinline__ void xcd_barrier(const XcdBarrier& b) {
    asm volatile("s_waitcnt vmcnt(0)" ::: "memory");
    __syncthreads();
    if (threadIdx.x == 0) {
        unsigned* bar = b.bar;
        __builtin_amdgcn_s_waitcnt(0);
        unsigned nloc = b.st[0], nx = b.st[1];
        if (nloc == 0u) { xcd_barrier_complete(bar, b.x, nloc, nx); b.st[0] = nloc; b.st[1] = nx; }
        const unsigned old = xb_add(&bar[XB_XSUB(b.x)], 1u);
        const unsigned gen = old / nloc;
        if (old + 1u == (gen + 1u) * nloc) {
            __builtin_amdgcn_fence(__ATOMIC_RELEASE, "agent");
            asm volatile("s_waitcnt vmcnt(0)" ::: "memory");
            const unsigned og = xb_add(&bar[XB_TOP], 1u);
            const unsigned tg = og / nx;
            if (og + 1u == (tg + 1u) * nx) xb_add(&bar[XB_TOPGEN], 1u);
            else XB_SPIN(xb_ld(&bar[XB_TOPGEN]) == tg, bar);
            __builtin_amdgcn_fence(__ATOMIC_ACQUIRE, "agent");
            xb_add(&bar[XB_XGEN(b.x)], 1u);
            asm volatile("s_waitcnt vmcnt(0)" ::: "memory");
        } else {
            XB_SPIN(xb_ld(&bar[XB_XGEN(b.x)]) == gen, bar);
            __builtin_amdgcn_fence(__ATOMIC_ACQUIRE, "agent");
            asm volatile("s_waitcnt vmcnt(0)" ::: "memory");
        }
    }
    __syncthreads();
}
namespace pg8 {
__device__ __forceinline__ float bf2f(unsigned short h) { return __uint_as_float(((unsigned)h) << 16); }
__device__ __forceinline__ float bflo(unsigned w) { return __uint_as_float(w << 16); }
__device__ __forceinline__ float bfhi(unsigned w) { return __uint_as_float(w & 0xffff0000u); }
__device__ __forceinline__ float sigm(float x) { return 1.0f / (1.0f + __expf(-x)); }
struct EpiZ { static constexpr bool PERM = true, AFTER_DRAIN = false; bf16_t* O;
    __device__ __forceinline__ void operator()(const f32x4 (&acc)[2][2][4][2], const Unit& u, int wr, int wc, int fr, int fq) const {
        const int row0 = u.pm * BM + wr * 64 + fr, col0 = u.pn * BM + wc * 32 + 8 * fq;
#pragma unroll
        for (int ai = 0; ai < 2; ++ai)
#pragma unroll
            for (int m = 0; m < 4; ++m) { bf16_t* rowp = O + (size_t)(row0 + ai * HALF + m * 16) * 4736 + col0;
#pragma unroll
                for (int bj = 0; bj < 2; ++bj) { if (u.pn * BM + bj * HALF < 4736) { const f32x4 v0 = acc[ai][bj][m][0], v1 = acc[ai][bj][m][1];
                    u32x4 w; w.x = cvt_pk_bf16(v0[0], v0[1]); w.y = cvt_pk_bf16(v0[2], v0[3]); w.z = cvt_pk_bf16(v1[0], v1[1]); w.w = cvt_pk_bf16(v1[2], v1[3]);
                    *(u32x4*)(rowp + bj * HALF) = w; } } }
    }
};
struct EpiPlain { static constexpr bool PERM = true, AFTER_DRAIN = false; bf16_t* O; int ldc;
    __device__ __forceinline__ void operator()(const f32x4 (&acc)[2][2][4][2], const Unit& u, int wr, int wc, int fr, int fq) const {
        const int row0 = u.pm * BM + wr * 64 + fr, col0 = u.pn * BM + wc * 32 + 8 * fq;
#pragma unroll
        for (int ai = 0; ai < 2; ++ai)
#pragma unroll
            for (int m = 0; m < 4; ++m) { bf16_t* rowp = O + (size_t)(row0 + ai * HALF + m * 16) * ldc + col0;
#pragma unroll
                for (int bj = 0; bj < 2; ++bj) { const f32x4 v0 = acc[ai][bj][m][0], v1 = acc[ai][bj][m][1];
                    u32x4 w; w.x = cvt_pk_bf16(v0[0], v0[1]); w.y = cvt_pk_bf16(v0[2], v0[3]); w.z = cvt_pk_bf16(v1[0], v1[1]); w.w = cvt_pk_bf16(v1[2], v1[3]);
                    *(u32x4*)(rowp + bj * HALF) = w; } }
    }
};
template <bool ADD> struct EpiGate { static constexpr bool PERM = true, AFTER_DRAIN = false; bf16_t* O; const bf16_t* Z; int zc0;
    __device__ __forceinline__ void operator()(const f32x4 (&acc)[2][2][4][2], const Unit& u, int wr, int wc, int fr, int fq) const {
        const int row0 = u.pm * BM + wr * 64 + fr, col0 = u.pn * BM + wc * 32 + 8 * fq;
#pragma unroll
        for (int ai = 0; ai < 2; ++ai)
#pragma unroll
            for (int m = 0; m < 4; ++m) { const size_t row = (size_t)(row0 + ai * HALF + m * 16); bf16_t* rowp = O + row * 1024 + col0; const bf16_t* zp = Z + row * 4736 + zc0 + col0;
#pragma unroll
                for (int bj = 0; bj < 2; ++bj) { const f32x4 v0 = acc[ai][bj][m][0], v1 = acc[ai][bj][m][1];
                    const u32x4 zg = *(const u32x4*)(zp + bj * HALF);
                    float r0 = sigm(bflo(zg.x)) * v0[0], r1 = sigm(bfhi(zg.x)) * v0[1], r2 = sigm(bflo(zg.y)) * v0[2], r3 = sigm(bfhi(zg.y)) * v0[3];
                    float r4 = sigm(bflo(zg.z)) * v1[0], r5 = sigm(bfhi(zg.z)) * v1[1], r6 = sigm(bflo(zg.w)) * v1[2], r7 = sigm(bfhi(zg.w)) * v1[3];
                    if (ADD) { const u32x4 p = *(const u32x4*)(rowp + bj * HALF);
                        r0 += bflo(p.x); r1 += bfhi(p.x); r2 += bflo(p.y); r3 += bfhi(p.y); r4 += bflo(p.z); r5 += bfhi(p.z); r6 += bflo(p.w); r7 += bfhi(p.w); }
                    u32x4 w; w.x = cvt_pk_bf16(r0, r1); w.y = cvt_pk_bf16(r2, r3); w.z = cvt_pk_bf16(r4, r5); w.w = cvt_pk_bf16(r6, r7);
                    *(u32x4*)(rowp + bj * HALF) = w; } }
    }
};
struct EpiRes { static constexpr bool PERM = false, AFTER_DRAIN = false; const float* X; const float* mod; float* O;
    __device__ __forceinline__ void operator()(const f32x4 (&acc)[2][2][4][2], const Unit& u, int wr, int wc, int fr, int fq) const {
        const int col0 = u.pn * BM + wc * 32 + 4 * fq; const int b = (u.pm * BM) >> 11;
        f32x4 gt[2][2];
#pragma unroll
        for (int bj = 0; bj < 2; ++bj)
#pragma unroll
            for (int n = 0; n < 2; ++n) gt[bj][n] = *(const f32x4*)(mod + (size_t)b * 6144 + 2048 + col0 + bj * HALF + n * 16);
#pragma unroll
        for (int ai = 0; ai < 2; ++ai)
#pragma unroll
            for (int m = 0; m < 4; ++m) { const size_t off = (size_t)(u.pm * BM + ai * HALF + wr * 64 + m * 16 + fr) * 1024 + col0;
#pragma unroll
                for (int bj = 0; bj < 2; ++bj)
#pragma unroll
                    for (int n = 0; n < 2; ++n) { const f32x4 xs = *(const f32x4*)(X + off + bj * HALF + n * 16);
                        *(f32x4*)(O + off + bj * HALF + n * 16) = xs + gt[bj][n] * acc[ai][bj][m][n]; } }
    }
};
template <int NPL> struct GroupOrder { int G, c;
    __device__ __forceinline__ bool next(int i, Unit& u) const { const int L = i * G + c; if (L >= 256 * NPL) return false;
        const int e = L / (16 * NPL), r = L % (16 * NPL); u.pm = e * 16 + (r % 16); u.pn = e * NPL + r / 16; return true; }
    __device__ __forceinline__ void a_ready(const Unit&) const {}
    __device__ __forceinline__ void done(const Unit&) const {}
};
struct EpiSwiglu { static constexpr bool PERM = true, AFTER_DRAIN = false; bf16_t* O;
    __device__ __forceinline__ void operator()(const f32x4 (&acc)[2][2][4][2], const Unit& u, int wr, int wc, int fr, int fq) const {
        const int row0 = u.pm * BM + wr * 64 + fr, col0 = (u.pn & 7) * 128 + wc * 32 + 8 * fq;
#pragma unroll
        for (int ai = 0; ai < 2; ++ai)
#pragma unroll
            for (int m = 0; m < 4; ++m) { bf16_t* rowp = O + (size_t)(row0 + ai * HALF + m * 16) * 1024 + col0;
                float r[8];
#pragma unroll
                for (int n = 0; n < 2; ++n)
#pragma unroll
                    for (int i = 0; i < 4; ++i) { const float g = acc[ai][0][m][n][i], up = acc[ai][1][m][n][i]; r[n * 4 + i] = g * sigm(g) * up; }
                u32x4 w; w.x = cvt_pk_bf16(r[0], r[1]); w.y = cvt_pk_bf16(r[2], r[3]); w.z = cvt_pk_bf16(r[4], r[5]); w.w = cvt_pk_bf16(r[6], r[7]);
                *(u32x4*)rowp = w; }
    }
};
struct EpiDown { static constexpr bool PERM = true, AFTER_DRAIN = false; bf16_t* O; const float* aff;
    __device__ __forceinline__ void operator()(const f32x4 (&acc)[2][2][4][2], const Unit& u, int wr, int wc, int fr, int fq) const {
        const int row0 = u.pm * BM + wr * 64 + fr, col0 = (u.pn & 3) * BM + wc * 32 + 8 * fq;
#pragma unroll
        for (int ai = 0; ai < 2; ++ai)
#pragma unroll
            for (int m = 0; m < 4; ++m) { const int row = row0 + ai * HALF + m * 16; const float a = aff[row]; bf16_t* rowp = O + (size_t)row * 1024 + col0;
#pragma unroll
                for (int bj = 0; bj < 2; ++bj) { const f32x4 v0 = acc[ai][bj][m][0] * a, v1 = acc[ai][bj][m][1] * a;
                    u32x4 w; w.x = cvt_pk_bf16(v0[0], v0[1]); w.y = cvt_pk_bf16(v0[2], v0[3]); w.z = cvt_pk_bf16(v1[0], v1[1]); w.w = cvt_pk_bf16(v1[2], v1[3]);
                    *(u32x4*)(rowp + bj * HALF) = w; } }
    }
};
}

struct Frame { LAS unsigned char* lds; volatile LAS unsigned* MISC; gu32* ctl; int tid, lane, wave, vcu, G; };
struct Args { const void* in[30]; float* out; unsigned char* ws; int ph_lo, ph_hi; };
typedef const __attribute__((address_space(4))) Args* ArgsP;
#define LAUNDER(p) asm volatile("" : "+s"(p))
typedef float f32x16 __attribute__((ext_vector_type(16)));
typedef unsigned u32x2 __attribute__((ext_vector_type(2)));

__device__ __forceinline__ float wave_sum(float v) {
#pragma unroll
    for (int o = 1; o < 64; o <<= 1) v += __shfl_xor(v, o);
    return v;
}
__device__ __forceinline__ float bf2f(bf16 h) { return __uint_as_float(((unsigned)h) << 16); }
__device__ __forceinline__ float bflo(unsigned w) { return __uint_as_float(w << 16); }
__device__ __forceinline__ float bfhi(unsigned w) { return __uint_as_float(w & 0xffff0000u); }
__device__ __forceinline__ float sigm(float x) { return 1.0f / (1.0f + __expf(-x)); }

__device__ __forceinline__ void tr_item(const float* W, int N, int k0, int n0, bf16* WT, int KD, int dst_row0, LAS float* scr, int lane) {
#pragma unroll 8
    for (int i = 0; i < 32; ++i) { const int kk = 2 * i + (lane >> 5); scr[kk * 33 + (lane & 31)] = W[(size_t)(k0 + kk) * N + n0 + (lane & 31)]; }
    LDS_WAIT(); asm volatile("" ::: "memory");
    const int c = lane & 7;
#pragma unroll
    for (int j = 0; j < 4; ++j) { const int n = (lane >> 3) + 8 * j; const LAS float* s = scr + (8 * c) * 33 + n;
        v4u o; o.x = pk2(s[0 * 33], s[1 * 33]); o.y = pk2(s[2 * 33], s[3 * 33]); o.z = pk2(s[4 * 33], s[5 * 33]); o.w = pk2(s[6 * 33], s[7 * 33]);
        *(GAS v4u*)(WT + (size_t)(dst_row0 + n) * KD + k0 + 8 * c) = o; }
    LDS_WAIT(); asm volatile("" ::: "memory");
}

__device__ __forceinline__ void p0_prologue(const Frame& F, ArgsP A) {
    unsigned char* ws = A->ws;
    LAS float* scr = (LAS float*)(F.lds + F.wave * 16384);
    const int gw = F.vcu * NWAVES + F.wave, NGW = F.G * NWAVES;
    const float* w_in = (const float*)A->in[6]; const float* p_rwkv = (const float*)A->in[22]; const float* p_attn = (const float*)A->in[23];
    const float* w_out = (const float*)A->in[24]; const float* g2 = (const float*)A->in[13];
    bf16* WinT = (bf16*)(ws + WS_WINT); bf16* PrT = (bf16*)(ws + WS_PRT); bf16* PaT = (bf16*)(ws + WS_PAT); bf16* WoT = (bf16*)(ws + WS_WOT); bf16* G2T = (bf16*)(ws + WS_G2T);
    constexpr int I_IN = 16 * 148, I_P = 8 * 32, I_O = 16 * 32, I_G = 2 * 16, NIT = I_IN + 2 * I_P + I_O + I_G;
    for (int it = gw; it < NIT; it += NGW) {
        int r = it;
        if (r < I_IN) { tr_item(w_in, NZ, 64 * (r / 148), 32 * (r % 148), WinT, 1024, 32 * (r % 148), scr, F.lane); continue; } r -= I_IN;
        if (r < I_P) { tr_item(p_rwkv, 1024, 64 * (r / 32), 32 * (r % 32), PrT, 512, 32 * (r % 32), scr, F.lane); continue; } r -= I_P;
        if (r < I_P) { tr_item(p_attn, 1024, 64 * (r / 32), 32 * (r % 32), PaT, 512, 32 * (r % 32), scr, F.lane); continue; } r -= I_P;
        if (r < I_O) { tr_item(w_out, 1024, 64 * (r / 32), 32 * (r % 32), WoT, 1024, 32 * (r % 32), scr, F.lane); continue; } r -= I_O;
        tr_item(g2, 512, 64 * (r / 16), 32 * (r % 16), G2T, 256, 32 * (r % 16), scr, F.lane);
    }
    { const int gt = (F.vcu * NWAVES + F.wave) * 64 + F.lane, NT = F.G * NWAVES * 64; const v4u z4 = {0u, 0u, 0u, 0u};
      for (int i = gt; i < 128 * 128; i += NT) *(GAS v4u*)(WinT + (size_t)4736 * 1024 + (size_t)i * 8) = z4;
      for (int i = gt; i < 512 * 16; i += NT) *(GAS v4u*)(G2T + (size_t)(i >> 4) * 256 + 128 + (i & 15) * 8) = z4; }
    __syncthreads();
    const float* cvec = (const float*)A->in[1]; const float* w_ada = (const float*)A->in[3]; const float* b_ada = (const float*)A->in[4];
    float* mod = (float*)(ws + WS_MOD);
    for (int cg = F.vcu; cg < 96; cg += F.G) {
        LAS float* ca = (LAS float*)F.lds;
        LAS float* red = (LAS float*)(F.lds + 65536);
        for (int i = F.tid; i < 16 * 1024; i += 512) { const int b = i >> 10, d = i & 1023; const float cv = cvec[i]; ca[d * 16 + b] = cv / (1.0f + __expf(-cv)); }
        __syncthreads();
        float acc[16];
#pragma unroll
        for (int b = 0; b < 16; ++b) acc[b] = 0.f;
        const int col = cg * 64 + F.lane;
        for (int dd = 0; dd < 128; ++dd) { const int d = F.wave * 128 + dd; const float w = w_ada[(size_t)d * 6144 + col];
            const LAS f32x4* cp = (const LAS f32x4*)(ca + d * 16);
#pragma unroll
            for (int q = 0; q < 4; ++q) { const f32x4 cv = cp[q]; acc[q * 4 + 0] += cv[0] * w; acc[q * 4 + 1] += cv[1] * w; acc[q * 4 + 2] += cv[2] * w; acc[q * 4 + 3] += cv[3] * w; } }
#pragma unroll
        for (int b = 0; b < 16; ++b) red[(F.wave * 16 + b) * 64 + F.lane] = acc[b];
        __syncthreads();
        for (int o = F.tid; o < 1024; o += 512) { const int b = o >> 6, cl = o & 63; float s = 0.f;
#pragma unroll
            for (int w = 0; w < 8; ++w) s += red[(w * 16 + b) * 64 + cl];
            mod[b * 6144 + cg * 64 + cl] = s + b_ada[cg * 64 + cl]; }
        __syncthreads();
    }
}

__device__ __forceinline__ void modnorm_row(const float* xrow, const float* g, const float* sh, const float* sc, bf16* orow, int lane, f32x4 (&u)[4]) {
    const GAS f32x4* xr = (const GAS f32x4*)xrow + lane;
    f32x4 v[4]; float s = 0.f;
#pragma unroll
    for (int j = 0; j < 4; ++j) { v[j] = xr[64 * j]; s += (v[j].x * v[j].x + v[j].y * v[j].y) + (v[j].z * v[j].z + v[j].w * v[j].w); }
    const float rs = rsqrtf(wave_sum(s) * (1.0f / 1024.0f) + 1e-6f);
    GAS unsigned long long* o8 = (GAS unsigned long long*)orow + lane;
#pragma unroll
    for (int j = 0; j < 4; ++j) { const f32x4 gg = ((const GAS f32x4*)g)[lane + 64 * j], s1 = ((const GAS f32x4*)sc)[lane + 64 * j], s0 = ((const GAS f32x4*)sh)[lane + 64 * j];
        f32x4 y = (v[j] * rs) * gg; y = y * (s1 + 1.0f) + s0; u[j] = y;
        o8[64 * j] = (unsigned long long)pk2(y.x, y.y) | ((unsigned long long)pk2(y.z, y.w) << 32); }
}

__device__ __forceinline__ float softplusf(float x) { return x > 20.f ? x : log1pf(__expf(x)); }
__device__ __forceinline__ void scan_chain(const Frame& F, ArgsP A, int b, int h, int dir) {
    constexpr int CT = 32;
    LAS float* L = (LAS float*)F.lds;
    LAS float* W2S = L; LAS float* A2S = L + 4096; LAS float* ZRs = L + 8192; LAS float* ZKs = ZRs + 2048; LAS float* ZVs = ZKs + 2048; LAS float* TWs = ZVs + 2048; LAS float* ZAs = TWs + 2048;
    LAS float* DEC = ZAs + 2048; LAS float* KD = DEC + 2048; LAS float* AV = KD + 2048; LAS float* BV = AV + 2048; LAS float* YB = BV + 2048; LAS float* BON = YB + 2048;
    const bf16* Z = (const bf16*)(A->ws + WS_Z);
    const float* mu_prev = (const float*)A->in[7]; const float* mu_next = (const float*)A->in[8];
    const float* w0 = (const float*)A->in[9]; const float* w2 = (const float*)A->in[10]; const float* a0 = (const float*)A->in[11]; const float* a2 = (const float*)A->in[12];
    const float* k_k = (const float*)A->in[14]; const float* k_a = (const float*)A->in[15]; const float* r_k = (const float*)A->in[16];
    bf16* ydir = (bf16*)(A->ws + WS_XN) + (size_t)dir * M * 512; float* bonus = (float*)(A->ws + WS_BONUS) + (size_t)dir * M * 8;
    const int tid = F.tid, lane = F.lane, wave = F.wave;
    for (int i = tid; i < 4096; i += 512) { const int l = i >> 6, j = i & 63; W2S[i] = w2[((size_t)dir * 64 + l) * 512 + h * 64 + j]; A2S[i] = a2[((size_t)dir * 64 + l) * 512 + h * 64 + j]; }
    const int ch = h * 64 + lane;
    const float w0j = w0[dir * 512 + ch], a0j = a0[dir * 512 + ch], kkj = k_k[ch], kaj = k_a[ch], rkj = r_k[ch];
    float s[8];
#pragma unroll
    for (int q = 0; q < 8; ++q) s[q] = 0.f;
    const int ri = tid >> 3, jg = tid & 7;
    for (int ci = 0; ci < T / CT; ++ci) {
        const int t0 = (dir ? (T / CT - 1 - ci) : ci) * CT;
#pragma unroll 4
        for (int i = 0; i < 20; ++i) { const int e = tid + 512 * i, arr = e >> 11, rem = e & 2047, tl = rem >> 6, j = rem & 63;
            const int col = (arr == 0 ? ZR + h * 64 : arr == 1 ? ZK + h * 64 : arr == 2 ? ZV + h * 64 : arr == 3 ? ZWD + dir * 64 : ZAD + dir * 64) + j;
            const int t = t0 + tl; const bf16* zp = Z + ((size_t)b * T + t) * NZ + col;
            const float z0 = bf2f(zp[0]), zm = t > 0 ? bf2f(zp[-NZ]) : 0.f, zq = t < T - 1 ? bf2f(zp[NZ]) : 0.f;
            float zs = z0 + mu_prev[col] * (zm - z0) + mu_next[col] * (zq - z0);
            if (arr == 3) zs = tanhf(zs);
            ZRs[arr * 2048 + rem] = zs; }
        __syncthreads();
#pragma unroll 1
        for (int q = 0; q < 4; ++q) { const int tl = wave + 8 * q;
            float wraw = w0j, araw = a0j;
#pragma unroll 8
            for (int l = 0; l < 64; ++l) { wraw += TWs[tl * 64 + l] * W2S[l * 64 + lane]; araw += ZAs[tl * 64 + l] * A2S[l * 64 + lane]; }
            const float w = -softplusf(-wraw) - 0.5f, dec = __expf(-__expf(w)), ad = sigm(araw);
            const float k = ZKs[tl * 64 + lane], kkr = k * kkj, nrm = sqrtf(wave_sum(kkr * kkr)), kk = kkr / fmaxf(nrm, 1e-12f);
            const float kd = k * (1.0f + (ad - 1.0f) * kaj);
            DEC[tl * 64 + lane] = dec; KD[tl * 64 + lane] = kd; AV[tl * 64 + lane] = -kk; BV[tl * 64 + lane] = kk * ad;
            const float bon = wave_sum(ZRs[tl * 64 + lane] * kd * rkj); if (lane == 0) BON[tl] = bon; }
        __syncthreads();
#pragma unroll 1
        for (int st = 0; st < CT; ++st) { const int tl = dir ? (CT - 1 - st) : st; const int o = tl * 64 + jg * 8;
            const f32x4 a0v = *(const LAS f32x4*)(AV + o), a1v = *(const LAS f32x4*)(AV + o + 4), d0 = *(const LAS f32x4*)(DEC + o), d1 = *(const LAS f32x4*)(DEC + o + 4);
            const f32x4 b0 = *(const LAS f32x4*)(BV + o), b1 = *(const LAS f32x4*)(BV + o + 4), k0 = *(const LAS f32x4*)(KD + o), k1 = *(const LAS f32x4*)(KD + o + 4);
            const f32x4 r0 = *(const LAS f32x4*)(ZRs + o), r1 = *(const LAS f32x4*)(ZRs + o + 4); const float vi = ZVs[tl * 64 + ri];
            float p = (s[0] * a0v[0] + s[1] * a0v[1]) + (s[2] * a0v[2] + s[3] * a0v[3]) + (s[4] * a1v[0] + s[5] * a1v[1]) + (s[6] * a1v[2] + s[7] * a1v[3]);
            p += __shfl_xor(p, 1); p += __shfl_xor(p, 2); p += __shfl_xor(p, 4);
            s[0] = s[0] * d0[0] + p * b0[0] + vi * k0[0]; s[1] = s[1] * d0[1] + p * b0[1] + vi * k0[1]; s[2] = s[2] * d0[2] + p * b0[2] + vi * k0[2]; s[3] = s[3] * d0[3] + p * b0[3] + vi * k0[3];
            s[4] = s[4] * d1[0] + p * b1[0] + vi * k1[0]; s[5] = s[5] * d1[1] + p * b1[1] + vi * k1[1]; s[6] = s[6] * d1[2] + p * b1[2] + vi * k1[2]; s[7] = s[7] * d1[3] + p * b1[3] + vi * k1[3];
            float y = (s[0] * r0[0] + s[1] * r0[1]) + (s[2] * r0[2] + s[3] * r0[3]) + (s[4] * r1[0] + s[5] * r1[1]) + (s[6] * r1[2] + s[7] * r1[3]);
            y += __shfl_xor(y, 1); y += __shfl_xor(y, 2); y += __shfl_xor(y, 4);
            if (jg == 0) YB[tl * 64 + ri] = y; }
        __syncthreads();
#pragma unroll
        for (int i = 0; i < 4; ++i) { const int e = tid + 512 * i, tl = e >> 6, c = e & 63; ydir[((size_t)b * T + t0 + tl) * 512 + h * 64 + c] = (bf16)f2bf(YB[e]); }
        if (tid < CT) bonus[((size_t)b * T + t0 + tid) * 8 + h] = BON[tid];
        __syncthreads();
    }
}

__device__ __forceinline__ void attn_unit(const Frame& F, ArgsP A, int b, int kvh, int qb) {
    constexpr int KST = 72, VST = 388;
    LAS bf16* KS = (LAS bf16*)F.lds;
    LAS bf16* VT = (LAS bf16*)(F.lds + 384 * KST * 2);
    LAS float* wsf = (LAS float*)(F.lds + 384 * KST * 2 + 64 * VST * 2);
    const bf16* Z = (const bf16*)(A->ws + WS_Z); bf16* OA = (bf16*)(A->ws + WS_OATT);
    const int* positions = (const int*)A->in[2]; const float* qg = (const float*)A->in[19]; const float* kg = (const float*)A->in[20]; const float* sink = (const float*)A->in[21];
    const int tid = F.tid, lane = F.lane, wave = F.wave;
    const float LN_THETA = 13.122363377404328f;
#pragma unroll 1
    for (int i = 0; i < 6; ++i) { const int ct = tid + 512 * i, key = ct >> 3, ch = ct & 7; const int kp = qb * 128 - 128 + key; const bool valid = (kp >= 0) && (kp < T);
        const size_t rowoff = ((size_t)b * T + (valid ? kp : 0)) * NZ;
        v4u kw = *(const GAS v4u*)(Z + rowoff + ZKA + kvh * 64 + ch * 8), vw = *(const GAS v4u*)(Z + rowoff + ZVA + kvh * 64 + ch * 8);
        if (!valid) { kw = (v4u){0u, 0u, 0u, 0u}; vw = kw; }
        float kf[8] = {bflo(kw.x), bfhi(kw.x), bflo(kw.y), bfhi(kw.y), bflo(kw.z), bfhi(kw.z), bflo(kw.w), bfhi(kw.w)};
        float ss = 0.f;
#pragma unroll
        for (int j = 0; j < 8; ++j) ss += kf[j] * kf[j];
        ss += __shfl_xor(ss, 1); ss += __shfl_xor(ss, 2); ss += __shfl_xor(ss, 4);
        const float rs = rsqrtf(ss * (1.0f / 64.0f) + 1e-6f);
#pragma unroll
        for (int j = 0; j < 8; ++j) kf[j] = kf[j] * rs * kg[ch * 8 + j];
        float oth[8];
#pragma unroll
        for (int j = 0; j < 8; ++j) oth[j] = __shfl_xor(kf[j], 1);
        if (ch < 2) { const float pos = (float)positions[b * T + (valid ? kp : 0)];
#pragma unroll
            for (int j = 0; j < 8; ++j) { const float ang = pos * __expf(-(float)j * 0.125f * LN_THETA); float sn, cs; sincosf(ang, &sn, &cs);
                kf[j] = (ch == 0) ? (kf[j] * cs - oth[j] * sn) : (kf[j] * cs + oth[j] * sn); } }
        v4u ko; ko.x = pk2(kf[0], kf[1]); ko.y = pk2(kf[2], kf[3]); ko.z = pk2(kf[4], kf[5]); ko.w = pk2(kf[6], kf[7]);
        *(LAS v4u*)(KS + key * KST + ch * 8) = ko;
        const unsigned vv[4] = {vw.x, vw.y, vw.z, vw.w};
#pragma unroll
        for (int j = 0; j < 4; ++j) { VT[(ch * 8 + 2 * j) * VST + key] = (bf16)(vv[j] & 0xffffu); VT[(ch * 8 + 2 * j + 1) * VST + key] = (bf16)(vv[j] >> 16); } }
    __syncthreads();
    const int g = wave >> 1, hq = kvh * 4 + g, r32 = lane & 31, hh = lane >> 5;
    const float snk = sink[hq];
#pragma unroll 1
    for (int qt = 0; qt < 2; ++qt) { const int qo = (wave & 1) * 64 + qt * 32, qrel = qo + r32; const size_t tok = (size_t)b * T + qb * 128 + qrel;
        float qf[4][8]; float ss = 0.f;
#pragma unroll
        for (int sI = 0; sI < 4; ++sI) { const v4u qw = *(const GAS v4u*)(Z + tok * NZ + ZQ + hq * 64 + 16 * sI + 8 * hh);
            qf[sI][0] = bflo(qw.x); qf[sI][1] = bfhi(qw.x); qf[sI][2] = bflo(qw.y); qf[sI][3] = bfhi(qw.y); qf[sI][4] = bflo(qw.z); qf[sI][5] = bfhi(qw.z); qf[sI][6] = bflo(qw.w); qf[sI][7] = bfhi(qw.w);
#pragma unroll
            for (int j = 0; j < 8; ++j) ss += qf[sI][j] * qf[sI][j]; }
        ss += __shfl_xor(ss, 32);
        const float rs = rsqrtf(ss * (1.0f / 64.0f) + 1e-6f) * 0.125f;
#pragma unroll
        for (int sI = 0; sI < 4; ++sI)
#pragma unroll
            for (int j = 0; j < 8; ++j) qf[sI][j] = qf[sI][j] * rs * qg[16 * sI + 8 * hh + j];
        { const float pos = (float)positions[tok];
#pragma unroll
          for (int j = 0; j < 8; ++j) { const float oth = __shfl_xor(qf[0][j], 32); const float ang = pos * __expf(-(float)j * 0.125f * LN_THETA); float sn, cs; sincosf(ang, &sn, &cs);
              qf[0][j] = (hh == 0) ? (qf[0][j] * cs - oth * sn) : (qf[0][j] * cs + oth * sn); } }
        bf16x8 qr[4];
#pragma unroll
        for (int sI = 0; sI < 4; ++sI) { v4u w; w.x = pk2(qf[sI][0], qf[sI][1]); w.y = pk2(qf[sI][2], qf[sI][3]); w.z = pk2(qf[sI][4], qf[sI][5]); w.w = pk2(qf[sI][6], qf[sI][7]); qr[sI] = __builtin_bit_cast(bf16x8, w); }
        const int kt0 = qo >> 5;
        float mrun = -1e30f;
#pragma unroll 1
        for (int kt = 0; kt < 9; ++kt) { const int kbase = (kt0 + kt) * 32;
            f32x16 acc = {};
#pragma unroll
            for (int sI = 0; sI < 4; ++sI) { const bf16x8 kfr = *(const LAS bf16x8*)(KS + (kbase + r32) * KST + 16 * sI + 8 * hh); acc = __builtin_amdgcn_mfma_f32_32x32x16_bf16(kfr, qr[sI], acc, 0, 0, 0); }
#pragma unroll
            for (int r = 0; r < 16; ++r) { const int ki = kbase + (r & 3) + 8 * (r >> 2) + 4 * hh; const int dq = ki - 128 - qrel, kp = qb * 128 - 128 + ki;
                const bool ok = (dq >= -128) && (dq <= 128) && (kp >= 0) && (kp < T); mrun = fmaxf(mrun, ok ? acc[r] : -1e30f); } }
        mrun = fmaxf(mrun, __shfl_xor(mrun, 32));
        const float mx = fmaxf(mrun, snk);
        float lrun = 0.f; f32x16 o0 = {}, o1 = {};
#pragma unroll 1
        for (int kt = 0; kt < 9; ++kt) { const int kbase = (kt0 + kt) * 32;
            f32x16 acc = {};
#pragma unroll
            for (int sI = 0; sI < 4; ++sI) { const bf16x8 kfr = *(const LAS bf16x8*)(KS + (kbase + r32) * KST + 16 * sI + 8 * hh); acc = __builtin_amdgcn_mfma_f32_32x32x16_bf16(kfr, qr[sI], acc, 0, 0, 0); }
            float p[16];
#pragma unroll
            for (int r = 0; r < 16; ++r) { const int ki = kbase + (r & 3) + 8 * (r >> 2) + 4 * hh; const int dq = ki - 128 - qrel, kp = qb * 128 - 128 + ki;
                const bool ok = (dq >= -128) && (dq <= 128) && (kp >= 0) && (kp < T); p[r] = ok ? __expf(acc[r] - mx) : 0.f; lrun += p[r]; }
#pragma unroll
            for (int sI = 0; sI < 2; ++sI) { v4u pw; pw.x = pk2(p[8 * sI + 0], p[8 * sI + 1]); pw.y = pk2(p[8 * sI + 2], p[8 * sI + 3]); pw.z = pk2(p[8 * sI + 4], p[8 * sI + 5]); pw.w = pk2(p[8 * sI + 6], p[8 * sI + 7]);
                const bf16x8 pa = __builtin_bit_cast(bf16x8, pw); const int key0 = kbase + 16 * sI + 4 * hh;
                { const u32x2 lo = *(const LAS u32x2*)(VT + r32 * VST + key0), hi = *(const LAS u32x2*)(VT + r32 * VST + key0 + 8); v4u vw; vw.x = lo.x; vw.y = lo.y; vw.z = hi.x; vw.w = hi.y;
                  o0 = __builtin_amdgcn_mfma_f32_32x32x16_bf16(pa, __builtin_bit_cast(bf16x8, vw), o0, 0, 0, 0); }
                { const u32x2 lo = *(const LAS u32x2*)(VT + (32 + r32) * VST + key0), hi = *(const LAS u32x2*)(VT + (32 + r32) * VST + key0 + 8); v4u vw; vw.x = lo.x; vw.y = lo.y; vw.z = hi.x; vw.w = hi.y;
                  o1 = __builtin_amdgcn_mfma_f32_32x32x16_bf16(pa, __builtin_bit_cast(bf16x8, vw), o1, 0, 0, 0); } } }
        lrun += __shfl_xor(lrun, 32);
        const float linv = 1.0f / (lrun + __expf(snk - mx));
        if (hh == 0) wsf[wave * 64 + r32] = linv;
        LDS_WAIT(); asm volatile("" ::: "memory");
#pragma unroll
        for (int r = 0; r < 16; ++r) { const int row = (r & 3) + 8 * (r >> 2) + 4 * hh; const float li = wsf[wave * 64 + row];
            bf16* op = OA + ((size_t)b * T + qb * 128 + qo + row) * 512 + hq * 64;
            op[r32] = (bf16)f2bf(o0[r] * li); op[32 + r32] = (bf16)f2bf(o1[r] * li); }
        LDS_WAIT(); asm volatile("" ::: "memory");
    }
    __syncthreads();
}

__device__ __forceinline__ void pg_rows(const Frame& F, ArgsP A) {
    const bf16* Z = (const bf16*)(A->ws + WS_Z); const bf16* Y0 = (const bf16*)(A->ws + WS_XN); const bf16* Y1 = Y0 + (size_t)M * 512;
    bf16* Gb = (bf16*)(A->ws + WS_G); const float* bonus = (const float*)(A->ws + WS_BONUS);
    const float* mu_prev = (const float*)A->in[7]; const float* mu_next = (const float*)A->in[8]; const float* gn_w = (const float*)A->in[17]; const float* gn_b = (const float*)A->in[18];
    const int gw = F.vcu * NWAVES + F.wave, NGW = F.G * NWAVES, lane = F.lane, c0 = lane * 8, h = lane >> 3;
    float mp[8], mn[8], gw_[8], gb_[8];
#pragma unroll
    for (int j = 0; j < 8; ++j) { mp[j] = mu_prev[ZV + c0 + j]; mn[j] = mu_next[ZV + c0 + j]; gw_[j] = gn_w[c0 + j]; gb_[j] = gn_b[c0 + j]; }
    for (int m = gw; m < M; m += NGW) { const int t = m & (T - 1);
        const v4u y0 = *(const GAS v4u*)(Y0 + (size_t)m * 512 + c0), y1 = *(const GAS v4u*)(Y1 + (size_t)m * 512 + c0), gv = *(const GAS v4u*)(Gb + (size_t)m * 512 + c0);
        const v4u z0 = *(const GAS v4u*)(Z + (size_t)m * NZ + ZV + c0);
        v4u zm = {0u, 0u, 0u, 0u}, zq = {0u, 0u, 0u, 0u};
        if (t > 0) zm = *(const GAS v4u*)(Z + (size_t)(m - 1) * NZ + ZV + c0);
        if (t < T - 1) zq = *(const GAS v4u*)(Z + (size_t)(m + 1) * NZ + ZV + c0);
        const float bon = bonus[(size_t)m * 8 + h] + bonus[(size_t)M * 8 + (size_t)m * 8 + h];
        const unsigned y0w[4] = {y0.x, y0.y, y0.z, y0.w}, y1w[4] = {y1.x, y1.y, y1.z, y1.w}, gvw[4] = {gv.x, gv.y, gv.z, gv.w}, z0w[4] = {z0.x, z0.y, z0.z, z0.w}, zmw[4] = {zm.x, zm.y, zm.z, zm.w}, zqw[4] = {zq.x, zq.y, zq.z, zq.w};
        float y[8], gg[8], vv[8]; float s = 0.f;
#pragma unroll
        for (int j = 0; j < 4; ++j) { y[2 * j] = bflo(y0w[j]) + bflo(y1w[j]); y[2 * j + 1] = bfhi(y0w[j]) + bfhi(y1w[j]); gg[2 * j] = bflo(gvw[j]); gg[2 * j + 1] = bfhi(gvw[j]);
            const float a0 = bflo(z0w[j]), a1 = bfhi(z0w[j]);
            vv[2 * j] = a0 + mp[2 * j] * (bflo(zmw[j]) - a0) + mn[2 * j] * (bflo(zqw[j]) - a0); vv[2 * j + 1] = a1 + mp[2 * j + 1] * (bfhi(zmw[j]) - a1) + mn[2 * j + 1] * (bfhi(zqw[j]) - a1);
            s += y[2 * j] + y[2 * j + 1]; }
        s += __shfl_xor(s, 1); s += __shfl_xor(s, 2); s += __shfl_xor(s, 4);
        const float mu = s * (1.0f / 64.0f); float q = 0.f;
#pragma unroll
        for (int j = 0; j < 8; ++j) { const float d = y[j] - mu; q += d * d; }
        q += __shfl_xor(q, 1); q += __shfl_xor(q, 2); q += __shfl_xor(q, 4);
        const float rstd = rsqrtf(q * (1.0f / 64.0f) + 64e-5f);
        float o[8];
#pragma unroll
        for (int j = 0; j < 8; ++j) o[j] = ((y[j] - mu) * rstd * gw_[j] + gb_[j] + bon * vv[j]) * gg[j];
        v4u w; w.x = pk2(o[0], o[1]); w.y = pk2(o[2], o[3]); w.z = pk2(o[4], o[5]); w.w = pk2(o[6], o[7]);
        *(GAS v4u*)(Gb + (size_t)m * 512 + c0) = w; }
}

__device__ __forceinline__ void pj_phase(const Frame& F, ArgsP A) {
    unsigned char* ws = A->ws;
    const int gw = F.vcu * NWAVES + F.wave, NGW = F.G * NWAVES, lane = F.lane;
    { LAS float* scr = (LAS float*)(F.lds + F.wave * 16384);
      const float* w_gate = (const float*)A->in[27]; const float* w_up = (const float*)A->in[28]; const float* w_down = (const float*)A->in[29];
      bf16* WguT = (bf16*)(ws + WS_WGUT); bf16* WdT = (bf16*)(ws + WS_WDT);
      constexpr int PER = 512, NIT = 16 * 3 * PER;
      for (int it = gw; it < NIT; it += NGW) { const int e = it / (3 * PER), r = it % (3 * PER), which = r / PER, q = r % PER, kb = q >> 5, nb = q & 31, n0 = 32 * nb;
          if (which == 0) tr_item(w_gate + (size_t)e * 1048576, 1024, 64 * kb, n0, WguT, 1024, e * 2048 + (n0 >> 7) * 256 + (n0 & 127), scr, lane);
          else if (which == 1) tr_item(w_up + (size_t)e * 1048576, 1024, 64 * kb, n0, WguT, 1024, e * 2048 + (n0 >> 7) * 256 + 128 + (n0 & 127), scr, lane);
          else tr_item(w_down + (size_t)e * 1048576, 1024, 64 * kb, n0, WdT, 1024, e * 1024 + n0, scr, lane); }
    }
    __syncthreads();
    LAS float* wrT = (LAS float*)F.lds;
    const float* w_router = (const float*)A->in[26];
    for (int i = F.tid; i < 16384; i += 512) { const int d = i >> 4, e = i & 15; wrT[e * 1024 + d] = w_router[i]; }
    __syncthreads();
    const float* x1 = A->out; const float* g2n = (const float*)A->in[25]; const float* mod = (const float*)(ws + WS_MOD);
    bf16* XN2 = (bf16*)(ws + WS_XN); float* aff = (float*)(ws + WS_AFF);
    for (int m = gw; m < M; m += NGW) { const int b = m >> 11, t = m & (T - 1);
        f32x4 u[4];
        modnorm_row(x1 + (size_t)m * 1024, g2n, mod + (size_t)b * 6144 + 3072, mod + (size_t)b * 6144 + 4096, XN2 + (size_t)m * 1024, lane, u);
        float mylg = 0.f;
#pragma unroll 2
        for (int e = 0; e < 16; ++e) { float s = 0.f;
#pragma unroll
            for (int j = 0; j < 4; ++j) { const f32x4 w = *(const LAS f32x4*)(wrT + e * 1024 + 4 * lane + 256 * j); s += (u[j].x * w.x + u[j].y * w.y) + (u[j].z * w.z + u[j].w * w.w); }
            s = wave_sum(s); mylg = (lane == e) ? s : mylg; }
        float mx = mylg;
#pragma unroll
        for (int o = 1; o < 16; o <<= 1) mx = fmaxf(mx, __shfl_xor(mx, o));
        const float ex = expf(mylg - mx); float den = ex;
#pragma unroll
        for (int o = 1; o < 16; o <<= 1) den += __shfl_xor(den, o);
        if (lane < 16) aff[((size_t)b * 16 + lane) * T + t] = ex / den; }
}

__device__ __forceinline__ void pk_task(const Frame& F, ArgsP A, int b, int e) {
    unsigned char* ws = A->ws;
    const float* aff = (const float*)(ws + WS_AFF) + ((size_t)b * 16 + e) * T;
    int* slotmap = (int*)(ws + WS_SLOT); float* selaff = (float*)(ws + WS_SELAFF);
    const bf16* XN2 = (const bf16*)(ws + WS_XN); bf16* XE = (bf16*)(ws + WS_XE);
    LAS unsigned* cnt = (LAS unsigned*)F.lds;
    LAS int* tokl = (LAS int*)(F.lds + 256);
    const int tid = F.tid, lane = F.lane, wave = F.wave;
    const f32x4 v4 = *(const GAS f32x4*)(aff + 4 * tid);
    const unsigned key[4] = {__float_as_uint(v4.x), __float_as_uint(v4.y), __float_as_uint(v4.z), __float_as_uint(v4.w)};
    unsigned thr = 0u;
#pragma unroll 1
    for (int bit = 31; bit >= 0; --bit) { const unsigned cand = thr | (1u << bit);
        int c = (key[0] >= cand) + (key[1] >= cand) + (key[2] >= cand) + (key[3] >= cand);
#pragma unroll
        for (int o = 1; o < 64; o <<= 1) c += __shfl_xor(c, o);
        if (lane == 0) cnt[wave] = (unsigned)c;
        __syncthreads();
        unsigned tot = 0;
#pragma unroll
        for (int w = 0; w < 8; ++w) tot += cnt[w];
        __syncthreads();
        if (tot >= 256u) thr = cand; }
    int ngt = 0, neq = 0;
#pragma unroll
    for (int j = 0; j < 4; ++j) { ngt += key[j] > thr; neq += key[j] == thr; }
    int sg = ngt, se = neq;
#pragma unroll
    for (int o = 1; o < 64; o <<= 1) { const int a = __shfl_up(sg, o), c = __shfl_up(se, o); if (lane >= o) { sg += a; se += c; } }
    if (lane == 63) { cnt[wave] = (unsigned)sg; cnt[8 + wave] = (unsigned)se; }
    __syncthreads();
    int bg = 0, be = 0, totg = 0;
#pragma unroll
    for (int w = 0; w < 8; ++w) { const int a = (int)cnt[w], c = (int)cnt[8 + w]; if (w < wave) { bg += a; be += c; } totg += a; }
    int pg = bg + sg - ngt, pe = be + se - neq;
    const int need_eq = 256 - totg;
    int* smrow = slotmap + ((size_t)b * T + 4 * tid) * 16 + e;
#pragma unroll
    for (int j = 0; j < 4; ++j) { int slot = -1;
        if (key[j] > thr) { slot = pg; ++pg; } else if (key[j] == thr) { if (pe < need_eq) slot = totg + pe; ++pe; }
        smrow[j * 16] = slot;
        if (slot >= 0) { tokl[slot] = 4 * tid + j; selaff[((size_t)e * 16 + b) * 256 + slot] = __uint_as_float(key[j]); } }
    __syncthreads();
    for (int sl = wave; sl < 256; sl += 8) { const int tk = tokl[sl];
        const GAS v4u* src = (const GAS v4u*)(XN2 + ((size_t)b * T + tk) * 1024); GAS v4u* dst = (GAS v4u*)(XE + (((size_t)e * 16 + b) * 256 + sl) * 1024);
        dst[lane] = src[lane]; dst[64 + lane] = src[64 + lane]; }
    __syncthreads();
}

__device__ __forceinline__ void pn_rows(const Frame& F, ArgsP A) {
    unsigned char* ws = A->ws;
    const int* slotmap = (const int*)(ws + WS_SLOT); const bf16* YE = (const bf16*)(ws + WS_XE); const float* mod = (const float*)(ws + WS_MOD); float* out = A->out;
    const int gw = F.vcu * NWAVES + F.wave, NGW = F.G * NWAVES, lane = F.lane;
    for (int m = gw; m < M; m += NGW) { const int b = m >> 11;
        float acc[16];
#pragma unroll
        for (int j = 0; j < 16; ++j) acc[j] = 0.f;
        const int myslot = slotmap[(size_t)m * 16 + (lane & 15)];
#pragma unroll 1
        for (int e = 0; e < 16; ++e) { const int sl = __shfl(myslot, e);
            if (sl >= 0) { const GAS v4u* yr = (const GAS v4u*)(YE + (((size_t)e * 16 + b) * 256 + sl) * 1024);
#pragma unroll
                for (int hlf = 0; hlf < 2; ++hlf) { const v4u w = yr[hlf * 64 + lane];
                    acc[hlf * 8 + 0] += bflo(w.x); acc[hlf * 8 + 1] += bfhi(w.x); acc[hlf * 8 + 2] += bflo(w.y); acc[hlf * 8 + 3] += bfhi(w.y);
                    acc[hlf * 8 + 4] += bflo(w.z); acc[hlf * 8 + 5] += bfhi(w.z); acc[hlf * 8 + 6] += bflo(w.w); acc[hlf * 8 + 7] += bfhi(w.w); } } }
        const float* gt2 = mod + (size_t)b * 6144 + 5120; float* orow = out + (size_t)m * 1024;
#pragma unroll
        for (int hlf = 0; hlf < 2; ++hlf)
#pragma unroll
            for (int q = 0; q < 2; ++q) { const int c = hlf * 512 + lane * 8 + q * 4; const f32x4 x = *(const GAS f32x4*)(orow + c), g = *(const GAS f32x4*)(gt2 + c);
                f32x4 a; a.x = acc[hlf * 8 + q * 4 + 0]; a.y = acc[hlf * 8 + q * 4 + 1]; a.z = acc[hlf * 8 + q * 4 + 2]; a.w = acc[hlf * 8 + q * 4 + 3];
                *(GAS f32x4*)(orow + c) = x + g * a; } }
}

__device__ __forceinline__ void mk_frame(Frame& F, LAS unsigned char* lds) {
    int bx = blockIdx.x, G = gridDim.x; LAUNDER(bx); LAUNDER(G);
    F.lds = lds; F.MISC = (volatile LAS unsigned*)(lds + MISC_OFF); F.ctl = nullptr;
    int tid_ = threadIdx.x; asm volatile("" : "+v"(tid_));
    F.tid = tid_; F.lane = F.tid & 63; F.wave = __builtin_amdgcn_readfirstlane(F.tid >> 6);
    F.G = G; F.vcu = (G % 8 == 0) ? (bx % 8) * (G / 8) + bx / 8 : bx;
}
__global__ void __launch_bounds__(NWAVES * 64, 2) fwd_kernel(Args args) {
    extern __shared__ __attribute__((aligned(16))) unsigned char lds[];
    LAS unsigned char* const ldsb = (LAS unsigned char*)lds;
    ArgsP ap0 = (ArgsP)__builtin_amdgcn_kernarg_segment_ptr();
    for (int u = threadIdx.x; u < (LDS_BYTES - LDSCTL_OFF) / 4; u += NWAVES * 64) ((LAS unsigned*)(ldsb + LDSCTL_OFF))[u] = 0u;
    __syncthreads();
#define MKBAR XcdBarrier bar; { ArgsP a_ = ap0; LAUNDER(a_); bar.bar = (unsigned*)(a_->ws + WS_CTL) + CW_BAR; bar.x = xb_xcc_id(); bar.st = (volatile LAS unsigned*)(ldsb + MISC_OFF) + 8; }
#if ONE_LAUNCH
    { MKBAR; if (threadIdx.x == 0) (void)xb_add(&bar.bar[XB_XCNT(bar.x)], 1u); }
#ifndef PHM
#define PHM 0x3fff
#endif
#define IN(k) ((PHM >> (k)) & 1)
#define SEAM(k) do { if (IN(k) && IN((k) + 1)) { MKBAR; xcd_barrier(bar); } } while (0)
#else
    int lo, hi; { ArgsP a = ap0; LAUNDER(a); lo = a->ph_lo; hi = a->ph_hi; }
#define IN(k) (lo <= (k) && (k) < hi)
#define SEAM(k) do { } while (0)
#endif
    typedef pg8::bf16_t pb;
#define PHASE_ARGS ArgsP ap = ap0; LAUNDER(ap); unsigned char* ws = ap->ws; (void)ws; Frame F; mk_frame(F, ldsb); const int gw = F.vcu * NWAVES + F.wave, NGW = F.G * NWAVES; (void)gw; (void)NGW
    if (IN(0)) { PHASE_ARGS; p0_prologue(F, ap); } SEAM(0);
    if (IN(1)) { PHASE_ARGS; const float* x = (const float*)ap->in[0]; const float* g1 = (const float*)ap->in[5]; const float* mod = (const float*)(ws + WS_MOD); bf16* XN = (bf16*)(ws + WS_XN);
        for (int m = gw; m < M; m += NGW) { const int b = m >> 11; f32x4 u[4]; modnorm_row(x + (size_t)m * 1024, g1, mod + (size_t)b * 6144, mod + (size_t)b * 6144 + 1024, XN + (size_t)m * 1024, F.lane, u); } } SEAM(1);
    if (IN(2)) { PHASE_ARGS; pg8::Gemm g{(const pb*)(ws + WS_XN), (const pb*)(ws + WS_WINT), M, NZP, D}; pg8::StaticOrder S; S.init(M, NZP, F.G, (int)blockIdx.x);
        pg8::EpiZ E{(pb*)(ws + WS_Z)}; pg8::gemm_phase<pg8::EpiZ, pg8::StaticOrder, true, true>(F.lds, g, S, E); } SEAM(2);
    if (IN(3)) { PHASE_ARGS;
        for (int c = F.vcu; c < 256; c += F.G) { scan_chain(F, ap, c >> 4, (c >> 1) & 7, c & 1); __syncthreads(); }
        for (int u = F.vcu; u < 512; u += F.G) { attn_unit(F, ap, u >> 5, (u >> 4) & 1, u & 15); }
        { const bf16* Z = (const bf16*)(ws + WS_Z); bf16* SGD = (bf16*)(ws + WS_SGD); const float* mu_prev = (const float*)ap->in[7]; const float* mu_next = (const float*)ap->in[8];
          const int c = ZGD + 2 * F.lane; const float mp0 = mu_prev[c], mp1 = mu_prev[c + 1], mn0 = mu_next[c], mn1 = mu_next[c + 1];
          for (int m = gw; m < M; m += NGW) { const int t = m & (T - 1);
              const unsigned z0 = *(const GAS unsigned*)(Z + (size_t)m * NZ + c), zm = t > 0 ? *(const GAS unsigned*)(Z + (size_t)(m - 1) * NZ + c) : 0u, zq = t < T - 1 ? *(const GAS unsigned*)(Z + (size_t)(m + 1) * NZ + c) : 0u;
              const float a0 = bflo(z0), a1 = bfhi(z0); const float s0 = a0 + mp0 * (bflo(zm) - a0) + mn0 * (bflo(zq) - a0), s1 = a1 + mp1 * (bfhi(zm) - a1) + mn1 * (bfhi(zq) - a1);
              *(GAS unsigned*)(SGD + (size_t)m * 256 + 2 * F.lane) = pk2(sigm(s0), sigm(s1)); *(GAS unsigned*)(SGD + (size_t)m * 256 + 128 + 2 * F.lane) = 0u; } }
    } SEAM(3);
    if (IN(4)) { PHASE_ARGS; pg8::Gemm g{(const pb*)(ws + WS_SGD), (const pb*)(ws + WS_G2T), M, 512, 256}; pg8::StaticOrder S; S.init(M, 512, F.G, (int)blockIdx.x);
        pg8::EpiPlain E{(pb*)(ws + WS_G), 512}; pg8::gemm_phase<pg8::EpiPlain, pg8::StaticOrder, true, true>(F.lds, g, S, E); } SEAM(4);
    if (IN(5)) { PHASE_ARGS; pg_rows(F, ap); } SEAM(5);
    if (IN(6)) { PHASE_ARGS; pg8::Gemm g{(const pb*)(ws + WS_G), (const pb*)(ws + WS_PRT), M, 1024, 512}; pg8::StaticOrder S; S.init(M, 1024, F.G, (int)blockIdx.x);
        pg8::EpiGate<false> E{(pb*)(ws + WS_XN), (const pb*)(ws + WS_Z), ZGA}; pg8::gemm_phase<pg8::EpiGate<false>, pg8::StaticOrder, true, true>(F.lds, g, S, E); } SEAM(6);
    if (IN(7)) { PHASE_ARGS; pg8::Gemm g{(const pb*)(ws + WS_OATT), (const pb*)(ws + WS_PAT), M, 1024, 512}; pg8::StaticOrder S; S.init(M, 1024, F.G, (int)blockIdx.x);
        pg8::EpiGate<true> E{(pb*)(ws + WS_XN), (const pb*)(ws + WS_Z), ZGB}; pg8::gemm_phase<pg8::EpiGate<true>, pg8::StaticOrder, true, true>(F.lds, g, S, E); } SEAM(7);
    if (IN(8)) { PHASE_ARGS; pg8::Gemm g{(const pb*)(ws + WS_XN), (const pb*)(ws + WS_WOT), M, 1024, 1024}; pg8::StaticOrder S; S.init(M, 1024, F.G, (int)blockIdx.x);
        pg8::EpiRes E{(const float*)ap->in[0], (const float*)(ws + WS_MOD), ap->out}; pg8::gemm_phase<pg8::EpiRes, pg8::StaticOrder, true, true>(F.lds, g, S, E); } SEAM(8);
    if (IN(9)) { PHASE_ARGS; pj_phase(F, ap); } SEAM(9);
    if (IN(10)) { PHASE_ARGS; for (int p = F.vcu; p < 256; p += F.G) pk_task(F, ap, p >> 4, p & 15); } SEAM(10);
    if (IN(11)) { PHASE_ARGS; pg8::Gemm g{(const pb*)(ws + WS_XE), (const pb*)(ws + WS_WGUT), ME, 16 * 2048, 1024}; pg8::GroupOrder<8> S{F.G, (int)blockIdx.x};
        pg8::EpiSwiglu E{(pb*)(ws + WS_H)}; pg8::gemm_phase<pg8::EpiSwiglu, pg8::GroupOrder<8>, true, true>(F.lds, g, S, E); } SEAM(11);
    if (IN(12)) { PHASE_ARGS; pg8::Gemm g{(const pb*)(ws + WS_H), (const pb*)(ws + WS_WDT), ME, 16 * 1024, 1024}; pg8::GroupOrder<4> S{F.G, (int)blockIdx.x};
        pg8::EpiDown E{(pb*)(ws + WS_XE), (const float*)(ws + WS_SELAFF)}; pg8::gemm_phase<pg8::EpiDown, pg8::GroupOrder<4>, true, true>(F.lds, g, S, E); } SEAM(12);
    if (IN(13)) { PHASE_ARGS; pn_rows(F, ap); }
#undef IN
#undef SEAM
}

extern "C" void kernel_launch(void* const* d_in, const int* in_sizes, int n_in, void* d_out, int out_size, void* d_ws, size_t ws_size, hipStream_t stream) {
    static int grid = 0;
    if (grid == 0) {
        if (n_in != 30 || out_size != M * D || ws_size < WS_END) { fprintf(stderr, "kernel_launch: unexpected shapes n_in %d out %d ws %zu\n", n_in, out_size, ws_size); grid = -1; return; }
        int dev = 0, cus = 0, per_cu = 0;
        if (hipGetDevice(&dev) != hipSuccess || hipDeviceGetAttribute(&cus, hipDeviceAttributeMultiprocessorCount, dev) != hipSuccess) { grid = -1; return; }
        if (hipFuncSetAttribute((const void*)fwd_kernel, hipFuncAttributeMaxDynamicSharedMemorySize, LDS_BYTES) != hipSuccess) { fprintf(stderr, "kernel_launch: hipFuncSetAttribute failed\n"); grid = -1; return; }
        if (hipOccupancyMaxActiveBlocksPerMultiprocessor(&per_cu, (const void*)fwd_kernel, NWAVES * 64, LDS_BYTES) != hipSuccess || per_cu < 1) fprintf(stderr, "kernel_launch: occupancy query reports %d\n", per_cu);
        (void)hipGetLastError();
        grid = cus;
    }
    if (grid < 0) return;
    if (hipMemsetAsync((char*)d_ws + WS_CTL, 0, CTL_ZERO_BYTES, stream) != hipSuccess) return;
    Args a{};
    for (int i = 0; i < 30; ++i) a.in[i] = d_in[i];
    a.out = (float*)d_out; a.ws = (unsigned char*)d_ws;
#if ONE_LAUNCH
    a.ph_lo = 0; a.ph_hi = NPHASE;
    hipLaunchKernelGGL(fwd_kernel, dim3(grid), dim3(NWAVES * 64), LDS_BYTES, stream, a);
#else
    for (int p = 0; p < NPHASE; ++p) { a.ph_lo = p; a.ph_hi = p + 1; hipLaunchKernelGGL(fwd_kernel, dim3(grid), dim3(NWAVES * 64), LDS_BYTES, stream, a); }
#endif
}
```

```cpp
#include <hip/hip_runtime.h>
#include <cstdio>
#include <cstdint>
#include <cmath>
namespace pg8 {
#define PG8_LAS __attribute__((address_space(3)))
typedef unsigned short bf16_t;
typedef short bf16x8 __attribute__((ext_vector_type(8)));
typedef float f32x4 __attribute__((ext_vector_type(4)));
typedef unsigned u32x4 __attribute__((ext_vector_type(4)));
constexpr int BM = 256, BK = 64, HALF = 128, HTB = HALF * BK * 2  , STAGE_BYTES = 8 * HTB, NXCD = 8, WGM = 8;

__host__ __device__ __forceinline__ int lds_byte(int r, int c) { const int st = (r >> 4) * 2 + (c >> 5), rr = r & 15, cc = c & 31, ob = rr * 64 + cc * 2; return st * 1024 + (ob ^ (((ob >> 9) & 1) << 5)); }
__host__ __device__ __forceinline__ void stage_rc(int b, int& R, int& C) { const int st = b / 1024, sb = b % 1024, swz = sb ^ (((sb >> 9) & 1) << 5); R = (st >> 1) * 16 + swz / 64; C = (st & 1) * 32 + (swz % 64) / 2; }
__host__ __device__ __forceinline__ int perm32(int rho) { const int n = rho >> 4, i = rho & 15; return 8 * (i >> 2) + 4 * n + (i & 3); }

struct Unit { int pm, pn; };
struct Gemm { const bf16_t* A; const bf16_t* Bt; int M, N, K; };

struct StaticOrder {
    int nM, nN, nwg, G, c;
    __host__ __device__ void init(int M, int N, int G_, int c_) { nM = M / BM; nN = N / BM; nwg = nM * nN; G = G_; c = c_; }
    __host__ __device__ bool next(int i, Unit& u) const {
        const long L = (long)i * G + c; if (L >= nwg) return false;
        int wgid = (int)L; { const int q = nwg / NXCD, r = nwg % NXCD, xcd = wgid % NXCD, off = wgid / NXCD; wgid = (xcd < r ? xcd * (q + 1) : r * (q + 1) + (xcd - r) * q) + off; }
        const int nig = WGM * nN, gid = wgid / nig, fm = gid * WGM, gsz = (nM - fm) < WGM ? (nM - fm) : WGM;
        u.pm = fm + ((wgid % nig) % gsz); u.pn = (wgid % nig) / gsz; return true;
    }
    __device__ __forceinline__ void a_ready(const Unit&) const {}
    __device__ __forceinline__ void done(const Unit&) const {}
};

__device__ __forceinline__ unsigned cvt_pk_bf16(float lo, float hi) { unsigned r; asm volatile("v_cvt_pk_bf16_f32 %0, %1, %2" : "=v"(r) : "v"(lo), "v"(hi)); return r; }
typedef float f32x2 __attribute__((ext_vector_type(2)));
template <class Epi, class Sched, bool ALIGN_EPI = false, bool SP2 = false, bool GATHER = false>
__device__ __forceinline__ void gemm_phase(PG8_LAS unsigned char* lds, const Gemm g, const Sched& S, const Epi& E, int tid_in, const int* gidx = nullptr) {
    static_assert(!GATHER || SP2, "the gather variant is written for the SP2 loop");
    int tid_ = tid_in; asm volatile("" : "+v"(tid_));
    const int tid = tid_, wid = __builtin_amdgcn_readfirstlane(tid >> 6), lane = tid & 63, wr = wid >> 2, wc = wid & 3, fr = lane & 15, fq = lane >> 4;
    const int K = g.K, nt = K / BK;
    unsigned voffA[2], voffB[2];
#pragma unroll
    for (int i = 0; i < 2; ++i) { int R, C; stage_rc(tid * 16 + i * 8192, R, C); const int Rb = Epi::PERM ? ((R & ~31) + perm32(R & 31)) : R;
        voffA[i] = (unsigned)(R * K + C) * 2u; voffB[i] = (unsigned)(Rb * K + C) * 2u; }
    int gRA[2] = {0, 0}; unsigned gCA[2] = {0u, 0u}; unsigned gc[2][2] = {{0u, 0u}, {0u, 0u}}, gn[2][2] = {{0u, 0u}, {0u, 0u}};
    if constexpr (GATHER) {
#pragma unroll
        for (int i = 0; i < 2; ++i) { int R, C; stage_rc(tid * 16 + i * 8192, R, C); gRA[i] = R; gCA[i] = (unsigned)C * 2u; } }
#define PG8_GLOAD(dst, un) do { _Pragma("unroll") for (int h_ = 0; h_ < 2; ++h_) _Pragma("unroll") for (int i_ = 0; i_ < 2; ++i_) \
        dst[h_][i_] = (unsigned)gidx[(un).pm * 256 + h_ * 128 + gRA[i_]] * (unsigned)(K * 2) + gCA[i_]; } while (0)
#define PG8_STAGE_G(bufoff, gbase, nx, h) do { unsigned vo_[2] = {(nx) ? gn[h][0] : gc[h][0], (nx) ? gn[h][1] : gc[h][1]}; PG8_STAGE(bufoff, gbase, vo_); } while (0)
    const size_t kstep = (size_t)(BK * 2);
    const size_t hstep = (size_t)HALF * K * 2;
    const size_t tstep = 2 * hstep;
    const unsigned ldsw = (unsigned)wid * 1024u;
    const int aoff = lds_byte(wr * 64 + fr, fq * 8), boff = lds_byte(wc * 32 + fr, fq * 8);
#define PG8_SA(b, h) (((b) * 2 + (h)) * HTB)
#define PG8_SB(b, h) ((4 + (b) * 2 + (h)) * HTB)
#define PG8_STAGE(bufoff, gbase, voff) do { _Pragma("unroll") for (int _i = 0; _i < 2; ++_i) \
        __builtin_amdgcn_global_load_lds((const unsigned*)((const char*)(gbase) + (voff)[_i]), (PG8_LAS unsigned*)(lds + (bufoff) + ldsw + _i * 8192), 16, 0, 0); } while (0)
#define PG8_LDA(dst, b, h) do { _Pragma("unroll") for (int m = 0; m < 4; ++m) _Pragma("unroll") for (int k = 0; k < 2; ++k) dst[m][k] = *(const PG8_LAS bf16x8*)(lds + PG8_SA(b, h) + aoff + m * 2048 + k * 1024); } while (0)
#define PG8_LDB(dst, b, h) do { _Pragma("unroll") for (int n = 0; n < 2; ++n) _Pragma("unroll") for (int k = 0; k < 2; ++k) dst[n][k] = *(const PG8_LAS bf16x8*)(lds + PG8_SB(b, h) + boff + n * 2048 + k * 1024); } while (0)
#define PG8_MMA(ai, bj, At, Bt) do { __builtin_amdgcn_s_setprio(1); _Pragma("unroll") for (int m = 0; m < 4; ++m) _Pragma("unroll") for (int n = 0; n < 2; ++n) _Pragma("unroll") for (int k = 0; k < 2; ++k) \
        acc[ai][bj][m][n] = __builtin_amdgcn_mfma_f32_16x16x32_bf16(Bt[n][k], At[m][k], acc[ai][bj][m][n], 0, 0, 0); __builtin_amdgcn_s_setprio(0); } while (0)
#define PG8_WAIT_V(n) asm volatile("s_waitcnt vmcnt(" #n ")" ::: "memory")
#define PG8_WAIT_L(n) asm volatile("s_waitcnt lgkmcnt(" #n ")" ::: "memory")
#define PG8_BAR __builtin_amdgcn_s_barrier()
#define PG8_SCHED __builtin_amdgcn_sched_barrier(0)
    Unit cur, nxt; int ui = 0;
    if (!S.next(0, cur)) return;
    f32x4 acc[2][2][4][2];
#pragma unroll
    for (int a = 0; a < 2; ++a)
#pragma unroll
        for (int b = 0; b < 2; ++b)
#pragma unroll
            for (int m = 0; m < 4; ++m)
#pragma unroll
                for (int n = 0; n < 2; ++n) acc[a][b][m][n] = (f32x4){0.f, 0.f, 0.f, 0.f};
    bf16x8 At[4][2], B0[2][2], B1[2][2];
    const char* cA = GATHER ? (const char*)g.A : (const char*)g.A + (size_t)cur.pm * tstep; const char* cB = (const char*)g.Bt + (size_t)cur.pn * tstep;
    if constexpr (GATHER) { PG8_GLOAD(gc, cur); Unit n1_; if (S.next(1, n1_)) PG8_GLOAD(gn, n1_); else { gn[0][0] = gc[0][0]; gn[0][1] = gc[0][1]; gn[1][0] = gc[1][0]; gn[1][1] = gc[1][1]; } }
    S.a_ready(cur);
    if constexpr (SP2) {
        PG8_STAGE(PG8_SB(0, 0), cB, voffB); PG8_STAGE(PG8_SB(0, 1), cB + hstep, voffB);
        if constexpr (GATHER) { PG8_STAGE_G(PG8_SA(0, 0), cA, false, 0); PG8_STAGE_G(PG8_SA(0, 1), cA, false, 1); } else { PG8_STAGE(PG8_SA(0, 0), cA, voffA); PG8_STAGE(PG8_SA(0, 1), cA + hstep, voffA); }
        if (wr == 1) PG8_BAR;
        PG8_WAIT_V(2); PG8_BAR;
        PG8_STAGE(PG8_SB(1, 0), cB + kstep, voffB); if constexpr (GATHER) PG8_STAGE_G(PG8_SA(1, 0), cA + kstep, false, 0); else PG8_STAGE(PG8_SA(1, 0), cA + kstep, voffA); PG8_STAGE(PG8_SB(1, 1), cB + hstep + kstep, voffB);
        PG8_WAIT_V(6); PG8_BAR;
    } else {
        PG8_STAGE(PG8_SB(0, 0), cB, voffB); PG8_STAGE(PG8_SA(0, 0), cA, voffA); PG8_STAGE(PG8_SB(0, 1), cB + hstep, voffB); PG8_STAGE(PG8_SA(0, 1), cA + hstep, voffA);
        if (wr == 1) PG8_BAR;
        PG8_WAIT_V(4); PG8_BAR;
        PG8_STAGE(PG8_SB(1, 0), cB + kstep, voffB); PG8_STAGE(PG8_SA(1, 0), cA + kstep, voffA); PG8_STAGE(PG8_SB(1, 1), cB + hstep + kstep, voffB);
        PG8_WAIT_V(6); PG8_BAR;
    }
    for (;;) {
        const bool has_next = S.next(ui + 1, nxt);
        if constexpr (GATHER) { if (!has_next) { gn[0][0] = gc[0][0]; gn[0][1] = gc[0][1]; gn[1][0] = gc[1][0]; gn[1][1] = gc[1][1]; } }
        const char* nA = (has_next && !GATHER) ? (const char*)g.A + (size_t)nxt.pm * tstep : cA; const char* nB = has_next ? (const char*)g.Bt + (size_t)nxt.pn * tstep : cB;
        for (int t = 0; t < nt; t += 2) {
            const bool last = (t == nt - 2);
            const char* a1 = cA + (size_t)(t + 1) * kstep;
            const char* a2 = last ? nA : cA + (size_t)(t + 2) * kstep; const char* b2 = last ? nB : cB + (size_t)(t + 2) * kstep;
            const char* a3 = a2 + kstep; const char* b3 = b2 + kstep;
            if (last && has_next) S.a_ready(nxt);
            if constexpr (SP2) {
            PG8_LDB(B0, 0, 0); PG8_LDB(B1, 0, 1); PG8_SCHED; PG8_LDA(At, 0, 0); if constexpr (GATHER) PG8_STAGE_G(PG8_SA(1, 1), a1, false, 1); else PG8_STAGE(PG8_SA(1, 1), a1 + hstep, voffA);
            PG8_WAIT_V(8); PG8_WAIT_L(0); PG8_BAR; PG8_MMA(0, 0, At, B0); PG8_MMA(0, 1, At, B1); PG8_BAR; PG8_SCHED;
            PG8_LDA(At, 0, 1); PG8_STAGE(PG8_SB(0, 0), b2, voffB); PG8_STAGE(PG8_SB(0, 1), b2 + hstep, voffB); if constexpr (GATHER) PG8_STAGE_G(PG8_SA(0, 0), a2, last, 0); else PG8_STAGE(PG8_SA(0, 0), a2, voffA);
            PG8_WAIT_V(8); PG8_WAIT_L(0); PG8_BAR; PG8_MMA(1, 0, At, B0); PG8_MMA(1, 1, At, B1); PG8_BAR; PG8_SCHED;
            PG8_LDB(B0, 1, 0); PG8_LDB(B1, 1, 1); PG8_SCHED; PG8_LDA(At, 1, 0); if constexpr (GATHER) PG8_STAGE_G(PG8_SA(0, 1), a2, last, 1); else PG8_STAGE(PG8_SA(0, 1), a2 + hstep, voffA);
            PG8_WAIT_V(8); PG8_WAIT_L(0); PG8_BAR; PG8_MMA(0, 0, At, B0); PG8_MMA(0, 1, At, B1); PG8_BAR; PG8_SCHED;
            PG8_LDA(At, 1, 1); PG8_STAGE(PG8_SB(1, 0), b3, voffB); PG8_STAGE(PG8_SB(1, 1), b3 + hstep, voffB); if constexpr (GATHER) PG8_STAGE_G(PG8_SA(1, 0), a3, last, 0); else PG8_STAGE(PG8_SA(1, 0), a3, voffA);
            PG8_WAIT_V(8); PG8_WAIT_L(0); PG8_BAR; PG8_MMA(1, 0, At, B0); PG8_MMA(1, 1, At, B1); PG8_BAR; PG8_SCHED;
            } else {
            PG8_LDB(B0, 0, 0); PG8_SCHED; PG8_LDA(At, 0, 0); PG8_STAGE(PG8_SA(1, 1), a1 + hstep, voffA);
            PG8_WAIT_L(8); PG8_BAR; PG8_WAIT_L(0); PG8_MMA(0, 0, At, B0); PG8_BAR; PG8_SCHED;
            PG8_LDB(B1, 0, 1); PG8_STAGE(PG8_SB(0, 0), b2, voffB);
            PG8_BAR; PG8_WAIT_L(0); PG8_MMA(0, 1, At, B1); PG8_BAR;
            PG8_LDA(At, 0, 1); PG8_STAGE(PG8_SA(0, 0), a2, voffA);
            PG8_BAR; PG8_WAIT_L(0); PG8_MMA(1, 0, At, B0); PG8_BAR; PG8_SCHED;
            PG8_STAGE(PG8_SB(0, 1), b2 + hstep, voffB);
            PG8_WAIT_V(6); PG8_BAR; PG8_MMA(1, 1, At, B1); PG8_BAR;
            PG8_LDB(B0, 1, 0); PG8_SCHED; PG8_LDA(At, 1, 0); PG8_STAGE(PG8_SA(0, 1), a2 + hstep, voffA);
            PG8_WAIT_L(8); PG8_BAR; PG8_WAIT_L(0); PG8_MMA(0, 0, At, B0); PG8_BAR; PG8_SCHED;
            PG8_LDB(B1, 1, 1); PG8_STAGE(PG8_SB(1, 0), b3, voffB);
            PG8_BAR; PG8_WAIT_L(0); PG8_MMA(0, 1, At, B1); PG8_BAR;
            PG8_LDA(At, 1, 1); PG8_STAGE(PG8_SA(1, 0), a3, voffA);
            PG8_BAR; PG8_WAIT_L(0); PG8_MMA(1, 0, At, B0); PG8_BAR; PG8_SCHED;
            PG8_STAGE(PG8_SB(1, 1), b3 + hstep, voffB);
            PG8_WAIT_V(6); PG8_BAR; PG8_MMA(1, 1, At, B1); PG8_BAR;
            }
        }
        if constexpr (ALIGN_EPI) { if (wr == 0) PG8_BAR; }
        if constexpr (!Epi::AFTER_DRAIN) { E(acc, cur, wr, wc, fr, fq); S.done(cur); }
        unsigned g2_[2][2] = {{0u, 0u}, {0u, 0u}};
        if constexpr (GATHER) { Unit nn_; if (has_next && S.next(ui + 2, nn_)) PG8_GLOAD(g2_, nn_); else { g2_[0][0] = gn[0][0]; g2_[0][1] = gn[0][1]; g2_[1][0] = gn[1][0]; g2_[1][1] = gn[1][1]; } }
        if (!has_next) break;
#pragma unroll
        for (int a = 0; a < 2; ++a)
#pragma unroll
            for (int b = 0; b < 2; ++b)
#pragma unroll
                for (int m = 0; m < 4; ++m)
#pragma unroll
                    for (int n = 0; n < 2; ++n) acc[a][b][m][n] = (f32x4){0.f, 0.f, 0.f, 0.f};
        cur = nxt; cA = nA; cB = nB; ++ui;
        if constexpr (GATHER) { gc[0][0] = gn[0][0]; gc[0][1] = gn[0][1]; gc[1][0] = gn[1][0]; gc[1][1] = gn[1][1]; gn[0][0] = g2_[0][0]; gn[0][1] = g2_[0][1]; gn[1][0] = g2_[1][0]; gn[1][1] = g2_[1][1]; }
        if constexpr (ALIGN_EPI) { if (wr == 1) PG8_BAR; }
    }
    PG8_WAIT_V(0);
    if constexpr (!ALIGN_EPI) { if (wr == 0) PG8_BAR; }
    PG8_BAR;
    if constexpr (Epi::AFTER_DRAIN) { E.fused(acc, cur, wr, wc, fr, fq, lds, wid, lane); S.done(cur); }
#undef PG8_SA
#undef PG8_SB
#undef PG8_STAGE
#undef PG8_STAGE_G
#undef PG8_GLOAD
#undef PG8_LDA
#undef PG8_LDB
#undef PG8_MMA
#undef PG8_WAIT_V
#undef PG8_WAIT_L
#undef PG8_BAR
#undef PG8_SCHED
}
}

#ifndef ONE_LAUNCH
#define ONE_LAUNCH 1
#endif
constexpr int NB = 16, T = 2048, D = 1024, M = NB * T;
constexpr int NZ = 4736, NZP = 4864;
constexpr int RW = 512, NE = 16, CAP = 256, ME = NE * NB * CAP;
constexpr int ZR = 0, ZK = 512, ZV = 1024, ZWD = 1536, ZAD = 1664, ZGD = 1792, ZQ = 1920, ZKA = 2432, ZVA = 2560, ZGA = 2688, ZGB = 3712;
constexpr int NWAVES = 8, NPHASE = 14;
constexpr size_t MiB = 1u << 20;
constexpr size_t WS_CTL = 0, CTL_ZERO_BYTES = 64 * 1024 + 16 * 6144 * 4;
constexpr size_t WS_MOD = 64 * 1024, WS_BONUS = 2 * MiB, WS_AFF = 4 * MiB, WS_SELAFF = 6 * MiB, WS_SLOT = 7 * MiB, WS_G2T = 9 * MiB;
constexpr size_t WS_WINT = 10 * MiB, WS_PRT = 20 * MiB, WS_PAT = 21 * MiB, WS_WOT = 22 * MiB, WS_SGD = 24 * MiB;
constexpr size_t WS_XN = 40 * MiB;
constexpr size_t WS_OATT = 104 * MiB;
constexpr size_t WS_G = 136 * MiB;
constexpr size_t WS_Z = 168 * MiB;
constexpr size_t WS_X1 = 104 * MiB;
constexpr size_t OUT_WGUT = 0;
constexpr size_t OUT_WDT = 64 * MiB;
constexpr size_t WS_XE = 200 * MiB;
constexpr size_t WS_H = 328 * MiB;
constexpr size_t WS_END = 464 * MiB;
constexpr size_t WS_ROPE = WS_AFF;
constexpr size_t WS_SELIDX = WS_SELAFF + 512 * 1024;
constexpr int CW_BAR = 4096;
constexpr int RING_BYTES = 131072, LDSCTL_OFF = RING_BYTES, MISC_OFF = LDSCTL_OFF + 320, LDS_BYTES = 147456;

#define GAS __attribute__((address_space(1)))
#define LAS __attribute__((address_space(3)))
typedef unsigned short bf16;
typedef unsigned v4u __attribute__((ext_vector_type(4)));
typedef float f32x4 __attribute__((ext_vector_type(4)));
typedef short bf16x8 __attribute__((ext_vector_type(8)));
typedef GAS unsigned gu32;
typedef GAS unsigned long long gu64;
#define RLX_AGENT __ATOMIC_RELAXED, __HIP_MEMORY_SCOPE_AGENT
#define LDS_WAIT() asm volatile("s_waitcnt lgkmcnt(0)" ::: "memory")
#define VM_WAIT() asm volatile("s_waitcnt vmcnt(0)" ::: "memory")
__device__ __forceinline__ unsigned long long rt() { return __builtin_amdgcn_s_memrealtime(); }
__device__ __forceinline__ unsigned f2bf(float f) { unsigned u = __builtin_bit_cast(unsigned, f); return (u + 0x7fffu + ((u >> 16) & 1u)) >> 16; }
typedef float f32x2hw __attribute__((ext_vector_type(2))); typedef __bf16 bf16x2hw __attribute__((ext_vector_type(2)));
__device__ __forceinline__ unsigned pk2(float lo, float hi) { f32x2hw v = {lo, hi}; bf16x2hw b = __builtin_convertvector(v, bf16x2hw); return __builtin_bit_cast(unsigned, b); }

#define XB_TMO      128
#define XB_XCNT(j)  (256  + 64 * (j))
#define XB_XSUB(j)  (1280 + 64 * (j))
#define XB_XGEN(j)  (2304 + 64 * (j))
#define XB_TOP      3328
#define XB_TOPGEN   3392
#define XCD_BAR_WORDS 3456
#define XB_SPIN_CAP (1u << 18)

__device__ __forceinline__ unsigned xb_ld(unsigned* p)              { return __hip_atomic_load(p, __ATOMIC_RELAXED, __HIP_MEMORY_SCOPE_AGENT); }
__device__ __forceinline__ unsigned xb_add(unsigned* p, unsigned v) { return __hip_atomic_fetch_add(p, v, __ATOMIC_RELAXED, __HIP_MEMORY_SCOPE_AGENT); }
__device__ __forceinline__ unsigned xb_xcc_id() { return (unsigned)__builtin_amdgcn_s_getreg((3 << 11) | 20) & 0xFu; }
#define XB_SPIN(cond, bar) do { unsigned _sp = 0; while (cond) { __builtin_amdgcn_s_sleep(1); \
    if ((++_sp & 255u) == 0u) { if (xb_ld(&(bar)[XB_TMO])) break; if (_sp > XB_SPIN_CAP) { atomicAdd(&(bar)[XB_TMO], 1u); break; } } } } while (0)

struct XcdBarrier {
    unsigned* bar; unsigned x;
    volatile LAS unsigned* st;
};

__device__ __forceinline__ XcdBarrier xcd_barrier_post(unsigned* bar, volatile LAS unsigned* st) {
    XcdBarrier b; b.bar = bar; b.x = xb_xcc_id(); b.st = st;
    if (threadIdx.x == 0) (void)xb_add(&bar[XB_XCNT(b.x)], 1u);
    return b;
}
__device__ __forceinline__ void xcd_barrier_complete(unsigned* bar, unsigned x, unsigned& nloc, unsigned& nx) {
    const unsigned G = gridDim.x * gridDim.y * gridDim.z;
    unsigned sum, cnt, mine, sp = 0u;
    for (;;) {
        sum = 0u; cnt = 0u; mine = 0u;
#pragma unroll
        for (unsigned j = 0; j < 16; ++j) { const unsigned c = xb_ld(&bar[XB_XCNT(j)]); sum += c; cnt += (c > 0u) ? 1u : 0u; mine = (j == x) ? c : mine; }
        if (sum == G) break;
        __builtin_amdgcn_s_sleep(1);
        if ((++sp & 255u) == 0u) { if (xb_ld(&bar[XB_TMO])) break; if (sp > XB_SPIN_CAP) { atomicAdd(&bar[XB_TMO], 1u); break; } }
    }
    nloc = mine > 0u ? mine : 1u; nx = cnt > 0u ? cnt : 1u;
}

__device__ __forceinline__ void xcd_barrier(const XcdBarrier& b, bool is_thread0) {
    asm volatile("s_waitcnt vmcnt(0)" ::: "memory");
    __syncthreads();
    if (is_thread0) {
        unsigned* bar = b.bar;
        __builtin_amdgcn_s_waitcnt(0);
        unsigned nloc = b.st[0], nx = b.st[1];
        if (nloc == 0u) { xcd_barrier_complete(bar, b.x, nloc, nx); b.st[0] = nloc; b.st[1] = nx; }
        const unsigned old = xb_add(&bar[XB_XSUB(b.x)], 1u);
        const unsigned gen = old / nloc;
        if (old + 1u == (gen + 1u) * nloc) {
            __builtin_amdgcn_fence(__ATOMIC_RELEASE, "agent");
            asm volatile("s_waitcnt vmcnt(0)" ::: "memory");
            const unsigned og = xb_add(&bar[XB_TOP], 1u);
            const unsigned tg = og / nx;
            if (og + 1u == (tg + 1u) * nx) xb_add(&bar[XB_TOPGEN], 1u);
            else XB_SPIN(xb_ld(&bar[XB_TOPGEN]) == tg, bar);
            __builtin_amdgcn_fence(__ATOMIC_ACQUIRE, "agent");
            xb_add(&bar[XB_XGEN(b.x)], 1u);
            asm volatile("s_waitcnt vmcnt(0)" ::: "memory");
        } else {
            XB_SPIN(xb_ld(&bar[XB_XGEN(b.x)]) == gen, bar);
            __builtin_amdgcn_fence(__ATOMIC_ACQUIRE, "agent");
            asm volatile("s_waitcnt vmcnt(0)" ::: "memory");
        }
    }
    __syncthreads();
}
namespace pg8 {
__device__ __forceinline__ float bf2f(unsigned short h) { return __uint_as_float(((unsigned)h) << 16); }
__device__ __forceinline__ float bflo(unsigned w) { return __uint_as_float(w << 16); }
__device__ __forceinline__ float bfhi(unsigned w) { return __uint_as_float(w & 0xffff0000u); }
__device__ __forceinline__ float sigm(float x) { return 1.0f / (1.0f + __expf(-x)); }
struct EpiZ { static constexpr bool PERM = true, AFTER_DRAIN = false; bf16_t* O;
    __device__ __forceinline__ void operator()(const f32x4 (&acc)[2][2][4][2], const Unit& u, int wr, int wc, int fr, int fq) const {
        const int row0 = u.pm * BM + wr * 64 + fr, col0 = u.pn * BM + wc * 32 + 8 * fq;
#pragma unroll
        for (int ai = 0; ai < 2; ++ai)
#pragma unroll
            for (int m = 0; m < 4; ++m) { bf16_t* rowp = O + (size_t)(row0 + ai * HALF + m * 16) * 4736 + col0;
#pragma unroll
                for (int bj = 0; bj < 2; ++bj) { if (u.pn * BM + bj * HALF < 4736) { const f32x4 v0 = acc[ai][bj][m][0], v1 = acc[ai][bj][m][1];
                    u32x4 w; w.x = cvt_pk_bf16(v0[0], v0[1]); w.y = cvt_pk_bf16(v0[2], v0[3]); w.z = cvt_pk_bf16(v1[0], v1[1]); w.w = cvt_pk_bf16(v1[2], v1[3]);
                    *(u32x4*)(rowp + bj * HALF) = w; } } }
    }
};
struct EpiPlain { static constexpr bool PERM = true, AFTER_DRAIN = false; bf16_t* O; int ldc;
    __device__ __forceinline__ void operator()(const f32x4 (&acc)[2][2][4][2], const Unit& u, int wr, int wc, int fr, int fq) const {
        const int row0 = u.pm * BM + wr * 64 + fr, col0 = u.pn * BM + wc * 32 + 8 * fq;
#pragma unroll
        for (int ai = 0; ai < 2; ++ai)
#pragma unroll
            for (int m = 0; m < 4; ++m) { bf16_t* rowp = O + (size_t)(row0 + ai * HALF + m * 16) * ldc + col0;
#pragma unroll
                for (int bj = 0; bj < 2; ++bj) { const f32x4 v0 = acc[ai][bj][m][0], v1 = acc[ai][bj][m][1];
                    u32x4 w; w.x = cvt_pk_bf16(v0[0], v0[1]); w.y = cvt_pk_bf16(v0[2], v0[3]); w.z = cvt_pk_bf16(v1[0], v1[1]); w.w = cvt_pk_bf16(v1[2], v1[3]);
                    *(u32x4*)(rowp + bj * HALF) = w; } }
    }
};
template <bool ADD> struct EpiGate { static constexpr bool PERM = true, AFTER_DRAIN = false; bf16_t* O; const bf16_t* Z; int zc0;
    __device__ __forceinline__ void operator()(const f32x4 (&acc)[2][2][4][2], const Unit& u, int wr, int wc, int fr, int fq) const {
        const int row0 = u.pm * BM + wr * 64 + fr, col0 = u.pn * BM + wc * 32 + 8 * fq;
#pragma unroll
        for (int ai = 0; ai < 2; ++ai)
#pragma unroll
            for (int m = 0; m < 4; ++m) { const size_t row = (size_t)(row0 + ai * HALF + m * 16); bf16_t* rowp = O + row * 1024 + col0; const bf16_t* zp = Z + row * 4736 + zc0 + col0;
#pragma unroll
                for (int bj = 0; bj < 2; ++bj) { const f32x4 v0 = acc[ai][bj][m][0], v1 = acc[ai][bj][m][1];
                    const u32x4 zg = *(const u32x4*)(zp + bj * HALF);
                    float r0 = sigm(bflo(zg.x)) * v0[0], r1 = sigm(bfhi(zg.x)) * v0[1], r2 = sigm(bflo(zg.y)) * v0[2], r3 = sigm(bfhi(zg.y)) * v0[3];
                    float r4 = sigm(bflo(zg.z)) * v1[0], r5 = sigm(bfhi(zg.z)) * v1[1], r6 = sigm(bflo(zg.w)) * v1[2], r7 = sigm(bfhi(zg.w)) * v1[3];
                    if (ADD) { const u32x4 p = *(const u32x4*)(rowp + bj * HALF);
                        r0 += bflo(p.x); r1 += bfhi(p.x); r2 += bflo(p.y); r3 += bfhi(p.y); r4 += bflo(p.z); r5 += bfhi(p.z); r6 += bflo(p.w); r7 += bfhi(p.w); }
                    u32x4 w; w.x = cvt_pk_bf16(r0, r1); w.y = cvt_pk_bf16(r2, r3); w.z = cvt_pk_bf16(r4, r5); w.w = cvt_pk_bf16(r6, r7);
                    *(u32x4*)(rowp + bj * HALF) = w; } }
    }
};
struct EpiGate2 { static constexpr bool PERM = true, AFTER_DRAIN = false; bf16_t* O; const bf16_t* Z;
    __device__ __forceinline__ void operator()(const f32x4 (&acc)[2][2][4][2], const Unit& u, int wr, int wc, int fr, int fq) const {
        const bool add = u.pm < 128; const int zc0 = add ? 3712 : 2688;
        const int row0 = (u.pm & 127) * BM + wr * 64 + fr, col0 = (u.pn & 3) * BM + wc * 32 + 8 * fq;
#pragma unroll
        for (int ai = 0; ai < 2; ++ai) {
            u32x4 zg[4][2], pv[4][2];
#pragma unroll
            for (int m = 0; m < 4; ++m) { const size_t row = (size_t)(row0 + ai * HALF + m * 16);
#pragma unroll
                for (int bj = 0; bj < 2; ++bj) { zg[m][bj] = *(const u32x4*)(Z + row * 4736 + zc0 + col0 + bj * HALF); pv[m][bj] = (u32x4){0u, 0u, 0u, 0u}; if (add) pv[m][bj] = *(const u32x4*)(O + row * 1024 + col0 + bj * HALF); } }
#pragma unroll
            for (int m = 0; m < 4; ++m) { const size_t row = (size_t)(row0 + ai * HALF + m * 16); bf16_t* rowp = O + row * 1024 + col0;
#pragma unroll
                for (int bj = 0; bj < 2; ++bj) { const f32x4 v0 = acc[ai][bj][m][0], v1 = acc[ai][bj][m][1]; const u32x4 g = zg[m][bj], p = pv[m][bj];
                    const float r0 = sigm(bflo(g.x)) * v0[0] + bflo(p.x), r1 = sigm(bfhi(g.x)) * v0[1] + bfhi(p.x), r2 = sigm(bflo(g.y)) * v0[2] + bflo(p.y), r3 = sigm(bfhi(g.y)) * v0[3] + bfhi(p.y);
                    const float r4 = sigm(bflo(g.z)) * v1[0] + bflo(p.z), r5 = sigm(bfhi(g.z)) * v1[1] + bfhi(p.z), r6 = sigm(bflo(g.w)) * v1[2] + bflo(p.w), r7 = sigm(bfhi(g.w)) * v1[3] + bfhi(p.w);
                    u32x4 w; w.x = cvt_pk_bf16(r0, r1); w.y = cvt_pk_bf16(r2, r3); w.z = cvt_pk_bf16(r4, r5); w.w = cvt_pk_bf16(r6, r7);
                    *(u32x4*)(rowp + bj * HALF) = w; } } }
    }
};
struct MergeOrder { StaticOrder S; int nu;
    __device__ __forceinline__ void init(int G, int c) { S.init(32768, 1024, G, c); nu = (512 - c + G - 1) / G; }
    __device__ __forceinline__ bool next(int i, Unit& u) const { if (i >= 2 * nu) return false; Unit t; S.next(i < nu ? i : i - nu, t);
        if (i < nu) { u.pm = 128 + t.pm; u.pn = t.pn; } else { u.pm = t.pm; u.pn = 4 + t.pn; } return true; }
    __device__ __forceinline__ void a_ready(const Unit&) const {}
    __device__ __forceinline__ void done(const Unit&) const {}
};
struct EpiRes { static constexpr bool PERM = true, AFTER_DRAIN = false; const float* X; const float* mod; bf16_t* O;
    __device__ __forceinline__ void operator()(const f32x4 (&acc)[2][2][4][2], const Unit& u, int wr, int wc, int fr, int fq) const {
        const int row0 = u.pm * BM + wr * 64 + fr, col0 = u.pn * BM + wc * 32 + 8 * fq; const int b = (u.pm * BM) >> 11;
        f32x4 gt[2][2];
#pragma unroll
        for (int bj = 0; bj < 2; ++bj)
#pragma unroll
            for (int n = 0; n < 2; ++n) gt[bj][n] = *(const f32x4*)(mod + (size_t)b * 6144 + 2048 + col0 + bj * HALF + n * 4);
#pragma unroll
        for (int ai = 0; ai < 2; ++ai) { f32x4 xv[4][2][2];
#pragma unroll
            for (int m = 0; m < 4; ++m) { const size_t off = (size_t)(row0 + ai * HALF + m * 16) * 1024 + col0;
#pragma unroll
                for (int bj = 0; bj < 2; ++bj) { xv[m][bj][0] = *(const f32x4*)(X + off + bj * HALF); xv[m][bj][1] = *(const f32x4*)(X + off + bj * HALF + 4); } }
#pragma unroll
            for (int m = 0; m < 4; ++m) { const size_t off = (size_t)(row0 + ai * HALF + m * 16) * 1024 + col0;
#pragma unroll
                for (int bj = 0; bj < 2; ++bj) { const f32x4 v0 = xv[m][bj][0] + gt[bj][0] * acc[ai][bj][m][0], v1 = xv[m][bj][1] + gt[bj][1] * acc[ai][bj][m][1];
                    u32x4 w; w.x = cvt_pk_bf16(v0[0], v0[1]); w.y = cvt_pk_bf16(v0[2], v0[3]); w.z = cvt_pk_bf16(v1[0], v1[1]); w.w = cvt_pk_bf16(v1[2], v1[3]);
                    *(u32x4*)(O + off + bj * HALF) = w; } } }
    }
};
template <int NPL> struct GroupOrder { int G, c;
    __device__ __forceinline__ bool next(int i, Unit& u) const { const int L = i * G + c; if (L >= 256 * NPL) return false;
        const int e = L / (16 * NPL), r = L % (16 * NPL); u.pm = e * 16 + (r % 16); u.pn = e * NPL + r / 16; return true; }
    __device__ __forceinline__ void a_ready(const Unit&) const {}
    __device__ __forceinline__ void done(const Unit&) const {}
};
struct EpiSwiglu { static constexpr bool PERM = true, AFTER_DRAIN = false; bf16_t* O;
    __device__ __forceinline__ void operator()(const f32x4 (&acc)[2][2][4][2], const Unit& u, int wr, int wc, int fr, int fq) const {
        const int row0 = u.pm * BM + wr * 64 + fr, col0 = (u.pn & 7) * 128 + wc * 32 + 8 * fq;
#pragma unroll
        for (int ai = 0; ai < 2; ++ai)
#pragma unroll
            for (int m = 0; m < 4; ++m) { bf16_t* rowp = O + (size_t)(row0 + ai * HALF + m * 16) * 1024 + col0;
                float r[8];
#pragma unroll
                for (int n = 0; n < 2; ++n)
#pragma unroll
                    for (int i = 0; i < 4; ++i) { const float g = acc[ai][0][m][n][i], up = acc[ai][1][m][n][i]; r[n * 4 + i] = g * sigm(g) * up; }
                u32x4 w; w.x = cvt_pk_bf16(r[0], r[1]); w.y = cvt_pk_bf16(r[2], r[3]); w.z = cvt_pk_bf16(r[4], r[5]); w.w = cvt_pk_bf16(r[6], r[7]);
                *(u32x4*)rowp = w; }
    }
};
struct EpiDown { static constexpr bool PERM = true, AFTER_DRAIN = false; bf16_t* O; const float* aff;
    __device__ __forceinline__ void operator()(const f32x4 (&acc)[2][2][4][2], const Unit& u, int wr, int wc, int fr, int fq) const {
        const int row0 = u.pm * BM + wr * 64 + fr, col0 = (u.pn & 3) * BM + wc * 32 + 8 * fq;
        float av[2][4];
#pragma unroll
        for (int ai = 0; ai < 2; ++ai)
#pragma unroll
            for (int m = 0; m < 4; ++m) av[ai][m] = aff[row0 + ai * HALF + m * 16];
#pragma unroll
        for (int ai = 0; ai < 2; ++ai)
#pragma unroll
            for (int m = 0; m < 4; ++m) { const int row = row0 + ai * HALF + m * 16; const float a = av[ai][m]; bf16_t* rowp = O + (size_t)row * 1024 + col0;
#pragma unroll
                for (int bj = 0; bj < 2; ++bj) { const f32x4 v0 = acc[ai][bj][m][0] * a, v1 = acc[ai][bj][m][1] * a;
                    u32x4 w; w.x = cvt_pk_bf16(v0[0], v0[1]); w.y = cvt_pk_bf16(v0[2], v0[3]); w.z = cvt_pk_bf16(v1[0], v1[1]); w.w = cvt_pk_bf16(v1[2], v1[3]);
                    *(u32x4*)(rowp + bj * HALF) = w; } }
    }
};
}

struct Frame { LAS unsigned char* lds; volatile LAS unsigned* MISC; gu32* ctl; int tid, lane, wave, vcu, G; };
struct Args { const void* in[30]; float* out; unsigned char* ws; int ph_lo, ph_hi; };
typedef const __attribute__((address_space(4))) Args* ArgsP;
#define LAUNDER(p) asm volatile("" : "+s"(p))
typedef float f32x16 __attribute__((ext_vector_type(16)));
typedef unsigned u32x2 __attribute__((ext_vector_type(2)));

__device__ __forceinline__ float wave_sum(float v) {
#pragma unroll
    for (int o = 1; o < 64; o <<= 1) v += __shfl_xor(v, o);
    return v;
}
__device__ __forceinline__ float bf2f(bf16 h) { return __uint_as_float(((unsigned)h) << 16); }
__device__ __forceinline__ float bflo(unsigned w) { return __uint_as_float(w << 16); }
__device__ __forceinline__ float bfhi(unsigned w) { return __uint_as_float(w & 0xffff0000u); }
__device__ __forceinline__ float sigm(float x) { return 1.0f / (1.0f + __expf(-x)); }

__device__ __forceinline__ void tr_item(const float* W, int N, int k0, int n0, bf16* WT, int KD, int dst_row0, LAS float* scr, int lane) {
    f32x4 v[8];
#pragma unroll
    for (int i = 0; i < 8; ++i) v[i] = *(const GAS f32x4*)(W + (size_t)(k0 + 8 * i + (lane >> 3)) * N + n0 + 4 * (lane & 7));
#pragma unroll
    for (int i = 0; i < 8; ++i) { LAS float* d = scr + (8 * i + (lane >> 3)) * 33 + 4 * (lane & 7); d[0] = v[i].x; d[1] = v[i].y; d[2] = v[i].z; d[3] = v[i].w; }
    LDS_WAIT(); asm volatile("" ::: "memory");
    const int c = lane & 7;
#pragma unroll
    for (int j = 0; j < 4; ++j) { const int n = (lane >> 3) + 8 * j; const LAS float* s = scr + (8 * c) * 33 + n;
        v4u o; o.x = pk2(s[0 * 33], s[1 * 33]); o.y = pk2(s[2 * 33], s[3 * 33]); o.z = pk2(s[4 * 33], s[5 * 33]); o.w = pk2(s[6 * 33], s[7 * 33]);
        *(GAS v4u*)(WT + (size_t)(dst_row0 + n) * KD + k0 + 8 * c) = o; }
    LDS_WAIT(); asm volatile("" ::: "memory");
}

__device__ __forceinline__ void p0_prologue(const Frame& F, ArgsP A) {
    unsigned char* ws = A->ws;
    LAS float* scr = (LAS float*)(F.lds + F.wave * 16384);
    const int gw = F.vcu * NWAVES + F.wave, NGW = F.G * NWAVES;
    const float* w_in = (const float*)A->in[6]; const float* p_rwkv = (const float*)A->in[22]; const float* p_attn = (const float*)A->in[23];
    const float* w_out = (const float*)A->in[24]; const float* g2 = (const float*)A->in[13];
    bf16* WinT = (bf16*)(ws + WS_WINT); bf16* PrT = (bf16*)(ws + WS_PRT); bf16* PaT = (bf16*)(ws + WS_PAT); bf16* WoT = (bf16*)(ws + WS_WOT); bf16* G2T = (bf16*)(ws + WS_G2T);
    constexpr int I_IN = 16 * 148, I_P = 8 * 32, I_O = 16 * 32, I_G = 2 * 16, NIT = I_IN + 2 * I_P + I_O + I_G;
    for (int it = gw; it < NIT; it += NGW) {
        int r = it;
        if (r < I_IN) { tr_item(w_in, NZ, 64 * (r / 148), 32 * (r % 148), WinT, 1024, 32 * (r % 148), scr, F.lane); continue; } r -= I_IN;
        if (r < I_P) { tr_item(p_rwkv, 1024, 64 * (r / 32), 32 * (r % 32), PrT, 512, 32 * (r % 32), scr, F.lane); continue; } r -= I_P;
        if (r < I_P) { tr_item(p_attn, 1024, 64 * (r / 32), 32 * (r % 32), PaT, 512, 32 * (r % 32), scr, F.lane); continue; } r -= I_P;
        if (r < I_O) { tr_item(w_out, 1024, 64 * (r / 32), 32 * (r % 32), WoT, 1024, 32 * (r % 32), scr, F.lane); continue; } r -= I_O;
        tr_item(g2, 512, 64 * (r / 16), 32 * (r % 16), G2T, 256, 32 * (r % 16), scr, F.lane);
    }
    { const int gt = (F.vcu * NWAVES + F.wave) * 64 + F.lane, NT = F.G * NWAVES * 64; const v4u z4 = {0u, 0u, 0u, 0u};
      for (int i = gt; i < 128 * 128; i += NT) *(GAS v4u*)(WinT + (size_t)4736 * 1024 + (size_t)i * 8) = z4;
      for (int i = gt; i < 512 * 16; i += NT) *(GAS v4u*)(G2T + (size_t)(i >> 4) * 256 + 128 + (i & 15) * 8) = z4; }
    __syncthreads();
    const float* cvec = (const float*)A->in[1]; const float* w_ada = (const float*)A->in[3]; const float* b_ada = (const float*)A->in[4];
    float* mod = (float*)(ws + WS_MOD);
    for (int task = F.vcu; task < 192; task += F.G) { const int cg = task % 96, dh = task / 96;
        LAS float* ca = (LAS float*)F.lds;
        LAS float* red = (LAS float*)(F.lds + 65536);
        for (int i = F.tid; i < 16 * 1024; i += 512) { const int b = i >> 10, d = i & 1023; const float cv = cvec[i]; ca[d * 16 + b] = cv / (1.0f + __expf(-cv)); }
        __syncthreads();
        float acc[16];
#pragma unroll
        for (int b = 0; b < 16; ++b) acc[b] = 0.f;
        const int col = cg * 64 + F.lane;
#pragma unroll 8
        for (int dd = 0; dd < 64; ++dd) { const int d = dh * 512 + F.wave * 64 + dd; const float w = w_ada[(size_t)d * 6144 + col];
            const LAS f32x4* cp = (const LAS f32x4*)(ca + d * 16);
#pragma unroll
            for (int q = 0; q < 4; ++q) { const f32x4 cv = cp[q]; acc[q * 4 + 0] += cv[0] * w; acc[q * 4 + 1] += cv[1] * w; acc[q * 4 + 2] += cv[2] * w; acc[q * 4 + 3] += cv[3] * w; } }
#pragma unroll
        for (int b = 0; b < 16; ++b) red[(F.wave * 16 + b) * 64 + F.lane] = acc[b];
        __syncthreads();
        for (int o = F.tid; o < 1024; o += 512) { const int b = o >> 6, cl = o & 63; float sacc = 0.f;
#pragma unroll
            for (int w = 0; w < 8; ++w) sacc += red[(w * 16 + b) * 64 + cl];
            atomicAdd(&mod[b * 6144 + cg * 64 + cl], sacc + (dh == 0 ? b_ada[cg * 64 + cl] : 0.f)); }
        __syncthreads();
    }
}


__device__ __forceinline__ float dpp_wave_sum(float v) {
    v += __int_as_float(__builtin_amdgcn_update_dpp(0, __float_as_int(v), 0xB1, 0xf, 0xf, false));
    v += __int_as_float(__builtin_amdgcn_update_dpp(0, __float_as_int(v), 0x4E, 0xf, 0xf, false));
    v += __int_as_float(__builtin_amdgcn_update_dpp(0, __float_as_int(v), 0x141, 0xf, 0xf, false));
    v += __int_as_float(__builtin_amdgcn_update_dpp(0, __float_as_int(v), 0x140, 0xf, 0xf, false));
    v += __int_as_float(__builtin_amdgcn_ds_swizzle(__float_as_int(v), 0x401F));
    auto r_ = __builtin_amdgcn_permlane32_swap(__float_as_uint(v), __float_as_uint(v), false, false);
    return __uint_as_float(r_[0]) + __uint_as_float(r_[1]); }

template <int R, bool XBF> __device__ __forceinline__ void modnorm_rows(const void* x, int m0, int mstride, const float* g, const float* mod, int sh_off, int sc_off, bf16* out, int lane, f32x4 (&u)[R][4]) {
    f32x4 v[R][4];
#pragma unroll
    for (int i = 0; i < R; ++i) {
        if (XBF) { const GAS u32x2* xr = (const GAS u32x2*)((const bf16*)x + (size_t)(m0 + i * mstride) * 1024) + lane;
#pragma unroll
            for (int j = 0; j < 4; ++j) { const u32x2 w = xr[64 * j]; v[i][j] = (f32x4){bflo(w.x), bfhi(w.x), bflo(w.y), bfhi(w.y)}; } }
        else { const GAS f32x4* xr = (const GAS f32x4*)((const float*)x + (size_t)(m0 + i * mstride) * 1024) + lane;
#pragma unroll
            for (int j = 0; j < 4; ++j) v[i][j] = xr[64 * j]; } }
    f32x4 gg[4];
#pragma unroll
    for (int j = 0; j < 4; ++j) gg[j] = ((const GAS f32x4*)g)[lane + 64 * j];
#pragma unroll
    for (int i = 0; i < R; ++i) { const int m = m0 + i * mstride, b = m >> 11; float s = 0.f;
#pragma unroll
        for (int j = 0; j < 4; ++j) s += (v[i][j].x * v[i][j].x + v[i][j].y * v[i][j].y) + (v[i][j].z * v[i][j].z + v[i][j].w * v[i][j].w);
        const float rs = rsqrtf(dpp_wave_sum(s) * (1.0f / 1024.0f) + 1e-6f);
        const float* sh = mod + (size_t)b * 6144 + sh_off; const float* sc = mod + (size_t)b * 6144 + sc_off;
        GAS unsigned long long* o8 = (GAS unsigned long long*)(out + (size_t)m * 1024) + lane;
#pragma unroll
        for (int j = 0; j < 4; ++j) { const f32x4 s1 = ((const GAS f32x4*)sc)[lane + 64 * j], s0 = ((const GAS f32x4*)sh)[lane + 64 * j];
            f32x4 y = (v[i][j] * rs) * gg[j]; y = y * (s1 + 1.0f) + s0; u[i][j] = y;
            o8[64 * j] = (unsigned long long)pk2(y.x, y.y) | ((unsigned long long)pk2(y.z, y.w) << 32); } }
}

template <int R> __device__ __forceinline__ void load_rows_bf16(const bf16* x, int m0, int mstride, int lane_in, u32x2 (&raw)[R][4]) {
    int lane = lane_in; asm volatile("" : "+v"(lane));
#pragma unroll
    for (int i = 0; i < R; ++i) { const GAS u32x2* xr = (const GAS u32x2*)(x + (size_t)(m0 + i * mstride) * 1024) + lane;
#pragma unroll
        for (int j = 0; j < 4; ++j) raw[i][j] = xr[64 * j]; }
}
template <int R> __device__ __forceinline__ void modnorm_rows_pre(const u32x2 (&raw)[R][4], int m0, int mstride, const float* g, const float* mod, int sh_off, int sc_off, bf16* out, int lane, f32x4 (&u)[R][4]) {
    f32x4 gg[4];
#pragma unroll
    for (int j = 0; j < 4; ++j) gg[j] = ((const GAS f32x4*)g)[lane + 64 * j];
#pragma unroll
    for (int i = 0; i < R; ++i) { const int m = m0 + i * mstride, b = m >> 11; float s = 0.f; f32x4 v[4];
#pragma unroll
        for (int j = 0; j < 4; ++j) { const u32x2 w = raw[i][j]; v[j] = (f32x4){bflo(w.x), bfhi(w.x), bflo(w.y), bfhi(w.y)}; s += (v[j].x * v[j].x + v[j].y * v[j].y) + (v[j].z * v[j].z + v[j].w * v[j].w); }
        const float rs = rsqrtf(dpp_wave_sum(s) * (1.0f / 1024.0f) + 1e-6f);
        const float* sh = mod + (size_t)b * 6144 + sh_off; const float* sc = mod + (size_t)b * 6144 + sc_off;
        GAS unsigned long long* o8 = (GAS unsigned long long*)(out + (size_t)m * 1024) + lane;
#pragma unroll
        for (int j = 0; j < 4; ++j) { const f32x4 s1 = ((const GAS f32x4*)sc)[lane + 64 * j], s0 = ((const GAS f32x4*)sh)[lane + 64 * j];
            f32x4 y = (v[j] * rs) * gg[j]; y = y * (s1 + 1.0f) + s0; u[i][j] = y;
            o8[64 * j] = (unsigned long long)pk2(y.x, y.y) | ((unsigned long long)pk2(y.z, y.w) << 32); } }
}

__device__ __forceinline__ void modnorm_row(const float* xrow, const float* g, const float* sh, const float* sc, bf16* orow, int lane, f32x4 (&u)[4]) {
    const GAS f32x4* xr = (const GAS f32x4*)xrow + lane;
    f32x4 v[4]; float s = 0.f;
#pragma unroll
    for (int j = 0; j < 4; ++j) { v[j] = xr[64 * j]; s += (v[j].x * v[j].x + v[j].y * v[j].y) + (v[j].z * v[j].z + v[j].w * v[j].w); }
    const float rs = rsqrtf(wave_sum(s) * (1.0f / 1024.0f) + 1e-6f);
    GAS unsigned long long* o8 = (GAS unsigned long long*)orow + lane;
#pragma unroll
    for (int j = 0; j < 4; ++j) { const f32x4 gg = ((const GAS f32x4*)g)[lane + 64 * j], s1 = ((const GAS f32x4*)sc)[lane + 64 * j], s0 = ((const GAS f32x4*)sh)[lane + 64 * j];
        f32x4 y = (v[j] * rs) * gg; y = y * (s1 + 1.0f) + s0; u[j] = y;
        o8[64 * j] = (unsigned long long)pk2(y.x, y.y) | ((unsigned long long)pk2(y.z, y.w) << 32); }
}

__device__ __forceinline__ float softplusf(float x) { return x > 20.f ? x : log1pf(__expf(x)); }
__device__ __forceinline__ void scan_chain(const Frame& F, ArgsP A, int b, int h, int dir) {
    constexpr int CT = 32;
    LAS float* L = (LAS float*)F.lds;
    LAS float* W2S = L; LAS float* A2S = L + 4096; LAS float* ZRs = L + 8192; LAS float* ZKs = ZRs + 2048; LAS float* ZVs = ZKs + 2048; LAS float* TWs = ZVs + 2048; LAS float* ZAs = TWs + 2048;
    LAS float* DEC = ZAs + 2048; LAS float* KD = DEC + 2048; LAS float* AV = KD + 2048; LAS float* BV = AV + 2048; LAS float* YB = BV + 2048; LAS float* BON = YB + 2048;
    const bf16* Z = (const bf16*)(A->ws + WS_Z);
    const float* mu_prev = (const float*)A->in[7]; const float* mu_next = (const float*)A->in[8];
    const float* w0 = (const float*)A->in[9]; const float* w2 = (const float*)A->in[10]; const float* a0 = (const float*)A->in[11]; const float* a2 = (const float*)A->in[12];
    const float* k_k = (const float*)A->in[14]; const float* k_a = (const float*)A->in[15]; const float* r_k = (const float*)A->in[16];
    bf16* ydir = (bf16*)(A->ws + WS_XN) + (size_t)dir * M * 512; float* bonus = (float*)(A->ws + WS_BONUS) + (size_t)dir * M * 8;
    const int tid = F.tid, lane = F.lane, wave = F.wave;
    for (int i = tid; i < 4096; i += 512) { const int l = i >> 6, j = i & 63; W2S[i] = w2[((size_t)dir * 64 + l) * 512 + h * 64 + j]; A2S[i] = a2[((size_t)dir * 64 + l) * 512 + h * 64 + j]; }
    const int ch = h * 64 + lane;
    const float w0j = w0[dir * 512 + ch], a0j = a0[dir * 512 + ch], kkj = k_k[ch], kaj = k_a[ch], rkj = r_k[ch];
    float s[8];
#pragma unroll
    for (int q = 0; q < 8; ++q) s[q] = 0.f;
    const int ri = tid >> 3, jg = tid & 7;
    for (int ci = 0; ci < T / CT; ++ci) {
        const int t0 = (dir ? (T / CT - 1 - ci) : ci) * CT;
#pragma unroll 4
        for (int i = 0; i < 20; ++i) { const int e = tid + 512 * i, arr = e >> 11, rem = e & 2047, tl = rem >> 6, j = rem & 63;
            const int col = (arr == 0 ? ZR + h * 64 : arr == 1 ? ZK + h * 64 : arr == 2 ? ZV + h * 64 : arr == 3 ? ZWD + dir * 64 : ZAD + dir * 64) + j;
            const int t = t0 + tl; const bf16* zp = Z + ((size_t)b * T + t) * NZ + col;
            const float z0 = bf2f(zp[0]), zm = t > 0 ? bf2f(zp[-NZ]) : 0.f, zq = t < T - 1 ? bf2f(zp[NZ]) : 0.f;
            float zs = z0 + mu_prev[col] * (zm - z0) + mu_next[col] * (zq - z0);
            if (arr == 3) zs = tanhf(zs);
            ZRs[arr * 2048 + rem] = zs; }
        __syncthreads();
#pragma unroll 1
        for (int q = 0; q < 4; ++q) { const int tl = wave + 8 * q;
            float wraw = w0j, araw = a0j;
#pragma unroll 8
            for (int l = 0; l < 64; ++l) { wraw += TWs[tl * 64 + l] * W2S[l * 64 + lane]; araw += ZAs[tl * 64 + l] * A2S[l * 64 + lane]; }
            const float w = -softplusf(-wraw) - 0.5f, dec = __expf(-__expf(w)), ad = sigm(araw);
            const float k = ZKs[tl * 64 + lane], kkr = k * kkj, nrm = sqrtf(wave_sum(kkr * kkr)), kk = kkr / fmaxf(nrm, 1e-12f);
            const float kd = k * (1.0f + (ad - 1.0f) * kaj);
            DEC[tl * 64 + lane] = dec; KD[tl * 64 + lane] = kd; AV[tl * 64 + lane] = -kk; BV[tl * 64 + lane] = kk * ad;
            const float bon = wave_sum(ZRs[tl * 64 + lane] * kd * rkj); if (lane == 0) BON[tl] = bon; }
        __syncthreads();
#pragma unroll 1
        for (int st = 0; st < CT; ++st) { const int tl = dir ? (CT - 1 - st) : st; const int o = tl * 64 + jg * 8;
            const f32x4 a0v = *(const LAS f32x4*)(AV + o), a1v = *(const LAS f32x4*)(AV + o + 4), d0 = *(const LAS f32x4*)(DEC + o), d1 = *(const LAS f32x4*)(DEC + o + 4);
            const f32x4 b0 = *(const LAS f32x4*)(BV + o), b1 = *(const LAS f32x4*)(BV + o + 4), k0 = *(const LAS f32x4*)(KD + o), k1 = *(const LAS f32x4*)(KD + o + 4);
            const f32x4 r0 = *(const LAS f32x4*)(ZRs + o), r1 = *(const LAS f32x4*)(ZRs + o + 4); const float vi = ZVs[tl * 64 + ri];
            float p = (s[0] * a0v[0] + s[1] * a0v[1]) + (s[2] * a0v[2] + s[3] * a0v[3]) + (s[4] * a1v[0] + s[5] * a1v[1]) + (s[6] * a1v[2] + s[7] * a1v[3]);
            p += __shfl_xor(p, 1); p += __shfl_xor(p, 2); p += __shfl_xor(p, 4);
            s[0] = s[0] * d0[0] + p * b0[0] + vi * k0[0]; s[1] = s[1] * d0[1] + p * b0[1] + vi * k0[1]; s[2] = s[2] * d0[2] + p * b0[2] + vi * k0[2]; s[3] = s[3] * d0[3] + p * b0[3] + vi * k0[3];
            s[4] = s[4] * d1[0] + p * b1[0] + vi * k1[0]; s[5] = s[5] * d1[1] + p * b1[1] + vi * k1[1]; s[6] = s[6] * d1[2] + p * b1[2] + vi * k1[2]; s[7] = s[7] * d1[3] + p * b1[3] + vi * k1[3];
            float y = (s[0] * r0[0] + s[1] * r0[1]) + (s[2] * r0[2] + s[3] * r0[3]) + (s[4] * r1[0] + s[5] * r1[1]) + (s[6] * r1[2] + s[7] * r1[3]);
            y += __shfl_xor(y, 1); y += __shfl_xor(y, 2); y += __shfl_xor(y, 4);
            if (jg == 0) YB[tl * 64 + ri] = y; }
        __syncthreads();
#pragma unroll
        for (int i = 0; i < 4; ++i) { const int e = tid + 512 * i, tl = e >> 6, c = e & 63; ydir[((size_t)b * T + t0 + tl) * 512 + h * 64 + c] = (bf16)f2bf(YB[e]); }
        if (tid < CT) bonus[((size_t)b * T + t0 + tid) * 8 + h] = BON[tid];
        __syncthreads();
    }
}


#define SDEV __device__ __forceinline__
#define S_UNROLL _Pragma("unroll")
#define S_MEMBAR() do { asm volatile("" ::: "memory"); __builtin_amdgcn_sched_barrier(0); } while (0)
#define S_LAUNDER_I(x) asm volatile("" : "+v"(x))
#define S_LAUNDER_S(x) asm volatile("" : "+s"(x))
#define S_PIN(x) asm volatile("" : "+v"(x))
typedef float f32x2s __attribute__((ext_vector_type(2))); typedef __bf16 bf16x2s __attribute__((ext_vector_type(2)));
__device__ __forceinline__ unsigned s_cvtpk(float lo, float hi) { f32x2s v = {lo, hi}; bf16x2s b = __builtin_convertvector(v, bf16x2s); return __builtin_bit_cast(unsigned, b); }
__device__ __forceinline__ float s_rowsum16(float v) {
    v += __int_as_float(__builtin_amdgcn_update_dpp(0, __float_as_int(v), 0xB1, 0xf, 0xf, false));
    v += __int_as_float(__builtin_amdgcn_update_dpp(0, __float_as_int(v), 0x4E, 0xf, 0xf, false));
    v += __int_as_float(__builtin_amdgcn_update_dpp(0, __float_as_int(v), 0x141, 0xf, 0xf, false));
    v += __int_as_float(__builtin_amdgcn_update_dpp(0, __float_as_int(v), 0x140, 0xf, 0xf, false));
    return v; }
#define S_MFMA(a, b, c) __builtin_amdgcn_mfma_f32_32x32x16_bf16(a, b, c, 0, 0, 0)
#define S_PK(lo, hi) s_cvtpk(lo, hi)
#define S_SWAP(x, y) do { auto r_ = __builtin_amdgcn_permlane32_swap(x, y, false, false); x = r_[0]; y = r_[1]; } while (0)
#define S_ROWSUM16(v) s_rowsum16(v)
__device__ __forceinline__ float s_wavesum(float v) { v = s_rowsum16(v);
    v += __int_as_float(__builtin_amdgcn_ds_swizzle(__float_as_int(v), 0x401F));
    auto r_ = __builtin_amdgcn_permlane32_swap(__float_as_uint(v), __float_as_uint(v), false, false);
    return __uint_as_float(r_[0]) + __uint_as_float(r_[1]); }
#define S_WAVESUM(v) s_wavesum(v)
#define S_GAS GAS
#define S_READLANE(v, l) __int_as_float(__builtin_amdgcn_readlane(__float_as_int(v), l))
#define S_RCP(x) __builtin_amdgcn_rcpf(x)
#define S_EXP2(x) __builtin_amdgcn_exp2f(x)
#define S_LOG2(x) __builtin_amdgcn_logf(x)
#define S_RSQ(x) __builtin_amdgcn_rsqf(x)
#define S_LDS_WAIT() asm volatile("s_waitcnt lgkmcnt(0)" ::: "memory")
#define S_LDSP LAS unsigned char*
#define S_LDS_BF16P LAS bf16*
#define S_LDS_U32P LAS unsigned*
#define S_LDS_F32P LAS float*
#define S_LDS_CONST_BF16X8P const LAS bf16x8*
#define S_LDS_BF16X8P LAS bf16x8*
#define S_LDS_CONST_F32X4P const LAS f32x4*
#define S_FLAG_STORE(p, v) do { *(volatile LAS unsigned*)(p) = (v); } while (0)
#define S_FLAG_WAIT(p, v) do { unsigned sp_ = 0; while (*(volatile LAS unsigned*)(p) != (v)) { __builtin_amdgcn_s_sleep(2); if (++sp_ > (1u << 24)) break; } asm volatile("" ::: "memory"); } while (0)
struct SFrag { bf16x8 s[2]; };
struct SMat { SFrag t[2]; };
SDEV f32x16 smm(const SFrag& X, const SFrag& Y, f32x16 acc) { acc = S_MFMA(X.s[0], Y.s[0], acc); acc = S_MFMA(X.s[1], Y.s[1], acc); return acc; }
SDEV f32x16 szero() { f32x16 z; S_UNROLL for (int i = 0; i < 16; ++i) z[i] = 0.f; return z; }
SDEV SFrag spack(const f32x16& d) { SFrag f;
    S_UNROLL for (int s = 0; s < 2; ++s) { v4u w; S_UNROLL for (int q = 0; q < 4; ++q) w[q] = S_PK(d[8 * s + 2 * q], d[8 * s + 2 * q + 1]); f.s[s] = __builtin_bit_cast(bf16x8, w); }
    return f; }
SDEV f32x16 sunpack(const SFrag& f) { f32x16 d;
    S_UNROLL for (int s = 0; s < 2; ++s) { const v4u w = __builtin_bit_cast(v4u, f.s[s]); S_UNROLL for (int q = 0; q < 4; ++q) { d[8 * s + 2 * q] = __uint_as_float(w[q] << 16); d[8 * s + 2 * q + 1] = __uint_as_float(w[q] & 0xffff0000u); } }
    return d; }
SDEV SMat splain2d(const unsigned (&pp)[16]) { unsigned d0[8], d1[8];
    S_UNROLL for (int g = 0; g < 4; ++g) S_UNROLL for (int p = 0; p < 2; ++p) { unsigned x = pp[4 * g + p], y = pp[4 * g + 2 + p]; S_SWAP(x, y); d0[2 * g + p] = x; d1[2 * g + p] = y; }
    SMat m;
    S_UNROLL for (int s = 0; s < 2; ++s) { v4u a, b; S_UNROLL for (int q = 0; q < 4; ++q) { a[q] = d0[4 * s + q]; b[q] = d1[4 * s + q]; } m.t[0].s[s] = __builtin_bit_cast(bf16x8, a); m.t[1].s[s] = __builtin_bit_cast(bf16x8, b); }
    return m; }
SDEV void sd2plain(const f32x16& D0, const f32x16& D1, float (&x)[32]) {
    S_UNROLL for (int r = 0; r < 16; ++r) { unsigned a = __float_as_uint(D0[r]), b = __float_as_uint(D1[r]); S_SWAP(a, b); const int ta = (r & 3) + 8 * (r >> 2); x[ta] = __uint_as_float(a); x[ta + 4] = __uint_as_float(b); } }
SDEV SFrag sident(int n_in, int hh_in) { int n1 = n_in, r1 = 4 * hh_in; S_LAUNDER_I(n1); S_LAUNDER_I(r1); f32x16 id; S_UNROLL for (int g = 0; g < 16; ++g) id[g] = (((g & 3) + 8 * (g >> 2) + r1) == n1) ? 1.f : 0.f; return spack(id); }
SDEV void sd2plain_pk(const f32x16& D0, const f32x16& D1, unsigned (&xp)[16]) {
    S_UNROLL for (int m = 0; m < 8; ++m) { unsigned a = S_PK(D0[2 * m], D0[2 * m + 1]), b = S_PK(D1[2 * m], D1[2 * m + 1]); S_SWAP(a, b); const int qa = 4 * (m >> 1) + (m & 1); xp[qa] = a; xp[qa + 2] = b; } }
SDEV float swave_sum(float v) { return S_WAVESUM(v); }

struct ScanArgs { const S_GAS bf16* Z; const S_GAS float* mu_prev; const S_GAS float* mu_next; const S_GAS float* w0; const S_GAS float* a0; const S_GAS float* k_k; const S_GAS float* k_a; const S_GAS float* r_k; S_GAS bf16* ydir; S_GAS float* bonus; };

#define SC_W2F 0
#define SC_A2F 8192
#define SC_SIG 16384
#define SC_GTAB 24576
#define SC_FLAG 26624
#define SC_WR 28672
#define SC_AR 94208
#define SC_LDS_BYTES 126976
#define SC_PF 4

SDEV void scan2_setup(S_LDSP lds, const S_GAS float* w2, const S_GAS float* a2, int h, int dir, int tid) {
    { float wv[16];
      S_UNROLL for (int it = 0; it < 16; ++it) { const int e = tid + 512 * it; const int mat = e >> 12, r = e & 4095, jj = r & 7, ln = (r >> 3) & 63, s = (r >> 9) & 1, jt = (r >> 10) & 1, lt = (r >> 11) & 1;
          const int n = ln & 31, hh = ln >> 5, g = 8 * s + jj, l = 32 * lt + (g & 3) + 8 * (g >> 2) + 4 * hh, j = 32 * jt + n;
          wv[it] = (mat ? a2 : w2)[((size_t)dir * 64 + l) * 512 + h * 64 + j]; }
      S_UNROLL for (int it = 0; it < 16; ++it) { const int e = tid + 512 * it; const int mat = e >> 12, r = e & 4095;
          ((S_LDS_BF16P)(lds + (mat ? SC_A2F : SC_W2F)))[r] = (bf16)(S_PK(wv[it], 0.f) & 0xffffu); } }
    for (int e = tid; e < 2048; e += 512) ((S_LDS_U32P)(lds + SC_SIG))[e] = 0u;
    if (tid == 0) S_FLAG_STORE(lds + SC_FLAG, 0u);
}

SDEV void scan2_chunk(S_LDSP lds, const ScanArgs& A_in, int b_in, int h_in, int dir_in, int c, int lane_in, int wave) {
    ScanArgs A = A_in; int b = b_in, h = h_in, dir = dir_in;
    S_LAUNDER_S(A.Z); S_LAUNDER_S(A.mu_prev); S_LAUNDER_S(A.mu_next); S_LAUNDER_S(A.w0); S_LAUNDER_S(A.a0); S_LAUNDER_S(A.k_k); S_LAUNDER_S(A.k_a); S_LAUNDER_S(A.r_k); S_LAUNDER_S(A.ydir); S_LAUNDER_S(A.bonus);
    S_LAUNDER_S(b); S_LAUNDER_S(h); S_LAUNDER_S(dir);
    int lane = lane_in; S_LAUNDER_I(lane);
    const int n = lane & 31, hh = lane >> 5;
    const int sgn = dir ? -1 : 1, tau0 = dir ? (T - 1 - 32 * c) : 32 * c;
    const S_GAS bf16* zb = A.Z + (size_t)b * T * NZ;
    const ptrdiff_t st = (ptrdiff_t)sgn * NZ; const bool first = (c == 0), last = (c == T / 32 - 1);
    const int cr = ZR + h * 64 + lane, ck = ZK + h * 64 + lane, cv = ZV + h * 64 + lane, cw = ZWD + dir * 64 + lane, ca = ZAD + dir * 64 + lane, chn = h * 64 + lane;
    {   const SFrag IDF = sident(n, hh); unsigned ppw[16], ppa[16];
        { const float mA = dir ? A.mu_next[cw] : A.mu_prev[cw], mB = dir ? A.mu_prev[cw] : A.mu_next[cw], nA = dir ? A.mu_next[ca] : A.mu_prev[ca], nB = dir ? A.mu_prev[ca] : A.mu_next[ca];
          const S_GAS bf16* pw = zb + (ptrdiff_t)tau0 * NZ + cw - st; const S_GAS bf16* pa = zb + (ptrdiff_t)tau0 * NZ + ca - st;
          float rw[34], ra[34];
          S_UNROLL for (int q = 0; q < 34; ++q) { const bool ok = !((q == 0 && first) || (q == 33 && last)); rw[q] = ok ? bf2f(*pw) : 0.f; ra[q] = ok ? bf2f(*pa) : 0.f; pw += st; pa += st; }
          S_MEMBAR();
          const float mC = 1.f - mA - mB, nC = 1.f - nA - nB; float tprev = 0.f, aprev = 0.f;
          S_UNROLL for (int p = 0; p < 32; ++p) { if ((p & 7) == 0) S_MEMBAR();
              const float ws = mC * rw[p + 1] + mA * rw[p] + mB * rw[p + 2], as = nC * ra[p + 1] + nA * ra[p] + nB * ra[p + 2];
              const float tw = 1.f - 2.f * S_RCP(1.f + S_EXP2(ws * 2.885390082f));
              if (p & 1) { ppw[p >> 1] = S_PK(tprev, tw); ppa[p >> 1] = S_PK(aprev, as); S_PIN(ppw[p >> 1]); S_PIN(ppa[p >> 1]); } else { tprev = tw; aprev = as; } } }
        S_MEMBAR();
        const SMat TW = splain2d(ppw), AD = splain2d(ppa);
        SFrag TWT[2], ADT[2];
        S_UNROLL for (int lt = 0; lt < 2; ++lt) { TWT[lt] = spack(smm(TW.t[lt], IDF, szero())); ADT[lt] = spack(smm(AD.t[lt], IDF, szero())); }
        f32x16 dw[2], da[2];
        S_UNROLL for (int jt = 0; jt < 2; ++jt) { dw[jt] = szero(); da[jt] = szero();
            S_UNROLL for (int lt = 0; lt < 2; ++lt) { SFrag wf, af;
                S_UNROLL for (int s = 0; s < 2; ++s) { wf.s[s] = *(S_LDS_CONST_BF16X8P)(lds + SC_W2F + ((((lt * 2 + jt) * 2 + s) * 64 + lane) * 16)); af.s[s] = *(S_LDS_CONST_BF16X8P)(lds + SC_A2F + ((((lt * 2 + jt) * 2 + s) * 64 + lane) * 16)); }
                dw[jt] = smm(TWT[lt], wf, dw[jt]); da[jt] = smm(ADT[lt], af, da[jt]); } }
        S_UNROLL for (int jt = 0; jt < 2; ++jt) S_UNROLL for (int g = 0; g < 16; ++g) { const int t = (g & 3) + 8 * (g >> 2) + 4 * hh;
            ((S_LDS_F32P)(lds + SC_WR + wave * 8192))[t * 64 + 32 * jt + n] = dw[jt][g]; ((S_LDS_BF16P)(lds + SC_AR + wave * 4096))[t * 64 + 32 * jt + n] = (bf16)(S_PK(da[jt][g], 0.f) & 0xffffu); }
        S_LDS_WAIT();
    }
    S_MEMBAR();
    unsigned ppA[16], ppR[16], ppB[16], ppK[16], ppV[16], ppQ[16]; float gamC;
    {   const float mAr = dir ? A.mu_next[cr] : A.mu_prev[cr], mBr = dir ? A.mu_prev[cr] : A.mu_next[cr], mAk = dir ? A.mu_next[ck] : A.mu_prev[ck], mBk = dir ? A.mu_prev[ck] : A.mu_next[ck];
        const float mAv = dir ? A.mu_next[cv] : A.mu_prev[cv], mBv = dir ? A.mu_prev[cv] : A.mu_next[cv];
        const float w0j = A.w0[dir * 512 + chn], a0j = A.a0[dir * 512 + chn], kkj = A.k_k[chn], kaj = A.k_a[chn], rkj = A.r_k[chn];
        const S_GAS bf16* pr = zb + (ptrdiff_t)tau0 * NZ + cr - st; const S_GAS bf16* pk = zb + (ptrdiff_t)tau0 * NZ + ck - st; const S_GAS bf16* pv = zb + (ptrdiff_t)tau0 * NZ + cv - st;
        float rr[34], rk[34], rv[34];
        S_UNROLL for (int q = 0; q < 34; ++q) { const bool ok = !((q == 0 && first) || (q == 33 && last)); rr[q] = ok ? bf2f(*pr) : 0.f; rk[q] = ok ? bf2f(*pk) : 0.f; rv[q] = ok ? bf2f(*pv) : 0.f; pr += st; pk += st; pv += st; }
        S_MEMBAR();
        const float mCr = 1.f - mAr - mBr, mCk = 1.f - mAk - mBk, mCv = 1.f - mAv - mBv;
        float cs = 0.f, gprev = 1.f; float eA = 0.f, eR = 0.f, eB = 0.f, eK = 0.f, eV = 0.f, eQ = 0.f;
        S_UNROLL for (int p = 0; p < 32; ++p) { S_MEMBAR();
            const float r = mCr * rr[p + 1] + mAr * rr[p] + mBr * rr[p + 2], k = mCk * rk[p + 1] + mAk * rk[p] + mBk * rk[p + 2], v = mCv * rv[p + 1] + mAv * rv[p] + mBv * rv[p + 2];
            const float wraw = ((S_LDS_F32P)(lds + SC_WR + wave * 8192))[p * 64 + lane] + w0j, araw = bf2f(((S_LDS_BF16P)(lds + SC_AR + wave * 4096))[p * 64 + lane]) + a0j;
            const float x = -wraw; const float sp = fmaxf(x, 0.f) + 0.6931471806f * S_LOG2(1.f + S_EXP2(-fabsf(x) * 1.442695041f));
            const float w = -sp - 0.5f; const float lw2 = -S_EXP2(w * 1.442695041f) * 1.442695041f;
            const float al = S_RCP(1.f + S_EXP2(-araw * 1.442695041f));
            const float kkr = k * kkj; const float nrm2 = swave_sum(kkr * kkr); const float kk = kkr * S_RSQ(fmaxf(nrm2, 1e-24f));
            const float kd = k * (1.f + (al - 1.f) * kaj);
            cs += lw2; const float gam = S_EXP2(cs), ig = S_EXP2(-cs);
            const float xa = -kk * gprev, xr = r * gam, xb = kk * al * ig, xk = kd * ig, xq = xr * rkj; gprev = gam;
            if (p & 1) { ppA[p >> 1] = S_PK(eA, xa); ppR[p >> 1] = S_PK(eR, xr); ppB[p >> 1] = S_PK(eB, xb); ppK[p >> 1] = S_PK(eK, xk); ppV[p >> 1] = S_PK(eV, v); ppQ[p >> 1] = S_PK(eQ, xq);
                         S_PIN(ppQ[p >> 1]); S_PIN(ppA[p >> 1]); S_PIN(ppR[p >> 1]); S_PIN(ppB[p >> 1]); S_PIN(ppK[p >> 1]); S_PIN(ppV[p >> 1]); }
            else { eA = xa; eR = xr; eB = xb; eK = xk; eV = v; eQ = xq; } }
        gamC = gprev;
    }
    S_MEMBAR();
    float gc0, gc1; { unsigned x = __float_as_uint(gamC), y = x; S_SWAP(x, y); gc0 = __uint_as_float(x); gc1 = __uint_as_float(y); }
    ((S_LDS_F32P)(lds + SC_GTAB + wave * 256))[lane] = gamC;
    const SMat FA = splain2d(ppA), FB = splain2d(ppB), FK = splain2d(ppK), FV = splain2d(ppV);
    SFrag RT[2], MrbT, MrkT, LakT, Pf, PTf; f32x16 TT;
    {   const SFrag IDF = sident(n, hh); SFrag AT[2], BT[2], KT[2];
        { const SMat FR = splain2d(ppR); S_UNROLL for (int dt = 0; dt < 2; ++dt) RT[dt] = spack(smm(FR.t[dt], IDF, szero())); }
        SFrag QT[2]; { const SMat FQ = splain2d(ppQ); S_UNROLL for (int dt = 0; dt < 2; ++dt) QT[dt] = spack(smm(FQ.t[dt], IDF, szero())); }
        S_UNROLL for (int dt = 0; dt < 2; ++dt) { AT[dt] = spack(smm(FA.t[dt], IDF, szero())); BT[dt] = spack(smm(FB.t[dt], IDF, szero())); KT[dt] = spack(smm(FK.t[dt], IDF, szero())); }
        f32x16 L = szero(), LT = szero(), lak = szero(), mrb = szero(), mrk = szero();
        { f32x16 bq = szero(); S_UNROLL for (int dt = 0; dt < 2; ++dt) bq = smm(KT[dt], QT[dt], bq);
          int nb = n, rb = 4 * hh; S_LAUNDER_I(nb); S_LAUNDER_I(rb); float dsum = 0.f; S_UNROLL for (int g = 0; g < 16; ++g) dsum += (((g & 3) + 8 * (g >> 2) + rb) == nb) ? bq[g] : 0.f;
          if (((nb >> 2) & 1) == (rb >> 2)) A.bonus[((size_t)b * T + (tau0 + sgn * nb)) * 8 + h] = dsum; }
        S_UNROLL for (int dt = 0; dt < 2; ++dt) { L = smm(AT[dt], BT[dt], L); LT = smm(BT[dt], AT[dt], LT); lak = smm(KT[dt], AT[dt], lak); mrb = smm(BT[dt], RT[dt], mrb); mrk = smm(KT[dt], RT[dt], mrk); }
        int n2 = n, r2 = 4 * hh; S_LAUNDER_I(n2); S_LAUNDER_I(r2);
        S_UNROLL for (int g = 0; g < 16; ++g) { const int row = (g & 3) + 8 * (g >> 2) + r2;
            L[g] = (row > n2) ? L[g] : 0.f; LT[g] = (row < n2) ? LT[g] : 0.f; lak[g] = (row < n2) ? lak[g] : 0.f; mrb[g] = (row <= n2) ? mrb[g] : 0.f; mrk[g] = (row <= n2) ? mrk[g] : 0.f; }
        Pf = spack(L); PTf = spack(LT); LakT = spack(lak); MrbT = spack(mrb); MrkT = spack(mrk);
        TT = LT; S_UNROLL for (int g = 0; g < 16; ++g) TT[g] += (((g & 3) + 8 * (g >> 2) + r2) == n2) ? 1.f : 0.f;
    }
    S_MEMBAR();
    SFrag TTf = spack(TT);
    S_UNROLL for (int i = 1; i <= 4; ++i) { const f32x16 P2 = smm(PTf, Pf, szero()); SFrag P2Tf; if (i < 4) P2Tf = spack(smm(Pf, PTf, szero()));
        Pf = spack(P2); TT = smm(Pf, TTf, TT); TTf = spack(TT); if (i < 4) PTf = P2Tf; }
    S_MEMBAR();
    SFrag U0[2], Ap[2], RpT[2], Y0[2], GTf[2][2], Hf[2][2];
    S_UNROLL for (int vt = 0; vt < 2; ++vt) { const SFrag W = spack(smm(LakT, FV.t[vt], szero())); U0[vt] = spack(smm(TTf, W, szero())); }
    S_UNROLL for (int kt = 0; kt < 2; ++kt) Ap[kt] = spack(smm(TTf, FA.t[kt], szero()));
    S_UNROLL for (int kt = 0; kt < 2; ++kt) RpT[kt] = spack(smm(Ap[kt], MrbT, sunpack(RT[kt])));
    S_UNROLL for (int vt = 0; vt < 2; ++vt) Y0[vt] = spack(smm(MrkT, FV.t[vt], smm(MrbT, U0[vt], szero())));
    int n3 = n, r3 = 4 * hh; S_LAUNDER_I(n3); S_LAUNDER_I(r3);
    S_UNROLL for (int nt = 0; nt < 2; ++nt) S_UNROLL for (int mt = 0; mt < 2; ++mt) { f32x16 gt = smm(Ap[nt], FB.t[mt], szero()); const float gcv = mt ? gc1 : gc0;
        S_UNROLL for (int g = 0; g < 16; ++g) { const float idv = (nt == mt && ((g & 3) + 8 * (g >> 2) + r3) == n3) ? 1.f : 0.f; gt[g] = (gt[g] + idv) * gcv; }
        GTf[nt][mt] = spack(gt); }
    S_LDS_WAIT();
    S_UNROLL for (int mt = 0; mt < 2; ++mt) { float gr[16];
        S_UNROLL for (int q = 0; q < 4; ++q) { const f32x4 t4 = *(S_LDS_CONST_F32X4P)(lds + SC_GTAB + wave * 256 + (32 * mt + 8 * q + 4 * hh) * 4); S_UNROLL for (int i = 0; i < 4; ++i) gr[4 * q + i] = t4[i]; }
        S_UNROLL for (int vt = 0; vt < 2; ++vt) { f32x16 hm = smm(FK.t[mt], FV.t[vt], smm(FB.t[mt], U0[vt], szero())); S_UNROLL for (int g = 0; g < 16; ++g) hm[g] *= gr[g]; Hf[mt][vt] = spack(hm); } }
    S_MEMBAR();
    S_FLAG_WAIT(lds + SC_FLAG, (unsigned)c);
    SFrag SG[2][2];
    S_UNROLL for (int kt = 0; kt < 2; ++kt) S_UNROLL for (int vt = 0; vt < 2; ++vt) S_UNROLL for (int s = 0; s < 2; ++s) SG[kt][vt].s[s] = *(S_LDS_CONST_BF16X8P)(lds + SC_SIG + ((((kt * 2 + vt) * 2 + s) * 64 + lane) * 16));
    S_LDS_WAIT();
    S_UNROLL for (int mt = 0; mt < 2; ++mt) S_UNROLL for (int vt = 0; vt < 2; ++vt) { f32x16 sn = sunpack(Hf[mt][vt]); S_UNROLL for (int nt = 0; nt < 2; ++nt) sn = smm(GTf[nt][mt], SG[nt][vt], sn);
        const SFrag f = spack(sn); S_UNROLL for (int s = 0; s < 2; ++s) *(S_LDS_BF16X8P)(lds + SC_SIG + ((((mt * 2 + vt) * 2 + s) * 64 + lane) * 16)) = f.s[s]; }
    S_LDS_WAIT();
    S_FLAG_STORE(lds + SC_FLAG, (unsigned)(c + 1));
    S_UNROLL for (int vt = 0; vt < 2; ++vt) { f32x16 y = sunpack(Y0[vt]); S_UNROLL for (int kt = 0; kt < 2; ++kt) y = smm(RpT[kt], SG[kt][vt], y);
        S_UNROLL for (int g = 0; g < 16; ++g) { const int p = (g & 3) + 8 * (g >> 2) + 4 * hh; A.ydir[((size_t)b * T + (tau0 + sgn * p)) * 512 + h * 64 + 32 * vt + n] = (bf16)(S_PK(y[g], 0.f) & 0xffffu); } }
}

__device__ __forceinline__ void attn_unit(const Frame& F, ArgsP A, int b, int kvh, int qb) {
    constexpr int KST = 72, VST = 388;
    LAS bf16* KS = (LAS bf16*)F.lds;
    LAS bf16* VT = (LAS bf16*)(F.lds + 384 * KST * 2);
    LAS float* wsf = (LAS float*)(F.lds + 384 * KST * 2 + 64 * VST * 2);
    const bf16* Z = (const bf16*)(A->ws + WS_Z); bf16* OA = (bf16*)(A->ws + WS_OATT);
    const int* positions = (const int*)A->in[2]; const float* qg = (const float*)A->in[19]; const float* kg = (const float*)A->in[20]; const float* sink = (const float*)A->in[21];
    const int tid = F.tid, lane = F.lane, wave = F.wave;
    const float LN_THETA = 13.122363377404328f;
    v4u kwa[6], vwa[6], rca[6], rsa[6];
#pragma unroll
    for (int i = 0; i < 6; ++i) { const int ct = tid + 512 * i, key = ct >> 3, ch = ct & 7; const int kp = qb * 128 - 128 + key; const bool valid = (kp >= 0) && (kp < T);
        const size_t rowoff = ((size_t)b * T + (valid ? kp : 0)) * NZ;
        kwa[i] = *(const GAS v4u*)(Z + rowoff + ZKA + kvh * 64 + ch * 8); vwa[i] = *(const GAS v4u*)(Z + rowoff + ZVA + kvh * 64 + ch * 8);
        const GAS v4u* rt = (const GAS v4u*)((const bf16*)(A->ws + WS_ROPE) + ((size_t)b * T + (valid ? kp : 0)) * 16); rca[i] = rt[0]; rsa[i] = rt[1]; }
#pragma unroll
    for (int i = 0; i < 6; ++i) { const int ct = tid + 512 * i, key = ct >> 3, ch = ct & 7; const int kp = qb * 128 - 128 + key; const bool valid = (kp >= 0) && (kp < T);
        v4u kw = kwa[i], vw = vwa[i];
        if (!valid) { kw = (v4u){0u, 0u, 0u, 0u}; vw = kw; }
        float kf[8] = {bflo(kw.x), bfhi(kw.x), bflo(kw.y), bfhi(kw.y), bflo(kw.z), bfhi(kw.z), bflo(kw.w), bfhi(kw.w)};
        float ss = 0.f;
#pragma unroll
        for (int j = 0; j < 8; ++j) ss += kf[j] * kf[j];
        ss += __shfl_xor(ss, 1); ss += __shfl_xor(ss, 2); ss += __shfl_xor(ss, 4);
        const float rs = rsqrtf(ss * (1.0f / 64.0f) + 1e-6f);
#pragma unroll
        for (int j = 0; j < 8; ++j) kf[j] = kf[j] * rs * kg[ch * 8 + j];
        float oth[8];
#pragma unroll
        for (int j = 0; j < 8; ++j) oth[j] = __shfl_xor(kf[j], 1);
        if (ch < 2) { const v4u cw = rca[i], sw = rsa[i];
            const float cs[8] = {bflo(cw.x), bfhi(cw.x), bflo(cw.y), bfhi(cw.y), bflo(cw.z), bfhi(cw.z), bflo(cw.w), bfhi(cw.w)};
            const float sn[8] = {bflo(sw.x), bfhi(sw.x), bflo(sw.y), bfhi(sw.y), bflo(sw.z), bfhi(sw.z), bflo(sw.w), bfhi(sw.w)};
#pragma unroll
            for (int j = 0; j < 8; ++j) kf[j] = (ch == 0) ? (kf[j] * cs[j] - oth[j] * sn[j]) : (kf[j] * cs[j] + oth[j] * sn[j]); }
        v4u ko; ko.x = pk2(kf[0], kf[1]); ko.y = pk2(kf[2], kf[3]); ko.z = pk2(kf[4], kf[5]); ko.w = pk2(kf[6], kf[7]);
        *(LAS v4u*)(KS + key * KST + ch * 8) = ko;
        const unsigned vv[4] = {vw.x, vw.y, vw.z, vw.w};
#pragma unroll
        for (int j = 0; j < 4; ++j) { VT[(ch * 8 + 2 * j) * VST + key] = (bf16)(vv[j] & 0xffffu); VT[(ch * 8 + 2 * j + 1) * VST + key] = (bf16)(vv[j] >> 16); } }
    __syncthreads();
    const int g = wave >> 1, hq = kvh * 4 + g, r32 = lane & 31, hh = lane >> 5;
    const float snk = sink[hq];
    float kbound; { float gm = fabsf(kg[lane]);
#pragma unroll
        for (int o = 1; o < 64; o <<= 1) gm = fmaxf(gm, __shfl_xor(gm, o));
        kbound = 8.0f * gm; }
#pragma unroll 1
    for (int qt = 0; qt < 2; ++qt) { const int qo = (wave & 1) * 64 + qt * 32, qrel = qo + r32; const size_t tok = (size_t)b * T + qb * 128 + qrel;
        float qf[4][8]; float ss = 0.f; v4u qraw[4];
#pragma unroll
        for (int sI = 0; sI < 4; ++sI) qraw[sI] = *(const GAS v4u*)(Z + tok * NZ + ZQ + hq * 64 + 16 * sI + 8 * hh);
        const GAS v4u* qrt = (const GAS v4u*)((const bf16*)(A->ws + WS_ROPE) + tok * 16); const v4u qrc = qrt[0], qrs = qrt[1];
#pragma unroll
        for (int sI = 0; sI < 4; ++sI) { const v4u qw = qraw[sI];
            qf[sI][0] = bflo(qw.x); qf[sI][1] = bfhi(qw.x); qf[sI][2] = bflo(qw.y); qf[sI][3] = bfhi(qw.y); qf[sI][4] = bflo(qw.z); qf[sI][5] = bfhi(qw.z); qf[sI][6] = bflo(qw.w); qf[sI][7] = bfhi(qw.w);
#pragma unroll
            for (int j = 0; j < 8; ++j) ss += qf[sI][j] * qf[sI][j]; }
        ss += __shfl_xor(ss, 32);
        const float rs = rsqrtf(ss * (1.0f / 64.0f) + 1e-6f) * 0.125f;
#pragma unroll
        for (int sI = 0; sI < 4; ++sI)
#pragma unroll
            for (int j = 0; j < 8; ++j) qf[sI][j] = qf[sI][j] * rs * qg[16 * sI + 8 * hh + j];
        { const v4u cw = qrc, sw = qrs;
          const float cs[8] = {bflo(cw.x), bfhi(cw.x), bflo(cw.y), bfhi(cw.y), bflo(cw.z), bfhi(cw.z), bflo(cw.w), bfhi(cw.w)}, sn[8] = {bflo(sw.x), bfhi(sw.x), bflo(sw.y), bfhi(sw.y), bflo(sw.z), bfhi(sw.z), bflo(sw.w), bfhi(sw.w)};
#pragma unroll
          for (int j = 0; j < 8; ++j) { const float oth = __shfl_xor(qf[0][j], 32); qf[0][j] = (hh == 0) ? (qf[0][j] * cs[j] - oth * sn[j]) : (qf[0][j] * cs[j] + oth * sn[j]); } }
        bf16x8 qr[4];
#pragma unroll
        for (int sI = 0; sI < 4; ++sI) { v4u w; w.x = pk2(qf[sI][0], qf[sI][1]); w.y = pk2(qf[sI][2], qf[sI][3]); w.z = pk2(qf[sI][4], qf[sI][5]); w.w = pk2(qf[sI][6], qf[sI][7]); qr[sI] = __builtin_bit_cast(bf16x8, w); }
        const int kt0 = qo >> 5;
        float qn2 = 0.f;
#pragma unroll
        for (int sI = 0; sI < 4; ++sI)
#pragma unroll
            for (int j = 0; j < 8; ++j) qn2 += qf[sI][j] * qf[sI][j];
        qn2 += __shfl_xor(qn2, 32);
        float mrun = sqrtf(qn2) * kbound * 1.02f;
        if (__any(mrun > 40.f)) { mrun = -1e30f;
#pragma unroll 1
            for (int kt = 0; kt < 9; ++kt) { const int kbase = (kt0 + kt) * 32;
                f32x16 acc = {};
#pragma unroll
                for (int sI = 0; sI < 4; ++sI) { const bf16x8 kfr = *(const LAS bf16x8*)(KS + (kbase + r32) * KST + 16 * sI + 8 * hh); acc = __builtin_amdgcn_mfma_f32_32x32x16_bf16(kfr, qr[sI], acc, 0, 0, 0); }
#pragma unroll
                for (int r = 0; r < 16; ++r) { const int ki = kbase + (r & 3) + 8 * (r >> 2) + 4 * hh; const int dq = ki - 128 - qrel, kp = qb * 128 - 128 + ki;
                    const bool ok = (dq >= -128) && (dq <= 128) && (kp >= 0) && (kp < T); mrun = fmaxf(mrun, ok ? acc[r] : -1e30f); } }
            mrun = fmaxf(mrun, __shfl_xor(mrun, 32)); }
        const float mx = fmaxf(mrun, snk);
        float lrun = 0.f; f32x16 o0 = {}, o1 = {}; const float mxl = mx * 1.442695041f; const bool edge = (qb == 0) || (qb == T / 128 - 1);
#pragma unroll 1
        for (int kt = 0; kt < 9; ++kt) { const int kbase = (kt0 + kt) * 32;
            f32x16 acc = {};
#pragma unroll
            for (int sI = 0; sI < 4; ++sI) { const bf16x8 kfr = *(const LAS bf16x8*)(KS + (kbase + r32) * KST + 16 * sI + 8 * hh); acc = __builtin_amdgcn_mfma_f32_32x32x16_bf16(kfr, qr[sI], acc, 0, 0, 0); }
            float p[16];
            if (edge || kt == 0 || kt == 8) {
#pragma unroll
                for (int r = 0; r < 16; ++r) { const int ki = kbase + (r & 3) + 8 * (r >> 2) + 4 * hh; const int dq = ki - 128 - qrel, kp = qb * 128 - 128 + ki;
                    const bool ok = (dq >= -128) && (dq <= 128) && (kp >= 0) && (kp < T); p[r] = ok ? __builtin_amdgcn_exp2f(acc[r] * 1.442695041f - mxl) : 0.f; lrun += p[r]; }
            } else {
#pragma unroll
                for (int r = 0; r < 16; ++r) { p[r] = __builtin_amdgcn_exp2f(acc[r] * 1.442695041f - mxl); lrun += p[r]; } }
#pragma unroll
            for (int sI = 0; sI < 2; ++sI) { v4u pw; pw.x = pk2(p[8 * sI + 0], p[8 * sI + 1]); pw.y = pk2(p[8 * sI + 2], p[8 * sI + 3]); pw.z = pk2(p[8 * sI + 4], p[8 * sI + 5]); pw.w = pk2(p[8 * sI + 6], p[8 * sI + 7]);
                const bf16x8 pa = __builtin_bit_cast(bf16x8, pw); const int key0 = kbase + 16 * sI + 4 * hh;
                { const u32x2 lo = *(const LAS u32x2*)(VT + r32 * VST + key0), hi = *(const LAS u32x2*)(VT + r32 * VST + key0 + 8); v4u vw; vw.x = lo.x; vw.y = lo.y; vw.z = hi.x; vw.w = hi.y;
                  o0 = __builtin_amdgcn_mfma_f32_32x32x16_bf16(pa, __builtin_bit_cast(bf16x8, vw), o0, 0, 0, 0); }
                { const u32x2 lo = *(const LAS u32x2*)(VT + (32 + r32) * VST + key0), hi = *(const LAS u32x2*)(VT + (32 + r32) * VST + key0 + 8); v4u vw; vw.x = lo.x; vw.y = lo.y; vw.z = hi.x; vw.w = hi.y;
                  o1 = __builtin_amdgcn_mfma_f32_32x32x16_bf16(pa, __builtin_bit_cast(bf16x8, vw), o1, 0, 0, 0); } } }
        lrun += __shfl_xor(lrun, 32);
        const float linv = 1.0f / (lrun + __expf(snk - mx));
        if (hh == 0) wsf[wave * 64 + r32] = linv;
        LDS_WAIT(); asm volatile("" ::: "memory");
#pragma unroll
        for (int r = 0; r < 16; ++r) { const int row = (r & 3) + 8 * (r >> 2) + 4 * hh; const float li = wsf[wave * 64 + row];
            bf16* op = OA + ((size_t)b * T + qb * 128 + qo + row) * 512 + hq * 64;
            op[r32] = (bf16)f2bf(o0[r] * li); op[32 + r32] = (bf16)f2bf(o1[r] * li); }
        LDS_WAIT(); asm volatile("" ::: "memory");
    }
    __syncthreads();
}

__device__ __forceinline__ void pg_rows(const Frame& F, ArgsP A, bf16* wout) {
    const bf16* Z = (const bf16*)(A->ws + WS_Z); const bf16* Y0 = (const bf16*)(A->ws + WS_XN); const bf16* Y1 = Y0 + (size_t)M * 512;
    bf16* Gb = (bf16*)(A->ws + WS_G); const float* bonus = (const float*)(A->ws + WS_BONUS);
    const float* mu_prev = (const float*)A->in[7]; const float* mu_next = (const float*)A->in[8]; const float* gn_w = (const float*)A->in[17]; const float* gn_b = (const float*)A->in[18];
    const int gw = F.vcu * NWAVES + F.wave, NGW = F.G * NWAVES, lane = F.lane, c0 = lane * 8, h = lane >> 3;
    float mp[8], mn[8], gw_[8], gb_[8];
#pragma unroll
    for (int j = 0; j < 8; ++j) { mp[j] = mu_prev[ZV + c0 + j]; mn[j] = mu_next[ZV + c0 + j]; gw_[j] = gn_w[c0 + j]; gb_[j] = gn_b[c0 + j]; }
#pragma unroll 1
    for (int m0 = gw; m0 < M; m0 += 4 * NGW) {
        v4u y0[4], y1[4], gv[4], z0[4], zm[4], zq[4]; float bon[4];
#pragma unroll
        for (int i = 0; i < 4; ++i) { const int m = m0 + i * NGW, t = m & (T - 1);
            y0[i] = *(const GAS v4u*)(Y0 + (size_t)m * 512 + c0); y1[i] = *(const GAS v4u*)(Y1 + (size_t)m * 512 + c0); gv[i] = *(const GAS v4u*)(Gb + (size_t)m * 512 + c0);
            z0[i] = *(const GAS v4u*)(Z + (size_t)m * NZ + ZV + c0);
            zm[i] = (v4u){0u, 0u, 0u, 0u}; zq[i] = (v4u){0u, 0u, 0u, 0u};
            if (t > 0) zm[i] = *(const GAS v4u*)(Z + (size_t)(m - 1) * NZ + ZV + c0);
            if (t < T - 1) zq[i] = *(const GAS v4u*)(Z + (size_t)(m + 1) * NZ + ZV + c0);
            bon[i] = bonus[(size_t)m * 8 + h] + bonus[(size_t)M * 8 + (size_t)m * 8 + h]; }
#pragma unroll
        for (int i = 0; i < 4; ++i) { const int m = m0 + i * NGW;
            const unsigned y0w[4] = {y0[i].x, y0[i].y, y0[i].z, y0[i].w}, y1w[4] = {y1[i].x, y1[i].y, y1[i].z, y1[i].w}, gvw[4] = {gv[i].x, gv[i].y, gv[i].z, gv[i].w};
            const unsigned z0w[4] = {z0[i].x, z0[i].y, z0[i].z, z0[i].w}, zmw[4] = {zm[i].x, zm[i].y, zm[i].z, zm[i].w}, zqw[4] = {zq[i].x, zq[i].y, zq[i].z, zq[i].w};
            float y[8], gg[8], vv[8]; float sacc = 0.f;
#pragma unroll
            for (int j = 0; j < 4; ++j) { y[2 * j] = bflo(y0w[j]) + bflo(y1w[j]); y[2 * j + 1] = bfhi(y0w[j]) + bfhi(y1w[j]); gg[2 * j] = bflo(gvw[j]); gg[2 * j + 1] = bfhi(gvw[j]);
                const float a0 = bflo(z0w[j]), a1 = bfhi(z0w[j]);
                vv[2 * j] = a0 + mp[2 * j] * (bflo(zmw[j]) - a0) + mn[2 * j] * (bflo(zqw[j]) - a0); vv[2 * j + 1] = a1 + mp[2 * j + 1] * (bfhi(zmw[j]) - a1) + mn[2 * j + 1] * (bfhi(zqw[j]) - a1);
                sacc += y[2 * j] + y[2 * j + 1]; }
            sacc += __shfl_xor(sacc, 1); sacc += __shfl_xor(sacc, 2); sacc += __shfl_xor(sacc, 4);
            const float mu = sacc * (1.0f / 64.0f); float q = 0.f;
#pragma unroll
            for (int j = 0; j < 8; ++j) { const float d = y[j] - mu; q += d * d; }
            q += __shfl_xor(q, 1); q += __shfl_xor(q, 2); q += __shfl_xor(q, 4);
            const float rstd = rsqrtf(q * (1.0f / 64.0f) + 64e-5f);
            float o[8];
#pragma unroll
            for (int j = 0; j < 8; ++j) o[j] = ((y[j] - mu) * rstd * gw_[j] + gb_[j] + bon[i] * vv[j]) * gg[j];
            v4u w; w.x = pk2(o[0], o[1]); w.y = pk2(o[2], o[3]); w.z = pk2(o[4], o[5]); w.w = pk2(o[6], o[7]);
            *(GAS v4u*)(wout + (size_t)m * 512 + c0) = w; } }
}

__device__ __forceinline__ void pj_phase(const Frame& F, ArgsP A) {
    unsigned char* ws = A->ws;
    const int gw = F.vcu * NWAVES + F.wave, NGW = F.G * NWAVES, lane = F.lane;
    { LAS float* scr = (LAS float*)(F.lds + F.wave * 16384);
      const float* w_gate = (const float*)A->in[27]; const float* w_up = (const float*)A->in[28]; const float* w_down = (const float*)A->in[29];
      bf16* WguT = (bf16*)((unsigned char*)A->out + OUT_WGUT); bf16* WdT = (bf16*)((unsigned char*)A->out + OUT_WDT);
      constexpr int PER = 512, NIT = 16 * 3 * PER;
      for (int it = gw; it < NIT; it += NGW) { const int e = it / (3 * PER), r = it % (3 * PER), which = r / PER, q = r % PER, kb = q >> 5, nb = q & 31, n0 = 32 * nb;
          if (which == 0) tr_item(w_gate + (size_t)e * 1048576, 1024, 64 * kb, n0, WguT, 1024, e * 2048 + (n0 >> 7) * 256 + (n0 & 127), scr, lane);
          else if (which == 1) tr_item(w_up + (size_t)e * 1048576, 1024, 64 * kb, n0, WguT, 1024, e * 2048 + (n0 >> 7) * 256 + 128 + (n0 & 127), scr, lane);
          else tr_item(w_down + (size_t)e * 1048576, 1024, 64 * kb, n0, WdT, 1024, e * 1024 + n0, scr, lane); }
    }
    __syncthreads();
    LAS float* wrT = (LAS float*)F.lds;
    const float* w_router = (const float*)A->in[26];
    for (int i = F.tid; i < 16384; i += 512) { const int d = i >> 4, e = i & 15; wrT[e * 1024 + d] = w_router[i]; }
    __syncthreads();
    const bf16* x1 = (const bf16*)(ws + WS_X1); const float* g2n = (const float*)A->in[25]; const float* mod = (const float*)(ws + WS_MOD);
    bf16* XN2 = (bf16*)(ws + WS_XN); float* aff = (float*)(ws + WS_AFF);
    u32x2 raw[4][4]; load_rows_bf16<4>(x1, gw, NGW, lane, raw);
#pragma unroll 1
    for (int m0 = gw; m0 < M; m0 += 4 * NGW) { f32x4 u[4][4];
        modnorm_rows_pre<4>(raw, m0, NGW, g2n, mod, 3072, 4096, XN2, lane, u);
        if (m0 + 4 * NGW < M) load_rows_bf16<4>(x1, m0 + 4 * NGW, NGW, lane, raw);
        float mylg[4] = {0.f, 0.f, 0.f, 0.f};
#pragma unroll 2
        for (int e = 0; e < 16; ++e) { f32x4 w[4];
#pragma unroll
            for (int j = 0; j < 4; ++j) w[j] = *(const LAS f32x4*)(wrT + e * 1024 + 4 * lane + 256 * j);
#pragma unroll
            for (int i = 0; i < 4; ++i) { float sacc = 0.f;
#pragma unroll
                for (int j = 0; j < 4; ++j) sacc += (u[i][j].x * w[j].x + u[i][j].y * w[j].y) + (u[i][j].z * w[j].z + u[i][j].w * w[j].w);
                sacc = dpp_wave_sum(sacc); mylg[i] = (lane == e) ? sacc : mylg[i]; } }
#pragma unroll
        for (int i = 0; i < 4; ++i) { const int m = m0 + i * NGW, b = m >> 11, t = m & (T - 1);
            float mx = mylg[i];
#pragma unroll
            for (int o = 1; o < 16; o <<= 1) mx = fmaxf(mx, __shfl_xor(mx, o));
            const float ex = expf(mylg[i] - mx); float den = ex;
#pragma unroll
            for (int o = 1; o < 16; o <<= 1) den += __shfl_xor(den, o);
            if (lane < 16) aff[((size_t)b * 16 + lane) * T + t] = ex / den; } }
}

__device__ __forceinline__ void pk_task(const Frame& F, ArgsP A, int b, int e) {
    unsigned char* ws = A->ws;
    const float* aff = (const float*)(ws + WS_AFF) + ((size_t)b * 16 + e) * T;
    int* slotmap = (int*)(ws + WS_SLOT); float* selaff = (float*)(ws + WS_SELAFF); int* selidx = (int*)(ws + WS_SELIDX);
    const bf16* XN2 = (const bf16*)(ws + WS_XN); bf16* XE = (bf16*)(ws + WS_XE);
    LAS unsigned* cnt = (LAS unsigned*)F.lds;
    LAS int* tokl = (LAS int*)(F.lds + 256);
    const int tid = F.tid, lane = F.lane, wave = F.wave;
    const f32x4 v4 = *(const GAS f32x4*)(aff + 4 * tid);
    const unsigned key[4] = {__float_as_uint(v4.x), __float_as_uint(v4.y), __float_as_uint(v4.z), __float_as_uint(v4.w)};
    unsigned thr = 0u;
#pragma unroll 1
    for (int bit = 31; bit >= 0; --bit) { const unsigned cand = thr | (1u << bit);
        const unsigned c = (unsigned)(__popcll(__ballot(key[0] >= cand)) + __popcll(__ballot(key[1] >= cand)) + __popcll(__ballot(key[2] >= cand)) + __popcll(__ballot(key[3] >= cand)));
        LAS unsigned* slot_ = cnt + 16 + (bit & 1) * 8;
        if (lane == 0) slot_[wave] = c;
        __syncthreads();
        unsigned tot = 0;
#pragma unroll
        for (int w = 0; w < 8; ++w) tot += slot_[w];
        if (tot >= 256u) thr = cand; }
    __syncthreads();
    int ngt = 0, neq = 0;
#pragma unroll
    for (int j = 0; j < 4; ++j) { ngt += key[j] > thr; neq += key[j] == thr; }
    int sg = ngt, se = neq;
#pragma unroll
    for (int o = 1; o < 64; o <<= 1) { const int a = __shfl_up(sg, o), c = __shfl_up(se, o); if (lane >= o) { sg += a; se += c; } }
    if (lane == 63) { cnt[wave] = (unsigned)sg; cnt[8 + wave] = (unsigned)se; }
    __syncthreads();
    int bg = 0, be = 0, totg = 0;
#pragma unroll
    for (int w = 0; w < 8; ++w) { const int a = (int)cnt[w], c = (int)cnt[8 + w]; if (w < wave) { bg += a; be += c; } totg += a; }
    int pg = bg + sg - ngt, pe = be + se - neq;
    const int need_eq = 256 - totg;
    int* smrow = slotmap + ((size_t)b * T + 4 * tid) * 16 + e;
#pragma unroll
    for (int j = 0; j < 4; ++j) { int slot = -1;
        if (key[j] > thr) { slot = pg; ++pg; } else if (key[j] == thr) { if (pe < need_eq) slot = totg + pe; ++pe; }
        smrow[j * 16] = slot;
        if (slot >= 0) { selidx[((size_t)e * 16 + b) * 256 + slot] = b * T + 4 * tid + j; selaff[((size_t)e * 16 + b) * 256 + slot] = __uint_as_float(key[j]); } }
    __syncthreads();
}

__device__ __forceinline__ void pn_rows(const Frame& F, ArgsP A, float* wout) {
    unsigned char* ws = A->ws;
    const int* slotmap = (const int*)(ws + WS_SLOT); const bf16* YE = (const bf16*)(ws + WS_XE); const float* mod = (const float*)(ws + WS_MOD); const bf16* X1 = (const bf16*)(ws + WS_X1);
    const int gw = F.vcu * NWAVES + F.wave, NGW = F.G * NWAVES, lane = F.lane;
#pragma unroll 1
    for (int m0 = gw; m0 < M; m0 += 2 * NGW) {
        int myslot[2]; f32x4 xv[2][4];
#pragma unroll
        for (int i = 0; i < 2; ++i) { const int m = m0 + i * NGW; myslot[i] = slotmap[(size_t)m * 16 + (lane & 15)];
#pragma unroll
            for (int hq = 0; hq < 2; ++hq) { const v4u w = *(const GAS v4u*)(X1 + (size_t)m * 1024 + hq * 512 + lane * 8);
                xv[i][2 * hq] = (f32x4){bflo(w.x), bfhi(w.x), bflo(w.y), bfhi(w.y)}; xv[i][2 * hq + 1] = (f32x4){bflo(w.z), bfhi(w.z), bflo(w.w), bfhi(w.w)}; } }
        unsigned long long msk[2]; v4u yw[2][4][2];
#pragma unroll
        for (int i = 0; i < 2; ++i) { const int b = (m0 + i * NGW) >> 11; msk[i] = __ballot(myslot[i] >= 0) & 0xffffull;
#pragma unroll
            for (int k = 0; k < 4; ++k) { const bool has = msk[i] != 0ull; const int e = has ? __builtin_ctzll(msk[i]) : 0; if (has) msk[i] &= msk[i] - 1; const int sl = __shfl(myslot[i], e);
                yw[i][k][0] = (v4u){0u, 0u, 0u, 0u}; yw[i][k][1] = (v4u){0u, 0u, 0u, 0u};
                if (has) { const GAS v4u* yr = (const GAS v4u*)(YE + (((size_t)e * 16 + b) * 256 + sl) * 1024); yw[i][k][0] = yr[lane]; yw[i][k][1] = yr[64 + lane]; } } }
#pragma unroll
        for (int i = 0; i < 2; ++i) { const int m = m0 + i * NGW, b = m >> 11;
            float acc[16];
#pragma unroll
            for (int j = 0; j < 16; ++j) acc[j] = 0.f;
#pragma unroll
            for (int k = 0; k < 4; ++k)
#pragma unroll
                for (int hlf = 0; hlf < 2; ++hlf) { const v4u w = yw[i][k][hlf];
                    acc[hlf * 8 + 0] += bflo(w.x); acc[hlf * 8 + 1] += bfhi(w.x); acc[hlf * 8 + 2] += bflo(w.y); acc[hlf * 8 + 3] += bfhi(w.y);
                    acc[hlf * 8 + 4] += bflo(w.z); acc[hlf * 8 + 5] += bfhi(w.z); acc[hlf * 8 + 6] += bflo(w.w); acc[hlf * 8 + 7] += bfhi(w.w); }
            unsigned long long mk = msk[i];
            while (mk) { const int e = __builtin_ctzll(mk); mk &= mk - 1; const int sl = __shfl(myslot[i], e);
                const GAS v4u* yr = (const GAS v4u*)(YE + (((size_t)e * 16 + b) * 256 + sl) * 1024);
#pragma unroll
                for (int hlf = 0; hlf < 2; ++hlf) { const v4u w = yr[hlf * 64 + lane];
                    acc[hlf * 8 + 0] += bflo(w.x); acc[hlf * 8 + 1] += bfhi(w.x); acc[hlf * 8 + 2] += bflo(w.y); acc[hlf * 8 + 3] += bfhi(w.y);
                    acc[hlf * 8 + 4] += bflo(w.z); acc[hlf * 8 + 5] += bfhi(w.z); acc[hlf * 8 + 6] += bflo(w.w); acc[hlf * 8 + 7] += bfhi(w.w); } }
            const float* gt2 = mod + (size_t)b * 6144 + 5120; float* orow = wout + (size_t)m * 1024;
#pragma unroll
            for (int q = 0; q < 4; ++q) { const int c = (q >> 1) * 512 + lane * 8 + (q & 1) * 4; const f32x4 g = *(const GAS f32x4*)(gt2 + c);
                f32x4 a; a.x = acc[(q >> 1) * 8 + (q & 1) * 4 + 0]; a.y = acc[(q >> 1) * 8 + (q & 1) * 4 + 1]; a.z = acc[(q >> 1) * 8 + (q & 1) * 4 + 2]; a.w = acc[(q >> 1) * 8 + (q & 1) * 4 + 3];
                *(GAS f32x4*)(orow + c) = xv[i][q] + g * a; } } }
}

__device__ __forceinline__ void mk_frame(Frame& F, LAS unsigned char* lds, int wave_s) {
    int bx = blockIdx.x, G = gridDim.x; LAUNDER(bx); LAUNDER(G);
    F.lds = lds; F.MISC = (volatile LAS unsigned*)(lds + MISC_OFF); F.ctl = nullptr;
    unsigned ones_ = ~0u; asm volatile("" : "+s"(ones_));
    int lane_ = (int)__builtin_amdgcn_mbcnt_hi(ones_, __builtin_amdgcn_mbcnt_lo(ones_, 0u)); asm volatile("" : "+v"(lane_));
    F.lane = lane_; F.wave = wave_s; F.tid = wave_s * 64 + lane_;
    F.G = G; F.vcu = (G % 8 == 0) ? (bx % 8) * (G / 8) + bx / 8 : bx;
}
__global__ void __launch_bounds__(NWAVES * 64, 2) fwd_kernel(Args args) {
    extern __shared__ __attribute__((aligned(16))) unsigned char lds[];
    LAS unsigned char* const ldsb = (LAS unsigned char*)lds;
    ArgsP ap0 = (ArgsP)__builtin_amdgcn_kernarg_segment_ptr();
    int wave_s = __builtin_amdgcn_readfirstlane((int)threadIdx.x >> 6); asm volatile("" : "+s"(wave_s));
    for (int u = threadIdx.x; u < (LDS_BYTES - LDSCTL_OFF) / 4; u += NWAVES * 64) ((LAS unsigned*)(ldsb + LDSCTL_OFF))[u] = 0u;
    __syncthreads();
#define MKBAR XcdBarrier bar; { ArgsP a_ = ap0; LAUNDER(a_); bar.bar = (unsigned*)(a_->ws + WS_CTL) + CW_BAR; bar.x = xb_xcc_id(); bar.st = (volatile LAS unsigned*)(ldsb + MISC_OFF) + 8; }
#if ONE_LAUNCH
    { MKBAR; if (threadIdx.x == 0) (void)xb_add(&bar.bar[XB_XCNT(bar.x)], 1u); }
#ifndef PHM
#define PHM 0x3fff
#endif
#define IN(k) ((PHM >> (k)) & 1)
#define SEAM(k) do { if (IN(k) && IN((k) + 1)) { MKBAR; { unsigned o_ = ~0u; asm volatile("" : "+s"(o_)); xcd_barrier(bar, wave_s == 0 && __builtin_amdgcn_mbcnt_hi(o_, __builtin_amdgcn_mbcnt_lo(o_, 0u)) == 0u); } } } while (0)
#else
    int lo, hi; { ArgsP a = ap0; LAUNDER(a); lo = a->ph_lo; hi = a->ph_hi; }
#define IN(k) (lo <= (k) && (k) < hi)
#define SEAM(k) do { } while (0)
#endif
    typedef pg8::bf16_t pb;
#ifndef REPMASK
#define REPMASK 0
#endif
#define PHASE_ARGS ArgsP ap = ap0; LAUNDER(ap); unsigned char* ws = ap->ws; (void)ws; Frame F; mk_frame(F, ldsb, wave_s); const int gw = F.vcu * NWAVES + F.wave, NGW = F.G * NWAVES; (void)gw; (void)NGW
    if (IN(0)) _Pragma("unroll 1") for (int rep_ = 0; rep_ <= ((REPMASK >> 0) & 1); ++rep_) { PHASE_ARGS; p0_prologue(F, ap); } SEAM(0);
    if (IN(1)) _Pragma("unroll 1") for (int rep_ = 0; rep_ <= ((REPMASK >> 1) & 1); ++rep_) { PHASE_ARGS; const float* x = (const float*)ap->in[0]; const float* g1 = (const float*)ap->in[5]; const float* mod = (const float*)(ws + WS_MOD); bf16* XN = (bf16*)(ws + WS_XN);
#pragma unroll 1
        for (int m = gw; m < M; m += 4 * NGW) { f32x4 u[4][4]; modnorm_rows<4, false>(x, m, NGW, g1, mod, 0, 1024, XN, F.lane, u);
            if (F.lane < 32) { const int mm = m + (F.lane >> 3) * NGW, j = F.lane & 7; const float pos = (float)((const int*)ap->in[2])[mm];
                const float ang = pos * __expf(-(float)j * 0.125f * 13.122363377404328f); float sn, cs; sincosf(ang, &sn, &cs);
                bf16* rt = (bf16*)(ws + WS_ROPE) + (size_t)mm * 16; rt[j] = (bf16)(pk2(cs, 0.f) & 0xffffu); rt[8 + j] = (bf16)(pk2(sn, 0.f) & 0xffffu); } } } SEAM(1);
    if (IN(2)) _Pragma("unroll 1") for (int rep_ = 0; rep_ <= ((REPMASK >> 2) & 1); ++rep_) { PHASE_ARGS; pg8::Gemm g{(const pb*)(ws + WS_XN), (const pb*)(ws + WS_WINT), M, NZP, D}; pg8::StaticOrder S; S.init(M, NZP, F.G, (int)blockIdx.x);
        pg8::EpiZ E{(pb*)(ws + WS_Z)}; pg8::gemm_phase<pg8::EpiZ, pg8::StaticOrder, true, true>(F.lds, g, S, E, F.tid); } SEAM(2);
    if (IN(3)) {
#ifndef REP_SCAN
#define REP_SCAN 1
#endif
#ifndef REP_ATTN
#define REP_ATTN 1
#endif
      { int c0_, G_; { Frame F0; mk_frame(F0, ldsb, wave_s); c0_ = F0.vcu; G_ = F0.G; }
#pragma unroll 1
        for (int c = c0_; c < 256 * REP_SCAN; c += G_) { PHASE_ARGS; const int b = (c >> 4) & 15, h = (c >> 1) & 7, dir = c & 1;
            scan2_setup(F.lds, (const GAS float*)ap->in[10], (const GAS float*)ap->in[12], h, dir, F.tid); __syncthreads();
            const ScanArgs SA{(const GAS bf16*)(ws + WS_Z), (const GAS float*)ap->in[7], (const GAS float*)ap->in[8], (const GAS float*)ap->in[9], (const GAS float*)ap->in[11], (const GAS float*)ap->in[14], (const GAS float*)ap->in[15], (const GAS float*)ap->in[16],
                              (GAS bf16*)(ws + WS_XN) + (size_t)dir * M * 512, (GAS float*)(ws + WS_BONUS) + (size_t)dir * M * 8};
#pragma unroll 1
            for (int cc = F.wave; cc < T / 32; cc += 8) scan2_chunk(F.lds, SA, b, h, dir, cc, F.lane, F.wave);
            __syncthreads(); } }
      { PHASE_ARGS;
#pragma unroll 1
        for (int u = F.vcu; u < 512 * REP_ATTN; u += F.G) { attn_unit(F, ap, (u >> 5) & 15, (u >> 4) & 1, u & 15); } }
      { PHASE_ARGS;
        const bf16* Z = (const bf16*)(ws + WS_Z); bf16* SGD = (bf16*)(ws + WS_SGD); const float* mu_prev = (const float*)ap->in[7]; const float* mu_next = (const float*)ap->in[8];
          const int c = ZGD + 2 * F.lane; const float mp0 = mu_prev[c], mp1 = mu_prev[c + 1], mn0 = mu_next[c], mn1 = mu_next[c + 1];
#ifndef REP_SGD
#define REP_SGD 1
#endif
#pragma unroll 1
          for (int rp_ = 0; rp_ < REP_SGD; ++rp_)
#pragma unroll 1
          for (int m0 = gw; m0 < M; m0 += 4 * NGW) { unsigned z0[4], zm[4], zq[4];
#pragma unroll
              for (int i = 0; i < 4; ++i) { const int m = m0 + i * NGW, t = m & (T - 1);
                  z0[i] = *(const GAS unsigned*)(Z + (size_t)m * NZ + c); zm[i] = t > 0 ? *(const GAS unsigned*)(Z + (size_t)(m - 1) * NZ + c) : 0u; zq[i] = t < T - 1 ? *(const GAS unsigned*)(Z + (size_t)(m + 1) * NZ + c) : 0u; }
#pragma unroll
              for (int i = 0; i < 4; ++i) { const int m = m0 + i * NGW;
                  const float a0 = bflo(z0[i]), a1 = bfhi(z0[i]); const float s0 = a0 + mp0 * (bflo(zm[i]) - a0) + mn0 * (bflo(zq[i]) - a0), s1 = a1 + mp1 * (bfhi(zm[i]) - a1) + mn1 * (bfhi(zq[i]) - a1);
                  *(GAS unsigned*)(SGD + (size_t)m * 256 + 2 * F.lane) = pk2(sigm(s0), sigm(s1)); *(GAS unsigned*)(SGD + (size_t)m * 256 + 128 + 2 * F.lane) = 0u; } } }
    } SEAM(3);
    if (IN(4)) _Pragma("unroll 1") for (int rep_ = 0; rep_ <= ((REPMASK >> 4) & 1); ++rep_) { PHASE_ARGS; pg8::Gemm g{(const pb*)(ws + WS_SGD), (const pb*)(ws + WS_G2T), M, 512, 256}; pg8::StaticOrder S; S.init(M, 512, F.G, (int)blockIdx.x);
        pg8::EpiPlain E{(pb*)(ws + WS_G), 512}; pg8::gemm_phase<pg8::EpiPlain, pg8::StaticOrder, true, true>(F.lds, g, S, E, F.tid); } SEAM(4);
#ifndef REP_PG
#define REP_PG 0
#endif
    if (IN(5)) { PHASE_ARGS; if (REP_PG) pg_rows(F, ap, (bf16*)ap->out); pg_rows(F, ap, (bf16*)(ws + WS_G)); } SEAM(5);
    if (IN(6)) { PHASE_ARGS; static_assert(WS_G == WS_OATT + (size_t)M * 512 * 2 && WS_PAT == WS_PRT + (size_t)1024 * 512 * 2, "merged operand views need adjacent buffers");
        pg8::Gemm g{(const pb*)(ws + WS_OATT), (const pb*)(ws + WS_PRT), 2 * M, 2048, 512}; pg8::MergeOrder S; S.init(F.G, (int)blockIdx.x);
        pg8::EpiGate2 E{(pb*)(ws + WS_XN), (const pb*)(ws + WS_Z)}; pg8::gemm_phase<pg8::EpiGate2, pg8::MergeOrder, true, true>(F.lds, g, S, E, F.tid); } SEAM(7);
    if (IN(8)) _Pragma("unroll 1") for (int rep_ = 0; rep_ <= ((REPMASK >> 8) & 1); ++rep_) { PHASE_ARGS; pg8::Gemm g{(const pb*)(ws + WS_XN), (const pb*)(ws + WS_WOT), M, 1024, 1024}; pg8::StaticOrder S; S.init(M, 1024, F.G, (int)blockIdx.x);
        pg8::EpiRes E{(const float*)ap->in[0], (const float*)(ws + WS_MOD), (pb*)(ws + WS_X1)}; pg8::gemm_phase<pg8::EpiRes, pg8::StaticOrder, true, true>(F.lds, g, S, E, F.tid); } SEAM(8);
    if (IN(9)) _Pragma("unroll 1") for (int rep_ = 0; rep_ <= ((REPMASK >> 9) & 1); ++rep_) { PHASE_ARGS; pj_phase(F, ap); } SEAM(9);
    if (IN(10)) _Pragma("unroll 1") for (int rep_ = 0; rep_ <= ((REPMASK >> 10) & 1); ++rep_) { PHASE_ARGS; for (int p = F.vcu; p < 256; p += F.G) pk_task(F, ap, p >> 4, p & 15); } SEAM(10);
    if (IN(11)) _Pragma("unroll 1") for (int rep_ = 0; rep_ <= ((REPMASK >> 11) & 1); ++rep_) { PHASE_ARGS; pg8::Gemm g{(const pb*)(ws + WS_XN), (const pb*)((unsigned char*)ap->out + OUT_WGUT), ME, 16 * 2048, 1024}; pg8::GroupOrder<8> S{F.G, (int)blockIdx.x};
        pg8::EpiSwiglu E{(pb*)(ws + WS_H)}; pg8::gemm_phase<pg8::EpiSwiglu, pg8::GroupOrder<8>, true, true, true>(F.lds, g, S, E, F.tid, (const int*)(ws + WS_SELIDX)); } SEAM(11);
    if (IN(12)) _Pragma("unroll 1") for (int rep_ = 0; rep_ <= ((REPMASK >> 12) & 1); ++rep_) { PHASE_ARGS; pg8::Gemm g{(const pb*)(ws + WS_H), (const pb*)((unsigned char*)ap->out + OUT_WDT), ME, 16 * 1024, 1024}; pg8::GroupOrder<4> S{F.G, (int)blockIdx.x};
        pg8::EpiDown E{(pb*)(ws + WS_XE), (const float*)(ws + WS_SELAFF)}; pg8::gemm_phase<pg8::EpiDown, pg8::GroupOrder<4>, true, true>(F.lds, g, S, E, F.tid); } SEAM(12);
#ifndef EXTRA_BARS
#define EXTRA_BARS 0
#endif
#if ONE_LAUNCH
    _Pragma("unroll 1") for (int xb_ = 0; xb_ < EXTRA_BARS; ++xb_) { MKBAR; { unsigned o_ = ~0u; asm volatile("" : "+s"(o_)); xcd_barrier(bar, wave_s == 0 && __builtin_amdgcn_mbcnt_hi(o_, __builtin_amdgcn_mbcnt_lo(o_, 0u)) == 0u); } }
#endif
#ifndef REP_PN
#define REP_PN 0
#endif
    if (IN(13)) { PHASE_ARGS; if (REP_PN) pn_rows(F, ap, (float*)(ws + WS_H)); pn_rows(F, ap, ap->out); }
#undef IN
#undef SEAM
}

extern "C" void kernel_launch(void* const* d_in, const int* in_sizes, int n_in, void* d_out, int out_size, void* d_ws, size_t ws_size, hipStream_t stream) {
    static int grid = 0;
    if (grid == 0) {
        if (n_in != 30 || out_size != M * D || ws_size < WS_END) { fprintf(stderr, "kernel_launch: unexpected shapes n_in %d out %d ws %zu\n", n_in, out_size, ws_size); grid = -1; return; }
        int dev = 0, cus = 0, per_cu = 0;
        if (hipGetDevice(&dev) != hipSuccess || hipDeviceGetAttribute(&cus, hipDeviceAttributeMultiprocessorCount, dev) != hipSuccess) { grid = -1; return; }
        if (hipFuncSetAttribute((const void*)fwd_kernel, hipFuncAttributeMaxDynamicSharedMemorySize, LDS_BYTES) != hipSuccess) { fprintf(stderr, "kernel_launch: hipFuncSetAttribute failed\n"); grid = -1; return; }
        if (hipOccupancyMaxActiveBlocksPerMultiprocessor(&per_cu, (const void*)fwd_kernel, NWAVES * 64, LDS_BYTES) != hipSuccess || per_cu < 1) fprintf(stderr, "kernel_launch: occupancy query reports %d\n", per_cu);
        (void)hipGetLastError();
        grid = cus;
    }
    if (grid < 0) return;
    if (hipMemsetAsync((char*)d_ws + WS_CTL, 0, CTL_ZERO_BYTES, stream) != hipSuccess) return;
    Args a{};
    for (int i = 0; i < 30; ++i) a.in[i] = d_in[i];
    a.out = (float*)d_out; a.ws = (unsigned char*)d_ws;
#if ONE_LAUNCH
    a.ph_lo = 0; a.ph_hi = NPHASE;
    hipLaunchKernelGGL(fwd_kernel, dim3(grid), dim3(NWAVES * 64), LDS_BYTES, stream, a);
#else
    for (int p = 0; p < NPHASE; ++p) { a.ph_lo = p; a.ph_hi = p + 1; hipLaunchKernelGGL(fwd_kernel, dim3(grid), dim3(NWAVES * 64), LDS_BYTES, stream, a); }
#endif
}
```

```cpp
#include <hip/hip_runtime.h>
#include <cstdio>
#include <cstdint>
#include <cmath>
namespace pg8 {
#define PG8_LAS __attribute__((address_space(3)))
typedef unsigned short bf16_t;
typedef short bf16x8 __attribute__((ext_vector_type(8)));
typedef float f32x4 __attribute__((ext_vector_type(4)));
typedef unsigned u32x4 __attribute__((ext_vector_type(4)));
constexpr int BM = 256, BK = 64, HALF = 128, HTB = HALF * BK * 2  , STAGE_BYTES = 8 * HTB, NXCD = 8, WGM = 8;

__host__ __device__ __forceinline__ int lds_byte(int r, int c) { const int st = (r >> 4) * 2 + (c >> 5), rr = r & 15, cc = c & 31, ob = rr * 64 + cc * 2; return st * 1024 + (ob ^ (((ob >> 9) & 1) << 5)); }
__host__ __device__ __forceinline__ void stage_rc(int b, int& R, int& C) { const int st = b / 1024, sb = b % 1024, swz = sb ^ (((sb >> 9) & 1) << 5); R = (st >> 1) * 16 + swz / 64; C = (st & 1) * 32 + (swz % 64) / 2; }
__host__ __device__ __forceinline__ int perm32(int rho) { const int n = rho >> 4, i = rho & 15; return 8 * (i >> 2) + 4 * n + (i & 3); }

struct Unit { int pm, pn; };
struct Gemm { const bf16_t* A; const bf16_t* Bt; int M, N, K; };

struct StaticOrder {
    int nM, nN, nwg, G, c;
    __host__ __device__ void init(int M, int N, int G_, int c_) { nM = M / BM; nN = N / BM; nwg = nM * nN; G = G_; c = c_; }
    __host__ __device__ bool next(int i, Unit& u) const {
        const long L = (long)i * G + c; if (L >= nwg) return false;
        int wgid = (int)L; { const int q = nwg / NXCD, r = nwg % NXCD, xcd = wgid % NXCD, off = wgid / NXCD; wgid = (xcd < r ? xcd * (q + 1) : r * (q + 1) + (xcd - r) * q) + off; }
        const int nig = WGM * nN, gid = wgid / nig, fm = gid * WGM, gsz = (nM - fm) < WGM ? (nM - fm) : WGM;
        u.pm = fm + ((wgid % nig) % gsz); u.pn = (wgid % nig) / gsz; return true;
    }
    __device__ __forceinline__ void a_ready(const Unit&) const {}
    __device__ __forceinline__ void done(const Unit&) const {}
};

__device__ __forceinline__ unsigned cvt_pk_bf16(float lo, float hi) { unsigned r; asm volatile("v_cvt_pk_bf16_f32 %0, %1, %2" : "=v"(r) : "v"(lo), "v"(hi)); return r; }
typedef float f32x2 __attribute__((ext_vector_type(2)));
template <class Epi, class Sched, bool ALIGN_EPI = false, bool SP2 = false, bool GATHER = false>
__device__ __forceinline__ void gemm_phase(PG8_LAS unsigned char* lds, const Gemm g, const Sched& S, const Epi& E, int tid_in, const int* gidx = nullptr) {
    static_assert(!GATHER || SP2, "the gather variant is written for the SP2 loop");
    int tid_ = tid_in; asm volatile("" : "+v"(tid_));
    const int tid = tid_, wid = __builtin_amdgcn_readfirstlane(tid >> 6), lane = tid & 63, wr = wid >> 2, wc = wid & 3, fr = lane & 15, fq = lane >> 4;
    const int K = g.K, nt = K / BK;
    unsigned voffA[2], voffB[2];
#pragma unroll
    for (int i = 0; i < 2; ++i) { int R, C; stage_rc(tid * 16 + i * 8192, R, C); const int Rb = Epi::PERM ? ((R & ~31) + perm32(R & 31)) : R;
        voffA[i] = (unsigned)(R * K + C) * 2u; voffB[i] = (unsigned)(Rb * K + C) * 2u; }
    int gRA[2] = {0, 0}; unsigned gCA[2] = {0u, 0u}; unsigned gc[2][2] = {{0u, 0u}, {0u, 0u}}, gn[2][2] = {{0u, 0u}, {0u, 0u}};
    if constexpr (GATHER) {
#pragma unroll
        for (int i = 0; i < 2; ++i) { int R, C; stage_rc(tid * 16 + i * 8192, R, C); gRA[i] = R; gCA[i] = (unsigned)C * 2u; } }
#define PG8_GLOAD(dst, un) do { _Pragma("unroll") for (int h_ = 0; h_ < 2; ++h_) _Pragma("unroll") for (int i_ = 0; i_ < 2; ++i_) \
        dst[h_][i_] = (unsigned)gidx[(un).pm * 256 + h_ * 128 + gRA[i_]] * (unsigned)(K * 2) + gCA[i_]; } while (0)
#define PG8_STAGE_G(bufoff, gbase, nx, h) do { unsigned vo_[2] = {(nx) ? gn[h][0] : gc[h][0], (nx) ? gn[h][1] : gc[h][1]}; PG8_STAGE(bufoff, gbase, vo_); } while (0)
    const size_t kstep = (size_t)(BK * 2);
    const size_t hstep = (size_t)HALF * K * 2;
    const size_t tstep = 2 * hstep;
    const unsigned ldsw = (unsigned)wid * 1024u;
    const int aoff = lds_byte(wr * 64 + fr, fq * 8), boff = lds_byte(wc * 32 + fr, fq * 8);
#define PG8_SA(b, h) (((b) * 2 + (h)) * HTB)
#define PG8_SB(b, h) ((4 + (b) * 2 + (h)) * HTB)
#define PG8_STAGE(bufoff, gbase, voff) do { _Pragma("unroll") for (int _i = 0; _i < 2; ++_i) \
        __builtin_amdgcn_global_load_lds((const unsigned*)((const char*)(gbase) + (voff)[_i]), (PG8_LAS unsigned*)(lds + (bufoff) + ldsw + _i * 8192), 16, 0, 0); } while (0)
#define PG8_LDA(dst, b, h) do { _Pragma("unroll") for (int m = 0; m < 4; ++m) _Pragma("unroll") for (int k = 0; k < 2; ++k) dst[m][k] = *(const PG8_LAS bf16x8*)(lds + PG8_SA(b, h) + aoff + m * 2048 + k * 1024); } while (0)
#define PG8_LDB(dst, b, h) do { _Pragma("unroll") for (int n = 0; n < 2; ++n) _Pragma("unroll") for (int k = 0; k < 2; ++k) dst[n][k] = *(const PG8_LAS bf16x8*)(lds + PG8_SB(b, h) + boff + n * 2048 + k * 1024); } while (0)
#define PG8_MMA(ai, bj, At, Bt) do { __builtin_amdgcn_s_setprio(1); _Pragma("unroll") for (int m = 0; m < 4; ++m) _Pragma("unroll") for (int n = 0; n < 2; ++n) _Pragma("unroll") for (int k = 0; k < 2; ++k) \
        acc[ai][bj][m][n] = __builtin_amdgcn_mfma_f32_16x16x32_bf16(Bt[n][k], At[m][k], acc[ai][bj][m][n], 0, 0, 0); __builtin_amdgcn_s_setprio(0); } while (0)
#define PG8_WAIT_V(n) asm volatile("s_waitcnt vmcnt(" #n ")" ::: "memory")
#define PG8_WAIT_L(n) asm volatile("s_waitcnt lgkmcnt(" #n ")" ::: "memory")
#define PG8_BAR __builtin_amdgcn_s_barrier()
#define PG8_SCHED __builtin_amdgcn_sched_barrier(0)
    Unit cur, nxt; int ui = 0;
    if (!S.next(0, cur)) return;
    f32x4 acc[2][2][4][2];
#pragma unroll
    for (int a = 0; a < 2; ++a)
#pragma unroll
        for (int b = 0; b < 2; ++b)
#pragma unroll
            for (int m = 0; m < 4; ++m)
#pragma unroll
                for (int n = 0; n < 2; ++n) acc[a][b][m][n] = (f32x4){0.f, 0.f, 0.f, 0.f};
    bf16x8 At[4][2], B0[2][2], B1[2][2];
    const char* cA = GATHER ? (const char*)g.A : (const char*)g.A + (size_t)cur.pm * tstep; const char* cB = (const char*)g.Bt + (size_t)cur.pn * tstep;
    if constexpr (GATHER) { PG8_GLOAD(gc, cur); Unit n1_; if (S.next(1, n1_)) PG8_GLOAD(gn, n1_); else { gn[0][0] = gc[0][0]; gn[0][1] = gc[0][1]; gn[1][0] = gc[1][0]; gn[1][1] = gc[1][1]; } }
    S.a_ready(cur);
    if constexpr (SP2) {
        PG8_STAGE(PG8_SB(0, 0), cB, voffB); PG8_STAGE(PG8_SB(0, 1), cB + hstep, voffB);
        if constexpr (GATHER) { PG8_STAGE_G(PG8_SA(0, 0), cA, false, 0); PG8_STAGE_G(PG8_SA(0, 1), cA, false, 1); } else { PG8_STAGE(PG8_SA(0, 0), cA, voffA); PG8_STAGE(PG8_SA(0, 1), cA + hstep, voffA); }
        if (wr == 1) PG8_BAR;
        PG8_WAIT_V(2); PG8_BAR;
        PG8_STAGE(PG8_SB(1, 0), cB + kstep, voffB); if constexpr (GATHER) PG8_STAGE_G(PG8_SA(1, 0), cA + kstep, false, 0); else PG8_STAGE(PG8_SA(1, 0), cA + kstep, voffA); PG8_STAGE(PG8_SB(1, 1), cB + hstep + kstep, voffB);
        PG8_WAIT_V(6); PG8_BAR;
    } else {
        PG8_STAGE(PG8_SB(0, 0), cB, voffB); PG8_STAGE(PG8_SA(0, 0), cA, voffA); PG8_STAGE(PG8_SB(0, 1), cB + hstep, voffB); PG8_STAGE(PG8_SA(0, 1), cA + hstep, voffA);
        if (wr == 1) PG8_BAR;
        PG8_WAIT_V(4); PG8_BAR;
        PG8_STAGE(PG8_SB(1, 0), cB + kstep, voffB); PG8_STAGE(PG8_SA(1, 0), cA + kstep, voffA); PG8_STAGE(PG8_SB(1, 1), cB + hstep + kstep, voffB);
        PG8_WAIT_V(6); PG8_BAR;
    }
    for (;;) {
        const bool has_next = S.next(ui + 1, nxt);
        if constexpr (GATHER) { if (!has_next) { gn[0][0] = gc[0][0]; gn[0][1] = gc[0][1]; gn[1][0] = gc[1][0]; gn[1][1] = gc[1][1]; } }
        const char* nA = (has_next && !GATHER) ? (const char*)g.A + (size_t)nxt.pm * tstep : cA; const char* nB = has_next ? (const char*)g.Bt + (size_t)nxt.pn * tstep : cB;
        for (int t = 0; t < nt; t += 2) {
            const bool last = (t == nt - 2);
            const char* a1 = cA + (size_t)(t + 1) * kstep;
            const char* a2 = last ? nA : cA + (size_t)(t + 2) * kstep; const char* b2 = last ? nB : cB + (size_t)(t + 2) * kstep;
            const char* a3 = a2 + kstep; const char* b3 = b2 + kstep;
            if (last && has_next) S.a_ready(nxt);
            if constexpr (SP2) {
            PG8_LDB(B0, 0, 0); PG8_LDB(B1, 0, 1); PG8_SCHED; PG8_LDA(At, 0, 0); if constexpr (GATHER) PG8_STAGE_G(PG8_SA(1, 1), a1, false, 1); else PG8_STAGE(PG8_SA(1, 1), a1 + hstep, voffA);
            PG8_WAIT_V(8); PG8_WAIT_L(0); PG8_BAR; PG8_MMA(0, 0, At, B0); PG8_MMA(0, 1, At, B1); PG8_BAR; PG8_SCHED;
            PG8_LDA(At, 0, 1); PG8_STAGE(PG8_SB(0, 0), b2, voffB); PG8_STAGE(PG8_SB(0, 1), b2 + hstep, voffB); if constexpr (GATHER) PG8_STAGE_G(PG8_SA(0, 0), a2, last, 0); else PG8_STAGE(PG8_SA(0, 0), a2, voffA);
            PG8_WAIT_V(8); PG8_WAIT_L(0); PG8_BAR; PG8_MMA(1, 0, At, B0); PG8_MMA(1, 1, At, B1); PG8_BAR; PG8_SCHED;
            PG8_LDB(B0, 1, 0); PG8_LDB(B1, 1, 1); PG8_SCHED; PG8_LDA(At, 1, 0); if constexpr (GATHER) PG8_STAGE_G(PG8_SA(0, 1), a2, last, 1); else PG8_STAGE(PG8_SA(0, 1), a2 + hstep, voffA);
            PG8_WAIT_V(8); PG8_WAIT_L(0); PG8_BAR; PG8_MMA(0, 0, At, B0); PG8_MMA(0, 1, At, B1); PG8_BAR; PG8_SCHED;
            PG8_LDA(At, 1, 1); PG8_STAGE(PG8_SB(1, 0), b3, voffB); PG8_STAGE(PG8_SB(1, 1), b3 + hstep, voffB); if constexpr (GATHER) PG8_STAGE_G(PG8_SA(1, 0), a3, last, 0); else PG8_STAGE(PG8_SA(1, 0), a3, voffA);
            PG8_WAIT_V(8); PG8_WAIT_L(0); PG8_BAR; PG8_MMA(1, 0, At, B0); PG8_MMA(1, 1, At, B1); PG8_BAR; PG8_SCHED;
            } else {
            PG8_LDB(B0, 0, 0); PG8_SCHED; PG8_LDA(At, 0, 0); PG8_STAGE(PG8_SA(1, 1), a1 + hstep, voffA);
            PG8_WAIT_L(8); PG8_BAR; PG8_WAIT_L(0); PG8_MMA(0, 0, At, B0); PG8_BAR; PG8_SCHED;
            PG8_LDB(B1, 0, 1); PG8_STAGE(PG8_SB(0, 0), b2, voffB);
            PG8_BAR; PG8_WAIT_L(0); PG8_MMA(0, 1, At, B1); PG8_BAR;
            PG8_LDA(At, 0, 1); PG8_STAGE(PG8_SA(0, 0), a2, voffA);
            PG8_BAR; PG8_WAIT_L(0); PG8_MMA(1, 0, At, B0); PG8_BAR; PG8_SCHED;
            PG8_STAGE(PG8_SB(0, 1), b2 + hstep, voffB);
            PG8_WAIT_V(6); PG8_BAR; PG8_MMA(1, 1, At, B1); PG8_BAR;
            PG8_LDB(B0, 1, 0); PG8_SCHED; PG8_LDA(At, 1, 0); PG8_STAGE(PG8_SA(0, 1), a2 + hstep, voffA);
            PG8_WAIT_L(8); PG8_BAR; PG8_WAIT_L(0); PG8_MMA(0, 0, At, B0); PG8_BAR; PG8_SCHED;
            PG8_LDB(B1, 1, 1); PG8_STAGE(PG8_SB(1, 0), b3, voffB);
            PG8_BAR; PG8_WAIT_L(0); PG8_MMA(0, 1, At, B1); PG8_BAR;
            PG8_LDA(At, 1, 1); PG8_STAGE(PG8_SA(1, 0), a3, voffA);
            PG8_BAR; PG8_WAIT_L(0); PG8_MMA(1, 0, At, B0); PG8_BAR; PG8_SCHED;
            PG8_STAGE(PG8_SB(1, 1), b3 + hstep, voffB);
            PG8_WAIT_V(6); PG8_BAR; PG8_MMA(1, 1, At, B1); PG8_BAR;
            }
        }
        if constexpr (ALIGN_EPI) { if (wr == 0) PG8_BAR; }
        if constexpr (!Epi::AFTER_DRAIN) { E(acc, cur, wr, wc, fr, fq); S.done(cur); }
        unsigned g2_[2][2] = {{0u, 0u}, {0u, 0u}};
        if constexpr (GATHER) { Unit nn_; if (has_next && S.next(ui + 2, nn_)) PG8_GLOAD(g2_, nn_); else { g2_[0][0] = gn[0][0]; g2_[0][1] = gn[0][1]; g2_[1][0] = gn[1][0]; g2_[1][1] = gn[1][1]; } }
        if (!has_next) break;
#pragma unroll
        for (int a = 0; a < 2; ++a)
#pragma unroll
            for (int b = 0; b < 2; ++b)
#pragma unroll
                for (int m = 0; m < 4; ++m)
#pragma unroll
                    for (int n = 0; n < 2; ++n) acc[a][b][m][n] = (f32x4){0.f, 0.f, 0.f, 0.f};
        cur = nxt; cA = nA; cB = nB; ++ui;
        if constexpr (GATHER) { gc[0][0] = gn[0][0]; gc[0][1] = gn[0][1]; gc[1][0] = gn[1][0]; gc[1][1] = gn[1][1]; gn[0][0] = g2_[0][0]; gn[0][1] = g2_[0][1]; gn[1][0] = g2_[1][0]; gn[1][1] = g2_[1][1]; }
        if constexpr (ALIGN_EPI) { if (wr == 1) PG8_BAR; }
    }
    PG8_WAIT_V(0);
    if constexpr (!ALIGN_EPI) { if (wr == 0) PG8_BAR; }
    PG8_BAR;
    if constexpr (Epi::AFTER_DRAIN) { E.fused(acc, cur, wr, wc, fr, fq, lds, wid, lane); S.done(cur); }
#undef PG8_SA
#undef PG8_SB
#undef PG8_STAGE
#undef PG8_STAGE_G
#undef PG8_GLOAD
#undef PG8_LDA
#undef PG8_LDB
#undef PG8_MMA
#undef PG8_WAIT_V
#undef PG8_WAIT_L
#undef PG8_BAR
#undef PG8_SCHED
}
}

#ifndef ONE_LAUNCH
#define ONE_LAUNCH 1
#endif
constexpr int NB = 16, T = 2048, D = 1024, M = NB * T;
constexpr int NZ = 4736, NZP = 4864;
constexpr int RW = 512, NE = 16, CAP = 256, ME = NE * NB * CAP;
constexpr int ZR = 0, ZK = 512, ZV = 1024, ZWD = 1536, ZAD = 1664, ZGD = 1792, ZQ = 1920, ZKA = 2432, ZVA = 2560, ZGA = 2688, ZGB = 3712;
constexpr int NWAVES = 8, NPHASE = 14;
constexpr size_t MiB = 1u << 20;
constexpr size_t WS_CTL = 0, CTL_ZERO_BYTES = 64 * 1024 + 16 * 6144 * 4;
constexpr size_t WS_MOD = 64 * 1024, WS_BONUS = 2 * MiB, WS_AFF = 4 * MiB, WS_SELAFF = 6 * MiB, WS_SLOT = 7 * MiB, WS_G2T = 9 * MiB;
constexpr size_t WS_WINT = 10 * MiB, WS_PRT = 20 * MiB, WS_PAT = 21 * MiB, WS_WOT = 22 * MiB, WS_SGD = 24 * MiB;
constexpr size_t WS_XN = 40 * MiB;
constexpr size_t WS_OATT = 104 * MiB;
constexpr size_t WS_G = 136 * MiB;
constexpr size_t WS_Z = 168 * MiB;
constexpr size_t WS_X1 = 104 * MiB;
constexpr size_t OUT_WGUT = 0;
constexpr size_t OUT_WDT = 64 * MiB;
constexpr size_t WS_XE = 200 * MiB;
constexpr size_t WS_H = 328 * MiB;
constexpr size_t WS_END = 464 * MiB;
constexpr size_t WS_ROPE = WS_AFF;
constexpr size_t WS_SELIDX = WS_SELAFF + 512 * 1024;
constexpr int CW_BAR = 4096;
constexpr int RING_BYTES = 131072, LDSCTL_OFF = RING_BYTES, MISC_OFF = LDSCTL_OFF + 320, LDS_BYTES = 147456;

#define GAS __attribute__((address_space(1)))
#define LAS __attribute__((address_space(3)))
typedef unsigned short bf16;
typedef unsigned v4u __attribute__((ext_vector_type(4)));
typedef float f32x4 __attribute__((ext_vector_type(4)));
typedef short bf16x8 __attribute__((ext_vector_type(8)));
typedef GAS unsigned gu32;
typedef GAS unsigned long long gu64;
#define RLX_AGENT __ATOMIC_RELAXED, __HIP_MEMORY_SCOPE_AGENT
#define LDS_WAIT() asm volatile("s_waitcnt lgkmcnt(0)" ::: "memory")
#define VM_WAIT() asm volatile("s_waitcnt vmcnt(0)" ::: "memory")
__device__ __forceinline__ unsigned long long rt() { return __builtin_amdgcn_s_memrealtime(); }
__device__ __forceinline__ unsigned f2bf(float f) { unsigned u = __builtin_bit_cast(unsigned, f); return (u + 0x7fffu + ((u >> 16) & 1u)) >> 16; }
typedef float f32x2hw __attribute__((ext_vector_type(2))); typedef __bf16 bf16x2hw __attribute__((ext_vector_type(2)));
__device__ __forceinline__ unsigned pk2(float lo, float hi) { f32x2hw v = {lo, hi}; bf16x2hw b = __builtin_convertvector(v, bf16x2hw); return __builtin_bit_cast(unsigned, b); }

#define XB_TMO      128
#define XB_XCNT(j)  (256  + 64 * (j))
#define XB_XSUB(j)  (1280 + 64 * (j))
#define XB_XGEN(j)  (2304 + 64 * (j))
#define XB_TOP      3328
#define XB_TOPGEN   3392
#define XCD_BAR_WORDS 3456
#define XB_SPIN_CAP (1u << 18)

__device__ __forceinline__ unsigned xb_ld(unsigned* p)              { return __hip_atomic_load(p, __ATOMIC_RELAXED, __HIP_MEMORY_SCOPE_AGENT); }
__device__ __forceinline__ unsigned xb_add(unsigned* p, unsigned v) { return __hip_atomic_fetch_add(p, v, __ATOMIC_RELAXED, __HIP_MEMORY_SCOPE_AGENT); }
__device__ __forceinline__ unsigned xb_xcc_id() { return (unsigned)__builtin_amdgcn_s_getreg((3 << 11) | 20) & 0xFu; }
#define XB_SPIN(cond, bar) do { unsigned _sp = 0; while (cond) { __builtin_amdgcn_s_sleep(1); \
    if ((++_sp & 255u) == 0u) { if (xb_ld(&(bar)[XB_TMO])) break; if (_sp > XB_SPIN_CAP) { atomicAdd(&(bar)[XB_TMO], 1u); break; } } } } while (0)

struct XcdBarrier {
    unsigned* bar; unsigned x;
    volatile LAS unsigned* st;
};

__device__ __forceinline__ XcdBarrier xcd_barrier_post(unsigned* bar, volatile LAS unsigned* st) {
    XcdBarrier b; b.bar = bar; b.x = xb_xcc_id(); b.st = st;
    if (threadIdx.x == 0) (void)xb_add(&bar[XB_XCNT(b.x)], 1u);
    return b;
}
__device__ __forceinline__ void xcd_barrier_complete(unsigned* bar, unsigned x, unsigned& nloc, unsigned& nx) {
    const unsigned G = gridDim.x * gridDim.y * gridDim.z;
    unsigned sum, cnt, mine, sp = 0u;
    for (;;) {
        sum = 0u; cnt = 0u; mine = 0u;
#pragma unroll
        for (unsigned j = 0; j < 16; ++j) { const unsigned c = xb_ld(&bar[XB_XCNT(j)]); sum += c; cnt += (c > 0u) ? 1u : 0u; mine = (j == x) ? c : mine; }
        if (sum == G) break;
        __builtin_amdgcn_s_sleep(1);
        if ((++sp & 255u) == 0u) { if (xb_ld(&bar[XB_TMO])) break; if (sp > XB_SPIN_CAP) { atomicAdd(&bar[XB_TMO], 1u); break; } }
    }
    nloc = mine > 0u ? mine : 1u; nx = cnt > 0u ? cnt : 1u;
}

__device__ __forceinline__ void xcd_barrier(const XcdBarrier& b, bool is_thread0) {
    asm volatile("s_waitcnt vmcnt(0)" ::: "memory");
    __syncthreads();
    if (is_thread0) {
        unsigned* bar = b.bar;
        __builtin_amdgcn_s_waitcnt(0);
        unsigned nloc = b.st[0], nx = b.st[1];
        if (nloc == 0u) { xcd_barrier_complete(bar, b.x, nloc, nx); b.st[0] = nloc; b.st[1] = nx; }
        const unsigned old = xb_add(&bar[XB_XSUB(b.x)], 1u);
        const unsigned gen = old / nloc;
        if (old + 1u == (gen + 1u) * nloc) {
            __builtin_amdgcn_fence(__ATOMIC_RELEASE, "agent");
            asm volatile("s_waitcnt vmcnt(0)" ::: "memory");
            const unsigned og = xb_add(&bar[XB_TOP], 1u);
            const unsigned tg = og / nx;
            if (og + 1u == (tg + 1u) * nx) xb_add(&bar[XB_TOPGEN], 1u);
            else XB_SPIN(xb_ld(&bar[XB_TOPGEN]) == tg, bar);
            __builtin_amdgcn_fence(__ATOMIC_ACQUIRE, "agent");
            xb_add(&bar[XB_XGEN(b.x)], 1u);
            asm volatile("s_waitcnt vmcnt(0)" ::: "memory");
        } else {
            XB_SPIN(xb_ld(&bar[XB_XGEN(b.x)]) == gen, bar);
            __builtin_amdgcn_fence(__ATOMIC_ACQUIRE, "agent");
            asm volatile("s_waitcnt vmcnt(0)" ::: "memory");
        }
    }
    __syncthreads();
}
namespace pg8 {
__device__ __forceinline__ float bf2f(unsigned short h) { return __uint_as_float(((unsigned)h) << 16); }
__device__ __forceinline__ float bflo(unsigned w) { return __uint_as_float(w << 16); }
__device__ __forceinline__ float bfhi(unsigned w) { return __uint_as_float(w & 0xffff0000u); }
__device__ __forceinline__ float sigm(float x) { return 1.0f / (1.0f + __expf(-x)); }
struct EpiZ { static constexpr bool PERM = true, AFTER_DRAIN = false; bf16_t* O;
    __device__ __forceinline__ void operator()(const f32x4 (&acc)[2][2][4][2], const Unit& u, int wr, int wc, int fr, int fq) const {
        const int row0 = u.pm * BM + wr * 64 + fr, col0 = u.pn * BM + wc * 32 + 8 * fq;
#pragma unroll
        for (int ai = 0; ai < 2; ++ai)
#pragma unroll
            for (int m = 0; m < 4; ++m) { bf16_t* rowp = O + (size_t)(row0 + ai * HALF + m * 16) * 4736 + col0;
#pragma unroll
                for (int bj = 0; bj < 2; ++bj) { if (u.pn * BM + bj * HALF < 4736) { const f32x4 v0 = acc[ai][bj][m][0], v1 = acc[ai][bj][m][1];
                    u32x4 w; w.x = cvt_pk_bf16(v0[0], v0[1]); w.y = cvt_pk_bf16(v0[2], v0[3]); w.z = cvt_pk_bf16(v1[0], v1[1]); w.w = cvt_pk_bf16(v1[2], v1[3]);
                    *(u32x4*)(rowp + bj * HALF) = w; } } }
    }
};
struct EpiPlain { static constexpr bool PERM = true, AFTER_DRAIN = false; bf16_t* O; int ldc;
    __device__ __forceinline__ void operator()(const f32x4 (&acc)[2][2][4][2], const Unit& u, int wr, int wc, int fr, int fq) const {
        const int row0 = u.pm * BM + wr * 64 + fr, col0 = u.pn * BM + wc * 32 + 8 * fq;
#pragma unroll
        for (int ai = 0; ai < 2; ++ai)
#pragma unroll
            for (int m = 0; m < 4; ++m) { bf16_t* rowp = O + (size_t)(row0 + ai * HALF + m * 16) * ldc + col0;
#pragma unroll
                for (int bj = 0; bj < 2; ++bj) { const f32x4 v0 = acc[ai][bj][m][0], v1 = acc[ai][bj][m][1];
                    u32x4 w; w.x = cvt_pk_bf16(v0[0], v0[1]); w.y = cvt_pk_bf16(v0[2], v0[3]); w.z = cvt_pk_bf16(v1[0], v1[1]); w.w = cvt_pk_bf16(v1[2], v1[3]);
                    *(u32x4*)(rowp + bj * HALF) = w; } }
    }
};
template <bool ADD> struct EpiGate { static constexpr bool PERM = true, AFTER_DRAIN = false; bf16_t* O; const bf16_t* Z; int zc0;
    __device__ __forceinline__ void operator()(const f32x4 (&acc)[2][2][4][2], const Unit& u, int wr, int wc, int fr, int fq) const {
        const int row0 = u.pm * BM + wr * 64 + fr, col0 = u.pn * BM + wc * 32 + 8 * fq;
#pragma unroll
        for (int ai = 0; ai < 2; ++ai)
#pragma unroll
            for (int m = 0; m < 4; ++m) { const size_t row = (size_t)(row0 + ai * HALF + m * 16); bf16_t* rowp = O + row * 1024 + col0; const bf16_t* zp = Z + row * 4736 + zc0 + col0;
#pragma unroll
                for (int bj = 0; bj < 2; ++bj) { const f32x4 v0 = acc[ai][bj][m][0], v1 = acc[ai][bj][m][1];
                    const u32x4 zg = *(const u32x4*)(zp + bj * HALF);
                    float r0 = sigm(bflo(zg.x)) * v0[0], r1 = sigm(bfhi(zg.x)) * v0[1], r2 = sigm(bflo(zg.y)) * v0[2], r3 = sigm(bfhi(zg.y)) * v0[3];
                    float r4 = sigm(bflo(zg.z)) * v1[0], r5 = sigm(bfhi(zg.z)) * v1[1], r6 = sigm(bflo(zg.w)) * v1[2], r7 = sigm(bfhi(zg.w)) * v1[3];
                    if (ADD) { const u32x4 p = *(const u32x4*)(rowp + bj * HALF);
                        r0 += bflo(p.x); r1 += bfhi(p.x); r2 += bflo(p.y); r3 += bfhi(p.y); r4 += bflo(p.z); r5 += bfhi(p.z); r6 += bflo(p.w); r7 += bfhi(p.w); }
                    u32x4 w; w.x = cvt_pk_bf16(r0, r1); w.y = cvt_pk_bf16(r2, r3); w.z = cvt_pk_bf16(r4, r5); w.w = cvt_pk_bf16(r6, r7);
                    *(u32x4*)(rowp + bj * HALF) = w; } }
    }
};
struct EpiGate2 { static constexpr bool PERM = true, AFTER_DRAIN = false; bf16_t* O; const bf16_t* Z;
    __device__ __forceinline__ void operator()(const f32x4 (&acc)[2][2][4][2], const Unit& u, int wr, int wc, int fr, int fq) const {
        const bool add = u.pm < 128; const int zc0 = add ? 3712 : 2688;
        const int row0 = (u.pm & 127) * BM + wr * 64 + fr, col0 = (u.pn & 3) * BM + wc * 32 + 8 * fq;
#pragma unroll
        for (int ai = 0; ai < 2; ++ai) {
            u32x4 zg[4][2], pv[4][2];
#pragma unroll
            for (int m = 0; m < 4; ++m) { const size_t row = (size_t)(row0 + ai * HALF + m * 16);
#pragma unroll
                for (int bj = 0; bj < 2; ++bj) { zg[m][bj] = *(const u32x4*)(Z + row * 4736 + zc0 + col0 + bj * HALF); pv[m][bj] = (u32x4){0u, 0u, 0u, 0u}; if (add) pv[m][bj] = *(const u32x4*)(O + row * 1024 + col0 + bj * HALF); } }
#pragma unroll
            for (int m = 0; m < 4; ++m) { const size_t row = (size_t)(row0 + ai * HALF + m * 16); bf16_t* rowp = O + row * 1024 + col0;
#pragma unroll
                for (int bj = 0; bj < 2; ++bj) { const f32x4 v0 = acc[ai][bj][m][0], v1 = acc[ai][bj][m][1]; const u32x4 g = zg[m][bj], p = pv[m][bj];
                    const float r0 = sigm(bflo(g.x)) * v0[0] + bflo(p.x), r1 = sigm(bfhi(g.x)) * v0[1] + bfhi(p.x), r2 = sigm(bflo(g.y)) * v0[2] + bflo(p.y), r3 = sigm(bfhi(g.y)) * v0[3] + bfhi(p.y);
                    const float r4 = sigm(bflo(g.z)) * v1[0] + bflo(p.z), r5 = sigm(bfhi(g.z)) * v1[1] + bfhi(p.z), r6 = sigm(bflo(g.w)) * v1[2] + bflo(p.w), r7 = sigm(bfhi(g.w)) * v1[3] + bfhi(p.w);
                    u32x4 w; w.x = cvt_pk_bf16(r0, r1); w.y = cvt_pk_bf16(r2, r3); w.z = cvt_pk_bf16(r4, r5); w.w = cvt_pk_bf16(r6, r7);
                    *(u32x4*)(rowp + bj * HALF) = w; } } }
    }
};
struct MergeOrder { StaticOrder S; int nu;
    __device__ __forceinline__ void init(int G, int c) { S.init(32768, 1024, G, c); nu = (512 - c + G - 1) / G; }
    __device__ __forceinline__ bool next(int i, Unit& u) const { if (i >= 2 * nu) return false; Unit t; S.next(i < nu ? i : i - nu, t);
        if (i < nu) { u.pm = 128 + t.pm; u.pn = t.pn; } else { u.pm = t.pm; u.pn = 4 + t.pn; } return true; }
    __device__ __forceinline__ void a_ready(const Unit&) const {}
    __device__ __forceinline__ void done(const Unit&) const {}
};
struct EpiRes { static constexpr bool PERM = true, AFTER_DRAIN = false; const float* X; const float* mod; bf16_t* O;
    __device__ __forceinline__ void operator()(const f32x4 (&acc)[2][2][4][2], const Unit& u, int wr, int wc, int fr, int fq) const {
        const int row0 = u.pm * BM + wr * 64 + fr, col0 = u.pn * BM + wc * 32 + 8 * fq; const int b = (u.pm * BM) >> 11;
        f32x4 gt[2][2];
#pragma unroll
        for (int bj = 0; bj < 2; ++bj)
#pragma unroll
            for (int n = 0; n < 2; ++n) gt[bj][n] = *(const f32x4*)(mod + (size_t)b * 6144 + 2048 + col0 + bj * HALF + n * 4);
#pragma unroll
        for (int ai = 0; ai < 2; ++ai) { f32x4 xv[4][2][2];
#pragma unroll
            for (int m = 0; m < 4; ++m) { const size_t off = (size_t)(row0 + ai * HALF + m * 16) * 1024 + col0;
#pragma unroll
                for (int bj = 0; bj < 2; ++bj) { xv[m][bj][0] = *(const f32x4*)(X + off + bj * HALF); xv[m][bj][1] = *(const f32x4*)(X + off + bj * HALF + 4); } }
#pragma unroll
            for (int m = 0; m < 4; ++m) { const size_t off = (size_t)(row0 + ai * HALF + m * 16) * 1024 + col0;
#pragma unroll
                for (int bj = 0; bj < 2; ++bj) { const f32x4 v0 = xv[m][bj][0] + gt[bj][0] * acc[ai][bj][m][0], v1 = xv[m][bj][1] + gt[bj][1] * acc[ai][bj][m][1];
                    u32x4 w; w.x = cvt_pk_bf16(v0[0], v0[1]); w.y = cvt_pk_bf16(v0[2], v0[3]); w.z = cvt_pk_bf16(v1[0], v1[1]); w.w = cvt_pk_bf16(v1[2], v1[3]);
                    *(u32x4*)(O + off + bj * HALF) = w; } } }
    }
};
template <int NPL> struct GroupOrder { int G, c;
    __device__ __forceinline__ bool next(int i, Unit& u) const { const int L = i * G + c; if (L >= 256 * NPL) return false;
        const int e = L / (16 * NPL), r = L % (16 * NPL); u.pm = e * 16 + (r % 16); u.pn = e * NPL + r / 16; return true; }
    __device__ __forceinline__ void a_ready(const Unit&) const {}
    __device__ __forceinline__ void done(const Unit&) const {}
};
struct EpiSwiglu { static constexpr bool PERM = true, AFTER_DRAIN = false; bf16_t* O;
    __device__ __forceinline__ void operator()(const f32x4 (&acc)[2][2][4][2], const Unit& u, int wr, int wc, int fr, int fq) const {
        const int row0 = u.pm * BM + wr * 64 + fr, col0 = (u.pn & 7) * 128 + wc * 32 + 8 * fq;
#pragma unroll
        for (int ai = 0; ai < 2; ++ai)
#pragma unroll
            for (int m = 0; m < 4; ++m) { bf16_t* rowp = O + (size_t)(row0 + ai * HALF + m * 16) * 1024 + col0;
                float r[8];
#pragma unroll
                for (int n = 0; n < 2; ++n)
#pragma unroll
                    for (int i = 0; i < 4; ++i) { const float g = acc[ai][0][m][n][i], up = acc[ai][1][m][n][i]; r[n * 4 + i] = g * sigm(g) * up; }
                u32x4 w; w.x = cvt_pk_bf16(r[0], r[1]); w.y = cvt_pk_bf16(r[2], r[3]); w.z = cvt_pk_bf16(r[4], r[5]); w.w = cvt_pk_bf16(r[6], r[7]);
                *(u32x4*)rowp = w; }
    }
};
struct EpiDown { static constexpr bool PERM = true, AFTER_DRAIN = false; bf16_t* O; const float* aff;
    __device__ __forceinline__ void operator()(const f32x4 (&acc)[2][2][4][2], const Unit& u, int wr, int wc, int fr, int fq) const {
        const int row0 = u.pm * BM + wr * 64 + fr, col0 = (u.pn & 3) * BM + wc * 32 + 8 * fq;
        float av[2][4];
#pragma unroll
        for (int ai = 0; ai < 2; ++ai)
#pragma unroll
            for (int m = 0; m < 4; ++m) av[ai][m] = aff[row0 + ai * HALF + m * 16];
#pragma unroll
        for (int ai = 0; ai < 2; ++ai)
#pragma unroll
            for (int m = 0; m < 4; ++m) { const int row = row0 + ai * HALF + m * 16; const float a = av[ai][m]; bf16_t* rowp = O + (size_t)row * 1024 + col0;
#pragma unroll
                for (int bj = 0; bj < 2; ++bj) { const f32x4 v0 = acc[ai][bj][m][0] * a, v1 = acc[ai][bj][m][1] * a;
                    u32x4 w; w.x = cvt_pk_bf16(v0[0], v0[1]); w.y = cvt_pk_bf16(v0[2], v0[3]); w.z = cvt_pk_bf16(v1[0], v1[1]); w.w = cvt_pk_bf16(v1[2], v1[3]);
                    *(u32x4*)(rowp + bj * HALF) = w; } }
    }
};
}

struct Frame { LAS unsigned char* lds; volatile LAS unsigned* MISC; gu32* ctl; int tid, lane, wave, vcu, G; };
struct Args { const void* in[30]; float* out; unsigned char* ws; int ph_lo, ph_hi; };
typedef const __attribute__((address_space(4))) Args* ArgsP;
#define LAUNDER(p) asm volatile("" : "+s"(p))
typedef float f32x16 __attribute__((ext_vector_type(16)));
typedef unsigned u32x2 __attribute__((ext_vector_type(2)));

__device__ __forceinline__ float wave_sum(float v) {
#pragma unroll
    for (int o = 1; o < 64; o <<= 1) v += __shfl_xor(v, o);
    return v;
}
__device__ __forceinline__ float bf2f(bf16 h) { return __uint_as_float(((unsigned)h) << 16); }
__device__ __forceinline__ float bflo(unsigned w) { return __uint_as_float(w << 16); }
__device__ __forceinline__ float bfhi(unsigned w) { return __uint_as_float(w & 0xffff0000u); }
__device__ __forceinline__ float sigm(float x) { return 1.0f / (1.0f + __expf(-x)); }

__device__ __forceinline__ void tr_item(const float* W, int N, int k0, int n0, bf16* WT, int KD, int dst_row0, LAS float* scr, int lane) {
    f32x4 v[8];
#pragma unroll
    for (int i = 0; i < 8; ++i) v[i] = *(const GAS f32x4*)(W + (size_t)(k0 + 8 * i + (lane >> 3)) * N + n0 + 4 * (lane & 7));
#pragma unroll
    for (int i = 0; i < 8; ++i) { LAS float* d = scr + (8 * i + (lane >> 3)) * 33 + 4 * (lane & 7); d[0] = v[i].x; d[1] = v[i].y; d[2] = v[i].z; d[3] = v[i].w; }
    LDS_WAIT(); asm volatile("" ::: "memory");
    const int c = lane & 7;
#pragma unroll
    for (int j = 0; j < 4; ++j) { const int n = (lane >> 3) + 8 * j; const LAS float* s = scr + (8 * c) * 33 + n;
        v4u o; o.x = pk2(s[0 * 33], s[1 * 33]); o.y = pk2(s[2 * 33], s[3 * 33]); o.z = pk2(s[4 * 33], s[5 * 33]); o.w = pk2(s[6 * 33], s[7 * 33]);
        *(GAS v4u*)(WT + (size_t)(dst_row0 + n) * KD + k0 + 8 * c) = o; }
    LDS_WAIT(); asm volatile("" ::: "memory");
}

__device__ __forceinline__ void p0_prologue(const Frame& F, ArgsP A) {
    unsigned char* ws = A->ws;
    LAS float* scr = (LAS float*)(F.lds + F.wave * 16384);
    const int gw = F.vcu * NWAVES + F.wave, NGW = F.G * NWAVES;
    const float* w_in = (const float*)A->in[6]; const float* p_rwkv = (const float*)A->in[22]; const float* p_attn = (const float*)A->in[23];
    const float* w_out = (const float*)A->in[24]; const float* g2 = (const float*)A->in[13];
    bf16* WinT = (bf16*)(ws + WS_WINT); bf16* PrT = (bf16*)(ws + WS_PRT); bf16* PaT = (bf16*)(ws + WS_PAT); bf16* WoT = (bf16*)(ws + WS_WOT); bf16* G2T = (bf16*)(ws + WS_G2T);
    constexpr int I_IN = 16 * 148, I_P = 8 * 32, I_O = 16 * 32, I_G = 2 * 16, NIT = I_IN + 2 * I_P + I_O + I_G;
    for (int it = gw; it < NIT; it += NGW) {
        int r = it;
        if (r < I_IN) { tr_item(w_in, NZ, 64 * (r / 148), 32 * (r % 148), WinT, 1024, 32 * (r % 148), scr, F.lane); continue; } r -= I_IN;
        if (r < I_P) { tr_item(p_rwkv, 1024, 64 * (r / 32), 32 * (r % 32), PrT, 512, 32 * (r % 32), scr, F.lane); continue; } r -= I_P;
        if (r < I_P) { tr_item(p_attn, 1024, 64 * (r / 32), 32 * (r % 32), PaT, 512, 32 * (r % 32), scr, F.lane); continue; } r -= I_P;
        if (r < I_O) { tr_item(w_out, 1024, 64 * (r / 32), 32 * (r % 32), WoT, 1024, 32 * (r % 32), scr, F.lane); continue; } r -= I_O;
        tr_item(g2, 512, 64 * (r / 16), 32 * (r % 16), G2T, 256, 32 * (r % 16), scr, F.lane);
    }
    { const int gt = (F.vcu * NWAVES + F.wave) * 64 + F.lane, NT = F.G * NWAVES * 64; const v4u z4 = {0u, 0u, 0u, 0u};
      for (int i = gt; i < 128 * 128; i += NT) *(GAS v4u*)(WinT + (size_t)4736 * 1024 + (size_t)i * 8) = z4;
      for (int i = gt; i < 512 * 16; i += NT) *(GAS v4u*)(G2T + (size_t)(i >> 4) * 256 + 128 + (i & 15) * 8) = z4; }
    __syncthreads();
    const float* cvec = (const float*)A->in[1]; const float* w_ada = (const float*)A->in[3]; const float* b_ada = (const float*)A->in[4];
    float* mod = (float*)(ws + WS_MOD);
    for (int task = F.vcu; task < 192; task += F.G) { const int cg = task % 96, dh = task / 96;
        LAS float* ca = (LAS float*)F.lds;
        LAS float* red = (LAS float*)(F.lds + 65536);
        for (int i = F.tid; i < 16 * 1024; i += 512) { const int b = i >> 10, d = i & 1023; const float cv = cvec[i]; ca[d * 16 + b] = cv / (1.0f + __expf(-cv)); }
        __syncthreads();
        float acc[16];
#pragma unroll
        for (int b = 0; b < 16; ++b) acc[b] = 0.f;
        const int col = cg * 64 + F.lane;
#pragma unroll 8
        for (int dd = 0; dd < 64; ++dd) { const int d = dh * 512 + F.wave * 64 + dd; const float w = w_ada[(size_t)d * 6144 + col];
            const LAS f32x4* cp = (const LAS f32x4*)(ca + d * 16);
#pragma unroll
            for (int q = 0; q < 4; ++q) { const f32x4 cv = cp[q]; acc[q * 4 + 0] += cv[0] * w; acc[q * 4 + 1] += cv[1] * w; acc[q * 4 + 2] += cv[2] * w; acc[q * 4 + 3] += cv[3] * w; } }
#pragma unroll
        for (int b = 0; b < 16; ++b) red[(F.wave * 16 + b) * 64 + F.lane] = acc[b];
        __syncthreads();
        for (int o = F.tid; o < 1024; o += 512) { const int b = o >> 6, cl = o & 63; float sacc = 0.f;
#pragma unroll
            for (int w = 0; w < 8; ++w) sacc += red[(w * 16 + b) * 64 + cl];
            atomicAdd(&mod[b * 6144 + cg * 64 + cl], sacc + (dh == 0 ? b_ada[cg * 64 + cl] : 0.f)); }
        __syncthreads();
    }
}


__device__ __forceinline__ float dpp_wave_sum(float v) {
    v += __int_as_float(__builtin_amdgcn_update_dpp(0, __float_as_int(v), 0xB1, 0xf, 0xf, false));
    v += __int_as_float(__builtin_amdgcn_update_dpp(0, __float_as_int(v), 0x4E, 0xf, 0xf, false));
    v += __int_as_float(__builtin_amdgcn_update_dpp(0, __float_as_int(v), 0x141, 0xf, 0xf, false));
    v += __int_as_float(__builtin_amdgcn_update_dpp(0, __float_as_int(v), 0x140, 0xf, 0xf, false));
    v += __int_as_float(__builtin_amdgcn_ds_swizzle(__float_as_int(v), 0x401F));
    auto r_ = __builtin_amdgcn_permlane32_swap(__float_as_uint(v), __float_as_uint(v), false, false);
    return __uint_as_float(r_[0]) + __uint_as_float(r_[1]); }

template <int R, bool XBF> __device__ __forceinline__ void modnorm_rows(const void* x, int m0, int mstride, const float* g, const float* mod, int sh_off, int sc_off, bf16* out, int lane, f32x4 (&u)[R][4]) {
    f32x4 v[R][4];
#pragma unroll
    for (int i = 0; i < R; ++i) {
        if (XBF) { const GAS u32x2* xr = (const GAS u32x2*)((const bf16*)x + (size_t)(m0 + i * mstride) * 1024) + lane;
#pragma unroll
            for (int j = 0; j < 4; ++j) { const u32x2 w = xr[64 * j]; v[i][j] = (f32x4){bflo(w.x), bfhi(w.x), bflo(w.y), bfhi(w.y)}; } }
        else { const GAS f32x4* xr = (const GAS f32x4*)((const float*)x + (size_t)(m0 + i * mstride) * 1024) + lane;
#pragma unroll
            for (int j = 0; j < 4; ++j) v[i][j] = xr[64 * j]; } }
    f32x4 gg[4];
#pragma unroll
    for (int j = 0; j < 4; ++j) gg[j] = ((const GAS f32x4*)g)[lane + 64 * j];
#pragma unroll
    for (int i = 0; i < R; ++i) { const int m = m0 + i * mstride, b = m >> 11; float s = 0.f;
#pragma unroll
        for (int j = 0; j < 4; ++j) s += (v[i][j].x * v[i][j].x + v[i][j].y * v[i][j].y) + (v[i][j].z * v[i][j].z + v[i][j].w * v[i][j].w);
        const float rs = rsqrtf(dpp_wave_sum(s) * (1.0f / 1024.0f) + 1e-6f);
        const float* sh = mod + (size_t)b * 6144 + sh_off; const float* sc = mod + (size_t)b * 6144 + sc_off;
        GAS unsigned long long* o8 = (GAS unsigned long long*)(out + (size_t)m * 1024) + lane;
#pragma unroll
        for (int j = 0; j < 4; ++j) { const f32x4 s1 = ((const GAS f32x4*)sc)[lane + 64 * j], s0 = ((const GAS f32x4*)sh)[lane + 64 * j];
            f32x4 y = (v[i][j] * rs) * gg[j]; y = y * (s1 + 1.0f) + s0; u[i][j] = y;
            o8[64 * j] = (unsigned long long)pk2(y.x, y.y) | ((unsigned long long)pk2(y.z, y.w) << 32); } }
}

template <int R> __device__ __forceinline__ void load_rows_bf16(const bf16* x, int m0, int mstride, int lane_in, u32x2 (&raw)[R][4]) {
    int lane = lane_in; asm volatile("" : "+v"(lane));
#pragma unroll
    for (int i = 0; i < R; ++i) { const GAS u32x2* xr = (const GAS u32x2*)(x + (size_t)(m0 + i * mstride) * 1024) + lane;
#pragma unroll
        for (int j = 0; j < 4; ++j) raw[i][j] = xr[64 * j]; }
}
template <int R> __device__ __forceinline__ void modnorm_rows_pre(const u32x2 (&raw)[R][4], int m0, int mstride, const float* g, const float* mod, int sh_off, int sc_off, bf16* out, int lane, f32x4 (&u)[R][4]) {
    f32x4 gg[4];
#pragma unroll
    for (int j = 0; j < 4; ++j) gg[j] = ((const GAS f32x4*)g)[lane + 64 * j];
#pragma unroll
    for (int i = 0; i < R; ++i) { const int m = m0 + i * mstride, b = m >> 11; float s = 0.f; f32x4 v[4];
#pragma unroll
        for (int j = 0; j < 4; ++j) { const u32x2 w = raw[i][j]; v[j] = (f32x4){bflo(w.x), bfhi(w.x), bflo(w.y), bfhi(w.y)}; s += (v[j].x * v[j].x + v[j].y * v[j].y) + (v[j].z * v[j].z + v[j].w * v[j].w); }
        const float rs = rsqrtf(dpp_wave_sum(s) * (1.0f / 1024.0f) + 1e-6f);
        const float* sh = mod + (size_t)b * 6144 + sh_off; const float* sc = mod + (size_t)b * 6144 + sc_off;
        GAS unsigned long long* o8 = (GAS unsigned long long*)(out + (size_t)m * 1024) + lane;
#pragma unroll
        for (int j = 0; j < 4; ++j) { const f32x4 s1 = ((const GAS f32x4*)sc)[lane + 64 * j], s0 = ((const GAS f32x4*)sh)[lane + 64 * j];
            f32x4 y = (v[j] * rs) * gg[j]; y = y * (s1 + 1.0f) + s0; u[i][j] = y;
            o8[64 * j] = (unsigned long long)pk2(y.x, y.y) | ((unsigned long long)pk2(y.z, y.w) << 32); } }
}

__device__ __forceinline__ void modnorm_row(const float* xrow, const float* g, const float* sh, const float* sc, bf16* orow, int lane, f32x4 (&u)[4]) {
    const GAS f32x4* xr = (const GAS f32x4*)xrow + lane;
    f32x4 v[4]; float s = 0.f;
#pragma unroll
    for (int j = 0; j < 4; ++j) { v[j] = xr[64 * j]; s += (v[j].x * v[j].x + v[j].y * v[j].y) + (v[j].z * v[j].z + v[j].w * v[j].w); }
    const float rs = rsqrtf(wave_sum(s) * (1.0f / 1024.0f) + 1e-6f);
    GAS unsigned long long* o8 = (GAS unsigned long long*)orow + lane;
#pragma unroll
    for (int j = 0; j < 4; ++j) { const f32x4 gg = ((const GAS f32x4*)g)[lane + 64 * j], s1 = ((const GAS f32x4*)sc)[lane + 64 * j], s0 = ((const GAS f32x4*)sh)[lane + 64 * j];
        f32x4 y = (v[j] * rs) * gg; y = y * (s1 + 1.0f) + s0; u[j] = y;
        o8[64 * j] = (unsigned long long)pk2(y.x, y.y) | ((unsigned long long)pk2(y.z, y.w) << 32); }
}

__device__ __forceinline__ float softplusf(float x) { return x > 20.f ? x : log1pf(__expf(x)); }
__device__ __forceinline__ void scan_chain(const Frame& F, ArgsP A, int b, int h, int dir) {
    constexpr int CT = 32;
    LAS float* L = (LAS float*)F.lds;
    LAS float* W2S = L; LAS float* A2S = L + 4096; LAS float* ZRs = L + 8192; LAS float* ZKs = ZRs + 2048; LAS float* ZVs = ZKs + 2048; LAS float* TWs = ZVs + 2048; LAS float* ZAs = TWs + 2048;
    LAS float* DEC = ZAs + 2048; LAS float* KD = DEC + 2048; LAS float* AV = KD + 2048; LAS float* BV = AV + 2048; LAS float* YB = BV + 2048; LAS float* BON = YB + 2048;
    const bf16* Z = (const bf16*)(A->ws + WS_Z);
    const float* mu_prev = (const float*)A->in[7]; const float* mu_next = (const float*)A->in[8];
    const float* w0 = (const float*)A->in[9]; const float* w2 = (const float*)A->in[10]; const float* a0 = (const float*)A->in[11]; const float* a2 = (const float*)A->in[12];
    const float* k_k = (const float*)A->in[14]; const float* k_a = (const float*)A->in[15]; const float* r_k = (const float*)A->in[16];
    bf16* ydir = (bf16*)(A->ws + WS_XN) + (size_t)dir * M * 512; float* bonus = (float*)(A->ws + WS_BONUS) + (size_t)dir * M * 8;
    const int tid = F.tid, lane = F.lane, wave = F.wave;
    for (int i = tid; i < 4096; i += 512) { const int l = i >> 6, j = i & 63; W2S[i] = w2[((size_t)dir * 64 + l) * 512 + h * 64 + j]; A2S[i] = a2[((size_t)dir * 64 + l) * 512 + h * 64 + j]; }
    const int ch = h * 64 + lane;
    const float w0j = w0[dir * 512 + ch], a0j = a0[dir * 512 + ch], kkj = k_k[ch], kaj = k_a[ch], rkj = r_k[ch];
    float s[8];
#pragma unroll
    for (int q = 0; q < 8; ++q) s[q] = 0.f;
    const int ri = tid >> 3, jg = tid & 7;
    for (int ci = 0; ci < T / CT; ++ci) {
        const int t0 = (dir ? (T / CT - 1 - ci) : ci) * CT;
#pragma unroll 4
        for (int i = 0; i < 20; ++i) { const int e = tid + 512 * i, arr = e >> 11, rem = e & 2047, tl = rem >> 6, j = rem & 63;
            const int col = (arr == 0 ? ZR + h * 64 : arr == 1 ? ZK + h * 64 : arr == 2 ? ZV + h * 64 : arr == 3 ? ZWD + dir * 64 : ZAD + dir * 64) + j;
            const int t = t0 + tl; const bf16* zp = Z + ((size_t)b * T + t) * NZ + col;
            const float z0 = bf2f(zp[0]), zm = t > 0 ? bf2f(zp[-NZ]) : 0.f, zq = t < T - 1 ? bf2f(zp[NZ]) : 0.f;
            float zs = z0 + mu_prev[col] * (zm - z0) + mu_next[col] * (zq - z0);
            if (arr == 3) zs = tanhf(zs);
            ZRs[arr * 2048 + rem] = zs; }
        __syncthreads();
#pragma unroll 1
        for (int q = 0; q < 4; ++q) { const int tl = wave + 8 * q;
            float wraw = w0j, araw = a0j;
#pragma unroll 8
            for (int l = 0; l < 64; ++l) { wraw += TWs[tl * 64 + l] * W2S[l * 64 + lane]; araw += ZAs[tl * 64 + l] * A2S[l * 64 + lane]; }
            const float w = -softplusf(-wraw) - 0.5f, dec = __expf(-__expf(w)), ad = sigm(araw);
            const float k = ZKs[tl * 64 + lane], kkr = k * kkj, nrm = sqrtf(wave_sum(kkr * kkr)), kk = kkr / fmaxf(nrm, 1e-12f);
            const float kd = k * (1.0f + (ad - 1.0f) * kaj);
            DEC[tl * 64 + lane] = dec; KD[tl * 64 + lane] = kd; AV[tl * 64 + lane] = -kk; BV[tl * 64 + lane] = kk * ad;
            const float bon = wave_sum(ZRs[tl * 64 + lane] * kd * rkj); if (lane == 0) BON[tl] = bon; }
        __syncthreads();
#pragma unroll 1
        for (int st = 0; st < CT; ++st) { const int tl = dir ? (CT - 1 - st) : st; const int o = tl * 64 + jg * 8;
            const f32x4 a0v = *(const LAS f32x4*)(AV + o), a1v = *(const LAS f32x4*)(AV + o + 4), d0 = *(const LAS f32x4*)(DEC + o), d1 = *(const LAS f32x4*)(DEC + o + 4);
            const f32x4 b0 = *(const LAS f32x4*)(BV + o), b1 = *(const LAS f32x4*)(BV + o + 4), k0 = *(const LAS f32x4*)(KD + o), k1 = *(const LAS f32x4*)(KD + o + 4);
            const f32x4 r0 = *(const LAS f32x4*)(ZRs + o), r1 = *(const LAS f32x4*)(ZRs + o + 4); const float vi = ZVs[tl * 64 + ri];
            float p = (s[0] * a0v[0] + s[1] * a0v[1]) + (s[2] * a0v[2] + s[3] * a0v[3]) + (s[4] * a1v[0] + s[5] * a1v[1]) + (s[6] * a1v[2] + s[7] * a1v[3]);
            p += __shfl_xor(p, 1); p += __shfl_xor(p, 2); p += __shfl_xor(p, 4);
            s[0] = s[0] * d0[0] + p * b0[0] + vi * k0[0]; s[1] = s[1] * d0[1] + p * b0[1] + vi * k0[1]; s[2] = s[2] * d0[2] + p * b0[2] + vi * k0[2]; s[3] = s[3] * d0[3] + p * b0[3] + vi * k0[3];
            s[4] = s[4] * d1[0] + p * b1[0] + vi * k1[0]; s[5] = s[5] * d1[1] + p * b1[1] + vi * k1[1]; s[6] = s[6] * d1[2] + p * b1[2] + vi * k1[2]; s[7] = s[7] * d1[3] + p * b1[3] + vi * k1[3];
            float y = (s[0] * r0[0] + s[1] * r0[1]) + (s[2] * r0[2] + s[3] * r0[3]) + (s[4] * r1[0] + s[5] * r1[1]) + (s[6] * r1[2] + s[7] * r1[3]);
            y += __shfl_xor(y, 1); y += __shfl_xor(y, 2); y += __shfl_xor(y, 4);
            if (jg == 0) YB[tl * 64 + ri] = y; }
        __syncthreads();
#pragma unroll
        for (int i = 0; i < 4; ++i) { const int e = tid + 512 * i, tl = e >> 6, c = e & 63; ydir[((size_t)b * T + t0 + tl) * 512 + h * 64 + c] = (bf16)f2bf(YB[e]); }
        if (tid < CT) bonus[((size_t)b * T + t0 + tid) * 8 + h] = BON[tid];
        __syncthreads();
    }
}


#define SDEV __device__ __forceinline__
#define S_UNROLL _Pragma("unroll")
#define S_MEMBAR() do { asm volatile("" ::: "memory"); __builtin_amdgcn_sched_barrier(0); } while (0)
#define S_LAUNDER_I(x) asm volatile("" : "+v"(x))
#define S_LAUNDER_S(x) asm volatile("" : "+s"(x))
#define S_PIN(x) asm volatile("" : "+v"(x))
typedef float f32x2s __attribute__((ext_vector_type(2))); typedef __bf16 bf16x2s __attribute__((ext_vector_type(2)));
__device__ __forceinline__ unsigned s_cvtpk(float lo, float hi) { f32x2s v = {lo, hi}; bf16x2s b = __builtin_convertvector(v, bf16x2s); return __builtin_bit_cast(unsigned, b); }
__device__ __forceinline__ float s_rowsum16(float v) {
    v += __int_as_float(__builtin_amdgcn_update_dpp(0, __float_as_int(v), 0xB1, 0xf, 0xf, false));
    v += __int_as_float(__builtin_amdgcn_update_dpp(0, __float_as_int(v), 0x4E, 0xf, 0xf, false));
    v += __int_as_float(__builtin_amdgcn_update_dpp(0, __float_as_int(v), 0x141, 0xf, 0xf, false));
    v += __int_as_float(__builtin_amdgcn_update_dpp(0, __float_as_int(v), 0x140, 0xf, 0xf, false));
    return v; }
#define S_MFMA(a, b, c) __builtin_amdgcn_mfma_f32_32x32x16_bf16(a, b, c, 0, 0, 0)
#define S_PK(lo, hi) s_cvtpk(lo, hi)
#define S_SWAP(x, y) do { auto r_ = __builtin_amdgcn_permlane32_swap(x, y, false, false); x = r_[0]; y = r_[1]; } while (0)
#define S_ROWSUM16(v) s_rowsum16(v)
__device__ __forceinline__ float s_wavesum(float v) { v = s_rowsum16(v);
    v += __int_as_float(__builtin_amdgcn_ds_swizzle(__float_as_int(v), 0x401F));
    auto r_ = __builtin_amdgcn_permlane32_swap(__float_as_uint(v), __float_as_uint(v), false, false);
    return __uint_as_float(r_[0]) + __uint_as_float(r_[1]); }
#define S_WAVESUM(v) s_wavesum(v)
#define S_GAS GAS
#define S_READLANE(v, l) __int_as_float(__builtin_amdgcn_readlane(__float_as_int(v), l))
#define S_RCP(x) __builtin_amdgcn_rcpf(x)
#define S_EXP2(x) __builtin_amdgcn_exp2f(x)
#define S_LOG2(x) __builtin_amdgcn_logf(x)
#define S_RSQ(x) __builtin_amdgcn_rsqf(x)
#define S_LDS_WAIT() asm volatile("s_waitcnt lgkmcnt(0)" ::: "memory")
#define S_LDSP LAS unsigned char*
#define S_LDS_BF16P LAS bf16*
#define S_LDS_U32P LAS unsigned*
#define S_LDS_F32P LAS float*
#define S_LDS_CONST_BF16X8P const LAS bf16x8*
#define S_LDS_BF16X8P LAS bf16x8*
#define S_LDS_CONST_F32X4P const LAS f32x4*
#define S_FLAG_STORE(p, v) do { *(volatile LAS unsigned*)(p) = (v); } while (0)
#define S_FLAG_WAIT(p, v) do { unsigned sp_ = 0; while (*(volatile LAS unsigned*)(p) != (v)) { __builtin_amdgcn_s_sleep(2); if (++sp_ > (1u << 24)) break; } asm volatile("" ::: "memory"); } while (0)
struct SFrag { bf16x8 s[2]; };
struct SMat { SFrag t[2]; };
SDEV f32x16 smm(const SFrag& X, const SFrag& Y, f32x16 acc) { acc = S_MFMA(X.s[0], Y.s[0], acc); acc = S_MFMA(X.s[1], Y.s[1], acc); return acc; }
SDEV f32x16 szero() { f32x16 z; S_UNROLL for (int i = 0; i < 16; ++i) z[i] = 0.f; return z; }
SDEV SFrag spack(const f32x16& d) { SFrag f;
    S_UNROLL for (int s = 0; s < 2; ++s) { v4u w; S_UNROLL for (int q = 0; q < 4; ++q) w[q] = S_PK(d[8 * s + 2 * q], d[8 * s + 2 * q + 1]); f.s[s] = __builtin_bit_cast(bf16x8, w); }
    return f; }
SDEV f32x16 sunpack(const SFrag& f) { f32x16 d;
    S_UNROLL for (int s = 0; s < 2; ++s) { const v4u w = __builtin_bit_cast(v4u, f.s[s]); S_UNROLL for (int q = 0; q < 4; ++q) { d[8 * s + 2 * q] = __uint_as_float(w[q] << 16); d[8 * s + 2 * q + 1] = __uint_as_float(w[q] & 0xffff0000u); } }
    return d; }
SDEV SMat splain2d(const unsigned (&pp)[16]) { unsigned d0[8], d1[8];
    S_UNROLL for (int g = 0; g < 4; ++g) S_UNROLL for (int p = 0; p < 2; ++p) { unsigned x = pp[4 * g + p], y = pp[4 * g + 2 + p]; S_SWAP(x, y); d0[2 * g + p] = x; d1[2 * g + p] = y; }
    SMat m;
    S_UNROLL for (int s = 0; s < 2; ++s) { v4u a, b; S_UNROLL for (int q = 0; q < 4; ++q) { a[q] = d0[4 * s + q]; b[q] = d1[4 * s + q]; } m.t[0].s[s] = __builtin_bit_cast(bf16x8, a); m.t[1].s[s] = __builtin_bit_cast(bf16x8, b); }
    return m; }
SDEV void sd2plain(const f32x16& D0, const f32x16& D1, float (&x)[32]) {
    S_UNROLL for (int r = 0; r < 16; ++r) { unsigned a = __float_as_uint(D0[r]), b = __float_as_uint(D1[r]); S_SWAP(a, b); const int ta = (r & 3) + 8 * (r >> 2); x[ta] = __uint_as_float(a); x[ta + 4] = __uint_as_float(b); } }
SDEV SFrag sident(int n_in, int hh_in) { int n1 = n_in, r1 = 4 * hh_in; S_LAUNDER_I(n1); S_LAUNDER_I(r1); f32x16 id; S_UNROLL for (int g = 0; g < 16; ++g) id[g] = (((g & 3) + 8 * (g >> 2) + r1) == n1) ? 1.f : 0.f; return spack(id); }
SDEV void sd2plain_pk(const f32x16& D0, const f32x16& D1, unsigned (&xp)[16]) {
    S_UNROLL for (int m = 0; m < 8; ++m) { unsigned a = S_PK(D0[2 * m], D0[2 * m + 1]), b = S_PK(D1[2 * m], D1[2 * m + 1]); S_SWAP(a, b); const int qa = 4 * (m >> 1) + (m & 1); xp[qa] = a; xp[qa + 2] = b; } }
SDEV float swave_sum(float v) { return S_WAVESUM(v); }

struct ScanArgs { const S_GAS bf16* Z; const S_GAS float* mu_prev; const S_GAS float* mu_next; const S_GAS float* w0; const S_GAS float* a0; const S_GAS float* k_k; const S_GAS float* k_a; const S_GAS float* r_k; S_GAS bf16* ydir; S_GAS float* bonus; };

#define SC_W2F 0
#define SC_A2F 8192
#define SC_SIG 16384
#define SC_GTAB 24576
#define SC_FLAG 26624
#define SC_WR 28672
#define SC_AR 94208
#define SC_LDS_BYTES 126976
#define SC_PF 4

SDEV void scan2_setup(S_LDSP lds, const S_GAS float* w2, const S_GAS float* a2, int h, int dir, int tid) {
    { float wv[16];
      S_UNROLL for (int it = 0; it < 16; ++it) { const int e = tid + 512 * it; const int mat = e >> 12, r = e & 4095, jj = r & 7, ln = (r >> 3) & 63, s = (r >> 9) & 1, jt = (r >> 10) & 1, lt = (r >> 11) & 1;
          const int n = ln & 31, hh = ln >> 5, g = 8 * s + jj, l = 32 * lt + (g & 3) + 8 * (g >> 2) + 4 * hh, j = 32 * jt + n;
          wv[it] = (mat ? a2 : w2)[((size_t)dir * 64 + l) * 512 + h * 64 + j]; }
      S_UNROLL for (int it = 0; it < 16; ++it) { const int e = tid + 512 * it; const int mat = e >> 12, r = e & 4095;
          ((S_LDS_BF16P)(lds + (mat ? SC_A2F : SC_W2F)))[r] = (bf16)(S_PK(wv[it], 0.f) & 0xffffu); } }
    for (int e = tid; e < 2048; e += 512) ((S_LDS_U32P)(lds + SC_SIG))[e] = 0u;
    if (tid == 0) S_FLAG_STORE(lds + SC_FLAG, 0u);
}

SDEV void scan2_chunk(S_LDSP lds, const ScanArgs& A_in, int b_in, int h_in, int dir_in, int c, int lane_in, int wave) {
    ScanArgs A = A_in; int b = b_in, h = h_in, dir = dir_in;
    S_LAUNDER_S(A.Z); S_LAUNDER_S(A.mu_prev); S_LAUNDER_S(A.mu_next); S_LAUNDER_S(A.w0); S_LAUNDER_S(A.a0); S_LAUNDER_S(A.k_k); S_LAUNDER_S(A.k_a); S_LAUNDER_S(A.r_k); S_LAUNDER_S(A.ydir); S_LAUNDER_S(A.bonus);
    S_LAUNDER_S(b); S_LAUNDER_S(h); S_LAUNDER_S(dir);
    int lane = lane_in; S_LAUNDER_I(lane);
    const int n = lane & 31, hh = lane >> 5;
    const int sgn = dir ? -1 : 1, tau0 = dir ? (T - 1 - 32 * c) : 32 * c;
    const S_GAS bf16* zb = A.Z + (size_t)b * T * NZ;
    const ptrdiff_t st = (ptrdiff_t)sgn * NZ; const bool first = (c == 0), last = (c == T / 32 - 1);
    const int cr = ZR + h * 64 + lane, ck = ZK + h * 64 + lane, cv = ZV + h * 64 + lane, cw = ZWD + dir * 64 + lane, ca = ZAD + dir * 64 + lane, chn = h * 64 + lane;
    {   const SFrag IDF = sident(n, hh); unsigned ppw[16], ppa[16];
        { const float mA = dir ? A.mu_next[cw] : A.mu_prev[cw], mB = dir ? A.mu_prev[cw] : A.mu_next[cw], nA = dir ? A.mu_next[ca] : A.mu_prev[ca], nB = dir ? A.mu_prev[ca] : A.mu_next[ca];
          const S_GAS bf16* pw = zb + (ptrdiff_t)tau0 * NZ + cw - st; const S_GAS bf16* pa = zb + (ptrdiff_t)tau0 * NZ + ca - st;
          float rw[34], ra[34];
          S_UNROLL for (int q = 0; q < 34; ++q) { const bool ok = !((q == 0 && first) || (q == 33 && last)); rw[q] = ok ? bf2f(*pw) : 0.f; ra[q] = ok ? bf2f(*pa) : 0.f; pw += st; pa += st; }
          S_MEMBAR();
          const float mC = 1.f - mA - mB, nC = 1.f - nA - nB; float tprev = 0.f, aprev = 0.f;
          S_UNROLL for (int p = 0; p < 32; ++p) { if ((p & 7) == 0) S_MEMBAR();
              const float ws = mC * rw[p + 1] + mA * rw[p] + mB * rw[p + 2], as = nC * ra[p + 1] + nA * ra[p] + nB * ra[p + 2];
              const float tw = 1.f - 2.f * S_RCP(1.f + S_EXP2(ws * 2.885390082f));
              if (p & 1) { ppw[p >> 1] = S_PK(tprev, tw); ppa[p >> 1] = S_PK(aprev, as); S_PIN(ppw[p >> 1]); S_PIN(ppa[p >> 1]); } else { tprev = tw; aprev = as; } } }
        S_MEMBAR();
        const SMat TW = splain2d(ppw), AD = splain2d(ppa);
        SFrag TWT[2], ADT[2];
        S_UNROLL for (int lt = 0; lt < 2; ++lt) { TWT[lt] = spack(smm(TW.t[lt], IDF, szero())); ADT[lt] = spack(smm(AD.t[lt], IDF, szero())); }
        f32x16 dw[2], da[2];
        S_UNROLL for (int jt = 0; jt < 2; ++jt) { dw[jt] = szero(); da[jt] = szero();
            S_UNROLL for (int lt = 0; lt < 2; ++lt) { SFrag wf, af;
                S_UNROLL for (int s = 0; s < 2; ++s) { wf.s[s] = *(S_LDS_CONST_BF16X8P)(lds + SC_W2F + ((((lt * 2 + jt) * 2 + s) * 64 + lane) * 16)); af.s[s] = *(S_LDS_CONST_BF16X8P)(lds + SC_A2F + ((((lt * 2 + jt) * 2 + s) * 64 + lane) * 16)); }
                dw[jt] = smm(TWT[lt], wf, dw[jt]); da[jt] = smm(ADT[lt], af, da[jt]); } }
        S_UNROLL for (int jt = 0; jt < 2; ++jt) S_UNROLL for (int g = 0; g < 16; ++g) { const int t = (g & 3) + 8 * (g >> 2) + 4 * hh;
            ((S_LDS_F32P)(lds + SC_WR + wave * 8192))[t * 64 + 32 * jt + n] = dw[jt][g]; ((S_LDS_BF16P)(lds + SC_AR + wave * 4096))[t * 64 + 32 * jt + n] = (bf16)(S_PK(da[jt][g], 0.f) & 0xffffu); }
        S_LDS_WAIT();
    }
    S_MEMBAR();
    unsigned ppA[16], ppR[16], ppB[16], ppK[16], ppV[16], ppQ[16]; float gamC;
    {   const float mAr = dir ? A.mu_next[cr] : A.mu_prev[cr], mBr = dir ? A.mu_prev[cr] : A.mu_next[cr], mAk = dir ? A.mu_next[ck] : A.mu_prev[ck], mBk = dir ? A.mu_prev[ck] : A.mu_next[ck];
        const float mAv = dir ? A.mu_next[cv] : A.mu_prev[cv], mBv = dir ? A.mu_prev[cv] : A.mu_next[cv];
        const float w0j = A.w0[dir * 512 + chn], a0j = A.a0[dir * 512 + chn], kkj = A.k_k[chn], kaj = A.k_a[chn], rkj = A.r_k[chn];
        const S_GAS bf16* pr = zb + (ptrdiff_t)tau0 * NZ + cr - st; const S_GAS bf16* pk = zb + (ptrdiff_t)tau0 * NZ + ck - st; const S_GAS bf16* pv = zb + (ptrdiff_t)tau0 * NZ + cv - st;
        float rr[34], rk[34], rv[34];
        S_UNROLL for (int q = 0; q < 34; ++q) { const bool ok = !((q == 0 && first) || (q == 33 && last)); rr[q] = ok ? bf2f(*pr) : 0.f; rk[q] = ok ? bf2f(*pk) : 0.f; rv[q] = ok ? bf2f(*pv) : 0.f; pr += st; pk += st; pv += st; }
        S_MEMBAR();
        const float mCr = 1.f - mAr - mBr, mCk = 1.f - mAk - mBk, mCv = 1.f - mAv - mBv;
        float cs = 0.f, gprev = 1.f; float eA = 0.f, eR = 0.f, eB = 0.f, eK = 0.f, eV = 0.f, eQ = 0.f;
        S_UNROLL for (int p = 0; p < 32; ++p) { S_MEMBAR();
            const float r = mCr * rr[p + 1] + mAr * rr[p] + mBr * rr[p + 2], k = mCk * rk[p + 1] + mAk * rk[p] + mBk * rk[p + 2], v = mCv * rv[p + 1] + mAv * rv[p] + mBv * rv[p + 2];
            const float wraw = ((S_LDS_F32P)(lds + SC_WR + wave * 8192))[p * 64 + lane] + w0j, araw = bf2f(((S_LDS_BF16P)(lds + SC_AR + wave * 4096))[p * 64 + lane]) + a0j;
            const float x = -wraw; const float sp = fmaxf(x, 0.f) + 0.6931471806f * S_LOG2(1.f + S_EXP2(-fabsf(x) * 1.442695041f));
            const float w = -sp - 0.5f; const float lw2 = -S_EXP2(w * 1.442695041f) * 1.442695041f;
            const float al = S_RCP(1.f + S_EXP2(-araw * 1.442695041f));
            const float kkr = k * kkj; const float nrm2 = swave_sum(kkr * kkr); const float kk = kkr * S_RSQ(fmaxf(nrm2, 1e-24f));
            const float kd = k * (1.f + (al - 1.f) * kaj);
            cs += lw2; const float gam = S_EXP2(cs), ig = S_EXP2(-cs);
            const float xa = -kk * gprev, xr = r * gam, xb = kk * al * ig, xk = kd * ig, xq = xr * rkj; gprev = gam;
            if (p & 1) { ppA[p >> 1] = S_PK(eA, xa); ppR[p >> 1] = S_PK(eR, xr); ppB[p >> 1] = S_PK(eB, xb); ppK[p >> 1] = S_PK(eK, xk); ppV[p >> 1] = S_PK(eV, v); ppQ[p >> 1] = S_PK(eQ, xq);
                         S_PIN(ppQ[p >> 1]); S_PIN(ppA[p >> 1]); S_PIN(ppR[p >> 1]); S_PIN(ppB[p >> 1]); S_PIN(ppK[p >> 1]); S_PIN(ppV[p >> 1]); }
            else { eA = xa; eR = xr; eB = xb; eK = xk; eV = v; eQ = xq; } }
        gamC = gprev;
    }
    S_MEMBAR();
    float gc0, gc1; { unsigned x = __float_as_uint(gamC), y = x; S_SWAP(x, y); gc0 = __uint_as_float(x); gc1 = __uint_as_float(y); }
    ((S_LDS_F32P)(lds + SC_GTAB + wave * 256))[lane] = gamC;
    const SMat FA = splain2d(ppA), FB = splain2d(ppB), FK = splain2d(ppK), FV = splain2d(ppV);
    SFrag RT[2], MrbT, MrkT, LakT, Pf, PTf; f32x16 TT;
    {   const SFrag IDF = sident(n, hh); SFrag AT[2], BT[2], KT[2];
        { const SMat FR = splain2d(ppR); S_UNROLL for (int dt = 0; dt < 2; ++dt) RT[dt] = spack(smm(FR.t[dt], IDF, szero())); }
        SFrag QT[2]; { const SMat FQ = splain2d(ppQ); S_UNROLL for (int dt = 0; dt < 2; ++dt) QT[dt] = spack(smm(FQ.t[dt], IDF, szero())); }
        S_UNROLL for (int dt = 0; dt < 2; ++dt) { AT[dt] = spack(smm(FA.t[dt], IDF, szero())); BT[dt] = spack(smm(FB.t[dt], IDF, szero())); KT[dt] = spack(smm(FK.t[dt], IDF, szero())); }
        f32x16 L = szero(), LT = szero(), lak = szero(), mrb = szero(), mrk = szero();
        { f32x16 bq = szero(); S_UNROLL for (int dt = 0; dt < 2; ++dt) bq = smm(KT[dt], QT[dt], bq);
          int nb = n, rb = 4 * hh; S_LAUNDER_I(nb); S_LAUNDER_I(rb); float dsum = 0.f; S_UNROLL for (int g = 0; g < 16; ++g) dsum += (((g & 3) + 8 * (g >> 2) + rb) == nb) ? bq[g] : 0.f;
          if (((nb >> 2) & 1) == (rb >> 2)) A.bonus[((size_t)b * T + (tau0 + sgn * nb)) * 8 + h] = dsum; }
        S_UNROLL for (int dt = 0; dt < 2; ++dt) { L = smm(AT[dt], BT[dt], L); LT = smm(BT[dt], AT[dt], LT); lak = smm(KT[dt], AT[dt], lak); mrb = smm(BT[dt], RT[dt], mrb); mrk = smm(KT[dt], RT[dt], mrk); }
        int n2 = n, r2 = 4 * hh; S_LAUNDER_I(n2); S_LAUNDER_I(r2);
        S_UNROLL for (int g = 0; g < 16; ++g) { const int row = (g & 3) + 8 * (g >> 2) + r2;
            L[g] = (row > n2) ? L[g] : 0.f; LT[g] = (row < n2) ? LT[g] : 0.f; lak[g] = (row < n2) ? lak[g] : 0.f; mrb[g] = (row <= n2) ? mrb[g] : 0.f; mrk[g] = (row <= n2) ? mrk[g] : 0.f; }
        Pf = spack(L); PTf = spack(LT); LakT = spack(lak); MrbT = spack(mrb); MrkT = spack(mrk);
        TT = LT; S_UNROLL for (int g = 0; g < 16; ++g) TT[g] += (((g & 3) + 8 * (g >> 2) + r2) == n2) ? 1.f : 0.f;
    }
    S_MEMBAR();
    SFrag TTf = spack(TT);
    S_UNROLL for (int i = 1; i <= 4; ++i) { const f32x16 P2 = smm(PTf, Pf, szero()); SFrag P2Tf; if (i < 4) P2Tf = spack(smm(Pf, PTf, szero()));
        Pf = spack(P2); TT = smm(Pf, TTf, TT); TTf = spack(TT); if (i < 4) PTf = P2Tf; }
    S_MEMBAR();
    SFrag U0[2], Ap[2], RpT[2], Y0[2], GTf[2][2], Hf[2][2];
    S_UNROLL for (int vt = 0; vt < 2; ++vt) { const SFrag W = spack(smm(LakT, FV.t[vt], szero())); U0[vt] = spack(smm(TTf, W, szero())); }
    S_UNROLL for (int kt = 0; kt < 2; ++kt) Ap[kt] = spack(smm(TTf, FA.t[kt], szero()));
    S_UNROLL for (int kt = 0; kt < 2; ++kt) RpT[kt] = spack(smm(Ap[kt], MrbT, sunpack(RT[kt])));
    S_UNROLL for (int vt = 0; vt < 2; ++vt) Y0[vt] = spack(smm(MrkT, FV.t[vt], smm(MrbT, U0[vt], szero())));
    int n3 = n, r3 = 4 * hh; S_LAUNDER_I(n3); S_LAUNDER_I(r3);
    S_UNROLL for (int nt = 0; nt < 2; ++nt) S_UNROLL for (int mt = 0; mt < 2; ++mt) { f32x16 gt = smm(Ap[nt], FB.t[mt], szero()); const float gcv = mt ? gc1 : gc0;
        S_UNROLL for (int g = 0; g < 16; ++g) { const float idv = (nt == mt && ((g & 3) + 8 * (g >> 2) + r3) == n3) ? 1.f : 0.f; gt[g] = (gt[g] + idv) * gcv; }
        GTf[nt][mt] = spack(gt); }
    S_LDS_WAIT();
    S_UNROLL for (int mt = 0; mt < 2; ++mt) { float gr[16];
        S_UNROLL for (int q = 0; q < 4; ++q) { const f32x4 t4 = *(S_LDS_CONST_F32X4P)(lds + SC_GTAB + wave * 256 + (32 * mt + 8 * q + 4 * hh) * 4); S_UNROLL for (int i = 0; i < 4; ++i) gr[4 * q + i] = t4[i]; }
        S_UNROLL for (int vt = 0; vt < 2; ++vt) { f32x16 hm = smm(FK.t[mt], FV.t[vt], smm(FB.t[mt], U0[vt], szero())); S_UNROLL for (int g = 0; g < 16; ++g) hm[g] *= gr[g]; Hf[mt][vt] = spack(hm); } }
    S_MEMBAR();
    S_FLAG_WAIT(lds + SC_FLAG, (unsigned)c);
    SFrag SG[2][2];
    S_UNROLL for (int kt = 0; kt < 2; ++kt) S_UNROLL for (int vt = 0; vt < 2; ++vt) S_UNROLL for (int s = 0; s < 2; ++s) SG[kt][vt].s[s] = *(S_LDS_CONST_BF16X8P)(lds + SC_SIG + ((((kt * 2 + vt) * 2 + s) * 64 + lane) * 16));
    S_LDS_WAIT();
    S_UNROLL for (int mt = 0; mt < 2; ++mt) S_UNROLL for (int vt = 0; vt < 2; ++vt) { f32x16 sn = sunpack(Hf[mt][vt]); S_UNROLL for (int nt = 0; nt < 2; ++nt) sn = smm(GTf[nt][mt], SG[nt][vt], sn);
        const SFrag f = spack(sn); S_UNROLL for (int s = 0; s < 2; ++s) *(S_LDS_BF16X8P)(lds + SC_SIG + ((((mt * 2 + vt) * 2 + s) * 64 + lane) * 16)) = f.s[s]; }
    S_LDS_WAIT();
    S_FLAG_STORE(lds + SC_FLAG, (unsigned)(c + 1));
    S_UNROLL for (int vt = 0; vt < 2; ++vt) { f32x16 y = sunpack(Y0[vt]); S_UNROLL for (int kt = 0; kt < 2; ++kt) y = smm(RpT[kt], SG[kt][vt], y);
        S_UNROLL for (int g = 0; g < 16; ++g) { const int p = (g & 3) + 8 * (g >> 2) + 4 * hh; A.ydir[((size_t)b * T + (tau0 + sgn * p)) * 512 + h * 64 + 32 * vt + n] = (bf16)(S_PK(y[g], 0.f) & 0xffffu); } }
}

__device__ __forceinline__ void attn_unit(const Frame& F, ArgsP A, int b, int kvh, int qb) {
    constexpr int KST = 72, VST = 388;
    LAS bf16* KS = (LAS bf16*)F.lds;
    LAS bf16* VT = (LAS bf16*)(F.lds + 384 * KST * 2);
    LAS float* wsf = (LAS float*)(F.lds + 384 * KST * 2 + 64 * VST * 2);
    const bf16* Z = (const bf16*)(A->ws + WS_Z); bf16* OA = (bf16*)(A->ws + WS_OATT);
    const int* positions = (const int*)A->in[2]; const float* qg = (const float*)A->in[19]; const float* kg = (const float*)A->in[20]; const float* sink = (const float*)A->in[21];
    const int tid = F.tid, lane = F.lane, wave = F.wave;
    const float LN_THETA = 13.122363377404328f;
    v4u kwa[6], vwa[6], rca[6], rsa[6];
#pragma unroll
    for (int i = 0; i < 6; ++i) { const int ct = tid + 512 * i, key = ct >> 3, ch = ct & 7; const int kp = qb * 128 - 128 + key; const bool valid = (kp >= 0) && (kp < T);
        const size_t rowoff = ((size_t)b * T + (valid ? kp : 0)) * NZ;
        kwa[i] = *(const GAS v4u*)(Z + rowoff + ZKA + kvh * 64 + ch * 8); vwa[i] = *(const GAS v4u*)(Z + rowoff + ZVA + kvh * 64 + ch * 8);
        const GAS v4u* rt = (const GAS v4u*)((const bf16*)(A->ws + WS_ROPE) + ((size_t)b * T + (valid ? kp : 0)) * 16); rca[i] = rt[0]; rsa[i] = rt[1]; }
#pragma unroll
    for (int i = 0; i < 6; ++i) { const int ct = tid + 512 * i, key = ct >> 3, ch = ct & 7; const int kp = qb * 128 - 128 + key; const bool valid = (kp >= 0) && (kp < T);
        v4u kw = kwa[i], vw = vwa[i];
        if (!valid) { kw = (v4u){0u, 0u, 0u, 0u}; vw = kw; }
        float kf[8] = {bflo(kw.x), bfhi(kw.x), bflo(kw.y), bfhi(kw.y), bflo(kw.z), bfhi(kw.z), bflo(kw.w), bfhi(kw.w)};
        float ss = 0.f;
#pragma unroll
        for (int j = 0; j < 8; ++j) ss += kf[j] * kf[j];
        ss += __shfl_xor(ss, 1); ss += __shfl_xor(ss, 2); ss += __shfl_xor(ss, 4);
        const float rs = rsqrtf(ss * (1.0f / 64.0f) + 1e-6f);
#pragma unroll
        for (int j = 0; j < 8; ++j) kf[j] = kf[j] * rs * kg[ch * 8 + j];
        float oth[8];
#pragma unroll
        for (int j = 0; j < 8; ++j) oth[j] = __shfl_xor(kf[j], 1);
        if (ch < 2) { const v4u cw = rca[i], sw = rsa[i];
            const float cs[8] = {bflo(cw.x), bfhi(cw.x), bflo(cw.y), bfhi(cw.y), bflo(cw.z), bfhi(cw.z), bflo(cw.w), bfhi(cw.w)};
            const float sn[8] = {bflo(sw.x), bfhi(sw.x), bflo(sw.y), bfhi(sw.y), bflo(sw.z), bfhi(sw.z), bflo(sw.w), bfhi(sw.w)};
#pragma unroll
            for (int j = 0; j < 8; ++j) kf[j] = (ch == 0) ? (kf[j] * cs[j] - oth[j] * sn[j]) : (kf[j] * cs[j] + oth[j] * sn[j]); }
        v4u ko; ko.x = pk2(kf[0], kf[1]); ko.y = pk2(kf[2], kf[3]); ko.z = pk2(kf[4], kf[5]); ko.w = pk2(kf[6], kf[7]);
        *(LAS v4u*)(KS + key * KST + ch * 8) = ko;
        const unsigned vv[4] = {vw.x, vw.y, vw.z, vw.w};
#pragma unroll
        for (int j = 0; j < 4; ++j) { VT[(ch * 8 + 2 * j) * VST + key] = (bf16)(vv[j] & 0xffffu); VT[(ch * 8 + 2 * j + 1) * VST + key] = (bf16)(vv[j] >> 16); } }
    __syncthreads();
    const int g = wave >> 1, hq = kvh * 4 + g, r32 = lane & 31, hh = lane >> 5;
    const float snk = sink[hq];
    float kbound; { float gm = fabsf(kg[lane]);
#pragma unroll
        for (int o = 1; o < 64; o <<= 1) gm = fmaxf(gm, __shfl_xor(gm, o));
        kbound = 8.0f * gm; }
#pragma unroll 1
    for (int qt = 0; qt < 2; ++qt) { const int qo = (wave & 1) * 64 + qt * 32, qrel = qo + r32; const size_t tok = (size_t)b * T + qb * 128 + qrel;
        float qf[4][8]; float ss = 0.f; v4u qraw[4];
#pragma unroll
        for (int sI = 0; sI < 4; ++sI) qraw[sI] = *(const GAS v4u*)(Z + tok * NZ + ZQ + hq * 64 + 16 * sI + 8 * hh);
        const GAS v4u* qrt = (const GAS v4u*)((const bf16*)(A->ws + WS_ROPE) + tok * 16); const v4u qrc = qrt[0], qrs = qrt[1];
#pragma unroll
        for (int sI = 0; sI < 4; ++sI) { const v4u qw = qraw[sI];
            qf[sI][0] = bflo(qw.x); qf[sI][1] = bfhi(qw.x); qf[sI][2] = bflo(qw.y); qf[sI][3] = bfhi(qw.y); qf[sI][4] = bflo(qw.z); qf[sI][5] = bfhi(qw.z); qf[sI][6] = bflo(qw.w); qf[sI][7] = bfhi(qw.w);
#pragma unroll
            for (int j = 0; j < 8; ++j) ss += qf[sI][j] * qf[sI][j]; }
        ss += __shfl_xor(ss, 32);
        const float rs = rsqrtf(ss * (1.0f / 64.0f) + 1e-6f) * 0.125f;
#pragma unroll
        for (int sI = 0; sI < 4; ++sI)
#pragma unroll
            for (int j = 0; j < 8; ++j) qf[sI][j] = qf[sI][j] * rs * qg[16 * sI + 8 * hh + j];
        { const v4u cw = qrc, sw = qrs;
          const float cs[8] = {bflo(cw.x), bfhi(cw.x), bflo(cw.y), bfhi(cw.y), bflo(cw.z), bfhi(cw.z), bflo(cw.w), bfhi(cw.w)}, sn[8] = {bflo(sw.x), bfhi(sw.x), bflo(sw.y), bfhi(sw.y), bflo(sw.z), bfhi(sw.z), bflo(sw.w), bfhi(sw.w)};
#pragma unroll
          for (int j = 0; j < 8; ++j) { const float oth = __shfl_xor(qf[0][j], 32); qf[0][j] = (hh == 0) ? (qf[0][j] * cs[j] - oth * sn[j]) : (qf[0][j] * cs[j] + oth * sn[j]); } }
        bf16x8 qr[4];
#pragma unroll
        for (int sI = 0; sI < 4; ++sI) { v4u w; w.x = pk2(qf[sI][0], qf[sI][1]); w.y = pk2(qf[sI][2], qf[sI][3]); w.z = pk2(qf[sI][4], qf[sI][5]); w.w = pk2(qf[sI][6], qf[sI][7]); qr[sI] = __builtin_bit_cast(bf16x8, w); }
        const int kt0 = qo >> 5;
        float qn2 = 0.f;
#pragma unroll
        for (int sI = 0; sI < 4; ++sI)
#pragma unroll
            for (int j = 0; j < 8; ++j) qn2 += qf[sI][j] * qf[sI][j];
        qn2 += __shfl_xor(qn2, 32);
        float mrun = sqrtf(qn2) * kbound * 1.02f;
        if (__any(mrun > 40.f)) { mrun = -1e30f;
#pragma unroll 1
            for (int kt = 0; kt < 9; ++kt) { const int kbase = (kt0 + kt) * 32;
                f32x16 acc = {};
#pragma unroll
                for (int sI = 0; sI < 4; ++sI) { const bf16x8 kfr = *(const LAS bf16x8*)(KS + (kbase + r32) * KST + 16 * sI + 8 * hh); acc = __builtin_amdgcn_mfma_f32_32x32x16_bf16(kfr, qr[sI], acc, 0, 0, 0); }
#pragma unroll
                for (int r = 0; r < 16; ++r) { const int ki = kbase + (r & 3) + 8 * (r >> 2) + 4 * hh; const int dq = ki - 128 - qrel, kp = qb * 128 - 128 + ki;
                    const bool ok = (dq >= -128) && (dq <= 128) && (kp >= 0) && (kp < T); mrun = fmaxf(mrun, ok ? acc[r] : -1e30f); } }
            mrun = fmaxf(mrun, __shfl_xor(mrun, 32)); }
        const float mx = fmaxf(mrun, snk);
        float lrun = 0.f; f32x16 o0 = {}, o1 = {}; const float mxl = mx * 1.442695041f; const bool edge = (qb == 0) || (qb == T / 128 - 1);
#pragma unroll 1
        for (int kt = 0; kt < 9; ++kt) { const int kbase = (kt0 + kt) * 32;
            f32x16 acc = {};
#pragma unroll
            for (int sI = 0; sI < 4; ++sI) { const bf16x8 kfr = *(const LAS bf16x8*)(KS + (kbase + r32) * KST + 16 * sI + 8 * hh); acc = __builtin_amdgcn_mfma_f32_32x32x16_bf16(kfr, qr[sI], acc, 0, 0, 0); }
            float p[16];
            if (edge || kt == 0 || kt == 8) {
#pragma unroll
                for (int r = 0; r < 16; ++r) { const int ki = kbase + (r & 3) + 8 * (r >> 2) + 4 * hh; const int dq = ki - 128 - qrel, kp = qb * 128 - 128 + ki;
                    const bool ok = (dq >= -128) && (dq <= 128) && (kp >= 0) && (kp < T); p[r] = ok ? __builtin_amdgcn_exp2f(acc[r] * 1.442695041f - mxl) : 0.f; lrun += p[r]; }
            } else {
#pragma unroll
                for (int r = 0; r < 16; ++r) { p[r] = __builtin_amdgcn_exp2f(acc[r] * 1.442695041f - mxl); lrun += p[r]; } }
#pragma unroll
            for (int sI = 0; sI < 2; ++sI) { v4u pw; pw.x = pk2(p[8 * sI + 0], p[8 * sI + 1]); pw.y = pk2(p[8 * sI + 2], p[8 * sI + 3]); pw.z = pk2(p[8 * sI + 4], p[8 * sI + 5]); pw.w = pk2(p[8 * sI + 6], p[8 * sI + 7]);
                const bf16x8 pa = __builtin_bit_cast(bf16x8, pw); const int key0 = kbase + 16 * sI + 4 * hh;
                { const u32x2 lo = *(const LAS u32x2*)(VT + r32 * VST + key0), hi = *(const LAS u32x2*)(VT + r32 * VST + key0 + 8); v4u vw; vw.x = lo.x; vw.y = lo.y; vw.z = hi.x; vw.w = hi.y;
                  o0 = __builtin_amdgcn_mfma_f32_32x32x16_bf16(pa, __builtin_bit_cast(bf16x8, vw), o0, 0, 0, 0); }
                { const u32x2 lo = *(const LAS u32x2*)(VT + (32 + r32) * VST + key0), hi = *(const LAS u32x2*)(VT + (32 + r32) * VST + key0 + 8); v4u vw; vw.x = lo.x; vw.y = lo.y; vw.z = hi.x; vw.w = hi.y;
                  o1 = __builtin_amdgcn_mfma_f32_32x32x16_bf16(pa, __builtin_bit_cast(bf16x8, vw), o1, 0, 0, 0); } } }
        lrun += __shfl_xor(lrun, 32);
        const float linv = 1.0f / (lrun + __expf(snk - mx));
        if (hh == 0) wsf[wave * 64 + r32] = linv;
        LDS_WAIT(); asm volatile("" ::: "memory");
#pragma unroll
        for (int r = 0; r < 16; ++r) { const int row = (r & 3) + 8 * (r >> 2) + 4 * hh; const float li = wsf[wave * 64 + row];
            bf16* op = OA + ((size_t)b * T + qb * 128 + qo + row) * 512 + hq * 64;
            op[r32] = (bf16)f2bf(o0[r] * li); op[32 + r32] = (bf16)f2bf(o1[r] * li); }
        LDS_WAIT(); asm volatile("" ::: "memory");
    }
    __syncthreads();
}

__device__ __forceinline__ void pg_rows(const Frame& F, ArgsP A, bf16* wout) {
    const bf16* Z = (const bf16*)(A->ws + WS_Z); const bf16* Y0 = (const bf16*)(A->ws + WS_XN); const bf16* Y1 = Y0 + (size_t)M * 512;
    bf16* Gb = (bf16*)(A->ws + WS_G); const float* bonus = (const float*)(A->ws + WS_BONUS);
    const float* mu_prev = (const float*)A->in[7]; const float* mu_next = (const float*)A->in[8]; const float* gn_w = (const float*)A->in[17]; const float* gn_b = (const float*)A->in[18];
    const int gw = F.vcu * NWAVES + F.wave, NGW = F.G * NWAVES, lane = F.lane, c0 = lane * 8, h = lane >> 3;
    float mp[8], mn[8], gw_[8], gb_[8];
#pragma unroll
    for (int j = 0; j < 8; ++j) { mp[j] = mu_prev[ZV + c0 + j]; mn[j] = mu_next[ZV + c0 + j]; gw_[j] = gn_w[c0 + j]; gb_[j] = gn_b[c0 + j]; }
#pragma unroll 1
    for (int m0 = gw; m0 < M; m0 += 4 * NGW) {
        v4u y0[4], y1[4], gv[4], z0[4], zm[4], zq[4]; float bon[4];
#pragma unroll
        for (int i = 0; i < 4; ++i) { const int m = m0 + i * NGW, t = m & (T - 1);
            y0[i] = *(const GAS v4u*)(Y0 + (size_t)m * 512 + c0); y1[i] = *(const GAS v4u*)(Y1 + (size_t)m * 512 + c0); gv[i] = *(const GAS v4u*)(Gb + (size_t)m * 512 + c0);
            z0[i] = *(const GAS v4u*)(Z + (size_t)m * NZ + ZV + c0);
            zm[i] = (v4u){0u, 0u, 0u, 0u}; zq[i] = (v4u){0u, 0u, 0u, 0u};
            if (t > 0) zm[i] = *(const GAS v4u*)(Z + (size_t)(m - 1) * NZ + ZV + c0);
            if (t < T - 1) zq[i] = *(const GAS v4u*)(Z + (size_t)(m + 1) * NZ + ZV + c0);
            bon[i] = bonus[(size_t)m * 8 + h] + bonus[(size_t)M * 8 + (size_t)m * 8 + h]; }
#pragma unroll
        for (int i = 0; i < 4; ++i) { const int m = m0 + i * NGW;
            const unsigned y0w[4] = {y0[i].x, y0[i].y, y0[i].z, y0[i].w}, y1w[4] = {y1[i].x, y1[i].y, y1[i].z, y1[i].w}, gvw[4] = {gv[i].x, gv[i].y, gv[i].z, gv[i].w};
            const unsigned z0w[4] = {z0[i].x, z0[i].y, z0[i].z, z0[i].w}, zmw[4] = {zm[i].x, zm[i].y, zm[i].z, zm[i].w}, zqw[4] = {zq[i].x, zq[i].y, zq[i].z, zq[i].w};
            float y[8], gg[8], vv[8]; float sacc = 0.f;
#pragma unroll
            for (int j = 0; j < 4; ++j) { y[2 * j] = bflo(y0w[j]) + bflo(y1w[j]); y[2 * j + 1] = bfhi(y0w[j]) + bfhi(y1w[j]); gg[2 * j] = bflo(gvw[j]); gg[2 * j + 1] = bfhi(gvw[j]);
                const float a0 = bflo(z0w[j]), a1 = bfhi(z0w[j]);
                vv[2 * j] = a0 + mp[2 * j] * (bflo(zmw[j]) - a0) + mn[2 * j] * (bflo(zqw[j]) - a0); vv[2 * j + 1] = a1 + mp[2 * j + 1] * (bfhi(zmw[j]) - a1) + mn[2 * j + 1] * (bfhi(zqw[j]) - a1);
                sacc += y[2 * j] + y[2 * j + 1]; }
            sacc += __shfl_xor(sacc, 1); sacc += __shfl_xor(sacc, 2); sacc += __shfl_xor(sacc, 4);
            const float mu = sacc * (1.0f / 64.0f); float q = 0.f;
#pragma unroll
            for (int j = 0; j < 8; ++j) { const float d = y[j] - mu; q += d * d; }
            q += __shfl_xor(q, 1); q += __shfl_xor(q, 2); q += __shfl_xor(q, 4);
            const float rstd = rsqrtf(q * (1.0f / 64.0f) + 64e-5f);
            float o[8];
#pragma unroll
            for (int j = 0; j < 8; ++j) o[j] = ((y[j] - mu) * rstd * gw_[j] + gb_[j] + bon[i] * vv[j]) * gg[j];
            v4u w; w.x = pk2(o[0], o[1]); w.y = pk2(o[2], o[3]); w.z = pk2(o[4], o[5]); w.w = pk2(o[6], o[7]);
            *(GAS v4u*)(wout + (size_t)m * 512 + c0) = w; } }
}

__device__ __forceinline__ void pj_phase(const Frame& F, ArgsP A) {
    unsigned char* ws = A->ws;
    const int gw = F.vcu * NWAVES + F.wave, NGW = F.G * NWAVES, lane = F.lane;
    { LAS float* scr = (LAS float*)(F.lds + F.wave * 16384);
      const float* w_gate = (const float*)A->in[27]; const float* w_up = (const float*)A->in[28]; const float* w_down = (const float*)A->in[29];
      bf16* WguT = (bf16*)((unsigned char*)A->out + OUT_WGUT); bf16* WdT = (bf16*)((unsigned char*)A->out + OUT_WDT);
      constexpr int PER = 512, NIT = 16 * 3 * PER;
      for (int it = gw; it < NIT; it += NGW) { const int e = it / (3 * PER), r = it % (3 * PER), which = r / PER, q = r % PER, kb = q >> 5, nb = q & 31, n0 = 32 * nb;
          if (which == 0) tr_item(w_gate + (size_t)e * 1048576, 1024, 64 * kb, n0, WguT, 1024, e * 2048 + (n0 >> 7) * 256 + (n0 & 127), scr, lane);
          else if (which == 1) tr_item(w_up + (size_t)e * 1048576, 1024, 64 * kb, n0, WguT, 1024, e * 2048 + (n0 >> 7) * 256 + 128 + (n0 & 127), scr, lane);
          else tr_item(w_down + (size_t)e * 1048576, 1024, 64 * kb, n0, WdT, 1024, e * 1024 + n0, scr, lane); }
    }
    __syncthreads();
    LAS float* wrT = (LAS float*)F.lds;
    const float* w_router = (const float*)A->in[26];
    for (int i = F.tid; i < 16384; i += 512) { const int d = i >> 4, e = i & 15; wrT[e * 1024 + d] = w_router[i]; }
    __syncthreads();
    const bf16* x1 = (const bf16*)(ws + WS_X1); const float* g2n = (const float*)A->in[25]; const float* mod = (const float*)(ws + WS_MOD);
    bf16* XN2 = (bf16*)(ws + WS_XN); float* aff = (float*)(ws + WS_AFF);
    u32x2 raw[4][4]; load_rows_bf16<4>(x1, gw, NGW, lane, raw);
#pragma unroll 1
    for (int m0 = gw; m0 < M; m0 += 4 * NGW) { f32x4 u[4][4];
        modnorm_rows_pre<4>(raw, m0, NGW, g2n, mod, 3072, 4096, XN2, lane, u);
        if (m0 + 4 * NGW < M) load_rows_bf16<4>(x1, m0 + 4 * NGW, NGW, lane, raw);
        float mylg[4] = {0.f, 0.f, 0.f, 0.f};
#pragma unroll 2
        for (int e = 0; e < 16; ++e) { f32x4 w[4];
#pragma unroll
            for (int j = 0; j < 4; ++j) w[j] = *(const LAS f32x4*)(wrT + e * 1024 + 4 * lane + 256 * j);
#pragma unroll
            for (int i = 0; i < 4; ++i) { float sacc = 0.f;
#pragma unroll
                for (int j = 0; j < 4; ++j) sacc += (u[i][j].x * w[j].x + u[i][j].y * w[j].y) + (u[i][j].z * w[j].z + u[i][j].w * w[j].w);
                sacc = dpp_wave_sum(sacc); mylg[i] = (lane == e) ? sacc : mylg[i]; } }
#pragma unroll
        for (int i = 0; i < 4; ++i) { const int m = m0 + i * NGW, b = m >> 11, t = m & (T - 1);
            float mx = mylg[i];
#pragma unroll
            for (int o = 1; o < 16; o <<= 1) mx = fmaxf(mx, __shfl_xor(mx, o));
            const float ex = expf(mylg[i] - mx); float den = ex;
#pragma unroll
            for (int o = 1; o < 16; o <<= 1) den += __shfl_xor(den, o);
            if (lane < 16) aff[((size_t)b * 16 + lane) * T + t] = ex / den; } }
}

__device__ __forceinline__ void pk_task(const Frame& F, ArgsP A, int b, int e) {
    unsigned char* ws = A->ws;
    const float* aff = (const float*)(ws + WS_AFF) + ((size_t)b * 16 + e) * T;
    int* slotmap = (int*)(ws + WS_SLOT); float* selaff = (float*)(ws + WS_SELAFF); int* selidx = (int*)(ws + WS_SELIDX);
    const bf16* XN2 = (const bf16*)(ws + WS_XN); bf16* XE = (bf16*)(ws + WS_XE);
    LAS unsigned* cnt = (LAS unsigned*)F.lds;
    LAS int* tokl = (LAS int*)(F.lds + 256);
    const int tid = F.tid, lane = F.lane, wave = F.wave;
    const f32x4 v4 = *(const GAS f32x4*)(aff + 4 * tid);
    const unsigned key[4] = {__float_as_uint(v4.x), __float_as_uint(v4.y), __float_as_uint(v4.z), __float_as_uint(v4.w)};
    unsigned thr = 0u;
#pragma unroll 1
    for (int bit = 31; bit >= 0; --bit) { const unsigned cand = thr | (1u << bit);
        const unsigned c = (unsigned)(__popcll(__ballot(key[0] >= cand)) + __popcll(__ballot(key[1] >= cand)) + __popcll(__ballot(key[2] >= cand)) + __popcll(__ballot(key[3] >= cand)));
        LAS unsigned* slot_ = cnt + 16 + (bit & 1) * 8;
        if (lane == 0) slot_[wave] = c;
        __syncthreads();
        unsigned tot = 0;
#pragma unroll
        for (int w = 0; w < 8; ++w) tot += slot_[w];
        if (tot >= 256u) thr = cand; }
    __syncthreads();
    int ngt = 0, neq = 0;
#pragma unroll
    for (int j = 0; j < 4; ++j) { ngt += key[j] > thr; neq += key[j] == thr; }
    int sg = ngt, se = neq;
#pragma unroll
    for (int o = 1; o < 64; o <<= 1) { const int a = __shfl_up(sg, o), c = __shfl_up(se, o); if (lane >= o) { sg += a; se += c; } }
    if (lane == 63) { cnt[wave] = (unsigned)sg; cnt[8 + wave] = (unsigned)se; }
    __syncthreads();
    int bg = 0, be = 0, totg = 0;
#pragma unroll
    for (int w = 0; w < 8; ++w) { const int a = (int)cnt[w], c = (int)cnt[8 + w]; if (w < wave) { bg += a; be += c; } totg += a; }
    int pg = bg + sg - ngt, pe = be + se - neq;
    const int need_eq = 256 - totg;
    int* smrow = slotmap + ((size_t)b * T + 4 * tid) * 16 + e;
#pragma unroll
    for (int j = 0; j < 4; ++j) { int slot = -1;
        if (key[j] > thr) { slot = pg; ++pg; } else if (key[j] == thr) { if (pe < need_eq) slot = totg + pe; ++pe; }
        smrow[j * 16] = slot;
        if (slot >= 0) { selidx[((size_t)e * 16 + b) * 256 + slot] = b * T + 4 * tid + j; selaff[((size_t)e * 16 + b) * 256 + slot] = __uint_as_float(key[j]); } }
    __syncthreads();
}

__device__ __forceinline__ void pn_rows(const Frame& F, ArgsP A, float* wout) {
    unsigned char* ws = A->ws;
    const int* slotmap = (const int*)(ws + WS_SLOT); const bf16* YE = (const bf16*)(ws + WS_XE); const float* mod = (const float*)(ws + WS_MOD); const bf16* X1 = (const bf16*)(ws + WS_X1);
    const int gw = F.vcu * NWAVES + F.wave, NGW = F.G * NWAVES, lane = F.lane;
#pragma unroll 1
    for (int m0 = gw; m0 < M; m0 += 2 * NGW) {
        int myslot[2]; f32x4 xv[2][4];
#pragma unroll
        for (int i = 0; i < 2; ++i) { const int m = m0 + i * NGW; myslot[i] = slotmap[(size_t)m * 16 + (lane & 15)];
#pragma unroll
            for (int hq = 0; hq < 2; ++hq) { const v4u w = *(const GAS v4u*)(X1 + (size_t)m * 1024 + hq * 512 + lane * 8);
                xv[i][2 * hq] = (f32x4){bflo(w.x), bfhi(w.x), bflo(w.y), bfhi(w.y)}; xv[i][2 * hq + 1] = (f32x4){bflo(w.z), bfhi(w.z), bflo(w.w), bfhi(w.w)}; } }
        unsigned long long msk[2]; v4u yw[2][4][2];
#pragma unroll
        for (int i = 0; i < 2; ++i) { const int b = (m0 + i * NGW) >> 11; msk[i] = __ballot(myslot[i] >= 0) & 0xffffull;
#pragma unroll
            for (int k = 0; k < 4; ++k) { const bool has = msk[i] != 0ull; const int e = has ? __builtin_ctzll(msk[i]) : 0; if (has) msk[i] &= msk[i] - 1; const int sl = __shfl(myslot[i], e);
                yw[i][k][0] = (v4u){0u, 0u, 0u, 0u}; yw[i][k][1] = (v4u){0u, 0u, 0u, 0u};
                if (has) { const GAS v4u* yr = (const GAS v4u*)(YE + (((size_t)e * 16 + b) * 256 + sl) * 1024); yw[i][k][0] = yr[lane]; yw[i][k][1] = yr[64 + lane]; } } }
#pragma unroll
        for (int i = 0; i < 2; ++i) { const int m = m0 + i * NGW, b = m >> 11;
            float acc[16];
#pragma unroll
            for (int j = 0; j < 16; ++j) acc[j] = 0.f;
#pragma unroll
            for (int k = 0; k < 4; ++k)
#pragma unroll
                for (int hlf = 0; hlf < 2; ++hlf) { const v4u w = yw[i][k][hlf];
                    acc[hlf * 8 + 0] += bflo(w.x); acc[hlf * 8 + 1] += bfhi(w.x); acc[hlf * 8 + 2] += bflo(w.y); acc[hlf * 8 + 3] += bfhi(w.y);
                    acc[hlf * 8 + 4] += bflo(w.z); acc[hlf * 8 + 5] += bfhi(w.z); acc[hlf * 8 + 6] += bflo(w.w); acc[hlf * 8 + 7] += bfhi(w.w); }
            unsigned long long mk = msk[i];
            while (mk) { const int e = __builtin_ctzll(mk); mk &= mk - 1; const int sl = __shfl(myslot[i], e);
                const GAS v4u* yr = (const GAS v4u*)(YE + (((size_t)e * 16 + b) * 256 + sl) * 1024);
#pragma unroll
                for (int hlf = 0; hlf < 2; ++hlf) { const v4u w = yr[hlf * 64 + lane];
                    acc[hlf * 8 + 0] += bflo(w.x); acc[hlf * 8 + 1] += bfhi(w.x); acc[hlf * 8 + 2] += bflo(w.y); acc[hlf * 8 + 3] += bfhi(w.y);
                    acc[hlf * 8 + 4] += bflo(w.z); acc[hlf * 8 + 5] += bfhi(w.z); acc[hlf * 8 + 6] += bflo(w.w); acc[hlf * 8 + 7] += bfhi(w.w); } }
            const float* gt2 = mod + (size_t)b * 6144 + 5120; float* orow = wout + (size_t)m * 1024;
#pragma unroll
            for (int q = 0; q < 4; ++q) { const int c = (q >> 1) * 512 + lane * 8 + (q & 1) * 4; const f32x4 g = *(const GAS f32x4*)(gt2 + c);
                f32x4 a; a.x = acc[(q >> 1) * 8 + (q & 1) * 4 + 0]; a.y = acc[(q >> 1) * 8 + (q & 1) * 4 + 1]; a.z = acc[(q >> 1) * 8 + (q & 1) * 4 + 2]; a.w = acc[(q >> 1) * 8 + (q & 1) * 4 + 3];
                *(GAS f32x4*)(orow + c) = xv[i][q] + g * a; } } }
}

__device__ __forceinline__ void mk_frame(Frame& F, LAS unsigned char* lds, int wave_s) {
    int bx = blockIdx.x, G = gridDim.x; LAUNDER(bx); LAUNDER(G);
    F.lds = lds; F.MISC = (volatile LAS unsigned*)(lds + MISC_OFF); F.ctl = nullptr;
    unsigned ones_ = ~0u; asm volatile("" : "+s"(ones_));
    int lane_ = (int)__builtin_amdgcn_mbcnt_hi(ones_, __builtin_amdgcn_mbcnt_lo(ones_, 0u)); asm volatile("" : "+v"(lane_));
    F.lane = lane_; F.wave = wave_s; F.tid = wave_s * 64 + lane_;
    F.G = G; F.vcu = (G % 8 == 0) ? (bx % 8) * (G / 8) + bx / 8 : bx;
}
__global__ void __launch_bounds__(NWAVES * 64, 2) fwd_kernel(Args args) {
    extern __shared__ __attribute__((aligned(16))) unsigned char lds[];
    LAS unsigned char* const ldsb = (LAS unsigned char*)lds;
    ArgsP ap0 = (ArgsP)__builtin_amdgcn_kernarg_segment_ptr();
    int wave_s = __builtin_amdgcn_readfirstlane((int)threadIdx.x >> 6); asm volatile("" : "+s"(wave_s));
    for (int u = threadIdx.x; u < (LDS_BYTES - LDSCTL_OFF) / 4; u += NWAVES * 64) ((LAS unsigned*)(ldsb + LDSCTL_OFF))[u] = 0u;
    __syncthreads();
#define MKBAR XcdBarrier bar; { ArgsP a_ = ap0; LAUNDER(a_); bar.bar = (unsigned*)(a_->ws + WS_CTL) + CW_BAR; bar.x = xb_xcc_id(); bar.st = (volatile LAS unsigned*)(ldsb + MISC_OFF) + 8; }
#if ONE_LAUNCH
    { MKBAR; if (threadIdx.x == 0) (void)xb_add(&bar.bar[XB_XCNT(bar.x)], 1u); }
#ifndef PHM
#define PHM 0x3fff
#endif
#define IN(k) ((PHM >> (k)) & 1)
#define SEAM(k) do { if (IN(k) && IN((k) + 1)) { MKBAR; { unsigned o_ = ~0u; asm volatile("" : "+s"(o_)); xcd_barrier(bar, wave_s == 0 && __builtin_amdgcn_mbcnt_hi(o_, __builtin_amdgcn_mbcnt_lo(o_, 0u)) == 0u); } } } while (0)
#else
    int lo, hi; { ArgsP a = ap0; LAUNDER(a); lo = a->ph_lo; hi = a->ph_hi; }
#define IN(k) (lo <= (k) && (k) < hi)
#define SEAM(k) do { } while (0)
#endif
    typedef pg8::bf16_t pb;
#ifndef REPMASK
#define REPMASK 0
#endif
#define PHASE_ARGS ArgsP ap = ap0; LAUNDER(ap); unsigned char* ws = ap->ws; (void)ws; Frame F; mk_frame(F, ldsb, wave_s); const int gw = F.vcu * NWAVES + F.wave, NGW = F.G * NWAVES; (void)gw; (void)NGW
    if (IN(0)) _Pragma("unroll 1") for (int rep_ = 0; rep_ <= ((REPMASK >> 0) & 1); ++rep_) { PHASE_ARGS; p0_prologue(F, ap); } SEAM(0);
    if (IN(1)) _Pragma("unroll 1") for (int rep_ = 0; rep_ <= ((REPMASK >> 1) & 1); ++rep_) { PHASE_ARGS; const float* x = (const float*)ap->in[0]; const float* g1 = (const float*)ap->in[5]; const float* mod = (const float*)(ws + WS_MOD); bf16* XN = (bf16*)(ws + WS_XN);
#pragma unroll 1
        for (int m = gw; m < M; m += 4 * NGW) { f32x4 u[4][4]; modnorm_rows<4, false>(x, m, NGW, g1, mod, 0, 1024, XN, F.lane, u);
            if (F.lane < 32) { const int mm = m + (F.lane >> 3) * NGW, j = F.lane & 7; const float pos = (float)((const int*)ap->in[2])[mm];
                const float ang = pos * __expf(-(float)j * 0.125f * 13.122363377404328f); float sn, cs; sincosf(ang, &sn, &cs);
                bf16* rt = (bf16*)(ws + WS_ROPE) + (size_t)mm * 16; rt[j] = (bf16)(pk2(cs, 0.f) & 0xffffu); rt[8 + j] = (bf16)(pk2(sn, 0.f) & 0xffffu); } } } SEAM(1);
    if (IN(2)) _Pragma("unroll 1") for (int rep_ = 0; rep_ <= ((REPMASK >> 2) & 1); ++rep_) { PHASE_ARGS; pg8::Gemm g{(const pb*)(ws + WS_XN), (const pb*)(ws + WS_WINT), M, NZP, D}; pg8::StaticOrder S; S.init(M, NZP, F.G, (int)blockIdx.x);
        pg8::EpiZ E{(pb*)(ws + WS_Z)}; pg8::gemm_phase<pg8::EpiZ, pg8::StaticOrder, true, true>(F.lds, g, S, E, F.tid); } SEAM(2);
    if (IN(3)) {
#ifndef REP_SCAN
#define REP_SCAN 1
#endif
#ifndef REP_ATTN
#define REP_ATTN 1
#endif
      { int c0_, G_; { Frame F0; mk_frame(F0, ldsb, wave_s); c0_ = F0.vcu; G_ = F0.G; }
#pragma unroll 1
        for (int c = c0_; c < 256 * REP_SCAN; c += G_) { PHASE_ARGS; const int b = (c >> 4) & 15, h = (c >> 1) & 7, dir = c & 1;
            scan2_setup(F.lds, (const GAS float*)ap->in[10], (const GAS float*)ap->in[12], h, dir, F.tid); __syncthreads();
            const ScanArgs SA{(const GAS bf16*)(ws + WS_Z), (const GAS float*)ap->in[7], (const GAS float*)ap->in[8], (const GAS float*)ap->in[9], (const GAS float*)ap->in[11], (const GAS float*)ap->in[14], (const GAS float*)ap->in[15], (const GAS float*)ap->in[16],
                              (GAS bf16*)(ws + WS_XN) + (size_t)dir * M * 512, (GAS float*)(ws + WS_BONUS) + (size_t)dir * M * 8};
#pragma unroll 1
            for (int cc = F.wave; cc < T / 32; cc += 8) scan2_chunk(F.lds, SA, b, h, dir, cc, F.lane, F.wave);
            __syncthreads(); } }
      { PHASE_ARGS;
#pragma unroll 1
        for (int u = F.vcu; u < 512 * REP_ATTN; u += F.G) { attn_unit(F, ap, (u >> 5) & 15, (u >> 4) & 1, u & 15); } }
      { PHASE_ARGS;
        const bf16* Z = (const bf16*)(ws + WS_Z); bf16* SGD = (bf16*)(ws + WS_SGD); const float* mu_prev = (const float*)ap->in[7]; const float* mu_next = (const float*)ap->in[8];
          const int c = ZGD + 2 * F.lane; const float mp0 = mu_prev[c], mp1 = mu_prev[c + 1], mn0 = mu_next[c], mn1 = mu_next[c + 1];
#ifndef REP_SGD
#define REP_SGD 1
#endif
          pg8::StaticOrder S4; S4.init(M, 512, F.G, (int)blockIdx.x); pg8::Unit u4; const bool has4 = S4.next(0, u4);
          const int mt0 = (has4 ? u4.pm : 0) * 256 + F.wave * 32;
#pragma unroll 1
          for (int rp_ = 0; rp_ < REP_SGD; ++rp_)
#pragma unroll 1
          for (int m0 = mt0; m0 < mt0 + 32; m0 += 4) { unsigned z0[4], zm[4], zq[4];
#pragma unroll
              for (int i = 0; i < 4; ++i) { const int m = m0 + i, t = m & (T - 1);
                  z0[i] = *(const GAS unsigned*)(Z + (size_t)m * NZ + c); zm[i] = t > 0 ? *(const GAS unsigned*)(Z + (size_t)(m - 1) * NZ + c) : 0u; zq[i] = t < T - 1 ? *(const GAS unsigned*)(Z + (size_t)(m + 1) * NZ + c) : 0u; }
#pragma unroll
              for (int i = 0; i < 4; ++i) { const int m = m0 + i;
                  const float a0 = bflo(z0[i]), a1 = bfhi(z0[i]); const float s0 = a0 + mp0 * (bflo(zm[i]) - a0) + mn0 * (bflo(zq[i]) - a0), s1 = a1 + mp1 * (bfhi(zm[i]) - a1) + mn1 * (bfhi(zq[i]) - a1);
                  *(GAS unsigned*)(SGD + (size_t)m * 256 + 2 * F.lane) = pk2(sigm(s0), sigm(s1)); *(GAS unsigned*)(SGD + (size_t)m * 256 + 128 + 2 * F.lane) = 0u; } } }
      asm volatile("s_waitcnt vmcnt(0)" ::: "memory"); __syncthreads();
    }
    if (IN(4)) _Pragma("unroll 1") for (int rep_ = 0; rep_ <= ((REPMASK >> 4) & 1); ++rep_) { PHASE_ARGS; pg8::Gemm g{(const pb*)(ws + WS_SGD), (const pb*)(ws + WS_G2T), M, 512, 256}; pg8::StaticOrder S; S.init(M, 512, F.G, (int)blockIdx.x);
        pg8::EpiPlain E{(pb*)(ws + WS_G), 512}; pg8::gemm_phase<pg8::EpiPlain, pg8::StaticOrder, true, true>(F.lds, g, S, E, F.tid); } SEAM(4);
#ifndef REP_PG
#define REP_PG 0
#endif
    if (IN(5)) { PHASE_ARGS; if (REP_PG) pg_rows(F, ap, (bf16*)ap->out); pg_rows(F, ap, (bf16*)(ws + WS_G)); } SEAM(5);
    if (IN(6)) { PHASE_ARGS; static_assert(WS_G == WS_OATT + (size_t)M * 512 * 2 && WS_PAT == WS_PRT + (size_t)1024 * 512 * 2, "merged operand views need adjacent buffers");
        pg8::Gemm g{(const pb*)(ws + WS_OATT), (const pb*)(ws + WS_PRT), 2 * M, 2048, 512}; pg8::MergeOrder S; S.init(F.G, (int)blockIdx.x);
        pg8::EpiGate2 E{(pb*)(ws + WS_XN), (const pb*)(ws + WS_Z)}; pg8::gemm_phase<pg8::EpiGate2, pg8::MergeOrder, true, true>(F.lds, g, S, E, F.tid); } SEAM(7);
    if (IN(8)) _Pragma("unroll 1") for (int rep_ = 0; rep_ <= ((REPMASK >> 8) & 1); ++rep_) { PHASE_ARGS; pg8::Gemm g{(const pb*)(ws + WS_XN), (const pb*)(ws + WS_WOT), M, 1024, 1024}; pg8::StaticOrder S; S.init(M, 1024, F.G, (int)blockIdx.x);
        pg8::EpiRes E{(const float*)ap->in[0], (const float*)(ws + WS_MOD), (pb*)(ws + WS_X1)}; pg8::gemm_phase<pg8::EpiRes, pg8::StaticOrder, true, true>(F.lds, g, S, E, F.tid); } SEAM(8);
    if (IN(9)) _Pragma("unroll 1") for (int rep_ = 0; rep_ <= ((REPMASK >> 9) & 1); ++rep_) { PHASE_ARGS; pj_phase(F, ap); } SEAM(9);
    if (IN(10)) _Pragma("unroll 1") for (int rep_ = 0; rep_ <= ((REPMASK >> 10) & 1); ++rep_) { PHASE_ARGS; for (int p = F.vcu; p < 256; p += F.G) pk_task(F, ap, p >> 4, p & 15); } SEAM(10);
    if (IN(11)) _Pragma("unroll 1") for (int rep_ = 0; rep_ <= ((REPMASK >> 11) & 1); ++rep_) { PHASE_ARGS; pg8::Gemm g{(const pb*)(ws + WS_XN), (const pb*)((unsigned char*)ap->out + OUT_WGUT), ME, 16 * 2048, 1024}; pg8::GroupOrder<8> S{F.G, (int)blockIdx.x};
        pg8::EpiSwiglu E{(pb*)(ws + WS_H)}; pg8::gemm_phase<pg8::EpiSwiglu, pg8::GroupOrder<8>, true, true, true>(F.lds, g, S, E, F.tid, (const int*)(ws + WS_SELIDX)); } SEAM(11);
    if (IN(12)) _Pragma("unroll 1") for (int rep_ = 0; rep_ <= ((REPMASK >> 12) & 1); ++rep_) { PHASE_ARGS; pg8::Gemm g{(const pb*)(ws + WS_H), (const pb*)((unsigned char*)ap->out + OUT_WDT), ME, 16 * 1024, 1024}; pg8::GroupOrder<4> S{F.G, (int)blockIdx.x};
        pg8::EpiDown E{(pb*)(ws + WS_XE), (const float*)(ws + WS_SELAFF)}; pg8::gemm_phase<pg8::EpiDown, pg8::GroupOrder<4>, true, true>(F.lds, g, S, E, F.tid); } SEAM(12);
#ifndef EXTRA_BARS
#define EXTRA_BARS 0
#endif
#if ONE_LAUNCH
    _Pragma("unroll 1") for (int xb_ = 0; xb_ < EXTRA_BARS; ++xb_) { MKBAR; { unsigned o_ = ~0u; asm volatile("" : "+s"(o_)); xcd_barrier(bar, wave_s == 0 && __builtin_amdgcn_mbcnt_hi(o_, __builtin_amdgcn_mbcnt_lo(o_, 0u)) == 0u); } }
#endif
#ifndef REP_PN
#define REP_PN 0
#endif
    if (IN(13)) { PHASE_ARGS; if (REP_PN) pn_rows(F, ap, (float*)(ws + WS_H)); pn_rows(F, ap, ap->out); }
#undef IN
#undef SEAM
}

extern "C" void kernel_launch(void* const* d_in, const int* in_sizes, int n_in, void* d_out, int out_size, void* d_ws, size_t ws_size, hipStream_t stream) {
    static int grid = 0;
    if (grid == 0) {
        if (n_in != 30 || out_size != M * D || ws_size < WS_END) { fprintf(stderr, "kernel_launch: unexpected shapes n_in %d out %d ws %zu\n", n_in, out_size, ws_size); grid = -1; return; }
        int dev = 0, cus = 0, per_cu = 0;
        if (hipGetDevice(&dev) != hipSuccess || hipDeviceGetAttribute(&cus, hipDeviceAttributeMultiprocessorCount, dev) != hipSuccess) { grid = -1; return; }
        if (hipFuncSetAttribute((const void*)fwd_kernel, hipFuncAttributeMaxDynamicSharedMemorySize, LDS_BYTES) != hipSuccess) { fprintf(stderr, "kernel_launch: hipFuncSetAttribute failed\n"); grid = -1; return; }
        if (hipOccupancyMaxActiveBlocksPerMultiprocessor(&per_cu, (const void*)fwd_kernel, NWAVES * 64, LDS_BYTES) != hipSuccess || per_cu < 1) fprintf(stderr, "kernel_launch: occupancy query reports %d\n", per_cu);
        (void)hipGetLastError();
        grid = cus;
    }
    if (grid < 0) return;
    if (hipMemsetAsync((char*)d_ws + WS_CTL, 0, CTL_ZERO_BYTES, stream) != hipSuccess) return;
    Args a{};
    for (int i = 0; i < 30; ++i) a.in[i] = d_in[i];
    a.out = (float*)d_out; a.ws = (unsigned char*)d_ws;
#if ONE_LAUNCH
    a.ph_lo = 0; a.ph_hi = NPHASE;
    hipLaunchKernelGGL(fwd_kernel, dim3(grid), dim3(NWAVES * 64), LDS_BYTES, stream, a);
#else
    for (int p = 0; p < NPHASE; ++p) { a.ph_lo = p; a.ph_hi = p + 1; hipLaunchKernelGGL(fwd_kernel, dim3(grid), dim3(NWAVES * 64), LDS_BYTES, stream, a); }
#endif
}
```

```cpp
#include <hip/hip_runtime.h>
#include <cstdio>
#include <cstdint>
#include <cmath>
namespace pg8 {
#define PG8_LAS __attribute__((address_space(3)))
typedef unsigned short bf16_t;
typedef short bf16x8 __attribute__((ext_vector_type(8)));
typedef float f32x4 __attribute__((ext_vector_type(4)));
typedef unsigned u32x4 __attribute__((ext_vector_type(4)));
constexpr int BM = 256, BK = 64, HALF = 128, HTB = HALF * BK * 2  , STAGE_BYTES = 8 * HTB, NXCD = 8, WGM = 8;

__host__ __device__ __forceinline__ int lds_byte(int r, int c) { const int st = (r >> 4) * 2 + (c >> 5), rr = r & 15, cc = c & 31, ob = rr * 64 + cc * 2; return st * 1024 + (ob ^ (((ob >> 9) & 1) << 5)); }
__host__ __device__ __forceinline__ void stage_rc(int b, int& R, int& C) { const int st = b / 1024, sb = b % 1024, swz = sb ^ (((sb >> 9) & 1) << 5); R = (st >> 1) * 16 + swz / 64; C = (st & 1) * 32 + (swz % 64) / 2; }
__host__ __device__ __forceinline__ int perm32(int rho) { const int n = rho >> 4, i = rho & 15; return 8 * (i >> 2) + 4 * n + (i & 3); }

struct Unit { int pm, pn; };
struct Gemm { const bf16_t* A; const bf16_t* Bt; int M, N, K; };

struct StaticOrder {
    int nM, nN, nwg, G, c;
    __host__ __device__ void init(int M, int N, int G_, int c_) { nM = M / BM; nN = N / BM; nwg = nM * nN; G = G_; c = c_; }
    __host__ __device__ bool next(int i, Unit& u) const {
        const long L = (long)i * G + c; if (L >= nwg) return false;
        int wgid = (int)L; { const int q = nwg / NXCD, r = nwg % NXCD, xcd = wgid % NXCD, off = wgid / NXCD; wgid = (xcd < r ? xcd * (q + 1) : r * (q + 1) + (xcd - r) * q) + off; }
        const int nig = WGM * nN, gid = wgid / nig, fm = gid * WGM, gsz = (nM - fm) < WGM ? (nM - fm) : WGM;
        u.pm = fm + ((wgid % nig) % gsz); u.pn = (wgid % nig) / gsz; return true;
    }
    __device__ __forceinline__ void a_ready(const Unit&) const {}
    __device__ __forceinline__ void done(const Unit&) const {}
};

__device__ __forceinline__ unsigned cvt_pk_bf16(float lo, float hi) { unsigned r; asm volatile("v_cvt_pk_bf16_f32 %0, %1, %2" : "=v"(r) : "v"(lo), "v"(hi)); return r; }
typedef float f32x2 __attribute__((ext_vector_type(2)));
template <class Epi, class Sched, bool ALIGN_EPI = false, bool SP2 = false, bool GATHER = false>
__device__ __forceinline__ void gemm_phase(PG8_LAS unsigned char* lds, const Gemm g, const Sched& S, const Epi& E, int tid_in, const int* gidx = nullptr) {
    static_assert(!GATHER || SP2, "the gather variant is written for the SP2 loop");
    int tid_ = tid_in; asm volatile("" : "+v"(tid_));
    const int tid = tid_, wid = __builtin_amdgcn_readfirstlane(tid >> 6), lane = tid & 63, wr = wid >> 2, wc = wid & 3, fr = lane & 15, fq = lane >> 4;
    const int K = g.K, nt = K / BK;
    unsigned voffA[2], voffB[2];
#pragma unroll
    for (int i = 0; i < 2; ++i) { int R, C; stage_rc(tid * 16 + i * 8192, R, C); const int Rb = Epi::PERM ? ((R & ~31) + perm32(R & 31)) : R;
        voffA[i] = (unsigned)(R * K + C) * 2u; voffB[i] = (unsigned)(Rb * K + C) * 2u; }
    int gRA[2] = {0, 0}; unsigned gCA[2] = {0u, 0u}; unsigned gc[2][2] = {{0u, 0u}, {0u, 0u}}, gn[2][2] = {{0u, 0u}, {0u, 0u}};
    if constexpr (GATHER) {
#pragma unroll
        for (int i = 0; i < 2; ++i) { int R, C; stage_rc(tid * 16 + i * 8192, R, C); gRA[i] = R; gCA[i] = (unsigned)C * 2u; } }
#define PG8_GLOAD(dst, un) do { _Pragma("unroll") for (int h_ = 0; h_ < 2; ++h_) _Pragma("unroll") for (int i_ = 0; i_ < 2; ++i_) \
        dst[h_][i_] = (unsigned)gidx[(un).pm * 256 + h_ * 128 + gRA[i_]] * (unsigned)(K * 2) + gCA[i_]; } while (0)
#define PG8_STAGE_G(bufoff, gbase, nx, h) do { unsigned vo_[2] = {(nx) ? gn[h][0] : gc[h][0], (nx) ? gn[h][1] : gc[h][1]}; PG8_STAGE(bufoff, gbase, vo_); } while (0)
    const size_t kstep = (size_t)(BK * 2);
    const size_t hstep = (size_t)HALF * K * 2;
    const size_t tstep = 2 * hstep;
    const unsigned ldsw = (unsigned)wid * 1024u;
    const int aoff = lds_byte(wr * 64 + fr, fq * 8), boff = lds_byte(wc * 32 + fr, fq * 8);
#define PG8_SA(b, h) (((b) * 2 + (h)) * HTB)
#define PG8_SB(b, h) ((4 + (b) * 2 + (h)) * HTB)
#define PG8_STAGE(bufoff, gbase, voff) do { _Pragma("unroll") for (int _i = 0; _i < 2; ++_i) \
        __builtin_amdgcn_global_load_lds((const unsigned*)((const char*)(gbase) + (voff)[_i]), (PG8_LAS unsigned*)(lds + (bufoff) + ldsw + _i * 8192), 16, 0, 0); } while (0)
#define PG8_LDA(dst, b, h) do { _Pragma("unroll") for (int m = 0; m < 4; ++m) _Pragma("unroll") for (int k = 0; k < 2; ++k) dst[m][k] = *(const PG8_LAS bf16x8*)(lds + PG8_SA(b, h) + aoff + m * 2048 + k * 1024); } while (0)
#define PG8_LDB(dst, b, h) do { _Pragma("unroll") for (int n = 0; n < 2; ++n) _Pragma("unroll") for (int k = 0; k < 2; ++k) dst[n][k] = *(const PG8_LAS bf16x8*)(lds + PG8_SB(b, h) + boff + n * 2048 + k * 1024); } while (0)
#define PG8_MMA(ai, bj, At, Bt) do { __builtin_amdgcn_s_setprio(1); _Pragma("unroll") for (int m = 0; m < 4; ++m) _Pragma("unroll") for (int n = 0; n < 2; ++n) _Pragma("unroll") for (int k = 0; k < 2; ++k) \
        acc[ai][bj][m][n] = __builtin_amdgcn_mfma_f32_16x16x32_bf16(Bt[n][k], At[m][k], acc[ai][bj][m][n], 0, 0, 0); __builtin_amdgcn_s_setprio(0); } while (0)
#define PG8_WAIT_V(n) asm volatile("s_waitcnt vmcnt(" #n ")" ::: "memory")
#define PG8_WAIT_L(n) asm volatile("s_waitcnt lgkmcnt(" #n ")" ::: "memory")
#define PG8_BAR __builtin_amdgcn_s_barrier()
#define PG8_SCHED __builtin_amdgcn_sched_barrier(0)
    Unit cur, nxt; int ui = 0;
    if (!S.next(0, cur)) return;
    f32x4 acc[2][2][4][2];
#pragma unroll
    for (int a = 0; a < 2; ++a)
#pragma unroll
        for (int b = 0; b < 2; ++b)
#pragma unroll
            for (int m = 0; m < 4; ++m)
#pragma unroll
                for (int n = 0; n < 2; ++n) acc[a][b][m][n] = (f32x4){0.f, 0.f, 0.f, 0.f};
    bf16x8 At[4][2], B0[2][2], B1[2][2];
    const char* cA = GATHER ? (const char*)g.A : (const char*)g.A + (size_t)cur.pm * tstep; const char* cB = (const char*)g.Bt + (size_t)cur.pn * tstep;
    if constexpr (GATHER) { PG8_GLOAD(gc, cur); Unit n1_; if (S.next(1, n1_)) PG8_GLOAD(gn, n1_); else { gn[0][0] = gc[0][0]; gn[0][1] = gc[0][1]; gn[1][0] = gc[1][0]; gn[1][1] = gc[1][1]; } }
    S.a_ready(cur);
    if constexpr (SP2) {
        PG8_STAGE(PG8_SB(0, 0), cB, voffB); PG8_STAGE(PG8_SB(0, 1), cB + hstep, voffB);
        if constexpr (GATHER) { PG8_STAGE_G(PG8_SA(0, 0), cA, false, 0); PG8_STAGE_G(PG8_SA(0, 1), cA, false, 1); } else { PG8_STAGE(PG8_SA(0, 0), cA, voffA); PG8_STAGE(PG8_SA(0, 1), cA + hstep, voffA); }
        if (wr == 1) PG8_BAR;
        PG8_WAIT_V(2); PG8_BAR;
        PG8_STAGE(PG8_SB(1, 0), cB + kstep, voffB); if constexpr (GATHER) PG8_STAGE_G(PG8_SA(1, 0), cA + kstep, false, 0); else PG8_STAGE(PG8_SA(1, 0), cA + kstep, voffA); PG8_STAGE(PG8_SB(1, 1), cB + hstep + kstep, voffB);
        PG8_WAIT_V(6); PG8_BAR;
    } else {
        PG8_STAGE(PG8_SB(0, 0), cB, voffB); PG8_STAGE(PG8_SA(0, 0), cA, voffA); PG8_STAGE(PG8_SB(0, 1), cB + hstep, voffB); PG8_STAGE(PG8_SA(0, 1), cA + hstep, voffA);
        if (wr == 1) PG8_BAR;
        PG8_WAIT_V(4); PG8_BAR;
        PG8_STAGE(PG8_SB(1, 0), cB + kstep, voffB); PG8_STAGE(PG8_SA(1, 0), cA + kstep, voffA); PG8_STAGE(PG8_SB(1, 1), cB + hstep + kstep, voffB);
        PG8_WAIT_V(6); PG8_BAR;
    }
    for (;;) {
        const bool has_next = S.next(ui + 1, nxt);
        if constexpr (GATHER) { if (!has_next) { gn[0][0] = gc[0][0]; gn[0][1] = gc[0][1]; gn[1][0] = gc[1][0]; gn[1][1] = gc[1][1]; } }
        const char* nA = (has_next && !GATHER) ? (const char*)g.A + (size_t)nxt.pm * tstep : cA; const char* nB = has_next ? (const char*)g.Bt + (size_t)nxt.pn * tstep : cB;
        for (int t = 0; t < nt; t += 2) {
            const bool last = (t == nt - 2);
            const char* a1 = cA + (size_t)(t + 1) * kstep;
            const char* a2 = last ? nA : cA + (size_t)(t + 2) * kstep; const char* b2 = last ? nB : cB + (size_t)(t + 2) * kstep;
            const char* a3 = a2 + kstep; const char* b3 = b2 + kstep;
            if (last && has_next) S.a_ready(nxt);
            if constexpr (SP2) {
            PG8_LDB(B0, 0, 0); PG8_LDB(B1, 0, 1); PG8_SCHED; PG8_LDA(At, 0, 0); if constexpr (GATHER) PG8_STAGE_G(PG8_SA(1, 1), a1, false, 1); else PG8_STAGE(PG8_SA(1, 1), a1 + hstep, voffA);
            PG8_WAIT_V(8); PG8_WAIT_L(0); PG8_BAR; PG8_MMA(0, 0, At, B0); PG8_MMA(0, 1, At, B1); PG8_BAR; PG8_SCHED;
            PG8_LDA(At, 0, 1); PG8_STAGE(PG8_SB(0, 0), b2, voffB); PG8_STAGE(PG8_SB(0, 1), b2 + hstep, voffB); if constexpr (GATHER) PG8_STAGE_G(PG8_SA(0, 0), a2, last, 0); else PG8_STAGE(PG8_SA(0, 0), a2, voffA);
            PG8_WAIT_V(8); PG8_WAIT_L(0); PG8_BAR; PG8_MMA(1, 0, At, B0); PG8_MMA(1, 1, At, B1); PG8_BAR; PG8_SCHED;
            PG8_LDB(B0, 1, 0); PG8_LDB(B1, 1, 1); PG8_SCHED; PG8_LDA(At, 1, 0); if constexpr (GATHER) PG8_STAGE_G(PG8_SA(0, 1), a2, last, 1); else PG8_STAGE(PG8_SA(0, 1), a2 + hstep, voffA);
            PG8_WAIT_V(8); PG8_WAIT_L(0); PG8_BAR; PG8_MMA(0, 0, At, B0); PG8_MMA(0, 1, At, B1); PG8_BAR; PG8_SCHED;
            PG8_LDA(At, 1, 1); PG8_STAGE(PG8_SB(1, 0), b3, voffB); PG8_STAGE(PG8_SB(1, 1), b3 + hstep, voffB); if constexpr (GATHER) PG8_STAGE_G(PG8_SA(1, 0), a3, last, 0); else PG8_STAGE(PG8_SA(1, 0), a3, voffA);
            PG8_WAIT_V(8); PG8_WAIT_L(0); PG8_BAR; PG8_MMA(1, 0, At, B0); PG8_MMA(1, 1, At, B1); PG8_BAR; PG8_SCHED;
            } else {
            PG8_LDB(B0, 0, 0); PG8_SCHED; PG8_LDA(At, 0, 0); PG8_STAGE(PG8_SA(1, 1), a1 + hstep, voffA);
            PG8_WAIT_L(8); PG8_BAR; PG8_WAIT_L(0); PG8_MMA(0, 0, At, B0); PG8_BAR; PG8_SCHED;
            PG8_LDB(B1, 0, 1); PG8_STAGE(PG8_SB(0, 0), b2, voffB);
            PG8_BAR; PG8_WAIT_L(0); PG8_MMA(0, 1, At, B1); PG8_BAR;
            PG8_LDA(At, 0, 1); PG8_STAGE(PG8_SA(0, 0), a2, voffA);
            PG8_BAR; PG8_WAIT_L(0); PG8_MMA(1, 0, At, B0); PG8_BAR; PG8_SCHED;
            PG8_STAGE(PG8_SB(0, 1), b2 + hstep, voffB);
            PG8_WAIT_V(6); PG8_BAR; PG8_MMA(1, 1, At, B1); PG8_BAR;
            PG8_LDB(B0, 1, 0); PG8_SCHED; PG8_LDA(At, 1, 0); PG8_STAGE(PG8_SA(0, 1), a2 + hstep, voffA);
            PG8_WAIT_L(8); PG8_BAR; PG8_WAIT_L(0); PG8_MMA(0, 0, At, B0); PG8_BAR; PG8_SCHED;
            PG8_LDB(B1, 1, 1); PG8_STAGE(PG8_SB(1, 0), b3, voffB);
            PG8_BAR; PG8_WAIT_L(0); PG8_MMA(0, 1, At, B1); PG8_BAR;
            PG8_LDA(At, 1, 1); PG8_STAGE(PG8_SA(1, 0), a3, voffA);
            PG8_BAR; PG8_WAIT_L(0); PG8_MMA(1, 0, At, B0); PG8_BAR; PG8_SCHED;
            PG8_STAGE(PG8_SB(1, 1), b3 + hstep, voffB);
            PG8_WAIT_V(6); PG8_BAR; PG8_MMA(1, 1, At, B1); PG8_BAR;
            }
        }
        if constexpr (ALIGN_EPI) { if (wr == 0) PG8_BAR; }
        if constexpr (!Epi::AFTER_DRAIN) { E(acc, cur, wr, wc, fr, fq); S.done(cur); }
        unsigned g2_[2][2] = {{0u, 0u}, {0u, 0u}};
        if constexpr (GATHER) { Unit nn_; if (has_next && S.next(ui + 2, nn_)) PG8_GLOAD(g2_, nn_); else { g2_[0][0] = gn[0][0]; g2_[0][1] = gn[0][1]; g2_[1][0] = gn[1][0]; g2_[1][1] = gn[1][1]; } }
        if (!has_next) break;
#pragma unroll
        for (int a = 0; a < 2; ++a)
#pragma unroll
            for (int b = 0; b < 2; ++b)
#pragma unroll
                for (int m = 0; m < 4; ++m)
#pragma unroll
                    for (int n = 0; n < 2; ++n) acc[a][b][m][n] = (f32x4){0.f, 0.f, 0.f, 0.f};
        cur = nxt; cA = nA; cB = nB; ++ui;
        if constexpr (GATHER) { gc[0][0] = gn[0][0]; gc[0][1] = gn[0][1]; gc[1][0] = gn[1][0]; gc[1][1] = gn[1][1]; gn[0][0] = g2_[0][0]; gn[0][1] = g2_[0][1]; gn[1][0] = g2_[1][0]; gn[1][1] = g2_[1][1]; }
        if constexpr (ALIGN_EPI) { if (wr == 1) PG8_BAR; }
    }
    PG8_WAIT_V(0);
    if constexpr (!ALIGN_EPI) { if (wr == 0) PG8_BAR; }
    PG8_BAR;
    if constexpr (Epi::AFTER_DRAIN) { E.fused(acc, cur, wr, wc, fr, fq, lds, wid, lane); S.done(cur); }
#undef PG8_SA
#undef PG8_SB
#undef PG8_STAGE
#undef PG8_STAGE_G
#undef PG8_GLOAD
#undef PG8_LDA
#undef PG8_LDB
#undef PG8_MMA
#undef PG8_WAIT_V
#undef PG8_WAIT_L
#undef PG8_BAR
#undef PG8_SCHED
}
}

#ifndef ONE_LAUNCH
#define ONE_LAUNCH 1
#endif
constexpr int NB = 16, T = 2048, D = 1024, M = NB * T;
constexpr int NZ = 4736, NZP = 4864;
constexpr int RW = 512, NE = 16, CAP = 256, ME = NE * NB * CAP;
constexpr int ZR = 0, ZK = 512, ZV = 1024, ZWD = 1536, ZAD = 1664, ZGD = 1792, ZQ = 1920, ZKA = 2432, ZVA = 2560, ZGA = 2688, ZGB = 3712;
constexpr int NWAVES = 8, NPHASE = 14;
constexpr size_t MiB = 1u << 20;
constexpr size_t WS_CTL = 0, CTL_ZERO_BYTES = 64 * 1024 + 16 * 6144 * 4;
constexpr size_t WS_MOD = 64 * 1024, WS_BONUS = 2 * MiB, WS_AFF = 4 * MiB, WS_SELAFF = 6 * MiB, WS_SLOT = 7 * MiB, WS_G2T = 9 * MiB;
constexpr size_t WS_WINT = 10 * MiB, WS_PRT = 20 * MiB, WS_PAT = 21 * MiB, WS_WOT = 22 * MiB, WS_SGD = 24 * MiB;
constexpr size_t WS_XN = 40 * MiB;
constexpr size_t WS_OATT = 104 * MiB;
constexpr size_t WS_G = 136 * MiB;
constexpr size_t WS_Z = 168 * MiB;
constexpr size_t WS_X1 = 104 * MiB;
constexpr size_t OUT_WGUT = 0;
constexpr size_t OUT_WDT = 64 * MiB;
constexpr size_t WS_XE = 200 * MiB;
constexpr size_t WS_H = 328 * MiB;
constexpr size_t WS_END = 464 * MiB;
constexpr size_t WS_ROPE = WS_AFF;
constexpr size_t WS_SELIDX = WS_SELAFF + 512 * 1024;
constexpr int CW_BAR = 4096;
constexpr int RING_BYTES = 131072, LDSCTL_OFF = RING_BYTES, MISC_OFF = LDSCTL_OFF + 320, LDS_BYTES = 147456;

#define GAS __attribute__((address_space(1)))
#define LAS __attribute__((address_space(3)))
typedef unsigned short bf16;
typedef unsigned v4u __attribute__((ext_vector_type(4)));
typedef float f32x4 __attribute__((ext_vector_type(4)));
typedef short bf16x8 __attribute__((ext_vector_type(8)));
typedef GAS unsigned gu32;
typedef GAS unsigned long long gu64;
#define RLX_AGENT __ATOMIC_RELAXED, __HIP_MEMORY_SCOPE_AGENT
#define LDS_WAIT() asm volatile("s_waitcnt lgkmcnt(0)" ::: "memory")
#define VM_WAIT() asm volatile("s_waitcnt vmcnt(0)" ::: "memory")
__device__ __forceinline__ unsigned long long rt() { return __builtin_amdgcn_s_memrealtime(); }
__device__ __forceinline__ unsigned f2bf(float f) { unsigned u = __builtin_bit_cast(unsigned, f); return (u + 0x7fffu + ((u >> 16) & 1u)) >> 16; }
typedef float f32x2hw __attribute__((ext_vector_type(2))); typedef __bf16 bf16x2hw __attribute__((ext_vector_type(2)));
__device__ __forceinline__ unsigned pk2(float lo, float hi) { f32x2hw v = {lo, hi}; bf16x2hw b = __builtin_convertvector(v, bf16x2hw); return __builtin_bit_cast(unsigned, b); }

#define XB_TMO      128
#define XB_XCNT(j)  (256  + 64 * (j))
#define XB_XSUB(j)  (1280 + 64 * (j))
#define XB_XGEN(j)  (2304 + 64 * (j))
#define XB_TOP      3328
#define XB_TOPGEN   3392
#define XCD_BAR_WORDS 3456
#define XB_SPIN_CAP (1u << 18)

__device__ __forceinline__ unsigned xb_ld(unsigned* p)              { return __hip_atomic_load(p, __ATOMIC_RELAXED, __HIP_MEMORY_SCOPE_AGENT); }
__device__ __forceinline__ unsigned xb_add(unsigned* p, unsigned v) { return __hip_atomic_fetch_add(p, v, __ATOMIC_RELAXED, __HIP_MEMORY_SCOPE_AGENT); }
__device__ __forceinline__ unsigned xb_xcc_id() { return (unsigned)__builtin_amdgcn_s_getreg((3 << 11) | 20) & 0xFu; }
#define XB_SPIN(cond, bar) do { unsigned _sp = 0; while (cond) { __builtin_amdgcn_s_sleep(1); \
    if ((++_sp & 255u) == 0u) { if (xb_ld(&(bar)[XB_TMO])) break; if (_sp > XB_SPIN_CAP) { atomicAdd(&(bar)[XB_TMO], 1u); break; } } } } while (0)

struct XcdBarrier {
    unsigned* bar; unsigned x;
    volatile LAS unsigned* st;
};

__device__ __forceinline__ XcdBarrier xcd_barrier_post(unsigned* bar, volatile LAS unsigned* st) {
    XcdBarrier b; b.bar = bar; b.x = xb_xcc_id(); b.st = st;
    if (threadIdx.x == 0) (void)xb_add(&bar[XB_XCNT(b.x)], 1u);
    return b;
}
__device__ __forceinline__ void xcd_barrier_complete(unsigned* bar, unsigned x, unsigned& nloc, unsigned& nx) {
    const unsigned G = gridDim.x * gridDim.y * gridDim.z;
    unsigned sum, cnt, mine, sp = 0u;
    for (;;) {
        sum = 0u; cnt = 0u; mine = 0u;
#pragma unroll
        for (unsigned j = 0; j < 16; ++j) { const unsigned c = xb_ld(&bar[XB_XCNT(j)]); sum += c; cnt += (c > 0u) ? 1u : 0u; mine = (j == x) ? c : mine; }
        if (sum == G) break;
        __builtin_amdgcn_s_sleep(1);
        if ((++sp & 255u) == 0u) { if (xb_ld(&bar[XB_TMO])) break; if (sp > XB_SPIN_CAP) { atomicAdd(&bar[XB_TMO], 1u); break; } }
    }
    nloc = mine > 0u ? mine : 1u; nx = cnt > 0u ? cnt : 1u;
}

__device__ __forceinline__ void xcd_barrier(const XcdBarrier& b, bool is_thread0) {
    asm volatile("s_waitcnt vmcnt(0)" ::: "memory");
    __syncthreads();
    if (is_thread0) {
        unsigned* bar = b.bar;
        __builtin_amdgcn_s_waitcnt(0);
        unsigned nloc = b.st[0], nx = b.st[1];
        if (nloc == 0u) { xcd_barrier_complete(bar, b.x, nloc, nx); b.st[0] = nloc; b.st[1] = nx; }
        const unsigned old = xb_add(&bar[XB_XSUB(b.x)], 1u);
        const unsigned gen = old / nloc;
        if (old + 1u == (gen + 1u) * nloc) {
            __builtin_amdgcn_fence(__ATOMIC_RELEASE, "agent");
            asm volatile("s_waitcnt vmcnt(0)" ::: "memory");
            const unsigned og = xb_add(&bar[XB_TOP], 1u);
            const unsigned tg = og / nx;
            if (og + 1u == (tg + 1u) * nx) xb_add(&bar[XB_TOPGEN], 1u);
            else XB_SPIN(xb_ld(&bar[XB_TOPGEN]) == tg, bar);
            __builtin_amdgcn_fence(__ATOMIC_ACQUIRE, "agent");
            xb_add(&bar[XB_XGEN(b.x)], 1u);
            asm volatile("s_waitcnt vmcnt(0)" ::: "memory");
        } else {
            XB_SPIN(xb_ld(&bar[XB_XGEN(b.x)]) == gen, bar);
            __builtin_amdgcn_fence(__ATOMIC_ACQUIRE, "agent");
            asm volatile("s_waitcnt vmcnt(0)" ::: "memory");
        }
    }
    __syncthreads();
}
namespace pg8 {
__device__ __forceinline__ float bf2f(unsigned short h) { return __uint_as_float(((unsigned)h) << 16); }
__device__ __forceinline__ float bflo(unsigned w) { return __uint_as_float(w << 16); }
__device__ __forceinline__ float bfhi(unsigned w) { return __uint_as_float(w & 0xffff0000u); }
__device__ __forceinline__ float sigm(float x) { return 1.0f / (1.0f + __expf(-x)); }
struct EpiZ { static constexpr bool PERM = true, AFTER_DRAIN = false; bf16_t* O;
    __device__ __forceinline__ void operator()(const f32x4 (&acc)[2][2][4][2], const Unit& u, int wr, int wc, int fr, int fq) const {
        const int row0 = u.pm * BM + wr * 64 + fr, col0 = u.pn * BM + wc * 32 + 8 * fq;
#pragma unroll
        for (int ai = 0; ai < 2; ++ai)
#pragma unroll
            for (int m = 0; m < 4; ++m) { bf16_t* rowp = O + (size_t)(row0 + ai * HALF + m * 16) * 4736 + col0;
#pragma unroll
                for (int bj = 0; bj < 2; ++bj) { if (u.pn * BM + bj * HALF < 4736) { const f32x4 v0 = acc[ai][bj][m][0], v1 = acc[ai][bj][m][1];
                    u32x4 w; w.x = cvt_pk_bf16(v0[0], v0[1]); w.y = cvt_pk_bf16(v0[2], v0[3]); w.z = cvt_pk_bf16(v1[0], v1[1]); w.w = cvt_pk_bf16(v1[2], v1[3]);
                    *(u32x4*)(rowp + bj * HALF) = w; } } }
    }
};
struct EpiPlain { static constexpr bool PERM = true, AFTER_DRAIN = false; bf16_t* O; int ldc;
    __device__ __forceinline__ void operator()(const f32x4 (&acc)[2][2][4][2], const Unit& u, int wr, int wc, int fr, int fq) const {
        const int row0 = u.pm * BM + wr * 64 + fr, col0 = u.pn * BM + wc * 32 + 8 * fq;
#pragma unroll
        for (int ai = 0; ai < 2; ++ai)
#pragma unroll
            for (int m = 0; m < 4; ++m) { bf16_t* rowp = O + (size_t)(row0 + ai * HALF + m * 16) * ldc + col0;
#pragma unroll
                for (int bj = 0; bj < 2; ++bj) { const f32x4 v0 = acc[ai][bj][m][0], v1 = acc[ai][bj][m][1];
                    u32x4 w; w.x = cvt_pk_bf16(v0[0], v0[1]); w.y = cvt_pk_bf16(v0[2], v0[3]); w.z = cvt_pk_bf16(v1[0], v1[1]); w.w = cvt_pk_bf16(v1[2], v1[3]);
                    *(u32x4*)(rowp + bj * HALF) = w; } }
    }
};
template <bool ADD> struct EpiGate { static constexpr bool PERM = true, AFTER_DRAIN = false; bf16_t* O; const bf16_t* Z; int zc0;
    __device__ __forceinline__ void operator()(const f32x4 (&acc)[2][2][4][2], const Unit& u, int wr, int wc, int fr, int fq) const {
        const int row0 = u.pm * BM + wr * 64 + fr, col0 = u.pn * BM + wc * 32 + 8 * fq;
#pragma unroll
        for (int ai = 0; ai < 2; ++ai)
#pragma unroll
            for (int m = 0; m < 4; ++m) { const size_t row = (size_t)(row0 + ai * HALF + m * 16); bf16_t* rowp = O + row * 1024 + col0; const bf16_t* zp = Z + row * 4736 + zc0 + col0;
#pragma unroll
                for (int bj = 0; bj < 2; ++bj) { const f32x4 v0 = acc[ai][bj][m][0], v1 = acc[ai][bj][m][1];
                    const u32x4 zg = *(const u32x4*)(zp + bj * HALF);
                    float r0 = sigm(bflo(zg.x)) * v0[0], r1 = sigm(bfhi(zg.x)) * v0[1], r2 = sigm(bflo(zg.y)) * v0[2], r3 = sigm(bfhi(zg.y)) * v0[3];
                    float r4 = sigm(bflo(zg.z)) * v1[0], r5 = sigm(bfhi(zg.z)) * v1[1], r6 = sigm(bflo(zg.w)) * v1[2], r7 = sigm(bfhi(zg.w)) * v1[3];
                    if (ADD) { const u32x4 p = *(const u32x4*)(rowp + bj * HALF);
                        r0 += bflo(p.x); r1 += bfhi(p.x); r2 += bflo(p.y); r3 += bfhi(p.y); r4 += bflo(p.z); r5 += bfhi(p.z); r6 += bflo(p.w); r7 += bfhi(p.w); }
                    u32x4 w; w.x = cvt_pk_bf16(r0, r1); w.y = cvt_pk_bf16(r2, r3); w.z = cvt_pk_bf16(r4, r5); w.w = cvt_pk_bf16(r6, r7);
                    *(u32x4*)(rowp + bj * HALF) = w; } }
    }
};
struct EpiGate2 { static constexpr bool PERM = true, AFTER_DRAIN = false; bf16_t* O; const bf16_t* Z;
    __device__ __forceinline__ void operator()(const f32x4 (&acc)[2][2][4][2], const Unit& u, int wr, int wc, int fr, int fq) const {
        const bool add = u.pm < 128; const int zc0 = add ? 3712 : 2688;
        const int row0 = (u.pm & 127) * BM + wr * 64 + fr, col0 = (u.pn & 3) * BM + wc * 32 + 8 * fq;
#pragma unroll
        for (int ai = 0; ai < 2; ++ai) {
            u32x4 zg[4][2], pv[4][2];
#pragma unroll
            for (int m = 0; m < 4; ++m) { const size_t row = (size_t)(row0 + ai * HALF + m * 16);
#pragma unroll
                for (int bj = 0; bj < 2; ++bj) { zg[m][bj] = *(const u32x4*)(Z + row * 4736 + zc0 + col0 + bj * HALF); pv[m][bj] = (u32x4){0u, 0u, 0u, 0u}; if (add) pv[m][bj] = *(const u32x4*)(O + row * 1024 + col0 + bj * HALF); } }
#pragma unroll
            for (int m = 0; m < 4; ++m) { const size_t row = (size_t)(row0 + ai * HALF + m * 16); bf16_t* rowp = O + row * 1024 + col0;
#pragma unroll
                for (int bj = 0; bj < 2; ++bj) { const f32x4 v0 = acc[ai][bj][m][0], v1 = acc[ai][bj][m][1]; const u32x4 g = zg[m][bj], p = pv[m][bj];
                    const float r0 = sigm(bflo(g.x)) * v0[0] + bflo(p.x), r1 = sigm(bfhi(g.x)) * v0[1] + bfhi(p.x), r2 = sigm(bflo(g.y)) * v0[2] + bflo(p.y), r3 = sigm(bfhi(g.y)) * v0[3] + bfhi(p.y);
                    const float r4 = sigm(bflo(g.z)) * v1[0] + bflo(p.z), r5 = sigm(bfhi(g.z)) * v1[1] + bfhi(p.z), r6 = sigm(bflo(g.w)) * v1[2] + bflo(p.w), r7 = sigm(bfhi(g.w)) * v1[3] + bfhi(p.w);
                    u32x4 w; w.x = cvt_pk_bf16(r0, r1); w.y = cvt_pk_bf16(r2, r3); w.z = cvt_pk_bf16(r4, r5); w.w = cvt_pk_bf16(r6, r7);
                    *(u32x4*)(rowp + bj * HALF) = w; } } }
    }
};
struct MergeOrder { StaticOrder S; int nu;
    __device__ __forceinline__ void init(int G, int c) { S.init(32768, 1024, G, c); nu = (512 - c + G - 1) / G; }
    __device__ __forceinline__ bool next(int i, Unit& u) const { if (i >= 2 * nu) return false; Unit t; S.next(i < nu ? i : i - nu, t);
        if (i < nu) { u.pm = 128 + t.pm; u.pn = t.pn; } else { u.pm = t.pm; u.pn = 4 + t.pn; } return true; }
    __device__ __forceinline__ void a_ready(const Unit&) const {}
    __device__ __forceinline__ void done(const Unit&) const {}
};
struct EpiRes { static constexpr bool PERM = true, AFTER_DRAIN = false; const float* X; const float* mod; bf16_t* O;
    __device__ __forceinline__ void operator()(const f32x4 (&acc)[2][2][4][2], const Unit& u, int wr, int wc, int fr, int fq) const {
        const int row0 = u.pm * BM + wr * 64 + fr, col0 = u.pn * BM + wc * 32 + 8 * fq; const int b = (u.pm * BM) >> 11;
        f32x4 gt[2][2];
#pragma unroll
        for (int bj = 0; bj < 2; ++bj)
#pragma unroll
            for (int n = 0; n < 2; ++n) gt[bj][n] = *(const f32x4*)(mod + (size_t)b * 6144 + 2048 + col0 + bj * HALF + n * 4);
#pragma unroll
        for (int ai = 0; ai < 2; ++ai) { f32x4 xv[4][2][2];
#pragma unroll
            for (int m = 0; m < 4; ++m) { const size_t off = (size_t)(row0 + ai * HALF + m * 16) * 1024 + col0;
#pragma unroll
                for (int bj = 0; bj < 2; ++bj) { xv[m][bj][0] = *(const f32x4*)(X + off + bj * HALF); xv[m][bj][1] = *(const f32x4*)(X + off + bj * HALF + 4); } }
#pragma unroll
            for (int m = 0; m < 4; ++m) { const size_t off = (size_t)(row0 + ai * HALF + m * 16) * 1024 + col0;
#pragma unroll
                for (int bj = 0; bj < 2; ++bj) { const f32x4 v0 = xv[m][bj][0] + gt[bj][0] * acc[ai][bj][m][0], v1 = xv[m][bj][1] + gt[bj][1] * acc[ai][bj][m][1];
                    u32x4 w; w.x = cvt_pk_bf16(v0[0], v0[1]); w.y = cvt_pk_bf16(v0[2], v0[3]); w.z = cvt_pk_bf16(v1[0], v1[1]); w.w = cvt_pk_bf16(v1[2], v1[3]);
                    *(u32x4*)(O + off + bj * HALF) = w; } } }
    }
};
template <int NPL> struct GroupOrder { int G, c;
    __device__ __forceinline__ bool next(int i, Unit& u) const { const int L = i * G + c; if (L >= 256 * NPL) return false;
        const int e = L / (16 * NPL), r = L % (16 * NPL); u.pm = e * 16 + (r % 16); u.pn = e * NPL + r / 16; return true; }
    __device__ __forceinline__ void a_ready(const Unit&) const {}
    __device__ __forceinline__ void done(const Unit&) const {}
};
struct EpiSwiglu { static constexpr bool PERM = true, AFTER_DRAIN = false; bf16_t* O;
    __device__ __forceinline__ void operator()(const f32x4 (&acc)[2][2][4][2], const Unit& u, int wr, int wc, int fr, int fq) const {
        const int row0 = u.pm * BM + wr * 64 + fr, col0 = (u.pn & 7) * 128 + wc * 32 + 8 * fq;
#pragma unroll
        for (int ai = 0; ai < 2; ++ai)
#pragma unroll
            for (int m = 0; m < 4; ++m) { bf16_t* rowp = O + (size_t)(row0 + ai * HALF + m * 16) * 1024 + col0;
                float r[8];
#pragma unroll
                for (int n = 0; n < 2; ++n)
#pragma unroll
                    for (int i = 0; i < 4; ++i) { const float g = acc[ai][0][m][n][i], up = acc[ai][1][m][n][i]; r[n * 4 + i] = g * sigm(g) * up; }
                u32x4 w; w.x = cvt_pk_bf16(r[0], r[1]); w.y = cvt_pk_bf16(r[2], r[3]); w.z = cvt_pk_bf16(r[4], r[5]); w.w = cvt_pk_bf16(r[6], r[7]);
                *(u32x4*)rowp = w; }
    }
};
struct EpiDown { static constexpr bool PERM = true, AFTER_DRAIN = false; bf16_t* O; const float* aff;
    __device__ __forceinline__ void operator()(const f32x4 (&acc)[2][2][4][2], const Unit& u, int wr, int wc, int fr, int fq) const {
        const int row0 = u.pm * BM + wr * 64 + fr, col0 = (u.pn & 3) * BM + wc * 32 + 8 * fq;
        float av[2][4];
#pragma unroll
        for (int ai = 0; ai < 2; ++ai)
#pragma unroll
            for (int m = 0; m < 4; ++m) av[ai][m] = aff[row0 + ai * HALF + m * 16];
#pragma unroll
        for (int ai = 0; ai < 2; ++ai)
#pragma unroll
            for (int m = 0; m < 4; ++m) { const int row = row0 + ai * HALF + m * 16; const float a = av[ai][m]; bf16_t* rowp = O + (size_t)row * 1024 + col0;
#pragma unroll
                for (int bj = 0; bj < 2; ++bj) { const f32x4 v0 = acc[ai][bj][m][0] * a, v1 = acc[ai][bj][m][1] * a;
                    u32x4 w; w.x = cvt_pk_bf16(v0[0], v0[1]); w.y = cvt_pk_bf16(v0[2], v0[3]); w.z = cvt_pk_bf16(v1[0], v1[1]); w.w = cvt_pk_bf16(v1[2], v1[3]);
                    *(u32x4*)(rowp + bj * HALF) = w; } }
    }
};
}

struct Frame { LAS unsigned char* lds; volatile LAS unsigned* MISC; gu32* ctl; int tid, lane, wave, vcu, G; };
struct Args { const void* in[30]; float* out; unsigned char* ws; int ph_lo, ph_hi; };
typedef const __attribute__((address_space(4))) Args* ArgsP;
#define LAUNDER(p) asm volatile("" : "+s"(p))
typedef float f32x16 __attribute__((ext_vector_type(16)));
typedef unsigned u32x2 __attribute__((ext_vector_type(2)));

__device__ __forceinline__ float wave_sum(float v) {
#pragma unroll
    for (int o = 1; o < 64; o <<= 1) v += __shfl_xor(v, o);
    return v;
}
__device__ __forceinline__ float bf2f(bf16 h) { return __uint_as_float(((unsigned)h) << 16); }
__device__ __forceinline__ float bflo(unsigned w) { return __uint_as_float(w << 16); }
__device__ __forceinline__ float bfhi(unsigned w) { return __uint_as_float(w & 0xffff0000u); }
__device__ __forceinline__ float sigm(float x) { return 1.0f / (1.0f + __expf(-x)); }

__device__ __forceinline__ void tr_item(const float* W, int N, int k0, int n0, bf16* WT, int KD, int dst_row0, LAS float* scr, int lane) {
    f32x4 v[8];
#pragma unroll
    for (int i = 0; i < 8; ++i) v[i] = *(const GAS f32x4*)(W + (size_t)(k0 + 8 * i + (lane >> 3)) * N + n0 + 4 * (lane & 7));
#pragma unroll
    for (int i = 0; i < 8; ++i) { LAS float* d = scr + (8 * i + (lane >> 3)) * 33 + 4 * (lane & 7); d[0] = v[i].x; d[1] = v[i].y; d[2] = v[i].z; d[3] = v[i].w; }
    LDS_WAIT(); asm volatile("" ::: "memory");
    const int c = lane & 7;
#pragma unroll
    for (int j = 0; j < 4; ++j) { const int n = (lane >> 3) + 8 * j; const LAS float* s = scr + (8 * c) * 33 + n;
        v4u o; o.x = pk2(s[0 * 33], s[1 * 33]); o.y = pk2(s[2 * 33], s[3 * 33]); o.z = pk2(s[4 * 33], s[5 * 33]); o.w = pk2(s[6 * 33], s[7 * 33]);
        *(GAS v4u*)(WT + (size_t)(dst_row0 + n) * KD + k0 + 8 * c) = o; }
    LDS_WAIT(); asm volatile("" ::: "memory");
}

__device__ __forceinline__ void p0_prologue(const Frame& F, ArgsP A) {
    unsigned char* ws = A->ws;
    LAS float* scr = (LAS float*)(F.lds + F.wave * 16384);
    const int gw = F.vcu * NWAVES + F.wave, NGW = F.G * NWAVES;
    const float* w_in = (const float*)A->in[6]; const float* p_rwkv = (const float*)A->in[22]; const float* p_attn = (const float*)A->in[23];
    const float* w_out = (const float*)A->in[24]; const float* g2 = (const float*)A->in[13];
    bf16* WinT = (bf16*)(ws + WS_WINT); bf16* PrT = (bf16*)(ws + WS_PRT); bf16* PaT = (bf16*)(ws + WS_PAT); bf16* WoT = (bf16*)(ws + WS_WOT); bf16* G2T = (bf16*)(ws + WS_G2T);
    constexpr int I_IN = 16 * 148, I_P = 8 * 32, I_O = 16 * 32, I_G = 2 * 16, NIT = I_IN + 2 * I_P + I_O + I_G;
    for (int it = gw; it < NIT; it += NGW) {
        int r = it;
        if (r < I_IN) { tr_item(w_in, NZ, 64 * (r / 148), 32 * (r % 148), WinT, 1024, 32 * (r % 148), scr, F.lane); continue; } r -= I_IN;
        if (r < I_P) { tr_item(p_rwkv, 1024, 64 * (r / 32), 32 * (r % 32), PrT, 512, 32 * (r % 32), scr, F.lane); continue; } r -= I_P;
        if (r < I_P) { tr_item(p_attn, 1024, 64 * (r / 32), 32 * (r % 32), PaT, 512, 32 * (r % 32), scr, F.lane); continue; } r -= I_P;
        if (r < I_O) { tr_item(w_out, 1024, 64 * (r / 32), 32 * (r % 32), WoT, 1024, 32 * (r % 32), scr, F.lane); continue; } r -= I_O;
        tr_item(g2, 512, 64 * (r / 16), 32 * (r % 16), G2T, 256, 32 * (r % 16), scr, F.lane);
    }
    { const int gt = (F.vcu * NWAVES + F.wave) * 64 + F.lane, NT = F.G * NWAVES * 64; const v4u z4 = {0u, 0u, 0u, 0u};
      for (int i = gt; i < 128 * 128; i += NT) *(GAS v4u*)(WinT + (size_t)4736 * 1024 + (size_t)i * 8) = z4;
      for (int i = gt; i < 512 * 16; i += NT) *(GAS v4u*)(G2T + (size_t)(i >> 4) * 256 + 128 + (i & 15) * 8) = z4; }
    __syncthreads();
    const float* cvec = (const float*)A->in[1]; const float* w_ada = (const float*)A->in[3]; const float* b_ada = (const float*)A->in[4];
    float* mod = (float*)(ws + WS_MOD);
    for (int task = F.vcu; task < 192; task += F.G) { const int cg = task % 96, dh = task / 96;
        LAS float* ca = (LAS float*)F.lds;
        LAS float* red = (LAS float*)(F.lds + 65536);
        for (int i = F.tid; i < 16 * 1024; i += 512) { const int b = i >> 10, d = i & 1023; const float cv = cvec[i]; ca[d * 16 + b] = cv / (1.0f + __expf(-cv)); }
        __syncthreads();
        float acc[16];
#pragma unroll
        for (int b = 0; b < 16; ++b) acc[b] = 0.f;
        const int col = cg * 64 + F.lane;
#pragma unroll 8
        for (int dd = 0; dd < 64; ++dd) { const int d = dh * 512 + F.wave * 64 + dd; const float w = w_ada[(size_t)d * 6144 + col];
            const LAS f32x4* cp = (const LAS f32x4*)(ca + d * 16);
#pragma unroll
            for (int q = 0; q < 4; ++q) { const f32x4 cv = cp[q]; acc[q * 4 + 0] += cv[0] * w; acc[q * 4 + 1] += cv[1] * w; acc[q * 4 + 2] += cv[2] * w; acc[q * 4 + 3] += cv[3] * w; } }
#pragma unroll
        for (int b = 0; b < 16; ++b) red[(F.wave * 16 + b) * 64 + F.lane] = acc[b];
        __syncthreads();
        for (int o = F.tid; o < 1024; o += 512) { const int b = o >> 6, cl = o & 63; float sacc = 0.f;
#pragma unroll
            for (int w = 0; w < 8; ++w) sacc += red[(w * 16 + b) * 64 + cl];
            atomicAdd(&mod[b * 6144 + cg * 64 + cl], sacc + (dh == 0 ? b_ada[cg * 64 + cl] : 0.f)); }
        __syncthreads();
    }
}


__device__ __forceinline__ float dpp_wave_sum(float v) {
    v += __int_as_float(__builtin_amdgcn_update_dpp(0, __float_as_int(v), 0xB1, 0xf, 0xf, false));
    v += __int_as_float(__builtin_amdgcn_update_dpp(0, __float_as_int(v), 0x4E, 0xf, 0xf, false));
    v += __int_as_float(__builtin_amdgcn_update_dpp(0, __float_as_int(v), 0x141, 0xf, 0xf, false));
    v += __int_as_float(__builtin_amdgcn_update_dpp(0, __float_as_int(v), 0x140, 0xf, 0xf, false));
    v += __int_as_float(__builtin_amdgcn_ds_swizzle(__float_as_int(v), 0x401F));
    auto r_ = __builtin_amdgcn_permlane32_swap(__float_as_uint(v), __float_as_uint(v), false, false);
    return __uint_as_float(r_[0]) + __uint_as_float(r_[1]); }

template <int R, bool XBF> __device__ __forceinline__ void modnorm_rows(const void* x, int m0, int mstride, const float* g, const float* mod, int sh_off, int sc_off, bf16* out, int lane, f32x4 (&u)[R][4]) {
    f32x4 v[R][4];
#pragma unroll
    for (int i = 0; i < R; ++i) {
        if (XBF) { const GAS u32x2* xr = (const GAS u32x2*)((const bf16*)x + (size_t)(m0 + i * mstride) * 1024) + lane;
#pragma unroll
            for (int j = 0; j < 4; ++j) { const u32x2 w = xr[64 * j]; v[i][j] = (f32x4){bflo(w.x), bfhi(w.x), bflo(w.y), bfhi(w.y)}; } }
        else { const GAS f32x4* xr = (const GAS f32x4*)((const float*)x + (size_t)(m0 + i * mstride) * 1024) + lane;
#pragma unroll
            for (int j = 0; j < 4; ++j) v[i][j] = xr[64 * j]; } }
    f32x4 gg[4];
#pragma unroll
    for (int j = 0; j < 4; ++j) gg[j] = ((const GAS f32x4*)g)[lane + 64 * j];
#pragma unroll
    for (int i = 0; i < R; ++i) { const int m = m0 + i * mstride, b = m >> 11; float s = 0.f;
#pragma unroll
        for (int j = 0; j < 4; ++j) s += (v[i][j].x * v[i][j].x + v[i][j].y * v[i][j].y) + (v[i][j].z * v[i][j].z + v[i][j].w * v[i][j].w);
        const float rs = rsqrtf(dpp_wave_sum(s) * (1.0f / 1024.0f) + 1e-6f);
        const float* sh = mod + (size_t)b * 6144 + sh_off; const float* sc = mod + (size_t)b * 6144 + sc_off;
        GAS unsigned long long* o8 = (GAS unsigned long long*)(out + (size_t)m * 1024) + lane;
#pragma unroll
        for (int j = 0; j < 4; ++j) { const f32x4 s1 = ((const GAS f32x4*)sc)[lane + 64 * j], s0 = ((const GAS f32x4*)sh)[lane + 64 * j];
            f32x4 y = (v[i][j] * rs) * gg[j]; y = y * (s1 + 1.0f) + s0; u[i][j] = y;
            o8[64 * j] = (unsigned long long)pk2(y.x, y.y) | ((unsigned long long)pk2(y.z, y.w) << 32); } }
}

template <int R> __device__ __forceinline__ void load_rows_bf16(const bf16* x, int m0, int mstride, int lane_in, u32x2 (&raw)[R][4]) {
    int lane = lane_in; asm volatile("" : "+v"(lane));
#pragma unroll
    for (int i = 0; i < R; ++i) { const GAS u32x2* xr = (const GAS u32x2*)(x + (size_t)(m0 + i * mstride) * 1024) + lane;
#pragma unroll
        for (int j = 0; j < 4; ++j) raw[i][j] = xr[64 * j]; }
}
template <int R> __device__ __forceinline__ void modnorm_rows_pre(const u32x2 (&raw)[R][4], int m0, int mstride, const float* g, const float* mod, int sh_off, int sc_off, bf16* out, int lane, f32x4 (&u)[R][4]) {
    f32x4 gg[4];
#pragma unroll
    for (int j = 0; j < 4; ++j) gg[j] = ((const GAS f32x4*)g)[lane + 64 * j];
#pragma unroll
    for (int i = 0; i < R; ++i) { const int m = m0 + i * mstride, b = m >> 11; float s = 0.f; f32x4 v[4];
#pragma unroll
        for (int j = 0; j < 4; ++j) { const u32x2 w = raw[i][j]; v[j] = (f32x4){bflo(w.x), bfhi(w.x), bflo(w.y), bfhi(w.y)}; s += (v[j].x * v[j].x + v[j].y * v[j].y) + (v[j].z * v[j].z + v[j].w * v[j].w); }
        const float rs = rsqrtf(dpp_wave_sum(s) * (1.0f / 1024.0f) + 1e-6f);
        const float* sh = mod + (size_t)b * 6144 + sh_off; const float* sc = mod + (size_t)b * 6144 + sc_off;
        GAS unsigned long long* o8 = (GAS unsigned long long*)(out + (size_t)m * 1024) + lane;
#pragma unroll
        for (int j = 0; j < 4; ++j) { const f32x4 s1 = ((const GAS f32x4*)sc)[lane + 64 * j], s0 = ((const GAS f32x4*)sh)[lane + 64 * j];
            f32x4 y = (v[j] * rs) * gg[j]; y = y * (s1 + 1.0f) + s0; u[i][j] = y;
            o8[64 * j] = (unsigned long long)pk2(y.x, y.y) | ((unsigned long long)pk2(y.z, y.w) << 32); } }
}

__device__ __forceinline__ void modnorm_row(const float* xrow, const float* g, const float* sh, const float* sc, bf16* orow, int lane, f32x4 (&u)[4]) {
    const GAS f32x4* xr = (const GAS f32x4*)xrow + lane;
    f32x4 v[4]; float s = 0.f;
#pragma unroll
    for (int j = 0; j < 4; ++j) { v[j] = xr[64 * j]; s += (v[j].x * v[j].x + v[j].y * v[j].y) + (v[j].z * v[j].z + v[j].w * v[j].w); }
    const float rs = rsqrtf(wave_sum(s) * (1.0f / 1024.0f) + 1e-6f);
    GAS unsigned long long* o8 = (GAS unsigned long long*)orow + lane;
#pragma unroll
    for (int j = 0; j < 4; ++j) { const f32x4 gg = ((const GAS f32x4*)g)[lane + 64 * j], s1 = ((const GAS f32x4*)sc)[lane + 64 * j], s0 = ((const GAS f32x4*)sh)[lane + 64 * j];
        f32x4 y = (v[j] * rs) * gg; y = y * (s1 + 1.0f) + s0; u[j] = y;
        o8[64 * j] = (unsigned long long)pk2(y.x, y.y) | ((unsigned long long)pk2(y.z, y.w) << 32); }
}

__device__ __forceinline__ float softplusf(float x) { return x > 20.f ? x : log1pf(__expf(x)); }
__device__ __forceinline__ void scan_chain(const Frame& F, ArgsP A, int b, int h, int dir) {
    constexpr int CT = 32;
    LAS float* L = (LAS float*)F.lds;
    LAS float* W2S = L; LAS float* A2S = L + 4096; LAS float* ZRs = L + 8192; LAS float* ZKs = ZRs + 2048; LAS float* ZVs = ZKs + 2048; LAS float* TWs = ZVs + 2048; LAS float* ZAs = TWs + 2048;
    LAS float* DEC = ZAs + 2048; LAS float* KD = DEC + 2048; LAS float* AV = KD + 2048; LAS float* BV = AV + 2048; LAS float* YB = BV + 2048; LAS float* BON = YB + 2048;
    const bf16* Z = (const bf16*)(A->ws + WS_Z);
    const float* mu_prev = (const float*)A->in[7]; const float* mu_next = (const float*)A->in[8];
    const float* w0 = (const float*)A->in[9]; const float* w2 = (const float*)A->in[10]; const float* a0 = (const float*)A->in[11]; const float* a2 = (const float*)A->in[12];
    const float* k_k = (const float*)A->in[14]; const float* k_a = (const float*)A->in[15]; const float* r_k = (const float*)A->in[16];
    bf16* ydir = (bf16*)(A->ws + WS_XN) + (size_t)dir * M * 512; float* bonus = (float*)(A->ws + WS_BONUS) + (size_t)dir * M * 8;
    const int tid = F.tid, lane = F.lane, wave = F.wave;
    for (int i = tid; i < 4096; i += 512) { const int l = i >> 6, j = i & 63; W2S[i] = w2[((size_t)dir * 64 + l) * 512 + h * 64 + j]; A2S[i] = a2[((size_t)dir * 64 + l) * 512 + h * 64 + j]; }
    const int ch = h * 64 + lane;
    const float w0j = w0[dir * 512 + ch], a0j = a0[dir * 512 + ch], kkj = k_k[ch], kaj = k_a[ch], rkj = r_k[ch];
    float s[8];
#pragma unroll
    for (int q = 0; q < 8; ++q) s[q] = 0.f;
    const int ri = tid >> 3, jg = tid & 7;
    for (int ci = 0; ci < T / CT; ++ci) {
        const int t0 = (dir ? (T / CT - 1 - ci) : ci) * CT;
#pragma unroll 4
        for (int i = 0; i < 20; ++i) { const int e = tid + 512 * i, arr = e >> 11, rem = e & 2047, tl = rem >> 6, j = rem & 63;
            const int col = (arr == 0 ? ZR + h * 64 : arr == 1 ? ZK + h * 64 : arr == 2 ? ZV + h * 64 : arr == 3 ? ZWD + dir * 64 : ZAD + dir * 64) + j;
            const int t = t0 + tl; const bf16* zp = Z + ((size_t)b * T + t) * NZ + col;
            const float z0 = bf2f(zp[0]), zm = t > 0 ? bf2f(zp[-NZ]) : 0.f, zq = t < T - 1 ? bf2f(zp[NZ]) : 0.f;
            float zs = z0 + mu_prev[col] * (zm - z0) + mu_next[col] * (zq - z0);
            if (arr == 3) zs = tanhf(zs);
            ZRs[arr * 2048 + rem] = zs; }
        __syncthreads();
#pragma unroll 1
        for (int q = 0; q < 4; ++q) { const int tl = wave + 8 * q;
            float wraw = w0j, araw = a0j;
#pragma unroll 8
            for (int l = 0; l < 64; ++l) { wraw += TWs[tl * 64 + l] * W2S[l * 64 + lane]; araw += ZAs[tl * 64 + l] * A2S[l * 64 + lane]; }
            const float w = -softplusf(-wraw) - 0.5f, dec = __expf(-__expf(w)), ad = sigm(araw);
            const float k = ZKs[tl * 64 + lane], kkr = k * kkj, nrm = sqrtf(wave_sum(kkr * kkr)), kk = kkr / fmaxf(nrm, 1e-12f);
            const float kd = k * (1.0f + (ad - 1.0f) * kaj);
            DEC[tl * 64 + lane] = dec; KD[tl * 64 + lane] = kd; AV[tl * 64 + lane] = -kk; BV[tl * 64 + lane] = kk * ad;
            const float bon = wave_sum(ZRs[tl * 64 + lane] * kd * rkj); if (lane == 0) BON[tl] = bon; }
        __syncthreads();
#pragma unroll 1
        for (int st = 0; st < CT; ++st) { const int tl = dir ? (CT - 1 - st) : st; const int o = tl * 64 + jg * 8;
            const f32x4 a0v = *(const LAS f32x4*)(AV + o), a1v = *(const LAS f32x4*)(AV + o + 4), d0 = *(const LAS f32x4*)(DEC + o), d1 = *(const LAS f32x4*)(DEC + o + 4);
            const f32x4 b0 = *(const LAS f32x4*)(BV + o), b1 = *(const LAS f32x4*)(BV + o + 4), k0 = *(const LAS f32x4*)(KD + o), k1 = *(const LAS f32x4*)(KD + o + 4);
            const f32x4 r0 = *(const LAS f32x4*)(ZRs + o), r1 = *(const LAS f32x4*)(ZRs + o + 4); const float vi = ZVs[tl * 64 + ri];
            float p = (s[0] * a0v[0] + s[1] * a0v[1]) + (s[2] * a0v[2] + s[3] * a0v[3]) + (s[4] * a1v[0] + s[5] * a1v[1]) + (s[6] * a1v[2] + s[7] * a1v[3]);
            p += __shfl_xor(p, 1); p += __shfl_xor(p, 2); p += __shfl_xor(p, 4);
            s[0] = s[0] * d0[0] + p * b0[0] + vi * k0[0]; s[1] = s[1] * d0[1] + p * b0[1] + vi * k0[1]; s[2] = s[2] * d0[2] + p * b0[2] + vi * k0[2]; s[3] = s[3] * d0[3] + p * b0[3] + vi * k0[3];
            s[4] = s[4] * d1[0] + p * b1[0] + vi * k1[0]; s[5] = s[5] * d1[1] + p * b1[1] + vi * k1[1]; s[6] = s[6] * d1[2] + p * b1[2] + vi * k1[2]; s[7] = s[7] * d1[3] + p * b1[3] + vi * k1[3];
            float y = (s[0] * r0[0] + s[1] * r0[1]) + (s[2] * r0[2] + s[3] * r0[3]) + (s[4] * r1[0] + s[5] * r1[1]) + (s[6] * r1[2] + s[7] * r1[3]);
            y += __shfl_xor(y, 1); y += __shfl_xor(y, 2); y += __shfl_xor(y, 4);
            if (jg == 0) YB[tl * 64 + ri] = y; }
        __syncthreads();
#pragma unroll
        for (int i = 0; i < 4; ++i) { const int e = tid + 512 * i, tl = e >> 6, c = e & 63; ydir[((size_t)b * T + t0 + tl) * 512 + h * 64 + c] = (bf16)f2bf(YB[e]); }
        if (tid < CT) bonus[((size_t)b * T + t0 + tid) * 8 + h] = BON[tid];
        __syncthreads();
    }
}


#define SDEV __device__ __forceinline__
#define S_UNROLL _Pragma("unroll")
#define S_MEMBAR() do { asm volatile("" ::: "memory"); __builtin_amdgcn_sched_barrier(0); } while (0)
#define S_LAUNDER_I(x) asm volatile("" : "+v"(x))
#define S_LAUNDER_S(x) asm volatile("" : "+s"(x))
#define S_PIN(x) asm volatile("" : "+v"(x))
typedef float f32x2s __attribute__((ext_vector_type(2))); typedef __bf16 bf16x2s __attribute__((ext_vector_type(2)));
__device__ __forceinline__ unsigned s_cvtpk(float lo, float hi) { f32x2s v = {lo, hi}; bf16x2s b = __builtin_convertvector(v, bf16x2s); return __builtin_bit_cast(unsigned, b); }
__device__ __forceinline__ float s_rowsum16(float v) {
    v += __int_as_float(__builtin_amdgcn_update_dpp(0, __float_as_int(v), 0xB1, 0xf, 0xf, false));
    v += __int_as_float(__builtin_amdgcn_update_dpp(0, __float_as_int(v), 0x4E, 0xf, 0xf, false));
    v += __int_as_float(__builtin_amdgcn_update_dpp(0, __float_as_int(v), 0x141, 0xf, 0xf, false));
    v += __int_as_float(__builtin_amdgcn_update_dpp(0, __float_as_int(v), 0x140, 0xf, 0xf, false));
    return v; }
#define S_MFMA(a, b, c) __builtin_amdgcn_mfma_f32_32x32x16_bf16(a, b, c, 0, 0, 0)
#define S_PK(lo, hi) s_cvtpk(lo, hi)
#define S_SWAP(x, y) do { auto r_ = __builtin_amdgcn_permlane32_swap(x, y, false, false); x = r_[0]; y = r_[1]; } while (0)
#define S_ROWSUM16(v) s_rowsum16(v)
__device__ __forceinline__ float s_wavesum(float v) { v = s_rowsum16(v);
    v += __int_as_float(__builtin_amdgcn_ds_swizzle(__float_as_int(v), 0x401F));
    auto r_ = __builtin_amdgcn_permlane32_swap(__float_as_uint(v), __float_as_uint(v), false, false);
    return __uint_as_float(r_[0]) + __uint_as_float(r_[1]); }
#define S_WAVESUM(v) s_wavesum(v)
#define S_GAS GAS
#define S_READLANE(v, l) __int_as_float(__builtin_amdgcn_readlane(__float_as_int(v), l))
#define S_RCP(x) __builtin_amdgcn_rcpf(x)
#define S_EXP2(x) __builtin_amdgcn_exp2f(x)
#define S_LOG2(x) __builtin_amdgcn_logf(x)
#define S_RSQ(x) __builtin_amdgcn_rsqf(x)
#define S_LDS_WAIT() asm volatile("s_waitcnt lgkmcnt(0)" ::: "memory")
#define S_LDSP LAS unsigned char*
#define S_LDS_BF16P LAS bf16*
#define S_LDS_U32P LAS unsigned*
#define S_LDS_F32P LAS float*
#define S_LDS_CONST_BF16X8P const LAS bf16x8*
#define S_LDS_BF16X8P LAS bf16x8*
#define S_LDS_CONST_F32X4P const LAS f32x4*
#define S_FLAG_STORE(p, v) do { *(volatile LAS unsigned*)(p) = (v); } while (0)
#define S_FLAG_WAIT(p, v) do { unsigned sp_ = 0; while (*(volatile LAS unsigned*)(p) != (v)) { __builtin_amdgcn_s_sleep(2); if (++sp_ > (1u << 24)) break; } asm volatile("" ::: "memory"); } while (0)
struct SFrag { bf16x8 s[2]; };
struct SMat { SFrag t[2]; };
SDEV f32x16 smm(const SFrag& X, const SFrag& Y, f32x16 acc) { acc = S_MFMA(X.s[0], Y.s[0], acc); acc = S_MFMA(X.s[1], Y.s[1], acc); return acc; }
SDEV f32x16 szero() { f32x16 z; S_UNROLL for (int i = 0; i < 16; ++i) z[i] = 0.f; return z; }
SDEV SFrag spack(const f32x16& d) { SFrag f;
    S_UNROLL for (int s = 0; s < 2; ++s) { v4u w; S_UNROLL for (int q = 0; q < 4; ++q) w[q] = S_PK(d[8 * s + 2 * q], d[8 * s + 2 * q + 1]); f.s[s] = __builtin_bit_cast(bf16x8, w); }
    return f; }
SDEV f32x16 sunpack(const SFrag& f) { f32x16 d;
    S_UNROLL for (int s = 0; s < 2; ++s) { const v4u w = __builtin_bit_cast(v4u, f.s[s]); S_UNROLL for (int q = 0; q < 4; ++q) { d[8 * s + 2 * q] = __uint_as_float(w[q] << 16); d[8 * s + 2 * q + 1] = __uint_as_float(w[q] & 0xffff0000u); } }
    return d; }
SDEV SMat splain2d(const unsigned (&pp)[16]) { unsigned d0[8], d1[8];
    S_UNROLL for (int g = 0; g < 4; ++g) S_UNROLL for (int p = 0; p < 2; ++p) { unsigned x = pp[4 * g + p], y = pp[4 * g + 2 + p]; S_SWAP(x, y); d0[2 * g + p] = x; d1[2 * g + p] = y; }
    SMat m;
    S_UNROLL for (int s = 0; s < 2; ++s) { v4u a, b; S_UNROLL for (int q = 0; q < 4; ++q) { a[q] = d0[4 * s + q]; b[q] = d1[4 * s + q]; } m.t[0].s[s] = __builtin_bit_cast(bf16x8, a); m.t[1].s[s] = __builtin_bit_cast(bf16x8, b); }
    return m; }
SDEV void sd2plain(const f32x16& D0, const f32x16& D1, float (&x)[32]) {
    S_UNROLL for (int r = 0; r < 16; ++r) { unsigned a = __float_as_uint(D0[r]), b = __float_as_uint(D1[r]); S_SWAP(a, b); const int ta = (r & 3) + 8 * (r >> 2); x[ta] = __uint_as_float(a); x[ta + 4] = __uint_as_float(b); } }
SDEV SFrag sident(int n_in, int hh_in) { int n1 = n_in, r1 = 4 * hh_in; S_LAUNDER_I(n1); S_LAUNDER_I(r1); f32x16 id; S_UNROLL for (int g = 0; g < 16; ++g) id[g] = (((g & 3) + 8 * (g >> 2) + r1) == n1) ? 1.f : 0.f; return spack(id); }
SDEV void sd2plain_pk(const f32x16& D0, const f32x16& D1, unsigned (&xp)[16]) {
    S_UNROLL for (int m = 0; m < 8; ++m) { unsigned a = S_PK(D0[2 * m], D0[2 * m + 1]), b = S_PK(D1[2 * m], D1[2 * m + 1]); S_SWAP(a, b); const int qa = 4 * (m >> 1) + (m & 1); xp[qa] = a; xp[qa + 2] = b; } }
SDEV float swave_sum(float v) { return S_WAVESUM(v); }

struct ScanArgs { const S_GAS bf16* Z; const S_GAS float* mu_prev; const S_GAS float* mu_next; const S_GAS float* w0; const S_GAS float* a0; const S_GAS float* k_k; const S_GAS float* k_a; const S_GAS float* r_k; S_GAS bf16* ydir; S_GAS float* bonus; };

#define SC_W2F 0
#define SC_A2F 8192
#define SC_SIG 16384
#define SC_GTAB 24576
#define SC_FLAG 26624
#define SC_WR 28672
#define SC_AR 94208
#define SC_LDS_BYTES 126976
#define SC_PF 4

SDEV void scan2_setup(S_LDSP lds, const S_GAS float* w2, const S_GAS float* a2, int h, int dir, int tid) {
    { float wv[16];
      S_UNROLL for (int it = 0; it < 16; ++it) { const int e = tid + 512 * it; const int mat = e >> 12, r = e & 4095, jj = r & 7, ln = (r >> 3) & 63, s = (r >> 9) & 1, jt = (r >> 10) & 1, lt = (r >> 11) & 1;
          const int n = ln & 31, hh = ln >> 5, g = 8 * s + jj, l = 32 * lt + (g & 3) + 8 * (g >> 2) + 4 * hh, j = 32 * jt + n;
          wv[it] = (mat ? a2 : w2)[((size_t)dir * 64 + l) * 512 + h * 64 + j]; }
      S_UNROLL for (int it = 0; it < 16; ++it) { const int e = tid + 512 * it; const int mat = e >> 12, r = e & 4095;
          ((S_LDS_BF16P)(lds + (mat ? SC_A2F : SC_W2F)))[r] = (bf16)(S_PK(wv[it], 0.f) & 0xffffu); } }
    for (int e = tid; e < 2048; e += 512) ((S_LDS_U32P)(lds + SC_SIG))[e] = 0u;
    if (tid == 0) S_FLAG_STORE(lds + SC_FLAG, 0u);
}

SDEV void scan2_chunk(S_LDSP lds, const ScanArgs& A_in, int b_in, int h_in, int dir_in, int c, int lane_in, int wave) {
    ScanArgs A = A_in; int b = b_in, h = h_in, dir = dir_in;
    S_LAUNDER_S(A.Z); S_LAUNDER_S(A.mu_prev); S_LAUNDER_S(A.mu_next); S_LAUNDER_S(A.w0); S_LAUNDER_S(A.a0); S_LAUNDER_S(A.k_k); S_LAUNDER_S(A.k_a); S_LAUNDER_S(A.r_k); S_LAUNDER_S(A.ydir); S_LAUNDER_S(A.bonus);
    S_LAUNDER_S(b); S_LAUNDER_S(h); S_LAUNDER_S(dir);
    int lane = lane_in; S_LAUNDER_I(lane);
    const int n = lane & 31, hh = lane >> 5;
    const int sgn = dir ? -1 : 1, tau0 = dir ? (T - 1 - 32 * c) : 32 * c;
    const S_GAS bf16* zb = A.Z + (size_t)b * T * NZ;
    const ptrdiff_t st = (ptrdiff_t)sgn * NZ; const bool first = (c == 0), last = (c == T / 32 - 1);
    const int cr = ZR + h * 64 + lane, ck = ZK + h * 64 + lane, cv = ZV + h * 64 + lane, cw = ZWD + dir * 64 + lane, ca = ZAD + dir * 64 + lane, chn = h * 64 + lane;
    {   const SFrag IDF = sident(n, hh); unsigned ppw[16], ppa[16];
        { const float mA = dir ? A.mu_next[cw] : A.mu_prev[cw], mB = dir ? A.mu_prev[cw] : A.mu_next[cw], nA = dir ? A.mu_next[ca] : A.mu_prev[ca], nB = dir ? A.mu_prev[ca] : A.mu_next[ca];
          const S_GAS bf16* pw = zb + (ptrdiff_t)tau0 * NZ + cw - st; const S_GAS bf16* pa = zb + (ptrdiff_t)tau0 * NZ + ca - st;
          float rw[34], ra[34];
          S_UNROLL for (int q = 0; q < 34; ++q) { const bool ok = !((q == 0 && first) || (q == 33 && last)); rw[q] = ok ? bf2f(*pw) : 0.f; ra[q] = ok ? bf2f(*pa) : 0.f; pw += st; pa += st; }
          S_MEMBAR();
          const float mC = 1.f - mA - mB, nC = 1.f - nA - nB; float tprev = 0.f, aprev = 0.f;
          S_UNROLL for (int p = 0; p < 32; ++p) { if ((p & 7) == 0) S_MEMBAR();
              const float ws = mC * rw[p + 1] + mA * rw[p] + mB * rw[p + 2], as = nC * ra[p + 1] + nA * ra[p] + nB * ra[p + 2];
              const float tw = 1.f - 2.f * S_RCP(1.f + S_EXP2(ws * 2.885390082f));
              if (p & 1) { ppw[p >> 1] = S_PK(tprev, tw); ppa[p >> 1] = S_PK(aprev, as); S_PIN(ppw[p >> 1]); S_PIN(ppa[p >> 1]); } else { tprev = tw; aprev = as; } } }
        S_MEMBAR();
        const SMat TW = splain2d(ppw), AD = splain2d(ppa);
        SFrag TWT[2], ADT[2];
        S_UNROLL for (int lt = 0; lt < 2; ++lt) { TWT[lt] = spack(smm(TW.t[lt], IDF, szero())); ADT[lt] = spack(smm(AD.t[lt], IDF, szero())); }
        f32x16 dw[2], da[2];
        S_UNROLL for (int jt = 0; jt < 2; ++jt) { dw[jt] = szero(); da[jt] = szero();
            S_UNROLL for (int lt = 0; lt < 2; ++lt) { SFrag wf, af;
                S_UNROLL for (int s = 0; s < 2; ++s) { wf.s[s] = *(S_LDS_CONST_BF16X8P)(lds + SC_W2F + ((((lt * 2 + jt) * 2 + s) * 64 + lane) * 16)); af.s[s] = *(S_LDS_CONST_BF16X8P)(lds + SC_A2F + ((((lt * 2 + jt) * 2 + s) * 64 + lane) * 16)); }
                dw[jt] = smm(TWT[lt], wf, dw[jt]); da[jt] = smm(ADT[lt], af, da[jt]); } }
        S_UNROLL for (int jt = 0; jt < 2; ++jt) S_UNROLL for (int g = 0; g < 16; ++g) { const int t = (g & 3) + 8 * (g >> 2) + 4 * hh;
            ((S_LDS_F32P)(lds + SC_WR + wave * 8192))[t * 64 + 32 * jt + n] = dw[jt][g]; ((S_LDS_BF16P)(lds + SC_AR + wave * 4096))[t * 64 + 32 * jt + n] = (bf16)(S_PK(da[jt][g], 0.f) & 0xffffu); }
        S_LDS_WAIT();
    }
    S_MEMBAR();
    unsigned ppA[16], ppR[16], ppB[16], ppK[16], ppV[16], ppQ[16]; float gamC;
    {   const float mAr = dir ? A.mu_next[cr] : A.mu_prev[cr], mBr = dir ? A.mu_prev[cr] : A.mu_next[cr], mAk = dir ? A.mu_next[ck] : A.mu_prev[ck], mBk = dir ? A.mu_prev[ck] : A.mu_next[ck];
        const float mAv = dir ? A.mu_next[cv] : A.mu_prev[cv], mBv = dir ? A.mu_prev[cv] : A.mu_next[cv];
        const float w0j = A.w0[dir * 512 + chn], a0j = A.a0[dir * 512 + chn], kkj = A.k_k[chn], kaj = A.k_a[chn], rkj = A.r_k[chn];
        const S_GAS bf16* pr = zb + (ptrdiff_t)tau0 * NZ + cr - st; const S_GAS bf16* pk = zb + (ptrdiff_t)tau0 * NZ + ck - st; const S_GAS bf16* pv = zb + (ptrdiff_t)tau0 * NZ + cv - st;
        float rr[34], rk[34], rv[34];
        S_UNROLL for (int q = 0; q < 34; ++q) { const bool ok = !((q == 0 && first) || (q == 33 && last)); rr[q] = ok ? bf2f(*pr) : 0.f; rk[q] = ok ? bf2f(*pk) : 0.f; rv[q] = ok ? bf2f(*pv) : 0.f; pr += st; pk += st; pv += st; }
        S_MEMBAR();
        const float mCr = 1.f - mAr - mBr, mCk = 1.f - mAk - mBk, mCv = 1.f - mAv - mBv;
        float cs = 0.f, gprev = 1.f; float eA = 0.f, eR = 0.f, eB = 0.f, eK = 0.f, eV = 0.f, eQ = 0.f;
        S_UNROLL for (int p = 0; p < 32; ++p) { S_MEMBAR();
            const float r = mCr * rr[p + 1] + mAr * rr[p] + mBr * rr[p + 2], k = mCk * rk[p + 1] + mAk * rk[p] + mBk * rk[p + 2], v = mCv * rv[p + 1] + mAv * rv[p] + mBv * rv[p + 2];
            const float wraw = ((S_LDS_F32P)(lds + SC_WR + wave * 8192))[p * 64 + lane] + w0j, araw = bf2f(((S_LDS_BF16P)(lds + SC_AR + wave * 4096))[p * 64 + lane]) + a0j;
            const float x = -wraw; const float sp = fmaxf(x, 0.f) + 0.6931471806f * S_LOG2(1.f + S_EXP2(-fabsf(x) * 1.442695041f));
            const float w = -sp - 0.5f; const float lw2 = -S_EXP2(w * 1.442695041f) * 1.442695041f;
            const float al = S_RCP(1.f + S_EXP2(-araw * 1.442695041f));
            const float kkr = k * kkj; const float nrm2 = swave_sum(kkr * kkr); const float kk = kkr * S_RSQ(fmaxf(nrm2, 1e-24f));
            const float kd = k * (1.f + (al - 1.f) * kaj);
            cs += lw2; const float gam = S_EXP2(cs), ig = S_EXP2(-cs);
            const float xa = -kk * gprev, xr = r * gam, xb = kk * al * ig, xk = kd * ig, xq = xr * rkj; gprev = gam;
            if (p & 1) { ppA[p >> 1] = S_PK(eA, xa); ppR[p >> 1] = S_PK(eR, xr); ppB[p >> 1] = S_PK(eB, xb); ppK[p >> 1] = S_PK(eK, xk); ppV[p >> 1] = S_PK(eV, v); ppQ[p >> 1] = S_PK(eQ, xq);
                         S_PIN(ppQ[p >> 1]); S_PIN(ppA[p >> 1]); S_PIN(ppR[p >> 1]); S_PIN(ppB[p >> 1]); S_PIN(ppK[p >> 1]); S_PIN(ppV[p >> 1]); }
            else { eA = xa; eR = xr; eB = xb; eK = xk; eV = v; eQ = xq; } }
        gamC = gprev;
    }
    S_MEMBAR();
    float gc0, gc1; { unsigned x = __float_as_uint(gamC), y = x; S_SWAP(x, y); gc0 = __uint_as_float(x); gc1 = __uint_as_float(y); }
    ((S_LDS_F32P)(lds + SC_GTAB + wave * 256))[lane] = gamC;
    const SMat FA = splain2d(ppA), FB = splain2d(ppB), FK = splain2d(ppK), FV = splain2d(ppV);
    SFrag RT[2], MrbT, MrkT, LakT, Pf, PTf; f32x16 TT;
    {   const SFrag IDF = sident(n, hh); SFrag AT[2], BT[2], KT[2];
        { const SMat FR = splain2d(ppR); S_UNROLL for (int dt = 0; dt < 2; ++dt) RT[dt] = spack(smm(FR.t[dt], IDF, szero())); }
        SFrag QT[2]; { const SMat FQ = splain2d(ppQ); S_UNROLL for (int dt = 0; dt < 2; ++dt) QT[dt] = spack(smm(FQ.t[dt], IDF, szero())); }
        S_UNROLL for (int dt = 0; dt < 2; ++dt) { AT[dt] = spack(smm(FA.t[dt], IDF, szero())); BT[dt] = spack(smm(FB.t[dt], IDF, szero())); KT[dt] = spack(smm(FK.t[dt], IDF, szero())); }
        f32x16 L = szero(), LT = szero(), lak = szero(), mrb = szero(), mrk = szero();
        { f32x16 bq = szero(); S_UNROLL for (int dt = 0; dt < 2; ++dt) bq = smm(KT[dt], QT[dt], bq);
          int nb = n, rb = 4 * hh; S_LAUNDER_I(nb); S_LAUNDER_I(rb); float dsum = 0.f; S_UNROLL for (int g = 0; g < 16; ++g) dsum += (((g & 3) + 8 * (g >> 2) + rb) == nb) ? bq[g] : 0.f;
          if (((nb >> 2) & 1) == (rb >> 2)) A.bonus[((size_t)b * T + (tau0 + sgn * nb)) * 8 + h] = dsum; }
        S_UNROLL for (int dt = 0; dt < 2; ++dt) { L = smm(AT[dt], BT[dt], L); LT = smm(BT[dt], AT[dt], LT); lak = smm(KT[dt], AT[dt], lak); mrb = smm(BT[dt], RT[dt], mrb); mrk = smm(KT[dt], RT[dt], mrk); }
        int n2 = n, r2 = 4 * hh; S_LAUNDER_I(n2); S_LAUNDER_I(r2);
        S_UNROLL for (int g = 0; g < 16; ++g) { const int row = (g & 3) + 8 * (g >> 2) + r2;
            L[g] = (row > n2) ? L[g] : 0.f; LT[g] = (row < n2) ? LT[g] : 0.f; lak[g] = (row < n2) ? lak[g] : 0.f; mrb[g] = (row <= n2) ? mrb[g] : 0.f; mrk[g] = (row <= n2) ? mrk[g] : 0.f; }
        Pf = spack(L); PTf = spack(LT); LakT = spack(lak); MrbT = spack(mrb); MrkT = spack(mrk);
        TT = LT; S_UNROLL for (int g = 0; g < 16; ++g) TT[g] += (((g & 3) + 8 * (g >> 2) + r2) == n2) ? 1.f : 0.f;
    }
    S_MEMBAR();
    SFrag TTf = spack(TT);
    S_UNROLL for (int i = 1; i <= 4; ++i) { const f32x16 P2 = smm(PTf, Pf, szero()); SFrag P2Tf; if (i < 4) P2Tf = spack(smm(Pf, PTf, szero()));
        Pf = spack(P2); TT = smm(Pf, TTf, TT); TTf = spack(TT); if (i < 4) PTf = P2Tf; }
    S_MEMBAR();
    SFrag U0[2], Ap[2], RpT[2], Y0[2], GTf[2][2], Hf[2][2];
    S_UNROLL for (int vt = 0; vt < 2; ++vt) { const SFrag W = spack(smm(LakT, FV.t[vt], szero())); U0[vt] = spack(smm(TTf, W, szero())); }
    S_UNROLL for (int kt = 0; kt < 2; ++kt) Ap[kt] = spack(smm(TTf, FA.t[kt], szero()));
    S_UNROLL for (int kt = 0; kt < 2; ++kt) RpT[kt] = spack(smm(Ap[kt], MrbT, sunpack(RT[kt])));
    S_UNROLL for (int vt = 0; vt < 2; ++vt) Y0[vt] = spack(smm(MrkT, FV.t[vt], smm(MrbT, U0[vt], szero())));
    int n3 = n, r3 = 4 * hh; S_LAUNDER_I(n3); S_LAUNDER_I(r3);
    S_UNROLL for (int nt = 0; nt < 2; ++nt) S_UNROLL for (int mt = 0; mt < 2; ++mt) { f32x16 gt = smm(Ap[nt], FB.t[mt], szero()); const float gcv = mt ? gc1 : gc0;
        S_UNROLL for (int g = 0; g < 16; ++g) { const float idv = (nt == mt && ((g & 3) + 8 * (g >> 2) + r3) == n3) ? 1.f : 0.f; gt[g] = (gt[g] + idv) * gcv; }
        GTf[nt][mt] = spack(gt); }
    S_LDS_WAIT();
    S_UNROLL for (int mt = 0; mt < 2; ++mt) { float gr[16];
        S_UNROLL for (int q = 0; q < 4; ++q) { const f32x4 t4 = *(S_LDS_CONST_F32X4P)(lds + SC_GTAB + wave * 256 + (32 * mt + 8 * q + 4 * hh) * 4); S_UNROLL for (int i = 0; i < 4; ++i) gr[4 * q + i] = t4[i]; }
        S_UNROLL for (int vt = 0; vt < 2; ++vt) { f32x16 hm = smm(FK.t[mt], FV.t[vt], smm(FB.t[mt], U0[vt], szero())); S_UNROLL for (int g = 0; g < 16; ++g) hm[g] *= gr[g]; Hf[mt][vt] = spack(hm); } }
    S_MEMBAR();
    S_FLAG_WAIT(lds + SC_FLAG, (unsigned)c);
    SFrag SG[2][2];
    S_UNROLL for (int kt = 0; kt < 2; ++kt) S_UNROLL for (int vt = 0; vt < 2; ++vt) S_UNROLL for (int s = 0; s < 2; ++s) SG[kt][vt].s[s] = *(S_LDS_CONST_BF16X8P)(lds + SC_SIG + ((((kt * 2 + vt) * 2 + s) * 64 + lane) * 16));
    S_LDS_WAIT();
    S_UNROLL for (int mt = 0; mt < 2; ++mt) S_UNROLL for (int vt = 0; vt < 2; ++vt) { f32x16 sn = sunpack(Hf[mt][vt]); S_UNROLL for (int nt = 0; nt < 2; ++nt) sn = smm(GTf[nt][mt], SG[nt][vt], sn);
        const SFrag f = spack(sn); S_UNROLL for (int s = 0; s < 2; ++s) *(S_LDS_BF16X8P)(lds + SC_SIG + ((((mt * 2 + vt) * 2 + s) * 64 + lane) * 16)) = f.s[s]; }
    S_LDS_WAIT();
    S_FLAG_STORE(lds + SC_FLAG, (unsigned)(c + 1));
    S_UNROLL for (int vt = 0; vt < 2; ++vt) { f32x16 y = sunpack(Y0[vt]); S_UNROLL for (int kt = 0; kt < 2; ++kt) y = smm(RpT[kt], SG[kt][vt], y);
        S_UNROLL for (int g = 0; g < 16; ++g) { const int p = (g & 3) + 8 * (g >> 2) + 4 * hh; A.ydir[((size_t)b * T + (tau0 + sgn * p)) * 512 + h * 64 + 32 * vt + n] = (bf16)(S_PK(y[g], 0.f) & 0xffffu); } }
}

__device__ __forceinline__ void attn_unit(const Frame& F, ArgsP A, int b, int kvh, int qb) {
    constexpr int KST = 72, VST = 388;
    LAS bf16* KS = (LAS bf16*)F.lds;
    LAS bf16* VT = (LAS bf16*)(F.lds + 384 * KST * 2);
    LAS float* wsf = (LAS float*)(F.lds + 384 * KST * 2 + 64 * VST * 2);
    const bf16* Z = (const bf16*)(A->ws + WS_Z); bf16* OA = (bf16*)(A->ws + WS_OATT);
    const int* positions = (const int*)A->in[2]; const float* qg = (const float*)A->in[19]; const float* kg = (const float*)A->in[20]; const float* sink = (const float*)A->in[21];
    const int tid = F.tid, lane = F.lane, wave = F.wave;
    const float LN_THETA = 13.122363377404328f;
    v4u kwa[6], vwa[6], rca[6], rsa[6];
#pragma unroll
    for (int i = 0; i < 6; ++i) { const int ct = tid + 512 * i, key = ct >> 3, ch = ct & 7; const int kp = qb * 128 - 128 + key; const bool valid = (kp >= 0) && (kp < T);
        const size_t rowoff = ((size_t)b * T + (valid ? kp : 0)) * NZ;
        kwa[i] = *(const GAS v4u*)(Z + rowoff + ZKA + kvh * 64 + ch * 8); vwa[i] = *(const GAS v4u*)(Z + rowoff + ZVA + kvh * 64 + ch * 8);
        const GAS v4u* rt = (const GAS v4u*)((const bf16*)(A->ws + WS_ROPE) + ((size_t)b * T + (valid ? kp : 0)) * 16); rca[i] = rt[0]; rsa[i] = rt[1]; }
#pragma unroll
    for (int i = 0; i < 6; ++i) { const int ct = tid + 512 * i, key = ct >> 3, ch = ct & 7; const int kp = qb * 128 - 128 + key; const bool valid = (kp >= 0) && (kp < T);
        v4u kw = kwa[i], vw = vwa[i];
        if (!valid) { kw = (v4u){0u, 0u, 0u, 0u}; vw = kw; }
        float kf[8] = {bflo(kw.x), bfhi(kw.x), bflo(kw.y), bfhi(kw.y), bflo(kw.z), bfhi(kw.z), bflo(kw.w), bfhi(kw.w)};
        float ss = 0.f;
#pragma unroll
        for (int j = 0; j < 8; ++j) ss += kf[j] * kf[j];
        ss += __shfl_xor(ss, 1); ss += __shfl_xor(ss, 2); ss += __shfl_xor(ss, 4);
        const float rs = rsqrtf(ss * (1.0f / 64.0f) + 1e-6f);
#pragma unroll
        for (int j = 0; j < 8; ++j) kf[j] = kf[j] * rs * kg[ch * 8 + j];
        float oth[8];
#pragma unroll
        for (int j = 0; j < 8; ++j) oth[j] = __shfl_xor(kf[j], 1);
        if (ch < 2) { const v4u cw = rca[i], sw = rsa[i];
            const float cs[8] = {bflo(cw.x), bfhi(cw.x), bflo(cw.y), bfhi(cw.y), bflo(cw.z), bfhi(cw.z), bflo(cw.w), bfhi(cw.w)};
            const float sn[8] = {bflo(sw.x), bfhi(sw.x), bflo(sw.y), bfhi(sw.y), bflo(sw.z), bfhi(sw.z), bflo(sw.w), bfhi(sw.w)};
#pragma unroll
            for (int j = 0; j < 8; ++j) kf[j] = (ch == 0) ? (kf[j] * cs[j] - oth[j] * sn[j]) : (kf[j] * cs[j] + oth[j] * sn[j]); }
        v4u ko; ko.x = pk2(kf[0], kf[1]); ko.y = pk2(kf[2], kf[3]); ko.z = pk2(kf[4], kf[5]); ko.w = pk2(kf[6], kf[7]);
        *(LAS v4u*)(KS + key * KST + ch * 8) = ko;
        const unsigned vv[4] = {vw.x, vw.y, vw.z, vw.w};
#pragma unroll
        for (int j = 0; j < 4; ++j) { VT[(ch * 8 + 2 * j) * VST + key] = (bf16)(vv[j] & 0xffffu); VT[(ch * 8 + 2 * j + 1) * VST + key] = (bf16)(vv[j] >> 16); } }
    __syncthreads();
    const int g = wave >> 1, hq = kvh * 4 + g, r32 = lane & 31, hh = lane >> 5;
    const float snk = sink[hq];
    float kbound; { float gm = fabsf(kg[lane]);
#pragma unroll
        for (int o = 1; o < 64; o <<= 1) gm = fmaxf(gm, __shfl_xor(gm, o));
        kbound = 8.0f * gm; }
#pragma unroll 1
    for (int qt = 0; qt < 2; ++qt) { const int qo = (wave & 1) * 64 + qt * 32, qrel = qo + r32; const size_t tok = (size_t)b * T + qb * 128 + qrel;
        float qf[4][8]; float ss = 0.f; v4u qraw[4];
#pragma unroll
        for (int sI = 0; sI < 4; ++sI) qraw[sI] = *(const GAS v4u*)(Z + tok * NZ + ZQ + hq * 64 + 16 * sI + 8 * hh);
        const GAS v4u* qrt = (const GAS v4u*)((const bf16*)(A->ws + WS_ROPE) + tok * 16); const v4u qrc = qrt[0], qrs = qrt[1];
#pragma unroll
        for (int sI = 0; sI < 4; ++sI) { const v4u qw = qraw[sI];
            qf[sI][0] = bflo(qw.x); qf[sI][1] = bfhi(qw.x); qf[sI][2] = bflo(qw.y); qf[sI][3] = bfhi(qw.y); qf[sI][4] = bflo(qw.z); qf[sI][5] = bfhi(qw.z); qf[sI][6] = bflo(qw.w); qf[sI][7] = bfhi(qw.w);
#pragma unroll
            for (int j = 0; j < 8; ++j) ss += qf[sI][j] * qf[sI][j]; }
        ss += __shfl_xor(ss, 32);
        const float rs = rsqrtf(ss * (1.0f / 64.0f) + 1e-6f) * 0.125f;
#pragma unroll
        for (int sI = 0; sI < 4; ++sI)
#pragma unroll
            for (int j = 0; j < 8; ++j) qf[sI][j] = qf[sI][j] * rs * qg[16 * sI + 8 * hh + j];
        { const v4u cw = qrc, sw = qrs;
          const float cs[8] = {bflo(cw.x), bfhi(cw.x), bflo(cw.y), bfhi(cw.y), bflo(cw.z), bfhi(cw.z), bflo(cw.w), bfhi(cw.w)}, sn[8] = {bflo(sw.x), bfhi(sw.x), bflo(sw.y), bfhi(sw.y), bflo(sw.z), bfhi(sw.z), bflo(sw.w), bfhi(sw.w)};
#pragma unroll
          for (int j = 0; j < 8; ++j) { const float oth = __shfl_xor(qf[0][j], 32); qf[0][j] = (hh == 0) ? (qf[0][j] * cs[j] - oth * sn[j]) : (qf[0][j] * cs[j] + oth * sn[j]); } }
        bf16x8 qr[4];
#pragma unroll
        for (int sI = 0; sI < 4; ++sI) { v4u w; w.x = pk2(qf[sI][0], qf[sI][1]); w.y = pk2(qf[sI][2], qf[sI][3]); w.z = pk2(qf[sI][4], qf[sI][5]); w.w = pk2(qf[sI][6], qf[sI][7]); qr[sI] = __builtin_bit_cast(bf16x8, w); }
        const int kt0 = qo >> 5;
        float qn2 = 0.f;
#pragma unroll
        for (int sI = 0; sI < 4; ++sI)
#pragma unroll
            for (int j = 0; j < 8; ++j) qn2 += qf[sI][j] * qf[sI][j];
        qn2 += __shfl_xor(qn2, 32);
        float mrun = sqrtf(qn2) * kbound * 1.02f;
        if (__any(mrun > 40.f)) { mrun = -1e30f;
#pragma unroll 1
            for (int kt = 0; kt < 9; ++kt) { const int kbase = (kt0 + kt) * 32;
                f32x16 acc = {};
#pragma unroll
                for (int sI = 0; sI < 4; ++sI) { const bf16x8 kfr = *(const LAS bf16x8*)(KS + (kbase + r32) * KST + 16 * sI + 8 * hh); acc = __builtin_amdgcn_mfma_f32_32x32x16_bf16(kfr, qr[sI], acc, 0, 0, 0); }
#pragma unroll
                for (int r = 0; r < 16; ++r) { const int ki = kbase + (r & 3) + 8 * (r >> 2) + 4 * hh; const int dq = ki - 128 - qrel, kp = qb * 128 - 128 + ki;
                    const bool ok = (dq >= -128) && (dq <= 128) && (kp >= 0) && (kp < T); mrun = fmaxf(mrun, ok ? acc[r] : -1e30f); } }
            mrun = fmaxf(mrun, __shfl_xor(mrun, 32)); }
        const float mx = fmaxf(mrun, snk);
        float lrun = 0.f; f32x16 o0 = {}, o1 = {}; const float mxl = mx * 1.442695041f; const bool edge = (qb == 0) || (qb == T / 128 - 1);
#pragma unroll 1
        for (int kt = 0; kt < 9; ++kt) { const int kbase = (kt0 + kt) * 32;
            f32x16 acc = {};
#pragma unroll
            for (int sI = 0; sI < 4; ++sI) { const bf16x8 kfr = *(const LAS bf16x8*)(KS + (kbase + r32) * KST + 16 * sI + 8 * hh); acc = __builtin_amdgcn_mfma_f32_32x32x16_bf16(kfr, qr[sI], acc, 0, 0, 0); }
            float p[16];
            if (edge || kt == 0 || kt == 8) {
#pragma unroll
                for (int r = 0; r < 16; ++r) { const int ki = kbase + (r & 3) + 8 * (r >> 2) + 4 * hh; const int dq = ki - 128 - qrel, kp = qb * 128 - 128 + ki;
                    const bool ok = (dq >= -128) && (dq <= 128) && (kp >= 0) && (kp < T); p[r] = ok ? __builtin_amdgcn_exp2f(acc[r] * 1.442695041f - mxl) : 0.f; lrun += p[r]; }
            } else {
#pragma unroll
                for (int r = 0; r < 16; ++r) { p[r] = __builtin_amdgcn_exp2f(acc[r] * 1.442695041f - mxl); lrun += p[r]; } }
#pragma unroll
            for (int sI = 0; sI < 2; ++sI) { v4u pw; pw.x = pk2(p[8 * sI + 0], p[8 * sI + 1]); pw.y = pk2(p[8 * sI + 2], p[8 * sI + 3]); pw.z = pk2(p[8 * sI + 4], p[8 * sI + 5]); pw.w = pk2(p[8 * sI + 6], p[8 * sI + 7]);
                const bf16x8 pa = __builtin_bit_cast(bf16x8, pw); const int key0 = kbase + 16 * sI + 4 * hh;
                { const u32x2 lo = *(const LAS u32x2*)(VT + r32 * VST + key0), hi = *(const LAS u32x2*)(VT + r32 * VST + key0 + 8); v4u vw; vw.x = lo.x; vw.y = lo.y; vw.z = hi.x; vw.w = hi.y;
                  o0 = __builtin_amdgcn_mfma_f32_32x32x16_bf16(pa, __builtin_bit_cast(bf16x8, vw), o0, 0, 0, 0); }
                { const u32x2 lo = *(const LAS u32x2*)(VT + (32 + r32) * VST + key0), hi = *(const LAS u32x2*)(VT + (32 + r32) * VST + key0 + 8); v4u vw; vw.x = lo.x; vw.y = lo.y; vw.z = hi.x; vw.w = hi.y;
                  o1 = __builtin_amdgcn_mfma_f32_32x32x16_bf16(pa, __builtin_bit_cast(bf16x8, vw), o1, 0, 0, 0); } } }
        lrun += __shfl_xor(lrun, 32);
        const float linv = 1.0f / (lrun + __expf(snk - mx));
        if (hh == 0) wsf[wave * 64 + r32] = linv;
        LDS_WAIT(); asm volatile("" ::: "memory");
#pragma unroll
        for (int r = 0; r < 16; ++r) { const int row = (r & 3) + 8 * (r >> 2) + 4 * hh; const float li = wsf[wave * 64 + row];
            bf16* op = OA + ((size_t)b * T + qb * 128 + qo + row) * 512 + hq * 64;
            op[r32] = (bf16)f2bf(o0[r] * li); op[32 + r32] = (bf16)f2bf(o1[r] * li); }
        LDS_WAIT(); asm volatile("" ::: "memory");
    }
    __syncthreads();
}

__device__ __forceinline__ void pg_rows(const Frame& F, ArgsP A, bf16* wout) {
    const bf16* Z = (const bf16*)(A->ws + WS_Z); const bf16* Y0 = (const bf16*)(A->ws + WS_XN); const bf16* Y1 = Y0 + (size_t)M * 512;
    bf16* Gb = (bf16*)(A->ws + WS_G); const float* bonus = (const float*)(A->ws + WS_BONUS);
    const float* mu_prev = (const float*)A->in[7]; const float* mu_next = (const float*)A->in[8]; const float* gn_w = (const float*)A->in[17]; const float* gn_b = (const float*)A->in[18];
    const int gw = F.vcu * NWAVES + F.wave, NGW = F.G * NWAVES, lane = F.lane, c0 = lane * 8, h = lane >> 3;
    float mp[8], mn[8], gw_[8], gb_[8];
#pragma unroll
    for (int j = 0; j < 8; ++j) { mp[j] = mu_prev[ZV + c0 + j]; mn[j] = mu_next[ZV + c0 + j]; gw_[j] = gn_w[c0 + j]; gb_[j] = gn_b[c0 + j]; }
#pragma unroll 1
    for (int m0 = gw; m0 < M; m0 += 4 * NGW) {
        v4u y0[4], y1[4], gv[4], z0[4], zm[4], zq[4]; float bon[4];
#pragma unroll
        for (int i = 0; i < 4; ++i) { const int m = m0 + i * NGW, t = m & (T - 1);
            y0[i] = *(const GAS v4u*)(Y0 + (size_t)m * 512 + c0); y1[i] = *(const GAS v4u*)(Y1 + (size_t)m * 512 + c0); gv[i] = *(const GAS v4u*)(Gb + (size_t)m * 512 + c0);
            z0[i] = *(const GAS v4u*)(Z + (size_t)m * NZ + ZV + c0);
            zm[i] = (v4u){0u, 0u, 0u, 0u}; zq[i] = (v4u){0u, 0u, 0u, 0u};
            if (t > 0) zm[i] = *(const GAS v4u*)(Z + (size_t)(m - 1) * NZ + ZV + c0);
            if (t < T - 1) zq[i] = *(const GAS v4u*)(Z + (size_t)(m + 1) * NZ + ZV + c0);
            bon[i] = bonus[(size_t)m * 8 + h] + bonus[(size_t)M * 8 + (size_t)m * 8 + h]; }
#pragma unroll
        for (int i = 0; i < 4; ++i) { const int m = m0 + i * NGW;
            const unsigned y0w[4] = {y0[i].x, y0[i].y, y0[i].z, y0[i].w}, y1w[4] = {y1[i].x, y1[i].y, y1[i].z, y1[i].w}, gvw[4] = {gv[i].x, gv[i].y, gv[i].z, gv[i].w};
            const unsigned z0w[4] = {z0[i].x, z0[i].y, z0[i].z, z0[i].w}, zmw[4] = {zm[i].x, zm[i].y, zm[i].z, zm[i].w}, zqw[4] = {zq[i].x, zq[i].y, zq[i].z, zq[i].w};
            float y[8], gg[8], vv[8]; float sacc = 0.f;
#pragma unroll
            for (int j = 0; j < 4; ++j) { y[2 * j] = bflo(y0w[j]) + bflo(y1w[j]); y[2 * j + 1] = bfhi(y0w[j]) + bfhi(y1w[j]); gg[2 * j] = bflo(gvw[j]); gg[2 * j + 1] = bfhi(gvw[j]);
                const float a0 = bflo(z0w[j]), a1 = bfhi(z0w[j]);
                vv[2 * j] = a0 + mp[2 * j] * (bflo(zmw[j]) - a0) + mn[2 * j] * (bflo(zqw[j]) - a0); vv[2 * j + 1] = a1 + mp[2 * j + 1] * (bfhi(zmw[j]) - a1) + mn[2 * j + 1] * (bfhi(zqw[j]) - a1);
                sacc += y[2 * j] + y[2 * j + 1]; }
            sacc += __shfl_xor(sacc, 1); sacc += __shfl_xor(sacc, 2); sacc += __shfl_xor(sacc, 4);
            const float mu = sacc * (1.0f / 64.0f); float q = 0.f;
#pragma unroll
            for (int j = 0; j < 8; ++j) { const float d = y[j] - mu; q += d * d; }
            q += __shfl_xor(q, 1); q += __shfl_xor(q, 2); q += __shfl_xor(q, 4);
            const float rstd = rsqrtf(q * (1.0f / 64.0f) + 64e-5f);
            float o[8];
#pragma unroll
            for (int j = 0; j < 8; ++j) o[j] = ((y[j] - mu) * rstd * gw_[j] + gb_[j] + bon[i] * vv[j]) * gg[j];
            v4u w; w.x = pk2(o[0], o[1]); w.y = pk2(o[2], o[3]); w.z = pk2(o[4], o[5]); w.w = pk2(o[6], o[7]);
            *(GAS v4u*)(wout + (size_t)m * 512 + c0) = w; } }
}

__device__ __forceinline__ void pj_phase(const Frame& F, ArgsP A) {
    unsigned char* ws = A->ws;
    const int gw = F.vcu * NWAVES + F.wave, NGW = F.G * NWAVES, lane = F.lane;
    { LAS float* scr = (LAS float*)(F.lds + F.wave * 16384);
      const float* w_gate = (const float*)A->in[27]; const float* w_up = (const float*)A->in[28]; const float* w_down = (const float*)A->in[29];
      bf16* WguT = (bf16*)((unsigned char*)A->out + OUT_WGUT); bf16* WdT = (bf16*)((unsigned char*)A->out + OUT_WDT);
      constexpr int PER = 512, NIT = 16 * 3 * PER;
      for (int it = gw; it < NIT; it += NGW) { const int e = it / (3 * PER), r = it % (3 * PER), which = r / PER, q = r % PER, kb = q >> 5, nb = q & 31, n0 = 32 * nb;
          if (which == 0) tr_item(w_gate + (size_t)e * 1048576, 1024, 64 * kb, n0, WguT, 1024, e * 2048 + (n0 >> 7) * 256 + (n0 & 127), scr, lane);
          else if (which == 1) tr_item(w_up + (size_t)e * 1048576, 1024, 64 * kb, n0, WguT, 1024, e * 2048 + (n0 >> 7) * 256 + 128 + (n0 & 127), scr, lane);
          else tr_item(w_down + (size_t)e * 1048576, 1024, 64 * kb, n0, WdT, 1024, e * 1024 + n0, scr, lane); }
    }
    __syncthreads();
    LAS float* wrT = (LAS float*)F.lds;
    const float* w_router = (const float*)A->in[26];
    for (int i = F.tid; i < 16384; i += 512) { const int d = i >> 4, e = i & 15; wrT[e * 1024 + d] = w_router[i]; }
    __syncthreads();
    const bf16* x1 = (const bf16*)(ws + WS_X1); const float* g2n = (const float*)A->in[25]; const float* mod = (const float*)(ws + WS_MOD);
    bf16* XN2 = (bf16*)(ws + WS_XN); float* aff = (float*)(ws + WS_AFF);
    u32x2 raw[4][4]; load_rows_bf16<4>(x1, gw, NGW, lane, raw);
#pragma unroll 1
    for (int m0 = gw; m0 < M; m0 += 4 * NGW) { f32x4 u[4][4];
        modnorm_rows_pre<4>(raw, m0, NGW, g2n, mod, 3072, 4096, XN2, lane, u);
        if (m0 + 4 * NGW < M) load_rows_bf16<4>(x1, m0 + 4 * NGW, NGW, lane, raw);
        float mylg[4] = {0.f, 0.f, 0.f, 0.f};
#pragma unroll 2
        for (int e = 0; e < 16; ++e) { f32x4 w[4];
#pragma unroll
            for (int j = 0; j < 4; ++j) w[j] = *(const LAS f32x4*)(wrT + e * 1024 + 4 * lane + 256 * j);
#pragma unroll
            for (int i = 0; i < 4; ++i) { float sacc = 0.f;
#pragma unroll
                for (int j = 0; j < 4; ++j) sacc += (u[i][j].x * w[j].x + u[i][j].y * w[j].y) + (u[i][j].z * w[j].z + u[i][j].w * w[j].w);
                sacc = dpp_wave_sum(sacc); mylg[i] = (lane == e) ? sacc : mylg[i]; } }
#pragma unroll
        for (int i = 0; i < 4; ++i) { const int m = m0 + i * NGW, b = m >> 11, t = m & (T - 1);
            float mx = mylg[i];
#pragma unroll
            for (int o = 1; o < 16; o <<= 1) mx = fmaxf(mx, __shfl_xor(mx, o));
            const float ex = expf(mylg[i] - mx); float den = ex;
#pragma unroll
            for (int o = 1; o < 16; o <<= 1) den += __shfl_xor(den, o);
            if (lane < 16) aff[((size_t)b * 16 + lane) * T + t] = ex / den; } }
}

__device__ __forceinline__ void pk_task(const Frame& F, ArgsP A, int b, int e) {
    unsigned char* ws = A->ws;
    const float* aff = (const float*)(ws + WS_AFF) + ((size_t)b * 16 + e) * T;
    int* slotmap = (int*)(ws + WS_SLOT); float* selaff = (float*)(ws + WS_SELAFF); int* selidx = (int*)(ws + WS_SELIDX);
    const bf16* XN2 = (const bf16*)(ws + WS_XN); bf16* XE = (bf16*)(ws + WS_XE);
    LAS unsigned* cnt = (LAS unsigned*)F.lds;
    LAS int* tokl = (LAS int*)(F.lds + 256);
    const int tid = F.tid, lane = F.lane, wave = F.wave;
    const f32x4 v4 = *(const GAS f32x4*)(aff + 4 * tid);
    const unsigned key[4] = {__float_as_uint(v4.x), __float_as_uint(v4.y), __float_as_uint(v4.z), __float_as_uint(v4.w)};
    unsigned thr = 0u;
#pragma unroll 1
    for (int bit = 31; bit >= 0; --bit) { const unsigned cand = thr | (1u << bit);
        const unsigned c = (unsigned)(__popcll(__ballot(key[0] >= cand)) + __popcll(__ballot(key[1] >= cand)) + __popcll(__ballot(key[2] >= cand)) + __popcll(__ballot(key[3] >= cand)));
        LAS unsigned* slot_ = cnt + 16 + (bit & 1) * 8;
        if (lane == 0) slot_[wave] = c;
        __syncthreads();
        unsigned tot = 0;
#pragma unroll
        for (int w = 0; w < 8; ++w) tot += slot_[w];
        if (tot >= 256u) thr = cand; }
    __syncthreads();
    int ngt = 0, neq = 0;
#pragma unroll
    for (int j = 0; j < 4; ++j) { ngt += key[j] > thr; neq += key[j] == thr; }
    int sg = ngt, se = neq;
#pragma unroll
    for (int o = 1; o < 64; o <<= 1) { const int a = __shfl_up(sg, o), c = __shfl_up(se, o); if (lane >= o) { sg += a; se += c; } }
    if (lane == 63) { cnt[wave] = (unsigned)sg; cnt[8 + wave] = (unsigned)se; }
    __syncthreads();
    int bg = 0, be = 0, totg = 0;
#pragma unroll
    for (int w = 0; w < 8; ++w) { const int a = (int)cnt[w], c = (int)cnt[8 + w]; if (w < wave) { bg += a; be += c; } totg += a; }
    int pg = bg + sg - ngt, pe = be + se - neq;
    const int need_eq = 256 - totg;
    int* smrow = slotmap + ((size_t)b * T + 4 * tid) * 16 + e;
#pragma unroll
    for (int j = 0; j < 4; ++j) { int slot = -1;
        if (key[j] > thr) { slot = pg; ++pg; } else if (key[j] == thr) { if (pe < need_eq) slot = totg + pe; ++pe; }
        smrow[j * 16] = slot;
        if (slot >= 0) { selidx[((size_t)e * 16 + b) * 256 + slot] = b * T + 4 * tid + j; selaff[((size_t)e * 16 + b) * 256 + slot] = __uint_as_float(key[j]); } }
    __syncthreads();
}

__device__ __forceinline__ void pn_rows(const Frame& F, ArgsP A, float* wout) {
    unsigned char* ws = A->ws;
    const int* slotmap = (const int*)(ws + WS_SLOT); const bf16* YE = (const bf16*)(ws + WS_XE); const float* mod = (const float*)(ws + WS_MOD); const bf16* X1 = (const bf16*)(ws + WS_X1);
    const int gw = F.vcu * NWAVES + F.wave, NGW = F.G * NWAVES, lane = F.lane;
#pragma unroll 1
    for (int m0 = gw; m0 < M; m0 += 2 * NGW) {
        int myslot[2]; f32x4 xv[2][4];
#pragma unroll
        for (int i = 0; i < 2; ++i) { const int m = m0 + i * NGW; myslot[i] = slotmap[(size_t)m * 16 + (lane & 15)];
#pragma unroll
            for (int hq = 0; hq < 2; ++hq) { const v4u w = *(const GAS v4u*)(X1 + (size_t)m * 1024 + hq * 512 + lane * 8);
                xv[i][2 * hq] = (f32x4){bflo(w.x), bfhi(w.x), bflo(w.y), bfhi(w.y)}; xv[i][2 * hq + 1] = (f32x4){bflo(w.z), bfhi(w.z), bflo(w.w), bfhi(w.w)}; } }
        unsigned long long msk[2]; v4u yw[2][4][2];
#pragma unroll
        for (int i = 0; i < 2; ++i) { const int b = (m0 + i * NGW) >> 11; msk[i] = __ballot(myslot[i] >= 0) & 0xffffull;
#pragma unroll
            for (int k = 0; k < 4; ++k) { const bool has = msk[i] != 0ull; const int e = has ? __builtin_ctzll(msk[i]) : 0; if (has) msk[i] &= msk[i] - 1; const int sl = __shfl(myslot[i], e);
                yw[i][k][0] = (v4u){0u, 0u, 0u, 0u}; yw[i][k][1] = (v4u){0u, 0u, 0u, 0u};
                if (has) { const GAS v4u* yr = (const GAS v4u*)(YE + (((size_t)e * 16 + b) * 256 + sl) * 1024); yw[i][k][0] = yr[lane]; yw[i][k][1] = yr[64 + lane]; } } }
#pragma unroll
        for (int i = 0; i < 2; ++i) { const int m = m0 + i * NGW, b = m >> 11;
            float acc[16];
#pragma unroll
            for (int j = 0; j < 16; ++j) acc[j] = 0.f;
#pragma unroll
            for (int k = 0; k < 4; ++k)
#pragma unroll
                for (int hlf = 0; hlf < 2; ++hlf) { const v4u w = yw[i][k][hlf];
                    acc[hlf * 8 + 0] += bflo(w.x); acc[hlf * 8 + 1] += bfhi(w.x); acc[hlf * 8 + 2] += bflo(w.y); acc[hlf * 8 + 3] += bfhi(w.y);
                    acc[hlf * 8 + 4] += bflo(w.z); acc[hlf * 8 + 5] += bfhi(w.z); acc[hlf * 8 + 6] += bflo(w.w); acc[hlf * 8 + 7] += bfhi(w.w); }
            unsigned long long mk = msk[i];
            while (mk) { const int e = __builtin_ctzll(mk); mk &= mk - 1; const int sl = __shfl(myslot[i], e);
                const GAS v4u* yr = (const GAS v4u*)(YE + (((size_t)e * 16 + b) * 256 + sl) * 1024);
#pragma unroll
                for (int hlf = 0; hlf < 2; ++hlf) { const v4u w = yr[hlf * 64 + lane];
                    acc[hlf * 8 + 0] += bflo(w.x); acc[hlf * 8 + 1] += bfhi(w.x); acc[hlf * 8 + 2] += bflo(w.y); acc[hlf * 8 + 3] += bfhi(w.y);
                    acc[hlf * 8 + 4] += bflo(w.z); acc[hlf * 8 + 5] += bfhi(w.z); acc[hlf * 8 + 6] += bflo(w.w); acc[hlf * 8 + 7] += bfhi(w.w); } }
            const float* gt2 = mod + (size_t)b * 6144 + 5120; float* orow = wout + (size_t)m * 1024;
#pragma unroll
            for (int q = 0; q < 4; ++q) { const int c = (q >> 1) * 512 + lane * 8 + (q & 1) * 4; const f32x4 g = *(const GAS f32x4*)(gt2 + c);
                f32x4 a; a.x = acc[(q >> 1) * 8 + (q & 1) * 4 + 0]; a.y = acc[(q >> 1) * 8 + (q & 1) * 4 + 1]; a.z = acc[(q >> 1) * 8 + (q & 1) * 4 + 2]; a.w = acc[(q >> 1) * 8 + (q & 1) * 4 + 3];
                *(GAS f32x4*)(orow + c) = xv[i][q] + g * a; } } }
}

__device__ __forceinline__ void mk_frame(Frame& F, LAS unsigned char* lds, int wave_s) {
    int bx = blockIdx.x, G = gridDim.x; LAUNDER(bx); LAUNDER(G);
    F.lds = lds; F.MISC = (volatile LAS unsigned*)(lds + MISC_OFF); F.ctl = nullptr;
    unsigned ones_ = ~0u; asm volatile("" : "+s"(ones_));
    int lane_ = (int)__builtin_amdgcn_mbcnt_hi(ones_, __builtin_amdgcn_mbcnt_lo(ones_, 0u)); asm volatile("" : "+v"(lane_));
    F.lane = lane_; F.wave = wave_s; F.tid = wave_s * 64 + lane_;
    F.G = G; F.vcu = (G % 8 == 0) ? (bx % 8) * (G / 8) + bx / 8 : bx;
}
__global__ void __launch_bounds__(NWAVES * 64, 2) fwd_kernel(Args args) {
    extern __shared__ __attribute__((aligned(16))) unsigned char lds[];
    LAS unsigned char* const ldsb = (LAS unsigned char*)lds;
    ArgsP ap0 = (ArgsP)__builtin_amdgcn_kernarg_segment_ptr();
    int wave_s = __builtin_amdgcn_readfirstlane((int)threadIdx.x >> 6); asm volatile("" : "+s"(wave_s));
    for (int u = threadIdx.x; u < (LDS_BYTES - LDSCTL_OFF) / 4; u += NWAVES * 64) ((LAS unsigned*)(ldsb + LDSCTL_OFF))[u] = 0u;
    __syncthreads();
#define MKBAR XcdBarrier bar; { ArgsP a_ = ap0; LAUNDER(a_); bar.bar = (unsigned*)(a_->ws + WS_CTL) + CW_BAR; bar.x = xb_xcc_id(); bar.st = (volatile LAS unsigned*)(ldsb + MISC_OFF) + 8; }
#if ONE_LAUNCH
    { MKBAR; if (threadIdx.x == 0) (void)xb_add(&bar.bar[XB_XCNT(bar.x)], 1u); }
#ifndef PHM
#define PHM 0x3fff
#endif
#define IN(k) ((PHM >> (k)) & 1)
#define SEAM(k) do { if (IN(k) && IN((k) + 1)) { MKBAR; { unsigned o_ = ~0u; asm volatile("" : "+s"(o_)); xcd_barrier(bar, wave_s == 0 && __builtin_amdgcn_mbcnt_hi(o_, __builtin_amdgcn_mbcnt_lo(o_, 0u)) == 0u); } } } while (0)
#else
    int lo, hi; { ArgsP a = ap0; LAUNDER(a); lo = a->ph_lo; hi = a->ph_hi; }
#define IN(k) (lo <= (k) && (k) < hi)
#define SEAM(k) do { } while (0)
#endif
    typedef pg8::bf16_t pb;
#ifndef REPMASK
#define REPMASK 0
#endif
#define PHASE_ARGS ArgsP ap = ap0; LAUNDER(ap); unsigned char* ws = ap->ws; (void)ws; Frame F; mk_frame(F, ldsb, wave_s); const int gw = F.vcu * NWAVES + F.wave, NGW = F.G * NWAVES; (void)gw; (void)NGW
    if (IN(0)) _Pragma("unroll 1") for (int rep_ = 0; rep_ <= ((REPMASK >> 0) & 1); ++rep_) { PHASE_ARGS; p0_prologue(F, ap); } SEAM(0);
    if (IN(1)) _Pragma("unroll 1") for (int rep_ = 0; rep_ <= ((REPMASK >> 1) & 1); ++rep_) { PHASE_ARGS; const float* x = (const float*)ap->in[0]; const float* g1 = (const float*)ap->in[5]; const float* mod = (const float*)(ws + WS_MOD); bf16* XN = (bf16*)(ws + WS_XN);
#pragma unroll 1
        for (int m = gw; m < M; m += 4 * NGW) { f32x4 u[4][4]; modnorm_rows<4, false>(x, m, NGW, g1, mod, 0, 1024, XN, F.lane, u);
            if (F.lane < 32) { const int mm = m + (F.lane >> 3) * NGW, j = F.lane & 7; const float pos = (float)((const int*)ap->in[2])[mm];
                const float ang = pos * __expf(-(float)j * 0.125f * 13.122363377404328f); float sn, cs; sincosf(ang, &sn, &cs);
                bf16* rt = (bf16*)(ws + WS_ROPE) + (size_t)mm * 16; rt[j] = (bf16)(pk2(cs, 0.f) & 0xffffu); rt[8 + j] = (bf16)(pk2(sn, 0.f) & 0xffffu); } } } SEAM(1);
    if (IN(2)) _Pragma("unroll 1") for (int rep_ = 0; rep_ <= ((REPMASK >> 2) & 1); ++rep_) { PHASE_ARGS; pg8::Gemm g{(const pb*)(ws + WS_XN), (const pb*)(ws + WS_WINT), M, NZP, D}; pg8::StaticOrder S; S.init(M, NZP, F.G, (int)blockIdx.x);
        pg8::EpiZ E{(pb*)(ws + WS_Z)}; pg8::gemm_phase<pg8::EpiZ, pg8::StaticOrder, true, true>(F.lds, g, S, E, F.tid); } SEAM(2);
    if (IN(3)) {
#ifndef REP_SCAN
#define REP_SCAN 1
#endif
#ifndef REP_ATTN
#define REP_ATTN 1
#endif
      { int c0_, G_; { Frame F0; mk_frame(F0, ldsb, wave_s); c0_ = F0.vcu; G_ = F0.G; }
#pragma unroll 1
        for (int c = c0_; c < 256 * REP_SCAN; c += G_) { PHASE_ARGS; const int b = (c >> 4) & 15, h = (c >> 1) & 7, dir = c & 1;
            scan2_setup(F.lds, (const GAS float*)ap->in[10], (const GAS float*)ap->in[12], h, dir, F.tid); __syncthreads();
            const ScanArgs SA{(const GAS bf16*)(ws + WS_Z), (const GAS float*)ap->in[7], (const GAS float*)ap->in[8], (const GAS float*)ap->in[9], (const GAS float*)ap->in[11], (const GAS float*)ap->in[14], (const GAS float*)ap->in[15], (const GAS float*)ap->in[16],
                              (GAS bf16*)(ws + WS_XN) + (size_t)dir * M * 512, (GAS float*)(ws + WS_BONUS) + (size_t)dir * M * 8};
#pragma unroll 1
            for (int cc = F.wave; cc < T / 32; cc += 8) scan2_chunk(F.lds, SA, b, h, dir, cc, F.lane, F.wave);
            __syncthreads(); } }
      { PHASE_ARGS;
#pragma unroll 1
        for (int u = F.vcu; u < 512 * REP_ATTN; u += F.G) { attn_unit(F, ap, (u >> 5) & 15, (u >> 4) & 1, u & 15); } }
      { PHASE_ARGS;
        const bf16* Z = (const bf16*)(ws + WS_Z); bf16* SGD = (bf16*)(ws + WS_SGD); const float* mu_prev = (const float*)ap->in[7]; const float* mu_next = (const float*)ap->in[8];
          const int c = ZGD + 2 * F.lane; const float mp0 = mu_prev[c], mp1 = mu_prev[c + 1], mn0 = mu_next[c], mn1 = mu_next[c + 1];
#ifndef REP_SGD
#define REP_SGD 1
#endif
          const int tile = F.vcu;
          if (tile < 256) { const int pm = tile >> 1, pn = tile & 1; constexpr int RS = 136;
              LAS bf16* SG = (LAS bf16*)F.lds; LAS bf16* GT = (LAS bf16*)(F.lds + 256 * RS * 2);
              __syncthreads();
              const int mt0 = pm * 256 + F.wave * 32;
#pragma unroll 1
              for (int m0 = 0; m0 < 32; m0 += 4) { unsigned z0[4], zm[4], zq[4];
#pragma unroll
                  for (int i = 0; i < 4; ++i) { const int m = mt0 + m0 + i, t = m & (T - 1);
                      z0[i] = *(const GAS unsigned*)(Z + (size_t)m * NZ + c); zm[i] = t > 0 ? *(const GAS unsigned*)(Z + (size_t)(m - 1) * NZ + c) : 0u; zq[i] = t < T - 1 ? *(const GAS unsigned*)(Z + (size_t)(m + 1) * NZ + c) : 0u; }
#pragma unroll
                  for (int i = 0; i < 4; ++i) { const float a0 = bflo(z0[i]), a1 = bfhi(z0[i]); const float s0 = a0 + mp0 * (bflo(zm[i]) - a0) + mn0 * (bflo(zq[i]) - a0), s1 = a1 + mp1 * (bfhi(zm[i]) - a1) + mn1 * (bfhi(zq[i]) - a1);
                      *(LAS unsigned*)(SG + (F.wave * 32 + m0 + i) * RS + 2 * F.lane) = pk2(sigm(s0), sigm(s1)); } }
              __syncthreads();
              const int r32 = F.lane & 31, hh = F.lane >> 5; bf16x8 af[8];
#pragma unroll
              for (int sI = 0; sI < 8; ++sI) af[sI] = *(const LAS bf16x8*)(SG + (F.wave * 32 + r32) * RS + 16 * sI + 8 * hh);
              bf16* Gout = (bf16*)(ws + WS_G); const bf16* G2T = (const bf16*)(ws + WS_G2T);
#pragma unroll 1
              for (int hf = 0; hf < 2; ++hf) {
#pragma unroll
                  for (int i = 0; i < 4; ++i) { const int e = F.tid + 512 * i, rr = e >> 4, ch = e & 15; *(LAS v4u*)(GT + rr * RS + ch * 8) = *(const GAS v4u*)(G2T + (size_t)(256 * pn + 128 * hf + rr) * 256 + ch * 8); }
                  __syncthreads();
#pragma unroll 1
                  for (int ct = 0; ct < 4; ++ct) { f32x16 acc = {};
#pragma unroll
                      for (int sI = 0; sI < 8; ++sI) { const bf16x8 bfr = *(const LAS bf16x8*)(GT + (32 * ct + r32) * RS + 16 * sI + 8 * hh); acc = __builtin_amdgcn_mfma_f32_32x32x16_bf16(af[sI], bfr, acc, 0, 0, 0); }
#pragma unroll
                      for (int g = 0; g < 16; ++g) { const int row = (g & 3) + 8 * (g >> 2) + 4 * hh;
                          Gout[(size_t)(mt0 + row) * 512 + 256 * pn + 128 * hf + 32 * ct + r32] = (bf16)(pk2(acc[g], 0.f) & 0xffffu); } }
                  __syncthreads(); } } }
    } SEAM(4);
#ifndef REP_PG
#define REP_PG 0
#endif
    if (IN(5)) { PHASE_ARGS; if (REP_PG) pg_rows(F, ap, (bf16*)ap->out); pg_rows(F, ap, (bf16*)(ws + WS_G)); } SEAM(5);
    if (IN(6)) { PHASE_ARGS; static_assert(WS_G == WS_OATT + (size_t)M * 512 * 2 && WS_PAT == WS_PRT + (size_t)1024 * 512 * 2, "merged operand views need adjacent buffers");
        pg8::Gemm g{(const pb*)(ws + WS_OATT), (const pb*)(ws + WS_PRT), 2 * M, 2048, 512}; pg8::MergeOrder S; S.init(F.G, (int)blockIdx.x);
        pg8::EpiGate2 E{(pb*)(ws + WS_XN), (const pb*)(ws + WS_Z)}; pg8::gemm_phase<pg8::EpiGate2, pg8::MergeOrder, true, true>(F.lds, g, S, E, F.tid); } SEAM(7);
    if (IN(8)) _Pragma("unroll 1") for (int rep_ = 0; rep_ <= ((REPMASK >> 8) & 1); ++rep_) { PHASE_ARGS; pg8::Gemm g{(const pb*)(ws + WS_XN), (const pb*)(ws + WS_WOT), M, 1024, 1024}; pg8::StaticOrder S; S.init(M, 1024, F.G, (int)blockIdx.x);
        pg8::EpiRes E{(const float*)ap->in[0], (const float*)(ws + WS_MOD), (pb*)(ws + WS_X1)}; pg8::gemm_phase<pg8::EpiRes, pg8::StaticOrder, true, true>(F.lds, g, S, E, F.tid); } SEAM(8);
    if (IN(9)) _Pragma("unroll 1") for (int rep_ = 0; rep_ <= ((REPMASK >> 9) & 1); ++rep_) { PHASE_ARGS; pj_phase(F, ap); } SEAM(9);
    if (IN(10)) _Pragma("unroll 1") for (int rep_ = 0; rep_ <= ((REPMASK >> 10) & 1); ++rep_) { PHASE_ARGS; for (int p = F.vcu; p < 256; p += F.G) pk_task(F, ap, p >> 4, p & 15); } SEAM(10);
    if (IN(11)) _Pragma("unroll 1") for (int rep_ = 0; rep_ <= ((REPMASK >> 11) & 1); ++rep_) { PHASE_ARGS; pg8::Gemm g{(const pb*)(ws + WS_XN), (const pb*)((unsigned char*)ap->out + OUT_WGUT), ME, 16 * 2048, 1024}; pg8::GroupOrder<8> S{F.G, (int)blockIdx.x};
        pg8::EpiSwiglu E{(pb*)(ws + WS_H)}; pg8::gemm_phase<pg8::EpiSwiglu, pg8::GroupOrder<8>, true, true, true>(F.lds, g, S, E, F.tid, (const int*)(ws + WS_SELIDX)); } SEAM(11);
    if (IN(12)) _Pragma("unroll 1") for (int rep_ = 0; rep_ <= ((REPMASK >> 12) & 1); ++rep_) { PHASE_ARGS; pg8::Gemm g{(const pb*)(ws + WS_H), (const pb*)((unsigned char*)ap->out + OUT_WDT), ME, 16 * 1024, 1024}; pg8::GroupOrder<4> S{F.G, (int)blockIdx.x};
        pg8::EpiDown E{(pb*)(ws + WS_XE), (const float*)(ws + WS_SELAFF)}; pg8::gemm_phase<pg8::EpiDown, pg8::GroupOrder<4>, true, true>(F.lds, g, S, E, F.tid); } SEAM(12);
#ifndef EXTRA_BARS
#define EXTRA_BARS 0
#endif
#if ONE_LAUNCH
    _Pragma("unroll 1") for (int xb_ = 0; xb_ < EXTRA_BARS; ++xb_) { MKBAR; { unsigned o_ = ~0u; asm volatile("" : "+s"(o_)); xcd_barrier(bar, wave_s == 0 && __builtin_amdgcn_mbcnt_hi(o_, __builtin_amdgcn_mbcnt_lo(o_, 0u)) == 0u); } }
#endif
#ifndef REP_PN
#define REP_PN 0
#endif
    if (IN(13)) { PHASE_ARGS; if (REP_PN) pn_rows(F, ap, (float*)(ws + WS_H)); pn_rows(F, ap, ap->out); }
#undef IN
#undef SEAM
}

extern "C" void kernel_launch(void* const* d_in, const int* in_sizes, int n_in, void* d_out, int out_size, void* d_ws, size_t ws_size, hipStream_t stream) {
    static int grid = 0;
    if (grid == 0) {
        if (n_in != 30 || out_size != M * D || ws_size < WS_END) { fprintf(stderr, "kernel_launch: unexpected shapes n_in %d out %d ws %zu\n", n_in, out_size, ws_size); grid = -1; return; }
        int dev = 0, cus = 0, per_cu = 0;
        if (hipGetDevice(&dev) != hipSuccess || hipDeviceGetAttribute(&cus, hipDeviceAttributeMultiprocessorCount, dev) != hipSuccess) { grid = -1; return; }
        if (hipFuncSetAttribute((const void*)fwd_kernel, hipFuncAttributeMaxDynamicSharedMemorySize, LDS_BYTES) != hipSuccess) { fprintf(stderr, "kernel_launch: hipFuncSetAttribute failed\n"); grid = -1; return; }
        if (hipOccupancyMaxActiveBlocksPerMultiprocessor(&per_cu, (const void*)fwd_kernel, NWAVES * 64, LDS_BYTES) != hipSuccess || per_cu < 1) fprintf(stderr, "kernel_launch: occupancy query reports %d\n", per_cu);
        (void)hipGetLastError();
        grid = cus;
    }
    if (grid < 0) return;
    if (hipMemsetAsync((char*)d_ws + WS_CTL, 0, CTL_ZERO_BYTES, stream) != hipSuccess) return;
    Args a{};
    for (int i = 0; i < 30; ++i) a.in[i] = d_in[i];
    a.out = (float*)d_out; a.ws = (unsigned char*)d_ws;
#if ONE_LAUNCH
    a.ph_lo = 0; a.ph_hi = NPHASE;
    hipLaunchKernelGGL(fwd_kernel, dim3(grid), dim3(NWAVES * 64), LDS_BYTES, stream, a);
#else
    for (int p = 0; p < NPHASE; ++p) { a.ph_lo = p; a.ph_hi = p + 1; hipLaunchKernelGGL(fwd_kernel, dim3(grid), dim3(NWAVES * 64), LDS_BYTES, stream, a); }
#endif
}
```

```cpp
#include <hip/hip_runtime.h>
#include <cstdio>
#include <cstdint>
#include <cmath>
namespace pg8 {
#define PG8_LAS __attribute__((address_space(3)))
typedef unsigned short bf16_t;
typedef short bf16x8 __attribute__((ext_vector_type(8)));
typedef float f32x4 __attribute__((ext_vector_type(4)));
typedef unsigned u32x4 __attribute__((ext_vector_type(4)));
constexpr int BM = 256, BK = 64, HALF = 128, HTB = HALF * BK * 2  , STAGE_BYTES = 8 * HTB, NXCD = 8, WGM = 8;

__host__ __device__ __forceinline__ int lds_byte(int r, int c) { const int st = (r >> 4) * 2 + (c >> 5), rr = r & 15, cc = c & 31, ob = rr * 64 + cc * 2; return st * 1024 + (ob ^ (((ob >> 9) & 1) << 5)); }
__host__ __device__ __forceinline__ void stage_rc(int b, int& R, int& C) { const int st = b / 1024, sb = b % 1024, swz = sb ^ (((sb >> 9) & 1) << 5); R = (st >> 1) * 16 + swz / 64; C = (st & 1) * 32 + (swz % 64) / 2; }
__host__ __device__ __forceinline__ int perm32(int rho) { const int n = rho >> 4, i = rho & 15; return 8 * (i >> 2) + 4 * n + (i & 3); }

struct Unit { int pm, pn; };
struct Gemm { const bf16_t* A; const bf16_t* Bt; int M, N, K; };

struct StaticOrder {
    int nM, nN, nwg, G, c;
    __host__ __device__ void init(int M, int N, int G_, int c_) { nM = M / BM; nN = N / BM; nwg = nM * nN; G = G_; c = c_; }
    __host__ __device__ bool next(int i, Unit& u) const {
        const long L = (long)i * G + c; if (L >= nwg) return false;
        int wgid = (int)L; { const int q = nwg / NXCD, r = nwg % NXCD, xcd = wgid % NXCD, off = wgid / NXCD; wgid = (xcd < r ? xcd * (q + 1) : r * (q + 1) + (xcd - r) * q) + off; }
        const int nig = WGM * nN, gid = wgid / nig, fm = gid * WGM, gsz = (nM - fm) < WGM ? (nM - fm) : WGM;
        u.pm = fm + ((wgid % nig) % gsz); u.pn = (wgid % nig) / gsz; return true;
    }
    __device__ __forceinline__ void a_ready(const Unit&) const {}
    __device__ __forceinline__ void done(const Unit&) const {}
};

__device__ __forceinline__ unsigned cvt_pk_bf16(float lo, float hi) { unsigned r; asm volatile("v_cvt_pk_bf16_f32 %0, %1, %2" : "=v"(r) : "v"(lo), "v"(hi)); return r; }
typedef float f32x2 __attribute__((ext_vector_type(2)));
template <class Epi, class Sched, bool ALIGN_EPI = false, bool SP2 = false, bool GATHER = false>
__device__ __forceinline__ void gemm_phase(PG8_LAS unsigned char* lds, const Gemm g, const Sched& S, const Epi& E, int tid_in, const int* gidx = nullptr) {
    static_assert(!GATHER || SP2, "the gather variant is written for the SP2 loop");
    int tid_ = tid_in; asm volatile("" : "+v"(tid_));
    const int tid = tid_, wid = __builtin_amdgcn_readfirstlane(tid >> 6), lane = tid & 63, wr = wid >> 2, wc = wid & 3, fr = lane & 15, fq = lane >> 4;
    const int K = g.K, nt = K / BK;
    unsigned voffA[2], voffB[2];
#pragma unroll
    for (int i = 0; i < 2; ++i) { int R, C; stage_rc(tid * 16 + i * 8192, R, C); const int Rb = Epi::PERM ? ((R & ~31) + perm32(R & 31)) : R;
        voffA[i] = (unsigned)(R * K + C) * 2u; voffB[i] = (unsigned)(Rb * K + C) * 2u; }
    int gRA[2] = {0, 0}; unsigned gCA[2] = {0u, 0u}; unsigned gc[2][2] = {{0u, 0u}, {0u, 0u}}, gn[2][2] = {{0u, 0u}, {0u, 0u}};
    if constexpr (GATHER) {
#pragma unroll
        for (int i = 0; i < 2; ++i) { int R, C; stage_rc(tid * 16 + i * 8192, R, C); gRA[i] = R; gCA[i] = (unsigned)C * 2u; } }
#define PG8_GLOAD(dst, un) do { _Pragma("unroll") for (int h_ = 0; h_ < 2; ++h_) _Pragma("unroll") for (int i_ = 0; i_ < 2; ++i_) \
        dst[h_][i_] = (unsigned)gidx[(un).pm * 256 + h_ * 128 + gRA[i_]] * (unsigned)(K * 2) + gCA[i_]; } while (0)
#define PG8_STAGE_G(bufoff, gbase, nx, h) do { unsigned vo_[2] = {(nx) ? gn[h][0] : gc[h][0], (nx) ? gn[h][1] : gc[h][1]}; PG8_STAGE(bufoff, gbase, vo_); } while (0)
    const size_t kstep = (size_t)(BK * 2);
    const size_t hstep = (size_t)HALF * K * 2;
    const size_t tstep = 2 * hstep;
    const unsigned ldsw = (unsigned)wid * 1024u;
    const int aoff = lds_byte(wr * 64 + fr, fq * 8), boff = lds_byte(wc * 32 + fr, fq * 8);
#define PG8_SA(b, h) (((b) * 2 + (h)) * HTB)
#define PG8_SB(b, h) ((4 + (b) * 2 + (h)) * HTB)
#define PG8_STAGE(bufoff, gbase, voff) do { _Pragma("unroll") for (int _i = 0; _i < 2; ++_i) \
        __builtin_amdgcn_global_load_lds((const unsigned*)((const char*)(gbase) + (voff)[_i]), (PG8_LAS unsigned*)(lds + (bufoff) + ldsw + _i * 8192), 16, 0, 0); } while (0)
#define PG8_LDA(dst, b, h) do { _Pragma("unroll") for (int m = 0; m < 4; ++m) _Pragma("unroll") for (int k = 0; k < 2; ++k) dst[m][k] = *(const PG8_LAS bf16x8*)(lds + PG8_SA(b, h) + aoff + m * 2048 + k * 1024); } while (0)
#define PG8_LDB(dst, b, h) do { _Pragma("unroll") for (int n = 0; n < 2; ++n) _Pragma("unroll") for (int k = 0; k < 2; ++k) dst[n][k] = *(const PG8_LAS bf16x8*)(lds + PG8_SB(b, h) + boff + n * 2048 + k * 1024); } while (0)
#define PG8_MMA(ai, bj, At, Bt) do { __builtin_amdgcn_s_setprio(1); _Pragma("unroll") for (int m = 0; m < 4; ++m) _Pragma("unroll") for (int n = 0; n < 2; ++n) _Pragma("unroll") for (int k = 0; k < 2; ++k) \
        acc[ai][bj][m][n] = __builtin_amdgcn_mfma_f32_16x16x32_bf16(Bt[n][k], At[m][k], acc[ai][bj][m][n], 0, 0, 0); __builtin_amdgcn_s_setprio(0); } while (0)
#define PG8_WAIT_V(n) asm volatile("s_waitcnt vmcnt(" #n ")" ::: "memory")
#define PG8_WAIT_L(n) asm volatile("s_waitcnt lgkmcnt(" #n ")" ::: "memory")
#define PG8_BAR __builtin_amdgcn_s_barrier()
#define PG8_SCHED __builtin_amdgcn_sched_barrier(0)
    Unit cur, nxt; int ui = 0;
    if (!S.next(0, cur)) return;
    f32x4 acc[2][2][4][2];
#pragma unroll
    for (int a = 0; a < 2; ++a)
#pragma unroll
        for (int b = 0; b < 2; ++b)
#pragma unroll
            for (int m = 0; m < 4; ++m)
#pragma unroll
                for (int n = 0; n < 2; ++n) acc[a][b][m][n] = (f32x4){0.f, 0.f, 0.f, 0.f};
    bf16x8 At[4][2], B0[2][2], B1[2][2];
    const char* cA = GATHER ? (const char*)g.A : (const char*)g.A + (size_t)cur.pm * tstep; const char* cB = (const char*)g.Bt + (size_t)cur.pn * tstep;
    if constexpr (GATHER) { PG8_GLOAD(gc, cur); Unit n1_; if (S.next(1, n1_)) PG8_GLOAD(gn, n1_); else { gn[0][0] = gc[0][0]; gn[0][1] = gc[0][1]; gn[1][0] = gc[1][0]; gn[1][1] = gc[1][1]; } }
    S.a_ready(cur);
    if constexpr (SP2) {
        PG8_STAGE(PG8_SB(0, 0), cB, voffB); PG8_STAGE(PG8_SB(0, 1), cB + hstep, voffB);
        if constexpr (GATHER) { PG8_STAGE_G(PG8_SA(0, 0), cA, false, 0); PG8_STAGE_G(PG8_SA(0, 1), cA, false, 1); } else { PG8_STAGE(PG8_SA(0, 0), cA, voffA); PG8_STAGE(PG8_SA(0, 1), cA + hstep, voffA); }
        if (wr == 1) PG8_BAR;
        PG8_WAIT_V(2); PG8_BAR;
        PG8_STAGE(PG8_SB(1, 0), cB + kstep, voffB); if constexpr (GATHER) PG8_STAGE_G(PG8_SA(1, 0), cA + kstep, false, 0); else PG8_STAGE(PG8_SA(1, 0), cA + kstep, voffA); PG8_STAGE(PG8_SB(1, 1), cB + hstep + kstep, voffB);
        PG8_WAIT_V(6); PG8_BAR;
    } else {
        PG8_STAGE(PG8_SB(0, 0), cB, voffB); PG8_STAGE(PG8_SA(0, 0), cA, voffA); PG8_STAGE(PG8_SB(0, 1), cB + hstep, voffB); PG8_STAGE(PG8_SA(0, 1), cA + hstep, voffA);
        if (wr == 1) PG8_BAR;
        PG8_WAIT_V(4); PG8_BAR;
        PG8_STAGE(PG8_SB(1, 0), cB + kstep, voffB); PG8_STAGE(PG8_SA(1, 0), cA + kstep, voffA); PG8_STAGE(PG8_SB(1, 1), cB + hstep + kstep, voffB);
        PG8_WAIT_V(6); PG8_BAR;
    }
    for (;;) {
        const bool has_next = S.next(ui + 1, nxt);
        if constexpr (GATHER) { if (!has_next) { gn[0][0] = gc[0][0]; gn[0][1] = gc[0][1]; gn[1][0] = gc[1][0]; gn[1][1] = gc[1][1]; } }
        const char* nA = (has_next && !GATHER) ? (const char*)g.A + (size_t)nxt.pm * tstep : cA; const char* nB = has_next ? (const char*)g.Bt + (size_t)nxt.pn * tstep : cB;
        for (int t = 0; t < nt; t += 2) {
            const bool last = (t == nt - 2);
            const char* a1 = cA + (size_t)(t + 1) * kstep;
            const char* a2 = last ? nA : cA + (size_t)(t + 2) * kstep; const char* b2 = last ? nB : cB + (size_t)(t + 2) * kstep;
            const char* a3 = a2 + kstep; const char* b3 = b2 + kstep;
            if (last && has_next) S.a_ready(nxt);
            if constexpr (SP2) {
            PG8_LDB(B0, 0, 0); PG8_LDB(B1, 0, 1); PG8_SCHED; PG8_LDA(At, 0, 0); if constexpr (GATHER) PG8_STAGE_G(PG8_SA(1, 1), a1, false, 1); else PG8_STAGE(PG8_SA(1, 1), a1 + hstep, voffA);
            PG8_WAIT_V(8); PG8_WAIT_L(0); PG8_BAR; PG8_MMA(0, 0, At, B0); PG8_MMA(0, 1, At, B1); PG8_BAR; PG8_SCHED;
            PG8_LDA(At, 0, 1); PG8_STAGE(PG8_SB(0, 0), b2, voffB); PG8_STAGE(PG8_SB(0, 1), b2 + hstep, voffB); if constexpr (GATHER) PG8_STAGE_G(PG8_SA(0, 0), a2, last, 0); else PG8_STAGE(PG8_SA(0, 0), a2, voffA);
            PG8_WAIT_V(8); PG8_WAIT_L(0); PG8_BAR; PG8_MMA(1, 0, At, B0); PG8_MMA(1, 1, At, B1); PG8_BAR; PG8_SCHED;
            PG8_LDB(B0, 1, 0); PG8_LDB(B1, 1, 1); PG8_SCHED; PG8_LDA(At, 1, 0); if constexpr (GATHER) PG8_STAGE_G(PG8_SA(0, 1), a2, last, 1); else PG8_STAGE(PG8_SA(0, 1), a2 + hstep, voffA);
            PG8_WAIT_V(8); PG8_WAIT_L(0); PG8_BAR; PG8_MMA(0, 0, At, B0); PG8_MMA(0, 1, At, B1); PG8_BAR; PG8_SCHED;
            PG8_LDA(At, 1, 1); PG8_STAGE(PG8_SB(1, 0), b3, voffB); PG8_STAGE(PG8_SB(1, 1), b3 + hstep, voffB); if constexpr (GATHER) PG8_STAGE_G(PG8_SA(1, 0), a3, last, 0); else PG8_STAGE(PG8_SA(1, 0), a3, voffA);
            PG8_WAIT_V(8); PG8_WAIT_L(0); PG8_BAR; PG8_MMA(1, 0, At, B0); PG8_MMA(1, 1, At, B1); PG8_BAR; PG8_SCHED;
            } else {
            PG8_LDB(B0, 0, 0); PG8_SCHED; PG8_LDA(At, 0, 0); PG8_STAGE(PG8_SA(1, 1), a1 + hstep, voffA);
            PG8_WAIT_L(8); PG8_BAR; PG8_WAIT_L(0); PG8_MMA(0, 0, At, B0); PG8_BAR; PG8_SCHED;
            PG8_LDB(B1, 0, 1); PG8_STAGE(PG8_SB(0, 0), b2, voffB);
            PG8_BAR; PG8_WAIT_L(0); PG8_MMA(0, 1, At, B1); PG8_BAR;
            PG8_LDA(At, 0, 1); PG8_STAGE(PG8_SA(0, 0), a2, voffA);
            PG8_BAR; PG8_WAIT_L(0); PG8_MMA(1, 0, At, B0); PG8_BAR; PG8_SCHED;
            PG8_STAGE(PG8_SB(0, 1), b2 + hstep, voffB);
            PG8_WAIT_V(6); PG8_BAR; PG8_MMA(1, 1, At, B1); PG8_BAR;
            PG8_LDB(B0, 1, 0); PG8_SCHED; PG8_LDA(At, 1, 0); PG8_STAGE(PG8_SA(0, 1), a2 + hstep, voffA);
            PG8_WAIT_L(8); PG8_BAR; PG8_WAIT_L(0); PG8_MMA(0, 0, At, B0); PG8_BAR; PG8_SCHED;
            PG8_LDB(B1, 1, 1); PG8_STAGE(PG8_SB(1, 0), b3, voffB);
            PG8_BAR; PG8_WAIT_L(0); PG8_MMA(0, 1, At, B1); PG8_BAR;
            PG8_LDA(At, 1, 1); PG8_STAGE(PG8_SA(1, 0), a3, voffA);
            PG8_BAR; PG8_WAIT_L(0); PG8_MMA(1, 0, At, B0); PG8_BAR; PG8_SCHED;
            PG8_STAGE(PG8_SB(1, 1), b3 + hstep, voffB);
            PG8_WAIT_V(6); PG8_BAR; PG8_MMA(1, 1, At, B1); PG8_BAR;
            }
        }
        if constexpr (ALIGN_EPI) { if (wr == 0) PG8_BAR; }
        if constexpr (!Epi::AFTER_DRAIN) { E(acc, cur, wr, wc, fr, fq); S.done(cur); }
        unsigned g2_[2][2] = {{0u, 0u}, {0u, 0u}};
        if constexpr (GATHER) { Unit nn_; if (has_next && S.next(ui + 2, nn_)) PG8_GLOAD(g2_, nn_); else { g2_[0][0] = gn[0][0]; g2_[0][1] = gn[0][1]; g2_[1][0] = gn[1][0]; g2_[1][1] = gn[1][1]; } }
        if (!has_next) break;
#pragma unroll
        for (int a = 0; a < 2; ++a)
#pragma unroll
            for (int b = 0; b < 2; ++b)
#pragma unroll
                for (int m = 0; m < 4; ++m)
#pragma unroll
                    for (int n = 0; n < 2; ++n) acc[a][b][m][n] = (f32x4){0.f, 0.f, 0.f, 0.f};
        cur = nxt; cA = nA; cB = nB; ++ui;
        if constexpr (GATHER) { gc[0][0] = gn[0][0]; gc[0][1] = gn[0][1]; gc[1][0] = gn[1][0]; gc[1][1] = gn[1][1]; gn[0][0] = g2_[0][0]; gn[0][1] = g2_[0][1]; gn[1][0] = g2_[1][0]; gn[1][1] = g2_[1][1]; }
        if constexpr (ALIGN_EPI) { if (wr == 1) PG8_BAR; }
    }
    PG8_WAIT_V(0);
    if constexpr (!ALIGN_EPI) { if (wr == 0) PG8_BAR; }
    PG8_BAR;
    if constexpr (Epi::AFTER_DRAIN) { E.fused(acc, cur, wr, wc, fr, fq, lds, wid, lane); S.done(cur); }
#undef PG8_SA
#undef PG8_SB
#undef PG8_STAGE
#undef PG8_STAGE_G
#undef PG8_GLOAD
#undef PG8_LDA
#undef PG8_LDB
#undef PG8_MMA
#undef PG8_WAIT_V
#undef PG8_WAIT_L
#undef PG8_BAR
#undef PG8_SCHED
}
}

#ifndef ONE_LAUNCH
#define ONE_LAUNCH 1
#endif
constexpr int NB = 16, T = 2048, D = 1024, M = NB * T;
constexpr int NZ = 4736, NZP = 4864;
constexpr int RW = 512, NE = 16, CAP = 256, ME = NE * NB * CAP;
constexpr int ZR = 0, ZK = 512, ZV = 1024, ZWD = 1536, ZAD = 1664, ZGD = 1792, ZQ = 1920, ZKA = 2432, ZVA = 2560, ZGA = 2688, ZGB = 3712;
constexpr int NWAVES = 8, NPHASE = 14;
constexpr size_t MiB = 1u << 20;
constexpr size_t WS_CTL = 0, CTL_ZERO_BYTES = 64 * 1024 + 16 * 6144 * 4;
constexpr size_t WS_MOD = 64 * 1024, WS_BONUS = 2 * MiB, WS_AFF = 4 * MiB, WS_SELAFF = 6 * MiB, WS_SLOT = 7 * MiB, WS_G2T = 9 * MiB;
constexpr size_t WS_WINT = 10 * MiB, WS_PRT = 20 * MiB, WS_PAT = 21 * MiB, WS_WOT = 22 * MiB, WS_SGD = 24 * MiB;
constexpr size_t WS_XN = 40 * MiB;
constexpr size_t WS_OATT = 104 * MiB;
constexpr size_t WS_G = 136 * MiB;
constexpr size_t WS_Z = 168 * MiB;
constexpr size_t WS_X1 = 104 * MiB;
constexpr size_t OUT_WGUT = 0;
constexpr size_t OUT_WDT = 64 * MiB;
constexpr size_t WS_XE = 200 * MiB;
constexpr size_t WS_H = 328 * MiB;
constexpr size_t WS_END = 464 * MiB;
constexpr size_t WS_ROPE = WS_AFF;
constexpr size_t WS_SELIDX = WS_SELAFF + 512 * 1024;
constexpr int CW_BAR = 4096;
constexpr int RING_BYTES = 131072, LDSCTL_OFF = RING_BYTES, MISC_OFF = LDSCTL_OFF + 320, LDS_BYTES = 147456;

#define GAS __attribute__((address_space(1)))
#define LAS __attribute__((address_space(3)))
typedef unsigned short bf16;
typedef unsigned v4u __attribute__((ext_vector_type(4)));
typedef float f32x4 __attribute__((ext_vector_type(4)));
typedef short bf16x8 __attribute__((ext_vector_type(8)));
typedef GAS unsigned gu32;
typedef GAS unsigned long long gu64;
#define RLX_AGENT __ATOMIC_RELAXED, __HIP_MEMORY_SCOPE_AGENT
#define LDS_WAIT() asm volatile("s_waitcnt lgkmcnt(0)" ::: "memory")
#define VM_WAIT() asm volatile("s_waitcnt vmcnt(0)" ::: "memory")
__device__ __forceinline__ unsigned long long rt() { return __builtin_amdgcn_s_memrealtime(); }
__device__ __forceinline__ unsigned f2bf(float f) { unsigned u = __builtin_bit_cast(unsigned, f); return (u + 0x7fffu + ((u >> 16) & 1u)) >> 16; }
typedef float f32x2hw __attribute__((ext_vector_type(2))); typedef __bf16 bf16x2hw __attribute__((ext_vector_type(2)));
__device__ __forceinline__ unsigned pk2(float lo, float hi) { f32x2hw v = {lo, hi}; bf16x2hw b = __builtin_convertvector(v, bf16x2hw); return __builtin_bit_cast(unsigned, b); }

#define XB_TMO      128
#define XB_XCNT(j)  (256  + 64 * (j))
#define XB_XSUB(j)  (1280 + 64 * (j))
#define XB_XGEN(j)  (2304 + 64 * (j))
#define XB_TOP      3328
#define XB_TOPGEN   3392
#define XCD_BAR_WORDS 3456
#define XB_SPIN_CAP (1u << 18)

__device__ __forceinline__ unsigned xb_ld(unsigned* p)              { return __hip_atomic_load(p, __ATOMIC_RELAXED, __HIP_MEMORY_SCOPE_AGENT); }
__device__ __forceinline__ unsigned xb_add(unsigned* p, unsigned v) { return __hip_atomic_fetch_add(p, v, __ATOMIC_RELAXED, __HIP_MEMORY_SCOPE_AGENT); }
__device__ __forceinline__ unsigned xb_xcc_id() { return (unsigned)__builtin_amdgcn_s_getreg((3 << 11) | 20) & 0xFu; }
#define XB_SPIN(cond, bar) do { unsigned _sp = 0; while (cond) { __builtin_amdgcn_s_sleep(1); \
    if ((++_sp & 255u) == 0u) { if (xb_ld(&(bar)[XB_TMO])) break; if (_sp > XB_SPIN_CAP) { atomicAdd(&(bar)[XB_TMO], 1u); break; } } } } while (0)

struct XcdBarrier {
    unsigned* bar; unsigned x;
    volatile LAS unsigned* st;
};

__device__ __forceinline__ XcdBarrier xcd_barrier_post(unsigned* bar, volatile LAS unsigned* st) {
    XcdBarrier b; b.bar = bar; b.x = xb_xcc_id(); b.st = st;
    if (threadIdx.x == 0) (void)xb_add(&bar[XB_XCNT(b.x)], 1u);
    return b;
}
__device__ __forceinline__ void xcd_barrier_complete(unsigned* bar, unsigned x, unsigned& nloc, unsigned& nx) {
    const unsigned G = gridDim.x * gridDim.y * gridDim.z;
    unsigned sum, cnt, mine, sp = 0u;
    for (;;) {
        sum = 0u; cnt = 0u; mine = 0u;
#pragma unroll
        for (unsigned j = 0; j < 16; ++j) { const unsigned c = xb_ld(&bar[XB_XCNT(j)]); sum += c; cnt += (c > 0u) ? 1u : 0u; mine = (j == x) ? c : mine; }
        if (sum == G) break;
        __builtin_amdgcn_s_sleep(1);
        if ((++sp & 255u) == 0u) { if (xb_ld(&bar[XB_TMO])) break; if (sp > XB_SPIN_CAP) { atomicAdd(&bar[XB_TMO], 1u); break; } }
    }
    nloc = mine > 0u ? mine : 1u; nx = cnt > 0u ? cnt : 1u;
}

__device__ __forceinline__ void xcd_barrier(const XcdBarrier& b, bool is_thread0) {
    asm volatile("s_waitcnt vmcnt(0)" ::: "memory");
    __syncthreads();
    if (is_thread0) {
        unsigned* bar = b.bar;
        __builtin_amdgcn_s_waitcnt(0);
        unsigned nloc = b.st[0], nx = b.st[1];
        if (nloc == 0u) { xcd_barrier_complete(bar, b.x, nloc, nx); b.st[0] = nloc; b.st[1] = nx; }
        const unsigned old = xb_add(&bar[XB_XSUB(b.x)], 1u);
        const unsigned gen = old / nloc;
        if (old + 1u == (gen + 1u) * nloc) {
            __builtin_amdgcn_fence(__ATOMIC_RELEASE, "agent");
            asm volatile("s_waitcnt vmcnt(0)" ::: "memory");
            const unsigned og = xb_add(&bar[XB_TOP], 1u);
            const unsigned tg = og / nx;
            if (og + 1u == (tg + 1u) * nx) xb_add(&bar[XB_TOPGEN], 1u);
            else XB_SPIN(xb_ld(&bar[XB_TOPGEN]) == tg, bar);
            __builtin_amdgcn_fence(__ATOMIC_ACQUIRE, "agent");
            xb_add(&bar[XB_XGEN(b.x)], 1u);
            asm volatile("s_waitcnt vmcnt(0)" ::: "memory");
        } else {
            XB_SPIN(xb_ld(&bar[XB_XGEN(b.x)]) == gen, bar);
            __builtin_amdgcn_fence(__ATOMIC_ACQUIRE, "agent");
            asm volatile("s_waitcnt vmcnt(0)" ::: "memory");
        }
    }
    __syncthreads();
}
namespace pg8 {
__device__ __forceinline__ float bf2f(unsigned short h) { return __uint_as_float(((unsigned)h) << 16); }
__device__ __forceinline__ float bflo(unsigned w) { return __uint_as_float(w << 16); }
__device__ __forceinline__ float bfhi(unsigned w) { return __uint_as_float(w & 0xffff0000u); }
__device__ __forceinline__ float sigm(float x) { return 1.0f / (1.0f + __expf(-x)); }
struct EpiZ { static constexpr bool PERM = true, AFTER_DRAIN = false; bf16_t* O;
    __device__ __forceinline__ void operator()(const f32x4 (&acc)[2][2][4][2], const Unit& u, int wr, int wc, int fr, int fq) const {
        const int row0 = u.pm * BM + wr * 64 + fr, col0 = u.pn * BM + wc * 32 + 8 * fq;
#pragma unroll
        for (int ai = 0; ai < 2; ++ai)
#pragma unroll
            for (int m = 0; m < 4; ++m) { bf16_t* rowp = O + (size_t)(row0 + ai * HALF + m * 16) * 4736 + col0;
#pragma unroll
                for (int bj = 0; bj < 2; ++bj) { if (u.pn * BM + bj * HALF < 4736) { const f32x4 v0 = acc[ai][bj][m][0], v1 = acc[ai][bj][m][1];
                    u32x4 w; w.x = cvt_pk_bf16(v0[0], v0[1]); w.y = cvt_pk_bf16(v0[2], v0[3]); w.z = cvt_pk_bf16(v1[0], v1[1]); w.w = cvt_pk_bf16(v1[2], v1[3]);
                    *(u32x4*)(rowp + bj * HALF) = w; } } }
    }
};
struct EpiPlain { static constexpr bool PERM = true, AFTER_DRAIN = false; bf16_t* O; int ldc;
    __device__ __forceinline__ void operator()(const f32x4 (&acc)[2][2][4][2], const Unit& u, int wr, int wc, int fr, int fq) const {
        const int row0 = u.pm * BM + wr * 64 + fr, col0 = u.pn * BM + wc * 32 + 8 * fq;
#pragma unroll
        for (int ai = 0; ai < 2; ++ai)
#pragma unroll
            for (int m = 0; m < 4; ++m) { bf16_t* rowp = O + (size_t)(row0 + ai * HALF + m * 16) * ldc + col0;
#pragma unroll
                for (int bj = 0; bj < 2; ++bj) { const f32x4 v0 = acc[ai][bj][m][0], v1 = acc[ai][bj][m][1];
                    u32x4 w; w.x = cvt_pk_bf16(v0[0], v0[1]); w.y = cvt_pk_bf16(v0[2], v0[3]); w.z = cvt_pk_bf16(v1[0], v1[1]); w.w = cvt_pk_bf16(v1[2], v1[3]);
                    *(u32x4*)(rowp + bj * HALF) = w; } }
    }
};
template <bool ADD> struct EpiGate { static constexpr bool PERM = true, AFTER_DRAIN = false; bf16_t* O; const bf16_t* Z; int zc0;
    __device__ __forceinline__ void operator()(const f32x4 (&acc)[2][2][4][2], const Unit& u, int wr, int wc, int fr, int fq) const {
        const int row0 = u.pm * BM + wr * 64 + fr, col0 = u.pn * BM + wc * 32 + 8 * fq;
#pragma unroll
        for (int ai = 0; ai < 2; ++ai)
#pragma unroll
            for (int m = 0; m < 4; ++m) { const size_t row = (size_t)(row0 + ai * HALF + m * 16); bf16_t* rowp = O + row * 1024 + col0; const bf16_t* zp = Z + row * 4736 + zc0 + col0;
#pragma unroll
                for (int bj = 0; bj < 2; ++bj) { const f32x4 v0 = acc[ai][bj][m][0], v1 = acc[ai][bj][m][1];
                    const u32x4 zg = *(const u32x4*)(zp + bj * HALF);
                    float r0 = sigm(bflo(zg.x)) * v0[0], r1 = sigm(bfhi(zg.x)) * v0[1], r2 = sigm(bflo(zg.y)) * v0[2], r3 = sigm(bfhi(zg.y)) * v0[3];
                    float r4 = sigm(bflo(zg.z)) * v1[0], r5 = sigm(bfhi(zg.z)) * v1[1], r6 = sigm(bflo(zg.w)) * v1[2], r7 = sigm(bfhi(zg.w)) * v1[3];
                    if (ADD) { const u32x4 p = *(const u32x4*)(rowp + bj * HALF);
                        r0 += bflo(p.x); r1 += bfhi(p.x); r2 += bflo(p.y); r3 += bfhi(p.y); r4 += bflo(p.z); r5 += bfhi(p.z); r6 += bflo(p.w); r7 += bfhi(p.w); }
                    u32x4 w; w.x = cvt_pk_bf16(r0, r1); w.y = cvt_pk_bf16(r2, r3); w.z = cvt_pk_bf16(r4, r5); w.w = cvt_pk_bf16(r6, r7);
                    *(u32x4*)(rowp + bj * HALF) = w; } }
    }
};
struct EpiGate2 { static constexpr bool PERM = true, AFTER_DRAIN = false; bf16_t* O; const bf16_t* Z;
    __device__ __forceinline__ void operator()(const f32x4 (&acc)[2][2][4][2], const Unit& u, int wr, int wc, int fr, int fq) const {
        const bool add = u.pm < 128; const int zc0 = add ? 3712 : 2688;
        const int row0 = (u.pm & 127) * BM + wr * 64 + fr, col0 = (u.pn & 3) * BM + wc * 32 + 8 * fq;
#pragma unroll
        for (int ai = 0; ai < 2; ++ai) {
            u32x4 zg[4][2], pv[4][2];
#pragma unroll
            for (int m = 0; m < 4; ++m) { const size_t row = (size_t)(row0 + ai * HALF + m * 16);
#pragma unroll
                for (int bj = 0; bj < 2; ++bj) { zg[m][bj] = *(const u32x4*)(Z + row * 4736 + zc0 + col0 + bj * HALF); pv[m][bj] = (u32x4){0u, 0u, 0u, 0u}; if (add) pv[m][bj] = *(const u32x4*)(O + row * 1024 + col0 + bj * HALF); } }
#pragma unroll
            for (int m = 0; m < 4; ++m) { const size_t row = (size_t)(row0 + ai * HALF + m * 16); bf16_t* rowp = O + row * 1024 + col0;
#pragma unroll
                for (int bj = 0; bj < 2; ++bj) { const f32x4 v0 = acc[ai][bj][m][0], v1 = acc[ai][bj][m][1]; const u32x4 g = zg[m][bj], p = pv[m][bj];
                    const float r0 = sigm(bflo(g.x)) * v0[0] + bflo(p.x), r1 = sigm(bfhi(g.x)) * v0[1] + bfhi(p.x), r2 = sigm(bflo(g.y)) * v0[2] + bflo(p.y), r3 = sigm(bfhi(g.y)) * v0[3] + bfhi(p.y);
                    const float r4 = sigm(bflo(g.z)) * v1[0] + bflo(p.z), r5 = sigm(bfhi(g.z)) * v1[1] + bfhi(p.z), r6 = sigm(bflo(g.w)) * v1[2] + bflo(p.w), r7 = sigm(bfhi(g.w)) * v1[3] + bfhi(p.w);
                    u32x4 w; w.x = cvt_pk_bf16(r0, r1); w.y = cvt_pk_bf16(r2, r3); w.z = cvt_pk_bf16(r4, r5); w.w = cvt_pk_bf16(r6, r7);
                    *(u32x4*)(rowp + bj * HALF) = w; } } }
    }
};
struct MergeOrder { StaticOrder S; int nu;
    __device__ __forceinline__ void init(int G, int c) { S.init(32768, 1024, G, c); nu = (512 - c + G - 1) / G; }
    __device__ __forceinline__ bool next(int i, Unit& u) const { if (i >= 2 * nu) return false; Unit t; S.next(i < nu ? i : i - nu, t);
        if (i < nu) { u.pm = 128 + t.pm; u.pn = t.pn; } else { u.pm = t.pm; u.pn = 4 + t.pn; } return true; }
    __device__ __forceinline__ void a_ready(const Unit&) const {}
    __device__ __forceinline__ void done(const Unit&) const {}
};
struct EpiRes { static constexpr bool PERM = true, AFTER_DRAIN = false; const float* X; const float* mod; bf16_t* O;
    __device__ __forceinline__ void operator()(const f32x4 (&acc)[2][2][4][2], const Unit& u, int wr, int wc, int fr, int fq) const {
        const int row0 = u.pm * BM + wr * 64 + fr, col0 = u.pn * BM + wc * 32 + 8 * fq; const int b = (u.pm * BM) >> 11;
        f32x4 gt[2][2];
#pragma unroll
        for (int bj = 0; bj < 2; ++bj)
#pragma unroll
            for (int n = 0; n < 2; ++n) gt[bj][n] = *(const f32x4*)(mod + (size_t)b * 6144 + 2048 + col0 + bj * HALF + n * 4);
#pragma unroll
        for (int ai = 0; ai < 2; ++ai) { f32x4 xv[4][2][2];
#pragma unroll
            for (int m = 0; m < 4; ++m) { const size_t off = (size_t)(row0 + ai * HALF + m * 16) * 1024 + col0;
#pragma unroll
                for (int bj = 0; bj < 2; ++bj) { xv[m][bj][0] = *(const f32x4*)(X + off + bj * HALF); xv[m][bj][1] = *(const f32x4*)(X + off + bj * HALF + 4); } }
#pragma unroll
            for (int m = 0; m < 4; ++m) { const size_t off = (size_t)(row0 + ai * HALF + m * 16) * 1024 + col0;
#pragma unroll
                for (int bj = 0; bj < 2; ++bj) { const f32x4 v0 = xv[m][bj][0] + gt[bj][0] * acc[ai][bj][m][0], v1 = xv[m][bj][1] + gt[bj][1] * acc[ai][bj][m][1];
                    u32x4 w; w.x = cvt_pk_bf16(v0[0], v0[1]); w.y = cvt_pk_bf16(v0[2], v0[3]); w.z = cvt_pk_bf16(v1[0], v1[1]); w.w = cvt_pk_bf16(v1[2], v1[3]);
                    *(u32x4*)(O + off + bj * HALF) = w; } } }
    }
};
template <int NPL> struct GroupOrder { int G, c;
    __device__ __forceinline__ bool next(int i, Unit& u) const { const int L = i * G + c; if (L >= 256 * NPL) return false;
        const int e = L / (16 * NPL), r = L % (16 * NPL); u.pm = e * 16 + (r % 16); u.pn = e * NPL + r / 16; return true; }
    __device__ __forceinline__ void a_ready(const Unit&) const {}
    __device__ __forceinline__ void done(const Unit&) const {}
};
struct EpiSwiglu { static constexpr bool PERM = true, AFTER_DRAIN = false; bf16_t* O;
    __device__ __forceinline__ void operator()(const f32x4 (&acc)[2][2][4][2], const Unit& u, int wr, int wc, int fr, int fq) const {
        const int row0 = u.pm * BM + wr * 64 + fr, col0 = (u.pn & 7) * 128 + wc * 32 + 8 * fq;
#pragma unroll
        for (int ai = 0; ai < 2; ++ai)
#pragma unroll
            for (int m = 0; m < 4; ++m) { bf16_t* rowp = O + (size_t)(row0 + ai * HALF + m * 16) * 1024 + col0;
                float r[8];
#pragma unroll
                for (int n = 0; n < 2; ++n)
#pragma unroll
                    for (int i = 0; i < 4; ++i) { const float g = acc[ai][0][m][n][i], up = acc[ai][1][m][n][i]; r[n * 4 + i] = g * sigm(g) * up; }
                u32x4 w; w.x = cvt_pk_bf16(r[0], r[1]); w.y = cvt_pk_bf16(r[2], r[3]); w.z = cvt_pk_bf16(r[4], r[5]); w.w = cvt_pk_bf16(r[6], r[7]);
                *(u32x4*)rowp = w; }
    }
};
struct EpiDown { static constexpr bool PERM = true, AFTER_DRAIN = false; bf16_t* O; const float* aff;
    __device__ __forceinline__ void operator()(const f32x4 (&acc)[2][2][4][2], const Unit& u, int wr, int wc, int fr, int fq) const {
        const int row0 = u.pm * BM + wr * 64 + fr, col0 = (u.pn & 3) * BM + wc * 32 + 8 * fq;
        float av[2][4];
#pragma unroll
        for (int ai = 0; ai < 2; ++ai)
#pragma unroll
            for (int m = 0; m < 4; ++m) av[ai][m] = aff[row0 + ai * HALF + m * 16];
#pragma unroll
        for (int ai = 0; ai < 2; ++ai)
#pragma unroll
            for (int m = 0; m < 4; ++m) { const int row = row0 + ai * HALF + m * 16; const float a = av[ai][m]; bf16_t* rowp = O + (size_t)row * 1024 + col0;
#pragma unroll
                for (int bj = 0; bj < 2; ++bj) { const f32x4 v0 = acc[ai][bj][m][0] * a, v1 = acc[ai][bj][m][1] * a;
                    u32x4 w; w.x = cvt_pk_bf16(v0[0], v0[1]); w.y = cvt_pk_bf16(v0[2], v0[3]); w.z = cvt_pk_bf16(v1[0], v1[1]); w.w = cvt_pk_bf16(v1[2], v1[3]);
                    *(u32x4*)(rowp + bj * HALF) = w; } }
    }
};
}

struct Frame { LAS unsigned char* lds; volatile LAS unsigned* MISC; gu32* ctl; int tid, lane, wave, vcu, G; };
struct Args { const void* in[30]; float* out; unsigned char* ws; int ph_lo, ph_hi; };
typedef const __attribute__((address_space(4))) Args* ArgsP;
#define LAUNDER(p) asm volatile("" : "+s"(p))
typedef float f32x16 __attribute__((ext_vector_type(16)));
typedef unsigned u32x2 __attribute__((ext_vector_type(2)));

__device__ __forceinline__ float wave_sum(float v) {
#pragma unroll
    for (int o = 1; o < 64; o <<= 1) v += __shfl_xor(v, o);
    return v;
}
__device__ __forceinline__ float bf2f(bf16 h) { return __uint_as_float(((unsigned)h) << 16); }
__device__ __forceinline__ float bflo(unsigned w) { return __uint_as_float(w << 16); }
__device__ __forceinline__ float bfhi(unsigned w) { return __uint_as_float(w & 0xffff0000u); }
__device__ __forceinline__ float sigm(float x) { return 1.0f / (1.0f + __expf(-x)); }

__device__ __forceinline__ void tr_item(const float* W, int N, int k0, int n0, bf16* WT, int KD, int dst_row0, LAS float* scr, int lane) {
    f32x4 v[8];
#pragma unroll
    for (int i = 0; i < 8; ++i) v[i] = *(const GAS f32x4*)(W + (size_t)(k0 + 8 * i + (lane >> 3)) * N + n0 + 4 * (lane & 7));
#pragma unroll
    for (int i = 0; i < 8; ++i) { LAS float* d = scr + (8 * i + (lane >> 3)) * 33 + 4 * (lane & 7); d[0] = v[i].x; d[1] = v[i].y; d[2] = v[i].z; d[3] = v[i].w; }
    LDS_WAIT(); asm volatile("" ::: "memory");
    const int c = lane & 7;
#pragma unroll
    for (int j = 0; j < 4; ++j) { const int n = (lane >> 3) + 8 * j; const LAS float* s = scr + (8 * c) * 33 + n;
        v4u o; o.x = pk2(s[0 * 33], s[1 * 33]); o.y = pk2(s[2 * 33], s[3 * 33]); o.z = pk2(s[4 * 33], s[5 * 33]); o.w = pk2(s[6 * 33], s[7 * 33]);
        *(GAS v4u*)(WT + (size_t)(dst_row0 + n) * KD + k0 + 8 * c) = o; }
    LDS_WAIT(); asm volatile("" ::: "memory");
}

__device__ __forceinline__ void p0_prologue(const Frame& F, ArgsP A) {
    unsigned char* ws = A->ws;
    LAS float* scr = (LAS float*)(F.lds + F.wave * 16384);
    const int gw = F.vcu * NWAVES + F.wave, NGW = F.G * NWAVES;
    const float* w_in = (const float*)A->in[6]; const float* p_rwkv = (const float*)A->in[22]; const float* p_attn = (const float*)A->in[23];
    const float* w_out = (const float*)A->in[24]; const float* g2 = (const float*)A->in[13];
    bf16* WinT = (bf16*)(ws + WS_WINT); bf16* PrT = (bf16*)(ws + WS_PRT); bf16* PaT = (bf16*)(ws + WS_PAT); bf16* WoT = (bf16*)(ws + WS_WOT); bf16* G2T = (bf16*)(ws + WS_G2T);
    constexpr int I_IN = 16 * 148, I_P = 8 * 32, I_O = 16 * 32, I_G = 2 * 16, NIT = I_IN + 2 * I_P + I_O + I_G;
    for (int it = gw; it < NIT; it += NGW) {
        int r = it;
        if (r < I_IN) { tr_item(w_in, NZ, 64 * (r / 148), 32 * (r % 148), WinT, 1024, 32 * (r % 148), scr, F.lane); continue; } r -= I_IN;
        if (r < I_P) { tr_item(p_rwkv, 1024, 64 * (r / 32), 32 * (r % 32), PrT, 512, 32 * (r % 32), scr, F.lane); continue; } r -= I_P;
        if (r < I_P) { tr_item(p_attn, 1024, 64 * (r / 32), 32 * (r % 32), PaT, 512, 32 * (r % 32), scr, F.lane); continue; } r -= I_P;
        if (r < I_O) { tr_item(w_out, 1024, 64 * (r / 32), 32 * (r % 32), WoT, 1024, 32 * (r % 32), scr, F.lane); continue; } r -= I_O;
        tr_item(g2, 512, 64 * (r / 16), 32 * (r % 16), G2T, 256, 32 * (r % 16), scr, F.lane);
    }
    { const int gt = (F.vcu * NWAVES + F.wave) * 64 + F.lane, NT = F.G * NWAVES * 64; const v4u z4 = {0u, 0u, 0u, 0u};
      for (int i = gt; i < 128 * 128; i += NT) *(GAS v4u*)(WinT + (size_t)4736 * 1024 + (size_t)i * 8) = z4;
      for (int i = gt; i < 512 * 16; i += NT) *(GAS v4u*)(G2T + (size_t)(i >> 4) * 256 + 128 + (i & 15) * 8) = z4; }
    __syncthreads();
    const float* cvec = (const float*)A->in[1]; const float* w_ada = (const float*)A->in[3]; const float* b_ada = (const float*)A->in[4];
    float* mod = (float*)(ws + WS_MOD);
    for (int task = F.vcu; task < 192; task += F.G) { const int cg = task % 96, dh = task / 96;
        LAS float* ca = (LAS float*)F.lds;
        LAS float* red = (LAS float*)(F.lds + 65536);
        for (int i = F.tid; i < 16 * 1024; i += 512) { const int b = i >> 10, d = i & 1023; const float cv = cvec[i]; ca[d * 16 + b] = cv / (1.0f + __expf(-cv)); }
        __syncthreads();
        float acc[16];
#pragma unroll
        for (int b = 0; b < 16; ++b) acc[b] = 0.f;
        const int col = cg * 64 + F.lane;
#pragma unroll 8
        for (int dd = 0; dd < 64; ++dd) { const int d = dh * 512 + F.wave * 64 + dd; const float w = w_ada[(size_t)d * 6144 + col];
            const LAS f32x4* cp = (const LAS f32x4*)(ca + d * 16);
#pragma unroll
            for (int q = 0; q < 4; ++q) { const f32x4 cv = cp[q]; acc[q * 4 + 0] += cv[0] * w; acc[q * 4 + 1] += cv[1] * w; acc[q * 4 + 2] += cv[2] * w; acc[q * 4 + 3] += cv[3] * w; } }
#pragma unroll
        for (int b = 0; b < 16; ++b) red[(F.wave * 16 + b) * 64 + F.lane] = acc[b];
        __syncthreads();
        for (int o = F.tid; o < 1024; o += 512) { const int b = o >> 6, cl = o & 63; float sacc = 0.f;
#pragma unroll
            for (int w = 0; w < 8; ++w) sacc += red[(w * 16 + b) * 64 + cl];
            atomicAdd(&mod[b * 6144 + cg * 64 + cl], sacc + (dh == 0 ? b_ada[cg * 64 + cl] : 0.f)); }
        __syncthreads();
    }
}


__device__ __forceinline__ float dpp_wave_sum(float v) {
    v += __int_as_float(__builtin_amdgcn_update_dpp(0, __float_as_int(v), 0xB1, 0xf, 0xf, false));
    v += __int_as_float(__builtin_amdgcn_update_dpp(0, __float_as_int(v), 0x4E, 0xf, 0xf, false));
    v += __int_as_float(__builtin_amdgcn_update_dpp(0, __float_as_int(v), 0x141, 0xf, 0xf, false));
    v += __int_as_float(__builtin_amdgcn_update_dpp(0, __float_as_int(v), 0x140, 0xf, 0xf, false));
    v += __int_as_float(__builtin_amdgcn_ds_swizzle(__float_as_int(v), 0x401F));
    auto r_ = __builtin_amdgcn_permlane32_swap(__float_as_uint(v), __float_as_uint(v), false, false);
    return __uint_as_float(r_[0]) + __uint_as_float(r_[1]); }

template <int R, bool XBF> __device__ __forceinline__ void modnorm_rows(const void* x, int m0, int mstride, const float* g, const float* mod, int sh_off, int sc_off, bf16* out, int lane, f32x4 (&u)[R][4]) {
    f32x4 v[R][4];
#pragma unroll
    for (int i = 0; i < R; ++i) {
        if (XBF) { const GAS u32x2* xr = (const GAS u32x2*)((const bf16*)x + (size_t)(m0 + i * mstride) * 1024) + lane;
#pragma unroll
            for (int j = 0; j < 4; ++j) { const u32x2 w = xr[64 * j]; v[i][j] = (f32x4){bflo(w.x), bfhi(w.x), bflo(w.y), bfhi(w.y)}; } }
        else { const GAS f32x4* xr = (const GAS f32x4*)((const float*)x + (size_t)(m0 + i * mstride) * 1024) + lane;
#pragma unroll
            for (int j = 0; j < 4; ++j) v[i][j] = xr[64 * j]; } }
    f32x4 gg[4];
#pragma unroll
    for (int j = 0; j < 4; ++j) gg[j] = ((const GAS f32x4*)g)[lane + 64 * j];
#pragma unroll
    for (int i = 0; i < R; ++i) { const int m = m0 + i * mstride, b = m >> 11; float s = 0.f;
#pragma unroll
        for (int j = 0; j < 4; ++j) s += (v[i][j].x * v[i][j].x + v[i][j].y * v[i][j].y) + (v[i][j].z * v[i][j].z + v[i][j].w * v[i][j].w);
        const float rs = rsqrtf(dpp_wave_sum(s) * (1.0f / 1024.0f) + 1e-6f);
        const float* sh = mod + (size_t)b * 6144 + sh_off; const float* sc = mod + (size_t)b * 6144 + sc_off;
        GAS unsigned long long* o8 = (GAS unsigned long long*)(out + (size_t)m * 1024) + lane;
#pragma unroll
        for (int j = 0; j < 4; ++j) { const f32x4 s1 = ((const GAS f32x4*)sc)[lane + 64 * j], s0 = ((const GAS f32x4*)sh)[lane + 64 * j];
            f32x4 y = (v[i][j] * rs) * gg[j]; y = y * (s1 + 1.0f) + s0; u[i][j] = y;
            o8[64 * j] = (unsigned long long)pk2(y.x, y.y) | ((unsigned long long)pk2(y.z, y.w) << 32); } }
}

template <int R> __device__ __forceinline__ void load_rows_bf16(const bf16* x, int m0, int mstride, int lane_in, u32x2 (&raw)[R][4]) {
    int lane = lane_in; asm volatile("" : "+v"(lane));
#pragma unroll
    for (int i = 0; i < R; ++i) { const GAS u32x2* xr = (const GAS u32x2*)(x + (size_t)(m0 + i * mstride) * 1024) + lane;
#pragma unroll
        for (int j = 0; j < 4; ++j) raw[i][j] = xr[64 * j]; }
}
template <int R> __device__ __forceinline__ void modnorm_rows_pre(const u32x2 (&raw)[R][4], int m0, int mstride, const float* g, const float* mod, int sh_off, int sc_off, bf16* out, int lane, f32x4 (&u)[R][4]) {
    f32x4 gg[4];
#pragma unroll
    for (int j = 0; j < 4; ++j) gg[j] = ((const GAS f32x4*)g)[lane + 64 * j];
#pragma unroll
    for (int i = 0; i < R; ++i) { const int m = m0 + i * mstride, b = m >> 11; float s = 0.f; f32x4 v[4];
#pragma unroll
        for (int j = 0; j < 4; ++j) { const u32x2 w = raw[i][j]; v[j] = (f32x4){bflo(w.x), bfhi(w.x), bflo(w.y), bfhi(w.y)}; s += (v[j].x * v[j].x + v[j].y * v[j].y) + (v[j].z * v[j].z + v[j].w * v[j].w); }
        const float rs = rsqrtf(dpp_wave_sum(s) * (1.0f / 1024.0f) + 1e-6f);
        const float* sh = mod + (size_t)b * 6144 + sh_off; const float* sc = mod + (size_t)b * 6144 + sc_off;
        GAS unsigned long long* o8 = (GAS unsigned long long*)(out + (size_t)m * 1024) + lane;
#pragma unroll
        for (int j = 0; j < 4; ++j) { const f32x4 s1 = ((const GAS f32x4*)sc)[lane + 64 * j], s0 = ((const GAS f32x4*)sh)[lane + 64 * j];
            f32x4 y = (v[j] * rs) * gg[j]; y = y * (s1 + 1.0f) + s0; u[i][j] = y;
            o8[64 * j] = (unsigned long long)pk2(y.x, y.y) | ((unsigned long long)pk2(y.z, y.w) << 32); } }
}

__device__ __forceinline__ void modnorm_row(const float* xrow, const float* g, const float* sh, const float* sc, bf16* orow, int lane, f32x4 (&u)[4]) {
    const GAS f32x4* xr = (const GAS f32x4*)xrow + lane;
    f32x4 v[4]; float s = 0.f;
#pragma unroll
    for (int j = 0; j < 4; ++j) { v[j] = xr[64 * j]; s += (v[j].x * v[j].x + v[j].y * v[j].y) + (v[j].z * v[j].z + v[j].w * v[j].w); }
    const float rs = rsqrtf(wave_sum(s) * (1.0f / 1024.0f) + 1e-6f);
    GAS unsigned long long* o8 = (GAS unsigned long long*)orow + lane;
#pragma unroll
    for (int j = 0; j < 4; ++j) { const f32x4 gg = ((const GAS f32x4*)g)[lane + 64 * j], s1 = ((const GAS f32x4*)sc)[lane + 64 * j], s0 = ((const GAS f32x4*)sh)[lane + 64 * j];
        f32x4 y = (v[j] * rs) * gg; y = y * (s1 + 1.0f) + s0; u[j] = y;
        o8[64 * j] = (unsigned long long)pk2(y.x, y.y) | ((unsigned long long)pk2(y.z, y.w) << 32); }
}

__device__ __forceinline__ float softplusf(float x) { return x > 20.f ? x : log1pf(__expf(x)); }
__device__ __forceinline__ void scan_chain(const Frame& F, ArgsP A, int b, int h, int dir) {
    constexpr int CT = 32;
    LAS float* L = (LAS float*)F.lds;
    LAS float* W2S = L; LAS float* A2S = L + 4096; LAS float* ZRs = L + 8192; LAS float* ZKs = ZRs + 2048; LAS float* ZVs = ZKs + 2048; LAS float* TWs = ZVs + 2048; LAS float* ZAs = TWs + 2048;
    LAS float* DEC = ZAs + 2048; LAS float* KD = DEC + 2048; LAS float* AV = KD + 2048; LAS float* BV = AV + 2048; LAS float* YB = BV + 2048; LAS float* BON = YB + 2048;
    const bf16* Z = (const bf16*)(A->ws + WS_Z);
    const float* mu_prev = (const float*)A->in[7]; const float* mu_next = (const float*)A->in[8];
    const float* w0 = (const float*)A->in[9]; const float* w2 = (const float*)A->in[10]; const float* a0 = (const float*)A->in[11]; const float* a2 = (const float*)A->in[12];
    const float* k_k = (const float*)A->in[14]; const float* k_a = (const float*)A->in[15]; const float* r_k = (const float*)A->in[16];
    bf16* ydir = (bf16*)(A->ws + WS_XN) + (size_t)dir * M * 512; float* bonus = (float*)(A->ws + WS_BONUS) + (size_t)dir * M * 8;
    const int tid = F.tid, lane = F.lane, wave = F.wave;
    for (int i = tid; i < 4096; i += 512) { const int l = i >> 6, j = i & 63; W2S[i] = w2[((size_t)dir * 64 + l) * 512 + h * 64 + j]; A2S[i] = a2[((size_t)dir * 64 + l) * 512 + h * 64 + j]; }
    const int ch = h * 64 + lane;
    const float w0j = w0[dir * 512 + ch], a0j = a0[dir * 512 + ch], kkj = k_k[ch], kaj = k_a[ch], rkj = r_k[ch];
    float s[8];
#pragma unroll
    for (int q = 0; q < 8; ++q) s[q] = 0.f;
    const int ri = tid >> 3, jg = tid & 7;
    for (int ci = 0; ci < T / CT; ++ci) {
        const int t0 = (dir ? (T / CT - 1 - ci) : ci) * CT;
#pragma unroll 4
        for (int i = 0; i < 20; ++i) { const int e = tid + 512 * i, arr = e >> 11, rem = e & 2047, tl = rem >> 6, j = rem & 63;
            const int col = (arr == 0 ? ZR + h * 64 : arr == 1 ? ZK + h * 64 : arr == 2 ? ZV + h * 64 : arr == 3 ? ZWD + dir * 64 : ZAD + dir * 64) + j;
            const int t = t0 + tl; const bf16* zp = Z + ((size_t)b * T + t) * NZ + col;
            const float z0 = bf2f(zp[0]), zm = t > 0 ? bf2f(zp[-NZ]) : 0.f, zq = t < T - 1 ? bf2f(zp[NZ]) : 0.f;
            float zs = z0 + mu_prev[col] * (zm - z0) + mu_next[col] * (zq - z0);
            if (arr == 3) zs = tanhf(zs);
            ZRs[arr * 2048 + rem] = zs; }
        __syncthreads();
#pragma unroll 1
        for (int q = 0; q < 4; ++q) { const int tl = wave + 8 * q;
            float wraw = w0j, araw = a0j;
#pragma unroll 8
            for (int l = 0; l < 64; ++l) { wraw += TWs[tl * 64 + l] * W2S[l * 64 + lane]; araw += ZAs[tl * 64 + l] * A2S[l * 64 + lane]; }
            const float w = -softplusf(-wraw) - 0.5f, dec = __expf(-__expf(w)), ad = sigm(araw);
            const float k = ZKs[tl * 64 + lane], kkr = k * kkj, nrm = sqrtf(wave_sum(kkr * kkr)), kk = kkr / fmaxf(nrm, 1e-12f);
            const float kd = k * (1.0f + (ad - 1.0f) * kaj);
            DEC[tl * 64 + lane] = dec; KD[tl * 64 + lane] = kd; AV[tl * 64 + lane] = -kk; BV[tl * 64 + lane] = kk * ad;
            const float bon = wave_sum(ZRs[tl * 64 + lane] * kd * rkj); if (lane == 0) BON[tl] = bon; }
        __syncthreads();
#pragma unroll 1
        for (int st = 0; st < CT; ++st) { const int tl = dir ? (CT - 1 - st) : st; const int o = tl * 64 + jg * 8;
            const f32x4 a0v = *(const LAS f32x4*)(AV + o), a1v = *(const LAS f32x4*)(AV + o + 4), d0 = *(const LAS f32x4*)(DEC + o), d1 = *(const LAS f32x4*)(DEC + o + 4);
            const f32x4 b0 = *(const LAS f32x4*)(BV + o), b1 = *(const LAS f32x4*)(BV + o + 4), k0 = *(const LAS f32x4*)(KD + o), k1 = *(const LAS f32x4*)(KD + o + 4);
            const f32x4 r0 = *(const LAS f32x4*)(ZRs + o), r1 = *(const LAS f32x4*)(ZRs + o + 4); const float vi = ZVs[tl * 64 + ri];
            float p = (s[0] * a0v[0] + s[1] * a0v[1]) + (s[2] * a0v[2] + s[3] * a0v[3]) + (s[4] * a1v[0] + s[5] * a1v[1]) + (s[6] * a1v[2] + s[7] * a1v[3]);
            p += __shfl_xor(p, 1); p += __shfl_xor(p, 2); p += __shfl_xor(p, 4);
            s[0] = s[0] * d0[0] + p * b0[0] + vi * k0[0]; s[1] = s[1] * d0[1] + p * b0[1] + vi * k0[1]; s[2] = s[2] * d0[2] + p * b0[2] + vi * k0[2]; s[3] = s[3] * d0[3] + p * b0[3] + vi * k0[3];
            s[4] = s[4] * d1[0] + p * b1[0] + vi * k1[0]; s[5] = s[5] * d1[1] + p * b1[1] + vi * k1[1]; s[6] = s[6] * d1[2] + p * b1[2] + vi * k1[2]; s[7] = s[7] * d1[3] + p * b1[3] + vi * k1[3];
            float y = (s[0] * r0[0] + s[1] * r0[1]) + (s[2] * r0[2] + s[3] * r0[3]) + (s[4] * r1[0] + s[5] * r1[1]) + (s[6] * r1[2] + s[7] * r1[3]);
            y += __shfl_xor(y, 1); y += __shfl_xor(y, 2); y += __shfl_xor(y, 4);
            if (jg == 0) YB[tl * 64 + ri] = y; }
        __syncthreads();
#pragma unroll
        for (int i = 0; i < 4; ++i) { const int e = tid + 512 * i, tl = e >> 6, c = e & 63; ydir[((size_t)b * T + t0 + tl) * 512 + h * 64 + c] = (bf16)f2bf(YB[e]); }
        if (tid < CT) bonus[((size_t)b * T + t0 + tid) * 8 + h] = BON[tid];
        __syncthreads();
    }
}


#define SDEV __device__ __forceinline__
#define S_UNROLL _Pragma("unroll")
#define S_MEMBAR() do { asm volatile("" ::: "memory"); __builtin_amdgcn_sched_barrier(0); } while (0)
#define S_LAUNDER_I(x) asm volatile("" : "+v"(x))
#define S_LAUNDER_S(x) asm volatile("" : "+s"(x))
#define S_PIN(x) asm volatile("" : "+v"(x))
typedef float f32x2s __attribute__((ext_vector_type(2))); typedef __bf16 bf16x2s __attribute__((ext_vector_type(2)));
__device__ __forceinline__ unsigned s_cvtpk(float lo, float hi) { f32x2s v = {lo, hi}; bf16x2s b = __builtin_convertvector(v, bf16x2s); return __builtin_bit_cast(unsigned, b); }
__device__ __forceinline__ float s_rowsum16(float v) {
    v += __int_as_float(__builtin_amdgcn_update_dpp(0, __float_as_int(v), 0xB1, 0xf, 0xf, false));
    v += __int_as_float(__builtin_amdgcn_update_dpp(0, __float_as_int(v), 0x4E, 0xf, 0xf, false));
    v += __int_as_float(__builtin_amdgcn_update_dpp(0, __float_as_int(v), 0x141, 0xf, 0xf, false));
    v += __int_as_float(__builtin_amdgcn_update_dpp(0, __float_as_int(v), 0x140, 0xf, 0xf, false));
    return v; }
#define S_MFMA(a, b, c) __builtin_amdgcn_mfma_f32_32x32x16_bf16(a, b, c, 0, 0, 0)
#define S_PK(lo, hi) s_cvtpk(lo, hi)
#define S_SWAP(x, y) do { auto r_ = __builtin_amdgcn_permlane32_swap(x, y, false, false); x = r_[0]; y = r_[1]; } while (0)
#define S_ROWSUM16(v) s_rowsum16(v)
__device__ __forceinline__ float s_wavesum(float v) { v = s_rowsum16(v);
    v += __int_as_float(__builtin_amdgcn_ds_swizzle(__float_as_int(v), 0x401F));
    auto r_ = __builtin_amdgcn_permlane32_swap(__float_as_uint(v), __float_as_uint(v), false, false);
    return __uint_as_float(r_[0]) + __uint_as_float(r_[1]); }
#define S_WAVESUM(v) s_wavesum(v)
#define S_GAS GAS
#define S_READLANE(v, l) __int_as_float(__builtin_amdgcn_readlane(__float_as_int(v), l))
#define S_RCP(x) __builtin_amdgcn_rcpf(x)
#define S_EXP2(x) __builtin_amdgcn_exp2f(x)
#define S_LOG2(x) __builtin_amdgcn_logf(x)
#define S_RSQ(x) __builtin_amdgcn_rsqf(x)
#define S_LDS_WAIT() asm volatile("s_waitcnt lgkmcnt(0)" ::: "memory")
#define S_LDSP LAS unsigned char*
#define S_LDS_BF16P LAS bf16*
#define S_LDS_U32P LAS unsigned*
#define S_LDS_F32P LAS float*
#define S_LDS_CONST_BF16X8P const LAS bf16x8*
#define S_LDS_BF16X8P LAS bf16x8*
#define S_LDS_CONST_F32X4P const LAS f32x4*
#define S_FLAG_STORE(p, v) do { *(volatile LAS unsigned*)(p) = (v); } while (0)
#define S_FLAG_WAIT(p, v) do { unsigned sp_ = 0; while (*(volatile LAS unsigned*)(p) != (v)) { __builtin_amdgcn_s_sleep(2); if (++sp_ > (1u << 24)) break; } asm volatile("" ::: "memory"); } while (0)
struct SFrag { bf16x8 s[2]; };
struct SMat { SFrag t[2]; };
SDEV f32x16 smm(const SFrag& X, const SFrag& Y, f32x16 acc) { acc = S_MFMA(X.s[0], Y.s[0], acc); acc = S_MFMA(X.s[1], Y.s[1], acc); return acc; }
SDEV f32x16 szero() { f32x16 z; S_UNROLL for (int i = 0; i < 16; ++i) z[i] = 0.f; return z; }
SDEV SFrag spack(const f32x16& d) { SFrag f;
    S_UNROLL for (int s = 0; s < 2; ++s) { v4u w; S_UNROLL for (int q = 0; q < 4; ++q) w[q] = S_PK(d[8 * s + 2 * q], d[8 * s + 2 * q + 1]); f.s[s] = __builtin_bit_cast(bf16x8, w); }
    return f; }
SDEV f32x16 sunpack(const SFrag& f) { f32x16 d;
    S_UNROLL for (int s = 0; s < 2; ++s) { const v4u w = __builtin_bit_cast(v4u, f.s[s]); S_UNROLL for (int q = 0; q < 4; ++q) { d[8 * s + 2 * q] = __uint_as_float(w[q] << 16); d[8 * s + 2 * q + 1] = __uint_as_float(w[q] & 0xffff0000u); } }
    return d; }
SDEV SMat splain2d(const unsigned (&pp)[16]) { unsigned d0[8], d1[8];
    S_UNROLL for (int g = 0; g < 4; ++g) S_UNROLL for (int p = 0; p < 2; ++p) { unsigned x = pp[4 * g + p], y = pp[4 * g + 2 + p]; S_SWAP(x, y); d0[2 * g + p] = x; d1[2 * g + p] = y; }
    SMat m;
    S_UNROLL for (int s = 0; s < 2; ++s) { v4u a, b; S_UNROLL for (int q = 0; q < 4; ++q) { a[q] = d0[4 * s + q]; b[q] = d1[4 * s + q]; } m.t[0].s[s] = __builtin_bit_cast(bf16x8, a); m.t[1].s[s] = __builtin_bit_cast(bf16x8, b); }
    return m; }
SDEV void sd2plain(const f32x16& D0, const f32x16& D1, float (&x)[32]) {
    S_UNROLL for (int r = 0; r < 16; ++r) { unsigned a = __float_as_uint(D0[r]), b = __float_as_uint(D1[r]); S_SWAP(a, b); const int ta = (r & 3) + 8 * (r >> 2); x[ta] = __uint_as_float(a); x[ta + 4] = __uint_as_float(b); } }
SDEV SFrag sident(int n_in, int hh_in) { int n1 = n_in, r1 = 4 * hh_in; S_LAUNDER_I(n1); S_LAUNDER_I(r1); f32x16 id; S_UNROLL for (int g = 0; g < 16; ++g) id[g] = (((g & 3) + 8 * (g >> 2) + r1) == n1) ? 1.f : 0.f; return spack(id); }
SDEV void sd2plain_pk(const f32x16& D0, const f32x16& D1, unsigned (&xp)[16]) {
    S_UNROLL for (int m = 0; m < 8; ++m) { unsigned a = S_PK(D0[2 * m], D0[2 * m + 1]), b = S_PK(D1[2 * m], D1[2 * m + 1]); S_SWAP(a, b); const int qa = 4 * (m >> 1) + (m & 1); xp[qa] = a; xp[qa + 2] = b; } }
SDEV float swave_sum(float v) { return S_WAVESUM(v); }

struct ScanArgs { const S_GAS bf16* Z; const S_GAS float* mu_prev; const S_GAS float* mu_next; const S_GAS float* w0; const S_GAS float* a0; const S_GAS float* k_k; const S_GAS float* k_a; const S_GAS float* r_k; S_GAS bf16* ydir; S_GAS float* bonus; };

#define SC_W2F 0
#define SC_A2F 8192
#define SC_SIG 16384
#define SC_GTAB 24576
#define SC_FLAG 26624
#define SC_WR 28672
#define SC_AR 94208
#define SC_LDS_BYTES 126976
#define SC_PF 4

SDEV void scan2_setup(S_LDSP lds, const S_GAS float* w2, const S_GAS float* a2, int h, int dir, int tid) {
    { float wv[16];
      S_UNROLL for (int it = 0; it < 16; ++it) { const int e = tid + 512 * it; const int mat = e >> 12, r = e & 4095, jj = r & 7, ln = (r >> 3) & 63, s = (r >> 9) & 1, jt = (r >> 10) & 1, lt = (r >> 11) & 1;
          const int n = ln & 31, hh = ln >> 5, g = 8 * s + jj, l = 32 * lt + (g & 3) + 8 * (g >> 2) + 4 * hh, j = 32 * jt + n;
          wv[it] = (mat ? a2 : w2)[((size_t)dir * 64 + l) * 512 + h * 64 + j]; }
      S_UNROLL for (int it = 0; it < 16; ++it) { const int e = tid + 512 * it; const int mat = e >> 12, r = e & 4095;
          ((S_LDS_BF16P)(lds + (mat ? SC_A2F : SC_W2F)))[r] = (bf16)(S_PK(wv[it], 0.f) & 0xffffu); } }
    for (int e = tid; e < 2048; e += 512) ((S_LDS_U32P)(lds + SC_SIG))[e] = 0u;
    if (tid == 0) S_FLAG_STORE(lds + SC_FLAG, 0u);
}

SDEV void scan2_chunk(S_LDSP lds, const ScanArgs& A_in, int b_in, int h_in, int dir_in, int c, int lane_in, int wave) {
    ScanArgs A = A_in; int b = b_in, h = h_in, dir = dir_in;
    S_LAUNDER_S(A.Z); S_LAUNDER_S(A.mu_prev); S_LAUNDER_S(A.mu_next); S_LAUNDER_S(A.w0); S_LAUNDER_S(A.a0); S_LAUNDER_S(A.k_k); S_LAUNDER_S(A.k_a); S_LAUNDER_S(A.r_k); S_LAUNDER_S(A.ydir); S_LAUNDER_S(A.bonus);
    S_LAUNDER_S(b); S_LAUNDER_S(h); S_LAUNDER_S(dir);
    int lane = lane_in; S_LAUNDER_I(lane);
    const int n = lane & 31, hh = lane >> 5;
    const int sgn = dir ? -1 : 1, tau0 = dir ? (T - 1 - 32 * c) : 32 * c;
    const S_GAS bf16* zb = A.Z + (size_t)b * T * NZ;
    const ptrdiff_t st = (ptrdiff_t)sgn * NZ; const bool first = (c == 0), last = (c == T / 32 - 1);
    const int cr = ZR + h * 64 + lane, ck = ZK + h * 64 + lane, cv = ZV + h * 64 + lane, cw = ZWD + dir * 64 + lane, ca = ZAD + dir * 64 + lane, chn = h * 64 + lane;
    {   const SFrag IDF = sident(n, hh); unsigned ppw[16], ppa[16];
        { const float mA = dir ? A.mu_next[cw] : A.mu_prev[cw], mB = dir ? A.mu_prev[cw] : A.mu_next[cw], nA = dir ? A.mu_next[ca] : A.mu_prev[ca], nB = dir ? A.mu_prev[ca] : A.mu_next[ca];
          const S_GAS bf16* pw = zb + (ptrdiff_t)tau0 * NZ + cw - st; const S_GAS bf16* pa = zb + (ptrdiff_t)tau0 * NZ + ca - st;
          float rw[34], ra[34];
          S_UNROLL for (int q = 0; q < 34; ++q) { const bool ok = !((q == 0 && first) || (q == 33 && last)); rw[q] = ok ? bf2f(*pw) : 0.f; ra[q] = ok ? bf2f(*pa) : 0.f; pw += st; pa += st; }
          S_MEMBAR();
          const float mC = 1.f - mA - mB, nC = 1.f - nA - nB; float tprev = 0.f, aprev = 0.f;
          S_UNROLL for (int p = 0; p < 32; ++p) { if ((p & 7) == 0) S_MEMBAR();
              const float ws = mC * rw[p + 1] + mA * rw[p] + mB * rw[p + 2], as = nC * ra[p + 1] + nA * ra[p] + nB * ra[p + 2];
              const float tw = 1.f - 2.f * S_RCP(1.f + S_EXP2(ws * 2.885390082f));
              if (p & 1) { ppw[p >> 1] = S_PK(tprev, tw); ppa[p >> 1] = S_PK(aprev, as); S_PIN(ppw[p >> 1]); S_PIN(ppa[p >> 1]); } else { tprev = tw; aprev = as; } } }
        S_MEMBAR();
        const SMat TW = splain2d(ppw), AD = splain2d(ppa);
        SFrag TWT[2], ADT[2];
        S_UNROLL for (int lt = 0; lt < 2; ++lt) { TWT[lt] = spack(smm(TW.t[lt], IDF, szero())); ADT[lt] = spack(smm(AD.t[lt], IDF, szero())); }
        f32x16 dw[2], da[2];
        S_UNROLL for (int jt = 0; jt < 2; ++jt) { dw[jt] = szero(); da[jt] = szero();
            S_UNROLL for (int lt = 0; lt < 2; ++lt) { SFrag wf, af;
                S_UNROLL for (int s = 0; s < 2; ++s) { wf.s[s] = *(S_LDS_CONST_BF16X8P)(lds + SC_W2F + ((((lt * 2 + jt) * 2 + s) * 64 + lane) * 16)); af.s[s] = *(S_LDS_CONST_BF16X8P)(lds + SC_A2F + ((((lt * 2 + jt) * 2 + s) * 64 + lane) * 16)); }
                dw[jt] = smm(TWT[lt], wf, dw[jt]); da[jt] = smm(ADT[lt], af, da[jt]); } }
        S_UNROLL for (int jt = 0; jt < 2; ++jt) S_UNROLL for (int g = 0; g < 16; ++g) { const int t = (g & 3) + 8 * (g >> 2) + 4 * hh;
            ((S_LDS_F32P)(lds + SC_WR + wave * 8192))[t * 64 + 32 * jt + n] = dw[jt][g]; ((S_LDS_BF16P)(lds + SC_AR + wave * 4096))[t * 64 + 32 * jt + n] = (bf16)(S_PK(da[jt][g], 0.f) & 0xffffu); }
        S_LDS_WAIT();
    }
    S_MEMBAR();
    unsigned ppA[16], ppR[16], ppB[16], ppK[16], ppV[16], ppQ[16]; float gamC;
    {   const float mAr = dir ? A.mu_next[cr] : A.mu_prev[cr], mBr = dir ? A.mu_prev[cr] : A.mu_next[cr], mAk = dir ? A.mu_next[ck] : A.mu_prev[ck], mBk = dir ? A.mu_prev[ck] : A.mu_next[ck];
        const float mAv = dir ? A.mu_next[cv] : A.mu_prev[cv], mBv = dir ? A.mu_prev[cv] : A.mu_next[cv];
        const float w0j = A.w0[dir * 512 + chn], a0j = A.a0[dir * 512 + chn], kkj = A.k_k[chn], kaj = A.k_a[chn], rkj = A.r_k[chn];
        const S_GAS bf16* pr = zb + (ptrdiff_t)tau0 * NZ + cr - st; const S_GAS bf16* pk = zb + (ptrdiff_t)tau0 * NZ + ck - st; const S_GAS bf16* pv = zb + (ptrdiff_t)tau0 * NZ + cv - st;
        float rr[34], rk[34], rv[34];
        S_UNROLL for (int q = 0; q < 34; ++q) { const bool ok = !((q == 0 && first) || (q == 33 && last)); rr[q] = ok ? bf2f(*pr) : 0.f; rk[q] = ok ? bf2f(*pk) : 0.f; rv[q] = ok ? bf2f(*pv) : 0.f; pr += st; pk += st; pv += st; }
        S_MEMBAR();
        const float mCr = 1.f - mAr - mBr, mCk = 1.f - mAk - mBk, mCv = 1.f - mAv - mBv;
        float cs = 0.f, gprev = 1.f; float eA = 0.f, eR = 0.f, eB = 0.f, eK = 0.f, eV = 0.f, eQ = 0.f;
        S_UNROLL for (int p = 0; p < 32; ++p) { S_MEMBAR();
            const float r = mCr * rr[p + 1] + mAr * rr[p] + mBr * rr[p + 2], k = mCk * rk[p + 1] + mAk * rk[p] + mBk * rk[p + 2], v = mCv * rv[p + 1] + mAv * rv[p] + mBv * rv[p + 2];
            const float wraw = ((S_LDS_F32P)(lds + SC_WR + wave * 8192))[p * 64 + lane] + w0j, araw = bf2f(((S_LDS_BF16P)(lds + SC_AR + wave * 4096))[p * 64 + lane]) + a0j;
            const float x = -wraw; const float sp = fmaxf(x, 0.f) + 0.6931471806f * S_LOG2(1.f + S_EXP2(-fabsf(x) * 1.442695041f));
            const float w = -sp - 0.5f; const float lw2 = -S_EXP2(w * 1.442695041f) * 1.442695041f;
            const float al = S_RCP(1.f + S_EXP2(-araw * 1.442695041f));
            const float kkr = k * kkj; const float nrm2 = swave_sum(kkr * kkr); const float kk = kkr * S_RSQ(fmaxf(nrm2, 1e-24f));
            const float kd = k * (1.f + (al - 1.f) * kaj);
            cs += lw2; const float gam = S_EXP2(cs), ig = S_EXP2(-cs);
            const float xa = -kk * gprev, xr = r * gam, xb = kk * al * ig, xk = kd * ig, xq = xr * rkj; gprev = gam;
            if (p & 1) { ppA[p >> 1] = S_PK(eA, xa); ppR[p >> 1] = S_PK(eR, xr); ppB[p >> 1] = S_PK(eB, xb); ppK[p >> 1] = S_PK(eK, xk); ppV[p >> 1] = S_PK(eV, v); ppQ[p >> 1] = S_PK(eQ, xq);
                         S_PIN(ppQ[p >> 1]); S_PIN(ppA[p >> 1]); S_PIN(ppR[p >> 1]); S_PIN(ppB[p >> 1]); S_PIN(ppK[p >> 1]); S_PIN(ppV[p >> 1]); }
            else { eA = xa; eR = xr; eB = xb; eK = xk; eV = v; eQ = xq; } }
        gamC = gprev;
    }
    S_MEMBAR();
    float gc0, gc1; { unsigned x = __float_as_uint(gamC), y = x; S_SWAP(x, y); gc0 = __uint_as_float(x); gc1 = __uint_as_float(y); }
    ((S_LDS_F32P)(lds + SC_GTAB + wave * 256))[lane] = gamC;
    const SMat FA = splain2d(ppA), FB = splain2d(ppB), FK = splain2d(ppK), FV = splain2d(ppV);
    SFrag RT[2], MrbT, MrkT, LakT, Pf, PTf; f32x16 TT;
    {   const SFrag IDF = sident(n, hh); SFrag AT[2], BT[2], KT[2];
        { const SMat FR = splain2d(ppR); S_UNROLL for (int dt = 0; dt < 2; ++dt) RT[dt] = spack(smm(FR.t[dt], IDF, szero())); }
        SFrag QT[2]; { const SMat FQ = splain2d(ppQ); S_UNROLL for (int dt = 0; dt < 2; ++dt) QT[dt] = spack(smm(FQ.t[dt], IDF, szero())); }
        S_UNROLL for (int dt = 0; dt < 2; ++dt) { AT[dt] = spack(smm(FA.t[dt], IDF, szero())); BT[dt] = spack(smm(FB.t[dt], IDF, szero())); KT[dt] = spack(smm(FK.t[dt], IDF, szero())); }
        f32x16 L = szero(), LT = szero(), lak = szero(), mrb = szero(), mrk = szero();
        { f32x16 bq = szero(); S_UNROLL for (int dt = 0; dt < 2; ++dt) bq = smm(KT[dt], QT[dt], bq);
          int nb = n, rb = 4 * hh; S_LAUNDER_I(nb); S_LAUNDER_I(rb); float dsum = 0.f; S_UNROLL for (int g = 0; g < 16; ++g) dsum += (((g & 3) + 8 * (g >> 2) + rb) == nb) ? bq[g] : 0.f;
          if (((nb >> 2) & 1) == (rb >> 2)) A.bonus[((size_t)b * T + (tau0 + sgn * nb)) * 8 + h] = dsum; }
        S_UNROLL for (int dt = 0; dt < 2; ++dt) { L = smm(AT[dt], BT[dt], L); LT = smm(BT[dt], AT[dt], LT); lak = smm(KT[dt], AT[dt], lak); mrb = smm(BT[dt], RT[dt], mrb); mrk = smm(KT[dt], RT[dt], mrk); }
        int n2 = n, r2 = 4 * hh; S_LAUNDER_I(n2); S_LAUNDER_I(r2);
        S_UNROLL for (int g = 0; g < 16; ++g) { const int row = (g & 3) + 8 * (g >> 2) + r2;
            L[g] = (row > n2) ? L[g] : 0.f; LT[g] = (row < n2) ? LT[g] : 0.f; lak[g] = (row < n2) ? lak[g] : 0.f; mrb[g] = (row <= n2) ? mrb[g] : 0.f; mrk[g] = (row <= n2) ? mrk[g] : 0.f; }
        Pf = spack(L); PTf = spack(LT); LakT = spack(lak); MrbT = spack(mrb); MrkT = spack(mrk);
        TT = LT; S_UNROLL for (int g = 0; g < 16; ++g) TT[g] += (((g & 3) + 8 * (g >> 2) + r2) == n2) ? 1.f : 0.f;
    }
    S_MEMBAR();
    SFrag TTf = spack(TT);
    S_UNROLL for (int i = 1; i <= 4; ++i) { const f32x16 P2 = smm(PTf, Pf, szero()); SFrag P2Tf; if (i < 4) P2Tf = spack(smm(Pf, PTf, szero()));
        Pf = spack(P2); TT = smm(Pf, TTf, TT); TTf = spack(TT); if (i < 4) PTf = P2Tf; }
    S_MEMBAR();
    SFrag U0[2], Ap[2], RpT[2], Y0[2], GTf[2][2], Hf[2][2];
    S_UNROLL for (int vt = 0; vt < 2; ++vt) { const SFrag W = spack(smm(LakT, FV.t[vt], szero())); U0[vt] = spack(smm(TTf, W, szero())); }
    S_UNROLL for (int kt = 0; kt < 2; ++kt) Ap[kt] = spack(smm(TTf, FA.t[kt], szero()));
    S_UNROLL for (int kt = 0; kt < 2; ++kt) RpT[kt] = spack(smm(Ap[kt], MrbT, sunpack(RT[kt])));
    S_UNROLL for (int vt = 0; vt < 2; ++vt) Y0[vt] = spack(smm(MrkT, FV.t[vt], smm(MrbT, U0[vt], szero())));
    int n3 = n, r3 = 4 * hh; S_LAUNDER_I(n3); S_LAUNDER_I(r3);
    S_UNROLL for (int nt = 0; nt < 2; ++nt) S_UNROLL for (int mt = 0; mt < 2; ++mt) { f32x16 gt = smm(Ap[nt], FB.t[mt], szero()); const float gcv = mt ? gc1 : gc0;
        S_UNROLL for (int g = 0; g < 16; ++g) { const float idv = (nt == mt && ((g & 3) + 8 * (g >> 2) + r3) == n3) ? 1.f : 0.f; gt[g] = (gt[g] + idv) * gcv; }
        GTf[nt][mt] = spack(gt); }
    S_LDS_WAIT();
    S_UNROLL for (int mt = 0; mt < 2; ++mt) { float gr[16];
        S_UNROLL for (int q = 0; q < 4; ++q) { const f32x4 t4 = *(S_LDS_CONST_F32X4P)(lds + SC_GTAB + wave * 256 + (32 * mt + 8 * q + 4 * hh) * 4); S_UNROLL for (int i = 0; i < 4; ++i) gr[4 * q + i] = t4[i]; }
        S_UNROLL for (int vt = 0; vt < 2; ++vt) { f32x16 hm = smm(FK.t[mt], FV.t[vt], smm(FB.t[mt], U0[vt], szero())); S_UNROLL for (int g = 0; g < 16; ++g) hm[g] *= gr[g]; Hf[mt][vt] = spack(hm); } }
    S_MEMBAR();
    S_FLAG_WAIT(lds + SC_FLAG, (unsigned)c);
    SFrag SG[2][2];
    S_UNROLL for (int kt = 0; kt < 2; ++kt) S_UNROLL for (int vt = 0; vt < 2; ++vt) S_UNROLL for (int s = 0; s < 2; ++s) SG[kt][vt].s[s] = *(S_LDS_CONST_BF16X8P)(lds + SC_SIG + ((((kt * 2 + vt) * 2 + s) * 64 + lane) * 16));
    S_LDS_WAIT();
    S_UNROLL for (int mt = 0; mt < 2; ++mt) S_UNROLL for (int vt = 0; vt < 2; ++vt) { f32x16 sn = sunpack(Hf[mt][vt]); S_UNROLL for (int nt = 0; nt < 2; ++nt) sn = smm(GTf[nt][mt], SG[nt][vt], sn);
        const SFrag f = spack(sn); S_UNROLL for (int s = 0; s < 2; ++s) *(S_LDS_BF16X8P)(lds + SC_SIG + ((((mt * 2 + vt) * 2 + s) * 64 + lane) * 16)) = f.s[s]; }
    S_LDS_WAIT();
    S_FLAG_STORE(lds + SC_FLAG, (unsigned)(c + 1));
    S_UNROLL for (int vt = 0; vt < 2; ++vt) { f32x16 y = sunpack(Y0[vt]); S_UNROLL for (int kt = 0; kt < 2; ++kt) y = smm(RpT[kt], SG[kt][vt], y);
        S_UNROLL for (int g = 0; g < 16; ++g) { const int p = (g & 3) + 8 * (g >> 2) + 4 * hh; A.ydir[((size_t)b * T + (tau0 + sgn * p)) * 512 + h * 64 + 32 * vt + n] = (bf16)(S_PK(y[g], 0.f) & 0xffffu); } }
}

__device__ __forceinline__ void attn_unit(const Frame& F, ArgsP A, int b, int kvh, int qb) {
    constexpr int KST = 72, VST = 388;
    LAS bf16* KS = (LAS bf16*)F.lds;
    LAS bf16* VT = (LAS bf16*)(F.lds + 384 * KST * 2);
    LAS float* wsf = (LAS float*)(F.lds + 384 * KST * 2 + 64 * VST * 2);
    const bf16* Z = (const bf16*)(A->ws + WS_Z); bf16* OA = (bf16*)(A->ws + WS_OATT);
    const int* positions = (const int*)A->in[2]; const float* qg = (const float*)A->in[19]; const float* kg = (const float*)A->in[20]; const float* sink = (const float*)A->in[21];
    const int tid = F.tid, lane = F.lane, wave = F.wave;
    const float LN_THETA = 13.122363377404328f;
    v4u kwa[6], vwa[6], rca[6], rsa[6];
#pragma unroll
    for (int i = 0; i < 6; ++i) { const int ct = tid + 512 * i, key = ct >> 3, ch = ct & 7; const int kp = qb * 128 - 128 + key; const bool valid = (kp >= 0) && (kp < T);
        const size_t rowoff = ((size_t)b * T + (valid ? kp : 0)) * NZ;
        kwa[i] = *(const GAS v4u*)(Z + rowoff + ZKA + kvh * 64 + ch * 8); vwa[i] = *(const GAS v4u*)(Z + rowoff + ZVA + kvh * 64 + ch * 8);
        const GAS v4u* rt = (const GAS v4u*)((const bf16*)(A->ws + WS_ROPE) + ((size_t)b * T + (valid ? kp : 0)) * 16); rca[i] = rt[0]; rsa[i] = rt[1]; }
#pragma unroll
    for (int i = 0; i < 6; ++i) { const int ct = tid + 512 * i, key = ct >> 3, ch = ct & 7; const int kp = qb * 128 - 128 + key; const bool valid = (kp >= 0) && (kp < T);
        v4u kw = kwa[i], vw = vwa[i];
        if (!valid) { kw = (v4u){0u, 0u, 0u, 0u}; vw = kw; }
        float kf[8] = {bflo(kw.x), bfhi(kw.x), bflo(kw.y), bfhi(kw.y), bflo(kw.z), bfhi(kw.z), bflo(kw.w), bfhi(kw.w)};
        float ss = 0.f;
#pragma unroll
        for (int j = 0; j < 8; ++j) ss += kf[j] * kf[j];
        ss += __shfl_xor(ss, 1); ss += __shfl_xor(ss, 2); ss += __shfl_xor(ss, 4);
        const float rs = rsqrtf(ss * (1.0f / 64.0f) + 1e-6f);
#pragma unroll
        for (int j = 0; j < 8; ++j) kf[j] = kf[j] * rs * kg[ch * 8 + j];
        float oth[8];
#pragma unroll
        for (int j = 0; j < 8; ++j) oth[j] = __shfl_xor(kf[j], 1);
        if (ch < 2) { const v4u cw = rca[i], sw = rsa[i];
            const float cs[8] = {bflo(cw.x), bfhi(cw.x), bflo(cw.y), bfhi(cw.y), bflo(cw.z), bfhi(cw.z), bflo(cw.w), bfhi(cw.w)};
            const float sn[8] = {bflo(sw.x), bfhi(sw.x), bflo(sw.y), bfhi(sw.y), bflo(sw.z), bfhi(sw.z), bflo(sw.w), bfhi(sw.w)};
#pragma unroll
            for (int j = 0; j < 8; ++j) kf[j] = (ch == 0) ? (kf[j] * cs[j] - oth[j] * sn[j]) : (kf[j] * cs[j] + oth[j] * sn[j]); }
        v4u ko; ko.x = pk2(kf[0], kf[1]); ko.y = pk2(kf[2], kf[3]); ko.z = pk2(kf[4], kf[5]); ko.w = pk2(kf[6], kf[7]);
        *(LAS v4u*)(KS + key * KST + ch * 8) = ko;
        const unsigned vv[4] = {vw.x, vw.y, vw.z, vw.w};
#pragma unroll
        for (int j = 0; j < 4; ++j) { VT[(ch * 8 + 2 * j) * VST + key] = (bf16)(vv[j] & 0xffffu); VT[(ch * 8 + 2 * j + 1) * VST + key] = (bf16)(vv[j] >> 16); } }
    __syncthreads();
    const int g = wave >> 1, hq = kvh * 4 + g, r32 = lane & 31, hh = lane >> 5;
    const float snk = sink[hq];
    float kbound; { float gm = fabsf(kg[lane]);
#pragma unroll
        for (int o = 1; o < 64; o <<= 1) gm = fmaxf(gm, __shfl_xor(gm, o));
        kbound = 8.0f * gm; }
#pragma unroll 1
    for (int qt = 0; qt < 2; ++qt) { const int qo = (wave & 1) * 64 + qt * 32, qrel = qo + r32; const size_t tok = (size_t)b * T + qb * 128 + qrel;
        float qf[4][8]; float ss = 0.f; v4u qraw[4];
#pragma unroll
        for (int sI = 0; sI < 4; ++sI) qraw[sI] = *(const GAS v4u*)(Z + tok * NZ + ZQ + hq * 64 + 16 * sI + 8 * hh);
        const GAS v4u* qrt = (const GAS v4u*)((const bf16*)(A->ws + WS_ROPE) + tok * 16); const v4u qrc = qrt[0], qrs = qrt[1];
#pragma unroll
        for (int sI = 0; sI < 4; ++sI) { const v4u qw = qraw[sI];
            qf[sI][0] = bflo(qw.x); qf[sI][1] = bfhi(qw.x); qf[sI][2] = bflo(qw.y); qf[sI][3] = bfhi(qw.y); qf[sI][4] = bflo(qw.z); qf[sI][5] = bfhi(qw.z); qf[sI][6] = bflo(qw.w); qf[sI][7] = bfhi(qw.w);
#pragma unroll
            for (int j = 0; j < 8; ++j) ss += qf[sI][j] * qf[sI][j]; }
        ss += __shfl_xor(ss, 32);
        const float rs = rsqrtf(ss * (1.0f / 64.0f) + 1e-6f) * 0.125f;
#pragma unroll
        for (int sI = 0; sI < 4; ++sI)
#pragma unroll
            for (int j = 0; j < 8; ++j) qf[sI][j] = qf[sI][j] * rs * qg[16 * sI + 8 * hh + j];
        { const v4u cw = qrc, sw = qrs;
          const float cs[8] = {bflo(cw.x), bfhi(cw.x), bflo(cw.y), bfhi(cw.y), bflo(cw.z), bfhi(cw.z), bflo(cw.w), bfhi(cw.w)}, sn[8] = {bflo(sw.x), bfhi(sw.x), bflo(sw.y), bfhi(sw.y), bflo(sw.z), bfhi(sw.z), bflo(sw.w), bfhi(sw.w)};
#pragma unroll
          for (int j = 0; j < 8; ++j) { const float oth = __shfl_xor(qf[0][j], 32); qf[0][j] = (hh == 0) ? (qf[0][j] * cs[j] - oth * sn[j]) : (qf[0][j] * cs[j] + oth * sn[j]); } }
        bf16x8 qr[4];
#pragma unroll
        for (int sI = 0; sI < 4; ++sI) { v4u w; w.x = pk2(qf[sI][0], qf[sI][1]); w.y = pk2(qf[sI][2], qf[sI][3]); w.z = pk2(qf[sI][4], qf[sI][5]); w.w = pk2(qf[sI][6], qf[sI][7]); qr[sI] = __builtin_bit_cast(bf16x8, w); }
        const int kt0 = qo >> 5;
        float qn2 = 0.f;
#pragma unroll
        for (int sI = 0; sI < 4; ++sI)
#pragma unroll
            for (int j = 0; j < 8; ++j) qn2 += qf[sI][j] * qf[sI][j];
        qn2 += __shfl_xor(qn2, 32);
        float mrun = sqrtf(qn2) * kbound * 1.02f;
        if (__any(mrun > 40.f)) { mrun = -1e30f;
#pragma unroll 1
            for (int kt = 0; kt < 9; ++kt) { const int kbase = (kt0 + kt) * 32;
                f32x16 acc = {};
#pragma unroll
                for (int sI = 0; sI < 4; ++sI) { const bf16x8 kfr = *(const LAS bf16x8*)(KS + (kbase + r32) * KST + 16 * sI + 8 * hh); acc = __builtin_amdgcn_mfma_f32_32x32x16_bf16(kfr, qr[sI], acc, 0, 0, 0); }
#pragma unroll
                for (int r = 0; r < 16; ++r) { const int ki = kbase + (r & 3) + 8 * (r >> 2) + 4 * hh; const int dq = ki - 128 - qrel, kp = qb * 128 - 128 + ki;
                    const bool ok = (dq >= -128) && (dq <= 128) && (kp >= 0) && (kp < T); mrun = fmaxf(mrun, ok ? acc[r] : -1e30f); } }
            mrun = fmaxf(mrun, __shfl_xor(mrun, 32)); }
        const float mx = fmaxf(mrun, snk);
        float lrun = 0.f; f32x16 o0 = {}, o1 = {}; const float mxl = mx * 1.442695041f; const bool edge = (qb == 0) || (qb == T / 128 - 1);
#pragma unroll 1
        for (int kt = 0; kt < 9; ++kt) { const int kbase = (kt0 + kt) * 32;
            f32x16 acc = {};
#pragma unroll
            for (int sI = 0; sI < 4; ++sI) { const bf16x8 kfr = *(const LAS bf16x8*)(KS + (kbase + r32) * KST + 16 * sI + 8 * hh); acc = __builtin_amdgcn_mfma_f32_32x32x16_bf16(kfr, qr[sI], acc, 0, 0, 0); }
            float p[16];
            if (edge || kt == 0 || kt == 8) {
#pragma unroll
                for (int r = 0; r < 16; ++r) { const int ki = kbase + (r & 3) + 8 * (r >> 2) + 4 * hh; const int dq = ki - 128 - qrel, kp = qb * 128 - 128 + ki;
                    const bool ok = (dq >= -128) && (dq <= 128) && (kp >= 0) && (kp < T); p[r] = ok ? __builtin_amdgcn_exp2f(acc[r] * 1.442695041f - mxl) : 0.f; lrun += p[r]; }
            } else {
#pragma unroll
                for (int r = 0; r < 16; ++r) { p[r] = __builtin_amdgcn_exp2f(acc[r] * 1.442695041f - mxl); lrun += p[r]; } }
#pragma unroll
            for (int sI = 0; sI < 2; ++sI) { v4u pw; pw.x = pk2(p[8 * sI + 0], p[8 * sI + 1]); pw.y = pk2(p[8 * sI + 2], p[8 * sI + 3]); pw.z = pk2(p[8 * sI + 4], p[8 * sI + 5]); pw.w = pk2(p[8 * sI + 6], p[8 * sI + 7]);
                const bf16x8 pa = __builtin_bit_cast(bf16x8, pw); const int key0 = kbase + 16 * sI + 4 * hh;
                { const u32x2 lo = *(const LAS u32x2*)(VT + r32 * VST + key0), hi = *(const LAS u32x2*)(VT + r32 * VST + key0 + 8); v4u vw; vw.x = lo.x; vw.y = lo.y; vw.z = hi.x; vw.w = hi.y;
                  o0 = __builtin_amdgcn_mfma_f32_32x32x16_bf16(pa, __builtin_bit_cast(bf16x8, vw), o0, 0, 0, 0); }
                { const u32x2 lo = *(const LAS u32x2*)(VT + (32 + r32) * VST + key0), hi = *(const LAS u32x2*)(VT + (32 + r32) * VST + key0 + 8); v4u vw; vw.x = lo.x; vw.y = lo.y; vw.z = hi.x; vw.w = hi.y;
                  o1 = __builtin_amdgcn_mfma_f32_32x32x16_bf16(pa, __builtin_bit_cast(bf16x8, vw), o1, 0, 0, 0); } } }
        lrun += __shfl_xor(lrun, 32);
        const float linv = 1.0f / (lrun + __expf(snk - mx));
        if (hh == 0) wsf[wave * 64 + r32] = linv;
        LDS_WAIT(); asm volatile("" ::: "memory");
#pragma unroll
        for (int r = 0; r < 16; ++r) { const int row = (r & 3) + 8 * (r >> 2) + 4 * hh; const float li = wsf[wave * 64 + row];
            bf16* op = OA + ((size_t)b * T + qb * 128 + qo + row) * 512 + hq * 64;
            op[r32] = (bf16)f2bf(o0[r] * li); op[32 + r32] = (bf16)f2bf(o1[r] * li); }
        LDS_WAIT(); asm volatile("" ::: "memory");
    }
    __syncthreads();
}

__device__ __forceinline__ void pg_rows(const Frame& F, ArgsP A, bf16* wout) {
    const bf16* Z = (const bf16*)(A->ws + WS_Z); const bf16* Y0 = (const bf16*)(A->ws + WS_XN); const bf16* Y1 = Y0 + (size_t)M * 512;
    bf16* Gb = (bf16*)(A->ws + WS_G); const float* bonus = (const float*)(A->ws + WS_BONUS);
    const float* mu_prev = (const float*)A->in[7]; const float* mu_next = (const float*)A->in[8]; const float* gn_w = (const float*)A->in[17]; const float* gn_b = (const float*)A->in[18];
    const int gw = F.vcu * NWAVES + F.wave, NGW = F.G * NWAVES, lane = F.lane, c0 = lane * 8, h = lane >> 3;
    float mp[8], mn[8], gw_[8], gb_[8];
#pragma unroll
    for (int j = 0; j < 8; ++j) { mp[j] = mu_prev[ZV + c0 + j]; mn[j] = mu_next[ZV + c0 + j]; gw_[j] = gn_w[c0 + j]; gb_[j] = gn_b[c0 + j]; }
#pragma unroll 1
    for (int m0 = gw; m0 < M; m0 += 4 * NGW) {
        v4u y0[4], y1[4], gv[4], z0[4], zm[4], zq[4]; float bon[4];
#pragma unroll
        for (int i = 0; i < 4; ++i) { const int m = m0 + i * NGW, t = m & (T - 1);
            y0[i] = *(const GAS v4u*)(Y0 + (size_t)m * 512 + c0); y1[i] = *(const GAS v4u*)(Y1 + (size_t)m * 512 + c0); gv[i] = *(const GAS v4u*)(Gb + (size_t)m * 512 + c0);
            z0[i] = *(const GAS v4u*)(Z + (size_t)m * NZ + ZV + c0);
            zm[i] = (v4u){0u, 0u, 0u, 0u}; zq[i] = (v4u){0u, 0u, 0u, 0u};
            if (t > 0) zm[i] = *(const GAS v4u*)(Z + (size_t)(m - 1) * NZ + ZV + c0);
            if (t < T - 1) zq[i] = *(const GAS v4u*)(Z + (size_t)(m + 1) * NZ + ZV + c0);
            bon[i] = bonus[(size_t)m * 8 + h] + bonus[(size_t)M * 8 + (size_t)m * 8 + h]; }
#pragma unroll
        for (int i = 0; i < 4; ++i) { const int m = m0 + i * NGW;
            const unsigned y0w[4] = {y0[i].x, y0[i].y, y0[i].z, y0[i].w}, y1w[4] = {y1[i].x, y1[i].y, y1[i].z, y1[i].w}, gvw[4] = {gv[i].x, gv[i].y, gv[i].z, gv[i].w};
            const unsigned z0w[4] = {z0[i].x, z0[i].y, z0[i].z, z0[i].w}, zmw[4] = {zm[i].x, zm[i].y, zm[i].z, zm[i].w}, zqw[4] = {zq[i].x, zq[i].y, zq[i].z, zq[i].w};
            float y[8], gg[8], vv[8]; float sacc = 0.f;
#pragma unroll
            for (int j = 0; j < 4; ++j) { y[2 * j] = bflo(y0w[j]) + bflo(y1w[j]); y[2 * j + 1] = bfhi(y0w[j]) + bfhi(y1w[j]); gg[2 * j] = bflo(gvw[j]); gg[2 * j + 1] = bfhi(gvw[j]);
                const float a0 = bflo(z0w[j]), a1 = bfhi(z0w[j]);
                vv[2 * j] = a0 + mp[2 * j] * (bflo(zmw[j]) - a0) + mn[2 * j] * (bflo(zqw[j]) - a0); vv[2 * j + 1] = a1 + mp[2 * j + 1] * (bfhi(zmw[j]) - a1) + mn[2 * j + 1] * (bfhi(zqw[j]) - a1);
                sacc += y[2 * j] + y[2 * j + 1]; }
            sacc += __shfl_xor(sacc, 1); sacc += __shfl_xor(sacc, 2); sacc += __shfl_xor(sacc, 4);
            const float mu = sacc * (1.0f / 64.0f); float q = 0.f;
#pragma unroll
            for (int j = 0; j < 8; ++j) { const float d = y[j] - mu; q += d * d; }
            q += __shfl_xor(q, 1); q += __shfl_xor(q, 2); q += __shfl_xor(q, 4);
            const float rstd = rsqrtf(q * (1.0f / 64.0f) + 64e-5f);
            float o[8];
#pragma unroll
            for (int j = 0; j < 8; ++j) o[j] = ((y[j] - mu) * rstd * gw_[j] + gb_[j] + bon[i] * vv[j]) * gg[j];
            v4u w; w.x = pk2(o[0], o[1]); w.y = pk2(o[2], o[3]); w.z = pk2(o[4], o[5]); w.w = pk2(o[6], o[7]);
            *(GAS v4u*)(wout + (size_t)m * 512 + c0) = w; } }
}

__device__ __forceinline__ void pj_phase(const Frame& F, ArgsP A) {
    unsigned char* ws = A->ws;
    const int gw = F.vcu * NWAVES + F.wave, NGW = F.G * NWAVES, lane = F.lane;
    { LAS float* scr = (LAS float*)(F.lds + F.wave * 16384);
      const float* w_gate = (const float*)A->in[27]; const float* w_up = (const float*)A->in[28]; const float* w_down = (const float*)A->in[29];
      bf16* WguT = (bf16*)((unsigned char*)A->out + OUT_WGUT); bf16* WdT = (bf16*)((unsigned char*)A->out + OUT_WDT);
      constexpr int PER = 512, NIT = 16 * 3 * PER;
      for (int it = gw; it < NIT; it += NGW) { const int e = it / (3 * PER), r = it % (3 * PER), which = r / PER, q = r % PER, kb = q >> 5, nb = q & 31, n0 = 32 * nb;
          if (which == 0) tr_item(w_gate + (size_t)e * 1048576, 1024, 64 * kb, n0, WguT, 1024, e * 2048 + (n0 >> 7) * 256 + (n0 & 127), scr, lane);
          else if (which == 1) tr_item(w_up + (size_t)e * 1048576, 1024, 64 * kb, n0, WguT, 1024, e * 2048 + (n0 >> 7) * 256 + 128 + (n0 & 127), scr, lane);
          else tr_item(w_down + (size_t)e * 1048576, 1024, 64 * kb, n0, WdT, 1024, e * 1024 + n0, scr, lane); }
    }
    __syncthreads();
    const float* w_router = (const float*)A->in[26]; const bf16* x1 = (const bf16*)(ws + WS_X1); const float* g2n = (const float*)A->in[25]; const float* mod = (const float*)(ws + WS_MOD);
    bf16* XN2 = (bf16*)(ws + WS_XN); float* aff = (float*)(ws + WS_AFF);
    LAS bf16* WF = (LAS bf16*)F.lds;
    LAS float* AT = (LAS float*)(F.lds + 65536); LAS float* BT = AT + 1024; LAS float* CB = BT + 1024;
    const int tile = gw, b = tile >> 7;
    for (int d = F.tid; d < 1024; d += 512) { AT[d] = g2n[d] * (1.0f + mod[(size_t)b * 6144 + 4096 + d]); BT[d] = mod[(size_t)b * 6144 + 3072 + d]; }
    __syncthreads();
#pragma unroll 4
    for (int k = 0; k < 32; ++k) { const int it = F.tid + 512 * k, jj = it & 7, ln = (it >> 3) & 63, sI = it >> 9, q = ln >> 4, e = ln & 15, d = 32 * sI + 8 * q + jj;
        const float v = AT[d] * w_router[d * 16 + e]; const unsigned hi = pk2(v, 0.f) & 0xffffu; const float lo = v - __uint_as_float(hi << 16);
        WF[it] = (bf16)hi; WF[16384 + it] = (bf16)(pk2(lo, 0.f) & 0xffffu); }
    { float c0 = 0.f, c1 = 0.f;
#pragma unroll 4
      for (int k = 0; k < 16; ++k) { const int d = lane + 64 * k; c0 += BT[d] * w_router[d * 16 + 2 * F.wave]; c1 += BT[d] * w_router[d * 16 + 2 * F.wave + 1]; }
      c0 = dpp_wave_sum(c0); c1 = dpp_wave_sum(c1); if (lane == 0) { CB[2 * F.wave] = c0; CB[2 * F.wave + 1] = c1; } }
    __syncthreads();
    if (tile < M / 16) { const int r = lane & 15, q = lane >> 4; const size_t m = (size_t)tile * 16 + r;
        float ss = 0.f;
#pragma unroll 1
        for (int hf = 0; hf < 2; ++hf) { v4u raw[16];
#pragma unroll
            for (int sI = 0; sI < 16; ++sI) raw[sI] = *(const GAS v4u*)(x1 + m * 1024 + 32 * (16 * hf + sI) + 8 * q);
#pragma unroll
            for (int sI = 0; sI < 16; ++sI) { const v4u w = raw[sI]; const float a0 = bflo(w.x), a1 = bfhi(w.x), a2 = bflo(w.y), a3 = bfhi(w.y), a4 = bflo(w.z), a5 = bfhi(w.z), a6 = bflo(w.w), a7 = bfhi(w.w);
                ss += (a0 * a0 + a1 * a1) + (a2 * a2 + a3 * a3) + (a4 * a4 + a5 * a5) + (a6 * a6 + a7 * a7); } }
        ss += __shfl_xor(ss, 16); ss += __shfl_xor(ss, 32);
        const float rs = rsqrtf(ss * (1.0f / 1024.0f) + 1e-6f);
        f32x4 ah = {0.f, 0.f, 0.f, 0.f}, al = {0.f, 0.f, 0.f, 0.f};
#pragma unroll 1
        for (int hf = 0; hf < 2; ++hf) { v4u raw[16];
#pragma unroll
            for (int sI = 0; sI < 16; ++sI) raw[sI] = *(const GAS v4u*)(x1 + m * 1024 + 32 * (16 * hf + sI) + 8 * q);
#pragma unroll
            for (int sI = 0; sI < 16; ++sI) { const int sg = 16 * hf + sI; const bf16x8 xa = __builtin_bit_cast(bf16x8, raw[sI]);
                const bf16x8 bh = *(const LAS bf16x8*)(WF + (sg * 64 + lane) * 8), bl = *(const LAS bf16x8*)(WF + 16384 + (sg * 64 + lane) * 8);
                ah = __builtin_amdgcn_mfma_f32_16x16x32_bf16(xa, bh, ah, 0, 0, 0); al = __builtin_amdgcn_mfma_f32_16x16x32_bf16(xa, bl, al, 0, 0, 0); }
#pragma unroll
            for (int sI = 0; sI < 16; ++sI) { if ((sI & 3) == 0) asm volatile("" ::: "memory");
                const int d0 = 32 * (16 * hf + sI) + 8 * q; const v4u w = raw[sI];
                const f32x4 a0 = *(const LAS f32x4*)(AT + d0), a1 = *(const LAS f32x4*)(AT + d0 + 4), b0 = *(const LAS f32x4*)(BT + d0), b1 = *(const LAS f32x4*)(BT + d0 + 4);
                v4u o; o.x = pk2(bflo(w.x) * rs * a0.x + b0.x, bfhi(w.x) * rs * a0.y + b0.y); o.y = pk2(bflo(w.y) * rs * a0.z + b0.z, bfhi(w.y) * rs * a0.w + b0.w);
                o.z = pk2(bflo(w.z) * rs * a1.x + b1.x, bfhi(w.z) * rs * a1.y + b1.y); o.w = pk2(bflo(w.w) * rs * a1.z + b1.z, bfhi(w.w) * rs * a1.w + b1.w);
                *(GAS v4u*)(XN2 + m * 1024 + d0) = o; } }
        const float cb = CB[lane & 15]; float lg[4], mx[4], ex[4], den[4];
#pragma unroll
        for (int i = 0; i < 4; ++i) { const float rsr = __shfl(rs, 4 * q + i); lg[i] = rsr * (ah[i] + al[i]) + cb; mx[i] = lg[i]; }
#pragma unroll
        for (int o = 1; o < 16; o <<= 1)
#pragma unroll
            for (int i = 0; i < 4; ++i) mx[i] = fmaxf(mx[i], __shfl_xor(mx[i], o));
#pragma unroll
        for (int i = 0; i < 4; ++i) { ex[i] = expf(lg[i] - mx[i]); den[i] = ex[i]; }
#pragma unroll
        for (int o = 1; o < 16; o <<= 1)
#pragma unroll
            for (int i = 0; i < 4; ++i) den[i] += __shfl_xor(den[i], o);
        { const int t0 = (tile & 127) * 16 + 4 * q; f32x4 av; av.x = ex[0] / den[0]; av.y = ex[1] / den[1]; av.z = ex[2] / den[2]; av.w = ex[3] / den[3];
          *(GAS f32x4*)(aff + ((size_t)b * 16 + (lane & 15)) * T + t0) = av; } }
}

__device__ __forceinline__ void pk_task(const Frame& F, ArgsP A, int b, int e) {
    unsigned char* ws = A->ws;
    const float* aff = (const float*)(ws + WS_AFF) + ((size_t)b * 16 + e) * T;
    int* slotmap = (int*)(ws + WS_SLOT); float* selaff = (float*)(ws + WS_SELAFF); int* selidx = (int*)(ws + WS_SELIDX);
    const bf16* XN2 = (const bf16*)(ws + WS_XN); bf16* XE = (bf16*)(ws + WS_XE);
    LAS unsigned* cnt = (LAS unsigned*)F.lds;
    LAS int* tokl = (LAS int*)(F.lds + 256);
    const int tid = F.tid, lane = F.lane, wave = F.wave;
    const f32x4 v4 = *(const GAS f32x4*)(aff + 4 * tid);
    const unsigned key[4] = {__float_as_uint(v4.x), __float_as_uint(v4.y), __float_as_uint(v4.z), __float_as_uint(v4.w)};
    unsigned thr = 0u;
#pragma unroll 1
    for (int bit = 31; bit >= 0; --bit) { const unsigned cand = thr | (1u << bit);
        const unsigned c = (unsigned)(__popcll(__ballot(key[0] >= cand)) + __popcll(__ballot(key[1] >= cand)) + __popcll(__ballot(key[2] >= cand)) + __popcll(__ballot(key[3] >= cand)));
        LAS unsigned* slot_ = cnt + 16 + (bit & 1) * 8;
        if (lane == 0) slot_[wave] = c;
        __syncthreads();
        unsigned tot = 0;
#pragma unroll
        for (int w = 0; w < 8; ++w) tot += slot_[w];
        if (tot >= 256u) thr = cand; }
    __syncthreads();
    int ngt = 0, neq = 0;
#pragma unroll
    for (int j = 0; j < 4; ++j) { ngt += key[j] > thr; neq += key[j] == thr; }
    int sg = ngt, se = neq;
#pragma unroll
    for (int o = 1; o < 64; o <<= 1) { const int a = __shfl_up(sg, o), c = __shfl_up(se, o); if (lane >= o) { sg += a; se += c; } }
    if (lane == 63) { cnt[wave] = (unsigned)sg; cnt[8 + wave] = (unsigned)se; }
    __syncthreads();
    int bg = 0, be = 0, totg = 0;
#pragma unroll
    for (int w = 0; w < 8; ++w) { const int a = (int)cnt[w], c = (int)cnt[8 + w]; if (w < wave) { bg += a; be += c; } totg += a; }
    int pg = bg + sg - ngt, pe = be + se - neq;
    const int need_eq = 256 - totg;
    int* smrow = slotmap + ((size_t)b * T + 4 * tid) * 16 + e;
#pragma unroll
    for (int j = 0; j < 4; ++j) { int slot = -1;
        if (key[j] > thr) { slot = pg; ++pg; } else if (key[j] == thr) { if (pe < need_eq) slot = totg + pe; ++pe; }
        smrow[j * 16] = slot;
        if (slot >= 0) { selidx[((size_t)e * 16 + b) * 256 + slot] = b * T + 4 * tid + j; selaff[((size_t)e * 16 + b) * 256 + slot] = __uint_as_float(key[j]); } }
    __syncthreads();
}

__device__ __forceinline__ void pn_rows(const Frame& F, ArgsP A, float* wout) {
    unsigned char* ws = A->ws;
    const int* slotmap = (const int*)(ws + WS_SLOT); const bf16* YE = (const bf16*)(ws + WS_XE); const float* mod = (const float*)(ws + WS_MOD); const bf16* X1 = (const bf16*)(ws + WS_X1);
    const int gw = F.vcu * NWAVES + F.wave, NGW = F.G * NWAVES, lane = F.lane;
#pragma unroll 1
    for (int m0 = gw; m0 < M; m0 += 2 * NGW) {
        int myslot[2]; f32x4 xv[2][4];
#pragma unroll
        for (int i = 0; i < 2; ++i) { const int m = m0 + i * NGW; myslot[i] = slotmap[(size_t)m * 16 + (lane & 15)];
#pragma unroll
            for (int hq = 0; hq < 2; ++hq) { const v4u w = *(const GAS v4u*)(X1 + (size_t)m * 1024 + hq * 512 + lane * 8);
                xv[i][2 * hq] = (f32x4){bflo(w.x), bfhi(w.x), bflo(w.y), bfhi(w.y)}; xv[i][2 * hq + 1] = (f32x4){bflo(w.z), bfhi(w.z), bflo(w.w), bfhi(w.w)}; } }
        unsigned long long msk[2]; v4u yw[2][4][2];
#pragma unroll
        for (int i = 0; i < 2; ++i) { const int b = (m0 + i * NGW) >> 11; msk[i] = __ballot(myslot[i] >= 0) & 0xffffull;
#pragma unroll
            for (int k = 0; k < 4; ++k) { const bool has = msk[i] != 0ull; const int e = has ? __builtin_ctzll(msk[i]) : 0; if (has) msk[i] &= msk[i] - 1; const int sl = __shfl(myslot[i], e);
                yw[i][k][0] = (v4u){0u, 0u, 0u, 0u}; yw[i][k][1] = (v4u){0u, 0u, 0u, 0u};
                if (has) { const GAS v4u* yr = (const GAS v4u*)(YE + (((size_t)e * 16 + b) * 256 + sl) * 1024); yw[i][k][0] = yr[lane]; yw[i][k][1] = yr[64 + lane]; } } }
#pragma unroll
        for (int i = 0; i < 2; ++i) { const int m = m0 + i * NGW, b = m >> 11;
            float acc[16];
#pragma unroll
            for (int j = 0; j < 16; ++j) acc[j] = 0.f;
#pragma unroll
            for (int k = 0; k < 4; ++k)
#pragma unroll
                for (int hlf = 0; hlf < 2; ++hlf) { const v4u w = yw[i][k][hlf];
                    acc[hlf * 8 + 0] += bflo(w.x); acc[hlf * 8 + 1] += bfhi(w.x); acc[hlf * 8 + 2] += bflo(w.y); acc[hlf * 8 + 3] += bfhi(w.y);
                    acc[hlf * 8 + 4] += bflo(w.z); acc[hlf * 8 + 5] += bfhi(w.z); acc[hlf * 8 + 6] += bflo(w.w); acc[hlf * 8 + 7] += bfhi(w.w); }
            unsigned long long mk = msk[i];
            while (mk) { const int e = __builtin_ctzll(mk); mk &= mk - 1; const int sl = __shfl(myslot[i], e);
                const GAS v4u* yr = (const GAS v4u*)(YE + (((size_t)e * 16 + b) * 256 + sl) * 1024);
#pragma unroll
                for (int hlf = 0; hlf < 2; ++hlf) { const v4u w = yr[hlf * 64 + lane];
                    acc[hlf * 8 + 0] += bflo(w.x); acc[hlf * 8 + 1] += bfhi(w.x); acc[hlf * 8 + 2] += bflo(w.y); acc[hlf * 8 + 3] += bfhi(w.y);
                    acc[hlf * 8 + 4] += bflo(w.z); acc[hlf * 8 + 5] += bfhi(w.z); acc[hlf * 8 + 6] += bflo(w.w); acc[hlf * 8 + 7] += bfhi(w.w); } }
            const float* gt2 = mod + (size_t)b * 6144 + 5120; float* orow = wout + (size_t)m * 1024;
#pragma unroll
            for (int q = 0; q < 4; ++q) { const int c = (q >> 1) * 512 + lane * 8 + (q & 1) * 4; const f32x4 g = *(const GAS f32x4*)(gt2 + c);
                f32x4 a; a.x = acc[(q >> 1) * 8 + (q & 1) * 4 + 0]; a.y = acc[(q >> 1) * 8 + (q & 1) * 4 + 1]; a.z = acc[(q >> 1) * 8 + (q & 1) * 4 + 2]; a.w = acc[(q >> 1) * 8 + (q & 1) * 4 + 3];
                *(GAS f32x4*)(orow + c) = xv[i][q] + g * a; } } }
}

__device__ __forceinline__ void mk_frame(Frame& F, LAS unsigned char* lds, int wave_s) {
    int bx = blockIdx.x, G = gridDim.x; LAUNDER(bx); LAUNDER(G);
    F.lds = lds; F.MISC = (volatile LAS unsigned*)(lds + MISC_OFF); F.ctl = nullptr;
    unsigned ones_ = ~0u; asm volatile("" : "+s"(ones_));
    int lane_ = (int)__builtin_amdgcn_mbcnt_hi(ones_, __builtin_amdgcn_mbcnt_lo(ones_, 0u)); asm volatile("" : "+v"(lane_));
    F.lane = lane_; F.wave = wave_s; F.tid = wave_s * 64 + lane_;
    F.G = G; F.vcu = (G % 8 == 0) ? (bx % 8) * (G / 8) + bx / 8 : bx;
}
__global__ void __launch_bounds__(NWAVES * 64, 2) fwd_kernel(Args args) {
    extern __shared__ __attribute__((aligned(16))) unsigned char lds[];
    LAS unsigned char* const ldsb = (LAS unsigned char*)lds;
    ArgsP ap0 = (ArgsP)__builtin_amdgcn_kernarg_segment_ptr();
    int wave_s = __builtin_amdgcn_readfirstlane((int)threadIdx.x >> 6); asm volatile("" : "+s"(wave_s));
    for (int u = threadIdx.x; u < (LDS_BYTES - LDSCTL_OFF) / 4; u += NWAVES * 64) ((LAS unsigned*)(ldsb + LDSCTL_OFF))[u] = 0u;
    __syncthreads();
#define MKBAR XcdBarrier bar; { ArgsP a_ = ap0; LAUNDER(a_); bar.bar = (unsigned*)(a_->ws + WS_CTL) + CW_BAR; bar.x = xb_xcc_id(); bar.st = (volatile LAS unsigned*)(ldsb + MISC_OFF) + 8; }
#if ONE_LAUNCH
    { MKBAR; if (threadIdx.x == 0) (void)xb_add(&bar.bar[XB_XCNT(bar.x)], 1u); }
#ifndef PHM
#define PHM 0x3fff
#endif
#define IN(k) ((PHM >> (k)) & 1)
#define SEAM(k) do { if (IN(k) && IN((k) + 1)) { MKBAR; { unsigned o_ = ~0u; asm volatile("" : "+s"(o_)); xcd_barrier(bar, wave_s == 0 && __builtin_amdgcn_mbcnt_hi(o_, __builtin_amdgcn_mbcnt_lo(o_, 0u)) == 0u); } } } while (0)
#else
    int lo, hi; { ArgsP a = ap0; LAUNDER(a); lo = a->ph_lo; hi = a->ph_hi; }
#define IN(k) (lo <= (k) && (k) < hi)
#define SEAM(k) do { } while (0)
#endif
    typedef pg8::bf16_t pb;
#ifndef REPMASK
#define REPMASK 0
#endif
#define PHASE_ARGS ArgsP ap = ap0; LAUNDER(ap); unsigned char* ws = ap->ws; (void)ws; Frame F; mk_frame(F, ldsb, wave_s); const int gw = F.vcu * NWAVES + F.wave, NGW = F.G * NWAVES; (void)gw; (void)NGW
    if (IN(0)) _Pragma("unroll 1") for (int rep_ = 0; rep_ <= ((REPMASK >> 0) & 1); ++rep_) { PHASE_ARGS; p0_prologue(F, ap); } SEAM(0);
    if (IN(1)) _Pragma("unroll 1") for (int rep_ = 0; rep_ <= ((REPMASK >> 1) & 1); ++rep_) { PHASE_ARGS; const float* x = (const float*)ap->in[0]; const float* g1 = (const float*)ap->in[5]; const float* mod = (const float*)(ws + WS_MOD); bf16* XN = (bf16*)(ws + WS_XN);
#pragma unroll 1
        for (int m = gw; m < M; m += 4 * NGW) { f32x4 u[4][4]; modnorm_rows<4, false>(x, m, NGW, g1, mod, 0, 1024, XN, F.lane, u);
            if (F.lane < 32) { const int mm = m + (F.lane >> 3) * NGW, j = F.lane & 7; const float pos = (float)((const int*)ap->in[2])[mm];
                const float ang = pos * __expf(-(float)j * 0.125f * 13.122363377404328f); float sn, cs; sincosf(ang, &sn, &cs);
                bf16* rt = (bf16*)(ws + WS_ROPE) + (size_t)mm * 16; rt[j] = (bf16)(pk2(cs, 0.f) & 0xffffu); rt[8 + j] = (bf16)(pk2(sn, 0.f) & 0xffffu); } } } SEAM(1);
    if (IN(2)) _Pragma("unroll 1") for (int rep_ = 0; rep_ <= ((REPMASK >> 2) & 1); ++rep_) { PHASE_ARGS; pg8::Gemm g{(const pb*)(ws + WS_XN), (const pb*)(ws + WS_WINT), M, NZP, D}; pg8::StaticOrder S; S.init(M, NZP, F.G, (int)blockIdx.x);
        pg8::EpiZ E{(pb*)(ws + WS_Z)}; pg8::gemm_phase<pg8::EpiZ, pg8::StaticOrder, true, true>(F.lds, g, S, E, F.tid); } SEAM(2);
    if (IN(3)) {
#ifndef REP_SCAN
#define REP_SCAN 1
#endif
#ifndef REP_ATTN
#define REP_ATTN 1
#endif
      { int c0_, G_; { Frame F0; mk_frame(F0, ldsb, wave_s); c0_ = F0.vcu; G_ = F0.G; }
#pragma unroll 1
        for (int c = c0_; c < 256 * REP_SCAN; c += G_) { PHASE_ARGS; const int b = (c >> 4) & 15, h = (c >> 1) & 7, dir = c & 1;
            scan2_setup(F.lds, (const GAS float*)ap->in[10], (const GAS float*)ap->in[12], h, dir, F.tid); __syncthreads();
            const ScanArgs SA{(const GAS bf16*)(ws + WS_Z), (const GAS float*)ap->in[7], (const GAS float*)ap->in[8], (const GAS float*)ap->in[9], (const GAS float*)ap->in[11], (const GAS float*)ap->in[14], (const GAS float*)ap->in[15], (const GAS float*)ap->in[16],
                              (GAS bf16*)(ws + WS_XN) + (size_t)dir * M * 512, (GAS float*)(ws + WS_BONUS) + (size_t)dir * M * 8};
#pragma unroll 1
            for (int cc = F.wave; cc < T / 32; cc += 8) scan2_chunk(F.lds, SA, b, h, dir, cc, F.lane, F.wave);
            __syncthreads(); } }
      { PHASE_ARGS;
#pragma unroll 1
        for (int u = F.vcu; u < 512 * REP_ATTN; u += F.G) { attn_unit(F, ap, (u >> 5) & 15, (u >> 4) & 1, u & 15); } }
      { PHASE_ARGS;
        const bf16* Z = (const bf16*)(ws + WS_Z); bf16* SGD = (bf16*)(ws + WS_SGD); const float* mu_prev = (const float*)ap->in[7]; const float* mu_next = (const float*)ap->in[8];
          const int c = ZGD + 2 * F.lane; const float mp0 = mu_prev[c], mp1 = mu_prev[c + 1], mn0 = mu_next[c], mn1 = mu_next[c + 1];
#ifndef REP_SGD
#define REP_SGD 1
#endif
          const int tile = F.vcu;
          if (tile < 256) { const int pm = tile >> 1, pn = tile & 1; constexpr int RS = 136;
              LAS bf16* SG = (LAS bf16*)F.lds; LAS bf16* GT = (LAS bf16*)(F.lds + 256 * RS * 2);
              __syncthreads();
              const int mt0 = pm * 256 + F.wave * 32;
#pragma unroll 1
              for (int m0 = 0; m0 < 32; m0 += 4) { unsigned z0[4], zm[4], zq[4];
#pragma unroll
                  for (int i = 0; i < 4; ++i) { const int m = mt0 + m0 + i, t = m & (T - 1);
                      z0[i] = *(const GAS unsigned*)(Z + (size_t)m * NZ + c); zm[i] = t > 0 ? *(const GAS unsigned*)(Z + (size_t)(m - 1) * NZ + c) : 0u; zq[i] = t < T - 1 ? *(const GAS unsigned*)(Z + (size_t)(m + 1) * NZ + c) : 0u; }
#pragma unroll
                  for (int i = 0; i < 4; ++i) { const float a0 = bflo(z0[i]), a1 = bfhi(z0[i]); const float s0 = a0 + mp0 * (bflo(zm[i]) - a0) + mn0 * (bflo(zq[i]) - a0), s1 = a1 + mp1 * (bfhi(zm[i]) - a1) + mn1 * (bfhi(zq[i]) - a1);
                      *(LAS unsigned*)(SG + (F.wave * 32 + m0 + i) * RS + 2 * F.lane) = pk2(sigm(s0), sigm(s1)); } }
              __syncthreads();
              const int r32 = F.lane & 31, hh = F.lane >> 5; bf16x8 af[8];
#pragma unroll
              for (int sI = 0; sI < 8; ++sI) af[sI] = *(const LAS bf16x8*)(SG + (F.wave * 32 + r32) * RS + 16 * sI + 8 * hh);
              bf16* Gout = (bf16*)(ws + WS_G); const bf16* G2T = (const bf16*)(ws + WS_G2T);
#pragma unroll 1
              for (int hf = 0; hf < 2; ++hf) {
#pragma unroll
                  for (int i = 0; i < 4; ++i) { const int e = F.tid + 512 * i, rr = e >> 4, ch = e & 15; *(LAS v4u*)(GT + rr * RS + ch * 8) = *(const GAS v4u*)(G2T + (size_t)(256 * pn + 128 * hf + rr) * 256 + ch * 8); }
                  __syncthreads();
#pragma unroll 1
                  for (int ct = 0; ct < 4; ++ct) { f32x16 acc = {};
#pragma unroll
                      for (int sI = 0; sI < 8; ++sI) { const bf16x8 bfr = *(const LAS bf16x8*)(GT + (32 * ct + r32) * RS + 16 * sI + 8 * hh); acc = __builtin_amdgcn_mfma_f32_32x32x16_bf16(af[sI], bfr, acc, 0, 0, 0); }
#pragma unroll
                      for (int g = 0; g < 16; ++g) { const int row = (g & 3) + 8 * (g >> 2) + 4 * hh;
                          Gout[(size_t)(mt0 + row) * 512 + 256 * pn + 128 * hf + 32 * ct + r32] = (bf16)(pk2(acc[g], 0.f) & 0xffffu); } }
                  __syncthreads(); } } }
    } SEAM(4);
#ifndef REP_PG
#define REP_PG 0
#endif
    if (IN(5)) { PHASE_ARGS; if (REP_PG) pg_rows(F, ap, (bf16*)ap->out); pg_rows(F, ap, (bf16*)(ws + WS_G)); } SEAM(5);
    if (IN(6)) { PHASE_ARGS; static_assert(WS_G == WS_OATT + (size_t)M * 512 * 2 && WS_PAT == WS_PRT + (size_t)1024 * 512 * 2, "merged operand views need adjacent buffers");
        pg8::Gemm g{(const pb*)(ws + WS_OATT), (const pb*)(ws + WS_PRT), 2 * M, 2048, 512}; pg8::MergeOrder S; S.init(F.G, (int)blockIdx.x);
        pg8::EpiGate2 E{(pb*)(ws + WS_XN), (const pb*)(ws + WS_Z)}; pg8::gemm_phase<pg8::EpiGate2, pg8::MergeOrder, true, true>(F.lds, g, S, E, F.tid); } SEAM(7);
    if (IN(8)) _Pragma("unroll 1") for (int rep_ = 0; rep_ <= ((REPMASK >> 8) & 1); ++rep_) { PHASE_ARGS; pg8::Gemm g{(const pb*)(ws + WS_XN), (const pb*)(ws + WS_WOT), M, 1024, 1024}; pg8::StaticOrder S; S.init(M, 1024, F.G, (int)blockIdx.x);
        pg8::EpiRes E{(const float*)ap->in[0], (const float*)(ws + WS_MOD), (pb*)(ws + WS_X1)}; pg8::gemm_phase<pg8::EpiRes, pg8::StaticOrder, true, true>(F.lds, g, S, E, F.tid); } SEAM(8);
    if (IN(9)) _Pragma("unroll 1") for (int rep_ = 0; rep_ <= ((REPMASK >> 9) & 1); ++rep_) { PHASE_ARGS; pj_phase(F, ap); } SEAM(9);
    if (IN(10)) _Pragma("unroll 1") for (int rep_ = 0; rep_ <= ((REPMASK >> 10) & 1); ++rep_) { PHASE_ARGS; for (int p = F.vcu; p < 256; p += F.G) pk_task(F, ap, p >> 4, p & 15); } SEAM(10);
    if (IN(11)) _Pragma("unroll 1") for (int rep_ = 0; rep_ <= ((REPMASK >> 11) & 1); ++rep_) { PHASE_ARGS; pg8::Gemm g{(const pb*)(ws + WS_XN), (const pb*)((unsigned char*)ap->out + OUT_WGUT), ME, 16 * 2048, 1024}; pg8::GroupOrder<8> S{F.G, (int)blockIdx.x};
        pg8::EpiSwiglu E{(pb*)(ws + WS_H)}; pg8::gemm_phase<pg8::EpiSwiglu, pg8::GroupOrder<8>, true, true, true>(F.lds, g, S, E, F.tid, (const int*)(ws + WS_SELIDX)); } SEAM(11);
    if (IN(12)) _Pragma("unroll 1") for (int rep_ = 0; rep_ <= ((REPMASK >> 12) & 1); ++rep_) { PHASE_ARGS; pg8::Gemm g{(const pb*)(ws + WS_H), (const pb*)((unsigned char*)ap->out + OUT_WDT), ME, 16 * 1024, 1024}; pg8::GroupOrder<4> S{F.G, (int)blockIdx.x};
        pg8::EpiDown E{(pb*)(ws + WS_XE), (const float*)(ws + WS_SELAFF)}; pg8::gemm_phase<pg8::EpiDown, pg8::GroupOrder<4>, true, true>(F.lds, g, S, E, F.tid); } SEAM(12);
#ifndef EXTRA_BARS
#define EXTRA_BARS 0
#endif
#if ONE_LAUNCH
    _Pragma("unroll 1") for (int xb_ = 0; xb_ < EXTRA_BARS; ++xb_) { MKBAR; { unsigned o_ = ~0u; asm volatile("" : "+s"(o_)); xcd_barrier(bar, wave_s == 0 && __builtin_amdgcn_mbcnt_hi(o_, __builtin_amdgcn_mbcnt_lo(o_, 0u)) == 0u); } }
#endif
#ifndef REP_PN
#define REP_PN 0
#endif
    if (IN(13)) { PHASE_ARGS; if (REP_PN) pn_rows(F, ap, (float*)(ws + WS_H)); pn_rows(F, ap, ap->out); }
#undef IN
#undef SEAM
}

extern "C" void kernel_launch(void* const* d_in, const int* in_sizes, int n_in, void* d_out, int out_size, void* d_ws, size_t ws_size, hipStream_t stream) {
    static int grid = 0;
    if (grid == 0) {
        if (n_in != 30 || out_size != M * D || ws_size < WS_END) { fprintf(stderr, "kernel_launch: unexpected shapes n_in %d out %d ws %zu\n", n_in, out_size, ws_size); grid = -1; return; }
        int dev = 0, cus = 0, per_cu = 0;
        if (hipGetDevice(&dev) != hipSuccess || hipDeviceGetAttribute(&cus, hipDeviceAttributeMultiprocessorCount, dev) != hipSuccess) { grid = -1; return; }
        if (hipFuncSetAttribute((const void*)fwd_kernel, hipFuncAttributeMaxDynamicSharedMemorySize, LDS_BYTES) != hipSuccess) { fprintf(stderr, "kernel_launch: hipFuncSetAttribute failed\n"); grid = -1; return; }
        if (hipOccupancyMaxActiveBlocksPerMultiprocessor(&per_cu, (const void*)fwd_kernel, NWAVES * 64, LDS_BYTES) != hipSuccess || per_cu < 1) fprintf(stderr, "kernel_launch: occupancy query reports %d\n", per_cu);
        (void)hipGetLastError();
        grid = cus;
    }
    if (grid < 0) return;
    if (hipMemsetAsync((char*)d_ws + WS_CTL, 0, CTL_ZERO_BYTES, stream) != hipSuccess) return;
    Args a{};
    for (int i = 0; i < 30; ++i) a.in[i] = d_in[i];
    a.out = (float*)d_out; a.ws = (unsigned char*)d_ws;
#if ONE_LAUNCH
    a.ph_lo = 0; a.ph_hi = NPHASE;
    hipLaunchKernelGGL(fwd_kernel, dim3(grid), dim3(NWAVES * 64), LDS_BYTES, stream, a);
#else
    for (int p = 0; p < NPHASE; ++p) { a.ph_lo = p; a.ph_hi = p + 1; hipLaunchKernelGGL(fwd_kernel, dim3(grid), dim3(NWAVES * 64), LDS_BYTES, stream, a); }
#endif
}
```

```cpp
#include <hip/hip_runtime.h>
#include <cstdio>
#include <cstdint>
#include <cmath>
namespace pg8 {
#define PG8_LAS __attribute__((address_space(3)))
typedef unsigned short bf16_t;
typedef short bf16x8 __attribute__((ext_vector_type(8)));
typedef float f32x4 __attribute__((ext_vector_type(4)));
typedef unsigned u32x4 __attribute__((ext_vector_type(4)));
constexpr int BM = 256, BK = 64, HALF = 128, HTB = HALF * BK * 2  , STAGE_BYTES = 8 * HTB, NXCD = 8, WGM = 8;

__host__ __device__ __forceinline__ int lds_byte(int r, int c) { const int st = (r >> 4) * 2 + (c >> 5), rr = r & 15, cc = c & 31, ob = rr * 64 + cc * 2; return st * 1024 + (ob ^ (((ob >> 9) & 1) << 5)); }
__host__ __device__ __forceinline__ void stage_rc(int b, int& R, int& C) { const int st = b / 1024, sb = b % 1024, swz = sb ^ (((sb >> 9) & 1) << 5); R = (st >> 1) * 16 + swz / 64; C = (st & 1) * 32 + (swz % 64) / 2; }
__host__ __device__ __forceinline__ int perm32(int rho) { const int n = rho >> 4, i = rho & 15; return 8 * (i >> 2) + 4 * n + (i & 3); }

struct Unit { int pm, pn; };
struct Gemm { const bf16_t* A; const bf16_t* Bt; int M, N, K; };

struct StaticOrder {
    int nM, nN, nwg, G, c;
    __host__ __device__ void init(int M, int N, int G_, int c_) { nM = M / BM; nN = N / BM; nwg = nM * nN; G = G_; c = c_; }
    __host__ __device__ bool next(int i, Unit& u) const {
        const long L = (long)i * G + c; if (L >= nwg) return false;
        int wgid = (int)L; { const int q = nwg / NXCD, r = nwg % NXCD, xcd = wgid % NXCD, off = wgid / NXCD; wgid = (xcd < r ? xcd * (q + 1) : r * (q + 1) + (xcd - r) * q) + off; }
        const int nig = WGM * nN, gid = wgid / nig, fm = gid * WGM, gsz = (nM - fm) < WGM ? (nM - fm) : WGM;
        u.pm = fm + ((wgid % nig) % gsz); u.pn = (wgid % nig) / gsz; return true;
    }
    __device__ __forceinline__ void a_ready(const Unit&) const {}
    __device__ __forceinline__ void done(const Unit&) const {}
};

__device__ __forceinline__ unsigned cvt_pk_bf16(float lo, float hi) { unsigned r; asm volatile("v_cvt_pk_bf16_f32 %0, %1, %2" : "=v"(r) : "v"(lo), "v"(hi)); return r; }
typedef float f32x2 __attribute__((ext_vector_type(2)));
template <class Epi, class Sched, bool ALIGN_EPI = false, bool SP2 = false, bool GATHER = false>
__device__ __forceinline__ void gemm_phase(PG8_LAS unsigned char* lds, const Gemm g, const Sched& S, const Epi& E, int tid_in, const int* gidx = nullptr) {
    static_assert(!GATHER || SP2, "the gather variant is written for the SP2 loop");
    int tid_ = tid_in; asm volatile("" : "+v"(tid_));
    const int tid = tid_, wid = __builtin_amdgcn_readfirstlane(tid >> 6), lane = tid & 63, wr = wid >> 2, wc = wid & 3, fr = lane & 15, fq = lane >> 4;
    const int K = g.K, nt = K / BK;
    unsigned voffA[2], voffB[2];
#pragma unroll
    for (int i = 0; i < 2; ++i) { int R, C; stage_rc(tid * 16 + i * 8192, R, C); const int Rb = Epi::PERM ? ((R & ~31) + perm32(R & 31)) : R;
        voffA[i] = (unsigned)(R * K + C) * 2u; voffB[i] = (unsigned)(Rb * K + C) * 2u; }
    int gRA[2] = {0, 0}; unsigned gCA[2] = {0u, 0u}; unsigned gc[2][2] = {{0u, 0u}, {0u, 0u}}, gn[2][2] = {{0u, 0u}, {0u, 0u}};
    if constexpr (GATHER) {
#pragma unroll
        for (int i = 0; i < 2; ++i) { int R, C; stage_rc(tid * 16 + i * 8192, R, C); gRA[i] = R; gCA[i] = (unsigned)C * 2u; } }
#define PG8_GLOAD(dst, un) do { _Pragma("unroll") for (int h_ = 0; h_ < 2; ++h_) _Pragma("unroll") for (int i_ = 0; i_ < 2; ++i_) \
        dst[h_][i_] = (unsigned)gidx[(un).pm * 256 + h_ * 128 + gRA[i_]] * (unsigned)(K * 2) + gCA[i_]; } while (0)
#define PG8_STAGE_G(bufoff, gbase, nx, h) do { unsigned vo_[2] = {(nx) ? gn[h][0] : gc[h][0], (nx) ? gn[h][1] : gc[h][1]}; PG8_STAGE(bufoff, gbase, vo_); } while (0)
    const size_t kstep = (size_t)(BK * 2);
    const size_t hstep = (size_t)HALF * K * 2;
    const size_t tstep = 2 * hstep;
    const unsigned ldsw = (unsigned)wid * 1024u;
    const int aoff = lds_byte(wr * 64 + fr, fq * 8), boff = lds_byte(wc * 32 + fr, fq * 8);
#define PG8_SA(b, h) (((b) * 2 + (h)) * HTB)
#define PG8_SB(b, h) ((4 + (b) * 2 + (h)) * HTB)
#define PG8_STAGE(bufoff, gbase, voff) do { _Pragma("unroll") for (int _i = 0; _i < 2; ++_i) \
        __builtin_amdgcn_global_load_lds((const unsigned*)((const char*)(gbase) + (voff)[_i]), (PG8_LAS unsigned*)(lds + (bufoff) + ldsw + _i * 8192), 16, 0, 0); } while (0)
#define PG8_LDA(dst, b, h) do { _Pragma("unroll") for (int m = 0; m < 4; ++m) _Pragma("unroll") for (int k = 0; k < 2; ++k) dst[m][k] = *(const PG8_LAS bf16x8*)(lds + PG8_SA(b, h) + aoff + m * 2048 + k * 1024); } while (0)
#define PG8_LDB(dst, b, h) do { _Pragma("unroll") for (int n = 0; n < 2; ++n) _Pragma("unroll") for (int k = 0; k < 2; ++k) dst[n][k] = *(const PG8_LAS bf16x8*)(lds + PG8_SB(b, h) + boff + n * 2048 + k * 1024); } while (0)
#define PG8_MMA(ai, bj, At, Bt) do { __builtin_amdgcn_s_setprio(1); _Pragma("unroll") for (int m = 0; m < 4; ++m) _Pragma("unroll") for (int n = 0; n < 2; ++n) _Pragma("unroll") for (int k = 0; k < 2; ++k) \
        acc[ai][bj][m][n] = __builtin_amdgcn_mfma_f32_16x16x32_bf16(Bt[n][k], At[m][k], acc[ai][bj][m][n], 0, 0, 0); __builtin_amdgcn_s_setprio(0); } while (0)
#define PG8_WAIT_V(n) asm volatile("s_waitcnt vmcnt(" #n ")" ::: "memory")
#define PG8_WAIT_L(n) asm volatile("s_waitcnt lgkmcnt(" #n ")" ::: "memory")
#define PG8_BAR __builtin_amdgcn_s_barrier()
#define PG8_SCHED __builtin_amdgcn_sched_barrier(0)
    Unit cur, nxt; int ui = 0;
    if (!S.next(0, cur)) return;
    f32x4 acc[2][2][4][2];
#pragma unroll
    for (int a = 0; a < 2; ++a)
#pragma unroll
        for (int b = 0; b < 2; ++b)
#pragma unroll
            for (int m = 0; m < 4; ++m)
#pragma unroll
                for (int n = 0; n < 2; ++n) acc[a][b][m][n] = (f32x4){0.f, 0.f, 0.f, 0.f};
    bf16x8 At[4][2], B0[2][2], B1[2][2];
    const char* cA = GATHER ? (const char*)g.A : (const char*)g.A + (size_t)cur.pm * tstep; const char* cB = (const char*)g.Bt + (size_t)cur.pn * tstep;
    if constexpr (GATHER) { PG8_GLOAD(gc, cur); Unit n1_; if (S.next(1, n1_)) PG8_GLOAD(gn, n1_); else { gn[0][0] = gc[0][0]; gn[0][1] = gc[0][1]; gn[1][0] = gc[1][0]; gn[1][1] = gc[1][1]; } }
    S.a_ready(cur);
    if constexpr (SP2) {
        PG8_STAGE(PG8_SB(0, 0), cB, voffB); PG8_STAGE(PG8_SB(0, 1), cB + hstep, voffB);
        if constexpr (GATHER) { PG8_STAGE_G(PG8_SA(0, 0), cA, false, 0); PG8_STAGE_G(PG8_SA(0, 1), cA, false, 1); } else { PG8_STAGE(PG8_SA(0, 0), cA, voffA); PG8_STAGE(PG8_SA(0, 1), cA + hstep, voffA); }
        if (wr == 1) PG8_BAR;
        PG8_WAIT_V(2); PG8_BAR;
        PG8_STAGE(PG8_SB(1, 0), cB + kstep, voffB); if constexpr (GATHER) PG8_STAGE_G(PG8_SA(1, 0), cA + kstep, false, 0); else PG8_STAGE(PG8_SA(1, 0), cA + kstep, voffA); PG8_STAGE(PG8_SB(1, 1), cB + hstep + kstep, voffB);
        PG8_WAIT_V(6); PG8_BAR;
    } else {
        PG8_STAGE(PG8_SB(0, 0), cB, voffB); PG8_STAGE(PG8_SA(0, 0), cA, voffA); PG8_STAGE(PG8_SB(0, 1), cB + hstep, voffB); PG8_STAGE(PG8_SA(0, 1), cA + hstep, voffA);
        if (wr == 1) PG8_BAR;
        PG8_WAIT_V(4); PG8_BAR;
        PG8_STAGE(PG8_SB(1, 0), cB + kstep, voffB); PG8_STAGE(PG8_SA(1, 0), cA + kstep, voffA); PG8_STAGE(PG8_SB(1, 1), cB + hstep + kstep, voffB);
        PG8_WAIT_V(6); PG8_BAR;
    }
    for (;;) {
        const bool has_next = S.next(ui + 1, nxt);
        if constexpr (GATHER) { if (!has_next) { gn[0][0] = gc[0][0]; gn[0][1] = gc[0][1]; gn[1][0] = gc[1][0]; gn[1][1] = gc[1][1]; } }
        const char* nA = (has_next && !GATHER) ? (const char*)g.A + (size_t)nxt.pm * tstep : cA; const char* nB = has_next ? (const char*)g.Bt + (size_t)nxt.pn * tstep : cB;
        for (int t = 0; t < nt; t += 2) {
            const bool last = (t == nt - 2);
            const char* a1 = cA + (size_t)(t + 1) * kstep;
            const char* a2 = last ? nA : cA + (size_t)(t + 2) * kstep; const char* b2 = last ? nB : cB + (size_t)(t + 2) * kstep;
            const char* a3 = a2 + kstep; const char* b3 = b2 + kstep;
            if (last && has_next) S.a_ready(nxt);
            if constexpr (SP2) {
            PG8_LDB(B0, 0, 0); PG8_LDB(B1, 0, 1); PG8_SCHED; PG8_LDA(At, 0, 0); if constexpr (GATHER) PG8_STAGE_G(PG8_SA(1, 1), a1, false, 1); else PG8_STAGE(PG8_SA(1, 1), a1 + hstep, voffA);
            PG8_WAIT_V(8); PG8_WAIT_L(0); PG8_BAR; PG8_MMA(0, 0, At, B0); PG8_MMA(0, 1, At, B1); PG8_BAR; PG8_SCHED;
            PG8_LDA(At, 0, 1); PG8_STAGE(PG8_SB(0, 0), b2, voffB); PG8_STAGE(PG8_SB(0, 1), b2 + hstep, voffB); if constexpr (GATHER) PG8_STAGE_G(PG8_SA(0, 0), a2, last, 0); else PG8_STAGE(PG8_SA(0, 0), a2, voffA);
            PG8_WAIT_V(8); PG8_WAIT_L(0); PG8_BAR; PG8_MMA(1, 0, At, B0); PG8_MMA(1, 1, At, B1); PG8_BAR; PG8_SCHED;
            PG8_LDB(B0, 1, 0); PG8_LDB(B1, 1, 1); PG8_SCHED; PG8_LDA(At, 1, 0); if constexpr (GATHER) PG8_STAGE_G(PG8_SA(0, 1), a2, last, 1); else PG8_STAGE(PG8_SA(0, 1), a2 + hstep, voffA);
            PG8_WAIT_V(8); PG8_WAIT_L(0); PG8_BAR; PG8_MMA(0, 0, At, B0); PG8_MMA(0, 1, At, B1); PG8_BAR; PG8_SCHED;
            PG8_LDA(At, 1, 1); PG8_STAGE(PG8_SB(1, 0), b3, voffB); PG8_STAGE(PG8_SB(1, 1), b3 + hstep, voffB); if constexpr (GATHER) PG8_STAGE_G(PG8_SA(1, 0), a3, last, 0); else PG8_STAGE(PG8_SA(1, 0), a3, voffA);
            PG8_WAIT_V(8); PG8_WAIT_L(0); PG8_BAR; PG8_MMA(1, 0, At, B0); PG8_MMA(1, 1, At, B1); PG8_BAR; PG8_SCHED;
            } else {
            PG8_LDB(B0, 0, 0); PG8_SCHED; PG8_LDA(At, 0, 0); PG8_STAGE(PG8_SA(1, 1), a1 + hstep, voffA);
            PG8_WAIT_L(8); PG8_BAR; PG8_WAIT_L(0); PG8_MMA(0, 0, At, B0); PG8_BAR; PG8_SCHED;
            PG8_LDB(B1, 0, 1); PG8_STAGE(PG8_SB(0, 0), b2, voffB);
            PG8_BAR; PG8_WAIT_L(0); PG8_MMA(0, 1, At, B1); PG8_BAR;
            PG8_LDA(At, 0, 1); PG8_STAGE(PG8_SA(0, 0), a2, voffA);
            PG8_BAR; PG8_WAIT_L(0); PG8_MMA(1, 0, At, B0); PG8_BAR; PG8_SCHED;
            PG8_STAGE(PG8_SB(0, 1), b2 + hstep, voffB);
            PG8_WAIT_V(6); PG8_BAR; PG8_MMA(1, 1, At, B1); PG8_BAR;
            PG8_LDB(B0, 1, 0); PG8_SCHED; PG8_LDA(At, 1, 0); PG8_STAGE(PG8_SA(0, 1), a2 + hstep, voffA);
            PG8_WAIT_L(8); PG8_BAR; PG8_WAIT_L(0); PG8_MMA(0, 0, At, B0); PG8_BAR; PG8_SCHED;
            PG8_LDB(B1, 1, 1); PG8_STAGE(PG8_SB(1, 0), b3, voffB);
            PG8_BAR; PG8_WAIT_L(0); PG8_MMA(0, 1, At, B1); PG8_BAR;
            PG8_LDA(At, 1, 1); PG8_STAGE(PG8_SA(1, 0), a3, voffA);
            PG8_BAR; PG8_WAIT_L(0); PG8_MMA(1, 0, At, B0); PG8_BAR; PG8_SCHED;
            PG8_STAGE(PG8_SB(1, 1), b3 + hstep, voffB);
            PG8_WAIT_V(6); PG8_BAR; PG8_MMA(1, 1, At, B1); PG8_BAR;
            }
        }
        if constexpr (ALIGN_EPI) { if (wr == 0) PG8_BAR; }
        if constexpr (!Epi::AFTER_DRAIN) { E(acc, cur, wr, wc, fr, fq); S.done(cur); }
        unsigned g2_[2][2] = {{0u, 0u}, {0u, 0u}};
        if constexpr (GATHER) { Unit nn_; if (has_next && S.next(ui + 2, nn_)) PG8_GLOAD(g2_, nn_); else { g2_[0][0] = gn[0][0]; g2_[0][1] = gn[0][1]; g2_[1][0] = gn[1][0]; g2_[1][1] = gn[1][1]; } }
        if (!has_next) break;
#pragma unroll
        for (int a = 0; a < 2; ++a)
#pragma unroll
            for (int b = 0; b < 2; ++b)
#pragma unroll
                for (int m = 0; m < 4; ++m)
#pragma unroll
                    for (int n = 0; n < 2; ++n) acc[a][b][m][n] = (f32x4){0.f, 0.f, 0.f, 0.f};
        cur = nxt; cA = nA; cB = nB; ++ui;
        if constexpr (GATHER) { gc[0][0] = gn[0][0]; gc[0][1] = gn[0][1]; gc[1][0] = gn[1][0]; gc[1][1] = gn[1][1]; gn[0][0] = g2_[0][0]; gn[0][1] = g2_[0][1]; gn[1][0] = g2_[1][0]; gn[1][1] = g2_[1][1]; }
        if constexpr (ALIGN_EPI) { if (wr == 1) PG8_BAR; }
    }
    PG8_WAIT_V(0);
    if constexpr (!ALIGN_EPI) { if (wr == 0) PG8_BAR; }
    PG8_BAR;
    if constexpr (Epi::AFTER_DRAIN) { E.fused(acc, cur, wr, wc, fr, fq, lds, wid, lane); S.done(cur); }
#undef PG8_SA
#undef PG8_SB
#undef PG8_STAGE
#undef PG8_STAGE_G
#undef PG8_GLOAD
#undef PG8_LDA
#undef PG8_LDB
#undef PG8_MMA
#undef PG8_WAIT_V
#undef PG8_WAIT_L
#undef PG8_BAR
#undef PG8_SCHED
}
}

#ifndef ONE_LAUNCH
#define ONE_LAUNCH 1
#endif
constexpr int NB = 16, T = 2048, D = 1024, M = NB * T;
constexpr int NZ = 4736, NZP = 4864;
constexpr int RW = 512, NE = 16, CAP = 256, ME = NE * NB * CAP;
constexpr int ZR = 0, ZK = 512, ZV = 1024, ZWD = 1536, ZAD = 1664, ZGD = 1792, ZQ = 1920, ZKA = 2432, ZVA = 2560, ZGA = 2688, ZGB = 3712;
constexpr int NWAVES = 8, NPHASE = 14;
constexpr size_t MiB = 1u << 20;
constexpr size_t WS_CTL = 0, CTL_ZERO_BYTES = 64 * 1024 + 16 * 6144 * 4;
constexpr size_t WS_MOD = 64 * 1024, WS_BONUS = 2 * MiB, WS_AFF = 4 * MiB, WS_SELAFF = 6 * MiB, WS_SLOT = 7 * MiB, WS_G2T = 9 * MiB;
constexpr size_t WS_WINT = 10 * MiB, WS_PRT = 20 * MiB, WS_PAT = 21 * MiB, WS_WOT = 22 * MiB, WS_SGD = 24 * MiB;
constexpr size_t WS_XN = 40 * MiB;
constexpr size_t WS_OATT = 104 * MiB;
constexpr size_t WS_G = 136 * MiB;
constexpr size_t WS_Z = 168 * MiB;
constexpr size_t WS_X1 = 104 * MiB;
constexpr size_t OUT_WGUT = 0;
constexpr size_t OUT_WDT = 64 * MiB;
constexpr size_t WS_XE = 200 * MiB;
constexpr size_t WS_H = 328 * MiB;
constexpr size_t WS_END = 464 * MiB;
constexpr size_t WS_ROPE = WS_AFF;
constexpr size_t WS_SELIDX = WS_SELAFF + 512 * 1024;
constexpr int CW_BAR = 4096;
constexpr int RING_BYTES = 131072, LDSCTL_OFF = RING_BYTES, MISC_OFF = LDSCTL_OFF + 320, LDS_BYTES = 147456;

#define GAS __attribute__((address_space(1)))
#define LAS __attribute__((address_space(3)))
typedef unsigned short bf16;
typedef unsigned v4u __attribute__((ext_vector_type(4)));
typedef float f32x4 __attribute__((ext_vector_type(4)));
typedef short bf16x8 __attribute__((ext_vector_type(8)));
typedef GAS unsigned gu32;
typedef GAS unsigned long long gu64;
#define RLX_AGENT __ATOMIC_RELAXED, __HIP_MEMORY_SCOPE_AGENT
#define LDS_WAIT() asm volatile("s_waitcnt lgkmcnt(0)" ::: "memory")
#define VM_WAIT() asm volatile("s_waitcnt vmcnt(0)" ::: "memory")
__device__ __forceinline__ unsigned long long rt() { return __builtin_amdgcn_s_memrealtime(); }
__device__ __forceinline__ unsigned f2bf(float f) { unsigned u = __builtin_bit_cast(unsigned, f); return (u + 0x7fffu + ((u >> 16) & 1u)) >> 16; }
typedef float f32x2hw __attribute__((ext_vector_type(2))); typedef __bf16 bf16x2hw __attribute__((ext_vector_type(2)));
__device__ __forceinline__ unsigned pk2(float lo, float hi) { f32x2hw v = {lo, hi}; bf16x2hw b = __builtin_convertvector(v, bf16x2hw); return __builtin_bit_cast(unsigned, b); }

#define XB_TMO      128
#define XB_XCNT(j)  (256  + 64 * (j))
#define XB_XSUB(j)  (1280 + 64 * (j))
#define XB_XGEN(j)  (2304 + 64 * (j))
#define XB_TOP      3328
#define XB_TOPGEN   3392
#define XCD_BAR_WORDS 3456
#define XB_SPIN_CAP (1u << 18)

__device__ __forceinline__ unsigned xb_ld(unsigned* p)              { return __hip_atomic_load(p, __ATOMIC_RELAXED, __HIP_MEMORY_SCOPE_AGENT); }
__device__ __forceinline__ unsigned xb_add(unsigned* p, unsigned v) { return __hip_atomic_fetch_add(p, v, __ATOMIC_RELAXED, __HIP_MEMORY_SCOPE_AGENT); }
__device__ __forceinline__ unsigned xb_xcc_id() { return (unsigned)__builtin_amdgcn_s_getreg((3 << 11) | 20) & 0xFu; }
#define XB_SPIN(cond, bar) do { unsigned _sp = 0; while (cond) { __builtin_amdgcn_s_sleep(1); \
    if ((++_sp & 255u) == 0u) { if (xb_ld(&(bar)[XB_TMO])) break; if (_sp > XB_SPIN_CAP) { atomicAdd(&(bar)[XB_TMO], 1u); break; } } } } while (0)

struct XcdBarrier {
    unsigned* bar; unsigned x;
    volatile LAS unsigned* st;
};

__device__ __forceinline__ XcdBarrier xcd_barrier_post(unsigned* bar, volatile LAS unsigned* st) {
    XcdBarrier b; b.bar = bar; b.x = xb_xcc_id(); b.st = st;
    if (threadIdx.x == 0) (void)xb_add(&bar[XB_XCNT(b.x)], 1u);
    return b;
}
__device__ __forceinline__ void xcd_barrier_complete(unsigned* bar, unsigned x, unsigned& nloc, unsigned& nx) {
    const unsigned G = gridDim.x * gridDim.y * gridDim.z;
    unsigned sum, cnt, mine, sp = 0u;
    for (;;) {
        sum = 0u; cnt = 0u; mine = 0u;
#pragma unroll
        for (unsigned j = 0; j < 16; ++j) { const unsigned c = xb_ld(&bar[XB_XCNT(j)]); sum += c; cnt += (c > 0u) ? 1u : 0u; mine = (j == x) ? c : mine; }
        if (sum == G) break;
        __builtin_amdgcn_s_sleep(1);
        if ((++sp & 255u) == 0u) { if (xb_ld(&bar[XB_TMO])) break; if (sp > XB_SPIN_CAP) { atomicAdd(&bar[XB_TMO], 1u); break; } }
    }
    nloc = mine > 0u ? mine : 1u; nx = cnt > 0u ? cnt : 1u;
}

__device__ __forceinline__ void xcd_barrier(const XcdBarrier& b, bool is_thread0) {
    asm volatile("s_waitcnt vmcnt(0)" ::: "memory");
    __syncthreads();
    if (is_thread0) {
        unsigned* bar = b.bar;
        __builtin_amdgcn_s_waitcnt(0);
        unsigned nloc = b.st[0], nx = b.st[1];
        if (nloc == 0u) { xcd_barrier_complete(bar, b.x, nloc, nx); b.st[0] = nloc; b.st[1] = nx; }
        const unsigned old = xb_add(&bar[XB_XSUB(b.x)], 1u);
        const unsigned gen = old / nloc;
        if (old + 1u == (gen + 1u) * nloc) {
            __builtin_amdgcn_fence(__ATOMIC_RELEASE, "agent");
            asm volatile("s_waitcnt vmcnt(0)" ::: "memory");
            const unsigned og = xb_add(&bar[XB_TOP], 1u);
            const unsigned tg = og / nx;
            if (og + 1u == (tg + 1u) * nx) xb_add(&bar[XB_TOPGEN], 1u);
            else XB_SPIN(xb_ld(&bar[XB_TOPGEN]) == tg, bar);
            __builtin_amdgcn_fence(__ATOMIC_ACQUIRE, "agent");
            xb_add(&bar[XB_XGEN(b.x)], 1u);
            asm volatile("s_waitcnt vmcnt(0)" ::: "memory");
        } else {
            XB_SPIN(xb_ld(&bar[XB_XGEN(b.x)]) == gen, bar);
            __builtin_amdgcn_fence(__ATOMIC_ACQUIRE, "agent");
            asm volatile("s_waitcnt vmcnt(0)" ::: "memory");
        }
    }
    __syncthreads();
}
namespace pg8 {
__device__ __forceinline__ float bf2f(unsigned short h) { return __uint_as_float(((unsigned)h) << 16); }
__device__ __forceinline__ float bflo(unsigned w) { return __uint_as_float(w << 16); }
__device__ __forceinline__ float bfhi(unsigned w) { return __uint_as_float(w & 0xffff0000u); }
__device__ __forceinline__ float sigm(float x) { return 1.0f / (1.0f + __expf(-x)); }
struct EpiZ { static constexpr bool PERM = true, AFTER_DRAIN = false; bf16_t* O;
    __device__ __forceinline__ void operator()(const f32x4 (&acc)[2][2][4][2], const Unit& u, int wr, int wc, int fr, int fq) const {
        const int row0 = u.pm * BM + wr * 64 + fr, col0 = u.pn * BM + wc * 32 + 8 * fq;
#pragma unroll
        for (int ai = 0; ai < 2; ++ai)
#pragma unroll
            for (int m = 0; m < 4; ++m) { bf16_t* rowp = O + (size_t)(row0 + ai * HALF + m * 16) * 4736 + col0;
#pragma unroll
                for (int bj = 0; bj < 2; ++bj) { if (u.pn * BM + bj * HALF < 4736) { const f32x4 v0 = acc[ai][bj][m][0], v1 = acc[ai][bj][m][1];
                    u32x4 w; w.x = cvt_pk_bf16(v0[0], v0[1]); w.y = cvt_pk_bf16(v0[2], v0[3]); w.z = cvt_pk_bf16(v1[0], v1[1]); w.w = cvt_pk_bf16(v1[2], v1[3]);
                    *(u32x4*)(rowp + bj * HALF) = w; } } }
    }
};
struct EpiPlain { static constexpr bool PERM = true, AFTER_DRAIN = false; bf16_t* O; int ldc;
    __device__ __forceinline__ void operator()(const f32x4 (&acc)[2][2][4][2], const Unit& u, int wr, int wc, int fr, int fq) const {
        const int row0 = u.pm * BM + wr * 64 + fr, col0 = u.pn * BM + wc * 32 + 8 * fq;
#pragma unroll
        for (int ai = 0; ai < 2; ++ai)
#pragma unroll
            for (int m = 0; m < 4; ++m) { bf16_t* rowp = O + (size_t)(row0 + ai * HALF + m * 16) * ldc + col0;
#pragma unroll
                for (int bj = 0; bj < 2; ++bj) { const f32x4 v0 = acc[ai][bj][m][0], v1 = acc[ai][bj][m][1];
                    u32x4 w; w.x = cvt_pk_bf16(v0[0], v0[1]); w.y = cvt_pk_bf16(v0[2], v0[3]); w.z = cvt_pk_bf16(v1[0], v1[1]); w.w = cvt_pk_bf16(v1[2], v1[3]);
                    *(u32x4*)(rowp + bj * HALF) = w; } }
    }
};
template <bool ADD> struct EpiGate { static constexpr bool PERM = true, AFTER_DRAIN = false; bf16_t* O; const bf16_t* Z; int zc0;
    __device__ __forceinline__ void operator()(const f32x4 (&acc)[2][2][4][2], const Unit& u, int wr, int wc, int fr, int fq) const {
        const int row0 = u.pm * BM + wr * 64 + fr, col0 = u.pn * BM + wc * 32 + 8 * fq;
#pragma unroll
        for (int ai = 0; ai < 2; ++ai)
#pragma unroll
            for (int m = 0; m < 4; ++m) { const size_t row = (size_t)(row0 + ai * HALF + m * 16); bf16_t* rowp = O + row * 1024 + col0; const bf16_t* zp = Z + row * 4736 + zc0 + col0;
#pragma unroll
                for (int bj = 0; bj < 2; ++bj) { const f32x4 v0 = acc[ai][bj][m][0], v1 = acc[ai][bj][m][1];
                    const u32x4 zg = *(const u32x4*)(zp + bj * HALF);
                    float r0 = sigm(bflo(zg.x)) * v0[0], r1 = sigm(bfhi(zg.x)) * v0[1], r2 = sigm(bflo(zg.y)) * v0[2], r3 = sigm(bfhi(zg.y)) * v0[3];
                    float r4 = sigm(bflo(zg.z)) * v1[0], r5 = sigm(bfhi(zg.z)) * v1[1], r6 = sigm(bflo(zg.w)) * v1[2], r7 = sigm(bfhi(zg.w)) * v1[3];
                    if (ADD) { const u32x4 p = *(const u32x4*)(rowp + bj * HALF);
                        r0 += bflo(p.x); r1 += bfhi(p.x); r2 += bflo(p.y); r3 += bfhi(p.y); r4 += bflo(p.z); r5 += bfhi(p.z); r6 += bflo(p.w); r7 += bfhi(p.w); }
                    u32x4 w; w.x = cvt_pk_bf16(r0, r1); w.y = cvt_pk_bf16(r2, r3); w.z = cvt_pk_bf16(r4, r5); w.w = cvt_pk_bf16(r6, r7);
                    *(u32x4*)(rowp + bj * HALF) = w; } }
    }
};
struct EpiGate2 { static constexpr bool PERM = true, AFTER_DRAIN = false; bf16_t* O; const bf16_t* Z;
    __device__ __forceinline__ void operator()(const f32x4 (&acc)[2][2][4][2], const Unit& u, int wr, int wc, int fr, int fq) const {
        const bool add = u.pm < 128; const int zc0 = add ? 3712 : 2688;
        const int row0 = (u.pm & 127) * BM + wr * 64 + fr, col0 = (u.pn & 3) * BM + wc * 32 + 8 * fq;
#pragma unroll
        for (int ai = 0; ai < 2; ++ai) {
            u32x4 zg[4][2], pv[4][2];
#pragma unroll
            for (int m = 0; m < 4; ++m) { const size_t row = (size_t)(row0 + ai * HALF + m * 16);
#pragma unroll
                for (int bj = 0; bj < 2; ++bj) { zg[m][bj] = *(const u32x4*)(Z + row * 4736 + zc0 + col0 + bj * HALF); pv[m][bj] = (u32x4){0u, 0u, 0u, 0u}; if (add) pv[m][bj] = *(const u32x4*)(O + row * 1024 + col0 + bj * HALF); } }
#pragma unroll
            for (int m = 0; m < 4; ++m) { const size_t row = (size_t)(row0 + ai * HALF + m * 16); bf16_t* rowp = O + row * 1024 + col0;
#pragma unroll
                for (int bj = 0; bj < 2; ++bj) { const f32x4 v0 = acc[ai][bj][m][0], v1 = acc[ai][bj][m][1]; const u32x4 g = zg[m][bj], p = pv[m][bj];
                    const float r0 = sigm(bflo(g.x)) * v0[0] + bflo(p.x), r1 = sigm(bfhi(g.x)) * v0[1] + bfhi(p.x), r2 = sigm(bflo(g.y)) * v0[2] + bflo(p.y), r3 = sigm(bfhi(g.y)) * v0[3] + bfhi(p.y);
                    const float r4 = sigm(bflo(g.z)) * v1[0] + bflo(p.z), r5 = sigm(bfhi(g.z)) * v1[1] + bfhi(p.z), r6 = sigm(bflo(g.w)) * v1[2] + bflo(p.w), r7 = sigm(bfhi(g.w)) * v1[3] + bfhi(p.w);
                    u32x4 w; w.x = cvt_pk_bf16(r0, r1); w.y = cvt_pk_bf16(r2, r3); w.z = cvt_pk_bf16(r4, r5); w.w = cvt_pk_bf16(r6, r7);
                    *(u32x4*)(rowp + bj * HALF) = w; } } }
    }
};
struct MergeOrder { StaticOrder S; int nu;
    __device__ __forceinline__ void init(int G, int c) { S.init(32768, 1024, G, c); nu = (512 - c + G - 1) / G; }
    __device__ __forceinline__ bool next(int i, Unit& u) const { if (i >= 2 * nu) return false; Unit t; S.next(i < nu ? i : i - nu, t);
        if (i < nu) { u.pm = 128 + t.pm; u.pn = t.pn; } else { u.pm = t.pm; u.pn = 4 + t.pn; } return true; }
    __device__ __forceinline__ void a_ready(const Unit&) const {}
    __device__ __forceinline__ void done(const Unit&) const {}
};
struct EpiRes { static constexpr bool PERM = true, AFTER_DRAIN = false; const float* X; const float* mod; bf16_t* O;
    __device__ __forceinline__ void operator()(const f32x4 (&acc)[2][2][4][2], const Unit& u, int wr, int wc, int fr, int fq) const {
        const int row0 = u.pm * BM + wr * 64 + fr, col0 = u.pn * BM + wc * 32 + 8 * fq; const int b = (u.pm * BM) >> 11;
        f32x4 gt[2][2];
#pragma unroll
        for (int bj = 0; bj < 2; ++bj)
#pragma unroll
            for (int n = 0; n < 2; ++n) gt[bj][n] = *(const f32x4*)(mod + (size_t)b * 6144 + 2048 + col0 + bj * HALF + n * 4);
#pragma unroll
        for (int ai = 0; ai < 2; ++ai) { f32x4 xv[4][2][2];
#pragma unroll
            for (int m = 0; m < 4; ++m) { const size_t off = (size_t)(row0 + ai * HALF + m * 16) * 1024 + col0;
#pragma unroll
                for (int bj = 0; bj < 2; ++bj) { xv[m][bj][0] = *(const f32x4*)(X + off + bj * HALF); xv[m][bj][1] = *(const f32x4*)(X + off + bj * HALF + 4); } }
#pragma unroll
            for (int m = 0; m < 4; ++m) { const size_t off = (size_t)(row0 + ai * HALF + m * 16) * 1024 + col0;
#pragma unroll
                for (int bj = 0; bj < 2; ++bj) { const f32x4 v0 = xv[m][bj][0] + gt[bj][0] * acc[ai][bj][m][0], v1 = xv[m][bj][1] + gt[bj][1] * acc[ai][bj][m][1];
                    u32x4 w; w.x = cvt_pk_bf16(v0[0], v0[1]); w.y = cvt_pk_bf16(v0[2], v0[3]); w.z = cvt_pk_bf16(v1[0], v1[1]); w.w = cvt_pk_bf16(v1[2], v1[3]);
                    *(u32x4*)(O + off + bj * HALF) = w; } } }
    }
};
template <int NPL> struct GroupOrder { int G, c;
    __device__ __forceinline__ bool next(int i, Unit& u) const { const int L = i * G + c; if (L >= 256 * NPL) return false;
        const int e = L / (16 * NPL), r = L % (16 * NPL); u.pm = e * 16 + (r % 16); u.pn = e * NPL + r / 16; return true; }
    __device__ __forceinline__ void a_ready(const Unit&) const {}
    __device__ __forceinline__ void done(const Unit&) const {}
};
struct EpiSwiglu { static constexpr bool PERM = true, AFTER_DRAIN = false; bf16_t* O;
    __device__ __forceinline__ void operator()(const f32x4 (&acc)[2][2][4][2], const Unit& u, int wr, int wc, int fr, int fq) const {
        const int row0 = u.pm * BM + wr * 64 + fr, col0 = (u.pn & 7) * 128 + wc * 32 + 8 * fq;
#pragma unroll
        for (int ai = 0; ai < 2; ++ai)
#pragma unroll
            for (int m = 0; m < 4; ++m) { bf16_t* rowp = O + (size_t)(row0 + ai * HALF + m * 16) * 1024 + col0;
                float r[8];
#pragma unroll
                for (int n = 0; n < 2; ++n)
#pragma unroll
                    for (int i = 0; i < 4; ++i) { const float g = acc[ai][0][m][n][i], up = acc[ai][1][m][n][i]; r[n * 4 + i] = g * sigm(g) * up; }
                u32x4 w; w.x = cvt_pk_bf16(r[0], r[1]); w.y = cvt_pk_bf16(r[2], r[3]); w.z = cvt_pk_bf16(r[4], r[5]); w.w = cvt_pk_bf16(r[6], r[7]);
                *(u32x4*)rowp = w; }
    }
};
struct EpiDown { static constexpr bool PERM = true, AFTER_DRAIN = false; bf16_t* O; const float* aff;
    __device__ __forceinline__ void operator()(const f32x4 (&acc)[2][2][4][2], const Unit& u, int wr, int wc, int fr, int fq) const {
        const int row0 = u.pm * BM + wr * 64 + fr, col0 = (u.pn & 3) * BM + wc * 32 + 8 * fq;
        float av[2][4];
#pragma unroll
        for (int ai = 0; ai < 2; ++ai)
#pragma unroll
            for (int m = 0; m < 4; ++m) av[ai][m] = aff[row0 + ai * HALF + m * 16];
#pragma unroll
        for (int ai = 0; ai < 2; ++ai)
#pragma unroll
            for (int m = 0; m < 4; ++m) { const int row = row0 + ai * HALF + m * 16; const float a = av[ai][m]; bf16_t* rowp = O + (size_t)row * 1024 + col0;
#pragma unroll
                for (int bj = 0; bj < 2; ++bj) { const f32x4 v0 = acc[ai][bj][m][0] * a, v1 = acc[ai][bj][m][1] * a;
                    u32x4 w; w.x = cvt_pk_bf16(v0[0], v0[1]); w.y = cvt_pk_bf16(v0[2], v0[3]); w.z = cvt_pk_bf16(v1[0], v1[1]); w.w = cvt_pk_bf16(v1[2], v1[3]);
                    *(u32x4*)(rowp + bj * HALF) = w; } }
    }
};
}

struct Frame { LAS unsigned char* lds; volatile LAS unsigned* MISC; gu32* ctl; int tid, lane, wave, vcu, G; };
struct Args { const void* in[30]; float* out; unsigned char* ws; int ph_lo, ph_hi; };
typedef const __attribute__((address_space(4))) Args* ArgsP;
#define LAUNDER(p) asm volatile("" : "+s"(p))
typedef float f32x16 __attribute__((ext_vector_type(16)));
typedef unsigned u32x2 __attribute__((ext_vector_type(2)));

__device__ __forceinline__ float wave_sum(float v) {
#pragma unroll
    for (int o = 1; o < 64; o <<= 1) v += __shfl_xor(v, o);
    return v;
}
__device__ __forceinline__ float bf2f(bf16 h) { return __uint_as_float(((unsigned)h) << 16); }
__device__ __forceinline__ float bflo(unsigned w) { return __uint_as_float(w << 16); }
__device__ __forceinline__ float bfhi(unsigned w) { return __uint_as_float(w & 0xffff0000u); }
__device__ __forceinline__ float sigm(float x) { return 1.0f / (1.0f + __expf(-x)); }

__device__ __forceinline__ void tr_item(const float* W, int N, int k0, int n0, bf16* WT, int KD, int dst_row0, LAS float* scr, int lane) {
    f32x4 v[8];
#pragma unroll
    for (int i = 0; i < 8; ++i) v[i] = *(const GAS f32x4*)(W + (size_t)(k0 + 8 * i + (lane >> 3)) * N + n0 + 4 * (lane & 7));
#pragma unroll
    for (int i = 0; i < 8; ++i) { LAS float* d = scr + (8 * i + (lane >> 3)) * 33 + 4 * (lane & 7); d[0] = v[i].x; d[1] = v[i].y; d[2] = v[i].z; d[3] = v[i].w; }
    LDS_WAIT(); asm volatile("" ::: "memory");
    const int c = lane & 7;
#pragma unroll
    for (int j = 0; j < 4; ++j) { const int n = (lane >> 3) + 8 * j; const LAS float* s = scr + (8 * c) * 33 + n;
        v4u o; o.x = pk2(s[0 * 33], s[1 * 33]); o.y = pk2(s[2 * 33], s[3 * 33]); o.z = pk2(s[4 * 33], s[5 * 33]); o.w = pk2(s[6 * 33], s[7 * 33]);
        *(GAS v4u*)(WT + (size_t)(dst_row0 + n) * KD + k0 + 8 * c) = o; }
    LDS_WAIT(); asm volatile("" ::: "memory");
}

__device__ __forceinline__ void p0_prologue(const Frame& F, ArgsP A) {
    unsigned char* ws = A->ws;
    LAS float* scr = (LAS float*)(F.lds + F.wave * 16384);
    const int gw = F.vcu * NWAVES + F.wave, NGW = F.G * NWAVES;
    const float* w_in = (const float*)A->in[6]; const float* p_rwkv = (const float*)A->in[22]; const float* p_attn = (const float*)A->in[23];
    const float* w_out = (const float*)A->in[24]; const float* g2 = (const float*)A->in[13];
    bf16* WinT = (bf16*)(ws + WS_WINT); bf16* PrT = (bf16*)(ws + WS_PRT); bf16* PaT = (bf16*)(ws + WS_PAT); bf16* WoT = (bf16*)(ws + WS_WOT); bf16* G2T = (bf16*)(ws + WS_G2T);
    constexpr int I_IN = 16 * 148, I_P = 8 * 32, I_O = 16 * 32, I_G = 2 * 16, NIT = I_IN + 2 * I_P + I_O + I_G;
    for (int it = gw; it < NIT; it += NGW) {
        int r = it;
        if (r < I_IN) { tr_item(w_in, NZ, 64 * (r / 148), 32 * (r % 148), WinT, 1024, 32 * (r % 148), scr, F.lane); continue; } r -= I_IN;
        if (r < I_P) { tr_item(p_rwkv, 1024, 64 * (r / 32), 32 * (r % 32), PrT, 512, 32 * (r % 32), scr, F.lane); continue; } r -= I_P;
        if (r < I_P) { tr_item(p_attn, 1024, 64 * (r / 32), 32 * (r % 32), PaT, 512, 32 * (r % 32), scr, F.lane); continue; } r -= I_P;
        if (r < I_O) { tr_item(w_out, 1024, 64 * (r / 32), 32 * (r % 32), WoT, 1024, 32 * (r % 32), scr, F.lane); continue; } r -= I_O;
        tr_item(g2, 512, 64 * (r / 16), 32 * (r % 16), G2T, 256, 32 * (r % 16), scr, F.lane);
    }
    { const int gt = (F.vcu * NWAVES + F.wave) * 64 + F.lane, NT = F.G * NWAVES * 64; const v4u z4 = {0u, 0u, 0u, 0u};
      for (int i = gt; i < 128 * 128; i += NT) *(GAS v4u*)(WinT + (size_t)4736 * 1024 + (size_t)i * 8) = z4;
      for (int i = gt; i < 512 * 16; i += NT) *(GAS v4u*)(G2T + (size_t)(i >> 4) * 256 + 128 + (i & 15) * 8) = z4; }
    __syncthreads();
    const float* cvec = (const float*)A->in[1]; const float* w_ada = (const float*)A->in[3]; const float* b_ada = (const float*)A->in[4];
    float* mod = (float*)(ws + WS_MOD);
    for (int task = F.vcu; task < 192; task += F.G) { const int cg = task % 96, dh = task / 96;
        LAS float* ca = (LAS float*)F.lds;
        LAS float* red = (LAS float*)(F.lds + 65536);
        for (int i = F.tid; i < 16 * 1024; i += 512) { const int b = i >> 10, d = i & 1023; const float cv = cvec[i]; ca[d * 16 + b] = cv / (1.0f + __expf(-cv)); }
        __syncthreads();
        float acc[16];
#pragma unroll
        for (int b = 0; b < 16; ++b) acc[b] = 0.f;
        const int col = cg * 64 + F.lane;
#pragma unroll 8
        for (int dd = 0; dd < 64; ++dd) { const int d = dh * 512 + F.wave * 64 + dd; const float w = w_ada[(size_t)d * 6144 + col];
            const LAS f32x4* cp = (const LAS f32x4*)(ca + d * 16);
#pragma unroll
            for (int q = 0; q < 4; ++q) { const f32x4 cv = cp[q]; acc[q * 4 + 0] += cv[0] * w; acc[q * 4 + 1] += cv[1] * w; acc[q * 4 + 2] += cv[2] * w; acc[q * 4 + 3] += cv[3] * w; } }
#pragma unroll
        for (int b = 0; b < 16; ++b) red[(F.wave * 16 + b) * 64 + F.lane] = acc[b];
        __syncthreads();
        for (int o = F.tid; o < 1024; o += 512) { const int b = o >> 6, cl = o & 63; float sacc = 0.f;
#pragma unroll
            for (int w = 0; w < 8; ++w) sacc += red[(w * 16 + b) * 64 + cl];
            atomicAdd(&mod[b * 6144 + cg * 64 + cl], sacc + (dh == 0 ? b_ada[cg * 64 + cl] : 0.f)); }
        __syncthreads();
    }
}


__device__ __forceinline__ float dpp_wave_sum(float v) {
    v += __int_as_float(__builtin_amdgcn_update_dpp(0, __float_as_int(v), 0xB1, 0xf, 0xf, false));
    v += __int_as_float(__builtin_amdgcn_update_dpp(0, __float_as_int(v), 0x4E, 0xf, 0xf, false));
    v += __int_as_float(__builtin_amdgcn_update_dpp(0, __float_as_int(v), 0x141, 0xf, 0xf, false));
    v += __int_as_float(__builtin_amdgcn_update_dpp(0, __float_as_int(v), 0x140, 0xf, 0xf, false));
    v += __int_as_float(__builtin_amdgcn_ds_swizzle(__float_as_int(v), 0x401F));
    auto r_ = __builtin_amdgcn_permlane32_swap(__float_as_uint(v), __float_as_uint(v), false, false);
    return __uint_as_float(r_[0]) + __uint_as_float(r_[1]); }

template <int R, bool XBF> __device__ __forceinline__ void modnorm_rows(const void* x, int m0, int mstride, const float* g, const float* mod, int sh_off, int sc_off, bf16* out, int lane, f32x4 (&u)[R][4]) {
    f32x4 v[R][4];
#pragma unroll
    for (int i = 0; i < R; ++i) {
        if (XBF) { const GAS u32x2* xr = (const GAS u32x2*)((const bf16*)x + (size_t)(m0 + i * mstride) * 1024) + lane;
#pragma unroll
            for (int j = 0; j < 4; ++j) { const u32x2 w = xr[64 * j]; v[i][j] = (f32x4){bflo(w.x), bfhi(w.x), bflo(w.y), bfhi(w.y)}; } }
        else { const GAS f32x4* xr = (const GAS f32x4*)((const float*)x + (size_t)(m0 + i * mstride) * 1024) + lane;
#pragma unroll
            for (int j = 0; j < 4; ++j) v[i][j] = xr[64 * j]; } }
    f32x4 gg[4];
#pragma unroll
    for (int j = 0; j < 4; ++j) gg[j] = ((const GAS f32x4*)g)[lane + 64 * j];
#pragma unroll
    for (int i = 0; i < R; ++i) { const int m = m0 + i * mstride, b = m >> 11; float s = 0.f;
#pragma unroll
        for (int j = 0; j < 4; ++j) s += (v[i][j].x * v[i][j].x + v[i][j].y * v[i][j].y) + (v[i][j].z * v[i][j].z + v[i][j].w * v[i][j].w);
        const float rs = rsqrtf(dpp_wave_sum(s) * (1.0f / 1024.0f) + 1e-6f);
        const float* sh = mod + (size_t)b * 6144 + sh_off; const float* sc = mod + (size_t)b * 6144 + sc_off;
        GAS unsigned long long* o8 = (GAS unsigned long long*)(out + (size_t)m * 1024) + lane;
#pragma unroll
        for (int j = 0; j < 4; ++j) { const f32x4 s1 = ((const GAS f32x4*)sc)[lane + 64 * j], s0 = ((const GAS f32x4*)sh)[lane + 64 * j];
            f32x4 y = (v[i][j] * rs) * gg[j]; y = y * (s1 + 1.0f) + s0; u[i][j] = y;
            o8[64 * j] = (unsigned long long)pk2(y.x, y.y) | ((unsigned long long)pk2(y.z, y.w) << 32); } }
}

template <int R> __device__ __forceinline__ void load_rows_bf16(const bf16* x, int m0, int mstride, int lane_in, u32x2 (&raw)[R][4]) {
    int lane = lane_in; asm volatile("" : "+v"(lane));
#pragma unroll
    for (int i = 0; i < R; ++i) { const GAS u32x2* xr = (const GAS u32x2*)(x + (size_t)(m0 + i * mstride) * 1024) + lane;
#pragma unroll
        for (int j = 0; j < 4; ++j) raw[i][j] = xr[64 * j]; }
}
template <int R> __device__ __forceinline__ void modnorm_rows_pre(const u32x2 (&raw)[R][4], int m0, int mstride, const float* g, const float* mod, int sh_off, int sc_off, bf16* out, int lane, f32x4 (&u)[R][4]) {
    f32x4 gg[4];
#pragma unroll
    for (int j = 0; j < 4; ++j) gg[j] = ((const GAS f32x4*)g)[lane + 64 * j];
#pragma unroll
    for (int i = 0; i < R; ++i) { const int m = m0 + i * mstride, b = m >> 11; float s = 0.f; f32x4 v[4];
#pragma unroll
        for (int j = 0; j < 4; ++j) { const u32x2 w = raw[i][j]; v[j] = (f32x4){bflo(w.x), bfhi(w.x), bflo(w.y), bfhi(w.y)}; s += (v[j].x * v[j].x + v[j].y * v[j].y) + (v[j].z * v[j].z + v[j].w * v[j].w); }
        const float rs = rsqrtf(dpp_wave_sum(s) * (1.0f / 1024.0f) + 1e-6f);
        const float* sh = mod + (size_t)b * 6144 + sh_off; const float* sc = mod + (size_t)b * 6144 + sc_off;
        GAS unsigned long long* o8 = (GAS unsigned long long*)(out + (size_t)m * 1024) + lane;
#pragma unroll
        for (int j = 0; j < 4; ++j) { const f32x4 s1 = ((const GAS f32x4*)sc)[lane + 64 * j], s0 = ((const GAS f32x4*)sh)[lane + 64 * j];
            f32x4 y = (v[j] * rs) * gg[j]; y = y * (s1 + 1.0f) + s0; u[i][j] = y;
            o8[64 * j] = (unsigned long long)pk2(y.x, y.y) | ((unsigned long long)pk2(y.z, y.w) << 32); } }
}

__device__ __forceinline__ void modnorm_row(const float* xrow, const float* g, const float* sh, const float* sc, bf16* orow, int lane, f32x4 (&u)[4]) {
    const GAS f32x4* xr = (const GAS f32x4*)xrow + lane;
    f32x4 v[4]; float s = 0.f;
#pragma unroll
    for (int j = 0; j < 4; ++j) { v[j] = xr[64 * j]; s += (v[j].x * v[j].x + v[j].y * v[j].y) + (v[j].z * v[j].z + v[j].w * v[j].w); }
    const float rs = rsqrtf(wave_sum(s) * (1.0f / 1024.0f) + 1e-6f);
    GAS unsigned long long* o8 = (GAS unsigned long long*)orow + lane;
#pragma unroll
    for (int j = 0; j < 4; ++j) { const f32x4 gg = ((const GAS f32x4*)g)[lane + 64 * j], s1 = ((const GAS f32x4*)sc)[lane + 64 * j], s0 = ((const GAS f32x4*)sh)[lane + 64 * j];
        f32x4 y = (v[j] * rs) * gg; y = y * (s1 + 1.0f) + s0; u[j] = y;
        o8[64 * j] = (unsigned long long)pk2(y.x, y.y) | ((unsigned long long)pk2(y.z, y.w) << 32); }
}

__device__ __forceinline__ float softplusf(float x) { return x > 20.f ? x : log1pf(__expf(x)); }
__device__ __forceinline__ void scan_chain(const Frame& F, ArgsP A, int b, int h, int dir) {
    constexpr int CT = 32;
    LAS float* L = (LAS float*)F.lds;
    LAS float* W2S = L; LAS float* A2S = L + 4096; LAS float* ZRs = L + 8192; LAS float* ZKs = ZRs + 2048; LAS float* ZVs = ZKs + 2048; LAS float* TWs = ZVs + 2048; LAS float* ZAs = TWs + 2048;
    LAS float* DEC = ZAs + 2048; LAS float* KD = DEC + 2048; LAS float* AV = KD + 2048; LAS float* BV = AV + 2048; LAS float* YB = BV + 2048; LAS float* BON = YB + 2048;
    const bf16* Z = (const bf16*)(A->ws + WS_Z);
    const float* mu_prev = (const float*)A->in[7]; const float* mu_next = (const float*)A->in[8];
    const float* w0 = (const float*)A->in[9]; const float* w2 = (const float*)A->in[10]; const float* a0 = (const float*)A->in[11]; const float* a2 = (const float*)A->in[12];
    const float* k_k = (const float*)A->in[14]; const float* k_a = (const float*)A->in[15]; const float* r_k = (const float*)A->in[16];
    bf16* ydir = (bf16*)(A->ws + WS_XN) + (size_t)dir * M * 512; float* bonus = (float*)(A->ws + WS_BONUS) + (size_t)dir * M * 8;
    const int tid = F.tid, lane = F.lane, wave = F.wave;
    for (int i = tid; i < 4096; i += 512) { const int l = i >> 6, j = i & 63; W2S[i] = w2[((size_t)dir * 64 + l) * 512 + h * 64 + j]; A2S[i] = a2[((size_t)dir * 64 + l) * 512 + h * 64 + j]; }
    const int ch = h * 64 + lane;
    const float w0j = w0[dir * 512 + ch], a0j = a0[dir * 512 + ch], kkj = k_k[ch], kaj = k_a[ch], rkj = r_k[ch];
    float s[8];
#pragma unroll
    for (int q = 0; q < 8; ++q) s[q] = 0.f;
    const int ri = tid >> 3, jg = tid & 7;
    for (int ci = 0; ci < T / CT; ++ci) {
        const int t0 = (dir ? (T / CT - 1 - ci) : ci) * CT;
#pragma unroll 4
        for (int i = 0; i < 20; ++i) { const int e = tid + 512 * i, arr = e >> 11, rem = e & 2047, tl = rem >> 6, j = rem & 63;
            const int col = (arr == 0 ? ZR + h * 64 : arr == 1 ? ZK + h * 64 : arr == 2 ? ZV + h * 64 : arr == 3 ? ZWD + dir * 64 : ZAD + dir * 64) + j;
            const int t = t0 + tl; const bf16* zp = Z + ((size_t)b * T + t) * NZ + col;
            const float z0 = bf2f(zp[0]), zm = t > 0 ? bf2f(zp[-NZ]) : 0.f, zq = t < T - 1 ? bf2f(zp[NZ]) : 0.f;
            float zs = z0 + mu_prev[col] * (zm - z0) + mu_next[col] * (zq - z0);
            if (arr == 3) zs = tanhf(zs);
            ZRs[arr * 2048 + rem] = zs; }
        __syncthreads();
#pragma unroll 1
        for (int q = 0; q < 4; ++q) { const int tl = wave + 8 * q;
            float wraw = w0j, araw = a0j;
#pragma unroll 8
            for (int l = 0; l < 64; ++l) { wraw += TWs[tl * 64 + l] * W2S[l * 64 + lane]; araw += ZAs[tl * 64 + l] * A2S[l * 64 + lane]; }
            const float w = -softplusf(-wraw) - 0.5f, dec = __expf(-__expf(w)), ad = sigm(araw);
            const float k = ZKs[tl * 64 + lane], kkr = k * kkj, nrm = sqrtf(wave_sum(kkr * kkr)), kk = kkr / fmaxf(nrm, 1e-12f);
            const float kd = k * (1.0f + (ad - 1.0f) * kaj);
            DEC[tl * 64 + lane] = dec; KD[tl * 64 + lane] = kd; AV[tl * 64 + lane] = -kk; BV[tl * 64 + lane] = kk * ad;
            const float bon = wave_sum(ZRs[tl * 64 + lane] * kd * rkj); if (lane == 0) BON[tl] = bon; }
        __syncthreads();
#pragma unroll 1
        for (int st = 0; st < CT; ++st) { const int tl = dir ? (CT - 1 - st) : st; const int o = tl * 64 + jg * 8;
            const f32x4 a0v = *(const LAS f32x4*)(AV + o), a1v = *(const LAS f32x4*)(AV + o + 4), d0 = *(const LAS f32x4*)(DEC + o), d1 = *(const LAS f32x4*)(DEC + o + 4);
            const f32x4 b0 = *(const LAS f32x4*)(BV + o), b1 = *(const LAS f32x4*)(BV + o + 4), k0 = *(const LAS f32x4*)(KD + o), k1 = *(const LAS f32x4*)(KD + o + 4);
            const f32x4 r0 = *(const LAS f32x4*)(ZRs + o), r1 = *(const LAS f32x4*)(ZRs + o + 4); const float vi = ZVs[tl * 64 + ri];
            float p = (s[0] * a0v[0] + s[1] * a0v[1]) + (s[2] * a0v[2] + s[3] * a0v[3]) + (s[4] * a1v[0] + s[5] * a1v[1]) + (s[6] * a1v[2] + s[7] * a1v[3]);
            p += __shfl_xor(p, 1); p += __shfl_xor(p, 2); p += __shfl_xor(p, 4);
            s[0] = s[0] * d0[0] + p * b0[0] + vi * k0[0]; s[1] = s[1] * d0[1] + p * b0[1] + vi * k0[1]; s[2] = s[2] * d0[2] + p * b0[2] + vi * k0[2]; s[3] = s[3] * d0[3] + p * b0[3] + vi * k0[3];
            s[4] = s[4] * d1[0] + p * b1[0] + vi * k1[0]; s[5] = s[5] * d1[1] + p * b1[1] + vi * k1[1]; s[6] = s[6] * d1[2] + p * b1[2] + vi * k1[2]; s[7] = s[7] * d1[3] + p * b1[3] + vi * k1[3];
            float y = (s[0] * r0[0] + s[1] * r0[1]) + (s[2] * r0[2] + s[3] * r0[3]) + (s[4] * r1[0] + s[5] * r1[1]) + (s[6] * r1[2] + s[7] * r1[3]);
            y += __shfl_xor(y, 1); y += __shfl_xor(y, 2); y += __shfl_xor(y, 4);
            if (jg == 0) YB[tl * 64 + ri] = y; }
        __syncthreads();
#pragma unroll
        for (int i = 0; i < 4; ++i) { const int e = tid + 512 * i, tl = e >> 6, c = e & 63; ydir[((size_t)b * T + t0 + tl) * 512 + h * 64 + c] = (bf16)f2bf(YB[e]); }
        if (tid < CT) bonus[((size_t)b * T + t0 + tid) * 8 + h] = BON[tid];
        __syncthreads();
    }
}


#define SDEV __device__ __forceinline__
#define S_UNROLL _Pragma("unroll")
#define S_MEMBAR() do { asm volatile("" ::: "memory"); __builtin_amdgcn_sched_barrier(0); } while (0)
#define S_LAUNDER_I(x) asm volatile("" : "+v"(x))
#define S_LAUNDER_S(x) asm volatile("" : "+s"(x))
#define S_PIN(x) asm volatile("" : "+v"(x))
typedef float f32x2s __attribute__((ext_vector_type(2))); typedef __bf16 bf16x2s __attribute__((ext_vector_type(2)));
__device__ __forceinline__ unsigned s_cvtpk(float lo, float hi) { f32x2s v = {lo, hi}; bf16x2s b = __builtin_convertvector(v, bf16x2s); return __builtin_bit_cast(unsigned, b); }
__device__ __forceinline__ float s_rowsum16(float v) {
    v += __int_as_float(__builtin_amdgcn_update_dpp(0, __float_as_int(v), 0xB1, 0xf, 0xf, false));
    v += __int_as_float(__builtin_amdgcn_update_dpp(0, __float_as_int(v), 0x4E, 0xf, 0xf, false));
    v += __int_as_float(__builtin_amdgcn_update_dpp(0, __float_as_int(v), 0x141, 0xf, 0xf, false));
    v += __int_as_float(__builtin_amdgcn_update_dpp(0, __float_as_int(v), 0x140, 0xf, 0xf, false));
    return v; }
#define S_MFMA(a, b, c) __builtin_amdgcn_mfma_f32_32x32x16_bf16(a, b, c, 0, 0, 0)
#define S_PK(lo, hi) s_cvtpk(lo, hi)
#define S_SWAP(x, y) do { auto r_ = __builtin_amdgcn_permlane32_swap(x, y, false, false); x = r_[0]; y = r_[1]; } while (0)
#define S_ROWSUM16(v) s_rowsum16(v)
__device__ __forceinline__ float s_wavesum(float v) { v = s_rowsum16(v);
    v += __int_as_float(__builtin_amdgcn_ds_swizzle(__float_as_int(v), 0x401F));
    auto r_ = __builtin_amdgcn_permlane32_swap(__float_as_uint(v), __float_as_uint(v), false, false);
    return __uint_as_float(r_[0]) + __uint_as_float(r_[1]); }
#define S_WAVESUM(v) s_wavesum(v)
#define S_GAS GAS
#define S_READLANE(v, l) __int_as_float(__builtin_amdgcn_readlane(__float_as_int(v), l))
#define S_RCP(x) __builtin_amdgcn_rcpf(x)
#define S_EXP2(x) __builtin_amdgcn_exp2f(x)
#define S_LOG2(x) __builtin_amdgcn_logf(x)
#define S_RSQ(x) __builtin_amdgcn_rsqf(x)
#define S_LDS_WAIT() asm volatile("s_waitcnt lgkmcnt(0)" ::: "memory")
#define S_LDSP LAS unsigned char*
#define S_LDS_BF16P LAS bf16*
#define S_LDS_U32P LAS unsigned*
#define S_LDS_F32P LAS float*
#define S_LDS_CONST_BF16X8P const LAS bf16x8*
#define S_LDS_BF16X8P LAS bf16x8*
#define S_LDS_CONST_F32X4P const LAS f32x4*
#define S_FLAG_STORE(p, v) do { *(volatile LAS unsigned*)(p) = (v); } while (0)
#define S_FLAG_WAIT(p, v) do { unsigned sp_ = 0; while (*(volatile LAS unsigned*)(p) != (v)) { __builtin_amdgcn_s_sleep(2); if (++sp_ > (1u << 24)) break; } asm volatile("" ::: "memory"); } while (0)
struct SFrag { bf16x8 s[2]; };
struct SMat { SFrag t[2]; };
SDEV f32x16 smm(const SFrag& X, const SFrag& Y, f32x16 acc) { acc = S_MFMA(X.s[0], Y.s[0], acc); acc = S_MFMA(X.s[1], Y.s[1], acc); return acc; }
SDEV f32x16 szero() { f32x16 z; S_UNROLL for (int i = 0; i < 16; ++i) z[i] = 0.f; return z; }
SDEV SFrag spack(const f32x16& d) { SFrag f;
    S_UNROLL for (int s = 0; s < 2; ++s) { v4u w; S_UNROLL for (int q = 0; q < 4; ++q) w[q] = S_PK(d[8 * s + 2 * q], d[8 * s + 2 * q + 1]); f.s[s] = __builtin_bit_cast(bf16x8, w); }
    return f; }
SDEV f32x16 sunpack(const SFrag& f) { f32x16 d;
    S_UNROLL for (int s = 0; s < 2; ++s) { const v4u w = __builtin_bit_cast(v4u, f.s[s]); S_UNROLL for (int q = 0; q < 4; ++q) { d[8 * s + 2 * q] = __uint_as_float(w[q] << 16); d[8 * s + 2 * q + 1] = __uint_as_float(w[q] & 0xffff0000u); } }
    return d; }
SDEV SMat splain2d(const unsigned (&pp)[16]) { unsigned d0[8], d1[8];
    S_UNROLL for (int g = 0; g < 4; ++g) S_UNROLL for (int p = 0; p < 2; ++p) { unsigned x = pp[4 * g + p], y = pp[4 * g + 2 + p]; S_SWAP(x, y); d0[2 * g + p] = x; d1[2 * g + p] = y; }
    SMat m;
    S_UNROLL for (int s = 0; s < 2; ++s) { v4u a, b; S_UNROLL for (int q = 0; q < 4; ++q) { a[q] = d0[4 * s + q]; b[q] = d1[4 * s + q]; } m.t[0].s[s] = __builtin_bit_cast(bf16x8, a); m.t[1].s[s] = __builtin_bit_cast(bf16x8, b); }
    return m; }
SDEV void sd2plain(const f32x16& D0, const f32x16& D1, float (&x)[32]) {
    S_UNROLL for (int r = 0; r < 16; ++r) { unsigned a = __float_as_uint(D0[r]), b = __float_as_uint(D1[r]); S_SWAP(a, b); const int ta = (r & 3) + 8 * (r >> 2); x[ta] = __uint_as_float(a); x[ta + 4] = __uint_as_float(b); } }
SDEV SFrag sident(int n_in, int hh_in) { int n1 = n_in, r1 = 4 * hh_in; S_LAUNDER_I(n1); S_LAUNDER_I(r1); f32x16 id; S_UNROLL for (int g = 0; g < 16; ++g) id[g] = (((g & 3) + 8 * (g >> 2) + r1) == n1) ? 1.f : 0.f; return spack(id); }
SDEV void sd2plain_pk(const f32x16& D0, const f32x16& D1, unsigned (&xp)[16]) {
    S_UNROLL for (int m = 0; m < 8; ++m) { unsigned a = S_PK(D0[2 * m], D0[2 * m + 1]), b = S_PK(D1[2 * m], D1[2 * m + 1]); S_SWAP(a, b); const int qa = 4 * (m >> 1) + (m & 1); xp[qa] = a; xp[qa + 2] = b; } }
SDEV float swave_sum(float v) { return S_WAVESUM(v); }

struct ScanArgs { const S_GAS bf16* Z; const S_GAS float* mu_prev; const S_GAS float* mu_next; const S_GAS float* w0; const S_GAS float* a0; const S_GAS float* k_k; const S_GAS float* k_a; const S_GAS float* r_k; S_GAS bf16* ydir; S_GAS float* bonus; };

#define SC_W2F 0
#define SC_A2F 8192
#define SC_SIG 16384
#define SC_GTAB 24576
#define SC_FLAG 26624
#define SC_WR 28672
#define SC_AR 94208
#define SC_LDS_BYTES 126976
#define SC_PF 4

SDEV void scan2_setup(S_LDSP lds, const S_GAS float* w2, const S_GAS float* a2, int h, int dir, int tid) {
    { float wv[16];
      S_UNROLL for (int it = 0; it < 16; ++it) { const int e = tid + 512 * it; const int mat = e >> 12, r = e & 4095, jj = r & 7, ln = (r >> 3) & 63, s = (r >> 9) & 1, jt = (r >> 10) & 1, lt = (r >> 11) & 1;
          const int n = ln & 31, hh = ln >> 5, g = 8 * s + jj, l = 32 * lt + (g & 3) + 8 * (g >> 2) + 4 * hh, j = 32 * jt + n;
          wv[it] = (mat ? a2 : w2)[((size_t)dir * 64 + l) * 512 + h * 64 + j]; }
      S_UNROLL for (int it = 0; it < 16; ++it) { const int e = tid + 512 * it; const int mat = e >> 12, r = e & 4095;
          ((S_LDS_BF16P)(lds + (mat ? SC_A2F : SC_W2F)))[r] = (bf16)(S_PK(wv[it], 0.f) & 0xffffu); } }
    for (int e = tid; e < 2048; e += 512) ((S_LDS_U32P)(lds + SC_SIG))[e] = 0u;
    if (tid == 0) S_FLAG_STORE(lds + SC_FLAG, 0u);
}

SDEV void scan2_chunk(S_LDSP lds, const ScanArgs& A_in, int b_in, int h_in, int dir_in, int c, int lane_in, int wave) {
    ScanArgs A = A_in; int b = b_in, h = h_in, dir = dir_in;
    S_LAUNDER_S(A.Z); S_LAUNDER_S(A.mu_prev); S_LAUNDER_S(A.mu_next); S_LAUNDER_S(A.w0); S_LAUNDER_S(A.a0); S_LAUNDER_S(A.k_k); S_LAUNDER_S(A.k_a); S_LAUNDER_S(A.r_k); S_LAUNDER_S(A.ydir); S_LAUNDER_S(A.bonus);
    S_LAUNDER_S(b); S_LAUNDER_S(h); S_LAUNDER_S(dir);
    int lane = lane_in; S_LAUNDER_I(lane);
    const int n = lane & 31, hh = lane >> 5;
    const int sgn = dir ? -1 : 1, tau0 = dir ? (T - 1 - 32 * c) : 32 * c;
    const S_GAS bf16* zb = A.Z + (size_t)b * T * NZ;
    const ptrdiff_t st = (ptrdiff_t)sgn * NZ; const bool first = (c == 0), last = (c == T / 32 - 1);
    const int cr = ZR + h * 64 + lane, ck = ZK + h * 64 + lane, cv = ZV + h * 64 + lane, cw = ZWD + dir * 64 + lane, ca = ZAD + dir * 64 + lane, chn = h * 64 + lane;
    {   const SFrag IDF = sident(n, hh); unsigned ppw[16], ppa[16];
        { const float mA = dir ? A.mu_next[cw] : A.mu_prev[cw], mB = dir ? A.mu_prev[cw] : A.mu_next[cw], nA = dir ? A.mu_next[ca] : A.mu_prev[ca], nB = dir ? A.mu_prev[ca] : A.mu_next[ca];
          const S_GAS bf16* pw = zb + (ptrdiff_t)tau0 * NZ + cw - st; const S_GAS bf16* pa = zb + (ptrdiff_t)tau0 * NZ + ca - st;
          float rw[34], ra[34];
          S_UNROLL for (int q = 0; q < 34; ++q) { const bool ok = !((q == 0 && first) || (q == 33 && last)); rw[q] = ok ? bf2f(*pw) : 0.f; ra[q] = ok ? bf2f(*pa) : 0.f; pw += st; pa += st; }
          S_MEMBAR();
          const float mC = 1.f - mA - mB, nC = 1.f - nA - nB; float tprev = 0.f, aprev = 0.f;
          S_UNROLL for (int p = 0; p < 32; ++p) { if ((p & 7) == 0) S_MEMBAR();
              const float ws = mC * rw[p + 1] + mA * rw[p] + mB * rw[p + 2], as = nC * ra[p + 1] + nA * ra[p] + nB * ra[p + 2];
              const float tw = 1.f - 2.f * S_RCP(1.f + S_EXP2(ws * 2.885390082f));
              if (p & 1) { ppw[p >> 1] = S_PK(tprev, tw); ppa[p >> 1] = S_PK(aprev, as); S_PIN(ppw[p >> 1]); S_PIN(ppa[p >> 1]); } else { tprev = tw; aprev = as; } } }
        S_MEMBAR();
        const SMat TW = splain2d(ppw), AD = splain2d(ppa);
        SFrag TWT[2], ADT[2];
        S_UNROLL for (int lt = 0; lt < 2; ++lt) { TWT[lt] = spack(smm(TW.t[lt], IDF, szero())); ADT[lt] = spack(smm(AD.t[lt], IDF, szero())); }
        f32x16 dw[2], da[2];
        S_UNROLL for (int jt = 0; jt < 2; ++jt) { dw[jt] = szero(); da[jt] = szero();
            S_UNROLL for (int lt = 0; lt < 2; ++lt) { SFrag wf, af;
                S_UNROLL for (int s = 0; s < 2; ++s) { wf.s[s] = *(S_LDS_CONST_BF16X8P)(lds + SC_W2F + ((((lt * 2 + jt) * 2 + s) * 64 + lane) * 16)); af.s[s] = *(S_LDS_CONST_BF16X8P)(lds + SC_A2F + ((((lt * 2 + jt) * 2 + s) * 64 + lane) * 16)); }
                dw[jt] = smm(TWT[lt], wf, dw[jt]); da[jt] = smm(ADT[lt], af, da[jt]); } }
        S_UNROLL for (int jt = 0; jt < 2; ++jt) S_UNROLL for (int g = 0; g < 16; ++g) { const int t = (g & 3) + 8 * (g >> 2) + 4 * hh;
            ((S_LDS_F32P)(lds + SC_WR + wave * 8192))[t * 64 + 32 * jt + n] = dw[jt][g]; ((S_LDS_BF16P)(lds + SC_AR + wave * 4096))[t * 64 + 32 * jt + n] = (bf16)(S_PK(da[jt][g], 0.f) & 0xffffu); }
        S_LDS_WAIT();
    }
    S_MEMBAR();
    unsigned ppA[16], ppR[16], ppB[16], ppK[16], ppV[16], ppQ[16]; float gamC;
    {   const float mAr = dir ? A.mu_next[cr] : A.mu_prev[cr], mBr = dir ? A.mu_prev[cr] : A.mu_next[cr], mAk = dir ? A.mu_next[ck] : A.mu_prev[ck], mBk = dir ? A.mu_prev[ck] : A.mu_next[ck];
        const float mAv = dir ? A.mu_next[cv] : A.mu_prev[cv], mBv = dir ? A.mu_prev[cv] : A.mu_next[cv];
        const float w0j = A.w0[dir * 512 + chn], a0j = A.a0[dir * 512 + chn], kkj = A.k_k[chn], kaj = A.k_a[chn], rkj = A.r_k[chn];
        const S_GAS bf16* pr = zb + (ptrdiff_t)tau0 * NZ + cr - st; const S_GAS bf16* pk = zb + (ptrdiff_t)tau0 * NZ + ck - st; const S_GAS bf16* pv = zb + (ptrdiff_t)tau0 * NZ + cv - st;
        float rr[34], rk[34], rv[34];
        S_UNROLL for (int q = 0; q < 34; ++q) { const bool ok = !((q == 0 && first) || (q == 33 && last)); rr[q] = ok ? bf2f(*pr) : 0.f; rk[q] = ok ? bf2f(*pk) : 0.f; rv[q] = ok ? bf2f(*pv) : 0.f; pr += st; pk += st; pv += st; }
        S_MEMBAR();
        const float mCr = 1.f - mAr - mBr, mCk = 1.f - mAk - mBk, mCv = 1.f - mAv - mBv;
        float cs = 0.f, gprev = 1.f; float eA = 0.f, eR = 0.f, eB = 0.f, eK = 0.f, eV = 0.f, eQ = 0.f;
        S_UNROLL for (int p = 0; p < 32; ++p) { S_MEMBAR();
            const float r = mCr * rr[p + 1] + mAr * rr[p] + mBr * rr[p + 2], k = mCk * rk[p + 1] + mAk * rk[p] + mBk * rk[p + 2], v = mCv * rv[p + 1] + mAv * rv[p] + mBv * rv[p + 2];
            const float wraw = ((S_LDS_F32P)(lds + SC_WR + wave * 8192))[p * 64 + lane] + w0j, araw = bf2f(((S_LDS_BF16P)(lds + SC_AR + wave * 4096))[p * 64 + lane]) + a0j;
            const float x = -wraw; const float sp = fmaxf(x, 0.f) + 0.6931471806f * S_LOG2(1.f + S_EXP2(-fabsf(x) * 1.442695041f));
            const float w = -sp - 0.5f; const float lw2 = -S_EXP2(w * 1.442695041f) * 1.442695041f;
            const float al = S_RCP(1.f + S_EXP2(-araw * 1.442695041f));
            const float kkr = k * kkj; const float nrm2 = swave_sum(kkr * kkr); const float kk = kkr * S_RSQ(fmaxf(nrm2, 1e-24f));
            const float kd = k * (1.f + (al - 1.f) * kaj);
            cs += lw2; const float gam = S_EXP2(cs), ig = S_EXP2(-cs);
            const float xa = -kk * gprev, xr = r * gam, xb = kk * al * ig, xk = kd * ig, xq = xr * rkj; gprev = gam;
            if (p & 1) { ppA[p >> 1] = S_PK(eA, xa); ppR[p >> 1] = S_PK(eR, xr); ppB[p >> 1] = S_PK(eB, xb); ppK[p >> 1] = S_PK(eK, xk); ppV[p >> 1] = S_PK(eV, v); ppQ[p >> 1] = S_PK(eQ, xq);
                         S_PIN(ppQ[p >> 1]); S_PIN(ppA[p >> 1]); S_PIN(ppR[p >> 1]); S_PIN(ppB[p >> 1]); S_PIN(ppK[p >> 1]); S_PIN(ppV[p >> 1]); }
            else { eA = xa; eR = xr; eB = xb; eK = xk; eV = v; eQ = xq; } }
        gamC = gprev;
    }
    S_MEMBAR();
    float gc0, gc1; { unsigned x = __float_as_uint(gamC), y = x; S_SWAP(x, y); gc0 = __uint_as_float(x); gc1 = __uint_as_float(y); }
    ((S_LDS_F32P)(lds + SC_GTAB + wave * 256))[lane] = gamC;
    const SMat FA = splain2d(ppA), FB = splain2d(ppB), FK = splain2d(ppK), FV = splain2d(ppV);
    SFrag RT[2], MrbT, MrkT, LakT, Pf, PTf; f32x16 TT;
    {   const SFrag IDF = sident(n, hh); SFrag AT[2], BT[2], KT[2];
        { const SMat FR = splain2d(ppR); S_UNROLL for (int dt = 0; dt < 2; ++dt) RT[dt] = spack(smm(FR.t[dt], IDF, szero())); }
        SFrag QT[2]; { const SMat FQ = splain2d(ppQ); S_UNROLL for (int dt = 0; dt < 2; ++dt) QT[dt] = spack(smm(FQ.t[dt], IDF, szero())); }
        S_UNROLL for (int dt = 0; dt < 2; ++dt) { AT[dt] = spack(smm(FA.t[dt], IDF, szero())); BT[dt] = spack(smm(FB.t[dt], IDF, szero())); KT[dt] = spack(smm(FK.t[dt], IDF, szero())); }
        f32x16 L = szero(), LT = szero(), lak = szero(), mrb = szero(), mrk = szero();
        { f32x16 bq = szero(); S_UNROLL for (int dt = 0; dt < 2; ++dt) bq = smm(KT[dt], QT[dt], bq);
          int nb = n, rb = 4 * hh; S_LAUNDER_I(nb); S_LAUNDER_I(rb); float dsum = 0.f; S_UNROLL for (int g = 0; g < 16; ++g) dsum += (((g & 3) + 8 * (g >> 2) + rb) == nb) ? bq[g] : 0.f;
          if (((nb >> 2) & 1) == (rb >> 2)) A.bonus[((size_t)b * T + (tau0 + sgn * nb)) * 8 + h] = dsum; }
        S_UNROLL for (int dt = 0; dt < 2; ++dt) { L = smm(AT[dt], BT[dt], L); LT = smm(BT[dt], AT[dt], LT); lak = smm(KT[dt], AT[dt], lak); mrb = smm(BT[dt], RT[dt], mrb); mrk = smm(KT[dt], RT[dt], mrk); }
        int n2 = n, r2 = 4 * hh; S_LAUNDER_I(n2); S_LAUNDER_I(r2);
        S_UNROLL for (int g = 0; g < 16; ++g) { const int row = (g & 3) + 8 * (g >> 2) + r2;
            L[g] = (row > n2) ? L[g] : 0.f; LT[g] = (row < n2) ? LT[g] : 0.f; lak[g] = (row < n2) ? lak[g] : 0.f; mrb[g] = (row <= n2) ? mrb[g] : 0.f; mrk[g] = (row <= n2) ? mrk[g] : 0.f; }
        Pf = spack(L); PTf = spack(LT); LakT = spack(lak); MrbT = spack(mrb); MrkT = spack(mrk);
        TT = LT; S_UNROLL for (int g = 0; g < 16; ++g) TT[g] += (((g & 3) + 8 * (g >> 2) + r2) == n2) ? 1.f : 0.f;
    }
    S_MEMBAR();
    SFrag TTf = spack(TT);
    S_UNROLL for (int i = 1; i <= 4; ++i) { const f32x16 P2 = smm(PTf, Pf, szero()); SFrag P2Tf; if (i < 4) P2Tf = spack(smm(Pf, PTf, szero()));
        Pf = spack(P2); TT = smm(Pf, TTf, TT); TTf = spack(TT); if (i < 4) PTf = P2Tf; }
    S_MEMBAR();
    SFrag U0[2], Ap[2], RpT[2], Y0[2], GTf[2][2], Hf[2][2];
    S_UNROLL for (int vt = 0; vt < 2; ++vt) { const SFrag W = spack(smm(LakT, FV.t[vt], szero())); U0[vt] = spack(smm(TTf, W, szero())); }
    S_UNROLL for (int kt = 0; kt < 2; ++kt) Ap[kt] = spack(smm(TTf, FA.t[kt], szero()));
    S_UNROLL for (int kt = 0; kt < 2; ++kt) RpT[kt] = spack(smm(Ap[kt], MrbT, sunpack(RT[kt])));
    S_UNROLL for (int vt = 0; vt < 2; ++vt) Y0[vt] = spack(smm(MrkT, FV.t[vt], smm(MrbT, U0[vt], szero())));
    int n3 = n, r3 = 4 * hh; S_LAUNDER_I(n3); S_LAUNDER_I(r3);
    S_UNROLL for (int nt = 0; nt < 2; ++nt) S_UNROLL for (int mt = 0; mt < 2; ++mt) { f32x16 gt = smm(Ap[nt], FB.t[mt], szero()); const float gcv = mt ? gc1 : gc0;
        S_UNROLL for (int g = 0; g < 16; ++g) { const float idv = (nt == mt && ((g & 3) + 8 * (g >> 2) + r3) == n3) ? 1.f : 0.f; gt[g] = (gt[g] + idv) * gcv; }
        GTf[nt][mt] = spack(gt); }
    S_LDS_WAIT();
    S_UNROLL for (int mt = 0; mt < 2; ++mt) { float gr[16];
        S_UNROLL for (int q = 0; q < 4; ++q) { const f32x4 t4 = *(S_LDS_CONST_F32X4P)(lds + SC_GTAB + wave * 256 + (32 * mt + 8 * q + 4 * hh) * 4); S_UNROLL for (int i = 0; i < 4; ++i) gr[4 * q + i] = t4[i]; }
        S_UNROLL for (int vt = 0; vt < 2; ++vt) { f32x16 hm = smm(FK.t[mt], FV.t[vt], smm(FB.t[mt], U0[vt], szero())); S_UNROLL for (int g = 0; g < 16; ++g) hm[g] *= gr[g]; Hf[mt][vt] = spack(hm); } }
    S_MEMBAR();
    S_FLAG_WAIT(lds + SC_FLAG, (unsigned)c);
    SFrag SG[2][2];
    S_UNROLL for (int kt = 0; kt < 2; ++kt) S_UNROLL for (int vt = 0; vt < 2; ++vt) S_UNROLL for (int s = 0; s < 2; ++s) SG[kt][vt].s[s] = *(S_LDS_CONST_BF16X8P)(lds + SC_SIG + ((((kt * 2 + vt) * 2 + s) * 64 + lane) * 16));
    S_LDS_WAIT();
    S_UNROLL for (int mt = 0; mt < 2; ++mt) S_UNROLL for (int vt = 0; vt < 2; ++vt) { f32x16 sn = sunpack(Hf[mt][vt]); S_UNROLL for (int nt = 0; nt < 2; ++nt) sn = smm(GTf[nt][mt], SG[nt][vt], sn);
        const SFrag f = spack(sn); S_UNROLL for (int s = 0; s < 2; ++s) *(S_LDS_BF16X8P)(lds + SC_SIG + ((((mt * 2 + vt) * 2 + s) * 64 + lane) * 16)) = f.s[s]; }
    S_LDS_WAIT();
    S_FLAG_STORE(lds + SC_FLAG, (unsigned)(c + 1));
    S_UNROLL for (int vt = 0; vt < 2; ++vt) { f32x16 y = sunpack(Y0[vt]); S_UNROLL for (int kt = 0; kt < 2; ++kt) y = smm(RpT[kt], SG[kt][vt], y);
        S_UNROLL for (int g = 0; g < 16; ++g) { const int p = (g & 3) + 8 * (g >> 2) + 4 * hh; A.ydir[((size_t)b * T + (tau0 + sgn * p)) * 512 + h * 64 + 32 * vt + n] = (bf16)(S_PK(y[g], 0.f) & 0xffffu); } }
}

__device__ __forceinline__ void attn_unit(const Frame& F, ArgsP A, int b, int kvh, int qb) {
    constexpr int KST = 72, VST = 388;
    LAS bf16* KS = (LAS bf16*)F.lds;
    LAS bf16* VT = (LAS bf16*)(F.lds + 384 * KST * 2);
    LAS float* wsf = (LAS float*)(F.lds + 384 * KST * 2 + 64 * VST * 2);
    const bf16* Z = (const bf16*)(A->ws + WS_Z); bf16* OA = (bf16*)(A->ws + WS_OATT);
    const int* positions = (const int*)A->in[2]; const float* qg = (const float*)A->in[19]; const float* kg = (const float*)A->in[20]; const float* sink = (const float*)A->in[21];
    const int tid = F.tid, lane = F.lane, wave = F.wave;
    const float LN_THETA = 13.122363377404328f;
    v4u kwa[6], vwa[6], rca[6], rsa[6];
#pragma unroll
    for (int i = 0; i < 6; ++i) { const int ct = tid + 512 * i, key = ct >> 3, ch = ct & 7; const int kp = qb * 128 - 128 + key; const bool valid = (kp >= 0) && (kp < T);
        const size_t rowoff = ((size_t)b * T + (valid ? kp : 0)) * NZ;
        kwa[i] = *(const GAS v4u*)(Z + rowoff + ZKA + kvh * 64 + ch * 8); vwa[i] = *(const GAS v4u*)(Z + rowoff + ZVA + kvh * 64 + ch * 8);
        const GAS v4u* rt = (const GAS v4u*)((const bf16*)(A->ws + WS_ROPE) + ((size_t)b * T + (valid ? kp : 0)) * 16); rca[i] = rt[0]; rsa[i] = rt[1]; }
#pragma unroll
    for (int i = 0; i < 6; ++i) { const int ct = tid + 512 * i, key = ct >> 3, ch = ct & 7; const int kp = qb * 128 - 128 + key; const bool valid = (kp >= 0) && (kp < T);
        v4u kw = kwa[i], vw = vwa[i];
        if (!valid) { kw = (v4u){0u, 0u, 0u, 0u}; vw = kw; }
        float kf[8] = {bflo(kw.x), bfhi(kw.x), bflo(kw.y), bfhi(kw.y), bflo(kw.z), bfhi(kw.z), bflo(kw.w), bfhi(kw.w)};
        float ss = 0.f;
#pragma unroll
        for (int j = 0; j < 8; ++j) ss += kf[j] * kf[j];
        ss += __shfl_xor(ss, 1); ss += __shfl_xor(ss, 2); ss += __shfl_xor(ss, 4);
        const float rs = rsqrtf(ss * (1.0f / 64.0f) + 1e-6f);
#pragma unroll
        for (int j = 0; j < 8; ++j) kf[j] = kf[j] * rs * kg[ch * 8 + j];
        float oth[8];
#pragma unroll
        for (int j = 0; j < 8; ++j) oth[j] = __shfl_xor(kf[j], 1);
        if (ch < 2) { const v4u cw = rca[i], sw = rsa[i];
            const float cs[8] = {bflo(cw.x), bfhi(cw.x), bflo(cw.y), bfhi(cw.y), bflo(cw.z), bfhi(cw.z), bflo(cw.w), bfhi(cw.w)};
            const float sn[8] = {bflo(sw.x), bfhi(sw.x), bflo(sw.y), bfhi(sw.y), bflo(sw.z), bfhi(sw.z), bflo(sw.w), bfhi(sw.w)};
#pragma unroll
            for (int j = 0; j < 8; ++j) kf[j] = (ch == 0) ? (kf[j] * cs[j] - oth[j] * sn[j]) : (kf[j] * cs[j] + oth[j] * sn[j]); }
        v4u ko; ko.x = pk2(kf[0], kf[1]); ko.y = pk2(kf[2], kf[3]); ko.z = pk2(kf[4], kf[5]); ko.w = pk2(kf[6], kf[7]);
        *(LAS v4u*)(KS + key * KST + ch * 8) = ko;
        const unsigned vv[4] = {vw.x, vw.y, vw.z, vw.w};
#pragma unroll
        for (int j = 0; j < 4; ++j) { VT[(ch * 8 + 2 * j) * VST + key] = (bf16)(vv[j] & 0xffffu); VT[(ch * 8 + 2 * j + 1) * VST + key] = (bf16)(vv[j] >> 16); } }
    __syncthreads();
    const int g = wave >> 1, hq = kvh * 4 + g, r32 = lane & 31, hh = lane >> 5;
    const float snk = sink[hq];
    float kbound; { float gm = fabsf(kg[lane]);
#pragma unroll
        for (int o = 1; o < 64; o <<= 1) gm = fmaxf(gm, __shfl_xor(gm, o));
        kbound = 8.0f * gm; }
#pragma unroll 1
    for (int qt = 0; qt < 2; ++qt) { const int qo = (wave & 1) * 64 + qt * 32, qrel = qo + r32; const size_t tok = (size_t)b * T + qb * 128 + qrel;
        float qf[4][8]; float ss = 0.f; v4u qraw[4];
#pragma unroll
        for (int sI = 0; sI < 4; ++sI) qraw[sI] = *(const GAS v4u*)(Z + tok * NZ + ZQ + hq * 64 + 16 * sI + 8 * hh);
        const GAS v4u* qrt = (const GAS v4u*)((const bf16*)(A->ws + WS_ROPE) + tok * 16); const v4u qrc = qrt[0], qrs = qrt[1];
#pragma unroll
        for (int sI = 0; sI < 4; ++sI) { const v4u qw = qraw[sI];
            qf[sI][0] = bflo(qw.x); qf[sI][1] = bfhi(qw.x); qf[sI][2] = bflo(qw.y); qf[sI][3] = bfhi(qw.y); qf[sI][4] = bflo(qw.z); qf[sI][5] = bfhi(qw.z); qf[sI][6] = bflo(qw.w); qf[sI][7] = bfhi(qw.w);
#pragma unroll
            for (int j = 0; j < 8; ++j) ss += qf[sI][j] * qf[sI][j]; }
        ss += __shfl_xor(ss, 32);
        const float rs = rsqrtf(ss * (1.0f / 64.0f) + 1e-6f) * 0.125f;
#pragma unroll
        for (int sI = 0; sI < 4; ++sI)
#pragma unroll
            for (int j = 0; j < 8; ++j) qf[sI][j] = qf[sI][j] * rs * qg[16 * sI + 8 * hh + j];
        { const v4u cw = qrc, sw = qrs;
          const float cs[8] = {bflo(cw.x), bfhi(cw.x), bflo(cw.y), bfhi(cw.y), bflo(cw.z), bfhi(cw.z), bflo(cw.w), bfhi(cw.w)}, sn[8] = {bflo(sw.x), bfhi(sw.x), bflo(sw.y), bfhi(sw.y), bflo(sw.z), bfhi(sw.z), bflo(sw.w), bfhi(sw.w)};
#pragma unroll
          for (int j = 0; j < 8; ++j) { const float oth = __shfl_xor(qf[0][j], 32); qf[0][j] = (hh == 0) ? (qf[0][j] * cs[j] - oth * sn[j]) : (qf[0][j] * cs[j] + oth * sn[j]); } }
        bf16x8 qr[4];
#pragma unroll
        for (int sI = 0; sI < 4; ++sI) { v4u w; w.x = pk2(qf[sI][0], qf[sI][1]); w.y = pk2(qf[sI][2], qf[sI][3]); w.z = pk2(qf[sI][4], qf[sI][5]); w.w = pk2(qf[sI][6], qf[sI][7]); qr[sI] = __builtin_bit_cast(bf16x8, w); }
        const int kt0 = qo >> 5;
        float qn2 = 0.f;
#pragma unroll
        for (int sI = 0; sI < 4; ++sI)
#pragma unroll
            for (int j = 0; j < 8; ++j) qn2 += qf[sI][j] * qf[sI][j];
        qn2 += __shfl_xor(qn2, 32);
        float mrun = sqrtf(qn2) * kbound * 1.02f;
        if (__any(mrun > 40.f)) { mrun = -1e30f;
#pragma unroll 1
            for (int kt = 0; kt < 9; ++kt) { const int kbase = (kt0 + kt) * 32;
                f32x16 acc = {};
#pragma unroll
                for (int sI = 0; sI < 4; ++sI) { const bf16x8 kfr = *(const LAS bf16x8*)(KS + (kbase + r32) * KST + 16 * sI + 8 * hh); acc = __builtin_amdgcn_mfma_f32_32x32x16_bf16(kfr, qr[sI], acc, 0, 0, 0); }
#pragma unroll
                for (int r = 0; r < 16; ++r) { const int ki = kbase + (r & 3) + 8 * (r >> 2) + 4 * hh; const int dq = ki - 128 - qrel, kp = qb * 128 - 128 + ki;
                    const bool ok = (dq >= -128) && (dq <= 128) && (kp >= 0) && (kp < T); mrun = fmaxf(mrun, ok ? acc[r] : -1e30f); } }
            mrun = fmaxf(mrun, __shfl_xor(mrun, 32)); }
        const float mx = fmaxf(mrun, snk);
        float lrun = 0.f; f32x16 o0 = {}, o1 = {}; const float mxl = mx * 1.442695041f; const bool edge = (qb == 0) || (qb == T / 128 - 1);
#pragma unroll 1
        for (int kt = 0; kt < 9; ++kt) { const int kbase = (kt0 + kt) * 32;
            f32x16 acc = {};
#pragma unroll
            for (int sI = 0; sI < 4; ++sI) { const bf16x8 kfr = *(const LAS bf16x8*)(KS + (kbase + r32) * KST + 16 * sI + 8 * hh); acc = __builtin_amdgcn_mfma_f32_32x32x16_bf16(kfr, qr[sI], acc, 0, 0, 0); }
            float p[16];
            if (edge || kt == 0 || kt == 8) {
#pragma unroll
                for (int r = 0; r < 16; ++r) { const int ki = kbase + (r & 3) + 8 * (r >> 2) + 4 * hh; const int dq = ki - 128 - qrel, kp = qb * 128 - 128 + ki;
                    const bool ok = (dq >= -128) && (dq <= 128) && (kp >= 0) && (kp < T); p[r] = ok ? __builtin_amdgcn_exp2f(acc[r] * 1.442695041f - mxl) : 0.f; lrun += p[r]; }
            } else {
#pragma unroll
                for (int r = 0; r < 16; ++r) { p[r] = __builtin_amdgcn_exp2f(acc[r] * 1.442695041f - mxl); lrun += p[r]; } }
#pragma unroll
            for (int sI = 0; sI < 2; ++sI) { v4u pw; pw.x = pk2(p[8 * sI + 0], p[8 * sI + 1]); pw.y = pk2(p[8 * sI + 2], p[8 * sI + 3]); pw.z = pk2(p[8 * sI + 4], p[8 * sI + 5]); pw.w = pk2(p[8 * sI + 6], p[8 * sI + 7]);
                const bf16x8 pa = __builtin_bit_cast(bf16x8, pw); const int key0 = kbase + 16 * sI + 4 * hh;
                { const u32x2 lo = *(const LAS u32x2*)(VT + r32 * VST + key0), hi = *(const LAS u32x2*)(VT + r32 * VST + key0 + 8); v4u vw; vw.x = lo.x; vw.y = lo.y; vw.z = hi.x; vw.w = hi.y;
                  o0 = __builtin_amdgcn_mfma_f32_32x32x16_bf16(pa, __builtin_bit_cast(bf16x8, vw), o0, 0, 0, 0); }
                { const u32x2 lo = *(const LAS u32x2*)(VT + (32 + r32) * VST + key0), hi = *(const LAS u32x2*)(VT + (32 + r32) * VST + key0 + 8); v4u vw; vw.x = lo.x; vw.y = lo.y; vw.z = hi.x; vw.w = hi.y;
                  o1 = __builtin_amdgcn_mfma_f32_32x32x16_bf16(pa, __builtin_bit_cast(bf16x8, vw), o1, 0, 0, 0); } } }
        lrun += __shfl_xor(lrun, 32);
        const float linv = 1.0f / (lrun + __expf(snk - mx));
        if (hh == 0) wsf[wave * 64 + r32] = linv;
        LDS_WAIT(); asm volatile("" ::: "memory");
#pragma unroll
        for (int r = 0; r < 16; ++r) { const int row = (r & 3) + 8 * (r >> 2) + 4 * hh; const float li = wsf[wave * 64 + row];
            bf16* op = OA + ((size_t)b * T + qb * 128 + qo + row) * 512 + hq * 64;
            op[r32] = (bf16)f2bf(o0[r] * li); op[32 + r32] = (bf16)f2bf(o1[r] * li); }
        LDS_WAIT(); asm volatile("" ::: "memory");
    }
    __syncthreads();
}

__device__ __forceinline__ void pg_rows(const Frame& F, ArgsP A, bf16* wout) {
    const bf16* Z = (const bf16*)(A->ws + WS_Z); const bf16* Y0 = (const bf16*)(A->ws + WS_XN); const bf16* Y1 = Y0 + (size_t)M * 512;
    bf16* Gb = (bf16*)(A->ws + WS_G); const float* bonus = (const float*)(A->ws + WS_BONUS);
    const float* mu_prev = (const float*)A->in[7]; const float* mu_next = (const float*)A->in[8]; const float* gn_w = (const float*)A->in[17]; const float* gn_b = (const float*)A->in[18];
    const int gw = F.vcu * NWAVES + F.wave, NGW = F.G * NWAVES, lane = F.lane, c0 = lane * 8, h = lane >> 3;
    float mp[8], mn[8], gw_[8], gb_[8];
#pragma unroll
    for (int j = 0; j < 8; ++j) { mp[j] = mu_prev[ZV + c0 + j]; mn[j] = mu_next[ZV + c0 + j]; gw_[j] = gn_w[c0 + j]; gb_[j] = gn_b[c0 + j]; }
#pragma unroll 1
    for (int m0 = gw; m0 < M; m0 += 4 * NGW) {
        v4u y0[4], y1[4], gv[4], z0[4], zm[4], zq[4]; float bon[4];
#pragma unroll
        for (int i = 0; i < 4; ++i) { const int m = m0 + i * NGW, t = m & (T - 1);
            y0[i] = *(const GAS v4u*)(Y0 + (size_t)m * 512 + c0); y1[i] = *(const GAS v4u*)(Y1 + (size_t)m * 512 + c0); gv[i] = *(const GAS v4u*)(Gb + (size_t)m * 512 + c0);
            z0[i] = *(const GAS v4u*)(Z + (size_t)m * NZ + ZV + c0);
            zm[i] = (v4u){0u, 0u, 0u, 0u}; zq[i] = (v4u){0u, 0u, 0u, 0u};
            if (t > 0) zm[i] = *(const GAS v4u*)(Z + (size_t)(m - 1) * NZ + ZV + c0);
            if (t < T - 1) zq[i] = *(const GAS v4u*)(Z + (size_t)(m + 1) * NZ + ZV + c0);
            bon[i] = bonus[(size_t)m * 8 + h] + bonus[(size_t)M * 8 + (size_t)m * 8 + h]; }
#pragma unroll
        for (int i = 0; i < 4; ++i) { const int m = m0 + i * NGW;
            const unsigned y0w[4] = {y0[i].x, y0[i].y, y0[i].z, y0[i].w}, y1w[4] = {y1[i].x, y1[i].y, y1[i].z, y1[i].w}, gvw[4] = {gv[i].x, gv[i].y, gv[i].z, gv[i].w};
            const unsigned z0w[4] = {z0[i].x, z0[i].y, z0[i].z, z0[i].w}, zmw[4] = {zm[i].x, zm[i].y, zm[i].z, zm[i].w}, zqw[4] = {zq[i].x, zq[i].y, zq[i].z, zq[i].w};
            float y[8], gg[8], vv[8]; float sacc = 0.f;
#pragma unroll
            for (int j = 0; j < 4; ++j) { y[2 * j] = bflo(y0w[j]) + bflo(y1w[j]); y[2 * j + 1] = bfhi(y0w[j]) + bfhi(y1w[j]); gg[2 * j] = bflo(gvw[j]); gg[2 * j + 1] = bfhi(gvw[j]);
                const float a0 = bflo(z0w[j]), a1 = bfhi(z0w[j]);
                vv[2 * j] = a0 + mp[2 * j] * (bflo(zmw[j]) - a0) + mn[2 * j] * (bflo(zqw[j]) - a0); vv[2 * j + 1] = a1 + mp[2 * j + 1] * (bfhi(zmw[j]) - a1) + mn[2 * j + 1] * (bfhi(zqw[j]) - a1);
                sacc += y[2 * j] + y[2 * j + 1]; }
            sacc += __shfl_xor(sacc, 1); sacc += __shfl_xor(sacc, 2); sacc += __shfl_xor(sacc, 4);
            const float mu = sacc * (1.0f / 64.0f); float q = 0.f;
#pragma unroll
            for (int j = 0; j < 8; ++j) { const float d = y[j] - mu; q += d * d; }
            q += __shfl_xor(q, 1); q += __shfl_xor(q, 2); q += __shfl_xor(q, 4);
            const float rstd = rsqrtf(q * (1.0f / 64.0f) + 64e-5f);
            float o[8];
#pragma unroll
            for (int j = 0; j < 8; ++j) o[j] = ((y[j] - mu) * rstd * gw_[j] + gb_[j] + bon[i] * vv[j]) * gg[j];
            v4u w; w.x = pk2(o[0], o[1]); w.y = pk2(o[2], o[3]); w.z = pk2(o[4], o[5]); w.w = pk2(o[6], o[7]);
            *(GAS v4u*)(wout + (size_t)m * 512 + c0) = w; } }
}

__device__ __forceinline__ void pj_phase(const Frame& F, ArgsP A) {
    unsigned char* ws = A->ws;
    const int gw = F.vcu * NWAVES + F.wave, NGW = F.G * NWAVES, lane = F.lane;
    { LAS float* scr = (LAS float*)(F.lds + F.wave * 16384);
      const float* w_gate = (const float*)A->in[27]; const float* w_up = (const float*)A->in[28]; const float* w_down = (const float*)A->in[29];
      bf16* WguT = (bf16*)((unsigned char*)A->out + OUT_WGUT); bf16* WdT = (bf16*)((unsigned char*)A->out + OUT_WDT);
      constexpr int PER = 512, NIT = 16 * 3 * PER;
      for (int it = gw; it < NIT; it += NGW) { const int e = it / (3 * PER), r = it % (3 * PER), which = r / PER, q = r % PER, kb = q >> 5, nb = q & 31, n0 = 32 * nb;
          if (which == 0) tr_item(w_gate + (size_t)e * 1048576, 1024, 64 * kb, n0, WguT, 1024, e * 2048 + (n0 >> 7) * 256 + (n0 & 127), scr, lane);
          else if (which == 1) tr_item(w_up + (size_t)e * 1048576, 1024, 64 * kb, n0, WguT, 1024, e * 2048 + (n0 >> 7) * 256 + 128 + (n0 & 127), scr, lane);
          else tr_item(w_down + (size_t)e * 1048576, 1024, 64 * kb, n0, WdT, 1024, e * 1024 + n0, scr, lane); }
    }
    __syncthreads();
    const float* w_router = (const float*)A->in[26]; const bf16* x1 = (const bf16*)(ws + WS_X1); const float* g2n = (const float*)A->in[25]; const float* mod = (const float*)(ws + WS_MOD);
    bf16* XN2 = (bf16*)(ws + WS_XN); float* aff = (float*)(ws + WS_AFF);
    LAS bf16* WF = (LAS bf16*)F.lds;
    LAS float* AT = (LAS float*)(F.lds + 65536); LAS float* BT = AT + 1024; LAS float* CB = BT + 1024;
    const int tile = gw, b = tile >> 7;
    for (int d = F.tid; d < 1024; d += 512) { AT[d] = g2n[d] * (1.0f + mod[(size_t)b * 6144 + 4096 + d]); BT[d] = mod[(size_t)b * 6144 + 3072 + d]; }
    __syncthreads();
#pragma unroll 4
    for (int k = 0; k < 32; ++k) { const int it = F.tid + 512 * k, jj = it & 7, ln = (it >> 3) & 63, sI = it >> 9, q = ln >> 4, e = ln & 15, d = 32 * sI + 8 * q + jj;
        const float v = AT[d] * w_router[d * 16 + e]; const unsigned hi = pk2(v, 0.f) & 0xffffu; const float lo = v - __uint_as_float(hi << 16);
        WF[it] = (bf16)hi; WF[16384 + it] = (bf16)(pk2(lo, 0.f) & 0xffffu); }
    { float c0 = 0.f, c1 = 0.f;
#pragma unroll 4
      for (int k = 0; k < 16; ++k) { const int d = lane + 64 * k; c0 += BT[d] * w_router[d * 16 + 2 * F.wave]; c1 += BT[d] * w_router[d * 16 + 2 * F.wave + 1]; }
      c0 = dpp_wave_sum(c0); c1 = dpp_wave_sum(c1); if (lane == 0) { CB[2 * F.wave] = c0; CB[2 * F.wave + 1] = c1; } }
    __syncthreads();
    if (tile < M / 16) { const int r = lane & 15, q = lane >> 4; const size_t m = (size_t)tile * 16 + r;
        float ss = 0.f;
#pragma unroll 1
        for (int hf = 0; hf < 2; ++hf) { v4u raw[16];
#pragma unroll
            for (int sI = 0; sI < 16; ++sI) raw[sI] = *(const GAS v4u*)(x1 + m * 1024 + 32 * (16 * hf + sI) + 8 * q);
#pragma unroll
            for (int sI = 0; sI < 16; ++sI) { const v4u w = raw[sI]; const float a0 = bflo(w.x), a1 = bfhi(w.x), a2 = bflo(w.y), a3 = bfhi(w.y), a4 = bflo(w.z), a5 = bfhi(w.z), a6 = bflo(w.w), a7 = bfhi(w.w);
                ss += (a0 * a0 + a1 * a1) + (a2 * a2 + a3 * a3) + (a4 * a4 + a5 * a5) + (a6 * a6 + a7 * a7); } }
        ss += __shfl_xor(ss, 16); ss += __shfl_xor(ss, 32);
        const float rs = rsqrtf(ss * (1.0f / 1024.0f) + 1e-6f);
        f32x4 ah = {0.f, 0.f, 0.f, 0.f}, al = {0.f, 0.f, 0.f, 0.f};
#pragma unroll 1
        for (int hf = 0; hf < 2; ++hf) { v4u raw[16];
#pragma unroll
            for (int sI = 0; sI < 16; ++sI) raw[sI] = *(const GAS v4u*)(x1 + m * 1024 + 32 * (16 * hf + sI) + 8 * q);
#pragma unroll
            for (int sI = 0; sI < 16; ++sI) { const int sg = 16 * hf + sI; const bf16x8 xa = __builtin_bit_cast(bf16x8, raw[sI]);
                const bf16x8 bh = *(const LAS bf16x8*)(WF + (sg * 64 + lane) * 8), bl = *(const LAS bf16x8*)(WF + 16384 + (sg * 64 + lane) * 8);
                ah = __builtin_amdgcn_mfma_f32_16x16x32_bf16(xa, bh, ah, 0, 0, 0); al = __builtin_amdgcn_mfma_f32_16x16x32_bf16(xa, bl, al, 0, 0, 0); }
#pragma unroll
            for (int sI = 0; sI < 16; ++sI) { if ((sI & 3) == 0) asm volatile("" ::: "memory");
                const int d0 = 32 * (16 * hf + sI) + 8 * q; const v4u w = raw[sI];
                const f32x4 a0 = *(const LAS f32x4*)(AT + d0), a1 = *(const LAS f32x4*)(AT + d0 + 4), b0 = *(const LAS f32x4*)(BT + d0), b1 = *(const LAS f32x4*)(BT + d0 + 4);
                v4u o; o.x = pk2(bflo(w.x) * rs * a0.x + b0.x, bfhi(w.x) * rs * a0.y + b0.y); o.y = pk2(bflo(w.y) * rs * a0.z + b0.z, bfhi(w.y) * rs * a0.w + b0.w);
                o.z = pk2(bflo(w.z) * rs * a1.x + b1.x, bfhi(w.z) * rs * a1.y + b1.y); o.w = pk2(bflo(w.w) * rs * a1.z + b1.z, bfhi(w.w) * rs * a1.w + b1.w);
                *(GAS v4u*)(XN2 + m * 1024 + d0) = o; } }
        const float cb = CB[lane & 15]; float lg[4], mx[4], ex[4], den[4];
#pragma unroll
        for (int i = 0; i < 4; ++i) { const float rsr = __shfl(rs, 4 * q + i); lg[i] = rsr * (ah[i] + al[i]) + cb; mx[i] = lg[i]; }
#pragma unroll
        for (int o = 1; o < 16; o <<= 1)
#pragma unroll
            for (int i = 0; i < 4; ++i) mx[i] = fmaxf(mx[i], __shfl_xor(mx[i], o));
#pragma unroll
        for (int i = 0; i < 4; ++i) { ex[i] = expf(lg[i] - mx[i]); den[i] = ex[i]; }
#pragma unroll
        for (int o = 1; o < 16; o <<= 1)
#pragma unroll
            for (int i = 0; i < 4; ++i) den[i] += __shfl_xor(den[i], o);
        { const int t0 = (tile & 127) * 16 + 4 * q; f32x4 av; av.x = ex[0] / den[0]; av.y = ex[1] / den[1]; av.z = ex[2] / den[2]; av.w = ex[3] / den[3];
          *(GAS f32x4*)(aff + ((size_t)b * 16 + (lane & 15)) * T + t0) = av; } }
}

__device__ __forceinline__ void pk_task(const Frame& F, ArgsP A, int b, int e) {
    unsigned char* ws = A->ws;
    const float* aff = (const float*)(ws + WS_AFF) + ((size_t)b * 16 + e) * T;
    int* slotmap = (int*)(ws + WS_SLOT); float* selaff = (float*)(ws + WS_SELAFF); int* selidx = (int*)(ws + WS_SELIDX);
    const bf16* XN2 = (const bf16*)(ws + WS_XN); bf16* XE = (bf16*)(ws + WS_XE);
    LAS unsigned* cnt = (LAS unsigned*)F.lds;
    LAS int* tokl = (LAS int*)(F.lds + 256);
    const int tid = F.tid, lane = F.lane, wave = F.wave;
    const f32x4 v4 = *(const GAS f32x4*)(aff + 4 * tid);
    const unsigned key[4] = {__float_as_uint(v4.x), __float_as_uint(v4.y), __float_as_uint(v4.z), __float_as_uint(v4.w)};
    unsigned thr = 0u;
#pragma unroll 1
    for (int bit = 31; bit >= 0; --bit) { const unsigned cand = thr | (1u << bit);
        const unsigned c = (unsigned)(__popcll(__ballot(key[0] >= cand)) + __popcll(__ballot(key[1] >= cand)) + __popcll(__ballot(key[2] >= cand)) + __popcll(__ballot(key[3] >= cand)));
        LAS unsigned* slot_ = cnt + 16 + (bit & 1) * 8;
        if (lane == 0) slot_[wave] = c;
        __syncthreads();
        unsigned tot = 0;
#pragma unroll
        for (int w = 0; w < 8; ++w) tot += slot_[w];
        if (tot >= 256u) thr = cand; }
    __syncthreads();
    int ngt = 0, neq = 0;
#pragma unroll
    for (int j = 0; j < 4; ++j) { ngt += key[j] > thr; neq += key[j] == thr; }
    int sg = ngt, se = neq;
#pragma unroll
    for (int o = 1; o < 64; o <<= 1) { const int a = __shfl_up(sg, o), c = __shfl_up(se, o); if (lane >= o) { sg += a; se += c; } }
    if (lane == 63) { cnt[wave] = (unsigned)sg; cnt[8 + wave] = (unsigned)se; }
    __syncthreads();
    int bg = 0, be = 0, totg = 0;
#pragma unroll
    for (int w = 0; w < 8; ++w) { const int a = (int)cnt[w], c = (int)cnt[8 + w]; if (w < wave) { bg += a; be += c; } totg += a; }
    int pg = bg + sg - ngt, pe = be + se - neq;
    const int need_eq = 256 - totg;
    int* smrow = slotmap + ((size_t)b * T + 4 * tid) * 16 + e;
#pragma unroll
    for (int j = 0; j < 4; ++j) { int slot = -1;
        if (key[j] > thr) { slot = pg; ++pg; } else if (key[j] == thr) { if (pe < need_eq) slot = totg + pe; ++pe; }
        smrow[j * 16] = slot;
        if (slot >= 0) { selidx[((size_t)e * 16 + b) * 256 + slot] = b * T + 4 * tid + j; selaff[((size_t)e * 16 + b) * 256 + slot] = __uint_as_float(key[j]); } }
    __syncthreads();
}

__device__ __forceinline__ void pn_rows(const Frame& F, ArgsP A, float* wout) {
    unsigned char* ws = A->ws;
    const int* slotmap = (const int*)(ws + WS_SLOT); const bf16* YE = (const bf16*)(ws + WS_XE); const float* mod = (const float*)(ws + WS_MOD); const bf16* X1 = (const bf16*)(ws + WS_X1);
    const int gw = F.vcu * NWAVES + F.wave, NGW = F.G * NWAVES, lane = F.lane;
#pragma unroll 1
    for (int m0 = gw * 16; m0 < gw * 16 + 16; m0 += 2) {
        int myslot[2]; f32x4 xv[2][4];
#pragma unroll
        for (int i = 0; i < 2; ++i) { const int m = m0 + i; myslot[i] = slotmap[(size_t)m * 16 + (lane & 15)];
#pragma unroll
            for (int hq = 0; hq < 2; ++hq) { const v4u w = *(const GAS v4u*)(X1 + (size_t)m * 1024 + hq * 512 + lane * 8);
                xv[i][2 * hq] = (f32x4){bflo(w.x), bfhi(w.x), bflo(w.y), bfhi(w.y)}; xv[i][2 * hq + 1] = (f32x4){bflo(w.z), bfhi(w.z), bflo(w.w), bfhi(w.w)}; } }
        unsigned long long msk[2]; v4u yw[2][4][2];
#pragma unroll
        for (int i = 0; i < 2; ++i) { const int b = (m0 + i) >> 11; msk[i] = __ballot(myslot[i] >= 0) & 0xffffull;
#pragma unroll
            for (int k = 0; k < 4; ++k) { const bool has = msk[i] != 0ull; const int e = has ? __builtin_ctzll(msk[i]) : 0; if (has) msk[i] &= msk[i] - 1; const int sl = __shfl(myslot[i], e);
                yw[i][k][0] = (v4u){0u, 0u, 0u, 0u}; yw[i][k][1] = (v4u){0u, 0u, 0u, 0u};
                if (has) { const GAS v4u* yr = (const GAS v4u*)(YE + (((size_t)e * 16 + b) * 256 + sl) * 1024); yw[i][k][0] = yr[lane]; yw[i][k][1] = yr[64 + lane]; } } }
#pragma unroll
        for (int i = 0; i < 2; ++i) { const int m = m0 + i, b = m >> 11;
            float acc[16];
#pragma unroll
            for (int j = 0; j < 16; ++j) acc[j] = 0.f;
#pragma unroll
            for (int k = 0; k < 4; ++k)
#pragma unroll
                for (int hlf = 0; hlf < 2; ++hlf) { const v4u w = yw[i][k][hlf];
                    acc[hlf * 8 + 0] += bflo(w.x); acc[hlf * 8 + 1] += bfhi(w.x); acc[hlf * 8 + 2] += bflo(w.y); acc[hlf * 8 + 3] += bfhi(w.y);
                    acc[hlf * 8 + 4] += bflo(w.z); acc[hlf * 8 + 5] += bfhi(w.z); acc[hlf * 8 + 6] += bflo(w.w); acc[hlf * 8 + 7] += bfhi(w.w); }
            unsigned long long mk = msk[i];
            while (mk) { const int e = __builtin_ctzll(mk); mk &= mk - 1; const int sl = __shfl(myslot[i], e);
                const GAS v4u* yr = (const GAS v4u*)(YE + (((size_t)e * 16 + b) * 256 + sl) * 1024);
#pragma unroll
                for (int hlf = 0; hlf < 2; ++hlf) { const v4u w = yr[hlf * 64 + lane];
                    acc[hlf * 8 + 0] += bflo(w.x); acc[hlf * 8 + 1] += bfhi(w.x); acc[hlf * 8 + 2] += bflo(w.y); acc[hlf * 8 + 3] += bfhi(w.y);
                    acc[hlf * 8 + 4] += bflo(w.z); acc[hlf * 8 + 5] += bfhi(w.z); acc[hlf * 8 + 6] += bflo(w.w); acc[hlf * 8 + 7] += bfhi(w.w); } }
            const float* gt2 = mod + (size_t)b * 6144 + 5120; float* orow = wout + (size_t)m * 1024;
#pragma unroll
            for (int q = 0; q < 4; ++q) { const int c = (q >> 1) * 512 + lane * 8 + (q & 1) * 4; const f32x4 g = *(const GAS f32x4*)(gt2 + c);
                f32x4 a; a.x = acc[(q >> 1) * 8 + (q & 1) * 4 + 0]; a.y = acc[(q >> 1) * 8 + (q & 1) * 4 + 1]; a.z = acc[(q >> 1) * 8 + (q & 1) * 4 + 2]; a.w = acc[(q >> 1) * 8 + (q & 1) * 4 + 3];
                *(GAS f32x4*)(orow + c) = xv[i][q] + g * a; } } }
}

__device__ __forceinline__ void mk_frame(Frame& F, LAS unsigned char* lds, int wave_s) {
    int bx = blockIdx.x, G = gridDim.x; LAUNDER(bx); LAUNDER(G);
    F.lds = lds; F.MISC = (volatile LAS unsigned*)(lds + MISC_OFF); F.ctl = nullptr;
    unsigned ones_ = ~0u; asm volatile("" : "+s"(ones_));
    int lane_ = (int)__builtin_amdgcn_mbcnt_hi(ones_, __builtin_amdgcn_mbcnt_lo(ones_, 0u)); asm volatile("" : "+v"(lane_));
    F.lane = lane_; F.wave = wave_s; F.tid = wave_s * 64 + lane_;
    F.G = G; F.vcu = (G % 8 == 0) ? (bx % 8) * (G / 8) + bx / 8 : bx;
}
__global__ void __launch_bounds__(NWAVES * 64, 2) fwd_kernel(Args args) {
    extern __shared__ __attribute__((aligned(16))) unsigned char lds[];
    LAS unsigned char* const ldsb = (LAS unsigned char*)lds;
    ArgsP ap0 = (ArgsP)__builtin_amdgcn_kernarg_segment_ptr();
    int wave_s = __builtin_amdgcn_readfirstlane((int)threadIdx.x >> 6); asm volatile("" : "+s"(wave_s));
    for (int u = threadIdx.x; u < (LDS_BYTES - LDSCTL_OFF) / 4; u += NWAVES * 64) ((LAS unsigned*)(ldsb + LDSCTL_OFF))[u] = 0u;
    __syncthreads();
#define MKBAR XcdBarrier bar; { ArgsP a_ = ap0; LAUNDER(a_); bar.bar = (unsigned*)(a_->ws + WS_CTL) + CW_BAR; bar.x = xb_xcc_id(); bar.st = (volatile LAS unsigned*)(ldsb + MISC_OFF) + 8; }
#if ONE_LAUNCH
    { MKBAR; if (threadIdx.x == 0) (void)xb_add(&bar.bar[XB_XCNT(bar.x)], 1u); }
#ifndef PHM
#define PHM 0x3fff
#endif
#define IN(k) ((PHM >> (k)) & 1)
#define SEAM(k) do { if (IN(k) && IN((k) + 1)) { MKBAR; { unsigned o_ = ~0u; asm volatile("" : "+s"(o_)); xcd_barrier(bar, wave_s == 0 && __builtin_amdgcn_mbcnt_hi(o_, __builtin_amdgcn_mbcnt_lo(o_, 0u)) == 0u); } } } while (0)
#else
    int lo, hi; { ArgsP a = ap0; LAUNDER(a); lo = a->ph_lo; hi = a->ph_hi; }
#define IN(k) (lo <= (k) && (k) < hi)
#define SEAM(k) do { } while (0)
#endif
    typedef pg8::bf16_t pb;
#ifndef REPMASK
#define REPMASK 0
#endif
#define PHASE_ARGS ArgsP ap = ap0; LAUNDER(ap); unsigned char* ws = ap->ws; (void)ws; Frame F; mk_frame(F, ldsb, wave_s); const int gw = F.vcu * NWAVES + F.wave, NGW = F.G * NWAVES; (void)gw; (void)NGW
    if (IN(0)) _Pragma("unroll 1") for (int rep_ = 0; rep_ <= ((REPMASK >> 0) & 1); ++rep_) { PHASE_ARGS; p0_prologue(F, ap); } SEAM(0);
    if (IN(1)) _Pragma("unroll 1") for (int rep_ = 0; rep_ <= ((REPMASK >> 1) & 1); ++rep_) { PHASE_ARGS; const float* x = (const float*)ap->in[0]; const float* g1 = (const float*)ap->in[5]; const float* mod = (const float*)(ws + WS_MOD); bf16* XN = (bf16*)(ws + WS_XN);
#pragma unroll 1
        for (int wv = gw; wv < M / 16; wv += NGW) {
#pragma unroll 1
          for (int k4 = 0; k4 < 4; ++k4) { const int m = wv * 16 + 4 * k4; f32x4 u[4][4]; modnorm_rows<4, false>(x, m, 1, g1, mod, 0, 1024, XN, F.lane, u);
            if (F.lane < 32) { const int mm = m + (F.lane >> 3), j = F.lane & 7; const float pos = (float)((const int*)ap->in[2])[mm];
                const float ang = pos * __expf(-(float)j * 0.125f * 13.122363377404328f); const float sn = __sinf(ang), cs = __cosf(ang);
                bf16* rt = (bf16*)(ws + WS_ROPE) + (size_t)mm * 16; rt[j] = (bf16)(pk2(cs, 0.f) & 0xffffu); rt[8 + j] = (bf16)(pk2(sn, 0.f) & 0xffffu); } } } } SEAM(1);
    if (IN(2)) _Pragma("unroll 1") for (int rep_ = 0; rep_ <= ((REPMASK >> 2) & 1); ++rep_) { PHASE_ARGS; pg8::Gemm g{(const pb*)(ws + WS_XN), (const pb*)(ws + WS_WINT), M, NZP, D}; pg8::StaticOrder S; S.init(M, NZP, F.G, (int)blockIdx.x);
        pg8::EpiZ E{(pb*)(ws + WS_Z)}; pg8::gemm_phase<pg8::EpiZ, pg8::StaticOrder, true, true>(F.lds, g, S, E, F.tid); } SEAM(2);
    if (IN(3)) {
#ifndef REP_SCAN
#define REP_SCAN 1
#endif
#ifndef REP_ATTN
#define REP_ATTN 1
#endif
      { int c0_, G_; { Frame F0; mk_frame(F0, ldsb, wave_s); c0_ = F0.vcu; G_ = F0.G; }
#pragma unroll 1
        for (int c = c0_; c < 256 * REP_SCAN; c += G_) { PHASE_ARGS; const int b = (c >> 4) & 15, h = (c >> 1) & 7, dir = c & 1;
            scan2_setup(F.lds, (const GAS float*)ap->in[10], (const GAS float*)ap->in[12], h, dir, F.tid); __syncthreads();
            const ScanArgs SA{(const GAS bf16*)(ws + WS_Z), (const GAS float*)ap->in[7], (const GAS float*)ap->in[8], (const GAS float*)ap->in[9], (const GAS float*)ap->in[11], (const GAS float*)ap->in[14], (const GAS float*)ap->in[15], (const GAS float*)ap->in[16],
                              (GAS bf16*)(ws + WS_XN) + (size_t)dir * M * 512, (GAS float*)(ws + WS_BONUS) + (size_t)dir * M * 8};
#pragma unroll 1
            for (int cc = F.wave; cc < T / 32; cc += 8) scan2_chunk(F.lds, SA, b, h, dir, cc, F.lane, F.wave);
            __syncthreads(); } }
      { PHASE_ARGS;
#pragma unroll 1
        for (int u = F.vcu; u < 512 * REP_ATTN; u += F.G) { attn_unit(F, ap, (u >> 5) & 15, (u >> 4) & 1, u & 15); } }
      { PHASE_ARGS;
        const bf16* Z = (const bf16*)(ws + WS_Z); bf16* SGD = (bf16*)(ws + WS_SGD); const float* mu_prev = (const float*)ap->in[7]; const float* mu_next = (const float*)ap->in[8];
          const int c = ZGD + 2 * F.lane; const float mp0 = mu_prev[c], mp1 = mu_prev[c + 1], mn0 = mu_next[c], mn1 = mu_next[c + 1];
#ifndef REP_SGD
#define REP_SGD 1
#endif
          const int tile = F.vcu;
          if (tile < 256) { const int pm = tile >> 1, pn = tile & 1; constexpr int RS = 136;
              LAS bf16* SG = (LAS bf16*)F.lds; LAS bf16* GT = (LAS bf16*)(F.lds + 256 * RS * 2);
              __syncthreads();
              const int mt0 = pm * 256 + F.wave * 32;
#pragma unroll 1
              for (int m0 = 0; m0 < 32; m0 += 4) { unsigned z0[4], zm[4], zq[4];
#pragma unroll
                  for (int i = 0; i < 4; ++i) { const int m = mt0 + m0 + i, t = m & (T - 1);
                      z0[i] = *(const GAS unsigned*)(Z + (size_t)m * NZ + c); zm[i] = t > 0 ? *(const GAS unsigned*)(Z + (size_t)(m - 1) * NZ + c) : 0u; zq[i] = t < T - 1 ? *(const GAS unsigned*)(Z + (size_t)(m + 1) * NZ + c) : 0u; }
#pragma unroll
                  for (int i = 0; i < 4; ++i) { const float a0 = bflo(z0[i]), a1 = bfhi(z0[i]); const float s0 = a0 + mp0 * (bflo(zm[i]) - a0) + mn0 * (bflo(zq[i]) - a0), s1 = a1 + mp1 * (bfhi(zm[i]) - a1) + mn1 * (bfhi(zq[i]) - a1);
                      *(LAS unsigned*)(SG + (F.wave * 32 + m0 + i) * RS + 2 * F.lane) = pk2(sigm(s0), sigm(s1)); } }
              __syncthreads();
              const int r32 = F.lane & 31, hh = F.lane >> 5; bf16x8 af[8];
#pragma unroll
              for (int sI = 0; sI < 8; ++sI) af[sI] = *(const LAS bf16x8*)(SG + (F.wave * 32 + r32) * RS + 16 * sI + 8 * hh);
              bf16* Gout = (bf16*)(ws + WS_G); const bf16* G2T = (const bf16*)(ws + WS_G2T);
#pragma unroll 1
              for (int hf = 0; hf < 2; ++hf) {
#pragma unroll
                  for (int i = 0; i < 4; ++i) { const int e = F.tid + 512 * i, rr = e >> 4, ch = e & 15; *(LAS v4u*)(GT + rr * RS + ch * 8) = *(const GAS v4u*)(G2T + (size_t)(256 * pn + 128 * hf + rr) * 256 + ch * 8); }
                  __syncthreads();
#pragma unroll 1
                  for (int ct = 0; ct < 4; ++ct) { f32x16 acc = {};
#pragma unroll
                      for (int sI = 0; sI < 8; ++sI) { const bf16x8 bfr = *(const LAS bf16x8*)(GT + (32 * ct + r32) * RS + 16 * sI + 8 * hh); acc = __builtin_amdgcn_mfma_f32_32x32x16_bf16(af[sI], bfr, acc, 0, 0, 0); }
#pragma unroll
                      for (int g = 0; g < 16; ++g) { const int row = (g & 3) + 8 * (g >> 2) + 4 * hh;
                          Gout[(size_t)(mt0 + row) * 512 + 256 * pn + 128 * hf + 32 * ct + r32] = (bf16)(pk2(acc[g], 0.f) & 0xffffu); } }
                  __syncthreads(); } } }
    } SEAM(4);
#ifndef REP_PG
#define REP_PG 0
#endif
    if (IN(5)) { PHASE_ARGS; if (REP_PG) pg_rows(F, ap, (bf16*)ap->out); pg_rows(F, ap, (bf16*)(ws + WS_G)); } SEAM(5);
    if (IN(6)) { PHASE_ARGS; static_assert(WS_G == WS_OATT + (size_t)M * 512 * 2 && WS_PAT == WS_PRT + (size_t)1024 * 512 * 2, "merged operand views need adjacent buffers");
        pg8::Gemm g{(const pb*)(ws + WS_OATT), (const pb*)(ws + WS_PRT), 2 * M, 2048, 512}; pg8::MergeOrder S; S.init(F.G, (int)blockIdx.x);
        pg8::EpiGate2 E{(pb*)(ws + WS_XN), (const pb*)(ws + WS_Z)}; pg8::gemm_phase<pg8::EpiGate2, pg8::MergeOrder, true, true>(F.lds, g, S, E, F.tid); } SEAM(7);
    if (IN(8)) _Pragma("unroll 1") for (int rep_ = 0; rep_ <= ((REPMASK >> 8) & 1); ++rep_) { PHASE_ARGS; pg8::Gemm g{(const pb*)(ws + WS_XN), (const pb*)(ws + WS_WOT), M, 1024, 1024}; pg8::StaticOrder S; S.init(M, 1024, F.G, (int)blockIdx.x);
        pg8::EpiRes E{(const float*)ap->in[0], (const float*)(ws + WS_MOD), (pb*)(ws + WS_X1)}; pg8::gemm_phase<pg8::EpiRes, pg8::StaticOrder, true, true>(F.lds, g, S, E, F.tid); } SEAM(8);
    if (IN(9)) _Pragma("unroll 1") for (int rep_ = 0; rep_ <= ((REPMASK >> 9) & 1); ++rep_) { PHASE_ARGS; pj_phase(F, ap); } SEAM(9);
    if (IN(10)) _Pragma("unroll 1") for (int rep_ = 0; rep_ <= ((REPMASK >> 10) & 1); ++rep_) { PHASE_ARGS; for (int p = F.vcu; p < 256; p += F.G) pk_task(F, ap, p >> 4, p & 15); } SEAM(10);
    if (IN(11)) _Pragma("unroll 1") for (int rep_ = 0; rep_ <= ((REPMASK >> 11) & 1); ++rep_) { PHASE_ARGS; pg8::Gemm g{(const pb*)(ws + WS_XN), (const pb*)((unsigned char*)ap->out + OUT_WGUT), ME, 16 * 2048, 1024}; pg8::GroupOrder<8> S{F.G, (int)blockIdx.x};
        pg8::EpiSwiglu E{(pb*)(ws + WS_H)}; pg8::gemm_phase<pg8::EpiSwiglu, pg8::GroupOrder<8>, true, true, true>(F.lds, g, S, E, F.tid, (const int*)(ws + WS_SELIDX)); } SEAM(11);
    if (IN(12)) _Pragma("unroll 1") for (int rep_ = 0; rep_ <= ((REPMASK >> 12) & 1); ++rep_) { PHASE_ARGS; pg8::Gemm g{(const pb*)(ws + WS_H), (const pb*)((unsigned char*)ap->out + OUT_WDT), ME, 16 * 1024, 1024}; pg8::GroupOrder<4> S{F.G, (int)blockIdx.x};
        pg8::EpiDown E{(pb*)(ws + WS_XE), (const float*)(ws + WS_SELAFF)}; pg8::gemm_phase<pg8::EpiDown, pg8::GroupOrder<4>, true, true>(F.lds, g, S, E, F.tid); } SEAM(12);
#ifndef EXTRA_BARS
#define EXTRA_BARS 0
#endif
#if ONE_LAUNCH
    _Pragma("unroll 1") for (int xb_ = 0; xb_ < EXTRA_BARS; ++xb_) { MKBAR; { unsigned o_ = ~0u; asm volatile("" : "+s"(o_)); xcd_barrier(bar, wave_s == 0 && __builtin_amdgcn_mbcnt_hi(o_, __builtin_amdgcn_mbcnt_lo(o_, 0u)) == 0u); } }
#endif
#ifndef REP_PN
#define REP_PN 0
#endif
    if (IN(13)) { PHASE_ARGS; if (REP_PN) pn_rows(F, ap, (float*)(ws + WS_H)); pn_rows(F, ap, ap->out); }
#undef IN
#undef SEAM
}

extern "C" void kernel_launch(void* const* d_in, const int* in_sizes, int n_in, void* d_out, int out_size, void* d_ws, size_t ws_size, hipStream_t stream) {
    static int grid = 0;
    if (grid == 0) {
        if (n_in != 30 || out_size != M * D || ws_size < WS_END) { fprintf(stderr, "kernel_launch: unexpected shapes n_in %d out %d ws %zu\n", n_in, out_size, ws_size); grid = -1; return; }
        int dev = 0, cus = 0, per_cu = 0;
        if (hipGetDevice(&dev) != hipSuccess || hipDeviceGetAttribute(&cus, hipDeviceAttributeMultiprocessorCount, dev) != hipSuccess) { grid = -1; return; }
        if (hipFuncSetAttribute((const void*)fwd_kernel, hipFuncAttributeMaxDynamicSharedMemorySize, LDS_BYTES) != hipSuccess) { fprintf(stderr, "kernel_launch: hipFuncSetAttribute failed\n"); grid = -1; return; }
        if (hipOccupancyMaxActiveBlocksPerMultiprocessor(&per_cu, (const void*)fwd_kernel, NWAVES * 64, LDS_BYTES) != hipSuccess || per_cu < 1) fprintf(stderr, "kernel_launch: occupancy query reports %d\n", per_cu);
        (void)hipGetLastError();
        grid = cus;
    }
    if (grid < 0) return;
    if (hipMemsetAsync((char*)d_ws + WS_CTL, 0, CTL_ZERO_BYTES, stream) != hipSuccess) return;
    Args a{};
    for (int i = 0; i < 30; ++i) a.in[i] = d_in[i];
    a.out = (float*)d_out; a.ws = (unsigned char*)d_ws;
#if ONE_LAUNCH
    a.ph_lo = 0; a.ph_hi = NPHASE;
    hipLaunchKernelGGL(fwd_kernel, dim3(grid), dim3(NWAVES * 64), LDS_BYTES, stream, a);
#else
    for (int p = 0; p < NPHASE; ++p) { a.ph_lo = p; a.ph_hi = p + 1; hipLaunchKernelGGL(fwd_kernel, dim3(grid), dim3(NWAVES * 64), LDS_BYTES, stream, a); }
#endif
}
```

```cpp
#include <hip/hip_runtime.h>
#include <cstdio>
#include <cstdint>
#include <cmath>
namespace pg8 {
#define PG8_LAS __attribute__((address_space(3)))
typedef unsigned short bf16_t;
typedef short bf16x8 __attribute__((ext_vector_type(8)));
typedef float f32x4 __attribute__((ext_vector_type(4)));
typedef unsigned u32x4 __attribute__((ext_vector_type(4)));
constexpr int BM = 256, BK = 64, HALF = 128, HTB = HALF * BK * 2  , STAGE_BYTES = 8 * HTB, NXCD = 8, WGM = 4;

__host__ __device__ __forceinline__ int lds_byte(int r, int c) { const int st = (r >> 4) * 2 + (c >> 5), rr = r & 15, cc = c & 31, ob = rr * 64 + cc * 2; return st * 1024 + (ob ^ (((ob >> 9) & 1) << 5)); }
__host__ __device__ __forceinline__ void stage_rc(int b, int& R, int& C) { const int st = b / 1024, sb = b % 1024, swz = sb ^ (((sb >> 9) & 1) << 5); R = (st >> 1) * 16 + swz / 64; C = (st & 1) * 32 + (swz % 64) / 2; }
__host__ __device__ __forceinline__ int perm32(int rho) { const int n = rho >> 4, i = rho & 15; return 8 * (i >> 2) + 4 * n + (i & 3); }

struct Unit { int pm, pn; };
struct Gemm { const bf16_t* A; const bf16_t* Bt; int M, N, K; };

struct StaticOrder {
    int nM, nN, nwg, G, c;
    __host__ __device__ void init(int M, int N, int G_, int c_) { nM = M / BM; nN = N / BM; nwg = nM * nN; G = G_; c = c_; }
    __host__ __device__ bool next(int i, Unit& u) const {
        const long L = (long)i * G + c; if (L >= nwg) return false;
        int wgid = (int)L; { const int q = nwg / NXCD, r = nwg % NXCD, xcd = wgid % NXCD, off = wgid / NXCD; wgid = (xcd < r ? xcd * (q + 1) : r * (q + 1) + (xcd - r) * q) + off; }
        const int nig = WGM * nN, gid = wgid / nig, fm = gid * WGM, gsz = (nM - fm) < WGM ? (nM - fm) : WGM;
        u.pm = fm + ((wgid % nig) % gsz); u.pn = (wgid % nig) / gsz; return true;
    }
    __device__ __forceinline__ void a_ready(const Unit&) const {}
    __device__ __forceinline__ void done(const Unit&) const {}
};

__device__ __forceinline__ unsigned cvt_pk_bf16(float lo, float hi) { unsigned r; asm volatile("v_cvt_pk_bf16_f32 %0, %1, %2" : "=v"(r) : "v"(lo), "v"(hi)); return r; }
typedef float f32x2 __attribute__((ext_vector_type(2)));
template <class Epi, class Sched, bool ALIGN_EPI = false, bool SP2 = false, bool GATHER = false>
__device__ __forceinline__ void gemm_phase(PG8_LAS unsigned char* lds, const Gemm g, const Sched& S, const Epi& E, int tid_in, const int* gidx = nullptr) {
    static_assert(!GATHER || SP2, "the gather variant is written for the SP2 loop");
    int tid_ = tid_in; asm volatile("" : "+v"(tid_));
    const int tid = tid_, wid = __builtin_amdgcn_readfirstlane(tid >> 6), lane = tid & 63, wr = wid >> 2, wc = wid & 3, fr = lane & 15, fq = lane >> 4;
    const int K = g.K, nt = K / BK;
    unsigned voffA[2], voffB[2];
#pragma unroll
    for (int i = 0; i < 2; ++i) { int R, C; stage_rc(tid * 16 + i * 8192, R, C); const int Rb = Epi::PERM ? ((R & ~31) + perm32(R & 31)) : R;
        voffA[i] = (unsigned)(R * K + C) * 2u; voffB[i] = (unsigned)(Rb * K + C) * 2u; }
    int gRA[2] = {0, 0}; unsigned gCA[2] = {0u, 0u}; unsigned gc[2][2] = {{0u, 0u}, {0u, 0u}}, gn[2][2] = {{0u, 0u}, {0u, 0u}};
    if constexpr (GATHER) {
#pragma unroll
        for (int i = 0; i < 2; ++i) { int R, C; stage_rc(tid * 16 + i * 8192, R, C); gRA[i] = R; gCA[i] = (unsigned)C * 2u; } }
#define PG8_GLOAD(dst, un) do { _Pragma("unroll") for (int h_ = 0; h_ < 2; ++h_) _Pragma("unroll") for (int i_ = 0; i_ < 2; ++i_) \
        dst[h_][i_] = (unsigned)gidx[(un).pm * 256 + h_ * 128 + gRA[i_]] * (unsigned)(K * 2) + gCA[i_]; } while (0)
#define PG8_STAGE_G(bufoff, gbase, nx, h) do { unsigned vo_[2] = {(nx) ? gn[h][0] : gc[h][0], (nx) ? gn[h][1] : gc[h][1]}; PG8_STAGE(bufoff, gbase, vo_); } while (0)
    const size_t kstep = (size_t)(BK * 2);
    const size_t hstep = (size_t)HALF * K * 2;
    const size_t tstep = 2 * hstep;
    const unsigned ldsw = (unsigned)wid * 1024u;
    const int aoff = lds_byte(wr * 64 + fr, fq * 8), boff = lds_byte(wc * 32 + fr, fq * 8);
#define PG8_SA(b, h) (((b) * 2 + (h)) * HTB)
#define PG8_SB(b, h) ((4 + (b) * 2 + (h)) * HTB)
#define PG8_STAGE(bufoff, gbase, voff) do { _Pragma("unroll") for (int _i = 0; _i < 2; ++_i) \
        __builtin_amdgcn_global_load_lds((const unsigned*)((const char*)(gbase) + (voff)[_i]), (PG8_LAS unsigned*)(lds + (bufoff) + ldsw + _i * 8192), 16, 0, 0); } while (0)
#define PG8_LDA(dst, b, h) do { _Pragma("unroll") for (int m = 0; m < 4; ++m) _Pragma("unroll") for (int k = 0; k < 2; ++k) dst[m][k] = *(const PG8_LAS bf16x8*)(lds + PG8_SA(b, h) + aoff + m * 2048 + k * 1024); } while (0)
#define PG8_LDB(dst, b, h) do { _Pragma("unroll") for (int n = 0; n < 2; ++n) _Pragma("unroll") for (int k = 0; k < 2; ++k) dst[n][k] = *(const PG8_LAS bf16x8*)(lds + PG8_SB(b, h) + boff + n * 2048 + k * 1024); } while (0)
#define PG8_MMA(ai, bj, At, Bt) do { __builtin_amdgcn_s_setprio(1); _Pragma("unroll") for (int m = 0; m < 4; ++m) _Pragma("unroll") for (int n = 0; n < 2; ++n) _Pragma("unroll") for (int k = 0; k < 2; ++k) \
        acc[ai][bj][m][n] = __builtin_amdgcn_mfma_f32_16x16x32_bf16(Bt[n][k], At[m][k], acc[ai][bj][m][n], 0, 0, 0); __builtin_amdgcn_s_setprio(0); } while (0)
#define PG8_WAIT_V(n) asm volatile("s_waitcnt vmcnt(" #n ")" ::: "memory")
#define PG8_WAIT_L(n) asm volatile("s_waitcnt lgkmcnt(" #n ")" ::: "memory")
#define PG8_BAR __builtin_amdgcn_s_barrier()
#define PG8_SCHED __builtin_amdgcn_sched_barrier(0)
    Unit cur, nxt; int ui = 0;
    if (!S.next(0, cur)) return;
    f32x4 acc[2][2][4][2];
#pragma unroll
    for (int a = 0; a < 2; ++a)
#pragma unroll
        for (int b = 0; b < 2; ++b)
#pragma unroll
            for (int m = 0; m < 4; ++m)
#pragma unroll
                for (int n = 0; n < 2; ++n) acc[a][b][m][n] = (f32x4){0.f, 0.f, 0.f, 0.f};
    bf16x8 At[4][2], B0[2][2], B1[2][2];
    const char* cA = GATHER ? (const char*)g.A : (const char*)g.A + (size_t)cur.pm * tstep; const char* cB = (const char*)g.Bt + (size_t)cur.pn * tstep;
    if constexpr (GATHER) { PG8_GLOAD(gc, cur); Unit n1_; if (S.next(1, n1_)) PG8_GLOAD(gn, n1_); else { gn[0][0] = gc[0][0]; gn[0][1] = gc[0][1]; gn[1][0] = gc[1][0]; gn[1][1] = gc[1][1]; } }
    S.a_ready(cur);
    if constexpr (SP2) {
        PG8_STAGE(PG8_SB(0, 0), cB, voffB); PG8_STAGE(PG8_SB(0, 1), cB + hstep, voffB);
        if constexpr (GATHER) { PG8_STAGE_G(PG8_SA(0, 0), cA, false, 0); PG8_STAGE_G(PG8_SA(0, 1), cA, false, 1); } else { PG8_STAGE(PG8_SA(0, 0), cA, voffA); PG8_STAGE(PG8_SA(0, 1), cA + hstep, voffA); }
        if (wr == 1) PG8_BAR;
        PG8_WAIT_V(2); PG8_BAR;
        PG8_STAGE(PG8_SB(1, 0), cB + kstep, voffB); if constexpr (GATHER) PG8_STAGE_G(PG8_SA(1, 0), cA + kstep, false, 0); else PG8_STAGE(PG8_SA(1, 0), cA + kstep, voffA); PG8_STAGE(PG8_SB(1, 1), cB + hstep + kstep, voffB);
        PG8_WAIT_V(6); PG8_BAR;
    } else {
        PG8_STAGE(PG8_SB(0, 0), cB, voffB); PG8_STAGE(PG8_SA(0, 0), cA, voffA); PG8_STAGE(PG8_SB(0, 1), cB + hstep, voffB); PG8_STAGE(PG8_SA(0, 1), cA + hstep, voffA);
        if (wr == 1) PG8_BAR;
        PG8_WAIT_V(4); PG8_BAR;
        PG8_STAGE(PG8_SB(1, 0), cB + kstep, voffB); PG8_STAGE(PG8_SA(1, 0), cA + kstep, voffA); PG8_STAGE(PG8_SB(1, 1), cB + hstep + kstep, voffB);
        PG8_WAIT_V(6); PG8_BAR;
    }
    for (;;) {
        const bool has_next = S.next(ui + 1, nxt);
        if constexpr (GATHER) { if (!has_next) { gn[0][0] = gc[0][0]; gn[0][1] = gc[0][1]; gn[1][0] = gc[1][0]; gn[1][1] = gc[1][1]; } }
        const char* nA = (has_next && !GATHER) ? (const char*)g.A + (size_t)nxt.pm * tstep : cA; const char* nB = has_next ? (const char*)g.Bt + (size_t)nxt.pn * tstep : cB;
        for (int t = 0; t < nt; t += 2) {
            const bool last = (t == nt - 2);
            const char* a1 = cA + (size_t)(t + 1) * kstep;
            const char* a2 = last ? nA : cA + (size_t)(t + 2) * kstep; const char* b2 = last ? nB : cB + (size_t)(t + 2) * kstep;
            const char* a3 = a2 + kstep; const char* b3 = b2 + kstep;
            if (last && has_next) S.a_ready(nxt);
            if constexpr (SP2) {
            PG8_LDB(B0, 0, 0); PG8_LDB(B1, 0, 1); PG8_SCHED; PG8_LDA(At, 0, 0); if constexpr (GATHER) PG8_STAGE_G(PG8_SA(1, 1), a1, false, 1); else PG8_STAGE(PG8_SA(1, 1), a1 + hstep, voffA);
            PG8_WAIT_V(8); PG8_WAIT_L(0); PG8_BAR; PG8_MMA(0, 0, At, B0); PG8_MMA(0, 1, At, B1); PG8_BAR; PG8_SCHED;
            PG8_LDA(At, 0, 1); PG8_STAGE(PG8_SB(0, 0), b2, voffB); PG8_STAGE(PG8_SB(0, 1), b2 + hstep, voffB); if constexpr (GATHER) PG8_STAGE_G(PG8_SA(0, 0), a2, last, 0); else PG8_STAGE(PG8_SA(0, 0), a2, voffA);
            PG8_WAIT_V(8); PG8_WAIT_L(0); PG8_BAR; PG8_MMA(1, 0, At, B0); PG8_MMA(1, 1, At, B1); PG8_BAR; PG8_SCHED;
            PG8_LDB(B0, 1, 0); PG8_LDB(B1, 1, 1); PG8_SCHED; PG8_LDA(At, 1, 0); if constexpr (GATHER) PG8_STAGE_G(PG8_SA(0, 1), a2, last, 1); else PG8_STAGE(PG8_SA(0, 1), a2 + hstep, voffA);
            PG8_WAIT_V(8); PG8_WAIT_L(0); PG8_BAR; PG8_MMA(0, 0, At, B0); PG8_MMA(0, 1, At, B1); PG8_BAR; PG8_SCHED;
            PG8_LDA(At, 1, 1); PG8_STAGE(PG8_SB(1, 0), b3, voffB); PG8_STAGE(PG8_SB(1, 1), b3 + hstep, voffB); if constexpr (GATHER) PG8_STAGE_G(PG8_SA(1, 0), a3, last, 0); else PG8_STAGE(PG8_SA(1, 0), a3, voffA);
            PG8_WAIT_V(8); PG8_WAIT_L(0); PG8_BAR; PG8_MMA(1, 0, At, B0); PG8_MMA(1, 1, At, B1); PG8_BAR; PG8_SCHED;
            } else {
            PG8_LDB(B0, 0, 0); PG8_SCHED; PG8_LDA(At, 0, 0); PG8_STAGE(PG8_SA(1, 1), a1 + hstep, voffA);
            PG8_WAIT_L(8); PG8_BAR; PG8_WAIT_L(0); PG8_MMA(0, 0, At, B0); PG8_BAR; PG8_SCHED;
            PG8_LDB(B1, 0, 1); PG8_STAGE(PG8_SB(0, 0), b2, voffB);
            PG8_BAR; PG8_WAIT_L(0); PG8_MMA(0, 1, At, B1); PG8_BAR;
            PG8_LDA(At, 0, 1); PG8_STAGE(PG8_SA(0, 0), a2, voffA);
            PG8_BAR; PG8_WAIT_L(0); PG8_MMA(1, 0, At, B0); PG8_BAR; PG8_SCHED;
            PG8_STAGE(PG8_SB(0, 1), b2 + hstep, voffB);
            PG8_WAIT_V(6); PG8_BAR; PG8_MMA(1, 1, At, B1); PG8_BAR;
            PG8_LDB(B0, 1, 0); PG8_SCHED; PG8_LDA(At, 1, 0); PG8_STAGE(PG8_SA(0, 1), a2 + hstep, voffA);
            PG8_WAIT_L(8); PG8_BAR; PG8_WAIT_L(0); PG8_MMA(0, 0, At, B0); PG8_BAR; PG8_SCHED;
            PG8_LDB(B1, 1, 1); PG8_STAGE(PG8_SB(1, 0), b3, voffB);
            PG8_BAR; PG8_WAIT_L(0); PG8_MMA(0, 1, At, B1); PG8_BAR;
            PG8_LDA(At, 1, 1); PG8_STAGE(PG8_SA(1, 0), a3, voffA);
            PG8_BAR; PG8_WAIT_L(0); PG8_MMA(1, 0, At, B0); PG8_BAR; PG8_SCHED;
            PG8_STAGE(PG8_SB(1, 1), b3 + hstep, voffB);
            PG8_WAIT_V(6); PG8_BAR; PG8_MMA(1, 1, At, B1); PG8_BAR;
            }
        }
        if constexpr (ALIGN_EPI) { if (wr == 0) PG8_BAR; }
#ifdef REP_EPI
        if constexpr (!Epi::AFTER_DRAIN) { E(acc, cur, wr, wc, fr, fq); asm volatile("" ::: "memory"); }
#endif
        if constexpr (!Epi::AFTER_DRAIN) { E(acc, cur, wr, wc, fr, fq); S.done(cur); }
        unsigned g2_[2][2] = {{0u, 0u}, {0u, 0u}};
        if constexpr (GATHER) { Unit nn_; if (has_next && S.next(ui + 2, nn_)) PG8_GLOAD(g2_, nn_); else { g2_[0][0] = gn[0][0]; g2_[0][1] = gn[0][1]; g2_[1][0] = gn[1][0]; g2_[1][1] = gn[1][1]; } }
        if (!has_next) break;
#pragma unroll
        for (int a = 0; a < 2; ++a)
#pragma unroll
            for (int b = 0; b < 2; ++b)
#pragma unroll
                for (int m = 0; m < 4; ++m)
#pragma unroll
                    for (int n = 0; n < 2; ++n) acc[a][b][m][n] = (f32x4){0.f, 0.f, 0.f, 0.f};
        cur = nxt; cA = nA; cB = nB; ++ui;
        if constexpr (GATHER) { gc[0][0] = gn[0][0]; gc[0][1] = gn[0][1]; gc[1][0] = gn[1][0]; gc[1][1] = gn[1][1]; gn[0][0] = g2_[0][0]; gn[0][1] = g2_[0][1]; gn[1][0] = g2_[1][0]; gn[1][1] = g2_[1][1]; }
        if constexpr (ALIGN_EPI) { if (wr == 1) PG8_BAR; }
    }
    PG8_WAIT_V(0);
    if constexpr (!ALIGN_EPI) { if (wr == 0) PG8_BAR; }
    PG8_BAR;
    if constexpr (Epi::AFTER_DRAIN) { E.fused(acc, cur, wr, wc, fr, fq, lds, wid, lane); S.done(cur); }
#undef PG8_SA
#undef PG8_SB
#undef PG8_STAGE
#undef PG8_STAGE_G
#undef PG8_GLOAD
#undef PG8_LDA
#undef PG8_LDB
#undef PG8_MMA
#undef PG8_WAIT_V
#undef PG8_WAIT_L
#undef PG8_BAR
#undef PG8_SCHED
}
}

#ifndef ONE_LAUNCH
#define ONE_LAUNCH 1
#endif
constexpr int NB = 16, T = 2048, D = 1024, M = NB * T;
constexpr int NZ = 4736, NZP = 4864;
constexpr int RW = 512, NE = 16, CAP = 256, ME = NE * NB * CAP;
constexpr int ZR = 0, ZK = 512, ZV = 1024, ZWD = 1536, ZAD = 1664, ZGD = 1792, ZQ = 1920, ZKA = 2432, ZVA = 2560, ZGA = 2688, ZGB = 3712;
constexpr int NWAVES = 8, NPHASE = 14;
constexpr size_t MiB = 1u << 20;
constexpr size_t WS_CTL = 0, CTL_ZERO_BYTES = 64 * 1024 + 16 * 6144 * 4;
constexpr size_t WS_MOD = 64 * 1024, WS_BONUS = 2 * MiB, WS_AFF = 4 * MiB, WS_SELAFF = 6 * MiB, WS_SLOT = 7 * MiB, WS_G2T = 9 * MiB;
constexpr size_t WS_WINT = 10 * MiB, WS_PRT = 20 * MiB, WS_PAT = 21 * MiB, WS_WOT = 22 * MiB, WS_SGD = 24 * MiB;
constexpr size_t WS_XN = 40 * MiB;
constexpr size_t WS_OATT = 104 * MiB;
constexpr size_t WS_G = 136 * MiB;
constexpr size_t WS_Z = 168 * MiB;
constexpr size_t WS_X1 = 104 * MiB;
constexpr size_t OUT_WGUT = 0;
constexpr size_t OUT_WDT = 64 * MiB;
constexpr size_t WS_XE = 200 * MiB;
constexpr size_t WS_H = 328 * MiB;
constexpr size_t WS_END = 464 * MiB;
constexpr size_t WS_ROPE = WS_AFF;
constexpr size_t WS_SELIDX = WS_SELAFF + 512 * 1024;
constexpr int CW_BAR = 4096;
constexpr int RING_BYTES = 131072, LDSCTL_OFF = RING_BYTES, MISC_OFF = LDSCTL_OFF + 320, LDS_BYTES = 147456;

#define GAS __attribute__((address_space(1)))
#define LAS __attribute__((address_space(3)))
typedef unsigned short bf16;
typedef unsigned v4u __attribute__((ext_vector_type(4)));
typedef float f32x4 __attribute__((ext_vector_type(4)));
typedef short bf16x8 __attribute__((ext_vector_type(8)));
typedef GAS unsigned gu32;
typedef GAS unsigned long long gu64;
#define RLX_AGENT __ATOMIC_RELAXED, __HIP_MEMORY_SCOPE_AGENT
#define LDS_WAIT() asm volatile("s_waitcnt lgkmcnt(0)" ::: "memory")
#define VM_WAIT() asm volatile("s_waitcnt vmcnt(0)" ::: "memory")
__device__ __forceinline__ unsigned long long rt() { return __builtin_amdgcn_s_memrealtime(); }
__device__ __forceinline__ unsigned f2bf(float f) { unsigned u = __builtin_bit_cast(unsigned, f); return (u + 0x7fffu + ((u >> 16) & 1u)) >> 16; }
typedef float f32x2hw __attribute__((ext_vector_type(2))); typedef __bf16 bf16x2hw __attribute__((ext_vector_type(2)));
__device__ __forceinline__ unsigned pk2(float lo, float hi) { f32x2hw v = {lo, hi}; bf16x2hw b = __builtin_convertvector(v, bf16x2hw); return __builtin_bit_cast(unsigned, b); }

#define XB_TMO      128
#define XB_XCNT(j)  (256  + 64 * (j))
#define XB_XSUB(j)  (1280 + 64 * (j))
#define XB_XGEN(j)  (2304 + 64 * (j))
#define XB_TOP      3328
#define XB_TOPGEN   3392
#define XCD_BAR_WORDS 3456
#define XB_SPIN_CAP (1u << 18)

__device__ __forceinline__ unsigned xb_ld(unsigned* p)              { return __hip_atomic_load(p, __ATOMIC_RELAXED, __HIP_MEMORY_SCOPE_AGENT); }
__device__ __forceinline__ unsigned xb_add(unsigned* p, unsigned v) { return __hip_atomic_fetch_add(p, v, __ATOMIC_RELAXED, __HIP_MEMORY_SCOPE_AGENT); }
__device__ __forceinline__ unsigned xb_xcc_id() { return (unsigned)__builtin_amdgcn_s_getreg((3 << 11) | 20) & 0xFu; }
#define XB_SPIN(cond, bar) do { unsigned _sp = 0; while (cond) { __builtin_amdgcn_s_sleep(1); \
    if ((++_sp & 255u) == 0u) { if (xb_ld(&(bar)[XB_TMO])) break; if (_sp > XB_SPIN_CAP) { atomicAdd(&(bar)[XB_TMO], 1u); break; } } } } while (0)

struct XcdBarrier {
    unsigned* bar; unsigned x;
    volatile LAS unsigned* st;
};

__device__ __forceinline__ XcdBarrier xcd_barrier_post(unsigned* bar, volatile LAS unsigned* st) {
    XcdBarrier b; b.bar = bar; b.x = xb_xcc_id(); b.st = st;
    if (threadIdx.x == 0) (void)xb_add(&bar[XB_XCNT(b.x)], 1u);
    return b;
}
__device__ __forceinline__ void xcd_barrier_complete(unsigned* bar, unsigned x, unsigned& nloc, unsigned& nx) {
    const unsigned G = gridDim.x * gridDim.y * gridDim.z;
    unsigned sum, cnt, mine, sp = 0u;
    for (;;) {
        sum = 0u; cnt = 0u; mine = 0u;
#pragma unroll
        for (unsigned j = 0; j < 16; ++j) { const unsigned c = xb_ld(&bar[XB_XCNT(j)]); sum += c; cnt += (c > 0u) ? 1u : 0u; mine = (j == x) ? c : mine; }
        if (sum == G) break;
        __builtin_amdgcn_s_sleep(1);
        if ((++sp & 255u) == 0u) { if (xb_ld(&bar[XB_TMO])) break; if (sp > XB_SPIN_CAP) { atomicAdd(&bar[XB_TMO], 1u); break; } }
    }
    nloc = mine > 0u ? mine : 1u; nx = cnt > 0u ? cnt : 1u;
}

__device__ __forceinline__ void xcd_barrier(const XcdBarrier& b, bool is_thread0) {
    asm volatile("s_waitcnt vmcnt(0)" ::: "memory");
    __syncthreads();
    if (is_thread0) {
        unsigned* bar = b.bar;
        __builtin_amdgcn_s_waitcnt(0);
        unsigned nloc = b.st[0], nx = b.st[1];
        if (nloc == 0u) { xcd_barrier_complete(bar, b.x, nloc, nx); b.st[0] = nloc; b.st[1] = nx; }
        const unsigned old = xb_add(&bar[XB_XSUB(b.x)], 1u);
        const unsigned gen = old / nloc;
        if (old + 1u == (gen + 1u) * nloc) {
            __builtin_amdgcn_fence(__ATOMIC_RELEASE, "agent");
            asm volatile("s_waitcnt vmcnt(0)" ::: "memory");
            const unsigned og = xb_add(&bar[XB_TOP], 1u);
            const unsigned tg = og / nx;
            if (og + 1u == (tg + 1u) * nx) xb_add(&bar[XB_TOPGEN], 1u);
            else XB_SPIN(xb_ld(&bar[XB_TOPGEN]) == tg, bar);
            __builtin_amdgcn_fence(__ATOMIC_ACQUIRE, "agent");
            xb_add(&bar[XB_XGEN(b.x)], 1u);
            asm volatile("s_waitcnt vmcnt(0)" ::: "memory");
        } else {
            XB_SPIN(xb_ld(&bar[XB_XGEN(b.x)]) == gen, bar);
            __builtin_amdgcn_fence(__ATOMIC_ACQUIRE, "agent");
            asm volatile("s_waitcnt vmcnt(0)" ::: "memory");
        }
    }
    __syncthreads();
}
namespace pg8 {
__device__ __forceinline__ float bf2f(unsigned short h) { return __uint_as_float(((unsigned)h) << 16); }
__device__ __forceinline__ float bflo(unsigned w) { return __uint_as_float(w << 16); }
__device__ __forceinline__ float bfhi(unsigned w) { return __uint_as_float(w & 0xffff0000u); }
__device__ __forceinline__ float sigm(float x) { return 1.0f / (1.0f + __expf(-x)); }
struct EpiZ { static constexpr bool PERM = true, AFTER_DRAIN = false; bf16_t* O;
    __device__ __forceinline__ void operator()(const f32x4 (&acc)[2][2][4][2], const Unit& u, int wr, int wc, int fr, int fq) const {
        const int row0 = u.pm * BM + wr * 64 + fr, col0 = u.pn * BM + wc * 32 + 8 * fq;
#pragma unroll
        for (int ai = 0; ai < 2; ++ai)
#pragma unroll
            for (int m = 0; m < 4; ++m) { bf16_t* rowp = O + (size_t)(row0 + ai * HALF + m * 16) * 4736 + col0;
#pragma unroll
                for (int bj = 0; bj < 2; ++bj) { if (u.pn * BM + bj * HALF < 4736) { const f32x4 v0 = acc[ai][bj][m][0], v1 = acc[ai][bj][m][1];
                    u32x4 w; w.x = cvt_pk_bf16(v0[0], v0[1]); w.y = cvt_pk_bf16(v0[2], v0[3]); w.z = cvt_pk_bf16(v1[0], v1[1]); w.w = cvt_pk_bf16(v1[2], v1[3]);
                    *(u32x4*)(rowp + bj * HALF) = w; } } }
    }
};
struct EpiPlain { static constexpr bool PERM = true, AFTER_DRAIN = false; bf16_t* O; int ldc;
    __device__ __forceinline__ void operator()(const f32x4 (&acc)[2][2][4][2], const Unit& u, int wr, int wc, int fr, int fq) const {
        const int row0 = u.pm * BM + wr * 64 + fr, col0 = u.pn * BM + wc * 32 + 8 * fq;
#pragma unroll
        for (int ai = 0; ai < 2; ++ai)
#pragma unroll
            for (int m = 0; m < 4; ++m) { bf16_t* rowp = O + (size_t)(row0 + ai * HALF + m * 16) * ldc + col0;
#pragma unroll
                for (int bj = 0; bj < 2; ++bj) { const f32x4 v0 = acc[ai][bj][m][0], v1 = acc[ai][bj][m][1];
                    u32x4 w; w.x = cvt_pk_bf16(v0[0], v0[1]); w.y = cvt_pk_bf16(v0[2], v0[3]); w.z = cvt_pk_bf16(v1[0], v1[1]); w.w = cvt_pk_bf16(v1[2], v1[3]);
                    *(u32x4*)(rowp + bj * HALF) = w; } }
    }
};
template <bool ADD> struct EpiGate { static constexpr bool PERM = true, AFTER_DRAIN = false; bf16_t* O; const bf16_t* Z; int zc0;
    __device__ __forceinline__ void operator()(const f32x4 (&acc)[2][2][4][2], const Unit& u, int wr, int wc, int fr, int fq) const {
        const int row0 = u.pm * BM + wr * 64 + fr, col0 = u.pn * BM + wc * 32 + 8 * fq;
#pragma unroll
        for (int ai = 0; ai < 2; ++ai)
#pragma unroll
            for (int m = 0; m < 4; ++m) { const size_t row = (size_t)(row0 + ai * HALF + m * 16); bf16_t* rowp = O + row * 1024 + col0; const bf16_t* zp = Z + row * 4736 + zc0 + col0;
#pragma unroll
                for (int bj = 0; bj < 2; ++bj) { const f32x4 v0 = acc[ai][bj][m][0], v1 = acc[ai][bj][m][1];
                    const u32x4 zg = *(const u32x4*)(zp + bj * HALF);
                    float r0 = sigm(bflo(zg.x)) * v0[0], r1 = sigm(bfhi(zg.x)) * v0[1], r2 = sigm(bflo(zg.y)) * v0[2], r3 = sigm(bfhi(zg.y)) * v0[3];
                    float r4 = sigm(bflo(zg.z)) * v1[0], r5 = sigm(bfhi(zg.z)) * v1[1], r6 = sigm(bflo(zg.w)) * v1[2], r7 = sigm(bfhi(zg.w)) * v1[3];
                    if (ADD) { const u32x4 p = *(const u32x4*)(rowp + bj * HALF);
                        r0 += bflo(p.x); r1 += bfhi(p.x); r2 += bflo(p.y); r3 += bfhi(p.y); r4 += bflo(p.z); r5 += bfhi(p.z); r6 += bflo(p.w); r7 += bfhi(p.w); }
                    u32x4 w; w.x = cvt_pk_bf16(r0, r1); w.y = cvt_pk_bf16(r2, r3); w.z = cvt_pk_bf16(r4, r5); w.w = cvt_pk_bf16(r6, r7);
                    *(u32x4*)(rowp + bj * HALF) = w; } }
    }
};
struct EpiGate2 { static constexpr bool PERM = true, AFTER_DRAIN = false; bf16_t* O; const bf16_t* Z;
    __device__ __forceinline__ void operator()(const f32x4 (&acc)[2][2][4][2], const Unit& u, int wr, int wc, int fr, int fq) const {
        const bool add = u.pm < 128; const int zc0 = add ? 3712 : 2688;
        const int row0 = (u.pm & 127) * BM + wr * 64 + fr, col0 = (u.pn & 3) * BM + wc * 32 + 8 * fq;
#pragma unroll
        for (int ai = 0; ai < 2; ++ai) {
            u32x4 zg[4][2], pv[4][2];
#pragma unroll
            for (int m = 0; m < 4; ++m) { const size_t row = (size_t)(row0 + ai * HALF + m * 16);
#pragma unroll
                for (int bj = 0; bj < 2; ++bj) { zg[m][bj] = *(const u32x4*)(Z + row * 4736 + zc0 + col0 + bj * HALF); pv[m][bj] = (u32x4){0u, 0u, 0u, 0u}; if (add) pv[m][bj] = *(const u32x4*)(O + row * 1024 + col0 + bj * HALF); } }
#pragma unroll
            for (int m = 0; m < 4; ++m) { const size_t row = (size_t)(row0 + ai * HALF + m * 16); bf16_t* rowp = O + row * 1024 + col0;
#pragma unroll
                for (int bj = 0; bj < 2; ++bj) { const f32x4 v0 = acc[ai][bj][m][0], v1 = acc[ai][bj][m][1]; const u32x4 g = zg[m][bj], p = pv[m][bj];
                    const float r0 = sigm(bflo(g.x)) * v0[0] + bflo(p.x), r1 = sigm(bfhi(g.x)) * v0[1] + bfhi(p.x), r2 = sigm(bflo(g.y)) * v0[2] + bflo(p.y), r3 = sigm(bfhi(g.y)) * v0[3] + bfhi(p.y);
                    const float r4 = sigm(bflo(g.z)) * v1[0] + bflo(p.z), r5 = sigm(bfhi(g.z)) * v1[1] + bfhi(p.z), r6 = sigm(bflo(g.w)) * v1[2] + bflo(p.w), r7 = sigm(bfhi(g.w)) * v1[3] + bfhi(p.w);
                    u32x4 w; w.x = cvt_pk_bf16(r0, r1); w.y = cvt_pk_bf16(r2, r3); w.z = cvt_pk_bf16(r4, r5); w.w = cvt_pk_bf16(r6, r7);
                    *(u32x4*)(rowp + bj * HALF) = w; } } }
    }
};
struct MergeOrder { StaticOrder S; int nu;
    __device__ __forceinline__ void init(int G, int c) { S.init(32768, 1024, G, c); nu = (512 - c + G - 1) / G; }
    __device__ __forceinline__ bool next(int i, Unit& u) const { if (i >= 2 * nu) return false; Unit t; S.next(i < nu ? i : i - nu, t);
        if (i < nu) { u.pm = 128 + t.pm; u.pn = t.pn; } else { u.pm = t.pm; u.pn = 4 + t.pn; } return true; }
    __device__ __forceinline__ void a_ready(const Unit&) const {}
    __device__ __forceinline__ void done(const Unit&) const {}
};
struct EpiRes { static constexpr bool PERM = true, AFTER_DRAIN = false; const float* X; const float* mod; bf16_t* O;
    __device__ __forceinline__ void operator()(const f32x4 (&acc)[2][2][4][2], const Unit& u, int wr, int wc, int fr, int fq) const {
        const int row0 = u.pm * BM + wr * 64 + fr, col0 = u.pn * BM + wc * 32 + 8 * fq; const int b = (u.pm * BM) >> 11;
        f32x4 gt[2][2];
#pragma unroll
        for (int bj = 0; bj < 2; ++bj)
#pragma unroll
            for (int n = 0; n < 2; ++n) gt[bj][n] = *(const f32x4*)(mod + (size_t)b * 6144 + 2048 + col0 + bj * HALF + n * 4);
#pragma unroll
        for (int ai = 0; ai < 2; ++ai) { f32x4 xv[4][2][2];
#pragma unroll
            for (int m = 0; m < 4; ++m) { const size_t off = (size_t)(row0 + ai * HALF + m * 16) * 1024 + col0;
#pragma unroll
                for (int bj = 0; bj < 2; ++bj) { xv[m][bj][0] = *(const f32x4*)(X + off + bj * HALF); xv[m][bj][1] = *(const f32x4*)(X + off + bj * HALF + 4); } }
#pragma unroll
            for (int m = 0; m < 4; ++m) { const size_t off = (size_t)(row0 + ai * HALF + m * 16) * 1024 + col0;
#pragma unroll
                for (int bj = 0; bj < 2; ++bj) { const f32x4 v0 = xv[m][bj][0] + gt[bj][0] * acc[ai][bj][m][0], v1 = xv[m][bj][1] + gt[bj][1] * acc[ai][bj][m][1];
                    u32x4 w; w.x = cvt_pk_bf16(v0[0], v0[1]); w.y = cvt_pk_bf16(v0[2], v0[3]); w.z = cvt_pk_bf16(v1[0], v1[1]); w.w = cvt_pk_bf16(v1[2], v1[3]);
                    *(u32x4*)(O + off + bj * HALF) = w; } } }
    }
};
template <int NPL> struct GroupOrder { int G, c;
    __device__ __forceinline__ bool next(int i, Unit& u) const { const int L = i * G + c; if (L >= 256 * NPL) return false;
        if (G == 256) {
            const int q = i * 32 + (c >> 3), e = (c & 7) * 2 + q / (16 * NPL), r = q % (16 * NPL), rho = r >> 5, j = r & 31;
            u.pm = e * 16 + (rho & 1) * 8 + (j & 7); u.pn = e * NPL + (rho >> 1) * 4 + (j >> 3); return true; }
        const int e = L / (16 * NPL), r = L % (16 * NPL); u.pm = e * 16 + (r % 16); u.pn = e * NPL + r / 16; return true; }
    __device__ __forceinline__ void a_ready(const Unit&) const {}
    __device__ __forceinline__ void done(const Unit&) const {}
};
struct EpiSwiglu { static constexpr bool PERM = true, AFTER_DRAIN = false; bf16_t* O;
    __device__ __forceinline__ void operator()(const f32x4 (&acc)[2][2][4][2], const Unit& u, int wr, int wc, int fr, int fq) const {
        const int row0 = u.pm * BM + wr * 64 + fr, col0 = (u.pn & 7) * 128 + wc * 32 + 8 * fq;
#pragma unroll
        for (int ai = 0; ai < 2; ++ai)
#pragma unroll
            for (int m = 0; m < 4; ++m) { bf16_t* rowp = O + (size_t)(row0 + ai * HALF + m * 16) * 1024 + col0;
                float r[8];
#pragma unroll
                for (int n = 0; n < 2; ++n)
#pragma unroll
                    for (int i = 0; i < 4; ++i) { const float g = acc[ai][0][m][n][i], up = acc[ai][1][m][n][i]; r[n * 4 + i] = g * sigm(g) * up; }
                u32x4 w; w.x = cvt_pk_bf16(r[0], r[1]); w.y = cvt_pk_bf16(r[2], r[3]); w.z = cvt_pk_bf16(r[4], r[5]); w.w = cvt_pk_bf16(r[6], r[7]);
                *(u32x4*)rowp = w; }
    }
};
struct EpiDown { static constexpr bool PERM = true, AFTER_DRAIN = false; bf16_t* O; const float* aff;
    __device__ __forceinline__ void operator()(const f32x4 (&acc)[2][2][4][2], const Unit& u, int wr, int wc, int fr, int fq) const {
        const int row0 = u.pm * BM + wr * 64 + fr, col0 = (u.pn & 3) * BM + wc * 32 + 8 * fq;
        float av[2][4];
#pragma unroll
        for (int ai = 0; ai < 2; ++ai)
#pragma unroll
            for (int m = 0; m < 4; ++m) av[ai][m] = aff[row0 + ai * HALF + m * 16];
#pragma unroll
        for (int ai = 0; ai < 2; ++ai)
#pragma unroll
            for (int m = 0; m < 4; ++m) { const int row = row0 + ai * HALF + m * 16; const float a = av[ai][m]; bf16_t* rowp = O + (size_t)row * 1024 + col0;
#pragma unroll
                for (int bj = 0; bj < 2; ++bj) { const f32x4 v0 = acc[ai][bj][m][0] * a, v1 = acc[ai][bj][m][1] * a;
                    u32x4 w; w.x = cvt_pk_bf16(v0[0], v0[1]); w.y = cvt_pk_bf16(v0[2], v0[3]); w.z = cvt_pk_bf16(v1[0], v1[1]); w.w = cvt_pk_bf16(v1[2], v1[3]);
                    *(u32x4*)(rowp + bj * HALF) = w; } }
    }
};
}

struct Frame { LAS unsigned char* lds; volatile LAS unsigned* MISC; gu32* ctl; int tid, lane, wave, vcu, G; };
struct Args { const void* in[30]; float* out; unsigned char* ws; int ph_lo, ph_hi; };
typedef const __attribute__((address_space(4))) Args* ArgsP;
#define LAUNDER(p) asm volatile("" : "+s"(p))
typedef float f32x16 __attribute__((ext_vector_type(16)));
typedef unsigned u32x2 __attribute__((ext_vector_type(2)));

__device__ __forceinline__ float wave_sum(float v) {
#pragma unroll
    for (int o = 1; o < 64; o <<= 1) v += __shfl_xor(v, o);
    return v;
}
__device__ __forceinline__ float bf2f(bf16 h) { return __uint_as_float(((unsigned)h) << 16); }
__device__ __forceinline__ float bflo(unsigned w) { return __uint_as_float(w << 16); }
__device__ __forceinline__ float bfhi(unsigned w) { return __uint_as_float(w & 0xffff0000u); }
__device__ __forceinline__ float sigm(float x) { return 1.0f / (1.0f + __expf(-x)); }

__device__ __forceinline__ void tr_item(const float* W, int N, int k0, int n0, bf16* WT, int KD, int dst_row0, LAS float* scr, int lane) {
    f32x4 v[8];
#pragma unroll
    for (int i = 0; i < 8; ++i) v[i] = *(const GAS f32x4*)(W + (size_t)(k0 + 8 * i + (lane >> 3)) * N + n0 + 4 * (lane & 7));
#pragma unroll
    for (int i = 0; i < 8; ++i) { LAS float* d = scr + (8 * i + (lane >> 3)) * 33 + 4 * (lane & 7); d[0] = v[i].x; d[1] = v[i].y; d[2] = v[i].z; d[3] = v[i].w; }
    LDS_WAIT(); asm volatile("" ::: "memory");
    const int c = lane & 7;
#pragma unroll
    for (int j = 0; j < 4; ++j) { const int n = (lane >> 3) + 8 * j; const LAS float* s = scr + (8 * c) * 33 + n;
        v4u o; o.x = pk2(s[0 * 33], s[1 * 33]); o.y = pk2(s[2 * 33], s[3 * 33]); o.z = pk2(s[4 * 33], s[5 * 33]); o.w = pk2(s[6 * 33], s[7 * 33]);
        *(GAS v4u*)(WT + (size_t)(dst_row0 + n) * KD + k0 + 8 * c) = o; }
    LDS_WAIT(); asm volatile("" ::: "memory");
}

__device__ __forceinline__ void p0_prologue(const Frame& F, ArgsP A) {
    unsigned char* ws = A->ws;
    LAS float* scr = (LAS float*)(F.lds + F.wave * 16384);
    const int gw = F.vcu * NWAVES + F.wave, NGW = F.G * NWAVES;
    const float* w_in = (const float*)A->in[6]; const float* p_rwkv = (const float*)A->in[22]; const float* p_attn = (const float*)A->in[23];
    const float* w_out = (const float*)A->in[24]; const float* g2 = (const float*)A->in[13];
    bf16* WinT = (bf16*)(ws + WS_WINT); bf16* PrT = (bf16*)(ws + WS_PRT); bf16* PaT = (bf16*)(ws + WS_PAT); bf16* WoT = (bf16*)(ws + WS_WOT); bf16* G2T = (bf16*)(ws + WS_G2T);
    constexpr int I_IN = 16 * 148, I_P = 8 * 32, I_O = 16 * 32, I_G = 2 * 16, NIT = I_IN + 2 * I_P + I_O + I_G;
    for (int it = gw; it < NIT; it += NGW) {
        int r = it;
        if (r < I_IN) { tr_item(w_in, NZ, 64 * (r / 148), 32 * (r % 148), WinT, 1024, 32 * (r % 148), scr, F.lane); continue; } r -= I_IN;
        if (r < I_P) { tr_item(p_rwkv, 1024, 64 * (r / 32), 32 * (r % 32), PrT, 512, 32 * (r % 32), scr, F.lane); continue; } r -= I_P;
        if (r < I_P) { tr_item(p_attn, 1024, 64 * (r / 32), 32 * (r % 32), PaT, 512, 32 * (r % 32), scr, F.lane); continue; } r -= I_P;
        if (r < I_O) { tr_item(w_out, 1024, 64 * (r / 32), 32 * (r % 32), WoT, 1024, 32 * (r % 32), scr, F.lane); continue; } r -= I_O;
        tr_item(g2, 512, 64 * (r / 16), 32 * (r % 16), G2T, 256, 32 * (r % 16), scr, F.lane);
    }
    { const int gt = (F.vcu * NWAVES + F.wave) * 64 + F.lane, NT = F.G * NWAVES * 64; const v4u z4 = {0u, 0u, 0u, 0u};
      for (int i = gt; i < 128 * 128; i += NT) *(GAS v4u*)(WinT + (size_t)4736 * 1024 + (size_t)i * 8) = z4;
      for (int i = gt; i < 512 * 16; i += NT) *(GAS v4u*)(G2T + (size_t)(i >> 4) * 256 + 128 + (i & 15) * 8) = z4; }
    __syncthreads();
    const float* cvec = (const float*)A->in[1]; const float* w_ada = (const float*)A->in[3]; const float* b_ada = (const float*)A->in[4];
    float* mod = (float*)(ws + WS_MOD);
    for (int task = F.vcu; task < 192; task += F.G) { const int cg = task % 96, dh = task / 96;
        LAS float* ca = (LAS float*)F.lds;
        LAS float* red = (LAS float*)(F.lds + 65536);
        for (int i = F.tid; i < 16 * 1024; i += 512) { const int b = i >> 10, d = i & 1023; const float cv = cvec[i]; ca[d * 16 + b] = cv / (1.0f + __expf(-cv)); }
        __syncthreads();
        float acc[16];
#pragma unroll
        for (int b = 0; b < 16; ++b) acc[b] = 0.f;
        const int col = cg * 64 + F.lane;
#pragma unroll 8
        for (int dd = 0; dd < 64; ++dd) { const int d = dh * 512 + F.wave * 64 + dd; const float w = w_ada[(size_t)d * 6144 + col];
            const LAS f32x4* cp = (const LAS f32x4*)(ca + d * 16);
#pragma unroll
            for (int q = 0; q < 4; ++q) { const f32x4 cv = cp[q]; acc[q * 4 + 0] += cv[0] * w; acc[q * 4 + 1] += cv[1] * w; acc[q * 4 + 2] += cv[2] * w; acc[q * 4 + 3] += cv[3] * w; } }
#pragma unroll
        for (int b = 0; b < 16; ++b) red[(F.wave * 16 + b) * 64 + F.lane] = acc[b];
        __syncthreads();
        for (int o = F.tid; o < 1024; o += 512) { const int b = o >> 6, cl = o & 63; float sacc = 0.f;
#pragma unroll
            for (int w = 0; w < 8; ++w) sacc += red[(w * 16 + b) * 64 + cl];
            atomicAdd(&mod[b * 6144 + cg * 64 + cl], sacc + (dh == 0 ? b_ada[cg * 64 + cl] : 0.f)); }
        __syncthreads();
    }
}


__device__ __forceinline__ float dpp_wave_sum(float v) {
    v += __int_as_float(__builtin_amdgcn_update_dpp(0, __float_as_int(v), 0xB1, 0xf, 0xf, false));
    v += __int_as_float(__builtin_amdgcn_update_dpp(0, __float_as_int(v), 0x4E, 0xf, 0xf, false));
    v += __int_as_float(__builtin_amdgcn_update_dpp(0, __float_as_int(v), 0x141, 0xf, 0xf, false));
    v += __int_as_float(__builtin_amdgcn_update_dpp(0, __float_as_int(v), 0x140, 0xf, 0xf, false));
    v += __int_as_float(__builtin_amdgcn_ds_swizzle(__float_as_int(v), 0x401F));
    auto r_ = __builtin_amdgcn_permlane32_swap(__float_as_uint(v), __float_as_uint(v), false, false);
    return __uint_as_float(r_[0]) + __uint_as_float(r_[1]); }

template <int R, bool XBF> __device__ __forceinline__ void modnorm_rows(const void* x, int m0, int mstride, const float* g, const float* mod, int sh_off, int sc_off, bf16* out, int lane, f32x4 (&u)[R][4]) {
    f32x4 v[R][4];
#pragma unroll
    for (int i = 0; i < R; ++i) {
        if (XBF) { const GAS u32x2* xr = (const GAS u32x2*)((const bf16*)x + (size_t)(m0 + i * mstride) * 1024) + lane;
#pragma unroll
            for (int j = 0; j < 4; ++j) { const u32x2 w = xr[64 * j]; v[i][j] = (f32x4){bflo(w.x), bfhi(w.x), bflo(w.y), bfhi(w.y)}; } }
        else { const GAS f32x4* xr = (const GAS f32x4*)((const float*)x + (size_t)(m0 + i * mstride) * 1024) + lane;
#pragma unroll
            for (int j = 0; j < 4; ++j) v[i][j] = xr[64 * j]; } }
    f32x4 gg[4];
#pragma unroll
    for (int j = 0; j < 4; ++j) gg[j] = ((const GAS f32x4*)g)[lane + 64 * j];
#pragma unroll
    for (int i = 0; i < R; ++i) { const int m = m0 + i * mstride, b = m >> 11; float s = 0.f;
#pragma unroll
        for (int j = 0; j < 4; ++j) s += (v[i][j].x * v[i][j].x + v[i][j].y * v[i][j].y) + (v[i][j].z * v[i][j].z + v[i][j].w * v[i][j].w);
        const float rs = rsqrtf(dpp_wave_sum(s) * (1.0f / 1024.0f) + 1e-6f);
        const float* sh = mod + (size_t)b * 6144 + sh_off; const float* sc = mod + (size_t)b * 6144 + sc_off;
        GAS unsigned long long* o8 = (GAS unsigned long long*)(out + (size_t)m * 1024) + lane;
#pragma unroll
        for (int j = 0; j < 4; ++j) { const f32x4 s1 = ((const GAS f32x4*)sc)[lane + 64 * j], s0 = ((const GAS f32x4*)sh)[lane + 64 * j];
            f32x4 y = (v[i][j] * rs) * gg[j]; y = y * (s1 + 1.0f) + s0; u[i][j] = y;
            o8[64 * j] = (unsigned long long)pk2(y.x, y.y) | ((unsigned long long)pk2(y.z, y.w) << 32); } }
}

template <int R> __device__ __forceinline__ void load_rows_bf16(const bf16* x, int m0, int mstride, int lane_in, u32x2 (&raw)[R][4]) {
    int lane = lane_in; asm volatile("" : "+v"(lane));
#pragma unroll
    for (int i = 0; i < R; ++i) { const GAS u32x2* xr = (const GAS u32x2*)(x + (size_t)(m0 + i * mstride) * 1024) + lane;
#pragma unroll
        for (int j = 0; j < 4; ++j) raw[i][j] = xr[64 * j]; }
}
template <int R> __device__ __forceinline__ void modnorm_rows_pre(const u32x2 (&raw)[R][4], int m0, int mstride, const float* g, const float* mod, int sh_off, int sc_off, bf16* out, int lane, f32x4 (&u)[R][4]) {
    f32x4 gg[4];
#pragma unroll
    for (int j = 0; j < 4; ++j) gg[j] = ((const GAS f32x4*)g)[lane + 64 * j];
#pragma unroll
    for (int i = 0; i < R; ++i) { const int m = m0 + i * mstride, b = m >> 11; float s = 0.f; f32x4 v[4];
#pragma unroll
        for (int j = 0; j < 4; ++j) { const u32x2 w = raw[i][j]; v[j] = (f32x4){bflo(w.x), bfhi(w.x), bflo(w.y), bfhi(w.y)}; s += (v[j].x * v[j].x + v[j].y * v[j].y) + (v[j].z * v[j].z + v[j].w * v[j].w); }
        const float rs = rsqrtf(dpp_wave_sum(s) * (1.0f / 1024.0f) + 1e-6f);
        const float* sh = mod + (size_t)b * 6144 + sh_off; const float* sc = mod + (size_t)b * 6144 + sc_off;
        GAS unsigned long long* o8 = (GAS unsigned long long*)(out + (size_t)m * 1024) + lane;
#pragma unroll
        for (int j = 0; j < 4; ++j) { const f32x4 s1 = ((const GAS f32x4*)sc)[lane + 64 * j], s0 = ((const GAS f32x4*)sh)[lane + 64 * j];
            f32x4 y = (v[j] * rs) * gg[j]; y = y * (s1 + 1.0f) + s0; u[i][j] = y;
            o8[64 * j] = (unsigned long long)pk2(y.x, y.y) | ((unsigned long long)pk2(y.z, y.w) << 32); } }
}

__device__ __forceinline__ void modnorm_row(const float* xrow, const float* g, const float* sh, const float* sc, bf16* orow, int lane, f32x4 (&u)[4]) {
    const GAS f32x4* xr = (const GAS f32x4*)xrow + lane;
    f32x4 v[4]; float s = 0.f;
#pragma unroll
    for (int j = 0; j < 4; ++j) { v[j] = xr[64 * j]; s += (v[j].x * v[j].x + v[j].y * v[j].y) + (v[j].z * v[j].z + v[j].w * v[j].w); }
    const float rs = rsqrtf(wave_sum(s) * (1.0f / 1024.0f) + 1e-6f);
    GAS unsigned long long* o8 = (GAS unsigned long long*)orow + lane;
#pragma unroll
    for (int j = 0; j < 4; ++j) { const f32x4 gg = ((const GAS f32x4*)g)[lane + 64 * j], s1 = ((const GAS f32x4*)sc)[lane + 64 * j], s0 = ((const GAS f32x4*)sh)[lane + 64 * j];
        f32x4 y = (v[j] * rs) * gg; y = y * (s1 + 1.0f) + s0; u[j] = y;
        o8[64 * j] = (unsigned long long)pk2(y.x, y.y) | ((unsigned long long)pk2(y.z, y.w) << 32); }
}

__device__ __forceinline__ float softplusf(float x) { return x > 20.f ? x : log1pf(__expf(x)); }
__device__ __forceinline__ void scan_chain(const Frame& F, ArgsP A, int b, int h, int dir) {
    constexpr int CT = 32;
    LAS float* L = (LAS float*)F.lds;
    LAS float* W2S = L; LAS float* A2S = L + 4096; LAS float* ZRs = L + 8192; LAS float* ZKs = ZRs + 2048; LAS float* ZVs = ZKs + 2048; LAS float* TWs = ZVs + 2048; LAS float* ZAs = TWs + 2048;
    LAS float* DEC = ZAs + 2048; LAS float* KD = DEC + 2048; LAS float* AV = KD + 2048; LAS float* BV = AV + 2048; LAS float* YB = BV + 2048; LAS float* BON = YB + 2048;
    const bf16* Z = (const bf16*)(A->ws + WS_Z);
    const float* mu_prev = (const float*)A->in[7]; const float* mu_next = (const float*)A->in[8];
    const float* w0 = (const float*)A->in[9]; const float* w2 = (const float*)A->in[10]; const float* a0 = (const float*)A->in[11]; const float* a2 = (const float*)A->in[12];
    const float* k_k = (const float*)A->in[14]; const float* k_a = (const float*)A->in[15]; const float* r_k = (const float*)A->in[16];
    bf16* ydir = (bf16*)(A->ws + WS_XN) + (size_t)dir * M * 512; float* bonus = (float*)(A->ws + WS_BONUS) + (size_t)dir * M * 8;
    const int tid = F.tid, lane = F.lane, wave = F.wave;
    for (int i = tid; i < 4096; i += 512) { const int l = i >> 6, j = i & 63; W2S[i] = w2[((size_t)dir * 64 + l) * 512 + h * 64 + j]; A2S[i] = a2[((size_t)dir * 64 + l) * 512 + h * 64 + j]; }
    const int ch = h * 64 + lane;
    const float w0j = w0[dir * 512 + ch], a0j = a0[dir * 512 + ch], kkj = k_k[ch], kaj = k_a[ch], rkj = r_k[ch];
    float s[8];
#pragma unroll
    for (int q = 0; q < 8; ++q) s[q] = 0.f;
    const int ri = tid >> 3, jg = tid & 7;
    for (int ci = 0; ci < T / CT; ++ci) {
        const int t0 = (dir ? (T / CT - 1 - ci) : ci) * CT;
#pragma unroll 4
        for (int i = 0; i < 20; ++i) { const int e = tid + 512 * i, arr = e >> 11, rem = e & 2047, tl = rem >> 6, j = rem & 63;
            const int col = (arr == 0 ? ZR + h * 64 : arr == 1 ? ZK + h * 64 : arr == 2 ? ZV + h * 64 : arr == 3 ? ZWD + dir * 64 : ZAD + dir * 64) + j;
            const int t = t0 + tl; const bf16* zp = Z + ((size_t)b * T + t) * NZ + col;
            const float z0 = bf2f(zp[0]), zm = t > 0 ? bf2f(zp[-NZ]) : 0.f, zq = t < T - 1 ? bf2f(zp[NZ]) : 0.f;
            float zs = z0 + mu_prev[col] * (zm - z0) + mu_next[col] * (zq - z0);
            if (arr == 3) zs = tanhf(zs);
            ZRs[arr * 2048 + rem] = zs; }
        __syncthreads();
#pragma unroll 1
        for (int q = 0; q < 4; ++q) { const int tl = wave + 8 * q;
            float wraw = w0j, araw = a0j;
#pragma unroll 8
            for (int l = 0; l < 64; ++l) { wraw += TWs[tl * 64 + l] * W2S[l * 64 + lane]; araw += ZAs[tl * 64 + l] * A2S[l * 64 + lane]; }
            const float w = -softplusf(-wraw) - 0.5f, dec = __expf(-__expf(w)), ad = sigm(araw);
            const float k = ZKs[tl * 64 + lane], kkr = k * kkj, nrm = sqrtf(wave_sum(kkr * kkr)), kk = kkr / fmaxf(nrm, 1e-12f);
            const float kd = k * (1.0f + (ad - 1.0f) * kaj);
            DEC[tl * 64 + lane] = dec; KD[tl * 64 + lane] = kd; AV[tl * 64 + lane] = -kk; BV[tl * 64 + lane] = kk * ad;
            const float bon = wave_sum(ZRs[tl * 64 + lane] * kd * rkj); if (lane == 0) BON[tl] = bon; }
        __syncthreads();
#pragma unroll 1
        for (int st = 0; st < CT; ++st) { const int tl = dir ? (CT - 1 - st) : st; const int o = tl * 64 + jg * 8;
            const f32x4 a0v = *(const LAS f32x4*)(AV + o), a1v = *(const LAS f32x4*)(AV + o + 4), d0 = *(const LAS f32x4*)(DEC + o), d1 = *(const LAS f32x4*)(DEC + o + 4);
            const f32x4 b0 = *(const LAS f32x4*)(BV + o), b1 = *(const LAS f32x4*)(BV + o + 4), k0 = *(const LAS f32x4*)(KD + o), k1 = *(const LAS f32x4*)(KD + o + 4);
            const f32x4 r0 = *(const LAS f32x4*)(ZRs + o), r1 = *(const LAS f32x4*)(ZRs + o + 4); const float vi = ZVs[tl * 64 + ri];
            float p = (s[0] * a0v[0] + s[1] * a0v[1]) + (s[2] * a0v[2] + s[3] * a0v[3]) + (s[4] * a1v[0] + s[5] * a1v[1]) + (s[6] * a1v[2] + s[7] * a1v[3]);
            p += __shfl_xor(p, 1); p += __shfl_xor(p, 2); p += __shfl_xor(p, 4);
            s[0] = s[0] * d0[0] + p * b0[0] + vi * k0[0]; s[1] = s[1] * d0[1] + p * b0[1] + vi * k0[1]; s[2] = s[2] * d0[2] + p * b0[2] + vi * k0[2]; s[3] = s[3] * d0[3] + p * b0[3] + vi * k0[3];
            s[4] = s[4] * d1[0] + p * b1[0] + vi * k1[0]; s[5] = s[5] * d1[1] + p * b1[1] + vi * k1[1]; s[6] = s[6] * d1[2] + p * b1[2] + vi * k1[2]; s[7] = s[7] * d1[3] + p * b1[3] + vi * k1[3];
            float y = (s[0] * r0[0] + s[1] * r0[1]) + (s[2] * r0[2] + s[3] * r0[3]) + (s[4] * r1[0] + s[5] * r1[1]) + (s[6] * r1[2] + s[7] * r1[3]);
            y += __shfl_xor(y, 1); y += __shfl_xor(y, 2); y += __shfl_xor(y, 4);
            if (jg == 0) YB[tl * 64 + ri] = y; }
        __syncthreads();
#pragma unroll
        for (int i = 0; i < 4; ++i) { const int e = tid + 512 * i, tl = e >> 6, c = e & 63; ydir[((size_t)b * T + t0 + tl) * 512 + h * 64 + c] = (bf16)f2bf(YB[e]); }
        if (tid < CT) bonus[((size_t)b * T + t0 + tid) * 8 + h] = BON[tid];
        __syncthreads();
    }
}


#define SDEV __device__ __forceinline__
#define S_UNROLL _Pragma("unroll")
#define S_MEMBAR() do { asm volatile("" ::: "memory"); __builtin_amdgcn_sched_barrier(0); } while (0)
#define S_LAUNDER_I(x) asm volatile("" : "+v"(x))
#define S_LAUNDER_S(x) asm volatile("" : "+s"(x))
#define S_PIN(x) asm volatile("" : "+v"(x))
typedef float f32x2s __attribute__((ext_vector_type(2))); typedef __bf16 bf16x2s __attribute__((ext_vector_type(2)));
__device__ __forceinline__ unsigned s_cvtpk(float lo, float hi) { f32x2s v = {lo, hi}; bf16x2s b = __builtin_convertvector(v, bf16x2s); return __builtin_bit_cast(unsigned, b); }
__device__ __forceinline__ float s_rowsum16(float v) {
    v += __int_as_float(__builtin_amdgcn_update_dpp(0, __float_as_int(v), 0xB1, 0xf, 0xf, false));
    v += __int_as_float(__builtin_amdgcn_update_dpp(0, __float_as_int(v), 0x4E, 0xf, 0xf, false));
    v += __int_as_float(__builtin_amdgcn_update_dpp(0, __float_as_int(v), 0x141, 0xf, 0xf, false));
    v += __int_as_float(__builtin_amdgcn_update_dpp(0, __float_as_int(v), 0x140, 0xf, 0xf, false));
    return v; }
#define S_MFMA(a, b, c) __builtin_amdgcn_mfma_f32_32x32x16_bf16(a, b, c, 0, 0, 0)
#define S_PK(lo, hi) s_cvtpk(lo, hi)
#define S_SWAP(x, y) do { auto r_ = __builtin_amdgcn_permlane32_swap(x, y, false, false); x = r_[0]; y = r_[1]; } while (0)
#define S_ROWSUM16(v) s_rowsum16(v)
__device__ __forceinline__ float s_wavesum(float v) { v = s_rowsum16(v);
    v += __int_as_float(__builtin_amdgcn_ds_swizzle(__float_as_int(v), 0x401F));
    auto r_ = __builtin_amdgcn_permlane32_swap(__float_as_uint(v), __float_as_uint(v), false, false);
    return __uint_as_float(r_[0]) + __uint_as_float(r_[1]); }
#define S_WAVESUM(v) s_wavesum(v)
#define S_GAS GAS
#define S_READLANE(v, l) __int_as_float(__builtin_amdgcn_readlane(__float_as_int(v), l))
#define S_RCP(x) __builtin_amdgcn_rcpf(x)
#define S_EXP2(x) __builtin_amdgcn_exp2f(x)
#define S_LOG2(x) __builtin_amdgcn_logf(x)
#define S_RSQ(x) __builtin_amdgcn_rsqf(x)
#define S_LDS_WAIT() asm volatile("s_waitcnt lgkmcnt(0)" ::: "memory")
#define S_LDSP LAS unsigned char*
#define S_LDS_BF16P LAS bf16*
#define S_LDS_U32P LAS unsigned*
#define S_LDS_F32P LAS float*
#define S_LDS_CONST_BF16X8P const LAS bf16x8*
#define S_LDS_BF16X8P LAS bf16x8*
#define S_LDS_CONST_F32X4P const LAS f32x4*
#define S_FLAG_STORE(p, v) do { *(volatile LAS unsigned*)(p) = (v); } while (0)
#define S_FLAG_WAIT(p, v) do { unsigned sp_ = 0; while (*(volatile LAS unsigned*)(p) != (v)) { __builtin_amdgcn_s_sleep(2); if (++sp_ > (1u << 24)) break; } asm volatile("" ::: "memory"); } while (0)
struct SFrag { bf16x8 s[2]; };
struct SMat { SFrag t[2]; };
SDEV f32x16 smm(const SFrag& X, const SFrag& Y, f32x16 acc) { acc = S_MFMA(X.s[0], Y.s[0], acc); acc = S_MFMA(X.s[1], Y.s[1], acc); return acc; }
SDEV f32x16 szero() { f32x16 z; S_UNROLL for (int i = 0; i < 16; ++i) z[i] = 0.f; return z; }
SDEV SFrag spack(const f32x16& d) { SFrag f;
    S_UNROLL for (int s = 0; s < 2; ++s) { v4u w; S_UNROLL for (int q = 0; q < 4; ++q) w[q] = S_PK(d[8 * s + 2 * q], d[8 * s + 2 * q + 1]); f.s[s] = __builtin_bit_cast(bf16x8, w); }
    return f; }
SDEV f32x16 sunpack(const SFrag& f) { f32x16 d;
    S_UNROLL for (int s = 0; s < 2; ++s) { const v4u w = __builtin_bit_cast(v4u, f.s[s]); S_UNROLL for (int q = 0; q < 4; ++q) { d[8 * s + 2 * q] = __uint_as_float(w[q] << 16); d[8 * s + 2 * q + 1] = __uint_as_float(w[q] & 0xffff0000u); } }
    return d; }
SDEV SMat splain2d(const unsigned (&pp)[16]) { unsigned d0[8], d1[8];
    S_UNROLL for (int g = 0; g < 4; ++g) S_UNROLL for (int p = 0; p < 2; ++p) { unsigned x = pp[4 * g + p], y = pp[4 * g + 2 + p]; S_SWAP(x, y); d0[2 * g + p] = x; d1[2 * g + p] = y; }
    SMat m;
    S_UNROLL for (int s = 0; s < 2; ++s) { v4u a, b; S_UNROLL for (int q = 0; q < 4; ++q) { a[q] = d0[4 * s + q]; b[q] = d1[4 * s + q]; } m.t[0].s[s] = __builtin_bit_cast(bf16x8, a); m.t[1].s[s] = __builtin_bit_cast(bf16x8, b); }
    return m; }
SDEV void sd2plain(const f32x16& D0, const f32x16& D1, float (&x)[32]) {
    S_UNROLL for (int r = 0; r < 16; ++r) { unsigned a = __float_as_uint(D0[r]), b = __float_as_uint(D1[r]); S_SWAP(a, b); const int ta = (r & 3) + 8 * (r >> 2); x[ta] = __uint_as_float(a); x[ta + 4] = __uint_as_float(b); } }
SDEV SFrag sident(int n_in, int hh_in) { int n1 = n_in, r1 = 4 * hh_in; S_LAUNDER_I(n1); S_LAUNDER_I(r1); f32x16 id; S_UNROLL for (int g = 0; g < 16; ++g) id[g] = (((g & 3) + 8 * (g >> 2) + r1) == n1) ? 1.f : 0.f; return spack(id); }
SDEV void sd2plain_pk(const f32x16& D0, const f32x16& D1, unsigned (&xp)[16]) {
    S_UNROLL for (int m = 0; m < 8; ++m) { unsigned a = S_PK(D0[2 * m], D0[2 * m + 1]), b = S_PK(D1[2 * m], D1[2 * m + 1]); S_SWAP(a, b); const int qa = 4 * (m >> 1) + (m & 1); xp[qa] = a; xp[qa + 2] = b; } }
SDEV float swave_sum(float v) { return S_WAVESUM(v); }

struct ScanArgs { const S_GAS bf16* Z; const S_GAS float* mu_prev; const S_GAS float* mu_next; const S_GAS float* w0; const S_GAS float* a0; const S_GAS float* k_k; const S_GAS float* k_a; const S_GAS float* r_k; S_GAS bf16* ydir; S_GAS float* bonus; };

#define SC_W2F 0
#define SC_A2F 8192
#define SC_SIG 16384
#define SC_GTAB 24576
#define SC_FLAG 26624
#define SC_WR 28672
#define SC_AR 94208
#define SC_LDS_BYTES 126976
#define SC_PF 4

SDEV void scan2_setup(S_LDSP lds, const S_GAS float* w2, const S_GAS float* a2, int h, int dir, int tid) {
    { float wv[16];
      S_UNROLL for (int it = 0; it < 16; ++it) { const int e = tid + 512 * it; const int mat = e >> 12, r = e & 4095, jj = r & 7, ln = (r >> 3) & 63, s = (r >> 9) & 1, jt = (r >> 10) & 1, lt = (r >> 11) & 1;
          const int n = ln & 31, hh = ln >> 5, g = 8 * s + jj, l = 32 * lt + (g & 3) + 8 * (g >> 2) + 4 * hh, j = 32 * jt + n;
          wv[it] = (mat ? a2 : w2)[((size_t)dir * 64 + l) * 512 + h * 64 + j]; }
      S_UNROLL for (int it = 0; it < 16; ++it) { const int e = tid + 512 * it; const int mat = e >> 12, r = e & 4095;
          ((S_LDS_BF16P)(lds + (mat ? SC_A2F : SC_W2F)))[r] = (bf16)(S_PK(wv[it], 0.f) & 0xffffu); } }
    for (int e = tid; e < 2048; e += 512) ((S_LDS_U32P)(lds + SC_SIG))[e] = 0u;
    if (tid == 0) S_FLAG_STORE(lds + SC_FLAG, 0u);
}

SDEV void scan2_chunk(S_LDSP lds, const ScanArgs& A_in, int b_in, int h_in, int dir_in, int c, int lane_in, int wave) {
    ScanArgs A = A_in; int b = b_in, h = h_in, dir = dir_in;
    S_LAUNDER_S(A.Z); S_LAUNDER_S(A.mu_prev); S_LAUNDER_S(A.mu_next); S_LAUNDER_S(A.w0); S_LAUNDER_S(A.a0); S_LAUNDER_S(A.k_k); S_LAUNDER_S(A.k_a); S_LAUNDER_S(A.r_k); S_LAUNDER_S(A.ydir); S_LAUNDER_S(A.bonus);
    S_LAUNDER_S(b); S_LAUNDER_S(h); S_LAUNDER_S(dir);
    int lane = lane_in; S_LAUNDER_I(lane);
    const int n = lane & 31, hh = lane >> 5;
    const int sgn = dir ? -1 : 1, tau0 = dir ? (T - 1 - 32 * c) : 32 * c;
    const S_GAS bf16* zb = A.Z + (size_t)b * T * NZ;
    const ptrdiff_t st = (ptrdiff_t)sgn * NZ; const bool first = (c == 0), last = (c == T / 32 - 1);
    const int cr = ZR + h * 64 + lane, ck = ZK + h * 64 + lane, cv = ZV + h * 64 + lane, cw = ZWD + dir * 64 + lane, ca = ZAD + dir * 64 + lane, chn = h * 64 + lane;
    {   const SFrag IDF = sident(n, hh); unsigned ppw[16], ppa[16];
        { const float mA = dir ? A.mu_next[cw] : A.mu_prev[cw], mB = dir ? A.mu_prev[cw] : A.mu_next[cw], nA = dir ? A.mu_next[ca] : A.mu_prev[ca], nB = dir ? A.mu_prev[ca] : A.mu_next[ca];
          const S_GAS bf16* pw = zb + (ptrdiff_t)tau0 * NZ + cw - st; const S_GAS bf16* pa = zb + (ptrdiff_t)tau0 * NZ + ca - st;
          float rw[34], ra[34];
          S_UNROLL for (int q = 0; q < 34; ++q) { const bool ok = !((q == 0 && first) || (q == 33 && last)); rw[q] = ok ? bf2f(*pw) : 0.f; ra[q] = ok ? bf2f(*pa) : 0.f; pw += st; pa += st; }
          S_MEMBAR();
          const float mC = 1.f - mA - mB, nC = 1.f - nA - nB; float tprev = 0.f, aprev = 0.f;
          S_UNROLL for (int p = 0; p < 32; ++p) { if ((p & 7) == 0) S_MEMBAR();
              const float ws = mC * rw[p + 1] + mA * rw[p] + mB * rw[p + 2], as = nC * ra[p + 1] + nA * ra[p] + nB * ra[p + 2];
              const float tw = 1.f - 2.f * S_RCP(1.f + S_EXP2(ws * 2.885390082f));
              if (p & 1) { ppw[p >> 1] = S_PK(tprev, tw); ppa[p >> 1] = S_PK(aprev, as); S_PIN(ppw[p >> 1]); S_PIN(ppa[p >> 1]); } else { tprev = tw; aprev = as; } } }
        S_MEMBAR();
        const SMat TW = splain2d(ppw), AD = splain2d(ppa);
        SFrag TWT[2], ADT[2];
        S_UNROLL for (int lt = 0; lt < 2; ++lt) { TWT[lt] = spack(smm(TW.t[lt], IDF, szero())); ADT[lt] = spack(smm(AD.t[lt], IDF, szero())); }
        f32x16 dw[2], da[2];
        S_UNROLL for (int jt = 0; jt < 2; ++jt) { dw[jt] = szero(); da[jt] = szero();
            S_UNROLL for (int lt = 0; lt < 2; ++lt) { SFrag wf, af;
                S_UNROLL for (int s = 0; s < 2; ++s) { wf.s[s] = *(S_LDS_CONST_BF16X8P)(lds + SC_W2F + ((((lt * 2 + jt) * 2 + s) * 64 + lane) * 16)); af.s[s] = *(S_LDS_CONST_BF16X8P)(lds + SC_A2F + ((((lt * 2 + jt) * 2 + s) * 64 + lane) * 16)); }
                dw[jt] = smm(TWT[lt], wf, dw[jt]); da[jt] = smm(ADT[lt], af, da[jt]); } }
        S_UNROLL for (int jt = 0; jt < 2; ++jt) S_UNROLL for (int g = 0; g < 16; ++g) { const int t = (g & 3) + 8 * (g >> 2) + 4 * hh;
            ((S_LDS_F32P)(lds + SC_WR + wave * 8192))[t * 64 + 32 * jt + n] = dw[jt][g]; ((S_LDS_BF16P)(lds + SC_AR + wave * 4096))[t * 64 + 32 * jt + n] = (bf16)(S_PK(da[jt][g], 0.f) & 0xffffu); }
        S_LDS_WAIT();
    }
    S_MEMBAR();
    unsigned ppA[16], ppR[16], ppB[16], ppK[16], ppV[16], ppQ[16]; float gamC;
    {   const float mAr = dir ? A.mu_next[cr] : A.mu_prev[cr], mBr = dir ? A.mu_prev[cr] : A.mu_next[cr], mAk = dir ? A.mu_next[ck] : A.mu_prev[ck], mBk = dir ? A.mu_prev[ck] : A.mu_next[ck];
        const float mAv = dir ? A.mu_next[cv] : A.mu_prev[cv], mBv = dir ? A.mu_prev[cv] : A.mu_next[cv];
        const float w0j = A.w0[dir * 512 + chn], a0j = A.a0[dir * 512 + chn], kkj = A.k_k[chn], kaj = A.k_a[chn], rkj = A.r_k[chn];
        const S_GAS bf16* pr = zb + (ptrdiff_t)tau0 * NZ + cr - st; const S_GAS bf16* pk = zb + (ptrdiff_t)tau0 * NZ + ck - st; const S_GAS bf16* pv = zb + (ptrdiff_t)tau0 * NZ + cv - st;
        float rr[34], rk[34], rv[34];
        S_UNROLL for (int q = 0; q < 34; ++q) { const bool ok = !((q == 0 && first) || (q == 33 && last)); rr[q] = ok ? bf2f(*pr) : 0.f; rk[q] = ok ? bf2f(*pk) : 0.f; rv[q] = ok ? bf2f(*pv) : 0.f; pr += st; pk += st; pv += st; }
        S_MEMBAR();
        const float mCr = 1.f - mAr - mBr, mCk = 1.f - mAk - mBk, mCv = 1.f - mAv - mBv;
        float cs = 0.f, gprev = 1.f; float eA = 0.f, eR = 0.f, eB = 0.f, eK = 0.f, eV = 0.f, eQ = 0.f;
        S_UNROLL for (int p = 0; p < 32; ++p) { S_MEMBAR();
            const float r = mCr * rr[p + 1] + mAr * rr[p] + mBr * rr[p + 2], k = mCk * rk[p + 1] + mAk * rk[p] + mBk * rk[p + 2], v = mCv * rv[p + 1] + mAv * rv[p] + mBv * rv[p + 2];
            const float wraw = ((S_LDS_F32P)(lds + SC_WR + wave * 8192))[p * 64 + lane] + w0j, araw = bf2f(((S_LDS_BF16P)(lds + SC_AR + wave * 4096))[p * 64 + lane]) + a0j;
            const float x = -wraw; const float sp = fmaxf(x, 0.f) + 0.6931471806f * S_LOG2(1.f + S_EXP2(-fabsf(x) * 1.442695041f));
            const float w = -sp - 0.5f; const float lw2 = -S_EXP2(w * 1.442695041f) * 1.442695041f;
            const float al = S_RCP(1.f + S_EXP2(-araw * 1.442695041f));
            const float kkr = k * kkj; const float nrm2 = swave_sum(kkr * kkr); const float kk = kkr * S_RSQ(fmaxf(nrm2, 1e-24f));
            const float kd = k * (1.f + (al - 1.f) * kaj);
            cs += lw2; const float gam = S_EXP2(cs), ig = S_EXP2(-cs);
            const float xa = -kk * gprev, xr = r * gam, xb = kk * al * ig, xk = kd * ig, xq = xr * rkj; gprev = gam;
            if (p & 1) { ppA[p >> 1] = S_PK(eA, xa); ppR[p >> 1] = S_PK(eR, xr); ppB[p >> 1] = S_PK(eB, xb); ppK[p >> 1] = S_PK(eK, xk); ppV[p >> 1] = S_PK(eV, v); ppQ[p >> 1] = S_PK(eQ, xq);
                         S_PIN(ppQ[p >> 1]); S_PIN(ppA[p >> 1]); S_PIN(ppR[p >> 1]); S_PIN(ppB[p >> 1]); S_PIN(ppK[p >> 1]); S_PIN(ppV[p >> 1]); }
            else { eA = xa; eR = xr; eB = xb; eK = xk; eV = v; eQ = xq; } }
        gamC = gprev;
    }
    S_MEMBAR();
    float gc0, gc1; { unsigned x = __float_as_uint(gamC), y = x; S_SWAP(x, y); gc0 = __uint_as_float(x); gc1 = __uint_as_float(y); }
    ((S_LDS_F32P)(lds + SC_GTAB + wave * 256))[lane] = gamC;
    const SMat FA = splain2d(ppA), FB = splain2d(ppB), FK = splain2d(ppK), FV = splain2d(ppV);
    SFrag RT[2], MrbT, MrkT, LakT, Pf, PTf; f32x16 TT;
    {   const SFrag IDF = sident(n, hh); SFrag AT[2], BT[2], KT[2];
        { const SMat FR = splain2d(ppR); S_UNROLL for (int dt = 0; dt < 2; ++dt) RT[dt] = spack(smm(FR.t[dt], IDF, szero())); }
        SFrag QT[2]; { const SMat FQ = splain2d(ppQ); S_UNROLL for (int dt = 0; dt < 2; ++dt) QT[dt] = spack(smm(FQ.t[dt], IDF, szero())); }
        S_UNROLL for (int dt = 0; dt < 2; ++dt) { AT[dt] = spack(smm(FA.t[dt], IDF, szero())); BT[dt] = spack(smm(FB.t[dt], IDF, szero())); KT[dt] = spack(smm(FK.t[dt], IDF, szero())); }
        f32x16 L = szero(), LT = szero(), lak = szero(), mrb = szero(), mrk = szero();
        { f32x16 bq = szero(); S_UNROLL for (int dt = 0; dt < 2; ++dt) bq = smm(KT[dt], QT[dt], bq);
          int nb = n, rb = 4 * hh; S_LAUNDER_I(nb); S_LAUNDER_I(rb); float dsum = 0.f; S_UNROLL for (int g = 0; g < 16; ++g) dsum += (((g & 3) + 8 * (g >> 2) + rb) == nb) ? bq[g] : 0.f;
          if (((nb >> 2) & 1) == (rb >> 2)) A.bonus[((size_t)b * T + (tau0 + sgn * nb)) * 8 + h] = dsum; }
        S_UNROLL for (int dt = 0; dt < 2; ++dt) { L = smm(AT[dt], BT[dt], L); LT = smm(BT[dt], AT[dt], LT); lak = smm(KT[dt], AT[dt], lak); mrb = smm(BT[dt], RT[dt], mrb); mrk = smm(KT[dt], RT[dt], mrk); }
        int n2 = n, r2 = 4 * hh; S_LAUNDER_I(n2); S_LAUNDER_I(r2);
        S_UNROLL for (int g = 0; g < 16; ++g) { const int row = (g & 3) + 8 * (g >> 2) + r2;
            L[g] = (row > n2) ? L[g] : 0.f; LT[g] = (row < n2) ? LT[g] : 0.f; lak[g] = (row < n2) ? lak[g] : 0.f; mrb[g] = (row <= n2) ? mrb[g] : 0.f; mrk[g] = (row <= n2) ? mrk[g] : 0.f; }
        Pf = spack(L); PTf = spack(LT); LakT = spack(lak); MrbT = spack(mrb); MrkT = spack(mrk);
        TT = LT; S_UNROLL for (int g = 0; g < 16; ++g) TT[g] += (((g & 3) + 8 * (g >> 2) + r2) == n2) ? 1.f : 0.f;
    }
    S_MEMBAR();
    SFrag TTf = spack(TT);
    S_UNROLL for (int i = 1; i <= 4; ++i) { const f32x16 P2 = smm(PTf, Pf, szero()); SFrag P2Tf; if (i < 4) P2Tf = spack(smm(Pf, PTf, szero()));
        Pf = spack(P2); TT = smm(Pf, TTf, TT); TTf = spack(TT); if (i < 4) PTf = P2Tf; }
    S_MEMBAR();
    SFrag U0[2], Ap[2], RpT[2], Y0[2], GTf[2][2], Hf[2][2];
    S_UNROLL for (int vt = 0; vt < 2; ++vt) { const SFrag W = spack(smm(LakT, FV.t[vt], szero())); U0[vt] = spack(smm(TTf, W, szero())); }
    S_UNROLL for (int kt = 0; kt < 2; ++kt) Ap[kt] = spack(smm(TTf, FA.t[kt], szero()));
    S_UNROLL for (int kt = 0; kt < 2; ++kt) RpT[kt] = spack(smm(Ap[kt], MrbT, sunpack(RT[kt])));
    S_UNROLL for (int vt = 0; vt < 2; ++vt) Y0[vt] = spack(smm(MrkT, FV.t[vt], smm(MrbT, U0[vt], szero())));
    int n3 = n, r3 = 4 * hh; S_LAUNDER_I(n3); S_LAUNDER_I(r3);
    S_UNROLL for (int nt = 0; nt < 2; ++nt) S_UNROLL for (int mt = 0; mt < 2; ++mt) { f32x16 gt = smm(Ap[nt], FB.t[mt], szero()); const float gcv = mt ? gc1 : gc0;
        S_UNROLL for (int g = 0; g < 16; ++g) { const float idv = (nt == mt && ((g & 3) + 8 * (g >> 2) + r3) == n3) ? 1.f : 0.f; gt[g] = (gt[g] + idv) * gcv; }
        GTf[nt][mt] = spack(gt); }
    S_LDS_WAIT();
    S_UNROLL for (int mt = 0; mt < 2; ++mt) { float gr[16];
        S_UNROLL for (int q = 0; q < 4; ++q) { const f32x4 t4 = *(S_LDS_CONST_F32X4P)(lds + SC_GTAB + wave * 256 + (32 * mt + 8 * q + 4 * hh) * 4); S_UNROLL for (int i = 0; i < 4; ++i) gr[4 * q + i] = t4[i]; }
        S_UNROLL for (int vt = 0; vt < 2; ++vt) { f32x16 hm = smm(FK.t[mt], FV.t[vt], smm(FB.t[mt], U0[vt], szero())); S_UNROLL for (int g = 0; g < 16; ++g) hm[g] *= gr[g]; Hf[mt][vt] = spack(hm); } }
    S_MEMBAR();
    S_FLAG_WAIT(lds + SC_FLAG, (unsigned)c);
    SFrag SG[2][2];
    S_UNROLL for (int kt = 0; kt < 2; ++kt) S_UNROLL for (int vt = 0; vt < 2; ++vt) S_UNROLL for (int s = 0; s < 2; ++s) SG[kt][vt].s[s] = *(S_LDS_CONST_BF16X8P)(lds + SC_SIG + ((((kt * 2 + vt) * 2 + s) * 64 + lane) * 16));
    S_LDS_WAIT();
    S_UNROLL for (int mt = 0; mt < 2; ++mt) S_UNROLL for (int vt = 0; vt < 2; ++vt) { f32x16 sn = sunpack(Hf[mt][vt]); S_UNROLL for (int nt = 0; nt < 2; ++nt) sn = smm(GTf[nt][mt], SG[nt][vt], sn);
        const SFrag f = spack(sn); S_UNROLL for (int s = 0; s < 2; ++s) *(S_LDS_BF16X8P)(lds + SC_SIG + ((((mt * 2 + vt) * 2 + s) * 64 + lane) * 16)) = f.s[s]; }
    S_LDS_WAIT();
    S_FLAG_STORE(lds + SC_FLAG, (unsigned)(c + 1));
    S_UNROLL for (int vt = 0; vt < 2; ++vt) { f32x16 y = sunpack(Y0[vt]); S_UNROLL for (int kt = 0; kt < 2; ++kt) y = smm(RpT[kt], SG[kt][vt], y);
        S_UNROLL for (int g = 0; g < 16; ++g) { const int p = (g & 3) + 8 * (g >> 2) + 4 * hh; A.ydir[((size_t)b * T + (tau0 + sgn * p)) * 512 + h * 64 + 32 * vt + n] = (bf16)(S_PK(y[g], 0.f) & 0xffffu); } }
}

__device__ __forceinline__ void attn_unit(const Frame& F, ArgsP A, int b, int kvh, int qb) {
    constexpr int KST = 72, VST = 388;
    LAS bf16* KS = (LAS bf16*)F.lds;
    LAS bf16* VT = (LAS bf16*)(F.lds + 384 * KST * 2);
    LAS float* wsf = (LAS float*)(F.lds + 384 * KST * 2 + 64 * VST * 2);
    const bf16* Z = (const bf16*)(A->ws + WS_Z); bf16* OA = (bf16*)(A->ws + WS_OATT);
    const int* positions = (const int*)A->in[2]; const float* qg = (const float*)A->in[19]; const float* kg = (const float*)A->in[20]; const float* sink = (const float*)A->in[21];
    const int tid = F.tid, lane = F.lane, wave = F.wave;
    const float LN_THETA = 13.122363377404328f;
    v4u kwa[6], vwa[6], rca[6], rsa[6];
    v4u qn[4], qnc, qns;
    { const size_t tok0 = (size_t)b * T + qb * 128 + (wave & 1) * 64 + (lane & 31); const int hq0 = kvh * 4 + (wave >> 1);
#pragma unroll
      for (int sI = 0; sI < 4; ++sI) qn[sI] = *(const GAS v4u*)(Z + tok0 * NZ + ZQ + hq0 * 64 + 16 * sI + 8 * (lane >> 5));
      const GAS v4u* qrt0 = (const GAS v4u*)((const bf16*)(A->ws + WS_ROPE) + tok0 * 16); qnc = qrt0[0]; qns = qrt0[1]; }
#pragma unroll
    for (int i = 0; i < 6; ++i) { const int ct = tid + 512 * i, key = ct >> 3, ch = ct & 7; const int kp = qb * 128 - 128 + key; const bool valid = (kp >= 0) && (kp < T);
        const size_t rowoff = ((size_t)b * T + (valid ? kp : 0)) * NZ;
        kwa[i] = *(const GAS v4u*)(Z + rowoff + ZKA + kvh * 64 + ch * 8); vwa[i] = *(const GAS v4u*)(Z + rowoff + ZVA + kvh * 64 + ch * 8);
        const GAS v4u* rt = (const GAS v4u*)((const bf16*)(A->ws + WS_ROPE) + ((size_t)b * T + (valid ? kp : 0)) * 16); rca[i] = rt[0]; rsa[i] = rt[1]; }
#pragma unroll
    for (int i = 0; i < 6; ++i) { const int ct = tid + 512 * i, key = ct >> 3, ch = ct & 7; const int kp = qb * 128 - 128 + key; const bool valid = (kp >= 0) && (kp < T);
        v4u kw = kwa[i], vw = vwa[i];
        if (!valid) { kw = (v4u){0u, 0u, 0u, 0u}; vw = kw; }
        float kf[8] = {bflo(kw.x), bfhi(kw.x), bflo(kw.y), bfhi(kw.y), bflo(kw.z), bfhi(kw.z), bflo(kw.w), bfhi(kw.w)};
        float ss = 0.f;
#pragma unroll
        for (int j = 0; j < 8; ++j) ss += kf[j] * kf[j];
        ss += __shfl_xor(ss, 1); ss += __shfl_xor(ss, 2); ss += __shfl_xor(ss, 4);
        const float rs = rsqrtf(ss * (1.0f / 64.0f) + 1e-6f);
#pragma unroll
        for (int j = 0; j < 8; ++j) kf[j] = kf[j] * rs * kg[ch * 8 + j];
        float oth[8];
#pragma unroll
        for (int j = 0; j < 8; ++j) oth[j] = __shfl_xor(kf[j], 1);
        if (ch < 2) { const v4u cw = rca[i], sw = rsa[i];
            const float cs[8] = {bflo(cw.x), bfhi(cw.x), bflo(cw.y), bfhi(cw.y), bflo(cw.z), bfhi(cw.z), bflo(cw.w), bfhi(cw.w)};
            const float sn[8] = {bflo(sw.x), bfhi(sw.x), bflo(sw.y), bfhi(sw.y), bflo(sw.z), bfhi(sw.z), bflo(sw.w), bfhi(sw.w)};
#pragma unroll
            for (int j = 0; j < 8; ++j) kf[j] = (ch == 0) ? (kf[j] * cs[j] - oth[j] * sn[j]) : (kf[j] * cs[j] + oth[j] * sn[j]); }
        v4u ko; ko.x = pk2(kf[0], kf[1]); ko.y = pk2(kf[2], kf[3]); ko.z = pk2(kf[4], kf[5]); ko.w = pk2(kf[6], kf[7]);
        *(LAS v4u*)(KS + key * KST + ch * 8) = ko;
        const unsigned vv[4] = {vw.x, vw.y, vw.z, vw.w};
#pragma unroll
        for (int j = 0; j < 4; ++j) { VT[(ch * 8 + 2 * j) * VST + key] = (bf16)(vv[j] & 0xffffu); VT[(ch * 8 + 2 * j + 1) * VST + key] = (bf16)(vv[j] >> 16); } }
    __syncthreads();
    const int g = wave >> 1, hq = kvh * 4 + g, r32 = lane & 31, hh = lane >> 5;
    const float snk = sink[hq];
    float kbound; { float gm = fabsf(kg[lane]);
#pragma unroll
        for (int o = 1; o < 64; o <<= 1) gm = fmaxf(gm, __shfl_xor(gm, o));
        kbound = 8.0f * gm; }
#pragma unroll 1
    for (int qt = 0; qt < 2; ++qt) { const int qo = (wave & 1) * 64 + qt * 32, qrel = qo + r32; const size_t tok = (size_t)b * T + qb * 128 + qrel;
        float qf[4][8]; float ss = 0.f; v4u qraw[4];
#pragma unroll
        for (int sI = 0; sI < 4; ++sI) qraw[sI] = qn[sI];
        const v4u qrc = qnc, qrs = qns;
        if (qt == 0) { const size_t tok1 = tok + 32;
#pragma unroll
            for (int sI = 0; sI < 4; ++sI) qn[sI] = *(const GAS v4u*)(Z + tok1 * NZ + ZQ + hq * 64 + 16 * sI + 8 * hh);
            const GAS v4u* qrt1 = (const GAS v4u*)((const bf16*)(A->ws + WS_ROPE) + tok1 * 16); qnc = qrt1[0]; qns = qrt1[1]; }
#pragma unroll
        for (int sI = 0; sI < 4; ++sI) { const v4u qw = qraw[sI];
            qf[sI][0] = bflo(qw.x); qf[sI][1] = bfhi(qw.x); qf[sI][2] = bflo(qw.y); qf[sI][3] = bfhi(qw.y); qf[sI][4] = bflo(qw.z); qf[sI][5] = bfhi(qw.z); qf[sI][6] = bflo(qw.w); qf[sI][7] = bfhi(qw.w);
#pragma unroll
            for (int j = 0; j < 8; ++j) ss += qf[sI][j] * qf[sI][j]; }
        ss += __shfl_xor(ss, 32);
        const float rs = rsqrtf(ss * (1.0f / 64.0f) + 1e-6f) * 0.125f;
#pragma unroll
        for (int sI = 0; sI < 4; ++sI)
#pragma unroll
            for (int j = 0; j < 8; ++j) qf[sI][j] = qf[sI][j] * rs * qg[16 * sI + 8 * hh + j];
        { const v4u cw = qrc, sw = qrs;
          const float cs[8] = {bflo(cw.x), bfhi(cw.x), bflo(cw.y), bfhi(cw.y), bflo(cw.z), bfhi(cw.z), bflo(cw.w), bfhi(cw.w)}, sn[8] = {bflo(sw.x), bfhi(sw.x), bflo(sw.y), bfhi(sw.y), bflo(sw.z), bfhi(sw.z), bflo(sw.w), bfhi(sw.w)};
#pragma unroll
          for (int j = 0; j < 8; ++j) { const float oth = __shfl_xor(qf[0][j], 32); qf[0][j] = (hh == 0) ? (qf[0][j] * cs[j] - oth * sn[j]) : (qf[0][j] * cs[j] + oth * sn[j]); } }
        bf16x8 qr[4];
#pragma unroll
        for (int sI = 0; sI < 4; ++sI) { v4u w; w.x = pk2(qf[sI][0], qf[sI][1]); w.y = pk2(qf[sI][2], qf[sI][3]); w.z = pk2(qf[sI][4], qf[sI][5]); w.w = pk2(qf[sI][6], qf[sI][7]); qr[sI] = __builtin_bit_cast(bf16x8, w); }
        const int kt0 = qo >> 5;
        float qn2 = 0.f;
#pragma unroll
        for (int sI = 0; sI < 4; ++sI)
#pragma unroll
            for (int j = 0; j < 8; ++j) qn2 += qf[sI][j] * qf[sI][j];
        qn2 += __shfl_xor(qn2, 32);
        float mrun = sqrtf(qn2) * kbound * 1.02f;
        if (__any(mrun > 40.f)) { mrun = -1e30f;
#pragma unroll 1
            for (int kt = 0; kt < 9; ++kt) { const int kbase = (kt0 + kt) * 32;
                f32x16 acc = {};
#pragma unroll
                for (int sI = 0; sI < 4; ++sI) { const bf16x8 kfr = *(const LAS bf16x8*)(KS + (kbase + r32) * KST + 16 * sI + 8 * hh); acc = __builtin_amdgcn_mfma_f32_32x32x16_bf16(kfr, qr[sI], acc, 0, 0, 0); }
#pragma unroll
                for (int r = 0; r < 16; ++r) { const int ki = kbase + (r & 3) + 8 * (r >> 2) + 4 * hh; const int dq = ki - 128 - qrel, kp = qb * 128 - 128 + ki;
                    const bool ok = (dq >= -128) && (dq <= 128) && (kp >= 0) && (kp < T); mrun = fmaxf(mrun, ok ? acc[r] : -1e30f); } }
            mrun = fmaxf(mrun, __shfl_xor(mrun, 32)); }
        const float mx = fmaxf(mrun, snk);
        float lrun = 0.f; f32x16 o0 = {}, o1 = {}; const float mxl = mx * 1.442695041f; const bool edge = (qb == 0) || (qb == T / 128 - 1);
#pragma unroll 1
        for (int kt = 0; kt < 9; ++kt) { const int kbase = (kt0 + kt) * 32;
            f32x16 acc = {};
#pragma unroll
            for (int sI = 0; sI < 4; ++sI) { const bf16x8 kfr = *(const LAS bf16x8*)(KS + (kbase + r32) * KST + 16 * sI + 8 * hh); acc = __builtin_amdgcn_mfma_f32_32x32x16_bf16(kfr, qr[sI], acc, 0, 0, 0); }
            float p[16];
            if (edge || kt == 0 || kt == 8) {
#pragma unroll
                for (int r = 0; r < 16; ++r) { const int ki = kbase + (r & 3) + 8 * (r >> 2) + 4 * hh; const int dq = ki - 128 - qrel, kp = qb * 128 - 128 + ki;
                    const bool ok = (dq >= -128) && (dq <= 128) && (kp >= 0) && (kp < T); p[r] = ok ? __builtin_amdgcn_exp2f(acc[r] * 1.442695041f - mxl) : 0.f; lrun += p[r]; }
            } else {
#pragma unroll
                for (int r = 0; r < 16; ++r) { p[r] = __builtin_amdgcn_exp2f(acc[r] * 1.442695041f - mxl); lrun += p[r]; } }
#pragma unroll
            for (int sI = 0; sI < 2; ++sI) { v4u pw; pw.x = pk2(p[8 * sI + 0], p[8 * sI + 1]); pw.y = pk2(p[8 * sI + 2], p[8 * sI + 3]); pw.z = pk2(p[8 * sI + 4], p[8 * sI + 5]); pw.w = pk2(p[8 * sI + 6], p[8 * sI + 7]);
                const bf16x8 pa = __builtin_bit_cast(bf16x8, pw); const int key0 = kbase + 16 * sI + 4 * hh;
                { const u32x2 lo = *(const LAS u32x2*)(VT + r32 * VST + key0), hi = *(const LAS u32x2*)(VT + r32 * VST + key0 + 8); v4u vw; vw.x = lo.x; vw.y = lo.y; vw.z = hi.x; vw.w = hi.y;
                  o0 = __builtin_amdgcn_mfma_f32_32x32x16_bf16(pa, __builtin_bit_cast(bf16x8, vw), o0, 0, 0, 0); }
                { const u32x2 lo = *(const LAS u32x2*)(VT + (32 + r32) * VST + key0), hi = *(const LAS u32x2*)(VT + (32 + r32) * VST + key0 + 8); v4u vw; vw.x = lo.x; vw.y = lo.y; vw.z = hi.x; vw.w = hi.y;
                  o1 = __builtin_amdgcn_mfma_f32_32x32x16_bf16(pa, __builtin_bit_cast(bf16x8, vw), o1, 0, 0, 0); } } }
        lrun += __shfl_xor(lrun, 32);
        const float linv = 1.0f / (lrun + __expf(snk - mx));
        if (hh == 0) wsf[wave * 64 + r32] = linv;
        LDS_WAIT(); asm volatile("" ::: "memory");
#pragma unroll
        for (int r = 0; r < 16; ++r) { const int row = (r & 3) + 8 * (r >> 2) + 4 * hh; const float li = wsf[wave * 64 + row];
            bf16* op = OA + ((size_t)b * T + qb * 128 + qo + row) * 512 + hq * 64;
            op[r32] = (bf16)f2bf(o0[r] * li); op[32 + r32] = (bf16)f2bf(o1[r] * li); }
        LDS_WAIT(); asm volatile("" ::: "memory");
    }
    __syncthreads();
}

__device__ __forceinline__ void pg_rows(const Frame& F, ArgsP A, bf16* wout) {
    const bf16* Z = (const bf16*)(A->ws + WS_Z); const bf16* Y0 = (const bf16*)(A->ws + WS_XN); const bf16* Y1 = Y0 + (size_t)M * 512;
    bf16* Gb = (bf16*)(A->ws + WS_G); const float* bonus = (const float*)(A->ws + WS_BONUS);
    const float* mu_prev = (const float*)A->in[7]; const float* mu_next = (const float*)A->in[8]; const float* gn_w = (const float*)A->in[17]; const float* gn_b = (const float*)A->in[18];
    const int gw = F.vcu * NWAVES + F.wave, NGW = F.G * NWAVES, lane = F.lane, c0 = lane * 8, h = lane >> 3;
    float mp[8], mn[8], gw_[8], gb_[8];
#pragma unroll
    for (int j = 0; j < 8; ++j) { mp[j] = mu_prev[ZV + c0 + j]; mn[j] = mu_next[ZV + c0 + j]; gw_[j] = gn_w[c0 + j]; gb_[j] = gn_b[c0 + j]; }
#pragma unroll 1
    for (int m0 = gw; m0 < M; m0 += 4 * NGW) {
        v4u y0[4], y1[4], gv[4], z0[4], zm[4], zq[4]; float bon[4];
#pragma unroll
        for (int i = 0; i < 4; ++i) { const int m = m0 + i * NGW, t = m & (T - 1);
            y0[i] = *(const GAS v4u*)(Y0 + (size_t)m * 512 + c0); y1[i] = *(const GAS v4u*)(Y1 + (size_t)m * 512 + c0); gv[i] = *(const GAS v4u*)(Gb + (size_t)m * 512 + c0);
            z0[i] = *(const GAS v4u*)(Z + (size_t)m * NZ + ZV + c0);
            zm[i] = (v4u){0u, 0u, 0u, 0u}; zq[i] = (v4u){0u, 0u, 0u, 0u};
            if (t > 0) zm[i] = *(const GAS v4u*)(Z + (size_t)(m - 1) * NZ + ZV + c0);
            if (t < T - 1) zq[i] = *(const GAS v4u*)(Z + (size_t)(m + 1) * NZ + ZV + c0);
            bon[i] = bonus[(size_t)m * 8 + h] + bonus[(size_t)M * 8 + (size_t)m * 8 + h]; }
#pragma unroll
        for (int i = 0; i < 4; ++i) { const int m = m0 + i * NGW;
            const unsigned y0w[4] = {y0[i].x, y0[i].y, y0[i].z, y0[i].w}, y1w[4] = {y1[i].x, y1[i].y, y1[i].z, y1[i].w}, gvw[4] = {gv[i].x, gv[i].y, gv[i].z, gv[i].w};
            const unsigned z0w[4] = {z0[i].x, z0[i].y, z0[i].z, z0[i].w}, zmw[4] = {zm[i].x, zm[i].y, zm[i].z, zm[i].w}, zqw[4] = {zq[i].x, zq[i].y, zq[i].z, zq[i].w};
            float y[8], gg[8], vv[8]; float sacc = 0.f;
#pragma unroll
            for (int j = 0; j < 4; ++j) { y[2 * j] = bflo(y0w[j]) + bflo(y1w[j]); y[2 * j + 1] = bfhi(y0w[j]) + bfhi(y1w[j]); gg[2 * j] = bflo(gvw[j]); gg[2 * j + 1] = bfhi(gvw[j]);
                const float a0 = bflo(z0w[j]), a1 = bfhi(z0w[j]);
                vv[2 * j] = a0 + mp[2 * j] * (bflo(zmw[j]) - a0) + mn[2 * j] * (bflo(zqw[j]) - a0); vv[2 * j + 1] = a1 + mp[2 * j + 1] * (bfhi(zmw[j]) - a1) + mn[2 * j + 1] * (bfhi(zqw[j]) - a1);
                sacc += y[2 * j] + y[2 * j + 1]; }
            sacc += __shfl_xor(sacc, 1); sacc += __shfl_xor(sacc, 2); sacc += __shfl_xor(sacc, 4);
            const float mu = sacc * (1.0f / 64.0f); float q = 0.f;
#pragma unroll
            for (int j = 0; j < 8; ++j) { const float d = y[j] - mu; q += d * d; }
            q += __shfl_xor(q, 1); q += __shfl_xor(q, 2); q += __shfl_xor(q, 4);
            const float rstd = rsqrtf(q * (1.0f / 64.0f) + 64e-5f);
            float o[8];
#pragma unroll
            for (int j = 0; j < 8; ++j) o[j] = ((y[j] - mu) * rstd * gw_[j] + gb_[j] + bon[i] * vv[j]) * gg[j];
            v4u w; w.x = pk2(o[0], o[1]); w.y = pk2(o[2], o[3]); w.z = pk2(o[4], o[5]); w.w = pk2(o[6], o[7]);
            *(GAS v4u*)(wout + (size_t)m * 512 + c0) = w; } }
}

__device__ __forceinline__ void pj_phase(const Frame& F, ArgsP A) {
    unsigned char* ws = A->ws;
    const int gw = F.vcu * NWAVES + F.wave, NGW = F.G * NWAVES, lane = F.lane;
    { LAS float* scr = (LAS float*)(F.lds + F.wave * 16384);
      const float* w_gate = (const float*)A->in[27]; const float* w_up = (const float*)A->in[28]; const float* w_down = (const float*)A->in[29];
      bf16* WguT = (bf16*)((unsigned char*)A->out + OUT_WGUT); bf16* WdT = (bf16*)((unsigned char*)A->out + OUT_WDT);
      constexpr int PER = 512, NIT = 16 * 3 * PER;
      for (int it = gw; it < NIT; it += NGW) { const int e = it / (3 * PER), r = it % (3 * PER), which = r / PER, q = r % PER, kb = q >> 5, nb = q & 31, n0 = 32 * nb;
          if (which == 0) tr_item(w_gate + (size_t)e * 1048576, 1024, 64 * kb, n0, WguT, 1024, e * 2048 + (n0 >> 7) * 256 + (n0 & 127), scr, lane);
          else if (which == 1) tr_item(w_up + (size_t)e * 1048576, 1024, 64 * kb, n0, WguT, 1024, e * 2048 + (n0 >> 7) * 256 + 128 + (n0 & 127), scr, lane);
          else tr_item(w_down + (size_t)e * 1048576, 1024, 64 * kb, n0, WdT, 1024, e * 1024 + n0, scr, lane); }
    }
    __syncthreads();
    const float* w_router = (const float*)A->in[26]; const bf16* x1 = (const bf16*)(ws + WS_X1); const float* g2n = (const float*)A->in[25]; const float* mod = (const float*)(ws + WS_MOD);
    bf16* XN2 = (bf16*)(ws + WS_XN); float* aff = (float*)(ws + WS_AFF);
    LAS bf16* WF = (LAS bf16*)F.lds;
    LAS float* AT = (LAS float*)(F.lds + 65536); LAS float* BT = AT + 1024; LAS float* CB = BT + 1024;
    const int tile = gw, b = tile >> 7;
    for (int d = F.tid; d < 1024; d += 512) { AT[d] = g2n[d] * (1.0f + mod[(size_t)b * 6144 + 4096 + d]); BT[d] = mod[(size_t)b * 6144 + 3072 + d]; }
    __syncthreads();
#pragma unroll 4
    for (int k = 0; k < 32; ++k) { const int it = F.tid + 512 * k, jj = it & 7, ln = (it >> 3) & 63, sI = it >> 9, q = ln >> 4, e = ln & 15, d = 32 * sI + 8 * q + jj;
        const float v = AT[d] * w_router[d * 16 + e]; const unsigned hi = pk2(v, 0.f) & 0xffffu; const float lo = v - __uint_as_float(hi << 16);
        WF[it] = (bf16)hi; WF[16384 + it] = (bf16)(pk2(lo, 0.f) & 0xffffu); }
    { float c0 = 0.f, c1 = 0.f;
#pragma unroll 4
      for (int k = 0; k < 16; ++k) { const int d = lane + 64 * k; c0 += BT[d] * w_router[d * 16 + 2 * F.wave]; c1 += BT[d] * w_router[d * 16 + 2 * F.wave + 1]; }
      c0 = dpp_wave_sum(c0); c1 = dpp_wave_sum(c1); if (lane == 0) { CB[2 * F.wave] = c0; CB[2 * F.wave + 1] = c1; } }
    __syncthreads();
    if (tile < M / 16) { const int r = lane & 15, q = lane >> 4; const size_t m = (size_t)tile * 16 + r;
        float ss = 0.f;
#pragma unroll 1
        for (int hf = 0; hf < 2; ++hf) { v4u raw[16];
#pragma unroll
            for (int sI = 0; sI < 16; ++sI) raw[sI] = *(const GAS v4u*)(x1 + m * 1024 + 32 * (16 * hf + sI) + 8 * q);
#pragma unroll
            for (int sI = 0; sI < 16; ++sI) { const v4u w = raw[sI]; const float a0 = bflo(w.x), a1 = bfhi(w.x), a2 = bflo(w.y), a3 = bfhi(w.y), a4 = bflo(w.z), a5 = bfhi(w.z), a6 = bflo(w.w), a7 = bfhi(w.w);
                ss += (a0 * a0 + a1 * a1) + (a2 * a2 + a3 * a3) + (a4 * a4 + a5 * a5) + (a6 * a6 + a7 * a7); } }
        ss += __shfl_xor(ss, 16); ss += __shfl_xor(ss, 32);
        const float rs = rsqrtf(ss * (1.0f / 1024.0f) + 1e-6f);
        f32x4 ah = {0.f, 0.f, 0.f, 0.f}, al = {0.f, 0.f, 0.f, 0.f};
#pragma unroll 1
        for (int hf = 0; hf < 2; ++hf) { v4u raw[16];
#pragma unroll
            for (int sI = 0; sI < 16; ++sI) raw[sI] = *(const GAS v4u*)(x1 + m * 1024 + 32 * (16 * hf + sI) + 8 * q);
#pragma unroll
            for (int sI = 0; sI < 16; ++sI) { const int sg = 16 * hf + sI; const bf16x8 xa = __builtin_bit_cast(bf16x8, raw[sI]);
                const bf16x8 bh = *(const LAS bf16x8*)(WF + (sg * 64 + lane) * 8), bl = *(const LAS bf16x8*)(WF + 16384 + (sg * 64 + lane) * 8);
                ah = __builtin_amdgcn_mfma_f32_16x16x32_bf16(xa, bh, ah, 0, 0, 0); al = __builtin_amdgcn_mfma_f32_16x16x32_bf16(xa, bl, al, 0, 0, 0); }
#pragma unroll
            for (int sI = 0; sI < 16; ++sI) { if ((sI & 3) == 0) asm volatile("" ::: "memory");
                const int d0 = 32 * (16 * hf + sI) + 8 * q; const v4u w = raw[sI];
                const f32x4 a0 = *(const LAS f32x4*)(AT + d0), a1 = *(const LAS f32x4*)(AT + d0 + 4), b0 = *(const LAS f32x4*)(BT + d0), b1 = *(const LAS f32x4*)(BT + d0 + 4);
                v4u o; o.x = pk2(bflo(w.x) * rs * a0.x + b0.x, bfhi(w.x) * rs * a0.y + b0.y); o.y = pk2(bflo(w.y) * rs * a0.z + b0.z, bfhi(w.y) * rs * a0.w + b0.w);
                o.z = pk2(bflo(w.z) * rs * a1.x + b1.x, bfhi(w.z) * rs * a1.y + b1.y); o.w = pk2(bflo(w.w) * rs * a1.z + b1.z, bfhi(w.w) * rs * a1.w + b1.w);
                *(GAS v4u*)(XN2 + m * 1024 + d0) = o; } }
        const float cb = CB[lane & 15]; float lg[4], mx[4], ex[4], den[4];
#pragma unroll
        for (int i = 0; i < 4; ++i) { const float rsr = __shfl(rs, 4 * q + i); lg[i] = rsr * (ah[i] + al[i]) + cb; mx[i] = lg[i]; }
#pragma unroll
        for (int o = 1; o < 16; o <<= 1)
#pragma unroll
            for (int i = 0; i < 4; ++i) mx[i] = fmaxf(mx[i], __shfl_xor(mx[i], o));
#pragma unroll
        for (int i = 0; i < 4; ++i) { ex[i] = expf(lg[i] - mx[i]); den[i] = ex[i]; }
#pragma unroll
        for (int o = 1; o < 16; o <<= 1)
#pragma unroll
            for (int i = 0; i < 4; ++i) den[i] += __shfl_xor(den[i], o);
        { const int t0 = (tile & 127) * 16 + 4 * q; f32x4 av; av.x = ex[0] / den[0]; av.y = ex[1] / den[1]; av.z = ex[2] / den[2]; av.w = ex[3] / den[3];
          *(GAS f32x4*)(aff + ((size_t)b * 16 + (lane & 15)) * T + t0) = av; } }
}

__device__ __forceinline__ void pk_task(const Frame& F, ArgsP A, int b, int e) {
    unsigned char* ws = A->ws;
    const float* aff = (const float*)(ws + WS_AFF) + ((size_t)b * 16 + e) * T;
    int* slotmap = (int*)(ws + WS_SLOT); float* selaff = (float*)(ws + WS_SELAFF); int* selidx = (int*)(ws + WS_SELIDX);
    const bf16* XN2 = (const bf16*)(ws + WS_XN); bf16* XE = (bf16*)(ws + WS_XE);
    LAS unsigned* cnt = (LAS unsigned*)F.lds;
    LAS int* tokl = (LAS int*)(F.lds + 256);
    const int tid = F.tid, lane = F.lane, wave = F.wave;
    const f32x4 v4 = *(const GAS f32x4*)(aff + 4 * tid);
    const unsigned key[4] = {__float_as_uint(v4.x), __float_as_uint(v4.y), __float_as_uint(v4.z), __float_as_uint(v4.w)};
    unsigned thr = 0u;
#pragma unroll 1
    for (int bit = 31; bit >= 0; --bit) { const unsigned cand = thr | (1u << bit);
        const unsigned c = (unsigned)(__popcll(__ballot(key[0] >= cand)) + __popcll(__ballot(key[1] >= cand)) + __popcll(__ballot(key[2] >= cand)) + __popcll(__ballot(key[3] >= cand)));
        LAS unsigned* slot_ = cnt + 16 + (bit & 1) * 8;
        if (lane == 0) slot_[wave] = c;
        __syncthreads();
        unsigned tot = 0;
#pragma unroll
        for (int w = 0; w < 8; ++w) tot += slot_[w];
        if (tot >= 256u) thr = cand; }
    __syncthreads();
    int ngt = 0, neq = 0;
#pragma unroll
    for (int j = 0; j < 4; ++j) { ngt += key[j] > thr; neq += key[j] == thr; }
    int sg = ngt, se = neq;
#pragma unroll
    for (int o = 1; o < 64; o <<= 1) { const int a = __shfl_up(sg, o), c = __shfl_up(se, o); if (lane >= o) { sg += a; se += c; } }
    if (lane == 63) { cnt[wave] = (unsigned)sg; cnt[8 + wave] = (unsigned)se; }
    __syncthreads();
    int bg = 0, be = 0, totg = 0;
#pragma unroll
    for (int w = 0; w < 8; ++w) { const int a = (int)cnt[w], c = (int)cnt[8 + w]; if (w < wave) { bg += a; be += c; } totg += a; }
    int pg = bg + sg - ngt, pe = be + se - neq;
    const int need_eq = 256 - totg;
    int* smrow = slotmap + ((size_t)b * T + 4 * tid) * 16 + e;
#pragma unroll
    for (int j = 0; j < 4; ++j) { int slot = -1;
        if (key[j] > thr) { slot = pg; ++pg; } else if (key[j] == thr) { if (pe < need_eq) slot = totg + pe; ++pe; }
        smrow[j * 16] = slot;
        if (slot >= 0) { selidx[((size_t)e * 16 + b) * 256 + slot] = b * T + 4 * tid + j; selaff[((size_t)e * 16 + b) * 256 + slot] = __uint_as_float(key[j]); } }
    __syncthreads();
}

__device__ __forceinline__ void pn_rows(const Frame& F, ArgsP A, float* wout) {
    unsigned char* ws = A->ws;
    const int* slotmap = (const int*)(ws + WS_SLOT); const bf16* YE = (const bf16*)(ws + WS_XE); const float* mod = (const float*)(ws + WS_MOD); const bf16* X1 = (const bf16*)(ws + WS_X1);
    const int gw = F.vcu * NWAVES + F.wave, NGW = F.G * NWAVES, lane = F.lane;
#pragma unroll 1
    for (int m0 = gw * 16; m0 < gw * 16 + 16; m0 += 2) {
        int myslot[2]; f32x4 xv[2][4];
#pragma unroll
        for (int i = 0; i < 2; ++i) { const int m = m0 + i; myslot[i] = slotmap[(size_t)m * 16 + (lane & 15)];
#pragma unroll
            for (int hq = 0; hq < 2; ++hq) { const v4u w = *(const GAS v4u*)(X1 + (size_t)m * 1024 + hq * 512 + lane * 8);
                xv[i][2 * hq] = (f32x4){bflo(w.x), bfhi(w.x), bflo(w.y), bfhi(w.y)}; xv[i][2 * hq + 1] = (f32x4){bflo(w.z), bfhi(w.z), bflo(w.w), bfhi(w.w)}; } }
        unsigned long long msk[2]; v4u yw[2][4][2];
#pragma unroll
        for (int i = 0; i < 2; ++i) { const int b = (m0 + i) >> 11; msk[i] = __ballot(myslot[i] >= 0) & 0xffffull;
#pragma unroll
            for (int k = 0; k < 4; ++k) { const bool has = msk[i] != 0ull; const int e = has ? __builtin_ctzll(msk[i]) : 0; if (has) msk[i] &= msk[i] - 1; const int sl = __shfl(myslot[i], e);
                yw[i][k][0] = (v4u){0u, 0u, 0u, 0u}; yw[i][k][1] = (v4u){0u, 0u, 0u, 0u};
                if (has) { const GAS v4u* yr = (const GAS v4u*)(YE + (((size_t)e * 16 + b) * 256 + sl) * 1024); yw[i][k][0] = yr[lane]; yw[i][k][1] = yr[64 + lane]; } } }
#pragma unroll
        for (int i = 0; i < 2; ++i) { const int m = m0 + i, b = m >> 11;
            float acc[16];
#pragma unroll
            for (int j = 0; j < 16; ++j) acc[j] = 0.f;
#pragma unroll
            for (int k = 0; k < 4; ++k)
#pragma unroll
                for (int hlf = 0; hlf < 2; ++hlf) { const v4u w = yw[i][k][hlf];
                    acc[hlf * 8 + 0] += bflo(w.x); acc[hlf * 8 + 1] += bfhi(w.x); acc[hlf * 8 + 2] += bflo(w.y); acc[hlf * 8 + 3] += bfhi(w.y);
                    acc[hlf * 8 + 4] += bflo(w.z); acc[hlf * 8 + 5] += bfhi(w.z); acc[hlf * 8 + 6] += bflo(w.w); acc[hlf * 8 + 7] += bfhi(w.w); }
            unsigned long long mk = msk[i];
            while (mk) { const int e = __builtin_ctzll(mk); mk &= mk - 1; const int sl = __shfl(myslot[i], e);
                const GAS v4u* yr = (const GAS v4u*)(YE + (((size_t)e * 16 + b) * 256 + sl) * 1024);
#pragma unroll
                for (int hlf = 0; hlf < 2; ++hlf) { const v4u w = yr[hlf * 64 + lane];
                    acc[hlf * 8 + 0] += bflo(w.x); acc[hlf * 8 + 1] += bfhi(w.x); acc[hlf * 8 + 2] += bflo(w.y); acc[hlf * 8 + 3] += bfhi(w.y);
                    acc[hlf * 8 + 4] += bflo(w.z); acc[hlf * 8 + 5] += bfhi(w.z); acc[hlf * 8 + 6] += bflo(w.w); acc[hlf * 8 + 7] += bfhi(w.w); } }
            const float* gt2 = mod + (size_t)b * 6144 + 5120; float* orow = wout + (size_t)m * 1024;
#pragma unroll
            for (int q = 0; q < 4; ++q) { const int c = (q >> 1) * 512 + lane * 8 + (q & 1) * 4; const f32x4 g = *(const GAS f32x4*)(gt2 + c);
                f32x4 a; a.x = acc[(q >> 1) * 8 + (q & 1) * 4 + 0]; a.y = acc[(q >> 1) * 8 + (q & 1) * 4 + 1]; a.z = acc[(q >> 1) * 8 + (q & 1) * 4 + 2]; a.w = acc[(q >> 1) * 8 + (q & 1) * 4 + 3];
                *(GAS f32x4*)(orow + c) = xv[i][q] + g * a; } } }
}

__device__ __forceinline__ void mk_frame(Frame& F, LAS unsigned char* lds, int wave_s) {
    int bx = blockIdx.x, G = gridDim.x; LAUNDER(bx); LAUNDER(G);
    F.lds = lds; F.MISC = (volatile LAS unsigned*)(lds + MISC_OFF); F.ctl = nullptr;
    unsigned ones_ = ~0u; asm volatile("" : "+s"(ones_));
    int lane_ = (int)__builtin_amdgcn_mbcnt_hi(ones_, __builtin_amdgcn_mbcnt_lo(ones_, 0u)); asm volatile("" : "+v"(lane_));
    F.lane = lane_; F.wave = wave_s; F.tid = wave_s * 64 + lane_;
    F.G = G; F.vcu = (G % 8 == 0) ? (bx % 8) * (G / 8) + bx / 8 : bx;
}
__global__ void __launch_bounds__(NWAVES * 64, 2) fwd_kernel(Args args) {
    extern __shared__ __attribute__((aligned(16))) unsigned char lds[];
    LAS unsigned char* const ldsb = (LAS unsigned char*)lds;
    ArgsP ap0 = (ArgsP)__builtin_amdgcn_kernarg_segment_ptr();
    int wave_s = __builtin_amdgcn_readfirstlane((int)threadIdx.x >> 6); asm volatile("" : "+s"(wave_s));
    for (int u = threadIdx.x; u < (LDS_BYTES - LDSCTL_OFF) / 4; u += NWAVES * 64) ((LAS unsigned*)(ldsb + LDSCTL_OFF))[u] = 0u;
    __syncthreads();
#define MKBAR XcdBarrier bar; { ArgsP a_ = ap0; LAUNDER(a_); bar.bar = (unsigned*)(a_->ws + WS_CTL) + CW_BAR; bar.x = xb_xcc_id(); bar.st = (volatile LAS unsigned*)(ldsb + MISC_OFF) + 8; }
#if ONE_LAUNCH
    { MKBAR; if (threadIdx.x == 0) (void)xb_add(&bar.bar[XB_XCNT(bar.x)], 1u); }
#ifndef PHM
#define PHM 0x3fff
#endif
#define IN(k) ((PHM >> (k)) & 1)
#define SEAM(k) do { if (IN(k) && IN((k) + 1)) { MKBAR; { unsigned o_ = ~0u; asm volatile("" : "+s"(o_)); xcd_barrier(bar, wave_s == 0 && __builtin_amdgcn_mbcnt_hi(o_, __builtin_amdgcn_mbcnt_lo(o_, 0u)) == 0u); } } } while (0)
#else
    int lo, hi; { ArgsP a = ap0; LAUNDER(a); lo = a->ph_lo; hi = a->ph_hi; }
#define IN(k) (lo <= (k) && (k) < hi)
#define SEAM(k) do { } while (0)
#endif
    typedef pg8::bf16_t pb;
#ifndef REPMASK
#define REPMASK 0
#endif
#define PHASE_ARGS ArgsP ap = ap0; LAUNDER(ap); unsigned char* ws = ap->ws; (void)ws; Frame F; mk_frame(F, ldsb, wave_s); const int gw = F.vcu * NWAVES + F.wave, NGW = F.G * NWAVES; (void)gw; (void)NGW
    if (IN(0)) _Pragma("unroll 1") for (int rep_ = 0; rep_ <= ((REPMASK >> 0) & 1); ++rep_) { PHASE_ARGS; p0_prologue(F, ap); } SEAM(0);
    if (IN(1)) _Pragma("unroll 1") for (int rep_ = 0; rep_ <= ((REPMASK >> 1) & 1); ++rep_) { PHASE_ARGS; const float* x = (const float*)ap->in[0]; const float* g1 = (const float*)ap->in[5]; const float* mod = (const float*)(ws + WS_MOD); bf16* XN = (bf16*)(ws + WS_XN);
#pragma unroll 1
        for (int wv = gw; wv < M / 16; wv += NGW) {
#pragma unroll 1
          for (int k4 = 0; k4 < 4; ++k4) { const int m = wv * 16 + 4 * k4; f32x4 u[4][4]; modnorm_rows<4, false>(x, m, 1, g1, mod, 0, 1024, XN, F.lane, u);
            if (F.lane < 32) { const int mm = m + (F.lane >> 3), j = F.lane & 7; const float pos = (float)((const int*)ap->in[2])[mm];
                const float ang = pos * __expf(-(float)j * 0.125f * 13.122363377404328f); const float sn = __sinf(ang), cs = __cosf(ang);
                bf16* rt = (bf16*)(ws + WS_ROPE) + (size_t)mm * 16; rt[j] = (bf16)(pk2(cs, 0.f) & 0xffffu); rt[8 + j] = (bf16)(pk2(sn, 0.f) & 0xffffu); } } } } SEAM(1);
    if (IN(2)) _Pragma("unroll 1") for (int rep_ = 0; rep_ <= ((REPMASK >> 2) & 1); ++rep_) { PHASE_ARGS; pg8::Gemm g{(const pb*)(ws + WS_XN), (const pb*)(ws + WS_WINT), M, NZP, D}; pg8::StaticOrder S; S.init(M, NZP, F.G, (int)blockIdx.x);
        pg8::EpiZ E{(pb*)(ws + WS_Z)}; pg8::gemm_phase<pg8::EpiZ, pg8::StaticOrder, true, true>(F.lds, g, S, E, F.tid); } SEAM(2);
    if (IN(3)) {
#ifndef REP_SCAN
#define REP_SCAN 1
#endif
#ifndef REP_ATTN
#define REP_ATTN 1
#endif
      { int c0_, G_; { Frame F0; mk_frame(F0, ldsb, wave_s); c0_ = F0.vcu; G_ = F0.G; }
#pragma unroll 1
        for (int c = c0_; c < 256 * REP_SCAN; c += G_) { PHASE_ARGS; const int b = (c >> 4) & 15, h = (c >> 1) & 7, dir = c & 1;
            scan2_setup(F.lds, (const GAS float*)ap->in[10], (const GAS float*)ap->in[12], h, dir, F.tid); __syncthreads();
            const ScanArgs SA{(const GAS bf16*)(ws + WS_Z), (const GAS float*)ap->in[7], (const GAS float*)ap->in[8], (const GAS float*)ap->in[9], (const GAS float*)ap->in[11], (const GAS float*)ap->in[14], (const GAS float*)ap->in[15], (const GAS float*)ap->in[16],
                              (GAS bf16*)(ws + WS_XN) + (size_t)dir * M * 512, (GAS float*)(ws + WS_BONUS) + (size_t)dir * M * 8};
#pragma unroll 1
            for (int cc = F.wave; cc < T / 32; cc += 8) scan2_chunk(F.lds, SA, b, h, dir, cc, F.lane, F.wave);
            __syncthreads(); } }
      { PHASE_ARGS;
#pragma unroll 1
        for (int u = F.vcu; u < 512 * REP_ATTN; u += F.G) { attn_unit(F, ap, (u >> 5) & 15, (u >> 4) & 1, u & 15); } }
      { PHASE_ARGS;
        const bf16* Z = (const bf16*)(ws + WS_Z); bf16* SGD = (bf16*)(ws + WS_SGD); const float* mu_prev = (const float*)ap->in[7]; const float* mu_next = (const float*)ap->in[8];
          const int c = ZGD + 2 * F.lane; const float mp0 = mu_prev[c], mp1 = mu_prev[c + 1], mn0 = mu_next[c], mn1 = mu_next[c + 1];
#ifndef REP_SGD
#define REP_SGD 1
#endif
          const int tile = F.vcu;
          if (tile < 256) { const int pm = tile >> 1, pn = tile & 1; constexpr int RS = 136;
              LAS bf16* SG = (LAS bf16*)F.lds; LAS bf16* GT = (LAS bf16*)(F.lds + 256 * RS * 2);
              __syncthreads();
              const int mt0 = pm * 256 + F.wave * 32;
#pragma unroll 1
              for (int m0 = 0; m0 < 32; m0 += 4) { unsigned z0[4], zm[4], zq[4];
#pragma unroll
                  for (int i = 0; i < 4; ++i) { const int m = mt0 + m0 + i, t = m & (T - 1);
                      z0[i] = *(const GAS unsigned*)(Z + (size_t)m * NZ + c); zm[i] = t > 0 ? *(const GAS unsigned*)(Z + (size_t)(m - 1) * NZ + c) : 0u; zq[i] = t < T - 1 ? *(const GAS unsigned*)(Z + (size_t)(m + 1) * NZ + c) : 0u; }
#pragma unroll
                  for (int i = 0; i < 4; ++i) { const float a0 = bflo(z0[i]), a1 = bfhi(z0[i]); const float s0 = a0 + mp0 * (bflo(zm[i]) - a0) + mn0 * (bflo(zq[i]) - a0), s1 = a1 + mp1 * (bfhi(zm[i]) - a1) + mn1 * (bfhi(zq[i]) - a1);
                      *(LAS unsigned*)(SG + (F.wave * 32 + m0 + i) * RS + 2 * F.lane) = pk2(sigm(s0), sigm(s1)); } }
              __syncthreads();
              const int r32 = F.lane & 31, hh = F.lane >> 5; bf16x8 af[8];
#pragma unroll
              for (int sI = 0; sI < 8; ++sI) af[sI] = *(const LAS bf16x8*)(SG + (F.wave * 32 + r32) * RS + 16 * sI + 8 * hh);
              bf16* Gout = (bf16*)(ws + WS_G); const bf16* G2T = (const bf16*)(ws + WS_G2T);
#pragma unroll 1
              for (int hf = 0; hf < 2; ++hf) {
#pragma unroll
                  for (int i = 0; i < 4; ++i) { const int e = F.tid + 512 * i, rr = e >> 4, ch = e & 15; *(LAS v4u*)(GT + rr * RS + ch * 8) = *(const GAS v4u*)(G2T + (size_t)(256 * pn + 128 * hf + rr) * 256 + ch * 8); }
                  __syncthreads();
#pragma unroll 1
                  for (int ct = 0; ct < 4; ++ct) { f32x16 acc = {};
#pragma unroll
                      for (int sI = 0; sI < 8; ++sI) { const bf16x8 bfr = *(const LAS bf16x8*)(GT + (32 * ct + r32) * RS + 16 * sI + 8 * hh); acc = __builtin_amdgcn_mfma_f32_32x32x16_bf16(af[sI], bfr, acc, 0, 0, 0); }
#pragma unroll
                      for (int g = 0; g < 16; ++g) { const int row = (g & 3) + 8 * (g >> 2) + 4 * hh;
                          Gout[(size_t)(mt0 + row) * 512 + 256 * pn + 128 * hf + 32 * ct + r32] = (bf16)(pk2(acc[g], 0.f) & 0xffffu); } }
                  __syncthreads(); } } }
    } SEAM(4);
#ifndef REP_PG
#define REP_PG 0
#endif
    if (IN(5)) { PHASE_ARGS; if (REP_PG) pg_rows(F, ap, (bf16*)ap->out); pg_rows(F, ap, (bf16*)(ws + WS_G)); } SEAM(5);
    if (IN(6)) { PHASE_ARGS; static_assert(WS_G == WS_OATT + (size_t)M * 512 * 2 && WS_PAT == WS_PRT + (size_t)1024 * 512 * 2, "merged operand views need adjacent buffers");
        pg8::Gemm g{(const pb*)(ws + WS_OATT), (const pb*)(ws + WS_PRT), 2 * M, 2048, 512}; pg8::MergeOrder S; S.init(F.G, (int)blockIdx.x);
        pg8::EpiGate2 E{(pb*)(ws + WS_XN), (const pb*)(ws + WS_Z)}; pg8::gemm_phase<pg8::EpiGate2, pg8::MergeOrder, true, true>(F.lds, g, S, E, F.tid); } SEAM(7);
    if (IN(8)) _Pragma("unroll 1") for (int rep_ = 0; rep_ <= ((REPMASK >> 8) & 1); ++rep_) { PHASE_ARGS; pg8::Gemm g{(const pb*)(ws + WS_XN), (const pb*)(ws + WS_WOT), M, 1024, 1024}; pg8::StaticOrder S; S.init(M, 1024, F.G, (int)blockIdx.x);
        pg8::EpiRes E{(const float*)ap->in[0], (const float*)(ws + WS_MOD), (pb*)(ws + WS_X1)}; pg8::gemm_phase<pg8::EpiRes, pg8::StaticOrder, true, true>(F.lds, g, S, E, F.tid); } SEAM(8);
    if (IN(9)) _Pragma("unroll 1") for (int rep_ = 0; rep_ <= ((REPMASK >> 9) & 1); ++rep_) { PHASE_ARGS; pj_phase(F, ap); } SEAM(9);
    if (IN(10)) _Pragma("unroll 1") for (int rep_ = 0; rep_ <= ((REPMASK >> 10) & 1); ++rep_) { PHASE_ARGS; for (int p = F.vcu; p < 256; p += F.G) pk_task(F, ap, p >> 4, p & 15); } SEAM(10);
    if (IN(11)) _Pragma("unroll 1") for (int rep_ = 0; rep_ <= ((REPMASK >> 11) & 1); ++rep_) { PHASE_ARGS; pg8::Gemm g{(const pb*)(ws + WS_XN), (const pb*)((unsigned char*)ap->out + OUT_WGUT), ME, 16 * 2048, 1024}; pg8::GroupOrder<8> S{F.G, (int)blockIdx.x};
        pg8::EpiSwiglu E{(pb*)(ws + WS_H)}; pg8::gemm_phase<pg8::EpiSwiglu, pg8::GroupOrder<8>, true, true, true>(F.lds, g, S, E, F.tid, (const int*)(ws + WS_SELIDX)); } SEAM(11);
    if (IN(12)) _Pragma("unroll 1") for (int rep_ = 0; rep_ <= ((REPMASK >> 12) & 1); ++rep_) { PHASE_ARGS; pg8::Gemm g{(const pb*)(ws + WS_H), (const pb*)((unsigned char*)ap->out + OUT_WDT), ME, 16 * 1024, 1024}; pg8::GroupOrder<4> S{F.G, (int)blockIdx.x};
        pg8::EpiDown E{(pb*)(ws + WS_XE), (const float*)(ws + WS_SELAFF)}; pg8::gemm_phase<pg8::EpiDown, pg8::GroupOrder<4>, true, true>(F.lds, g, S, E, F.tid); } SEAM(12);
#ifndef EXTRA_BARS
#define EXTRA_BARS 0
#endif
#if ONE_LAUNCH
    _Pragma("unroll 1") for (int xb_ = 0; xb_ < EXTRA_BARS; ++xb_) { MKBAR; { unsigned o_ = ~0u; asm volatile("" : "+s"(o_)); xcd_barrier(bar, wave_s == 0 && __builtin_amdgcn_mbcnt_hi(o_, __builtin_amdgcn_mbcnt_lo(o_, 0u)) == 0u); } }
#endif
#ifndef REP_PN
#define REP_PN 0
#endif
    if (IN(13)) { PHASE_ARGS; if (REP_PN) pn_rows(F, ap, (float*)(ws + WS_H)); pn_rows(F, ap, ap->out); }
#undef IN
#undef SEAM
}

extern "C" void kernel_launch(void* const* d_in, const int* in_sizes, int n_in, void* d_out, int out_size, void* d_ws, size_t ws_size, hipStream_t stream) {
    static int grid = 0;
    if (grid == 0) {
        if (n_in != 30 || out_size != M * D || ws_size < WS_END) { fprintf(stderr, "kernel_launch: unexpected shapes n_in %d out %d ws %zu\n", n_in, out_size, ws_size); grid = -1; return; }
        int dev = 0, cus = 0, per_cu = 0;
        if (hipGetDevice(&dev) != hipSuccess || hipDeviceGetAttribute(&cus, hipDeviceAttributeMultiprocessorCount, dev) != hipSuccess) { grid = -1; return; }
        if (hipFuncSetAttribute((const void*)fwd_kernel, hipFuncAttributeMaxDynamicSharedMemorySize, LDS_BYTES) != hipSuccess) { fprintf(stderr, "kernel_launch: hipFuncSetAttribute failed\n"); grid = -1; return; }
        if (hipOccupancyMaxActiveBlocksPerMultiprocessor(&per_cu, (const void*)fwd_kernel, NWAVES * 64, LDS_BYTES) != hipSuccess || per_cu < 1) fprintf(stderr, "kernel_launch: occupancy query reports %d\n", per_cu);
        (void)hipGetLastError();
        grid = cus;
    }
    if (grid < 0) return;
    if (hipMemsetAsync((char*)d_ws + WS_CTL, 0, CTL_ZERO_BYTES, stream) != hipSuccess) return;
    Args a{};
    for (int i = 0; i < 30; ++i) a.in[i] = d_in[i];
    a.out = (float*)d_out; a.ws = (unsigned char*)d_ws;
#if ONE_LAUNCH
    a.ph_lo = 0; a.ph_hi = NPHASE;
    hipLaunchKernelGGL(fwd_kernel, dim3(grid), dim3(NWAVES * 64), LDS_BYTES, stream, a);
#else
    for (int p = 0; p < NPHASE; ++p) { a.ph_lo = p; a.ph_hi = p + 1; hipLaunchKernelGGL(fwd_kernel, dim3(grid), dim3(NWAVES * 64), LDS_BYTES, stream, a); }
#endif
}
```

```cpp
#include <hip/hip_runtime.h>
#include <cstdio>
#include <cstdint>
#include <cmath>
namespace pg8 {
#define PG8_LAS __attribute__((address_space(3)))
typedef unsigned short bf16_t;
typedef short bf16x8 __attribute__((ext_vector_type(8)));
typedef float f32x4 __attribute__((ext_vector_type(4)));
typedef unsigned u32x4 __attribute__((ext_vector_type(4)));
constexpr int BM = 256, BK = 64, HALF = 128, HTB = HALF * BK * 2  , STAGE_BYTES = 8 * HTB, NXCD = 8, WGM = 4;

__host__ __device__ __forceinline__ int lds_byte(int r, int c) { const int st = (r >> 4) * 2 + (c >> 5), rr = r & 15, cc = c & 31, ob = rr * 64 + cc * 2; return st * 1024 + (ob ^ (((ob >> 9) & 1) << 5)); }
__host__ __device__ __forceinline__ void stage_rc(int b, int& R, int& C) { const int st = b / 1024, sb = b % 1024, swz = sb ^ (((sb >> 9) & 1) << 5); R = (st >> 1) * 16 + swz / 64; C = (st & 1) * 32 + (swz % 64) / 2; }
__host__ __device__ __forceinline__ int perm32(int rho) { const int n = rho >> 4, i = rho & 15; return 8 * (i >> 2) + 4 * n + (i & 3); }

struct Unit { int pm, pn; };
struct Gemm { const bf16_t* A; const bf16_t* Bt; int M, N, K; };

struct StaticOrder {
    int nM, nN, nwg, G, c;
    __host__ __device__ void init(int M, int N, int G_, int c_) { nM = M / BM; nN = N / BM; nwg = nM * nN; G = G_; c = c_; }
    __host__ __device__ bool next(int i, Unit& u) const {
        const long L = (long)i * G + c; if (L >= nwg) return false;
        int wgid = (int)L; { const int q = nwg / NXCD, r = nwg % NXCD, xcd = wgid % NXCD, off = wgid / NXCD; wgid = (xcd < r ? xcd * (q + 1) : r * (q + 1) + (xcd - r) * q) + off; }
        const int nig = WGM * nN, gid = wgid / nig, fm = gid * WGM, gsz = (nM - fm) < WGM ? (nM - fm) : WGM;
        u.pm = fm + ((wgid % nig) % gsz); u.pn = (wgid % nig) / gsz; return true;
    }
    __device__ __forceinline__ void a_ready(const Unit&) const {}
    __device__ __forceinline__ void done(const Unit&) const {}
};

__device__ __forceinline__ unsigned cvt_pk_bf16(float lo, float hi) { unsigned r; asm volatile("v_cvt_pk_bf16_f32 %0, %1, %2" : "=v"(r) : "v"(lo), "v"(hi)); return r; }
typedef float f32x2 __attribute__((ext_vector_type(2)));
template <class Epi, class Sched, bool ALIGN_EPI = false, bool SP2 = false, bool GATHER = false>
__device__ __forceinline__ void gemm_phase(PG8_LAS unsigned char* lds, const Gemm g, const Sched& S, const Epi& E, int tid_in, const int* gidx = nullptr) {
    static_assert(!GATHER || SP2, "the gather variant is written for the SP2 loop");
    int tid_ = tid_in; asm volatile("" : "+v"(tid_));
    const int tid = tid_, wid = __builtin_amdgcn_readfirstlane(tid >> 6), lane = tid & 63, wr = wid >> 2, wc = wid & 3, fr = lane & 15, fq = lane >> 4;
    const int K = g.K, nt = K / BK;
    unsigned voffA[2], voffB[2];
#pragma unroll
    for (int i = 0; i < 2; ++i) { int R, C; stage_rc(tid * 16 + i * 8192, R, C); const int Rb = Epi::PERM ? ((R & ~31) + perm32(R & 31)) : R;
        voffA[i] = (unsigned)(R * K + C) * 2u; voffB[i] = (unsigned)(Rb * K + C) * 2u; }
    int gRA[2] = {0, 0}; unsigned gCA[2] = {0u, 0u}; unsigned gc[2][2] = {{0u, 0u}, {0u, 0u}}, gn[2][2] = {{0u, 0u}, {0u, 0u}};
    if constexpr (GATHER) {
#pragma unroll
        for (int i = 0; i < 2; ++i) { int R, C; stage_rc(tid * 16 + i * 8192, R, C); gRA[i] = R; gCA[i] = (unsigned)C * 2u; } }
#define PG8_GLOAD(dst, un) do { _Pragma("unroll") for (int h_ = 0; h_ < 2; ++h_) _Pragma("unroll") for (int i_ = 0; i_ < 2; ++i_) \
        dst[h_][i_] = (unsigned)gidx[(un).pm * 256 + h_ * 128 + gRA[i_]] * (unsigned)(K * 2) + gCA[i_]; } while (0)
#define PG8_STAGE_G(bufoff, gbase, nx, h) do { unsigned vo_[2] = {(nx) ? gn[h][0] : gc[h][0], (nx) ? gn[h][1] : gc[h][1]}; PG8_STAGE(bufoff, gbase, vo_); } while (0)
    const size_t kstep = (size_t)(BK * 2);
    const size_t hstep = (size_t)HALF * K * 2;
    const size_t tstep = 2 * hstep;
    const unsigned ldsw = (unsigned)wid * 1024u;
    const int aoff = lds_byte(wr * 64 + fr, fq * 8), boff = lds_byte(wc * 32 + fr, fq * 8);
#define PG8_SA(b, h) (((b) * 2 + (h)) * HTB)
#define PG8_SB(b, h) ((4 + (b) * 2 + (h)) * HTB)
#define PG8_STAGE(bufoff, gbase, voff) do { _Pragma("unroll") for (int _i = 0; _i < 2; ++_i) \
        __builtin_amdgcn_global_load_lds((const unsigned*)((const char*)(gbase) + (voff)[_i]), (PG8_LAS unsigned*)(lds + (bufoff) + ldsw + _i * 8192), 16, 0, 0); } while (0)
#define PG8_LDA(dst, b, h) do { _Pragma("unroll") for (int m = 0; m < 4; ++m) _Pragma("unroll") for (int k = 0; k < 2; ++k) dst[m][k] = *(const PG8_LAS bf16x8*)(lds + PG8_SA(b, h) + aoff + m * 2048 + k * 1024); } while (0)
#define PG8_LDB(dst, b, h) do { _Pragma("unroll") for (int n = 0; n < 2; ++n) _Pragma("unroll") for (int k = 0; k < 2; ++k) dst[n][k] = *(const PG8_LAS bf16x8*)(lds + PG8_SB(b, h) + boff + n * 2048 + k * 1024); } while (0)
#define PG8_MMA(ai, bj, At, Bt) do { __builtin_amdgcn_s_setprio(1); _Pragma("unroll") for (int m = 0; m < 4; ++m) _Pragma("unroll") for (int n = 0; n < 2; ++n) _Pragma("unroll") for (int k = 0; k < 2; ++k) \
        acc[ai][bj][m][n] = __builtin_amdgcn_mfma_f32_16x16x32_bf16(Bt[n][k], At[m][k], acc[ai][bj][m][n], 0, 0, 0); __builtin_amdgcn_s_setprio(0); } while (0)
#define PG8_WAIT_V(n) asm volatile("s_waitcnt vmcnt(" #n ")" ::: "memory")
#define PG8_WAIT_L(n) asm volatile("s_waitcnt lgkmcnt(" #n ")" ::: "memory")
#define PG8_BAR __builtin_amdgcn_s_barrier()
#define PG8_SCHED __builtin_amdgcn_sched_barrier(0)
    Unit cur, nxt; int ui = 0;
    if (!S.next(0, cur)) return;
    f32x4 acc[2][2][4][2];
#pragma unroll
    for (int a = 0; a < 2; ++a)
#pragma unroll
        for (int b = 0; b < 2; ++b)
#pragma unroll
            for (int m = 0; m < 4; ++m)
#pragma unroll
                for (int n = 0; n < 2; ++n) acc[a][b][m][n] = (f32x4){0.f, 0.f, 0.f, 0.f};
    bf16x8 At[4][2], B0[2][2], B1[2][2];
    const char* cA = GATHER ? (const char*)g.A : (const char*)g.A + (size_t)cur.pm * tstep; const char* cB = (const char*)g.Bt + (size_t)cur.pn * tstep;
    if constexpr (GATHER) { PG8_GLOAD(gc, cur); Unit n1_; if (S.next(1, n1_)) PG8_GLOAD(gn, n1_); else { gn[0][0] = gc[0][0]; gn[0][1] = gc[0][1]; gn[1][0] = gc[1][0]; gn[1][1] = gc[1][1]; } }
    S.a_ready(cur);
    if constexpr (SP2) {
        PG8_STAGE(PG8_SB(0, 0), cB, voffB); PG8_STAGE(PG8_SB(0, 1), cB + hstep, voffB);
        if constexpr (GATHER) { PG8_STAGE_G(PG8_SA(0, 0), cA, false, 0); PG8_STAGE_G(PG8_SA(0, 1), cA, false, 1); } else { PG8_STAGE(PG8_SA(0, 0), cA, voffA); PG8_STAGE(PG8_SA(0, 1), cA + hstep, voffA); }
        if (wr == 1) PG8_BAR;
        PG8_WAIT_V(2); PG8_BAR;
        PG8_STAGE(PG8_SB(1, 0), cB + kstep, voffB); if constexpr (GATHER) PG8_STAGE_G(PG8_SA(1, 0), cA + kstep, false, 0); else PG8_STAGE(PG8_SA(1, 0), cA + kstep, voffA); PG8_STAGE(PG8_SB(1, 1), cB + hstep + kstep, voffB);
        PG8_WAIT_V(6); PG8_BAR;
    } else {
        PG8_STAGE(PG8_SB(0, 0), cB, voffB); PG8_STAGE(PG8_SA(0, 0), cA, voffA); PG8_STAGE(PG8_SB(0, 1), cB + hstep, voffB); PG8_STAGE(PG8_SA(0, 1), cA + hstep, voffA);
        if (wr == 1) PG8_BAR;
        PG8_WAIT_V(4); PG8_BAR;
        PG8_STAGE(PG8_SB(1, 0), cB + kstep, voffB); PG8_STAGE(PG8_SA(1, 0), cA + kstep, voffA); PG8_STAGE(PG8_SB(1, 1), cB + hstep + kstep, voffB);
        PG8_WAIT_V(6); PG8_BAR;
    }
    for (;;) {
        const bool has_next = S.next(ui + 1, nxt);
        if constexpr (GATHER) { if (!has_next) { gn[0][0] = gc[0][0]; gn[0][1] = gc[0][1]; gn[1][0] = gc[1][0]; gn[1][1] = gc[1][1]; } }
        const char* nA = (has_next && !GATHER) ? (const char*)g.A + (size_t)nxt.pm * tstep : cA; const char* nB = has_next ? (const char*)g.Bt + (size_t)nxt.pn * tstep : cB;
        for (int t = 0; t < nt; t += 2) {
            const bool last = (t == nt - 2);
            const char* a1 = cA + (size_t)(t + 1) * kstep;
            const char* a2 = last ? nA : cA + (size_t)(t + 2) * kstep; const char* b2 = last ? nB : cB + (size_t)(t + 2) * kstep;
            const char* a3 = a2 + kstep; const char* b3 = b2 + kstep;
            if (last && has_next) S.a_ready(nxt);
            if constexpr (SP2) {
            PG8_LDB(B0, 0, 0); PG8_LDB(B1, 0, 1); PG8_SCHED; PG8_LDA(At, 0, 0); if constexpr (GATHER) PG8_STAGE_G(PG8_SA(1, 1), a1, false, 1); else PG8_STAGE(PG8_SA(1, 1), a1 + hstep, voffA);
            PG8_WAIT_V(8); PG8_WAIT_L(0); PG8_BAR; PG8_MMA(0, 0, At, B0); PG8_MMA(0, 1, At, B1); PG8_BAR; PG8_SCHED;
            PG8_LDA(At, 0, 1); PG8_STAGE(PG8_SB(0, 0), b2, voffB); PG8_STAGE(PG8_SB(0, 1), b2 + hstep, voffB); if constexpr (GATHER) PG8_STAGE_G(PG8_SA(0, 0), a2, last, 0); else PG8_STAGE(PG8_SA(0, 0), a2, voffA);
            PG8_WAIT_V(8); PG8_WAIT_L(0); PG8_BAR; PG8_MMA(1, 0, At, B0); PG8_MMA(1, 1, At, B1); PG8_BAR; PG8_SCHED;
            PG8_LDB(B0, 1, 0); PG8_LDB(B1, 1, 1); PG8_SCHED; PG8_LDA(At, 1, 0); if constexpr (GATHER) PG8_STAGE_G(PG8_SA(0, 1), a2, last, 1); else PG8_STAGE(PG8_SA(0, 1), a2 + hstep, voffA);
            PG8_WAIT_V(8); PG8_WAIT_L(0); PG8_BAR; PG8_MMA(0, 0, At, B0); PG8_MMA(0, 1, At, B1); PG8_BAR; PG8_SCHED;
            PG8_LDA(At, 1, 1); PG8_STAGE(PG8_SB(1, 0), b3, voffB); PG8_STAGE(PG8_SB(1, 1), b3 + hstep, voffB); if constexpr (GATHER) PG8_STAGE_G(PG8_SA(1, 0), a3, last, 0); else PG8_STAGE(PG8_SA(1, 0), a3, voffA);
            PG8_WAIT_V(8); PG8_WAIT_L(0); PG8_BAR; PG8_MMA(1, 0, At, B0); PG8_MMA(1, 1, At, B1); PG8_BAR; PG8_SCHED;
            } else {
            PG8_LDB(B0, 0, 0); PG8_SCHED; PG8_LDA(At, 0, 0); PG8_STAGE(PG8_SA(1, 1), a1 + hstep, voffA);
            PG8_WAIT_L(8); PG8_BAR; PG8_WAIT_L(0); PG8_MMA(0, 0, At, B0); PG8_BAR; PG8_SCHED;
            PG8_LDB(B1, 0, 1); PG8_STAGE(PG8_SB(0, 0), b2, voffB);
            PG8_BAR; PG8_WAIT_L(0); PG8_MMA(0, 1, At, B1); PG8_BAR;
            PG8_LDA(At, 0, 1); PG8_STAGE(PG8_SA(0, 0), a2, voffA);
            PG8_BAR; PG8_WAIT_L(0); PG8_MMA(1, 0, At, B0); PG8_BAR; PG8_SCHED;
            PG8_STAGE(PG8_SB(0, 1), b2 + hstep, voffB);
            PG8_WAIT_V(6); PG8_BAR; PG8_MMA(1, 1, At, B1); PG8_BAR;
            PG8_LDB(B0, 1, 0); PG8_SCHED; PG8_LDA(At, 1, 0); PG8_STAGE(PG8_SA(0, 1), a2 + hstep, voffA);
            PG8_WAIT_L(8); PG8_BAR; PG8_WAIT_L(0); PG8_MMA(0, 0, At, B0); PG8_BAR; PG8_SCHED;
            PG8_LDB(B1, 1, 1); PG8_STAGE(PG8_SB(1, 0), b3, voffB);
            PG8_BAR; PG8_WAIT_L(0); PG8_MMA(0, 1, At, B1); PG8_BAR;
            PG8_LDA(At, 1, 1); PG8_STAGE(PG8_SA(1, 0), a3, voffA);
            PG8_BAR; PG8_WAIT_L(0); PG8_MMA(1, 0, At, B0); PG8_BAR; PG8_SCHED;
            PG8_STAGE(PG8_SB(1, 1), b3 + hstep, voffB);
            PG8_WAIT_V(6); PG8_BAR; PG8_MMA(1, 1, At, B1); PG8_BAR;
            }
        }
        if constexpr (ALIGN_EPI) { if (wr == 0) PG8_BAR; }
#ifdef REP_EPI
        if constexpr (!Epi::AFTER_DRAIN) { E(acc, cur, wr, wc, fr, fq); asm volatile("" ::: "memory"); }
#endif
        if constexpr (!Epi::AFTER_DRAIN) { E(acc, cur, wr, wc, fr, fq); S.done(cur); }
        unsigned g2_[2][2] = {{0u, 0u}, {0u, 0u}};
        if constexpr (GATHER) { Unit nn_; if (has_next && S.next(ui + 2, nn_)) PG8_GLOAD(g2_, nn_); else { g2_[0][0] = gn[0][0]; g2_[0][1] = gn[0][1]; g2_[1][0] = gn[1][0]; g2_[1][1] = gn[1][1]; } }
        if (!has_next) break;
#pragma unroll
        for (int a = 0; a < 2; ++a)
#pragma unroll
            for (int b = 0; b < 2; ++b)
#pragma unroll
                for (int m = 0; m < 4; ++m)
#pragma unroll
                    for (int n = 0; n < 2; ++n) acc[a][b][m][n] = (f32x4){0.f, 0.f, 0.f, 0.f};
        cur = nxt; cA = nA; cB = nB; ++ui;
        if constexpr (GATHER) { gc[0][0] = gn[0][0]; gc[0][1] = gn[0][1]; gc[1][0] = gn[1][0]; gc[1][1] = gn[1][1]; gn[0][0] = g2_[0][0]; gn[0][1] = g2_[0][1]; gn[1][0] = g2_[1][0]; gn[1][1] = g2_[1][1]; }
        if constexpr (ALIGN_EPI) { if (wr == 1) PG8_BAR; }
    }
    PG8_WAIT_V(0);
    if constexpr (!ALIGN_EPI) { if (wr == 0) PG8_BAR; }
    PG8_BAR;
    if constexpr (Epi::AFTER_DRAIN) { E.fused(acc, cur, wr, wc, fr, fq, lds, wid, lane); S.done(cur); }
#undef PG8_SA
#undef PG8_SB
#undef PG8_STAGE
#undef PG8_STAGE_G
#undef PG8_GLOAD
#undef PG8_LDA
#undef PG8_LDB
#undef PG8_MMA
#undef PG8_WAIT_V
#undef PG8_WAIT_L
#undef PG8_BAR
#undef PG8_SCHED
}
}

#ifndef ONE_LAUNCH
#define ONE_LAUNCH 1
#endif
constexpr int NB = 16, T = 2048, D = 1024, M = NB * T;
constexpr int NZ = 4736, NZP = 4864;
constexpr int RW = 512, NE = 16, CAP = 256, ME = NE * NB * CAP;
constexpr int ZR = 0, ZK = 512, ZV = 1024, ZWD = 1536, ZAD = 1664, ZGD = 1792, ZQ = 1920, ZKA = 2432, ZVA = 2560, ZGA = 2688, ZGB = 3712;
constexpr int NWAVES = 8, NPHASE = 14;
constexpr size_t MiB = 1u << 20;
constexpr size_t WS_CTL = 0, CTL_ZERO_BYTES = 64 * 1024 + 16 * 6144 * 4;
constexpr size_t WS_MOD = 64 * 1024, WS_BONUS = 2 * MiB, WS_AFF = 4 * MiB, WS_SELAFF = 6 * MiB, WS_SLOT = 7 * MiB, WS_G2T = 9 * MiB;
constexpr size_t WS_WINT = 10 * MiB, WS_PRT = 20 * MiB, WS_PAT = 21 * MiB, WS_WOT = 22 * MiB, WS_SGD = 24 * MiB;
constexpr size_t WS_XN = 40 * MiB;
constexpr size_t WS_OATT = 104 * MiB;
constexpr size_t WS_G = 136 * MiB;
constexpr size_t WS_Z = 168 * MiB;
constexpr size_t WS_X1 = 104 * MiB;
constexpr size_t OUT_WGUT = 0;
constexpr size_t OUT_WDT = 64 * MiB;
constexpr size_t WS_XE = 200 * MiB;
constexpr size_t WS_H = 328 * MiB;
constexpr size_t WS_END = 464 * MiB;
constexpr size_t WS_ROPE = WS_AFF;
constexpr size_t WS_SELIDX = WS_SELAFF + 512 * 1024;
constexpr int CW_BAR = 4096;
constexpr int RING_BYTES = 131072, LDSCTL_OFF = RING_BYTES, MISC_OFF = LDSCTL_OFF + 320, LDS_BYTES = 147456;

#define GAS __attribute__((address_space(1)))
#define LAS __attribute__((address_space(3)))
typedef unsigned short bf16;
typedef unsigned v4u __attribute__((ext_vector_type(4)));
typedef float f32x4 __attribute__((ext_vector_type(4)));
typedef short bf16x8 __attribute__((ext_vector_type(8)));
typedef GAS unsigned gu32;
typedef GAS unsigned long long gu64;
#define RLX_AGENT __ATOMIC_RELAXED, __HIP_MEMORY_SCOPE_AGENT
#define LDS_WAIT() asm volatile("s_waitcnt lgkmcnt(0)" ::: "memory")
#define VM_WAIT() asm volatile("s_waitcnt vmcnt(0)" ::: "memory")
__device__ __forceinline__ unsigned long long rt() { return __builtin_amdgcn_s_memrealtime(); }
__device__ __forceinline__ unsigned f2bf(float f) { unsigned u = __builtin_bit_cast(unsigned, f); return (u + 0x7fffu + ((u >> 16) & 1u)) >> 16; }
typedef float f32x2hw __attribute__((ext_vector_type(2))); typedef __bf16 bf16x2hw __attribute__((ext_vector_type(2)));
__device__ __forceinline__ unsigned pk2(float lo, float hi) { f32x2hw v = {lo, hi}; bf16x2hw b = __builtin_convertvector(v, bf16x2hw); return __builtin_bit_cast(unsigned, b); }

#define XB_TMO      128
#define XB_XCNT(j)  (256  + 64 * (j))
#define XB_XSUB(j)  (1280 + 64 * (j))
#define XB_XGEN(j)  (2304 + 64 * (j))
#define XB_TOP      3328
#define XB_TOPGEN   3392
#define XCD_BAR_WORDS 3456
#define XB_SPIN_CAP (1u << 18)

__device__ __forceinline__ unsigned xb_ld(unsigned* p)              { return __hip_atomic_load(p, __ATOMIC_RELAXED, __HIP_MEMORY_SCOPE_AGENT); }
__device__ __forceinline__ unsigned xb_add(unsigned* p, unsigned v) { return __hip_atomic_fetch_add(p, v, __ATOMIC_RELAXED, __HIP_MEMORY_SCOPE_AGENT); }
__device__ __forceinline__ unsigned xb_xcc_id() { return (unsigned)__builtin_amdgcn_s_getreg((3 << 11) | 20) & 0xFu; }
#define XB_SPIN(cond, bar) do { unsigned _sp = 0; while (cond) { __builtin_amdgcn_s_sleep(1); \
    if ((++_sp & 255u) == 0u) { if (xb_ld(&(bar)[XB_TMO])) break; if (_sp > XB_SPIN_CAP) { atomicAdd(&(bar)[XB_TMO], 1u); break; } } } } while (0)

struct XcdBarrier {
    unsigned* bar; unsigned x;
    volatile LAS unsigned* st;
};

__device__ __forceinline__ XcdBarrier xcd_barrier_post(unsigned* bar, volatile LAS unsigned* st) {
    XcdBarrier b; b.bar = bar; b.x = xb_xcc_id(); b.st = st;
    if (threadIdx.x == 0) (void)xb_add(&bar[XB_XCNT(b.x)], 1u);
    return b;
}
__device__ __forceinline__ void xcd_barrier_complete(unsigned* bar, unsigned x, unsigned& nloc, unsigned& nx) {
    const unsigned G = gridDim.x * gridDim.y * gridDim.z;
    unsigned sum, cnt, mine, sp = 0u;
    for (;;) {
        sum = 0u; cnt = 0u; mine = 0u;
#pragma unroll
        for (unsigned j = 0; j < 16; ++j) { const unsigned c = xb_ld(&bar[XB_XCNT(j)]); sum += c; cnt += (c > 0u) ? 1u : 0u; mine = (j == x) ? c : mine; }
        if (sum == G) break;
        __builtin_amdgcn_s_sleep(1);
        if ((++sp & 255u) == 0u) { if (xb_ld(&bar[XB_TMO])) break; if (sp > XB_SPIN_CAP) { atomicAdd(&bar[XB_TMO], 1u); break; } }
    }
    nloc = mine > 0u ? mine : 1u; nx = cnt > 0u ? cnt : 1u;
}

__device__ __forceinline__ void xcd_barrier(const XcdBarrier& b, bool is_thread0) {
    asm volatile("s_waitcnt vmcnt(0)" ::: "memory");
    __syncthreads();
    if (is_thread0) {
        unsigned* bar = b.bar;
        __builtin_amdgcn_s_waitcnt(0);
        unsigned nloc = b.st[0], nx = b.st[1];
        if (nloc == 0u) { xcd_barrier_complete(bar, b.x, nloc, nx); b.st[0] = nloc; b.st[1] = nx; }
        const unsigned old = xb_add(&bar[XB_XSUB(b.x)], 1u);
        const unsigned gen = old / nloc;
        if (old + 1u == (gen + 1u) * nloc) {
            __builtin_amdgcn_fence(__ATOMIC_RELEASE, "agent");
            asm volatile("s_waitcnt vmcnt(0)" ::: "memory");
            const unsigned og = xb_add(&bar[XB_TOP], 1u);
            const unsigned tg = og / nx;
            if (og + 1u == (tg + 1u) * nx) xb_add(&bar[XB_TOPGEN], 1u);
            else XB_SPIN(xb_ld(&bar[XB_TOPGEN]) == tg, bar);
            __builtin_amdgcn_fence(__ATOMIC_ACQUIRE, "agent");
            xb_add(&bar[XB_XGEN(b.x)], 1u);
            asm volatile("s_waitcnt vmcnt(0)" ::: "memory");
        } else {
            XB_SPIN(xb_ld(&bar[XB_XGEN(b.x)]) == gen, bar);
            __builtin_amdgcn_fence(__ATOMIC_ACQUIRE, "agent");
            asm volatile("s_waitcnt vmcnt(0)" ::: "memory");
        }
    }
    __syncthreads();
}
namespace pg8 {
__device__ __forceinline__ float bf2f(unsigned short h) { return __uint_as_float(((unsigned)h) << 16); }
__device__ __forceinline__ float bflo(unsigned w) { return __uint_as_float(w << 16); }
__device__ __forceinline__ float bfhi(unsigned w) { return __uint_as_float(w & 0xffff0000u); }
__device__ __forceinline__ float sigm(float x) { return 1.0f / (1.0f + __expf(-x)); }
struct EpiZ { static constexpr bool PERM = true, AFTER_DRAIN = false; bf16_t* O;
    __device__ __forceinline__ void operator()(const f32x4 (&acc)[2][2][4][2], const Unit& u, int wr, int wc, int fr, int fq) const {
        const int row0 = u.pm * BM + wr * 64 + fr, col0 = u.pn * BM + wc * 32 + 8 * fq;
#pragma unroll
        for (int ai = 0; ai < 2; ++ai)
#pragma unroll
            for (int m = 0; m < 4; ++m) { bf16_t* rowp = O + (size_t)(row0 + ai * HALF + m * 16) * 4736 + col0;
#pragma unroll
                for (int bj = 0; bj < 2; ++bj) { if (u.pn * BM + bj * HALF < 4736) { const f32x4 v0 = acc[ai][bj][m][0], v1 = acc[ai][bj][m][1];
                    u32x4 w; w.x = cvt_pk_bf16(v0[0], v0[1]); w.y = cvt_pk_bf16(v0[2], v0[3]); w.z = cvt_pk_bf16(v1[0], v1[1]); w.w = cvt_pk_bf16(v1[2], v1[3]);
                    *(u32x4*)(rowp + bj * HALF) = w; } } }
    }
};
struct EpiPlain { static constexpr bool PERM = true, AFTER_DRAIN = false; bf16_t* O; int ldc;
    __device__ __forceinline__ void operator()(const f32x4 (&acc)[2][2][4][2], const Unit& u, int wr, int wc, int fr, int fq) const {
        const int row0 = u.pm * BM + wr * 64 + fr, col0 = u.pn * BM + wc * 32 + 8 * fq;
#pragma unroll
        for (int ai = 0; ai < 2; ++ai)
#pragma unroll
            for (int m = 0; m < 4; ++m) { bf16_t* rowp = O + (size_t)(row0 + ai * HALF + m * 16) * ldc + col0;
#pragma unroll
                for (int bj = 0; bj < 2; ++bj) { const f32x4 v0 = acc[ai][bj][m][0], v1 = acc[ai][bj][m][1];
                    u32x4 w; w.x = cvt_pk_bf16(v0[0], v0[1]); w.y = cvt_pk_bf16(v0[2], v0[3]); w.z = cvt_pk_bf16(v1[0], v1[1]); w.w = cvt_pk_bf16(v1[2], v1[3]);
                    *(u32x4*)(rowp + bj * HALF) = w; } }
    }
};
template <bool ADD> struct EpiGate { static constexpr bool PERM = true, AFTER_DRAIN = false; bf16_t* O; const bf16_t* Z; int zc0;
    __device__ __forceinline__ void operator()(const f32x4 (&acc)[2][2][4][2], const Unit& u, int wr, int wc, int fr, int fq) const {
        const int row0 = u.pm * BM + wr * 64 + fr, col0 = u.pn * BM + wc * 32 + 8 * fq;
#pragma unroll
        for (int ai = 0; ai < 2; ++ai)
#pragma unroll
            for (int m = 0; m < 4; ++m) { const size_t row = (size_t)(row0 + ai * HALF + m * 16); bf16_t* rowp = O + row * 1024 + col0; const bf16_t* zp = Z + row * 4736 + zc0 + col0;
#pragma unroll
                for (int bj = 0; bj < 2; ++bj) { const f32x4 v0 = acc[ai][bj][m][0], v1 = acc[ai][bj][m][1];
                    const u32x4 zg = *(const u32x4*)(zp + bj * HALF);
                    float r0 = sigm(bflo(zg.x)) * v0[0], r1 = sigm(bfhi(zg.x)) * v0[1], r2 = sigm(bflo(zg.y)) * v0[2], r3 = sigm(bfhi(zg.y)) * v0[3];
                    float r4 = sigm(bflo(zg.z)) * v1[0], r5 = sigm(bfhi(zg.z)) * v1[1], r6 = sigm(bflo(zg.w)) * v1[2], r7 = sigm(bfhi(zg.w)) * v1[3];
                    if (ADD) { const u32x4 p = *(const u32x4*)(rowp + bj * HALF);
                        r0 += bflo(p.x); r1 += bfhi(p.x); r2 += bflo(p.y); r3 += bfhi(p.y); r4 += bflo(p.z); r5 += bfhi(p.z); r6 += bflo(p.w); r7 += bfhi(p.w); }
                    u32x4 w; w.x = cvt_pk_bf16(r0, r1); w.y = cvt_pk_bf16(r2, r3); w.z = cvt_pk_bf16(r4, r5); w.w = cvt_pk_bf16(r6, r7);
                    *(u32x4*)(rowp + bj * HALF) = w; } }
    }
};
struct EpiGate2 { static constexpr bool PERM = true, AFTER_DRAIN = false; bf16_t* O; const bf16_t* Z;
    __device__ __forceinline__ void operator()(const f32x4 (&acc)[2][2][4][2], const Unit& u, int wr, int wc, int fr, int fq) const {
        const bool add = u.pm < 128; const int zc0 = add ? 3712 : 2688;
        const int row0 = (u.pm & 127) * BM + wr * 64 + fr, col0 = (u.pn & 3) * BM + wc * 32 + 8 * fq;
#pragma unroll
        for (int ai = 0; ai < 2; ++ai) {
            u32x4 zg[4][2], pv[4][2];
#pragma unroll
            for (int m = 0; m < 4; ++m) { const size_t row = (size_t)(row0 + ai * HALF + m * 16);
#pragma unroll
                for (int bj = 0; bj < 2; ++bj) { zg[m][bj] = *(const u32x4*)(Z + row * 4736 + zc0 + col0 + bj * HALF); pv[m][bj] = (u32x4){0u, 0u, 0u, 0u}; if (add) pv[m][bj] = *(const u32x4*)(O + row * 1024 + col0 + bj * HALF); } }
#pragma unroll
            for (int m = 0; m < 4; ++m) { const size_t row = (size_t)(row0 + ai * HALF + m * 16); bf16_t* rowp = O + row * 1024 + col0;
#pragma unroll
                for (int bj = 0; bj < 2; ++bj) { const f32x4 v0 = acc[ai][bj][m][0], v1 = acc[ai][bj][m][1]; const u32x4 g = zg[m][bj], p = pv[m][bj];
                    const float r0 = sigm(bflo(g.x)) * v0[0] + bflo(p.x), r1 = sigm(bfhi(g.x)) * v0[1] + bfhi(p.x), r2 = sigm(bflo(g.y)) * v0[2] + bflo(p.y), r3 = sigm(bfhi(g.y)) * v0[3] + bfhi(p.y);
                    const float r4 = sigm(bflo(g.z)) * v1[0] + bflo(p.z), r5 = sigm(bfhi(g.z)) * v1[1] + bfhi(p.z), r6 = sigm(bflo(g.w)) * v1[2] + bflo(p.w), r7 = sigm(bfhi(g.w)) * v1[3] + bfhi(p.w);
                    u32x4 w; w.x = cvt_pk_bf16(r0, r1); w.y = cvt_pk_bf16(r2, r3); w.z = cvt_pk_bf16(r4, r5); w.w = cvt_pk_bf16(r6, r7);
                    *(u32x4*)(rowp + bj * HALF) = w; } } }
    }
};
struct MergeOrder { StaticOrder S; int nu;
    __device__ __forceinline__ void init(int G, int c) { S.init(32768, 1024, G, c); nu = (512 - c + G - 1) / G; }
    __device__ __forceinline__ bool next(int i, Unit& u) const { if (i >= 2 * nu) return false; Unit t; S.next(i < nu ? i : i - nu, t);
        if (i < nu) { u.pm = 128 + t.pm; u.pn = t.pn; } else { u.pm = t.pm; u.pn = 4 + t.pn; } return true; }
    __device__ __forceinline__ void a_ready(const Unit&) const {}
    __device__ __forceinline__ void done(const Unit&) const {}
};
struct EpiRes { static constexpr bool PERM = true, AFTER_DRAIN = false; const float* X; const float* mod; bf16_t* O;
    __device__ __forceinline__ void operator()(const f32x4 (&acc)[2][2][4][2], const Unit& u, int wr, int wc, int fr, int fq) const {
        const int row0 = u.pm * BM + wr * 64 + fr, col0 = u.pn * BM + wc * 32 + 8 * fq; const int b = (u.pm * BM) >> 11;
        f32x4 gt[2][2];
#pragma unroll
        for (int bj = 0; bj < 2; ++bj)
#pragma unroll
            for (int n = 0; n < 2; ++n) gt[bj][n] = *(const f32x4*)(mod + (size_t)b * 6144 + 2048 + col0 + bj * HALF + n * 4);
#pragma unroll
        for (int ai = 0; ai < 2; ++ai) { f32x4 xv[4][2][2];
#pragma unroll
            for (int m = 0; m < 4; ++m) { const size_t off = (size_t)(row0 + ai * HALF + m * 16) * 1024 + col0;
#pragma unroll
                for (int bj = 0; bj < 2; ++bj) { xv[m][bj][0] = *(const f32x4*)(X + off + bj * HALF); xv[m][bj][1] = *(const f32x4*)(X + off + bj * HALF + 4); } }
#pragma unroll
            for (int m = 0; m < 4; ++m) { const size_t off = (size_t)(row0 + ai * HALF + m * 16) * 1024 + col0;
#pragma unroll
                for (int bj = 0; bj < 2; ++bj) { const f32x4 v0 = xv[m][bj][0] + gt[bj][0] * acc[ai][bj][m][0], v1 = xv[m][bj][1] + gt[bj][1] * acc[ai][bj][m][1];
                    u32x4 w; w.x = cvt_pk_bf16(v0[0], v0[1]); w.y = cvt_pk_bf16(v0[2], v0[3]); w.z = cvt_pk_bf16(v1[0], v1[1]); w.w = cvt_pk_bf16(v1[2], v1[3]);
                    *(u32x4*)(O + off + bj * HALF) = w; } } }
    }
};
template <int NPL> struct GroupOrder { int G, c;
    __device__ __forceinline__ bool next(int i, Unit& u) const { const int L = i * G + c; if (L >= 256 * NPL) return false;
        if (G == 256) {
            const int q = i * 32 + (c >> 3), e = (c & 7) * 2 + q / (16 * NPL), r = q % (16 * NPL), rho = r >> 5, j = r & 31;
            u.pm = e * 16 + (rho & 1) * 8 + (j & 7); u.pn = e * NPL + (rho >> 1) * 4 + (j >> 3); return true; }
        const int e = L / (16 * NPL), r = L % (16 * NPL); u.pm = e * 16 + (r % 16); u.pn = e * NPL + r / 16; return true; }
    __device__ __forceinline__ void a_ready(const Unit&) const {}
    __device__ __forceinline__ void done(const Unit&) const {}
};
struct EpiSwiglu { static constexpr bool PERM = true, AFTER_DRAIN = false; bf16_t* O;
    __device__ __forceinline__ void operator()(const f32x4 (&acc)[2][2][4][2], const Unit& u, int wr, int wc, int fr, int fq) const {
        const int row0 = u.pm * BM + wr * 64 + fr, col0 = (u.pn & 7) * 128 + wc * 32 + 8 * fq;
#pragma unroll
        for (int ai = 0; ai < 2; ++ai)
#pragma unroll
            for (int m = 0; m < 4; ++m) { bf16_t* rowp = O + (size_t)(row0 + ai * HALF + m * 16) * 1024 + col0;
                float r[8];
#pragma unroll
                for (int n = 0; n < 2; ++n)
#pragma unroll
                    for (int i = 0; i < 4; ++i) { const float g = acc[ai][0][m][n][i], up = acc[ai][1][m][n][i]; r[n * 4 + i] = g * sigm(g) * up; }
                u32x4 w; w.x = cvt_pk_bf16(r[0], r[1]); w.y = cvt_pk_bf16(r[2], r[3]); w.z = cvt_pk_bf16(r[4], r[5]); w.w = cvt_pk_bf16(r[6], r[7]);
                *(u32x4*)rowp = w; }
    }
};
struct EpiDown { static constexpr bool PERM = true, AFTER_DRAIN = false; bf16_t* O; const float* aff;
    __device__ __forceinline__ void operator()(const f32x4 (&acc)[2][2][4][2], const Unit& u, int wr, int wc, int fr, int fq) const {
        const int row0 = u.pm * BM + wr * 64 + fr, col0 = (u.pn & 3) * BM + wc * 32 + 8 * fq;
        float av[2][4];
#pragma unroll
        for (int ai = 0; ai < 2; ++ai)
#pragma unroll
            for (int m = 0; m < 4; ++m) av[ai][m] = aff[row0 + ai * HALF + m * 16];
#pragma unroll
        for (int ai = 0; ai < 2; ++ai)
#pragma unroll
            for (int m = 0; m < 4; ++m) { const int row = row0 + ai * HALF + m * 16; const float a = av[ai][m]; bf16_t* rowp = O + (size_t)row * 1024 + col0;
#pragma unroll
                for (int bj = 0; bj < 2; ++bj) { const f32x4 v0 = acc[ai][bj][m][0] * a, v1 = acc[ai][bj][m][1] * a;
                    u32x4 w; w.x = cvt_pk_bf16(v0[0], v0[1]); w.y = cvt_pk_bf16(v0[2], v0[3]); w.z = cvt_pk_bf16(v1[0], v1[1]); w.w = cvt_pk_bf16(v1[2], v1[3]);
                    *(u32x4*)(rowp + bj * HALF) = w; } }
    }
};
}

struct Frame { LAS unsigned char* lds; volatile LAS unsigned* MISC; gu32* ctl; int tid, lane, wave, vcu, G; };
struct Args { const void* in[30]; float* out; unsigned char* ws; int ph_lo, ph_hi; };
typedef const __attribute__((address_space(4))) Args* ArgsP;
#define LAUNDER(p) asm volatile("" : "+s"(p))
typedef float f32x16 __attribute__((ext_vector_type(16)));
typedef unsigned u32x2 __attribute__((ext_vector_type(2)));

__device__ __forceinline__ float wave_sum(float v) {
#pragma unroll
    for (int o = 1; o < 64; o <<= 1) v += __shfl_xor(v, o);
    return v;
}
__device__ __forceinline__ float bf2f(bf16 h) { return __uint_as_float(((unsigned)h) << 16); }
__device__ __forceinline__ float bflo(unsigned w) { return __uint_as_float(w << 16); }
__device__ __forceinline__ float bfhi(unsigned w) { return __uint_as_float(w & 0xffff0000u); }
__device__ __forceinline__ float sigm(float x) { return 1.0f / (1.0f + __expf(-x)); }

__device__ __forceinline__ void tr_item(const float* W, int N, int k0, int n0, bf16* WT, int KD, int dst_row0, LAS float* scr, int lane) {
    f32x4 v[8];
#pragma unroll
    for (int i = 0; i < 8; ++i) v[i] = *(const GAS f32x4*)(W + (size_t)(k0 + 8 * i + (lane >> 3)) * N + n0 + 4 * (lane & 7));
#pragma unroll
    for (int i = 0; i < 8; ++i) { LAS float* d = scr + (8 * i + (lane >> 3)) * 33 + 4 * (lane & 7); d[0] = v[i].x; d[1] = v[i].y; d[2] = v[i].z; d[3] = v[i].w; }
    LDS_WAIT(); asm volatile("" ::: "memory");
    const int c = lane & 7;
#pragma unroll
    for (int j = 0; j < 4; ++j) { const int n = (lane >> 3) + 8 * j; const LAS float* s = scr + (8 * c) * 33 + n;
        v4u o; o.x = pk2(s[0 * 33], s[1 * 33]); o.y = pk2(s[2 * 33], s[3 * 33]); o.z = pk2(s[4 * 33], s[5 * 33]); o.w = pk2(s[6 * 33], s[7 * 33]);
        *(GAS v4u*)(WT + (size_t)(dst_row0 + n) * KD + k0 + 8 * c) = o; }
    LDS_WAIT(); asm volatile("" ::: "memory");
}

__device__ __forceinline__ void p0_prologue(const Frame& F, ArgsP A) {
    unsigned char* ws = A->ws;
    LAS float* scr = (LAS float*)(F.lds + F.wave * 16384);
    const int gw = F.vcu * NWAVES + F.wave, NGW = F.G * NWAVES;
    const float* w_in = (const float*)A->in[6]; const float* p_rwkv = (const float*)A->in[22]; const float* p_attn = (const float*)A->in[23];
    const float* w_out = (const float*)A->in[24]; const float* g2 = (const float*)A->in[13];
    bf16* WinT = (bf16*)(ws + WS_WINT); bf16* PrT = (bf16*)(ws + WS_PRT); bf16* PaT = (bf16*)(ws + WS_PAT); bf16* WoT = (bf16*)(ws + WS_WOT); bf16* G2T = (bf16*)(ws + WS_G2T);
    constexpr int I_IN = 16 * 148, I_P = 8 * 32, I_O = 16 * 32, I_G = 2 * 16, NIT = I_IN + 2 * I_P + I_O + I_G;
    for (int it = gw; it < NIT; it += NGW) {
        int r = it;
        if (r < I_IN) { tr_item(w_in, NZ, 64 * (r / 148), 32 * (r % 148), WinT, 1024, 32 * (r % 148), scr, F.lane); continue; } r -= I_IN;
        if (r < I_P) { tr_item(p_rwkv, 1024, 64 * (r / 32), 32 * (r % 32), PrT, 512, 32 * (r % 32), scr, F.lane); continue; } r -= I_P;
        if (r < I_P) { tr_item(p_attn, 1024, 64 * (r / 32), 32 * (r % 32), PaT, 512, 32 * (r % 32), scr, F.lane); continue; } r -= I_P;
        if (r < I_O) { tr_item(w_out, 1024, 64 * (r / 32), 32 * (r % 32), WoT, 1024, 32 * (r % 32), scr, F.lane); continue; } r -= I_O;
        tr_item(g2, 512, 64 * (r / 16), 32 * (r % 16), G2T, 256, 32 * (r % 16), scr, F.lane);
    }
    { const int gt = (F.vcu * NWAVES + F.wave) * 64 + F.lane, NT = F.G * NWAVES * 64; const v4u z4 = {0u, 0u, 0u, 0u};
      for (int i = gt; i < 128 * 128; i += NT) *(GAS v4u*)(WinT + (size_t)4736 * 1024 + (size_t)i * 8) = z4;
      for (int i = gt; i < 512 * 16; i += NT) *(GAS v4u*)(G2T + (size_t)(i >> 4) * 256 + 128 + (i & 15) * 8) = z4; }
    __syncthreads();
    const float* cvec = (const float*)A->in[1]; const float* w_ada = (const float*)A->in[3]; const float* b_ada = (const float*)A->in[4];
    float* mod = (float*)(ws + WS_MOD);
    for (int task = F.vcu; task < 192; task += F.G) { const int cg = task % 96, dh = task / 96;
        LAS float* ca = (LAS float*)F.lds;
        LAS float* red = (LAS float*)(F.lds + 65536);
        for (int i = F.tid; i < 16 * 1024; i += 512) { const int b = i >> 10, d = i & 1023; const float cv = cvec[i]; ca[d * 16 + b] = cv / (1.0f + __expf(-cv)); }
        __syncthreads();
        float acc[16];
#pragma unroll
        for (int b = 0; b < 16; ++b) acc[b] = 0.f;
        const int col = cg * 64 + F.lane;
#pragma unroll 8
        for (int dd = 0; dd < 64; ++dd) { const int d = dh * 512 + F.wave * 64 + dd; const float w = w_ada[(size_t)d * 6144 + col];
            const LAS f32x4* cp = (const LAS f32x4*)(ca + d * 16);
#pragma unroll
            for (int q = 0; q < 4; ++q) { const f32x4 cv = cp[q]; acc[q * 4 + 0] += cv[0] * w; acc[q * 4 + 1] += cv[1] * w; acc[q * 4 + 2] += cv[2] * w; acc[q * 4 + 3] += cv[3] * w; } }
#pragma unroll
        for (int b = 0; b < 16; ++b) red[(F.wave * 16 + b) * 64 + F.lane] = acc[b];
        __syncthreads();
        for (int o = F.tid; o < 1024; o += 512) { const int b = o >> 6, cl = o & 63; float sacc = 0.f;
#pragma unroll
            for (int w = 0; w < 8; ++w) sacc += red[(w * 16 + b) * 64 + cl];
            atomicAdd(&mod[b * 6144 + cg * 64 + cl], sacc + (dh == 0 ? b_ada[cg * 64 + cl] : 0.f)); }
        __syncthreads();
    }
}


__device__ __forceinline__ float dpp_wave_sum(float v) {
    v += __int_as_float(__builtin_amdgcn_update_dpp(0, __float_as_int(v), 0xB1, 0xf, 0xf, false));
    v += __int_as_float(__builtin_amdgcn_update_dpp(0, __float_as_int(v), 0x4E, 0xf, 0xf, false));
    v += __int_as_float(__builtin_amdgcn_update_dpp(0, __float_as_int(v), 0x141, 0xf, 0xf, false));
    v += __int_as_float(__builtin_amdgcn_update_dpp(0, __float_as_int(v), 0x140, 0xf, 0xf, false));
    v += __int_as_float(__builtin_amdgcn_ds_swizzle(__float_as_int(v), 0x401F));
    auto r_ = __builtin_amdgcn_permlane32_swap(__float_as_uint(v), __float_as_uint(v), false, false);
    return __uint_as_float(r_[0]) + __uint_as_float(r_[1]); }

template <int R, bool XBF> __device__ __forceinline__ void modnorm_rows(const void* x, int m0, int mstride, const float* g, const float* mod, int sh_off, int sc_off, bf16* out, int lane, f32x4 (&u)[R][4]) {
    f32x4 v[R][4];
#pragma unroll
    for (int i = 0; i < R; ++i) {
        if (XBF) { const GAS u32x2* xr = (const GAS u32x2*)((const bf16*)x + (size_t)(m0 + i * mstride) * 1024) + lane;
#pragma unroll
            for (int j = 0; j < 4; ++j) { const u32x2 w = xr[64 * j]; v[i][j] = (f32x4){bflo(w.x), bfhi(w.x), bflo(w.y), bfhi(w.y)}; } }
        else { const GAS f32x4* xr = (const GAS f32x4*)((const float*)x + (size_t)(m0 + i * mstride) * 1024) + lane;
#pragma unroll
            for (int j = 0; j < 4; ++j) v[i][j] = xr[64 * j]; } }
    f32x4 gg[4];
#pragma unroll
    for (int j = 0; j < 4; ++j) gg[j] = ((const GAS f32x4*)g)[lane + 64 * j];
#pragma unroll
    for (int i = 0; i < R; ++i) { const int m = m0 + i * mstride, b = m >> 11; float s = 0.f;
#pragma unroll
        for (int j = 0; j < 4; ++j) s += (v[i][j].x * v[i][j].x + v[i][j].y * v[i][j].y) + (v[i][j].z * v[i][j].z + v[i][j].w * v[i][j].w);
        const float rs = rsqrtf(dpp_wave_sum(s) * (1.0f / 1024.0f) + 1e-6f);
        const float* sh = mod + (size_t)b * 6144 + sh_off; const float* sc = mod + (size_t)b * 6144 + sc_off;
        GAS unsigned long long* o8 = (GAS unsigned long long*)(out + (size_t)m * 1024) + lane;
#pragma unroll
        for (int j = 0; j < 4; ++j) { const f32x4 s1 = ((const GAS f32x4*)sc)[lane + 64 * j], s0 = ((const GAS f32x4*)sh)[lane + 64 * j];
            f32x4 y = (v[i][j] * rs) * gg[j]; y = y * (s1 + 1.0f) + s0; u[i][j] = y;
            o8[64 * j] = (unsigned long long)pk2(y.x, y.y) | ((unsigned long long)pk2(y.z, y.w) << 32); } }
}

template <int R> __device__ __forceinline__ void load_rows_bf16(const bf16* x, int m0, int mstride, int lane_in, u32x2 (&raw)[R][4]) {
    int lane = lane_in; asm volatile("" : "+v"(lane));
#pragma unroll
    for (int i = 0; i < R; ++i) { const GAS u32x2* xr = (const GAS u32x2*)(x + (size_t)(m0 + i * mstride) * 1024) + lane;
#pragma unroll
        for (int j = 0; j < 4; ++j) raw[i][j] = xr[64 * j]; }
}
template <int R> __device__ __forceinline__ void modnorm_rows_pre(const u32x2 (&raw)[R][4], int m0, int mstride, const float* g, const float* mod, int sh_off, int sc_off, bf16* out, int lane, f32x4 (&u)[R][4]) {
    f32x4 gg[4];
#pragma unroll
    for (int j = 0; j < 4; ++j) gg[j] = ((const GAS f32x4*)g)[lane + 64 * j];
#pragma unroll
    for (int i = 0; i < R; ++i) { const int m = m0 + i * mstride, b = m >> 11; float s = 0.f; f32x4 v[4];
#pragma unroll
        for (int j = 0; j < 4; ++j) { const u32x2 w = raw[i][j]; v[j] = (f32x4){bflo(w.x), bfhi(w.x), bflo(w.y), bfhi(w.y)}; s += (v[j].x * v[j].x + v[j].y * v[j].y) + (v[j].z * v[j].z + v[j].w * v[j].w); }
        const float rs = rsqrtf(dpp_wave_sum(s) * (1.0f / 1024.0f) + 1e-6f);
        const float* sh = mod + (size_t)b * 6144 + sh_off; const float* sc = mod + (size_t)b * 6144 + sc_off;
        GAS unsigned long long* o8 = (GAS unsigned long long*)(out + (size_t)m * 1024) + lane;
#pragma unroll
        for (int j = 0; j < 4; ++j) { const f32x4 s1 = ((const GAS f32x4*)sc)[lane + 64 * j], s0 = ((const GAS f32x4*)sh)[lane + 64 * j];
            f32x4 y = (v[j] * rs) * gg[j]; y = y * (s1 + 1.0f) + s0; u[i][j] = y;
            o8[64 * j] = (unsigned long long)pk2(y.x, y.y) | ((unsigned long long)pk2(y.z, y.w) << 32); } }
}

__device__ __forceinline__ void modnorm_row(const float* xrow, const float* g, const float* sh, const float* sc, bf16* orow, int lane, f32x4 (&u)[4]) {
    const GAS f32x4* xr = (const GAS f32x4*)xrow + lane;
    f32x4 v[4]; float s = 0.f;
#pragma unroll
    for (int j = 0; j < 4; ++j) { v[j] = xr[64 * j]; s += (v[j].x * v[j].x + v[j].y * v[j].y) + (v[j].z * v[j].z + v[j].w * v[j].w); }
    const float rs = rsqrtf(wave_sum(s) * (1.0f / 1024.0f) + 1e-6f);
    GAS unsigned long long* o8 = (GAS unsigned long long*)orow + lane;
#pragma unroll
    for (int j = 0; j < 4; ++j) { const f32x4 gg = ((const GAS f32x4*)g)[lane + 64 * j], s1 = ((const GAS f32x4*)sc)[lane + 64 * j], s0 = ((const GAS f32x4*)sh)[lane + 64 * j];
        f32x4 y = (v[j] * rs) * gg; y = y * (s1 + 1.0f) + s0; u[j] = y;
        o8[64 * j] = (unsigned long long)pk2(y.x, y.y) | ((unsigned long long)pk2(y.z, y.w) << 32); }
}

__device__ __forceinline__ float softplusf(float x) { return x > 20.f ? x : log1pf(__expf(x)); }
__device__ __forceinline__ void scan_chain(const Frame& F, ArgsP A, int b, int h, int dir) {
    constexpr int CT = 32;
    LAS float* L = (LAS float*)F.lds;
    LAS float* W2S = L; LAS float* A2S = L + 4096; LAS float* ZRs = L + 8192; LAS float* ZKs = ZRs + 2048; LAS float* ZVs = ZKs + 2048; LAS float* TWs = ZVs + 2048; LAS float* ZAs = TWs + 2048;
    LAS float* DEC = ZAs + 2048; LAS float* KD = DEC + 2048; LAS float* AV = KD + 2048; LAS float* BV = AV + 2048; LAS float* YB = BV + 2048; LAS float* BON = YB + 2048;
    const bf16* Z = (const bf16*)(A->ws + WS_Z);
    const float* mu_prev = (const float*)A->in[7]; const float* mu_next = (const float*)A->in[8];
    const float* w0 = (const float*)A->in[9]; const float* w2 = (const float*)A->in[10]; const float* a0 = (const float*)A->in[11]; const float* a2 = (const float*)A->in[12];
    const float* k_k = (const float*)A->in[14]; const float* k_a = (const float*)A->in[15]; const float* r_k = (const float*)A->in[16];
    bf16* ydir = (bf16*)(A->ws + WS_XN) + (size_t)dir * M * 512; float* bonus = (float*)(A->ws + WS_BONUS) + (size_t)dir * M * 8;
    const int tid = F.tid, lane = F.lane, wave = F.wave;
    for (int i = tid; i < 4096; i += 512) { const int l = i >> 6, j = i & 63; W2S[i] = w2[((size_t)dir * 64 + l) * 512 + h * 64 + j]; A2S[i] = a2[((size_t)dir * 64 + l) * 512 + h * 64 + j]; }
    const int ch = h * 64 + lane;
    const float w0j = w0[dir * 512 + ch], a0j = a0[dir * 512 + ch], kkj = k_k[ch], kaj = k_a[ch], rkj = r_k[ch];
    float s[8];
#pragma unroll
    for (int q = 0; q < 8; ++q) s[q] = 0.f;
    const int ri = tid >> 3, jg = tid & 7;
    for (int ci = 0; ci < T / CT; ++ci) {
        const int t0 = (dir ? (T / CT - 1 - ci) : ci) * CT;
#pragma unroll 4
        for (int i = 0; i < 20; ++i) { const int e = tid + 512 * i, arr = e >> 11, rem = e & 2047, tl = rem >> 6, j = rem & 63;
            const int col = (arr == 0 ? ZR + h * 64 : arr == 1 ? ZK + h * 64 : arr == 2 ? ZV + h * 64 : arr == 3 ? ZWD + dir * 64 : ZAD + dir * 64) + j;
            const int t = t0 + tl; const bf16* zp = Z + ((size_t)b * T + t) * NZ + col;
            const float z0 = bf2f(zp[0]), zm = t > 0 ? bf2f(zp[-NZ]) : 0.f, zq = t < T - 1 ? bf2f(zp[NZ]) : 0.f;
            float zs = z0 + mu_prev[col] * (zm - z0) + mu_next[col] * (zq - z0);
            if (arr == 3) zs = tanhf(zs);
            ZRs[arr * 2048 + rem] = zs; }
        __syncthreads();
#pragma unroll 1
        for (int q = 0; q < 4; ++q) { const int tl = wave + 8 * q;
            float wraw = w0j, araw = a0j;
#pragma unroll 8
            for (int l = 0; l < 64; ++l) { wraw += TWs[tl * 64 + l] * W2S[l * 64 + lane]; araw += ZAs[tl * 64 + l] * A2S[l * 64 + lane]; }
            const float w = -softplusf(-wraw) - 0.5f, dec = __expf(-__expf(w)), ad = sigm(araw);
            const float k = ZKs[tl * 64 + lane], kkr = k * kkj, nrm = sqrtf(wave_sum(kkr * kkr)), kk = kkr / fmaxf(nrm, 1e-12f);
            const float kd = k * (1.0f + (ad - 1.0f) * kaj);
            DEC[tl * 64 + lane] = dec; KD[tl * 64 + lane] = kd; AV[tl * 64 + lane] = -kk; BV[tl * 64 + lane] = kk * ad;
            const float bon = wave_sum(ZRs[tl * 64 + lane] * kd * rkj); if (lane == 0) BON[tl] = bon; }
        __syncthreads();
#pragma unroll 1
        for (int st = 0; st < CT; ++st) { const int tl = dir ? (CT - 1 - st) : st; const int o = tl * 64 + jg * 8;
            const f32x4 a0v = *(const LAS f32x4*)(AV + o), a1v = *(const LAS f32x4*)(AV + o + 4), d0 = *(const LAS f32x4*)(DEC + o), d1 = *(const LAS f32x4*)(DEC + o + 4);
            const f32x4 b0 = *(const LAS f32x4*)(BV + o), b1 = *(const LAS f32x4*)(BV + o + 4), k0 = *(const LAS f32x4*)(KD + o), k1 = *(const LAS f32x4*)(KD + o + 4);
            const f32x4 r0 = *(const LAS f32x4*)(ZRs + o), r1 = *(const LAS f32x4*)(ZRs + o + 4); const float vi = ZVs[tl * 64 + ri];
            float p = (s[0] * a0v[0] + s[1] * a0v[1]) + (s[2] * a0v[2] + s[3] * a0v[3]) + (s[4] * a1v[0] + s[5] * a1v[1]) + (s[6] * a1v[2] + s[7] * a1v[3]);
            p += __shfl_xor(p, 1); p += __shfl_xor(p, 2); p += __shfl_xor(p, 4);
            s[0] = s[0] * d0[0] + p * b0[0] + vi * k0[0]; s[1] = s[1] * d0[1] + p * b0[1] + vi * k0[1]; s[2] = s[2] * d0[2] + p * b0[2] + vi * k0[2]; s[3] = s[3] * d0[3] + p * b0[3] + vi * k0[3];
            s[4] = s[4] * d1[0] + p * b1[0] + vi * k1[0]; s[5] = s[5] * d1[1] + p * b1[1] + vi * k1[1]; s[6] = s[6] * d1[2] + p * b1[2] + vi * k1[2]; s[7] = s[7] * d1[3] + p * b1[3] + vi * k1[3];
            float y = (s[0] * r0[0] + s[1] * r0[1]) + (s[2] * r0[2] + s[3] * r0[3]) + (s[4] * r1[0] + s[5] * r1[1]) + (s[6] * r1[2] + s[7] * r1[3]);
            y += __shfl_xor(y, 1); y += __shfl_xor(y, 2); y += __shfl_xor(y, 4);
            if (jg == 0) YB[tl * 64 + ri] = y; }
        __syncthreads();
#pragma unroll
        for (int i = 0; i < 4; ++i) { const int e = tid + 512 * i, tl = e >> 6, c = e & 63; ydir[((size_t)b * T + t0 + tl) * 512 + h * 64 + c] = (bf16)f2bf(YB[e]); }
        if (tid < CT) bonus[((size_t)b * T + t0 + tid) * 8 + h] = BON[tid];
        __syncthreads();
    }
}


#define SDEV __device__ __forceinline__
#define S_UNROLL _Pragma("unroll")
#define S_MEMBAR() do { asm volatile("" ::: "memory"); __builtin_amdgcn_sched_barrier(0); } while (0)
#define S_LAUNDER_I(x) asm volatile("" : "+v"(x))
#define S_LAUNDER_S(x) asm volatile("" : "+s"(x))
#define S_PIN(x) asm volatile("" : "+v"(x))
typedef float f32x2s __attribute__((ext_vector_type(2))); typedef __bf16 bf16x2s __attribute__((ext_vector_type(2)));
__device__ __forceinline__ unsigned s_cvtpk(float lo, float hi) { f32x2s v = {lo, hi}; bf16x2s b = __builtin_convertvector(v, bf16x2s); return __builtin_bit_cast(unsigned, b); }
__device__ __forceinline__ float s_rowsum16(float v) {
    v += __int_as_float(__builtin_amdgcn_update_dpp(0, __float_as_int(v), 0xB1, 0xf, 0xf, false));
    v += __int_as_float(__builtin_amdgcn_update_dpp(0, __float_as_int(v), 0x4E, 0xf, 0xf, false));
    v += __int_as_float(__builtin_amdgcn_update_dpp(0, __float_as_int(v), 0x141, 0xf, 0xf, false));
    v += __int_as_float(__builtin_amdgcn_update_dpp(0, __float_as_int(v), 0x140, 0xf, 0xf, false));
    return v; }
#define S_MFMA(a, b, c) __builtin_amdgcn_mfma_f32_32x32x16_bf16(a, b, c, 0, 0, 0)
#define S_PK(lo, hi) s_cvtpk(lo, hi)
#define S_SWAP(x, y) do { auto r_ = __builtin_amdgcn_permlane32_swap(x, y, false, false); x = r_[0]; y = r_[1]; } while (0)
#define S_ROWSUM16(v) s_rowsum16(v)
__device__ __forceinline__ float s_wavesum(float v) { v = s_rowsum16(v);
    v += __int_as_float(__builtin_amdgcn_ds_swizzle(__float_as_int(v), 0x401F));
    auto r_ = __builtin_amdgcn_permlane32_swap(__float_as_uint(v), __float_as_uint(v), false, false);
    return __uint_as_float(r_[0]) + __uint_as_float(r_[1]); }
#define S_WAVESUM(v) s_wavesum(v)
#define S_SWAP16(x, y) do { auto r_ = __builtin_amdgcn_permlane16_swap(x, y, false, false); x = r_[0]; y = r_[1]; } while (0)
#define S_DPPF(v, ctrl) __int_as_float(__builtin_amdgcn_update_dpp(0, __float_as_int(v), ctrl, 0xf, 0xf, false))
__device__ __forceinline__ float s_treesum32(float (&q)[32], int lane) {
    _Pragma("unroll") for (int i = 0; i < 16; ++i) { unsigned x = __float_as_uint(q[i]), y = __float_as_uint(q[i + 16]); S_SWAP(x, y); q[i] = __uint_as_float(x) + __uint_as_float(y); }
    _Pragma("unroll") for (int i = 0; i < 8; ++i) { unsigned x = __float_as_uint(q[i]), y = __float_as_uint(q[i + 8]); S_SWAP16(x, y); q[i] = __uint_as_float(x) + __uint_as_float(y); }
    const bool b3 = (lane & 8) != 0, b2 = (lane & 4) != 0, b1 = (lane & 2) != 0;
    _Pragma("unroll") for (int i = 0; i < 4; ++i) { const float a = q[i], b = q[i + 4]; const float c = b3 ? b : a, d = b3 ? a : b; q[i] = c + S_DPPF(d, 0x140); }
    _Pragma("unroll") for (int i = 0; i < 2; ++i) { const float a = q[i], b = q[i + 2]; const float c = b2 ? b : a, d = b2 ? a : b; q[i] = c + S_DPPF(d, 0x141); }
    { const float a = q[0], b = q[1]; const float c = b1 ? b : a, d = b1 ? a : b; q[0] = c + S_DPPF(d, 0x1B); }
    return q[0] + S_DPPF(q[0], 0xB1); }
#define S_GAS GAS
#define S_READLANE(v, l) __int_as_float(__builtin_amdgcn_readlane(__float_as_int(v), l))
#define S_RCP(x) __builtin_amdgcn_rcpf(x)
#define S_EXP2(x) __builtin_amdgcn_exp2f(x)
#define S_LOG2(x) __builtin_amdgcn_logf(x)
#define S_RSQ(x) __builtin_amdgcn_rsqf(x)
#define S_LDS_WAIT() asm volatile("s_waitcnt lgkmcnt(0)" ::: "memory")
#define S_LDSP LAS unsigned char*
#define S_LDS_BF16P LAS bf16*
#define S_LDS_U32P LAS unsigned*
#define S_LDS_F32P LAS float*
#define S_LDS_CONST_BF16X8P const LAS bf16x8*
#define S_LDS_BF16X8P LAS bf16x8*
#define S_LDS_CONST_F32X4P const LAS f32x4*
#define S_LDS_CONST_F32P const LAS float*
#define S_FLAG_STORE(p, v) do { *(volatile LAS unsigned*)(p) = (v); } while (0)
#define S_FLAG_WAIT(p, v) do { unsigned sp_ = 0; while (*(volatile LAS unsigned*)(p) != (v)) { __builtin_amdgcn_s_sleep(2); if (++sp_ > (1u << 24)) break; } asm volatile("" ::: "memory"); } while (0)
struct SFrag { bf16x8 s[2]; };
struct SMat { SFrag t[2]; };
SDEV f32x16 smm(const SFrag& X, const SFrag& Y, f32x16 acc) { acc = S_MFMA(X.s[0], Y.s[0], acc); acc = S_MFMA(X.s[1], Y.s[1], acc); return acc; }
SDEV f32x16 szero() { f32x16 z; S_UNROLL for (int i = 0; i < 16; ++i) z[i] = 0.f; return z; }
SDEV SFrag spack(const f32x16& d) { SFrag f;
    S_UNROLL for (int s = 0; s < 2; ++s) { v4u w; S_UNROLL for (int q = 0; q < 4; ++q) w[q] = S_PK(d[8 * s + 2 * q], d[8 * s + 2 * q + 1]); f.s[s] = __builtin_bit_cast(bf16x8, w); }
    return f; }
SDEV f32x16 sunpack(const SFrag& f) { f32x16 d;
    S_UNROLL for (int s = 0; s < 2; ++s) { const v4u w = __builtin_bit_cast(v4u, f.s[s]); S_UNROLL for (int q = 0; q < 4; ++q) { d[8 * s + 2 * q] = __uint_as_float(w[q] << 16); d[8 * s + 2 * q + 1] = __uint_as_float(w[q] & 0xffff0000u); } }
    return d; }
SDEV SMat splain2d(const unsigned (&pp)[16]) { unsigned d0[8], d1[8];
    S_UNROLL for (int g = 0; g < 4; ++g) S_UNROLL for (int p = 0; p < 2; ++p) { unsigned x = pp[4 * g + p], y = pp[4 * g + 2 + p]; S_SWAP(x, y); d0[2 * g + p] = x; d1[2 * g + p] = y; }
    SMat m;
    S_UNROLL for (int s = 0; s < 2; ++s) { v4u a, b; S_UNROLL for (int q = 0; q < 4; ++q) { a[q] = d0[4 * s + q]; b[q] = d1[4 * s + q]; } m.t[0].s[s] = __builtin_bit_cast(bf16x8, a); m.t[1].s[s] = __builtin_bit_cast(bf16x8, b); }
    return m; }
SDEV void sd2plain(const f32x16& D0, const f32x16& D1, float (&x)[32]) {
    S_UNROLL for (int r = 0; r < 16; ++r) { unsigned a = __float_as_uint(D0[r]), b = __float_as_uint(D1[r]); S_SWAP(a, b); const int ta = (r & 3) + 8 * (r >> 2); x[ta] = __uint_as_float(a); x[ta + 4] = __uint_as_float(b); } }
SDEV SFrag sident(int n_in, int hh_in) { int n1 = n_in, r1 = 4 * hh_in; S_LAUNDER_I(n1); S_LAUNDER_I(r1); f32x16 id; S_UNROLL for (int g = 0; g < 16; ++g) id[g] = (((g & 3) + 8 * (g >> 2) + r1) == n1) ? 1.f : 0.f; return spack(id); }
SDEV void sd2plain_pk(const f32x16& D0, const f32x16& D1, unsigned (&xp)[16]) {
    S_UNROLL for (int m = 0; m < 8; ++m) { unsigned a = S_PK(D0[2 * m], D0[2 * m + 1]), b = S_PK(D1[2 * m], D1[2 * m + 1]); S_SWAP(a, b); const int qa = 4 * (m >> 1) + (m & 1); xp[qa] = a; xp[qa + 2] = b; } }
SDEV float swave_sum(float v) { return S_WAVESUM(v); }

struct ScanArgs { const S_GAS bf16* Z; const S_GAS float* mu_prev; const S_GAS float* mu_next; const S_GAS float* w0; const S_GAS float* a0; const S_GAS float* k_k; const S_GAS float* k_a; const S_GAS float* r_k; S_GAS bf16* ydir; S_GAS float* bonus; };

#define SC_W2F 0
#define SC_A2F 8192
#define SC_SIG 16384
#define SC_GTAB 24576
#define SC_FLAG 26624
#define SC_WR 28672
#define SC_AR 94208
#define SC_RSQ 126976
#define SC_LDS_BYTES 128000
#ifndef SB_ILP
#define SB_ILP 8
#endif
#define SC_PF 4

SDEV void scan2_setup(S_LDSP lds, const S_GAS float* w2, const S_GAS float* a2, int h, int dir, int tid) {
    { float wv[16];
      S_UNROLL for (int it = 0; it < 16; ++it) { const int e = tid + 512 * it; const int mat = e >> 12, r = e & 4095, jj = r & 7, ln = (r >> 3) & 63, s = (r >> 9) & 1, jt = (r >> 10) & 1, lt = (r >> 11) & 1;
          const int n = ln & 31, hh = ln >> 5, g = 8 * s + jj, l = 32 * lt + (g & 3) + 8 * (g >> 2) + 4 * hh, j = 32 * jt + n;
          wv[it] = (mat ? a2 : w2)[((size_t)dir * 64 + l) * 512 + h * 64 + j]; }
      S_UNROLL for (int it = 0; it < 16; ++it) { const int e = tid + 512 * it; const int mat = e >> 12, r = e & 4095;
          ((S_LDS_BF16P)(lds + (mat ? SC_A2F : SC_W2F)))[r] = (bf16)(S_PK(wv[it], 0.f) & 0xffffu); } }
    for (int e = tid; e < 2048; e += 512) ((S_LDS_U32P)(lds + SC_SIG))[e] = 0u;
    if (tid == 0) S_FLAG_STORE(lds + SC_FLAG, 0u);
}

SDEV void scan2_chunk(S_LDSP lds, const ScanArgs& A_in, int b_in, int h_in, int dir_in, int c, int lane_in, int wave) {
    ScanArgs A = A_in; int b = b_in, h = h_in, dir = dir_in;
    S_LAUNDER_S(A.Z); S_LAUNDER_S(A.mu_prev); S_LAUNDER_S(A.mu_next); S_LAUNDER_S(A.w0); S_LAUNDER_S(A.a0); S_LAUNDER_S(A.k_k); S_LAUNDER_S(A.k_a); S_LAUNDER_S(A.r_k); S_LAUNDER_S(A.ydir); S_LAUNDER_S(A.bonus);
    S_LAUNDER_S(b); S_LAUNDER_S(h); S_LAUNDER_S(dir);
    int lane = lane_in; S_LAUNDER_I(lane);
    const int n = lane & 31, hh = lane >> 5;
    const int sgn = dir ? -1 : 1, tau0 = dir ? (T - 1 - 32 * c) : 32 * c;
    const S_GAS bf16* zb = A.Z + (size_t)b * T * NZ;
    const ptrdiff_t st = (ptrdiff_t)sgn * NZ; const bool first = (c == 0), last = (c == T / 32 - 1);
    const int cr = ZR + h * 64 + lane, ck = ZK + h * 64 + lane, cv = ZV + h * 64 + lane, cw = ZWD + dir * 64 + lane, ca = ZAD + dir * 64 + lane, chn = h * 64 + lane;
    {   const SFrag IDF = sident(n, hh); unsigned ppw[16], ppa[16];
        { const float mA = dir ? A.mu_next[cw] : A.mu_prev[cw], mB = dir ? A.mu_prev[cw] : A.mu_next[cw], nA = dir ? A.mu_next[ca] : A.mu_prev[ca], nB = dir ? A.mu_prev[ca] : A.mu_next[ca];
          const S_GAS bf16* pw = zb + (ptrdiff_t)tau0 * NZ + cw - st; const S_GAS bf16* pa = zb + (ptrdiff_t)tau0 * NZ + ca - st;
          float rw[34], ra[34];
          S_UNROLL for (int q = 0; q < 34; ++q) { const bool ok = !((q == 0 && first) || (q == 33 && last)); rw[q] = ok ? bf2f(*pw) : 0.f; ra[q] = ok ? bf2f(*pa) : 0.f; pw += st; pa += st; }
          S_MEMBAR();
          const float mC = 1.f - mA - mB, nC = 1.f - nA - nB; float tprev = 0.f, aprev = 0.f;
          S_UNROLL for (int p = 0; p < 32; ++p) { if ((p & 7) == 0) S_MEMBAR();
              const float ws = mC * rw[p + 1] + mA * rw[p] + mB * rw[p + 2], as = nC * ra[p + 1] + nA * ra[p] + nB * ra[p + 2];
              const float tw = 1.f - 2.f * S_RCP(1.f + S_EXP2(ws * 2.885390082f));
              if (p & 1) { ppw[p >> 1] = S_PK(tprev, tw); ppa[p >> 1] = S_PK(aprev, as); S_PIN(ppw[p >> 1]); S_PIN(ppa[p >> 1]); } else { tprev = tw; aprev = as; } } }
        S_MEMBAR();
        const SMat TW = splain2d(ppw), AD = splain2d(ppa);
        SFrag TWT[2], ADT[2];
        S_UNROLL for (int lt = 0; lt < 2; ++lt) { TWT[lt] = spack(smm(TW.t[lt], IDF, szero())); ADT[lt] = spack(smm(AD.t[lt], IDF, szero())); }
        f32x16 dw[2], da[2];
        S_UNROLL for (int jt = 0; jt < 2; ++jt) { dw[jt] = szero(); da[jt] = szero();
            S_UNROLL for (int lt = 0; lt < 2; ++lt) { SFrag wf, af;
                S_UNROLL for (int s = 0; s < 2; ++s) { wf.s[s] = *(S_LDS_CONST_BF16X8P)(lds + SC_W2F + ((((lt * 2 + jt) * 2 + s) * 64 + lane) * 16)); af.s[s] = *(S_LDS_CONST_BF16X8P)(lds + SC_A2F + ((((lt * 2 + jt) * 2 + s) * 64 + lane) * 16)); }
                dw[jt] = smm(TWT[lt], wf, dw[jt]); da[jt] = smm(ADT[lt], af, da[jt]); } }
        S_UNROLL for (int jt = 0; jt < 2; ++jt) S_UNROLL for (int g = 0; g < 16; ++g) { const int t = (g & 3) + 8 * (g >> 2) + 4 * hh;
            ((S_LDS_F32P)(lds + SC_WR + wave * 8192))[t * 64 + 32 * jt + n] = dw[jt][g]; ((S_LDS_BF16P)(lds + SC_AR + wave * 4096))[t * 64 + 32 * jt + n] = (bf16)(S_PK(da[jt][g], 0.f) & 0xffffu); }
        S_LDS_WAIT();
    }
    S_MEMBAR();
    unsigned ppA[16], ppR[16], ppB[16], ppK[16], ppV[16], ppQ[16]; float gamC;
    {   const float mAr = dir ? A.mu_next[cr] : A.mu_prev[cr], mBr = dir ? A.mu_prev[cr] : A.mu_next[cr], mAk = dir ? A.mu_next[ck] : A.mu_prev[ck], mBk = dir ? A.mu_prev[ck] : A.mu_next[ck];
        const float mAv = dir ? A.mu_next[cv] : A.mu_prev[cv], mBv = dir ? A.mu_prev[cv] : A.mu_next[cv];
        const float w0j = A.w0[dir * 512 + chn], a0j = A.a0[dir * 512 + chn], kkj = A.k_k[chn], kaj = A.k_a[chn], rkj = A.r_k[chn];
        const S_GAS bf16* pr = zb + (ptrdiff_t)tau0 * NZ + cr - st; const S_GAS bf16* pk = zb + (ptrdiff_t)tau0 * NZ + ck - st; const S_GAS bf16* pv = zb + (ptrdiff_t)tau0 * NZ + cv - st;
        float rr[34], rk[34], rv[34];
        S_UNROLL for (int q = 0; q < 34; ++q) { const bool ok = !((q == 0 && first) || (q == 33 && last)); rr[q] = ok ? bf2f(*pr) : 0.f; rk[q] = ok ? bf2f(*pk) : 0.f; rv[q] = ok ? bf2f(*pv) : 0.f; pr += st; pk += st; pv += st; }
        S_MEMBAR();
        const float mCr = 1.f - mAr - mBr, mCk = 1.f - mAk - mBk, mCv = 1.f - mAv - mBv;
        float cs = 0.f, gprev = 1.f; float eA = 0.f, eR = 0.f, eB = 0.f, eK = 0.f, eV = 0.f, eQ = 0.f;
        {
            float sq[32];
            S_UNROLL for (int p = 0; p < 32; ++p) { rk[p] = mCk * rk[p + 1] + mAk * rk[p] + mBk * rk[p + 2]; const float t_ = rk[p] * kkj; sq[p] = t_ * t_; }
            const float tot = s_treesum32(sq, lane);
            ((S_LDS_F32P)(lds + SC_RSQ + wave * 128))[lane >> 1] = S_RSQ(fmaxf(tot, 1e-24f)); }
        S_MEMBAR();
        S_UNROLL for (int p = 0; p < 32; ++p) { if ((p & (SB_ILP - 1)) == 0) S_MEMBAR();
            const float r = mCr * rr[p + 1] + mAr * rr[p] + mBr * rr[p + 2], k = rk[p], v = mCv * rv[p + 1] + mAv * rv[p] + mBv * rv[p + 2];
            const float wraw = ((S_LDS_F32P)(lds + SC_WR + wave * 8192))[p * 64 + lane] + w0j, araw = bf2f(((S_LDS_BF16P)(lds + SC_AR + wave * 4096))[p * 64 + lane]) + a0j;
            const float lw2 = -0.8750387749f * S_RCP(1.f + S_EXP2(wraw * -1.442695041f));
            const float al = S_RCP(1.f + S_EXP2(-araw * 1.442695041f));
            const float kk = k * kkj * ((S_LDS_CONST_F32P)(lds + SC_RSQ + wave * 128))[p];
            const float kd = k * (1.f + (al - 1.f) * kaj);
            cs += lw2; const float gam = S_EXP2(cs), ig = S_EXP2(-cs);
            const float xa = -kk * gprev, xr = r * gam, xb = kk * al * ig, xk = kd * ig, xq = xr * rkj; gprev = gam;
            if (p & 1) { ppA[p >> 1] = S_PK(eA, xa); ppR[p >> 1] = S_PK(eR, xr); ppB[p >> 1] = S_PK(eB, xb); ppK[p >> 1] = S_PK(eK, xk); ppV[p >> 1] = S_PK(eV, v); ppQ[p >> 1] = S_PK(eQ, xq);
                         S_PIN(ppQ[p >> 1]); S_PIN(ppA[p >> 1]); S_PIN(ppR[p >> 1]); S_PIN(ppB[p >> 1]); S_PIN(ppK[p >> 1]); S_PIN(ppV[p >> 1]); }
            else { eA = xa; eR = xr; eB = xb; eK = xk; eV = v; eQ = xq; } }
        gamC = gprev;
    }
    S_MEMBAR();
    float gc0, gc1; { unsigned x = __float_as_uint(gamC), y = x; S_SWAP(x, y); gc0 = __uint_as_float(x); gc1 = __uint_as_float(y); }
    ((S_LDS_F32P)(lds + SC_GTAB + wave * 256))[lane] = gamC;
    const SMat FA = splain2d(ppA), FB = splain2d(ppB), FK = splain2d(ppK), FV = splain2d(ppV);
    SFrag RT[2], MrbT, MrkT, LakT, Pf, PTf; f32x16 TT;
    {   const SFrag IDF = sident(n, hh); SFrag AT[2], BT[2], KT[2];
        { const SMat FR = splain2d(ppR); S_UNROLL for (int dt = 0; dt < 2; ++dt) RT[dt] = spack(smm(FR.t[dt], IDF, szero())); }
        SFrag QT[2]; { const SMat FQ = splain2d(ppQ); S_UNROLL for (int dt = 0; dt < 2; ++dt) QT[dt] = spack(smm(FQ.t[dt], IDF, szero())); }
        S_UNROLL for (int dt = 0; dt < 2; ++dt) { AT[dt] = spack(smm(FA.t[dt], IDF, szero())); BT[dt] = spack(smm(FB.t[dt], IDF, szero())); KT[dt] = spack(smm(FK.t[dt], IDF, szero())); }
        f32x16 L = szero(), LT = szero(), lak = szero(), mrb = szero(), mrk = szero();
        { f32x16 bq = szero(); S_UNROLL for (int dt = 0; dt < 2; ++dt) bq = smm(KT[dt], QT[dt], bq);
          int nb = n, rb = 4 * hh; S_LAUNDER_I(nb); S_LAUNDER_I(rb); float dsum = 0.f; S_UNROLL for (int g = 0; g < 16; ++g) dsum += (((g & 3) + 8 * (g >> 2) + rb) == nb) ? bq[g] : 0.f;
          if (((nb >> 2) & 1) == (rb >> 2)) A.bonus[((size_t)b * T + (tau0 + sgn * nb)) * 8 + h] = dsum; }
        S_UNROLL for (int dt = 0; dt < 2; ++dt) { L = smm(AT[dt], BT[dt], L); LT = smm(BT[dt], AT[dt], LT); lak = smm(KT[dt], AT[dt], lak); mrb = smm(BT[dt], RT[dt], mrb); mrk = smm(KT[dt], RT[dt], mrk); }
        int n2 = n, r2 = 4 * hh; S_LAUNDER_I(n2); S_LAUNDER_I(r2);
        S_UNROLL for (int g = 0; g < 16; ++g) { const int row = (g & 3) + 8 * (g >> 2) + r2;
            L[g] = (row > n2) ? L[g] : 0.f; LT[g] = (row < n2) ? LT[g] : 0.f; lak[g] = (row < n2) ? lak[g] : 0.f; mrb[g] = (row <= n2) ? mrb[g] : 0.f; mrk[g] = (row <= n2) ? mrk[g] : 0.f; }
        Pf = spack(L); PTf = spack(LT); LakT = spack(lak); MrbT = spack(mrb); MrkT = spack(mrk);
        TT = LT; S_UNROLL for (int g = 0; g < 16; ++g) TT[g] += (((g & 3) + 8 * (g >> 2) + r2) == n2) ? 1.f : 0.f;
    }
    S_MEMBAR();
    SFrag TTf = spack(TT);
    S_UNROLL for (int i = 1; i <= 4; ++i) { const f32x16 P2 = smm(PTf, Pf, szero()); SFrag P2Tf; if (i < 4) P2Tf = spack(smm(Pf, PTf, szero()));
        Pf = spack(P2); TT = smm(Pf, TTf, TT); TTf = spack(TT); if (i < 4) PTf = P2Tf; }
    S_MEMBAR();
    SFrag U0[2], Ap[2], RpT[2], Y0[2], GTf[2][2], Hf[2][2];
    S_UNROLL for (int vt = 0; vt < 2; ++vt) { const SFrag W = spack(smm(LakT, FV.t[vt], szero())); U0[vt] = spack(smm(TTf, W, szero())); }
    S_UNROLL for (int kt = 0; kt < 2; ++kt) Ap[kt] = spack(smm(TTf, FA.t[kt], szero()));
    S_UNROLL for (int kt = 0; kt < 2; ++kt) RpT[kt] = spack(smm(Ap[kt], MrbT, sunpack(RT[kt])));
    S_UNROLL for (int vt = 0; vt < 2; ++vt) Y0[vt] = spack(smm(MrkT, FV.t[vt], smm(MrbT, U0[vt], szero())));
    int n3 = n, r3 = 4 * hh; S_LAUNDER_I(n3); S_LAUNDER_I(r3);
    S_UNROLL for (int nt = 0; nt < 2; ++nt) S_UNROLL for (int mt = 0; mt < 2; ++mt) { f32x16 gt = smm(Ap[nt], FB.t[mt], szero()); const float gcv = mt ? gc1 : gc0;
        S_UNROLL for (int g = 0; g < 16; ++g) { const float idv = (nt == mt && ((g & 3) + 8 * (g >> 2) + r3) == n3) ? 1.f : 0.f; gt[g] = (gt[g] + idv) * gcv; }
        GTf[nt][mt] = spack(gt); }
    S_LDS_WAIT();
    S_UNROLL for (int mt = 0; mt < 2; ++mt) { float gr[16];
        S_UNROLL for (int q = 0; q < 4; ++q) { const f32x4 t4 = *(S_LDS_CONST_F32X4P)(lds + SC_GTAB + wave * 256 + (32 * mt + 8 * q + 4 * hh) * 4); S_UNROLL for (int i = 0; i < 4; ++i) gr[4 * q + i] = t4[i]; }
        S_UNROLL for (int vt = 0; vt < 2; ++vt) { f32x16 hm = smm(FK.t[mt], FV.t[vt], smm(FB.t[mt], U0[vt], szero())); S_UNROLL for (int g = 0; g < 16; ++g) hm[g] *= gr[g]; Hf[mt][vt] = spack(hm); } }
    S_MEMBAR();
    S_FLAG_WAIT(lds + SC_FLAG, (unsigned)c);
    SFrag SG[2][2];
    S_UNROLL for (int kt = 0; kt < 2; ++kt) S_UNROLL for (int vt = 0; vt < 2; ++vt) S_UNROLL for (int s = 0; s < 2; ++s) SG[kt][vt].s[s] = *(S_LDS_CONST_BF16X8P)(lds + SC_SIG + ((((kt * 2 + vt) * 2 + s) * 64 + lane) * 16));
    S_LDS_WAIT();
    S_UNROLL for (int mt = 0; mt < 2; ++mt) S_UNROLL for (int vt = 0; vt < 2; ++vt) { f32x16 sn = sunpack(Hf[mt][vt]); S_UNROLL for (int nt = 0; nt < 2; ++nt) sn = smm(GTf[nt][mt], SG[nt][vt], sn);
        const SFrag f = spack(sn); S_UNROLL for (int s = 0; s < 2; ++s) *(S_LDS_BF16X8P)(lds + SC_SIG + ((((mt * 2 + vt) * 2 + s) * 64 + lane) * 16)) = f.s[s]; }
    S_LDS_WAIT();
    S_FLAG_STORE(lds + SC_FLAG, (unsigned)(c + 1));
    S_UNROLL for (int vt = 0; vt < 2; ++vt) { f32x16 y = sunpack(Y0[vt]); S_UNROLL for (int kt = 0; kt < 2; ++kt) y = smm(RpT[kt], SG[kt][vt], y);
        S_UNROLL for (int g = 0; g < 16; ++g) { const int p = (g & 3) + 8 * (g >> 2) + 4 * hh; A.ydir[((size_t)b * T + (tau0 + sgn * p)) * 512 + h * 64 + 32 * vt + n] = (bf16)(S_PK(y[g], 0.f) & 0xffffu); } }
}

__device__ __forceinline__ void attn_unit(const Frame& F, ArgsP A, int b, int kvh, int qb) {
    constexpr int KST = 72, VST = 388;
    LAS bf16* KS = (LAS bf16*)F.lds;
    LAS bf16* VT = (LAS bf16*)(F.lds + 384 * KST * 2);
    LAS float* wsf = (LAS float*)(F.lds + 384 * KST * 2 + 64 * VST * 2);
    const bf16* Z = (const bf16*)(A->ws + WS_Z); bf16* OA = (bf16*)(A->ws + WS_OATT);
    const int* positions = (const int*)A->in[2]; const float* qg = (const float*)A->in[19]; const float* kg = (const float*)A->in[20]; const float* sink = (const float*)A->in[21];
    const int tid = F.tid, lane = F.lane, wave = F.wave;
    const float LN_THETA = 13.122363377404328f;
    v4u kwa[6], vwa[6], rca[6], rsa[6];
    v4u qn[4], qnc, qns;
    { const size_t tok0 = (size_t)b * T + qb * 128 + (wave & 1) * 64 + (lane & 31); const int hq0 = kvh * 4 + (wave >> 1);
#pragma unroll
      for (int sI = 0; sI < 4; ++sI) qn[sI] = *(const GAS v4u*)(Z + tok0 * NZ + ZQ + hq0 * 64 + 16 * sI + 8 * (lane >> 5));
      const GAS v4u* qrt0 = (const GAS v4u*)((const bf16*)(A->ws + WS_ROPE) + tok0 * 16); qnc = qrt0[0]; qns = qrt0[1]; }
#pragma unroll
    for (int i = 0; i < 6; ++i) { const int ct = tid + 512 * i, key = ct >> 3, ch = ct & 7; const int kp = qb * 128 - 128 + key; const bool valid = (kp >= 0) && (kp < T);
        const size_t rowoff = ((size_t)b * T + (valid ? kp : 0)) * NZ;
        kwa[i] = *(const GAS v4u*)(Z + rowoff + ZKA + kvh * 64 + ch * 8); vwa[i] = *(const GAS v4u*)(Z + rowoff + ZVA + kvh * 64 + ch * 8);
        const GAS v4u* rt = (const GAS v4u*)((const bf16*)(A->ws + WS_ROPE) + ((size_t)b * T + (valid ? kp : 0)) * 16); rca[i] = rt[0]; rsa[i] = rt[1]; }
#pragma unroll
    for (int i = 0; i < 6; ++i) { const int ct = tid + 512 * i, key = ct >> 3, ch = ct & 7; const int kp = qb * 128 - 128 + key; const bool valid = (kp >= 0) && (kp < T);
        v4u kw = kwa[i], vw = vwa[i];
        if (!valid) { kw = (v4u){0u, 0u, 0u, 0u}; vw = kw; }
        float kf[8] = {bflo(kw.x), bfhi(kw.x), bflo(kw.y), bfhi(kw.y), bflo(kw.z), bfhi(kw.z), bflo(kw.w), bfhi(kw.w)};
        float ss = 0.f;
#pragma unroll
        for (int j = 0; j < 8; ++j) ss += kf[j] * kf[j];
        ss += __shfl_xor(ss, 1); ss += __shfl_xor(ss, 2); ss += __shfl_xor(ss, 4);
        const float rs = rsqrtf(ss * (1.0f / 64.0f) + 1e-6f);
#pragma unroll
        for (int j = 0; j < 8; ++j) kf[j] = kf[j] * rs * kg[ch * 8 + j];
        float oth[8];
#pragma unroll
        for (int j = 0; j < 8; ++j) oth[j] = __shfl_xor(kf[j], 1);
        if (ch < 2) { const v4u cw = rca[i], sw = rsa[i];
            const float cs[8] = {bflo(cw.x), bfhi(cw.x), bflo(cw.y), bfhi(cw.y), bflo(cw.z), bfhi(cw.z), bflo(cw.w), bfhi(cw.w)};
            const float sn[8] = {bflo(sw.x), bfhi(sw.x), bflo(sw.y), bfhi(sw.y), bflo(sw.z), bfhi(sw.z), bflo(sw.w), bfhi(sw.w)};
#pragma unroll
            for (int j = 0; j < 8; ++j) kf[j] = (ch == 0) ? (kf[j] * cs[j] - oth[j] * sn[j]) : (kf[j] * cs[j] + oth[j] * sn[j]); }
        v4u ko; ko.x = pk2(kf[0], kf[1]); ko.y = pk2(kf[2], kf[3]); ko.z = pk2(kf[4], kf[5]); ko.w = pk2(kf[6], kf[7]);
        *(LAS v4u*)(KS + key * KST + ch * 8) = ko;
        const unsigned vv[4] = {vw.x, vw.y, vw.z, vw.w};
#pragma unroll
        for (int j = 0; j < 4; ++j) { VT[(ch * 8 + 2 * j) * VST + key] = (bf16)(vv[j] & 0xffffu); VT[(ch * 8 + 2 * j + 1) * VST + key] = (bf16)(vv[j] >> 16); } }
    __syncthreads();
    const int g = wave >> 1, hq = kvh * 4 + g, r32 = lane & 31, hh = lane >> 5;
    const float snk = sink[hq];
    float kbound; { float gm = fabsf(kg[lane]);
#pragma unroll
        for (int o = 1; o < 64; o <<= 1) gm = fmaxf(gm, __shfl_xor(gm, o));
        kbound = 8.0f * gm; }
#pragma unroll 1
    for (int qt = 0; qt < 2; ++qt) { const int qo = (wave & 1) * 64 + qt * 32, qrel = qo + r32; const size_t tok = (size_t)b * T + qb * 128 + qrel;
        float qf[4][8]; float ss = 0.f; v4u qraw[4];
#pragma unroll
        for (int sI = 0; sI < 4; ++sI) qraw[sI] = qn[sI];
        const v4u qrc = qnc, qrs = qns;
        if (qt == 0) { const size_t tok1 = tok + 32;
#pragma unroll
            for (int sI = 0; sI < 4; ++sI) qn[sI] = *(const GAS v4u*)(Z + tok1 * NZ + ZQ + hq * 64 + 16 * sI + 8 * hh);
            const GAS v4u* qrt1 = (const GAS v4u*)((const bf16*)(A->ws + WS_ROPE) + tok1 * 16); qnc = qrt1[0]; qns = qrt1[1]; }
#pragma unroll
        for (int sI = 0; sI < 4; ++sI) { const v4u qw = qraw[sI];
            qf[sI][0] = bflo(qw.x); qf[sI][1] = bfhi(qw.x); qf[sI][2] = bflo(qw.y); qf[sI][3] = bfhi(qw.y); qf[sI][4] = bflo(qw.z); qf[sI][5] = bfhi(qw.z); qf[sI][6] = bflo(qw.w); qf[sI][7] = bfhi(qw.w);
#pragma unroll
            for (int j = 0; j < 8; ++j) ss += qf[sI][j] * qf[sI][j]; }
        ss += __shfl_xor(ss, 32);
        const float rs = rsqrtf(ss * (1.0f / 64.0f) + 1e-6f) * 0.125f;
#pragma unroll
        for (int sI = 0; sI < 4; ++sI)
#pragma unroll
            for (int j = 0; j < 8; ++j) qf[sI][j] = qf[sI][j] * rs * qg[16 * sI + 8 * hh + j];
        { const v4u cw = qrc, sw = qrs;
          const float cs[8] = {bflo(cw.x), bfhi(cw.x), bflo(cw.y), bfhi(cw.y), bflo(cw.z), bfhi(cw.z), bflo(cw.w), bfhi(cw.w)}, sn[8] = {bflo(sw.x), bfhi(sw.x), bflo(sw.y), bfhi(sw.y), bflo(sw.z), bfhi(sw.z), bflo(sw.w), bfhi(sw.w)};
#pragma unroll
          for (int j = 0; j < 8; ++j) { const float oth = __shfl_xor(qf[0][j], 32); qf[0][j] = (hh == 0) ? (qf[0][j] * cs[j] - oth * sn[j]) : (qf[0][j] * cs[j] + oth * sn[j]); } }
        bf16x8 qr[4];
#pragma unroll
        for (int sI = 0; sI < 4; ++sI) { v4u w; w.x = pk2(qf[sI][0], qf[sI][1]); w.y = pk2(qf[sI][2], qf[sI][3]); w.z = pk2(qf[sI][4], qf[sI][5]); w.w = pk2(qf[sI][6], qf[sI][7]); qr[sI] = __builtin_bit_cast(bf16x8, w); }
        const int kt0 = qo >> 5;
        float qn2 = 0.f;
#pragma unroll
        for (int sI = 0; sI < 4; ++sI)
#pragma unroll
            for (int j = 0; j < 8; ++j) qn2 += qf[sI][j] * qf[sI][j];
        qn2 += __shfl_xor(qn2, 32);
        float mrun = sqrtf(qn2) * kbound * 1.02f;
        if (__any(mrun > 40.f)) { mrun = -1e30f;
#pragma unroll 1
            for (int kt = 0; kt < 9; ++kt) { const int kbase = (kt0 + kt) * 32;
                f32x16 acc = {};
#pragma unroll
                for (int sI = 0; sI < 4; ++sI) { const bf16x8 kfr = *(const LAS bf16x8*)(KS + (kbase + r32) * KST + 16 * sI + 8 * hh); acc = __builtin_amdgcn_mfma_f32_32x32x16_bf16(kfr, qr[sI], acc, 0, 0, 0); }
#pragma unroll
                for (int r = 0; r < 16; ++r) { const int ki = kbase + (r & 3) + 8 * (r >> 2) + 4 * hh; const int dq = ki - 128 - qrel, kp = qb * 128 - 128 + ki;
                    const bool ok = (dq >= -128) && (dq <= 128) && (kp >= 0) && (kp < T); mrun = fmaxf(mrun, ok ? acc[r] : -1e30f); } }
            mrun = fmaxf(mrun, __shfl_xor(mrun, 32)); }
        const float mx = fmaxf(mrun, snk);
        float lrun = 0.f; f32x16 o0 = {}, o1 = {}; const float mxl = mx * 1.442695041f; const bool edge = (qb == 0) || (qb == T / 128 - 1);
#pragma unroll 1
        for (int kt = 0; kt < 9; ++kt) { const int kbase = (kt0 + kt) * 32;
            f32x16 acc = {};
#pragma unroll
            for (int sI = 0; sI < 4; ++sI) { const bf16x8 kfr = *(const LAS bf16x8*)(KS + (kbase + r32) * KST + 16 * sI + 8 * hh); acc = __builtin_amdgcn_mfma_f32_32x32x16_bf16(kfr, qr[sI], acc, 0, 0, 0); }
            float p[16];
            if (edge || kt == 0 || kt == 8) {
#pragma unroll
                for (int r = 0; r < 16; ++r) { const int ki = kbase + (r & 3) + 8 * (r >> 2) + 4 * hh; const int dq = ki - 128 - qrel, kp = qb * 128 - 128 + ki;
                    const bool ok = (dq >= -128) && (dq <= 128) && (kp >= 0) && (kp < T); p[r] = ok ? __builtin_amdgcn_exp2f(acc[r] * 1.442695041f - mxl) : 0.f; lrun += p[r]; }
            } else {
#pragma unroll
                for (int r = 0; r < 16; ++r) { p[r] = __builtin_amdgcn_exp2f(acc[r] * 1.442695041f - mxl); lrun += p[r]; } }
#pragma unroll
            for (int sI = 0; sI < 2; ++sI) { v4u pw; pw.x = pk2(p[8 * sI + 0], p[8 * sI + 1]); pw.y = pk2(p[8 * sI + 2], p[8 * sI + 3]); pw.z = pk2(p[8 * sI + 4], p[8 * sI + 5]); pw.w = pk2(p[8 * sI + 6], p[8 * sI + 7]);
                const bf16x8 pa = __builtin_bit_cast(bf16x8, pw); const int key0 = kbase + 16 * sI + 4 * hh;
                { const u32x2 lo = *(const LAS u32x2*)(VT + r32 * VST + key0), hi = *(const LAS u32x2*)(VT + r32 * VST + key0 + 8); v4u vw; vw.x = lo.x; vw.y = lo.y; vw.z = hi.x; vw.w = hi.y;
                  o0 = __builtin_amdgcn_mfma_f32_32x32x16_bf16(pa, __builtin_bit_cast(bf16x8, vw), o0, 0, 0, 0); }
                { const u32x2 lo = *(const LAS u32x2*)(VT + (32 + r32) * VST + key0), hi = *(const LAS u32x2*)(VT + (32 + r32) * VST + key0 + 8); v4u vw; vw.x = lo.x; vw.y = lo.y; vw.z = hi.x; vw.w = hi.y;
                  o1 = __builtin_amdgcn_mfma_f32_32x32x16_bf16(pa, __builtin_bit_cast(bf16x8, vw), o1, 0, 0, 0); } } }
        lrun += __shfl_xor(lrun, 32);
        const float linv = 1.0f / (lrun + __expf(snk - mx));
        if (hh == 0) wsf[wave * 64 + r32] = linv;
        LDS_WAIT(); asm volatile("" ::: "memory");
#pragma unroll
        for (int r = 0; r < 16; ++r) { const int row = (r & 3) + 8 * (r >> 2) + 4 * hh; const float li = wsf[wave * 64 + row];
            bf16* op = OA + ((size_t)b * T + qb * 128 + qo + row) * 512 + hq * 64;
            op[r32] = (bf16)f2bf(o0[r] * li); op[32 + r32] = (bf16)f2bf(o1[r] * li); }
        LDS_WAIT(); asm volatile("" ::: "memory");
    }
    __syncthreads();
}

__device__ __forceinline__ void pg_rows(const Frame& F, ArgsP A, bf16* wout) {
    const bf16* Z = (const bf16*)(A->ws + WS_Z); const bf16* Y0 = (const bf16*)(A->ws + WS_XN); const bf16* Y1 = Y0 + (size_t)M * 512;
    bf16* Gb = (bf16*)(A->ws + WS_G); const float* bonus = (const float*)(A->ws + WS_BONUS);
    const float* mu_prev = (const float*)A->in[7]; const float* mu_next = (const float*)A->in[8]; const float* gn_w = (const float*)A->in[17]; const float* gn_b = (const float*)A->in[18];
    const int gw = F.vcu * NWAVES + F.wave, NGW = F.G * NWAVES, lane = F.lane, c0 = lane * 8, h = lane >> 3;
    float mp[8], mn[8], gw_[8], gb_[8];
#pragma unroll
    for (int j = 0; j < 8; ++j) { mp[j] = mu_prev[ZV + c0 + j]; mn[j] = mu_next[ZV + c0 + j]; gw_[j] = gn_w[c0 + j]; gb_[j] = gn_b[c0 + j]; }
#pragma unroll 1
    for (int m0 = gw; m0 < M; m0 += 4 * NGW) {
        v4u y0[4], y1[4], gv[4], z0[4], zm[4], zq[4]; float bon[4];
#pragma unroll
        for (int i = 0; i < 4; ++i) { const int m = m0 + i * NGW, t = m & (T - 1);
            y0[i] = *(const GAS v4u*)(Y0 + (size_t)m * 512 + c0); y1[i] = *(const GAS v4u*)(Y1 + (size_t)m * 512 + c0); gv[i] = *(const GAS v4u*)(Gb + (size_t)m * 512 + c0);
            z0[i] = *(const GAS v4u*)(Z + (size_t)m * NZ + ZV + c0);
            zm[i] = (v4u){0u, 0u, 0u, 0u}; zq[i] = (v4u){0u, 0u, 0u, 0u};
            if (t > 0) zm[i] = *(const GAS v4u*)(Z + (size_t)(m - 1) * NZ + ZV + c0);
            if (t < T - 1) zq[i] = *(const GAS v4u*)(Z + (size_t)(m + 1) * NZ + ZV + c0);
            bon[i] = bonus[(size_t)m * 8 + h] + bonus[(size_t)M * 8 + (size_t)m * 8 + h]; }
#pragma unroll
        for (int i = 0; i < 4; ++i) { const int m = m0 + i * NGW;
            const unsigned y0w[4] = {y0[i].x, y0[i].y, y0[i].z, y0[i].w}, y1w[4] = {y1[i].x, y1[i].y, y1[i].z, y1[i].w}, gvw[4] = {gv[i].x, gv[i].y, gv[i].z, gv[i].w};
            const unsigned z0w[4] = {z0[i].x, z0[i].y, z0[i].z, z0[i].w}, zmw[4] = {zm[i].x, zm[i].y, zm[i].z, zm[i].w}, zqw[4] = {zq[i].x, zq[i].y, zq[i].z, zq[i].w};
            float y[8], gg[8], vv[8]; float sacc = 0.f;
#pragma unroll
            for (int j = 0; j < 4; ++j) { y[2 * j] = bflo(y0w[j]) + bflo(y1w[j]); y[2 * j + 1] = bfhi(y0w[j]) + bfhi(y1w[j]); gg[2 * j] = bflo(gvw[j]); gg[2 * j + 1] = bfhi(gvw[j]);
                const float a0 = bflo(z0w[j]), a1 = bfhi(z0w[j]);
                vv[2 * j] = a0 + mp[2 * j] * (bflo(zmw[j]) - a0) + mn[2 * j] * (bflo(zqw[j]) - a0); vv[2 * j + 1] = a1 + mp[2 * j + 1] * (bfhi(zmw[j]) - a1) + mn[2 * j + 1] * (bfhi(zqw[j]) - a1);
                sacc += y[2 * j] + y[2 * j + 1]; }
            sacc += __shfl_xor(sacc, 1); sacc += __shfl_xor(sacc, 2); sacc += __shfl_xor(sacc, 4);
            const float mu = sacc * (1.0f / 64.0f); float q = 0.f;
#pragma unroll
            for (int j = 0; j < 8; ++j) { const float d = y[j] - mu; q += d * d; }
            q += __shfl_xor(q, 1); q += __shfl_xor(q, 2); q += __shfl_xor(q, 4);
            const float rstd = rsqrtf(q * (1.0f / 64.0f) + 64e-5f);
            float o[8];
#pragma unroll
            for (int j = 0; j < 8; ++j) o[j] = ((y[j] - mu) * rstd * gw_[j] + gb_[j] + bon[i] * vv[j]) * gg[j];
            v4u w; w.x = pk2(o[0], o[1]); w.y = pk2(o[2], o[3]); w.z = pk2(o[4], o[5]); w.w = pk2(o[6], o[7]);
            *(GAS v4u*)(wout + (size_t)m * 512 + c0) = w; } }
}

__device__ __forceinline__ void pj_phase(const Frame& F, ArgsP A) {
    unsigned char* ws = A->ws;
    const int gw = F.vcu * NWAVES + F.wave, NGW = F.G * NWAVES, lane = F.lane;
    { LAS float* scr = (LAS float*)(F.lds + F.wave * 16384);
      const float* w_gate = (const float*)A->in[27]; const float* w_up = (const float*)A->in[28]; const float* w_down = (const float*)A->in[29];
      bf16* WguT = (bf16*)((unsigned char*)A->out + OUT_WGUT); bf16* WdT = (bf16*)((unsigned char*)A->out + OUT_WDT);
      constexpr int PER = 512, NIT = 16 * 3 * PER;
      for (int it = gw; it < NIT; it += NGW) { const int e = it / (3 * PER), r = it % (3 * PER), which = r / PER, q = r % PER, kb = q >> 5, nb = q & 31, n0 = 32 * nb;
          if (which == 0) tr_item(w_gate + (size_t)e * 1048576, 1024, 64 * kb, n0, WguT, 1024, e * 2048 + (n0 >> 7) * 256 + (n0 & 127), scr, lane);
          else if (which == 1) tr_item(w_up + (size_t)e * 1048576, 1024, 64 * kb, n0, WguT, 1024, e * 2048 + (n0 >> 7) * 256 + 128 + (n0 & 127), scr, lane);
          else tr_item(w_down + (size_t)e * 1048576, 1024, 64 * kb, n0, WdT, 1024, e * 1024 + n0, scr, lane); }
    }
    __syncthreads();
    const float* w_router = (const float*)A->in[26]; const bf16* x1 = (const bf16*)(ws + WS_X1); const float* g2n = (const float*)A->in[25]; const float* mod = (const float*)(ws + WS_MOD);
    bf16* XN2 = (bf16*)(ws + WS_XN); float* aff = (float*)(ws + WS_AFF);
    LAS bf16* WF = (LAS bf16*)F.lds;
    LAS float* AT = (LAS float*)(F.lds + 65536); LAS float* BT = AT + 1024; LAS float* CB = BT + 1024;
    const int tile = gw, b = tile >> 7;
    for (int d = F.tid; d < 1024; d += 512) { AT[d] = g2n[d] * (1.0f + mod[(size_t)b * 6144 + 4096 + d]); BT[d] = mod[(size_t)b * 6144 + 3072 + d]; }
    __syncthreads();
#pragma unroll 4
    for (int k = 0; k < 32; ++k) { const int it = F.tid + 512 * k, jj = it & 7, ln = (it >> 3) & 63, sI = it >> 9, q = ln >> 4, e = ln & 15, d = 32 * sI + 8 * q + jj;
        const float v = AT[d] * w_router[d * 16 + e]; const unsigned hi = pk2(v, 0.f) & 0xffffu; const float lo = v - __uint_as_float(hi << 16);
        WF[it] = (bf16)hi; WF[16384 + it] = (bf16)(pk2(lo, 0.f) & 0xffffu); }
    { float c0 = 0.f, c1 = 0.f;
#pragma unroll 4
      for (int k = 0; k < 16; ++k) { const int d = lane + 64 * k; c0 += BT[d] * w_router[d * 16 + 2 * F.wave]; c1 += BT[d] * w_router[d * 16 + 2 * F.wave + 1]; }
      c0 = dpp_wave_sum(c0); c1 = dpp_wave_sum(c1); if (lane == 0) { CB[2 * F.wave] = c0; CB[2 * F.wave + 1] = c1; } }
    __syncthreads();
    if (tile < M / 16) { const int r = lane & 15, q = lane >> 4; const size_t m = (size_t)tile * 16 + r;
        float ss = 0.f;
#pragma unroll 1
        for (int hf = 0; hf < 2; ++hf) { v4u raw[16];
#pragma unroll
            for (int sI = 0; sI < 16; ++sI) raw[sI] = *(const GAS v4u*)(x1 + m * 1024 + 32 * (16 * hf + sI) + 8 * q);
#pragma unroll
            for (int sI = 0; sI < 16; ++sI) { const v4u w = raw[sI]; const float a0 = bflo(w.x), a1 = bfhi(w.x), a2 = bflo(w.y), a3 = bfhi(w.y), a4 = bflo(w.z), a5 = bfhi(w.z), a6 = bflo(w.w), a7 = bfhi(w.w);
                ss += (a0 * a0 + a1 * a1) + (a2 * a2 + a3 * a3) + (a4 * a4 + a5 * a5) + (a6 * a6 + a7 * a7); } }
        ss += __shfl_xor(ss, 16); ss += __shfl_xor(ss, 32);
        const float rs = rsqrtf(ss * (1.0f / 1024.0f) + 1e-6f);
        f32x4 ah = {0.f, 0.f, 0.f, 0.f}, al = {0.f, 0.f, 0.f, 0.f};
#pragma unroll 1
        for (int hf = 0; hf < 2; ++hf) { v4u raw[16];
#pragma unroll
            for (int sI = 0; sI < 16; ++sI) raw[sI] = *(const GAS v4u*)(x1 + m * 1024 + 32 * (16 * hf + sI) + 8 * q);
#pragma unroll
            for (int sI = 0; sI < 16; ++sI) { const int sg = 16 * hf + sI; const bf16x8 xa = __builtin_bit_cast(bf16x8, raw[sI]);
                const bf16x8 bh = *(const LAS bf16x8*)(WF + (sg * 64 + lane) * 8), bl = *(const LAS bf16x8*)(WF + 16384 + (sg * 64 + lane) * 8);
                ah = __builtin_amdgcn_mfma_f32_16x16x32_bf16(xa, bh, ah, 0, 0, 0); al = __builtin_amdgcn_mfma_f32_16x16x32_bf16(xa, bl, al, 0, 0, 0); }
#pragma unroll
            for (int sI = 0; sI < 16; ++sI) { if ((sI & 3) == 0) asm volatile("" ::: "memory");
                const int d0 = 32 * (16 * hf + sI) + 8 * q; const v4u w = raw[sI];
                const f32x4 a0 = *(const LAS f32x4*)(AT + d0), a1 = *(const LAS f32x4*)(AT + d0 + 4), b0 = *(const LAS f32x4*)(BT + d0), b1 = *(const LAS f32x4*)(BT + d0 + 4);
                v4u o; o.x = pk2(bflo(w.x) * rs * a0.x + b0.x, bfhi(w.x) * rs * a0.y + b0.y); o.y = pk2(bflo(w.y) * rs * a0.z + b0.z, bfhi(w.y) * rs * a0.w + b0.w);
                o.z = pk2(bflo(w.z) * rs * a1.x + b1.x, bfhi(w.z) * rs * a1.y + b1.y); o.w = pk2(bflo(w.w) * rs * a1.z + b1.z, bfhi(w.w) * rs * a1.w + b1.w);
                *(GAS v4u*)(XN2 + m * 1024 + d0) = o; } }
        const float cb = CB[lane & 15]; float lg[4], mx[4], ex[4], den[4];
#pragma unroll
        for (int i = 0; i < 4; ++i) { const float rsr = __shfl(rs, 4 * q + i); lg[i] = rsr * (ah[i] + al[i]) + cb; mx[i] = lg[i]; }
#pragma unroll
        for (int o = 1; o < 16; o <<= 1)
#pragma unroll
            for (int i = 0; i < 4; ++i) mx[i] = fmaxf(mx[i], __shfl_xor(mx[i], o));
#pragma unroll
        for (int i = 0; i < 4; ++i) { ex[i] = expf(lg[i] - mx[i]); den[i] = ex[i]; }
#pragma unroll
        for (int o = 1; o < 16; o <<= 1)
#pragma unroll
            for (int i = 0; i < 4; ++i) den[i] += __shfl_xor(den[i], o);
        { const int t0 = (tile & 127) * 16 + 4 * q; f32x4 av; av.x = ex[0] / den[0]; av.y = ex[1] / den[1]; av.z = ex[2] / den[2]; av.w = ex[3] / den[3];
          *(GAS f32x4*)(aff + ((size_t)b * 16 + (lane & 15)) * T + t0) = av; } }
}

__device__ __forceinline__ void pk_task(const Frame& F, ArgsP A, int b, int e) {
    unsigned char* ws = A->ws;
    const float* aff = (const float*)(ws + WS_AFF) + ((size_t)b * 16 + e) * T;
    int* slotmap = (int*)(ws + WS_SLOT); float* selaff = (float*)(ws + WS_SELAFF); int* selidx = (int*)(ws + WS_SELIDX);
    const bf16* XN2 = (const bf16*)(ws + WS_XN); bf16* XE = (bf16*)(ws + WS_XE);
    LAS unsigned* cnt = (LAS unsigned*)F.lds;
    LAS int* tokl = (LAS int*)(F.lds + 256);
    const int tid = F.tid, lane = F.lane, wave = F.wave;
    const f32x4 v4 = *(const GAS f32x4*)(aff + 4 * tid);
    const unsigned key[4] = {__float_as_uint(v4.x), __float_as_uint(v4.y), __float_as_uint(v4.z), __float_as_uint(v4.w)};
    unsigned thr = 0u;
#pragma unroll 1
    for (int bit = 31; bit >= 0; --bit) { const unsigned cand = thr | (1u << bit);
        const unsigned c = (unsigned)(__popcll(__ballot(key[0] >= cand)) + __popcll(__ballot(key[1] >= cand)) + __popcll(__ballot(key[2] >= cand)) + __popcll(__ballot(key[3] >= cand)));
        LAS unsigned* slot_ = cnt + 16 + (bit & 1) * 8;
        if (lane == 0) slot_[wave] = c;
        __syncthreads();
        unsigned tot = 0;
#pragma unroll
        for (int w = 0; w < 8; ++w) tot += slot_[w];
        if (tot >= 256u) thr = cand; }
    __syncthreads();
    int ngt = 0, neq = 0;
#pragma unroll
    for (int j = 0; j < 4; ++j) { ngt += key[j] > thr; neq += key[j] == thr; }
    int sg = ngt, se = neq;
#pragma unroll
    for (int o = 1; o < 64; o <<= 1) { const int a = __shfl_up(sg, o), c = __shfl_up(se, o); if (lane >= o) { sg += a; se += c; } }
    if (lane == 63) { cnt[wave] = (unsigned)sg; cnt[8 + wave] = (unsigned)se; }
    __syncthreads();
    int bg = 0, be = 0, totg = 0;
#pragma unroll
    for (int w = 0; w < 8; ++w) { const int a = (int)cnt[w], c = (int)cnt[8 + w]; if (w < wave) { bg += a; be += c; } totg += a; }
    int pg = bg + sg - ngt, pe = be + se - neq;
    const int need_eq = 256 - totg;
    int* smrow = slotmap + ((size_t)b * T + 4 * tid) * 16 + e;
#pragma unroll
    for (int j = 0; j < 4; ++j) { int slot = -1;
        if (key[j] > thr) { slot = pg; ++pg; } else if (key[j] == thr) { if (pe < need_eq) slot = totg + pe; ++pe; }
        smrow[j * 16] = slot;
        if (slot >= 0) { selidx[((size_t)e * 16 + b) * 256 + slot] = b * T + 4 * tid + j; selaff[((size_t)e * 16 + b) * 256 + slot] = __uint_as_float(key[j]); } }
    __syncthreads();
}

__device__ __forceinline__ void pn_rows(const Frame& F, ArgsP A, float* wout) {
    unsigned char* ws = A->ws;
    const int* slotmap = (const int*)(ws + WS_SLOT); const bf16* YE = (const bf16*)(ws + WS_XE); const float* mod = (const float*)(ws + WS_MOD); const bf16* X1 = (const bf16*)(ws + WS_X1);
    const int gw = F.vcu * NWAVES + F.wave, NGW = F.G * NWAVES, lane = F.lane;
#pragma unroll 1
    for (int m0 = gw * 16; m0 < gw * 16 + 16; m0 += 2) {
        int myslot[2]; f32x4 xv[2][4];
#pragma unroll
        for (int i = 0; i < 2; ++i) { const int m = m0 + i; myslot[i] = slotmap[(size_t)m * 16 + (lane & 15)];
#pragma unroll
            for (int hq = 0; hq < 2; ++hq) { const v4u w = *(const GAS v4u*)(X1 + (size_t)m * 1024 + hq * 512 + lane * 8);
                xv[i][2 * hq] = (f32x4){bflo(w.x), bfhi(w.x), bflo(w.y), bfhi(w.y)}; xv[i][2 * hq + 1] = (f32x4){bflo(w.z), bfhi(w.z), bflo(w.w), bfhi(w.w)}; } }
        unsigned long long msk[2]; v4u yw[2][4][2];
#pragma unroll
        for (int i = 0; i < 2; ++i) { const int b = (m0 + i) >> 11; msk[i] = __ballot(myslot[i] >= 0) & 0xffffull;
#pragma unroll
            for (int k = 0; k < 4; ++k) { const bool has = msk[i] != 0ull; const int e = has ? __builtin_ctzll(msk[i]) : 0; if (has) msk[i] &= msk[i] - 1; const int sl = __shfl(myslot[i], e);
                yw[i][k][0] = (v4u){0u, 0u, 0u, 0u}; yw[i][k][1] = (v4u){0u, 0u, 0u, 0u};
                if (has) { const GAS v4u* yr = (const GAS v4u*)(YE + (((size_t)e * 16 + b) * 256 + sl) * 1024); yw[i][k][0] = yr[lane]; yw[i][k][1] = yr[64 + lane]; } } }
#pragma unroll
        for (int i = 0; i < 2; ++i) { const int m = m0 + i, b = m >> 11;
            float acc[16];
#pragma unroll
            for (int j = 0; j < 16; ++j) acc[j] = 0.f;
#pragma unroll
            for (int k = 0; k < 4; ++k)
#pragma unroll
                for (int hlf = 0; hlf < 2; ++hlf) { const v4u w = yw[i][k][hlf];
                    acc[hlf * 8 + 0] += bflo(w.x); acc[hlf * 8 + 1] += bfhi(w.x); acc[hlf * 8 + 2] += bflo(w.y); acc[hlf * 8 + 3] += bfhi(w.y);
                    acc[hlf * 8 + 4] += bflo(w.z); acc[hlf * 8 + 5] += bfhi(w.z); acc[hlf * 8 + 6] += bflo(w.w); acc[hlf * 8 + 7] += bfhi(w.w); }
            unsigned long long mk = msk[i];
            while (mk) { const int e = __builtin_ctzll(mk); mk &= mk - 1; const int sl = __shfl(myslot[i], e);
                const GAS v4u* yr = (const GAS v4u*)(YE + (((size_t)e * 16 + b) * 256 + sl) * 1024);
#pragma unroll
                for (int hlf = 0; hlf < 2; ++hlf) { const v4u w = yr[hlf * 64 + lane];
                    acc[hlf * 8 + 0] += bflo(w.x); acc[hlf * 8 + 1] += bfhi(w.x); acc[hlf * 8 + 2] += bflo(w.y); acc[hlf * 8 + 3] += bfhi(w.y);
                    acc[hlf * 8 + 4] += bflo(w.z); acc[hlf * 8 + 5] += bfhi(w.z); acc[hlf * 8 + 6] += bflo(w.w); acc[hlf * 8 + 7] += bfhi(w.w); } }
            const float* gt2 = mod + (size_t)b * 6144 + 5120; float* orow = wout + (size_t)m * 1024;
#pragma unroll
            for (int q = 0; q < 4; ++q) { const int c = (q >> 1) * 512 + lane * 8 + (q & 1) * 4; const f32x4 g = *(const GAS f32x4*)(gt2 + c);
                f32x4 a; a.x = acc[(q >> 1) * 8 + (q & 1) * 4 + 0]; a.y = acc[(q >> 1) * 8 + (q & 1) * 4 + 1]; a.z = acc[(q >> 1) * 8 + (q & 1) * 4 + 2]; a.w = acc[(q >> 1) * 8 + (q & 1) * 4 + 3];
                *(GAS f32x4*)(orow + c) = xv[i][q] + g * a; } } }
}

__device__ __forceinline__ void mk_frame(Frame& F, LAS unsigned char* lds, int wave_s) {
    int bx = blockIdx.x, G = gridDim.x; LAUNDER(bx); LAUNDER(G);
    F.lds = lds; F.MISC = (volatile LAS unsigned*)(lds + MISC_OFF); F.ctl = nullptr;
    unsigned ones_ = ~0u; asm volatile("" : "+s"(ones_));
    int lane_ = (int)__builtin_amdgcn_mbcnt_hi(ones_, __builtin_amdgcn_mbcnt_lo(ones_, 0u)); asm volatile("" : "+v"(lane_));
    F.lane = lane_; F.wave = wave_s; F.tid = wave_s * 64 + lane_;
    F.G = G; F.vcu = (G % 8 == 0) ? (bx % 8) * (G / 8) + bx / 8 : bx;
}
__global__ void __launch_bounds__(NWAVES * 64, 2) fwd_kernel(Args args) {
    extern __shared__ __attribute__((aligned(16))) unsigned char lds[];
    LAS unsigned char* const ldsb = (LAS unsigned char*)lds;
    ArgsP ap0 = (ArgsP)__builtin_amdgcn_kernarg_segment_ptr();
    int wave_s = __builtin_amdgcn_readfirstlane((int)threadIdx.x >> 6); asm volatile("" : "+s"(wave_s));
    for (int u = threadIdx.x; u < (LDS_BYTES - LDSCTL_OFF) / 4; u += NWAVES * 64) ((LAS unsigned*)(ldsb + LDSCTL_OFF))[u] = 0u;
    __syncthreads();
#define MKBAR XcdBarrier bar; { ArgsP a_ = ap0; LAUNDER(a_); bar.bar = (unsigned*)(a_->ws + WS_CTL) + CW_BAR; bar.x = xb_xcc_id(); bar.st = (volatile LAS unsigned*)(ldsb + MISC_OFF) + 8; }
#if ONE_LAUNCH
    { MKBAR; if (threadIdx.x == 0) (void)xb_add(&bar.bar[XB_XCNT(bar.x)], 1u); }
#ifndef PHM
#define PHM 0x3fff
#endif
#define IN(k) ((PHM >> (k)) & 1)
#define SEAM(k) do { if (IN(k) && IN((k) + 1)) { MKBAR; { unsigned o_ = ~0u; asm volatile("" : "+s"(o_)); xcd_barrier(bar, wave_s == 0 && __builtin_amdgcn_mbcnt_hi(o_, __builtin_amdgcn_mbcnt_lo(o_, 0u)) == 0u); } } } while (0)
#else
    int lo, hi; { ArgsP a = ap0; LAUNDER(a); lo = a->ph_lo; hi = a->ph_hi; }
#define IN(k) (lo <= (k) && (k) < hi)
#define SEAM(k) do { } while (0)
#endif
    typedef pg8::bf16_t pb;
#ifndef REPMASK
#define REPMASK 0
#endif
#define PHASE_ARGS ArgsP ap = ap0; LAUNDER(ap); unsigned char* ws = ap->ws; (void)ws; Frame F; mk_frame(F, ldsb, wave_s); const int gw = F.vcu * NWAVES + F.wave, NGW = F.G * NWAVES; (void)gw; (void)NGW
    if (IN(0)) _Pragma("unroll 1") for (int rep_ = 0; rep_ <= ((REPMASK >> 0) & 1); ++rep_) { PHASE_ARGS; p0_prologue(F, ap); } SEAM(0);
    if (IN(1)) _Pragma("unroll 1") for (int rep_ = 0; rep_ <= ((REPMASK >> 1) & 1); ++rep_) { PHASE_ARGS; const float* x = (const float*)ap->in[0]; const float* g1 = (const float*)ap->in[5]; const float* mod = (const float*)(ws + WS_MOD); bf16* XN = (bf16*)(ws + WS_XN);
#pragma unroll 1
        for (int wv = gw; wv < M / 16; wv += NGW) {
#pragma unroll 1
          for (int k4 = 0; k4 < 4; ++k4) { const int m = wv * 16 + 4 * k4; f32x4 u[4][4]; modnorm_rows<4, false>(x, m, 1, g1, mod, 0, 1024, XN, F.lane, u);
            if (F.lane < 32) { const int mm = m + (F.lane >> 3), j = F.lane & 7; const float pos = (float)((const int*)ap->in[2])[mm];
                const float ang = pos * __expf(-(float)j * 0.125f * 13.122363377404328f); const float sn = __sinf(ang), cs = __cosf(ang);
                bf16* rt = (bf16*)(ws + WS_ROPE) + (size_t)mm * 16; rt[j] = (bf16)(pk2(cs, 0.f) & 0xffffu); rt[8 + j] = (bf16)(pk2(sn, 0.f) & 0xffffu); } } } } SEAM(1);
    if (IN(2)) _Pragma("unroll 1") for (int rep_ = 0; rep_ <= ((REPMASK >> 2) & 1); ++rep_) { PHASE_ARGS; pg8::Gemm g{(const pb*)(ws + WS_XN), (const pb*)(ws + WS_WINT), M, NZP, D}; pg8::StaticOrder S; S.init(M, NZP, F.G, (int)blockIdx.x);
        pg8::EpiZ E{(pb*)(ws + WS_Z)}; pg8::gemm_phase<pg8::EpiZ, pg8::StaticOrder, true, true>(F.lds, g, S, E, F.tid); } SEAM(2);
    if (IN(3)) {
#ifndef REP_SCAN
#define REP_SCAN 1
#endif
#ifndef REP_ATTN
#define REP_ATTN 1
#endif
      { int c0_, G_; { Frame F0; mk_frame(F0, ldsb, wave_s); c0_ = F0.vcu; G_ = F0.G; }
#pragma unroll 1
        for (int c = c0_; c < 256 * REP_SCAN; c += G_) { PHASE_ARGS; const int b = (c >> 4) & 15, h = (c >> 1) & 7, dir = c & 1;
            scan2_setup(F.lds, (const GAS float*)ap->in[10], (const GAS float*)ap->in[12], h, dir, F.tid); __syncthreads();
            const ScanArgs SA{(const GAS bf16*)(ws + WS_Z), (const GAS float*)ap->in[7], (const GAS float*)ap->in[8], (const GAS float*)ap->in[9], (const GAS float*)ap->in[11], (const GAS float*)ap->in[14], (const GAS float*)ap->in[15], (const GAS float*)ap->in[16],
                              (GAS bf16*)(ws + WS_XN) + (size_t)dir * M * 512, (GAS float*)(ws + WS_BONUS) + (size_t)dir * M * 8};
#pragma unroll 1
            for (int cc = F.wave; cc < T / 32; cc += 8) scan2_chunk(F.lds, SA, b, h, dir, cc, F.lane, F.wave);
            __syncthreads(); } }
      { PHASE_ARGS;
#pragma unroll 1
        for (int u = F.vcu; u < 512 * REP_ATTN; u += F.G) { attn_unit(F, ap, (u >> 5) & 15, (u >> 4) & 1, u & 15); } }
      { PHASE_ARGS;
        const bf16* Z = (const bf16*)(ws + WS_Z); bf16* SGD = (bf16*)(ws + WS_SGD); const float* mu_prev = (const float*)ap->in[7]; const float* mu_next = (const float*)ap->in[8];
          const int c = ZGD + 2 * F.lane; const float mp0 = mu_prev[c], mp1 = mu_prev[c + 1], mn0 = mu_next[c], mn1 = mu_next[c + 1];
#ifndef REP_SGD
#define REP_SGD 1
#endif
          const int tile = F.vcu;
          if (tile < 256) { const int pm = tile >> 1, pn = tile & 1; constexpr int RS = 136;
              LAS bf16* SG = (LAS bf16*)F.lds; LAS bf16* GT = (LAS bf16*)(F.lds + 256 * RS * 2);
              __syncthreads();
              const int mt0 = pm * 256 + F.wave * 32;
#pragma unroll 1
              for (int m0 = 0; m0 < 32; m0 += 4) { unsigned z0[4], zm[4], zq[4];
#pragma unroll
                  for (int i = 0; i < 4; ++i) { const int m = mt0 + m0 + i, t = m & (T - 1);
                      z0[i] = *(const GAS unsigned*)(Z + (size_t)m * NZ + c); zm[i] = t > 0 ? *(const GAS unsigned*)(Z + (size_t)(m - 1) * NZ + c) : 0u; zq[i] = t < T - 1 ? *(const GAS unsigned*)(Z + (size_t)(m + 1) * NZ + c) : 0u; }
#pragma unroll
                  for (int i = 0; i < 4; ++i) { const float a0 = bflo(z0[i]), a1 = bfhi(z0[i]); const float s0 = a0 + mp0 * (bflo(zm[i]) - a0) + mn0 * (bflo(zq[i]) - a0), s1 = a1 + mp1 * (bfhi(zm[i]) - a1) + mn1 * (bfhi(zq[i]) - a1);
                      *(LAS unsigned*)(SG + (F.wave * 32 + m0 + i) * RS + 2 * F.lane) = pk2(sigm(s0), sigm(s1)); } }
              __syncthreads();
              const int r32 = F.lane & 31, hh = F.lane >> 5; bf16x8 af[8];
#pragma unroll
              for (int sI = 0; sI < 8; ++sI) af[sI] = *(const LAS bf16x8*)(SG + (F.wave * 32 + r32) * RS + 16 * sI + 8 * hh);
              bf16* Gout = (bf16*)(ws + WS_G); const bf16* G2T = (const bf16*)(ws + WS_G2T);
#pragma unroll 1
              for (int hf = 0; hf < 2; ++hf) {
#pragma unroll
                  for (int i = 0; i < 4; ++i) { const int e = F.tid + 512 * i, rr = e >> 4, ch = e & 15; *(LAS v4u*)(GT + rr * RS + ch * 8) = *(const GAS v4u*)(G2T + (size_t)(256 * pn + 128 * hf + rr) * 256 + ch * 8); }
                  __syncthreads();
#pragma unroll 1
                  for (int ct = 0; ct < 4; ++ct) { f32x16 acc = {};
#pragma unroll
                      for (int sI = 0; sI < 8; ++sI) { const bf16x8 bfr = *(const LAS bf16x8*)(GT + (32 * ct + r32) * RS + 16 * sI + 8 * hh); acc = __builtin_amdgcn_mfma_f32_32x32x16_bf16(af[sI], bfr, acc, 0, 0, 0); }
#pragma unroll
                      for (int g = 0; g < 16; ++g) { const int row = (g & 3) + 8 * (g >> 2) + 4 * hh;
                          Gout[(size_t)(mt0 + row) * 512 + 256 * pn + 128 * hf + 32 * ct + r32] = (bf16)(pk2(acc[g], 0.f) & 0xffffu); } }
                  __syncthreads(); } } }
    } SEAM(4);
#ifndef REP_PG
#define REP_PG 0
#endif
    if (IN(5)) { PHASE_ARGS; if (REP_PG) pg_rows(F, ap, (bf16*)ap->out); pg_rows(F, ap, (bf16*)(ws + WS_G)); } SEAM(5);
    if (IN(6)) { PHASE_ARGS; static_assert(WS_G == WS_OATT + (size_t)M * 512 * 2 && WS_PAT == WS_PRT + (size_t)1024 * 512 * 2, "merged operand views need adjacent buffers");
        pg8::Gemm g{(const pb*)(ws + WS_OATT), (const pb*)(ws + WS_PRT), 2 * M, 2048, 512}; pg8::MergeOrder S; S.init(F.G, (int)blockIdx.x);
        pg8::EpiGate2 E{(pb*)(ws + WS_XN), (const pb*)(ws + WS_Z)}; pg8::gemm_phase<pg8::EpiGate2, pg8::MergeOrder, true, true>(F.lds, g, S, E, F.tid); } SEAM(7);
    if (IN(8)) _Pragma("unroll 1") for (int rep_ = 0; rep_ <= ((REPMASK >> 8) & 1); ++rep_) { PHASE_ARGS; pg8::Gemm g{(const pb*)(ws + WS_XN), (const pb*)(ws + WS_WOT), M, 1024, 1024}; pg8::StaticOrder S; S.init(M, 1024, F.G, (int)blockIdx.x);
        pg8::EpiRes E{(const float*)ap->in[0], (const float*)(ws + WS_MOD), (pb*)(ws + WS_X1)}; pg8::gemm_phase<pg8::EpiRes, pg8::StaticOrder, true, true>(F.lds, g, S, E, F.tid); } SEAM(8);
    if (IN(9)) _Pragma("unroll 1") for (int rep_ = 0; rep_ <= ((REPMASK >> 9) & 1); ++rep_) { PHASE_ARGS; pj_phase(F, ap); } SEAM(9);
    if (IN(10)) _Pragma("unroll 1") for (int rep_ = 0; rep_ <= ((REPMASK >> 10) & 1); ++rep_) { PHASE_ARGS; for (int p = F.vcu; p < 256; p += F.G) pk_task(F, ap, p >> 4, p & 15); } SEAM(10);
    if (IN(11)) _Pragma("unroll 1") for (int rep_ = 0; rep_ <= ((REPMASK >> 11) & 1); ++rep_) { PHASE_ARGS; pg8::Gemm g{(const pb*)(ws + WS_XN), (const pb*)((unsigned char*)ap->out + OUT_WGUT), ME, 16 * 2048, 1024}; pg8::GroupOrder<8> S{F.G, (int)blockIdx.x};
        pg8::EpiSwiglu E{(pb*)(ws + WS_H)}; pg8::gemm_phase<pg8::EpiSwiglu, pg8::GroupOrder<8>, true, true, true>(F.lds, g, S, E, F.tid, (const int*)(ws + WS_SELIDX)); } SEAM(11);
    if (IN(12)) _Pragma("unroll 1") for (int rep_ = 0; rep_ <= ((REPMASK >> 12) & 1); ++rep_) { PHASE_ARGS; pg8::Gemm g{(const pb*)(ws + WS_H), (const pb*)((unsigned char*)ap->out + OUT_WDT), ME, 16 * 1024, 1024}; pg8::GroupOrder<4> S{F.G, (int)blockIdx.x};
        pg8::EpiDown E{(pb*)(ws + WS_XE), (const float*)(ws + WS_SELAFF)}; pg8::gemm_phase<pg8::EpiDown, pg8::GroupOrder<4>, true, true>(F.lds, g, S, E, F.tid); } SEAM(12);
#ifndef EXTRA_BARS
#define EXTRA_BARS 0
#endif
#if ONE_LAUNCH
    _Pragma("unroll 1") for (int xb_ = 0; xb_ < EXTRA_BARS; ++xb_) { MKBAR; { unsigned o_ = ~0u; asm volatile("" : "+s"(o_)); xcd_barrier(bar, wave_s == 0 && __builtin_amdgcn_mbcnt_hi(o_, __builtin_amdgcn_mbcnt_lo(o_, 0u)) == 0u); } }
#endif
#ifndef REP_PN
#define REP_PN 0
#endif
    if (IN(13)) { PHASE_ARGS; if (REP_PN) pn_rows(F, ap, (float*)(ws + WS_H)); pn_rows(F, ap, ap->out); }
#undef IN
#undef SEAM
}

extern "C" void kernel_launch(void* const* d_in, const int* in_sizes, int n_in, void* d_out, int out_size, void* d_ws, size_t ws_size, hipStream_t stream) {
    static int grid = 0;
    if (grid == 0) {
        if (n_in != 30 || out_size != M * D || ws_size < WS_END) { fprintf(stderr, "kernel_launch: unexpected shapes n_in %d out %d ws %zu\n", n_in, out_size, ws_size); grid = -1; return; }
        int dev = 0, cus = 0, per_cu = 0;
        if (hipGetDevice(&dev) != hipSuccess || hipDeviceGetAttribute(&cus, hipDeviceAttributeMultiprocessorCount, dev) != hipSuccess) { grid = -1; return; }
        if (hipFuncSetAttribute((const void*)fwd_kernel, hipFuncAttributeMaxDynamicSharedMemorySize, LDS_BYTES) != hipSuccess) { fprintf(stderr, "kernel_launch: hipFuncSetAttribute failed\n"); grid = -1; return; }
        if (hipOccupancyMaxActiveBlocksPerMultiprocessor(&per_cu, (const void*)fwd_kernel, NWAVES * 64, LDS_BYTES) != hipSuccess || per_cu < 1) fprintf(stderr, "kernel_launch: occupancy query reports %d\n", per_cu);
        (void)hipGetLastError();
        grid = cus;
    }
    if (grid < 0) return;
    if (hipMemsetAsync((char*)d_ws + WS_CTL, 0, CTL_ZERO_BYTES, stream) != hipSuccess) return;
    Args a{};
    for (int i = 0; i < 30; ++i) a.in[i] = d_in[i];
    a.out = (float*)d_out; a.ws = (unsigned char*)d_ws;
#if ONE_LAUNCH
    a.ph_lo = 0; a.ph_hi = NPHASE;
    hipLaunchKernelGGL(fwd_kernel, dim3(grid), dim3(NWAVES * 64), LDS_BYTES, stream, a);
#else
    for (int p = 0; p < NPHASE; ++p) { a.ph_lo = p; a.ph_hi = p + 1; hipLaunchKernelGGL(fwd_kernel, dim3(grid), dim3(NWAVES * 64), LDS_BYTES, stream, a); }
#endif
}
```

```cpp
#include <hip/hip_runtime.h>
#include <cstdio>
#include <cstdint>
#include <cmath>
namespace pg8 {
#define PG8_LAS __attribute__((address_space(3)))
typedef unsigned short bf16_t;
typedef short bf16x8 __attribute__((ext_vector_type(8)));
typedef float f32x4 __attribute__((ext_vector_type(4)));
typedef unsigned u32x4 __attribute__((ext_vector_type(4)));
constexpr int BM = 256, BK = 64, HALF = 128, HTB = HALF * BK * 2  , STAGE_BYTES = 8 * HTB, NXCD = 8, WGM = 4;

__host__ __device__ __forceinline__ int lds_byte(int r, int c) { const int st = (r >> 4) * 2 + (c >> 5), rr = r & 15, cc = c & 31, ob = rr * 64 + cc * 2; return st * 1024 + (ob ^ (((ob >> 9) & 1) << 5)); }
__host__ __device__ __forceinline__ void stage_rc(int b, int& R, int& C) { const int st = b / 1024, sb = b % 1024, swz = sb ^ (((sb >> 9) & 1) << 5); R = (st >> 1) * 16 + swz / 64; C = (st & 1) * 32 + (swz % 64) / 2; }
__host__ __device__ __forceinline__ int perm32(int rho) { const int n = rho >> 4, i = rho & 15; return 8 * (i >> 2) + 4 * n + (i & 3); }

struct Unit { int pm, pn; };
struct Gemm { const bf16_t* A; const bf16_t* Bt; int M, N, K; };

struct StaticOrder {
    int nM, nN, nwg, G, c;
    __host__ __device__ void init(int M, int N, int G_, int c_) { nM = M / BM; nN = N / BM; nwg = nM * nN; G = G_; c = c_; }
    __host__ __device__ bool next(int i, Unit& u) const {
        const long L = (long)i * G + c; if (L >= nwg) return false;
        int wgid = (int)L; { const int q = nwg / NXCD, r = nwg % NXCD, xcd = wgid % NXCD, off = wgid / NXCD; wgid = (xcd < r ? xcd * (q + 1) : r * (q + 1) + (xcd - r) * q) + off; }
        const int nig = WGM * nN, gid = wgid / nig, fm = gid * WGM, gsz = (nM - fm) < WGM ? (nM - fm) : WGM;
        u.pm = fm + ((wgid % nig) % gsz); u.pn = (wgid % nig) / gsz; return true;
    }
    __device__ __forceinline__ void a_ready(const Unit&) const {}
    __device__ __forceinline__ void done(const Unit&) const {}
};

__device__ __forceinline__ unsigned cvt_pk_bf16(float lo, float hi) { unsigned r; asm volatile("v_cvt_pk_bf16_f32 %0, %1, %2" : "=v"(r) : "v"(lo), "v"(hi)); return r; }
typedef float f32x2 __attribute__((ext_vector_type(2)));
template <class Epi, class Sched, bool ALIGN_EPI = false, bool SP2 = false, bool GATHER = false>
__device__ __forceinline__ void gemm_phase(PG8_LAS unsigned char* lds, const Gemm g, const Sched& S, const Epi& E, int tid_in, const int* gidx = nullptr) {
    static_assert(!GATHER || SP2, "the gather variant is written for the SP2 loop");
    int tid_ = tid_in; asm volatile("" : "+v"(tid_));
    const int tid = tid_, wid = __builtin_amdgcn_readfirstlane(tid >> 6), lane = tid & 63, wr = wid >> 2, wc = wid & 3, fr = lane & 15, fq = lane >> 4;
    const int K = g.K, nt = K / BK;
    unsigned voffA[2], voffB[2];
#pragma unroll
    for (int i = 0; i < 2; ++i) { int R, C; stage_rc(tid * 16 + i * 8192, R, C); const int Rb = Epi::PERM ? ((R & ~31) + perm32(R & 31)) : R;
        voffA[i] = (unsigned)(R * K + C) * 2u; voffB[i] = (unsigned)(Rb * K + C) * 2u; }
    int gRA[2] = {0, 0}; unsigned gCA[2] = {0u, 0u}; unsigned gc[2][2] = {{0u, 0u}, {0u, 0u}}, gn[2][2] = {{0u, 0u}, {0u, 0u}};
    if constexpr (GATHER) {
#pragma unroll
        for (int i = 0; i < 2; ++i) { int R, C; stage_rc(tid * 16 + i * 8192, R, C); gRA[i] = R; gCA[i] = (unsigned)C * 2u; } }
#define PG8_GLOAD(dst, un) do { _Pragma("unroll") for (int h_ = 0; h_ < 2; ++h_) _Pragma("unroll") for (int i_ = 0; i_ < 2; ++i_) \
        dst[h_][i_] = (unsigned)gidx[(un).pm * 256 + h_ * 128 + gRA[i_]] * (unsigned)(K * 2) + gCA[i_]; } while (0)
#define PG8_STAGE_G(bufoff, gbase, nx, h) do { unsigned vo_[2] = {(nx) ? gn[h][0] : gc[h][0], (nx) ? gn[h][1] : gc[h][1]}; PG8_STAGE(bufoff, gbase, vo_); } while (0)
    const size_t kstep = (size_t)(BK * 2);
    const size_t hstep = (size_t)HALF * K * 2;
    const size_t tstep = 2 * hstep;
    const unsigned ldsw = (unsigned)wid * 1024u;
    const int aoff = lds_byte(wr * 64 + fr, fq * 8), boff = lds_byte(wc * 32 + fr, fq * 8);
#define PG8_SA(b, h) (((b) * 2 + (h)) * HTB)
#define PG8_SB(b, h) ((4 + (b) * 2 + (h)) * HTB)
#define PG8_STAGE(bufoff, gbase, voff) do { _Pragma("unroll") for (int _i = 0; _i < 2; ++_i) \
        __builtin_amdgcn_global_load_lds((const unsigned*)((const char*)(gbase) + (voff)[_i]), (PG8_LAS unsigned*)(lds + (bufoff) + ldsw + _i * 8192), 16, 0, 0); } while (0)
#define PG8_LDA(dst, b, h) do { _Pragma("unroll") for (int m = 0; m < 4; ++m) _Pragma("unroll") for (int k = 0; k < 2; ++k) dst[m][k] = *(const PG8_LAS bf16x8*)(lds + PG8_SA(b, h) + aoff + m * 2048 + k * 1024); } while (0)
#define PG8_LDB(dst, b, h) do { _Pragma("unroll") for (int n = 0; n < 2; ++n) _Pragma("unroll") for (int k = 0; k < 2; ++k) dst[n][k] = *(const PG8_LAS bf16x8*)(lds + PG8_SB(b, h) + boff + n * 2048 + k * 1024); } while (0)
#define PG8_MMA(ai, bj, At, Bt) do { __builtin_amdgcn_s_setprio(1); _Pragma("unroll") for (int m = 0; m < 4; ++m) _Pragma("unroll") for (int n = 0; n < 2; ++n) _Pragma("unroll") for (int k = 0; k < 2; ++k) \
        acc[ai][bj][m][n] = __builtin_amdgcn_mfma_f32_16x16x32_bf16(Bt[n][k], At[m][k], acc[ai][bj][m][n], 0, 0, 0); __builtin_amdgcn_s_setprio(0); } while (0)
#define PG8_WAIT_V(n) asm volatile("s_waitcnt vmcnt(" #n ")" ::: "memory")
#define PG8_WAIT_L(n) asm volatile("s_waitcnt lgkmcnt(" #n ")" ::: "memory")
#define PG8_BAR __builtin_amdgcn_s_barrier()
#define PG8_SCHED __builtin_amdgcn_sched_barrier(0)
    Unit cur, nxt; int ui = 0;
    if (!S.next(0, cur)) return;
    f32x4 acc[2][2][4][2];
#pragma unroll
    for (int a = 0; a < 2; ++a)
#pragma unroll
        for (int b = 0; b < 2; ++b)
#pragma unroll
            for (int m = 0; m < 4; ++m)
#pragma unroll
                for (int n = 0; n < 2; ++n) acc[a][b][m][n] = (f32x4){0.f, 0.f, 0.f, 0.f};
    bf16x8 At[4][2], B0[2][2], B1[2][2];
    const char* cA = GATHER ? (const char*)g.A : (const char*)g.A + (size_t)cur.pm * tstep; const char* cB = (const char*)g.Bt + (size_t)cur.pn * tstep;
    if constexpr (GATHER) { PG8_GLOAD(gc, cur); Unit n1_; if (S.next(1, n1_)) PG8_GLOAD(gn, n1_); else { gn[0][0] = gc[0][0]; gn[0][1] = gc[0][1]; gn[1][0] = gc[1][0]; gn[1][1] = gc[1][1]; } }
    S.a_ready(cur);
    if constexpr (SP2) {
        PG8_STAGE(PG8_SB(0, 0), cB, voffB); PG8_STAGE(PG8_SB(0, 1), cB + hstep, voffB);
        if constexpr (GATHER) { PG8_STAGE_G(PG8_SA(0, 0), cA, false, 0); PG8_STAGE_G(PG8_SA(0, 1), cA, false, 1); } else { PG8_STAGE(PG8_SA(0, 0), cA, voffA); PG8_STAGE(PG8_SA(0, 1), cA + hstep, voffA); }
        if (wr == 1) PG8_BAR;
        PG8_WAIT_V(2); PG8_BAR;
        PG8_STAGE(PG8_SB(1, 0), cB + kstep, voffB); if constexpr (GATHER) PG8_STAGE_G(PG8_SA(1, 0), cA + kstep, false, 0); else PG8_STAGE(PG8_SA(1, 0), cA + kstep, voffA); PG8_STAGE(PG8_SB(1, 1), cB + hstep + kstep, voffB);
        PG8_WAIT_V(6); PG8_BAR;
    } else {
        PG8_STAGE(PG8_SB(0, 0), cB, voffB); PG8_STAGE(PG8_SA(0, 0), cA, voffA); PG8_STAGE(PG8_SB(0, 1), cB + hstep, voffB); PG8_STAGE(PG8_SA(0, 1), cA + hstep, voffA);
        if (wr == 1) PG8_BAR;
        PG8_WAIT_V(4); PG8_BAR;
        PG8_STAGE(PG8_SB(1, 0), cB + kstep, voffB); PG8_STAGE(PG8_SA(1, 0), cA + kstep, voffA); PG8_STAGE(PG8_SB(1, 1), cB + hstep + kstep, voffB);
        PG8_WAIT_V(6); PG8_BAR;
    }
    for (;;) {
        const bool has_next = S.next(ui + 1, nxt);
        if constexpr (GATHER) { if (!has_next) { gn[0][0] = gc[0][0]; gn[0][1] = gc[0][1]; gn[1][0] = gc[1][0]; gn[1][1] = gc[1][1]; } }
        const char* nA = (has_next && !GATHER) ? (const char*)g.A + (size_t)nxt.pm * tstep : cA; const char* nB = has_next ? (const char*)g.Bt + (size_t)nxt.pn * tstep : cB;
        for (int t = 0; t < nt; t += 2) {
            const bool last = (t == nt - 2);
            const char* a1 = cA + (size_t)(t + 1) * kstep;
            const char* a2 = last ? nA : cA + (size_t)(t + 2) * kstep; const char* b2 = last ? nB : cB + (size_t)(t + 2) * kstep;
            const char* a3 = a2 + kstep; const char* b3 = b2 + kstep;
            if (last && has_next) S.a_ready(nxt);
            if constexpr (SP2) {
            PG8_LDB(B0, 0, 0); PG8_LDB(B1, 0, 1); PG8_SCHED; PG8_LDA(At, 0, 0); if constexpr (GATHER) PG8_STAGE_G(PG8_SA(1, 1), a1, false, 1); else PG8_STAGE(PG8_SA(1, 1), a1 + hstep, voffA);
            PG8_WAIT_V(8); PG8_WAIT_L(0); PG8_BAR; PG8_MMA(0, 0, At, B0); PG8_MMA(0, 1, At, B1); PG8_BAR; PG8_SCHED;
            PG8_LDA(At, 0, 1); PG8_STAGE(PG8_SB(0, 0), b2, voffB); PG8_STAGE(PG8_SB(0, 1), b2 + hstep, voffB); if constexpr (GATHER) PG8_STAGE_G(PG8_SA(0, 0), a2, last, 0); else PG8_STAGE(PG8_SA(0, 0), a2, voffA);
            PG8_WAIT_V(8); PG8_WAIT_L(0); PG8_BAR; PG8_MMA(1, 0, At, B0); PG8_MMA(1, 1, At, B1); PG8_BAR; PG8_SCHED;
            PG8_LDB(B0, 1, 0); PG8_LDB(B1, 1, 1); PG8_SCHED; PG8_LDA(At, 1, 0); if constexpr (GATHER) PG8_STAGE_G(PG8_SA(0, 1), a2, last, 1); else PG8_STAGE(PG8_SA(0, 1), a2 + hstep, voffA);
            PG8_WAIT_V(8); PG8_WAIT_L(0); PG8_BAR; PG8_MMA(0, 0, At, B0); PG8_MMA(0, 1, At, B1); PG8_BAR; PG8_SCHED;
            PG8_LDA(At, 1, 1); PG8_STAGE(PG8_SB(1, 0), b3, voffB); PG8_STAGE(PG8_SB(1, 1), b3 + hstep, voffB); if constexpr (GATHER) PG8_STAGE_G(PG8_SA(1, 0), a3, last, 0); else PG8_STAGE(PG8_SA(1, 0), a3, voffA);
            PG8_WAIT_V(8); PG8_WAIT_L(0); PG8_BAR; PG8_MMA(1, 0, At, B0); PG8_MMA(1, 1, At, B1); PG8_BAR; PG8_SCHED;
            } else {
            PG8_LDB(B0, 0, 0); PG8_SCHED; PG8_LDA(At, 0, 0); PG8_STAGE(PG8_SA(1, 1), a1 + hstep, voffA);
            PG8_WAIT_L(8); PG8_BAR; PG8_WAIT_L(0); PG8_MMA(0, 0, At, B0); PG8_BAR; PG8_SCHED;
            PG8_LDB(B1, 0, 1); PG8_STAGE(PG8_SB(0, 0), b2, voffB);
            PG8_BAR; PG8_WAIT_L(0); PG8_MMA(0, 1, At, B1); PG8_BAR;
            PG8_LDA(At, 0, 1); PG8_STAGE(PG8_SA(0, 0), a2, voffA);
            PG8_BAR; PG8_WAIT_L(0); PG8_MMA(1, 0, At, B0); PG8_BAR; PG8_SCHED;
            PG8_STAGE(PG8_SB(0, 1), b2 + hstep, voffB);
            PG8_WAIT_V(6); PG8_BAR; PG8_MMA(1, 1, At, B1); PG8_BAR;
            PG8_LDB(B0, 1, 0); PG8_SCHED; PG8_LDA(At, 1, 0); PG8_STAGE(PG8_SA(0, 1), a2 + hstep, voffA);
            PG8_WAIT_L(8); PG8_BAR; PG8_WAIT_L(0); PG8_MMA(0, 0, At, B0); PG8_BAR; PG8_SCHED;
            PG8_LDB(B1, 1, 1); PG8_STAGE(PG8_SB(1, 0), b3, voffB);
            PG8_BAR; PG8_WAIT_L(0); PG8_MMA(0, 1, At, B1); PG8_BAR;
            PG8_LDA(At, 1, 1); PG8_STAGE(PG8_SA(1, 0), a3, voffA);
            PG8_BAR; PG8_WAIT_L(0); PG8_MMA(1, 0, At, B0); PG8_BAR; PG8_SCHED;
            PG8_STAGE(PG8_SB(1, 1), b3 + hstep, voffB);
            PG8_WAIT_V(6); PG8_BAR; PG8_MMA(1, 1, At, B1); PG8_BAR;
            }
        }
        if constexpr (ALIGN_EPI) { if (wr == 0) PG8_BAR; }
#ifdef REP_EPI
        if constexpr (!Epi::AFTER_DRAIN) { E(acc, cur, wr, wc, fr, fq); asm volatile("" ::: "memory"); }
#endif
        if constexpr (!Epi::AFTER_DRAIN) { E(acc, cur, wr, wc, fr, fq); S.done(cur); }
        unsigned g2_[2][2] = {{0u, 0u}, {0u, 0u}};
        if constexpr (GATHER) { Unit nn_; if (has_next && S.next(ui + 2, nn_)) PG8_GLOAD(g2_, nn_); else { g2_[0][0] = gn[0][0]; g2_[0][1] = gn[0][1]; g2_[1][0] = gn[1][0]; g2_[1][1] = gn[1][1]; } }
        if (!has_next) break;
#pragma unroll
        for (int a = 0; a < 2; ++a)
#pragma unroll
            for (int b = 0; b < 2; ++b)
#pragma unroll
                for (int m = 0; m < 4; ++m)
#pragma unroll
                    for (int n = 0; n < 2; ++n) acc[a][b][m][n] = (f32x4){0.f, 0.f, 0.f, 0.f};
        cur = nxt; cA = nA; cB = nB; ++ui;
        if constexpr (GATHER) { gc[0][0] = gn[0][0]; gc[0][1] = gn[0][1]; gc[1][0] = gn[1][0]; gc[1][1] = gn[1][1]; gn[0][0] = g2_[0][0]; gn[0][1] = g2_[0][1]; gn[1][0] = g2_[1][0]; gn[1][1] = g2_[1][1]; }
        if constexpr (ALIGN_EPI) { if (wr == 1) PG8_BAR; }
    }
    PG8_WAIT_V(0);
    if constexpr (!ALIGN_EPI) { if (wr == 0) PG8_BAR; }
    PG8_BAR;
    if constexpr (Epi::AFTER_DRAIN) { E.fused(acc, cur, wr, wc, fr, fq, lds, wid, lane); S.done(cur); }
#undef PG8_SA
#undef PG8_SB
#undef PG8_STAGE
#undef PG8_STAGE_G
#undef PG8_GLOAD
#undef PG8_LDA
#undef PG8_LDB
#undef PG8_MMA
#undef PG8_WAIT_V
#undef PG8_WAIT_L
#undef PG8_BAR
#undef PG8_SCHED
}
}

#ifndef ONE_LAUNCH
#define ONE_LAUNCH 1
#endif
constexpr int NB = 16, T = 2048, D = 1024, M = NB * T;
constexpr int NZ = 4736, NZP = 4864;
constexpr int RW = 512, NE = 16, CAP = 256, ME = NE * NB * CAP;
constexpr int ZR = 0, ZK = 512, ZV = 1024, ZWD = 1536, ZAD = 1664, ZGD = 1792, ZQ = 1920, ZKA = 2432, ZVA = 2560, ZGA = 2688, ZGB = 3712;
constexpr int NWAVES = 8, NPHASE = 14;
constexpr size_t MiB = 1u << 20;
constexpr size_t WS_CTL = 0, CTL_ZERO_BYTES = 64 * 1024 + 16 * 6144 * 4;
constexpr size_t WS_MOD = 64 * 1024, WS_BONUS = 2 * MiB, WS_AFF = 4 * MiB, WS_SELAFF = 6 * MiB, WS_SLOT = 7 * MiB, WS_G2T = 9 * MiB;
constexpr size_t WS_WINT = 10 * MiB, WS_PRT = 20 * MiB, WS_PAT = 21 * MiB, WS_WOT = 22 * MiB, WS_SGD = 24 * MiB;
constexpr size_t WS_XN = 40 * MiB;
constexpr size_t WS_OATT = 104 * MiB;
constexpr size_t WS_G = 136 * MiB;
constexpr size_t WS_Z = 168 * MiB;
constexpr size_t WS_X1 = 104 * MiB;
constexpr size_t OUT_WGUT = 0;
constexpr size_t OUT_WDT = 64 * MiB;
constexpr size_t WS_XE = 200 * MiB;
constexpr size_t WS_H = 328 * MiB;
constexpr size_t WS_END = 464 * MiB;
constexpr size_t WS_ROPE = WS_AFF;
constexpr size_t WS_SELIDX = WS_SELAFF + 512 * 1024;
constexpr int CW_BAR = 4096;
constexpr int RING_BYTES = 131072, LDSCTL_OFF = RING_BYTES, MISC_OFF = LDSCTL_OFF + 320, LDS_BYTES = 147456;

#define GAS __attribute__((address_space(1)))
#define LAS __attribute__((address_space(3)))
typedef unsigned short bf16;
typedef unsigned v4u __attribute__((ext_vector_type(4)));
typedef float f32x4 __attribute__((ext_vector_type(4)));
typedef short bf16x8 __attribute__((ext_vector_type(8)));
typedef GAS unsigned gu32;
typedef GAS unsigned long long gu64;
#define RLX_AGENT __ATOMIC_RELAXED, __HIP_MEMORY_SCOPE_AGENT
#define LDS_WAIT() asm volatile("s_waitcnt lgkmcnt(0)" ::: "memory")
#define VM_WAIT() asm volatile("s_waitcnt vmcnt(0)" ::: "memory")
__device__ __forceinline__ unsigned long long rt() { return __builtin_amdgcn_s_memrealtime(); }
__device__ __forceinline__ unsigned f2bf(float f) { unsigned u = __builtin_bit_cast(unsigned, f); return (u + 0x7fffu + ((u >> 16) & 1u)) >> 16; }
typedef float f32x2hw __attribute__((ext_vector_type(2))); typedef __bf16 bf16x2hw __attribute__((ext_vector_type(2)));
__device__ __forceinline__ unsigned pk2(float lo, float hi) { f32x2hw v = {lo, hi}; bf16x2hw b = __builtin_convertvector(v, bf16x2hw); return __builtin_bit_cast(unsigned, b); }

#define XB_TMO      128
#define XB_XCNT(j)  (256  + 64 * (j))
#define XB_XSUB(j)  (1280 + 64 * (j))
#define XB_XGEN(j)  (2304 + 64 * (j))
#define XB_TOP      3328
#define XB_TOPGEN   3392
#define XCD_BAR_WORDS 3456
#define XB_SPIN_CAP (1u << 18)

__device__ __forceinline__ unsigned xb_ld(unsigned* p)              { return __hip_atomic_load(p, __ATOMIC_RELAXED, __HIP_MEMORY_SCOPE_AGENT); }
__device__ __forceinline__ unsigned xb_add(unsigned* p, unsigned v) { return __hip_atomic_fetch_add(p, v, __ATOMIC_RELAXED, __HIP_MEMORY_SCOPE_AGENT); }
__device__ __forceinline__ unsigned xb_xcc_id() { return (unsigned)__builtin_amdgcn_s_getreg((3 << 11) | 20) & 0xFu; }
#define XB_SPIN(cond, bar) do { unsigned _sp = 0; while (cond) { __builtin_amdgcn_s_sleep(1); \
    if ((++_sp & 255u) == 0u) { if (xb_ld(&(bar)[XB_TMO])) break; if (_sp > XB_SPIN_CAP) { atomicAdd(&(bar)[XB_TMO], 1u); break; } } } } while (0)

struct XcdBarrier {
    unsigned* bar; unsigned x;
    volatile LAS unsigned* st;
};

__device__ __forceinline__ XcdBarrier xcd_barrier_post(unsigned* bar, volatile LAS unsigned* st) {
    XcdBarrier b; b.bar = bar; b.x = xb_xcc_id(); b.st = st;
    if (threadIdx.x == 0) (void)xb_add(&bar[XB_XCNT(b.x)], 1u);
    return b;
}
__device__ __forceinline__ void xcd_barrier_complete(unsigned* bar, unsigned x, unsigned& nloc, unsigned& nx) {
    const unsigned G = gridDim.x * gridDim.y * gridDim.z;
    unsigned sum, cnt, mine, sp = 0u;
    for (;;) {
        sum = 0u; cnt = 0u; mine = 0u;
#pragma unroll
        for (unsigned j = 0; j < 16; ++j) { const unsigned c = xb_ld(&bar[XB_XCNT(j)]); sum += c; cnt += (c > 0u) ? 1u : 0u; mine = (j == x) ? c : mine; }
        if (sum == G) break;
        __builtin_amdgcn_s_sleep(1);
        if ((++sp & 255u) == 0u) { if (xb_ld(&bar[XB_TMO])) break; if (sp > XB_SPIN_CAP) { atomicAdd(&bar[XB_TMO], 1u); break; } }
    }
    nloc = mine > 0u ? mine : 1u; nx = cnt > 0u ? cnt : 1u;
}

__device__ __forceinline__ void xcd_barrier(const XcdBarrier& b, bool is_thread0) {
    asm volatile("s_waitcnt vmcnt(0)" ::: "memory");
    __syncthreads();
    if (is_thread0) {
        unsigned* bar = b.bar;
        __builtin_amdgcn_s_waitcnt(0);
        unsigned nloc = b.st[0], nx = b.st[1];
        if (nloc == 0u) { xcd_barrier_complete(bar, b.x, nloc, nx); b.st[0] = nloc; b.st[1] = nx; }
        const unsigned old = xb_add(&bar[XB_XSUB(b.x)], 1u);
        const unsigned gen = old / nloc;
        if (old + 1u == (gen + 1u) * nloc) {
            __builtin_amdgcn_fence(__ATOMIC_RELEASE, "agent");
            asm volatile("s_waitcnt vmcnt(0)" ::: "memory");
            const unsigned og = xb_add(&bar[XB_TOP], 1u);
            const unsigned tg = og / nx;
            if (og + 1u == (tg + 1u) * nx) xb_add(&bar[XB_TOPGEN], 1u);
            else XB_SPIN(xb_ld(&bar[XB_TOPGEN]) == tg, bar);
            __builtin_amdgcn_fence(__ATOMIC_ACQUIRE, "agent");
            xb_add(&bar[XB_XGEN(b.x)], 1u);
            asm volatile("s_waitcnt vmcnt(0)" ::: "memory");
        } else {
            XB_SPIN(xb_ld(&bar[XB_XGEN(b.x)]) == gen, bar);
            __builtin_amdgcn_fence(__ATOMIC_ACQUIRE, "agent");
            asm volatile("s_waitcnt vmcnt(0)" ::: "memory");
        }
    }
    __syncthreads();
}
namespace pg8 {
__device__ __forceinline__ float bf2f(unsigned short h) { return __uint_as_float(((unsigned)h) << 16); }
__device__ __forceinline__ float bflo(unsigned w) { return __uint_as_float(w << 16); }
__device__ __forceinline__ float bfhi(unsigned w) { return __uint_as_float(w & 0xffff0000u); }
__device__ __forceinline__ float sigm(float x) { return 1.0f / (1.0f + __expf(-x)); }
struct EpiZ { static constexpr bool PERM = true, AFTER_DRAIN = false; bf16_t* O;
    __device__ __forceinline__ void operator()(const f32x4 (&acc)[2][2][4][2], const Unit& u, int wr, int wc, int fr, int fq) const {
        const int row0 = u.pm * BM + wr * 64 + fr, col0 = u.pn * BM + wc * 32 + 8 * fq;
#pragma unroll
        for (int ai = 0; ai < 2; ++ai)
#pragma unroll
            for (int m = 0; m < 4; ++m) { bf16_t* rowp = O + (size_t)(row0 + ai * HALF + m * 16) * 4736 + col0;
#pragma unroll
                for (int bj = 0; bj < 2; ++bj) { if (u.pn * BM + bj * HALF < 4736) { const f32x4 v0 = acc[ai][bj][m][0], v1 = acc[ai][bj][m][1];
                    u32x4 w; w.x = cvt_pk_bf16(v0[0], v0[1]); w.y = cvt_pk_bf16(v0[2], v0[3]); w.z = cvt_pk_bf16(v1[0], v1[1]); w.w = cvt_pk_bf16(v1[2], v1[3]);
                    *(u32x4*)(rowp + bj * HALF) = w; } } }
    }
};
struct EpiPlain { static constexpr bool PERM = true, AFTER_DRAIN = false; bf16_t* O; int ldc;
    __device__ __forceinline__ void operator()(const f32x4 (&acc)[2][2][4][2], const Unit& u, int wr, int wc, int fr, int fq) const {
        const int row0 = u.pm * BM + wr * 64 + fr, col0 = u.pn * BM + wc * 32 + 8 * fq;
#pragma unroll
        for (int ai = 0; ai < 2; ++ai)
#pragma unroll
            for (int m = 0; m < 4; ++m) { bf16_t* rowp = O + (size_t)(row0 + ai * HALF + m * 16) * ldc + col0;
#pragma unroll
                for (int bj = 0; bj < 2; ++bj) { const f32x4 v0 = acc[ai][bj][m][0], v1 = acc[ai][bj][m][1];
                    u32x4 w; w.x = cvt_pk_bf16(v0[0], v0[1]); w.y = cvt_pk_bf16(v0[2], v0[3]); w.z = cvt_pk_bf16(v1[0], v1[1]); w.w = cvt_pk_bf16(v1[2], v1[3]);
                    *(u32x4*)(rowp + bj * HALF) = w; } }
    }
};
template <bool ADD> struct EpiGate { static constexpr bool PERM = true, AFTER_DRAIN = false; bf16_t* O; const bf16_t* Z; int zc0;
    __device__ __forceinline__ void operator()(const f32x4 (&acc)[2][2][4][2], const Unit& u, int wr, int wc, int fr, int fq) const {
        const int row0 = u.pm * BM + wr * 64 + fr, col0 = u.pn * BM + wc * 32 + 8 * fq;
#pragma unroll
        for (int ai = 0; ai < 2; ++ai)
#pragma unroll
            for (int m = 0; m < 4; ++m) { const size_t row = (size_t)(row0 + ai * HALF + m * 16); bf16_t* rowp = O + row * 1024 + col0; const bf16_t* zp = Z + row * 4736 + zc0 + col0;
#pragma unroll
                for (int bj = 0; bj < 2; ++bj) { const f32x4 v0 = acc[ai][bj][m][0], v1 = acc[ai][bj][m][1];
                    const u32x4 zg = *(const u32x4*)(zp + bj * HALF);
                    float r0 = sigm(bflo(zg.x)) * v0[0], r1 = sigm(bfhi(zg.x)) * v0[1], r2 = sigm(bflo(zg.y)) * v0[2], r3 = sigm(bfhi(zg.y)) * v0[3];
                    float r4 = sigm(bflo(zg.z)) * v1[0], r5 = sigm(bfhi(zg.z)) * v1[1], r6 = sigm(bflo(zg.w)) * v1[2], r7 = sigm(bfhi(zg.w)) * v1[3];
                    if (ADD) { const u32x4 p = *(const u32x4*)(rowp + bj * HALF);
                        r0 += bflo(p.x); r1 += bfhi(p.x); r2 += bflo(p.y); r3 += bfhi(p.y); r4 += bflo(p.z); r5 += bfhi(p.z); r6 += bflo(p.w); r7 += bfhi(p.w); }
                    u32x4 w; w.x = cvt_pk_bf16(r0, r1); w.y = cvt_pk_bf16(r2, r3); w.z = cvt_pk_bf16(r4, r5); w.w = cvt_pk_bf16(r6, r7);
                    *(u32x4*)(rowp + bj * HALF) = w; } }
    }
};
struct EpiGate2 { static constexpr bool PERM = true, AFTER_DRAIN = false; bf16_t* O; const bf16_t* Z;
    __device__ __forceinline__ void operator()(const f32x4 (&acc)[2][2][4][2], const Unit& u, int wr, int wc, int fr, int fq) const {
        const bool add = u.pm < 128; const int zc0 = add ? 3712 : 2688;
        const int row0 = (u.pm & 127) * BM + wr * 64 + fr, col0 = (u.pn & 3) * BM + wc * 32 + 8 * fq;
#pragma unroll
        for (int ai = 0; ai < 2; ++ai) {
            u32x4 zg[4][2], pv[4][2];
#pragma unroll
            for (int m = 0; m < 4; ++m) { const size_t row = (size_t)(row0 + ai * HALF + m * 16);
#pragma unroll
                for (int bj = 0; bj < 2; ++bj) { zg[m][bj] = *(const u32x4*)(Z + row * 4736 + zc0 + col0 + bj * HALF); pv[m][bj] = (u32x4){0u, 0u, 0u, 0u}; if (add) pv[m][bj] = *(const u32x4*)(O + row * 1024 + col0 + bj * HALF); } }
#pragma unroll
            for (int m = 0; m < 4; ++m) { const size_t row = (size_t)(row0 + ai * HALF + m * 16); bf16_t* rowp = O + row * 1024 + col0;
#pragma unroll
                for (int bj = 0; bj < 2; ++bj) { const f32x4 v0 = acc[ai][bj][m][0], v1 = acc[ai][bj][m][1]; const u32x4 g = zg[m][bj], p = pv[m][bj];
                    const float r0 = sigm(bflo(g.x)) * v0[0] + bflo(p.x), r1 = sigm(bfhi(g.x)) * v0[1] + bfhi(p.x), r2 = sigm(bflo(g.y)) * v0[2] + bflo(p.y), r3 = sigm(bfhi(g.y)) * v0[3] + bfhi(p.y);
                    const float r4 = sigm(bflo(g.z)) * v1[0] + bflo(p.z), r5 = sigm(bfhi(g.z)) * v1[1] + bfhi(p.z), r6 = sigm(bflo(g.w)) * v1[2] + bflo(p.w), r7 = sigm(bfhi(g.w)) * v1[3] + bfhi(p.w);
                    u32x4 w; w.x = cvt_pk_bf16(r0, r1); w.y = cvt_pk_bf16(r2, r3); w.z = cvt_pk_bf16(r4, r5); w.w = cvt_pk_bf16(r6, r7);
                    *(u32x4*)(rowp + bj * HALF) = w; } } }
    }
};
struct MergeOrder { StaticOrder S; int nu;
    __device__ __forceinline__ void init(int G, int c) { S.init(32768, 1024, G, c); nu = (512 - c + G - 1) / G; }
    __device__ __forceinline__ bool next(int i, Unit& u) const { if (i >= 2 * nu) return false; Unit t; S.next(i < nu ? i : i - nu, t);
        if (i < nu) { u.pm = 128 + t.pm; u.pn = t.pn; } else { u.pm = t.pm; u.pn = 4 + t.pn; } return true; }
    __device__ __forceinline__ void a_ready(const Unit&) const {}
    __device__ __forceinline__ void done(const Unit&) const {}
};
struct EpiRes { static constexpr bool PERM = true, AFTER_DRAIN = false; const float* X; const float* mod; bf16_t* O;
    __device__ __forceinline__ void operator()(const f32x4 (&acc)[2][2][4][2], const Unit& u, int wr, int wc, int fr, int fq) const {
        const int row0 = u.pm * BM + wr * 64 + fr, col0 = u.pn * BM + wc * 32 + 8 * fq; const int b = (u.pm * BM) >> 11;
        f32x4 gt[2][2];
#pragma unroll
        for (int bj = 0; bj < 2; ++bj)
#pragma unroll
            for (int n = 0; n < 2; ++n) gt[bj][n] = *(const f32x4*)(mod + (size_t)b * 6144 + 2048 + col0 + bj * HALF + n * 4);
#pragma unroll
        for (int ai = 0; ai < 2; ++ai) { f32x4 xv[4][2][2];
#pragma unroll
            for (int m = 0; m < 4; ++m) { const size_t off = (size_t)(row0 + ai * HALF + m * 16) * 1024 + col0;
#pragma unroll
                for (int bj = 0; bj < 2; ++bj) { xv[m][bj][0] = *(const f32x4*)(X + off + bj * HALF); xv[m][bj][1] = *(const f32x4*)(X + off + bj * HALF + 4); } }
#pragma unroll
            for (int m = 0; m < 4; ++m) { const size_t off = (size_t)(row0 + ai * HALF + m * 16) * 1024 + col0;
#pragma unroll
                for (int bj = 0; bj < 2; ++bj) { const f32x4 v0 = xv[m][bj][0] + gt[bj][0] * acc[ai][bj][m][0], v1 = xv[m][bj][1] + gt[bj][1] * acc[ai][bj][m][1];
                    u32x4 w; w.x = cvt_pk_bf16(v0[0], v0[1]); w.y = cvt_pk_bf16(v0[2], v0[3]); w.z = cvt_pk_bf16(v1[0], v1[1]); w.w = cvt_pk_bf16(v1[2], v1[3]);
                    *(u32x4*)(O + off + bj * HALF) = w; } } }
    }
};
template <int NPL> struct GroupOrder { int G, c;
    __device__ __forceinline__ bool next(int i, Unit& u) const { const int L = i * G + c; if (L >= 256 * NPL) return false;
        if (G == 256) {
            const int q = i * 32 + (c >> 3), e = (c & 7) * 2 + q / (16 * NPL), r = q % (16 * NPL), rho = r >> 5, j = r & 31;
            u.pm = e * 16 + (rho & 1) * 8 + (j & 7); u.pn = e * NPL + (rho >> 1) * 4 + (j >> 3); return true; }
        const int e = L / (16 * NPL), r = L % (16 * NPL); u.pm = e * 16 + (r % 16); u.pn = e * NPL + r / 16; return true; }
    __device__ __forceinline__ void a_ready(const Unit&) const {}
    __device__ __forceinline__ void done(const Unit&) const {}
};
struct EpiSwiglu { static constexpr bool PERM = true, AFTER_DRAIN = false; bf16_t* O;
    __device__ __forceinline__ void operator()(const f32x4 (&acc)[2][2][4][2], const Unit& u, int wr, int wc, int fr, int fq) const {
        const int row0 = u.pm * BM + wr * 64 + fr, col0 = (u.pn & 7) * 128 + wc * 32 + 8 * fq;
#pragma unroll
        for (int ai = 0; ai < 2; ++ai)
#pragma unroll
            for (int m = 0; m < 4; ++m) { bf16_t* rowp = O + (size_t)(row0 + ai * HALF + m * 16) * 1024 + col0;
                float r[8];
#pragma unroll
                for (int n = 0; n < 2; ++n)
#pragma unroll
                    for (int i = 0; i < 4; ++i) { const float g = acc[ai][0][m][n][i], up = acc[ai][1][m][n][i]; r[n * 4 + i] = g * sigm(g) * up; }
                u32x4 w; w.x = cvt_pk_bf16(r[0], r[1]); w.y = cvt_pk_bf16(r[2], r[3]); w.z = cvt_pk_bf16(r[4], r[5]); w.w = cvt_pk_bf16(r[6], r[7]);
                *(u32x4*)rowp = w; }
    }
};
struct EpiDown { static constexpr bool PERM = true, AFTER_DRAIN = false; bf16_t* O; const float* aff;
    __device__ __forceinline__ void operator()(const f32x4 (&acc)[2][2][4][2], const Unit& u, int wr, int wc, int fr, int fq) const {
        const int row0 = u.pm * BM + wr * 64 + fr, col0 = (u.pn & 3) * BM + wc * 32 + 8 * fq;
        float av[2][4];
#pragma unroll
        for (int ai = 0; ai < 2; ++ai)
#pragma unroll
            for (int m = 0; m < 4; ++m) av[ai][m] = aff[row0 + ai * HALF + m * 16];
#pragma unroll
        for (int ai = 0; ai < 2; ++ai)
#pragma unroll
            for (int m = 0; m < 4; ++m) { const int row = row0 + ai * HALF + m * 16; const float a = av[ai][m]; bf16_t* rowp = O + (size_t)row * 1024 + col0;
#pragma unroll
                for (int bj = 0; bj < 2; ++bj) { const f32x4 v0 = acc[ai][bj][m][0] * a, v1 = acc[ai][bj][m][1] * a;
                    u32x4 w; w.x = cvt_pk_bf16(v0[0], v0[1]); w.y = cvt_pk_bf16(v0[2], v0[3]); w.z = cvt_pk_bf16(v1[0], v1[1]); w.w = cvt_pk_bf16(v1[2], v1[3]);
                    *(u32x4*)(rowp + bj * HALF) = w; } }
    }
};
}

struct Frame { LAS unsigned char* lds; volatile LAS unsigned* MISC; gu32* ctl; int tid, lane, wave, vcu, G; };
struct Args { const void* in[30]; float* out; unsigned char* ws; int ph_lo, ph_hi; };
typedef const __attribute__((address_space(4))) Args* ArgsP;
#define LAUNDER(p) asm volatile("" : "+s"(p))
typedef float f32x16 __attribute__((ext_vector_type(16)));
typedef unsigned u32x2 __attribute__((ext_vector_type(2)));

__device__ __forceinline__ float wave_sum(float v) {
#pragma unroll
    for (int o = 1; o < 64; o <<= 1) v += __shfl_xor(v, o);
    return v;
}
__device__ __forceinline__ float bf2f(bf16 h) { return __uint_as_float(((unsigned)h) << 16); }
__device__ __forceinline__ float bflo(unsigned w) { return __uint_as_float(w << 16); }
__device__ __forceinline__ float bfhi(unsigned w) { return __uint_as_float(w & 0xffff0000u); }
__device__ __forceinline__ float sigm(float x) { return 1.0f / (1.0f + __expf(-x)); }

__device__ __forceinline__ void tr_item(const float* W, int N, int k0, int n0, bf16* WT, int KD, int dst_row0, LAS float* scr, int lane) {
    f32x4 v[8];
#pragma unroll
    for (int i = 0; i < 8; ++i) v[i] = *(const GAS f32x4*)(W + (size_t)(k0 + 8 * i + (lane >> 3)) * N + n0 + 4 * (lane & 7));
#pragma unroll
    for (int i = 0; i < 8; ++i) { LAS float* d = scr + (8 * i + (lane >> 3)) * 33 + 4 * (lane & 7); d[0] = v[i].x; d[1] = v[i].y; d[2] = v[i].z; d[3] = v[i].w; }
    LDS_WAIT(); asm volatile("" ::: "memory");
    const int c = lane & 7;
#pragma unroll
    for (int j = 0; j < 4; ++j) { const int n = (lane >> 3) + 8 * j; const LAS float* s = scr + (8 * c) * 33 + n;
        v4u o; o.x = pk2(s[0 * 33], s[1 * 33]); o.y = pk2(s[2 * 33], s[3 * 33]); o.z = pk2(s[4 * 33], s[5 * 33]); o.w = pk2(s[6 * 33], s[7 * 33]);
        *(GAS v4u*)(WT + (size_t)(dst_row0 + n) * KD + k0 + 8 * c) = o; }
    LDS_WAIT(); asm volatile("" ::: "memory");
}

__device__ __forceinline__ void p0_prologue(const Frame& F, ArgsP A) {
    unsigned char* ws = A->ws;
    LAS float* scr = (LAS float*)(F.lds + F.wave * 16384);
    const int gw = F.vcu * NWAVES + F.wave, NGW = F.G * NWAVES;
    const float* w_in = (const float*)A->in[6]; const float* p_rwkv = (const float*)A->in[22]; const float* p_attn = (const float*)A->in[23];
    const float* w_out = (const float*)A->in[24]; const float* g2 = (const float*)A->in[13];
    bf16* WinT = (bf16*)(ws + WS_WINT); bf16* PrT = (bf16*)(ws + WS_PRT); bf16* PaT = (bf16*)(ws + WS_PAT); bf16* WoT = (bf16*)(ws + WS_WOT); bf16* G2T = (bf16*)(ws + WS_G2T);
    constexpr int I_IN = 16 * 148, I_P = 8 * 32, I_O = 16 * 32, I_G = 2 * 16, NIT = I_IN + 2 * I_P + I_O + I_G;
    for (int it = gw; it < NIT; it += NGW) {
        int r = it;
        if (r < I_IN) { tr_item(w_in, NZ, 64 * (r / 148), 32 * (r % 148), WinT, 1024, 32 * (r % 148), scr, F.lane); continue; } r -= I_IN;
        if (r < I_P) { tr_item(p_rwkv, 1024, 64 * (r / 32), 32 * (r % 32), PrT, 512, 32 * (r % 32), scr, F.lane); continue; } r -= I_P;
        if (r < I_P) { tr_item(p_attn, 1024, 64 * (r / 32), 32 * (r % 32), PaT, 512, 32 * (r % 32), scr, F.lane); continue; } r -= I_P;
        if (r < I_O) { tr_item(w_out, 1024, 64 * (r / 32), 32 * (r % 32), WoT, 1024, 32 * (r % 32), scr, F.lane); continue; } r -= I_O;
        tr_item(g2, 512, 64 * (r / 16), 32 * (r % 16), G2T, 256, 32 * (r % 16), scr, F.lane);
    }
    { const int gt = (F.vcu * NWAVES + F.wave) * 64 + F.lane, NT = F.G * NWAVES * 64; const v4u z4 = {0u, 0u, 0u, 0u};
      for (int i = gt; i < 128 * 128; i += NT) *(GAS v4u*)(WinT + (size_t)4736 * 1024 + (size_t)i * 8) = z4;
      for (int i = gt; i < 512 * 16; i += NT) *(GAS v4u*)(G2T + (size_t)(i >> 4) * 256 + 128 + (i & 15) * 8) = z4; }
    __syncthreads();
    const float* cvec = (const float*)A->in[1]; const float* w_ada = (const float*)A->in[3]; const float* b_ada = (const float*)A->in[4];
    float* mod = (float*)(ws + WS_MOD);
    for (int task = F.vcu; task < 192; task += F.G) { const int cg = task % 96, dh = task / 96;
        LAS float* ca = (LAS float*)F.lds;
        LAS float* red = (LAS float*)(F.lds + 65536);
        for (int i = F.tid; i < 16 * 1024; i += 512) { const int b = i >> 10, d = i & 1023; const float cv = cvec[i]; ca[d * 16 + b] = cv / (1.0f + __expf(-cv)); }
        __syncthreads();
        float acc[16];
#pragma unroll
        for (int b = 0; b < 16; ++b) acc[b] = 0.f;
        const int col = cg * 64 + F.lane;
#pragma unroll 8
        for (int dd = 0; dd < 64; ++dd) { const int d = dh * 512 + F.wave * 64 + dd; const float w = w_ada[(size_t)d * 6144 + col];
            const LAS f32x4* cp = (const LAS f32x4*)(ca + d * 16);
#pragma unroll
            for (int q = 0; q < 4; ++q) { const f32x4 cv = cp[q]; acc[q * 4 + 0] += cv[0] * w; acc[q * 4 + 1] += cv[1] * w; acc[q * 4 + 2] += cv[2] * w; acc[q * 4 + 3] += cv[3] * w; } }
#pragma unroll
        for (int b = 0; b < 16; ++b) red[(F.wave * 16 + b) * 64 + F.lane] = acc[b];
        __syncthreads();
        for (int o = F.tid; o < 1024; o += 512) { const int b = o >> 6, cl = o & 63; float sacc = 0.f;
#pragma unroll
            for (int w = 0; w < 8; ++w) sacc += red[(w * 16 + b) * 64 + cl];
            atomicAdd(&mod[b * 6144 + cg * 64 + cl], sacc + (dh == 0 ? b_ada[cg * 64 + cl] : 0.f)); }
        __syncthreads();
    }
}


__device__ __forceinline__ float dpp_wave_sum(float v) {
    v += __int_as_float(__builtin_amdgcn_update_dpp(0, __float_as_int(v), 0xB1, 0xf, 0xf, false));
    v += __int_as_float(__builtin_amdgcn_update_dpp(0, __float_as_int(v), 0x4E, 0xf, 0xf, false));
    v += __int_as_float(__builtin_amdgcn_update_dpp(0, __float_as_int(v), 0x141, 0xf, 0xf, false));
    v += __int_as_float(__builtin_amdgcn_update_dpp(0, __float_as_int(v), 0x140, 0xf, 0xf, false));
    v += __int_as_float(__builtin_amdgcn_ds_swizzle(__float_as_int(v), 0x401F));
    auto r_ = __builtin_amdgcn_permlane32_swap(__float_as_uint(v), __float_as_uint(v), false, false);
    return __uint_as_float(r_[0]) + __uint_as_float(r_[1]); }

template <int R, bool XBF> __device__ __forceinline__ void modnorm_rows(const void* x, int m0, int mstride, const float* g, const float* mod, int sh_off, int sc_off, bf16* out, int lane, f32x4 (&u)[R][4]) {
    f32x4 v[R][4];
#pragma unroll
    for (int i = 0; i < R; ++i) {
        if (XBF) { const GAS u32x2* xr = (const GAS u32x2*)((const bf16*)x + (size_t)(m0 + i * mstride) * 1024) + lane;
#pragma unroll
            for (int j = 0; j < 4; ++j) { const u32x2 w = xr[64 * j]; v[i][j] = (f32x4){bflo(w.x), bfhi(w.x), bflo(w.y), bfhi(w.y)}; } }
        else { const GAS f32x4* xr = (const GAS f32x4*)((const float*)x + (size_t)(m0 + i * mstride) * 1024) + lane;
#pragma unroll
            for (int j = 0; j < 4; ++j) v[i][j] = xr[64 * j]; } }
    f32x4 gg[4];
#pragma unroll
    for (int j = 0; j < 4; ++j) gg[j] = ((const GAS f32x4*)g)[lane + 64 * j];
#pragma unroll
    for (int i = 0; i < R; ++i) { const int m = m0 + i * mstride, b = m >> 11; float s = 0.f;
#pragma unroll
        for (int j = 0; j < 4; ++j) s += (v[i][j].x * v[i][j].x + v[i][j].y * v[i][j].y) + (v[i][j].z * v[i][j].z + v[i][j].w * v[i][j].w);
        const float rs = rsqrtf(dpp_wave_sum(s) * (1.0f / 1024.0f) + 1e-6f);
        const float* sh = mod + (size_t)b * 6144 + sh_off; const float* sc = mod + (size_t)b * 6144 + sc_off;
        GAS unsigned long long* o8 = (GAS unsigned long long*)(out + (size_t)m * 1024) + lane;
#pragma unroll
        for (int j = 0; j < 4; ++j) { const f32x4 s1 = ((const GAS f32x4*)sc)[lane + 64 * j], s0 = ((const GAS f32x4*)sh)[lane + 64 * j];
            f32x4 y = (v[i][j] * rs) * gg[j]; y = y * (s1 + 1.0f) + s0; u[i][j] = y;
            o8[64 * j] = (unsigned long long)pk2(y.x, y.y) | ((unsigned long long)pk2(y.z, y.w) << 32); } }
}

template <int R> __device__ __forceinline__ void load_rows_bf16(const bf16* x, int m0, int mstride, int lane_in, u32x2 (&raw)[R][4]) {
    int lane = lane_in; asm volatile("" : "+v"(lane));
#pragma unroll
    for (int i = 0; i < R; ++i) { const GAS u32x2* xr = (const GAS u32x2*)(x + (size_t)(m0 + i * mstride) * 1024) + lane;
#pragma unroll
        for (int j = 0; j < 4; ++j) raw[i][j] = xr[64 * j]; }
}
template <int R> __device__ __forceinline__ void modnorm_rows_pre(const u32x2 (&raw)[R][4], int m0, int mstride, const float* g, const float* mod, int sh_off, int sc_off, bf16* out, int lane, f32x4 (&u)[R][4]) {
    f32x4 gg[4];
#pragma unroll
    for (int j = 0; j < 4; ++j) gg[j] = ((const GAS f32x4*)g)[lane + 64 * j];
#pragma unroll
    for (int i = 0; i < R; ++i) { const int m = m0 + i * mstride, b = m >> 11; float s = 0.f; f32x4 v[4];
#pragma unroll
        for (int j = 0; j < 4; ++j) { const u32x2 w = raw[i][j]; v[j] = (f32x4){bflo(w.x), bfhi(w.x), bflo(w.y), bfhi(w.y)}; s += (v[j].x * v[j].x + v[j].y * v[j].y) + (v[j].z * v[j].z + v[j].w * v[j].w); }
        const float rs = rsqrtf(dpp_wave_sum(s) * (1.0f / 1024.0f) + 1e-6f);
        const float* sh = mod + (size_t)b * 6144 + sh_off; const float* sc = mod + (size_t)b * 6144 + sc_off;
        GAS unsigned long long* o8 = (GAS unsigned long long*)(out + (size_t)m * 1024) + lane;
#pragma unroll
        for (int j = 0; j < 4; ++j) { const f32x4 s1 = ((const GAS f32x4*)sc)[lane + 64 * j], s0 = ((const GAS f32x4*)sh)[lane + 64 * j];
            f32x4 y = (v[j] * rs) * gg[j]; y = y * (s1 + 1.0f) + s0; u[i][j] = y;
            o8[64 * j] = (unsigned long long)pk2(y.x, y.y) | ((unsigned long long)pk2(y.z, y.w) << 32); } }
}

__device__ __forceinline__ void modnorm_row(const float* xrow, const float* g, const float* sh, const float* sc, bf16* orow, int lane, f32x4 (&u)[4]) {
    const GAS f32x4* xr = (const GAS f32x4*)xrow + lane;
    f32x4 v[4]; float s = 0.f;
#pragma unroll
    for (int j = 0; j < 4; ++j) { v[j] = xr[64 * j]; s += (v[j].x * v[j].x + v[j].y * v[j].y) + (v[j].z * v[j].z + v[j].w * v[j].w); }
    const float rs = rsqrtf(wave_sum(s) * (1.0f / 1024.0f) + 1e-6f);
    GAS unsigned long long* o8 = (GAS unsigned long long*)orow + lane;
#pragma unroll
    for (int j = 0; j < 4; ++j) { const f32x4 gg = ((const GAS f32x4*)g)[lane + 64 * j], s1 = ((const GAS f32x4*)sc)[lane + 64 * j], s0 = ((const GAS f32x4*)sh)[lane + 64 * j];
        f32x4 y = (v[j] * rs) * gg; y = y * (s1 + 1.0f) + s0; u[j] = y;
        o8[64 * j] = (unsigned long long)pk2(y.x, y.y) | ((unsigned long long)pk2(y.z, y.w) << 32); }
}

__device__ __forceinline__ float softplusf(float x) { return x > 20.f ? x : log1pf(__expf(x)); }
__device__ __forceinline__ void scan_chain(const Frame& F, ArgsP A, int b, int h, int dir) {
    constexpr int CT = 32;
    LAS float* L = (LAS float*)F.lds;
    LAS float* W2S = L; LAS float* A2S = L + 4096; LAS float* ZRs = L + 8192; LAS float* ZKs = ZRs + 2048; LAS float* ZVs = ZKs + 2048; LAS float* TWs = ZVs + 2048; LAS float* ZAs = TWs + 2048;
    LAS float* DEC = ZAs + 2048; LAS float* KD = DEC + 2048; LAS float* AV = KD + 2048; LAS float* BV = AV + 2048; LAS float* YB = BV + 2048; LAS float* BON = YB + 2048;
    const bf16* Z = (const bf16*)(A->ws + WS_Z);
    const float* mu_prev = (const float*)A->in[7]; const float* mu_next = (const float*)A->in[8];
    const float* w0 = (const float*)A->in[9]; const float* w2 = (const float*)A->in[10]; const float* a0 = (const float*)A->in[11]; const float* a2 = (const float*)A->in[12];
    const float* k_k = (const float*)A->in[14]; const float* k_a = (const float*)A->in[15]; const float* r_k = (const float*)A->in[16];
    bf16* ydir = (bf16*)(A->ws + WS_XN) + (size_t)dir * M * 512; float* bonus = (float*)(A->ws + WS_BONUS) + (size_t)dir * M * 8;
    const int tid = F.tid, lane = F.lane, wave = F.wave;
    for (int i = tid; i < 4096; i += 512) { const int l = i >> 6, j = i & 63; W2S[i] = w2[((size_t)dir * 64 + l) * 512 + h * 64 + j]; A2S[i] = a2[((size_t)dir * 64 + l) * 512 + h * 64 + j]; }
    const int ch = h * 64 + lane;
    const float w0j = w0[dir * 512 + ch], a0j = a0[dir * 512 + ch], kkj = k_k[ch], kaj = k_a[ch], rkj = r_k[ch];
    float s[8];
#pragma unroll
    for (int q = 0; q < 8; ++q) s[q] = 0.f;
    const int ri = tid >> 3, jg = tid & 7;
    for (int ci = 0; ci < T / CT; ++ci) {
        const int t0 = (dir ? (T / CT - 1 - ci) : ci) * CT;
#pragma unroll 4
        for (int i = 0; i < 20; ++i) { const int e = tid + 512 * i, arr = e >> 11, rem = e & 2047, tl = rem >> 6, j = rem & 63;
            const int col = (arr == 0 ? ZR + h * 64 : arr == 1 ? ZK + h * 64 : arr == 2 ? ZV + h * 64 : arr == 3 ? ZWD + dir * 64 : ZAD + dir * 64) + j;
            const int t = t0 + tl; const bf16* zp = Z + ((size_t)b * T + t) * NZ + col;
            const float z0 = bf2f(zp[0]), zm = t > 0 ? bf2f(zp[-NZ]) : 0.f, zq = t < T - 1 ? bf2f(zp[NZ]) : 0.f;
            float zs = z0 + mu_prev[col] * (zm - z0) + mu_next[col] * (zq - z0);
            if (arr == 3) zs = tanhf(zs);
            ZRs[arr * 2048 + rem] = zs; }
        __syncthreads();
#pragma unroll 1
        for (int q = 0; q < 4; ++q) { const int tl = wave + 8 * q;
            float wraw = w0j, araw = a0j;
#pragma unroll 8
            for (int l = 0; l < 64; ++l) { wraw += TWs[tl * 64 + l] * W2S[l * 64 + lane]; araw += ZAs[tl * 64 + l] * A2S[l * 64 + lane]; }
            const float w = -softplusf(-wraw) - 0.5f, dec = __expf(-__expf(w)), ad = sigm(araw);
            const float k = ZKs[tl * 64 + lane], kkr = k * kkj, nrm = sqrtf(wave_sum(kkr * kkr)), kk = kkr / fmaxf(nrm, 1e-12f);
            const float kd = k * (1.0f + (ad - 1.0f) * kaj);
            DEC[tl * 64 + lane] = dec; KD[tl * 64 + lane] = kd; AV[tl * 64 + lane] = -kk; BV[tl * 64 + lane] = kk * ad;
            const float bon = wave_sum(ZRs[tl * 64 + lane] * kd * rkj); if (lane == 0) BON[tl] = bon; }
        __syncthreads();
#pragma unroll 1
        for (int st = 0; st < CT; ++st) { const int tl = dir ? (CT - 1 - st) : st; const int o = tl * 64 + jg * 8;
            const f32x4 a0v = *(const LAS f32x4*)(AV + o), a1v = *(const LAS f32x4*)(AV + o + 4), d0 = *(const LAS f32x4*)(DEC + o), d1 = *(const LAS f32x4*)(DEC + o + 4);
            const f32x4 b0 = *(const LAS f32x4*)(BV + o), b1 = *(const LAS f32x4*)(BV + o + 4), k0 = *(const LAS f32x4*)(KD + o), k1 = *(const LAS f32x4*)(KD + o + 4);
            const f32x4 r0 = *(const LAS f32x4*)(ZRs + o), r1 = *(const LAS f32x4*)(ZRs + o + 4); const float vi = ZVs[tl * 64 + ri];
            float p = (s[0] * a0v[0] + s[1] * a0v[1]) + (s[2] * a0v[2] + s[3] * a0v[3]) + (s[4] * a1v[0] + s[5] * a1v[1]) + (s[6] * a1v[2] + s[7] * a1v[3]);
            p += __shfl_xor(p, 1); p += __shfl_xor(p, 2); p += __shfl_xor(p, 4);
            s[0] = s[0] * d0[0] + p * b0[0] + vi * k0[0]; s[1] = s[1] * d0[1] + p * b0[1] + vi * k0[1]; s[2] = s[2] * d0[2] + p * b0[2] + vi * k0[2]; s[3] = s[3] * d0[3] + p * b0[3] + vi * k0[3];
            s[4] = s[4] * d1[0] + p * b1[0] + vi * k1[0]; s[5] = s[5] * d1[1] + p * b1[1] + vi * k1[1]; s[6] = s[6] * d1[2] + p * b1[2] + vi * k1[2]; s[7] = s[7] * d1[3] + p * b1[3] + vi * k1[3];
            float y = (s[0] * r0[0] + s[1] * r0[1]) + (s[2] * r0[2] + s[3] * r0[3]) + (s[4] * r1[0] + s[5] * r1[1]) + (s[6] * r1[2] + s[7] * r1[3]);
            y += __shfl_xor(y, 1); y += __shfl_xor(y, 2); y += __shfl_xor(y, 4);
            if (jg == 0) YB[tl * 64 + ri] = y; }
        __syncthreads();
#pragma unroll
        for (int i = 0; i < 4; ++i) { const int e = tid + 512 * i, tl = e >> 6, c = e & 63; ydir[((size_t)b * T + t0 + tl) * 512 + h * 64 + c] = (bf16)f2bf(YB[e]); }
        if (tid < CT) bonus[((size_t)b * T + t0 + tid) * 8 + h] = BON[tid];
        __syncthreads();
    }
}


#define SDEV __device__ __forceinline__
#define S_UNROLL _Pragma("unroll")
#define S_MEMBAR() do { asm volatile("" ::: "memory"); __builtin_amdgcn_sched_barrier(0); } while (0)
#define S_LAUNDER_I(x) asm volatile("" : "+v"(x))
#define S_LAUNDER_S(x) asm volatile("" : "+s"(x))
#define S_PIN(x) asm volatile("" : "+v"(x))
typedef float f32x2s __attribute__((ext_vector_type(2))); typedef __bf16 bf16x2s __attribute__((ext_vector_type(2)));
__device__ __forceinline__ unsigned s_cvtpk(float lo, float hi) { f32x2s v = {lo, hi}; bf16x2s b = __builtin_convertvector(v, bf16x2s); return __builtin_bit_cast(unsigned, b); }
__device__ __forceinline__ float s_rowsum16(float v) {
    v += __int_as_float(__builtin_amdgcn_update_dpp(0, __float_as_int(v), 0xB1, 0xf, 0xf, false));
    v += __int_as_float(__builtin_amdgcn_update_dpp(0, __float_as_int(v), 0x4E, 0xf, 0xf, false));
    v += __int_as_float(__builtin_amdgcn_update_dpp(0, __float_as_int(v), 0x141, 0xf, 0xf, false));
    v += __int_as_float(__builtin_amdgcn_update_dpp(0, __float_as_int(v), 0x140, 0xf, 0xf, false));
    return v; }
#define S_MFMA(a, b, c) __builtin_amdgcn_mfma_f32_32x32x16_bf16(a, b, c, 0, 0, 0)
#define S_PK(lo, hi) s_cvtpk(lo, hi)
#define S_SWAP(x, y) do { auto r_ = __builtin_amdgcn_permlane32_swap(x, y, false, false); x = r_[0]; y = r_[1]; } while (0)
#define S_ROWSUM16(v) s_rowsum16(v)
__device__ __forceinline__ float s_wavesum(float v) { v = s_rowsum16(v);
    v += __int_as_float(__builtin_amdgcn_ds_swizzle(__float_as_int(v), 0x401F));
    auto r_ = __builtin_amdgcn_permlane32_swap(__float_as_uint(v), __float_as_uint(v), false, false);
    return __uint_as_float(r_[0]) + __uint_as_float(r_[1]); }
#define S_WAVESUM(v) s_wavesum(v)
#define S_SWAP16(x, y) do { auto r_ = __builtin_amdgcn_permlane16_swap(x, y, false, false); x = r_[0]; y = r_[1]; } while (0)
#define S_DPPF(v, ctrl) __int_as_float(__builtin_amdgcn_update_dpp(0, __float_as_int(v), ctrl, 0xf, 0xf, false))
__device__ __forceinline__ float s_treesum32(float (&q)[32], int lane) {
    _Pragma("unroll") for (int i = 0; i < 16; ++i) { unsigned x = __float_as_uint(q[i]), y = __float_as_uint(q[i + 16]); S_SWAP(x, y); q[i] = __uint_as_float(x) + __uint_as_float(y); }
    _Pragma("unroll") for (int i = 0; i < 8; ++i) { unsigned x = __float_as_uint(q[i]), y = __float_as_uint(q[i + 8]); S_SWAP16(x, y); q[i] = __uint_as_float(x) + __uint_as_float(y); }
    const bool b3 = (lane & 8) != 0, b2 = (lane & 4) != 0, b1 = (lane & 2) != 0;
    _Pragma("unroll") for (int i = 0; i < 4; ++i) { const float a = q[i], b = q[i + 4]; const float c = b3 ? b : a, d = b3 ? a : b; q[i] = c + S_DPPF(d, 0x140); }
    _Pragma("unroll") for (int i = 0; i < 2; ++i) { const float a = q[i], b = q[i + 2]; const float c = b2 ? b : a, d = b2 ? a : b; q[i] = c + S_DPPF(d, 0x141); }
    { const float a = q[0], b = q[1]; const float c = b1 ? b : a, d = b1 ? a : b; q[0] = c + S_DPPF(d, 0x1B); }
    return q[0] + S_DPPF(q[0], 0xB1); }
#define S_GAS GAS
#define S_READLANE(v, l) __int_as_float(__builtin_amdgcn_readlane(__float_as_int(v), l))
#define S_RCP(x) __builtin_amdgcn_rcpf(x)
#define S_EXP2(x) __builtin_amdgcn_exp2f(x)
#define S_LOG2(x) __builtin_amdgcn_logf(x)
#define S_RSQ(x) __builtin_amdgcn_rsqf(x)
#define S_LDS_WAIT() asm volatile("s_waitcnt lgkmcnt(0)" ::: "memory")
#define S_LDSP LAS unsigned char*
#define S_LDS_BF16P LAS bf16*
#define S_LDS_U32P LAS unsigned*
#define S_LDS_F32P LAS float*
#define S_LDS_CONST_BF16X8P const LAS bf16x8*
#define S_LDS_BF16X8P LAS bf16x8*
#define S_LDS_CONST_F32X4P const LAS f32x4*
#define S_LDS_CONST_F32P const LAS float*
#define S_FLAG_STORE(p, v) do { *(volatile LAS unsigned*)(p) = (v); } while (0)
#define S_FLAG_WAIT(p, v) do { unsigned sp_ = 0; while (*(volatile LAS unsigned*)(p) != (v)) { __builtin_amdgcn_s_sleep(2); if (++sp_ > (1u << 24)) break; } asm volatile("" ::: "memory"); } while (0)
struct SFrag { bf16x8 s[2]; };
struct SMat { SFrag t[2]; };
SDEV f32x16 smm(const SFrag& X, const SFrag& Y, f32x16 acc) { acc = S_MFMA(X.s[0], Y.s[0], acc); acc = S_MFMA(X.s[1], Y.s[1], acc); return acc; }
SDEV f32x16 szero() { f32x16 z; S_UNROLL for (int i = 0; i < 16; ++i) z[i] = 0.f; return z; }
SDEV SFrag spack(const f32x16& d) { SFrag f;
    S_UNROLL for (int s = 0; s < 2; ++s) { v4u w; S_UNROLL for (int q = 0; q < 4; ++q) w[q] = S_PK(d[8 * s + 2 * q], d[8 * s + 2 * q + 1]); f.s[s] = __builtin_bit_cast(bf16x8, w); }
    return f; }
SDEV f32x16 sunpack(const SFrag& f) { f32x16 d;
    S_UNROLL for (int s = 0; s < 2; ++s) { const v4u w = __builtin_bit_cast(v4u, f.s[s]); S_UNROLL for (int q = 0; q < 4; ++q) { d[8 * s + 2 * q] = __uint_as_float(w[q] << 16); d[8 * s + 2 * q + 1] = __uint_as_float(w[q] & 0xffff0000u); } }
    return d; }
SDEV SMat splain2d(const unsigned (&pp)[16]) { unsigned d0[8], d1[8];
    S_UNROLL for (int g = 0; g < 4; ++g) S_UNROLL for (int p = 0; p < 2; ++p) { unsigned x = pp[4 * g + p], y = pp[4 * g + 2 + p]; S_SWAP(x, y); d0[2 * g + p] = x; d1[2 * g + p] = y; }
    SMat m;
    S_UNROLL for (int s = 0; s < 2; ++s) { v4u a, b; S_UNROLL for (int q = 0; q < 4; ++q) { a[q] = d0[4 * s + q]; b[q] = d1[4 * s + q]; } m.t[0].s[s] = __builtin_bit_cast(bf16x8, a); m.t[1].s[s] = __builtin_bit_cast(bf16x8, b); }
    return m; }
SDEV void sd2plain(const f32x16& D0, const f32x16& D1, float (&x)[32]) {
    S_UNROLL for (int r = 0; r < 16; ++r) { unsigned a = __float_as_uint(D0[r]), b = __float_as_uint(D1[r]); S_SWAP(a, b); const int ta = (r & 3) + 8 * (r >> 2); x[ta] = __uint_as_float(a); x[ta + 4] = __uint_as_float(b); } }
SDEV SFrag sident(int n_in, int hh_in) { int n1 = n_in, r1 = 4 * hh_in; S_LAUNDER_I(n1); S_LAUNDER_I(r1); f32x16 id; S_UNROLL for (int g = 0; g < 16; ++g) id[g] = (((g & 3) + 8 * (g >> 2) + r1) == n1) ? 1.f : 0.f; return spack(id); }
SDEV void sd2plain_pk(const f32x16& D0, const f32x16& D1, unsigned (&xp)[16]) {
    S_UNROLL for (int m = 0; m < 8; ++m) { unsigned a = S_PK(D0[2 * m], D0[2 * m + 1]), b = S_PK(D1[2 * m], D1[2 * m + 1]); S_SWAP(a, b); const int qa = 4 * (m >> 1) + (m & 1); xp[qa] = a; xp[qa + 2] = b; } }
SDEV float swave_sum(float v) { return S_WAVESUM(v); }

struct ScanArgs { const S_GAS bf16* Z; const S_GAS float* mu_prev; const S_GAS float* mu_next; const S_GAS float* w0; const S_GAS float* a0; const S_GAS float* k_k; const S_GAS float* k_a; const S_GAS float* r_k; S_GAS bf16* ydir; S_GAS float* bonus; };

#define SC_W2F 0
#define SC_A2F 8192
#define SC_SIG 16384
#define SC_GTAB 24576
#define SC_FLAG 26624
#define SC_WR 28672
#define SC_AR 94208
#define SC_RSQ 126976
#define SC_LDS_BYTES 128000
#ifndef SB_ILP
#define SB_ILP 8
#endif
#define SC_PF 4

SDEV void scan2_setup(S_LDSP lds, const S_GAS float* w2, const S_GAS float* a2, int h, int dir, int tid) {
    { float wv[16];
      S_UNROLL for (int it = 0; it < 16; ++it) { const int e = tid + 512 * it; const int mat = e >> 12, r = e & 4095, jj = r & 7, ln = (r >> 3) & 63, s = (r >> 9) & 1, jt = (r >> 10) & 1, lt = (r >> 11) & 1;
          const int n = ln & 31, hh = ln >> 5, g = 8 * s + jj, l = 32 * lt + (g & 3) + 8 * (g >> 2) + 4 * hh, j = 32 * jt + n;
          wv[it] = (mat ? a2 : w2)[((size_t)dir * 64 + l) * 512 + h * 64 + j]; }
      S_UNROLL for (int it = 0; it < 16; ++it) { const int e = tid + 512 * it; const int mat = e >> 12, r = e & 4095;
          ((S_LDS_BF16P)(lds + (mat ? SC_A2F : SC_W2F)))[r] = (bf16)(S_PK(wv[it] * -1.442695041f, 0.f) & 0xffffu); } }
    for (int e = tid; e < 2048; e += 512) ((S_LDS_U32P)(lds + SC_SIG))[e] = 0u;
    if (tid == 0) S_FLAG_STORE(lds + SC_FLAG, 0u);
}

SDEV void scan2_chunk(S_LDSP lds, const ScanArgs& A_in, int b_in, int h_in, int dir_in, int c, int lane_in, int wave) {
    ScanArgs A = A_in; int b = b_in, h = h_in, dir = dir_in;
    S_LAUNDER_S(A.Z); S_LAUNDER_S(A.mu_prev); S_LAUNDER_S(A.mu_next); S_LAUNDER_S(A.w0); S_LAUNDER_S(A.a0); S_LAUNDER_S(A.k_k); S_LAUNDER_S(A.k_a); S_LAUNDER_S(A.r_k); S_LAUNDER_S(A.ydir); S_LAUNDER_S(A.bonus);
    S_LAUNDER_S(b); S_LAUNDER_S(h); S_LAUNDER_S(dir);
    int lane = lane_in; S_LAUNDER_I(lane);
    const int n = lane & 31, hh = lane >> 5;
    const int sgn = dir ? -1 : 1, tau0 = dir ? (T - 1 - 32 * c) : 32 * c;
    const S_GAS bf16* zb = A.Z + (size_t)b * T * NZ;
    const ptrdiff_t st = (ptrdiff_t)sgn * NZ; const bool first = (c == 0), last = (c == T / 32 - 1);
    const int cr = ZR + h * 64 + lane, ck = ZK + h * 64 + lane, cv = ZV + h * 64 + lane, cw = ZWD + dir * 64 + lane, ca = ZAD + dir * 64 + lane, chn = h * 64 + lane;
    {   const SFrag IDF = sident(n, hh); unsigned ppw[16], ppa[16];
        { const float mA = dir ? A.mu_next[cw] : A.mu_prev[cw], mB = dir ? A.mu_prev[cw] : A.mu_next[cw], nA = dir ? A.mu_next[ca] : A.mu_prev[ca], nB = dir ? A.mu_prev[ca] : A.mu_next[ca];
          const S_GAS bf16* pw = zb + (ptrdiff_t)tau0 * NZ + cw - st; const S_GAS bf16* pa = zb + (ptrdiff_t)tau0 * NZ + ca - st;
          float rw[34], ra[34];
          S_UNROLL for (int q = 0; q < 34; ++q) { const bool ok = !((q == 0 && first) || (q == 33 && last)); rw[q] = ok ? bf2f(*pw) : 0.f; ra[q] = ok ? bf2f(*pa) : 0.f; pw += st; pa += st; }
          S_MEMBAR();
          const float mC = 1.f - mA - mB, nC = 1.f - nA - nB; float tprev = 0.f, aprev = 0.f;
          S_UNROLL for (int p = 0; p < 32; ++p) { if ((p & 7) == 0) S_MEMBAR();
              const float ws = mC * rw[p + 1] + mA * rw[p] + mB * rw[p + 2], as = nC * ra[p + 1] + nA * ra[p] + nB * ra[p + 2];
              const float tw = 1.f - 2.f * S_RCP(1.f + S_EXP2(ws * 2.885390082f));
              if (p & 1) { ppw[p >> 1] = S_PK(tprev, tw); ppa[p >> 1] = S_PK(aprev, as); S_PIN(ppw[p >> 1]); S_PIN(ppa[p >> 1]); } else { tprev = tw; aprev = as; } } }
        S_MEMBAR();
        const SMat TW = splain2d(ppw), AD = splain2d(ppa);
        SFrag TWT[2], ADT[2];
        S_UNROLL for (int lt = 0; lt < 2; ++lt) { TWT[lt] = spack(smm(TW.t[lt], IDF, szero())); ADT[lt] = spack(smm(AD.t[lt], IDF, szero())); }
        f32x16 dw[2], da[2];
        S_UNROLL for (int jt = 0; jt < 2; ++jt) { const float w0s = A.w0[dir * 512 + h * 64 + 32 * jt + n] * -1.442695041f, a0s = A.a0[dir * 512 + h * 64 + 32 * jt + n] * -1.442695041f;
            S_UNROLL for (int g = 0; g < 16; ++g) { dw[jt][g] = w0s; da[jt][g] = a0s; }
            S_UNROLL for (int lt = 0; lt < 2; ++lt) { SFrag wf, af;
                S_UNROLL for (int s = 0; s < 2; ++s) { wf.s[s] = *(S_LDS_CONST_BF16X8P)(lds + SC_W2F + ((((lt * 2 + jt) * 2 + s) * 64 + lane) * 16)); af.s[s] = *(S_LDS_CONST_BF16X8P)(lds + SC_A2F + ((((lt * 2 + jt) * 2 + s) * 64 + lane) * 16)); }
                dw[jt] = smm(TWT[lt], wf, dw[jt]); da[jt] = smm(ADT[lt], af, da[jt]); } }
        S_UNROLL for (int jt = 0; jt < 2; ++jt) S_UNROLL for (int g = 0; g < 16; ++g) { const int t = (g & 3) + 8 * (g >> 2) + 4 * hh;
            ((S_LDS_F32P)(lds + SC_WR + wave * 8192))[t * 64 + 32 * jt + n] = dw[jt][g]; ((S_LDS_BF16P)(lds + SC_AR + wave * 4096))[t * 64 + 32 * jt + n] = (bf16)(S_PK(da[jt][g], 0.f) & 0xffffu); }
        S_LDS_WAIT();
    }
    S_MEMBAR();
    unsigned ppA[16], ppR[16], ppB[16], ppK[16], ppV[16], ppQ[16]; float gamC;
    {   const float mAr = dir ? A.mu_next[cr] : A.mu_prev[cr], mBr = dir ? A.mu_prev[cr] : A.mu_next[cr], mAk = dir ? A.mu_next[ck] : A.mu_prev[ck], mBk = dir ? A.mu_prev[ck] : A.mu_next[ck];
        const float mAv = dir ? A.mu_next[cv] : A.mu_prev[cv], mBv = dir ? A.mu_prev[cv] : A.mu_next[cv];
        const float kkj = A.k_k[chn], kaj = A.k_a[chn], rkj = A.r_k[chn];
        const S_GAS bf16* pr = zb + (ptrdiff_t)tau0 * NZ + cr - st; const S_GAS bf16* pk = zb + (ptrdiff_t)tau0 * NZ + ck - st; const S_GAS bf16* pv = zb + (ptrdiff_t)tau0 * NZ + cv - st;
        float rr[34], rk[34], rv[34];
        S_UNROLL for (int q = 0; q < 34; ++q) { const bool ok = !((q == 0 && first) || (q == 33 && last)); rr[q] = ok ? bf2f(*pr) : 0.f; rk[q] = ok ? bf2f(*pk) : 0.f; rv[q] = ok ? bf2f(*pv) : 0.f; pr += st; pk += st; pv += st; }
        S_MEMBAR();
        const float mCr = 1.f - mAr - mBr, mCk = 1.f - mAk - mBk, mCv = 1.f - mAv - mBv;
        float cs = 0.f, gprev = 1.f; float eA = 0.f, eR = 0.f, eB = 0.f, eK = 0.f, eV = 0.f, eQ = 0.f;
        {
            float sq[32];
            S_UNROLL for (int p = 0; p < 32; ++p) { rk[p] = mCk * rk[p + 1] + mAk * rk[p] + mBk * rk[p + 2]; const float t_ = rk[p] * kkj; sq[p] = t_ * t_; }
            const float tot = s_treesum32(sq, lane);
            ((S_LDS_F32P)(lds + SC_RSQ + wave * 128))[lane >> 1] = S_RSQ(fmaxf(tot, 1e-24f)); }
        S_MEMBAR();
        S_UNROLL for (int p = 0; p < 32; ++p) { if ((p & (SB_ILP - 1)) == 0) S_MEMBAR();
            const float r = mCr * rr[p + 1] + mAr * rr[p] + mBr * rr[p + 2], k = rk[p], v = mCv * rv[p + 1] + mAv * rv[p] + mBv * rv[p + 2];
            const float wraw = ((S_LDS_F32P)(lds + SC_WR + wave * 8192))[p * 64 + lane], araw = bf2f(((S_LDS_BF16P)(lds + SC_AR + wave * 4096))[p * 64 + lane]);
            const float lw2 = -0.8750387749f * S_RCP(1.f + S_EXP2(wraw));
            const float al = S_RCP(1.f + S_EXP2(araw));
            const float kk = k * kkj * ((S_LDS_CONST_F32P)(lds + SC_RSQ + wave * 128))[p];
            const float kd = k * (1.f + (al - 1.f) * kaj);
            cs += lw2; const float gam = S_EXP2(cs), ig = S_EXP2(-cs);
            const float xa = -kk * gprev, xr = r * gam, xb = kk * al * ig, xk = kd * ig, xq = xr * rkj; gprev = gam;
            if (p & 1) { ppA[p >> 1] = S_PK(eA, xa); ppR[p >> 1] = S_PK(eR, xr); ppB[p >> 1] = S_PK(eB, xb); ppK[p >> 1] = S_PK(eK, xk); ppV[p >> 1] = S_PK(eV, v); ppQ[p >> 1] = S_PK(eQ, xq);
                         S_PIN(ppQ[p >> 1]); S_PIN(ppA[p >> 1]); S_PIN(ppR[p >> 1]); S_PIN(ppB[p >> 1]); S_PIN(ppK[p >> 1]); S_PIN(ppV[p >> 1]); }
            else { eA = xa; eR = xr; eB = xb; eK = xk; eV = v; eQ = xq; } }
        gamC = gprev;
    }
    S_MEMBAR();
    float gc0, gc1; { unsigned x = __float_as_uint(gamC), y = x; S_SWAP(x, y); gc0 = __uint_as_float(x); gc1 = __uint_as_float(y); }
    ((S_LDS_F32P)(lds + SC_GTAB + wave * 256))[lane] = gamC;
    const SMat FA = splain2d(ppA), FB = splain2d(ppB), FK = splain2d(ppK), FV = splain2d(ppV);
    SFrag RT[2], MrbT, MrkT, LakT, Pf, PTf; f32x16 TT;
    {   const SFrag IDF = sident(n, hh); SFrag AT[2], BT[2], KT[2];
        { const SMat FR = splain2d(ppR); S_UNROLL for (int dt = 0; dt < 2; ++dt) RT[dt] = spack(smm(FR.t[dt], IDF, szero())); }
        SFrag QT[2]; { const SMat FQ = splain2d(ppQ); S_UNROLL for (int dt = 0; dt < 2; ++dt) QT[dt] = spack(smm(FQ.t[dt], IDF, szero())); }
        S_UNROLL for (int dt = 0; dt < 2; ++dt) { AT[dt] = spack(smm(FA.t[dt], IDF, szero())); BT[dt] = spack(smm(FB.t[dt], IDF, szero())); KT[dt] = spack(smm(FK.t[dt], IDF, szero())); }
        f32x16 L = szero(), LT = szero(), lak = szero(), mrb = szero(), mrk = szero();
        { f32x16 bq = szero(); S_UNROLL for (int dt = 0; dt < 2; ++dt) bq = smm(KT[dt], QT[dt], bq);
          int nb = n, rb = 4 * hh; S_LAUNDER_I(nb); S_LAUNDER_I(rb); float dsum = 0.f; S_UNROLL for (int g = 0; g < 16; ++g) dsum += (((g & 3) + 8 * (g >> 2) + rb) == nb) ? bq[g] : 0.f;
          if (((nb >> 2) & 1) == (rb >> 2)) A.bonus[((size_t)b * T + (tau0 + sgn * nb)) * 8 + h] = dsum; }
        S_UNROLL for (int dt = 0; dt < 2; ++dt) { L = smm(AT[dt], BT[dt], L); LT = smm(BT[dt], AT[dt], LT); lak = smm(KT[dt], AT[dt], lak); mrb = smm(BT[dt], RT[dt], mrb); mrk = smm(KT[dt], RT[dt], mrk); }
        int n2 = n, r2 = 4 * hh; S_LAUNDER_I(n2); S_LAUNDER_I(r2);
        S_UNROLL for (int g = 0; g < 16; ++g) { const int row = (g & 3) + 8 * (g >> 2) + r2;
            L[g] = (row > n2) ? L[g] : 0.f; LT[g] = (row < n2) ? LT[g] : 0.f; lak[g] = (row < n2) ? lak[g] : 0.f; mrb[g] = (row <= n2) ? mrb[g] : 0.f; mrk[g] = (row <= n2) ? mrk[g] : 0.f; }
        Pf = spack(L); PTf = spack(LT); LakT = spack(lak); MrbT = spack(mrb); MrkT = spack(mrk);
        TT = LT; S_UNROLL for (int g = 0; g < 16; ++g) TT[g] += (((g & 3) + 8 * (g >> 2) + r2) == n2) ? 1.f : 0.f;
    }
    S_MEMBAR();
    SFrag TTf = spack(TT);
    S_UNROLL for (int i = 1; i <= 4; ++i) { const f32x16 P2 = smm(PTf, Pf, szero()); SFrag P2Tf; if (i < 4) P2Tf = spack(smm(Pf, PTf, szero()));
        Pf = spack(P2); TT = smm(Pf, TTf, TT); TTf = spack(TT); if (i < 4) PTf = P2Tf; }
    S_MEMBAR();
    SFrag U0[2], Ap[2], RpT[2], Y0[2], GTf[2][2], Hf[2][2];
    S_UNROLL for (int vt = 0; vt < 2; ++vt) { const SFrag W = spack(smm(LakT, FV.t[vt], szero())); U0[vt] = spack(smm(TTf, W, szero())); }
    S_UNROLL for (int kt = 0; kt < 2; ++kt) Ap[kt] = spack(smm(TTf, FA.t[kt], szero()));
    S_UNROLL for (int kt = 0; kt < 2; ++kt) RpT[kt] = spack(smm(Ap[kt], MrbT, sunpack(RT[kt])));
    S_UNROLL for (int vt = 0; vt < 2; ++vt) Y0[vt] = spack(smm(MrkT, FV.t[vt], smm(MrbT, U0[vt], szero())));
    int n3 = n, r3 = 4 * hh; S_LAUNDER_I(n3); S_LAUNDER_I(r3);
    S_UNROLL for (int nt = 0; nt < 2; ++nt) S_UNROLL for (int mt = 0; mt < 2; ++mt) { f32x16 gt = smm(Ap[nt], FB.t[mt], szero()); const float gcv = mt ? gc1 : gc0;
        S_UNROLL for (int g = 0; g < 16; ++g) { const float idv = (nt == mt && ((g & 3) + 8 * (g >> 2) + r3) == n3) ? 1.f : 0.f; gt[g] = (gt[g] + idv) * gcv; }
        GTf[nt][mt] = spack(gt); }
    S_LDS_WAIT();
    S_UNROLL for (int mt = 0; mt < 2; ++mt) { float gr[16];
        S_UNROLL for (int q = 0; q < 4; ++q) { const f32x4 t4 = *(S_LDS_CONST_F32X4P)(lds + SC_GTAB + wave * 256 + (32 * mt + 8 * q + 4 * hh) * 4); S_UNROLL for (int i = 0; i < 4; ++i) gr[4 * q + i] = t4[i]; }
        S_UNROLL for (int vt = 0; vt < 2; ++vt) { f32x16 hm = smm(FK.t[mt], FV.t[vt], smm(FB.t[mt], U0[vt], szero())); S_UNROLL for (int g = 0; g < 16; ++g) hm[g] *= gr[g]; Hf[mt][vt] = spack(hm); } }
    S_MEMBAR();
    S_FLAG_WAIT(lds + SC_FLAG, (unsigned)c);
    SFrag SG[2][2];
    S_UNROLL for (int kt = 0; kt < 2; ++kt) S_UNROLL for (int vt = 0; vt < 2; ++vt) S_UNROLL for (int s = 0; s < 2; ++s) SG[kt][vt].s[s] = *(S_LDS_CONST_BF16X8P)(lds + SC_SIG + ((((kt * 2 + vt) * 2 + s) * 64 + lane) * 16));
    S_LDS_WAIT();
    S_UNROLL for (int mt = 0; mt < 2; ++mt) S_UNROLL for (int vt = 0; vt < 2; ++vt) { f32x16 sn = sunpack(Hf[mt][vt]); S_UNROLL for (int nt = 0; nt < 2; ++nt) sn = smm(GTf[nt][mt], SG[nt][vt], sn);
        const SFrag f = spack(sn); S_UNROLL for (int s = 0; s < 2; ++s) *(S_LDS_BF16X8P)(lds + SC_SIG + ((((mt * 2 + vt) * 2 + s) * 64 + lane) * 16)) = f.s[s]; }
    S_LDS_WAIT();
    S_FLAG_STORE(lds + SC_FLAG, (unsigned)(c + 1));
    S_UNROLL for (int vt = 0; vt < 2; ++vt) { f32x16 y = sunpack(Y0[vt]); S_UNROLL for (int kt = 0; kt < 2; ++kt) y = smm(RpT[kt], SG[kt][vt], y);
        S_UNROLL for (int g = 0; g < 16; ++g) { const int p = (g & 3) + 8 * (g >> 2) + 4 * hh; A.ydir[((size_t)b * T + (tau0 + sgn * p)) * 512 + h * 64 + 32 * vt + n] = (bf16)(S_PK(y[g], 0.f) & 0xffffu); } }
}

__device__ __forceinline__ void attn_unit(const Frame& F, ArgsP A, int b, int kvh, int qb) {
    constexpr int KST = 72, VST = 388;
    LAS bf16* KS = (LAS bf16*)F.lds;
    LAS bf16* VT = (LAS bf16*)(F.lds + 384 * KST * 2);
    LAS float* wsf = (LAS float*)(F.lds + 384 * KST * 2 + 64 * VST * 2);
    const bf16* Z = (const bf16*)(A->ws + WS_Z); bf16* OA = (bf16*)(A->ws + WS_OATT);
    const int* positions = (const int*)A->in[2]; const float* qg = (const float*)A->in[19]; const float* kg = (const float*)A->in[20]; const float* sink = (const float*)A->in[21];
    const int tid = F.tid, lane = F.lane, wave = F.wave;
    const float LN_THETA = 13.122363377404328f;
    v4u kwa[6], vwa[6], rca[6], rsa[6];
    v4u qn[4], qnc, qns;
    { const size_t tok0 = (size_t)b * T + qb * 128 + (wave & 1) * 64 + (lane & 31); const int hq0 = kvh * 4 + (wave >> 1);
#pragma unroll
      for (int sI = 0; sI < 4; ++sI) qn[sI] = *(const GAS v4u*)(Z + tok0 * NZ + ZQ + hq0 * 64 + 16 * sI + 8 * (lane >> 5));
      const GAS v4u* qrt0 = (const GAS v4u*)((const bf16*)(A->ws + WS_ROPE) + tok0 * 16); qnc = qrt0[0]; qns = qrt0[1]; }
#pragma unroll
    for (int i = 0; i < 6; ++i) { const int ct = tid + 512 * i, key = ct >> 3, ch = ct & 7; const int kp = qb * 128 - 128 + key; const bool valid = (kp >= 0) && (kp < T);
        const size_t rowoff = ((size_t)b * T + (valid ? kp : 0)) * NZ;
        kwa[i] = *(const GAS v4u*)(Z + rowoff + ZKA + kvh * 64 + ch * 8); vwa[i] = *(const GAS v4u*)(Z + rowoff + ZVA + kvh * 64 + ch * 8);
        const GAS v4u* rt = (const GAS v4u*)((const bf16*)(A->ws + WS_ROPE) + ((size_t)b * T + (valid ? kp : 0)) * 16); rca[i] = rt[0]; rsa[i] = rt[1]; }
#pragma unroll
    for (int i = 0; i < 6; ++i) { const int ct = tid + 512 * i, key = ct >> 3, ch = ct & 7; const int kp = qb * 128 - 128 + key; const bool valid = (kp >= 0) && (kp < T);
        v4u kw = kwa[i], vw = vwa[i];
        if (!valid) { kw = (v4u){0u, 0u, 0u, 0u}; vw = kw; }
        float kf[8] = {bflo(kw.x), bfhi(kw.x), bflo(kw.y), bfhi(kw.y), bflo(kw.z), bfhi(kw.z), bflo(kw.w), bfhi(kw.w)};
        float ss = 0.f;
#pragma unroll
        for (int j = 0; j < 8; ++j) ss += kf[j] * kf[j];
        ss += __shfl_xor(ss, 1); ss += __shfl_xor(ss, 2); ss += __shfl_xor(ss, 4);
        const float rs = rsqrtf(ss * (1.0f / 64.0f) + 1e-6f);
#pragma unroll
        for (int j = 0; j < 8; ++j) kf[j] = kf[j] * rs * kg[ch * 8 + j];
        float oth[8];
#pragma unroll
        for (int j = 0; j < 8; ++j) oth[j] = __shfl_xor(kf[j], 1);
        if (ch < 2) { const v4u cw = rca[i], sw = rsa[i];
            const float cs[8] = {bflo(cw.x), bfhi(cw.x), bflo(cw.y), bfhi(cw.y), bflo(cw.z), bfhi(cw.z), bflo(cw.w), bfhi(cw.w)};
            const float sn[8] = {bflo(sw.x), bfhi(sw.x), bflo(sw.y), bfhi(sw.y), bflo(sw.z), bfhi(sw.z), bflo(sw.w), bfhi(sw.w)};
#pragma unroll
            for (int j = 0; j < 8; ++j) kf[j] = (ch == 0) ? (kf[j] * cs[j] - oth[j] * sn[j]) : (kf[j] * cs[j] + oth[j] * sn[j]); }
        v4u ko; ko.x = pk2(kf[0], kf[1]); ko.y = pk2(kf[2], kf[3]); ko.z = pk2(kf[4], kf[5]); ko.w = pk2(kf[6], kf[7]);
        *(LAS v4u*)(KS + key * KST + ch * 8) = ko;
        const unsigned vv[4] = {vw.x, vw.y, vw.z, vw.w};
#pragma unroll
        for (int j = 0; j < 4; ++j) { VT[(ch * 8 + 2 * j) * VST + key] = (bf16)(vv[j] & 0xffffu); VT[(ch * 8 + 2 * j + 1) * VST + key] = (bf16)(vv[j] >> 16); } }
    __syncthreads();
    const int g = wave >> 1, hq = kvh * 4 + g, r32 = lane & 31, hh = lane >> 5;
    const float snk = sink[hq];
    float kbound; { float gm = fabsf(kg[lane]);
#pragma unroll
        for (int o = 1; o < 64; o <<= 1) gm = fmaxf(gm, __shfl_xor(gm, o));
        kbound = 8.0f * gm; }
#pragma unroll 1
    for (int qt = 0; qt < 2; ++qt) { const int qo = (wave & 1) * 64 + qt * 32, qrel = qo + r32; const size_t tok = (size_t)b * T + qb * 128 + qrel;
        float qf[4][8]; float ss = 0.f; v4u qraw[4];
#pragma unroll
        for (int sI = 0; sI < 4; ++sI) qraw[sI] = qn[sI];
        const v4u qrc = qnc, qrs = qns;
        if (qt == 0) { const size_t tok1 = tok + 32;
#pragma unroll
            for (int sI = 0; sI < 4; ++sI) qn[sI] = *(const GAS v4u*)(Z + tok1 * NZ + ZQ + hq * 64 + 16 * sI + 8 * hh);
            const GAS v4u* qrt1 = (const GAS v4u*)((const bf16*)(A->ws + WS_ROPE) + tok1 * 16); qnc = qrt1[0]; qns = qrt1[1]; }
#pragma unroll
        for (int sI = 0; sI < 4; ++sI) { const v4u qw = qraw[sI];
            qf[sI][0] = bflo(qw.x); qf[sI][1] = bfhi(qw.x); qf[sI][2] = bflo(qw.y); qf[sI][3] = bfhi(qw.y); qf[sI][4] = bflo(qw.z); qf[sI][5] = bfhi(qw.z); qf[sI][6] = bflo(qw.w); qf[sI][7] = bfhi(qw.w);
#pragma unroll
            for (int j = 0; j < 8; ++j) ss += qf[sI][j] * qf[sI][j]; }
        ss += __shfl_xor(ss, 32);
        const float rs = rsqrtf(ss * (1.0f / 64.0f) + 1e-6f) * 0.125f;
#pragma unroll
        for (int sI = 0; sI < 4; ++sI)
#pragma unroll
            for (int j = 0; j < 8; ++j) qf[sI][j] = qf[sI][j] * rs * qg[16 * sI + 8 * hh + j];
        { const v4u cw = qrc, sw = qrs;
          const float cs[8] = {bflo(cw.x), bfhi(cw.x), bflo(cw.y), bfhi(cw.y), bflo(cw.z), bfhi(cw.z), bflo(cw.w), bfhi(cw.w)}, sn[8] = {bflo(sw.x), bfhi(sw.x), bflo(sw.y), bfhi(sw.y), bflo(sw.z), bfhi(sw.z), bflo(sw.w), bfhi(sw.w)};
#pragma unroll
          for (int j = 0; j < 8; ++j) { const float oth = __shfl_xor(qf[0][j], 32); qf[0][j] = (hh == 0) ? (qf[0][j] * cs[j] - oth * sn[j]) : (qf[0][j] * cs[j] + oth * sn[j]); } }
        bf16x8 qr[4];
#pragma unroll
        for (int sI = 0; sI < 4; ++sI) { v4u w; w.x = pk2(qf[sI][0], qf[sI][1]); w.y = pk2(qf[sI][2], qf[sI][3]); w.z = pk2(qf[sI][4], qf[sI][5]); w.w = pk2(qf[sI][6], qf[sI][7]); qr[sI] = __builtin_bit_cast(bf16x8, w); }
        const int kt0 = qo >> 5;
        float qn2 = 0.f;
#pragma unroll
        for (int sI = 0; sI < 4; ++sI)
#pragma unroll
            for (int j = 0; j < 8; ++j) qn2 += qf[sI][j] * qf[sI][j];
        qn2 += __shfl_xor(qn2, 32);
        float mrun = sqrtf(qn2) * kbound * 1.02f;
        if (__any(mrun > 40.f)) { mrun = -1e30f;
#pragma unroll 1
            for (int kt = 0; kt < 9; ++kt) { const int kbase = (kt0 + kt) * 32;
                f32x16 acc = {};
#pragma unroll
                for (int sI = 0; sI < 4; ++sI) { const bf16x8 kfr = *(const LAS bf16x8*)(KS + (kbase + r32) * KST + 16 * sI + 8 * hh); acc = __builtin_amdgcn_mfma_f32_32x32x16_bf16(kfr, qr[sI], acc, 0, 0, 0); }
#pragma unroll
                for (int r = 0; r < 16; ++r) { const int ki = kbase + (r & 3) + 8 * (r >> 2) + 4 * hh; const int dq = ki - 128 - qrel, kp = qb * 128 - 128 + ki;
                    const bool ok = (dq >= -128) && (dq <= 128) && (kp >= 0) && (kp < T); mrun = fmaxf(mrun, ok ? acc[r] : -1e30f); } }
            mrun = fmaxf(mrun, __shfl_xor(mrun, 32)); }
        const float mx = fmaxf(mrun, snk);
        float lrun = 0.f; f32x16 o0 = {}, o1 = {}; const float mxl = mx * 1.442695041f; const bool edge = (qb == 0) || (qb == T / 128 - 1);
#pragma unroll 1
        for (int kt = 0; kt < 9; ++kt) { const int kbase = (kt0 + kt) * 32;
            f32x16 acc = {};
#pragma unroll
            for (int sI = 0; sI < 4; ++sI) { const bf16x8 kfr = *(const LAS bf16x8*)(KS + (kbase + r32) * KST + 16 * sI + 8 * hh); acc = __builtin_amdgcn_mfma_f32_32x32x16_bf16(kfr, qr[sI], acc, 0, 0, 0); }
            float p[16];
            if (edge || kt == 0 || kt == 8) {
#pragma unroll
                for (int r = 0; r < 16; ++r) { const int ki = kbase + (r & 3) + 8 * (r >> 2) + 4 * hh; const int dq = ki - 128 - qrel, kp = qb * 128 - 128 + ki;
                    const bool ok = (dq >= -128) && (dq <= 128) && (kp >= 0) && (kp < T); p[r] = ok ? __builtin_amdgcn_exp2f(acc[r] * 1.442695041f - mxl) : 0.f; lrun += p[r]; }
            } else {
#pragma unroll
                for (int r = 0; r < 16; ++r) { p[r] = __builtin_amdgcn_exp2f(acc[r] * 1.442695041f - mxl); lrun += p[r]; } }
#pragma unroll
            for (int sI = 0; sI < 2; ++sI) { v4u pw; pw.x = pk2(p[8 * sI + 0], p[8 * sI + 1]); pw.y = pk2(p[8 * sI + 2], p[8 * sI + 3]); pw.z = pk2(p[8 * sI + 4], p[8 * sI + 5]); pw.w = pk2(p[8 * sI + 6], p[8 * sI + 7]);
                const bf16x8 pa = __builtin_bit_cast(bf16x8, pw); const int key0 = kbase + 16 * sI + 4 * hh;
                { const u32x2 lo = *(const LAS u32x2*)(VT + r32 * VST + key0), hi = *(const LAS u32x2*)(VT + r32 * VST + key0 + 8); v4u vw; vw.x = lo.x; vw.y = lo.y; vw.z = hi.x; vw.w = hi.y;
                  o0 = __builtin_amdgcn_mfma_f32_32x32x16_bf16(pa, __builtin_bit_cast(bf16x8, vw), o0, 0, 0, 0); }
                { const u32x2 lo = *(const LAS u32x2*)(VT + (32 + r32) * VST + key0), hi = *(const LAS u32x2*)(VT + (32 + r32) * VST + key0 + 8); v4u vw; vw.x = lo.x; vw.y = lo.y; vw.z = hi.x; vw.w = hi.y;
                  o1 = __builtin_amdgcn_mfma_f32_32x32x16_bf16(pa, __builtin_bit_cast(bf16x8, vw), o1, 0, 0, 0); } } }
        lrun += __shfl_xor(lrun, 32);
        const float linv = 1.0f / (lrun + __expf(snk - mx));
        if (hh == 0) wsf[wave * 64 + r32] = linv;
        LDS_WAIT(); asm volatile("" ::: "memory");
#pragma unroll
        for (int r = 0; r < 16; ++r) { const int row = (r & 3) + 8 * (r >> 2) + 4 * hh; const float li = wsf[wave * 64 + row];
            bf16* op = OA + ((size_t)b * T + qb * 128 + qo + row) * 512 + hq * 64;
            op[r32] = (bf16)f2bf(o0[r] * li); op[32 + r32] = (bf16)f2bf(o1[r] * li); }
        LDS_WAIT(); asm volatile("" ::: "memory");
    }
    __syncthreads();
}

__device__ __forceinline__ void pg_rows(const Frame& F, ArgsP A, bf16* wout) {
    const bf16* Z = (const bf16*)(A->ws + WS_Z); const bf16* Y0 = (const bf16*)(A->ws + WS_XN); const bf16* Y1 = Y0 + (size_t)M * 512;
    bf16* Gb = (bf16*)(A->ws + WS_G); const float* bonus = (const float*)(A->ws + WS_BONUS);
    const float* mu_prev = (const float*)A->in[7]; const float* mu_next = (const float*)A->in[8]; const float* gn_w = (const float*)A->in[17]; const float* gn_b = (const float*)A->in[18];
    const int gw = F.vcu * NWAVES + F.wave, NGW = F.G * NWAVES, lane = F.lane, c0 = lane * 8, h = lane >> 3;
    float mp[8], mn[8], gw_[8], gb_[8];
#pragma unroll
    for (int j = 0; j < 8; ++j) { mp[j] = mu_prev[ZV + c0 + j]; mn[j] = mu_next[ZV + c0 + j]; gw_[j] = gn_w[c0 + j]; gb_[j] = gn_b[c0 + j]; }
#pragma unroll 1
    for (int m0 = gw; m0 < M; m0 += 4 * NGW) {
        v4u y0[4], y1[4], gv[4], z0[4], zm[4], zq[4]; float bon[4];
#pragma unroll
        for (int i = 0; i < 4; ++i) { const int m = m0 + i * NGW, t = m & (T - 1);
            y0[i] = *(const GAS v4u*)(Y0 + (size_t)m * 512 + c0); y1[i] = *(const GAS v4u*)(Y1 + (size_t)m * 512 + c0); gv[i] = *(const GAS v4u*)(Gb + (size_t)m * 512 + c0);
            z0[i] = *(const GAS v4u*)(Z + (size_t)m * NZ + ZV + c0);
            zm[i] = (v4u){0u, 0u, 0u, 0u}; zq[i] = (v4u){0u, 0u, 0u, 0u};
            if (t > 0) zm[i] = *(const GAS v4u*)(Z + (size_t)(m - 1) * NZ + ZV + c0);
            if (t < T - 1) zq[i] = *(const GAS v4u*)(Z + (size_t)(m + 1) * NZ + ZV + c0);
            bon[i] = bonus[(size_t)m * 8 + h] + bonus[(size_t)M * 8 + (size_t)m * 8 + h]; }
#pragma unroll
        for (int i = 0; i < 4; ++i) { const int m = m0 + i * NGW;
            const unsigned y0w[4] = {y0[i].x, y0[i].y, y0[i].z, y0[i].w}, y1w[4] = {y1[i].x, y1[i].y, y1[i].z, y1[i].w}, gvw[4] = {gv[i].x, gv[i].y, gv[i].z, gv[i].w};
            const unsigned z0w[4] = {z0[i].x, z0[i].y, z0[i].z, z0[i].w}, zmw[4] = {zm[i].x, zm[i].y, zm[i].z, zm[i].w}, zqw[4] = {zq[i].x, zq[i].y, zq[i].z, zq[i].w};
            float y[8], gg[8], vv[8]; float sacc = 0.f;
#pragma unroll
            for (int j = 0; j < 4; ++j) { y[2 * j] = bflo(y0w[j]) + bflo(y1w[j]); y[2 * j + 1] = bfhi(y0w[j]) + bfhi(y1w[j]); gg[2 * j] = bflo(gvw[j]); gg[2 * j + 1] = bfhi(gvw[j]);
                const float a0 = bflo(z0w[j]), a1 = bfhi(z0w[j]);
                vv[2 * j] = a0 + mp[2 * j] * (bflo(zmw[j]) - a0) + mn[2 * j] * (bflo(zqw[j]) - a0); vv[2 * j + 1] = a1 + mp[2 * j + 1] * (bfhi(zmw[j]) - a1) + mn[2 * j + 1] * (bfhi(zqw[j]) - a1);
                sacc += y[2 * j] + y[2 * j + 1]; }
            sacc += __shfl_xor(sacc, 1); sacc += __shfl_xor(sacc, 2); sacc += __shfl_xor(sacc, 4);
            const float mu = sacc * (1.0f / 64.0f); float q = 0.f;
#pragma unroll
            for (int j = 0; j < 8; ++j) { const float d = y[j] - mu; q += d * d; }
            q += __shfl_xor(q, 1); q += __shfl_xor(q, 2); q += __shfl_xor(q, 4);
            const float rstd = rsqrtf(q * (1.0f / 64.0f) + 64e-5f);
            float o[8];
#pragma unroll
            for (int j = 0; j < 8; ++j) o[j] = ((y[j] - mu) * rstd * gw_[j] + gb_[j] + bon[i] * vv[j]) * gg[j];
            v4u w; w.x = pk2(o[0], o[1]); w.y = pk2(o[2], o[3]); w.z = pk2(o[4], o[5]); w.w = pk2(o[6], o[7]);
            *(GAS v4u*)(wout + (size_t)m * 512 + c0) = w; } }
}

__device__ __forceinline__ void pj_phase(const Frame& F, ArgsP A) {
    unsigned char* ws = A->ws;
    const int gw = F.vcu * NWAVES + F.wave, NGW = F.G * NWAVES, lane = F.lane;
    { LAS float* scr = (LAS float*)(F.lds + F.wave * 16384);
      const float* w_gate = (const float*)A->in[27]; const float* w_up = (const float*)A->in[28]; const float* w_down = (const float*)A->in[29];
      bf16* WguT = (bf16*)((unsigned char*)A->out + OUT_WGUT); bf16* WdT = (bf16*)((unsigned char*)A->out + OUT_WDT);
      constexpr int PER = 512, NIT = 16 * 3 * PER;
      for (int it = gw; it < NIT; it += NGW) { const int e = it / (3 * PER), r = it % (3 * PER), which = r / PER, q = r % PER, kb = q >> 5, nb = q & 31, n0 = 32 * nb;
          if (which == 0) tr_item(w_gate + (size_t)e * 1048576, 1024, 64 * kb, n0, WguT, 1024, e * 2048 + (n0 >> 7) * 256 + (n0 & 127), scr, lane);
          else if (which == 1) tr_item(w_up + (size_t)e * 1048576, 1024, 64 * kb, n0, WguT, 1024, e * 2048 + (n0 >> 7) * 256 + 128 + (n0 & 127), scr, lane);
          else tr_item(w_down + (size_t)e * 1048576, 1024, 64 * kb, n0, WdT, 1024, e * 1024 + n0, scr, lane); }
    }
    __syncthreads();
    const float* w_router = (const float*)A->in[26]; const bf16* x1 = (const bf16*)(ws + WS_X1); const float* g2n = (const float*)A->in[25]; const float* mod = (const float*)(ws + WS_MOD);
    bf16* XN2 = (bf16*)(ws + WS_XN); float* aff = (float*)(ws + WS_AFF);
    LAS bf16* WF = (LAS bf16*)F.lds;
    LAS float* AT = (LAS float*)(F.lds + 65536); LAS float* BT = AT + 1024; LAS float* CB = BT + 1024;
    const int tile = gw, b = tile >> 7;
    for (int d = F.tid; d < 1024; d += 512) { AT[d] = g2n[d] * (1.0f + mod[(size_t)b * 6144 + 4096 + d]); BT[d] = mod[(size_t)b * 6144 + 3072 + d]; }
    __syncthreads();
#pragma unroll 4
    for (int k = 0; k < 32; ++k) { const int it = F.tid + 512 * k, jj = it & 7, ln = (it >> 3) & 63, sI = it >> 9, q = ln >> 4, e = ln & 15, d = 32 * sI + 8 * q + jj;
        const float v = AT[d] * w_router[d * 16 + e]; const unsigned hi = pk2(v, 0.f) & 0xffffu; const float lo = v - __uint_as_float(hi << 16);
        WF[it] = (bf16)hi; WF[16384 + it] = (bf16)(pk2(lo, 0.f) & 0xffffu); }
    { float c0 = 0.f, c1 = 0.f;
#pragma unroll 4
      for (int k = 0; k < 16; ++k) { const int d = lane + 64 * k; c0 += BT[d] * w_router[d * 16 + 2 * F.wave]; c1 += BT[d] * w_router[d * 16 + 2 * F.wave + 1]; }
      c0 = dpp_wave_sum(c0); c1 = dpp_wave_sum(c1); if (lane == 0) { CB[2 * F.wave] = c0; CB[2 * F.wave + 1] = c1; } }
    __syncthreads();
    if (tile < M / 16) { const int r = lane & 15, q = lane >> 4; const size_t m = (size_t)tile * 16 + r;
        float ss = 0.f;
#pragma unroll 1
        for (int hf = 0; hf < 2; ++hf) { v4u raw[16];
#pragma unroll
            for (int sI = 0; sI < 16; ++sI) raw[sI] = *(const GAS v4u*)(x1 + m * 1024 + 32 * (16 * hf + sI) + 8 * q);
#pragma unroll
            for (int sI = 0; sI < 16; ++sI) { const v4u w = raw[sI]; const float a0 = bflo(w.x), a1 = bfhi(w.x), a2 = bflo(w.y), a3 = bfhi(w.y), a4 = bflo(w.z), a5 = bfhi(w.z), a6 = bflo(w.w), a7 = bfhi(w.w);
                ss += (a0 * a0 + a1 * a1) + (a2 * a2 + a3 * a3) + (a4 * a4 + a5 * a5) + (a6 * a6 + a7 * a7); } }
        ss += __shfl_xor(ss, 16); ss += __shfl_xor(ss, 32);
        const float rs = rsqrtf(ss * (1.0f / 1024.0f) + 1e-6f);
        f32x4 ah = {0.f, 0.f, 0.f, 0.f}, al = {0.f, 0.f, 0.f, 0.f};
#pragma unroll 1
        for (int hf = 0; hf < 2; ++hf) { v4u raw[16];
#pragma unroll
            for (int sI = 0; sI < 16; ++sI) raw[sI] = *(const GAS v4u*)(x1 + m * 1024 + 32 * (16 * hf + sI) + 8 * q);
#pragma unroll
            for (int sI = 0; sI < 16; ++sI) { const int sg = 16 * hf + sI; const bf16x8 xa = __builtin_bit_cast(bf16x8, raw[sI]);
                const bf16x8 bh = *(const LAS bf16x8*)(WF + (sg * 64 + lane) * 8), bl = *(const LAS bf16x8*)(WF + 16384 + (sg * 64 + lane) * 8);
                ah = __builtin_amdgcn_mfma_f32_16x16x32_bf16(xa, bh, ah, 0, 0, 0); al = __builtin_amdgcn_mfma_f32_16x16x32_bf16(xa, bl, al, 0, 0, 0); }
#pragma unroll
            for (int sI = 0; sI < 16; ++sI) { if ((sI & 3) == 0) asm volatile("" ::: "memory");
                const int d0 = 32 * (16 * hf + sI) + 8 * q; const v4u w = raw[sI];
                const f32x4 a0 = *(const LAS f32x4*)(AT + d0), a1 = *(const LAS f32x4*)(AT + d0 + 4), b0 = *(const LAS f32x4*)(BT + d0), b1 = *(const LAS f32x4*)(BT + d0 + 4);
                v4u o; o.x = pk2(bflo(w.x) * rs * a0.x + b0.x, bfhi(w.x) * rs * a0.y + b0.y); o.y = pk2(bflo(w.y) * rs * a0.z + b0.z, bfhi(w.y) * rs * a0.w + b0.w);
                o.z = pk2(bflo(w.z) * rs * a1.x + b1.x, bfhi(w.z) * rs * a1.y + b1.y); o.w = pk2(bflo(w.w) * rs * a1.z + b1.z, bfhi(w.w) * rs * a1.w + b1.w);
                *(GAS v4u*)(XN2 + m * 1024 + d0) = o; } }
        const float cb = CB[lane & 15]; float lg[4], mx[4], ex[4], den[4];
#pragma unroll
        for (int i = 0; i < 4; ++i) { const float rsr = __shfl(rs, 4 * q + i); lg[i] = rsr * (ah[i] + al[i]) + cb; mx[i] = lg[i]; }
#pragma unroll
        for (int o = 1; o < 16; o <<= 1)
#pragma unroll
            for (int i = 0; i < 4; ++i) mx[i] = fmaxf(mx[i], __shfl_xor(mx[i], o));
#pragma unroll
        for (int i = 0; i < 4; ++i) { ex[i] = expf(lg[i] - mx[i]); den[i] = ex[i]; }
#pragma unroll
        for (int o = 1; o < 16; o <<= 1)
#pragma unroll
            for (int i = 0; i < 4; ++i) den[i] += __shfl_xor(den[i], o);
        { const int t0 = (tile & 127) * 16 + 4 * q; f32x4 av; av.x = ex[0] / den[0]; av.y = ex[1] / den[1]; av.z = ex[2] / den[2]; av.w = ex[3] / den[3];
          *(GAS f32x4*)(aff + ((size_t)b * 16 + (lane & 15)) * T + t0) = av; } }
}

__device__ __forceinline__ void pk_task(const Frame& F, ArgsP A, int b, int e) {
    unsigned char* ws = A->ws;
    const float* aff = (const float*)(ws + WS_AFF) + ((size_t)b * 16 + e) * T;
    int* slotmap = (int*)(ws + WS_SLOT); float* selaff = (float*)(ws + WS_SELAFF); int* selidx = (int*)(ws + WS_SELIDX);
    const bf16* XN2 = (const bf16*)(ws + WS_XN); bf16* XE = (bf16*)(ws + WS_XE);
    LAS unsigned* cnt = (LAS unsigned*)F.lds;
    LAS int* tokl = (LAS int*)(F.lds + 256);
    const int tid = F.tid, lane = F.lane, wave = F.wave;
    const f32x4 v4 = *(const GAS f32x4*)(aff + 4 * tid);
    const unsigned key[4] = {__float_as_uint(v4.x), __float_as_uint(v4.y), __float_as_uint(v4.z), __float_as_uint(v4.w)};
    unsigned thr = 0u;
#pragma unroll 1
    for (int bit = 31; bit >= 0; --bit) { const unsigned cand = thr | (1u << bit);
        const unsigned c = (unsigned)(__popcll(__ballot(key[0] >= cand)) + __popcll(__ballot(key[1] >= cand)) + __popcll(__ballot(key[2] >= cand)) + __popcll(__ballot(key[3] >= cand)));
        LAS unsigned* slot_ = cnt + 16 + (bit & 1) * 8;
        if (lane == 0) slot_[wave] = c;
        __syncthreads();
        unsigned tot = 0;
#pragma unroll
        for (int w = 0; w < 8; ++w) tot += slot_[w];
        if (tot >= 256u) thr = cand; }
    __syncthreads();
    int ngt = 0, neq = 0;
#pragma unroll
    for (int j = 0; j < 4; ++j) { ngt += key[j] > thr; neq += key[j] == thr; }
    int sg = ngt, se = neq;
#pragma unroll
    for (int o = 1; o < 64; o <<= 1) { const int a = __shfl_up(sg, o), c = __shfl_up(se, o); if (lane >= o) { sg += a; se += c; } }
    if (lane == 63) { cnt[wave] = (unsigned)sg; cnt[8 + wave] = (unsigned)se; }
    __syncthreads();
    int bg = 0, be = 0, totg = 0;
#pragma unroll
    for (int w = 0; w < 8; ++w) { const int a = (int)cnt[w], c = (int)cnt[8 + w]; if (w < wave) { bg += a; be += c; } totg += a; }
    int pg = bg + sg - ngt, pe = be + se - neq;
    const int need_eq = 256 - totg;
    int* smrow = slotmap + ((size_t)b * T + 4 * tid) * 16 + e;
#pragma unroll
    for (int j = 0; j < 4; ++j) { int slot = -1;
        if (key[j] > thr) { slot = pg; ++pg; } else if (key[j] == thr) { if (pe < need_eq) slot = totg + pe; ++pe; }
        smrow[j * 16] = slot;
        if (slot >= 0) { selidx[((size_t)e * 16 + b) * 256 + slot] = b * T + 4 * tid + j; selaff[((size_t)e * 16 + b) * 256 + slot] = __uint_as_float(key[j]); } }
    __syncthreads();
}

__device__ __forceinline__ void pn_rows(const Frame& F, ArgsP A, float* wout) {
    unsigned char* ws = A->ws;
    const int* slotmap = (const int*)(ws + WS_SLOT); const bf16* YE = (const bf16*)(ws + WS_XE); const float* mod = (const float*)(ws + WS_MOD); const bf16* X1 = (const bf16*)(ws + WS_X1);
    const int gw = F.vcu * NWAVES + F.wave, NGW = F.G * NWAVES, lane = F.lane;
#pragma unroll 1
    for (int m0 = gw * 16; m0 < gw * 16 + 16; m0 += 2) {
        int myslot[2]; f32x4 xv[2][4];
#pragma unroll
        for (int i = 0; i < 2; ++i) { const int m = m0 + i; myslot[i] = slotmap[(size_t)m * 16 + (lane & 15)];
#pragma unroll
            for (int hq = 0; hq < 2; ++hq) { const v4u w = *(const GAS v4u*)(X1 + (size_t)m * 1024 + hq * 512 + lane * 8);
                xv[i][2 * hq] = (f32x4){bflo(w.x), bfhi(w.x), bflo(w.y), bfhi(w.y)}; xv[i][2 * hq + 1] = (f32x4){bflo(w.z), bfhi(w.z), bflo(w.w), bfhi(w.w)}; } }
        unsigned long long msk[2]; v4u yw[2][4][2];
#pragma unroll
        for (int i = 0; i < 2; ++i) { const int b = (m0 + i) >> 11; msk[i] = __ballot(myslot[i] >= 0) & 0xffffull;
#pragma unroll
            for (int k = 0; k < 4; ++k) { const bool has = msk[i] != 0ull; const int e = has ? __builtin_ctzll(msk[i]) : 0; if (has) msk[i] &= msk[i] - 1; const int sl = __shfl(myslot[i], e);
                yw[i][k][0] = (v4u){0u, 0u, 0u, 0u}; yw[i][k][1] = (v4u){0u, 0u, 0u, 0u};
                if (has) { const GAS v4u* yr = (const GAS v4u*)(YE + (((size_t)e * 16 + b) * 256 + sl) * 1024); yw[i][k][0] = yr[lane]; yw[i][k][1] = yr[64 + lane]; } } }
#pragma unroll
        for (int i = 0; i < 2; ++i) { const int m = m0 + i, b = m >> 11;
            float acc[16];
#pragma unroll
            for (int j = 0; j < 16; ++j) acc[j] = 0.f;
#pragma unroll
            for (int k = 0; k < 4; ++k)
#pragma unroll
                for (int hlf = 0; hlf < 2; ++hlf) { const v4u w = yw[i][k][hlf];
                    acc[hlf * 8 + 0] += bflo(w.x); acc[hlf * 8 + 1] += bfhi(w.x); acc[hlf * 8 + 2] += bflo(w.y); acc[hlf * 8 + 3] += bfhi(w.y);
                    acc[hlf * 8 + 4] += bflo(w.z); acc[hlf * 8 + 5] += bfhi(w.z); acc[hlf * 8 + 6] += bflo(w.w); acc[hlf * 8 + 7] += bfhi(w.w); }
            unsigned long long mk = msk[i];
            while (mk) { const int e = __builtin_ctzll(mk); mk &= mk - 1; const int sl = __shfl(myslot[i], e);
                const GAS v4u* yr = (const GAS v4u*)(YE + (((size_t)e * 16 + b) * 256 + sl) * 1024);
#pragma unroll
                for (int hlf = 0; hlf < 2; ++hlf) { const v4u w = yr[hlf * 64 + lane];
                    acc[hlf * 8 + 0] += bflo(w.x); acc[hlf * 8 + 1] += bfhi(w.x); acc[hlf * 8 + 2] += bflo(w.y); acc[hlf * 8 + 3] += bfhi(w.y);
                    acc[hlf * 8 + 4] += bflo(w.z); acc[hlf * 8 + 5] += bfhi(w.z); acc[hlf * 8 + 6] += bflo(w.w); acc[hlf * 8 + 7] += bfhi(w.w); } }
            const float* gt2 = mod + (size_t)b * 6144 + 5120; float* orow = wout + (size_t)m * 1024;
#pragma unroll
            for (int q = 0; q < 4; ++q) { const int c = (q >> 1) * 512 + lane * 8 + (q & 1) * 4; const f32x4 g = *(const GAS f32x4*)(gt2 + c);
                f32x4 a; a.x = acc[(q >> 1) * 8 + (q & 1) * 4 + 0]; a.y = acc[(q >> 1) * 8 + (q & 1) * 4 + 1]; a.z = acc[(q >> 1) * 8 + (q & 1) * 4 + 2]; a.w = acc[(q >> 1) * 8 + (q & 1) * 4 + 3];
                *(GAS f32x4*)(orow + c) = xv[i][q] + g * a; } } }
}

__device__ __forceinline__ void mk_frame(Frame& F, LAS unsigned char* lds, int wave_s) {
    int bx = blockIdx.x, G = gridDim.x; LAUNDER(bx); LAUNDER(G);
    F.lds = lds; F.MISC = (volatile LAS unsigned*)(lds + MISC_OFF); F.ctl = nullptr;
    unsigned ones_ = ~0u; asm volatile("" : "+s"(ones_));
    int lane_ = (int)__builtin_amdgcn_mbcnt_hi(ones_, __builtin_amdgcn_mbcnt_lo(ones_, 0u)); asm volatile("" : "+v"(lane_));
    F.lane = lane_; F.wave = wave_s; F.tid = wave_s * 64 + lane_;
    F.G = G; F.vcu = (G % 8 == 0) ? (bx % 8) * (G / 8) + bx / 8 : bx;
}
__global__ void __launch_bounds__(NWAVES * 64, 2) fwd_kernel(Args args) {
    extern __shared__ __attribute__((aligned(16))) unsigned char lds[];
    LAS unsigned char* const ldsb = (LAS unsigned char*)lds;
    ArgsP ap0 = (ArgsP)__builtin_amdgcn_kernarg_segment_ptr();
    int wave_s = __builtin_amdgcn_readfirstlane((int)threadIdx.x >> 6); asm volatile("" : "+s"(wave_s));
    for (int u = threadIdx.x; u < (LDS_BYTES - LDSCTL_OFF) / 4; u += NWAVES * 64) ((LAS unsigned*)(ldsb + LDSCTL_OFF))[u] = 0u;
    __syncthreads();
#define MKBAR XcdBarrier bar; { ArgsP a_ = ap0; LAUNDER(a_); bar.bar = (unsigned*)(a_->ws + WS_CTL) + CW_BAR; bar.x = xb_xcc_id(); bar.st = (volatile LAS unsigned*)(ldsb + MISC_OFF) + 8; }
#if ONE_LAUNCH
    { MKBAR; if (threadIdx.x == 0) (void)xb_add(&bar.bar[XB_XCNT(bar.x)], 1u); }
#ifndef PHM
#define PHM 0x3fff
#endif
#define IN(k) ((PHM >> (k)) & 1)
#define SEAM(k) do { if (IN(k) && IN((k) + 1)) { MKBAR; { unsigned o_ = ~0u; asm volatile("" : "+s"(o_)); xcd_barrier(bar, wave_s == 0 && __builtin_amdgcn_mbcnt_hi(o_, __builtin_amdgcn_mbcnt_lo(o_, 0u)) == 0u); } } } while (0)
#else
    int lo, hi; { ArgsP a = ap0; LAUNDER(a); lo = a->ph_lo; hi = a->ph_hi; }
#define IN(k) (lo <= (k) && (k) < hi)
#define SEAM(k) do { } while (0)
#endif
    typedef pg8::bf16_t pb;
#ifndef REPMASK
#define REPMASK 0
#endif
#define PHASE_ARGS ArgsP ap = ap0; LAUNDER(ap); unsigned char* ws = ap->ws; (void)ws; Frame F; mk_frame(F, ldsb, wave_s); const int gw = F.vcu * NWAVES + F.wave, NGW = F.G * NWAVES; (void)gw; (void)NGW
    if (IN(0)) _Pragma("unroll 1") for (int rep_ = 0; rep_ <= ((REPMASK >> 0) & 1); ++rep_) { PHASE_ARGS; p0_prologue(F, ap); } SEAM(0);
    if (IN(1)) _Pragma("unroll 1") for (int rep_ = 0; rep_ <= ((REPMASK >> 1) & 1); ++rep_) { PHASE_ARGS; const float* x = (const float*)ap->in[0]; const float* g1 = (const float*)ap->in[5]; const float* mod = (const float*)(ws + WS_MOD); bf16* XN = (bf16*)(ws + WS_XN);
#pragma unroll 1
        for (int wv = gw; wv < M / 16; wv += NGW) {
#pragma unroll 1
          for (int k4 = 0; k4 < 4; ++k4) { const int m = wv * 16 + 4 * k4; f32x4 u[4][4]; modnorm_rows<4, false>(x, m, 1, g1, mod, 0, 1024, XN, F.lane, u);
            if (F.lane < 32) { const int mm = m + (F.lane >> 3), j = F.lane & 7; const float pos = (float)((const int*)ap->in[2])[mm];
                const float ang = pos * __expf(-(float)j * 0.125f * 13.122363377404328f); const float sn = __sinf(ang), cs = __cosf(ang);
                bf16* rt = (bf16*)(ws + WS_ROPE) + (size_t)mm * 16; rt[j] = (bf16)(pk2(cs, 0.f) & 0xffffu); rt[8 + j] = (bf16)(pk2(sn, 0.f) & 0xffffu); } } } } SEAM(1);
    if (IN(2)) _Pragma("unroll 1") for (int rep_ = 0; rep_ <= ((REPMASK >> 2) & 1); ++rep_) { PHASE_ARGS; pg8::Gemm g{(const pb*)(ws + WS_XN), (const pb*)(ws + WS_WINT), M, NZP, D}; pg8::StaticOrder S; S.init(M, NZP, F.G, (int)blockIdx.x);
        pg8::EpiZ E{(pb*)(ws + WS_Z)}; pg8::gemm_phase<pg8::EpiZ, pg8::StaticOrder, true, true>(F.lds, g, S, E, F.tid); } SEAM(2);
    if (IN(3)) {
#ifndef REP_SCAN
#define REP_SCAN 1
#endif
#ifndef REP_ATTN
#define REP_ATTN 1
#endif
      { int c0_, G_; { Frame F0; mk_frame(F0, ldsb, wave_s); c0_ = F0.vcu; G_ = F0.G; }
#pragma unroll 1
        for (int c = c0_; c < 256 * REP_SCAN; c += G_) { PHASE_ARGS; const int b = (c >> 4) & 15, h = (c >> 1) & 7, dir = c & 1;
            scan2_setup(F.lds, (const GAS float*)ap->in[10], (const GAS float*)ap->in[12], h, dir, F.tid); __syncthreads();
            const ScanArgs SA{(const GAS bf16*)(ws + WS_Z), (const GAS float*)ap->in[7], (const GAS float*)ap->in[8], (const GAS float*)ap->in[9], (const GAS float*)ap->in[11], (const GAS float*)ap->in[14], (const GAS float*)ap->in[15], (const GAS float*)ap->in[16],
                              (GAS bf16*)(ws + WS_XN) + (size_t)dir * M * 512, (GAS float*)(ws + WS_BONUS) + (size_t)dir * M * 8};
#pragma unroll 1
            for (int cc = F.wave; cc < T / 32; cc += 8) scan2_chunk(F.lds, SA, b, h, dir, cc, F.lane, F.wave);
            __syncthreads(); } }
      { PHASE_ARGS;
#pragma unroll 1
        for (int u = F.vcu; u < 512 * REP_ATTN; u += F.G) { attn_unit(F, ap, (u >> 5) & 15, (u >> 4) & 1, u & 15); } }
      { PHASE_ARGS;
        const bf16* Z = (const bf16*)(ws + WS_Z); bf16* SGD = (bf16*)(ws + WS_SGD); const float* mu_prev = (const float*)ap->in[7]; const float* mu_next = (const float*)ap->in[8];
          const int c = ZGD + 2 * F.lane; const float mp0 = mu_prev[c], mp1 = mu_prev[c + 1], mn0 = mu_next[c], mn1 = mu_next[c + 1];
#ifndef REP_SGD
#define REP_SGD 1
#endif
          const int tile = F.vcu;
          if (tile < 256) { const int pm = tile >> 1, pn = tile & 1; constexpr int RS = 136;
              LAS bf16* SG = (LAS bf16*)F.lds; LAS bf16* GT = (LAS bf16*)(F.lds + 256 * RS * 2);
              __syncthreads();
              const int mt0 = pm * 256 + F.wave * 32;
#pragma unroll 1
              for (int m0 = 0; m0 < 32; m0 += 4) { unsigned z0[4], zm[4], zq[4];
#pragma unroll
                  for (int i = 0; i < 4; ++i) { const int m = mt0 + m0 + i, t = m & (T - 1);
                      z0[i] = *(const GAS unsigned*)(Z + (size_t)m * NZ + c); zm[i] = t > 0 ? *(const GAS unsigned*)(Z + (size_t)(m - 1) * NZ + c) : 0u; zq[i] = t < T - 1 ? *(const GAS unsigned*)(Z + (size_t)(m + 1) * NZ + c) : 0u; }
#pragma unroll
                  for (int i = 0; i < 4; ++i) { const float a0 = bflo(z0[i]), a1 = bfhi(z0[i]); const float s0 = a0 + mp0 * (bflo(zm[i]) - a0) + mn0 * (bflo(zq[i]) - a0), s1 = a1 + mp1 * (bfhi(zm[i]) - a1) + mn1 * (bfhi(zq[i]) - a1);
                      *(LAS unsigned*)(SG + (F.wave * 32 + m0 + i) * RS + 2 * F.lane) = pk2(sigm(s0), sigm(s1)); } }
              __syncthreads();
              const int r32 = F.lane & 31, hh = F.lane >> 5; bf16x8 af[8];
#pragma unroll
              for (int sI = 0; sI < 8; ++sI) af[sI] = *(const LAS bf16x8*)(SG + (F.wave * 32 + r32) * RS + 16 * sI + 8 * hh);
              bf16* Gout = (bf16*)(ws + WS_G); const bf16* G2T = (const bf16*)(ws + WS_G2T);
#pragma unroll 1
              for (int hf = 0; hf < 2; ++hf) {
#pragma unroll
                  for (int i = 0; i < 4; ++i) { const int e = F.tid + 512 * i, rr = e >> 4, ch = e & 15; *(LAS v4u*)(GT + rr * RS + ch * 8) = *(const GAS v4u*)(G2T + (size_t)(256 * pn + 128 * hf + rr) * 256 + ch * 8); }
                  __syncthreads();
#pragma unroll 1
                  for (int ct = 0; ct < 4; ++ct) { f32x16 acc = {};
#pragma unroll
                      for (int sI = 0; sI < 8; ++sI) { const bf16x8 bfr = *(const LAS bf16x8*)(GT + (32 * ct + r32) * RS + 16 * sI + 8 * hh); acc = __builtin_amdgcn_mfma_f32_32x32x16_bf16(af[sI], bfr, acc, 0, 0, 0); }
#pragma unroll
                      for (int g = 0; g < 16; ++g) { const int row = (g & 3) + 8 * (g >> 2) + 4 * hh;
                          Gout[(size_t)(mt0 + row) * 512 + 256 * pn + 128 * hf + 32 * ct + r32] = (bf16)(pk2(acc[g], 0.f) & 0xffffu); } }
                  __syncthreads(); } } }
    } SEAM(4);
#ifndef REP_PG
#define REP_PG 0
#endif
    if (IN(5)) { PHASE_ARGS; if (REP_PG) pg_rows(F, ap, (bf16*)ap->out); pg_rows(F, ap, (bf16*)(ws + WS_G)); } SEAM(5);
    if (IN(6)) { PHASE_ARGS; static_assert(WS_G == WS_OATT + (size_t)M * 512 * 2 && WS_PAT == WS_PRT + (size_t)1024 * 512 * 2, "merged operand views need adjacent buffers");
        pg8::Gemm g{(const pb*)(ws + WS_OATT), (const pb*)(ws + WS_PRT), 2 * M, 2048, 512}; pg8::MergeOrder S; S.init(F.G, (int)blockIdx.x);
        pg8::EpiGate2 E{(pb*)(ws + WS_XN), (const pb*)(ws + WS_Z)}; pg8::gemm_phase<pg8::EpiGate2, pg8::MergeOrder, true, true>(F.lds, g, S, E, F.tid); } SEAM(7);
    if (IN(8)) _Pragma("unroll 1") for (int rep_ = 0; rep_ <= ((REPMASK >> 8) & 1); ++rep_) { PHASE_ARGS; pg8::Gemm g{(const pb*)(ws + WS_XN), (const pb*)(ws + WS_WOT), M, 1024, 1024}; pg8::StaticOrder S; S.init(M, 1024, F.G, (int)blockIdx.x);
        pg8::EpiRes E{(const float*)ap->in[0], (const float*)(ws + WS_MOD), (pb*)(ws + WS_X1)}; pg8::gemm_phase<pg8::EpiRes, pg8::StaticOrder, true, true>(F.lds, g, S, E, F.tid); } SEAM(8);
    if (IN(9)) _Pragma("unroll 1") for (int rep_ = 0; rep_ <= ((REPMASK >> 9) & 1); ++rep_) { PHASE_ARGS; pj_phase(F, ap); } SEAM(9);
    if (IN(10)) _Pragma("unroll 1") for (int rep_ = 0; rep_ <= ((REPMASK >> 10) & 1); ++rep_) { PHASE_ARGS; for (int p = F.vcu; p < 256; p += F.G) pk_task(F, ap, p >> 4, p & 15); } SEAM(10);
    if (IN(11)) _Pragma("unroll 1") for (int rep_ = 0; rep_ <= ((REPMASK >> 11) & 1); ++rep_) { PHASE_ARGS; pg8::Gemm g{(const pb*)(ws + WS_XN), (const pb*)((unsigned char*)ap->out + OUT_WGUT), ME, 16 * 2048, 1024}; pg8::GroupOrder<8> S{F.G, (int)blockIdx.x};
        pg8::EpiSwiglu E{(pb*)(ws + WS_H)}; pg8::gemm_phase<pg8::EpiSwiglu, pg8::GroupOrder<8>, true, true, true>(F.lds, g, S, E, F.tid, (const int*)(ws + WS_SELIDX)); } SEAM(11);
    if (IN(12)) _Pragma("unroll 1") for (int rep_ = 0; rep_ <= ((REPMASK >> 12) & 1); ++rep_) { PHASE_ARGS; pg8::Gemm g{(const pb*)(ws + WS_H), (const pb*)((unsigned char*)ap->out + OUT_WDT), ME, 16 * 1024, 1024}; pg8::GroupOrder<4> S{F.G, (int)blockIdx.x};
        pg8::EpiDown E{(pb*)(ws + WS_XE), (const float*)(ws + WS_SELAFF)}; pg8::gemm_phase<pg8::EpiDown, pg8::GroupOrder<4>, true, true>(F.lds, g, S, E, F.tid); } SEAM(12);
#ifndef EXTRA_BARS
#define EXTRA_BARS 0
#endif
#if ONE_LAUNCH
    _Pragma("unroll 1") for (int xb_ = 0; xb_ < EXTRA_BARS; ++xb_) { MKBAR; { unsigned o_ = ~0u; asm volatile("" : "+s"(o_)); xcd_barrier(bar, wave_s == 0 && __builtin_amdgcn_mbcnt_hi(o_, __builtin_amdgcn_mbcnt_lo(o_, 0u)) == 0u); } }
#endif
#ifndef REP_PN
#define REP_PN 0
#endif
    if (IN(13)) { PHASE_ARGS; if (REP_PN) pn_rows(F, ap, (float*)(ws + WS_H)); pn_rows(F, ap, ap->out); }
#undef IN
#undef SEAM
}

extern "C" void kernel_launch(void* const* d_in, const int* in_sizes, int n_in, void* d_out, int out_size, void* d_ws, size_t ws_size, hipStream_t stream) {
    static int grid = 0;
    if (grid == 0) {
        if (n_in != 30 || out_size != M * D || ws_size < WS_END) { fprintf(stderr, "kernel_launch: unexpected shapes n_in %d out %d ws %zu\n", n_in, out_size, ws_size); grid = -1; return; }
        int dev = 0, cus = 0, per_cu = 0;
        if (hipGetDevice(&dev) != hipSuccess || hipDeviceGetAttribute(&cus, hipDeviceAttributeMultiprocessorCount, dev) != hipSuccess) { grid = -1; return; }
        if (hipFuncSetAttribute((const void*)fwd_kernel, hipFuncAttributeMaxDynamicSharedMemorySize, LDS_BYTES) != hipSuccess) { fprintf(stderr, "kernel_launch: hipFuncSetAttribute failed\n"); grid = -1; return; }
        if (hipOccupancyMaxActiveBlocksPerMultiprocessor(&per_cu, (const void*)fwd_kernel, NWAVES * 64, LDS_BYTES) != hipSuccess || per_cu < 1) fprintf(stderr, "kernel_launch: occupancy query reports %d\n", per_cu);
        (void)hipGetLastError();
        grid = cus;
    }
    if (grid < 0) return;
    if (hipMemsetAsync((char*)d_ws + WS_CTL, 0, CTL_ZERO_BYTES, stream) != hipSuccess) return;
    Args a{};
    for (int i = 0; i < 30; ++i) a.in[i] = d_in[i];
    a.out = (float*)d_out; a.ws = (unsigned char*)d_ws;
#if ONE_LAUNCH
    a.ph_lo = 0; a.ph_hi = NPHASE;
    hipLaunchKernelGGL(fwd_kernel, dim3(grid), dim3(NWAVES * 64), LDS_BYTES, stream, a);
#else
    for (int p = 0; p < NPHASE; ++p) { a.ph_lo = p; a.ph_hi = p + 1; hipLaunchKernelGGL(fwd_kernel, dim3(grid), dim3(NWAVES * 64), LDS_BYTES, stream, a); }
#endif
}
```

```cpp
#include <hip/hip_runtime.h>
#include <cstdio>
#include <cstdint>
#include <cmath>
namespace pg8 {
#define PG8_LAS __attribute__((address_space(3)))
typedef unsigned short bf16_t;
typedef short bf16x8 __attribute__((ext_vector_type(8)));
typedef float f32x4 __attribute__((ext_vector_type(4)));
typedef unsigned u32x4 __attribute__((ext_vector_type(4)));
constexpr int BM = 256, BK = 64, HALF = 128, HTB = HALF * BK * 2  , STAGE_BYTES = 8 * HTB, NXCD = 8, WGM = 4;

__host__ __device__ __forceinline__ int lds_byte(int r, int c) { const int st = (r >> 4) * 2 + (c >> 5), rr = r & 15, cc = c & 31, ob = rr * 64 + cc * 2; return st * 1024 + (ob ^ (((ob >> 9) & 1) << 5)); }
__host__ __device__ __forceinline__ void stage_rc(int b, int& R, int& C) { const int st = b / 1024, sb = b % 1024, swz = sb ^ (((sb >> 9) & 1) << 5); R = (st >> 1) * 16 + swz / 64; C = (st & 1) * 32 + (swz % 64) / 2; }
__host__ __device__ __forceinline__ int perm32(int rho) { const int n = rho >> 4, i = rho & 15; return 8 * (i >> 2) + 4 * n + (i & 3); }

struct Unit { int pm, pn; };
struct Gemm { const bf16_t* A; const bf16_t* Bt; int M, N, K; };

struct StaticOrder {
    int nM, nN, nwg, G, c;
    __host__ __device__ void init(int M, int N, int G_, int c_) { nM = M / BM; nN = N / BM; nwg = nM * nN; G = G_; c = c_; }
    __host__ __device__ bool next(int i, Unit& u) const {
        const long L = (long)i * G + c; if (L >= nwg) return false;
        int wgid = (int)L; { const int q = nwg / NXCD, r = nwg % NXCD, xcd = wgid % NXCD, off = wgid / NXCD; wgid = (xcd < r ? xcd * (q + 1) : r * (q + 1) + (xcd - r) * q) + off; }
        const int nig = WGM * nN, gid = wgid / nig, fm = gid * WGM, gsz = (nM - fm) < WGM ? (nM - fm) : WGM;
        u.pm = fm + ((wgid % nig) % gsz); u.pn = (wgid % nig) / gsz; return true;
    }
    __device__ __forceinline__ void a_ready(const Unit&) const {}
    __device__ __forceinline__ void done(const Unit&) const {}
};

__device__ __forceinline__ unsigned cvt_pk_bf16(float lo, float hi) { unsigned r; asm volatile("v_cvt_pk_bf16_f32 %0, %1, %2" : "=v"(r) : "v"(lo), "v"(hi)); return r; }
typedef float f32x2 __attribute__((ext_vector_type(2)));
template <class Epi, class Sched, bool ALIGN_EPI = false, bool SP2 = false, bool GATHER = false>
__device__ __forceinline__ void gemm_phase(PG8_LAS unsigned char* lds, const Gemm g, const Sched& S, const Epi& E, int tid_in, const int* gidx = nullptr) {
    static_assert(!GATHER || SP2, "the gather variant is written for the SP2 loop");
    int tid_ = tid_in; asm volatile("" : "+v"(tid_));
    const int tid = tid_, wid = __builtin_amdgcn_readfirstlane(tid >> 6), lane = tid & 63, wr = wid >> 2, wc = wid & 3, fr = lane & 15, fq = lane >> 4;
    const int K = g.K, nt = K / BK;
    unsigned voffA[2], voffB[2];
#pragma unroll
    for (int i = 0; i < 2; ++i) { int R, C; stage_rc(tid * 16 + i * 8192, R, C); const int Rb = Epi::PERM ? ((R & ~31) + perm32(R & 31)) : R;
        voffA[i] = (unsigned)(R * K + C) * 2u; voffB[i] = (unsigned)(Rb * K + C) * 2u; }
    int gRA[2] = {0, 0}; unsigned gCA[2] = {0u, 0u}; unsigned gc[2][2] = {{0u, 0u}, {0u, 0u}}, gn[2][2] = {{0u, 0u}, {0u, 0u}};
    if constexpr (GATHER) {
#pragma unroll
        for (int i = 0; i < 2; ++i) { int R, C; stage_rc(tid * 16 + i * 8192, R, C); gRA[i] = R; gCA[i] = (unsigned)C * 2u; } }
#define PG8_GLOAD(dst, un) do { _Pragma("unroll") for (int h_ = 0; h_ < 2; ++h_) _Pragma("unroll") for (int i_ = 0; i_ < 2; ++i_) \
        dst[h_][i_] = (unsigned)gidx[(un).pm * 256 + h_ * 128 + gRA[i_]] * (unsigned)(K * 2) + gCA[i_]; } while (0)
#define PG8_STAGE_G(bufoff, gbase, nx, h) do { unsigned vo_[2] = {(nx) ? gn[h][0] : gc[h][0], (nx) ? gn[h][1] : gc[h][1]}; PG8_STAGE(bufoff, gbase, vo_); } while (0)
    const size_t kstep = (size_t)(BK * 2);
    const size_t hstep = (size_t)HALF * K * 2;
    const size_t tstep = 2 * hstep;
    const unsigned ldsw = (unsigned)wid * 1024u;
    const int aoff = lds_byte(wr * 64 + fr, fq * 8), boff = lds_byte(wc * 32 + fr, fq * 8);
#define PG8_SA(b, h) (((b) * 2 + (h)) * HTB)
#define PG8_SB(b, h) ((4 + (b) * 2 + (h)) * HTB)
#define PG8_STAGE(bufoff, gbase, voff) do { _Pragma("unroll") for (int _i = 0; _i < 2; ++_i) \
        __builtin_amdgcn_global_load_lds((const unsigned*)((const char*)(gbase) + (voff)[_i]), (PG8_LAS unsigned*)(lds + (bufoff) + ldsw + _i * 8192), 16, 0, 0); } while (0)
#define PG8_LDA(dst, b, h) do { _Pragma("unroll") for (int m = 0; m < 4; ++m) _Pragma("unroll") for (int k = 0; k < 2; ++k) dst[m][k] = *(const PG8_LAS bf16x8*)(lds + PG8_SA(b, h) + aoff + m * 2048 + k * 1024); } while (0)
#define PG8_LDB(dst, b, h) do { _Pragma("unroll") for (int n = 0; n < 2; ++n) _Pragma("unroll") for (int k = 0; k < 2; ++k) dst[n][k] = *(const PG8_LAS bf16x8*)(lds + PG8_SB(b, h) + boff + n * 2048 + k * 1024); } while (0)
#define PG8_MMA(ai, bj, At, Bt) do { __builtin_amdgcn_s_setprio(1); _Pragma("unroll") for (int m = 0; m < 4; ++m) _Pragma("unroll") for (int n = 0; n < 2; ++n) _Pragma("unroll") for (int k = 0; k < 2; ++k) \
        acc[ai][bj][m][n] = __builtin_amdgcn_mfma_f32_16x16x32_bf16(Bt[n][k], At[m][k], acc[ai][bj][m][n], 0, 0, 0); __builtin_amdgcn_s_setprio(0); } while (0)
#define PG8_WAIT_V(n) asm volatile("s_waitcnt vmcnt(" #n ")" ::: "memory")
#define PG8_WAIT_L(n) asm volatile("s_waitcnt lgkmcnt(" #n ")" ::: "memory")
#define PG8_BAR __builtin_amdgcn_s_barrier()
#define PG8_SCHED __builtin_amdgcn_sched_barrier(0)
    Unit cur, nxt; int ui = 0;
    if (!S.next(0, cur)) return;
    f32x4 acc[2][2][4][2];
#pragma unroll
    for (int a = 0; a < 2; ++a)
#pragma unroll
        for (int b = 0; b < 2; ++b)
#pragma unroll
            for (int m = 0; m < 4; ++m)
#pragma unroll
                for (int n = 0; n < 2; ++n) acc[a][b][m][n] = (f32x4){0.f, 0.f, 0.f, 0.f};
    bf16x8 At[4][2], B0[2][2], B1[2][2];
    const char* cA = GATHER ? (const char*)g.A : (const char*)g.A + (size_t)cur.pm * tstep; const char* cB = (const char*)g.Bt + (size_t)cur.pn * tstep;
    if constexpr (GATHER) { PG8_GLOAD(gc, cur); Unit n1_; if (S.next(1, n1_)) PG8_GLOAD(gn, n1_); else { gn[0][0] = gc[0][0]; gn[0][1] = gc[0][1]; gn[1][0] = gc[1][0]; gn[1][1] = gc[1][1]; } }
    S.a_ready(cur);
    if constexpr (SP2) {
        PG8_STAGE(PG8_SB(0, 0), cB, voffB); PG8_STAGE(PG8_SB(0, 1), cB + hstep, voffB);
        if constexpr (GATHER) { PG8_STAGE_G(PG8_SA(0, 0), cA, false, 0); PG8_STAGE_G(PG8_SA(0, 1), cA, false, 1); } else { PG8_STAGE(PG8_SA(0, 0), cA, voffA); PG8_STAGE(PG8_SA(0, 1), cA + hstep, voffA); }
        if (wr == 1) PG8_BAR;
        PG8_WAIT_V(2); PG8_BAR;
        PG8_STAGE(PG8_SB(1, 0), cB + kstep, voffB); if constexpr (GATHER) PG8_STAGE_G(PG8_SA(1, 0), cA + kstep, false, 0); else PG8_STAGE(PG8_SA(1, 0), cA + kstep, voffA); PG8_STAGE(PG8_SB(1, 1), cB + hstep + kstep, voffB);
        PG8_WAIT_V(6); PG8_BAR;
    } else {
        PG8_STAGE(PG8_SB(0, 0), cB, voffB); PG8_STAGE(PG8_SA(0, 0), cA, voffA); PG8_STAGE(PG8_SB(0, 1), cB + hstep, voffB); PG8_STAGE(PG8_SA(0, 1), cA + hstep, voffA);
        if (wr == 1) PG8_BAR;
        PG8_WAIT_V(4); PG8_BAR;
        PG8_STAGE(PG8_SB(1, 0), cB + kstep, voffB); PG8_STAGE(PG8_SA(1, 0), cA + kstep, voffA); PG8_STAGE(PG8_SB(1, 1), cB + hstep + kstep, voffB);
        PG8_WAIT_V(6); PG8_BAR;
    }
    for (;;) {
        const bool has_next = S.next(ui + 1, nxt);
        if constexpr (GATHER) { if (!has_next) { gn[0][0] = gc[0][0]; gn[0][1] = gc[0][1]; gn[1][0] = gc[1][0]; gn[1][1] = gc[1][1]; } }
        const char* nA = (has_next && !GATHER) ? (const char*)g.A + (size_t)nxt.pm * tstep : cA; const char* nB = has_next ? (const char*)g.Bt + (size_t)nxt.pn * tstep : cB;
        for (int t = 0; t < nt; t += 2) {
            const bool last = (t == nt - 2);
            const char* a1 = cA + (size_t)(t + 1) * kstep;
            const char* a2 = last ? nA : cA + (size_t)(t + 2) * kstep; const char* b2 = last ? nB : cB + (size_t)(t + 2) * kstep;
            const char* a3 = a2 + kstep; const char* b3 = b2 + kstep;
            if (last && has_next) S.a_ready(nxt);
            if constexpr (SP2) {
            PG8_LDB(B0, 0, 0); PG8_LDB(B1, 0, 1); PG8_SCHED; PG8_LDA(At, 0, 0); if constexpr (GATHER) PG8_STAGE_G(PG8_SA(1, 1), a1, false, 1); else PG8_STAGE(PG8_SA(1, 1), a1 + hstep, voffA);
            PG8_WAIT_V(8); PG8_WAIT_L(0); PG8_BAR; PG8_MMA(0, 0, At, B0); PG8_MMA(0, 1, At, B1); PG8_BAR; PG8_SCHED;
            PG8_LDA(At, 0, 1); PG8_STAGE(PG8_SB(0, 0), b2, voffB); PG8_STAGE(PG8_SB(0, 1), b2 + hstep, voffB); if constexpr (GATHER) PG8_STAGE_G(PG8_SA(0, 0), a2, last, 0); else PG8_STAGE(PG8_SA(0, 0), a2, voffA);
            PG8_WAIT_V(8); PG8_WAIT_L(0); PG8_BAR; PG8_MMA(1, 0, At, B0); PG8_MMA(1, 1, At, B1); PG8_BAR; PG8_SCHED;
            PG8_LDB(B0, 1, 0); PG8_LDB(B1, 1, 1); PG8_SCHED; PG8_LDA(At, 1, 0); if constexpr (GATHER) PG8_STAGE_G(PG8_SA(0, 1), a2, last, 1); else PG8_STAGE(PG8_SA(0, 1), a2 + hstep, voffA);
            PG8_WAIT_V(8); PG8_WAIT_L(0); PG8_BAR; PG8_MMA(0, 0, At, B0); PG8_MMA(0, 1, At, B1); PG8_BAR; PG8_SCHED;
            PG8_LDA(At, 1, 1); PG8_STAGE(PG8_SB(1, 0), b3, voffB); PG8_STAGE(PG8_SB(1, 1), b3 + hstep, voffB); if constexpr (GATHER) PG8_STAGE_G(PG8_SA(1, 0), a3, last, 0); else PG8_STAGE(PG8_SA(1, 0), a3, voffA);
            PG8_WAIT_V(8); PG8_WAIT_L(0); PG8_BAR; PG8_MMA(1, 0, At, B0); PG8_MMA(1, 1, At, B1); PG8_BAR; PG8_SCHED;
            } else {
            PG8_LDB(B0, 0, 0); PG8_SCHED; PG8_LDA(At, 0, 0); PG8_STAGE(PG8_SA(1, 1), a1 + hstep, voffA);
            PG8_WAIT_L(8); PG8_BAR; PG8_WAIT_L(0); PG8_MMA(0, 0, At, B0); PG8_BAR; PG8_SCHED;
            PG8_LDB(B1, 0, 1); PG8_STAGE(PG8_SB(0, 0), b2, voffB);
            PG8_BAR; PG8_WAIT_L(0); PG8_MMA(0, 1, At, B1); PG8_BAR;
            PG8_LDA(At, 0, 1); PG8_STAGE(PG8_SA(0, 0), a2, voffA);
            PG8_BAR; PG8_WAIT_L(0); PG8_MMA(1, 0, At, B0); PG8_BAR; PG8_SCHED;
            PG8_STAGE(PG8_SB(0, 1), b2 + hstep, voffB);
            PG8_WAIT_V(6); PG8_BAR; PG8_MMA(1, 1, At, B1); PG8_BAR;
            PG8_LDB(B0, 1, 0); PG8_SCHED; PG8_LDA(At, 1, 0); PG8_STAGE(PG8_SA(0, 1), a2 + hstep, voffA);
            PG8_WAIT_L(8); PG8_BAR; PG8_WAIT_L(0); PG8_MMA(0, 0, At, B0); PG8_BAR; PG8_SCHED;
            PG8_LDB(B1, 1, 1); PG8_STAGE(PG8_SB(1, 0), b3, voffB);
            PG8_BAR; PG8_WAIT_L(0); PG8_MMA(0, 1, At, B1); PG8_BAR;
            PG8_LDA(At, 1, 1); PG8_STAGE(PG8_SA(1, 0), a3, voffA);
            PG8_BAR; PG8_WAIT_L(0); PG8_MMA(1, 0, At, B0); PG8_BAR; PG8_SCHED;
            PG8_STAGE(PG8_SB(1, 1), b3 + hstep, voffB);
            PG8_WAIT_V(6); PG8_BAR; PG8_MMA(1, 1, At, B1); PG8_BAR;
            }
        }
        if constexpr (ALIGN_EPI) { if (wr == 0) PG8_BAR; }
#ifdef REP_EPI
        if constexpr (!Epi::AFTER_DRAIN) { E(acc, cur, wr, wc, fr, fq); asm volatile("" ::: "memory"); }
#endif
        if constexpr (!Epi::AFTER_DRAIN) { E(acc, cur, wr, wc, fr, fq); S.done(cur); }
        unsigned g2_[2][2] = {{0u, 0u}, {0u, 0u}};
        if constexpr (GATHER) { Unit nn_; if (has_next && S.next(ui + 2, nn_)) PG8_GLOAD(g2_, nn_); else { g2_[0][0] = gn[0][0]; g2_[0][1] = gn[0][1]; g2_[1][0] = gn[1][0]; g2_[1][1] = gn[1][1]; } }
        if (!has_next) break;
#pragma unroll
        for (int a = 0; a < 2; ++a)
#pragma unroll
            for (int b = 0; b < 2; ++b)
#pragma unroll
                for (int m = 0; m < 4; ++m)
#pragma unroll
                    for (int n = 0; n < 2; ++n) acc[a][b][m][n] = (f32x4){0.f, 0.f, 0.f, 0.f};
        cur = nxt; cA = nA; cB = nB; ++ui;
        if constexpr (GATHER) { gc[0][0] = gn[0][0]; gc[0][1] = gn[0][1]; gc[1][0] = gn[1][0]; gc[1][1] = gn[1][1]; gn[0][0] = g2_[0][0]; gn[0][1] = g2_[0][1]; gn[1][0] = g2_[1][0]; gn[1][1] = g2_[1][1]; }
        if constexpr (ALIGN_EPI) { if (wr == 1) PG8_BAR; }
    }
    PG8_WAIT_V(0);
    if constexpr (!ALIGN_EPI) { if (wr == 0) PG8_BAR; }
    PG8_BAR;
    if constexpr (Epi::AFTER_DRAIN) { E.fused(acc, cur, wr, wc, fr, fq, lds, wid, lane); S.done(cur); }
#undef PG8_SA
#undef PG8_SB
#undef PG8_STAGE
#undef PG8_STAGE_G
#undef PG8_GLOAD
#undef PG8_LDA
#undef PG8_LDB
#undef PG8_MMA
#undef PG8_WAIT_V
#undef PG8_WAIT_L
#undef PG8_BAR
#undef PG8_SCHED
}
}

#ifndef ONE_LAUNCH
#define ONE_LAUNCH 1
#endif
constexpr int NB = 16, T = 2048, D = 1024, M = NB * T;
constexpr int NZ = 4736, NZP = 4864;
constexpr int RW = 512, NE = 16, CAP = 256, ME = NE * NB * CAP;
constexpr int ZR = 0, ZK = 512, ZV = 1024, ZWD = 1536, ZAD = 1664, ZGD = 1792, ZQ = 1920, ZKA = 2432, ZVA = 2560, ZGA = 2688, ZGB = 3712;
constexpr int NWAVES = 8, NPHASE = 14;
constexpr size_t MiB = 1u << 20;
constexpr size_t WS_CTL = 0, CTL_ZERO_BYTES = 64 * 1024 + 16 * 6144 * 4;
constexpr size_t WS_MOD = 64 * 1024, WS_BONUS = 2 * MiB, WS_AFF = 4 * MiB, WS_SELAFF = 6 * MiB, WS_SLOT = 7 * MiB, WS_G2T = 9 * MiB;
constexpr size_t WS_WINT = 10 * MiB, WS_PRT = 20 * MiB, WS_PAT = 21 * MiB, WS_WOT = 22 * MiB, WS_SGD = 24 * MiB;
constexpr size_t WS_XN = 40 * MiB;
constexpr size_t WS_OATT = 104 * MiB;
constexpr size_t WS_G = 136 * MiB;
constexpr size_t WS_Z = 168 * MiB;
constexpr size_t WS_X1 = 104 * MiB;
constexpr size_t OUT_WGUT = 0;
constexpr size_t OUT_WDT = 64 * MiB;
constexpr size_t WS_XE = 200 * MiB;
constexpr size_t WS_H = 328 * MiB;
constexpr size_t WS_END = 464 * MiB;
constexpr size_t WS_ROPE = WS_AFF;
constexpr size_t WS_SELIDX = WS_SELAFF + 512 * 1024;
constexpr int CW_BAR = 4096;
constexpr int RING_BYTES = 131072, LDSCTL_OFF = RING_BYTES, MISC_OFF = LDSCTL_OFF + 320, LDS_BYTES = 147456;

#define GAS __attribute__((address_space(1)))
#define LAS __attribute__((address_space(3)))
typedef unsigned short bf16;
typedef unsigned v4u __attribute__((ext_vector_type(4)));
typedef float f32x4 __attribute__((ext_vector_type(4)));
typedef short bf16x8 __attribute__((ext_vector_type(8)));
typedef GAS unsigned gu32;
typedef GAS unsigned long long gu64;
#define RLX_AGENT __ATOMIC_RELAXED, __HIP_MEMORY_SCOPE_AGENT
#define LDS_WAIT() asm volatile("s_waitcnt lgkmcnt(0)" ::: "memory")
#define VM_WAIT() asm volatile("s_waitcnt vmcnt(0)" ::: "memory")
__device__ __forceinline__ unsigned long long rt() { return __builtin_amdgcn_s_memrealtime(); }
__device__ __forceinline__ unsigned f2bf(float f) { unsigned u = __builtin_bit_cast(unsigned, f); return (u + 0x7fffu + ((u >> 16) & 1u)) >> 16; }
typedef float f32x2hw __attribute__((ext_vector_type(2))); typedef __bf16 bf16x2hw __attribute__((ext_vector_type(2)));
__device__ __forceinline__ unsigned pk2(float lo, float hi) { f32x2hw v = {lo, hi}; bf16x2hw b = __builtin_convertvector(v, bf16x2hw); return __builtin_bit_cast(unsigned, b); }

#define XB_TMO      128
#define XB_XCNT(j)  (256  + 64 * (j))
#define XB_XSUB(j)  (1280 + 64 * (j))
#define XB_XGEN(j)  (2304 + 64 * (j))
#define XB_TOP      3328
#define XB_TOPGEN   3392
#define XCD_BAR_WORDS 3456
#define XB_SPIN_CAP (1u << 18)

__device__ __forceinline__ unsigned xb_ld(unsigned* p)              { return __hip_atomic_load(p, __ATOMIC_RELAXED, __HIP_MEMORY_SCOPE_AGENT); }
__device__ __forceinline__ unsigned xb_add(unsigned* p, unsigned v) { return __hip_atomic_fetch_add(p, v, __ATOMIC_RELAXED, __HIP_MEMORY_SCOPE_AGENT); }
__device__ __forceinline__ unsigned xb_xcc_id() { return (unsigned)__builtin_amdgcn_s_getreg((3 << 11) | 20) & 0xFu; }
#define XB_SPIN(cond, bar) do { unsigned _sp = 0; while (cond) { __builtin_amdgcn_s_sleep(1); \
    if ((++_sp & 255u) == 0u) { if (xb_ld(&(bar)[XB_TMO])) break; if (_sp > XB_SPIN_CAP) { atomicAdd(&(bar)[XB_TMO], 1u); break; } } } } while (0)

struct XcdBarrier {
    unsigned* bar; unsigned x;
    volatile LAS unsigned* st;
};

__device__ __forceinline__ XcdBarrier xcd_barrier_post(unsigned* bar, volatile LAS unsigned* st) {
    XcdBarrier b; b.bar = bar; b.x = xb_xcc_id(); b.st = st;
    if (threadIdx.x == 0) (void)xb_add(&bar[XB_XCNT(b.x)], 1u);
    return b;
}
__device__ __forceinline__ void xcd_barrier_complete(unsigned* bar, unsigned x, unsigned& nloc, unsigned& nx) {
    const unsigned G = gridDim.x * gridDim.y * gridDim.z;
    unsigned sum, cnt, mine, sp = 0u;
    for (;;) {
        sum = 0u; cnt = 0u; mine = 0u;
#pragma unroll
        for (unsigned j = 0; j < 16; ++j) { const unsigned c = xb_ld(&bar[XB_XCNT(j)]); sum += c; cnt += (c > 0u) ? 1u : 0u; mine = (j == x) ? c : mine; }
        if (sum == G) break;
        __builtin_amdgcn_s_sleep(1);
        if ((++sp & 255u) == 0u) { if (xb_ld(&bar[XB_TMO])) break; if (sp > XB_SPIN_CAP) { atomicAdd(&bar[XB_TMO], 1u); break; } }
    }
    nloc = mine > 0u ? mine : 1u; nx = cnt > 0u ? cnt : 1u;
}

__device__ __forceinline__ void xcd_barrier(const XcdBarrier& b, bool is_thread0) {
    asm volatile("s_waitcnt vmcnt(0)" ::: "memory");
    __syncthreads();
    if (is_thread0) {
        unsigned* bar = b.bar;
        __builtin_amdgcn_s_waitcnt(0);
        unsigned nloc = b.st[0], nx = b.st[1];
        if (nloc == 0u) { xcd_barrier_complete(bar, b.x, nloc, nx); b.st[0] = nloc; b.st[1] = nx; }
        const unsigned old = xb_add(&bar[XB_XSUB(b.x)], 1u);
        const unsigned gen = old / nloc;
        if (old + 1u == (gen + 1u) * nloc) {
            __builtin_amdgcn_fence(__ATOMIC_RELEASE, "agent");
            asm volatile("s_waitcnt vmcnt(0)" ::: "memory");
            const unsigned og = xb_add(&bar[XB_TOP], 1u);
            const unsigned tg = og / nx;
            if (og + 1u == (tg + 1u) * nx) xb_add(&bar[XB_TOPGEN], 1u);
            else XB_SPIN(xb_ld(&bar[XB_TOPGEN]) == tg, bar);
            __builtin_amdgcn_fence(__ATOMIC_ACQUIRE, "agent");
            xb_add(&bar[XB_XGEN(b.x)], 1u);
            asm volatile("s_waitcnt vmcnt(0)" ::: "memory");
        } else {
            XB_SPIN(xb_ld(&bar[XB_XGEN(b.x)]) == gen, bar);
            __builtin_amdgcn_fence(__ATOMIC_ACQUIRE, "agent");
            asm volatile("s_waitcnt vmcnt(0)" ::: "memory");
        }
    }
    __syncthreads();
}
namespace pg8 {
__device__ __forceinline__ float bf2f(unsigned short h) { return __uint_as_float(((unsigned)h) << 16); }
__device__ __forceinline__ float bflo(unsigned w) { return __uint_as_float(w << 16); }
__device__ __forceinline__ float bfhi(unsigned w) { return __uint_as_float(w & 0xffff0000u); }
__device__ __forceinline__ float sigm(float x) { return 1.0f / (1.0f + __expf(-x)); }
struct EpiZ { static constexpr bool PERM = true, AFTER_DRAIN = false; bf16_t* O;
    __device__ __forceinline__ void operator()(const f32x4 (&acc)[2][2][4][2], const Unit& u, int wr, int wc, int fr, int fq) const {
        const int row0 = u.pm * BM + wr * 64 + fr, col0 = u.pn * BM + wc * 32 + 8 * fq;
#pragma unroll
        for (int ai = 0; ai < 2; ++ai)
#pragma unroll
            for (int m = 0; m < 4; ++m) { bf16_t* rowp = O + (size_t)(row0 + ai * HALF + m * 16) * 4736 + col0;
#pragma unroll
                for (int bj = 0; bj < 2; ++bj) { if (u.pn * BM + bj * HALF < 4736) { const f32x4 v0 = acc[ai][bj][m][0], v1 = acc[ai][bj][m][1];
                    u32x4 w; w.x = cvt_pk_bf16(v0[0], v0[1]); w.y = cvt_pk_bf16(v0[2], v0[3]); w.z = cvt_pk_bf16(v1[0], v1[1]); w.w = cvt_pk_bf16(v1[2], v1[3]);
                    *(u32x4*)(rowp + bj * HALF) = w; } } }
    }
};
struct EpiPlain { static constexpr bool PERM = true, AFTER_DRAIN = false; bf16_t* O; int ldc;
    __device__ __forceinline__ void operator()(const f32x4 (&acc)[2][2][4][2], const Unit& u, int wr, int wc, int fr, int fq) const {
        const int row0 = u.pm * BM + wr * 64 + fr, col0 = u.pn * BM + wc * 32 + 8 * fq;
#pragma unroll
        for (int ai = 0; ai < 2; ++ai)
#pragma unroll
            for (int m = 0; m < 4; ++m) { bf16_t* rowp = O + (size_t)(row0 + ai * HALF + m * 16) * ldc + col0;
#pragma unroll
                for (int bj = 0; bj < 2; ++bj) { const f32x4 v0 = acc[ai][bj][m][0], v1 = acc[ai][bj][m][1];
                    u32x4 w; w.x = cvt_pk_bf16(v0[0], v0[1]); w.y = cvt_pk_bf16(v0[2], v0[3]); w.z = cvt_pk_bf16(v1[0], v1[1]); w.w = cvt_pk_bf16(v1[2], v1[3]);
                    *(u32x4*)(rowp + bj * HALF) = w; } }
    }
};
template <bool ADD> struct EpiGate { static constexpr bool PERM = true, AFTER_DRAIN = false; bf16_t* O; const bf16_t* Z; int zc0;
    __device__ __forceinline__ void operator()(const f32x4 (&acc)[2][2][4][2], const Unit& u, int wr, int wc, int fr, int fq) const {
        const int row0 = u.pm * BM + wr * 64 + fr, col0 = u.pn * BM + wc * 32 + 8 * fq;
#pragma unroll
        for (int ai = 0; ai < 2; ++ai)
#pragma unroll
            for (int m = 0; m < 4; ++m) { const size_t row = (size_t)(row0 + ai * HALF + m * 16); bf16_t* rowp = O + row * 1024 + col0; const bf16_t* zp = Z + row * 4736 + zc0 + col0;
#pragma unroll
                for (int bj = 0; bj < 2; ++bj) { const f32x4 v0 = acc[ai][bj][m][0], v1 = acc[ai][bj][m][1];
                    const u32x4 zg = *(const u32x4*)(zp + bj * HALF);
                    float r0 = sigm(bflo(zg.x)) * v0[0], r1 = sigm(bfhi(zg.x)) * v0[1], r2 = sigm(bflo(zg.y)) * v0[2], r3 = sigm(bfhi(zg.y)) * v0[3];
                    float r4 = sigm(bflo(zg.z)) * v1[0], r5 = sigm(bfhi(zg.z)) * v1[1], r6 = sigm(bflo(zg.w)) * v1[2], r7 = sigm(bfhi(zg.w)) * v1[3];
                    if (ADD) { const u32x4 p = *(const u32x4*)(rowp + bj * HALF);
                        r0 += bflo(p.x); r1 += bfhi(p.x); r2 += bflo(p.y); r3 += bfhi(p.y); r4 += bflo(p.z); r5 += bfhi(p.z); r6 += bflo(p.w); r7 += bfhi(p.w); }
                    u32x4 w; w.x = cvt_pk_bf16(r0, r1); w.y = cvt_pk_bf16(r2, r3); w.z = cvt_pk_bf16(r4, r5); w.w = cvt_pk_bf16(r6, r7);
                    *(u32x4*)(rowp + bj * HALF) = w; } }
    }
};
struct EpiGate2 { static constexpr bool PERM = true, AFTER_DRAIN = false; bf16_t* O; const bf16_t* Z;
    __device__ __forceinline__ void operator()(const f32x4 (&acc)[2][2][4][2], const Unit& u, int wr, int wc, int fr, int fq) const {
        const bool add = u.pm < 128; const int zc0 = add ? 3712 : 2688;
        const int row0 = (u.pm & 127) * BM + wr * 64 + fr, col0 = (u.pn & 3) * BM + wc * 32 + 8 * fq;
#pragma unroll
        for (int ai = 0; ai < 2; ++ai) {
            u32x4 zg[4][2], pv[4][2];
#pragma unroll
            for (int m = 0; m < 4; ++m) { const size_t row = (size_t)(row0 + ai * HALF + m * 16);
#pragma unroll
                for (int bj = 0; bj < 2; ++bj) { zg[m][bj] = *(const u32x4*)(Z + row * 4736 + zc0 + col0 + bj * HALF); pv[m][bj] = (u32x4){0u, 0u, 0u, 0u}; if (add) pv[m][bj] = *(const u32x4*)(O + row * 1024 + col0 + bj * HALF); } }
#pragma unroll
            for (int m = 0; m < 4; ++m) { const size_t row = (size_t)(row0 + ai * HALF + m * 16); bf16_t* rowp = O + row * 1024 + col0;
#pragma unroll
                for (int bj = 0; bj < 2; ++bj) { const f32x4 v0 = acc[ai][bj][m][0], v1 = acc[ai][bj][m][1]; const u32x4 g = zg[m][bj], p = pv[m][bj];
                    const float r0 = sigm(bflo(g.x)) * v0[0] + bflo(p.x), r1 = sigm(bfhi(g.x)) * v0[1] + bfhi(p.x), r2 = sigm(bflo(g.y)) * v0[2] + bflo(p.y), r3 = sigm(bfhi(g.y)) * v0[3] + bfhi(p.y);
                    const float r4 = sigm(bflo(g.z)) * v1[0] + bflo(p.z), r5 = sigm(bfhi(g.z)) * v1[1] + bfhi(p.z), r6 = sigm(bflo(g.w)) * v1[2] + bflo(p.w), r7 = sigm(bfhi(g.w)) * v1[3] + bfhi(p.w);
                    u32x4 w; w.x = cvt_pk_bf16(r0, r1); w.y = cvt_pk_bf16(r2, r3); w.z = cvt_pk_bf16(r4, r5); w.w = cvt_pk_bf16(r6, r7);
                    *(u32x4*)(rowp + bj * HALF) = w; } } }
    }
};
struct MergeOrder { StaticOrder S; int nu;
    __device__ __forceinline__ void init(int G, int c) { S.init(32768, 1024, G, c); nu = (512 - c + G - 1) / G; }
    __device__ __forceinline__ bool next(int i, Unit& u) const { if (i >= 2 * nu) return false; Unit t; S.next(i < nu ? i : i - nu, t);
        if (i < nu) { u.pm = 128 + t.pm; u.pn = t.pn; } else { u.pm = t.pm; u.pn = 4 + t.pn; } return true; }
    __device__ __forceinline__ void a_ready(const Unit&) const {}
    __device__ __forceinline__ void done(const Unit&) const {}
};
struct EpiRes { static constexpr bool PERM = true, AFTER_DRAIN = false; const float* X; const float* mod; bf16_t* O;
    __device__ __forceinline__ void operator()(const f32x4 (&acc)[2][2][4][2], const Unit& u, int wr, int wc, int fr, int fq) const {
        const int row0 = u.pm * BM + wr * 64 + fr, col0 = u.pn * BM + wc * 32 + 8 * fq; const int b = (u.pm * BM) >> 11;
        f32x4 gt[2][2];
#pragma unroll
        for (int bj = 0; bj < 2; ++bj)
#pragma unroll
            for (int n = 0; n < 2; ++n) gt[bj][n] = *(const f32x4*)(mod + (size_t)b * 6144 + 2048 + col0 + bj * HALF + n * 4);
#pragma unroll
        for (int ai = 0; ai < 2; ++ai) { f32x4 xv[4][2][2];
#pragma unroll
            for (int m = 0; m < 4; ++m) { const size_t off = (size_t)(row0 + ai * HALF + m * 16) * 1024 + col0;
#pragma unroll
                for (int bj = 0; bj < 2; ++bj) { xv[m][bj][0] = *(const f32x4*)(X + off + bj * HALF); xv[m][bj][1] = *(const f32x4*)(X + off + bj * HALF + 4); } }
#pragma unroll
            for (int m = 0; m < 4; ++m) { const size_t off = (size_t)(row0 + ai * HALF + m * 16) * 1024 + col0;
#pragma unroll
                for (int bj = 0; bj < 2; ++bj) { const f32x4 v0 = xv[m][bj][0] + gt[bj][0] * acc[ai][bj][m][0], v1 = xv[m][bj][1] + gt[bj][1] * acc[ai][bj][m][1];
                    u32x4 w; w.x = cvt_pk_bf16(v0[0], v0[1]); w.y = cvt_pk_bf16(v0[2], v0[3]); w.z = cvt_pk_bf16(v1[0], v1[1]); w.w = cvt_pk_bf16(v1[2], v1[3]);
                    *(u32x4*)(O + off + bj * HALF) = w; } } }
    }
};
template <int NPL> struct GroupOrder { int G, c;
    __device__ __forceinline__ bool next(int i, Unit& u) const { const int L = i * G + c; if (L >= 256 * NPL) return false;
        if (G == 256) {
            const int q = i * 32 + (c >> 3), e = (c & 7) * 2 + q / (16 * NPL), r = q % (16 * NPL), rho = r >> 5, j = r & 31;
            u.pm = e * 16 + (rho & 1) * 8 + (j & 7); u.pn = e * NPL + (rho >> 1) * 4 + (j >> 3); return true; }
        const int e = L / (16 * NPL), r = L % (16 * NPL); u.pm = e * 16 + (r % 16); u.pn = e * NPL + r / 16; return true; }
    __device__ __forceinline__ void a_ready(const Unit&) const {}
    __device__ __forceinline__ void done(const Unit&) const {}
};
struct EpiSwiglu { static constexpr bool PERM = true, AFTER_DRAIN = false; bf16_t* O;
    __device__ __forceinline__ void operator()(const f32x4 (&acc)[2][2][4][2], const Unit& u, int wr, int wc, int fr, int fq) const {
        const int row0 = u.pm * BM + wr * 64 + fr, col0 = (u.pn & 7) * 128 + wc * 32 + 8 * fq;
#pragma unroll
        for (int ai = 0; ai < 2; ++ai)
#pragma unroll
            for (int m = 0; m < 4; ++m) { bf16_t* rowp = O + (size_t)(row0 + ai * HALF + m * 16) * 1024 + col0;
                float r[8];
#pragma unroll
                for (int n = 0; n < 2; ++n)
#pragma unroll
                    for (int i = 0; i < 4; ++i) { const float g = acc[ai][0][m][n][i], up = acc[ai][1][m][n][i]; r[n * 4 + i] = g * sigm(g) * up; }
                u32x4 w; w.x = cvt_pk_bf16(r[0], r[1]); w.y = cvt_pk_bf16(r[2], r[3]); w.z = cvt_pk_bf16(r[4], r[5]); w.w = cvt_pk_bf16(r[6], r[7]);
                *(u32x4*)rowp = w; }
    }
};
struct EpiDown { static constexpr bool PERM = true, AFTER_DRAIN = false; bf16_t* O; const float* aff;
    __device__ __forceinline__ void operator()(const f32x4 (&acc)[2][2][4][2], const Unit& u, int wr, int wc, int fr, int fq) const {
        const int row0 = u.pm * BM + wr * 64 + fr, col0 = (u.pn & 3) * BM + wc * 32 + 8 * fq;
        float av[2][4];
#pragma unroll
        for (int ai = 0; ai < 2; ++ai)
#pragma unroll
            for (int m = 0; m < 4; ++m) av[ai][m] = aff[row0 + ai * HALF + m * 16];
#pragma unroll
        for (int ai = 0; ai < 2; ++ai)
#pragma unroll
            for (int m = 0; m < 4; ++m) { const int row = row0 + ai * HALF + m * 16; const float a = av[ai][m]; bf16_t* rowp = O + (size_t)row * 1024 + col0;
#pragma unroll
                for (int bj = 0; bj < 2; ++bj) { const f32x4 v0 = acc[ai][bj][m][0] * a, v1 = acc[ai][bj][m][1] * a;
                    u32x4 w; w.x = cvt_pk_bf16(v0[0], v0[1]); w.y = cvt_pk_bf16(v0[2], v0[3]); w.z = cvt_pk_bf16(v1[0], v1[1]); w.w = cvt_pk_bf16(v1[2], v1[3]);
                    *(u32x4*)(rowp + bj * HALF) = w; } }
    }
};
}

struct Frame { LAS unsigned char* lds; volatile LAS unsigned* MISC; gu32* ctl; int tid, lane, wave, vcu, G; };
struct Args { const void* in[30]; float* out; unsigned char* ws; int ph_lo, ph_hi; };
typedef const __attribute__((address_space(4))) Args* ArgsP;
#define LAUNDER(p) asm volatile("" : "+s"(p))
typedef float f32x16 __attribute__((ext_vector_type(16)));
typedef unsigned u32x2 __attribute__((ext_vector_type(2)));

__device__ __forceinline__ float wave_sum(float v) {
#pragma unroll
    for (int o = 1; o < 64; o <<= 1) v += __shfl_xor(v, o);
    return v;
}
__device__ __forceinline__ float bf2f(bf16 h) { return __uint_as_float(((unsigned)h) << 16); }
__device__ __forceinline__ float bflo(unsigned w) { return __uint_as_float(w << 16); }
__device__ __forceinline__ float bfhi(unsigned w) { return __uint_as_float(w & 0xffff0000u); }
__device__ __forceinline__ float sigm(float x) { return 1.0f / (1.0f + __expf(-x)); }

__device__ __forceinline__ void tr_item(const float* W, int N, int k0, int n0, bf16* WT, int KD, int dst_row0, LAS float* scr, int lane) {
    f32x4 v[8];
#pragma unroll
    for (int i = 0; i < 8; ++i) v[i] = *(const GAS f32x4*)(W + (size_t)(k0 + 8 * i + (lane >> 3)) * N + n0 + 4 * (lane & 7));
#pragma unroll
    for (int i = 0; i < 8; ++i) { LAS float* d = scr + (8 * i + (lane >> 3)) * 33 + 4 * (lane & 7); d[0] = v[i].x; d[1] = v[i].y; d[2] = v[i].z; d[3] = v[i].w; }
    LDS_WAIT(); asm volatile("" ::: "memory");
    const int c = lane & 7;
#pragma unroll
    for (int j = 0; j < 4; ++j) { const int n = (lane >> 3) + 8 * j; const LAS float* s = scr + (8 * c) * 33 + n;
        v4u o; o.x = pk2(s[0 * 33], s[1 * 33]); o.y = pk2(s[2 * 33], s[3 * 33]); o.z = pk2(s[4 * 33], s[5 * 33]); o.w = pk2(s[6 * 33], s[7 * 33]);
        *(GAS v4u*)(WT + (size_t)(dst_row0 + n) * KD + k0 + 8 * c) = o; }
    LDS_WAIT(); asm volatile("" ::: "memory");
}

__device__ __forceinline__ void p0_prologue(const Frame& F, ArgsP A) {
    unsigned char* ws = A->ws;
    LAS float* scr = (LAS float*)(F.lds + F.wave * 16384);
    const int gw = F.vcu * NWAVES + F.wave, NGW = F.G * NWAVES;
    const float* w_in = (const float*)A->in[6]; const float* p_rwkv = (const float*)A->in[22]; const float* p_attn = (const float*)A->in[23];
    const float* w_out = (const float*)A->in[24]; const float* g2 = (const float*)A->in[13];
    bf16* WinT = (bf16*)(ws + WS_WINT); bf16* PrT = (bf16*)(ws + WS_PRT); bf16* PaT = (bf16*)(ws + WS_PAT); bf16* WoT = (bf16*)(ws + WS_WOT); bf16* G2T = (bf16*)(ws + WS_G2T);
    constexpr int I_IN = 16 * 148, I_P = 8 * 32, I_O = 16 * 32, I_G = 2 * 16, NIT = I_IN + 2 * I_P + I_O + I_G;
    for (int it = gw; it < NIT; it += NGW) {
        int r = it;
        if (r < I_IN) { tr_item(w_in, NZ, 64 * (r / 148), 32 * (r % 148), WinT, 1024, 32 * (r % 148), scr, F.lane); continue; } r -= I_IN;
        if (r < I_P) { tr_item(p_rwkv, 1024, 64 * (r / 32), 32 * (r % 32), PrT, 512, 32 * (r % 32), scr, F.lane); continue; } r -= I_P;
        if (r < I_P) { tr_item(p_attn, 1024, 64 * (r / 32), 32 * (r % 32), PaT, 512, 32 * (r % 32), scr, F.lane); continue; } r -= I_P;
        if (r < I_O) { tr_item(w_out, 1024, 64 * (r / 32), 32 * (r % 32), WoT, 1024, 32 * (r % 32), scr, F.lane); continue; } r -= I_O;
        tr_item(g2, 512, 64 * (r / 16), 32 * (r % 16), G2T, 256, 32 * (r % 16), scr, F.lane);
    }
    { const int gt = (F.vcu * NWAVES + F.wave) * 64 + F.lane, NT = F.G * NWAVES * 64; const v4u z4 = {0u, 0u, 0u, 0u};
      for (int i = gt; i < 128 * 128; i += NT) *(GAS v4u*)(WinT + (size_t)4736 * 1024 + (size_t)i * 8) = z4;
      for (int i = gt; i < 512 * 16; i += NT) *(GAS v4u*)(G2T + (size_t)(i >> 4) * 256 + 128 + (i & 15) * 8) = z4; }
    __syncthreads();
    const float* cvec = (const float*)A->in[1]; const float* w_ada = (const float*)A->in[3]; const float* b_ada = (const float*)A->in[4];
    float* mod = (float*)(ws + WS_MOD);
    for (int task = F.vcu; task < 192; task += F.G) { const int cg = task % 96, dh = task / 96;
        LAS float* ca = (LAS float*)F.lds;
        LAS float* red = (LAS float*)(F.lds + 65536);
        for (int i = F.tid; i < 16 * 1024; i += 512) { const int b = i >> 10, d = i & 1023; const float cv = cvec[i]; ca[d * 16 + b] = cv / (1.0f + __expf(-cv)); }
        __syncthreads();
        float acc[16];
#pragma unroll
        for (int b = 0; b < 16; ++b) acc[b] = 0.f;
        const int col = cg * 64 + F.lane;
#pragma unroll 8
        for (int dd = 0; dd < 64; ++dd) { const int d = dh * 512 + F.wave * 64 + dd; const float w = w_ada[(size_t)d * 6144 + col];
            const LAS f32x4* cp = (const LAS f32x4*)(ca + d * 16);
#pragma unroll
            for (int q = 0; q < 4; ++q) { const f32x4 cv = cp[q]; acc[q * 4 + 0] += cv[0] * w; acc[q * 4 + 1] += cv[1] * w; acc[q * 4 + 2] += cv[2] * w; acc[q * 4 + 3] += cv[3] * w; } }
#pragma unroll
        for (int b = 0; b < 16; ++b) red[(F.wave * 16 + b) * 64 + F.lane] = acc[b];
        __syncthreads();
        for (int o = F.tid; o < 1024; o += 512) { const int b = o >> 6, cl = o & 63; float sacc = 0.f;
#pragma unroll
            for (int w = 0; w < 8; ++w) sacc += red[(w * 16 + b) * 64 + cl];
            atomicAdd(&mod[b * 6144 + cg * 64 + cl], sacc + (dh == 0 ? b_ada[cg * 64 + cl] : 0.f)); }
        __syncthreads();
    }
}


__device__ __forceinline__ float dpp_wave_sum(float v) {
    v += __int_as_float(__builtin_amdgcn_update_dpp(0, __float_as_int(v), 0xB1, 0xf, 0xf, false));
    v += __int_as_float(__builtin_amdgcn_update_dpp(0, __float_as_int(v), 0x4E, 0xf, 0xf, false));
    v += __int_as_float(__builtin_amdgcn_update_dpp(0, __float_as_int(v), 0x141, 0xf, 0xf, false));
    v += __int_as_float(__builtin_amdgcn_update_dpp(0, __float_as_int(v), 0x140, 0xf, 0xf, false));
    v += __int_as_float(__builtin_amdgcn_ds_swizzle(__float_as_int(v), 0x401F));
    auto r_ = __builtin_amdgcn_permlane32_swap(__float_as_uint(v), __float_as_uint(v), false, false);
    return __uint_as_float(r_[0]) + __uint_as_float(r_[1]); }

template <int R, bool XBF> __device__ __forceinline__ void modnorm_rows(const void* x, int m0, int mstride, const float* g, const float* mod, int sh_off, int sc_off, bf16* out, int lane, f32x4 (&u)[R][4]) {
    f32x4 v[R][4];
#pragma unroll
    for (int i = 0; i < R; ++i) {
        if (XBF) { const GAS u32x2* xr = (const GAS u32x2*)((const bf16*)x + (size_t)(m0 + i * mstride) * 1024) + lane;
#pragma unroll
            for (int j = 0; j < 4; ++j) { const u32x2 w = xr[64 * j]; v[i][j] = (f32x4){bflo(w.x), bfhi(w.x), bflo(w.y), bfhi(w.y)}; } }
        else { const GAS f32x4* xr = (const GAS f32x4*)((const float*)x + (size_t)(m0 + i * mstride) * 1024) + lane;
#pragma unroll
            for (int j = 0; j < 4; ++j) v[i][j] = xr[64 * j]; } }
    f32x4 gg[4];
#pragma unroll
    for (int j = 0; j < 4; ++j) gg[j] = ((const GAS f32x4*)g)[lane + 64 * j];
#pragma unroll
    for (int i = 0; i < R; ++i) { const int m = m0 + i * mstride, b = m >> 11; float s = 0.f;
#pragma unroll
        for (int j = 0; j < 4; ++j) s += (v[i][j].x * v[i][j].x + v[i][j].y * v[i][j].y) + (v[i][j].z * v[i][j].z + v[i][j].w * v[i][j].w);
        const float rs = rsqrtf(dpp_wave_sum(s) * (1.0f / 1024.0f) + 1e-6f);
        const float* sh = mod + (size_t)b * 6144 + sh_off; const float* sc = mod + (size_t)b * 6144 + sc_off;
        GAS unsigned long long* o8 = (GAS unsigned long long*)(out + (size_t)m * 1024) + lane;
#pragma unroll
        for (int j = 0; j < 4; ++j) { const f32x4 s1 = ((const GAS f32x4*)sc)[lane + 64 * j], s0 = ((const GAS f32x4*)sh)[lane + 64 * j];
            f32x4 y = (v[i][j] * rs) * gg[j]; y = y * (s1 + 1.0f) + s0; u[i][j] = y;
            o8[64 * j] = (unsigned long long)pk2(y.x, y.y) | ((unsigned long long)pk2(y.z, y.w) << 32); } }
}

template <int R> __device__ __forceinline__ void load_rows_bf16(const bf16* x, int m0, int mstride, int lane_in, u32x2 (&raw)[R][4]) {
    int lane = lane_in; asm volatile("" : "+v"(lane));
#pragma unroll
    for (int i = 0; i < R; ++i) { const GAS u32x2* xr = (const GAS u32x2*)(x + (size_t)(m0 + i * mstride) * 1024) + lane;
#pragma unroll
        for (int j = 0; j < 4; ++j) raw[i][j] = xr[64 * j]; }
}
template <int R> __device__ __forceinline__ void modnorm_rows_pre(const u32x2 (&raw)[R][4], int m0, int mstride, const float* g, const float* mod, int sh_off, int sc_off, bf16* out, int lane, f32x4 (&u)[R][4]) {
    f32x4 gg[4];
#pragma unroll
    for (int j = 0; j < 4; ++j) gg[j] = ((const GAS f32x4*)g)[lane + 64 * j];
#pragma unroll
    for (int i = 0; i < R; ++i) { const int m = m0 + i * mstride, b = m >> 11; float s = 0.f; f32x4 v[4];
#pragma unroll
        for (int j = 0; j < 4; ++j) { const u32x2 w = raw[i][j]; v[j] = (f32x4){bflo(w.x), bfhi(w.x), bflo(w.y), bfhi(w.y)}; s += (v[j].x * v[j].x + v[j].y * v[j].y) + (v[j].z * v[j].z + v[j].w * v[j].w); }
        const float rs = rsqrtf(dpp_wave_sum(s) * (1.0f / 1024.0f) + 1e-6f);
        const float* sh = mod + (size_t)b * 6144 + sh_off; const float* sc = mod + (size_t)b * 6144 + sc_off;
        GAS unsigned long long* o8 = (GAS unsigned long long*)(out + (size_t)m * 1024) + lane;
#pragma unroll
        for (int j = 0; j < 4; ++j) { const f32x4 s1 = ((const GAS f32x4*)sc)[lane + 64 * j], s0 = ((const GAS f32x4*)sh)[lane + 64 * j];
            f32x4 y = (v[j] * rs) * gg[j]; y = y * (s1 + 1.0f) + s0; u[i][j] = y;
            o8[64 * j] = (unsigned long long)pk2(y.x, y.y) | ((unsigned long long)pk2(y.z, y.w) << 32); } }
}

__device__ __forceinline__ void modnorm_row(const float* xrow, const float* g, const float* sh, const float* sc, bf16* orow, int lane, f32x4 (&u)[4]) {
    const GAS f32x4* xr = (const GAS f32x4*)xrow + lane;
    f32x4 v[4]; float s = 0.f;
#pragma unroll
    for (int j = 0; j < 4; ++j) { v[j] = xr[64 * j]; s += (v[j].x * v[j].x + v[j].y * v[j].y) + (v[j].z * v[j].z + v[j].w * v[j].w); }
    const float rs = rsqrtf(wave_sum(s) * (1.0f / 1024.0f) + 1e-6f);
    GAS unsigned long long* o8 = (GAS unsigned long long*)orow + lane;
#pragma unroll
    for (int j = 0; j < 4; ++j) { const f32x4 gg = ((const GAS f32x4*)g)[lane + 64 * j], s1 = ((const GAS f32x4*)sc)[lane + 64 * j], s0 = ((const GAS f32x4*)sh)[lane + 64 * j];
        f32x4 y = (v[j] * rs) * gg; y = y * (s1 + 1.0f) + s0; u[j] = y;
        o8[64 * j] = (unsigned long long)pk2(y.x, y.y) | ((unsigned long long)pk2(y.z, y.w) << 32); }
}

__device__ __forceinline__ float softplusf(float x) { return x > 20.f ? x : log1pf(__expf(x)); }
__device__ __forceinline__ void scan_chain(const Frame& F, ArgsP A, int b, int h, int dir) {
    constexpr int CT = 32;
    LAS float* L = (LAS float*)F.lds;
    LAS float* W2S = L; LAS float* A2S = L + 4096; LAS float* ZRs = L + 8192; LAS float* ZKs = ZRs + 2048; LAS float* ZVs = ZKs + 2048; LAS float* TWs = ZVs + 2048; LAS float* ZAs = TWs + 2048;
    LAS float* DEC = ZAs + 2048; LAS float* KD = DEC + 2048; LAS float* AV = KD + 2048; LAS float* BV = AV + 2048; LAS float* YB = BV + 2048; LAS float* BON = YB + 2048;
    const bf16* Z = (const bf16*)(A->ws + WS_Z);
    const float* mu_prev = (const float*)A->in[7]; const float* mu_next = (const float*)A->in[8];
    const float* w0 = (const float*)A->in[9]; const float* w2 = (const float*)A->in[10]; const float* a0 = (const float*)A->in[11]; const float* a2 = (const float*)A->in[12];
    const float* k_k = (const float*)A->in[14]; const float* k_a = (const float*)A->in[15]; const float* r_k = (const float*)A->in[16];
    bf16* ydir = (bf16*)(A->ws + WS_XN) + (size_t)dir * M * 512; float* bonus = (float*)(A->ws + WS_BONUS) + (size_t)dir * M * 8;
    const int tid = F.tid, lane = F.lane, wave = F.wave;
    for (int i = tid; i < 4096; i += 512) { const int l = i >> 6, j = i & 63; W2S[i] = w2[((size_t)dir * 64 + l) * 512 + h * 64 + j]; A2S[i] = a2[((size_t)dir * 64 + l) * 512 + h * 64 + j]; }
    const int ch = h * 64 + lane;
    const float w0j = w0[dir * 512 + ch], a0j = a0[dir * 512 + ch], kkj = k_k[ch], kaj = k_a[ch], rkj = r_k[ch];
    float s[8];
#pragma unroll
    for (int q = 0; q < 8; ++q) s[q] = 0.f;
    const int ri = tid >> 3, jg = tid & 7;
    for (int ci = 0; ci < T / CT; ++ci) {
        const int t0 = (dir ? (T / CT - 1 - ci) : ci) * CT;
#pragma unroll 4
        for (int i = 0; i < 20; ++i) { const int e = tid + 512 * i, arr = e >> 11, rem = e & 2047, tl = rem >> 6, j = rem & 63;
            const int col = (arr == 0 ? ZR + h * 64 : arr == 1 ? ZK + h * 64 : arr == 2 ? ZV + h * 64 : arr == 3 ? ZWD + dir * 64 : ZAD + dir * 64) + j;
            const int t = t0 + tl; const bf16* zp = Z + ((size_t)b * T + t) * NZ + col;
            const float z0 = bf2f(zp[0]), zm = t > 0 ? bf2f(zp[-NZ]) : 0.f, zq = t < T - 1 ? bf2f(zp[NZ]) : 0.f;
            float zs = z0 + mu_prev[col] * (zm - z0) + mu_next[col] * (zq - z0);
            if (arr == 3) zs = tanhf(zs);
            ZRs[arr * 2048 + rem] = zs; }
        __syncthreads();
#pragma unroll 1
        for (int q = 0; q < 4; ++q) { const int tl = wave + 8 * q;
            float wraw = w0j, araw = a0j;
#pragma unroll 8
            for (int l = 0; l < 64; ++l) { wraw += TWs[tl * 64 + l] * W2S[l * 64 + lane]; araw += ZAs[tl * 64 + l] * A2S[l * 64 + lane]; }
            const float w = -softplusf(-wraw) - 0.5f, dec = __expf(-__expf(w)), ad = sigm(araw);
            const float k = ZKs[tl * 64 + lane], kkr = k * kkj, nrm = sqrtf(wave_sum(kkr * kkr)), kk = kkr / fmaxf(nrm, 1e-12f);
            const float kd = k * (1.0f + (ad - 1.0f) * kaj);
            DEC[tl * 64 + lane] = dec; KD[tl * 64 + lane] = kd; AV[tl * 64 + lane] = -kk; BV[tl * 64 + lane] = kk * ad;
            const float bon = wave_sum(ZRs[tl * 64 + lane] * kd * rkj); if (lane == 0) BON[tl] = bon; }
        __syncthreads();
#pragma unroll 1
        for (int st = 0; st < CT; ++st) { const int tl = dir ? (CT - 1 - st) : st; const int o = tl * 64 + jg * 8;
            const f32x4 a0v = *(const LAS f32x4*)(AV + o), a1v = *(const LAS f32x4*)(AV + o + 4), d0 = *(const LAS f32x4*)(DEC + o), d1 = *(const LAS f32x4*)(DEC + o + 4);
            const f32x4 b0 = *(const LAS f32x4*)(BV + o), b1 = *(const LAS f32x4*)(BV + o + 4), k0 = *(const LAS f32x4*)(KD + o), k1 = *(const LAS f32x4*)(KD + o + 4);
            const f32x4 r0 = *(const LAS f32x4*)(ZRs + o), r1 = *(const LAS f32x4*)(ZRs + o + 4); const float vi = ZVs[tl * 64 + ri];
            float p = (s[0] * a0v[0] + s[1] * a0v[1]) + (s[2] * a0v[2] + s[3] * a0v[3]) + (s[4] * a1v[0] + s[5] * a1v[1]) + (s[6] * a1v[2] + s[7] * a1v[3]);
            p += __shfl_xor(p, 1); p += __shfl_xor(p, 2); p += __shfl_xor(p, 4);
            s[0] = s[0] * d0[0] + p * b0[0] + vi * k0[0]; s[1] = s[1] * d0[1] + p * b0[1] + vi * k0[1]; s[2] = s[2] * d0[2] + p * b0[2] + vi * k0[2]; s[3] = s[3] * d0[3] + p * b0[3] + vi * k0[3];
            s[4] = s[4] * d1[0] + p * b1[0] + vi * k1[0]; s[5] = s[5] * d1[1] + p * b1[1] + vi * k1[1]; s[6] = s[6] * d1[2] + p * b1[2] + vi * k1[2]; s[7] = s[7] * d1[3] + p * b1[3] + vi * k1[3];
            float y = (s[0] * r0[0] + s[1] * r0[1]) + (s[2] * r0[2] + s[3] * r0[3]) + (s[4] * r1[0] + s[5] * r1[1]) + (s[6] * r1[2] + s[7] * r1[3]);
            y += __shfl_xor(y, 1); y += __shfl_xor(y, 2); y += __shfl_xor(y, 4);
            if (jg == 0) YB[tl * 64 + ri] = y; }
        __syncthreads();
#pragma unroll
        for (int i = 0; i < 4; ++i) { const int e = tid + 512 * i, tl = e >> 6, c = e & 63; ydir[((size_t)b * T + t0 + tl) * 512 + h * 64 + c] = (bf16)f2bf(YB[e]); }
        if (tid < CT) bonus[((size_t)b * T + t0 + tid) * 8 + h] = BON[tid];
        __syncthreads();
    }
}


#define SDEV __device__ __forceinline__
#define S_UNROLL _Pragma("unroll")
#define S_MEMBAR() do { asm volatile("" ::: "memory"); __builtin_amdgcn_sched_barrier(0); } while (0)
#define S_LAUNDER_I(x) asm volatile("" : "+v"(x))
#define S_LAUNDER_S(x) asm volatile("" : "+s"(x))
#define S_PIN(x) asm volatile("" : "+v"(x))
typedef float f32x2s __attribute__((ext_vector_type(2))); typedef __bf16 bf16x2s __attribute__((ext_vector_type(2)));
__device__ __forceinline__ unsigned s_cvtpk(float lo, float hi) { f32x2s v = {lo, hi}; bf16x2s b = __builtin_convertvector(v, bf16x2s); return __builtin_bit_cast(unsigned, b); }
__device__ __forceinline__ float s_rowsum16(float v) {
    v += __int_as_float(__builtin_amdgcn_update_dpp(0, __float_as_int(v), 0xB1, 0xf, 0xf, false));
    v += __int_as_float(__builtin_amdgcn_update_dpp(0, __float_as_int(v), 0x4E, 0xf, 0xf, false));
    v += __int_as_float(__builtin_amdgcn_update_dpp(0, __float_as_int(v), 0x141, 0xf, 0xf, false));
    v += __int_as_float(__builtin_amdgcn_update_dpp(0, __float_as_int(v), 0x140, 0xf, 0xf, false));
    return v; }
#define S_MFMA(a, b, c) __builtin_amdgcn_mfma_f32_32x32x16_bf16(a, b, c, 0, 0, 0)
#define S_PK(lo, hi) s_cvtpk(lo, hi)
#define S_SWAP(x, y) do { auto r_ = __builtin_amdgcn_permlane32_swap(x, y, false, false); x = r_[0]; y = r_[1]; } while (0)
#define S_ROWSUM16(v) s_rowsum16(v)
__device__ __forceinline__ float s_wavesum(float v) { v = s_rowsum16(v);
    v += __int_as_float(__builtin_amdgcn_ds_swizzle(__float_as_int(v), 0x401F));
    auto r_ = __builtin_amdgcn_permlane32_swap(__float_as_uint(v), __float_as_uint(v), false, false);
    return __uint_as_float(r_[0]) + __uint_as_float(r_[1]); }
#define S_WAVESUM(v) s_wavesum(v)
#define S_SWAP16(x, y) do { auto r_ = __builtin_amdgcn_permlane16_swap(x, y, false, false); x = r_[0]; y = r_[1]; } while (0)
#define S_DPPF(v, ctrl) __int_as_float(__builtin_amdgcn_update_dpp(0, __float_as_int(v), ctrl, 0xf, 0xf, false))
__device__ __forceinline__ float s_treesum32(float (&q)[32], int lane) {
    _Pragma("unroll") for (int i = 0; i < 16; ++i) { unsigned x = __float_as_uint(q[i]), y = __float_as_uint(q[i + 16]); S_SWAP(x, y); q[i] = __uint_as_float(x) + __uint_as_float(y); }
    _Pragma("unroll") for (int i = 0; i < 8; ++i) { unsigned x = __float_as_uint(q[i]), y = __float_as_uint(q[i + 8]); S_SWAP16(x, y); q[i] = __uint_as_float(x) + __uint_as_float(y); }
    const bool b3 = (lane & 8) != 0, b2 = (lane & 4) != 0, b1 = (lane & 2) != 0;
    _Pragma("unroll") for (int i = 0; i < 4; ++i) { const float a = q[i], b = q[i + 4]; const float c = b3 ? b : a, d = b3 ? a : b; q[i] = c + S_DPPF(d, 0x140); }
    _Pragma("unroll") for (int i = 0; i < 2; ++i) { const float a = q[i], b = q[i + 2]; const float c = b2 ? b : a, d = b2 ? a : b; q[i] = c + S_DPPF(d, 0x141); }
    { const float a = q[0], b = q[1]; const float c = b1 ? b : a, d = b1 ? a : b; q[0] = c + S_DPPF(d, 0x1B); }
    return q[0] + S_DPPF(q[0], 0xB1); }
#define S_GAS GAS
#define S_READLANE(v, l) __int_as_float(__builtin_amdgcn_readlane(__float_as_int(v), l))
#define S_RCP(x) __builtin_amdgcn_rcpf(x)
#define S_EXP2(x) __builtin_amdgcn_exp2f(x)
#define S_LOG2(x) __builtin_amdgcn_logf(x)
#define S_RSQ(x) __builtin_amdgcn_rsqf(x)
#define S_LDS_WAIT() asm volatile("s_waitcnt lgkmcnt(0)" ::: "memory")
#define S_LDSP LAS unsigned char*
#define S_LDS_BF16P LAS bf16*
#define S_LDS_U32P LAS unsigned*
#define S_LDS_F32P LAS float*
#define S_LDS_CONST_BF16X8P const LAS bf16x8*
#define S_LDS_BF16X8P LAS bf16x8*
#define S_LDS_CONST_F32X4P const LAS f32x4*
#define S_LDS_CONST_F32P const LAS float*
#define S_FLAG_STORE(p, v) do { *(volatile LAS unsigned*)(p) = (v); } while (0)
#define S_FLAG_WAIT(p, v) do { unsigned sp_ = 0; while (*(volatile LAS unsigned*)(p) != (v)) { __builtin_amdgcn_s_sleep(2); if (++sp_ > (1u << 24)) break; } asm volatile("" ::: "memory"); } while (0)
struct SFrag { bf16x8 s[2]; };
struct SMat { SFrag t[2]; };
SDEV f32x16 smm(const SFrag& X, const SFrag& Y, f32x16 acc) { acc = S_MFMA(X.s[0], Y.s[0], acc); acc = S_MFMA(X.s[1], Y.s[1], acc); return acc; }
SDEV f32x16 szero() { f32x16 z; S_UNROLL for (int i = 0; i < 16; ++i) z[i] = 0.f; return z; }
SDEV SFrag spack(const f32x16& d) { SFrag f;
    S_UNROLL for (int s = 0; s < 2; ++s) { v4u w; S_UNROLL for (int q = 0; q < 4; ++q) w[q] = S_PK(d[8 * s + 2 * q], d[8 * s + 2 * q + 1]); f.s[s] = __builtin_bit_cast(bf16x8, w); }
    return f; }
SDEV f32x16 sunpack(const SFrag& f) { f32x16 d;
    S_UNROLL for (int s = 0; s < 2; ++s) { const v4u w = __builtin_bit_cast(v4u, f.s[s]); S_UNROLL for (int q = 0; q < 4; ++q) { d[8 * s + 2 * q] = __uint_as_float(w[q] << 16); d[8 * s + 2 * q + 1] = __uint_as_float(w[q] & 0xffff0000u); } }
    return d; }
SDEV SMat splain2d(const unsigned (&pp)[16]) { unsigned d0[8], d1[8];
    S_UNROLL for (int g = 0; g < 4; ++g) S_UNROLL for (int p = 0; p < 2; ++p) { unsigned x = pp[4 * g + p], y = pp[4 * g + 2 + p]; S_SWAP(x, y); d0[2 * g + p] = x; d1[2 * g + p] = y; }
    SMat m;
    S_UNROLL for (int s = 0; s < 2; ++s) { v4u a, b; S_UNROLL for (int q = 0; q < 4; ++q) { a[q] = d0[4 * s + q]; b[q] = d1[4 * s + q]; } m.t[0].s[s] = __builtin_bit_cast(bf16x8, a); m.t[1].s[s] = __builtin_bit_cast(bf16x8, b); }
    return m; }
SDEV void sd2plain(const f32x16& D0, const f32x16& D1, float (&x)[32]) {
    S_UNROLL for (int r = 0; r < 16; ++r) { unsigned a = __float_as_uint(D0[r]), b = __float_as_uint(D1[r]); S_SWAP(a, b); const int ta = (r & 3) + 8 * (r >> 2); x[ta] = __uint_as_float(a); x[ta + 4] = __uint_as_float(b); } }
SDEV SFrag sident(int n_in, int hh_in) { int n1 = n_in, r1 = 4 * hh_in; S_LAUNDER_I(n1); S_LAUNDER_I(r1); f32x16 id; S_UNROLL for (int g = 0; g < 16; ++g) id[g] = (((g & 3) + 8 * (g >> 2) + r1) == n1) ? 1.f : 0.f; return spack(id); }
SDEV void sd2plain_pk(const f32x16& D0, const f32x16& D1, unsigned (&xp)[16]) {
    S_UNROLL for (int m = 0; m < 8; ++m) { unsigned a = S_PK(D0[2 * m], D0[2 * m + 1]), b = S_PK(D1[2 * m], D1[2 * m + 1]); S_SWAP(a, b); const int qa = 4 * (m >> 1) + (m & 1); xp[qa] = a; xp[qa + 2] = b; } }
SDEV float swave_sum(float v) { return S_WAVESUM(v); }

struct ScanArgs { const S_GAS bf16* Z; const S_GAS float* mu_prev; const S_GAS float* mu_next; const S_GAS float* w0; const S_GAS float* a0; const S_GAS float* k_k; const S_GAS float* k_a; const S_GAS float* r_k; S_GAS bf16* ydir; S_GAS float* bonus; };

#define SC_W2F 0
#define SC_A2F 8192
#define SC_SIG 16384
#define SC_GTAB 24576
#define SC_FLAG 26624
#define SC_WR 28672
#define SC_AR 94208
#define SC_RSQ 126976
#define SC_LDS_BYTES 128000
#ifndef SB_ILP
#define SB_ILP 8
#endif
#define SC_PF 4

SDEV void scan2_setup(S_LDSP lds, const S_GAS float* w2, const S_GAS float* a2, int h, int dir, int tid) {
    { float wv[16];
      S_UNROLL for (int it = 0; it < 16; ++it) { const int e = tid + 512 * it; const int mat = e >> 12, r = e & 4095, jj = r & 7, ln = (r >> 3) & 63, s = (r >> 9) & 1, jt = (r >> 10) & 1, lt = (r >> 11) & 1;
          const int n = ln & 31, hh = ln >> 5, g = 8 * s + jj, l = 32 * lt + (g & 3) + 8 * (g >> 2) + 4 * hh, j = 32 * jt + n;
          wv[it] = (mat ? a2 : w2)[((size_t)dir * 64 + l) * 512 + h * 64 + j]; }
      S_UNROLL for (int it = 0; it < 16; ++it) { const int e = tid + 512 * it; const int mat = e >> 12, r = e & 4095;
          ((S_LDS_BF16P)(lds + (mat ? SC_A2F : SC_W2F)))[r] = (bf16)(S_PK(wv[it] * -1.442695041f, 0.f) & 0xffffu); } }
    for (int e = tid; e < 2048; e += 512) ((S_LDS_U32P)(lds + SC_SIG))[e] = 0u;
    if (tid == 0) S_FLAG_STORE(lds + SC_FLAG, 0u);
}

SDEV void scan2_chunk(S_LDSP lds, const ScanArgs& A_in, int b_in, int h_in, int dir_in, int c, int lane_in, int wave) {
    ScanArgs A = A_in; int b = b_in, h = h_in, dir = dir_in;
    S_LAUNDER_S(A.Z); S_LAUNDER_S(A.mu_prev); S_LAUNDER_S(A.mu_next); S_LAUNDER_S(A.w0); S_LAUNDER_S(A.a0); S_LAUNDER_S(A.k_k); S_LAUNDER_S(A.k_a); S_LAUNDER_S(A.r_k); S_LAUNDER_S(A.ydir); S_LAUNDER_S(A.bonus);
    S_LAUNDER_S(b); S_LAUNDER_S(h); S_LAUNDER_S(dir);
    int lane = lane_in; S_LAUNDER_I(lane);
    const int n = lane & 31, hh = lane >> 5;
    const int sgn = dir ? -1 : 1, tau0 = dir ? (T - 1 - 32 * c) : 32 * c;
    const S_GAS bf16* zb = A.Z + (size_t)b * T * NZ;
    const ptrdiff_t st = (ptrdiff_t)sgn * NZ; const bool first = (c == 0), last = (c == T / 32 - 1);
    const int cr = ZR + h * 64 + lane, ck = ZK + h * 64 + lane, cv = ZV + h * 64 + lane, cw = ZWD + dir * 64 + lane, ca = ZAD + dir * 64 + lane, chn = h * 64 + lane;
    {   const SFrag IDF = sident(n, hh); unsigned ppw[16], ppa[16];
        { const float mA = dir ? A.mu_next[cw] : A.mu_prev[cw], mB = dir ? A.mu_prev[cw] : A.mu_next[cw], nA = dir ? A.mu_next[ca] : A.mu_prev[ca], nB = dir ? A.mu_prev[ca] : A.mu_next[ca];
          const S_GAS bf16* pw = zb + (ptrdiff_t)tau0 * NZ + cw - st; const S_GAS bf16* pa = zb + (ptrdiff_t)tau0 * NZ + ca - st;
          float rw[34], ra[34];
          S_UNROLL for (int q = 0; q < 34; ++q) { const bool ok = !((q == 0 && first) || (q == 33 && last)); rw[q] = ok ? bf2f(*pw) : 0.f; ra[q] = ok ? bf2f(*pa) : 0.f; pw += st; pa += st; }
          S_MEMBAR();
          const float mC = 1.f - mA - mB, nC = 1.f - nA - nB; float tprev = 0.f, aprev = 0.f;
          S_UNROLL for (int p = 0; p < 32; ++p) { if ((p & 7) == 0) S_MEMBAR();
              const float ws = mC * rw[p + 1] + mA * rw[p] + mB * rw[p + 2], as = nC * ra[p + 1] + nA * ra[p] + nB * ra[p + 2];
              const float tw = 1.f - 2.f * S_RCP(1.f + S_EXP2(ws * 2.885390082f));
              if (p & 1) { ppw[p >> 1] = S_PK(tprev, tw); ppa[p >> 1] = S_PK(aprev, as); S_PIN(ppw[p >> 1]); S_PIN(ppa[p >> 1]); } else { tprev = tw; aprev = as; } } }
        S_MEMBAR();
        const SMat TW = splain2d(ppw), AD = splain2d(ppa);
        SFrag TWT[2], ADT[2];
        S_UNROLL for (int lt = 0; lt < 2; ++lt) { TWT[lt] = spack(smm(TW.t[lt], IDF, szero())); ADT[lt] = spack(smm(AD.t[lt], IDF, szero())); }
        f32x16 dw[2], da[2];
        S_UNROLL for (int jt = 0; jt < 2; ++jt) { const float w0s = A.w0[dir * 512 + h * 64 + 32 * jt + n] * -1.442695041f, a0s = A.a0[dir * 512 + h * 64 + 32 * jt + n] * -1.442695041f;
            S_UNROLL for (int g = 0; g < 16; ++g) { dw[jt][g] = w0s; da[jt][g] = a0s; }
            S_UNROLL for (int lt = 0; lt < 2; ++lt) { SFrag wf, af;
                S_UNROLL for (int s = 0; s < 2; ++s) { wf.s[s] = *(S_LDS_CONST_BF16X8P)(lds + SC_W2F + ((((lt * 2 + jt) * 2 + s) * 64 + lane) * 16)); af.s[s] = *(S_LDS_CONST_BF16X8P)(lds + SC_A2F + ((((lt * 2 + jt) * 2 + s) * 64 + lane) * 16)); }
                dw[jt] = smm(TWT[lt], wf, dw[jt]); da[jt] = smm(ADT[lt], af, da[jt]); } }
        S_UNROLL for (int jt = 0; jt < 2; ++jt) S_UNROLL for (int g = 0; g < 16; ++g) { const int t = (g & 3) + 8 * (g >> 2) + 4 * hh;
            ((S_LDS_F32P)(lds + SC_WR + wave * 8192))[t * 64 + 32 * jt + n] = dw[jt][g]; ((S_LDS_BF16P)(lds + SC_AR + wave * 4096))[t * 64 + 32 * jt + n] = (bf16)(S_PK(da[jt][g], 0.f) & 0xffffu); }
        S_LDS_WAIT();
    }
    S_MEMBAR();
    unsigned ppA[16], ppR[16], ppB[16], ppK[16], ppV[16], ppQ[16]; float gamC;
    {   const float mAr = dir ? A.mu_next[cr] : A.mu_prev[cr], mBr = dir ? A.mu_prev[cr] : A.mu_next[cr], mAk = dir ? A.mu_next[ck] : A.mu_prev[ck], mBk = dir ? A.mu_prev[ck] : A.mu_next[ck];
        const float mAv = dir ? A.mu_next[cv] : A.mu_prev[cv], mBv = dir ? A.mu_prev[cv] : A.mu_next[cv];
        const float kkj = A.k_k[chn], kaj = A.k_a[chn], rkj = A.r_k[chn];
        const S_GAS bf16* pr = zb + (ptrdiff_t)tau0 * NZ + cr - st; const S_GAS bf16* pk = zb + (ptrdiff_t)tau0 * NZ + ck - st; const S_GAS bf16* pv = zb + (ptrdiff_t)tau0 * NZ + cv - st;
        float rr[34], rk[34], rv[34];
        S_UNROLL for (int q = 0; q < 34; ++q) { const bool ok = !((q == 0 && first) || (q == 33 && last)); rr[q] = ok ? bf2f(*pr) : 0.f; rk[q] = ok ? bf2f(*pk) : 0.f; rv[q] = ok ? bf2f(*pv) : 0.f; pr += st; pk += st; pv += st; }
        S_MEMBAR();
        const float mCr = 1.f - mAr - mBr, mCk = 1.f - mAk - mBk, mCv = 1.f - mAv - mBv;
        float cs = 0.f, gprev = 1.f; float eA = 0.f, eR = 0.f, eB = 0.f, eK = 0.f, eV = 0.f, eQ = 0.f;
        {
            float sq[32];
            S_UNROLL for (int p = 0; p < 32; ++p) { rk[p] = mCk * rk[p + 1] + mAk * rk[p] + mBk * rk[p + 2]; const float t_ = rk[p] * kkj; sq[p] = t_ * t_; }
            const float tot = s_treesum32(sq, lane);
            ((S_LDS_F32P)(lds + SC_RSQ + wave * 128))[lane >> 1] = S_RSQ(fmaxf(tot, 1e-24f)); }
        S_MEMBAR();
        S_UNROLL for (int p = 0; p < 32; ++p) { if ((p & (SB_ILP - 1)) == 0) S_MEMBAR();
            const float r = mCr * rr[p + 1] + mAr * rr[p] + mBr * rr[p + 2], k = rk[p], v = mCv * rv[p + 1] + mAv * rv[p] + mBv * rv[p + 2];
            const float wraw = ((S_LDS_F32P)(lds + SC_WR + wave * 8192))[p * 64 + lane], araw = bf2f(((S_LDS_BF16P)(lds + SC_AR + wave * 4096))[p * 64 + lane]);
            const float lw2 = -0.8750387749f * S_RCP(1.f + S_EXP2(wraw));
            const float al = S_RCP(1.f + S_EXP2(araw));
            const float kk = k * kkj * ((S_LDS_CONST_F32P)(lds + SC_RSQ + wave * 128))[p];
            const float kd = k * (1.f + (al - 1.f) * kaj);
            cs += lw2; const float gam = S_EXP2(cs), ig = S_EXP2(-cs);
            const float xa = -kk * gprev, xr = r * gam, xb = kk * al * ig, xk = kd * ig, xq = xr * rkj; gprev = gam;
            if (p & 1) { ppA[p >> 1] = S_PK(eA, xa); ppR[p >> 1] = S_PK(eR, xr); ppB[p >> 1] = S_PK(eB, xb); ppK[p >> 1] = S_PK(eK, xk); ppV[p >> 1] = S_PK(eV, v); ppQ[p >> 1] = S_PK(eQ, xq);
                         S_PIN(ppQ[p >> 1]); S_PIN(ppA[p >> 1]); S_PIN(ppR[p >> 1]); S_PIN(ppB[p >> 1]); S_PIN(ppK[p >> 1]); S_PIN(ppV[p >> 1]); }
            else { eA = xa; eR = xr; eB = xb; eK = xk; eV = v; eQ = xq; } }
        gamC = gprev;
    }
    S_MEMBAR();
    float gc0, gc1; { unsigned x = __float_as_uint(gamC), y = x; S_SWAP(x, y); gc0 = __uint_as_float(x); gc1 = __uint_as_float(y); }
    ((S_LDS_F32P)(lds + SC_GTAB + wave * 256))[lane] = gamC;
    const SMat FA = splain2d(ppA), FB = splain2d(ppB), FK = splain2d(ppK), FV = splain2d(ppV);
    SFrag RT[2], MrbT, MrkT, LakT, Pf, PTf; f32x16 TT;
    {   const SFrag IDF = sident(n, hh); SFrag AT[2], BT[2], KT[2];
        { const SMat FR = splain2d(ppR); S_UNROLL for (int dt = 0; dt < 2; ++dt) RT[dt] = spack(smm(FR.t[dt], IDF, szero())); }
        SFrag QT[2]; { const SMat FQ = splain2d(ppQ); S_UNROLL for (int dt = 0; dt < 2; ++dt) QT[dt] = spack(smm(FQ.t[dt], IDF, szero())); }
        S_UNROLL for (int dt = 0; dt < 2; ++dt) { AT[dt] = spack(smm(FA.t[dt], IDF, szero())); BT[dt] = spack(smm(FB.t[dt], IDF, szero())); KT[dt] = spack(smm(FK.t[dt], IDF, szero())); }
        f32x16 L = szero(), LT = szero(), lak = szero(), mrb = szero(), mrk = szero();
        { f32x16 bq = szero(); S_UNROLL for (int dt = 0; dt < 2; ++dt) bq = smm(KT[dt], QT[dt], bq);
          int nb = n, rb = 4 * hh; S_LAUNDER_I(nb); S_LAUNDER_I(rb); float dsum = 0.f; S_UNROLL for (int g = 0; g < 16; ++g) dsum += (((g & 3) + 8 * (g >> 2) + rb) == nb) ? bq[g] : 0.f;
          if (((nb >> 2) & 1) == (rb >> 2)) A.bonus[((size_t)b * T + (tau0 + sgn * nb)) * 8 + h] = dsum; }
        S_UNROLL for (int dt = 0; dt < 2; ++dt) { L = smm(AT[dt], BT[dt], L); LT = smm(BT[dt], AT[dt], LT); lak = smm(KT[dt], AT[dt], lak); mrb = smm(BT[dt], RT[dt], mrb); mrk = smm(KT[dt], RT[dt], mrk); }
        int n2 = n, r2 = 4 * hh; S_LAUNDER_I(n2); S_LAUNDER_I(r2);
        S_UNROLL for (int g = 0; g < 16; ++g) { const int row = (g & 3) + 8 * (g >> 2) + r2;
            L[g] = (row > n2) ? L[g] : 0.f; LT[g] = (row < n2) ? LT[g] : 0.f; lak[g] = (row < n2) ? lak[g] : 0.f; mrb[g] = (row <= n2) ? mrb[g] : 0.f; mrk[g] = (row <= n2) ? mrk[g] : 0.f; }
        Pf = spack(L); PTf = spack(LT); LakT = spack(lak); MrbT = spack(mrb); MrkT = spack(mrk);
        TT = LT; S_UNROLL for (int g = 0; g < 16; ++g) TT[g] += (((g & 3) + 8 * (g >> 2) + r2) == n2) ? 1.f : 0.f;
    }
    S_MEMBAR();
    SFrag TTf = spack(TT);
    S_UNROLL for (int i = 1; i <= 4; ++i) { const f32x16 P2 = smm(PTf, Pf, szero()); SFrag P2Tf; if (i < 4) P2Tf = spack(smm(Pf, PTf, szero()));
        Pf = spack(P2); TT = smm(Pf, TTf, TT); TTf = spack(TT); if (i < 4) PTf = P2Tf; }
    S_MEMBAR();
    SFrag U0[2], Ap[2], RpT[2], Y0[2], GTf[2][2], Hf[2][2];
    S_UNROLL for (int vt = 0; vt < 2; ++vt) { const SFrag W = spack(smm(LakT, FV.t[vt], szero())); U0[vt] = spack(smm(TTf, W, szero())); }
    S_UNROLL for (int kt = 0; kt < 2; ++kt) Ap[kt] = spack(smm(TTf, FA.t[kt], szero()));
    S_UNROLL for (int kt = 0; kt < 2; ++kt) RpT[kt] = spack(smm(Ap[kt], MrbT, sunpack(RT[kt])));
    S_UNROLL for (int vt = 0; vt < 2; ++vt) Y0[vt] = spack(smm(MrkT, FV.t[vt], smm(MrbT, U0[vt], szero())));
    int n3 = n, r3 = 4 * hh; S_LAUNDER_I(n3); S_LAUNDER_I(r3);
    S_UNROLL for (int nt = 0; nt < 2; ++nt) S_UNROLL for (int mt = 0; mt < 2; ++mt) { f32x16 gt = smm(Ap[nt], FB.t[mt], szero()); const float gcv = mt ? gc1 : gc0;
        S_UNROLL for (int g = 0; g < 16; ++g) { const float idv = (nt == mt && ((g & 3) + 8 * (g >> 2) + r3) == n3) ? 1.f : 0.f; gt[g] = (gt[g] + idv) * gcv; }
        GTf[nt][mt] = spack(gt); }
    S_LDS_WAIT();
    S_UNROLL for (int mt = 0; mt < 2; ++mt) { float gr[16];
        S_UNROLL for (int q = 0; q < 4; ++q) { const f32x4 t4 = *(S_LDS_CONST_F32X4P)(lds + SC_GTAB + wave * 256 + (32 * mt + 8 * q + 4 * hh) * 4); S_UNROLL for (int i = 0; i < 4; ++i) gr[4 * q + i] = t4[i]; }
        S_UNROLL for (int vt = 0; vt < 2; ++vt) { f32x16 hm = smm(FK.t[mt], FV.t[vt], smm(FB.t[mt], U0[vt], szero())); S_UNROLL for (int g = 0; g < 16; ++g) hm[g] *= gr[g]; Hf[mt][vt] = spack(hm); } }
    S_MEMBAR();
    S_FLAG_WAIT(lds + SC_FLAG, (unsigned)c);
    SFrag SG[2][2];
    S_UNROLL for (int kt = 0; kt < 2; ++kt) S_UNROLL for (int vt = 0; vt < 2; ++vt) S_UNROLL for (int s = 0; s < 2; ++s) SG[kt][vt].s[s] = *(S_LDS_CONST_BF16X8P)(lds + SC_SIG + ((((kt * 2 + vt) * 2 + s) * 64 + lane) * 16));
    S_LDS_WAIT();
    S_UNROLL for (int mt = 0; mt < 2; ++mt) S_UNROLL for (int vt = 0; vt < 2; ++vt) { f32x16 sn = sunpack(Hf[mt][vt]); S_UNROLL for (int nt = 0; nt < 2; ++nt) sn = smm(GTf[nt][mt], SG[nt][vt], sn);
        const SFrag f = spack(sn); S_UNROLL for (int s = 0; s < 2; ++s) *(S_LDS_BF16X8P)(lds + SC_SIG + ((((mt * 2 + vt) * 2 + s) * 64 + lane) * 16)) = f.s[s]; }
    S_LDS_WAIT();
    S_FLAG_STORE(lds + SC_FLAG, (unsigned)(c + 1));
    S_UNROLL for (int vt = 0; vt < 2; ++vt) { f32x16 y = sunpack(Y0[vt]); S_UNROLL for (int kt = 0; kt < 2; ++kt) y = smm(RpT[kt], SG[kt][vt], y);
        S_UNROLL for (int g = 0; g < 16; ++g) { const int p = (g & 3) + 8 * (g >> 2) + 4 * hh; A.ydir[((size_t)b * T + (tau0 + sgn * p)) * 512 + h * 64 + 32 * vt + n] = (bf16)(S_PK(y[g], 0.f) & 0xffffu); } }
}

__device__ __forceinline__ void attn_unit(const Frame& F, ArgsP A, int b, int kvh, int qb) {
    constexpr int KST = 72, VST = 388;
    LAS bf16* KS = (LAS bf16*)F.lds;
    LAS bf16* VT = (LAS bf16*)(F.lds + 384 * KST * 2);
    LAS float* wsf = (LAS float*)(F.lds + 384 * KST * 2 + 64 * VST * 2);
    const bf16* Z = (const bf16*)(A->ws + WS_Z); bf16* OA = (bf16*)(A->ws + WS_OATT);
    const int* positions = (const int*)A->in[2]; const float* qg = (const float*)A->in[19]; const float* kg = (const float*)A->in[20]; const float* sink = (const float*)A->in[21];
    const int tid = F.tid, lane = F.lane, wave = F.wave;
    const float LN_THETA = 13.122363377404328f;
    v4u kwa[6], vwa[6], rca[6], rsa[6];
    v4u qn[4], qnc, qns;
    { const size_t tok0 = (size_t)b * T + qb * 128 + (wave & 1) * 64 + (lane & 31); const int hq0 = kvh * 4 + (wave >> 1);
#pragma unroll
      for (int sI = 0; sI < 4; ++sI) qn[sI] = *(const GAS v4u*)(Z + tok0 * NZ + ZQ + hq0 * 64 + 16 * sI + 8 * (lane >> 5));
      const GAS v4u* qrt0 = (const GAS v4u*)((const bf16*)(A->ws + WS_ROPE) + tok0 * 16); qnc = qrt0[0]; qns = qrt0[1]; }
#pragma unroll
    for (int i = 0; i < 6; ++i) { const int ct = tid + 512 * i, key = ct >> 3, ch = ct & 7; const int kp = qb * 128 - 128 + key; const bool valid = (kp >= 0) && (kp < T);
        const size_t rowoff = ((size_t)b * T + (valid ? kp : 0)) * NZ;
        kwa[i] = *(const GAS v4u*)(Z + rowoff + ZKA + kvh * 64 + ch * 8); vwa[i] = *(const GAS v4u*)(Z + rowoff + ZVA + kvh * 64 + ch * 8);
        const GAS v4u* rt = (const GAS v4u*)((const bf16*)(A->ws + WS_ROPE) + ((size_t)b * T + (valid ? kp : 0)) * 16); rca[i] = rt[0]; rsa[i] = rt[1]; }
#pragma unroll
    for (int i = 0; i < 6; ++i) { const int ct = tid + 512 * i, key = ct >> 3, ch = ct & 7; const int kp = qb * 128 - 128 + key; const bool valid = (kp >= 0) && (kp < T);
        v4u kw = kwa[i], vw = vwa[i];
        if (!valid) { kw = (v4u){0u, 0u, 0u, 0u}; vw = kw; }
        float kf[8] = {bflo(kw.x), bfhi(kw.x), bflo(kw.y), bfhi(kw.y), bflo(kw.z), bfhi(kw.z), bflo(kw.w), bfhi(kw.w)};
        float ss = 0.f;
#pragma unroll
        for (int j = 0; j < 8; ++j) ss += kf[j] * kf[j];
        ss += __shfl_xor(ss, 1); ss += __shfl_xor(ss, 2); ss += __shfl_xor(ss, 4);
        const float rs = rsqrtf(ss * (1.0f / 64.0f) + 1e-6f);
#pragma unroll
        for (int j = 0; j < 8; ++j) kf[j] = kf[j] * rs * kg[ch * 8 + j];
        float oth[8];
#pragma unroll
        for (int j = 0; j < 8; ++j) oth[j] = __shfl_xor(kf[j], 1);
        if (ch < 2) { const v4u cw = rca[i], sw = rsa[i];
            const float cs[8] = {bflo(cw.x), bfhi(cw.x), bflo(cw.y), bfhi(cw.y), bflo(cw.z), bfhi(cw.z), bflo(cw.w), bfhi(cw.w)};
            const float sn[8] = {bflo(sw.x), bfhi(sw.x), bflo(sw.y), bfhi(sw.y), bflo(sw.z), bfhi(sw.z), bflo(sw.w), bfhi(sw.w)};
#pragma unroll
            for (int j = 0; j < 8; ++j) kf[j] = (ch == 0) ? (kf[j] * cs[j] - oth[j] * sn[j]) : (kf[j] * cs[j] + oth[j] * sn[j]); }
        v4u ko; ko.x = pk2(kf[0], kf[1]); ko.y = pk2(kf[2], kf[3]); ko.z = pk2(kf[4], kf[5]); ko.w = pk2(kf[6], kf[7]);
        *(LAS v4u*)(KS + key * KST + ch * 8) = ko;
        const unsigned vv[4] = {vw.x, vw.y, vw.z, vw.w};
#pragma unroll
        for (int j = 0; j < 4; ++j) { VT[(ch * 8 + 2 * j) * VST + key] = (bf16)(vv[j] & 0xffffu); VT[(ch * 8 + 2 * j + 1) * VST + key] = (bf16)(vv[j] >> 16); } }
    __syncthreads();
    const int g = wave >> 1, hq = kvh * 4 + g, r32 = lane & 31, hh = lane >> 5;
    const float snk = sink[hq];
    float kbound; { float gm = fabsf(kg[lane]);
#pragma unroll
        for (int o = 1; o < 64; o <<= 1) gm = fmaxf(gm, __shfl_xor(gm, o));
        kbound = 8.0f * gm; }
#pragma unroll 1
    for (int qt = 0; qt < 2; ++qt) { const int qo = (wave & 1) * 64 + qt * 32, qrel = qo + r32; const size_t tok = (size_t)b * T + qb * 128 + qrel;
        float qf[4][8]; float ss = 0.f; v4u qraw[4];
#pragma unroll
        for (int sI = 0; sI < 4; ++sI) qraw[sI] = qn[sI];
        const v4u qrc = qnc, qrs = qns;
        if (qt == 0) { const size_t tok1 = tok + 32;
#pragma unroll
            for (int sI = 0; sI < 4; ++sI) qn[sI] = *(const GAS v4u*)(Z + tok1 * NZ + ZQ + hq * 64 + 16 * sI + 8 * hh);
            const GAS v4u* qrt1 = (const GAS v4u*)((const bf16*)(A->ws + WS_ROPE) + tok1 * 16); qnc = qrt1[0]; qns = qrt1[1]; }
#pragma unroll
        for (int sI = 0; sI < 4; ++sI) { const v4u qw = qraw[sI];
            qf[sI][0] = bflo(qw.x); qf[sI][1] = bfhi(qw.x); qf[sI][2] = bflo(qw.y); qf[sI][3] = bfhi(qw.y); qf[sI][4] = bflo(qw.z); qf[sI][5] = bfhi(qw.z); qf[sI][6] = bflo(qw.w); qf[sI][7] = bfhi(qw.w);
#pragma unroll
            for (int j = 0; j < 8; ++j) ss += qf[sI][j] * qf[sI][j]; }
        ss += __shfl_xor(ss, 32);
        const float rs = rsqrtf(ss * (1.0f / 64.0f) + 1e-6f) * 0.125f;
#pragma unroll
        for (int sI = 0; sI < 4; ++sI)
#pragma unroll
            for (int j = 0; j < 8; ++j) qf[sI][j] = qf[sI][j] * rs * qg[16 * sI + 8 * hh + j];
        { const v4u cw = qrc, sw = qrs;
          const float cs[8] = {bflo(cw.x), bfhi(cw.x), bflo(cw.y), bfhi(cw.y), bflo(cw.z), bfhi(cw.z), bflo(cw.w), bfhi(cw.w)}, sn[8] = {bflo(sw.x), bfhi(sw.x), bflo(sw.y), bfhi(sw.y), bflo(sw.z), bfhi(sw.z), bflo(sw.w), bfhi(sw.w)};
#pragma unroll
          for (int j = 0; j < 8; ++j) { const float oth = __shfl_xor(qf[0][j], 32); qf[0][j] = (hh == 0) ? (qf[0][j] * cs[j] - oth * sn[j]) : (qf[0][j] * cs[j] + oth * sn[j]); } }
        bf16x8 qr[4];
#pragma unroll
        for (int sI = 0; sI < 4; ++sI) { v4u w; w.x = pk2(qf[sI][0], qf[sI][1]); w.y = pk2(qf[sI][2], qf[sI][3]); w.z = pk2(qf[sI][4], qf[sI][5]); w.w = pk2(qf[sI][6], qf[sI][7]); qr[sI] = __builtin_bit_cast(bf16x8, w); }
        const int kt0 = qo >> 5;
        float qn2 = 0.f;
#pragma unroll
        for (int sI = 0; sI < 4; ++sI)
#pragma unroll
            for (int j = 0; j < 8; ++j) qn2 += qf[sI][j] * qf[sI][j];
        qn2 += __shfl_xor(qn2, 32);
        float mrun = sqrtf(qn2) * kbound * 1.02f;
        if (__any(mrun > 40.f)) { mrun = -1e30f;
#pragma unroll 1
            for (int kt = 0; kt < 9; ++kt) { const int kbase = (kt0 + kt) * 32;
                f32x16 acc = {};
#pragma unroll
                for (int sI = 0; sI < 4; ++sI) { const bf16x8 kfr = *(const LAS bf16x8*)(KS + (kbase + r32) * KST + 16 * sI + 8 * hh); acc = __builtin_amdgcn_mfma_f32_32x32x16_bf16(kfr, qr[sI], acc, 0, 0, 0); }
#pragma unroll
                for (int r = 0; r < 16; ++r) { const int ki = kbase + (r & 3) + 8 * (r >> 2) + 4 * hh; const int dq = ki - 128 - qrel, kp = qb * 128 - 128 + ki;
                    const bool ok = (dq >= -128) && (dq <= 128) && (kp >= 0) && (kp < T); mrun = fmaxf(mrun, ok ? acc[r] : -1e30f); } }
            mrun = fmaxf(mrun, __shfl_xor(mrun, 32)); }
        const float mx = fmaxf(mrun, snk);
        float lrun = 0.f; f32x16 o0 = {}, o1 = {}; const float mxl = mx * 1.442695041f; const bool edge = (qb == 0) || (qb == T / 128 - 1);
#pragma unroll 1
        for (int kt = 0; kt < 9; ++kt) { const int kbase = (kt0 + kt) * 32;
            f32x16 acc = {};
#pragma unroll
            for (int sI = 0; sI < 4; ++sI) { const bf16x8 kfr = *(const LAS bf16x8*)(KS + (kbase + r32) * KST + 16 * sI + 8 * hh); acc = __builtin_amdgcn_mfma_f32_32x32x16_bf16(kfr, qr[sI], acc, 0, 0, 0); }
            float p[16];
            if (edge || kt == 0 || kt == 8) {
#pragma unroll
                for (int r = 0; r < 16; ++r) { const int ki = kbase + (r & 3) + 8 * (r >> 2) + 4 * hh; const int dq = ki - 128 - qrel, kp = qb * 128 - 128 + ki;
                    const bool ok = (dq >= -128) && (dq <= 128) && (kp >= 0) && (kp < T); p[r] = ok ? __builtin_amdgcn_exp2f(acc[r] * 1.442695041f - mxl) : 0.f; lrun += p[r]; }
            } else {
#pragma unroll
                for (int r = 0; r < 16; ++r) { p[r] = __builtin_amdgcn_exp2f(acc[r] * 1.442695041f - mxl); lrun += p[r]; } }
#pragma unroll
            for (int sI = 0; sI < 2; ++sI) { v4u pw; pw.x = pk2(p[8 * sI + 0], p[8 * sI + 1]); pw.y = pk2(p[8 * sI + 2], p[8 * sI + 3]); pw.z = pk2(p[8 * sI + 4], p[8 * sI + 5]); pw.w = pk2(p[8 * sI + 6], p[8 * sI + 7]);
                const bf16x8 pa = __builtin_bit_cast(bf16x8, pw); const int key0 = kbase + 16 * sI + 4 * hh;
                { const u32x2 lo = *(const LAS u32x2*)(VT + r32 * VST + key0), hi = *(const LAS u32x2*)(VT + r32 * VST + key0 + 8); v4u vw; vw.x = lo.x; vw.y = lo.y; vw.z = hi.x; vw.w = hi.y;
                  o0 = __builtin_amdgcn_mfma_f32_32x32x16_bf16(pa, __builtin_bit_cast(bf16x8, vw), o0, 0, 0, 0); }
                { const u32x2 lo = *(const LAS u32x2*)(VT + (32 + r32) * VST + key0), hi = *(const LAS u32x2*)(VT + (32 + r32) * VST + key0 + 8); v4u vw; vw.x = lo.x; vw.y = lo.y; vw.z = hi.x; vw.w = hi.y;
                  o1 = __builtin_amdgcn_mfma_f32_32x32x16_bf16(pa, __builtin_bit_cast(bf16x8, vw), o1, 0, 0, 0); } } }
        lrun += __shfl_xor(lrun, 32);
        const float linv = 1.0f / (lrun + __expf(snk - mx));
        if (hh == 0) wsf[wave * 64 + r32] = linv;
        LDS_WAIT(); asm volatile("" ::: "memory");
#pragma unroll
        for (int r = 0; r < 16; ++r) { const int row = (r & 3) + 8 * (r >> 2) + 4 * hh; const float li = wsf[wave * 64 + row];
            bf16* op = OA + ((size_t)b * T + qb * 128 + qo + row) * 512 + hq * 64;
            op[r32] = (bf16)f2bf(o0[r] * li); op[32 + r32] = (bf16)f2bf(o1[r] * li); }
        LDS_WAIT(); asm volatile("" ::: "memory");
    }
    __syncthreads();
}

__device__ __forceinline__ void pg_rows(const Frame& F, ArgsP A, bf16* wout) {
    const bf16* Z = (const bf16*)(A->ws + WS_Z); const bf16* Y0 = (const bf16*)(A->ws + WS_XN); const bf16* Y1 = Y0 + (size_t)M * 512;
    bf16* Gb = (bf16*)(A->ws + WS_G); const float* bonus = (const float*)(A->ws + WS_BONUS);
    const float* mu_prev = (const float*)A->in[7]; const float* mu_next = (const float*)A->in[8]; const float* gn_w = (const float*)A->in[17]; const float* gn_b = (const float*)A->in[18];
    const int gw = F.vcu * NWAVES + F.wave, NGW = F.G * NWAVES, lane = F.lane, c0 = lane * 8, h = lane >> 3;
    float mp[8], mn[8], gw_[8], gb_[8];
#pragma unroll
    for (int j = 0; j < 8; ++j) { mp[j] = mu_prev[ZV + c0 + j]; mn[j] = mu_next[ZV + c0 + j]; gw_[j] = gn_w[c0 + j]; gb_[j] = gn_b[c0 + j]; }
#pragma unroll 1
    for (int m0 = gw; m0 < M; m0 += 4 * NGW) {
        v4u y0[4], y1[4], gv[4], z0[4], zm[4], zq[4]; float bon[4];
#pragma unroll
        for (int i = 0; i < 4; ++i) { const int m = m0 + i * NGW, t = m & (T - 1);
            y0[i] = *(const GAS v4u*)(Y0 + (size_t)m * 512 + c0); y1[i] = *(const GAS v4u*)(Y1 + (size_t)m * 512 + c0); gv[i] = *(const GAS v4u*)(Gb + (size_t)m * 512 + c0);
            z0[i] = *(const GAS v4u*)(Z + (size_t)m * NZ + ZV + c0);
            zm[i] = (v4u){0u, 0u, 0u, 0u}; zq[i] = (v4u){0u, 0u, 0u, 0u};
            if (t > 0) zm[i] = *(const GAS v4u*)(Z + (size_t)(m - 1) * NZ + ZV + c0);
            if (t < T - 1) zq[i] = *(const GAS v4u*)(Z + (size_t)(m + 1) * NZ + ZV + c0);
            bon[i] = bonus[(size_t)m * 8 + h] + bonus[(size_t)M * 8 + (size_t)m * 8 + h]; }
#pragma unroll
        for (int i = 0; i < 4; ++i) { const int m = m0 + i * NGW;
            const unsigned y0w[4] = {y0[i].x, y0[i].y, y0[i].z, y0[i].w}, y1w[4] = {y1[i].x, y1[i].y, y1[i].z, y1[i].w}, gvw[4] = {gv[i].x, gv[i].y, gv[i].z, gv[i].w};
            const unsigned z0w[4] = {z0[i].x, z0[i].y, z0[i].z, z0[i].w}, zmw[4] = {zm[i].x, zm[i].y, zm[i].z, zm[i].w}, zqw[4] = {zq[i].x, zq[i].y, zq[i].z, zq[i].w};
            float y[8], gg[8], vv[8]; float sacc = 0.f;
#pragma unroll
            for (int j = 0; j < 4; ++j) { y[2 * j] = bflo(y0w[j]) + bflo(y1w[j]); y[2 * j + 1] = bfhi(y0w[j]) + bfhi(y1w[j]); gg[2 * j] = bflo(gvw[j]); gg[2 * j + 1] = bfhi(gvw[j]);
                const float a0 = bflo(z0w[j]), a1 = bfhi(z0w[j]);
                vv[2 * j] = a0 + mp[2 * j] * (bflo(zmw[j]) - a0) + mn[2 * j] * (bflo(zqw[j]) - a0); vv[2 * j + 1] = a1 + mp[2 * j + 1] * (bfhi(zmw[j]) - a1) + mn[2 * j + 1] * (bfhi(zqw[j]) - a1);
                sacc += y[2 * j] + y[2 * j + 1]; }
            sacc += __shfl_xor(sacc, 1); sacc += __shfl_xor(sacc, 2); sacc += __shfl_xor(sacc, 4);
            const float mu = sacc * (1.0f / 64.0f); float q = 0.f;
#pragma unroll
            for (int j = 0; j < 8; ++j) { const float d = y[j] - mu; q += d * d; }
            q += __shfl_xor(q, 1); q += __shfl_xor(q, 2); q += __shfl_xor(q, 4);
            const float rstd = rsqrtf(q * (1.0f / 64.0f) + 64e-5f);
            float o[8];
#pragma unroll
            for (int j = 0; j < 8; ++j) o[j] = ((y[j] - mu) * rstd * gw_[j] + gb_[j] + bon[i] * vv[j]) * gg[j];
            v4u w; w.x = pk2(o[0], o[1]); w.y = pk2(o[2], o[3]); w.z = pk2(o[4], o[5]); w.w = pk2(o[6], o[7]);
            *(GAS v4u*)(wout + (size_t)m * 512 + c0) = w; } }
}

constexpr int CONV_PER = 512, CONV_NIT = 16 * 3 * CONV_PER, CONV_EARLY = 6144;
__device__ __forceinline__ void conv_items(const Frame& F, ArgsP A, int it0, int it1, int widx, int nw) {
    LAS float* scr = (LAS float*)(F.lds + F.wave * 16384); const int lane = F.lane;
    const float* w_gate = (const float*)A->in[27]; const float* w_up = (const float*)A->in[28]; const float* w_down = (const float*)A->in[29];
    bf16* WguT = (bf16*)((unsigned char*)A->out + OUT_WGUT); bf16* WdT = (bf16*)((unsigned char*)A->out + OUT_WDT);
    for (int it = it0 + widx; it < it1; it += nw) { const int e = it / (3 * CONV_PER), r = it % (3 * CONV_PER), which = r / CONV_PER, q = r % CONV_PER, kb = q >> 5, nb = q & 31, n0 = 32 * nb;
        if (which == 0) tr_item(w_gate + (size_t)e * 1048576, 1024, 64 * kb, n0, WguT, 1024, e * 2048 + (n0 >> 7) * 256 + (n0 & 127), scr, lane);
        else if (which == 1) tr_item(w_up + (size_t)e * 1048576, 1024, 64 * kb, n0, WguT, 1024, e * 2048 + (n0 >> 7) * 256 + 128 + (n0 & 127), scr, lane);
        else tr_item(w_down + (size_t)e * 1048576, 1024, 64 * kb, n0, WdT, 1024, e * 1024 + n0, scr, lane); }
}
__device__ __forceinline__ int conv_idle_first(int G) { const int nwg = (M / 256) * (NZP / 256), mx = (nwg + G - 1) / G; return nwg - (mx - 1) * G; }
__device__ __forceinline__ void pj_phase(const Frame& F, ArgsP A) {
    unsigned char* ws = A->ws;
    const int gw = F.vcu * NWAVES + F.wave, NGW = F.G * NWAVES, lane = F.lane;
    { const int c0 = conv_idle_first(F.G); conv_items(F, A, c0 < F.G ? CONV_EARLY : 0, CONV_NIT, gw, NGW); }
    __syncthreads();
    const float* w_router = (const float*)A->in[26]; const bf16* x1 = (const bf16*)(ws + WS_X1); const float* g2n = (const float*)A->in[25]; const float* mod = (const float*)(ws + WS_MOD);
    bf16* XN2 = (bf16*)(ws + WS_XN); float* aff = (float*)(ws + WS_AFF);
    LAS bf16* WF = (LAS bf16*)F.lds;
    LAS float* AT = (LAS float*)(F.lds + 65536); LAS float* BT = AT + 1024; LAS float* CB = BT + 1024;
    const int tile = gw, b = tile >> 7;
    for (int d = F.tid; d < 1024; d += 512) { AT[d] = g2n[d] * (1.0f + mod[(size_t)b * 6144 + 4096 + d]); BT[d] = mod[(size_t)b * 6144 + 3072 + d]; }
    __syncthreads();
#pragma unroll 4
    for (int k = 0; k < 32; ++k) { const int it = F.tid + 512 * k, jj = it & 7, ln = (it >> 3) & 63, sI = it >> 9, q = ln >> 4, e = ln & 15, d = 32 * sI + 8 * q + jj;
        const float v = AT[d] * w_router[d * 16 + e]; const unsigned hi = pk2(v, 0.f) & 0xffffu; const float lo = v - __uint_as_float(hi << 16);
        WF[it] = (bf16)hi; WF[16384 + it] = (bf16)(pk2(lo, 0.f) & 0xffffu); }
    { float c0 = 0.f, c1 = 0.f;
#pragma unroll 4
      for (int k = 0; k < 16; ++k) { const int d = lane + 64 * k; c0 += BT[d] * w_router[d * 16 + 2 * F.wave]; c1 += BT[d] * w_router[d * 16 + 2 * F.wave + 1]; }
      c0 = dpp_wave_sum(c0); c1 = dpp_wave_sum(c1); if (lane == 0) { CB[2 * F.wave] = c0; CB[2 * F.wave + 1] = c1; } }
    __syncthreads();
    if (tile < M / 16) { const int r = lane & 15, q = lane >> 4; const size_t m = (size_t)tile * 16 + r;
        float ss = 0.f;
#pragma unroll 1
        for (int hf = 0; hf < 2; ++hf) { v4u raw[16];
#pragma unroll
            for (int sI = 0; sI < 16; ++sI) raw[sI] = *(const GAS v4u*)(x1 + m * 1024 + 32 * (16 * hf + sI) + 8 * q);
#pragma unroll
            for (int sI = 0; sI < 16; ++sI) { const v4u w = raw[sI]; const float a0 = bflo(w.x), a1 = bfhi(w.x), a2 = bflo(w.y), a3 = bfhi(w.y), a4 = bflo(w.z), a5 = bfhi(w.z), a6 = bflo(w.w), a7 = bfhi(w.w);
                ss += (a0 * a0 + a1 * a1) + (a2 * a2 + a3 * a3) + (a4 * a4 + a5 * a5) + (a6 * a6 + a7 * a7); } }
        ss += __shfl_xor(ss, 16); ss += __shfl_xor(ss, 32);
        const float rs = rsqrtf(ss * (1.0f / 1024.0f) + 1e-6f);
        f32x4 ah = {0.f, 0.f, 0.f, 0.f}, al = {0.f, 0.f, 0.f, 0.f};
#pragma unroll 1
        for (int hf = 0; hf < 2; ++hf) { v4u raw[16];
#pragma unroll
            for (int sI = 0; sI < 16; ++sI) raw[sI] = *(const GAS v4u*)(x1 + m * 1024 + 32 * (16 * hf + sI) + 8 * q);
#pragma unroll
            for (int sI = 0; sI < 16; ++sI) { const int sg = 16 * hf + sI; const bf16x8 xa = __builtin_bit_cast(bf16x8, raw[sI]);
                const bf16x8 bh = *(const LAS bf16x8*)(WF + (sg * 64 + lane) * 8), bl = *(const LAS bf16x8*)(WF + 16384 + (sg * 64 + lane) * 8);
                ah = __builtin_amdgcn_mfma_f32_16x16x32_bf16(xa, bh, ah, 0, 0, 0); al = __builtin_amdgcn_mfma_f32_16x16x32_bf16(xa, bl, al, 0, 0, 0); }
#pragma unroll
            for (int sI = 0; sI < 16; ++sI) { if ((sI & 3) == 0) asm volatile("" ::: "memory");
                const int d0 = 32 * (16 * hf + sI) + 8 * q; const v4u w = raw[sI];
                const f32x4 a0 = *(const LAS f32x4*)(AT + d0), a1 = *(const LAS f32x4*)(AT + d0 + 4), b0 = *(const LAS f32x4*)(BT + d0), b1 = *(const LAS f32x4*)(BT + d0 + 4);
                v4u o; o.x = pk2(bflo(w.x) * rs * a0.x + b0.x, bfhi(w.x) * rs * a0.y + b0.y); o.y = pk2(bflo(w.y) * rs * a0.z + b0.z, bfhi(w.y) * rs * a0.w + b0.w);
                o.z = pk2(bflo(w.z) * rs * a1.x + b1.x, bfhi(w.z) * rs * a1.y + b1.y); o.w = pk2(bflo(w.w) * rs * a1.z + b1.z, bfhi(w.w) * rs * a1.w + b1.w);
                *(GAS v4u*)(XN2 + m * 1024 + d0) = o; } }
        const float cb = CB[lane & 15]; float lg[4], mx[4], ex[4], den[4];
#pragma unroll
        for (int i = 0; i < 4; ++i) { const float rsr = __shfl(rs, 4 * q + i); lg[i] = rsr * (ah[i] + al[i]) + cb; mx[i] = lg[i]; }
#pragma unroll
        for (int o = 1; o < 16; o <<= 1)
#pragma unroll
            for (int i = 0; i < 4; ++i) mx[i] = fmaxf(mx[i], __shfl_xor(mx[i], o));
#pragma unroll
        for (int i = 0; i < 4; ++i) { ex[i] = expf(lg[i] - mx[i]); den[i] = ex[i]; }
#pragma unroll
        for (int o = 1; o < 16; o <<= 1)
#pragma unroll
            for (int i = 0; i < 4; ++i) den[i] += __shfl_xor(den[i], o);
        { const int t0 = (tile & 127) * 16 + 4 * q; f32x4 av; av.x = ex[0] / den[0]; av.y = ex[1] / den[1]; av.z = ex[2] / den[2]; av.w = ex[3] / den[3];
          *(GAS f32x4*)(aff + ((size_t)b * 16 + (lane & 15)) * T + t0) = av; } }
}

__device__ __forceinline__ void pk_task(const Frame& F, ArgsP A, int b, int e) {
    unsigned char* ws = A->ws;
    const float* aff = (const float*)(ws + WS_AFF) + ((size_t)b * 16 + e) * T;
    int* slotmap = (int*)(ws + WS_SLOT); float* selaff = (float*)(ws + WS_SELAFF); int* selidx = (int*)(ws + WS_SELIDX);
    const bf16* XN2 = (const bf16*)(ws + WS_XN); bf16* XE = (bf16*)(ws + WS_XE);
    LAS unsigned* cnt = (LAS unsigned*)F.lds;
    LAS int* tokl = (LAS int*)(F.lds + 256);
    const int tid = F.tid, lane = F.lane, wave = F.wave;
    const f32x4 v4 = *(const GAS f32x4*)(aff + 4 * tid);
    const unsigned key[4] = {__float_as_uint(v4.x), __float_as_uint(v4.y), __float_as_uint(v4.z), __float_as_uint(v4.w)};
    unsigned thr = 0u;
#pragma unroll 1
    for (int bit = 31; bit >= 0; --bit) { const unsigned cand = thr | (1u << bit);
        const unsigned c = (unsigned)(__popcll(__ballot(key[0] >= cand)) + __popcll(__ballot(key[1] >= cand)) + __popcll(__ballot(key[2] >= cand)) + __popcll(__ballot(key[3] >= cand)));
        LAS unsigned* slot_ = cnt + 16 + (bit & 1) * 8;
        if (lane == 0) slot_[wave] = c;
        __syncthreads();
        unsigned tot = 0;
#pragma unroll
        for (int w = 0; w < 8; ++w) tot += slot_[w];
        if (tot >= 256u) thr = cand; }
    __syncthreads();
    int ngt = 0, neq = 0;
#pragma unroll
    for (int j = 0; j < 4; ++j) { ngt += key[j] > thr; neq += key[j] == thr; }
    int sg = ngt, se = neq;
#pragma unroll
    for (int o = 1; o < 64; o <<= 1) { const int a = __shfl_up(sg, o), c = __shfl_up(se, o); if (lane >= o) { sg += a; se += c; } }
    if (lane == 63) { cnt[wave] = (unsigned)sg; cnt[8 + wave] = (unsigned)se; }
    __syncthreads();
    int bg = 0, be = 0, totg = 0;
#pragma unroll
    for (int w = 0; w < 8; ++w) { const int a = (int)cnt[w], c = (int)cnt[8 + w]; if (w < wave) { bg += a; be += c; } totg += a; }
    int pg = bg + sg - ngt, pe = be + se - neq;
    const int need_eq = 256 - totg;
    int* smrow = slotmap + ((size_t)b * T + 4 * tid) * 16 + e;
#pragma unroll
    for (int j = 0; j < 4; ++j) { int slot = -1;
        if (key[j] > thr) { slot = pg; ++pg; } else if (key[j] == thr) { if (pe < need_eq) slot = totg + pe; ++pe; }
        smrow[j * 16] = slot;
        if (slot >= 0) { selidx[((size_t)e * 16 + b) * 256 + slot] = b * T + 4 * tid + j; selaff[((size_t)e * 16 + b) * 256 + slot] = __uint_as_float(key[j]); } }
    __syncthreads();
}

__device__ __forceinline__ void pn_rows(const Frame& F, ArgsP A, float* wout) {
    unsigned char* ws = A->ws;
    const int* slotmap = (const int*)(ws + WS_SLOT); const bf16* YE = (const bf16*)(ws + WS_XE); const float* mod = (const float*)(ws + WS_MOD); const bf16* X1 = (const bf16*)(ws + WS_X1);
    const int gw = F.vcu * NWAVES + F.wave, NGW = F.G * NWAVES, lane = F.lane;
#pragma unroll 1
    for (int m0 = gw * 16; m0 < gw * 16 + 16; m0 += 2) {
        int myslot[2]; f32x4 xv[2][4];
#pragma unroll
        for (int i = 0; i < 2; ++i) { const int m = m0 + i; myslot[i] = slotmap[(size_t)m * 16 + (lane & 15)];
#pragma unroll
            for (int hq = 0; hq < 2; ++hq) { const v4u w = *(const GAS v4u*)(X1 + (size_t)m * 1024 + hq * 512 + lane * 8);
                xv[i][2 * hq] = (f32x4){bflo(w.x), bfhi(w.x), bflo(w.y), bfhi(w.y)}; xv[i][2 * hq + 1] = (f32x4){bflo(w.z), bfhi(w.z), bflo(w.w), bfhi(w.w)}; } }
        unsigned long long msk[2]; v4u yw[2][4][2];
#pragma unroll
        for (int i = 0; i < 2; ++i) { const int b = (m0 + i) >> 11; msk[i] = __ballot(myslot[i] >= 0) & 0xffffull;
#pragma unroll
            for (int k = 0; k < 4; ++k) { const bool has = msk[i] != 0ull; const int e = has ? __builtin_ctzll(msk[i]) : 0; if (has) msk[i] &= msk[i] - 1; const int sl = __shfl(myslot[i], e);
                yw[i][k][0] = (v4u){0u, 0u, 0u, 0u}; yw[i][k][1] = (v4u){0u, 0u, 0u, 0u};
                if (has) { const GAS v4u* yr = (const GAS v4u*)(YE + (((size_t)e * 16 + b) * 256 + sl) * 1024); yw[i][k][0] = yr[lane]; yw[i][k][1] = yr[64 + lane]; } } }
#pragma unroll
        for (int i = 0; i < 2; ++i) { const int m = m0 + i, b = m >> 11;
            float acc[16];
#pragma unroll
            for (int j = 0; j < 16; ++j) acc[j] = 0.f;
#pragma unroll
            for (int k = 0; k < 4; ++k)
#pragma unroll
                for (int hlf = 0; hlf < 2; ++hlf) { const v4u w = yw[i][k][hlf];
                    acc[hlf * 8 + 0] += bflo(w.x); acc[hlf * 8 + 1] += bfhi(w.x); acc[hlf * 8 + 2] += bflo(w.y); acc[hlf * 8 + 3] += bfhi(w.y);
                    acc[hlf * 8 + 4] += bflo(w.z); acc[hlf * 8 + 5] += bfhi(w.z); acc[hlf * 8 + 6] += bflo(w.w); acc[hlf * 8 + 7] += bfhi(w.w); }
            unsigned long long mk = msk[i];
            while (mk) { const int e = __builtin_ctzll(mk); mk &= mk - 1; const int sl = __shfl(myslot[i], e);
                const GAS v4u* yr = (const GAS v4u*)(YE + (((size_t)e * 16 + b) * 256 + sl) * 1024);
#pragma unroll
                for (int hlf = 0; hlf < 2; ++hlf) { const v4u w = yr[hlf * 64 + lane];
                    acc[hlf * 8 + 0] += bflo(w.x); acc[hlf * 8 + 1] += bfhi(w.x); acc[hlf * 8 + 2] += bflo(w.y); acc[hlf * 8 + 3] += bfhi(w.y);
                    acc[hlf * 8 + 4] += bflo(w.z); acc[hlf * 8 + 5] += bfhi(w.z); acc[hlf * 8 + 6] += bflo(w.w); acc[hlf * 8 + 7] += bfhi(w.w); } }
            const float* gt2 = mod + (size_t)b * 6144 + 5120; float* orow = wout + (size_t)m * 1024;
#pragma unroll
            for (int q = 0; q < 4; ++q) { const int c = (q >> 1) * 512 + lane * 8 + (q & 1) * 4; const f32x4 g = *(const GAS f32x4*)(gt2 + c);
                f32x4 a; a.x = acc[(q >> 1) * 8 + (q & 1) * 4 + 0]; a.y = acc[(q >> 1) * 8 + (q & 1) * 4 + 1]; a.z = acc[(q >> 1) * 8 + (q & 1) * 4 + 2]; a.w = acc[(q >> 1) * 8 + (q & 1) * 4 + 3];
                *(GAS f32x4*)(orow + c) = xv[i][q] + g * a; } } }
}

__device__ __forceinline__ void mk_frame(Frame& F, LAS unsigned char* lds, int wave_s) {
    int bx = blockIdx.x, G = gridDim.x; LAUNDER(bx); LAUNDER(G);
    F.lds = lds; F.MISC = (volatile LAS unsigned*)(lds + MISC_OFF); F.ctl = nullptr;
    unsigned ones_ = ~0u; asm volatile("" : "+s"(ones_));
    int lane_ = (int)__builtin_amdgcn_mbcnt_hi(ones_, __builtin_amdgcn_mbcnt_lo(ones_, 0u)); asm volatile("" : "+v"(lane_));
    F.lane = lane_; F.wave = wave_s; F.tid = wave_s * 64 + lane_;
    F.G = G; F.vcu = (G % 8 == 0) ? (bx % 8) * (G / 8) + bx / 8 : bx;
}
__global__ void __launch_bounds__(NWAVES * 64, 2) fwd_kernel(Args args) {
    extern __shared__ __attribute__((aligned(16))) unsigned char lds[];
    LAS unsigned char* const ldsb = (LAS unsigned char*)lds;
    ArgsP ap0 = (ArgsP)__builtin_amdgcn_kernarg_segment_ptr();
    int wave_s = __builtin_amdgcn_readfirstlane((int)threadIdx.x >> 6); asm volatile("" : "+s"(wave_s));
    for (int u = threadIdx.x; u < (LDS_BYTES - LDSCTL_OFF) / 4; u += NWAVES * 64) ((LAS unsigned*)(ldsb + LDSCTL_OFF))[u] = 0u;
    __syncthreads();
#define MKBAR XcdBarrier bar; { ArgsP a_ = ap0; LAUNDER(a_); bar.bar = (unsigned*)(a_->ws + WS_CTL) + CW_BAR; bar.x = xb_xcc_id(); bar.st = (volatile LAS unsigned*)(ldsb + MISC_OFF) + 8; }
#if ONE_LAUNCH
    { MKBAR; if (threadIdx.x == 0) (void)xb_add(&bar.bar[XB_XCNT(bar.x)], 1u); }
#ifndef PHM
#define PHM 0x3fff
#endif
#define IN(k) ((PHM >> (k)) & 1)
#define SEAM(k) do { if (IN(k) && IN((k) + 1)) { MKBAR; { unsigned o_ = ~0u; asm volatile("" : "+s"(o_)); xcd_barrier(bar, wave_s == 0 && __builtin_amdgcn_mbcnt_hi(o_, __builtin_amdgcn_mbcnt_lo(o_, 0u)) == 0u); } } } while (0)
#else
    int lo, hi; { ArgsP a = ap0; LAUNDER(a); lo = a->ph_lo; hi = a->ph_hi; }
#define IN(k) (lo <= (k) && (k) < hi)
#define SEAM(k) do { } while (0)
#endif
    typedef pg8::bf16_t pb;
#ifndef REPMASK
#define REPMASK 0
#endif
#define PHASE_ARGS ArgsP ap = ap0; LAUNDER(ap); unsigned char* ws = ap->ws; (void)ws; Frame F; mk_frame(F, ldsb, wave_s); const int gw = F.vcu * NWAVES + F.wave, NGW = F.G * NWAVES; (void)gw; (void)NGW
    if (IN(0)) _Pragma("unroll 1") for (int rep_ = 0; rep_ <= ((REPMASK >> 0) & 1); ++rep_) { PHASE_ARGS; p0_prologue(F, ap); } SEAM(0);
    if (IN(1)) _Pragma("unroll 1") for (int rep_ = 0; rep_ <= ((REPMASK >> 1) & 1); ++rep_) { PHASE_ARGS; const float* x = (const float*)ap->in[0]; const float* g1 = (const float*)ap->in[5]; const float* mod = (const float*)(ws + WS_MOD); bf16* XN = (bf16*)(ws + WS_XN);
#pragma unroll 1
        for (int wv = gw; wv < M / 16; wv += NGW) {
#pragma unroll 1
          for (int k4 = 0; k4 < 4; ++k4) { const int m = wv * 16 + 4 * k4; f32x4 u[4][4]; modnorm_rows<4, false>(x, m, 1, g1, mod, 0, 1024, XN, F.lane, u);
            if (F.lane < 32) { const int mm = m + (F.lane >> 3), j = F.lane & 7; const float pos = (float)((const int*)ap->in[2])[mm];
                const float ang = pos * __expf(-(float)j * 0.125f * 13.122363377404328f); const float sn = __sinf(ang), cs = __cosf(ang);
                bf16* rt = (bf16*)(ws + WS_ROPE) + (size_t)mm * 16; rt[j] = (bf16)(pk2(cs, 0.f) & 0xffffu); rt[8 + j] = (bf16)(pk2(sn, 0.f) & 0xffffu); } } } } SEAM(1);
    if (IN(2)) _Pragma("unroll 1") for (int rep_ = 0; rep_ <= ((REPMASK >> 2) & 1); ++rep_) { PHASE_ARGS; pg8::Gemm g{(const pb*)(ws + WS_XN), (const pb*)(ws + WS_WINT), M, NZP, D}; pg8::StaticOrder S; S.init(M, NZP, F.G, (int)blockIdx.x);
        pg8::EpiZ E{(pb*)(ws + WS_Z)}; pg8::gemm_phase<pg8::EpiZ, pg8::StaticOrder, true, true>(F.lds, g, S, E, F.tid); }
    if (IN(2)) { PHASE_ARGS; const int c0 = conv_idle_first(F.G);
        if ((int)blockIdx.x >= c0 && c0 < F.G) { __syncthreads(); conv_items(F, ap, 0, CONV_EARLY, ((int)blockIdx.x - c0) * NWAVES + F.wave, (F.G - c0) * NWAVES); } }
    SEAM(2);
    if (IN(3)) {
#ifndef REP_SCAN
#define REP_SCAN 1
#endif
#ifndef REP_ATTN
#define REP_ATTN 1
#endif
      { int c0_, G_; { Frame F0; mk_frame(F0, ldsb, wave_s); c0_ = F0.vcu; G_ = F0.G; }
#pragma unroll 1
        for (int c = c0_; c < 256 * REP_SCAN; c += G_) { PHASE_ARGS; const int b = (c >> 4) & 15, h = (c >> 1) & 7, dir = c & 1;
            scan2_setup(F.lds, (const GAS float*)ap->in[10], (const GAS float*)ap->in[12], h, dir, F.tid); __syncthreads();
            const ScanArgs SA{(const GAS bf16*)(ws + WS_Z), (const GAS float*)ap->in[7], (const GAS float*)ap->in[8], (const GAS float*)ap->in[9], (const GAS float*)ap->in[11], (const GAS float*)ap->in[14], (const GAS float*)ap->in[15], (const GAS float*)ap->in[16],
                              (GAS bf16*)(ws + WS_XN) + (size_t)dir * M * 512, (GAS float*)(ws + WS_BONUS) + (size_t)dir * M * 8};
#pragma unroll 1
            for (int cc = F.wave; cc < T / 32; cc += 8) scan2_chunk(F.lds, SA, b, h, dir, cc, F.lane, F.wave);
            __syncthreads(); } }
      { PHASE_ARGS;
#pragma unroll 1
        for (int u = F.vcu; u < 512 * REP_ATTN; u += F.G) { attn_unit(F, ap, (u >> 5) & 15, (u >> 4) & 1, u & 15); } }
      { PHASE_ARGS;
        const bf16* Z = (const bf16*)(ws + WS_Z); bf16* SGD = (bf16*)(ws + WS_SGD); const float* mu_prev = (const float*)ap->in[7]; const float* mu_next = (const float*)ap->in[8];
          const int c = ZGD + 2 * F.lane; const float mp0 = mu_prev[c], mp1 = mu_prev[c + 1], mn0 = mu_next[c], mn1 = mu_next[c + 1];
#ifndef REP_SGD
#define REP_SGD 1
#endif
          const int tile = F.vcu;
          if (tile < 256) { const int pm = tile >> 1, pn = tile & 1; constexpr int RS = 136;
              LAS bf16* SG = (LAS bf16*)F.lds; LAS bf16* GT = (LAS bf16*)(F.lds + 256 * RS * 2);
              __syncthreads();
              const int mt0 = pm * 256 + F.wave * 32;
#pragma unroll 1
              for (int m0 = 0; m0 < 32; m0 += 4) { unsigned z0[4], zm[4], zq[4];
#pragma unroll
                  for (int i = 0; i < 4; ++i) { const int m = mt0 + m0 + i, t = m & (T - 1);
                      z0[i] = *(const GAS unsigned*)(Z + (size_t)m * NZ + c); zm[i] = t > 0 ? *(const GAS unsigned*)(Z + (size_t)(m - 1) * NZ + c) : 0u; zq[i] = t < T - 1 ? *(const GAS unsigned*)(Z + (size_t)(m + 1) * NZ + c) : 0u; }
#pragma unroll
                  for (int i = 0; i < 4; ++i) { const float a0 = bflo(z0[i]), a1 = bfhi(z0[i]); const float s0 = a0 + mp0 * (bflo(zm[i]) - a0) + mn0 * (bflo(zq[i]) - a0), s1 = a1 + mp1 * (bfhi(zm[i]) - a1) + mn1 * (bfhi(zq[i]) - a1);
                      *(LAS unsigned*)(SG + (F.wave * 32 + m0 + i) * RS + 2 * F.lane) = pk2(sigm(s0), sigm(s1)); } }
              __syncthreads();
              const int r32 = F.lane & 31, hh = F.lane >> 5; bf16x8 af[8];
#pragma unroll
              for (int sI = 0; sI < 8; ++sI) af[sI] = *(const LAS bf16x8*)(SG + (F.wave * 32 + r32) * RS + 16 * sI + 8 * hh);
              bf16* Gout = (bf16*)(ws + WS_G); const bf16* G2T = (const bf16*)(ws + WS_G2T);
#pragma unroll 1
              for (int hf = 0; hf < 2; ++hf) {
#pragma unroll
                  for (int i = 0; i < 4; ++i) { const int e = F.tid + 512 * i, rr = e >> 4, ch = e & 15; *(LAS v4u*)(GT + rr * RS + ch * 8) = *(const GAS v4u*)(G2T + (size_t)(256 * pn + 128 * hf + rr) * 256 + ch * 8); }
                  __syncthreads();
#pragma unroll 1
                  for (int ct = 0; ct < 4; ++ct) { f32x16 acc = {};
#pragma unroll
                      for (int sI = 0; sI < 8; ++sI) { const bf16x8 bfr = *(const LAS bf16x8*)(GT + (32 * ct + r32) * RS + 16 * sI + 8 * hh); acc = __builtin_amdgcn_mfma_f32_32x32x16_bf16(af[sI], bfr, acc, 0, 0, 0); }
#pragma unroll
                      for (int g = 0; g < 16; ++g) { const int row = (g & 3) + 8 * (g >> 2) + 4 * hh;
                          Gout[(size_t)(mt0 + row) * 512 + 256 * pn + 128 * hf + 32 * ct + r32] = (bf16)(pk2(acc[g], 0.f) & 0xffffu); } }
                  __syncthreads(); } } }
    } SEAM(4);
#ifndef REP_PG
#define REP_PG 0
#endif
    if (IN(5)) { PHASE_ARGS; if (REP_PG) pg_rows(F, ap, (bf16*)ap->out); pg_rows(F, ap, (bf16*)(ws + WS_G)); } SEAM(5);
    if (IN(6)) { PHASE_ARGS; static_assert(WS_G == WS_OATT + (size_t)M * 512 * 2 && WS_PAT == WS_PRT + (size_t)1024 * 512 * 2, "merged operand views need adjacent buffers");
        pg8::Gemm g{(const pb*)(ws + WS_OATT), (const pb*)(ws + WS_PRT), 2 * M, 2048, 512}; pg8::MergeOrder S; S.init(F.G, (int)blockIdx.x);
        pg8::EpiGate2 E{(pb*)(ws + WS_XN), (const pb*)(ws + WS_Z)}; pg8::gemm_phase<pg8::EpiGate2, pg8::MergeOrder, true, true>(F.lds, g, S, E, F.tid); } SEAM(7);
    if (IN(8)) _Pragma("unroll 1") for (int rep_ = 0; rep_ <= ((REPMASK >> 8) & 1); ++rep_) { PHASE_ARGS; pg8::Gemm g{(const pb*)(ws + WS_XN), (const pb*)(ws + WS_WOT), M, 1024, 1024}; pg8::StaticOrder S; S.init(M, 1024, F.G, (int)blockIdx.x);
        pg8::EpiRes E{(const float*)ap->in[0], (const float*)(ws + WS_MOD), (pb*)(ws + WS_X1)}; pg8::gemm_phase<pg8::EpiRes, pg8::StaticOrder, true, true>(F.lds, g, S, E, F.tid); } SEAM(8);
    if (IN(9)) _Pragma("unroll 1") for (int rep_ = 0; rep_ <= ((REPMASK >> 9) & 1); ++rep_) { PHASE_ARGS; pj_phase(F, ap); } SEAM(9);
    if (IN(10)) _Pragma("unroll 1") for (int rep_ = 0; rep_ <= ((REPMASK >> 10) & 1); ++rep_) { PHASE_ARGS; for (int p = F.vcu; p < 256; p += F.G) pk_task(F, ap, p >> 4, p & 15); } SEAM(10);
    if (IN(11)) _Pragma("unroll 1") for (int rep_ = 0; rep_ <= ((REPMASK >> 11) & 1); ++rep_) { PHASE_ARGS; pg8::Gemm g{(const pb*)(ws + WS_XN), (const pb*)((unsigned char*)ap->out + OUT_WGUT), ME, 16 * 2048, 1024}; pg8::GroupOrder<8> S{F.G, (int)blockIdx.x};
        pg8::EpiSwiglu E{(pb*)(ws + WS_H)}; pg8::gemm_phase<pg8::EpiSwiglu, pg8::GroupOrder<8>, true, true, true>(F.lds, g, S, E, F.tid, (const int*)(ws + WS_SELIDX)); } SEAM(11);
    if (IN(12)) _Pragma("unroll 1") for (int rep_ = 0; rep_ <= ((REPMASK >> 12) & 1); ++rep_) { PHASE_ARGS; pg8::Gemm g{(const pb*)(ws + WS_H), (const pb*)((unsigned char*)ap->out + OUT_WDT), ME, 16 * 1024, 1024}; pg8::GroupOrder<4> S{F.G, (int)blockIdx.x};
        pg8::EpiDown E{(pb*)(ws + WS_XE), (const float*)(ws + WS_SELAFF)}; pg8::gemm_phase<pg8::EpiDown, pg8::GroupOrder<4>, true, true>(F.lds, g, S, E, F.tid); } SEAM(12);
#ifndef EXTRA_BARS
#define EXTRA_BARS 0
#endif
#if ONE_LAUNCH
    _Pragma("unroll 1") for (int xb_ = 0; xb_ < EXTRA_BARS; ++xb_) { MKBAR; { unsigned o_ = ~0u; asm volatile("" : "+s"(o_)); xcd_barrier(bar, wave_s == 0 && __builtin_amdgcn_mbcnt_hi(o_, __builtin_amdgcn_mbcnt_lo(o_, 0u)) == 0u); } }
#endif
#ifndef REP_PN
#define REP_PN 0
#endif
    if (IN(13)) { PHASE_ARGS; if (REP_PN) pn_rows(F, ap, (float*)(ws + WS_H)); pn_rows(F, ap, ap->out); }
#undef IN
#undef SEAM
}

extern "C" void kernel_launch(void* const* d_in, const int* in_sizes, int n_in, void* d_out, int out_size, void* d_ws, size_t ws_size, hipStream_t stream) {
    static int grid = 0;
    if (grid == 0) {
        if (n_in != 30 || out_size != M * D || ws_size < WS_END) { fprintf(stderr, "kernel_launch: unexpected shapes n_in %d out %d ws %zu\n", n_in, out_size, ws_size); grid = -1; return; }
        int dev = 0, cus = 0, per_cu = 0;
        if (hipGetDevice(&dev) != hipSuccess || hipDeviceGetAttribute(&cus, hipDeviceAttributeMultiprocessorCount, dev) != hipSuccess) { grid = -1; return; }
        if (hipFuncSetAttribute((const void*)fwd_kernel, hipFuncAttributeMaxDynamicSharedMemorySize, LDS_BYTES) != hipSuccess) { fprintf(stderr, "kernel_launch: hipFuncSetAttribute failed\n"); grid = -1; return; }
        if (hipOccupancyMaxActiveBlocksPerMultiprocessor(&per_cu, (const void*)fwd_kernel, NWAVES * 64, LDS_BYTES) != hipSuccess || per_cu < 1) fprintf(stderr, "kernel_launch: occupancy query reports %d\n", per_cu);
        (void)hipGetLastError();
        grid = cus;
    }
    if (grid < 0) return;
    if (hipMemsetAsync((char*)d_ws + WS_CTL, 0, CTL_ZERO_BYTES, stream) != hipSuccess) return;
    Args a{};
    for (int i = 0; i < 30; ++i) a.in[i] = d_in[i];
    a.out = (float*)d_out; a.ws = (unsigned char*)d_ws;
#if ONE_LAUNCH
    a.ph_lo = 0; a.ph_hi = NPHASE;
    hipLaunchKernelGGL(fwd_kernel, dim3(grid), dim3(NWAVES * 64), LDS_BYTES, stream, a);
#else
    for (int p = 0; p < NPHASE; ++p) { a.ph_lo = p; a.ph_hi = p + 1; hipLaunchKernelGGL(fwd_kernel, dim3(grid), dim3(NWAVES * 64), LDS_BYTES, stream, a); }
#endif
}
```

```cpp
#include <hip/hip_runtime.h>
#include <cstdio>
#include <cstdint>
#include <cmath>
namespace pg8 {
#define PG8_LAS __attribute__((address_space(3)))
typedef unsigned short bf16_t;
typedef short bf16x8 __attribute__((ext_vector_type(8)));
typedef float f32x4 __attribute__((ext_vector_type(4)));
typedef unsigned u32x4 __attribute__((ext_vector_type(4)));
constexpr int BM = 256, BK = 64, HALF = 128, HTB = HALF * BK * 2  , STAGE_BYTES = 8 * HTB, NXCD = 8, WGM = 4;

__host__ __device__ __forceinline__ int lds_byte(int r, int c) { const int st = (r >> 4) * 2 + (c >> 5), rr = r & 15, cc = c & 31, ob = rr * 64 + cc * 2; return st * 1024 + (ob ^ (((ob >> 9) & 1) << 5)); }
__host__ __device__ __forceinline__ void stage_rc(int b, int& R, int& C) { const int st = b / 1024, sb = b % 1024, swz = sb ^ (((sb >> 9) & 1) << 5); R = (st >> 1) * 16 + swz / 64; C = (st & 1) * 32 + (swz % 64) / 2; }
__host__ __device__ __forceinline__ int perm32(int rho) { const int n = rho >> 4, i = rho & 15; return 8 * (i >> 2) + 4 * n + (i & 3); }

struct Unit { int pm, pn; };
struct Gemm { const bf16_t* A; const bf16_t* Bt; int M, N, K; };

struct StaticOrder {
    int nM, nN, nwg, G, c;
    __host__ __device__ void init(int M, int N, int G_, int c_) { nM = M / BM; nN = N / BM; nwg = nM * nN; G = G_; c = c_; }
    __host__ __device__ bool next(int i, Unit& u) const {
        const long L = (long)i * G + c; if (L >= nwg) return false;
        int wgid = (int)L; { const int q = nwg / NXCD, r = nwg % NXCD, xcd = wgid % NXCD, off = wgid / NXCD; wgid = (xcd < r ? xcd * (q + 1) : r * (q + 1) + (xcd - r) * q) + off; }
        const int nig = WGM * nN, gid = wgid / nig, fm = gid * WGM, gsz = (nM - fm) < WGM ? (nM - fm) : WGM;
        u.pm = fm + ((wgid % nig) % gsz); u.pn = (wgid % nig) / gsz; return true;
    }
    __device__ __forceinline__ void a_ready(const Unit&) const {}
    __device__ __forceinline__ void done(const Unit&) const {}
};

__device__ __forceinline__ unsigned cvt_pk_bf16(float lo, float hi) { unsigned r; asm volatile("v_cvt_pk_bf16_f32 %0, %1, %2" : "=v"(r) : "v"(lo), "v"(hi)); return r; }
typedef float f32x2 __attribute__((ext_vector_type(2)));
template <class Epi, class Sched, bool ALIGN_EPI = false, bool SP2 = false, bool GATHER = false>
__device__ __forceinline__ void gemm_phase(PG8_LAS unsigned char* lds, const Gemm g, const Sched& S, const Epi& E, int tid_in, const int* gidx = nullptr) {
    static_assert(!GATHER || SP2, "the gather variant is written for the SP2 loop");
    int tid_ = tid_in; asm volatile("" : "+v"(tid_));
    const int tid = tid_, wid = __builtin_amdgcn_readfirstlane(tid >> 6), lane = tid & 63, wr = wid >> 2, wc = wid & 3, fr = lane & 15, fq = lane >> 4;
    const int K = g.K, nt = K / BK;
    unsigned voffA[2], voffB[2];
#pragma unroll
    for (int i = 0; i < 2; ++i) { int R, C; stage_rc(tid * 16 + i * 8192, R, C); const int Rb = Epi::PERM ? ((R & ~31) + perm32(R & 31)) : R;
        voffA[i] = (unsigned)(R * K + C) * 2u; voffB[i] = (unsigned)(Rb * K + C) * 2u; }
    int gRA[2] = {0, 0}; unsigned gCA[2] = {0u, 0u}; unsigned gc[2][2] = {{0u, 0u}, {0u, 0u}}, gn[2][2] = {{0u, 0u}, {0u, 0u}};
    if constexpr (GATHER) {
#pragma unroll
        for (int i = 0; i < 2; ++i) { int R, C; stage_rc(tid * 16 + i * 8192, R, C); gRA[i] = R; gCA[i] = (unsigned)C * 2u; } }
#define PG8_GLOAD(dst, un) do { _Pragma("unroll") for (int h_ = 0; h_ < 2; ++h_) _Pragma("unroll") for (int i_ = 0; i_ < 2; ++i_) \
        dst[h_][i_] = (unsigned)gidx[(un).pm * 256 + h_ * 128 + gRA[i_]] * (unsigned)(K * 2) + gCA[i_]; } while (0)
#define PG8_STAGE_G(bufoff, gbase, nx, h) do { unsigned vo_[2] = {(nx) ? gn[h][0] : gc[h][0], (nx) ? gn[h][1] : gc[h][1]}; PG8_STAGE(bufoff, gbase, vo_); } while (0)
    const size_t kstep = (size_t)(BK * 2);
    const size_t hstep = (size_t)HALF * K * 2;
    const size_t tstep = 2 * hstep;
    const unsigned ldsw = (unsigned)wid * 1024u;
    const int aoff = lds_byte(wr * 64 + fr, fq * 8), boff = lds_byte(wc * 32 + fr, fq * 8);
#define PG8_SA(b, h) (((b) * 2 + (h)) * HTB)
#define PG8_SB(b, h) ((4 + (b) * 2 + (h)) * HTB)
#define PG8_STAGE(bufoff, gbase, voff) do { _Pragma("unroll") for (int _i = 0; _i < 2; ++_i) \
        __builtin_amdgcn_global_load_lds((const unsigned*)((const char*)(gbase) + (voff)[_i]), (PG8_LAS unsigned*)(lds + (bufoff) + ldsw + _i * 8192), 16, 0, 0); } while (0)
#define PG8_LDA(dst, b, h) do { _Pragma("unroll") for (int m = 0; m < 4; ++m) _Pragma("unroll") for (int k = 0; k < 2; ++k) dst[m][k] = *(const PG8_LAS bf16x8*)(lds + PG8_SA(b, h) + aoff + m * 2048 + k * 1024); } while (0)
#define PG8_LDB(dst, b, h) do { _Pragma("unroll") for (int n = 0; n < 2; ++n) _Pragma("unroll") for (int k = 0; k < 2; ++k) dst[n][k] = *(const PG8_LAS bf16x8*)(lds + PG8_SB(b, h) + boff + n * 2048 + k * 1024); } while (0)
#define PG8_MMA(ai, bj, At, Bt) do { __builtin_amdgcn_s_setprio(1); _Pragma("unroll") for (int m = 0; m < 4; ++m) _Pragma("unroll") for (int n = 0; n < 2; ++n) _Pragma("unroll") for (int k = 0; k < 2; ++k) \
        acc[ai][bj][m][n] = __builtin_amdgcn_mfma_f32_16x16x32_bf16(Bt[n][k], At[m][k], acc[ai][bj][m][n], 0, 0, 0); __builtin_amdgcn_s_setprio(0); } while (0)
#define PG8_WAIT_V(n) asm volatile("s_waitcnt vmcnt(" #n ")" ::: "memory")
#define PG8_WAIT_L(n) asm volatile("s_waitcnt lgkmcnt(" #n ")" ::: "memory")
#define PG8_BAR __builtin_amdgcn_s_barrier()
#define PG8_SCHED __builtin_amdgcn_sched_barrier(0)
    Unit cur, nxt; int ui = 0;
    if (!S.next(0, cur)) return;
    f32x4 acc[2][2][4][2];
#pragma unroll
    for (int a = 0; a < 2; ++a)
#pragma unroll
        for (int b = 0; b < 2; ++b)
#pragma unroll
            for (int m = 0; m < 4; ++m)
#pragma unroll
                for (int n = 0; n < 2; ++n) acc[a][b][m][n] = (f32x4){0.f, 0.f, 0.f, 0.f};
    bf16x8 At[4][2], B0[2][2], B1[2][2];
    const char* cA = GATHER ? (const char*)g.A : (const char*)g.A + (size_t)cur.pm * tstep; const char* cB = (const char*)g.Bt + (size_t)cur.pn * tstep;
    if constexpr (GATHER) { PG8_GLOAD(gc, cur); Unit n1_; if (S.next(1, n1_)) PG8_GLOAD(gn, n1_); else { gn[0][0] = gc[0][0]; gn[0][1] = gc[0][1]; gn[1][0] = gc[1][0]; gn[1][1] = gc[1][1]; } }
    S.a_ready(cur);
    if constexpr (SP2) {
        PG8_STAGE(PG8_SB(0, 0), cB, voffB); PG8_STAGE(PG8_SB(0, 1), cB + hstep, voffB);
        if constexpr (GATHER) { PG8_STAGE_G(PG8_SA(0, 0), cA, false, 0); PG8_STAGE_G(PG8_SA(0, 1), cA, false, 1); } else { PG8_STAGE(PG8_SA(0, 0), cA, voffA); PG8_STAGE(PG8_SA(0, 1), cA + hstep, voffA); }
        if (wr == 1) PG8_BAR;
        PG8_WAIT_V(2); PG8_BAR;
        PG8_STAGE(PG8_SB(1, 0), cB + kstep, voffB); if constexpr (GATHER) PG8_STAGE_G(PG8_SA(1, 0), cA + kstep, false, 0); else PG8_STAGE(PG8_SA(1, 0), cA + kstep, voffA); PG8_STAGE(PG8_SB(1, 1), cB + hstep + kstep, voffB);
        PG8_WAIT_V(6); PG8_BAR;
    } else {
        PG8_STAGE(PG8_SB(0, 0), cB, voffB); PG8_STAGE(PG8_SA(0, 0), cA, voffA); PG8_STAGE(PG8_SB(0, 1), cB + hstep, voffB); PG8_STAGE(PG8_SA(0, 1), cA + hstep, voffA);
        if (wr == 1) PG8_BAR;
        PG8_WAIT_V(4); PG8_BAR;
        PG8_STAGE(PG8_SB(1, 0), cB + kstep, voffB); PG8_STAGE(PG8_SA(1, 0), cA + kstep, voffA); PG8_STAGE(PG8_SB(1, 1), cB + hstep + kstep, voffB);
        PG8_WAIT_V(6); PG8_BAR;
    }
    for (;;) {
        const bool has_next = S.next(ui + 1, nxt);
        if constexpr (GATHER) { if (!has_next) { gn[0][0] = gc[0][0]; gn[0][1] = gc[0][1]; gn[1][0] = gc[1][0]; gn[1][1] = gc[1][1]; } }
        const char* nA = (has_next && !GATHER) ? (const char*)g.A + (size_t)nxt.pm * tstep : cA; const char* nB = has_next ? (const char*)g.Bt + (size_t)nxt.pn * tstep : cB;
        for (int t = 0; t < nt; t += 2) {
            const bool last = (t == nt - 2);
            const char* a1 = cA + (size_t)(t + 1) * kstep;
            const char* a2 = last ? nA : cA + (size_t)(t + 2) * kstep; const char* b2 = last ? nB : cB + (size_t)(t + 2) * kstep;
            const char* a3 = a2 + kstep; const char* b3 = b2 + kstep;
            if (last && has_next) S.a_ready(nxt);
            if constexpr (SP2) {
            PG8_LDB(B0, 0, 0); PG8_LDB(B1, 0, 1); PG8_SCHED; PG8_LDA(At, 0, 0); if constexpr (GATHER) PG8_STAGE_G(PG8_SA(1, 1), a1, false, 1); else PG8_STAGE(PG8_SA(1, 1), a1 + hstep, voffA);
            PG8_WAIT_V(8); PG8_WAIT_L(0); PG8_BAR; PG8_MMA(0, 0, At, B0); PG8_MMA(0, 1, At, B1); PG8_BAR; PG8_SCHED;
            PG8_LDA(At, 0, 1); PG8_STAGE(PG8_SB(0, 0), b2, voffB); PG8_STAGE(PG8_SB(0, 1), b2 + hstep, voffB); if constexpr (GATHER) PG8_STAGE_G(PG8_SA(0, 0), a2, last, 0); else PG8_STAGE(PG8_SA(0, 0), a2, voffA);
            PG8_WAIT_V(8); PG8_WAIT_L(0); PG8_BAR; PG8_MMA(1, 0, At, B0); PG8_MMA(1, 1, At, B1); PG8_BAR; PG8_SCHED;
            PG8_LDB(B0, 1, 0); PG8_LDB(B1, 1, 1); PG8_SCHED; PG8_LDA(At, 1, 0); if constexpr (GATHER) PG8_STAGE_G(PG8_SA(0, 1), a2, last, 1); else PG8_STAGE(PG8_SA(0, 1), a2 + hstep, voffA);
            PG8_WAIT_V(8); PG8_WAIT_L(0); PG8_BAR; PG8_MMA(0, 0, At, B0); PG8_MMA(0, 1, At, B1); PG8_BAR; PG8_SCHED;
            PG8_LDA(At, 1, 1); PG8_STAGE(PG8_SB(1, 0), b3, voffB); PG8_STAGE(PG8_SB(1, 1), b3 + hstep, voffB); if constexpr (GATHER) PG8_STAGE_G(PG8_SA(1, 0), a3, last, 0); else PG8_STAGE(PG8_SA(1, 0), a3, voffA);
            PG8_WAIT_V(8); PG8_WAIT_L(0); PG8_BAR; PG8_MMA(1, 0, At, B0); PG8_MMA(1, 1, At, B1); PG8_BAR; PG8_SCHED;
            } else {
            PG8_LDB(B0, 0, 0); PG8_SCHED; PG8_LDA(At, 0, 0); PG8_STAGE(PG8_SA(1, 1), a1 + hstep, voffA);
            PG8_WAIT_L(8); PG8_BAR; PG8_WAIT_L(0); PG8_MMA(0, 0, At, B0); PG8_BAR; PG8_SCHED;
            PG8_LDB(B1, 0, 1); PG8_STAGE(PG8_SB(0, 0), b2, voffB);
            PG8_BAR; PG8_WAIT_L(0); PG8_MMA(0, 1, At, B1); PG8_BAR;
            PG8_LDA(At, 0, 1); PG8_STAGE(PG8_SA(0, 0), a2, voffA);
            PG8_BAR; PG8_WAIT_L(0); PG8_MMA(1, 0, At, B0); PG8_BAR; PG8_SCHED;
            PG8_STAGE(PG8_SB(0, 1), b2 + hstep, voffB);
            PG8_WAIT_V(6); PG8_BAR; PG8_MMA(1, 1, At, B1); PG8_BAR;
            PG8_LDB(B0, 1, 0); PG8_SCHED; PG8_LDA(At, 1, 0); PG8_STAGE(PG8_SA(0, 1), a2 + hstep, voffA);
            PG8_WAIT_L(8); PG8_BAR; PG8_WAIT_L(0); PG8_MMA(0, 0, At, B0); PG8_BAR; PG8_SCHED;
            PG8_LDB(B1, 1, 1); PG8_STAGE(PG8_SB(1, 0), b3, voffB);
            PG8_BAR; PG8_WAIT_L(0); PG8_MMA(0, 1, At, B1); PG8_BAR;
            PG8_LDA(At, 1, 1); PG8_STAGE(PG8_SA(1, 0), a3, voffA);
            PG8_BAR; PG8_WAIT_L(0); PG8_MMA(1, 0, At, B0); PG8_BAR; PG8_SCHED;
            PG8_STAGE(PG8_SB(1, 1), b3 + hstep, voffB);
            PG8_WAIT_V(6); PG8_BAR; PG8_MMA(1, 1, At, B1); PG8_BAR;
            }
        }
        if constexpr (ALIGN_EPI) { if (wr == 0) PG8_BAR; }
#ifdef REP_EPI
        if constexpr (!Epi::AFTER_DRAIN) { E(acc, cur, wr, wc, fr, fq); asm volatile("" ::: "memory"); }
#endif
        if constexpr (!Epi::AFTER_DRAIN) { E(acc, cur, wr, wc, fr, fq); S.done(cur); }
        unsigned g2_[2][2] = {{0u, 0u}, {0u, 0u}};
        if constexpr (GATHER) { Unit nn_; if (has_next && S.next(ui + 2, nn_)) PG8_GLOAD(g2_, nn_); else { g2_[0][0] = gn[0][0]; g2_[0][1] = gn[0][1]; g2_[1][0] = gn[1][0]; g2_[1][1] = gn[1][1]; } }
        if (!has_next) break;
#pragma unroll
        for (int a = 0; a < 2; ++a)
#pragma unroll
            for (int b = 0; b < 2; ++b)
#pragma unroll
                for (int m = 0; m < 4; ++m)
#pragma unroll
                    for (int n = 0; n < 2; ++n) acc[a][b][m][n] = (f32x4){0.f, 0.f, 0.f, 0.f};
        cur = nxt; cA = nA; cB = nB; ++ui;
        if constexpr (GATHER) { gc[0][0] = gn[0][0]; gc[0][1] = gn[0][1]; gc[1][0] = gn[1][0]; gc[1][1] = gn[1][1]; gn[0][0] = g2_[0][0]; gn[0][1] = g2_[0][1]; gn[1][0] = g2_[1][0]; gn[1][1] = g2_[1][1]; }
        if constexpr (ALIGN_EPI) { if (wr == 1) PG8_BAR; }
    }
    PG8_WAIT_V(0);
    if constexpr (!ALIGN_EPI) { if (wr == 0) PG8_BAR; }
    PG8_BAR;
    if constexpr (Epi::AFTER_DRAIN) { E.fused(acc, cur, wr, wc, fr, fq, lds, wid, lane); S.done(cur); }
#undef PG8_SA
#undef PG8_SB
#undef PG8_STAGE
#undef PG8_STAGE_G
#undef PG8_GLOAD
#undef PG8_LDA
#undef PG8_LDB
#undef PG8_MMA
#undef PG8_WAIT_V
#undef PG8_WAIT_L
#undef PG8_BAR
#undef PG8_SCHED
}
}

#ifndef ONE_LAUNCH
#define ONE_LAUNCH 1
#endif
constexpr int NB = 16, T = 2048, D = 1024, M = NB * T;
constexpr int NZ = 4736, NZP = 4864;
constexpr int RW = 512, NE = 16, CAP = 256, ME = NE * NB * CAP;
constexpr int ZR = 0, ZK = 512, ZV = 1024, ZWD = 1536, ZAD = 1664, ZGD = 1792, ZQ = 1920, ZKA = 2432, ZVA = 2560, ZGA = 2688, ZGB = 3712;
constexpr int NWAVES = 8, NPHASE = 14;
constexpr size_t MiB = 1u << 20;
constexpr size_t WS_CTL = 0, CTL_ZERO_BYTES = 64 * 1024 + 16 * 6144 * 4;
constexpr size_t WS_MOD = 64 * 1024, WS_BONUS = 2 * MiB, WS_AFF = 4 * MiB, WS_SELAFF = 6 * MiB, WS_SLOT = 7 * MiB, WS_G2T = 9 * MiB;
constexpr size_t WS_WINT = 10 * MiB, WS_PRT = 20 * MiB, WS_PAT = 21 * MiB, WS_WOT = 22 * MiB, WS_SGD = 24 * MiB;
constexpr size_t WS_XN = 40 * MiB;
constexpr size_t WS_OATT = 104 * MiB;
constexpr size_t WS_G = 136 * MiB;
constexpr size_t WS_Z = 168 * MiB;
constexpr size_t WS_X1 = 104 * MiB;
constexpr size_t OUT_WGUT = 0;
constexpr size_t OUT_WDT = 64 * MiB;
constexpr size_t WS_XE = 200 * MiB;
constexpr size_t WS_H = 328 * MiB;
constexpr size_t WS_END = 464 * MiB;
constexpr size_t WS_ROPE = WS_AFF;
constexpr size_t WS_SELIDX = WS_SELAFF + 512 * 1024;
constexpr int CW_BAR = 4096;
constexpr int RING_BYTES = 131072, LDSCTL_OFF = RING_BYTES, MISC_OFF = LDSCTL_OFF + 320, LDS_BYTES = 147456;

#define GAS __attribute__((address_space(1)))
#define LAS __attribute__((address_space(3)))
typedef unsigned short bf16;
typedef unsigned v4u __attribute__((ext_vector_type(4)));
typedef float f32x4 __attribute__((ext_vector_type(4)));
typedef short bf16x8 __attribute__((ext_vector_type(8)));
typedef GAS unsigned gu32;
typedef GAS unsigned long long gu64;
#define RLX_AGENT __ATOMIC_RELAXED, __HIP_MEMORY_SCOPE_AGENT
#define LDS_WAIT() asm volatile("s_waitcnt lgkmcnt(0)" ::: "memory")
#define VM_WAIT() asm volatile("s_waitcnt vmcnt(0)" ::: "memory")
__device__ __forceinline__ unsigned long long rt() { return __builtin_amdgcn_s_memrealtime(); }
__device__ __forceinline__ unsigned f2bf(float f) { unsigned u = __builtin_bit_cast(unsigned, f); return (u + 0x7fffu + ((u >> 16) & 1u)) >> 16; }
typedef float f32x2hw __attribute__((ext_vector_type(2))); typedef __bf16 bf16x2hw __attribute__((ext_vector_type(2)));
__device__ __forceinline__ unsigned pk2(float lo, float hi) { f32x2hw v = {lo, hi}; bf16x2hw b = __builtin_convertvector(v, bf16x2hw); return __builtin_bit_cast(unsigned, b); }

#define XB_TMO      128
#define XB_XCNT(j)  (256  + 64 * (j))
#define XB_XSUB(j)  (1280 + 64 * (j))
#define XB_XGEN(j)  (2304 + 64 * (j))
#define XB_TOP      3328
#define XB_TOPGEN   3392
#define XCD_BAR_WORDS 3456
#define XB_SPIN_CAP (1u << 18)

__device__ __forceinline__ unsigned xb_ld(unsigned* p)              { return __hip_atomic_load(p, __ATOMIC_RELAXED, __HIP_MEMORY_SCOPE_AGENT); }
__device__ __forceinline__ unsigned xb_add(unsigned* p, unsigned v) { return __hip_atomic_fetch_add(p, v, __ATOMIC_RELAXED, __HIP_MEMORY_SCOPE_AGENT); }
__device__ __forceinline__ unsigned xb_xcc_id() { return (unsigned)__builtin_amdgcn_s_getreg((3 << 11) | 20) & 0xFu; }
#define XB_SPIN(cond, bar) do { unsigned _sp = 0; while (cond) { __builtin_amdgcn_s_sleep(1); \
    if ((++_sp & 255u) == 0u) { if (xb_ld(&(bar)[XB_TMO])) break; if (_sp > XB_SPIN_CAP) { atomicAdd(&(bar)[XB_TMO], 1u); break; } } } } while (0)

struct XcdBarrier {
    unsigned* bar; unsigned x;
    volatile LAS unsigned* st;
};

__device__ __forceinline__ XcdBarrier xcd_barrier_post(unsigned* bar, volatile LAS unsigned* st) {
    XcdBarrier b; b.bar = bar; b.x = xb_xcc_id(); b.st = st;
    if (threadIdx.x == 0) (void)xb_add(&bar[XB_XCNT(b.x)], 1u);
    return b;
}
__device__ __forceinline__ void xcd_barrier_complete(unsigned* bar, unsigned x, unsigned& nloc, unsigned& nx) {
    const unsigned G = gridDim.x * gridDim.y * gridDim.z;
    unsigned sum, cnt, mine, sp = 0u;
    for (;;) {
        sum = 0u; cnt = 0u; mine = 0u;
#pragma unroll
        for (unsigned j = 0; j < 16; ++j) { const unsigned c = xb_ld(&bar[XB_XCNT(j)]); sum += c; cnt += (c > 0u) ? 1u : 0u; mine = (j == x) ? c : mine; }
        if (sum == G) break;
        __builtin_amdgcn_s_sleep(1);
        if ((++sp & 255u) == 0u) { if (xb_ld(&bar[XB_TMO])) break; if (sp > XB_SPIN_CAP) { atomicAdd(&bar[XB_TMO], 1u); break; } }
    }
    nloc = mine > 0u ? mine : 1u; nx = cnt > 0u ? cnt : 1u;
}

__device__ __forceinline__ void xcd_barrier(const XcdBarrier& b, bool is_thread0) {
    asm volatile("s_waitcnt vmcnt(0)" ::: "memory");
    __syncthreads();
    if (is_thread0) {
        unsigned* bar = b.bar;
        __builtin_amdgcn_s_waitcnt(0);
        unsigned nloc = b.st[0], nx = b.st[1];
        if (nloc == 0u) { xcd_barrier_complete(bar, b.x, nloc, nx); b.st[0] = nloc; b.st[1] = nx; }
        const unsigned old = xb_add(&bar[XB_XSUB(b.x)], 1u);
        const unsigned gen = old / nloc;
        if (old + 1u == (gen + 1u) * nloc) {
            __builtin_amdgcn_fence(__ATOMIC_RELEASE, "agent");
            asm volatile("s_waitcnt vmcnt(0)" ::: "memory");
            const unsigned og = xb_add(&bar[XB_TOP], 1u);
            const unsigned tg = og / nx;
            if (og + 1u == (tg + 1u) * nx) xb_add(&bar[XB_TOPGEN], 1u);
            else XB_SPIN(xb_ld(&bar[XB_TOPGEN]) == tg, bar);
            __builtin_amdgcn_fence(__ATOMIC_ACQUIRE, "agent");
            xb_add(&bar[XB_XGEN(b.x)], 1u);
            asm volatile("s_waitcnt vmcnt(0)" ::: "memory");
        } else {
            XB_SPIN(xb_ld(&bar[XB_XGEN(b.x)]) == gen, bar);
            __builtin_amdgcn_fence(__ATOMIC_ACQUIRE, "agent");
            asm volatile("s_waitcnt vmcnt(0)" ::: "memory");
        }
    }
    __syncthreads();
}
namespace pg8 {
__device__ __forceinline__ float bf2f(unsigned short h) { return __uint_as_float(((unsigned)h) << 16); }
__device__ __forceinline__ float bflo(unsigned w) { return __uint_as_float(w << 16); }
__device__ __forceinline__ float bfhi(unsigned w) { return __uint_as_float(w & 0xffff0000u); }
__device__ __forceinline__ float sigm(float x) { return 1.0f / (1.0f + __expf(-x)); }
struct EpiZ { static constexpr bool PERM = true, AFTER_DRAIN = false; bf16_t* O;
    __device__ __forceinline__ void operator()(const f32x4 (&acc)[2][2][4][2], const Unit& u, int wr, int wc, int fr, int fq) const {
        const int row0 = u.pm * BM + wr * 64 + fr, col0 = u.pn * BM + wc * 32 + 8 * fq;
#pragma unroll
        for (int ai = 0; ai < 2; ++ai)
#pragma unroll
            for (int m = 0; m < 4; ++m) { bf16_t* rowp = O + (size_t)(row0 + ai * HALF + m * 16) * 4736 + col0;
#pragma unroll
                for (int bj = 0; bj < 2; ++bj) { if (u.pn * BM + bj * HALF < 4736) { const f32x4 v0 = acc[ai][bj][m][0], v1 = acc[ai][bj][m][1];
                    u32x4 w; w.x = cvt_pk_bf16(v0[0], v0[1]); w.y = cvt_pk_bf16(v0[2], v0[3]); w.z = cvt_pk_bf16(v1[0], v1[1]); w.w = cvt_pk_bf16(v1[2], v1[3]);
                    *(u32x4*)(rowp + bj * HALF) = w; } } }
    }
};
struct EpiPlain { static constexpr bool PERM = true, AFTER_DRAIN = false; bf16_t* O; int ldc;
    __device__ __forceinline__ void operator()(const f32x4 (&acc)[2][2][4][2], const Unit& u, int wr, int wc, int fr, int fq) const {
        const int row0 = u.pm * BM + wr * 64 + fr, col0 = u.pn * BM + wc * 32 + 8 * fq;
#pragma unroll
        for (int ai = 0; ai < 2; ++ai)
#pragma unroll
            for (int m = 0; m < 4; ++m) { bf16_t* rowp = O + (size_t)(row0 + ai * HALF + m * 16) * ldc + col0;
#pragma unroll
                for (int bj = 0; bj < 2; ++bj) { const f32x4 v0 = acc[ai][bj][m][0], v1 = acc[ai][bj][m][1];
                    u32x4 w; w.x = cvt_pk_bf16(v0[0], v0[1]); w.y = cvt_pk_bf16(v0[2], v0[3]); w.z = cvt_pk_bf16(v1[0], v1[1]); w.w = cvt_pk_bf16(v1[2], v1[3]);
                    *(u32x4*)(rowp + bj * HALF) = w; } }
    }
};
template <bool ADD> struct EpiGate { static constexpr bool PERM = true, AFTER_DRAIN = false; bf16_t* O; const bf16_t* Z; int zc0;
    __device__ __forceinline__ void operator()(const f32x4 (&acc)[2][2][4][2], const Unit& u, int wr, int wc, int fr, int fq) const {
        const int row0 = u.pm * BM + wr * 64 + fr, col0 = u.pn * BM + wc * 32 + 8 * fq;
#pragma unroll
        for (int ai = 0; ai < 2; ++ai)
#pragma unroll
            for (int m = 0; m < 4; ++m) { const size_t row = (size_t)(row0 + ai * HALF + m * 16); bf16_t* rowp = O + row * 1024 + col0; const bf16_t* zp = Z + row * 4736 + zc0 + col0;
#pragma unroll
                for (int bj = 0; bj < 2; ++bj) { const f32x4 v0 = acc[ai][bj][m][0], v1 = acc[ai][bj][m][1];
                    const u32x4 zg = *(const u32x4*)(zp + bj * HALF);
                    float r0 = sigm(bflo(zg.x)) * v0[0], r1 = sigm(bfhi(zg.x)) * v0[1], r2 = sigm(bflo(zg.y)) * v0[2], r3 = sigm(bfhi(zg.y)) * v0[3];
                    float r4 = sigm(bflo(zg.z)) * v1[0], r5 = sigm(bfhi(zg.z)) * v1[1], r6 = sigm(bflo(zg.w)) * v1[2], r7 = sigm(bfhi(zg.w)) * v1[3];
                    if (ADD) { const u32x4 p = *(const u32x4*)(rowp + bj * HALF);
                        r0 += bflo(p.x); r1 += bfhi(p.x); r2 += bflo(p.y); r3 += bfhi(p.y); r4 += bflo(p.z); r5 += bfhi(p.z); r6 += bflo(p.w); r7 += bfhi(p.w); }
                    u32x4 w; w.x = cvt_pk_bf16(r0, r1); w.y = cvt_pk_bf16(r2, r3); w.z = cvt_pk_bf16(r4, r5); w.w = cvt_pk_bf16(r6, r7);
                    *(u32x4*)(rowp + bj * HALF) = w; } }
    }
};
struct EpiGate2 { static constexpr bool PERM = true, AFTER_DRAIN = false; bf16_t* O; const bf16_t* Z;
    __device__ __forceinline__ void operator()(const f32x4 (&acc)[2][2][4][2], const Unit& u, int wr, int wc, int fr, int fq) const {
        const bool add = u.pm < 128; const int zc0 = add ? 3712 : 2688;
        const int row0 = (u.pm & 127) * BM + wr * 64 + fr, col0 = (u.pn & 3) * BM + wc * 32 + 8 * fq;
#pragma unroll
        for (int ai = 0; ai < 2; ++ai) {
            u32x4 zg[4][2], pv[4][2];
#pragma unroll
            for (int m = 0; m < 4; ++m) { const size_t row = (size_t)(row0 + ai * HALF + m * 16);
#pragma unroll
                for (int bj = 0; bj < 2; ++bj) { zg[m][bj] = *(const u32x4*)(Z + row * 4736 + zc0 + col0 + bj * HALF); pv[m][bj] = (u32x4){0u, 0u, 0u, 0u}; if (add) pv[m][bj] = *(const u32x4*)(O + row * 1024 + col0 + bj * HALF); } }
#pragma unroll
            for (int m = 0; m < 4; ++m) { const size_t row = (size_t)(row0 + ai * HALF + m * 16); bf16_t* rowp = O + row * 1024 + col0;
#pragma unroll
                for (int bj = 0; bj < 2; ++bj) { const f32x4 v0 = acc[ai][bj][m][0], v1 = acc[ai][bj][m][1]; const u32x4 g = zg[m][bj], p = pv[m][bj];
                    const float r0 = sigm(bflo(g.x)) * v0[0] + bflo(p.x), r1 = sigm(bfhi(g.x)) * v0[1] + bfhi(p.x), r2 = sigm(bflo(g.y)) * v0[2] + bflo(p.y), r3 = sigm(bfhi(g.y)) * v0[3] + bfhi(p.y);
                    const float r4 = sigm(bflo(g.z)) * v1[0] + bflo(p.z), r5 = sigm(bfhi(g.z)) * v1[1] + bfhi(p.z), r6 = sigm(bflo(g.w)) * v1[2] + bflo(p.w), r7 = sigm(bfhi(g.w)) * v1[3] + bfhi(p.w);
                    u32x4 w; w.x = cvt_pk_bf16(r0, r1); w.y = cvt_pk_bf16(r2, r3); w.z = cvt_pk_bf16(r4, r5); w.w = cvt_pk_bf16(r6, r7);
                    *(u32x4*)(rowp + bj * HALF) = w; } } }
    }
};
struct MergeOrder { StaticOrder S; int nu;
    __device__ __forceinline__ void init(int G, int c) { S.init(32768, 1024, G, c); nu = (512 - c + G - 1) / G; }
    __device__ __forceinline__ bool next(int i, Unit& u) const { if (i >= 2 * nu) return false; Unit t; S.next(i < nu ? i : i - nu, t);
        if (i < nu) { u.pm = 128 + t.pm; u.pn = t.pn; } else { u.pm = t.pm; u.pn = 4 + t.pn; } return true; }
    __device__ __forceinline__ void a_ready(const Unit&) const {}
    __device__ __forceinline__ void done(const Unit&) const {}
};
struct EpiRes { static constexpr bool PERM = true, AFTER_DRAIN = false; const float* X; const float* mod; bf16_t* O;
    __device__ __forceinline__ void operator()(const f32x4 (&acc)[2][2][4][2], const Unit& u, int wr, int wc, int fr, int fq) const {
        const int row0 = u.pm * BM + wr * 64 + fr, col0 = u.pn * BM + wc * 32 + 8 * fq; const int b = (u.pm * BM) >> 11;
        f32x4 gt[2][2];
#pragma unroll
        for (int bj = 0; bj < 2; ++bj)
#pragma unroll
            for (int n = 0; n < 2; ++n) gt[bj][n] = *(const f32x4*)(mod + (size_t)b * 6144 + 2048 + col0 + bj * HALF + n * 4);
#pragma unroll
        for (int ai = 0; ai < 2; ++ai) { f32x4 xv[4][2][2];
#pragma unroll
            for (int m = 0; m < 4; ++m) { const size_t off = (size_t)(row0 + ai * HALF + m * 16) * 1024 + col0;
#pragma unroll
                for (int bj = 0; bj < 2; ++bj) { xv[m][bj][0] = *(const f32x4*)(X + off + bj * HALF); xv[m][bj][1] = *(const f32x4*)(X + off + bj * HALF + 4); } }
#pragma unroll
            for (int m = 0; m < 4; ++m) { const size_t off = (size_t)(row0 + ai * HALF + m * 16) * 1024 + col0;
#pragma unroll
                for (int bj = 0; bj < 2; ++bj) { const f32x4 v0 = xv[m][bj][0] + gt[bj][0] * acc[ai][bj][m][0], v1 = xv[m][bj][1] + gt[bj][1] * acc[ai][bj][m][1];
                    u32x4 w; w.x = cvt_pk_bf16(v0[0], v0[1]); w.y = cvt_pk_bf16(v0[2], v0[3]); w.z = cvt_pk_bf16(v1[0], v1[1]); w.w = cvt_pk_bf16(v1[2], v1[3]);
                    *(u32x4*)(O + off + bj * HALF) = w; } } }
    }
};
template <int NPL> struct GroupOrder { int G, c;
    __device__ __forceinline__ bool next(int i, Unit& u) const { const int L = i * G + c; if (L >= 256 * NPL) return false;
        if (G == 256) {
            const int q = i * 32 + (c >> 3), e = (c & 7) * 2 + q / (16 * NPL), r = q % (16 * NPL), rho = r >> 5, j = r & 31;
            u.pm = e * 16 + (rho & 1) * 8 + (j & 7); u.pn = e * NPL + (rho >> 1) * 4 + (j >> 3); return true; }
        const int e = L / (16 * NPL), r = L % (16 * NPL); u.pm = e * 16 + (r % 16); u.pn = e * NPL + r / 16; return true; }
    __device__ __forceinline__ void a_ready(const Unit&) const {}
    __device__ __forceinline__ void done(const Unit&) const {}
};
struct EpiSwiglu { static constexpr bool PERM = true, AFTER_DRAIN = false; bf16_t* O;
    __device__ __forceinline__ void operator()(const f32x4 (&acc)[2][2][4][2], const Unit& u, int wr, int wc, int fr, int fq) const {
        const int row0 = u.pm * BM + wr * 64 + fr, col0 = (u.pn & 7) * 128 + wc * 32 + 8 * fq;
#pragma unroll
        for (int ai = 0; ai < 2; ++ai)
#pragma unroll
            for (int m = 0; m < 4; ++m) { bf16_t* rowp = O + (size_t)(row0 + ai * HALF + m * 16) * 1024 + col0;
                float r[8];
#pragma unroll
                for (int n = 0; n < 2; ++n)
#pragma unroll
                    for (int i = 0; i < 4; ++i) { const float g = acc[ai][0][m][n][i], up = acc[ai][1][m][n][i]; r[n * 4 + i] = g * sigm(g) * up; }
                u32x4 w; w.x = cvt_pk_bf16(r[0], r[1]); w.y = cvt_pk_bf16(r[2], r[3]); w.z = cvt_pk_bf16(r[4], r[5]); w.w = cvt_pk_bf16(r[6], r[7]);
                *(u32x4*)rowp = w; }
    }
};
struct EpiDown { static constexpr bool PERM = true, AFTER_DRAIN = false; bf16_t* O; const float* aff;
    __device__ __forceinline__ void operator()(const f32x4 (&acc)[2][2][4][2], const Unit& u, int wr, int wc, int fr, int fq) const {
        const int row0 = u.pm * BM + wr * 64 + fr, col0 = (u.pn & 3) * BM + wc * 32 + 8 * fq;
        float av[2][4];
#pragma unroll
        for (int ai = 0; ai < 2; ++ai)
#pragma unroll
            for (int m = 0; m < 4; ++m) av[ai][m] = aff[row0 + ai * HALF + m * 16];
#pragma unroll
        for (int ai = 0; ai < 2; ++ai)
#pragma unroll
            for (int m = 0; m < 4; ++m) { const int row = row0 + ai * HALF + m * 16; const float a = av[ai][m]; bf16_t* rowp = O + (size_t)row * 1024 + col0;
#pragma unroll
                for (int bj = 0; bj < 2; ++bj) { const f32x4 v0 = acc[ai][bj][m][0] * a, v1 = acc[ai][bj][m][1] * a;
                    u32x4 w; w.x = cvt_pk_bf16(v0[0], v0[1]); w.y = cvt_pk_bf16(v0[2], v0[3]); w.z = cvt_pk_bf16(v1[0], v1[1]); w.w = cvt_pk_bf16(v1[2], v1[3]);
                    *(u32x4*)(rowp + bj * HALF) = w; } }
    }
};
}

struct Frame { LAS unsigned char* lds; volatile LAS unsigned* MISC; gu32* ctl; int tid, lane, wave, vcu, G; };
struct Args { const void* in[30]; float* out; unsigned char* ws; int ph_lo, ph_hi; };
typedef const __attribute__((address_space(4))) Args* ArgsP;
#define LAUNDER(p) asm volatile("" : "+s"(p))
typedef float f32x16 __attribute__((ext_vector_type(16)));
typedef unsigned u32x2 __attribute__((ext_vector_type(2)));

__device__ __forceinline__ float wave_sum(float v) {
#pragma unroll
    for (int o = 1; o < 64; o <<= 1) v += __shfl_xor(v, o);
    return v;
}
__device__ __forceinline__ float bf2f(bf16 h) { return __uint_as_float(((unsigned)h) << 16); }
__device__ __forceinline__ float bflo(unsigned w) { return __uint_as_float(w << 16); }
__device__ __forceinline__ float bfhi(unsigned w) { return __uint_as_float(w & 0xffff0000u); }
__device__ __forceinline__ float sigm(float x) { return 1.0f / (1.0f + __expf(-x)); }

__device__ __forceinline__ void tr_item(const float* W, int N, int k0, int n0, bf16* WT, int KD, int dst_row0, LAS float* scr, int lane) {
    f32x4 v[8];
#pragma unroll
    for (int i = 0; i < 8; ++i) v[i] = *(const GAS f32x4*)(W + (size_t)(k0 + 8 * i + (lane >> 3)) * N + n0 + 4 * (lane & 7));
#pragma unroll
    for (int i = 0; i < 8; ++i) { LAS float* d = scr + (8 * i + (lane >> 3)) * 33 + 4 * (lane & 7); d[0] = v[i].x; d[1] = v[i].y; d[2] = v[i].z; d[3] = v[i].w; }
    LDS_WAIT(); asm volatile("" ::: "memory");
    const int c = lane & 7;
#pragma unroll
    for (int j = 0; j < 4; ++j) { const int n = (lane >> 3) + 8 * j; const LAS float* s = scr + (8 * c) * 33 + n;
        v4u o; o.x = pk2(s[0 * 33], s[1 * 33]); o.y = pk2(s[2 * 33], s[3 * 33]); o.z = pk2(s[4 * 33], s[5 * 33]); o.w = pk2(s[6 * 33], s[7 * 33]);
        *(GAS v4u*)(WT + (size_t)(dst_row0 + n) * KD + k0 + 8 * c) = o; }
    LDS_WAIT(); asm volatile("" ::: "memory");
}

__device__ __forceinline__ void p0_prologue(const Frame& F, ArgsP A) {
    unsigned char* ws = A->ws;
    LAS float* scr = (LAS float*)(F.lds + F.wave * 16384);
    const int gw = F.vcu * NWAVES + F.wave, NGW = F.G * NWAVES;
    const float* w_in = (const float*)A->in[6]; const float* p_rwkv = (const float*)A->in[22]; const float* p_attn = (const float*)A->in[23];
    const float* w_out = (const float*)A->in[24]; const float* g2 = (const float*)A->in[13];
    bf16* WinT = (bf16*)(ws + WS_WINT); bf16* PrT = (bf16*)(ws + WS_PRT); bf16* PaT = (bf16*)(ws + WS_PAT); bf16* WoT = (bf16*)(ws + WS_WOT); bf16* G2T = (bf16*)(ws + WS_G2T);
    constexpr int I_IN = 16 * 148, I_P = 8 * 32, I_O = 16 * 32, I_G = 2 * 16, NIT = I_IN + 2 * I_P + I_O + I_G;
    for (int it = gw; it < NIT; it += NGW) {
        int r = it;
        if (r < I_IN) { tr_item(w_in, NZ, 64 * (r / 148), 32 * (r % 148), WinT, 1024, 32 * (r % 148), scr, F.lane); continue; } r -= I_IN;
        if (r < I_P) { tr_item(p_rwkv, 1024, 64 * (r / 32), 32 * (r % 32), PrT, 512, 32 * (r % 32), scr, F.lane); continue; } r -= I_P;
        if (r < I_P) { tr_item(p_attn, 1024, 64 * (r / 32), 32 * (r % 32), PaT, 512, 32 * (r % 32), scr, F.lane); continue; } r -= I_P;
        if (r < I_O) { tr_item(w_out, 1024, 64 * (r / 32), 32 * (r % 32), WoT, 1024, 32 * (r % 32), scr, F.lane); continue; } r -= I_O;
        tr_item(g2, 512, 64 * (r / 16), 32 * (r % 16), G2T, 256, 32 * (r % 16), scr, F.lane);
    }
    { const int gt = (F.vcu * NWAVES + F.wave) * 64 + F.lane, NT = F.G * NWAVES * 64; const v4u z4 = {0u, 0u, 0u, 0u};
      for (int i = gt; i < 128 * 128; i += NT) *(GAS v4u*)(WinT + (size_t)4736 * 1024 + (size_t)i * 8) = z4;
      for (int i = gt; i < 512 * 16; i += NT) *(GAS v4u*)(G2T + (size_t)(i >> 4) * 256 + 128 + (i & 15) * 8) = z4; }
    __syncthreads();
    const float* cvec = (const float*)A->in[1]; const float* w_ada = (const float*)A->in[3]; const float* b_ada = (const float*)A->in[4];
    float* mod = (float*)(ws + WS_MOD);
    for (int task = F.vcu; task < 192; task += F.G) { const int cg = task % 96, dh = task / 96;
        LAS float* ca = (LAS float*)F.lds;
        LAS float* red = (LAS float*)(F.lds + 65536);
        for (int i = F.tid; i < 16 * 1024; i += 512) { const int b = i >> 10, d = i & 1023; const float cv = cvec[i]; ca[d * 16 + b] = cv / (1.0f + __expf(-cv)); }
        __syncthreads();
        float acc[16];
#pragma unroll
        for (int b = 0; b < 16; ++b) acc[b] = 0.f;
        const int col = cg * 64 + F.lane;
#pragma unroll 8
        for (int dd = 0; dd < 64; ++dd) { const int d = dh * 512 + F.wave * 64 + dd; const float w = w_ada[(size_t)d * 6144 + col];
            const LAS f32x4* cp = (const LAS f32x4*)(ca + d * 16);
#pragma unroll
            for (int q = 0; q < 4; ++q) { const f32x4 cv = cp[q]; acc[q * 4 + 0] += cv[0] * w; acc[q * 4 + 1] += cv[1] * w; acc[q * 4 + 2] += cv[2] * w; acc[q * 4 + 3] += cv[3] * w; } }
#pragma unroll
        for (int b = 0; b < 16; ++b) red[(F.wave * 16 + b) * 64 + F.lane] = acc[b];
        __syncthreads();
        for (int o = F.tid; o < 1024; o += 512) { const int b = o >> 6, cl = o & 63; float sacc = 0.f;
#pragma unroll
            for (int w = 0; w < 8; ++w) sacc += red[(w * 16 + b) * 64 + cl];
            atomicAdd(&mod[b * 6144 + cg * 64 + cl], sacc + (dh == 0 ? b_ada[cg * 64 + cl] : 0.f)); }
        __syncthreads();
    }
}


__device__ __forceinline__ float dpp_wave_sum(float v) {
    v += __int_as_float(__builtin_amdgcn_update_dpp(0, __float_as_int(v), 0xB1, 0xf, 0xf, false));
    v += __int_as_float(__builtin_amdgcn_update_dpp(0, __float_as_int(v), 0x4E, 0xf, 0xf, false));
    v += __int_as_float(__builtin_amdgcn_update_dpp(0, __float_as_int(v), 0x141, 0xf, 0xf, false));
    v += __int_as_float(__builtin_amdgcn_update_dpp(0, __float_as_int(v), 0x140, 0xf, 0xf, false));
    v += __int_as_float(__builtin_amdgcn_ds_swizzle(__float_as_int(v), 0x401F));
    auto r_ = __builtin_amdgcn_permlane32_swap(__float_as_uint(v), __float_as_uint(v), false, false);
    return __uint_as_float(r_[0]) + __uint_as_float(r_[1]); }

template <int R, bool XBF> __device__ __forceinline__ void modnorm_rows(const void* x, int m0, int mstride, const float* g, const float* mod, int sh_off, int sc_off, bf16* out, int lane, f32x4 (&u)[R][4]) {
    f32x4 v[R][4];
#pragma unroll
    for (int i = 0; i < R; ++i) {
        if (XBF) { const GAS u32x2* xr = (const GAS u32x2*)((const bf16*)x + (size_t)(m0 + i * mstride) * 1024) + lane;
#pragma unroll
            for (int j = 0; j < 4; ++j) { const u32x2 w = xr[64 * j]; v[i][j] = (f32x4){bflo(w.x), bfhi(w.x), bflo(w.y), bfhi(w.y)}; } }
        else { const GAS f32x4* xr = (const GAS f32x4*)((const float*)x + (size_t)(m0 + i * mstride) * 1024) + lane;
#pragma unroll
            for (int j = 0; j < 4; ++j) v[i][j] = xr[64 * j]; } }
    f32x4 gg[4];
#pragma unroll
    for (int j = 0; j < 4; ++j) gg[j] = ((const GAS f32x4*)g)[lane + 64 * j];
#pragma unroll
    for (int i = 0; i < R; ++i) { const int m = m0 + i * mstride, b = m >> 11; float s = 0.f;
#pragma unroll
        for (int j = 0; j < 4; ++j) s += (v[i][j].x * v[i][j].x + v[i][j].y * v[i][j].y) + (v[i][j].z * v[i][j].z + v[i][j].w * v[i][j].w);
        const float rs = rsqrtf(dpp_wave_sum(s) * (1.0f / 1024.0f) + 1e-6f);
        const float* sh = mod + (size_t)b * 6144 + sh_off; const float* sc = mod + (size_t)b * 6144 + sc_off;
        GAS unsigned long long* o8 = (GAS unsigned long long*)(out + (size_t)m * 1024) + lane;
#pragma unroll
        for (int j = 0; j < 4; ++j) { const f32x4 s1 = ((const GAS f32x4*)sc)[lane + 64 * j], s0 = ((const GAS f32x4*)sh)[lane + 64 * j];
            f32x4 y = (v[i][j] * rs) * gg[j]; y = y * (s1 + 1.0f) + s0; u[i][j] = y;
            o8[64 * j] = (unsigned long long)pk2(y.x, y.y) | ((unsigned long long)pk2(y.z, y.w) << 32); } }
}

template <int R> __device__ __forceinline__ void load_rows_bf16(const bf16* x, int m0, int mstride, int lane_in, u32x2 (&raw)[R][4]) {
    int lane = lane_in; asm volatile("" : "+v"(lane));
#pragma unroll
    for (int i = 0; i < R; ++i) { const GAS u32x2* xr = (const GAS u32x2*)(x + (size_t)(m0 + i * mstride) * 1024) + lane;
#pragma unroll
        for (int j = 0; j < 4; ++j) raw[i][j] = xr[64 * j]; }
}
template <int R> __device__ __forceinline__ void modnorm_rows_pre(const u32x2 (&raw)[R][4], int m0, int mstride, const float* g, const float* mod, int sh_off, int sc_off, bf16* out, int lane, f32x4 (&u)[R][4]) {
    f32x4 gg[4];
#pragma unroll
    for (int j = 0; j < 4; ++j) gg[j] = ((const GAS f32x4*)g)[lane + 64 * j];
#pragma unroll
    for (int i = 0; i < R; ++i) { const int m = m0 + i * mstride, b = m >> 11; float s = 0.f; f32x4 v[4];
#pragma unroll
        for (int j = 0; j < 4; ++j) { const u32x2 w = raw[i][j]; v[j] = (f32x4){bflo(w.x), bfhi(w.x), bflo(w.y), bfhi(w.y)}; s += (v[j].x * v[j].x + v[j].y * v[j].y) + (v[j].z * v[j].z + v[j].w * v[j].w); }
        const float rs = rsqrtf(dpp_wave_sum(s) * (1.0f / 1024.0f) + 1e-6f);
        const float* sh = mod + (size_t)b * 6144 + sh_off; const float* sc = mod + (size_t)b * 6144 + sc_off;
        GAS unsigned long long* o8 = (GAS unsigned long long*)(out + (size_t)m * 1024) + lane;
#pragma unroll
        for (int j = 0; j < 4; ++j) { const f32x4 s1 = ((const GAS f32x4*)sc)[lane + 64 * j], s0 = ((const GAS f32x4*)sh)[lane + 64 * j];
            f32x4 y = (v[j] * rs) * gg[j]; y = y * (s1 + 1.0f) + s0; u[i][j] = y;
            o8[64 * j] = (unsigned long long)pk2(y.x, y.y) | ((unsigned long long)pk2(y.z, y.w) << 32); } }
}

__device__ __forceinline__ void modnorm_row(const float* xrow, const float* g, const float* sh, const float* sc, bf16* orow, int lane, f32x4 (&u)[4]) {
    const GAS f32x4* xr = (const GAS f32x4*)xrow + lane;
    f32x4 v[4]; float s = 0.f;
#pragma unroll
    for (int j = 0; j < 4; ++j) { v[j] = xr[64 * j]; s += (v[j].x * v[j].x + v[j].y * v[j].y) + (v[j].z * v[j].z + v[j].w * v[j].w); }
    const float rs = rsqrtf(wave_sum(s) * (1.0f / 1024.0f) + 1e-6f);
    GAS unsigned long long* o8 = (GAS unsigned long long*)orow + lane;
#pragma unroll
    for (int j = 0; j < 4; ++j) { const f32x4 gg = ((const GAS f32x4*)g)[lane + 64 * j], s1 = ((const GAS f32x4*)sc)[lane + 64 * j], s0 = ((const GAS f32x4*)sh)[lane + 64 * j];
        f32x4 y = (v[j] * rs) * gg; y = y * (s1 + 1.0f) + s0; u[j] = y;
        o8[64 * j] = (unsigned long long)pk2(y.x, y.y) | ((unsigned long long)pk2(y.z, y.w) << 32); }
}

__device__ __forceinline__ float softplusf(float x) { return x > 20.f ? x : log1pf(__expf(x)); }
__device__ __forceinline__ void scan_chain(const Frame& F, ArgsP A, int b, int h, int dir) {
    constexpr int CT = 32;
    LAS float* L = (LAS float*)F.lds;
    LAS float* W2S = L; LAS float* A2S = L + 4096; LAS float* ZRs = L + 8192; LAS float* ZKs = ZRs + 2048; LAS float* ZVs = ZKs + 2048; LAS float* TWs = ZVs + 2048; LAS float* ZAs = TWs + 2048;
    LAS float* DEC = ZAs + 2048; LAS float* KD = DEC + 2048; LAS float* AV = KD + 2048; LAS float* BV = AV + 2048; LAS float* YB = BV + 2048; LAS float* BON = YB + 2048;
    const bf16* Z = (const bf16*)(A->ws + WS_Z);
    const float* mu_prev = (const float*)A->in[7]; const float* mu_next = (const float*)A->in[8];
    const float* w0 = (const float*)A->in[9]; const float* w2 = (const float*)A->in[10]; const float* a0 = (const float*)A->in[11]; const float* a2 = (const float*)A->in[12];
    const float* k_k = (const float*)A->in[14]; const float* k_a = (const float*)A->in[15]; const float* r_k = (const float*)A->in[16];
    bf16* ydir = (bf16*)(A->ws + WS_XN) + (size_t)dir * M * 512; float* bonus = (float*)(A->ws + WS_BONUS) + (size_t)dir * M * 8;
    const int tid = F.tid, lane = F.lane, wave = F.wave;
    for (int i = tid; i < 4096; i += 512) { const int l = i >> 6, j = i & 63; W2S[i] = w2[((size_t)dir * 64 + l) * 512 + h * 64 + j]; A2S[i] = a2[((size_t)dir * 64 + l) * 512 + h * 64 + j]; }
    const int ch = h * 64 + lane;
    const float w0j = w0[dir * 512 + ch], a0j = a0[dir * 512 + ch], kkj = k_k[ch], kaj = k_a[ch], rkj = r_k[ch];
    float s[8];
#pragma unroll
    for (int q = 0; q < 8; ++q) s[q] = 0.f;
    const int ri = tid >> 3, jg = tid & 7;
    for (int ci = 0; ci < T / CT; ++ci) {
        const int t0 = (dir ? (T / CT - 1 - ci) : ci) * CT;
#pragma unroll 4
        for (int i = 0; i < 20; ++i) { const int e = tid + 512 * i, arr = e >> 11, rem = e & 2047, tl = rem >> 6, j = rem & 63;
            const int col = (arr == 0 ? ZR + h * 64 : arr == 1 ? ZK + h * 64 : arr == 2 ? ZV + h * 64 : arr == 3 ? ZWD + dir * 64 : ZAD + dir * 64) + j;
            const int t = t0 + tl; const bf16* zp = Z + ((size_t)b * T + t) * NZ + col;
            const float z0 = bf2f(zp[0]), zm = t > 0 ? bf2f(zp[-NZ]) : 0.f, zq = t < T - 1 ? bf2f(zp[NZ]) : 0.f;
            float zs = z0 + mu_prev[col] * (zm - z0) + mu_next[col] * (zq - z0);
            if (arr == 3) zs = tanhf(zs);
            ZRs[arr * 2048 + rem] = zs; }
        __syncthreads();
#pragma unroll 1
        for (int q = 0; q < 4; ++q) { const int tl = wave + 8 * q;
            float wraw = w0j, araw = a0j;
#pragma unroll 8
            for (int l = 0; l < 64; ++l) { wraw += TWs[tl * 64 + l] * W2S[l * 64 + lane]; araw += ZAs[tl * 64 + l] * A2S[l * 64 + lane]; }
            const float w = -softplusf(-wraw) - 0.5f, dec = __expf(-__expf(w)), ad = sigm(araw);
            const float k = ZKs[tl * 64 + lane], kkr = k * kkj, nrm = sqrtf(wave_sum(kkr * kkr)), kk = kkr / fmaxf(nrm, 1e-12f);
            const float kd = k * (1.0f + (ad - 1.0f) * kaj);
            DEC[tl * 64 + lane] = dec; KD[tl * 64 + lane] = kd; AV[tl * 64 + lane] = -kk; BV[tl * 64 + lane] = kk * ad;
            const float bon = wave_sum(ZRs[tl * 64 + lane] * kd * rkj); if (lane == 0) BON[tl] = bon; }
        __syncthreads();
#pragma unroll 1
        for (int st = 0; st < CT; ++st) { const int tl = dir ? (CT - 1 - st) : st; const int o = tl * 64 + jg * 8;
            const f32x4 a0v = *(const LAS f32x4*)(AV + o), a1v = *(const LAS f32x4*)(AV + o + 4), d0 = *(const LAS f32x4*)(DEC + o), d1 = *(const LAS f32x4*)(DEC + o + 4);
            const f32x4 b0 = *(const LAS f32x4*)(BV + o), b1 = *(const LAS f32x4*)(BV + o + 4), k0 = *(const LAS f32x4*)(KD + o), k1 = *(const LAS f32x4*)(KD + o + 4);
            const f32x4 r0 = *(const LAS f32x4*)(ZRs + o), r1 = *(const LAS f32x4*)(ZRs + o + 4); const float vi = ZVs[tl * 64 + ri];
            float p = (s[0] * a0v[0] + s[1] * a0v[1]) + (s[2] * a0v[2] + s[3] * a0v[3]) + (s[4] * a1v[0] + s[5] * a1v[1]) + (s[6] * a1v[2] + s[7] * a1v[3]);
            p += __shfl_xor(p, 1); p += __shfl_xor(p, 2); p += __shfl_xor(p, 4);
            s[0] = s[0] * d0[0] + p * b0[0] + vi * k0[0]; s[1] = s[1] * d0[1] + p * b0[1] + vi * k0[1]; s[2] = s[2] * d0[2] + p * b0[2] + vi * k0[2]; s[3] = s[3] * d0[3] + p * b0[3] + vi * k0[3];
            s[4] = s[4] * d1[0] + p * b1[0] + vi * k1[0]; s[5] = s[5] * d1[1] + p * b1[1] + vi * k1[1]; s[6] = s[6] * d1[2] + p * b1[2] + vi * k1[2]; s[7] = s[7] * d1[3] + p * b1[3] + vi * k1[3];
            float y = (s[0] * r0[0] + s[1] * r0[1]) + (s[2] * r0[2] + s[3] * r0[3]) + (s[4] * r1[0] + s[5] * r1[1]) + (s[6] * r1[2] + s[7] * r1[3]);
            y += __shfl_xor(y, 1); y += __shfl_xor(y, 2); y += __shfl_xor(y, 4);
            if (jg == 0) YB[tl * 64 + ri] = y; }
        __syncthreads();
#pragma unroll
        for (int i = 0; i < 4; ++i) { const int e = tid + 512 * i, tl = e >> 6, c = e & 63; ydir[((size_t)b * T + t0 + tl) * 512 + h * 64 + c] = (bf16)f2bf(YB[e]); }
        if (tid < CT) bonus[((size_t)b * T + t0 + tid) * 8 + h] = BON[tid];
        __syncthreads();
    }
}


#define SDEV __device__ __forceinline__
#define S_UNROLL _Pragma("unroll")
#define S_MEMBAR() do { asm volatile("" ::: "memory"); __builtin_amdgcn_sched_barrier(0); } while (0)
#define S_LAUNDER_I(x) asm volatile("" : "+v"(x))
#define S_LAUNDER_S(x) asm volatile("" : "+s"(x))
#define S_PIN(x) asm volatile("" : "+v"(x))
typedef float f32x2s __attribute__((ext_vector_type(2))); typedef __bf16 bf16x2s __attribute__((ext_vector_type(2)));
__device__ __forceinline__ unsigned s_cvtpk(float lo, float hi) { f32x2s v = {lo, hi}; bf16x2s b = __builtin_convertvector(v, bf16x2s); return __builtin_bit_cast(unsigned, b); }
__device__ __forceinline__ float s_rowsum16(float v) {
    v += __int_as_float(__builtin_amdgcn_update_dpp(0, __float_as_int(v), 0xB1, 0xf, 0xf, false));
    v += __int_as_float(__builtin_amdgcn_update_dpp(0, __float_as_int(v), 0x4E, 0xf, 0xf, false));
    v += __int_as_float(__builtin_amdgcn_update_dpp(0, __float_as_int(v), 0x141, 0xf, 0xf, false));
    v += __int_as_float(__builtin_amdgcn_update_dpp(0, __float_as_int(v), 0x140, 0xf, 0xf, false));
    return v; }
#define S_MFMA(a, b, c) __builtin_amdgcn_mfma_f32_32x32x16_bf16(a, b, c, 0, 0, 0)
#define S_PK(lo, hi) s_cvtpk(lo, hi)
#define S_SWAP(x, y) do { auto r_ = __builtin_amdgcn_permlane32_swap(x, y, false, false); x = r_[0]; y = r_[1]; } while (0)
#define S_ROWSUM16(v) s_rowsum16(v)
__device__ __forceinline__ float s_wavesum(float v) { v = s_rowsum16(v);
    v += __int_as_float(__builtin_amdgcn_ds_swizzle(__float_as_int(v), 0x401F));
    auto r_ = __builtin_amdgcn_permlane32_swap(__float_as_uint(v), __float_as_uint(v), false, false);
    return __uint_as_float(r_[0]) + __uint_as_float(r_[1]); }
#define S_WAVESUM(v) s_wavesum(v)
#define S_SWAP16(x, y) do { auto r_ = __builtin_amdgcn_permlane16_swap(x, y, false, false); x = r_[0]; y = r_[1]; } while (0)
#define S_DPPF(v, ctrl) __int_as_float(__builtin_amdgcn_update_dpp(0, __float_as_int(v), ctrl, 0xf, 0xf, false))
__device__ __forceinline__ float s_treesum32(float (&q)[32], int lane) {
    _Pragma("unroll") for (int i = 0; i < 16; ++i) { unsigned x = __float_as_uint(q[i]), y = __float_as_uint(q[i + 16]); S_SWAP(x, y); q[i] = __uint_as_float(x) + __uint_as_float(y); }
    _Pragma("unroll") for (int i = 0; i < 8; ++i) { unsigned x = __float_as_uint(q[i]), y = __float_as_uint(q[i + 8]); S_SWAP16(x, y); q[i] = __uint_as_float(x) + __uint_as_float(y); }
    const bool b3 = (lane & 8) != 0, b2 = (lane & 4) != 0, b1 = (lane & 2) != 0;
    _Pragma("unroll") for (int i = 0; i < 4; ++i) { const float a = q[i], b = q[i + 4]; const float c = b3 ? b : a, d = b3 ? a : b; q[i] = c + S_DPPF(d, 0x140); }
    _Pragma("unroll") for (int i = 0; i < 2; ++i) { const float a = q[i], b = q[i + 2]; const float c = b2 ? b : a, d = b2 ? a : b; q[i] = c + S_DPPF(d, 0x141); }
    { const float a = q[0], b = q[1]; const float c = b1 ? b : a, d = b1 ? a : b; q[0] = c + S_DPPF(d, 0x1B); }
    return q[0] + S_DPPF(q[0], 0xB1); }
#define S_GAS GAS
#define S_READLANE(v, l) __int_as_float(__builtin_amdgcn_readlane(__float_as_int(v), l))
#define S_RCP(x) __builtin_amdgcn_rcpf(x)
#define S_EXP2(x) __builtin_amdgcn_exp2f(x)
#define S_LOG2(x) __builtin_amdgcn_logf(x)
#define S_RSQ(x) __builtin_amdgcn_rsqf(x)
#define S_LDS_WAIT() asm volatile("s_waitcnt lgkmcnt(0)" ::: "memory")
#define S_LDSP LAS unsigned char*
#define S_LDS_BF16P LAS bf16*
#define S_LDS_U32P LAS unsigned*
#define S_LDS_F32P LAS float*
#define S_LDS_CONST_BF16X8P const LAS bf16x8*
#define S_LDS_BF16X8P LAS bf16x8*
#define S_LDS_CONST_F32X4P const LAS f32x4*
#define S_LDS_CONST_F32P const LAS float*
#define S_FLAG_STORE(p, v) do { *(volatile LAS unsigned*)(p) = (v); } while (0)
#define S_FLAG_WAIT(p, v) do { unsigned sp_ = 0; while (*(volatile LAS unsigned*)(p) != (v)) { __builtin_amdgcn_s_sleep(2); if (++sp_ > (1u << 24)) break; } asm volatile("" ::: "memory"); } while (0)
struct SFrag { bf16x8 s[2]; };
struct SMat { SFrag t[2]; };
SDEV f32x16 smm(const SFrag& X, const SFrag& Y, f32x16 acc) { acc = S_MFMA(X.s[0], Y.s[0], acc); acc = S_MFMA(X.s[1], Y.s[1], acc); return acc; }
SDEV f32x16 szero() { f32x16 z; S_UNROLL for (int i = 0; i < 16; ++i) z[i] = 0.f; return z; }
SDEV SFrag spack(const f32x16& d) { SFrag f;
    S_UNROLL for (int s = 0; s < 2; ++s) { v4u w; S_UNROLL for (int q = 0; q < 4; ++q) w[q] = S_PK(d[8 * s + 2 * q], d[8 * s + 2 * q + 1]); f.s[s] = __builtin_bit_cast(bf16x8, w); }
    return f; }
SDEV f32x16 sunpack(const SFrag& f) { f32x16 d;
    S_UNROLL for (int s = 0; s < 2; ++s) { const v4u w = __builtin_bit_cast(v4u, f.s[s]); S_UNROLL for (int q = 0; q < 4; ++q) { d[8 * s + 2 * q] = __uint_as_float(w[q] << 16); d[8 * s + 2 * q + 1] = __uint_as_float(w[q] & 0xffff0000u); } }
    return d; }
SDEV SMat splain2d(const unsigned (&pp)[16]) { unsigned d0[8], d1[8];
    S_UNROLL for (int g = 0; g < 4; ++g) S_UNROLL for (int p = 0; p < 2; ++p) { unsigned x = pp[4 * g + p], y = pp[4 * g + 2 + p]; S_SWAP(x, y); d0[2 * g + p] = x; d1[2 * g + p] = y; }
    SMat m;
    S_UNROLL for (int s = 0; s < 2; ++s) { v4u a, b; S_UNROLL for (int q = 0; q < 4; ++q) { a[q] = d0[4 * s + q]; b[q] = d1[4 * s + q]; } m.t[0].s[s] = __builtin_bit_cast(bf16x8, a); m.t[1].s[s] = __builtin_bit_cast(bf16x8, b); }
    return m; }
SDEV void sd2plain(const f32x16& D0, const f32x16& D1, float (&x)[32]) {
    S_UNROLL for (int r = 0; r < 16; ++r) { unsigned a = __float_as_uint(D0[r]), b = __float_as_uint(D1[r]); S_SWAP(a, b); const int ta = (r & 3) + 8 * (r >> 2); x[ta] = __uint_as_float(a); x[ta + 4] = __uint_as_float(b); } }
SDEV SFrag sident(int n_in, int hh_in) { int n1 = n_in, r1 = 4 * hh_in; S_LAUNDER_I(n1); S_LAUNDER_I(r1); f32x16 id; S_UNROLL for (int g = 0; g < 16; ++g) id[g] = (((g & 3) + 8 * (g >> 2) + r1) == n1) ? 1.f : 0.f; return spack(id); }
SDEV void sd2plain_pk(const f32x16& D0, const f32x16& D1, unsigned (&xp)[16]) {
    S_UNROLL for (int m = 0; m < 8; ++m) { unsigned a = S_PK(D0[2 * m], D0[2 * m + 1]), b = S_PK(D1[2 * m], D1[2 * m + 1]); S_SWAP(a, b); const int qa = 4 * (m >> 1) + (m & 1); xp[qa] = a; xp[qa + 2] = b; } }
SDEV float swave_sum(float v) { return S_WAVESUM(v); }

struct ScanArgs { const S_GAS bf16* Z; const S_GAS float* mu_prev; const S_GAS float* mu_next; const S_GAS float* w0; const S_GAS float* a0; const S_GAS float* k_k; const S_GAS float* k_a; const S_GAS float* r_k; S_GAS bf16* ydir; S_GAS float* bonus; S_GAS unsigned char* prep; };

#define SC_W2F 0
#define SC_A2F 8192
#define SC_SIG 16384
#define SC_GTAB 24576
#define SC_FLAG 26624
#define SC_WR 28672
#define SC_AR 94208
#define SC_RSQ 126976
#define SC_LDS_BYTES 128000
#ifndef SB_ILP
#define SB_ILP 8
#endif
#define SC_PF 4

SDEV void scan2_setup(S_LDSP lds, const S_GAS float* w2, const S_GAS float* a2, int h, int dir, int tid) {
    { float wv[16];
      S_UNROLL for (int it = 0; it < 16; ++it) { const int e = tid + 512 * it; const int mat = e >> 12, r = e & 4095, jj = r & 7, ln = (r >> 3) & 63, s = (r >> 9) & 1, jt = (r >> 10) & 1, lt = (r >> 11) & 1;
          const int n = ln & 31, hh = ln >> 5, g = 8 * s + jj, l = 32 * lt + (g & 3) + 8 * (g >> 2) + 4 * hh, j = 32 * jt + n;
          wv[it] = (mat ? a2 : w2)[((size_t)dir * 64 + l) * 512 + h * 64 + j]; }
      S_UNROLL for (int it = 0; it < 16; ++it) { const int e = tid + 512 * it; const int mat = e >> 12, r = e & 4095;
          ((S_LDS_BF16P)(lds + (mat ? SC_A2F : SC_W2F)))[r] = (bf16)(S_PK(wv[it] * -1.442695041f, 0.f) & 0xffffu); } }
    for (int e = tid; e < 2048; e += 512) ((S_LDS_U32P)(lds + SC_SIG))[e] = 0u;
    if (tid == 0) S_FLAG_STORE(lds + SC_FLAG, 0u);
}

SDEV void scan2_prep(const ScanArgs& A_in, int b_in, int dir_in, int c, int lane_in) {
    ScanArgs A = A_in; int b = b_in, dir = dir_in;
    S_LAUNDER_S(A.Z); S_LAUNDER_S(A.mu_prev); S_LAUNDER_S(A.mu_next); S_LAUNDER_S(A.prep); S_LAUNDER_S(b); S_LAUNDER_S(dir);
    int lane = lane_in; S_LAUNDER_I(lane);
    const int n = lane & 31, hh = lane >> 5;
    const int sgn = dir ? -1 : 1, tau0 = dir ? (T - 1 - 32 * c) : 32 * c;
    const S_GAS bf16* zb = A.Z + (size_t)b * T * NZ;
    const ptrdiff_t st = (ptrdiff_t)sgn * NZ; const bool first = (c == 0), last = (c == T / 32 - 1);
    const int cw = ZWD + dir * 64 + lane, ca = ZAD + dir * 64 + lane;
    const SFrag IDF = sident(n, hh); unsigned ppw[16], ppa[16];
    { const float mA = dir ? A.mu_next[cw] : A.mu_prev[cw], mB = dir ? A.mu_prev[cw] : A.mu_next[cw], nA = dir ? A.mu_next[ca] : A.mu_prev[ca], nB = dir ? A.mu_prev[ca] : A.mu_next[ca];
      const S_GAS bf16* pw = zb + (ptrdiff_t)tau0 * NZ + cw - st; const S_GAS bf16* pa = zb + (ptrdiff_t)tau0 * NZ + ca - st;
      float rw[34], ra[34];
      S_UNROLL for (int q = 0; q < 34; ++q) { const bool ok = !((q == 0 && first) || (q == 33 && last)); rw[q] = ok ? bf2f(*pw) : 0.f; ra[q] = ok ? bf2f(*pa) : 0.f; pw += st; pa += st; }
      S_MEMBAR();
      const float mC = 1.f - mA - mB, nC = 1.f - nA - nB; float tprev = 0.f, aprev = 0.f;
      S_UNROLL for (int p = 0; p < 32; ++p) { if ((p & 7) == 0) S_MEMBAR();
          const float ws = mC * rw[p + 1] + mA * rw[p] + mB * rw[p + 2], as = nC * ra[p + 1] + nA * ra[p] + nB * ra[p + 2];
          const float tw = 1.f - 2.f * S_RCP(1.f + S_EXP2(ws * 2.885390082f));
          if (p & 1) { ppw[p >> 1] = S_PK(tprev, tw); ppa[p >> 1] = S_PK(aprev, as); S_PIN(ppw[p >> 1]); S_PIN(ppa[p >> 1]); } else { tprev = tw; aprev = as; } } }
    S_MEMBAR();
    const SMat TW = splain2d(ppw), AD = splain2d(ppa);
    S_GAS bf16x8* pf = (S_GAS bf16x8*)(A.prep + (size_t)((b * 2 + dir) * 64 + c) * 8192) + lane;
    S_UNROLL for (int lt = 0; lt < 2; ++lt) { const SFrag tw_ = spack(smm(TW.t[lt], IDF, szero())), ad_ = spack(smm(AD.t[lt], IDF, szero()));
        S_UNROLL for (int s = 0; s < 2; ++s) { pf[(lt * 2 + s) * 64] = tw_.s[s]; pf[256 + (lt * 2 + s) * 64] = ad_.s[s]; } }
}

SDEV void scan2_chunk(S_LDSP lds, const ScanArgs& A_in, int b_in, int h_in, int dir_in, int c, int lane_in, int wave) {
    ScanArgs A = A_in; int b = b_in, h = h_in, dir = dir_in;
    S_LAUNDER_S(A.Z); S_LAUNDER_S(A.mu_prev); S_LAUNDER_S(A.mu_next); S_LAUNDER_S(A.w0); S_LAUNDER_S(A.a0); S_LAUNDER_S(A.k_k); S_LAUNDER_S(A.k_a); S_LAUNDER_S(A.r_k); S_LAUNDER_S(A.ydir); S_LAUNDER_S(A.bonus); S_LAUNDER_S(A.prep);
    S_LAUNDER_S(b); S_LAUNDER_S(h); S_LAUNDER_S(dir);
    int lane = lane_in; S_LAUNDER_I(lane);
    const int n = lane & 31, hh = lane >> 5;
    const int sgn = dir ? -1 : 1, tau0 = dir ? (T - 1 - 32 * c) : 32 * c;
    const S_GAS bf16* zb = A.Z + (size_t)b * T * NZ;
    const ptrdiff_t st = (ptrdiff_t)sgn * NZ; const bool first = (c == 0), last = (c == T / 32 - 1);
    const int cr = ZR + h * 64 + lane, ck = ZK + h * 64 + lane, cv = ZV + h * 64 + lane, chn = h * 64 + lane;
    unsigned rr[34], rk[34], rv[34];
    {   SFrag TWT[2], ADT[2];
        { const S_GAS bf16x8* pf = (const S_GAS bf16x8*)(A.prep + (size_t)((b * 2 + dir) * 64 + c) * 8192) + lane;
          S_UNROLL for (int lt = 0; lt < 2; ++lt) S_UNROLL for (int s = 0; s < 2; ++s) { TWT[lt].s[s] = pf[(lt * 2 + s) * 64]; ADT[lt].s[s] = pf[256 + (lt * 2 + s) * 64]; } }
        { const S_GAS bf16* pr = zb + (ptrdiff_t)tau0 * NZ + cr - st; const S_GAS bf16* pk = zb + (ptrdiff_t)tau0 * NZ + ck - st; const S_GAS bf16* pv = zb + (ptrdiff_t)tau0 * NZ + cv - st;
          const ptrdiff_t o0 = first ? st : 0, o33 = last ? -st : 0;
          S_UNROLL for (int q = 0; q < 34; ++q) { const ptrdiff_t oo = (q == 0) ? o0 : (q == 33) ? o33 : 0; rr[q] = (unsigned)pr[oo]; rk[q] = (unsigned)pk[oo]; rv[q] = (unsigned)pv[oo]; pr += st; pk += st; pv += st; } }
        S_MEMBAR();
        f32x16 dw[2], da[2];
        S_UNROLL for (int jt = 0; jt < 2; ++jt) { const float w0s = A.w0[dir * 512 + h * 64 + 32 * jt + n] * -1.442695041f, a0s = A.a0[dir * 512 + h * 64 + 32 * jt + n] * -1.442695041f;
            S_UNROLL for (int g = 0; g < 16; ++g) { dw[jt][g] = w0s; da[jt][g] = a0s; }
            S_UNROLL for (int lt = 0; lt < 2; ++lt) { SFrag wf, af;
                S_UNROLL for (int s = 0; s < 2; ++s) { wf.s[s] = *(S_LDS_CONST_BF16X8P)(lds + SC_W2F + ((((lt * 2 + jt) * 2 + s) * 64 + lane) * 16)); af.s[s] = *(S_LDS_CONST_BF16X8P)(lds + SC_A2F + ((((lt * 2 + jt) * 2 + s) * 64 + lane) * 16)); }
                dw[jt] = smm(TWT[lt], wf, dw[jt]); da[jt] = smm(ADT[lt], af, da[jt]); } }
        S_UNROLL for (int jt = 0; jt < 2; ++jt) S_UNROLL for (int g = 0; g < 16; ++g) { const int t = (g & 3) + 8 * (g >> 2) + 4 * hh;
            ((S_LDS_F32P)(lds + SC_WR + wave * 8192))[t * 64 + 32 * jt + n] = dw[jt][g]; ((S_LDS_BF16P)(lds + SC_AR + wave * 4096))[t * 64 + 32 * jt + n] = (bf16)(S_PK(da[jt][g], 0.f) & 0xffffu); }
        S_LDS_WAIT();
    }
    S_MEMBAR();
    unsigned ppA[16], ppR[16], ppB[16], ppK[16], ppV[16], ppQ[16]; float gamC;
    {   const float mAr = dir ? A.mu_next[cr] : A.mu_prev[cr], mBr = dir ? A.mu_prev[cr] : A.mu_next[cr], mAk = dir ? A.mu_next[ck] : A.mu_prev[ck], mBk = dir ? A.mu_prev[ck] : A.mu_next[ck];
        const float mAv = dir ? A.mu_next[cv] : A.mu_prev[cv], mBv = dir ? A.mu_prev[cv] : A.mu_next[cv];
        const float kkj = A.k_k[chn], kaj = A.k_a[chn], rkj = A.r_k[chn];
        const float mCr = 1.f - mAr - mBr, mCk = 1.f - mAk - mBk, mCv = 1.f - mAv - mBv;
        float cs = 0.f, gprev = 1.f; float eA = 0.f, eR = 0.f, eB = 0.f, eK = 0.f, eV = 0.f, eQ = 0.f;
        float zf = first ? 0.f : 1.f, zl = last ? 0.f : 1.f; S_PIN(zf); S_PIN(zl);
        {
            float sq[32];
            float k_a = zf * __uint_as_float(rk[0] << 16), k_b = __uint_as_float(rk[1] << 16);
            S_UNROLL for (int p = 0; p < 32; ++p) { const float k_c = ((p == 31) ? zl : 1.f) * __uint_as_float(rk[p + 2] << 16); const float km = mCk * k_b + mAk * k_a + mBk * k_c; k_a = k_b; k_b = k_c;
                rk[p] = __float_as_uint(km); const float t_ = km * kkj; sq[p] = t_ * t_; }
            const float tot = s_treesum32(sq, lane);
            ((S_LDS_F32P)(lds + SC_RSQ + wave * 128))[lane >> 1] = S_RSQ(fmaxf(tot, 1e-24f)); }
        S_MEMBAR();
        float r_a = zf * __uint_as_float(rr[0] << 16), r_b = __uint_as_float(rr[1] << 16), v_a = zf * __uint_as_float(rv[0] << 16), v_b = __uint_as_float(rv[1] << 16);
        S_UNROLL for (int p = 0; p < 32; ++p) { if ((p & (SB_ILP - 1)) == 0) S_MEMBAR();
            const float zz = (p == 31) ? zl : 1.f; const float r_c = zz * __uint_as_float(rr[p + 2] << 16), v_c = zz * __uint_as_float(rv[p + 2] << 16);
            const float r = mCr * r_b + mAr * r_a + mBr * r_c, k = __uint_as_float(rk[p]), v = mCv * v_b + mAv * v_a + mBv * v_c; r_a = r_b; r_b = r_c; v_a = v_b; v_b = v_c;
            const float wraw = ((S_LDS_F32P)(lds + SC_WR + wave * 8192))[p * 64 + lane], araw = bf2f(((S_LDS_BF16P)(lds + SC_AR + wave * 4096))[p * 64 + lane]);
            const float lw2 = -0.8750387749f * S_RCP(1.f + S_EXP2(wraw));
            const float al = S_RCP(1.f + S_EXP2(araw));
            const float kk = k * kkj * ((S_LDS_CONST_F32P)(lds + SC_RSQ + wave * 128))[p];
            const float kd = k * (1.f + (al - 1.f) * kaj);
            cs += lw2; const float gam = S_EXP2(cs), ig = S_EXP2(-cs);
            const float xa = -kk * gprev, xr = r * gam, xb = kk * al * ig, xk = kd * ig, xq = xr * rkj; gprev = gam;
            if (p & 1) { ppA[p >> 1] = S_PK(eA, xa); ppR[p >> 1] = S_PK(eR, xr); ppB[p >> 1] = S_PK(eB, xb); ppK[p >> 1] = S_PK(eK, xk); ppV[p >> 1] = S_PK(eV, v); ppQ[p >> 1] = S_PK(eQ, xq);
                         S_PIN(ppQ[p >> 1]); S_PIN(ppA[p >> 1]); S_PIN(ppR[p >> 1]); S_PIN(ppB[p >> 1]); S_PIN(ppK[p >> 1]); S_PIN(ppV[p >> 1]); }
            else { eA = xa; eR = xr; eB = xb; eK = xk; eV = v; eQ = xq; } }
        gamC = gprev;
    }
    S_MEMBAR();
    float gc0, gc1; { unsigned x = __float_as_uint(gamC), y = x; S_SWAP(x, y); gc0 = __uint_as_float(x); gc1 = __uint_as_float(y); }
    ((S_LDS_F32P)(lds + SC_GTAB + wave * 256))[lane] = gamC;
    const SMat FA = splain2d(ppA), FB = splain2d(ppB), FK = splain2d(ppK), FV = splain2d(ppV);
    SFrag RT[2], MrbT, MrkT, LakT, Pf, PTf; f32x16 TT;
    {   const SFrag IDF = sident(n, hh); SFrag AT[2], BT[2], KT[2];
        { const SMat FR = splain2d(ppR); S_UNROLL for (int dt = 0; dt < 2; ++dt) RT[dt] = spack(smm(FR.t[dt], IDF, szero())); }
        SFrag QT[2]; { const SMat FQ = splain2d(ppQ); S_UNROLL for (int dt = 0; dt < 2; ++dt) QT[dt] = spack(smm(FQ.t[dt], IDF, szero())); }
        S_UNROLL for (int dt = 0; dt < 2; ++dt) { AT[dt] = spack(smm(FA.t[dt], IDF, szero())); BT[dt] = spack(smm(FB.t[dt], IDF, szero())); KT[dt] = spack(smm(FK.t[dt], IDF, szero())); }
        f32x16 L = szero(), LT = szero(), lak = szero(), mrb = szero(), mrk = szero();
        { f32x16 bq = szero(); S_UNROLL for (int dt = 0; dt < 2; ++dt) bq = smm(KT[dt], QT[dt], bq);
          int nb = n, rb = 4 * hh; S_LAUNDER_I(nb); S_LAUNDER_I(rb); float dsum = 0.f; S_UNROLL for (int g = 0; g < 16; ++g) dsum += (((g & 3) + 8 * (g >> 2) + rb) == nb) ? bq[g] : 0.f;
          if (((nb >> 2) & 1) == (rb >> 2)) A.bonus[((size_t)b * T + (tau0 + sgn * nb)) * 8 + h] = dsum; }
        S_UNROLL for (int dt = 0; dt < 2; ++dt) { L = smm(AT[dt], BT[dt], L); LT = smm(BT[dt], AT[dt], LT); lak = smm(KT[dt], AT[dt], lak); mrb = smm(BT[dt], RT[dt], mrb); mrk = smm(KT[dt], RT[dt], mrk); }
        int n2 = n, r2 = 4 * hh; S_LAUNDER_I(n2); S_LAUNDER_I(r2);
        S_UNROLL for (int g = 0; g < 16; ++g) { const int row = (g & 3) + 8 * (g >> 2) + r2;
            L[g] = (row > n2) ? L[g] : 0.f; LT[g] = (row < n2) ? LT[g] : 0.f; lak[g] = (row < n2) ? lak[g] : 0.f; mrb[g] = (row <= n2) ? mrb[g] : 0.f; mrk[g] = (row <= n2) ? mrk[g] : 0.f; }
        Pf = spack(L); PTf = spack(LT); LakT = spack(lak); MrbT = spack(mrb); MrkT = spack(mrk);
        TT = LT; S_UNROLL for (int g = 0; g < 16; ++g) TT[g] += (((g & 3) + 8 * (g >> 2) + r2) == n2) ? 1.f : 0.f;
    }
    S_MEMBAR();
    SFrag TTf = spack(TT);
    S_UNROLL for (int i = 1; i <= 4; ++i) { const f32x16 P2 = smm(PTf, Pf, szero()); SFrag P2Tf; if (i < 4) P2Tf = spack(smm(Pf, PTf, szero()));
        Pf = spack(P2); TT = smm(Pf, TTf, TT); TTf = spack(TT); if (i < 4) PTf = P2Tf; }
    S_MEMBAR();
    SFrag U0[2], Ap[2], RpT[2], Y0[2], GTf[2][2], Hf[2][2];
    S_UNROLL for (int vt = 0; vt < 2; ++vt) { const SFrag W = spack(smm(LakT, FV.t[vt], szero())); U0[vt] = spack(smm(TTf, W, szero())); }
    S_UNROLL for (int kt = 0; kt < 2; ++kt) Ap[kt] = spack(smm(TTf, FA.t[kt], szero()));
    S_UNROLL for (int kt = 0; kt < 2; ++kt) RpT[kt] = spack(smm(Ap[kt], MrbT, sunpack(RT[kt])));
    S_UNROLL for (int vt = 0; vt < 2; ++vt) Y0[vt] = spack(smm(MrkT, FV.t[vt], smm(MrbT, U0[vt], szero())));
    int n3 = n, r3 = 4 * hh; S_LAUNDER_I(n3); S_LAUNDER_I(r3);
    S_UNROLL for (int nt = 0; nt < 2; ++nt) S_UNROLL for (int mt = 0; mt < 2; ++mt) { f32x16 gt = smm(Ap[nt], FB.t[mt], szero()); const float gcv = mt ? gc1 : gc0;
        S_UNROLL for (int g = 0; g < 16; ++g) { const float idv = (nt == mt && ((g & 3) + 8 * (g >> 2) + r3) == n3) ? 1.f : 0.f; gt[g] = (gt[g] + idv) * gcv; }
        GTf[nt][mt] = spack(gt); }
    S_LDS_WAIT();
    S_UNROLL for (int mt = 0; mt < 2; ++mt) { float gr[16];
        S_UNROLL for (int q = 0; q < 4; ++q) { const f32x4 t4 = *(S_LDS_CONST_F32X4P)(lds + SC_GTAB + wave * 256 + (32 * mt + 8 * q + 4 * hh) * 4); S_UNROLL for (int i = 0; i < 4; ++i) gr[4 * q + i] = t4[i]; }
        S_UNROLL for (int vt = 0; vt < 2; ++vt) { f32x16 hm = smm(FK.t[mt], FV.t[vt], smm(FB.t[mt], U0[vt], szero())); S_UNROLL for (int g = 0; g < 16; ++g) hm[g] *= gr[g]; Hf[mt][vt] = spack(hm); } }
    S_MEMBAR();
    S_FLAG_WAIT(lds + SC_FLAG, (unsigned)c);
    SFrag SG[2][2];
    S_UNROLL for (int kt = 0; kt < 2; ++kt) S_UNROLL for (int vt = 0; vt < 2; ++vt) S_UNROLL for (int s = 0; s < 2; ++s) SG[kt][vt].s[s] = *(S_LDS_CONST_BF16X8P)(lds + SC_SIG + ((((kt * 2 + vt) * 2 + s) * 64 + lane) * 16));
    S_LDS_WAIT();
    S_UNROLL for (int mt = 0; mt < 2; ++mt) S_UNROLL for (int vt = 0; vt < 2; ++vt) { f32x16 sn = sunpack(Hf[mt][vt]); S_UNROLL for (int nt = 0; nt < 2; ++nt) sn = smm(GTf[nt][mt], SG[nt][vt], sn);
        const SFrag f = spack(sn); S_UNROLL for (int s = 0; s < 2; ++s) *(S_LDS_BF16X8P)(lds + SC_SIG + ((((mt * 2 + vt) * 2 + s) * 64 + lane) * 16)) = f.s[s]; }
    S_LDS_WAIT();
    S_FLAG_STORE(lds + SC_FLAG, (unsigned)(c + 1));
    S_UNROLL for (int vt = 0; vt < 2; ++vt) { f32x16 y = sunpack(Y0[vt]); S_UNROLL for (int kt = 0; kt < 2; ++kt) y = smm(RpT[kt], SG[kt][vt], y);
        S_UNROLL for (int g = 0; g < 16; ++g) { const int p = (g & 3) + 8 * (g >> 2) + 4 * hh; A.ydir[((size_t)b * T + (tau0 + sgn * p)) * 512 + h * 64 + 32 * vt + n] = (bf16)(S_PK(y[g], 0.f) & 0xffffu); } }
}

__device__ __forceinline__ void attn_unit(const Frame& F, ArgsP A, int b, int kvh, int qb) {
    constexpr int KST = 72, VST = 388;
    LAS bf16* KS = (LAS bf16*)F.lds;
    LAS bf16* VT = (LAS bf16*)(F.lds + 384 * KST * 2);
    LAS float* wsf = (LAS float*)(F.lds + 384 * KST * 2 + 64 * VST * 2);
    const bf16* Z = (const bf16*)(A->ws + WS_Z); bf16* OA = (bf16*)(A->ws + WS_OATT);
    const int* positions = (const int*)A->in[2]; const float* qg = (const float*)A->in[19]; const float* kg = (const float*)A->in[20]; const float* sink = (const float*)A->in[21];
    const int tid = F.tid, lane = F.lane, wave = F.wave;
    const float LN_THETA = 13.122363377404328f;
    v4u kwa[6], vwa[6], rca[6], rsa[6];
    v4u qn[4], qnc, qns;
    { const size_t tok0 = (size_t)b * T + qb * 128 + (wave & 1) * 64 + (lane & 31); const int hq0 = kvh * 4 + (wave >> 1);
#pragma unroll
      for (int sI = 0; sI < 4; ++sI) qn[sI] = *(const GAS v4u*)(Z + tok0 * NZ + ZQ + hq0 * 64 + 16 * sI + 8 * (lane >> 5));
      const GAS v4u* qrt0 = (const GAS v4u*)((const bf16*)(A->ws + WS_ROPE) + tok0 * 16); qnc = qrt0[0]; qns = qrt0[1]; }
#pragma unroll
    for (int i = 0; i < 6; ++i) { const int ct = tid + 512 * i, key = ct >> 3, ch = ct & 7; const int kp = qb * 128 - 128 + key; const bool valid = (kp >= 0) && (kp < T);
        const size_t rowoff = ((size_t)b * T + (valid ? kp : 0)) * NZ;
        kwa[i] = *(const GAS v4u*)(Z + rowoff + ZKA + kvh * 64 + ch * 8); vwa[i] = *(const GAS v4u*)(Z + rowoff + ZVA + kvh * 64 + ch * 8);
        const GAS v4u* rt = (const GAS v4u*)((const bf16*)(A->ws + WS_ROPE) + ((size_t)b * T + (valid ? kp : 0)) * 16); rca[i] = rt[0]; rsa[i] = rt[1]; }
#pragma unroll
    for (int i = 0; i < 6; ++i) { const int ct = tid + 512 * i, key = ct >> 3, ch = ct & 7; const int kp = qb * 128 - 128 + key; const bool valid = (kp >= 0) && (kp < T);
        v4u kw = kwa[i], vw = vwa[i];
        if (!valid) { kw = (v4u){0u, 0u, 0u, 0u}; vw = kw; }
        float kf[8] = {bflo(kw.x), bfhi(kw.x), bflo(kw.y), bfhi(kw.y), bflo(kw.z), bfhi(kw.z), bflo(kw.w), bfhi(kw.w)};
        float ss = 0.f;
#pragma unroll
        for (int j = 0; j < 8; ++j) ss += kf[j] * kf[j];
        ss += __shfl_xor(ss, 1); ss += __shfl_xor(ss, 2); ss += __shfl_xor(ss, 4);
        const float rs = rsqrtf(ss * (1.0f / 64.0f) + 1e-6f);
#pragma unroll
        for (int j = 0; j < 8; ++j) kf[j] = kf[j] * rs * kg[ch * 8 + j];
        float oth[8];
#pragma unroll
        for (int j = 0; j < 8; ++j) oth[j] = __shfl_xor(kf[j], 1);
        if (ch < 2) { const v4u cw = rca[i], sw = rsa[i];
            const float cs[8] = {bflo(cw.x), bfhi(cw.x), bflo(cw.y), bfhi(cw.y), bflo(cw.z), bfhi(cw.z), bflo(cw.w), bfhi(cw.w)};
            const float sn[8] = {bflo(sw.x), bfhi(sw.x), bflo(sw.y), bfhi(sw.y), bflo(sw.z), bfhi(sw.z), bflo(sw.w), bfhi(sw.w)};
#pragma unroll
            for (int j = 0; j < 8; ++j) kf[j] = (ch == 0) ? (kf[j] * cs[j] - oth[j] * sn[j]) : (kf[j] * cs[j] + oth[j] * sn[j]); }
        v4u ko; ko.x = pk2(kf[0], kf[1]); ko.y = pk2(kf[2], kf[3]); ko.z = pk2(kf[4], kf[5]); ko.w = pk2(kf[6], kf[7]);
        *(LAS v4u*)(KS + key * KST + ch * 8) = ko;
        const unsigned vv[4] = {vw.x, vw.y, vw.z, vw.w};
#pragma unroll
        for (int j = 0; j < 4; ++j) { VT[(ch * 8 + 2 * j) * VST + key] = (bf16)(vv[j] & 0xffffu); VT[(ch * 8 + 2 * j + 1) * VST + key] = (bf16)(vv[j] >> 16); } }
    __syncthreads();
    const int g = wave >> 1, hq = kvh * 4 + g, r32 = lane & 31, hh = lane >> 5;
    const float snk = sink[hq];
    float kbound; { float gm = fabsf(kg[lane]);
#pragma unroll
        for (int o = 1; o < 64; o <<= 1) gm = fmaxf(gm, __shfl_xor(gm, o));
        kbound = 8.0f * gm; }
#pragma unroll 1
    for (int qt = 0; qt < 2; ++qt) { const int qo = (wave & 1) * 64 + qt * 32, qrel = qo + r32; const size_t tok = (size_t)b * T + qb * 128 + qrel;
        float qf[4][8]; float ss = 0.f; v4u qraw[4];
#pragma unroll
        for (int sI = 0; sI < 4; ++sI) qraw[sI] = qn[sI];
        const v4u qrc = qnc, qrs = qns;
        if (qt == 0) { const size_t tok1 = tok + 32;
#pragma unroll
            for (int sI = 0; sI < 4; ++sI) qn[sI] = *(const GAS v4u*)(Z + tok1 * NZ + ZQ + hq * 64 + 16 * sI + 8 * hh);
            const GAS v4u* qrt1 = (const GAS v4u*)((const bf16*)(A->ws + WS_ROPE) + tok1 * 16); qnc = qrt1[0]; qns = qrt1[1]; }
#pragma unroll
        for (int sI = 0; sI < 4; ++sI) { const v4u qw = qraw[sI];
            qf[sI][0] = bflo(qw.x); qf[sI][1] = bfhi(qw.x); qf[sI][2] = bflo(qw.y); qf[sI][3] = bfhi(qw.y); qf[sI][4] = bflo(qw.z); qf[sI][5] = bfhi(qw.z); qf[sI][6] = bflo(qw.w); qf[sI][7] = bfhi(qw.w);
#pragma unroll
            for (int j = 0; j < 8; ++j) ss += qf[sI][j] * qf[sI][j]; }
        ss += __shfl_xor(ss, 32);
        const float rs = rsqrtf(ss * (1.0f / 64.0f) + 1e-6f) * 0.125f;
#pragma unroll
        for (int sI = 0; sI < 4; ++sI)
#pragma unroll
            for (int j = 0; j < 8; ++j) qf[sI][j] = qf[sI][j] * rs * qg[16 * sI + 8 * hh + j];
        { const v4u cw = qrc, sw = qrs;
          const float cs[8] = {bflo(cw.x), bfhi(cw.x), bflo(cw.y), bfhi(cw.y), bflo(cw.z), bfhi(cw.z), bflo(cw.w), bfhi(cw.w)}, sn[8] = {bflo(sw.x), bfhi(sw.x), bflo(sw.y), bfhi(sw.y), bflo(sw.z), bfhi(sw.z), bflo(sw.w), bfhi(sw.w)};
#pragma unroll
          for (int j = 0; j < 8; ++j) { const float oth = __shfl_xor(qf[0][j], 32); qf[0][j] = (hh == 0) ? (qf[0][j] * cs[j] - oth * sn[j]) : (qf[0][j] * cs[j] + oth * sn[j]); } }
        bf16x8 qr[4];
#pragma unroll
        for (int sI = 0; sI < 4; ++sI) { v4u w; w.x = pk2(qf[sI][0], qf[sI][1]); w.y = pk2(qf[sI][2], qf[sI][3]); w.z = pk2(qf[sI][4], qf[sI][5]); w.w = pk2(qf[sI][6], qf[sI][7]); qr[sI] = __builtin_bit_cast(bf16x8, w); }
        const int kt0 = qo >> 5;
        float qn2 = 0.f;
#pragma unroll
        for (int sI = 0; sI < 4; ++sI)
#pragma unroll
            for (int j = 0; j < 8; ++j) qn2 += qf[sI][j] * qf[sI][j];
        qn2 += __shfl_xor(qn2, 32);
        float mrun = sqrtf(qn2) * kbound * 1.02f;
        if (__any(mrun > 40.f)) { mrun = -1e30f;
#pragma unroll 1
            for (int kt = 0; kt < 9; ++kt) { const int kbase = (kt0 + kt) * 32;
                f32x16 acc = {};
#pragma unroll
                for (int sI = 0; sI < 4; ++sI) { const bf16x8 kfr = *(const LAS bf16x8*)(KS + (kbase + r32) * KST + 16 * sI + 8 * hh); acc = __builtin_amdgcn_mfma_f32_32x32x16_bf16(kfr, qr[sI], acc, 0, 0, 0); }
#pragma unroll
                for (int r = 0; r < 16; ++r) { const int ki = kbase + (r & 3) + 8 * (r >> 2) + 4 * hh; const int dq = ki - 128 - qrel, kp = qb * 128 - 128 + ki;
                    const bool ok = (dq >= -128) && (dq <= 128) && (kp >= 0) && (kp < T); mrun = fmaxf(mrun, ok ? acc[r] : -1e30f); } }
            mrun = fmaxf(mrun, __shfl_xor(mrun, 32)); }
        const float mx = fmaxf(mrun, snk);
        float lrun = 0.f; f32x16 o0 = {}, o1 = {}; const float mxl = mx * 1.442695041f; const bool edge = (qb == 0) || (qb == T / 128 - 1);
#pragma unroll 1
        for (int kt = 0; kt < 9; ++kt) { const int kbase = (kt0 + kt) * 32;
            f32x16 acc = {};
#pragma unroll
            for (int sI = 0; sI < 4; ++sI) { const bf16x8 kfr = *(const LAS bf16x8*)(KS + (kbase + r32) * KST + 16 * sI + 8 * hh); acc = __builtin_amdgcn_mfma_f32_32x32x16_bf16(kfr, qr[sI], acc, 0, 0, 0); }
            float p[16];
            if (edge || kt == 0 || kt == 8) {
#pragma unroll
                for (int r = 0; r < 16; ++r) { const int ki = kbase + (r & 3) + 8 * (r >> 2) + 4 * hh; const int dq = ki - 128 - qrel, kp = qb * 128 - 128 + ki;
                    const bool ok = (dq >= -128) && (dq <= 128) && (kp >= 0) && (kp < T); p[r] = ok ? __builtin_amdgcn_exp2f(acc[r] * 1.442695041f - mxl) : 0.f; lrun += p[r]; }
            } else {
#pragma unroll
                for (int r = 0; r < 16; ++r) { p[r] = __builtin_amdgcn_exp2f(acc[r] * 1.442695041f - mxl); lrun += p[r]; } }
#pragma unroll
            for (int sI = 0; sI < 2; ++sI) { v4u pw; pw.x = pk2(p[8 * sI + 0], p[8 * sI + 1]); pw.y = pk2(p[8 * sI + 2], p[8 * sI + 3]); pw.z = pk2(p[8 * sI + 4], p[8 * sI + 5]); pw.w = pk2(p[8 * sI + 6], p[8 * sI + 7]);
                const bf16x8 pa = __builtin_bit_cast(bf16x8, pw); const int key0 = kbase + 16 * sI + 4 * hh;
                { const u32x2 lo = *(const LAS u32x2*)(VT + r32 * VST + key0), hi = *(const LAS u32x2*)(VT + r32 * VST + key0 + 8); v4u vw; vw.x = lo.x; vw.y = lo.y; vw.z = hi.x; vw.w = hi.y;
                  o0 = __builtin_amdgcn_mfma_f32_32x32x16_bf16(pa, __builtin_bit_cast(bf16x8, vw), o0, 0, 0, 0); }
                { const u32x2 lo = *(const LAS u32x2*)(VT + (32 + r32) * VST + key0), hi = *(const LAS u32x2*)(VT + (32 + r32) * VST + key0 + 8); v4u vw; vw.x = lo.x; vw.y = lo.y; vw.z = hi.x; vw.w = hi.y;
                  o1 = __builtin_amdgcn_mfma_f32_32x32x16_bf16(pa, __builtin_bit_cast(bf16x8, vw), o1, 0, 0, 0); } } }
        lrun += __shfl_xor(lrun, 32);
        const float linv = 1.0f / (lrun + __expf(snk - mx));
        if (hh == 0) wsf[wave * 64 + r32] = linv;
        LDS_WAIT(); asm volatile("" ::: "memory");
#pragma unroll
        for (int r = 0; r < 16; ++r) { const int row = (r & 3) + 8 * (r >> 2) + 4 * hh; const float li = wsf[wave * 64 + row];
            bf16* op = OA + ((size_t)b * T + qb * 128 + qo + row) * 512 + hq * 64;
            op[r32] = (bf16)f2bf(o0[r] * li); op[32 + r32] = (bf16)f2bf(o1[r] * li); }
        LDS_WAIT(); asm volatile("" ::: "memory");
    }
    __syncthreads();
}

__device__ __forceinline__ void pg_rows(const Frame& F, ArgsP A, bf16* wout) {
    const bf16* Z = (const bf16*)(A->ws + WS_Z); const bf16* Y0 = (const bf16*)(A->ws + WS_XN); const bf16* Y1 = Y0 + (size_t)M * 512;
    bf16* Gb = (bf16*)(A->ws + WS_G); const float* bonus = (const float*)(A->ws + WS_BONUS);
    const float* mu_prev = (const float*)A->in[7]; const float* mu_next = (const float*)A->in[8]; const float* gn_w = (const float*)A->in[17]; const float* gn_b = (const float*)A->in[18];
    const int gw = F.vcu * NWAVES + F.wave, NGW = F.G * NWAVES, lane = F.lane, c0 = lane * 8, h = lane >> 3;
    float mp[8], mn[8], gw_[8], gb_[8];
#pragma unroll
    for (int j = 0; j < 8; ++j) { mp[j] = mu_prev[ZV + c0 + j]; mn[j] = mu_next[ZV + c0 + j]; gw_[j] = gn_w[c0 + j]; gb_[j] = gn_b[c0 + j]; }
#pragma unroll 1
    for (int m0 = gw; m0 < M; m0 += 4 * NGW) {
        v4u y0[4], y1[4], gv[4], z0[4], zm[4], zq[4]; float bon[4];
#pragma unroll
        for (int i = 0; i < 4; ++i) { const int m = m0 + i * NGW, t = m & (T - 1);
            y0[i] = *(const GAS v4u*)(Y0 + (size_t)m * 512 + c0); y1[i] = *(const GAS v4u*)(Y1 + (size_t)m * 512 + c0); gv[i] = *(const GAS v4u*)(Gb + (size_t)m * 512 + c0);
            z0[i] = *(const GAS v4u*)(Z + (size_t)m * NZ + ZV + c0);
            zm[i] = (v4u){0u, 0u, 0u, 0u}; zq[i] = (v4u){0u, 0u, 0u, 0u};
            if (t > 0) zm[i] = *(const GAS v4u*)(Z + (size_t)(m - 1) * NZ + ZV + c0);
            if (t < T - 1) zq[i] = *(const GAS v4u*)(Z + (size_t)(m + 1) * NZ + ZV + c0);
            bon[i] = bonus[(size_t)m * 8 + h] + bonus[(size_t)M * 8 + (size_t)m * 8 + h]; }
#pragma unroll
        for (int i = 0; i < 4; ++i) { const int m = m0 + i * NGW;
            const unsigned y0w[4] = {y0[i].x, y0[i].y, y0[i].z, y0[i].w}, y1w[4] = {y1[i].x, y1[i].y, y1[i].z, y1[i].w}, gvw[4] = {gv[i].x, gv[i].y, gv[i].z, gv[i].w};
            const unsigned z0w[4] = {z0[i].x, z0[i].y, z0[i].z, z0[i].w}, zmw[4] = {zm[i].x, zm[i].y, zm[i].z, zm[i].w}, zqw[4] = {zq[i].x, zq[i].y, zq[i].z, zq[i].w};
            float y[8], gg[8], vv[8]; float sacc = 0.f;
#pragma unroll
            for (int j = 0; j < 4; ++j) { y[2 * j] = bflo(y0w[j]) + bflo(y1w[j]); y[2 * j + 1] = bfhi(y0w[j]) + bfhi(y1w[j]); gg[2 * j] = bflo(gvw[j]); gg[2 * j + 1] = bfhi(gvw[j]);
                const float a0 = bflo(z0w[j]), a1 = bfhi(z0w[j]);
                vv[2 * j] = a0 + mp[2 * j] * (bflo(zmw[j]) - a0) + mn[2 * j] * (bflo(zqw[j]) - a0); vv[2 * j + 1] = a1 + mp[2 * j + 1] * (bfhi(zmw[j]) - a1) + mn[2 * j + 1] * (bfhi(zqw[j]) - a1);
                sacc += y[2 * j] + y[2 * j + 1]; }
            sacc += __shfl_xor(sacc, 1); sacc += __shfl_xor(sacc, 2); sacc += __shfl_xor(sacc, 4);
            const float mu = sacc * (1.0f / 64.0f); float q = 0.f;
#pragma unroll
            for (int j = 0; j < 8; ++j) { const float d = y[j] - mu; q += d * d; }
            q += __shfl_xor(q, 1); q += __shfl_xor(q, 2); q += __shfl_xor(q, 4);
            const float rstd = rsqrtf(q * (1.0f / 64.0f) + 64e-5f);
            float o[8];
#pragma unroll
            for (int j = 0; j < 8; ++j) o[j] = ((y[j] - mu) * rstd * gw_[j] + gb_[j] + bon[i] * vv[j]) * gg[j];
            v4u w; w.x = pk2(o[0], o[1]); w.y = pk2(o[2], o[3]); w.z = pk2(o[4], o[5]); w.w = pk2(o[6], o[7]);
            *(GAS v4u*)(wout + (size_t)m * 512 + c0) = w; } }
}

constexpr int CONV_PER = 512, CONV_NIT = 16 * 3 * CONV_PER, CONV_EARLY = 6144;
__device__ __forceinline__ void conv_items(const Frame& F, ArgsP A, int it0, int it1, int widx, int nw) {
    LAS float* scr = (LAS float*)(F.lds + F.wave * 16384); const int lane = F.lane;
    const float* w_gate = (const float*)A->in[27]; const float* w_up = (const float*)A->in[28]; const float* w_down = (const float*)A->in[29];
    bf16* WguT = (bf16*)((unsigned char*)A->out + OUT_WGUT); bf16* WdT = (bf16*)((unsigned char*)A->out + OUT_WDT);
    for (int it = it0 + widx; it < it1; it += nw) { const int e = it / (3 * CONV_PER), r = it % (3 * CONV_PER), which = r / CONV_PER, q = r % CONV_PER, kb = q >> 5, nb = q & 31, n0 = 32 * nb;
        if (which == 0) tr_item(w_gate + (size_t)e * 1048576, 1024, 64 * kb, n0, WguT, 1024, e * 2048 + (n0 >> 7) * 256 + (n0 & 127), scr, lane);
        else if (which == 1) tr_item(w_up + (size_t)e * 1048576, 1024, 64 * kb, n0, WguT, 1024, e * 2048 + (n0 >> 7) * 256 + 128 + (n0 & 127), scr, lane);
        else tr_item(w_down + (size_t)e * 1048576, 1024, 64 * kb, n0, WdT, 1024, e * 1024 + n0, scr, lane); }
}
__device__ __forceinline__ int conv_idle_first(int G) { const int nwg = (M / 256) * (NZP / 256), mx = (nwg + G - 1) / G; return nwg - (mx - 1) * G; }
__device__ __forceinline__ void pj_phase(const Frame& F, ArgsP A) {
    unsigned char* ws = A->ws;
    const int gw = F.vcu * NWAVES + F.wave, NGW = F.G * NWAVES, lane = F.lane;
    { const int c0 = conv_idle_first(F.G); conv_items(F, A, c0 < F.G ? CONV_EARLY : 0, CONV_NIT, gw, NGW); }
    __syncthreads();
    const float* w_router = (const float*)A->in[26]; const bf16* x1 = (const bf16*)(ws + WS_X1); const float* g2n = (const float*)A->in[25]; const float* mod = (const float*)(ws + WS_MOD);
    bf16* XN2 = (bf16*)(ws + WS_XN); float* aff = (float*)(ws + WS_AFF);
    LAS bf16* WF = (LAS bf16*)F.lds;
    LAS float* AT = (LAS float*)(F.lds + 65536); LAS float* BT = AT + 1024; LAS float* CB = BT + 1024;
    const int tile = gw, b = tile >> 7;
    for (int d = F.tid; d < 1024; d += 512) { AT[d] = g2n[d] * (1.0f + mod[(size_t)b * 6144 + 4096 + d]); BT[d] = mod[(size_t)b * 6144 + 3072 + d]; }
    __syncthreads();
#pragma unroll 4
    for (int k = 0; k < 32; ++k) { const int it = F.tid + 512 * k, jj = it & 7, ln = (it >> 3) & 63, sI = it >> 9, q = ln >> 4, e = ln & 15, d = 32 * sI + 8 * q + jj;
        const float v = AT[d] * w_router[d * 16 + e]; const unsigned hi = pk2(v, 0.f) & 0xffffu; const float lo = v - __uint_as_float(hi << 16);
        WF[it] = (bf16)hi; WF[16384 + it] = (bf16)(pk2(lo, 0.f) & 0xffffu); }
    { float c0 = 0.f, c1 = 0.f;
#pragma unroll 4
      for (int k = 0; k < 16; ++k) { const int d = lane + 64 * k; c0 += BT[d] * w_router[d * 16 + 2 * F.wave]; c1 += BT[d] * w_router[d * 16 + 2 * F.wave + 1]; }
      c0 = dpp_wave_sum(c0); c1 = dpp_wave_sum(c1); if (lane == 0) { CB[2 * F.wave] = c0; CB[2 * F.wave + 1] = c1; } }
    __syncthreads();
    if (tile < M / 16) { const int r = lane & 15, q = lane >> 4; const size_t m = (size_t)tile * 16 + r;
        float ss = 0.f;
#pragma unroll 1
        for (int hf = 0; hf < 2; ++hf) { v4u raw[16];
#pragma unroll
            for (int sI = 0; sI < 16; ++sI) raw[sI] = *(const GAS v4u*)(x1 + m * 1024 + 32 * (16 * hf + sI) + 8 * q);
#pragma unroll
            for (int sI = 0; sI < 16; ++sI) { const v4u w = raw[sI]; const float a0 = bflo(w.x), a1 = bfhi(w.x), a2 = bflo(w.y), a3 = bfhi(w.y), a4 = bflo(w.z), a5 = bfhi(w.z), a6 = bflo(w.w), a7 = bfhi(w.w);
                ss += (a0 * a0 + a1 * a1) + (a2 * a2 + a3 * a3) + (a4 * a4 + a5 * a5) + (a6 * a6 + a7 * a7); } }
        ss += __shfl_xor(ss, 16); ss += __shfl_xor(ss, 32);
        const float rs = rsqrtf(ss * (1.0f / 1024.0f) + 1e-6f);
        f32x4 ah = {0.f, 0.f, 0.f, 0.f}, al = {0.f, 0.f, 0.f, 0.f};
#pragma unroll 1
        for (int hf = 0; hf < 2; ++hf) { v4u raw[16];
#pragma unroll
            for (int sI = 0; sI < 16; ++sI) raw[sI] = *(const GAS v4u*)(x1 + m * 1024 + 32 * (16 * hf + sI) + 8 * q);
#pragma unroll
            for (int sI = 0; sI < 16; ++sI) { const int sg = 16 * hf + sI; const bf16x8 xa = __builtin_bit_cast(bf16x8, raw[sI]);
                const bf16x8 bh = *(const LAS bf16x8*)(WF + (sg * 64 + lane) * 8), bl = *(const LAS bf16x8*)(WF + 16384 + (sg * 64 + lane) * 8);
                ah = __builtin_amdgcn_mfma_f32_16x16x32_bf16(xa, bh, ah, 0, 0, 0); al = __builtin_amdgcn_mfma_f32_16x16x32_bf16(xa, bl, al, 0, 0, 0); }
#pragma unroll
            for (int sI = 0; sI < 16; ++sI) { if ((sI & 3) == 0) asm volatile("" ::: "memory");
                const int d0 = 32 * (16 * hf + sI) + 8 * q; const v4u w = raw[sI];
                const f32x4 a0 = *(const LAS f32x4*)(AT + d0), a1 = *(const LAS f32x4*)(AT + d0 + 4), b0 = *(const LAS f32x4*)(BT + d0), b1 = *(const LAS f32x4*)(BT + d0 + 4);
                v4u o; o.x = pk2(bflo(w.x) * rs * a0.x + b0.x, bfhi(w.x) * rs * a0.y + b0.y); o.y = pk2(bflo(w.y) * rs * a0.z + b0.z, bfhi(w.y) * rs * a0.w + b0.w);
                o.z = pk2(bflo(w.z) * rs * a1.x + b1.x, bfhi(w.z) * rs * a1.y + b1.y); o.w = pk2(bflo(w.w) * rs * a1.z + b1.z, bfhi(w.w) * rs * a1.w + b1.w);
                *(GAS v4u*)(XN2 + m * 1024 + d0) = o; } }
        const float cb = CB[lane & 15]; float lg[4], mx[4], ex[4], den[4];
#pragma unroll
        for (int i = 0; i < 4; ++i) { const float rsr = __shfl(rs, 4 * q + i); lg[i] = rsr * (ah[i] + al[i]) + cb; mx[i] = lg[i]; }
#pragma unroll
        for (int o = 1; o < 16; o <<= 1)
#pragma unroll
            for (int i = 0; i < 4; ++i) mx[i] = fmaxf(mx[i], __shfl_xor(mx[i], o));
#pragma unroll
        for (int i = 0; i < 4; ++i) { ex[i] = expf(lg[i] - mx[i]); den[i] = ex[i]; }
#pragma unroll
        for (int o = 1; o < 16; o <<= 1)
#pragma unroll
            for (int i = 0; i < 4; ++i) den[i] += __shfl_xor(den[i], o);
        { const int t0 = (tile & 127) * 16 + 4 * q; f32x4 av; av.x = ex[0] / den[0]; av.y = ex[1] / den[1]; av.z = ex[2] / den[2]; av.w = ex[3] / den[3];
          *(GAS f32x4*)(aff + ((size_t)b * 16 + (lane & 15)) * T + t0) = av; } }
}

__device__ __forceinline__ void pk_task(const Frame& F, ArgsP A, int b, int e) {
    unsigned char* ws = A->ws;
    const float* aff = (const float*)(ws + WS_AFF) + ((size_t)b * 16 + e) * T;
    int* slotmap = (int*)(ws + WS_SLOT); float* selaff = (float*)(ws + WS_SELAFF); int* selidx = (int*)(ws + WS_SELIDX);
    const bf16* XN2 = (const bf16*)(ws + WS_XN); bf16* XE = (bf16*)(ws + WS_XE);
    LAS unsigned* cnt = (LAS unsigned*)F.lds;
    LAS int* tokl = (LAS int*)(F.lds + 256);
    const int tid = F.tid, lane = F.lane, wave = F.wave;
    const f32x4 v4 = *(const GAS f32x4*)(aff + 4 * tid);
    const unsigned key[4] = {__float_as_uint(v4.x), __float_as_uint(v4.y), __float_as_uint(v4.z), __float_as_uint(v4.w)};
    unsigned thr = 0u;
#pragma unroll 1
    for (int bit = 31; bit >= 0; --bit) { const unsigned cand = thr | (1u << bit);
        const unsigned c = (unsigned)(__popcll(__ballot(key[0] >= cand)) + __popcll(__ballot(key[1] >= cand)) + __popcll(__ballot(key[2] >= cand)) + __popcll(__ballot(key[3] >= cand)));
        LAS unsigned* slot_ = cnt + 16 + (bit & 1) * 8;
        if (lane == 0) slot_[wave] = c;
        __syncthreads();
        unsigned tot = 0;
#pragma unroll
        for (int w = 0; w < 8; ++w) tot += slot_[w];
        if (tot >= 256u) thr = cand; }
    __syncthreads();
    int ngt = 0, neq = 0;
#pragma unroll
    for (int j = 0; j < 4; ++j) { ngt += key[j] > thr; neq += key[j] == thr; }
    int sg = ngt, se = neq;
#pragma unroll
    for (int o = 1; o < 64; o <<= 1) { const int a = __shfl_up(sg, o), c = __shfl_up(se, o); if (lane >= o) { sg += a; se += c; } }
    if (lane == 63) { cnt[wave] = (unsigned)sg; cnt[8 + wave] = (unsigned)se; }
    __syncthreads();
    int bg = 0, be = 0, totg = 0;
#pragma unroll
    for (int w = 0; w < 8; ++w) { const int a = (int)cnt[w], c = (int)cnt[8 + w]; if (w < wave) { bg += a; be += c; } totg += a; }
    int pg = bg + sg - ngt, pe = be + se - neq;
    const int need_eq = 256 - totg;
    int* smrow = slotmap + ((size_t)b * T + 4 * tid) * 16 + e;
#pragma unroll
    for (int j = 0; j < 4; ++j) { int slot = -1;
        if (key[j] > thr) { slot = pg; ++pg; } else if (key[j] == thr) { if (pe < need_eq) slot = totg + pe; ++pe; }
        smrow[j * 16] = slot;
        if (slot >= 0) { selidx[((size_t)e * 16 + b) * 256 + slot] = b * T + 4 * tid + j; selaff[((size_t)e * 16 + b) * 256 + slot] = __uint_as_float(key[j]); } }
    __syncthreads();
}

__device__ __forceinline__ void pn_rows(const Frame& F, ArgsP A, float* wout) {
    unsigned char* ws = A->ws;
    const int* slotmap = (const int*)(ws + WS_SLOT); const bf16* YE = (const bf16*)(ws + WS_XE); const float* mod = (const float*)(ws + WS_MOD); const bf16* X1 = (const bf16*)(ws + WS_X1);
    const int gw = F.vcu * NWAVES + F.wave, NGW = F.G * NWAVES, lane = F.lane;
#pragma unroll 1
    for (int m0 = gw * 16; m0 < gw * 16 + 16; m0 += 2) {
        int myslot[2]; f32x4 xv[2][4];
#pragma unroll
        for (int i = 0; i < 2; ++i) { const int m = m0 + i; myslot[i] = slotmap[(size_t)m * 16 + (lane & 15)];
#pragma unroll
            for (int hq = 0; hq < 2; ++hq) { const v4u w = *(const GAS v4u*)(X1 + (size_t)m * 1024 + hq * 512 + lane * 8);
                xv[i][2 * hq] = (f32x4){bflo(w.x), bfhi(w.x), bflo(w.y), bfhi(w.y)}; xv[i][2 * hq + 1] = (f32x4){bflo(w.z), bfhi(w.z), bflo(w.w), bfhi(w.w)}; } }
        unsigned long long msk[2]; v4u yw[2][4][2];
#pragma unroll
        for (int i = 0; i < 2; ++i) { const int b = (m0 + i) >> 11; msk[i] = __ballot(myslot[i] >= 0) & 0xffffull;
#pragma unroll
            for (int k = 0; k < 4; ++k) { const bool has = msk[i] != 0ull; const int e = has ? __builtin_ctzll(msk[i]) : 0; if (has) msk[i] &= msk[i] - 1; const int sl = __shfl(myslot[i], e);
                yw[i][k][0] = (v4u){0u, 0u, 0u, 0u}; yw[i][k][1] = (v4u){0u, 0u, 0u, 0u};
                if (has) { const GAS v4u* yr = (const GAS v4u*)(YE + (((size_t)e * 16 + b) * 256 + sl) * 1024); yw[i][k][0] = yr[lane]; yw[i][k][1] = yr[64 + lane]; } } }
#pragma unroll
        for (int i = 0; i < 2; ++i) { const int m = m0 + i, b = m >> 11;
            float acc[16];
#pragma unroll
            for (int j = 0; j < 16; ++j) acc[j] = 0.f;
#pragma unroll
            for (int k = 0; k < 4; ++k)
#pragma unroll
                for (int hlf = 0; hlf < 2; ++hlf) { const v4u w = yw[i][k][hlf];
                    acc[hlf * 8 + 0] += bflo(w.x); acc[hlf * 8 + 1] += bfhi(w.x); acc[hlf * 8 + 2] += bflo(w.y); acc[hlf * 8 + 3] += bfhi(w.y);
                    acc[hlf * 8 + 4] += bflo(w.z); acc[hlf * 8 + 5] += bfhi(w.z); acc[hlf * 8 + 6] += bflo(w.w); acc[hlf * 8 + 7] += bfhi(w.w); }
            unsigned long long mk = msk[i];
            while (mk) { const int e = __builtin_ctzll(mk); mk &= mk - 1; const int sl = __shfl(myslot[i], e);
                const GAS v4u* yr = (const GAS v4u*)(YE + (((size_t)e * 16 + b) * 256 + sl) * 1024);
#pragma unroll
                for (int hlf = 0; hlf < 2; ++hlf) { const v4u w = yr[hlf * 64 + lane];
                    acc[hlf * 8 + 0] += bflo(w.x); acc[hlf * 8 + 1] += bfhi(w.x); acc[hlf * 8 + 2] += bflo(w.y); acc[hlf * 8 + 3] += bfhi(w.y);
                    acc[hlf * 8 + 4] += bflo(w.z); acc[hlf * 8 + 5] += bfhi(w.z); acc[hlf * 8 + 6] += bflo(w.w); acc[hlf * 8 + 7] += bfhi(w.w); } }
            const float* gt2 = mod + (size_t)b * 6144 + 5120; float* orow = wout + (size_t)m * 1024;
#pragma unroll
            for (int q = 0; q < 4; ++q) { const int c = (q >> 1) * 512 + lane * 8 + (q & 1) * 4; const f32x4 g = *(const GAS f32x4*)(gt2 + c);
                f32x4 a; a.x = acc[(q >> 1) * 8 + (q & 1) * 4 + 0]; a.y = acc[(q >> 1) * 8 + (q & 1) * 4 + 1]; a.z = acc[(q >> 1) * 8 + (q & 1) * 4 + 2]; a.w = acc[(q >> 1) * 8 + (q & 1) * 4 + 3];
                *(GAS f32x4*)(orow + c) = xv[i][q] + g * a; } } }
}

__device__ __forceinline__ void mk_frame(Frame& F, LAS unsigned char* lds, int wave_s) {
    int bx = blockIdx.x, G = gridDim.x; LAUNDER(bx); LAUNDER(G);
    F.lds = lds; F.MISC = (volatile LAS unsigned*)(lds + MISC_OFF); F.ctl = nullptr;
    unsigned ones_ = ~0u; asm volatile("" : "+s"(ones_));
    int lane_ = (int)__builtin_amdgcn_mbcnt_hi(ones_, __builtin_amdgcn_mbcnt_lo(ones_, 0u)); asm volatile("" : "+v"(lane_));
    F.lane = lane_; F.wave = wave_s; F.tid = wave_s * 64 + lane_;
    F.G = G; F.vcu = (G % 8 == 0) ? (bx % 8) * (G / 8) + bx / 8 : bx;
}
__global__ void __launch_bounds__(NWAVES * 64, 2) fwd_kernel(Args args) {
    extern __shared__ __attribute__((aligned(16))) unsigned char lds[];
    LAS unsigned char* const ldsb = (LAS unsigned char*)lds;
    ArgsP ap0 = (ArgsP)__builtin_amdgcn_kernarg_segment_ptr();
    int wave_s = __builtin_amdgcn_readfirstlane((int)threadIdx.x >> 6); asm volatile("" : "+s"(wave_s));
    for (int u = threadIdx.x; u < (LDS_BYTES - LDSCTL_OFF) / 4; u += NWAVES * 64) ((LAS unsigned*)(ldsb + LDSCTL_OFF))[u] = 0u;
    __syncthreads();
#define MKBAR XcdBarrier bar; { ArgsP a_ = ap0; LAUNDER(a_); bar.bar = (unsigned*)(a_->ws + WS_CTL) + CW_BAR; bar.x = xb_xcc_id(); bar.st = (volatile LAS unsigned*)(ldsb + MISC_OFF) + 8; }
#if ONE_LAUNCH
    { MKBAR; if (threadIdx.x == 0) (void)xb_add(&bar.bar[XB_XCNT(bar.x)], 1u); }
#ifndef PHM
#define PHM 0x3fff
#endif
#define IN(k) ((PHM >> (k)) & 1)
#define GRIDBAR() do { MKBAR; { unsigned o_ = ~0u; asm volatile("" : "+s"(o_)); xcd_barrier(bar, wave_s == 0 && __builtin_amdgcn_mbcnt_hi(o_, __builtin_amdgcn_mbcnt_lo(o_, 0u)) == 0u); } } while (0)
#define SEAM(k) do { if (IN(k) && IN((k) + 1)) { MKBAR; { unsigned o_ = ~0u; asm volatile("" : "+s"(o_)); xcd_barrier(bar, wave_s == 0 && __builtin_amdgcn_mbcnt_hi(o_, __builtin_amdgcn_mbcnt_lo(o_, 0u)) == 0u); } } } while (0)
#else
    int lo, hi; { ArgsP a = ap0; LAUNDER(a); lo = a->ph_lo; hi = a->ph_hi; }
#define IN(k) (lo <= (k) && (k) < hi)
#define SEAM(k) do { } while (0)
#define GRIDBAR() do { } while (0)
#endif
    typedef pg8::bf16_t pb;
#ifndef REPMASK
#define REPMASK 0
#endif
#define PHASE_ARGS ArgsP ap = ap0; LAUNDER(ap); unsigned char* ws = ap->ws; (void)ws; Frame F; mk_frame(F, ldsb, wave_s); const int gw = F.vcu * NWAVES + F.wave, NGW = F.G * NWAVES; (void)gw; (void)NGW
    if (IN(0)) _Pragma("unroll 1") for (int rep_ = 0; rep_ <= ((REPMASK >> 0) & 1); ++rep_) { PHASE_ARGS; p0_prologue(F, ap); } SEAM(0);
    if (IN(1)) _Pragma("unroll 1") for (int rep_ = 0; rep_ <= ((REPMASK >> 1) & 1); ++rep_) { PHASE_ARGS; const float* x = (const float*)ap->in[0]; const float* g1 = (const float*)ap->in[5]; const float* mod = (const float*)(ws + WS_MOD); bf16* XN = (bf16*)(ws + WS_XN);
#pragma unroll 1
        for (int wv = gw; wv < M / 16; wv += NGW) {
#pragma unroll 1
          for (int k4 = 0; k4 < 4; ++k4) { const int m = wv * 16 + 4 * k4; f32x4 u[4][4]; modnorm_rows<4, false>(x, m, 1, g1, mod, 0, 1024, XN, F.lane, u);
            if (F.lane < 32) { const int mm = m + (F.lane >> 3), j = F.lane & 7; const float pos = (float)((const int*)ap->in[2])[mm];
                const float ang = pos * __expf(-(float)j * 0.125f * 13.122363377404328f); const float sn = __sinf(ang), cs = __cosf(ang);
                bf16* rt = (bf16*)(ws + WS_ROPE) + (size_t)mm * 16; rt[j] = (bf16)(pk2(cs, 0.f) & 0xffffu); rt[8 + j] = (bf16)(pk2(sn, 0.f) & 0xffffu); } } } } SEAM(1);
    if (IN(2)) _Pragma("unroll 1") for (int rep_ = 0; rep_ <= ((REPMASK >> 2) & 1); ++rep_) { PHASE_ARGS; pg8::Gemm g{(const pb*)(ws + WS_XN), (const pb*)(ws + WS_WINT), M, NZP, D}; pg8::StaticOrder S; S.init(M, NZP, F.G, (int)blockIdx.x);
        pg8::EpiZ E{(pb*)(ws + WS_Z)}; pg8::gemm_phase<pg8::EpiZ, pg8::StaticOrder, true, true>(F.lds, g, S, E, F.tid); }
    if (IN(2)) { PHASE_ARGS; const int c0 = conv_idle_first(F.G);
        if ((int)blockIdx.x >= c0 && c0 < F.G) { __syncthreads(); conv_items(F, ap, 0, CONV_EARLY, ((int)blockIdx.x - c0) * NWAVES + F.wave, (F.G - c0) * NWAVES); } }
    SEAM(2);
    if (IN(3)) {
#ifndef REP_SCAN
#define REP_SCAN 1
#endif
#ifndef REP_ATTN
#define REP_ATTN 1
#endif
      { PHASE_ARGS; const ScanArgs SP{(const GAS bf16*)(ws + WS_Z), (const GAS float*)ap->in[7], (const GAS float*)ap->in[8], nullptr, nullptr, nullptr, nullptr, nullptr, nullptr, nullptr, (GAS unsigned char*)(ws + WS_SGD)};
#pragma unroll 1
        for (int task = F.vcu * NWAVES + F.wave; task < 2048; task += F.G * NWAVES) scan2_prep(SP, task >> 7, (task >> 6) & 1, task & 63, F.lane); }
      GRIDBAR();
      { int c0_, G_; { Frame F0; mk_frame(F0, ldsb, wave_s); c0_ = F0.vcu; G_ = F0.G; }
#pragma unroll 1
        for (int c = c0_; c < 256 * REP_SCAN; c += G_) { PHASE_ARGS; const int b = (c >> 4) & 15, h = (c >> 1) & 7, dir = c & 1;
            scan2_setup(F.lds, (const GAS float*)ap->in[10], (const GAS float*)ap->in[12], h, dir, F.tid); __syncthreads();
            const ScanArgs SA{(const GAS bf16*)(ws + WS_Z), (const GAS float*)ap->in[7], (const GAS float*)ap->in[8], (const GAS float*)ap->in[9], (const GAS float*)ap->in[11], (const GAS float*)ap->in[14], (const GAS float*)ap->in[15], (const GAS float*)ap->in[16],
                              (GAS bf16*)(ws + WS_XN) + (size_t)dir * M * 512, (GAS float*)(ws + WS_BONUS) + (size_t)dir * M * 8, (GAS unsigned char*)(ws + WS_SGD)};
#pragma unroll 1
            for (int cc = F.wave; cc < T / 32; cc += 8) scan2_chunk(F.lds, SA, b, h, dir, cc, F.lane, F.wave);
            __syncthreads(); } }
      { PHASE_ARGS;
#pragma unroll 1
        for (int u = F.vcu; u < 512 * REP_ATTN; u += F.G) { attn_unit(F, ap, (u >> 5) & 15, (u >> 4) & 1, u & 15); } }
      { PHASE_ARGS;
        const bf16* Z = (const bf16*)(ws + WS_Z); bf16* SGD = (bf16*)(ws + WS_SGD); const float* mu_prev = (const float*)ap->in[7]; const float* mu_next = (const float*)ap->in[8];
          const int c = ZGD + 2 * F.lane; const float mp0 = mu_prev[c], mp1 = mu_prev[c + 1], mn0 = mu_next[c], mn1 = mu_next[c + 1];
#ifndef REP_SGD
#define REP_SGD 1
#endif
          const int tile = F.vcu;
          if (tile < 256) { const int pm = tile >> 1, pn = tile & 1; constexpr int RS = 136;
              LAS bf16* SG = (LAS bf16*)F.lds; LAS bf16* GT = (LAS bf16*)(F.lds + 256 * RS * 2);
              __syncthreads();
              const int mt0 = pm * 256 + F.wave * 32;
#pragma unroll 1
              for (int m0 = 0; m0 < 32; m0 += 4) { unsigned z0[4], zm[4], zq[4];
#pragma unroll
                  for (int i = 0; i < 4; ++i) { const int m = mt0 + m0 + i, t = m & (T - 1);
                      z0[i] = *(const GAS unsigned*)(Z + (size_t)m * NZ + c); zm[i] = t > 0 ? *(const GAS unsigned*)(Z + (size_t)(m - 1) * NZ + c) : 0u; zq[i] = t < T - 1 ? *(const GAS unsigned*)(Z + (size_t)(m + 1) * NZ + c) : 0u; }
#pragma unroll
                  for (int i = 0; i < 4; ++i) { const float a0 = bflo(z0[i]), a1 = bfhi(z0[i]); const float s0 = a0 + mp0 * (bflo(zm[i]) - a0) + mn0 * (bflo(zq[i]) - a0), s1 = a1 + mp1 * (bfhi(zm[i]) - a1) + mn1 * (bfhi(zq[i]) - a1);
                      *(LAS unsigned*)(SG + (F.wave * 32 + m0 + i) * RS + 2 * F.lane) = pk2(sigm(s0), sigm(s1)); } }
              __syncthreads();
              const int r32 = F.lane & 31, hh = F.lane >> 5; bf16x8 af[8];
#pragma unroll
              for (int sI = 0; sI < 8; ++sI) af[sI] = *(const LAS bf16x8*)(SG + (F.wave * 32 + r32) * RS + 16 * sI + 8 * hh);
              bf16* Gout = (bf16*)(ws + WS_G); const bf16* G2T = (const bf16*)(ws + WS_G2T);
#pragma unroll 1
              for (int hf = 0; hf < 2; ++hf) {
#pragma unroll
                  for (int i = 0; i < 4; ++i) { const int e = F.tid + 512 * i, rr = e >> 4, ch = e & 15; *(LAS v4u*)(GT + rr * RS + ch * 8) = *(const GAS v4u*)(G2T + (size_t)(256 * pn + 128 * hf + rr) * 256 + ch * 8); }
                  __syncthreads();
#pragma unroll 1
                  for (int ct = 0; ct < 4; ++ct) { f32x16 acc = {};
#pragma unroll
                      for (int sI = 0; sI < 8; ++sI) { const bf16x8 bfr = *(const LAS bf16x8*)(GT + (32 * ct + r32) * RS + 16 * sI + 8 * hh); acc = __builtin_amdgcn_mfma_f32_32x32x16_bf16(af[sI], bfr, acc, 0, 0, 0); }
#pragma unroll
                      for (int g = 0; g < 16; ++g) { const int row = (g & 3) + 8 * (g >> 2) + 4 * hh;
                          Gout[(size_t)(mt0 + row) * 512 + 256 * pn + 128 * hf + 32 * ct + r32] = (bf16)(pk2(acc[g], 0.f) & 0xffffu); } }
                  __syncthreads(); } } }
    } SEAM(4);
#ifndef REP_PG
#define REP_PG 0
#endif
    if (IN(5)) { PHASE_ARGS; if (REP_PG) pg_rows(F, ap, (bf16*)ap->out); pg_rows(F, ap, (bf16*)(ws + WS_G)); } SEAM(5);
    if (IN(6)) { PHASE_ARGS; static_assert(WS_G == WS_OATT + (size_t)M * 512 * 2 && WS_PAT == WS_PRT + (size_t)1024 * 512 * 2, "merged operand views need adjacent buffers");
        pg8::Gemm g{(const pb*)(ws + WS_OATT), (const pb*)(ws + WS_PRT), 2 * M, 2048, 512}; pg8::MergeOrder S; S.init(F.G, (int)blockIdx.x);
        pg8::EpiGate2 E{(pb*)(ws + WS_XN), (const pb*)(ws + WS_Z)}; pg8::gemm_phase<pg8::EpiGate2, pg8::MergeOrder, true, true>(F.lds, g, S, E, F.tid); } SEAM(7);
    if (IN(8)) _Pragma("unroll 1") for (int rep_ = 0; rep_ <= ((REPMASK >> 8) & 1); ++rep_) { PHASE_ARGS; pg8::Gemm g{(const pb*)(ws + WS_XN), (const pb*)(ws + WS_WOT), M, 1024, 1024}; pg8::StaticOrder S; S.init(M, 1024, F.G, (int)blockIdx.x);
        pg8::EpiRes E{(const float*)ap->in[0], (const float*)(ws + WS_MOD), (pb*)(ws + WS_X1)}; pg8::gemm_phase<pg8::EpiRes, pg8::StaticOrder, true, true>(F.lds, g, S, E, F.tid); } SEAM(8);
    if (IN(9)) _Pragma("unroll 1") for (int rep_ = 0; rep_ <= ((REPMASK >> 9) & 1); ++rep_) { PHASE_ARGS; pj_phase(F, ap); } SEAM(9);
    if (IN(10)) _Pragma("unroll 1") for (int rep_ = 0; rep_ <= ((REPMASK >> 10) & 1); ++rep_) { PHASE_ARGS; for (int p = F.vcu; p < 256; p += F.G) pk_task(F, ap, p >> 4, p & 15); } SEAM(10);
    if (IN(11)) _Pragma("unroll 1") for (int rep_ = 0; rep_ <= ((REPMASK >> 11) & 1); ++rep_) { PHASE_ARGS; pg8::Gemm g{(const pb*)(ws + WS_XN), (const pb*)((unsigned char*)ap->out + OUT_WGUT), ME, 16 * 2048, 1024}; pg8::GroupOrder<8> S{F.G, (int)blockIdx.x};
        pg8::EpiSwiglu E{(pb*)(ws + WS_H)}; pg8::gemm_phase<pg8::EpiSwiglu, pg8::GroupOrder<8>, true, true, true>(F.lds, g, S, E, F.tid, (const int*)(ws + WS_SELIDX)); } SEAM(11);
    if (IN(12)) _Pragma("unroll 1") for (int rep_ = 0; rep_ <= ((REPMASK >> 12) & 1); ++rep_) { PHASE_ARGS; pg8::Gemm g{(const pb*)(ws + WS_H), (const pb*)((unsigned char*)ap->out + OUT_WDT), ME, 16 * 1024, 1024}; pg8::GroupOrder<4> S{F.G, (int)blockIdx.x};
        pg8::EpiDown E{(pb*)(ws + WS_XE), (const float*)(ws + WS_SELAFF)}; pg8::gemm_phase<pg8::EpiDown, pg8::GroupOrder<4>, true, true>(F.lds, g, S, E, F.tid); } SEAM(12);
#ifndef EXTRA_BARS
#define EXTRA_BARS 0
#endif
#if ONE_LAUNCH
    _Pragma("unroll 1") for (int xb_ = 0; xb_ < EXTRA_BARS; ++xb_) { MKBAR; { unsigned o_ = ~0u; asm volatile("" : "+s"(o_)); xcd_barrier(bar, wave_s == 0 && __builtin_amdgcn_mbcnt_hi(o_, __builtin_amdgcn_mbcnt_lo(o_, 0u)) == 0u); } }
#endif
#ifndef REP_PN
#define REP_PN 0
#endif
    if (IN(13)) { PHASE_ARGS; if (REP_PN) pn_rows(F, ap, (float*)(ws + WS_H)); pn_rows(F, ap, ap->out); }
#undef IN
#undef SEAM
}

extern "C" void kernel_launch(void* const* d_in, const int* in_sizes, int n_in, void* d_out, int out_size, void* d_ws, size_t ws_size, hipStream_t stream) {
    static int grid = 0;
    if (grid == 0) {
        if (n_in != 30 || out_size != M * D || ws_size < WS_END) { fprintf(stderr, "kernel_launch: unexpected shapes n_in %d out %d ws %zu\n", n_in, out_size, ws_size); grid = -1; return; }
        int dev = 0, cus = 0, per_cu = 0;
        if (hipGetDevice(&dev) != hipSuccess || hipDeviceGetAttribute(&cus, hipDeviceAttributeMultiprocessorCount, dev) != hipSuccess) { grid = -1; return; }
        if (hipFuncSetAttribute((const void*)fwd_kernel, hipFuncAttributeMaxDynamicSharedMemorySize, LDS_BYTES) != hipSuccess) { fprintf(stderr, "kernel_launch: hipFuncSetAttribute failed\n"); grid = -1; return; }
        if (hipOccupancyMaxActiveBlocksPerMultiprocessor(&per_cu, (const void*)fwd_kernel, NWAVES * 64, LDS_BYTES) != hipSuccess || per_cu < 1) fprintf(stderr, "kernel_launch: occupancy query reports %d\n", per_cu);
        (void)hipGetLastError();
        grid = cus;
    }
    if (grid < 0) return;
    if (hipMemsetAsync((char*)d_ws + WS_CTL, 0, CTL_ZERO_BYTES, stream) != hipSuccess) return;
    Args a{};
    for (int i = 0; i < 30; ++i) a.in[i] = d_in[i];
    a.out = (float*)d_out; a.ws = (unsigned char*)d_ws;
#if ONE_LAUNCH
    a.ph_lo = 0; a.ph_hi = NPHASE;
    hipLaunchKernelGGL(fwd_kernel, dim3(grid), dim3(NWAVES * 64), LDS_BYTES, stream, a);
#else
    for (int p = 0; p < NPHASE; ++p) { a.ph_lo = p; a.ph_hi = p + 1; hipLaunchKernelGGL(fwd_kernel, dim3(grid), dim3(NWAVES * 64), LDS_BYTES, stream, a); }
#endif
}
```

```cpp
#include <hip/hip_runtime.h>
#include <cstdio>
#include <cstdint>
#include <cmath>
namespace pg8 {
#define PG8_LAS __attribute__((address_space(3)))
typedef unsigned short bf16_t;
typedef short bf16x8 __attribute__((ext_vector_type(8)));
typedef float f32x4 __attribute__((ext_vector_type(4)));
typedef unsigned u32x4 __attribute__((ext_vector_type(4)));
constexpr int BM = 256, BK = 64, HALF = 128, HTB = HALF * BK * 2  , STAGE_BYTES = 8 * HTB, NXCD = 8, WGM = 4;

__host__ __device__ __forceinline__ int lds_byte(int r, int c) { const int st = (r >> 4) * 2 + (c >> 5), rr = r & 15, cc = c & 31, ob = rr * 64 + cc * 2; return st * 1024 + (ob ^ (((ob >> 9) & 1) << 5)); }
__host__ __device__ __forceinline__ void stage_rc(int b, int& R, int& C) { const int st = b / 1024, sb = b % 1024, swz = sb ^ (((sb >> 9) & 1) << 5); R = (st >> 1) * 16 + swz / 64; C = (st & 1) * 32 + (swz % 64) / 2; }
__host__ __device__ __forceinline__ int perm32(int rho) { const int n = rho >> 4, i = rho & 15; return 8 * (i >> 2) + 4 * n + (i & 3); }

struct Unit { int pm, pn; };
struct Gemm { const bf16_t* A; const bf16_t* Bt; int M, N, K; };

struct StaticOrder {
    int nM, nN, nwg, G, c;
    __host__ __device__ void init(int M, int N, int G_, int c_) { nM = M / BM; nN = N / BM; nwg = nM * nN; G = G_; c = c_; }
    __host__ __device__ bool next(int i, Unit& u) const {
        const long L = (long)i * G + c; if (L >= nwg) return false;
        int wgid = (int)L; { const int q = nwg / NXCD, r = nwg % NXCD, xcd = wgid % NXCD, off = wgid / NXCD; wgid = (xcd < r ? xcd * (q + 1) : r * (q + 1) + (xcd - r) * q) + off; }
        const int nig = WGM * nN, gid = wgid / nig, fm = gid * WGM, gsz = (nM - fm) < WGM ? (nM - fm) : WGM;
        u.pm = fm + ((wgid % nig) % gsz); u.pn = (wgid % nig) / gsz; return true;
    }
    __device__ __forceinline__ void a_ready(const Unit&) const {}
    __device__ __forceinline__ void done(const Unit&) const {}
};

__device__ __forceinline__ unsigned cvt_pk_bf16(float lo, float hi) { unsigned r; asm volatile("v_cvt_pk_bf16_f32 %0, %1, %2" : "=v"(r) : "v"(lo), "v"(hi)); return r; }
typedef float f32x2 __attribute__((ext_vector_type(2)));
template <class Epi, class Sched, bool ALIGN_EPI = false, bool SP2 = false, bool GATHER = false>
__device__ __forceinline__ void gemm_phase(PG8_LAS unsigned char* lds, const Gemm g, const Sched& S, const Epi& E, int tid_in, const int* gidx = nullptr) {
    static_assert(!GATHER || SP2, "the gather variant is written for the SP2 loop");
    int tid_ = tid_in; asm volatile("" : "+v"(tid_));
    const int tid = tid_, wid = __builtin_amdgcn_readfirstlane(tid >> 6), lane = tid & 63, wr = wid >> 2, wc = wid & 3, fr = lane & 15, fq = lane >> 4;
    const int K = g.K, nt = K / BK;
    unsigned voffA[2], voffB[2];
#pragma unroll
    for (int i = 0; i < 2; ++i) { int R, C; stage_rc(tid * 16 + i * 8192, R, C); const int Rb = Epi::PERM ? ((R & ~31) + perm32(R & 31)) : R;
        voffA[i] = (unsigned)(R * K + C) * 2u; voffB[i] = (unsigned)(Rb * K + C) * 2u; }
    int gRA[2] = {0, 0}; unsigned gCA[2] = {0u, 0u}; unsigned gc[2][2] = {{0u, 0u}, {0u, 0u}}, gn[2][2] = {{0u, 0u}, {0u, 0u}};
    if constexpr (GATHER) {
#pragma unroll
        for (int i = 0; i < 2; ++i) { int R, C; stage_rc(tid * 16 + i * 8192, R, C); gRA[i] = R; gCA[i] = (unsigned)C * 2u; } }
#define PG8_GLOAD(dst, un) do { _Pragma("unroll") for (int h_ = 0; h_ < 2; ++h_) _Pragma("unroll") for (int i_ = 0; i_ < 2; ++i_) \
        dst[h_][i_] = (unsigned)gidx[(un).pm * 256 + h_ * 128 + gRA[i_]] * (unsigned)(K * 2) + gCA[i_]; } while (0)
#define PG8_STAGE_G(bufoff, gbase, nx, h) do { unsigned vo_[2] = {(nx) ? gn[h][0] : gc[h][0], (nx) ? gn[h][1] : gc[h][1]}; PG8_STAGE(bufoff, gbase, vo_); } while (0)
    const size_t kstep = (size_t)(BK * 2);
    const size_t hstep = (size_t)HALF * K * 2;
    const size_t tstep = 2 * hstep;
    const unsigned ldsw = (unsigned)wid * 1024u;
    const int aoff = lds_byte(wr * 64 + fr, fq * 8), boff = lds_byte(wc * 32 + fr, fq * 8);
#define PG8_SA(b, h) (((b) * 2 + (h)) * HTB)
#define PG8_SB(b, h) ((4 + (b) * 2 + (h)) * HTB)
#define PG8_STAGE(bufoff, gbase, voff) do { _Pragma("unroll") for (int _i = 0; _i < 2; ++_i) \
        __builtin_amdgcn_global_load_lds((const unsigned*)((const char*)(gbase) + (voff)[_i]), (PG8_LAS unsigned*)(lds + (bufoff) + ldsw + _i * 8192), 16, 0, 0); } while (0)
#define PG8_LDA(dst, b, h) do { _Pragma("unroll") for (int m = 0; m < 4; ++m) _Pragma("unroll") for (int k = 0; k < 2; ++k) dst[m][k] = *(const PG8_LAS bf16x8*)(lds + PG8_SA(b, h) + aoff + m * 2048 + k * 1024); } while (0)
#define PG8_LDB(dst, b, h) do { _Pragma("unroll") for (int n = 0; n < 2; ++n) _Pragma("unroll") for (int k = 0; k < 2; ++k) dst[n][k] = *(const PG8_LAS bf16x8*)(lds + PG8_SB(b, h) + boff + n * 2048 + k * 1024); } while (0)
#define PG8_MMA(ai, bj, At, Bt) do { __builtin_amdgcn_s_setprio(1); _Pragma("unroll") for (int m = 0; m < 4; ++m) _Pragma("unroll") for (int n = 0; n < 2; ++n) _Pragma("unroll") for (int k = 0; k < 2; ++k) \
        acc[ai][bj][m][n] = __builtin_amdgcn_mfma_f32_16x16x32_bf16(Bt[n][k], At[m][k], acc[ai][bj][m][n], 0, 0, 0); __builtin_amdgcn_s_setprio(0); } while (0)
#define PG8_WAIT_V(n) asm volatile("s_waitcnt vmcnt(" #n ")" ::: "memory")
#define PG8_WAIT_L(n) asm volatile("s_waitcnt lgkmcnt(" #n ")" ::: "memory")
#define PG8_BAR __builtin_amdgcn_s_barrier()
#define PG8_SCHED __builtin_amdgcn_sched_barrier(0)
    Unit cur, nxt; int ui = 0;
    if (!S.next(0, cur)) return;
    f32x4 acc[2][2][4][2];
#pragma unroll
    for (int a = 0; a < 2; ++a)
#pragma unroll
        for (int b = 0; b < 2; ++b)
#pragma unroll
            for (int m = 0; m < 4; ++m)
#pragma unroll
                for (int n = 0; n < 2; ++n) acc[a][b][m][n] = (f32x4){0.f, 0.f, 0.f, 0.f};
    bf16x8 At[4][2], B0[2][2], B1[2][2];
    const char* cA = GATHER ? (const char*)g.A : (const char*)g.A + (size_t)cur.pm * tstep; const char* cB = (const char*)g.Bt + (size_t)cur.pn * tstep;
    if constexpr (GATHER) { PG8_GLOAD(gc, cur); Unit n1_; if (S.next(1, n1_)) PG8_GLOAD(gn, n1_); else { gn[0][0] = gc[0][0]; gn[0][1] = gc[0][1]; gn[1][0] = gc[1][0]; gn[1][1] = gc[1][1]; } }
    S.a_ready(cur);
    if constexpr (SP2) {
        PG8_STAGE(PG8_SB(0, 0), cB, voffB); PG8_STAGE(PG8_SB(0, 1), cB + hstep, voffB);
        if constexpr (GATHER) { PG8_STAGE_G(PG8_SA(0, 0), cA, false, 0); PG8_STAGE_G(PG8_SA(0, 1), cA, false, 1); } else { PG8_STAGE(PG8_SA(0, 0), cA, voffA); PG8_STAGE(PG8_SA(0, 1), cA + hstep, voffA); }
        if (wr == 1) PG8_BAR;
        PG8_WAIT_V(2); PG8_BAR;
        PG8_STAGE(PG8_SB(1, 0), cB + kstep, voffB); if constexpr (GATHER) PG8_STAGE_G(PG8_SA(1, 0), cA + kstep, false, 0); else PG8_STAGE(PG8_SA(1, 0), cA + kstep, voffA); PG8_STAGE(PG8_SB(1, 1), cB + hstep + kstep, voffB);
        PG8_WAIT_V(6); PG8_BAR;
    } else {
        PG8_STAGE(PG8_SB(0, 0), cB, voffB); PG8_STAGE(PG8_SA(0, 0), cA, voffA); PG8_STAGE(PG8_SB(0, 1), cB + hstep, voffB); PG8_STAGE(PG8_SA(0, 1), cA + hstep, voffA);
        if (wr == 1) PG8_BAR;
        PG8_WAIT_V(4); PG8_BAR;
        PG8_STAGE(PG8_SB(1, 0), cB + kstep, voffB); PG8_STAGE(PG8_SA(1, 0), cA + kstep, voffA); PG8_STAGE(PG8_SB(1, 1), cB + hstep + kstep, voffB);
        PG8_WAIT_V(6); PG8_BAR;
    }
    for (;;) {
        const bool has_next = S.next(ui + 1, nxt);
        if constexpr (GATHER) { if (!has_next) { gn[0][0] = gc[0][0]; gn[0][1] = gc[0][1]; gn[1][0] = gc[1][0]; gn[1][1] = gc[1][1]; } }
        const char* nA = (has_next && !GATHER) ? (const char*)g.A + (size_t)nxt.pm * tstep : cA; const char* nB = has_next ? (const char*)g.Bt + (size_t)nxt.pn * tstep : cB;
        for (int t = 0; t < nt; t += 2) {
            const bool last = (t == nt - 2);
            const char* a1 = cA + (size_t)(t + 1) * kstep;
            const char* a2 = last ? nA : cA + (size_t)(t + 2) * kstep; const char* b2 = last ? nB : cB + (size_t)(t + 2) * kstep;
            const char* a3 = a2 + kstep; const char* b3 = b2 + kstep;
            if (last && has_next) S.a_ready(nxt);
            if constexpr (SP2) {
            PG8_LDB(B0, 0, 0); PG8_LDB(B1, 0, 1); PG8_SCHED; PG8_LDA(At, 0, 0); if constexpr (GATHER) PG8_STAGE_G(PG8_SA(1, 1), a1, false, 1); else PG8_STAGE(PG8_SA(1, 1), a1 + hstep, voffA);
            PG8_WAIT_V(8); PG8_WAIT_L(0); PG8_BAR; PG8_MMA(0, 0, At, B0); PG8_MMA(0, 1, At, B1); PG8_BAR; PG8_SCHED;
            PG8_LDA(At, 0, 1); PG8_STAGE(PG8_SB(0, 0), b2, voffB); PG8_STAGE(PG8_SB(0, 1), b2 + hstep, voffB); if constexpr (GATHER) PG8_STAGE_G(PG8_SA(0, 0), a2, last, 0); else PG8_STAGE(PG8_SA(0, 0), a2, voffA);
            PG8_WAIT_V(8); PG8_WAIT_L(0); PG8_BAR; PG8_MMA(1, 0, At, B0); PG8_MMA(1, 1, At, B1); PG8_BAR; PG8_SCHED;
            PG8_LDB(B0, 1, 0); PG8_LDB(B1, 1, 1); PG8_SCHED; PG8_LDA(At, 1, 0); if constexpr (GATHER) PG8_STAGE_G(PG8_SA(0, 1), a2, last, 1); else PG8_STAGE(PG8_SA(0, 1), a2 + hstep, voffA);
            PG8_WAIT_V(8); PG8_WAIT_L(0); PG8_BAR; PG8_MMA(0, 0, At, B0); PG8_MMA(0, 1, At, B1); PG8_BAR; PG8_SCHED;
            PG8_LDA(At, 1, 1); PG8_STAGE(PG8_SB(1, 0), b3, voffB); PG8_STAGE(PG8_SB(1, 1), b3 + hstep, voffB); if constexpr (GATHER) PG8_STAGE_G(PG8_SA(1, 0), a3, last, 0); else PG8_STAGE(PG8_SA(1, 0), a3, voffA);
            PG8_WAIT_V(8); PG8_WAIT_L(0); PG8_BAR; PG8_MMA(1, 0, At, B0); PG8_MMA(1, 1, At, B1); PG8_BAR; PG8_SCHED;
            } else {
            PG8_LDB(B0, 0, 0); PG8_SCHED; PG8_LDA(At, 0, 0); PG8_STAGE(PG8_SA(1, 1), a1 + hstep, voffA);
            PG8_WAIT_L(8); PG8_BAR; PG8_WAIT_L(0); PG8_MMA(0, 0, At, B0); PG8_BAR; PG8_SCHED;
            PG8_LDB(B1, 0, 1); PG8_STAGE(PG8_SB(0, 0), b2, voffB);
            PG8_BAR; PG8_WAIT_L(0); PG8_MMA(0, 1, At, B1); PG8_BAR;
            PG8_LDA(At, 0, 1); PG8_STAGE(PG8_SA(0, 0), a2, voffA);
            PG8_BAR; PG8_WAIT_L(0); PG8_MMA(1, 0, At, B0); PG8_BAR; PG8_SCHED;
            PG8_STAGE(PG8_SB(0, 1), b2 + hstep, voffB);
            PG8_WAIT_V(6); PG8_BAR; PG8_MMA(1, 1, At, B1); PG8_BAR;
            PG8_LDB(B0, 1, 0); PG8_SCHED; PG8_LDA(At, 1, 0); PG8_STAGE(PG8_SA(0, 1), a2 + hstep, voffA);
            PG8_WAIT_L(8); PG8_BAR; PG8_WAIT_L(0); PG8_MMA(0, 0, At, B0); PG8_BAR; PG8_SCHED;
            PG8_LDB(B1, 1, 1); PG8_STAGE(PG8_SB(1, 0), b3, voffB);
            PG8_BAR; PG8_WAIT_L(0); PG8_MMA(0, 1, At, B1); PG8_BAR;
            PG8_LDA(At, 1, 1); PG8_STAGE(PG8_SA(1, 0), a3, voffA);
            PG8_BAR; PG8_WAIT_L(0); PG8_MMA(1, 0, At, B0); PG8_BAR; PG8_SCHED;
            PG8_STAGE(PG8_SB(1, 1), b3 + hstep, voffB);
            PG8_WAIT_V(6); PG8_BAR; PG8_MMA(1, 1, At, B1); PG8_BAR;
            }
        }
        if constexpr (ALIGN_EPI) { if (wr == 0) PG8_BAR; }
#ifdef REP_EPI
        if constexpr (!Epi::AFTER_DRAIN) { E(acc, cur, wr, wc, fr, fq); asm volatile("" ::: "memory"); }
#endif
        if constexpr (!Epi::AFTER_DRAIN) { E(acc, cur, wr, wc, fr, fq); S.done(cur); }
        unsigned g2_[2][2] = {{0u, 0u}, {0u, 0u}};
        if constexpr (GATHER) { Unit nn_; if (has_next && S.next(ui + 2, nn_)) PG8_GLOAD(g2_, nn_); else { g2_[0][0] = gn[0][0]; g2_[0][1] = gn[0][1]; g2_[1][0] = gn[1][0]; g2_[1][1] = gn[1][1]; } }
        if (!has_next) break;
#pragma unroll
        for (int a = 0; a < 2; ++a)
#pragma unroll
            for (int b = 0; b < 2; ++b)
#pragma unroll
                for (int m = 0; m < 4; ++m)
#pragma unroll
                    for (int n = 0; n < 2; ++n) acc[a][b][m][n] = (f32x4){0.f, 0.f, 0.f, 0.f};
        cur = nxt; cA = nA; cB = nB; ++ui;
        if constexpr (GATHER) { gc[0][0] = gn[0][0]; gc[0][1] = gn[0][1]; gc[1][0] = gn[1][0]; gc[1][1] = gn[1][1]; gn[0][0] = g2_[0][0]; gn[0][1] = g2_[0][1]; gn[1][0] = g2_[1][0]; gn[1][1] = g2_[1][1]; }
        if constexpr (ALIGN_EPI) { if (wr == 1) PG8_BAR; }
    }
    PG8_WAIT_V(0);
    if constexpr (!ALIGN_EPI) { if (wr == 0) PG8_BAR; }
    PG8_BAR;
    if constexpr (Epi::AFTER_DRAIN) { E.fused(acc, cur, wr, wc, fr, fq, lds, wid, lane); S.done(cur); }
#undef PG8_SA
#undef PG8_SB
#undef PG8_STAGE
#undef PG8_STAGE_G
#undef PG8_GLOAD
#undef PG8_LDA
#undef PG8_LDB
#undef PG8_MMA
#undef PG8_WAIT_V
#undef PG8_WAIT_L
#undef PG8_BAR
#undef PG8_SCHED
}
}

#ifndef ONE_LAUNCH
#define ONE_LAUNCH 1
#endif
constexpr int NB = 16, T = 2048, D = 1024, M = NB * T;
constexpr int NZ = 4736, NZP = 4864;
constexpr int RW = 512, NE = 16, CAP = 256, ME = NE * NB * CAP;
constexpr int ZR = 0, ZK = 512, ZV = 1024, ZWD = 1536, ZAD = 1664, ZGD = 1792, ZQ = 1920, ZKA = 2432, ZVA = 2560, ZGA = 2688, ZGB = 3712;
constexpr int NWAVES = 8, NPHASE = 14;
constexpr size_t MiB = 1u << 20;
constexpr size_t WS_CTL = 0, CTL_ZERO_BYTES = 64 * 1024 + 16 * 6144 * 4;
constexpr size_t WS_MOD = 64 * 1024, WS_BONUS = 2 * MiB, WS_AFF = 4 * MiB, WS_SELAFF = 6 * MiB, WS_SLOT = 7 * MiB, WS_G2T = 9 * MiB;
constexpr size_t WS_WINT = 10 * MiB, WS_PRT = 20 * MiB, WS_PAT = 21 * MiB, WS_WOT = 22 * MiB, WS_SGD = 24 * MiB;
constexpr size_t WS_XN = 40 * MiB;
constexpr size_t WS_OATT = 104 * MiB;
constexpr size_t WS_G = 136 * MiB;
constexpr size_t WS_Z = 168 * MiB;
constexpr size_t WS_X1 = 104 * MiB;
constexpr size_t OUT_WGUT = 0;
constexpr size_t OUT_WDT = 64 * MiB;
constexpr size_t WS_XE = 200 * MiB;
constexpr size_t WS_H = 328 * MiB;
constexpr size_t WS_END = 464 * MiB;
constexpr size_t WS_ROPE = WS_AFF;
constexpr size_t WS_SELIDX = WS_SELAFF + 512 * 1024;
constexpr int CW_BAR = 4096;
constexpr int RING_BYTES = 131072, LDSCTL_OFF = RING_BYTES, MISC_OFF = LDSCTL_OFF + 320, LDS_BYTES = 147456;

#define GAS __attribute__((address_space(1)))
#define LAS __attribute__((address_space(3)))
typedef unsigned short bf16;
typedef unsigned v4u __attribute__((ext_vector_type(4)));
typedef float f32x4 __attribute__((ext_vector_type(4)));
typedef short bf16x8 __attribute__((ext_vector_type(8)));
typedef GAS unsigned gu32;
typedef GAS unsigned long long gu64;
#define RLX_AGENT __ATOMIC_RELAXED, __HIP_MEMORY_SCOPE_AGENT
#define LDS_WAIT() asm volatile("s_waitcnt lgkmcnt(0)" ::: "memory")
#define VM_WAIT() asm volatile("s_waitcnt vmcnt(0)" ::: "memory")
__device__ __forceinline__ unsigned long long rt() { return __builtin_amdgcn_s_memrealtime(); }
__device__ __forceinline__ unsigned f2bf(float f) { unsigned u = __builtin_bit_cast(unsigned, f); return (u + 0x7fffu + ((u >> 16) & 1u)) >> 16; }
typedef float f32x2hw __attribute__((ext_vector_type(2))); typedef __bf16 bf16x2hw __attribute__((ext_vector_type(2)));
__device__ __forceinline__ unsigned pk2(float lo, float hi) { f32x2hw v = {lo, hi}; bf16x2hw b = __builtin_convertvector(v, bf16x2hw); return __builtin_bit_cast(unsigned, b); }

#define XB_TMO      128
#define XB_XCNT(j)  (256  + 64 * (j))
#define XB_XSUB(j)  (1280 + 64 * (j))
#define XB_XGEN(j)  (2304 + 64 * (j))
#define XB_TOP      3328
#define XB_TOPGEN   3392
#define XCD_BAR_WORDS 3456
#define XB_SPIN_CAP (1u << 18)

__device__ __forceinline__ unsigned xb_ld(unsigned* p)              { return __hip_atomic_load(p, __ATOMIC_RELAXED, __HIP_MEMORY_SCOPE_AGENT); }
__device__ __forceinline__ unsigned xb_add(unsigned* p, unsigned v) { return __hip_atomic_fetch_add(p, v, __ATOMIC_RELAXED, __HIP_MEMORY_SCOPE_AGENT); }
__device__ __forceinline__ unsigned xb_xcc_id() { return (unsigned)__builtin_amdgcn_s_getreg((3 << 11) | 20) & 0xFu; }
#define XB_SPIN(cond, bar) do { unsigned _sp = 0; while (cond) { __builtin_amdgcn_s_sleep(1); \
    if ((++_sp & 255u) == 0u) { if (xb_ld(&(bar)[XB_TMO])) break; if (_sp > XB_SPIN_CAP) { atomicAdd(&(bar)[XB_TMO], 1u); break; } } } } while (0)

struct XcdBarrier {
    unsigned* bar; unsigned x;
    volatile LAS unsigned* st;
};

__device__ __forceinline__ XcdBarrier xcd_barrier_post(unsigned* bar, volatile LAS unsigned* st) {
    XcdBarrier b; b.bar = bar; b.x = xb_xcc_id(); b.st = st;
    if (threadIdx.x == 0) (void)xb_add(&bar[XB_XCNT(b.x)], 1u);
    return b;
}
__device__ __forceinline__ void xcd_barrier_complete(unsigned* bar, unsigned x, unsigned& nloc, unsigned& nx) {
    const unsigned G = gridDim.x * gridDim.y * gridDim.z;
    unsigned sum, cnt, mine, sp = 0u;
    for (;;) {
        sum = 0u; cnt = 0u; mine = 0u;
#pragma unroll
        for (unsigned j = 0; j < 16; ++j) { const unsigned c = xb_ld(&bar[XB_XCNT(j)]); sum += c; cnt += (c > 0u) ? 1u : 0u; mine = (j == x) ? c : mine; }
        if (sum == G) break;
        __builtin_amdgcn_s_sleep(1);
        if ((++sp & 255u) == 0u) { if (xb_ld(&bar[XB_TMO])) break; if (sp > XB_SPIN_CAP) { atomicAdd(&bar[XB_TMO], 1u); break; } }
    }
    nloc = mine > 0u ? mine : 1u; nx = cnt > 0u ? cnt : 1u;
}

__device__ __forceinline__ void xcd_barrier(const XcdBarrier& b, bool is_thread0) {
    asm volatile("s_waitcnt vmcnt(0)" ::: "memory");
    __syncthreads();
    if (is_thread0) {
        unsigned* bar = b.bar;
        __builtin_amdgcn_s_waitcnt(0);
        unsigned nloc = b.st[0], nx = b.st[1];
        if (nloc == 0u) { xcd_barrier_complete(bar, b.x, nloc, nx); b.st[0] = nloc; b.st[1] = nx; }
        const unsigned old = xb_add(&bar[XB_XSUB(b.x)], 1u);
        const unsigned gen = old / nloc;
        if (old + 1u == (gen + 1u) * nloc) {
            __builtin_amdgcn_fence(__ATOMIC_RELEASE, "agent");
            asm volatile("s_waitcnt vmcnt(0)" ::: "memory");
            const unsigned og = xb_add(&bar[XB_TOP], 1u);
            const unsigned tg = og / nx;
            if (og + 1u == (tg + 1u) * nx) xb_add(&bar[XB_TOPGEN], 1u);
            else XB_SPIN(xb_ld(&bar[XB_TOPGEN]) == tg, bar);
            __builtin_amdgcn_fence(__ATOMIC_ACQUIRE, "agent");
            xb_add(&bar[XB_XGEN(b.x)], 1u);
            asm volatile("s_waitcnt vmcnt(0)" ::: "memory");
        } else {
            XB_SPIN(xb_ld(&bar[XB_XGEN(b.x)]) == gen, bar);
            __builtin_amdgcn_fence(__ATOMIC_ACQUIRE, "agent");
            asm volatile("s_waitcnt vmcnt(0)" ::: "memory");
        }
    }
    __syncthreads();
}
namespace pg8 {
__device__ __forceinline__ float bf2f(unsigned short h) { return __uint_as_float(((unsigned)h) << 16); }
__device__ __forceinline__ float bflo(unsigned w) { return __uint_as_float(w << 16); }
__device__ __forceinline__ float bfhi(unsigned w) { return __uint_as_float(w & 0xffff0000u); }
__device__ __forceinline__ float sigm(float x) { return 1.0f / (1.0f + __expf(-x)); }
struct EpiZ { static constexpr bool PERM = true, AFTER_DRAIN = false; bf16_t* O;
    __device__ __forceinline__ void operator()(const f32x4 (&acc)[2][2][4][2], const Unit& u, int wr, int wc, int fr, int fq) const {
        const int row0 = u.pm * BM + wr * 64 + fr, col0 = u.pn * BM + wc * 32 + 8 * fq;
#pragma unroll
        for (int ai = 0; ai < 2; ++ai)
#pragma unroll
            for (int m = 0; m < 4; ++m) { bf16_t* rowp = O + (size_t)(row0 + ai * HALF + m * 16) * 4736 + col0;
#pragma unroll
                for (int bj = 0; bj < 2; ++bj) { if (u.pn * BM + bj * HALF < 4736) { const f32x4 v0 = acc[ai][bj][m][0], v1 = acc[ai][bj][m][1];
                    u32x4 w; w.x = cvt_pk_bf16(v0[0], v0[1]); w.y = cvt_pk_bf16(v0[2], v0[3]); w.z = cvt_pk_bf16(v1[0], v1[1]); w.w = cvt_pk_bf16(v1[2], v1[3]);
                    *(u32x4*)(rowp + bj * HALF) = w; } } }
    }
};
struct EpiPlain { static constexpr bool PERM = true, AFTER_DRAIN = false; bf16_t* O; int ldc;
    __device__ __forceinline__ void operator()(const f32x4 (&acc)[2][2][4][2], const Unit& u, int wr, int wc, int fr, int fq) const {
        const int row0 = u.pm * BM + wr * 64 + fr, col0 = u.pn * BM + wc * 32 + 8 * fq;
#pragma unroll
        for (int ai = 0; ai < 2; ++ai)
#pragma unroll
            for (int m = 0; m < 4; ++m) { bf16_t* rowp = O + (size_t)(row0 + ai * HALF + m * 16) * ldc + col0;
#pragma unroll
                for (int bj = 0; bj < 2; ++bj) { const f32x4 v0 = acc[ai][bj][m][0], v1 = acc[ai][bj][m][1];
                    u32x4 w; w.x = cvt_pk_bf16(v0[0], v0[1]); w.y = cvt_pk_bf16(v0[2], v0[3]); w.z = cvt_pk_bf16(v1[0], v1[1]); w.w = cvt_pk_bf16(v1[2], v1[3]);
                    *(u32x4*)(rowp + bj * HALF) = w; } }
    }
};
template <bool ADD> struct EpiGate { static constexpr bool PERM = true, AFTER_DRAIN = false; bf16_t* O; const bf16_t* Z; int zc0;
    __device__ __forceinline__ void operator()(const f32x4 (&acc)[2][2][4][2], const Unit& u, int wr, int wc, int fr, int fq) const {
        const int row0 = u.pm * BM + wr * 64 + fr, col0 = u.pn * BM + wc * 32 + 8 * fq;
#pragma unroll
        for (int ai = 0; ai < 2; ++ai)
#pragma unroll
            for (int m = 0; m < 4; ++m) { const size_t row = (size_t)(row0 + ai * HALF + m * 16); bf16_t* rowp = O + row * 1024 + col0; const bf16_t* zp = Z + row * 4736 + zc0 + col0;
#pragma unroll
                for (int bj = 0; bj < 2; ++bj) { const f32x4 v0 = acc[ai][bj][m][0], v1 = acc[ai][bj][m][1];
                    const u32x4 zg = *(const u32x4*)(zp + bj * HALF);
                    float r0 = sigm(bflo(zg.x)) * v0[0], r1 = sigm(bfhi(zg.x)) * v0[1], r2 = sigm(bflo(zg.y)) * v0[2], r3 = sigm(bfhi(zg.y)) * v0[3];
                    float r4 = sigm(bflo(zg.z)) * v1[0], r5 = sigm(bfhi(zg.z)) * v1[1], r6 = sigm(bflo(zg.w)) * v1[2], r7 = sigm(bfhi(zg.w)) * v1[3];
                    if (ADD) { const u32x4 p = *(const u32x4*)(rowp + bj * HALF);
                        r0 += bflo(p.x); r1 += bfhi(p.x); r2 += bflo(p.y); r3 += bfhi(p.y); r4 += bflo(p.z); r5 += bfhi(p.z); r6 += bflo(p.w); r7 += bfhi(p.w); }
                    u32x4 w; w.x = cvt_pk_bf16(r0, r1); w.y = cvt_pk_bf16(r2, r3); w.z = cvt_pk_bf16(r4, r5); w.w = cvt_pk_bf16(r6, r7);
                    *(u32x4*)(rowp + bj * HALF) = w; } }
    }
};
struct EpiGate2 { static constexpr bool PERM = true, AFTER_DRAIN = false; bf16_t* O; const bf16_t* Z;
    __device__ __forceinline__ void operator()(const f32x4 (&acc)[2][2][4][2], const Unit& u, int wr, int wc, int fr, int fq) const {
        const bool add = u.pm < 128; const int zc0 = add ? 3712 : 2688;
        const int row0 = (u.pm & 127) * BM + wr * 64 + fr, col0 = (u.pn & 3) * BM + wc * 32 + 8 * fq;
#pragma unroll
        for (int ai = 0; ai < 2; ++ai) {
            u32x4 zg[4][2], pv[4][2];
#pragma unroll
            for (int m = 0; m < 4; ++m) { const size_t row = (size_t)(row0 + ai * HALF + m * 16);
#pragma unroll
                for (int bj = 0; bj < 2; ++bj) { zg[m][bj] = *(const u32x4*)(Z + row * 4736 + zc0 + col0 + bj * HALF); pv[m][bj] = (u32x4){0u, 0u, 0u, 0u}; if (add) pv[m][bj] = *(const u32x4*)(O + row * 1024 + col0 + bj * HALF); } }
#pragma unroll
            for (int m = 0; m < 4; ++m) { const size_t row = (size_t)(row0 + ai * HALF + m * 16); bf16_t* rowp = O + row * 1024 + col0;
#pragma unroll
                for (int bj = 0; bj < 2; ++bj) { const f32x4 v0 = acc[ai][bj][m][0], v1 = acc[ai][bj][m][1]; const u32x4 g = zg[m][bj], p = pv[m][bj];
                    const float r0 = sigm(bflo(g.x)) * v0[0] + bflo(p.x), r1 = sigm(bfhi(g.x)) * v0[1] + bfhi(p.x), r2 = sigm(bflo(g.y)) * v0[2] + bflo(p.y), r3 = sigm(bfhi(g.y)) * v0[3] + bfhi(p.y);
                    const float r4 = sigm(bflo(g.z)) * v1[0] + bflo(p.z), r5 = sigm(bfhi(g.z)) * v1[1] + bfhi(p.z), r6 = sigm(bflo(g.w)) * v1[2] + bflo(p.w), r7 = sigm(bfhi(g.w)) * v1[3] + bfhi(p.w);
                    u32x4 w; w.x = cvt_pk_bf16(r0, r1); w.y = cvt_pk_bf16(r2, r3); w.z = cvt_pk_bf16(r4, r5); w.w = cvt_pk_bf16(r6, r7);
                    *(u32x4*)(rowp + bj * HALF) = w; } } }
    }
};
struct MergeOrder { StaticOrder S; int nu;
    __device__ __forceinline__ void init(int G, int c) { S.init(32768, 1024, G, c); nu = (512 - c + G - 1) / G; }
    __device__ __forceinline__ bool next(int i, Unit& u) const { if (i >= 2 * nu) return false; Unit t; S.next(i < nu ? i : i - nu, t);
        if (i < nu) { u.pm = 128 + t.pm; u.pn = t.pn; } else { u.pm = t.pm; u.pn = 4 + t.pn; } return true; }
    __device__ __forceinline__ void a_ready(const Unit&) const {}
    __device__ __forceinline__ void done(const Unit&) const {}
};
struct EpiRes { static constexpr bool PERM = true, AFTER_DRAIN = false; const float* X; const float* mod; bf16_t* O;
    __device__ __forceinline__ void operator()(const f32x4 (&acc)[2][2][4][2], const Unit& u, int wr, int wc, int fr, int fq) const {
        const int row0 = u.pm * BM + wr * 64 + fr, col0 = u.pn * BM + wc * 32 + 8 * fq; const int b = (u.pm * BM) >> 11;
        f32x4 gt[2][2];
#pragma unroll
        for (int bj = 0; bj < 2; ++bj)
#pragma unroll
            for (int n = 0; n < 2; ++n) gt[bj][n] = *(const f32x4*)(mod + (size_t)b * 6144 + 2048 + col0 + bj * HALF + n * 4);
#pragma unroll
        for (int ai = 0; ai < 2; ++ai) { f32x4 xv[4][2][2];
#pragma unroll
            for (int m = 0; m < 4; ++m) { const size_t off = (size_t)(row0 + ai * HALF + m * 16) * 1024 + col0;
#pragma unroll
                for (int bj = 0; bj < 2; ++bj) { xv[m][bj][0] = *(const f32x4*)(X + off + bj * HALF); xv[m][bj][1] = *(const f32x4*)(X + off + bj * HALF + 4); } }
#pragma unroll
            for (int m = 0; m < 4; ++m) { const size_t off = (size_t)(row0 + ai * HALF + m * 16) * 1024 + col0;
#pragma unroll
                for (int bj = 0; bj < 2; ++bj) { const f32x4 v0 = xv[m][bj][0] + gt[bj][0] * acc[ai][bj][m][0], v1 = xv[m][bj][1] + gt[bj][1] * acc[ai][bj][m][1];
                    u32x4 w; w.x = cvt_pk_bf16(v0[0], v0[1]); w.y = cvt_pk_bf16(v0[2], v0[3]); w.z = cvt_pk_bf16(v1[0], v1[1]); w.w = cvt_pk_bf16(v1[2], v1[3]);
                    *(u32x4*)(O + off + bj * HALF) = w; } } }
    }
};
template <int NPL> struct GroupOrder { int G, c;
    __device__ __forceinline__ bool next(int i, Unit& u) const { const int L = i * G + c; if (L >= 256 * NPL) return false;
        if (G == 256) {
            const int q = i * 32 + (c >> 3), e = (c & 7) * 2 + q / (16 * NPL), r = q % (16 * NPL), rho = r >> 5, j = r & 31;
            u.pm = e * 16 + (rho & 1) * 8 + (j & 7); u.pn = e * NPL + (rho >> 1) * 4 + (j >> 3); return true; }
        const int e = L / (16 * NPL), r = L % (16 * NPL); u.pm = e * 16 + (r % 16); u.pn = e * NPL + r / 16; return true; }
    __device__ __forceinline__ void a_ready(const Unit&) const {}
    __device__ __forceinline__ void done(const Unit&) const {}
};
struct EpiSwiglu { static constexpr bool PERM = true, AFTER_DRAIN = false; bf16_t* O;
    __device__ __forceinline__ void operator()(const f32x4 (&acc)[2][2][4][2], const Unit& u, int wr, int wc, int fr, int fq) const {
        const int row0 = u.pm * BM + wr * 64 + fr, col0 = (u.pn & 7) * 128 + wc * 32 + 8 * fq;
#pragma unroll
        for (int ai = 0; ai < 2; ++ai)
#pragma unroll
            for (int m = 0; m < 4; ++m) { bf16_t* rowp = O + (size_t)(row0 + ai * HALF + m * 16) * 1024 + col0;
                float r[8];
#pragma unroll
                for (int n = 0; n < 2; ++n)
#pragma unroll
                    for (int i = 0; i < 4; ++i) { const float g = acc[ai][0][m][n][i], up = acc[ai][1][m][n][i]; r[n * 4 + i] = g * sigm(g) * up; }
                u32x4 w; w.x = cvt_pk_bf16(r[0], r[1]); w.y = cvt_pk_bf16(r[2], r[3]); w.z = cvt_pk_bf16(r[4], r[5]); w.w = cvt_pk_bf16(r[6], r[7]);
                *(u32x4*)rowp = w; }
    }
};
struct EpiDown { static constexpr bool PERM = true, AFTER_DRAIN = false; bf16_t* O; const float* aff;
    __device__ __forceinline__ void operator()(const f32x4 (&acc)[2][2][4][2], const Unit& u, int wr, int wc, int fr, int fq) const {
        const int row0 = u.pm * BM + wr * 64 + fr, col0 = (u.pn & 3) * BM + wc * 32 + 8 * fq;
        float av[2][4];
#pragma unroll
        for (int ai = 0; ai < 2; ++ai)
#pragma unroll
            for (int m = 0; m < 4; ++m) av[ai][m] = aff[row0 + ai * HALF + m * 16];
#pragma unroll
        for (int ai = 0; ai < 2; ++ai)
#pragma unroll
            for (int m = 0; m < 4; ++m) { const int row = row0 + ai * HALF + m * 16; const float a = av[ai][m]; bf16_t* rowp = O + (size_t)row * 1024 + col0;
#pragma unroll
                for (int bj = 0; bj < 2; ++bj) { const f32x4 v0 = acc[ai][bj][m][0] * a, v1 = acc[ai][bj][m][1] * a;
                    u32x4 w; w.x = cvt_pk_bf16(v0[0], v0[1]); w.y = cvt_pk_bf16(v0[2], v0[3]); w.z = cvt_pk_bf16(v1[0], v1[1]); w.w = cvt_pk_bf16(v1[2], v1[3]);
                    *(u32x4*)(rowp + bj * HALF) = w; } }
    }
};
}

struct Frame { LAS unsigned char* lds; volatile LAS unsigned* MISC; gu32* ctl; int tid, lane, wave, vcu, G; };
struct Args { const void* in[30]; float* out; unsigned char* ws; int ph_lo, ph_hi; };
typedef const __attribute__((address_space(4))) Args* ArgsP;
#define LAUNDER(p) asm volatile("" : "+s"(p))
typedef float f32x16 __attribute__((ext_vector_type(16)));
typedef unsigned u32x2 __attribute__((ext_vector_type(2)));

__device__ __forceinline__ float wave_sum(float v) {
#pragma unroll
    for (int o = 1; o < 64; o <<= 1) v += __shfl_xor(v, o);
    return v;
}
__device__ __forceinline__ float bf2f(bf16 h) { return __uint_as_float(((unsigned)h) << 16); }
__device__ __forceinline__ float bflo(unsigned w) { return __uint_as_float(w << 16); }
__device__ __forceinline__ float bfhi(unsigned w) { return __uint_as_float(w & 0xffff0000u); }
__device__ __forceinline__ float sigm(float x) { return 1.0f / (1.0f + __expf(-x)); }

__device__ __forceinline__ void tr_load(f32x4 (&v)[8], const float* W, int N, int k0, int n0, int lane) {
#pragma unroll
    for (int i = 0; i < 8; ++i) v[i] = *(const GAS f32x4*)(W + (size_t)(k0 + 8 * i + (lane >> 3)) * N + n0 + 4 * (lane & 7));
}
__device__ __forceinline__ void tr_store(const f32x4 (&v)[8], int k0, bf16* WT, int KD, int dst_row0, LAS float* scr, int lane) {
#pragma unroll
    for (int i = 0; i < 8; ++i) { LAS float* d = scr + (8 * i + (lane >> 3)) * 33 + 4 * (lane & 7); d[0] = v[i].x; d[1] = v[i].y; d[2] = v[i].z; d[3] = v[i].w; }
    LDS_WAIT(); asm volatile("" ::: "memory");
    const int c = lane & 7;
#pragma unroll
    for (int j = 0; j < 4; ++j) { const int n = (lane >> 3) + 8 * j; const LAS float* s = scr + (8 * c) * 33 + n;
        v4u o; o.x = pk2(s[0 * 33], s[1 * 33]); o.y = pk2(s[2 * 33], s[3 * 33]); o.z = pk2(s[4 * 33], s[5 * 33]); o.w = pk2(s[6 * 33], s[7 * 33]);
        *(GAS v4u*)(WT + (size_t)(dst_row0 + n) * KD + k0 + 8 * c) = o; }
    LDS_WAIT(); asm volatile("" ::: "memory");
}
__device__ __forceinline__ void tr_item(const float* W, int N, int k0, int n0, bf16* WT, int KD, int dst_row0, LAS float* scr, int lane) {
    f32x4 v[8]; tr_load(v, W, N, k0, n0, lane); tr_store(v, k0, WT, KD, dst_row0, scr, lane);
}

__device__ __forceinline__ void p0_prologue(const Frame& F, ArgsP A) {
    unsigned char* ws = A->ws;
    LAS float* scr = (LAS float*)(F.lds + F.wave * 16384);
    const int gw = F.vcu * NWAVES + F.wave, NGW = F.G * NWAVES;
    const float* w_in = (const float*)A->in[6]; const float* p_rwkv = (const float*)A->in[22]; const float* p_attn = (const float*)A->in[23];
    const float* w_out = (const float*)A->in[24]; const float* g2 = (const float*)A->in[13];
    bf16* WinT = (bf16*)(ws + WS_WINT); bf16* PrT = (bf16*)(ws + WS_PRT); bf16* PaT = (bf16*)(ws + WS_PAT); bf16* WoT = (bf16*)(ws + WS_WOT); bf16* G2T = (bf16*)(ws + WS_G2T);
    constexpr int I_IN = 16 * 148, I_P = 8 * 32, I_O = 16 * 32, I_G = 2 * 16, NIT = I_IN + 2 * I_P + I_O + I_G;
    for (int it = gw; it < NIT; it += NGW) {
        int r = it;
        if (r < I_IN) { tr_item(w_in, NZ, 64 * (r / 148), 32 * (r % 148), WinT, 1024, 32 * (r % 148), scr, F.lane); continue; } r -= I_IN;
        if (r < I_P) { tr_item(p_rwkv, 1024, 64 * (r / 32), 32 * (r % 32), PrT, 512, 32 * (r % 32), scr, F.lane); continue; } r -= I_P;
        if (r < I_P) { tr_item(p_attn, 1024, 64 * (r / 32), 32 * (r % 32), PaT, 512, 32 * (r % 32), scr, F.lane); continue; } r -= I_P;
        if (r < I_O) { tr_item(w_out, 1024, 64 * (r / 32), 32 * (r % 32), WoT, 1024, 32 * (r % 32), scr, F.lane); continue; } r -= I_O;
        tr_item(g2, 512, 64 * (r / 16), 32 * (r % 16), G2T, 256, 32 * (r % 16), scr, F.lane);
    }
    { const int gt = (F.vcu * NWAVES + F.wave) * 64 + F.lane, NT = F.G * NWAVES * 64; const v4u z4 = {0u, 0u, 0u, 0u};
      for (int i = gt; i < 128 * 128; i += NT) *(GAS v4u*)(WinT + (size_t)4736 * 1024 + (size_t)i * 8) = z4;
      for (int i = gt; i < 512 * 16; i += NT) *(GAS v4u*)(G2T + (size_t)(i >> 4) * 256 + 128 + (i & 15) * 8) = z4; }
    __syncthreads();
    const float* cvec = (const float*)A->in[1]; const float* w_ada = (const float*)A->in[3]; const float* b_ada = (const float*)A->in[4];
    float* mod = (float*)(ws + WS_MOD);
    for (int task = F.vcu; task < 192; task += F.G) { const int cg = task % 96, dh = task / 96;
        LAS float* ca = (LAS float*)F.lds;
        LAS float* red = (LAS float*)(F.lds + 65536);
        for (int i = F.tid; i < 16 * 1024; i += 512) { const int b = i >> 10, d = i & 1023; const float cv = cvec[i]; ca[d * 16 + b] = cv / (1.0f + __expf(-cv)); }
        __syncthreads();
        float acc[16];
#pragma unroll
        for (int b = 0; b < 16; ++b) acc[b] = 0.f;
        const int col = cg * 64 + F.lane;
#pragma unroll 8
        for (int dd = 0; dd < 64; ++dd) { const int d = dh * 512 + F.wave * 64 + dd; const float w = w_ada[(size_t)d * 6144 + col];
            const LAS f32x4* cp = (const LAS f32x4*)(ca + d * 16);
#pragma unroll
            for (int q = 0; q < 4; ++q) { const f32x4 cv = cp[q]; acc[q * 4 + 0] += cv[0] * w; acc[q * 4 + 1] += cv[1] * w; acc[q * 4 + 2] += cv[2] * w; acc[q * 4 + 3] += cv[3] * w; } }
#pragma unroll
        for (int b = 0; b < 16; ++b) red[(F.wave * 16 + b) * 64 + F.lane] = acc[b];
        __syncthreads();
        for (int o = F.tid; o < 1024; o += 512) { const int b = o >> 6, cl = o & 63; float sacc = 0.f;
#pragma unroll
            for (int w = 0; w < 8; ++w) sacc += red[(w * 16 + b) * 64 + cl];
            atomicAdd(&mod[b * 6144 + cg * 64 + cl], sacc + (dh == 0 ? b_ada[cg * 64 + cl] : 0.f)); }
        __syncthreads();
    }
}


__device__ __forceinline__ float dpp_wave_sum(float v) {
    v += __int_as_float(__builtin_amdgcn_update_dpp(0, __float_as_int(v), 0xB1, 0xf, 0xf, false));
    v += __int_as_float(__builtin_amdgcn_update_dpp(0, __float_as_int(v), 0x4E, 0xf, 0xf, false));
    v += __int_as_float(__builtin_amdgcn_update_dpp(0, __float_as_int(v), 0x141, 0xf, 0xf, false));
    v += __int_as_float(__builtin_amdgcn_update_dpp(0, __float_as_int(v), 0x140, 0xf, 0xf, false));
    v += __int_as_float(__builtin_amdgcn_ds_swizzle(__float_as_int(v), 0x401F));
    auto r_ = __builtin_amdgcn_permlane32_swap(__float_as_uint(v), __float_as_uint(v), false, false);
    return __uint_as_float(r_[0]) + __uint_as_float(r_[1]); }

template <int R, bool XBF> __device__ __forceinline__ void modnorm_rows(const void* x, int m0, int mstride, const float* g, const float* mod, int sh_off, int sc_off, bf16* out, int lane, f32x4 (&u)[R][4]) {
    f32x4 v[R][4];
#pragma unroll
    for (int i = 0; i < R; ++i) {
        if (XBF) { const GAS u32x2* xr = (const GAS u32x2*)((const bf16*)x + (size_t)(m0 + i * mstride) * 1024) + lane;
#pragma unroll
            for (int j = 0; j < 4; ++j) { const u32x2 w = xr[64 * j]; v[i][j] = (f32x4){bflo(w.x), bfhi(w.x), bflo(w.y), bfhi(w.y)}; } }
        else { const GAS f32x4* xr = (const GAS f32x4*)((const float*)x + (size_t)(m0 + i * mstride) * 1024) + lane;
#pragma unroll
            for (int j = 0; j < 4; ++j) v[i][j] = xr[64 * j]; } }
    f32x4 gg[4];
#pragma unroll
    for (int j = 0; j < 4; ++j) gg[j] = ((const GAS f32x4*)g)[lane + 64 * j];
#pragma unroll
    for (int i = 0; i < R; ++i) { const int m = m0 + i * mstride, b = m >> 11; float s = 0.f;
#pragma unroll
        for (int j = 0; j < 4; ++j) s += (v[i][j].x * v[i][j].x + v[i][j].y * v[i][j].y) + (v[i][j].z * v[i][j].z + v[i][j].w * v[i][j].w);
        const float rs = rsqrtf(dpp_wave_sum(s) * (1.0f / 1024.0f) + 1e-6f);
        const float* sh = mod + (size_t)b * 6144 + sh_off; const float* sc = mod + (size_t)b * 6144 + sc_off;
        GAS unsigned long long* o8 = (GAS unsigned long long*)(out + (size_t)m * 1024) + lane;
#pragma unroll
        for (int j = 0; j < 4; ++j) { const f32x4 s1 = ((const GAS f32x4*)sc)[lane + 64 * j], s0 = ((const GAS f32x4*)sh)[lane + 64 * j];
            f32x4 y = (v[i][j] * rs) * gg[j]; y = y * (s1 + 1.0f) + s0; u[i][j] = y;
            o8[64 * j] = (unsigned long long)pk2(y.x, y.y) | ((unsigned long long)pk2(y.z, y.w) << 32); } }
}

template <int R> __device__ __forceinline__ void load_rows_bf16(const bf16* x, int m0, int mstride, int lane_in, u32x2 (&raw)[R][4]) {
    int lane = lane_in; asm volatile("" : "+v"(lane));
#pragma unroll
    for (int i = 0; i < R; ++i) { const GAS u32x2* xr = (const GAS u32x2*)(x + (size_t)(m0 + i * mstride) * 1024) + lane;
#pragma unroll
        for (int j = 0; j < 4; ++j) raw[i][j] = xr[64 * j]; }
}
template <int R> __device__ __forceinline__ void modnorm_rows_pre(const u32x2 (&raw)[R][4], int m0, int mstride, const float* g, const float* mod, int sh_off, int sc_off, bf16* out, int lane, f32x4 (&u)[R][4]) {
    f32x4 gg[4];
#pragma unroll
    for (int j = 0; j < 4; ++j) gg[j] = ((const GAS f32x4*)g)[lane + 64 * j];
#pragma unroll
    for (int i = 0; i < R; ++i) { const int m = m0 + i * mstride, b = m >> 11; float s = 0.f; f32x4 v[4];
#pragma unroll
        for (int j = 0; j < 4; ++j) { const u32x2 w = raw[i][j]; v[j] = (f32x4){bflo(w.x), bfhi(w.x), bflo(w.y), bfhi(w.y)}; s += (v[j].x * v[j].x + v[j].y * v[j].y) + (v[j].z * v[j].z + v[j].w * v[j].w); }
        const float rs = rsqrtf(dpp_wave_sum(s) * (1.0f / 1024.0f) + 1e-6f);
        const float* sh = mod + (size_t)b * 6144 + sh_off; const float* sc = mod + (size_t)b * 6144 + sc_off;
        GAS unsigned long long* o8 = (GAS unsigned long long*)(out + (size_t)m * 1024) + lane;
#pragma unroll
        for (int j = 0; j < 4; ++j) { const f32x4 s1 = ((const GAS f32x4*)sc)[lane + 64 * j], s0 = ((const GAS f32x4*)sh)[lane + 64 * j];
            f32x4 y = (v[j] * rs) * gg[j]; y = y * (s1 + 1.0f) + s0; u[i][j] = y;
            o8[64 * j] = (unsigned long long)pk2(y.x, y.y) | ((unsigned long long)pk2(y.z, y.w) << 32); } }
}

__device__ __forceinline__ void modnorm_row(const float* xrow, const float* g, const float* sh, const float* sc, bf16* orow, int lane, f32x4 (&u)[4]) {
    const GAS f32x4* xr = (const GAS f32x4*)xrow + lane;
    f32x4 v[4]; float s = 0.f;
#pragma unroll
    for (int j = 0; j < 4; ++j) { v[j] = xr[64 * j]; s += (v[j].x * v[j].x + v[j].y * v[j].y) + (v[j].z * v[j].z + v[j].w * v[j].w); }
    const float rs = rsqrtf(wave_sum(s) * (1.0f / 1024.0f) + 1e-6f);
    GAS unsigned long long* o8 = (GAS unsigned long long*)orow + lane;
#pragma unroll
    for (int j = 0; j < 4; ++j) { const f32x4 gg = ((const GAS f32x4*)g)[lane + 64 * j], s1 = ((const GAS f32x4*)sc)[lane + 64 * j], s0 = ((const GAS f32x4*)sh)[lane + 64 * j];
        f32x4 y = (v[j] * rs) * gg; y = y * (s1 + 1.0f) + s0; u[j] = y;
        o8[64 * j] = (unsigned long long)pk2(y.x, y.y) | ((unsigned long long)pk2(y.z, y.w) << 32); }
}

__device__ __forceinline__ float softplusf(float x) { return x > 20.f ? x : log1pf(__expf(x)); }
__device__ __forceinline__ void scan_chain(const Frame& F, ArgsP A, int b, int h, int dir) {
    constexpr int CT = 32;
    LAS float* L = (LAS float*)F.lds;
    LAS float* W2S = L; LAS float* A2S = L + 4096; LAS float* ZRs = L + 8192; LAS float* ZKs = ZRs + 2048; LAS float* ZVs = ZKs + 2048; LAS float* TWs = ZVs + 2048; LAS float* ZAs = TWs + 2048;
    LAS float* DEC = ZAs + 2048; LAS float* KD = DEC + 2048; LAS float* AV = KD + 2048; LAS float* BV = AV + 2048; LAS float* YB = BV + 2048; LAS float* BON = YB + 2048;
    const bf16* Z = (const bf16*)(A->ws + WS_Z);
    const float* mu_prev = (const float*)A->in[7]; const float* mu_next = (const float*)A->in[8];
    const float* w0 = (const float*)A->in[9]; const float* w2 = (const float*)A->in[10]; const float* a0 = (const float*)A->in[11]; const float* a2 = (const float*)A->in[12];
    const float* k_k = (const float*)A->in[14]; const float* k_a = (const float*)A->in[15]; const float* r_k = (const float*)A->in[16];
    bf16* ydir = (bf16*)(A->ws + WS_XN) + (size_t)dir * M * 512; float* bonus = (float*)(A->ws + WS_BONUS) + (size_t)dir * M * 8;
    const int tid = F.tid, lane = F.lane, wave = F.wave;
    for (int i = tid; i < 4096; i += 512) { const int l = i >> 6, j = i & 63; W2S[i] = w2[((size_t)dir * 64 + l) * 512 + h * 64 + j]; A2S[i] = a2[((size_t)dir * 64 + l) * 512 + h * 64 + j]; }
    const int ch = h * 64 + lane;
    const float w0j = w0[dir * 512 + ch], a0j = a0[dir * 512 + ch], kkj = k_k[ch], kaj = k_a[ch], rkj = r_k[ch];
    float s[8];
#pragma unroll
    for (int q = 0; q < 8; ++q) s[q] = 0.f;
    const int ri = tid >> 3, jg = tid & 7;
    for (int ci = 0; ci < T / CT; ++ci) {
        const int t0 = (dir ? (T / CT - 1 - ci) : ci) * CT;
#pragma unroll 4
        for (int i = 0; i < 20; ++i) { const int e = tid + 512 * i, arr = e >> 11, rem = e & 2047, tl = rem >> 6, j = rem & 63;
            const int col = (arr == 0 ? ZR + h * 64 : arr == 1 ? ZK + h * 64 : arr == 2 ? ZV + h * 64 : arr == 3 ? ZWD + dir * 64 : ZAD + dir * 64) + j;
            const int t = t0 + tl; const bf16* zp = Z + ((size_t)b * T + t) * NZ + col;
            const float z0 = bf2f(zp[0]), zm = t > 0 ? bf2f(zp[-NZ]) : 0.f, zq = t < T - 1 ? bf2f(zp[NZ]) : 0.f;
            float zs = z0 + mu_prev[col] * (zm - z0) + mu_next[col] * (zq - z0);
            if (arr == 3) zs = tanhf(zs);
            ZRs[arr * 2048 + rem] = zs; }
        __syncthreads();
#pragma unroll 1
        for (int q = 0; q < 4; ++q) { const int tl = wave + 8 * q;
            float wraw = w0j, araw = a0j;
#pragma unroll 8
            for (int l = 0; l < 64; ++l) { wraw += TWs[tl * 64 + l] * W2S[l * 64 + lane]; araw += ZAs[tl * 64 + l] * A2S[l * 64 + lane]; }
            const float w = -softplusf(-wraw) - 0.5f, dec = __expf(-__expf(w)), ad = sigm(araw);
            const float k = ZKs[tl * 64 + lane], kkr = k * kkj, nrm = sqrtf(wave_sum(kkr * kkr)), kk = kkr / fmaxf(nrm, 1e-12f);
            const float kd = k * (1.0f + (ad - 1.0f) * kaj);
            DEC[tl * 64 + lane] = dec; KD[tl * 64 + lane] = kd; AV[tl * 64 + lane] = -kk; BV[tl * 64 + lane] = kk * ad;
            const float bon = wave_sum(ZRs[tl * 64 + lane] * kd * rkj); if (lane == 0) BON[tl] = bon; }
        __syncthreads();
#pragma unroll 1
        for (int st = 0; st < CT; ++st) { const int tl = dir ? (CT - 1 - st) : st; const int o = tl * 64 + jg * 8;
            const f32x4 a0v = *(const LAS f32x4*)(AV + o), a1v = *(const LAS f32x4*)(AV + o + 4), d0 = *(const LAS f32x4*)(DEC + o), d1 = *(const LAS f32x4*)(DEC + o + 4);
            const f32x4 b0 = *(const LAS f32x4*)(BV + o), b1 = *(const LAS f32x4*)(BV + o + 4), k0 = *(const LAS f32x4*)(KD + o), k1 = *(const LAS f32x4*)(KD + o + 4);
            const f32x4 r0 = *(const LAS f32x4*)(ZRs + o), r1 = *(const LAS f32x4*)(ZRs + o + 4); const float vi = ZVs[tl * 64 + ri];
            float p = (s[0] * a0v[0] + s[1] * a0v[1]) + (s[2] * a0v[2] + s[3] * a0v[3]) + (s[4] * a1v[0] + s[5] * a1v[1]) + (s[6] * a1v[2] + s[7] * a1v[3]);
            p += __shfl_xor(p, 1); p += __shfl_xor(p, 2); p += __shfl_xor(p, 4);
            s[0] = s[0] * d0[0] + p * b0[0] + vi * k0[0]; s[1] = s[1] * d0[1] + p * b0[1] + vi * k0[1]; s[2] = s[2] * d0[2] + p * b0[2] + vi * k0[2]; s[3] = s[3] * d0[3] + p * b0[3] + vi * k0[3];
            s[4] = s[4] * d1[0] + p * b1[0] + vi * k1[0]; s[5] = s[5] * d1[1] + p * b1[1] + vi * k1[1]; s[6] = s[6] * d1[2] + p * b1[2] + vi * k1[2]; s[7] = s[7] * d1[3] + p * b1[3] + vi * k1[3];
            float y = (s[0] * r0[0] + s[1] * r0[1]) + (s[2] * r0[2] + s[3] * r0[3]) + (s[4] * r1[0] + s[5] * r1[1]) + (s[6] * r1[2] + s[7] * r1[3]);
            y += __shfl_xor(y, 1); y += __shfl_xor(y, 2); y += __shfl_xor(y, 4);
            if (jg == 0) YB[tl * 64 + ri] = y; }
        __syncthreads();
#pragma unroll
        for (int i = 0; i < 4; ++i) { const int e = tid + 512 * i, tl = e >> 6, c = e & 63; ydir[((size_t)b * T + t0 + tl) * 512 + h * 64 + c] = (bf16)f2bf(YB[e]); }
        if (tid < CT) bonus[((size_t)b * T + t0 + tid) * 8 + h] = BON[tid];
        __syncthreads();
    }
}


#define SDEV __device__ __forceinline__
#define S_UNROLL _Pragma("unroll")
#define S_MEMBAR() do { asm volatile("" ::: "memory"); __builtin_amdgcn_sched_barrier(0); } while (0)
#define S_LAUNDER_I(x) asm volatile("" : "+v"(x))
#define S_LAUNDER_S(x) asm volatile("" : "+s"(x))
#define S_PIN(x) asm volatile("" : "+v"(x))
typedef float f32x2s __attribute__((ext_vector_type(2))); typedef __bf16 bf16x2s __attribute__((ext_vector_type(2)));
__device__ __forceinline__ unsigned s_cvtpk(float lo, float hi) { f32x2s v = {lo, hi}; bf16x2s b = __builtin_convertvector(v, bf16x2s); return __builtin_bit_cast(unsigned, b); }
__device__ __forceinline__ float s_rowsum16(float v) {
    v += __int_as_float(__builtin_amdgcn_update_dpp(0, __float_as_int(v), 0xB1, 0xf, 0xf, false));
    v += __int_as_float(__builtin_amdgcn_update_dpp(0, __float_as_int(v), 0x4E, 0xf, 0xf, false));
    v += __int_as_float(__builtin_amdgcn_update_dpp(0, __float_as_int(v), 0x141, 0xf, 0xf, false));
    v += __int_as_float(__builtin_amdgcn_update_dpp(0, __float_as_int(v), 0x140, 0xf, 0xf, false));
    return v; }
#define S_MFMA(a, b, c) __builtin_amdgcn_mfma_f32_32x32x16_bf16(a, b, c, 0, 0, 0)
#define S_PK(lo, hi) s_cvtpk(lo, hi)
#define S_SWAP(x, y) do { auto r_ = __builtin_amdgcn_permlane32_swap(x, y, false, false); x = r_[0]; y = r_[1]; } while (0)
#define S_ROWSUM16(v) s_rowsum16(v)
__device__ __forceinline__ float s_wavesum(float v) { v = s_rowsum16(v);
    v += __int_as_float(__builtin_amdgcn_ds_swizzle(__float_as_int(v), 0x401F));
    auto r_ = __builtin_amdgcn_permlane32_swap(__float_as_uint(v), __float_as_uint(v), false, false);
    return __uint_as_float(r_[0]) + __uint_as_float(r_[1]); }
#define S_WAVESUM(v) s_wavesum(v)
#define S_SWAP16(x, y) do { auto r_ = __builtin_amdgcn_permlane16_swap(x, y, false, false); x = r_[0]; y = r_[1]; } while (0)
#define S_DPPF(v, ctrl) __int_as_float(__builtin_amdgcn_update_dpp(0, __float_as_int(v), ctrl, 0xf, 0xf, false))
__device__ __forceinline__ float s_treesum32(float (&q)[32], int lane) {
    _Pragma("unroll") for (int i = 0; i < 16; ++i) { unsigned x = __float_as_uint(q[i]), y = __float_as_uint(q[i + 16]); S_SWAP(x, y); q[i] = __uint_as_float(x) + __uint_as_float(y); }
    _Pragma("unroll") for (int i = 0; i < 8; ++i) { unsigned x = __float_as_uint(q[i]), y = __float_as_uint(q[i + 8]); S_SWAP16(x, y); q[i] = __uint_as_float(x) + __uint_as_float(y); }
    const bool b3 = (lane & 8) != 0, b2 = (lane & 4) != 0, b1 = (lane & 2) != 0;
    _Pragma("unroll") for (int i = 0; i < 4; ++i) { const float a = q[i], b = q[i + 4]; const float c = b3 ? b : a, d = b3 ? a : b; q[i] = c + S_DPPF(d, 0x140); }
    _Pragma("unroll") for (int i = 0; i < 2; ++i) { const float a = q[i], b = q[i + 2]; const float c = b2 ? b : a, d = b2 ? a : b; q[i] = c + S_DPPF(d, 0x141); }
    { const float a = q[0], b = q[1]; const float c = b1 ? b : a, d = b1 ? a : b; q[0] = c + S_DPPF(d, 0x1B); }
    return q[0] + S_DPPF(q[0], 0xB1); }
#define S_GAS GAS
#define S_READLANE(v, l) __int_as_float(__builtin_amdgcn_readlane(__float_as_int(v), l))
#define S_RCP(x) __builtin_amdgcn_rcpf(x)
#define S_EXP2(x) __builtin_amdgcn_exp2f(x)
#define S_LOG2(x) __builtin_amdgcn_logf(x)
#define S_RSQ(x) __builtin_amdgcn_rsqf(x)
#define S_LDS_WAIT() asm volatile("s_waitcnt lgkmcnt(0)" ::: "memory")
#define S_LDSP LAS unsigned char*
#define S_LDS_BF16P LAS bf16*
#define S_LDS_U32P LAS unsigned*
#define S_LDS_F32P LAS float*
#define S_LDS_CONST_BF16X8P const LAS bf16x8*
#define S_LDS_BF16X8P LAS bf16x8*
#define S_LDS_CONST_F32X4P const LAS f32x4*
#define S_LDS_CONST_F32P const LAS float*
#define S_FLAG_STORE(p, v) do { *(volatile LAS unsigned*)(p) = (v); } while (0)
#define S_FLAG_WAIT(p, v) do { unsigned sp_ = 0; while (*(volatile LAS unsigned*)(p) != (v)) { __builtin_amdgcn_s_sleep(2); if (++sp_ > (1u << 24)) break; } asm volatile("" ::: "memory"); } while (0)
struct SFrag { bf16x8 s[2]; };
struct SMat { SFrag t[2]; };
SDEV f32x16 smm(const SFrag& X, const SFrag& Y, f32x16 acc) { acc = S_MFMA(X.s[0], Y.s[0], acc); acc = S_MFMA(X.s[1], Y.s[1], acc); return acc; }
SDEV f32x16 szero() { f32x16 z; S_UNROLL for (int i = 0; i < 16; ++i) z[i] = 0.f; return z; }
SDEV SFrag spack(const f32x16& d) { SFrag f;
    S_UNROLL for (int s = 0; s < 2; ++s) { v4u w; S_UNROLL for (int q = 0; q < 4; ++q) w[q] = S_PK(d[8 * s + 2 * q], d[8 * s + 2 * q + 1]); f.s[s] = __builtin_bit_cast(bf16x8, w); }
    return f; }
SDEV f32x16 sunpack(const SFrag& f) { f32x16 d;
    S_UNROLL for (int s = 0; s < 2; ++s) { const v4u w = __builtin_bit_cast(v4u, f.s[s]); S_UNROLL for (int q = 0; q < 4; ++q) { d[8 * s + 2 * q] = __uint_as_float(w[q] << 16); d[8 * s + 2 * q + 1] = __uint_as_float(w[q] & 0xffff0000u); } }
    return d; }
SDEV SMat splain2d(const unsigned (&pp)[16]) { unsigned d0[8], d1[8];
    S_UNROLL for (int g = 0; g < 4; ++g) S_UNROLL for (int p = 0; p < 2; ++p) { unsigned x = pp[4 * g + p], y = pp[4 * g + 2 + p]; S_SWAP(x, y); d0[2 * g + p] = x; d1[2 * g + p] = y; }
    SMat m;
    S_UNROLL for (int s = 0; s < 2; ++s) { v4u a, b; S_UNROLL for (int q = 0; q < 4; ++q) { a[q] = d0[4 * s + q]; b[q] = d1[4 * s + q]; } m.t[0].s[s] = __builtin_bit_cast(bf16x8, a); m.t[1].s[s] = __builtin_bit_cast(bf16x8, b); }
    return m; }
SDEV void sd2plain(const f32x16& D0, const f32x16& D1, float (&x)[32]) {
    S_UNROLL for (int r = 0; r < 16; ++r) { unsigned a = __float_as_uint(D0[r]), b = __float_as_uint(D1[r]); S_SWAP(a, b); const int ta = (r & 3) + 8 * (r >> 2); x[ta] = __uint_as_float(a); x[ta + 4] = __uint_as_float(b); } }
SDEV SFrag sident(int n_in, int hh_in) { int n1 = n_in, r1 = 4 * hh_in; S_LAUNDER_I(n1); S_LAUNDER_I(r1); f32x16 id; S_UNROLL for (int g = 0; g < 16; ++g) id[g] = (((g & 3) + 8 * (g >> 2) + r1) == n1) ? 1.f : 0.f; return spack(id); }
SDEV void sd2plain_pk(const f32x16& D0, const f32x16& D1, unsigned (&xp)[16]) {
    S_UNROLL for (int m = 0; m < 8; ++m) { unsigned a = S_PK(D0[2 * m], D0[2 * m + 1]), b = S_PK(D1[2 * m], D1[2 * m + 1]); S_SWAP(a, b); const int qa = 4 * (m >> 1) + (m & 1); xp[qa] = a; xp[qa + 2] = b; } }
SDEV float swave_sum(float v) { return S_WAVESUM(v); }

struct ScanArgs { const S_GAS bf16* Z; const S_GAS float* mu_prev; const S_GAS float* mu_next; const S_GAS float* w0; const S_GAS float* a0; const S_GAS float* k_k; const S_GAS float* k_a; const S_GAS float* r_k; S_GAS bf16* ydir; S_GAS float* bonus; S_GAS unsigned char* prep; };

#define SC_W2F 0
#define SC_A2F 8192
#define SC_SIG 16384
#define SC_GTAB 24576
#define SC_FLAG 26624
#define SC_WR 28672
#define SC_AR 94208
#define SC_RSQ 126976
#define SC_LDS_BYTES 128000
#ifndef SB_ILP
#define SB_ILP 8
#endif
#define SC_PF 4

SDEV void scan2_setup(S_LDSP lds, const S_GAS float* w2, const S_GAS float* a2, int h, int dir, int tid) {
    { float wv[16];
      S_UNROLL for (int it = 0; it < 16; ++it) { const int e = tid + 512 * it; const int mat = e >> 12, r = e & 4095, jj = r & 7, ln = (r >> 3) & 63, s = (r >> 9) & 1, jt = (r >> 10) & 1, lt = (r >> 11) & 1;
          const int n = ln & 31, hh = ln >> 5, g = 8 * s + jj, l = 32 * lt + (g & 3) + 8 * (g >> 2) + 4 * hh, j = 32 * jt + n;
          wv[it] = (mat ? a2 : w2)[((size_t)dir * 64 + l) * 512 + h * 64 + j]; }
      S_UNROLL for (int it = 0; it < 16; ++it) { const int e = tid + 512 * it; const int mat = e >> 12, r = e & 4095;
          ((S_LDS_BF16P)(lds + (mat ? SC_A2F : SC_W2F)))[r] = (bf16)(S_PK(wv[it] * -1.442695041f, 0.f) & 0xffffu); } }
    for (int e = tid; e < 2048; e += 512) ((S_LDS_U32P)(lds + SC_SIG))[e] = 0u;
    if (tid == 0) S_FLAG_STORE(lds + SC_FLAG, 0u);
}

SDEV void scan2_prep(const ScanArgs& A_in, int b_in, int dir_in, int c, int lane_in) {
    ScanArgs A = A_in; int b = b_in, dir = dir_in;
    S_LAUNDER_S(A.Z); S_LAUNDER_S(A.mu_prev); S_LAUNDER_S(A.mu_next); S_LAUNDER_S(A.prep); S_LAUNDER_S(b); S_LAUNDER_S(dir);
    int lane = lane_in; S_LAUNDER_I(lane);
    const int n = lane & 31, hh = lane >> 5;
    const int sgn = dir ? -1 : 1, tau0 = dir ? (T - 1 - 32 * c) : 32 * c;
    const S_GAS bf16* zb = A.Z + (size_t)b * T * NZ;
    const ptrdiff_t st = (ptrdiff_t)sgn * NZ; const bool first = (c == 0), last = (c == T / 32 - 1);
    const int cw = ZWD + dir * 64 + lane, ca = ZAD + dir * 64 + lane;
    const SFrag IDF = sident(n, hh); unsigned ppw[16], ppa[16];
    { const float mA = dir ? A.mu_next[cw] : A.mu_prev[cw], mB = dir ? A.mu_prev[cw] : A.mu_next[cw], nA = dir ? A.mu_next[ca] : A.mu_prev[ca], nB = dir ? A.mu_prev[ca] : A.mu_next[ca];
      const S_GAS bf16* pw = zb + (ptrdiff_t)tau0 * NZ + cw - st; const S_GAS bf16* pa = zb + (ptrdiff_t)tau0 * NZ + ca - st;
      float rw[34], ra[34];
      S_UNROLL for (int q = 0; q < 34; ++q) { const bool ok = !((q == 0 && first) || (q == 33 && last)); rw[q] = ok ? bf2f(*pw) : 0.f; ra[q] = ok ? bf2f(*pa) : 0.f; pw += st; pa += st; }
      S_MEMBAR();
      const float mC = 1.f - mA - mB, nC = 1.f - nA - nB; float tprev = 0.f, aprev = 0.f;
      S_UNROLL for (int p = 0; p < 32; ++p) { if ((p & 7) == 0) S_MEMBAR();
          const float ws = mC * rw[p + 1] + mA * rw[p] + mB * rw[p + 2], as = nC * ra[p + 1] + nA * ra[p] + nB * ra[p + 2];
          const float tw = 1.f - 2.f * S_RCP(1.f + S_EXP2(ws * 2.885390082f));
          if (p & 1) { ppw[p >> 1] = S_PK(tprev, tw); ppa[p >> 1] = S_PK(aprev, as); S_PIN(ppw[p >> 1]); S_PIN(ppa[p >> 1]); } else { tprev = tw; aprev = as; } } }
    S_MEMBAR();
    const SMat TW = splain2d(ppw), AD = splain2d(ppa);
    S_GAS bf16x8* pf = (S_GAS bf16x8*)(A.prep + (size_t)((b * 2 + dir) * 64 + c) * 8192) + lane;
    S_UNROLL for (int lt = 0; lt < 2; ++lt) { const SFrag tw_ = spack(smm(TW.t[lt], IDF, szero())), ad_ = spack(smm(AD.t[lt], IDF, szero()));
        S_UNROLL for (int s = 0; s < 2; ++s) { pf[(lt * 2 + s) * 64] = tw_.s[s]; pf[256 + (lt * 2 + s) * 64] = ad_.s[s]; } }
}

SDEV void scan2_chunk(S_LDSP lds, const ScanArgs& A_in, int b_in, int h_in, int dir_in, int c, int lane_in, int wave) {
    ScanArgs A = A_in; int b = b_in, h = h_in, dir = dir_in;
    S_LAUNDER_S(A.Z); S_LAUNDER_S(A.mu_prev); S_LAUNDER_S(A.mu_next); S_LAUNDER_S(A.w0); S_LAUNDER_S(A.a0); S_LAUNDER_S(A.k_k); S_LAUNDER_S(A.k_a); S_LAUNDER_S(A.r_k); S_LAUNDER_S(A.ydir); S_LAUNDER_S(A.bonus); S_LAUNDER_S(A.prep);
    S_LAUNDER_S(b); S_LAUNDER_S(h); S_LAUNDER_S(dir);
    int lane = lane_in; S_LAUNDER_I(lane);
    const int n = lane & 31, hh = lane >> 5;
    const int sgn = dir ? -1 : 1, tau0 = dir ? (T - 1 - 32 * c) : 32 * c;
    const S_GAS bf16* zb = A.Z + (size_t)b * T * NZ;
    const ptrdiff_t st = (ptrdiff_t)sgn * NZ; const bool first = (c == 0), last = (c == T / 32 - 1);
    const int cr = ZR + h * 64 + lane, ck = ZK + h * 64 + lane, cv = ZV + h * 64 + lane, chn = h * 64 + lane;
    unsigned rr[34], rk[34], rv[34];
    {   SFrag TWT[2], ADT[2];
        { const S_GAS bf16x8* pf = (const S_GAS bf16x8*)(A.prep + (size_t)((b * 2 + dir) * 64 + c) * 8192) + lane;
          S_UNROLL for (int lt = 0; lt < 2; ++lt) S_UNROLL for (int s = 0; s < 2; ++s) { TWT[lt].s[s] = pf[(lt * 2 + s) * 64]; ADT[lt].s[s] = pf[256 + (lt * 2 + s) * 64]; } }
        { const S_GAS bf16* pr = zb + (ptrdiff_t)tau0 * NZ + cr - st; const S_GAS bf16* pk = zb + (ptrdiff_t)tau0 * NZ + ck - st; const S_GAS bf16* pv = zb + (ptrdiff_t)tau0 * NZ + cv - st;
          const ptrdiff_t o0 = first ? st : 0, o33 = last ? -st : 0;
          S_UNROLL for (int q = 0; q < 34; ++q) { const ptrdiff_t oo = (q == 0) ? o0 : (q == 33) ? o33 : 0; rr[q] = (unsigned)pr[oo]; rk[q] = (unsigned)pk[oo]; rv[q] = (unsigned)pv[oo]; pr += st; pk += st; pv += st; } }
        S_MEMBAR();
        f32x16 dw[2], da[2];
        S_UNROLL for (int jt = 0; jt < 2; ++jt) { const float w0s = A.w0[dir * 512 + h * 64 + 32 * jt + n] * -1.442695041f, a0s = A.a0[dir * 512 + h * 64 + 32 * jt + n] * -1.442695041f;
            S_UNROLL for (int g = 0; g < 16; ++g) { dw[jt][g] = w0s; da[jt][g] = a0s; }
            S_UNROLL for (int lt = 0; lt < 2; ++lt) { SFrag wf, af;
                S_UNROLL for (int s = 0; s < 2; ++s) { wf.s[s] = *(S_LDS_CONST_BF16X8P)(lds + SC_W2F + ((((lt * 2 + jt) * 2 + s) * 64 + lane) * 16)); af.s[s] = *(S_LDS_CONST_BF16X8P)(lds + SC_A2F + ((((lt * 2 + jt) * 2 + s) * 64 + lane) * 16)); }
                dw[jt] = smm(TWT[lt], wf, dw[jt]); da[jt] = smm(ADT[lt], af, da[jt]); } }
        S_UNROLL for (int jt = 0; jt < 2; ++jt) S_UNROLL for (int g = 0; g < 16; ++g) { const int t = (g & 3) + 8 * (g >> 2) + 4 * hh;
            ((S_LDS_F32P)(lds + SC_WR + wave * 8192))[t * 64 + 32 * jt + n] = dw[jt][g]; ((S_LDS_BF16P)(lds + SC_AR + wave * 4096))[t * 64 + 32 * jt + n] = (bf16)(S_PK(da[jt][g], 0.f) & 0xffffu); }
        S_LDS_WAIT();
    }
    S_MEMBAR();
    unsigned ppA[16], ppR[16], ppB[16], ppK[16], ppV[16], ppQ[16]; float gamC;
    {   const float mAr = dir ? A.mu_next[cr] : A.mu_prev[cr], mBr = dir ? A.mu_prev[cr] : A.mu_next[cr], mAk = dir ? A.mu_next[ck] : A.mu_prev[ck], mBk = dir ? A.mu_prev[ck] : A.mu_next[ck];
        const float mAv = dir ? A.mu_next[cv] : A.mu_prev[cv], mBv = dir ? A.mu_prev[cv] : A.mu_next[cv];
        const float kkj = A.k_k[chn], kaj = A.k_a[chn], rkj = A.r_k[chn];
        const float mCr = 1.f - mAr - mBr, mCk = 1.f - mAk - mBk, mCv = 1.f - mAv - mBv;
        float cs = 0.f, gprev = 1.f; float eA = 0.f, eR = 0.f, eB = 0.f, eK = 0.f, eV = 0.f, eQ = 0.f;
        float zf = first ? 0.f : 1.f, zl = last ? 0.f : 1.f; S_PIN(zf); S_PIN(zl);
        {
            float sq[32];
            float k_a = zf * __uint_as_float(rk[0] << 16), k_b = __uint_as_float(rk[1] << 16);
            S_UNROLL for (int p = 0; p < 32; ++p) { const float k_c = ((p == 31) ? zl : 1.f) * __uint_as_float(rk[p + 2] << 16); const float km = mCk * k_b + mAk * k_a + mBk * k_c; k_a = k_b; k_b = k_c;
                rk[p] = __float_as_uint(km); const float t_ = km * kkj; sq[p] = t_ * t_; }
            const float tot = s_treesum32(sq, lane);
            ((S_LDS_F32P)(lds + SC_RSQ + wave * 128))[lane >> 1] = S_RSQ(fmaxf(tot, 1e-24f)); }
        S_MEMBAR();
        float r_a = zf * __uint_as_float(rr[0] << 16), r_b = __uint_as_float(rr[1] << 16), v_a = zf * __uint_as_float(rv[0] << 16), v_b = __uint_as_float(rv[1] << 16);
        S_UNROLL for (int p = 0; p < 32; ++p) { if ((p & (SB_ILP - 1)) == 0) S_MEMBAR();
            const float zz = (p == 31) ? zl : 1.f; const float r_c = zz * __uint_as_float(rr[p + 2] << 16), v_c = zz * __uint_as_float(rv[p + 2] << 16);
            const float r = mCr * r_b + mAr * r_a + mBr * r_c, k = __uint_as_float(rk[p]), v = mCv * v_b + mAv * v_a + mBv * v_c; r_a = r_b; r_b = r_c; v_a = v_b; v_b = v_c;
            const float wraw = ((S_LDS_F32P)(lds + SC_WR + wave * 8192))[p * 64 + lane], araw = bf2f(((S_LDS_BF16P)(lds + SC_AR + wave * 4096))[p * 64 + lane]);
            const float lw2 = -0.8750387749f * S_RCP(1.f + S_EXP2(wraw));
            const float al = S_RCP(1.f + S_EXP2(araw));
            const float kk = k * kkj * ((S_LDS_CONST_F32P)(lds + SC_RSQ + wave * 128))[p];
            const float kd = k * (1.f + (al - 1.f) * kaj);
            cs += lw2; const float gam = S_EXP2(cs), ig = S_EXP2(-cs);
            const float xa = -kk * gprev, xr = r * gam, xb = kk * al * ig, xk = kd * ig, xq = xr * rkj; gprev = gam;
            if (p & 1) { ppA[p >> 1] = S_PK(eA, xa); ppR[p >> 1] = S_PK(eR, xr); ppB[p >> 1] = S_PK(eB, xb); ppK[p >> 1] = S_PK(eK, xk); ppV[p >> 1] = S_PK(eV, v); ppQ[p >> 1] = S_PK(eQ, xq);
                         S_PIN(ppQ[p >> 1]); S_PIN(ppA[p >> 1]); S_PIN(ppR[p >> 1]); S_PIN(ppB[p >> 1]); S_PIN(ppK[p >> 1]); S_PIN(ppV[p >> 1]); }
            else { eA = xa; eR = xr; eB = xb; eK = xk; eV = v; eQ = xq; } }
        gamC = gprev;
    }
    S_MEMBAR();
    float gc0, gc1; { unsigned x = __float_as_uint(gamC), y = x; S_SWAP(x, y); gc0 = __uint_as_float(x); gc1 = __uint_as_float(y); }
    ((S_LDS_F32P)(lds + SC_GTAB + wave * 256))[lane] = gamC;
    const SMat FA = splain2d(ppA), FB = splain2d(ppB), FK = splain2d(ppK), FV = splain2d(ppV);
    SFrag RT[2], MrbT, MrkT, LakT, Pf, PTf; f32x16 TT;
    {   const SFrag IDF = sident(n, hh); SFrag AT[2], BT[2], KT[2];
        { const SMat FR = splain2d(ppR); S_UNROLL for (int dt = 0; dt < 2; ++dt) RT[dt] = spack(smm(FR.t[dt], IDF, szero())); }
        SFrag QT[2]; { const SMat FQ = splain2d(ppQ); S_UNROLL for (int dt = 0; dt < 2; ++dt) QT[dt] = spack(smm(FQ.t[dt], IDF, szero())); }
        S_UNROLL for (int dt = 0; dt < 2; ++dt) { AT[dt] = spack(smm(FA.t[dt], IDF, szero())); BT[dt] = spack(smm(FB.t[dt], IDF, szero())); KT[dt] = spack(smm(FK.t[dt], IDF, szero())); }
        f32x16 L = szero(), LT = szero(), lak = szero(), mrb = szero(), mrk = szero();
        { f32x16 bq = szero(); S_UNROLL for (int dt = 0; dt < 2; ++dt) bq = smm(KT[dt], QT[dt], bq);
          int nb = n, rb = 4 * hh; S_LAUNDER_I(nb); S_LAUNDER_I(rb); float dsum = 0.f; S_UNROLL for (int g = 0; g < 16; ++g) dsum += (((g & 3) + 8 * (g >> 2) + rb) == nb) ? bq[g] : 0.f;
          if (((nb >> 2) & 1) == (rb >> 2)) A.bonus[((size_t)b * T + (tau0 + sgn * nb)) * 8 + h] = dsum; }
        S_UNROLL for (int dt = 0; dt < 2; ++dt) { L = smm(AT[dt], BT[dt], L); LT = smm(BT[dt], AT[dt], LT); lak = smm(KT[dt], AT[dt], lak); mrb = smm(BT[dt], RT[dt], mrb); mrk = smm(KT[dt], RT[dt], mrk); }
        int n2 = n, r2 = 4 * hh; S_LAUNDER_I(n2); S_LAUNDER_I(r2);
        S_UNROLL for (int g = 0; g < 16; ++g) { const int row = (g & 3) + 8 * (g >> 2) + r2;
            L[g] = (row > n2) ? L[g] : 0.f; LT[g] = (row < n2) ? LT[g] : 0.f; lak[g] = (row < n2) ? lak[g] : 0.f; mrb[g] = (row <= n2) ? mrb[g] : 0.f; mrk[g] = (row <= n2) ? mrk[g] : 0.f; }
        Pf = spack(L); PTf = spack(LT); LakT = spack(lak); MrbT = spack(mrb); MrkT = spack(mrk);
        TT = LT; S_UNROLL for (int g = 0; g < 16; ++g) TT[g] += (((g & 3) + 8 * (g >> 2) + r2) == n2) ? 1.f : 0.f;
    }
    S_MEMBAR();
    SFrag TTf = spack(TT);
    S_UNROLL for (int i = 1; i <= 4; ++i) { const f32x16 P2 = smm(PTf, Pf, szero()); SFrag P2Tf; if (i < 4) P2Tf = spack(smm(Pf, PTf, szero()));
        Pf = spack(P2); TT = smm(Pf, TTf, TT); TTf = spack(TT); if (i < 4) PTf = P2Tf; }
    S_MEMBAR();
    SFrag U0[2], Ap[2], RpT[2], Y0[2], GTf[2][2], Hf[2][2];
    S_UNROLL for (int vt = 0; vt < 2; ++vt) { const SFrag W = spack(smm(LakT, FV.t[vt], szero())); U0[vt] = spack(smm(TTf, W, szero())); }
    S_UNROLL for (int kt = 0; kt < 2; ++kt) Ap[kt] = spack(smm(TTf, FA.t[kt], szero()));
    S_UNROLL for (int kt = 0; kt < 2; ++kt) RpT[kt] = spack(smm(Ap[kt], MrbT, sunpack(RT[kt])));
    S_UNROLL for (int vt = 0; vt < 2; ++vt) Y0[vt] = spack(smm(MrkT, FV.t[vt], smm(MrbT, U0[vt], szero())));
    int n3 = n, r3 = 4 * hh; S_LAUNDER_I(n3); S_LAUNDER_I(r3);
    S_UNROLL for (int nt = 0; nt < 2; ++nt) S_UNROLL for (int mt = 0; mt < 2; ++mt) { f32x16 gt = smm(Ap[nt], FB.t[mt], szero()); const float gcv = mt ? gc1 : gc0;
        S_UNROLL for (int g = 0; g < 16; ++g) { const float idv = (nt == mt && ((g & 3) + 8 * (g >> 2) + r3) == n3) ? 1.f : 0.f; gt[g] = (gt[g] + idv) * gcv; }
        GTf[nt][mt] = spack(gt); }
    S_LDS_WAIT();
    S_UNROLL for (int mt = 0; mt < 2; ++mt) { float gr[16];
        S_UNROLL for (int q = 0; q < 4; ++q) { const f32x4 t4 = *(S_LDS_CONST_F32X4P)(lds + SC_GTAB + wave * 256 + (32 * mt + 8 * q + 4 * hh) * 4); S_UNROLL for (int i = 0; i < 4; ++i) gr[4 * q + i] = t4[i]; }
        S_UNROLL for (int vt = 0; vt < 2; ++vt) { f32x16 hm = smm(FK.t[mt], FV.t[vt], smm(FB.t[mt], U0[vt], szero())); S_UNROLL for (int g = 0; g < 16; ++g) hm[g] *= gr[g]; Hf[mt][vt] = spack(hm); } }
    S_MEMBAR();
    S_FLAG_WAIT(lds + SC_FLAG, (unsigned)c);
    SFrag SG[2][2];
    S_UNROLL for (int kt = 0; kt < 2; ++kt) S_UNROLL for (int vt = 0; vt < 2; ++vt) S_UNROLL for (int s = 0; s < 2; ++s) SG[kt][vt].s[s] = *(S_LDS_CONST_BF16X8P)(lds + SC_SIG + ((((kt * 2 + vt) * 2 + s) * 64 + lane) * 16));
    S_LDS_WAIT();
    S_UNROLL for (int mt = 0; mt < 2; ++mt) S_UNROLL for (int vt = 0; vt < 2; ++vt) { f32x16 sn = sunpack(Hf[mt][vt]); S_UNROLL for (int nt = 0; nt < 2; ++nt) sn = smm(GTf[nt][mt], SG[nt][vt], sn);
        const SFrag f = spack(sn); S_UNROLL for (int s = 0; s < 2; ++s) *(S_LDS_BF16X8P)(lds + SC_SIG + ((((mt * 2 + vt) * 2 + s) * 64 + lane) * 16)) = f.s[s]; }
    S_LDS_WAIT();
    S_FLAG_STORE(lds + SC_FLAG, (unsigned)(c + 1));
    S_UNROLL for (int vt = 0; vt < 2; ++vt) { f32x16 y = sunpack(Y0[vt]); S_UNROLL for (int kt = 0; kt < 2; ++kt) y = smm(RpT[kt], SG[kt][vt], y);
        S_UNROLL for (int g = 0; g < 16; ++g) { const int p = (g & 3) + 8 * (g >> 2) + 4 * hh; A.ydir[((size_t)b * T + (tau0 + sgn * p)) * 512 + h * 64 + 32 * vt + n] = (bf16)(S_PK(y[g], 0.f) & 0xffffu); } }
}

__device__ __forceinline__ void attn_unit(const Frame& F, ArgsP A, int b, int kvh, int qb) {
    constexpr int KST = 72, VST = 388;
    LAS bf16* KS = (LAS bf16*)F.lds;
    LAS bf16* VT = (LAS bf16*)(F.lds + 384 * KST * 2);
    LAS float* wsf = (LAS float*)(F.lds + 384 * KST * 2 + 64 * VST * 2);
    const bf16* Z = (const bf16*)(A->ws + WS_Z); bf16* OA = (bf16*)(A->ws + WS_OATT);
    const int* positions = (const int*)A->in[2]; const float* qg = (const float*)A->in[19]; const float* kg = (const float*)A->in[20]; const float* sink = (const float*)A->in[21];
    const int tid = F.tid, lane = F.lane, wave = F.wave;
    const float LN_THETA = 13.122363377404328f;
    v4u kwa[6], vwa[6], rca[6], rsa[6];
    v4u qn[4], qnc, qns;
    { const size_t tok0 = (size_t)b * T + qb * 128 + (wave & 1) * 64 + (lane & 31); const int hq0 = kvh * 4 + (wave >> 1);
#pragma unroll
      for (int sI = 0; sI < 4; ++sI) qn[sI] = *(const GAS v4u*)(Z + tok0 * NZ + ZQ + hq0 * 64 + 16 * sI + 8 * (lane >> 5));
      const GAS v4u* qrt0 = (const GAS v4u*)((const bf16*)(A->ws + WS_ROPE) + tok0 * 16); qnc = qrt0[0]; qns = qrt0[1]; }
#pragma unroll
    for (int i = 0; i < 6; ++i) { const int ct = tid + 512 * i, key = ct >> 3, ch = ct & 7; const int kp = qb * 128 - 128 + key; const bool valid = (kp >= 0) && (kp < T);
        const size_t rowoff = ((size_t)b * T + (valid ? kp : 0)) * NZ;
        kwa[i] = *(const GAS v4u*)(Z + rowoff + ZKA + kvh * 64 + ch * 8); vwa[i] = *(const GAS v4u*)(Z + rowoff + ZVA + kvh * 64 + ch * 8);
        const GAS v4u* rt = (const GAS v4u*)((const bf16*)(A->ws + WS_ROPE) + ((size_t)b * T + (valid ? kp : 0)) * 16); rca[i] = rt[0]; rsa[i] = rt[1]; }
#pragma unroll
    for (int i = 0; i < 6; ++i) { const int ct = tid + 512 * i, key = ct >> 3, ch = ct & 7; const int kp = qb * 128 - 128 + key; const bool valid = (kp >= 0) && (kp < T);
        v4u kw = kwa[i], vw = vwa[i];
        if (!valid) { kw = (v4u){0u, 0u, 0u, 0u}; vw = kw; }
        float kf[8] = {bflo(kw.x), bfhi(kw.x), bflo(kw.y), bfhi(kw.y), bflo(kw.z), bfhi(kw.z), bflo(kw.w), bfhi(kw.w)};
        float ss = 0.f;
#pragma unroll
        for (int j = 0; j < 8; ++j) ss += kf[j] * kf[j];
        ss += __shfl_xor(ss, 1); ss += __shfl_xor(ss, 2); ss += __shfl_xor(ss, 4);
        const float rs = rsqrtf(ss * (1.0f / 64.0f) + 1e-6f);
#pragma unroll
        for (int j = 0; j < 8; ++j) kf[j] = kf[j] * rs * kg[ch * 8 + j];
        float oth[8];
#pragma unroll
        for (int j = 0; j < 8; ++j) oth[j] = __shfl_xor(kf[j], 1);
        if (ch < 2) { const v4u cw = rca[i], sw = rsa[i];
            const float cs[8] = {bflo(cw.x), bfhi(cw.x), bflo(cw.y), bfhi(cw.y), bflo(cw.z), bfhi(cw.z), bflo(cw.w), bfhi(cw.w)};
            const float sn[8] = {bflo(sw.x), bfhi(sw.x), bflo(sw.y), bfhi(sw.y), bflo(sw.z), bfhi(sw.z), bflo(sw.w), bfhi(sw.w)};
#pragma unroll
            for (int j = 0; j < 8; ++j) kf[j] = (ch == 0) ? (kf[j] * cs[j] - oth[j] * sn[j]) : (kf[j] * cs[j] + oth[j] * sn[j]); }
        v4u ko; ko.x = pk2(kf[0], kf[1]); ko.y = pk2(kf[2], kf[3]); ko.z = pk2(kf[4], kf[5]); ko.w = pk2(kf[6], kf[7]);
        *(LAS v4u*)(KS + key * KST + ch * 8) = ko;
        const unsigned vv[4] = {vw.x, vw.y, vw.z, vw.w};
#pragma unroll
        for (int j = 0; j < 4; ++j) { VT[(ch * 8 + 2 * j) * VST + key] = (bf16)(vv[j] & 0xffffu); VT[(ch * 8 + 2 * j + 1) * VST + key] = (bf16)(vv[j] >> 16); } }
    __syncthreads();
    const int g = wave >> 1, hq = kvh * 4 + g, r32 = lane & 31, hh = lane >> 5;
    const float snk = sink[hq];
    float kbound; { float gm = fabsf(kg[lane]);
#pragma unroll
        for (int o = 1; o < 64; o <<= 1) gm = fmaxf(gm, __shfl_xor(gm, o));
        kbound = 8.0f * gm; }
#pragma unroll 1
    for (int qt = 0; qt < 2; ++qt) { const int qo = (wave & 1) * 64 + qt * 32, qrel = qo + r32; const size_t tok = (size_t)b * T + qb * 128 + qrel;
        float qf[4][8]; float ss = 0.f; v4u qraw[4];
#pragma unroll
        for (int sI = 0; sI < 4; ++sI) qraw[sI] = qn[sI];
        const v4u qrc = qnc, qrs = qns;
        if (qt == 0) { const size_t tok1 = tok + 32;
#pragma unroll
            for (int sI = 0; sI < 4; ++sI) qn[sI] = *(const GAS v4u*)(Z + tok1 * NZ + ZQ + hq * 64 + 16 * sI + 8 * hh);
            const GAS v4u* qrt1 = (const GAS v4u*)((const bf16*)(A->ws + WS_ROPE) + tok1 * 16); qnc = qrt1[0]; qns = qrt1[1]; }
#pragma unroll
        for (int sI = 0; sI < 4; ++sI) { const v4u qw = qraw[sI];
            qf[sI][0] = bflo(qw.x); qf[sI][1] = bfhi(qw.x); qf[sI][2] = bflo(qw.y); qf[sI][3] = bfhi(qw.y); qf[sI][4] = bflo(qw.z); qf[sI][5] = bfhi(qw.z); qf[sI][6] = bflo(qw.w); qf[sI][7] = bfhi(qw.w);
#pragma unroll
            for (int j = 0; j < 8; ++j) ss += qf[sI][j] * qf[sI][j]; }
        ss += __shfl_xor(ss, 32);
        const float rs = rsqrtf(ss * (1.0f / 64.0f) + 1e-6f) * 0.125f;
#pragma unroll
        for (int sI = 0; sI < 4; ++sI)
#pragma unroll
            for (int j = 0; j < 8; ++j) qf[sI][j] = qf[sI][j] * rs * qg[16 * sI + 8 * hh + j];
        { const v4u cw = qrc, sw = qrs;
          const float cs[8] = {bflo(cw.x), bfhi(cw.x), bflo(cw.y), bfhi(cw.y), bflo(cw.z), bfhi(cw.z), bflo(cw.w), bfhi(cw.w)}, sn[8] = {bflo(sw.x), bfhi(sw.x), bflo(sw.y), bfhi(sw.y), bflo(sw.z), bfhi(sw.z), bflo(sw.w), bfhi(sw.w)};
#pragma unroll
          for (int j = 0; j < 8; ++j) { const float oth = __shfl_xor(qf[0][j], 32); qf[0][j] = (hh == 0) ? (qf[0][j] * cs[j] - oth * sn[j]) : (qf[0][j] * cs[j] + oth * sn[j]); } }
        bf16x8 qr[4];
#pragma unroll
        for (int sI = 0; sI < 4; ++sI) { v4u w; w.x = pk2(qf[sI][0], qf[sI][1]); w.y = pk2(qf[sI][2], qf[sI][3]); w.z = pk2(qf[sI][4], qf[sI][5]); w.w = pk2(qf[sI][6], qf[sI][7]); qr[sI] = __builtin_bit_cast(bf16x8, w); }
        const int kt0 = qo >> 5;
        float qn2 = 0.f;
#pragma unroll
        for (int sI = 0; sI < 4; ++sI)
#pragma unroll
            for (int j = 0; j < 8; ++j) qn2 += qf[sI][j] * qf[sI][j];
        qn2 += __shfl_xor(qn2, 32);
        float mrun = sqrtf(qn2) * kbound * 1.02f;
        if (__any(mrun > 40.f)) { mrun = -1e30f;
#pragma unroll 1
            for (int kt = 0; kt < 9; ++kt) { const int kbase = (kt0 + kt) * 32;
                f32x16 acc = {};
#pragma unroll
                for (int sI = 0; sI < 4; ++sI) { const bf16x8 kfr = *(const LAS bf16x8*)(KS + (kbase + r32) * KST + 16 * sI + 8 * hh); acc = __builtin_amdgcn_mfma_f32_32x32x16_bf16(kfr, qr[sI], acc, 0, 0, 0); }
#pragma unroll
                for (int r = 0; r < 16; ++r) { const int ki = kbase + (r & 3) + 8 * (r >> 2) + 4 * hh; const int dq = ki - 128 - qrel, kp = qb * 128 - 128 + ki;
                    const bool ok = (dq >= -128) && (dq <= 128) && (kp >= 0) && (kp < T); mrun = fmaxf(mrun, ok ? acc[r] : -1e30f); } }
            mrun = fmaxf(mrun, __shfl_xor(mrun, 32)); }
        const float mx = fmaxf(mrun, snk);
        float lrun = 0.f; f32x16 o0 = {}, o1 = {}; const float mxl = mx * 1.442695041f; const bool edge = (qb == 0) || (qb == T / 128 - 1);
#pragma unroll 1
        for (int kt = 0; kt < 9; ++kt) { const int kbase = (kt0 + kt) * 32;
            f32x16 acc = {};
#pragma unroll
            for (int sI = 0; sI < 4; ++sI) { const bf16x8 kfr = *(const LAS bf16x8*)(KS + (kbase + r32) * KST + 16 * sI + 8 * hh); acc = __builtin_amdgcn_mfma_f32_32x32x16_bf16(kfr, qr[sI], acc, 0, 0, 0); }
            float p[16];
            if (edge || kt == 0 || kt == 8) {
#pragma unroll
                for (int r = 0; r < 16; ++r) { const int ki = kbase + (r & 3) + 8 * (r >> 2) + 4 * hh; const int dq = ki - 128 - qrel, kp = qb * 128 - 128 + ki;
                    const bool ok = (dq >= -128) && (dq <= 128) && (kp >= 0) && (kp < T); p[r] = ok ? __builtin_amdgcn_exp2f(acc[r] * 1.442695041f - mxl) : 0.f; lrun += p[r]; }
            } else {
#pragma unroll
                for (int r = 0; r < 16; ++r) { p[r] = __builtin_amdgcn_exp2f(acc[r] * 1.442695041f - mxl); lrun += p[r]; } }
#pragma unroll
            for (int sI = 0; sI < 2; ++sI) { v4u pw; pw.x = pk2(p[8 * sI + 0], p[8 * sI + 1]); pw.y = pk2(p[8 * sI + 2], p[8 * sI + 3]); pw.z = pk2(p[8 * sI + 4], p[8 * sI + 5]); pw.w = pk2(p[8 * sI + 6], p[8 * sI + 7]);
                const bf16x8 pa = __builtin_bit_cast(bf16x8, pw); const int key0 = kbase + 16 * sI + 4 * hh;
                { const u32x2 lo = *(const LAS u32x2*)(VT + r32 * VST + key0), hi = *(const LAS u32x2*)(VT + r32 * VST + key0 + 8); v4u vw; vw.x = lo.x; vw.y = lo.y; vw.z = hi.x; vw.w = hi.y;
                  o0 = __builtin_amdgcn_mfma_f32_32x32x16_bf16(pa, __builtin_bit_cast(bf16x8, vw), o0, 0, 0, 0); }
                { const u32x2 lo = *(const LAS u32x2*)(VT + (32 + r32) * VST + key0), hi = *(const LAS u32x2*)(VT + (32 + r32) * VST + key0 + 8); v4u vw; vw.x = lo.x; vw.y = lo.y; vw.z = hi.x; vw.w = hi.y;
                  o1 = __builtin_amdgcn_mfma_f32_32x32x16_bf16(pa, __builtin_bit_cast(bf16x8, vw), o1, 0, 0, 0); } } }
        lrun += __shfl_xor(lrun, 32);
        const float linv = 1.0f / (lrun + __expf(snk - mx));
        if (hh == 0) wsf[wave * 64 + r32] = linv;
        LDS_WAIT(); asm volatile("" ::: "memory");
#pragma unroll
        for (int r = 0; r < 16; ++r) { const int row = (r & 3) + 8 * (r >> 2) + 4 * hh; const float li = wsf[wave * 64 + row];
            bf16* op = OA + ((size_t)b * T + qb * 128 + qo + row) * 512 + hq * 64;
            op[r32] = (bf16)f2bf(o0[r] * li); op[32 + r32] = (bf16)f2bf(o1[r] * li); }
        LDS_WAIT(); asm volatile("" ::: "memory");
    }
    __syncthreads();
}

__device__ __forceinline__ void pg_rows(const Frame& F, ArgsP A, bf16* wout) {
    const bf16* Z = (const bf16*)(A->ws + WS_Z); const bf16* Y0 = (const bf16*)(A->ws + WS_XN); const bf16* Y1 = Y0 + (size_t)M * 512;
    bf16* Gb = (bf16*)(A->ws + WS_G); const float* bonus = (const float*)(A->ws + WS_BONUS);
    const float* mu_prev = (const float*)A->in[7]; const float* mu_next = (const float*)A->in[8]; const float* gn_w = (const float*)A->in[17]; const float* gn_b = (const float*)A->in[18];
    const int gw = F.vcu * NWAVES + F.wave, NGW = F.G * NWAVES, lane = F.lane, c0 = lane * 8, h = lane >> 3;
    float mp[8], mn[8], gw_[8], gb_[8];
#pragma unroll
    for (int j = 0; j < 8; ++j) { mp[j] = mu_prev[ZV + c0 + j]; mn[j] = mu_next[ZV + c0 + j]; gw_[j] = gn_w[c0 + j]; gb_[j] = gn_b[c0 + j]; }
#pragma unroll 1
    for (int m0 = gw; m0 < M; m0 += 4 * NGW) {
        v4u y0[4], y1[4], gv[4], z0[4], zm[4], zq[4]; float bon[4];
#pragma unroll
        for (int i = 0; i < 4; ++i) { const int m = m0 + i * NGW, t = m & (T - 1);
            y0[i] = *(const GAS v4u*)(Y0 + (size_t)m * 512 + c0); y1[i] = *(const GAS v4u*)(Y1 + (size_t)m * 512 + c0); gv[i] = *(const GAS v4u*)(Gb + (size_t)m * 512 + c0);
            z0[i] = *(const GAS v4u*)(Z + (size_t)m * NZ + ZV + c0);
            zm[i] = (v4u){0u, 0u, 0u, 0u}; zq[i] = (v4u){0u, 0u, 0u, 0u};
            if (t > 0) zm[i] = *(const GAS v4u*)(Z + (size_t)(m - 1) * NZ + ZV + c0);
            if (t < T - 1) zq[i] = *(const GAS v4u*)(Z + (size_t)(m + 1) * NZ + ZV + c0);
            bon[i] = bonus[(size_t)m * 8 + h] + bonus[(size_t)M * 8 + (size_t)m * 8 + h]; }
#pragma unroll
        for (int i = 0; i < 4; ++i) { const int m = m0 + i * NGW;
            const unsigned y0w[4] = {y0[i].x, y0[i].y, y0[i].z, y0[i].w}, y1w[4] = {y1[i].x, y1[i].y, y1[i].z, y1[i].w}, gvw[4] = {gv[i].x, gv[i].y, gv[i].z, gv[i].w};
            const unsigned z0w[4] = {z0[i].x, z0[i].y, z0[i].z, z0[i].w}, zmw[4] = {zm[i].x, zm[i].y, zm[i].z, zm[i].w}, zqw[4] = {zq[i].x, zq[i].y, zq[i].z, zq[i].w};
            float y[8], gg[8], vv[8]; float sacc = 0.f;
#pragma unroll
            for (int j = 0; j < 4; ++j) { y[2 * j] = bflo(y0w[j]) + bflo(y1w[j]); y[2 * j + 1] = bfhi(y0w[j]) + bfhi(y1w[j]); gg[2 * j] = bflo(gvw[j]); gg[2 * j + 1] = bfhi(gvw[j]);
                const float a0 = bflo(z0w[j]), a1 = bfhi(z0w[j]);
                vv[2 * j] = a0 + mp[2 * j] * (bflo(zmw[j]) - a0) + mn[2 * j] * (bflo(zqw[j]) - a0); vv[2 * j + 1] = a1 + mp[2 * j + 1] * (bfhi(zmw[j]) - a1) + mn[2 * j + 1] * (bfhi(zqw[j]) - a1);
                sacc += y[2 * j] + y[2 * j + 1]; }
            sacc += __shfl_xor(sacc, 1); sacc += __shfl_xor(sacc, 2); sacc += __shfl_xor(sacc, 4);
            const float mu = sacc * (1.0f / 64.0f); float q = 0.f;
#pragma unroll
            for (int j = 0; j < 8; ++j) { const float d = y[j] - mu; q += d * d; }
            q += __shfl_xor(q, 1); q += __shfl_xor(q, 2); q += __shfl_xor(q, 4);
            const float rstd = rsqrtf(q * (1.0f / 64.0f) + 64e-5f);
            float o[8];
#pragma unroll
            for (int j = 0; j < 8; ++j) o[j] = ((y[j] - mu) * rstd * gw_[j] + gb_[j] + bon[i] * vv[j]) * gg[j];
            v4u w; w.x = pk2(o[0], o[1]); w.y = pk2(o[2], o[3]); w.z = pk2(o[4], o[5]); w.w = pk2(o[6], o[7]);
            *(GAS v4u*)(wout + (size_t)m * 512 + c0) = w; } }
}

constexpr int CONV_PER = 512, CONV_NIT = 16 * 3 * CONV_PER, CONV_EARLY = 6144;
__device__ __forceinline__ void conv_items(const Frame& F, ArgsP A, int it0, int it1, int widx, int nw) {
    LAS float* scr = (LAS float*)(F.lds + F.wave * 16384); const int lane = F.lane;
    const float* w_gate = (const float*)A->in[27]; const float* w_up = (const float*)A->in[28]; const float* w_down = (const float*)A->in[29];
    bf16* WguT = (bf16*)((unsigned char*)A->out + OUT_WGUT); bf16* WdT = (bf16*)((unsigned char*)A->out + OUT_WDT);
    auto src_of = [&](int it, const float*& W, int& k0, int& n0, bf16*& WT, int& row0) { const int e = it / (3 * CONV_PER), r = it % (3 * CONV_PER), which = r / CONV_PER, q = r % CONV_PER, kb = q >> 5, nb = q & 31; k0 = 64 * kb; n0 = 32 * nb;
        if (which == 0) { W = w_gate + (size_t)e * 1048576; WT = WguT; row0 = e * 2048 + (n0 >> 7) * 256 + (n0 & 127); }
        else if (which == 1) { W = w_up + (size_t)e * 1048576; WT = WguT; row0 = e * 2048 + (n0 >> 7) * 256 + 128 + (n0 & 127); }
        else { W = w_down + (size_t)e * 1048576; WT = WdT; row0 = e * 1024 + n0; } };
    int it = it0 + widx; if (it >= it1) return;
    f32x4 va[8], vb[8]; const float* W; int k0, n0, row0; bf16* WT; src_of(it, W, k0, n0, WT, row0); tr_load(va, W, 1024, k0, n0, lane);
#pragma unroll 1
    for (;;) { const int itn = it + nw; const float* W2; int k2 = 0, n2 = 0, row2 = 0; bf16* WT2 = WT;
        if (itn < it1) { src_of(itn, W2, k2, n2, WT2, row2); tr_load(vb, W2, 1024, k2, n2, lane); }
        tr_store(va, k0, WT, 1024, row0, scr, lane);
        if (itn >= it1) break;
#pragma unroll
        for (int i = 0; i < 8; ++i) va[i] = vb[i];
        it = itn; k0 = k2; WT = WT2; row0 = row2; }
}
__device__ __forceinline__ int conv_idle_first(int G) { const int nwg = (M / 256) * (NZP / 256), mx = (nwg + G - 1) / G; return nwg - (mx - 1) * G; }
__device__ __forceinline__ void pj_phase(const Frame& F, ArgsP A) {
    unsigned char* ws = A->ws;
    const int gw = F.vcu * NWAVES + F.wave, NGW = F.G * NWAVES, lane = F.lane;
    { const int c0 = conv_idle_first(F.G); conv_items(F, A, c0 < F.G ? CONV_EARLY : 0, CONV_NIT, gw, NGW); }
    __syncthreads();
    const float* w_router = (const float*)A->in[26]; const bf16* x1 = (const bf16*)(ws + WS_X1); const float* g2n = (const float*)A->in[25]; const float* mod = (const float*)(ws + WS_MOD);
    bf16* XN2 = (bf16*)(ws + WS_XN); float* aff = (float*)(ws + WS_AFF);
    LAS bf16* WF = (LAS bf16*)F.lds;
    LAS float* AT = (LAS float*)(F.lds + 65536); LAS float* BT = AT + 1024; LAS float* CB = BT + 1024;
    const int tile = gw, b = tile >> 7;
    for (int d = F.tid; d < 1024; d += 512) { AT[d] = g2n[d] * (1.0f + mod[(size_t)b * 6144 + 4096 + d]); BT[d] = mod[(size_t)b * 6144 + 3072 + d]; }
    __syncthreads();
#pragma unroll 4
    for (int k = 0; k < 32; ++k) { const int it = F.tid + 512 * k, jj = it & 7, ln = (it >> 3) & 63, sI = it >> 9, q = ln >> 4, e = ln & 15, d = 32 * sI + 8 * q + jj;
        const float v = AT[d] * w_router[d * 16 + e]; const unsigned hi = pk2(v, 0.f) & 0xffffu; const float lo = v - __uint_as_float(hi << 16);
        WF[it] = (bf16)hi; WF[16384 + it] = (bf16)(pk2(lo, 0.f) & 0xffffu); }
    { float c0 = 0.f, c1 = 0.f;
#pragma unroll 4
      for (int k = 0; k < 16; ++k) { const int d = lane + 64 * k; c0 += BT[d] * w_router[d * 16 + 2 * F.wave]; c1 += BT[d] * w_router[d * 16 + 2 * F.wave + 1]; }
      c0 = dpp_wave_sum(c0); c1 = dpp_wave_sum(c1); if (lane == 0) { CB[2 * F.wave] = c0; CB[2 * F.wave + 1] = c1; } }
    __syncthreads();
    if (tile < M / 16) { const int r = lane & 15, q = lane >> 4; const size_t m = (size_t)tile * 16 + r;
        float ss = 0.f;
#pragma unroll 1
        for (int hf = 0; hf < 2; ++hf) { v4u raw[16];
#pragma unroll
            for (int sI = 0; sI < 16; ++sI) raw[sI] = *(const GAS v4u*)(x1 + m * 1024 + 32 * (16 * hf + sI) + 8 * q);
#pragma unroll
            for (int sI = 0; sI < 16; ++sI) { const v4u w = raw[sI]; const float a0 = bflo(w.x), a1 = bfhi(w.x), a2 = bflo(w.y), a3 = bfhi(w.y), a4 = bflo(w.z), a5 = bfhi(w.z), a6 = bflo(w.w), a7 = bfhi(w.w);
                ss += (a0 * a0 + a1 * a1) + (a2 * a2 + a3 * a3) + (a4 * a4 + a5 * a5) + (a6 * a6 + a7 * a7); } }
        ss += __shfl_xor(ss, 16); ss += __shfl_xor(ss, 32);
        const float rs = rsqrtf(ss * (1.0f / 1024.0f) + 1e-6f);
        f32x4 ah = {0.f, 0.f, 0.f, 0.f}, al = {0.f, 0.f, 0.f, 0.f};
#pragma unroll 1
        for (int hf = 0; hf < 2; ++hf) { v4u raw[16];
#pragma unroll
            for (int sI = 0; sI < 16; ++sI) raw[sI] = *(const GAS v4u*)(x1 + m * 1024 + 32 * (16 * hf + sI) + 8 * q);
#pragma unroll
            for (int sI = 0; sI < 16; ++sI) { const int sg = 16 * hf + sI; const bf16x8 xa = __builtin_bit_cast(bf16x8, raw[sI]);
                const bf16x8 bh = *(const LAS bf16x8*)(WF + (sg * 64 + lane) * 8), bl = *(const LAS bf16x8*)(WF + 16384 + (sg * 64 + lane) * 8);
                ah = __builtin_amdgcn_mfma_f32_16x16x32_bf16(xa, bh, ah, 0, 0, 0); al = __builtin_amdgcn_mfma_f32_16x16x32_bf16(xa, bl, al, 0, 0, 0); }
#pragma unroll
            for (int sI = 0; sI < 16; ++sI) { if ((sI & 3) == 0) asm volatile("" ::: "memory");
                const int d0 = 32 * (16 * hf + sI) + 8 * q; const v4u w = raw[sI];
                const f32x4 a0 = *(const LAS f32x4*)(AT + d0), a1 = *(const LAS f32x4*)(AT + d0 + 4), b0 = *(const LAS f32x4*)(BT + d0), b1 = *(const LAS f32x4*)(BT + d0 + 4);
                v4u o; o.x = pk2(bflo(w.x) * rs * a0.x + b0.x, bfhi(w.x) * rs * a0.y + b0.y); o.y = pk2(bflo(w.y) * rs * a0.z + b0.z, bfhi(w.y) * rs * a0.w + b0.w);
                o.z = pk2(bflo(w.z) * rs * a1.x + b1.x, bfhi(w.z) * rs * a1.y + b1.y); o.w = pk2(bflo(w.w) * rs * a1.z + b1.z, bfhi(w.w) * rs * a1.w + b1.w);
                *(GAS v4u*)(XN2 + m * 1024 + d0) = o; } }
        const float cb = CB[lane & 15]; float lg[4], mx[4], ex[4], den[4];
#pragma unroll
        for (int i = 0; i < 4; ++i) { const float rsr = __shfl(rs, 4 * q + i); lg[i] = rsr * (ah[i] + al[i]) + cb; mx[i] = lg[i]; }
#pragma unroll
        for (int o = 1; o < 16; o <<= 1)
#pragma unroll
            for (int i = 0; i < 4; ++i) mx[i] = fmaxf(mx[i], __shfl_xor(mx[i], o));
#pragma unroll
        for (int i = 0; i < 4; ++i) { ex[i] = expf(lg[i] - mx[i]); den[i] = ex[i]; }
#pragma unroll
        for (int o = 1; o < 16; o <<= 1)
#pragma unroll
            for (int i = 0; i < 4; ++i) den[i] += __shfl_xor(den[i], o);
        { const int t0 = (tile & 127) * 16 + 4 * q; f32x4 av; av.x = ex[0] / den[0]; av.y = ex[1] / den[1]; av.z = ex[2] / den[2]; av.w = ex[3] / den[3];
          *(GAS f32x4*)(aff + ((size_t)b * 16 + (lane & 15)) * T + t0) = av; } }
}

__device__ __forceinline__ void pk_task(const Frame& F, ArgsP A, int b, int e) {
    unsigned char* ws = A->ws;
    const float* aff = (const float*)(ws + WS_AFF) + ((size_t)b * 16 + e) * T;
    int* slotmap = (int*)(ws + WS_SLOT); float* selaff = (float*)(ws + WS_SELAFF); int* selidx = (int*)(ws + WS_SELIDX);
    const bf16* XN2 = (const bf16*)(ws + WS_XN); bf16* XE = (bf16*)(ws + WS_XE);
    LAS unsigned* cnt = (LAS unsigned*)F.lds;
    LAS int* tokl = (LAS int*)(F.lds + 256);
    const int tid = F.tid, lane = F.lane, wave = F.wave;
    const f32x4 v4 = *(const GAS f32x4*)(aff + 4 * tid);
    const unsigned key[4] = {__float_as_uint(v4.x), __float_as_uint(v4.y), __float_as_uint(v4.z), __float_as_uint(v4.w)};
    unsigned thr = 0u;
#pragma unroll 1
    for (int bit = 31; bit >= 0; --bit) { const unsigned cand = thr | (1u << bit);
        const unsigned c = (unsigned)(__popcll(__ballot(key[0] >= cand)) + __popcll(__ballot(key[1] >= cand)) + __popcll(__ballot(key[2] >= cand)) + __popcll(__ballot(key[3] >= cand)));
        LAS unsigned* slot_ = cnt + 16 + (bit & 1) * 8;
        if (lane == 0) slot_[wave] = c;
        __syncthreads();
        unsigned tot = 0;
#pragma unroll
        for (int w = 0; w < 8; ++w) tot += slot_[w];
        if (tot >= 256u) thr = cand; }
    __syncthreads();
    int ngt = 0, neq = 0;
#pragma unroll
    for (int j = 0; j < 4; ++j) { ngt += key[j] > thr; neq += key[j] == thr; }
    int sg = ngt, se = neq;
#pragma unroll
    for (int o = 1; o < 64; o <<= 1) { const int a = __shfl_up(sg, o), c = __shfl_up(se, o); if (lane >= o) { sg += a; se += c; } }
    if (lane == 63) { cnt[wave] = (unsigned)sg; cnt[8 + wave] = (unsigned)se; }
    __syncthreads();
    int bg = 0, be = 0, totg = 0;
#pragma unroll
    for (int w = 0; w < 8; ++w) { const int a = (int)cnt[w], c = (int)cnt[8 + w]; if (w < wave) { bg += a; be += c; } totg += a; }
    int pg = bg + sg - ngt, pe = be + se - neq;
    const int need_eq = 256 - totg;
    int* smrow = slotmap + ((size_t)b * T + 4 * tid) * 16 + e;
#pragma unroll
    for (int j = 0; j < 4; ++j) { int slot = -1;
        if (key[j] > thr) { slot = pg; ++pg; } else if (key[j] == thr) { if (pe < need_eq) slot = totg + pe; ++pe; }
        smrow[j * 16] = slot;
        if (slot >= 0) { selidx[((size_t)e * 16 + b) * 256 + slot] = b * T + 4 * tid + j; selaff[((size_t)e * 16 + b) * 256 + slot] = __uint_as_float(key[j]); } }
    __syncthreads();
}

__device__ __forceinline__ void pn_rows(const Frame& F, ArgsP A, float* wout) {
    unsigned char* ws = A->ws;
    const int* slotmap = (const int*)(ws + WS_SLOT); const bf16* YE = (const bf16*)(ws + WS_XE); const float* mod = (const float*)(ws + WS_MOD); const bf16* X1 = (const bf16*)(ws + WS_X1);
    const int gw = F.vcu * NWAVES + F.wave, NGW = F.G * NWAVES, lane = F.lane;
#pragma unroll 1
    for (int m0 = gw * 16; m0 < gw * 16 + 16; m0 += 2) {
        int myslot[2]; f32x4 xv[2][4];
#pragma unroll
        for (int i = 0; i < 2; ++i) { const int m = m0 + i; myslot[i] = slotmap[(size_t)m * 16 + (lane & 15)];
#pragma unroll
            for (int hq = 0; hq < 2; ++hq) { const v4u w = *(const GAS v4u*)(X1 + (size_t)m * 1024 + hq * 512 + lane * 8);
                xv[i][2 * hq] = (f32x4){bflo(w.x), bfhi(w.x), bflo(w.y), bfhi(w.y)}; xv[i][2 * hq + 1] = (f32x4){bflo(w.z), bfhi(w.z), bflo(w.w), bfhi(w.w)}; } }
        unsigned long long msk[2]; v4u yw[2][4][2];
#pragma unroll
        for (int i = 0; i < 2; ++i) { const int b = (m0 + i) >> 11; msk[i] = __ballot(myslot[i] >= 0) & 0xffffull;
#pragma unroll
            for (int k = 0; k < 4; ++k) { const bool has = msk[i] != 0ull; const int e = has ? __builtin_ctzll(msk[i]) : 0; if (has) msk[i] &= msk[i] - 1; const int sl = __shfl(myslot[i], e);
                yw[i][k][0] = (v4u){0u, 0u, 0u, 0u}; yw[i][k][1] = (v4u){0u, 0u, 0u, 0u};
                if (has) { const GAS v4u* yr = (const GAS v4u*)(YE + (((size_t)e * 16 + b) * 256 + sl) * 1024); yw[i][k][0] = yr[lane]; yw[i][k][1] = yr[64 + lane]; } } }
#pragma unroll
        for (int i = 0; i < 2; ++i) { const int m = m0 + i, b = m >> 11;
            float acc[16];
#pragma unroll
            for (int j = 0; j < 16; ++j) acc[j] = 0.f;
#pragma unroll
            for (int k = 0; k < 4; ++k)
#pragma unroll
                for (int hlf = 0; hlf < 2; ++hlf) { const v4u w = yw[i][k][hlf];
                    acc[hlf * 8 + 0] += bflo(w.x); acc[hlf * 8 + 1] += bfhi(w.x); acc[hlf * 8 + 2] += bflo(w.y); acc[hlf * 8 + 3] += bfhi(w.y);
                    acc[hlf * 8 + 4] += bflo(w.z); acc[hlf * 8 + 5] += bfhi(w.z); acc[hlf * 8 + 6] += bflo(w.w); acc[hlf * 8 + 7] += bfhi(w.w); }
            unsigned long long mk = msk[i];
            while (mk) { const int e = __builtin_ctzll(mk); mk &= mk - 1; const int sl = __shfl(myslot[i], e);
                const GAS v4u* yr = (const GAS v4u*)(YE + (((size_t)e * 16 + b) * 256 + sl) * 1024);
#pragma unroll
                for (int hlf = 0; hlf < 2; ++hlf) { const v4u w = yr[hlf * 64 + lane];
                    acc[hlf * 8 + 0] += bflo(w.x); acc[hlf * 8 + 1] += bfhi(w.x); acc[hlf * 8 + 2] += bflo(w.y); acc[hlf * 8 + 3] += bfhi(w.y);
                    acc[hlf * 8 + 4] += bflo(w.z); acc[hlf * 8 + 5] += bfhi(w.z); acc[hlf * 8 + 6] += bflo(w.w); acc[hlf * 8 + 7] += bfhi(w.w); } }
            const float* gt2 = mod + (size_t)b * 6144 + 5120; float* orow = wout + (size_t)m * 1024;
#pragma unroll
            for (int q = 0; q < 4; ++q) { const int c = (q >> 1) * 512 + lane * 8 + (q & 1) * 4; const f32x4 g = *(const GAS f32x4*)(gt2 + c);
                f32x4 a; a.x = acc[(q >> 1) * 8 + (q & 1) * 4 + 0]; a.y = acc[(q >> 1) * 8 + (q & 1) * 4 + 1]; a.z = acc[(q >> 1) * 8 + (q & 1) * 4 + 2]; a.w = acc[(q >> 1) * 8 + (q & 1) * 4 + 3];
                *(GAS f32x4*)(orow + c) = xv[i][q] + g * a; } } }
}

__device__ __forceinline__ void mk_frame(Frame& F, LAS unsigned char* lds, int wave_s) {
    int bx = blockIdx.x, G = gridDim.x; LAUNDER(bx); LAUNDER(G);
    F.lds = lds; F.MISC = (volatile LAS unsigned*)(lds + MISC_OFF); F.ctl = nullptr;
    unsigned ones_ = ~0u; asm volatile("" : "+s"(ones_));
    int lane_ = (int)__builtin_amdgcn_mbcnt_hi(ones_, __builtin_amdgcn_mbcnt_lo(ones_, 0u)); asm volatile("" : "+v"(lane_));
    F.lane = lane_; F.wave = wave_s; F.tid = wave_s * 64 + lane_;
    F.G = G; F.vcu = (G % 8 == 0) ? (bx % 8) * (G / 8) + bx / 8 : bx;
}
__global__ void __launch_bounds__(NWAVES * 64, 2) fwd_kernel(Args args) {
    extern __shared__ __attribute__((aligned(16))) unsigned char lds[];
    LAS unsigned char* const ldsb = (LAS unsigned char*)lds;
    ArgsP ap0 = (ArgsP)__builtin_amdgcn_kernarg_segment_ptr();
    int wave_s = __builtin_amdgcn_readfirstlane((int)threadIdx.x >> 6); asm volatile("" : "+s"(wave_s));
    for (int u = threadIdx.x; u < (LDS_BYTES - LDSCTL_OFF) / 4; u += NWAVES * 64) ((LAS unsigned*)(ldsb + LDSCTL_OFF))[u] = 0u;
    __syncthreads();
#define MKBAR XcdBarrier bar; { ArgsP a_ = ap0; LAUNDER(a_); bar.bar = (unsigned*)(a_->ws + WS_CTL) + CW_BAR; bar.x = xb_xcc_id(); bar.st = (volatile LAS unsigned*)(ldsb + MISC_OFF) + 8; }
#if ONE_LAUNCH
    { MKBAR; if (threadIdx.x == 0) (void)xb_add(&bar.bar[XB_XCNT(bar.x)], 1u); }
#ifndef PHM
#define PHM 0x3fff
#endif
#define IN(k) ((PHM >> (k)) & 1)
#define GRIDBAR() do { MKBAR; { unsigned o_ = ~0u; asm volatile("" : "+s"(o_)); xcd_barrier(bar, wave_s == 0 && __builtin_amdgcn_mbcnt_hi(o_, __builtin_amdgcn_mbcnt_lo(o_, 0u)) == 0u); } } while (0)
#define SEAM(k) do { if (IN(k) && IN((k) + 1)) { MKBAR; { unsigned o_ = ~0u; asm volatile("" : "+s"(o_)); xcd_barrier(bar, wave_s == 0 && __builtin_amdgcn_mbcnt_hi(o_, __builtin_amdgcn_mbcnt_lo(o_, 0u)) == 0u); } } } while (0)
#else
    int lo, hi; { ArgsP a = ap0; LAUNDER(a); lo = a->ph_lo; hi = a->ph_hi; }
#define IN(k) (lo <= (k) && (k) < hi)
#define SEAM(k) do { } while (0)
#define GRIDBAR() do { } while (0)
#endif
    typedef pg8::bf16_t pb;
#ifndef REPMASK
#define REPMASK 0
#endif
#define PHASE_ARGS ArgsP ap = ap0; LAUNDER(ap); unsigned char* ws = ap->ws; (void)ws; Frame F; mk_frame(F, ldsb, wave_s); const int gw = F.vcu * NWAVES + F.wave, NGW = F.G * NWAVES; (void)gw; (void)NGW
    if (IN(0)) _Pragma("unroll 1") for (int rep_ = 0; rep_ <= ((REPMASK >> 0) & 1); ++rep_) { PHASE_ARGS; p0_prologue(F, ap); } SEAM(0);
    if (IN(1)) _Pragma("unroll 1") for (int rep_ = 0; rep_ <= ((REPMASK >> 1) & 1); ++rep_) { PHASE_ARGS; const float* x = (const float*)ap->in[0]; const float* g1 = (const float*)ap->in[5]; const float* mod = (const float*)(ws + WS_MOD); bf16* XN = (bf16*)(ws + WS_XN);
#pragma unroll 1
        for (int wv = gw; wv < M / 16; wv += NGW) {
#pragma unroll 1
          for (int k4 = 0; k4 < 4; ++k4) { const int m = wv * 16 + 4 * k4; f32x4 u[4][4]; modnorm_rows<4, false>(x, m, 1, g1, mod, 0, 1024, XN, F.lane, u);
            if (F.lane < 32) { const int mm = m + (F.lane >> 3), j = F.lane & 7; const float pos = (float)((const int*)ap->in[2])[mm];
                const float ang = pos * __expf(-(float)j * 0.125f * 13.122363377404328f); const float sn = __sinf(ang), cs = __cosf(ang);
                bf16* rt = (bf16*)(ws + WS_ROPE) + (size_t)mm * 16; rt[j] = (bf16)(pk2(cs, 0.f) & 0xffffu); rt[8 + j] = (bf16)(pk2(sn, 0.f) & 0xffffu); } } } } SEAM(1);
    if (IN(2)) _Pragma("unroll 1") for (int rep_ = 0; rep_ <= ((REPMASK >> 2) & 1); ++rep_) { PHASE_ARGS; pg8::Gemm g{(const pb*)(ws + WS_XN), (const pb*)(ws + WS_WINT), M, NZP, D}; pg8::StaticOrder S; S.init(M, NZP, F.G, (int)blockIdx.x);
        pg8::EpiZ E{(pb*)(ws + WS_Z)}; pg8::gemm_phase<pg8::EpiZ, pg8::StaticOrder, true, true>(F.lds, g, S, E, F.tid); }
    if (IN(2)) { PHASE_ARGS; const int c0 = conv_idle_first(F.G);
        if ((int)blockIdx.x >= c0 && c0 < F.G) { __syncthreads(); conv_items(F, ap, 0, CONV_EARLY, ((int)blockIdx.x - c0) * NWAVES + F.wave, (F.G - c0) * NWAVES); } }
    SEAM(2);
    if (IN(3)) {
#ifndef REP_SCAN
#define REP_SCAN 1
#endif
#ifndef REP_ATTN
#define REP_ATTN 1
#endif
      { PHASE_ARGS; const ScanArgs SP{(const GAS bf16*)(ws + WS_Z), (const GAS float*)ap->in[7], (const GAS float*)ap->in[8], nullptr, nullptr, nullptr, nullptr, nullptr, nullptr, nullptr, (GAS unsigned char*)(ws + WS_SGD)};
#pragma unroll 1
        for (int task = F.vcu * NWAVES + F.wave; task < 2048; task += F.G * NWAVES) scan2_prep(SP, task >> 7, (task >> 6) & 1, task & 63, F.lane); }
      GRIDBAR();
      { int c0_, G_; { Frame F0; mk_frame(F0, ldsb, wave_s); c0_ = F0.vcu; G_ = F0.G; }
#pragma unroll 1
        for (int c = c0_; c < 256 * REP_SCAN; c += G_) { PHASE_ARGS; const int b = (c >> 4) & 15, h = (c >> 1) & 7, dir = c & 1;
            scan2_setup(F.lds, (const GAS float*)ap->in[10], (const GAS float*)ap->in[12], h, dir, F.tid); __syncthreads();
            const ScanArgs SA{(const GAS bf16*)(ws + WS_Z), (const GAS float*)ap->in[7], (const GAS float*)ap->in[8], (const GAS float*)ap->in[9], (const GAS float*)ap->in[11], (const GAS float*)ap->in[14], (const GAS float*)ap->in[15], (const GAS float*)ap->in[16],
                              (GAS bf16*)(ws + WS_XN) + (size_t)dir * M * 512, (GAS float*)(ws + WS_BONUS) + (size_t)dir * M * 8, (GAS unsigned char*)(ws + WS_SGD)};
#pragma unroll 1
            for (int cc = F.wave; cc < T / 32; cc += 8) scan2_chunk(F.lds, SA, b, h, dir, cc, F.lane, F.wave);
            __syncthreads(); } }
      { PHASE_ARGS;
#pragma unroll 1
        for (int u = F.vcu; u < 512 * REP_ATTN; u += F.G) { attn_unit(F, ap, (u >> 5) & 15, (u >> 4) & 1, u & 15); } }
      { PHASE_ARGS;
        const bf16* Z = (const bf16*)(ws + WS_Z); bf16* SGD = (bf16*)(ws + WS_SGD); const float* mu_prev = (const float*)ap->in[7]; const float* mu_next = (const float*)ap->in[8];
          const int c = ZGD + 2 * F.lane; const float mp0 = mu_prev[c], mp1 = mu_prev[c + 1], mn0 = mu_next[c], mn1 = mu_next[c + 1];
#ifndef REP_SGD
#define REP_SGD 1
#endif
          const int tile = F.vcu;
          if (tile < 256) { const int pm = tile >> 1, pn = tile & 1; constexpr int RS = 136;
              LAS bf16* SG = (LAS bf16*)F.lds; LAS bf16* GT = (LAS bf16*)(F.lds + 256 * RS * 2);
              __syncthreads();
              const int mt0 = pm * 256 + F.wave * 32;
#pragma unroll 1
              for (int m0 = 0; m0 < 32; m0 += 4) { unsigned z0[4], zm[4], zq[4];
#pragma unroll
                  for (int i = 0; i < 4; ++i) { const int m = mt0 + m0 + i, t = m & (T - 1);
                      z0[i] = *(const GAS unsigned*)(Z + (size_t)m * NZ + c); zm[i] = t > 0 ? *(const GAS unsigned*)(Z + (size_t)(m - 1) * NZ + c) : 0u; zq[i] = t < T - 1 ? *(const GAS unsigned*)(Z + (size_t)(m + 1) * NZ + c) : 0u; }
#pragma unroll
                  for (int i = 0; i < 4; ++i) { const float a0 = bflo(z0[i]), a1 = bfhi(z0[i]); const float s0 = a0 + mp0 * (bflo(zm[i]) - a0) + mn0 * (bflo(zq[i]) - a0), s1 = a1 + mp1 * (bfhi(zm[i]) - a1) + mn1 * (bfhi(zq[i]) - a1);
                      *(LAS unsigned*)(SG + (F.wave * 32 + m0 + i) * RS + 2 * F.lane) = pk2(sigm(s0), sigm(s1)); } }
              __syncthreads();
              const int r32 = F.lane & 31, hh = F.lane >> 5; bf16x8 af[8];
#pragma unroll
              for (int sI = 0; sI < 8; ++sI) af[sI] = *(const LAS bf16x8*)(SG + (F.wave * 32 + r32) * RS + 16 * sI + 8 * hh);
              bf16* Gout = (bf16*)(ws + WS_G); const bf16* G2T = (const bf16*)(ws + WS_G2T);
#pragma unroll 1
              for (int hf = 0; hf < 2; ++hf) {
#pragma unroll
                  for (int i = 0; i < 4; ++i) { const int e = F.tid + 512 * i, rr = e >> 4, ch = e & 15; *(LAS v4u*)(GT + rr * RS + ch * 8) = *(const GAS v4u*)(G2T + (size_t)(256 * pn + 128 * hf + rr) * 256 + ch * 8); }
                  __syncthreads();
#pragma unroll 1
                  for (int ct = 0; ct < 4; ++ct) { f32x16 acc = {};
#pragma unroll
                      for (int sI = 0; sI < 8; ++sI) { const bf16x8 bfr = *(const LAS bf16x8*)(GT + (32 * ct + r32) * RS + 16 * sI + 8 * hh); acc = __builtin_amdgcn_mfma_f32_32x32x16_bf16(af[sI], bfr, acc, 0, 0, 0); }
#pragma unroll
                      for (int g = 0; g < 16; ++g) { const int row = (g & 3) + 8 * (g >> 2) + 4 * hh;
                          Gout[(size_t)(mt0 + row) * 512 + 256 * pn + 128 * hf + 32 * ct + r32] = (bf16)(pk2(acc[g], 0.f) & 0xffffu); } }
                  __syncthreads(); } } }
    } SEAM(4);
#ifndef REP_PG
#define REP_PG 0
#endif
    if (IN(5)) { PHASE_ARGS; if (REP_PG) pg_rows(F, ap, (bf16*)ap->out); pg_rows(F, ap, (bf16*)(ws + WS_G)); } SEAM(5);
    if (IN(6)) { PHASE_ARGS; static_assert(WS_G == WS_OATT + (size_t)M * 512 * 2 && WS_PAT == WS_PRT + (size_t)1024 * 512 * 2, "merged operand views need adjacent buffers");
        pg8::Gemm g{(const pb*)(ws + WS_OATT), (const pb*)(ws + WS_PRT), 2 * M, 2048, 512}; pg8::MergeOrder S; S.init(F.G, (int)blockIdx.x);
        pg8::EpiGate2 E{(pb*)(ws + WS_XN), (const pb*)(ws + WS_Z)}; pg8::gemm_phase<pg8::EpiGate2, pg8::MergeOrder, true, true>(F.lds, g, S, E, F.tid); } SEAM(7);
    if (IN(8)) _Pragma("unroll 1") for (int rep_ = 0; rep_ <= ((REPMASK >> 8) & 1); ++rep_) { PHASE_ARGS; pg8::Gemm g{(const pb*)(ws + WS_XN), (const pb*)(ws + WS_WOT), M, 1024, 1024}; pg8::StaticOrder S; S.init(M, 1024, F.G, (int)blockIdx.x);
        pg8::EpiRes E{(const float*)ap->in[0], (const float*)(ws + WS_MOD), (pb*)(ws + WS_X1)}; pg8::gemm_phase<pg8::EpiRes, pg8::StaticOrder, true, true>(F.lds, g, S, E, F.tid); } SEAM(8);
    if (IN(9)) _Pragma("unroll 1") for (int rep_ = 0; rep_ <= ((REPMASK >> 9) & 1); ++rep_) { PHASE_ARGS; pj_phase(F, ap); } SEAM(9);
    if (IN(10)) _Pragma("unroll 1") for (int rep_ = 0; rep_ <= ((REPMASK >> 10) & 1); ++rep_) { PHASE_ARGS; for (int p = F.vcu; p < 256; p += F.G) pk_task(F, ap, p >> 4, p & 15); } SEAM(10);
    if (IN(11)) _Pragma("unroll 1") for (int rep_ = 0; rep_ <= ((REPMASK >> 11) & 1); ++rep_) { PHASE_ARGS; pg8::Gemm g{(const pb*)(ws + WS_XN), (const pb*)((unsigned char*)ap->out + OUT_WGUT), ME, 16 * 2048, 1024}; pg8::GroupOrder<8> S{F.G, (int)blockIdx.x};
        pg8::EpiSwiglu E{(pb*)(ws + WS_H)}; pg8::gemm_phase<pg8::EpiSwiglu, pg8::GroupOrder<8>, true, true, true>(F.lds, g, S, E, F.tid, (const int*)(ws + WS_SELIDX)); } SEAM(11);
    if (IN(12)) _Pragma("unroll 1") for (int rep_ = 0; rep_ <= ((REPMASK >> 12) & 1); ++rep_) { PHASE_ARGS; pg8::Gemm g{(const pb*)(ws + WS_H), (const pb*)((unsigned char*)ap->out + OUT_WDT), ME, 16 * 1024, 1024}; pg8::GroupOrder<4> S{F.G, (int)blockIdx.x};
        pg8::EpiDown E{(pb*)(ws + WS_XE), (const float*)(ws + WS_SELAFF)}; pg8::gemm_phase<pg8::EpiDown, pg8::GroupOrder<4>, true, true>(F.lds, g, S, E, F.tid); } SEAM(12);
#ifndef EXTRA_BARS
#define EXTRA_BARS 0
#endif
#if ONE_LAUNCH
    _Pragma("unroll 1") for (int xb_ = 0; xb_ < EXTRA_BARS; ++xb_) { MKBAR; { unsigned o_ = ~0u; asm volatile("" : "+s"(o_)); xcd_barrier(bar, wave_s == 0 && __builtin_amdgcn_mbcnt_hi(o_, __builtin_amdgcn_mbcnt_lo(o_, 0u)) == 0u); } }
#endif
#ifndef REP_PN
#define REP_PN 0
#endif
    if (IN(13)) { PHASE_ARGS; if (REP_PN) pn_rows(F, ap, (float*)(ws + WS_H)); pn_rows(F, ap, ap->out); }
#undef IN
#undef SEAM
}

extern "C" void kernel_launch(void* const* d_in, const int* in_sizes, int n_in, void* d_out, int out_size, void* d_ws, size_t ws_size, hipStream_t stream) {
    static int grid = 0;
    if (grid == 0) {
        if (n_in != 30 || out_size != M * D || ws_size < WS_END) { fprintf(stderr, "kernel_launch: unexpected shapes n_in %d out %d ws %zu\n", n_in, out_size, ws_size); grid = -1; return; }
        int dev = 0, cus = 0, per_cu = 0;
        if (hipGetDevice(&dev) != hipSuccess || hipDeviceGetAttribute(&cus, hipDeviceAttributeMultiprocessorCount, dev) != hipSuccess) { grid = -1; return; }
        if (hipFuncSetAttribute((const void*)fwd_kernel, hipFuncAttributeMaxDynamicSharedMemorySize, LDS_BYTES) != hipSuccess) { fprintf(stderr, "kernel_launch: hipFuncSetAttribute failed\n"); grid = -1; return; }
        if (hipOccupancyMaxActiveBlocksPerMultiprocessor(&per_cu, (const void*)fwd_kernel, NWAVES * 64, LDS_BYTES) != hipSuccess || per_cu < 1) fprintf(stderr, "kernel_launch: occupancy query reports %d\n", per_cu);
        (void)hipGetLastError();
        grid = cus;
    }
    if (grid < 0) return;
    if (hipMemsetAsync((char*)d_ws + WS_CTL, 0, CTL_ZERO_BYTES, stream) != hipSuccess) return;
    Args a{};
    for (int i = 0; i < 30; ++i) a.in[i] = d_in[i];
    a.out = (float*)d_out; a.ws = (unsigned char*)d_ws;
#if ONE_LAUNCH
    a.ph_lo = 0; a.ph_hi = NPHASE;
    hipLaunchKernelGGL(fwd_kernel, dim3(grid), dim3(NWAVES * 64), LDS_BYTES, stream, a);
#else
    for (int p = 0; p < NPHASE; ++p) { a.ph_lo = p; a.ph_hi = p + 1; hipLaunchKernelGGL(fwd_kernel, dim3(grid), dim3(NWAVES * 64), LDS_BYTES, stream, a); }
#endif
}
```

```cpp
#include <hip/hip_runtime.h>
#include <cstdio>
#include <cstdint>
#include <cmath>
namespace pg8 {
#define PG8_LAS __attribute__((address_space(3)))
typedef unsigned short bf16_t;
typedef short bf16x8 __attribute__((ext_vector_type(8)));
typedef float f32x4 __attribute__((ext_vector_type(4)));
typedef unsigned u32x4 __attribute__((ext_vector_type(4)));
constexpr int BM = 256, BK = 64, HALF = 128, HTB = HALF * BK * 2  , STAGE_BYTES = 8 * HTB, NXCD = 8, WGM = 4;

__host__ __device__ __forceinline__ int lds_byte(int r, int c) { const int st = (r >> 4) * 2 + (c >> 5), rr = r & 15, cc = c & 31, ob = rr * 64 + cc * 2; return st * 1024 + (ob ^ (((ob >> 9) & 1) << 5)); }
__host__ __device__ __forceinline__ void stage_rc(int b, int& R, int& C) { const int st = b / 1024, sb = b % 1024, swz = sb ^ (((sb >> 9) & 1) << 5); R = (st >> 1) * 16 + swz / 64; C = (st & 1) * 32 + (swz % 64) / 2; }
__host__ __device__ __forceinline__ int perm32(int rho) { const int n = rho >> 4, i = rho & 15; return 8 * (i >> 2) + 4 * n + (i & 3); }

struct Unit { int pm, pn; };
struct Gemm { const bf16_t* A; const bf16_t* Bt; int M, N, K; };

struct StaticOrder {
    int nM, nN, nwg, G, c;
    __host__ __device__ void init(int M, int N, int G_, int c_) { nM = M / BM; nN = N / BM; nwg = nM * nN; G = G_; c = c_; }
    __host__ __device__ bool next(int i, Unit& u) const {
        const long L = (long)i * G + c; if (L >= nwg) return false;
        int wgid = (int)L; { const int q = nwg / NXCD, r = nwg % NXCD, xcd = wgid % NXCD, off = wgid / NXCD; wgid = (xcd < r ? xcd * (q + 1) : r * (q + 1) + (xcd - r) * q) + off; }
        const int nig = WGM * nN, gid = wgid / nig, fm = gid * WGM, gsz = (nM - fm) < WGM ? (nM - fm) : WGM;
        u.pm = fm + ((wgid % nig) % gsz); u.pn = (wgid % nig) / gsz; return true;
    }
    __device__ __forceinline__ void a_ready(const Unit&) const {}
    __device__ __forceinline__ void done(const Unit&) const {}
};

__device__ __forceinline__ unsigned cvt_pk_bf16(float lo, float hi) { unsigned r; asm volatile("v_cvt_pk_bf16_f32 %0, %1, %2" : "=v"(r) : "v"(lo), "v"(hi)); return r; }
typedef float f32x2 __attribute__((ext_vector_type(2)));
template <class Epi, class Sched, bool ALIGN_EPI = false, bool SP2 = false, bool GATHER = false>
__device__ __forceinline__ void gemm_phase(PG8_LAS unsigned char* lds, const Gemm g, const Sched& S, const Epi& E, int tid_in, const int* gidx = nullptr) {
    static_assert(!GATHER || SP2, "the gather variant is written for the SP2 loop");
    int tid_ = tid_in; asm volatile("" : "+v"(tid_));
    const int tid = tid_, wid = __builtin_amdgcn_readfirstlane(tid >> 6), lane = tid & 63, wr = wid >> 2, wc = wid & 3, fr = lane & 15, fq = lane >> 4;
    const int K = g.K, nt = K / BK;
    unsigned voffA[2], voffB[2];
#pragma unroll
    for (int i = 0; i < 2; ++i) { int R, C; stage_rc(tid * 16 + i * 8192, R, C); const int Rb = Epi::PERM ? ((R & ~31) + perm32(R & 31)) : R;
        voffA[i] = (unsigned)(R * K + C) * 2u; voffB[i] = (unsigned)(Rb * K + C) * 2u; }
    int gRA[2] = {0, 0}; unsigned gCA[2] = {0u, 0u}; unsigned gc[2][2] = {{0u, 0u}, {0u, 0u}}, gn[2][2] = {{0u, 0u}, {0u, 0u}};
    if constexpr (GATHER) {
#pragma unroll
        for (int i = 0; i < 2; ++i) { int R, C; stage_rc(tid * 16 + i * 8192, R, C); gRA[i] = R; gCA[i] = (unsigned)C * 2u; } }
#define PG8_GLOAD(dst, un) do { _Pragma("unroll") for (int h_ = 0; h_ < 2; ++h_) _Pragma("unroll") for (int i_ = 0; i_ < 2; ++i_) \
        dst[h_][i_] = (unsigned)gidx[(un).pm * 256 + h_ * 128 + gRA[i_]] * (unsigned)(K * 2) + gCA[i_]; } while (0)
#define PG8_STAGE_G(bufoff, gbase, nx, h) do { unsigned vo_[2] = {(nx) ? gn[h][0] : gc[h][0], (nx) ? gn[h][1] : gc[h][1]}; PG8_STAGE(bufoff, gbase, vo_); } while (0)
    const size_t kstep = (size_t)(BK * 2);
    const size_t hstep = (size_t)HALF * K * 2;
    const size_t tstep = 2 * hstep;
    const unsigned ldsw = (unsigned)wid * 1024u;
    const int aoff = lds_byte(wr * 64 + fr, fq * 8), boff = lds_byte(wc * 32 + fr, fq * 8);
#define PG8_SA(b, h) (((b) * 2 + (h)) * HTB)
#define PG8_SB(b, h) ((4 + (b) * 2 + (h)) * HTB)
#define PG8_STAGE(bufoff, gbase, voff) do { _Pragma("unroll") for (int _i = 0; _i < 2; ++_i) \
        __builtin_amdgcn_global_load_lds((const unsigned*)((const char*)(gbase) + (voff)[_i]), (PG8_LAS unsigned*)(lds + (bufoff) + ldsw + _i * 8192), 16, 0, 0); } while (0)
#define PG8_LDA(dst, b, h) do { _Pragma("unroll") for (int m = 0; m < 4; ++m) _Pragma("unroll") for (int k = 0; k < 2; ++k) dst[m][k] = *(const PG8_LAS bf16x8*)(lds + PG8_SA(b, h) + aoff + m * 2048 + k * 1024); } while (0)
#define PG8_LDB(dst, b, h) do { _Pragma("unroll") for (int n = 0; n < 2; ++n) _Pragma("unroll") for (int k = 0; k < 2; ++k) dst[n][k] = *(const PG8_LAS bf16x8*)(lds + PG8_SB(b, h) + boff + n * 2048 + k * 1024); } while (0)
#define PG8_MMA(ai, bj, At, Bt) do { __builtin_amdgcn_s_setprio(1); _Pragma("unroll") for (int m = 0; m < 4; ++m) _Pragma("unroll") for (int n = 0; n < 2; ++n) _Pragma("unroll") for (int k = 0; k < 2; ++k) \
        acc[ai][bj][m][n] = __builtin_amdgcn_mfma_f32_16x16x32_bf16(Bt[n][k], At[m][k], acc[ai][bj][m][n], 0, 0, 0); __builtin_amdgcn_s_setprio(0); } while (0)
#define PG8_WAIT_V(n) asm volatile("s_waitcnt vmcnt(" #n ")" ::: "memory")
#define PG8_WAIT_L(n) asm volatile("s_waitcnt lgkmcnt(" #n ")" ::: "memory")
#define PG8_BAR __builtin_amdgcn_s_barrier()
#define PG8_SCHED __builtin_amdgcn_sched_barrier(0)
    Unit cur, nxt; int ui = 0;
    if (!S.next(0, cur)) return;
    f32x4 acc[2][2][4][2];
#pragma unroll
    for (int a = 0; a < 2; ++a)
#pragma unroll
        for (int b = 0; b < 2; ++b)
#pragma unroll
            for (int m = 0; m < 4; ++m)
#pragma unroll
                for (int n = 0; n < 2; ++n) acc[a][b][m][n] = (f32x4){0.f, 0.f, 0.f, 0.f};
    bf16x8 At[4][2], B0[2][2], B1[2][2];
    const char* cA = GATHER ? (const char*)g.A : (const char*)g.A + (size_t)cur.pm * tstep; const char* cB = (const char*)g.Bt + (size_t)cur.pn * tstep;
    if constexpr (GATHER) { PG8_GLOAD(gc, cur); Unit n1_; if (S.next(1, n1_)) PG8_GLOAD(gn, n1_); else { gn[0][0] = gc[0][0]; gn[0][1] = gc[0][1]; gn[1][0] = gc[1][0]; gn[1][1] = gc[1][1]; } }
    S.a_ready(cur);
    if constexpr (SP2) {
        PG8_STAGE(PG8_SB(0, 0), cB, voffB); PG8_STAGE(PG8_SB(0, 1), cB + hstep, voffB);
        if constexpr (GATHER) { PG8_STAGE_G(PG8_SA(0, 0), cA, false, 0); PG8_STAGE_G(PG8_SA(0, 1), cA, false, 1); } else { PG8_STAGE(PG8_SA(0, 0), cA, voffA); PG8_STAGE(PG8_SA(0, 1), cA + hstep, voffA); }
        if (wr == 1) PG8_BAR;
        PG8_WAIT_V(2); PG8_BAR;
        PG8_STAGE(PG8_SB(1, 0), cB + kstep, voffB); if constexpr (GATHER) PG8_STAGE_G(PG8_SA(1, 0), cA + kstep, false, 0); else PG8_STAGE(PG8_SA(1, 0), cA + kstep, voffA); PG8_STAGE(PG8_SB(1, 1), cB + hstep + kstep, voffB);
        PG8_WAIT_V(6); PG8_BAR;
    } else {
        PG8_STAGE(PG8_SB(0, 0), cB, voffB); PG8_STAGE(PG8_SA(0, 0), cA, voffA); PG8_STAGE(PG8_SB(0, 1), cB + hstep, voffB); PG8_STAGE(PG8_SA(0, 1), cA + hstep, voffA);
        if (wr == 1) PG8_BAR;
        PG8_WAIT_V(4); PG8_BAR;
        PG8_STAGE(PG8_SB(1, 0), cB + kstep, voffB); PG8_STAGE(PG8_SA(1, 0), cA + kstep, voffA); PG8_STAGE(PG8_SB(1, 1), cB + hstep + kstep, voffB);
        PG8_WAIT_V(6); PG8_BAR;
    }
    for (;;) {
        const bool has_next = S.next(ui + 1, nxt);
        if constexpr (GATHER) { if (!has_next) { gn[0][0] = gc[0][0]; gn[0][1] = gc[0][1]; gn[1][0] = gc[1][0]; gn[1][1] = gc[1][1]; } }
        const char* nA = (has_next && !GATHER) ? (const char*)g.A + (size_t)nxt.pm * tstep : cA; const char* nB = has_next ? (const char*)g.Bt + (size_t)nxt.pn * tstep : cB;
        for (int t = 0; t < nt; t += 2) {
            const bool last = (t == nt - 2);
            const char* a1 = cA + (size_t)(t + 1) * kstep;
            const char* a2 = last ? nA : cA + (size_t)(t + 2) * kstep; const char* b2 = last ? nB : cB + (size_t)(t + 2) * kstep;
            const char* a3 = a2 + kstep; const char* b3 = b2 + kstep;
            if (last && has_next) S.a_ready(nxt);
            if constexpr (SP2) {
            PG8_LDB(B0, 0, 0); PG8_LDB(B1, 0, 1); PG8_SCHED; PG8_LDA(At, 0, 0); if constexpr (GATHER) PG8_STAGE_G(PG8_SA(1, 1), a1, false, 1); else PG8_STAGE(PG8_SA(1, 1), a1 + hstep, voffA);
            PG8_WAIT_V(8); PG8_WAIT_L(0); PG8_BAR; PG8_MMA(0, 0, At, B0); PG8_MMA(0, 1, At, B1); PG8_BAR; PG8_SCHED;
            PG8_LDA(At, 0, 1); PG8_STAGE(PG8_SB(0, 0), b2, voffB); PG8_STAGE(PG8_SB(0, 1), b2 + hstep, voffB); if constexpr (GATHER) PG8_STAGE_G(PG8_SA(0, 0), a2, last, 0); else PG8_STAGE(PG8_SA(0, 0), a2, voffA);
            PG8_WAIT_V(8); PG8_WAIT_L(0); PG8_BAR; PG8_MMA(1, 0, At, B0); PG8_MMA(1, 1, At, B1); PG8_BAR; PG8_SCHED;
            PG8_LDB(B0, 1, 0); PG8_LDB(B1, 1, 1); PG8_SCHED; PG8_LDA(At, 1, 0); if constexpr (GATHER) PG8_STAGE_G(PG8_SA(0, 1), a2, last, 1); else PG8_STAGE(PG8_SA(0, 1), a2 + hstep, voffA);
            PG8_WAIT_V(8); PG8_WAIT_L(0); PG8_BAR; PG8_MMA(0, 0, At, B0); PG8_MMA(0, 1, At, B1); PG8_BAR; PG8_SCHED;
            PG8_LDA(At, 1, 1); PG8_STAGE(PG8_SB(1, 0), b3, voffB); PG8_STAGE(PG8_SB(1, 1), b3 + hstep, voffB); if constexpr (GATHER) PG8_STAGE_G(PG8_SA(1, 0), a3, last, 0); else PG8_STAGE(PG8_SA(1, 0), a3, voffA);
            PG8_WAIT_V(8); PG8_WAIT_L(0); PG8_BAR; PG8_MMA(1, 0, At, B0); PG8_MMA(1, 1, At, B1); PG8_BAR; PG8_SCHED;
            } else {
            PG8_LDB(B0, 0, 0); PG8_SCHED; PG8_LDA(At, 0, 0); PG8_STAGE(PG8_SA(1, 1), a1 + hstep, voffA);
            PG8_WAIT_L(8); PG8_BAR; PG8_WAIT_L(0); PG8_MMA(0, 0, At, B0); PG8_BAR; PG8_SCHED;
            PG8_LDB(B1, 0, 1); PG8_STAGE(PG8_SB(0, 0), b2, voffB);
            PG8_BAR; PG8_WAIT_L(0); PG8_MMA(0, 1, At, B1); PG8_BAR;
            PG8_LDA(At, 0, 1); PG8_STAGE(PG8_SA(0, 0), a2, voffA);
            PG8_BAR; PG8_WAIT_L(0); PG8_MMA(1, 0, At, B0); PG8_BAR; PG8_SCHED;
            PG8_STAGE(PG8_SB(0, 1), b2 + hstep, voffB);
            PG8_WAIT_V(6); PG8_BAR; PG8_MMA(1, 1, At, B1); PG8_BAR;
            PG8_LDB(B0, 1, 0); PG8_SCHED; PG8_LDA(At, 1, 0); PG8_STAGE(PG8_SA(0, 1), a2 + hstep, voffA);
            PG8_WAIT_L(8); PG8_BAR; PG8_WAIT_L(0); PG8_MMA(0, 0, At, B0); PG8_BAR; PG8_SCHED;
            PG8_LDB(B1, 1, 1); PG8_STAGE(PG8_SB(1, 0), b3, voffB);
            PG8_BAR; PG8_WAIT_L(0); PG8_MMA(0, 1, At, B1); PG8_BAR;
            PG8_LDA(At, 1, 1); PG8_STAGE(PG8_SA(1, 0), a3, voffA);
            PG8_BAR; PG8_WAIT_L(0); PG8_MMA(1, 0, At, B0); PG8_BAR; PG8_SCHED;
            PG8_STAGE(PG8_SB(1, 1), b3 + hstep, voffB);
            PG8_WAIT_V(6); PG8_BAR; PG8_MMA(1, 1, At, B1); PG8_BAR;
            }
        }
        if constexpr (ALIGN_EPI) { if (wr == 0) PG8_BAR; }
#ifdef REP_EPI
        if constexpr (!Epi::AFTER_DRAIN) { E(acc, cur, wr, wc, fr, fq); asm volatile("" ::: "memory"); }
#endif
        if constexpr (!Epi::AFTER_DRAIN) { E(acc, cur, wr, wc, fr, fq); S.done(cur); }
        unsigned g2_[2][2] = {{0u, 0u}, {0u, 0u}};
        if constexpr (GATHER) { Unit nn_; if (has_next && S.next(ui + 2, nn_)) PG8_GLOAD(g2_, nn_); else { g2_[0][0] = gn[0][0]; g2_[0][1] = gn[0][1]; g2_[1][0] = gn[1][0]; g2_[1][1] = gn[1][1]; } }
        if (!has_next) break;
#pragma unroll
        for (int a = 0; a < 2; ++a)
#pragma unroll
            for (int b = 0; b < 2; ++b)
#pragma unroll
                for (int m = 0; m < 4; ++m)
#pragma unroll
                    for (int n = 0; n < 2; ++n) acc[a][b][m][n] = (f32x4){0.f, 0.f, 0.f, 0.f};
        cur = nxt; cA = nA; cB = nB; ++ui;
        if constexpr (GATHER) { gc[0][0] = gn[0][0]; gc[0][1] = gn[0][1]; gc[1][0] = gn[1][0]; gc[1][1] = gn[1][1]; gn[0][0] = g2_[0][0]; gn[0][1] = g2_[0][1]; gn[1][0] = g2_[1][0]; gn[1][1] = g2_[1][1]; }
        if constexpr (ALIGN_EPI) { if (wr == 1) PG8_BAR; }
    }
    PG8_WAIT_V(0);
    if constexpr (!ALIGN_EPI) { if (wr == 0) PG8_BAR; }
    PG8_BAR;
    if constexpr (Epi::AFTER_DRAIN) { E.fused(acc, cur, wr, wc, fr, fq, lds, wid, lane); S.done(cur); }
#undef PG8_SA
#undef PG8_SB
#undef PG8_STAGE
#undef PG8_STAGE_G
#undef PG8_GLOAD
#undef PG8_LDA
#undef PG8_LDB
#undef PG8_MMA
#undef PG8_WAIT_V
#undef PG8_WAIT_L
#undef PG8_BAR
#undef PG8_SCHED
}
}

#ifndef ONE_LAUNCH
#define ONE_LAUNCH 1
#endif
constexpr int NB = 16, T = 2048, D = 1024, M = NB * T;
constexpr int NZ = 4736, NZP = 4864;
constexpr int RW = 512, NE = 16, CAP = 256, ME = NE * NB * CAP;
constexpr int ZR = 0, ZK = 512, ZV = 1024, ZWD = 1536, ZAD = 1664, ZGD = 1792, ZQ = 1920, ZKA = 2432, ZVA = 2560, ZGA = 2688, ZGB = 3712;
constexpr int NWAVES = 8, NPHASE = 14;
constexpr size_t MiB = 1u << 20;
constexpr size_t WS_CTL = 0, CTL_ZERO_BYTES = 64 * 1024 + 16 * 6144 * 4;
constexpr size_t WS_MOD = 64 * 1024, WS_BONUS = 2 * MiB, WS_AFF = 4 * MiB, WS_SELAFF = 6 * MiB, WS_SLOT = 7 * MiB, WS_G2T = 9 * MiB;
constexpr size_t WS_WINT = 10 * MiB, WS_PRT = 20 * MiB, WS_PAT = 21 * MiB, WS_WOT = 22 * MiB, WS_SGD = 24 * MiB;
constexpr size_t WS_XN = 40 * MiB;
constexpr size_t WS_OATT = 104 * MiB;
constexpr size_t WS_G = 136 * MiB;
constexpr size_t WS_Z = 168 * MiB;
constexpr size_t WS_X1 = 104 * MiB;
constexpr size_t OUT_WGUT = 0;
constexpr size_t OUT_WDT = 64 * MiB;
constexpr size_t WS_XE = 200 * MiB;
constexpr size_t WS_H = 328 * MiB;
constexpr size_t WS_END = 464 * MiB;
constexpr size_t WS_ROPE = WS_AFF;
constexpr size_t WS_SELIDX = WS_SELAFF + 512 * 1024;
constexpr int CW_BAR = 4096;
constexpr int RING_BYTES = 131072, LDSCTL_OFF = RING_BYTES, MISC_OFF = LDSCTL_OFF + 320, LDS_BYTES = 147456;

#define GAS __attribute__((address_space(1)))
#define LAS __attribute__((address_space(3)))
typedef unsigned short bf16;
typedef unsigned v4u __attribute__((ext_vector_type(4)));
typedef float f32x4 __attribute__((ext_vector_type(4)));
typedef short bf16x8 __attribute__((ext_vector_type(8)));
typedef GAS unsigned gu32;
typedef GAS unsigned long long gu64;
#define RLX_AGENT __ATOMIC_RELAXED, __HIP_MEMORY_SCOPE_AGENT
#define LDS_WAIT() asm volatile("s_waitcnt lgkmcnt(0)" ::: "memory")
#define VM_WAIT() asm volatile("s_waitcnt vmcnt(0)" ::: "memory")
__device__ __forceinline__ unsigned long long rt() { return __builtin_amdgcn_s_memrealtime(); }
__device__ __forceinline__ unsigned f2bf(float f) { unsigned u = __builtin_bit_cast(unsigned, f); return (u + 0x7fffu + ((u >> 16) & 1u)) >> 16; }
typedef float f32x2hw __attribute__((ext_vector_type(2))); typedef __bf16 bf16x2hw __attribute__((ext_vector_type(2)));
__device__ __forceinline__ unsigned pk2(float lo, float hi) { f32x2hw v = {lo, hi}; bf16x2hw b = __builtin_convertvector(v, bf16x2hw); return __builtin_bit_cast(unsigned, b); }

#define XB_TMO      128
#define XB_XCNT(j)  (256  + 64 * (j))
#define XB_XSUB(j)  (1280 + 64 * (j))
#define XB_XGEN(j)  (2304 + 64 * (j))
#define XB_TOP      3328
#define XB_TOPGEN   3392
#define XCD_BAR_WORDS 3456
#define XB_SPIN_CAP (1u << 18)

__device__ __forceinline__ unsigned xb_ld(unsigned* p)              { return __hip_atomic_load(p, __ATOMIC_RELAXED, __HIP_MEMORY_SCOPE_AGENT); }
__device__ __forceinline__ unsigned xb_add(unsigned* p, unsigned v) { return __hip_atomic_fetch_add(p, v, __ATOMIC_RELAXED, __HIP_MEMORY_SCOPE_AGENT); }
__device__ __forceinline__ unsigned xb_xcc_id() { return (unsigned)__builtin_amdgcn_s_getreg((3 << 11) | 20) & 0xFu; }
#define XB_SPIN(cond, bar) do { unsigned _sp = 0; while (cond) { __builtin_amdgcn_s_sleep(1); \
    if ((++_sp & 255u) == 0u) { if (xb_ld(&(bar)[XB_TMO])) break; if (_sp > XB_SPIN_CAP) { atomicAdd(&(bar)[XB_TMO], 1u); break; } } } } while (0)

struct XcdBarrier {
    unsigned* bar; unsigned x;
    volatile LAS unsigned* st;
};

__device__ __forceinline__ XcdBarrier xcd_barrier_post(unsigned* bar, volatile LAS unsigned* st) {
    XcdBarrier b; b.bar = bar; b.x = xb_xcc_id(); b.st = st;
    if (threadIdx.x == 0) (void)xb_add(&bar[XB_XCNT(b.x)], 1u);
    return b;
}
__device__ __forceinline__ void xcd_barrier_complete(unsigned* bar, unsigned x, unsigned& nloc, unsigned& nx) {
    const unsigned G = gridDim.x * gridDim.y * gridDim.z;
    unsigned sum, cnt, mine, sp = 0u;
    for (;;) {
        sum = 0u; cnt = 0u; mine = 0u;
#pragma unroll
        for (unsigned j = 0; j < 16; ++j) { const unsigned c = xb_ld(&bar[XB_XCNT(j)]); sum += c; cnt += (c > 0u) ? 1u : 0u; mine = (j == x) ? c : mine; }
        if (sum == G) break;
        __builtin_amdgcn_s_sleep(1);
        if ((++sp & 255u) == 0u) { if (xb_ld(&bar[XB_TMO])) break; if (sp > XB_SPIN_CAP) { atomicAdd(&bar[XB_TMO], 1u); break; } }
    }
    nloc = mine > 0u ? mine : 1u; nx = cnt > 0u ? cnt : 1u;
}

__device__ __forceinline__ void xcd_barrier_t0(const XcdBarrier& b) {
    {
        unsigned* bar = b.bar;
        __builtin_amdgcn_s_waitcnt(0);
        unsigned nloc = b.st[0], nx = b.st[1];
        if (nloc == 0u) { xcd_barrier_complete(bar, b.x, nloc, nx); b.st[0] = nloc; b.st[1] = nx; }
        const unsigned old = xb_add(&bar[XB_XSUB(b.x)], 1u);
        const unsigned gen = old / nloc;
        if (old + 1u == (gen + 1u) * nloc) {
            __builtin_amdgcn_fence(__ATOMIC_RELEASE, "agent");
            asm volatile("s_waitcnt vmcnt(0)" ::: "memory");
            const unsigned og = xb_add(&bar[XB_TOP], 1u);
            const unsigned tg = og / nx;
            if (og + 1u == (tg + 1u) * nx) xb_add(&bar[XB_TOPGEN], 1u);
            else XB_SPIN(xb_ld(&bar[XB_TOPGEN]) == tg, bar);
            __builtin_amdgcn_fence(__ATOMIC_ACQUIRE, "agent");
            xb_add(&bar[XB_XGEN(b.x)], 1u);
            asm volatile("s_waitcnt vmcnt(0)" ::: "memory");
        } else {
            XB_SPIN(xb_ld(&bar[XB_XGEN(b.x)]) == gen, bar);
            __builtin_amdgcn_fence(__ATOMIC_ACQUIRE, "agent");
            asm volatile("s_waitcnt vmcnt(0)" ::: "memory");
        }
    }
}
__device__ __forceinline__ void xcd_barrier(const XcdBarrier& b, bool is_thread0) {
    asm volatile("s_waitcnt vmcnt(0)" ::: "memory");
    __syncthreads();
    if (is_thread0) xcd_barrier_t0(b);
    __syncthreads();
}
namespace pg8 {
__device__ __forceinline__ float bf2f(unsigned short h) { return __uint_as_float(((unsigned)h) << 16); }
__device__ __forceinline__ float bflo(unsigned w) { return __uint_as_float(w << 16); }
__device__ __forceinline__ float bfhi(unsigned w) { return __uint_as_float(w & 0xffff0000u); }
__device__ __forceinline__ float sigm(float x) { return 1.0f / (1.0f + __expf(-x)); }
struct EpiZ { static constexpr bool PERM = true, AFTER_DRAIN = false; bf16_t* O;
    __device__ __forceinline__ void operator()(const f32x4 (&acc)[2][2][4][2], const Unit& u, int wr, int wc, int fr, int fq) const {
        const int row0 = u.pm * BM + wr * 64 + fr, col0 = u.pn * BM + wc * 32 + 8 * fq;
#pragma unroll
        for (int ai = 0; ai < 2; ++ai)
#pragma unroll
            for (int m = 0; m < 4; ++m) { bf16_t* rowp = O + (size_t)(row0 + ai * HALF + m * 16) * 4736 + col0;
#pragma unroll
                for (int bj = 0; bj < 2; ++bj) { if (u.pn * BM + bj * HALF < 4736) { const f32x4 v0 = acc[ai][bj][m][0], v1 = acc[ai][bj][m][1];
                    u32x4 w; w.x = cvt_pk_bf16(v0[0], v0[1]); w.y = cvt_pk_bf16(v0[2], v0[3]); w.z = cvt_pk_bf16(v1[0], v1[1]); w.w = cvt_pk_bf16(v1[2], v1[3]);
                    *(u32x4*)(rowp + bj * HALF) = w; } } }
    }
};
struct EpiPlain { static constexpr bool PERM = true, AFTER_DRAIN = false; bf16_t* O; int ldc;
    __device__ __forceinline__ void operator()(const f32x4 (&acc)[2][2][4][2], const Unit& u, int wr, int wc, int fr, int fq) const {
        const int row0 = u.pm * BM + wr * 64 + fr, col0 = u.pn * BM + wc * 32 + 8 * fq;
#pragma unroll
        for (int ai = 0; ai < 2; ++ai)
#pragma unroll
            for (int m = 0; m < 4; ++m) { bf16_t* rowp = O + (size_t)(row0 + ai * HALF + m * 16) * ldc + col0;
#pragma unroll
                for (int bj = 0; bj < 2; ++bj) { const f32x4 v0 = acc[ai][bj][m][0], v1 = acc[ai][bj][m][1];
                    u32x4 w; w.x = cvt_pk_bf16(v0[0], v0[1]); w.y = cvt_pk_bf16(v0[2], v0[3]); w.z = cvt_pk_bf16(v1[0], v1[1]); w.w = cvt_pk_bf16(v1[2], v1[3]);
                    *(u32x4*)(rowp + bj * HALF) = w; } }
    }
};
template <bool ADD> struct EpiGate { static constexpr bool PERM = true, AFTER_DRAIN = false; bf16_t* O; const bf16_t* Z; int zc0;
    __device__ __forceinline__ void operator()(const f32x4 (&acc)[2][2][4][2], const Unit& u, int wr, int wc, int fr, int fq) const {
        const int row0 = u.pm * BM + wr * 64 + fr, col0 = u.pn * BM + wc * 32 + 8 * fq;
#pragma unroll
        for (int ai = 0; ai < 2; ++ai)
#pragma unroll
            for (int m = 0; m < 4; ++m) { const size_t row = (size_t)(row0 + ai * HALF + m * 16); bf16_t* rowp = O + row * 1024 + col0; const bf16_t* zp = Z + row * 4736 + zc0 + col0;
#pragma unroll
                for (int bj = 0; bj < 2; ++bj) { const f32x4 v0 = acc[ai][bj][m][0], v1 = acc[ai][bj][m][1];
                    const u32x4 zg = *(const u32x4*)(zp + bj * HALF);
                    float r0 = sigm(bflo(zg.x)) * v0[0], r1 = sigm(bfhi(zg.x)) * v0[1], r2 = sigm(bflo(zg.y)) * v0[2], r3 = sigm(bfhi(zg.y)) * v0[3];
                    float r4 = sigm(bflo(zg.z)) * v1[0], r5 = sigm(bfhi(zg.z)) * v1[1], r6 = sigm(bflo(zg.w)) * v1[2], r7 = sigm(bfhi(zg.w)) * v1[3];
                    if (ADD) { const u32x4 p = *(const u32x4*)(rowp + bj * HALF);
                        r0 += bflo(p.x); r1 += bfhi(p.x); r2 += bflo(p.y); r3 += bfhi(p.y); r4 += bflo(p.z); r5 += bfhi(p.z); r6 += bflo(p.w); r7 += bfhi(p.w); }
                    u32x4 w; w.x = cvt_pk_bf16(r0, r1); w.y = cvt_pk_bf16(r2, r3); w.z = cvt_pk_bf16(r4, r5); w.w = cvt_pk_bf16(r6, r7);
                    *(u32x4*)(rowp + bj * HALF) = w; } }
    }
};
struct EpiGate2 { static constexpr bool PERM = true, AFTER_DRAIN = false; bf16_t* O; const bf16_t* Z;
    __device__ __forceinline__ void operator()(const f32x4 (&acc)[2][2][4][2], const Unit& u, int wr, int wc, int fr, int fq) const {
        const bool add = u.pm < 128; const int zc0 = add ? 3712 : 2688;
        const int row0 = (u.pm & 127) * BM + wr * 64 + fr, col0 = (u.pn & 3) * BM + wc * 32 + 8 * fq;
#pragma unroll
        for (int ai = 0; ai < 2; ++ai) {
            u32x4 zg[4][2], pv[4][2];
#pragma unroll
            for (int m = 0; m < 4; ++m) { const size_t row = (size_t)(row0 + ai * HALF + m * 16);
#pragma unroll
                for (int bj = 0; bj < 2; ++bj) { zg[m][bj] = *(const u32x4*)(Z + row * 4736 + zc0 + col0 + bj * HALF); pv[m][bj] = (u32x4){0u, 0u, 0u, 0u}; if (add) pv[m][bj] = *(const u32x4*)(O + row * 1024 + col0 + bj * HALF); } }
#pragma unroll
            for (int m = 0; m < 4; ++m) { const size_t row = (size_t)(row0 + ai * HALF + m * 16); bf16_t* rowp = O + row * 1024 + col0;
#pragma unroll
                for (int bj = 0; bj < 2; ++bj) { const f32x4 v0 = acc[ai][bj][m][0], v1 = acc[ai][bj][m][1]; const u32x4 g = zg[m][bj], p = pv[m][bj];
                    const float r0 = sigm(bflo(g.x)) * v0[0] + bflo(p.x), r1 = sigm(bfhi(g.x)) * v0[1] + bfhi(p.x), r2 = sigm(bflo(g.y)) * v0[2] + bflo(p.y), r3 = sigm(bfhi(g.y)) * v0[3] + bfhi(p.y);
                    const float r4 = sigm(bflo(g.z)) * v1[0] + bflo(p.z), r5 = sigm(bfhi(g.z)) * v1[1] + bfhi(p.z), r6 = sigm(bflo(g.w)) * v1[2] + bflo(p.w), r7 = sigm(bfhi(g.w)) * v1[3] + bfhi(p.w);
                    u32x4 w; w.x = cvt_pk_bf16(r0, r1); w.y = cvt_pk_bf16(r2, r3); w.z = cvt_pk_bf16(r4, r5); w.w = cvt_pk_bf16(r6, r7);
                    *(u32x4*)(rowp + bj * HALF) = w; } } }
    }
};
struct MergeOrder { StaticOrder S; int nu;
    __device__ __forceinline__ void init(int G, int c) { S.init(32768, 1024, G, c); nu = (512 - c + G - 1) / G; }
    __device__ __forceinline__ bool next(int i, Unit& u) const { if (i >= 2 * nu) return false; Unit t; S.next(i < nu ? i : i - nu, t);
        if (i < nu) { u.pm = 128 + t.pm; u.pn = t.pn; } else { u.pm = t.pm; u.pn = 4 + t.pn; } return true; }
    __device__ __forceinline__ void a_ready(const Unit&) const {}
    __device__ __forceinline__ void done(const Unit&) const {}
};
struct EpiRes { static constexpr bool PERM = true, AFTER_DRAIN = false; const float* X; const float* mod; bf16_t* O;
    __device__ __forceinline__ void operator()(const f32x4 (&acc)[2][2][4][2], const Unit& u, int wr, int wc, int fr, int fq) const {
        const int row0 = u.pm * BM + wr * 64 + fr, col0 = u.pn * BM + wc * 32 + 8 * fq; const int b = (u.pm * BM) >> 11;
        f32x4 gt[2][2];
#pragma unroll
        for (int bj = 0; bj < 2; ++bj)
#pragma unroll
            for (int n = 0; n < 2; ++n) gt[bj][n] = *(const f32x4*)(mod + (size_t)b * 6144 + 2048 + col0 + bj * HALF + n * 4);
#pragma unroll
        for (int ai = 0; ai < 2; ++ai) { f32x4 xv[4][2][2];
#pragma unroll
            for (int m = 0; m < 4; ++m) { const size_t off = (size_t)(row0 + ai * HALF + m * 16) * 1024 + col0;
#pragma unroll
                for (int bj = 0; bj < 2; ++bj) { xv[m][bj][0] = *(const f32x4*)(X + off + bj * HALF); xv[m][bj][1] = *(const f32x4*)(X + off + bj * HALF + 4); } }
#pragma unroll
            for (int m = 0; m < 4; ++m) { const size_t off = (size_t)(row0 + ai * HALF + m * 16) * 1024 + col0;
#pragma unroll
                for (int bj = 0; bj < 2; ++bj) { const f32x4 v0 = xv[m][bj][0] + gt[bj][0] * acc[ai][bj][m][0], v1 = xv[m][bj][1] + gt[bj][1] * acc[ai][bj][m][1];
                    u32x4 w; w.x = cvt_pk_bf16(v0[0], v0[1]); w.y = cvt_pk_bf16(v0[2], v0[3]); w.z = cvt_pk_bf16(v1[0], v1[1]); w.w = cvt_pk_bf16(v1[2], v1[3]);
                    *(u32x4*)(O + off + bj * HALF) = w; } } }
    }
};
template <int NPL> struct GroupOrder { int G, c;
    __device__ __forceinline__ bool next(int i, Unit& u) const { const int L = i * G + c; if (L >= 256 * NPL) return false;
        if (G == 256) {
            const int q = i * 32 + (c >> 3), e = (c & 7) * 2 + q / (16 * NPL), r = q % (16 * NPL), rho = r >> 5, j = r & 31;
            u.pm = e * 16 + (rho & 1) * 8 + (j & 7); u.pn = e * NPL + (rho >> 1) * 4 + (j >> 3); return true; }
        const int e = L / (16 * NPL), r = L % (16 * NPL); u.pm = e * 16 + (r % 16); u.pn = e * NPL + r / 16; return true; }
    __device__ __forceinline__ void a_ready(const Unit&) const {}
    __device__ __forceinline__ void done(const Unit&) const {}
};
struct EpiSwiglu { static constexpr bool PERM = true, AFTER_DRAIN = false; bf16_t* O;
    __device__ __forceinline__ void operator()(const f32x4 (&acc)[2][2][4][2], const Unit& u, int wr, int wc, int fr, int fq) const {
        const int row0 = u.pm * BM + wr * 64 + fr, col0 = (u.pn & 7) * 128 + wc * 32 + 8 * fq;
#pragma unroll
        for (int ai = 0; ai < 2; ++ai)
#pragma unroll
            for (int m = 0; m < 4; ++m) { bf16_t* rowp = O + (size_t)(row0 + ai * HALF + m * 16) * 1024 + col0;
                float r[8];
#pragma unroll
                for (int n = 0; n < 2; ++n)
#pragma unroll
                    for (int i = 0; i < 4; ++i) { const float g = acc[ai][0][m][n][i], up = acc[ai][1][m][n][i]; r[n * 4 + i] = g * sigm(g) * up; }
                u32x4 w; w.x = cvt_pk_bf16(r[0], r[1]); w.y = cvt_pk_bf16(r[2], r[3]); w.z = cvt_pk_bf16(r[4], r[5]); w.w = cvt_pk_bf16(r[6], r[7]);
                *(u32x4*)rowp = w; }
    }
};
struct EpiDown { static constexpr bool PERM = true, AFTER_DRAIN = false; bf16_t* O; const float* aff;
    __device__ __forceinline__ void operator()(const f32x4 (&acc)[2][2][4][2], const Unit& u, int wr, int wc, int fr, int fq) const {
        const int row0 = u.pm * BM + wr * 64 + fr, col0 = (u.pn & 3) * BM + wc * 32 + 8 * fq;
        float av[2][4];
#pragma unroll
        for (int ai = 0; ai < 2; ++ai)
#pragma unroll
            for (int m = 0; m < 4; ++m) av[ai][m] = aff[row0 + ai * HALF + m * 16];
#pragma unroll
        for (int ai = 0; ai < 2; ++ai)
#pragma unroll
            for (int m = 0; m < 4; ++m) { const int row = row0 + ai * HALF + m * 16; const float a = av[ai][m]; bf16_t* rowp = O + (size_t)row * 1024 + col0;
#pragma unroll
                for (int bj = 0; bj < 2; ++bj) { const f32x4 v0 = acc[ai][bj][m][0] * a, v1 = acc[ai][bj][m][1] * a;
                    u32x4 w; w.x = cvt_pk_bf16(v0[0], v0[1]); w.y = cvt_pk_bf16(v0[2], v0[3]); w.z = cvt_pk_bf16(v1[0], v1[1]); w.w = cvt_pk_bf16(v1[2], v1[3]);
                    *(u32x4*)(rowp + bj * HALF) = w; } }
    }
};
}

struct Frame { LAS unsigned char* lds; volatile LAS unsigned* MISC; gu32* ctl; int tid, lane, wave, vcu, G; };
struct Args { const void* in[30]; float* out; unsigned char* ws; int ph_lo, ph_hi; };
typedef const __attribute__((address_space(4))) Args* ArgsP;
#define LAUNDER(p) asm volatile("" : "+s"(p))
typedef float f32x16 __attribute__((ext_vector_type(16)));
typedef unsigned u32x2 __attribute__((ext_vector_type(2)));

__device__ __forceinline__ float wave_sum(float v) {
#pragma unroll
    for (int o = 1; o < 64; o <<= 1) v += __shfl_xor(v, o);
    return v;
}
__device__ __forceinline__ float bf2f(bf16 h) { return __uint_as_float(((unsigned)h) << 16); }
__device__ __forceinline__ float bflo(unsigned w) { return __uint_as_float(w << 16); }
__device__ __forceinline__ float bfhi(unsigned w) { return __uint_as_float(w & 0xffff0000u); }
__device__ __forceinline__ float sigm(float x) { return 1.0f / (1.0f + __expf(-x)); }

__device__ __forceinline__ void tr_load(f32x4 (&v)[8], const float* W, int N, int k0, int n0, int lane) {
#pragma unroll
    for (int i = 0; i < 8; ++i) v[i] = *(const GAS f32x4*)(W + (size_t)(k0 + 8 * i + (lane >> 3)) * N + n0 + 4 * (lane & 7));
}
__device__ __forceinline__ void tr_store(const f32x4 (&v)[8], int k0, bf16* WT, int KD, int dst_row0, LAS float* scr, int lane) {
#pragma unroll
    for (int i = 0; i < 8; ++i) { LAS float* d = scr + (8 * i + (lane >> 3)) * 33 + 4 * (lane & 7); d[0] = v[i].x; d[1] = v[i].y; d[2] = v[i].z; d[3] = v[i].w; }
    LDS_WAIT(); asm volatile("" ::: "memory");
    const int c = lane & 7;
#pragma unroll
    for (int j = 0; j < 4; ++j) { const int n = (lane >> 3) + 8 * j; const LAS float* s = scr + (8 * c) * 33 + n;
        v4u o; o.x = pk2(s[0 * 33], s[1 * 33]); o.y = pk2(s[2 * 33], s[3 * 33]); o.z = pk2(s[4 * 33], s[5 * 33]); o.w = pk2(s[6 * 33], s[7 * 33]);
        *(GAS v4u*)(WT + (size_t)(dst_row0 + n) * KD + k0 + 8 * c) = o; }
    LDS_WAIT(); asm volatile("" ::: "memory");
}
__device__ __forceinline__ void tr_item(const float* W, int N, int k0, int n0, bf16* WT, int KD, int dst_row0, LAS float* scr, int lane) {
    f32x4 v[8]; tr_load(v, W, N, k0, n0, lane); tr_store(v, k0, WT, KD, dst_row0, scr, lane);
}

__device__ __forceinline__ void p0_prologue(const Frame& F, ArgsP A) {
    unsigned char* ws = A->ws;
    LAS float* scr = (LAS float*)(F.lds + F.wave * 16384);
    const int gw = F.vcu * NWAVES + F.wave, NGW = F.G * NWAVES;
    const float* w_in = (const float*)A->in[6]; const float* p_rwkv = (const float*)A->in[22]; const float* p_attn = (const float*)A->in[23];
    const float* w_out = (const float*)A->in[24]; const float* g2 = (const float*)A->in[13];
    bf16* WinT = (bf16*)(ws + WS_WINT); bf16* PrT = (bf16*)(ws + WS_PRT); bf16* PaT = (bf16*)(ws + WS_PAT); bf16* WoT = (bf16*)(ws + WS_WOT); bf16* G2T = (bf16*)(ws + WS_G2T);
    constexpr int I_IN = 16 * 148, I_P = 8 * 32, I_O = 16 * 32, I_G = 2 * 16, NIT = I_IN + 2 * I_P + I_O + I_G;
    for (int it = gw; it < NIT; it += NGW) {
        int r = it;
        if (r < I_IN) { tr_item(w_in, NZ, 64 * (r / 148), 32 * (r % 148), WinT, 1024, 32 * (r % 148), scr, F.lane); continue; } r -= I_IN;
        if (r < I_P) { tr_item(p_rwkv, 1024, 64 * (r / 32), 32 * (r % 32), PrT, 512, 32 * (r % 32), scr, F.lane); continue; } r -= I_P;
        if (r < I_P) { tr_item(p_attn, 1024, 64 * (r / 32), 32 * (r % 32), PaT, 512, 32 * (r % 32), scr, F.lane); continue; } r -= I_P;
        if (r < I_O) { tr_item(w_out, 1024, 64 * (r / 32), 32 * (r % 32), WoT, 1024, 32 * (r % 32), scr, F.lane); continue; } r -= I_O;
        tr_item(g2, 512, 64 * (r / 16), 32 * (r % 16), G2T, 256, 32 * (r % 16), scr, F.lane);
    }
    { const int gt = (F.vcu * NWAVES + F.wave) * 64 + F.lane, NT = F.G * NWAVES * 64; const v4u z4 = {0u, 0u, 0u, 0u};
      for (int i = gt; i < 128 * 128; i += NT) *(GAS v4u*)(WinT + (size_t)4736 * 1024 + (size_t)i * 8) = z4;
      for (int i = gt; i < 512 * 16; i += NT) *(GAS v4u*)(G2T + (size_t)(i >> 4) * 256 + 128 + (i & 15) * 8) = z4; }
    __syncthreads();
    const float* cvec = (const float*)A->in[1]; const float* w_ada = (const float*)A->in[3]; const float* b_ada = (const float*)A->in[4];
    float* mod = (float*)(ws + WS_MOD);
    for (int task = F.vcu; task < 192; task += F.G) { const int cg = task % 96, dh = task / 96;
        LAS float* ca = (LAS float*)F.lds;
        LAS float* red = (LAS float*)(F.lds + 65536);
        for (int i = F.tid; i < 16 * 1024; i += 512) { const int b = i >> 10, d = i & 1023; const float cv = cvec[i]; ca[d * 16 + b] = cv / (1.0f + __expf(-cv)); }
        __syncthreads();
        float acc[16];
#pragma unroll
        for (int b = 0; b < 16; ++b) acc[b] = 0.f;
        const int col = cg * 64 + F.lane;
#pragma unroll 8
        for (int dd = 0; dd < 64; ++dd) { const int d = dh * 512 + F.wave * 64 + dd; const float w = w_ada[(size_t)d * 6144 + col];
            const LAS f32x4* cp = (const LAS f32x4*)(ca + d * 16);
#pragma unroll
            for (int q = 0; q < 4; ++q) { const f32x4 cv = cp[q]; acc[q * 4 + 0] += cv[0] * w; acc[q * 4 + 1] += cv[1] * w; acc[q * 4 + 2] += cv[2] * w; acc[q * 4 + 3] += cv[3] * w; } }
#pragma unroll
        for (int b = 0; b < 16; ++b) red[(F.wave * 16 + b) * 64 + F.lane] = acc[b];
        __syncthreads();
        for (int o = F.tid; o < 1024; o += 512) { const int b = o >> 6, cl = o & 63; float sacc = 0.f;
#pragma unroll
            for (int w = 0; w < 8; ++w) sacc += red[(w * 16 + b) * 64 + cl];
            atomicAdd(&mod[b * 6144 + cg * 64 + cl], sacc + (dh == 0 ? b_ada[cg * 64 + cl] : 0.f)); }
        __syncthreads();
    }
}


__device__ __forceinline__ float dpp_wave_sum(float v) {
    v += __int_as_float(__builtin_amdgcn_update_dpp(0, __float_as_int(v), 0xB1, 0xf, 0xf, false));
    v += __int_as_float(__builtin_amdgcn_update_dpp(0, __float_as_int(v), 0x4E, 0xf, 0xf, false));
    v += __int_as_float(__builtin_amdgcn_update_dpp(0, __float_as_int(v), 0x141, 0xf, 0xf, false));
    v += __int_as_float(__builtin_amdgcn_update_dpp(0, __float_as_int(v), 0x140, 0xf, 0xf, false));
    v += __int_as_float(__builtin_amdgcn_ds_swizzle(__float_as_int(v), 0x401F));
    auto r_ = __builtin_amdgcn_permlane32_swap(__float_as_uint(v), __float_as_uint(v), false, false);
    return __uint_as_float(r_[0]) + __uint_as_float(r_[1]); }

template <int R, bool XBF> __device__ __forceinline__ void modnorm_rows(const void* x, int m0, int mstride, const float* g, const float* mod, int sh_off, int sc_off, bf16* out, int lane, f32x4 (&u)[R][4]) {
    f32x4 v[R][4];
#pragma unroll
    for (int i = 0; i < R; ++i) {
        if (XBF) { const GAS u32x2* xr = (const GAS u32x2*)((const bf16*)x + (size_t)(m0 + i * mstride) * 1024) + lane;
#pragma unroll
            for (int j = 0; j < 4; ++j) { const u32x2 w = xr[64 * j]; v[i][j] = (f32x4){bflo(w.x), bfhi(w.x), bflo(w.y), bfhi(w.y)}; } }
        else { const GAS f32x4* xr = (const GAS f32x4*)((const float*)x + (size_t)(m0 + i * mstride) * 1024) + lane;
#pragma unroll
            for (int j = 0; j < 4; ++j) v[i][j] = xr[64 * j]; } }
    f32x4 gg[4];
#pragma unroll
    for (int j = 0; j < 4; ++j) gg[j] = ((const GAS f32x4*)g)[lane + 64 * j];
#pragma unroll
    for (int i = 0; i < R; ++i) { const int m = m0 + i * mstride, b = m >> 11; float s = 0.f;
#pragma unroll
        for (int j = 0; j < 4; ++j) s += (v[i][j].x * v[i][j].x + v[i][j].y * v[i][j].y) + (v[i][j].z * v[i][j].z + v[i][j].w * v[i][j].w);
        const float rs = rsqrtf(dpp_wave_sum(s) * (1.0f / 1024.0f) + 1e-6f);
        const float* sh = mod + (size_t)b * 6144 + sh_off; const float* sc = mod + (size_t)b * 6144 + sc_off;
        GAS unsigned long long* o8 = (GAS unsigned long long*)(out + (size_t)m * 1024) + lane;
#pragma unroll
        for (int j = 0; j < 4; ++j) { const f32x4 s1 = ((const GAS f32x4*)sc)[lane + 64 * j], s0 = ((const GAS f32x4*)sh)[lane + 64 * j];
            f32x4 y = (v[i][j] * rs) * gg[j]; y = y * (s1 + 1.0f) + s0; u[i][j] = y;
            o8[64 * j] = (unsigned long long)pk2(y.x, y.y) | ((unsigned long long)pk2(y.z, y.w) << 32); } }
}

template <int R> __device__ __forceinline__ void load_rows_bf16(const bf16* x, int m0, int mstride, int lane_in, u32x2 (&raw)[R][4]) {
    int lane = lane_in; asm volatile("" : "+v"(lane));
#pragma unroll
    for (int i = 0; i < R; ++i) { const GAS u32x2* xr = (const GAS u32x2*)(x + (size_t)(m0 + i * mstride) * 1024) + lane;
#pragma unroll
        for (int j = 0; j < 4; ++j) raw[i][j] = xr[64 * j]; }
}
template <int R> __device__ __forceinline__ void modnorm_rows_pre(const u32x2 (&raw)[R][4], int m0, int mstride, const float* g, const float* mod, int sh_off, int sc_off, bf16* out, int lane, f32x4 (&u)[R][4]) {
    f32x4 gg[4];
#pragma unroll
    for (int j = 0; j < 4; ++j) gg[j] = ((const GAS f32x4*)g)[lane + 64 * j];
#pragma unroll
    for (int i = 0; i < R; ++i) { const int m = m0 + i * mstride, b = m >> 11; float s = 0.f; f32x4 v[4];
#pragma unroll
        for (int j = 0; j < 4; ++j) { const u32x2 w = raw[i][j]; v[j] = (f32x4){bflo(w.x), bfhi(w.x), bflo(w.y), bfhi(w.y)}; s += (v[j].x * v[j].x + v[j].y * v[j].y) + (v[j].z * v[j].z + v[j].w * v[j].w); }
        const float rs = rsqrtf(dpp_wave_sum(s) * (1.0f / 1024.0f) + 1e-6f);
        const float* sh = mod + (size_t)b * 6144 + sh_off; const float* sc = mod + (size_t)b * 6144 + sc_off;
        GAS unsigned long long* o8 = (GAS unsigned long long*)(out + (size_t)m * 1024) + lane;
#pragma unroll
        for (int j = 0; j < 4; ++j) { const f32x4 s1 = ((const GAS f32x4*)sc)[lane + 64 * j], s0 = ((const GAS f32x4*)sh)[lane + 64 * j];
            f32x4 y = (v[j] * rs) * gg[j]; y = y * (s1 + 1.0f) + s0; u[i][j] = y;
            o8[64 * j] = (unsigned long long)pk2(y.x, y.y) | ((unsigned long long)pk2(y.z, y.w) << 32); } }
}

__device__ __forceinline__ void modnorm_row(const float* xrow, const float* g, const float* sh, const float* sc, bf16* orow, int lane, f32x4 (&u)[4]) {
    const GAS f32x4* xr = (const GAS f32x4*)xrow + lane;
    f32x4 v[4]; float s = 0.f;
#pragma unroll
    for (int j = 0; j < 4; ++j) { v[j] = xr[64 * j]; s += (v[j].x * v[j].x + v[j].y * v[j].y) + (v[j].z * v[j].z + v[j].w * v[j].w); }
    const float rs = rsqrtf(wave_sum(s) * (1.0f / 1024.0f) + 1e-6f);
    GAS unsigned long long* o8 = (GAS unsigned long long*)orow + lane;
#pragma unroll
    for (int j = 0; j < 4; ++j) { const f32x4 gg = ((const GAS f32x4*)g)[lane + 64 * j], s1 = ((const GAS f32x4*)sc)[lane + 64 * j], s0 = ((const GAS f32x4*)sh)[lane + 64 * j];
        f32x4 y = (v[j] * rs) * gg; y = y * (s1 + 1.0f) + s0; u[j] = y;
        o8[64 * j] = (unsigned long long)pk2(y.x, y.y) | ((unsigned long long)pk2(y.z, y.w) << 32); }
}

__device__ __forceinline__ float softplusf(float x) { return x > 20.f ? x : log1pf(__expf(x)); }
__device__ __forceinline__ void scan_chain(const Frame& F, ArgsP A, int b, int h, int dir) {
    constexpr int CT = 32;
    LAS float* L = (LAS float*)F.lds;
    LAS float* W2S = L; LAS float* A2S = L + 4096; LAS float* ZRs = L + 8192; LAS float* ZKs = ZRs + 2048; LAS float* ZVs = ZKs + 2048; LAS float* TWs = ZVs + 2048; LAS float* ZAs = TWs + 2048;
    LAS float* DEC = ZAs + 2048; LAS float* KD = DEC + 2048; LAS float* AV = KD + 2048; LAS float* BV = AV + 2048; LAS float* YB = BV + 2048; LAS float* BON = YB + 2048;
    const bf16* Z = (const bf16*)(A->ws + WS_Z);
    const float* mu_prev = (const float*)A->in[7]; const float* mu_next = (const float*)A->in[8];
    const float* w0 = (const float*)A->in[9]; const float* w2 = (const float*)A->in[10]; const float* a0 = (const float*)A->in[11]; const float* a2 = (const float*)A->in[12];
    const float* k_k = (const float*)A->in[14]; const float* k_a = (const float*)A->in[15]; const float* r_k = (const float*)A->in[16];
    bf16* ydir = (bf16*)(A->ws + WS_XN) + (size_t)dir * M * 512; float* bonus = (float*)(A->ws + WS_BONUS) + (size_t)dir * M * 8;
    const int tid = F.tid, lane = F.lane, wave = F.wave;
    for (int i = tid; i < 4096; i += 512) { const int l = i >> 6, j = i & 63; W2S[i] = w2[((size_t)dir * 64 + l) * 512 + h * 64 + j]; A2S[i] = a2[((size_t)dir * 64 + l) * 512 + h * 64 + j]; }
    const int ch = h * 64 + lane;
    const float w0j = w0[dir * 512 + ch], a0j = a0[dir * 512 + ch], kkj = k_k[ch], kaj = k_a[ch], rkj = r_k[ch];
    float s[8];
#pragma unroll
    for (int q = 0; q < 8; ++q) s[q] = 0.f;
    const int ri = tid >> 3, jg = tid & 7;
    for (int ci = 0; ci < T / CT; ++ci) {
        const int t0 = (dir ? (T / CT - 1 - ci) : ci) * CT;
#pragma unroll 4
        for (int i = 0; i < 20; ++i) { const int e = tid + 512 * i, arr = e >> 11, rem = e & 2047, tl = rem >> 6, j = rem & 63;
            const int col = (arr == 0 ? ZR + h * 64 : arr == 1 ? ZK + h * 64 : arr == 2 ? ZV + h * 64 : arr == 3 ? ZWD + dir * 64 : ZAD + dir * 64) + j;
            const int t = t0 + tl; const bf16* zp = Z + ((size_t)b * T + t) * NZ + col;
            const float z0 = bf2f(zp[0]), zm = t > 0 ? bf2f(zp[-NZ]) : 0.f, zq = t < T - 1 ? bf2f(zp[NZ]) : 0.f;
            float zs = z0 + mu_prev[col] * (zm - z0) + mu_next[col] * (zq - z0);
            if (arr == 3) zs = tanhf(zs);
            ZRs[arr * 2048 + rem] = zs; }
        __syncthreads();
#pragma unroll 1
        for (int q = 0; q < 4; ++q) { const int tl = wave + 8 * q;
            float wraw = w0j, araw = a0j;
#pragma unroll 8
            for (int l = 0; l < 64; ++l) { wraw += TWs[tl * 64 + l] * W2S[l * 64 + lane]; araw += ZAs[tl * 64 + l] * A2S[l * 64 + lane]; }
            const float w = -softplusf(-wraw) - 0.5f, dec = __expf(-__expf(w)), ad = sigm(araw);
            const float k = ZKs[tl * 64 + lane], kkr = k * kkj, nrm = sqrtf(wave_sum(kkr * kkr)), kk = kkr / fmaxf(nrm, 1e-12f);
            const float kd = k * (1.0f + (ad - 1.0f) * kaj);
            DEC[tl * 64 + lane] = dec; KD[tl * 64 + lane] = kd; AV[tl * 64 + lane] = -kk; BV[tl * 64 + lane] = kk * ad;
            const float bon = wave_sum(ZRs[tl * 64 + lane] * kd * rkj); if (lane == 0) BON[tl] = bon; }
        __syncthreads();
#pragma unroll 1
        for (int st = 0; st < CT; ++st) { const int tl = dir ? (CT - 1 - st) : st; const int o = tl * 64 + jg * 8;
            const f32x4 a0v = *(const LAS f32x4*)(AV + o), a1v = *(const LAS f32x4*)(AV + o + 4), d0 = *(const LAS f32x4*)(DEC + o), d1 = *(const LAS f32x4*)(DEC + o + 4);
            const f32x4 b0 = *(const LAS f32x4*)(BV + o), b1 = *(const LAS f32x4*)(BV + o + 4), k0 = *(const LAS f32x4*)(KD + o), k1 = *(const LAS f32x4*)(KD + o + 4);
            const f32x4 r0 = *(const LAS f32x4*)(ZRs + o), r1 = *(const LAS f32x4*)(ZRs + o + 4); const float vi = ZVs[tl * 64 + ri];
            float p = (s[0] * a0v[0] + s[1] * a0v[1]) + (s[2] * a0v[2] + s[3] * a0v[3]) + (s[4] * a1v[0] + s[5] * a1v[1]) + (s[6] * a1v[2] + s[7] * a1v[3]);
            p += __shfl_xor(p, 1); p += __shfl_xor(p, 2); p += __shfl_xor(p, 4);
            s[0] = s[0] * d0[0] + p * b0[0] + vi * k0[0]; s[1] = s[1] * d0[1] + p * b0[1] + vi * k0[1]; s[2] = s[2] * d0[2] + p * b0[2] + vi * k0[2]; s[3] = s[3] * d0[3] + p * b0[3] + vi * k0[3];
            s[4] = s[4] * d1[0] + p * b1[0] + vi * k1[0]; s[5] = s[5] * d1[1] + p * b1[1] + vi * k1[1]; s[6] = s[6] * d1[2] + p * b1[2] + vi * k1[2]; s[7] = s[7] * d1[3] + p * b1[3] + vi * k1[3];
            float y = (s[0] * r0[0] + s[1] * r0[1]) + (s[2] * r0[2] + s[3] * r0[3]) + (s[4] * r1[0] + s[5] * r1[1]) + (s[6] * r1[2] + s[7] * r1[3]);
            y += __shfl_xor(y, 1); y += __shfl_xor(y, 2); y += __shfl_xor(y, 4);
            if (jg == 0) YB[tl * 64 + ri] = y; }
        __syncthreads();
#pragma unroll
        for (int i = 0; i < 4; ++i) { const int e = tid + 512 * i, tl = e >> 6, c = e & 63; ydir[((size_t)b * T + t0 + tl) * 512 + h * 64 + c] = (bf16)f2bf(YB[e]); }
        if (tid < CT) bonus[((size_t)b * T + t0 + tid) * 8 + h] = BON[tid];
        __syncthreads();
    }
}


#define SDEV __device__ __forceinline__
#define S_UNROLL _Pragma("unroll")
#define S_MEMBAR() do { asm volatile("" ::: "memory"); __builtin_amdgcn_sched_barrier(0); } while (0)
#define S_LAUNDER_I(x) asm volatile("" : "+v"(x))
#define S_LAUNDER_S(x) asm volatile("" : "+s"(x))
#define S_PIN(x) asm volatile("" : "+v"(x))
typedef float f32x2s __attribute__((ext_vector_type(2))); typedef __bf16 bf16x2s __attribute__((ext_vector_type(2)));
__device__ __forceinline__ unsigned s_cvtpk(float lo, float hi) { f32x2s v = {lo, hi}; bf16x2s b = __builtin_convertvector(v, bf16x2s); return __builtin_bit_cast(unsigned, b); }
__device__ __forceinline__ float s_rowsum16(float v) {
    v += __int_as_float(__builtin_amdgcn_update_dpp(0, __float_as_int(v), 0xB1, 0xf, 0xf, false));
    v += __int_as_float(__builtin_amdgcn_update_dpp(0, __float_as_int(v), 0x4E, 0xf, 0xf, false));
    v += __int_as_float(__builtin_amdgcn_update_dpp(0, __float_as_int(v), 0x141, 0xf, 0xf, false));
    v += __int_as_float(__builtin_amdgcn_update_dpp(0, __float_as_int(v), 0x140, 0xf, 0xf, false));
    return v; }
#define S_MFMA(a, b, c) __builtin_amdgcn_mfma_f32_32x32x16_bf16(a, b, c, 0, 0, 0)
#define S_PK(lo, hi) s_cvtpk(lo, hi)
#define S_SWAP(x, y) do { auto r_ = __builtin_amdgcn_permlane32_swap(x, y, false, false); x = r_[0]; y = r_[1]; } while (0)
#define S_ROWSUM16(v) s_rowsum16(v)
__device__ __forceinline__ float s_wavesum(float v) { v = s_rowsum16(v);
    v += __int_as_float(__builtin_amdgcn_ds_swizzle(__float_as_int(v), 0x401F));
    auto r_ = __builtin_amdgcn_permlane32_swap(__float_as_uint(v), __float_as_uint(v), false, false);
    return __uint_as_float(r_[0]) + __uint_as_float(r_[1]); }
#define S_WAVESUM(v) s_wavesum(v)
#define S_SWAP16(x, y) do { auto r_ = __builtin_amdgcn_permlane16_swap(x, y, false, false); x = r_[0]; y = r_[1]; } while (0)
#define S_DPPF(v, ctrl) __int_as_float(__builtin_amdgcn_update_dpp(0, __float_as_int(v), ctrl, 0xf, 0xf, false))
__device__ __forceinline__ float s_treesum32(float (&q)[32], int lane) {
    _Pragma("unroll") for (int i = 0; i < 16; ++i) { unsigned x = __float_as_uint(q[i]), y = __float_as_uint(q[i + 16]); S_SWAP(x, y); q[i] = __uint_as_float(x) + __uint_as_float(y); }
    _Pragma("unroll") for (int i = 0; i < 8; ++i) { unsigned x = __float_as_uint(q[i]), y = __float_as_uint(q[i + 8]); S_SWAP16(x, y); q[i] = __uint_as_float(x) + __uint_as_float(y); }
    const bool b3 = (lane & 8) != 0, b2 = (lane & 4) != 0, b1 = (lane & 2) != 0;
    _Pragma("unroll") for (int i = 0; i < 4; ++i) { const float a = q[i], b = q[i + 4]; const float c = b3 ? b : a, d = b3 ? a : b; q[i] = c + S_DPPF(d, 0x140); }
    _Pragma("unroll") for (int i = 0; i < 2; ++i) { const float a = q[i], b = q[i + 2]; const float c = b2 ? b : a, d = b2 ? a : b; q[i] = c + S_DPPF(d, 0x141); }
    { const float a = q[0], b = q[1]; const float c = b1 ? b : a, d = b1 ? a : b; q[0] = c + S_DPPF(d, 0x1B); }
    return q[0] + S_DPPF(q[0], 0xB1); }
#define S_GAS GAS
#define S_READLANE(v, l) __int_as_float(__builtin_amdgcn_readlane(__float_as_int(v), l))
#define S_RCP(x) __builtin_amdgcn_rcpf(x)
#define S_EXP2(x) __builtin_amdgcn_exp2f(x)
#define S_LOG2(x) __builtin_amdgcn_logf(x)
#define S_RSQ(x) __builtin_amdgcn_rsqf(x)
#define S_LDS_WAIT() asm volatile("s_waitcnt lgkmcnt(0)" ::: "memory")
#define S_LDSP LAS unsigned char*
#define S_LDS_BF16P LAS bf16*
#define S_LDS_U32P LAS unsigned*
#define S_LDS_F32P LAS float*
#define S_LDS_CONST_BF16X8P const LAS bf16x8*
#define S_LDS_BF16X8P LAS bf16x8*
#define S_LDS_CONST_F32X4P const LAS f32x4*
#define S_LDS_CONST_F32P const LAS float*
#define S_FLAG_STORE(p, v) do { *(volatile LAS unsigned*)(p) = (v); } while (0)
#define S_FLAG_WAIT(p, v) do { unsigned sp_ = 0; while (*(volatile LAS unsigned*)(p) != (v)) { __builtin_amdgcn_s_sleep(2); if (++sp_ > (1u << 24)) break; } asm volatile("" ::: "memory"); } while (0)
struct SFrag { bf16x8 s[2]; };
struct SMat { SFrag t[2]; };
SDEV f32x16 smm(const SFrag& X, const SFrag& Y, f32x16 acc) { acc = S_MFMA(X.s[0], Y.s[0], acc); acc = S_MFMA(X.s[1], Y.s[1], acc); return acc; }
SDEV f32x16 szero() { f32x16 z; S_UNROLL for (int i = 0; i < 16; ++i) z[i] = 0.f; return z; }
SDEV SFrag spack(const f32x16& d) { SFrag f;
    S_UNROLL for (int s = 0; s < 2; ++s) { v4u w; S_UNROLL for (int q = 0; q < 4; ++q) w[q] = S_PK(d[8 * s + 2 * q], d[8 * s + 2 * q + 1]); f.s[s] = __builtin_bit_cast(bf16x8, w); }
    return f; }
SDEV f32x16 sunpack(const SFrag& f) { f32x16 d;
    S_UNROLL for (int s = 0; s < 2; ++s) { const v4u w = __builtin_bit_cast(v4u, f.s[s]); S_UNROLL for (int q = 0; q < 4; ++q) { d[8 * s + 2 * q] = __uint_as_float(w[q] << 16); d[8 * s + 2 * q + 1] = __uint_as_float(w[q] & 0xffff0000u); } }
    return d; }
SDEV SMat splain2d(const unsigned (&pp)[16]) { unsigned d0[8], d1[8];
    S_UNROLL for (int g = 0; g < 4; ++g) S_UNROLL for (int p = 0; p < 2; ++p) { unsigned x = pp[4 * g + p], y = pp[4 * g + 2 + p]; S_SWAP(x, y); d0[2 * g + p] = x; d1[2 * g + p] = y; }
    SMat m;
    S_UNROLL for (int s = 0; s < 2; ++s) { v4u a, b; S_UNROLL for (int q = 0; q < 4; ++q) { a[q] = d0[4 * s + q]; b[q] = d1[4 * s + q]; } m.t[0].s[s] = __builtin_bit_cast(bf16x8, a); m.t[1].s[s] = __builtin_bit_cast(bf16x8, b); }
    return m; }
SDEV void sd2plain(const f32x16& D0, const f32x16& D1, float (&x)[32]) {
    S_UNROLL for (int r = 0; r < 16; ++r) { unsigned a = __float_as_uint(D0[r]), b = __float_as_uint(D1[r]); S_SWAP(a, b); const int ta = (r & 3) + 8 * (r >> 2); x[ta] = __uint_as_float(a); x[ta + 4] = __uint_as_float(b); } }
SDEV SFrag sident(int n_in, int hh_in) { int n1 = n_in, r1 = 4 * hh_in; S_LAUNDER_I(n1); S_LAUNDER_I(r1); f32x16 id; S_UNROLL for (int g = 0; g < 16; ++g) id[g] = (((g & 3) + 8 * (g >> 2) + r1) == n1) ? 1.f : 0.f; return spack(id); }
SDEV void sd2plain_pk(const f32x16& D0, const f32x16& D1, unsigned (&xp)[16]) {
    S_UNROLL for (int m = 0; m < 8; ++m) { unsigned a = S_PK(D0[2 * m], D0[2 * m + 1]), b = S_PK(D1[2 * m], D1[2 * m + 1]); S_SWAP(a, b); const int qa = 4 * (m >> 1) + (m & 1); xp[qa] = a; xp[qa + 2] = b; } }
SDEV float swave_sum(float v) { return S_WAVESUM(v); }

struct ScanArgs { const S_GAS bf16* Z; const S_GAS float* mu_prev; const S_GAS float* mu_next; const S_GAS float* w0; const S_GAS float* a0; const S_GAS float* k_k; const S_GAS float* k_a; const S_GAS float* r_k; S_GAS bf16* ydir; S_GAS float* bonus; S_GAS unsigned char* prep; };

#define SC_W2F 0
#define SC_A2F 8192
#define SC_SIG 16384
#define SC_GTAB 24576
#define SC_FLAG 26624
#define SC_WR 28672
#define SC_AR 94208
#define SC_RSQ 126976
#define SC_LDS_BYTES 128000
#ifndef SB_ILP
#define SB_ILP 8
#endif
#define SC_PF 4

SDEV void scan2_setup(S_LDSP lds, const S_GAS float* w2, const S_GAS float* a2, int h, int dir, int tid) {
    { float wv[16];
      S_UNROLL for (int it = 0; it < 16; ++it) { const int e = tid + 512 * it; const int mat = e >> 12, r = e & 4095, jj = r & 7, ln = (r >> 3) & 63, s = (r >> 9) & 1, jt = (r >> 10) & 1, lt = (r >> 11) & 1;
          const int n = ln & 31, hh = ln >> 5, g = 8 * s + jj, l = 32 * lt + (g & 3) + 8 * (g >> 2) + 4 * hh, j = 32 * jt + n;
          wv[it] = (mat ? a2 : w2)[((size_t)dir * 64 + l) * 512 + h * 64 + j]; }
      S_UNROLL for (int it = 0; it < 16; ++it) { const int e = tid + 512 * it; const int mat = e >> 12, r = e & 4095;
          ((S_LDS_BF16P)(lds + (mat ? SC_A2F : SC_W2F)))[r] = (bf16)(S_PK(wv[it] * -1.442695041f, 0.f) & 0xffffu); } }
    for (int e = tid; e < 2048; e += 512) ((S_LDS_U32P)(lds + SC_SIG))[e] = 0u;
    if (tid == 0) S_FLAG_STORE(lds + SC_FLAG, 0u);
}

SDEV void scan2_prep(const ScanArgs& A_in, int b_in, int dir_in, int c, int lane_in) {
    ScanArgs A = A_in; int b = b_in, dir = dir_in;
    S_LAUNDER_S(A.Z); S_LAUNDER_S(A.mu_prev); S_LAUNDER_S(A.mu_next); S_LAUNDER_S(A.prep); S_LAUNDER_S(b); S_LAUNDER_S(dir);
    int lane = lane_in; S_LAUNDER_I(lane);
    const int n = lane & 31, hh = lane >> 5;
    const int sgn = dir ? -1 : 1, tau0 = dir ? (T - 1 - 32 * c) : 32 * c;
    const S_GAS bf16* zb = A.Z + (size_t)b * T * NZ;
    const ptrdiff_t st = (ptrdiff_t)sgn * NZ; const bool first = (c == 0), last = (c == T / 32 - 1);
    const int cw = ZWD + dir * 64 + lane, ca = ZAD + dir * 64 + lane;
    const SFrag IDF = sident(n, hh); unsigned ppw[16], ppa[16];
    { const float mA = dir ? A.mu_next[cw] : A.mu_prev[cw], mB = dir ? A.mu_prev[cw] : A.mu_next[cw], nA = dir ? A.mu_next[ca] : A.mu_prev[ca], nB = dir ? A.mu_prev[ca] : A.mu_next[ca];
      const S_GAS bf16* pw = zb + (ptrdiff_t)tau0 * NZ + cw - st; const S_GAS bf16* pa = zb + (ptrdiff_t)tau0 * NZ + ca - st;
      float rw[34], ra[34];
      S_UNROLL for (int q = 0; q < 34; ++q) { const bool ok = !((q == 0 && first) || (q == 33 && last)); rw[q] = ok ? bf2f(*pw) : 0.f; ra[q] = ok ? bf2f(*pa) : 0.f; pw += st; pa += st; }
      S_MEMBAR();
      const float mC = 1.f - mA - mB, nC = 1.f - nA - nB; float tprev = 0.f, aprev = 0.f;
      S_UNROLL for (int p = 0; p < 32; ++p) { if ((p & 7) == 0) S_MEMBAR();
          const float ws = mC * rw[p + 1] + mA * rw[p] + mB * rw[p + 2], as = nC * ra[p + 1] + nA * ra[p] + nB * ra[p + 2];
          const float tw = 1.f - 2.f * S_RCP(1.f + S_EXP2(ws * 2.885390082f));
          if (p & 1) { ppw[p >> 1] = S_PK(tprev, tw); ppa[p >> 1] = S_PK(aprev, as); S_PIN(ppw[p >> 1]); S_PIN(ppa[p >> 1]); } else { tprev = tw; aprev = as; } } }
    S_MEMBAR();
    const SMat TW = splain2d(ppw), AD = splain2d(ppa);
    S_GAS bf16x8* pf = (S_GAS bf16x8*)(A.prep + (size_t)((b * 2 + dir) * 64 + c) * 8192) + lane;
    S_UNROLL for (int lt = 0; lt < 2; ++lt) { const SFrag tw_ = spack(smm(TW.t[lt], IDF, szero())), ad_ = spack(smm(AD.t[lt], IDF, szero()));
        S_UNROLL for (int s = 0; s < 2; ++s) { pf[(lt * 2 + s) * 64] = tw_.s[s]; pf[256 + (lt * 2 + s) * 64] = ad_.s[s]; } }
}

SDEV void scan2_chunk(S_LDSP lds, const ScanArgs& A_in, int b_in, int h_in, int dir_in, int c, int lane_in, int wave) {
    ScanArgs A = A_in; int b = b_in, h = h_in, dir = dir_in;
    S_LAUNDER_S(A.Z); S_LAUNDER_S(A.mu_prev); S_LAUNDER_S(A.mu_next); S_LAUNDER_S(A.w0); S_LAUNDER_S(A.a0); S_LAUNDER_S(A.k_k); S_LAUNDER_S(A.k_a); S_LAUNDER_S(A.r_k); S_LAUNDER_S(A.ydir); S_LAUNDER_S(A.bonus); S_LAUNDER_S(A.prep);
    S_LAUNDER_S(b); S_LAUNDER_S(h); S_LAUNDER_S(dir);
    int lane = lane_in; S_LAUNDER_I(lane);
    const int n = lane & 31, hh = lane >> 5;
    const int sgn = dir ? -1 : 1, tau0 = dir ? (T - 1 - 32 * c) : 32 * c;
    const S_GAS bf16* zb = A.Z + (size_t)b * T * NZ;
    const ptrdiff_t st = (ptrdiff_t)sgn * NZ; const bool first = (c == 0), last = (c == T / 32 - 1);
    const int cr = ZR + h * 64 + lane, ck = ZK + h * 64 + lane, cv = ZV + h * 64 + lane, chn = h * 64 + lane;
    unsigned rr[34], rk[34], rv[34];
    {   SFrag TWT[2], ADT[2];
        { const S_GAS bf16x8* pf = (const S_GAS bf16x8*)(A.prep + (size_t)((b * 2 + dir) * 64 + c) * 8192) + lane;
          S_UNROLL for (int lt = 0; lt < 2; ++lt) S_UNROLL for (int s = 0; s < 2; ++s) { TWT[lt].s[s] = pf[(lt * 2 + s) * 64]; ADT[lt].s[s] = pf[256 + (lt * 2 + s) * 64]; } }
        { const S_GAS bf16* pr = zb + (ptrdiff_t)tau0 * NZ + cr - st; const S_GAS bf16* pk = zb + (ptrdiff_t)tau0 * NZ + ck - st; const S_GAS bf16* pv = zb + (ptrdiff_t)tau0 * NZ + cv - st;
          const ptrdiff_t o0 = first ? st : 0, o33 = last ? -st : 0;
          S_UNROLL for (int q = 0; q < 34; ++q) { const ptrdiff_t oo = (q == 0) ? o0 : (q == 33) ? o33 : 0; rr[q] = (unsigned)pr[oo]; rk[q] = (unsigned)pk[oo]; rv[q] = (unsigned)pv[oo]; pr += st; pk += st; pv += st; } }
        S_MEMBAR();
        f32x16 dw[2], da[2];
        S_UNROLL for (int jt = 0; jt < 2; ++jt) { const float w0s = A.w0[dir * 512 + h * 64 + 32 * jt + n] * -1.442695041f, a0s = A.a0[dir * 512 + h * 64 + 32 * jt + n] * -1.442695041f;
            S_UNROLL for (int g = 0; g < 16; ++g) { dw[jt][g] = w0s; da[jt][g] = a0s; }
            S_UNROLL for (int lt = 0; lt < 2; ++lt) { SFrag wf, af;
                S_UNROLL for (int s = 0; s < 2; ++s) { wf.s[s] = *(S_LDS_CONST_BF16X8P)(lds + SC_W2F + ((((lt * 2 + jt) * 2 + s) * 64 + lane) * 16)); af.s[s] = *(S_LDS_CONST_BF16X8P)(lds + SC_A2F + ((((lt * 2 + jt) * 2 + s) * 64 + lane) * 16)); }
                dw[jt] = smm(TWT[lt], wf, dw[jt]); da[jt] = smm(ADT[lt], af, da[jt]); } }
        S_UNROLL for (int jt = 0; jt < 2; ++jt) S_UNROLL for (int g = 0; g < 16; ++g) { const int t = (g & 3) + 8 * (g >> 2) + 4 * hh;
            ((S_LDS_F32P)(lds + SC_WR + wave * 8192))[t * 64 + 32 * jt + n] = dw[jt][g]; ((S_LDS_BF16P)(lds + SC_AR + wave * 4096))[t * 64 + 32 * jt + n] = (bf16)(S_PK(da[jt][g], 0.f) & 0xffffu); }
        S_LDS_WAIT();
    }
    S_MEMBAR();
    unsigned ppA[16], ppR[16], ppB[16], ppK[16], ppV[16], ppQ[16]; float gamC;
    {   const float mAr = dir ? A.mu_next[cr] : A.mu_prev[cr], mBr = dir ? A.mu_prev[cr] : A.mu_next[cr], mAk = dir ? A.mu_next[ck] : A.mu_prev[ck], mBk = dir ? A.mu_prev[ck] : A.mu_next[ck];
        const float mAv = dir ? A.mu_next[cv] : A.mu_prev[cv], mBv = dir ? A.mu_prev[cv] : A.mu_next[cv];
        const float kkj = A.k_k[chn], kaj = A.k_a[chn], rkj = A.r_k[chn];
        const float mCr = 1.f - mAr - mBr, mCk = 1.f - mAk - mBk, mCv = 1.f - mAv - mBv;
        float cs = 0.f, gprev = 1.f; float eA = 0.f, eR = 0.f, eB = 0.f, eK = 0.f, eV = 0.f, eQ = 0.f;
        float zf = first ? 0.f : 1.f, zl = last ? 0.f : 1.f; S_PIN(zf); S_PIN(zl);
        {
            float sq[32];
            float k_a = zf * __uint_as_float(rk[0] << 16), k_b = __uint_as_float(rk[1] << 16);
            S_UNROLL for (int p = 0; p < 32; ++p) { const float k_c = ((p == 31) ? zl : 1.f) * __uint_as_float(rk[p + 2] << 16); const float km = mCk * k_b + mAk * k_a + mBk * k_c; k_a = k_b; k_b = k_c;
                rk[p] = __float_as_uint(km); const float t_ = km * kkj; sq[p] = t_ * t_; }
            const float tot = s_treesum32(sq, lane);
            ((S_LDS_F32P)(lds + SC_RSQ + wave * 128))[lane >> 1] = S_RSQ(fmaxf(tot, 1e-24f)); }
        S_MEMBAR();
        float r_a = zf * __uint_as_float(rr[0] << 16), r_b = __uint_as_float(rr[1] << 16), v_a = zf * __uint_as_float(rv[0] << 16), v_b = __uint_as_float(rv[1] << 16);
        S_UNROLL for (int p = 0; p < 32; ++p) { if ((p & (SB_ILP - 1)) == 0) S_MEMBAR();
            const float zz = (p == 31) ? zl : 1.f; const float r_c = zz * __uint_as_float(rr[p + 2] << 16), v_c = zz * __uint_as_float(rv[p + 2] << 16);
            const float r = mCr * r_b + mAr * r_a + mBr * r_c, k = __uint_as_float(rk[p]), v = mCv * v_b + mAv * v_a + mBv * v_c; r_a = r_b; r_b = r_c; v_a = v_b; v_b = v_c;
            const float wraw = ((S_LDS_F32P)(lds + SC_WR + wave * 8192))[p * 64 + lane], araw = bf2f(((S_LDS_BF16P)(lds + SC_AR + wave * 4096))[p * 64 + lane]);
            const float lw2 = -0.8750387749f * S_RCP(1.f + S_EXP2(wraw));
            const float al = S_RCP(1.f + S_EXP2(araw));
            const float kk = k * kkj * ((S_LDS_CONST_F32P)(lds + SC_RSQ + wave * 128))[p];
            const float kd = k * (1.f + (al - 1.f) * kaj);
            cs += lw2; const float gam = S_EXP2(cs), ig = S_EXP2(-cs);
            const float xa = -kk * gprev, xr = r * gam, xb = kk * al * ig, xk = kd * ig, xq = xr * rkj; gprev = gam;
            if (p & 1) { ppA[p >> 1] = S_PK(eA, xa); ppR[p >> 1] = S_PK(eR, xr); ppB[p >> 1] = S_PK(eB, xb); ppK[p >> 1] = S_PK(eK, xk); ppV[p >> 1] = S_PK(eV, v); ppQ[p >> 1] = S_PK(eQ, xq);
                         S_PIN(ppQ[p >> 1]); S_PIN(ppA[p >> 1]); S_PIN(ppR[p >> 1]); S_PIN(ppB[p >> 1]); S_PIN(ppK[p >> 1]); S_PIN(ppV[p >> 1]); }
            else { eA = xa; eR = xr; eB = xb; eK = xk; eV = v; eQ = xq; } }
        gamC = gprev;
    }
    S_MEMBAR();
    float gc0, gc1; { unsigned x = __float_as_uint(gamC), y = x; S_SWAP(x, y); gc0 = __uint_as_float(x); gc1 = __uint_as_float(y); }
    ((S_LDS_F32P)(lds + SC_GTAB + wave * 256))[lane] = gamC;
    const SMat FA = splain2d(ppA), FB = splain2d(ppB), FK = splain2d(ppK), FV = splain2d(ppV);
    SFrag RT[2], MrbT, MrkT, LakT, Pf, PTf; f32x16 TT;
    {   const SFrag IDF = sident(n, hh); SFrag AT[2], BT[2], KT[2];
        { const SMat FR = splain2d(ppR); S_UNROLL for (int dt = 0; dt < 2; ++dt) RT[dt] = spack(smm(FR.t[dt], IDF, szero())); }
        SFrag QT[2]; { const SMat FQ = splain2d(ppQ); S_UNROLL for (int dt = 0; dt < 2; ++dt) QT[dt] = spack(smm(FQ.t[dt], IDF, szero())); }
        S_UNROLL for (int dt = 0; dt < 2; ++dt) { AT[dt] = spack(smm(FA.t[dt], IDF, szero())); BT[dt] = spack(smm(FB.t[dt], IDF, szero())); KT[dt] = spack(smm(FK.t[dt], IDF, szero())); }
        f32x16 L = szero(), LT = szero(), lak = szero(), mrb = szero(), mrk = szero();
        { f32x16 bq = szero(); S_UNROLL for (int dt = 0; dt < 2; ++dt) bq = smm(KT[dt], QT[dt], bq);
          int nb = n, rb = 4 * hh; S_LAUNDER_I(nb); S_LAUNDER_I(rb); float dsum = 0.f; S_UNROLL for (int g = 0; g < 16; ++g) dsum += (((g & 3) + 8 * (g >> 2) + rb) == nb) ? bq[g] : 0.f;
          if (((nb >> 2) & 1) == (rb >> 2)) A.bonus[((size_t)b * T + (tau0 + sgn * nb)) * 8 + h] = dsum; }
        S_UNROLL for (int dt = 0; dt < 2; ++dt) { L = smm(AT[dt], BT[dt], L); LT = smm(BT[dt], AT[dt], LT); lak = smm(KT[dt], AT[dt], lak); mrb = smm(BT[dt], RT[dt], mrb); mrk = smm(KT[dt], RT[dt], mrk); }
        int n2 = n, r2 = 4 * hh; S_LAUNDER_I(n2); S_LAUNDER_I(r2);
        S_UNROLL for (int g = 0; g < 16; ++g) { const int row = (g & 3) + 8 * (g >> 2) + r2;
            L[g] = (row > n2) ? L[g] : 0.f; LT[g] = (row < n2) ? LT[g] : 0.f; lak[g] = (row < n2) ? lak[g] : 0.f; mrb[g] = (row <= n2) ? mrb[g] : 0.f; mrk[g] = (row <= n2) ? mrk[g] : 0.f; }
        Pf = spack(L); PTf = spack(LT); LakT = spack(lak); MrbT = spack(mrb); MrkT = spack(mrk);
        TT = LT; S_UNROLL for (int g = 0; g < 16; ++g) TT[g] += (((g & 3) + 8 * (g >> 2) + r2) == n2) ? 1.f : 0.f;
    }
    S_MEMBAR();
    SFrag TTf = spack(TT);
    S_UNROLL for (int i = 1; i <= 4; ++i) { const f32x16 P2 = smm(PTf, Pf, szero()); SFrag P2Tf; if (i < 4) P2Tf = spack(smm(Pf, PTf, szero()));
        Pf = spack(P2); TT = smm(Pf, TTf, TT); TTf = spack(TT); if (i < 4) PTf = P2Tf; }
    S_MEMBAR();
    SFrag U0[2], Ap[2], RpT[2], Y0[2], GTf[2][2], Hf[2][2];
    S_UNROLL for (int vt = 0; vt < 2; ++vt) { const SFrag W = spack(smm(LakT, FV.t[vt], szero())); U0[vt] = spack(smm(TTf, W, szero())); }
    S_UNROLL for (int kt = 0; kt < 2; ++kt) Ap[kt] = spack(smm(TTf, FA.t[kt], szero()));
    S_UNROLL for (int kt = 0; kt < 2; ++kt) RpT[kt] = spack(smm(Ap[kt], MrbT, sunpack(RT[kt])));
    S_UNROLL for (int vt = 0; vt < 2; ++vt) Y0[vt] = spack(smm(MrkT, FV.t[vt], smm(MrbT, U0[vt], szero())));
    int n3 = n, r3 = 4 * hh; S_LAUNDER_I(n3); S_LAUNDER_I(r3);
    S_UNROLL for (int nt = 0; nt < 2; ++nt) S_UNROLL for (int mt = 0; mt < 2; ++mt) { f32x16 gt = smm(Ap[nt], FB.t[mt], szero()); const float gcv = mt ? gc1 : gc0;
        S_UNROLL for (int g = 0; g < 16; ++g) { const float idv = (nt == mt && ((g & 3) + 8 * (g >> 2) + r3) == n3) ? 1.f : 0.f; gt[g] = (gt[g] + idv) * gcv; }
        GTf[nt][mt] = spack(gt); }
    S_LDS_WAIT();
    S_UNROLL for (int mt = 0; mt < 2; ++mt) { float gr[16];
        S_UNROLL for (int q = 0; q < 4; ++q) { const f32x4 t4 = *(S_LDS_CONST_F32X4P)(lds + SC_GTAB + wave * 256 + (32 * mt + 8 * q + 4 * hh) * 4); S_UNROLL for (int i = 0; i < 4; ++i) gr[4 * q + i] = t4[i]; }
        S_UNROLL for (int vt = 0; vt < 2; ++vt) { f32x16 hm = smm(FK.t[mt], FV.t[vt], smm(FB.t[mt], U0[vt], szero())); S_UNROLL for (int g = 0; g < 16; ++g) hm[g] *= gr[g]; Hf[mt][vt] = spack(hm); } }
    S_MEMBAR();
    S_FLAG_WAIT(lds + SC_FLAG, (unsigned)c);
    SFrag SG[2][2];
    S_UNROLL for (int kt = 0; kt < 2; ++kt) S_UNROLL for (int vt = 0; vt < 2; ++vt) S_UNROLL for (int s = 0; s < 2; ++s) SG[kt][vt].s[s] = *(S_LDS_CONST_BF16X8P)(lds + SC_SIG + ((((kt * 2 + vt) * 2 + s) * 64 + lane) * 16));
    S_LDS_WAIT();
    S_UNROLL for (int mt = 0; mt < 2; ++mt) S_UNROLL for (int vt = 0; vt < 2; ++vt) { f32x16 sn = sunpack(Hf[mt][vt]); S_UNROLL for (int nt = 0; nt < 2; ++nt) sn = smm(GTf[nt][mt], SG[nt][vt], sn);
        const SFrag f = spack(sn); S_UNROLL for (int s = 0; s < 2; ++s) *(S_LDS_BF16X8P)(lds + SC_SIG + ((((mt * 2 + vt) * 2 + s) * 64 + lane) * 16)) = f.s[s]; }
    S_LDS_WAIT();
    S_FLAG_STORE(lds + SC_FLAG, (unsigned)(c + 1));
    S_UNROLL for (int vt = 0; vt < 2; ++vt) { f32x16 y = sunpack(Y0[vt]); S_UNROLL for (int kt = 0; kt < 2; ++kt) y = smm(RpT[kt], SG[kt][vt], y);
        S_UNROLL for (int g = 0; g < 16; ++g) { const int p = (g & 3) + 8 * (g >> 2) + 4 * hh; A.ydir[((size_t)b * T + (tau0 + sgn * p)) * 512 + h * 64 + 32 * vt + n] = (bf16)(S_PK(y[g], 0.f) & 0xffffu); } }
}

__device__ __forceinline__ void attn_unit(const Frame& F, ArgsP A, int b, int kvh, int qb) {
    constexpr int KST = 72, VST = 388;
    LAS bf16* KS = (LAS bf16*)F.lds;
    LAS bf16* VT = (LAS bf16*)(F.lds + 384 * KST * 2);
    LAS float* wsf = (LAS float*)(F.lds + 384 * KST * 2 + 64 * VST * 2);
    const bf16* Z = (const bf16*)(A->ws + WS_Z); bf16* OA = (bf16*)(A->ws + WS_OATT);
    const int* positions = (const int*)A->in[2]; const float* qg = (const float*)A->in[19]; const float* kg = (const float*)A->in[20]; const float* sink = (const float*)A->in[21];
    const int tid = F.tid, lane = F.lane, wave = F.wave;
    const float LN_THETA = 13.122363377404328f;
    v4u kwa[6], vwa[6], rca[6], rsa[6];
    v4u qn[4], qnc, qns;
    { const size_t tok0 = (size_t)b * T + qb * 128 + (wave & 1) * 64 + (lane & 31); const int hq0 = kvh * 4 + (wave >> 1);
#pragma unroll
      for (int sI = 0; sI < 4; ++sI) qn[sI] = *(const GAS v4u*)(Z + tok0 * NZ + ZQ + hq0 * 64 + 16 * sI + 8 * (lane >> 5));
      const GAS v4u* qrt0 = (const GAS v4u*)((const bf16*)(A->ws + WS_ROPE) + tok0 * 16); qnc = qrt0[0]; qns = qrt0[1]; }
#pragma unroll
    for (int i = 0; i < 6; ++i) { const int ct = tid + 512 * i, key = ct >> 3, ch = ct & 7; const int kp = qb * 128 - 128 + key; const bool valid = (kp >= 0) && (kp < T);
        const size_t rowoff = ((size_t)b * T + (valid ? kp : 0)) * NZ;
        kwa[i] = *(const GAS v4u*)(Z + rowoff + ZKA + kvh * 64 + ch * 8); vwa[i] = *(const GAS v4u*)(Z + rowoff + ZVA + kvh * 64 + ch * 8);
        const GAS v4u* rt = (const GAS v4u*)((const bf16*)(A->ws + WS_ROPE) + ((size_t)b * T + (valid ? kp : 0)) * 16); rca[i] = rt[0]; rsa[i] = rt[1]; }
#pragma unroll
    for (int i = 0; i < 6; ++i) { const int ct = tid + 512 * i, key = ct >> 3, ch = ct & 7; const int kp = qb * 128 - 128 + key; const bool valid = (kp >= 0) && (kp < T);
        v4u kw = kwa[i], vw = vwa[i];
        if (!valid) { kw = (v4u){0u, 0u, 0u, 0u}; vw = kw; }
        float kf[8] = {bflo(kw.x), bfhi(kw.x), bflo(kw.y), bfhi(kw.y), bflo(kw.z), bfhi(kw.z), bflo(kw.w), bfhi(kw.w)};
        float ss = 0.f;
#pragma unroll
        for (int j = 0; j < 8; ++j) ss += kf[j] * kf[j];
        ss += __shfl_xor(ss, 1); ss += __shfl_xor(ss, 2); ss += __shfl_xor(ss, 4);
        const float rs = rsqrtf(ss * (1.0f / 64.0f) + 1e-6f);
#pragma unroll
        for (int j = 0; j < 8; ++j) kf[j] = kf[j] * rs * kg[ch * 8 + j];
        float oth[8];
#pragma unroll
        for (int j = 0; j < 8; ++j) oth[j] = __shfl_xor(kf[j], 1);
        if (ch < 2) { const v4u cw = rca[i], sw = rsa[i];
            const float cs[8] = {bflo(cw.x), bfhi(cw.x), bflo(cw.y), bfhi(cw.y), bflo(cw.z), bfhi(cw.z), bflo(cw.w), bfhi(cw.w)};
            const float sn[8] = {bflo(sw.x), bfhi(sw.x), bflo(sw.y), bfhi(sw.y), bflo(sw.z), bfhi(sw.z), bflo(sw.w), bfhi(sw.w)};
#pragma unroll
            for (int j = 0; j < 8; ++j) kf[j] = (ch == 0) ? (kf[j] * cs[j] - oth[j] * sn[j]) : (kf[j] * cs[j] + oth[j] * sn[j]); }
        v4u ko; ko.x = pk2(kf[0], kf[1]); ko.y = pk2(kf[2], kf[3]); ko.z = pk2(kf[4], kf[5]); ko.w = pk2(kf[6], kf[7]);
        *(LAS v4u*)(KS + key * KST + ch * 8) = ko;
        const unsigned vv[4] = {vw.x, vw.y, vw.z, vw.w};
#pragma unroll
        for (int j = 0; j < 4; ++j) { VT[(ch * 8 + 2 * j) * VST + key] = (bf16)(vv[j] & 0xffffu); VT[(ch * 8 + 2 * j + 1) * VST + key] = (bf16)(vv[j] >> 16); } }
    __syncthreads();
    const int g = wave >> 1, hq = kvh * 4 + g, r32 = lane & 31, hh = lane >> 5;
    const float snk = sink[hq];
    float kbound; { float gm = fabsf(kg[lane]);
#pragma unroll
        for (int o = 1; o < 64; o <<= 1) gm = fmaxf(gm, __shfl_xor(gm, o));
        kbound = 8.0f * gm; }
#pragma unroll 1
    for (int qt = 0; qt < 2; ++qt) { const int qo = (wave & 1) * 64 + qt * 32, qrel = qo + r32; const size_t tok = (size_t)b * T + qb * 128 + qrel;
        float qf[4][8]; float ss = 0.f; v4u qraw[4];
#pragma unroll
        for (int sI = 0; sI < 4; ++sI) qraw[sI] = qn[sI];
        const v4u qrc = qnc, qrs = qns;
        if (qt == 0) { const size_t tok1 = tok + 32;
#pragma unroll
            for (int sI = 0; sI < 4; ++sI) qn[sI] = *(const GAS v4u*)(Z + tok1 * NZ + ZQ + hq * 64 + 16 * sI + 8 * hh);
            const GAS v4u* qrt1 = (const GAS v4u*)((const bf16*)(A->ws + WS_ROPE) + tok1 * 16); qnc = qrt1[0]; qns = qrt1[1]; }
#pragma unroll
        for (int sI = 0; sI < 4; ++sI) { const v4u qw = qraw[sI];
            qf[sI][0] = bflo(qw.x); qf[sI][1] = bfhi(qw.x); qf[sI][2] = bflo(qw.y); qf[sI][3] = bfhi(qw.y); qf[sI][4] = bflo(qw.z); qf[sI][5] = bfhi(qw.z); qf[sI][6] = bflo(qw.w); qf[sI][7] = bfhi(qw.w);
#pragma unroll
            for (int j = 0; j < 8; ++j) ss += qf[sI][j] * qf[sI][j]; }
        ss += __shfl_xor(ss, 32);
        const float rs = rsqrtf(ss * (1.0f / 64.0f) + 1e-6f) * 0.125f;
#pragma unroll
        for (int sI = 0; sI < 4; ++sI)
#pragma unroll
            for (int j = 0; j < 8; ++j) qf[sI][j] = qf[sI][j] * rs * qg[16 * sI + 8 * hh + j];
        { const v4u cw = qrc, sw = qrs;
          const float cs[8] = {bflo(cw.x), bfhi(cw.x), bflo(cw.y), bfhi(cw.y), bflo(cw.z), bfhi(cw.z), bflo(cw.w), bfhi(cw.w)}, sn[8] = {bflo(sw.x), bfhi(sw.x), bflo(sw.y), bfhi(sw.y), bflo(sw.z), bfhi(sw.z), bflo(sw.w), bfhi(sw.w)};
#pragma unroll
          for (int j = 0; j < 8; ++j) { const float oth = __shfl_xor(qf[0][j], 32); qf[0][j] = (hh == 0) ? (qf[0][j] * cs[j] - oth * sn[j]) : (qf[0][j] * cs[j] + oth * sn[j]); } }
        bf16x8 qr[4];
#pragma unroll
        for (int sI = 0; sI < 4; ++sI) { v4u w; w.x = pk2(qf[sI][0], qf[sI][1]); w.y = pk2(qf[sI][2], qf[sI][3]); w.z = pk2(qf[sI][4], qf[sI][5]); w.w = pk2(qf[sI][6], qf[sI][7]); qr[sI] = __builtin_bit_cast(bf16x8, w); }
        const int kt0 = qo >> 5;
        float qn2 = 0.f;
#pragma unroll
        for (int sI = 0; sI < 4; ++sI)
#pragma unroll
            for (int j = 0; j < 8; ++j) qn2 += qf[sI][j] * qf[sI][j];
        qn2 += __shfl_xor(qn2, 32);
        float mrun = sqrtf(qn2) * kbound * 1.02f;
        if (__any(mrun > 40.f)) { mrun = -1e30f;
#pragma unroll 1
            for (int kt = 0; kt < 9; ++kt) { const int kbase = (kt0 + kt) * 32;
                f32x16 acc = {};
#pragma unroll
                for (int sI = 0; sI < 4; ++sI) { const bf16x8 kfr = *(const LAS bf16x8*)(KS + (kbase + r32) * KST + 16 * sI + 8 * hh); acc = __builtin_amdgcn_mfma_f32_32x32x16_bf16(kfr, qr[sI], acc, 0, 0, 0); }
#pragma unroll
                for (int r = 0; r < 16; ++r) { const int ki = kbase + (r & 3) + 8 * (r >> 2) + 4 * hh; const int dq = ki - 128 - qrel, kp = qb * 128 - 128 + ki;
                    const bool ok = (dq >= -128) && (dq <= 128) && (kp >= 0) && (kp < T); mrun = fmaxf(mrun, ok ? acc[r] : -1e30f); } }
            mrun = fmaxf(mrun, __shfl_xor(mrun, 32)); }
        const float mx = fmaxf(mrun, snk);
        float lrun = 0.f; f32x16 o0 = {}, o1 = {}; const float mxl = mx * 1.442695041f; const bool edge = (qb == 0) || (qb == T / 128 - 1);
#pragma unroll 1
        for (int kt = 0; kt < 9; ++kt) { const int kbase = (kt0 + kt) * 32;
            f32x16 acc = {};
#pragma unroll
            for (int sI = 0; sI < 4; ++sI) { const bf16x8 kfr = *(const LAS bf16x8*)(KS + (kbase + r32) * KST + 16 * sI + 8 * hh); acc = __builtin_amdgcn_mfma_f32_32x32x16_bf16(kfr, qr[sI], acc, 0, 0, 0); }
            float p[16];
            if (edge || kt == 0 || kt == 8) {
#pragma unroll
                for (int r = 0; r < 16; ++r) { const int ki = kbase + (r & 3) + 8 * (r >> 2) + 4 * hh; const int dq = ki - 128 - qrel, kp = qb * 128 - 128 + ki;
                    const bool ok = (dq >= -128) && (dq <= 128) && (kp >= 0) && (kp < T); p[r] = ok ? __builtin_amdgcn_exp2f(acc[r] * 1.442695041f - mxl) : 0.f; lrun += p[r]; }
            } else {
#pragma unroll
                for (int r = 0; r < 16; ++r) { p[r] = __builtin_amdgcn_exp2f(acc[r] * 1.442695041f - mxl); lrun += p[r]; } }
#pragma unroll
            for (int sI = 0; sI < 2; ++sI) { v4u pw; pw.x = pk2(p[8 * sI + 0], p[8 * sI + 1]); pw.y = pk2(p[8 * sI + 2], p[8 * sI + 3]); pw.z = pk2(p[8 * sI + 4], p[8 * sI + 5]); pw.w = pk2(p[8 * sI + 6], p[8 * sI + 7]);
                const bf16x8 pa = __builtin_bit_cast(bf16x8, pw); const int key0 = kbase + 16 * sI + 4 * hh;
                { const u32x2 lo = *(const LAS u32x2*)(VT + r32 * VST + key0), hi = *(const LAS u32x2*)(VT + r32 * VST + key0 + 8); v4u vw; vw.x = lo.x; vw.y = lo.y; vw.z = hi.x; vw.w = hi.y;
                  o0 = __builtin_amdgcn_mfma_f32_32x32x16_bf16(pa, __builtin_bit_cast(bf16x8, vw), o0, 0, 0, 0); }
                { const u32x2 lo = *(const LAS u32x2*)(VT + (32 + r32) * VST + key0), hi = *(const LAS u32x2*)(VT + (32 + r32) * VST + key0 + 8); v4u vw; vw.x = lo.x; vw.y = lo.y; vw.z = hi.x; vw.w = hi.y;
                  o1 = __builtin_amdgcn_mfma_f32_32x32x16_bf16(pa, __builtin_bit_cast(bf16x8, vw), o1, 0, 0, 0); } } }
        lrun += __shfl_xor(lrun, 32);
        const float linv = 1.0f / (lrun + __expf(snk - mx));
        if (hh == 0) wsf[wave * 64 + r32] = linv;
        LDS_WAIT(); asm volatile("" ::: "memory");
#pragma unroll
        for (int r = 0; r < 16; ++r) { const int row = (r & 3) + 8 * (r >> 2) + 4 * hh; const float li = wsf[wave * 64 + row];
            bf16* op = OA + ((size_t)b * T + qb * 128 + qo + row) * 512 + hq * 64;
            op[r32] = (bf16)f2bf(o0[r] * li); op[32 + r32] = (bf16)f2bf(o1[r] * li); }
        LDS_WAIT(); asm volatile("" ::: "memory");
    }
    __syncthreads();
}

__device__ __forceinline__ void pg_rows(const Frame& F, ArgsP A, bf16* wout) {
    const bf16* Z = (const bf16*)(A->ws + WS_Z); const bf16* Y0 = (const bf16*)(A->ws + WS_XN); const bf16* Y1 = Y0 + (size_t)M * 512;
    bf16* Gb = (bf16*)(A->ws + WS_G); const float* bonus = (const float*)(A->ws + WS_BONUS);
    const float* mu_prev = (const float*)A->in[7]; const float* mu_next = (const float*)A->in[8]; const float* gn_w = (const float*)A->in[17]; const float* gn_b = (const float*)A->in[18];
    const int gw = F.vcu * NWAVES + F.wave, NGW = F.G * NWAVES, lane = F.lane, c0 = lane * 8, h = lane >> 3;
    float mp[8], mn[8], gw_[8], gb_[8];
#pragma unroll
    for (int j = 0; j < 8; ++j) { mp[j] = mu_prev[ZV + c0 + j]; mn[j] = mu_next[ZV + c0 + j]; gw_[j] = gn_w[c0 + j]; gb_[j] = gn_b[c0 + j]; }
#pragma unroll 1
    for (int m0 = gw; m0 < M; m0 += 4 * NGW) {
        v4u y0[4], y1[4], gv[4], z0[4], zm[4], zq[4]; float bon[4];
#pragma unroll
        for (int i = 0; i < 4; ++i) { const int m = m0 + i * NGW, t = m & (T - 1);
            y0[i] = *(const GAS v4u*)(Y0 + (size_t)m * 512 + c0); y1[i] = *(const GAS v4u*)(Y1 + (size_t)m * 512 + c0); gv[i] = *(const GAS v4u*)(Gb + (size_t)m * 512 + c0);
            z0[i] = *(const GAS v4u*)(Z + (size_t)m * NZ + ZV + c0);
            zm[i] = (v4u){0u, 0u, 0u, 0u}; zq[i] = (v4u){0u, 0u, 0u, 0u};
            if (t > 0) zm[i] = *(const GAS v4u*)(Z + (size_t)(m - 1) * NZ + ZV + c0);
            if (t < T - 1) zq[i] = *(const GAS v4u*)(Z + (size_t)(m + 1) * NZ + ZV + c0);
            bon[i] = bonus[(size_t)m * 8 + h] + bonus[(size_t)M * 8 + (size_t)m * 8 + h]; }
#pragma unroll
        for (int i = 0; i < 4; ++i) { const int m = m0 + i * NGW;
            const unsigned y0w[4] = {y0[i].x, y0[i].y, y0[i].z, y0[i].w}, y1w[4] = {y1[i].x, y1[i].y, y1[i].z, y1[i].w}, gvw[4] = {gv[i].x, gv[i].y, gv[i].z, gv[i].w};
            const unsigned z0w[4] = {z0[i].x, z0[i].y, z0[i].z, z0[i].w}, zmw[4] = {zm[i].x, zm[i].y, zm[i].z, zm[i].w}, zqw[4] = {zq[i].x, zq[i].y, zq[i].z, zq[i].w};
            float y[8], gg[8], vv[8]; float sacc = 0.f;
#pragma unroll
            for (int j = 0; j < 4; ++j) { y[2 * j] = bflo(y0w[j]) + bflo(y1w[j]); y[2 * j + 1] = bfhi(y0w[j]) + bfhi(y1w[j]); gg[2 * j] = bflo(gvw[j]); gg[2 * j + 1] = bfhi(gvw[j]);
                const float a0 = bflo(z0w[j]), a1 = bfhi(z0w[j]);
                vv[2 * j] = a0 + mp[2 * j] * (bflo(zmw[j]) - a0) + mn[2 * j] * (bflo(zqw[j]) - a0); vv[2 * j + 1] = a1 + mp[2 * j + 1] * (bfhi(zmw[j]) - a1) + mn[2 * j + 1] * (bfhi(zqw[j]) - a1);
                sacc += y[2 * j] + y[2 * j + 1]; }
            sacc += __shfl_xor(sacc, 1); sacc += __shfl_xor(sacc, 2); sacc += __shfl_xor(sacc, 4);
            const float mu = sacc * (1.0f / 64.0f); float q = 0.f;
#pragma unroll
            for (int j = 0; j < 8; ++j) { const float d = y[j] - mu; q += d * d; }
            q += __shfl_xor(q, 1); q += __shfl_xor(q, 2); q += __shfl_xor(q, 4);
            const float rstd = rsqrtf(q * (1.0f / 64.0f) + 64e-5f);
            float o[8];
#pragma unroll
            for (int j = 0; j < 8; ++j) o[j] = ((y[j] - mu) * rstd * gw_[j] + gb_[j] + bon[i] * vv[j]) * gg[j];
            v4u w; w.x = pk2(o[0], o[1]); w.y = pk2(o[2], o[3]); w.z = pk2(o[4], o[5]); w.w = pk2(o[6], o[7]);
            *(GAS v4u*)(wout + (size_t)m * 512 + c0) = w; } }
}

constexpr int CONV_PER = 512, CONV_NIT = 16 * 3 * CONV_PER, CONV_EARLY = 6144;
__device__ __forceinline__ void conv_items(const Frame& F, ArgsP A, int it0, int it1, int widx, int nw) {
    LAS float* scr = (LAS float*)(F.lds + F.wave * 16384); const int lane = F.lane;
    const float* w_gate = (const float*)A->in[27]; const float* w_up = (const float*)A->in[28]; const float* w_down = (const float*)A->in[29];
    bf16* WguT = (bf16*)((unsigned char*)A->out + OUT_WGUT); bf16* WdT = (bf16*)((unsigned char*)A->out + OUT_WDT);
    auto src_of = [&](int it, const float*& W, int& k0, int& n0, bf16*& WT, int& row0) { const int e = it / (3 * CONV_PER), r = it % (3 * CONV_PER), which = r / CONV_PER, q = r % CONV_PER, kb = q >> 5, nb = q & 31; k0 = 64 * kb; n0 = 32 * nb;
        if (which == 0) { W = w_gate + (size_t)e * 1048576; WT = WguT; row0 = e * 2048 + (n0 >> 7) * 256 + (n0 & 127); }
        else if (which == 1) { W = w_up + (size_t)e * 1048576; WT = WguT; row0 = e * 2048 + (n0 >> 7) * 256 + 128 + (n0 & 127); }
        else { W = w_down + (size_t)e * 1048576; WT = WdT; row0 = e * 1024 + n0; } };
    int it = it0 + widx; if (it >= it1) return;
    f32x4 va[8], vb[8]; const float* W; int k0, n0, row0; bf16* WT; src_of(it, W, k0, n0, WT, row0); tr_load(va, W, 1024, k0, n0, lane);
#pragma unroll 1
    for (;;) { const int itn = it + nw; const float* W2; int k2 = 0, n2 = 0, row2 = 0; bf16* WT2 = WT;
        if (itn < it1) { src_of(itn, W2, k2, n2, WT2, row2); tr_load(vb, W2, 1024, k2, n2, lane); }
        tr_store(va, k0, WT, 1024, row0, scr, lane);
        if (itn >= it1) break;
#pragma unroll
        for (int i = 0; i < 8; ++i) va[i] = vb[i];
        it = itn; k0 = k2; WT = WT2; row0 = row2; }
}
__device__ __forceinline__ int conv_idle_first(int G);
__device__ __forceinline__ void conv_one(LAS unsigned char* lds, int wave, int lane, ArgsP A, int it) {
    LAS float* scr = (LAS float*)(lds + wave * 16384);
    const float* w_gate = (const float*)A->in[27]; const float* w_up = (const float*)A->in[28]; const float* w_down = (const float*)A->in[29];
    bf16* WguT = (bf16*)((unsigned char*)A->out + OUT_WGUT); bf16* WdT = (bf16*)((unsigned char*)A->out + OUT_WDT);
    const int e = it / (3 * CONV_PER), r = it % (3 * CONV_PER), which = r / CONV_PER, q = r % CONV_PER, kb = q >> 5, nb = q & 31, n0 = 32 * nb;
    if (which == 0) tr_item(w_gate + (size_t)e * 1048576, 1024, 64 * kb, n0, WguT, 1024, e * 2048 + (n0 >> 7) * 256 + (n0 & 127), scr, lane);
    else if (which == 1) tr_item(w_up + (size_t)e * 1048576, 1024, 64 * kb, n0, WguT, 1024, e * 2048 + (n0 >> 7) * 256 + 128 + (n0 & 127), scr, lane);
    else tr_item(w_down + (size_t)e * 1048576, 1024, 64 * kb, n0, WdT, 1024, e * 1024 + n0, scr, lane);
}
#ifndef SHADOW_WAVES
#define SHADOW_WAVES 3
#endif
constexpr int CONV_SLOTS = 9, CONV_SW = SHADOW_WAVES;
__device__ __forceinline__ int conv_base(int G) { return conv_idle_first(G) < G ? CONV_EARLY : 0; }
__device__ __forceinline__ void xcd_barrier_shadow(const XcdBarrier& b, bool is_thread0, int wave, LAS unsigned char* lds, ArgsP A, int slot) {
    asm volatile("s_waitcnt vmcnt(0)" ::: "memory");
    __syncthreads();
    if (wave == 0) { if (is_thread0) xcd_barrier_t0(b); }
    else if (wave <= CONV_SW) { const int G = (int)gridDim.x; const int it = conv_base(G) + (slot * G + (int)blockIdx.x) * CONV_SW + (wave - 1);
        if (it < CONV_NIT) { unsigned o_ = ~0u; asm volatile("" : "+s"(o_)); const int lane = (int)__builtin_amdgcn_mbcnt_hi(o_, __builtin_amdgcn_mbcnt_lo(o_, 0u)); conv_one(lds, wave, lane, A, it); } }
    __syncthreads();
}
__device__ __forceinline__ int conv_idle_first(int G) { const int nwg = (M / 256) * (NZP / 256), mx = (nwg + G - 1) / G; return nwg - (mx - 1) * G; }
__device__ __forceinline__ void pj_phase(const Frame& F, ArgsP A) {
    unsigned char* ws = A->ws;
    const int gw = F.vcu * NWAVES + F.wave, NGW = F.G * NWAVES, lane = F.lane;
    { const int first = conv_base(F.G) + CONV_SLOTS * F.G * CONV_SW; if (first < CONV_NIT) conv_items(F, A, first, CONV_NIT, gw, NGW); }
    __syncthreads();
    const float* w_router = (const float*)A->in[26]; const bf16* x1 = (const bf16*)(ws + WS_X1); const float* g2n = (const float*)A->in[25]; const float* mod = (const float*)(ws + WS_MOD);
    bf16* XN2 = (bf16*)(ws + WS_XN); float* aff = (float*)(ws + WS_AFF);
    LAS bf16* WF = (LAS bf16*)F.lds;
    LAS float* AT = (LAS float*)(F.lds + 65536); LAS float* BT = AT + 1024; LAS float* CB = BT + 1024;
    const int tile = gw, b = tile >> 7;
    for (int d = F.tid; d < 1024; d += 512) { AT[d] = g2n[d] * (1.0f + mod[(size_t)b * 6144 + 4096 + d]); BT[d] = mod[(size_t)b * 6144 + 3072 + d]; }
    __syncthreads();
#pragma unroll 4
    for (int k = 0; k < 32; ++k) { const int it = F.tid + 512 * k, jj = it & 7, ln = (it >> 3) & 63, sI = it >> 9, q = ln >> 4, e = ln & 15, d = 32 * sI + 8 * q + jj;
        const float v = AT[d] * w_router[d * 16 + e]; const unsigned hi = pk2(v, 0.f) & 0xffffu; const float lo = v - __uint_as_float(hi << 16);
        WF[it] = (bf16)hi; WF[16384 + it] = (bf16)(pk2(lo, 0.f) & 0xffffu); }
    { float c0 = 0.f, c1 = 0.f;
#pragma unroll 4
      for (int k = 0; k < 16; ++k) { const int d = lane + 64 * k; c0 += BT[d] * w_router[d * 16 + 2 * F.wave]; c1 += BT[d] * w_router[d * 16 + 2 * F.wave + 1]; }
      c0 = dpp_wave_sum(c0); c1 = dpp_wave_sum(c1); if (lane == 0) { CB[2 * F.wave] = c0; CB[2 * F.wave + 1] = c1; } }
    __syncthreads();
    if (tile < M / 16) { const int r = lane & 15, q = lane >> 4; const size_t m = (size_t)tile * 16 + r;
        float ss = 0.f;
#pragma unroll 1
        for (int hf = 0; hf < 2; ++hf) { v4u raw[16];
#pragma unroll
            for (int sI = 0; sI < 16; ++sI) raw[sI] = *(const GAS v4u*)(x1 + m * 1024 + 32 * (16 * hf + sI) + 8 * q);
#pragma unroll
            for (int sI = 0; sI < 16; ++sI) { const v4u w = raw[sI]; const float a0 = bflo(w.x), a1 = bfhi(w.x), a2 = bflo(w.y), a3 = bfhi(w.y), a4 = bflo(w.z), a5 = bfhi(w.z), a6 = bflo(w.w), a7 = bfhi(w.w);
                ss += (a0 * a0 + a1 * a1) + (a2 * a2 + a3 * a3) + (a4 * a4 + a5 * a5) + (a6 * a6 + a7 * a7); } }
        ss += __shfl_xor(ss, 16); ss += __shfl_xor(ss, 32);
        const float rs = rsqrtf(ss * (1.0f / 1024.0f) + 1e-6f);
        f32x4 ah = {0.f, 0.f, 0.f, 0.f}, al = {0.f, 0.f, 0.f, 0.f};
#pragma unroll 1
        for (int hf = 0; hf < 2; ++hf) { v4u raw[16];
#pragma unroll
            for (int sI = 0; sI < 16; ++sI) raw[sI] = *(const GAS v4u*)(x1 + m * 1024 + 32 * (16 * hf + sI) + 8 * q);
#pragma unroll
            for (int sI = 0; sI < 16; ++sI) { const int sg = 16 * hf + sI; const bf16x8 xa = __builtin_bit_cast(bf16x8, raw[sI]);
                const bf16x8 bh = *(const LAS bf16x8*)(WF + (sg * 64 + lane) * 8), bl = *(const LAS bf16x8*)(WF + 16384 + (sg * 64 + lane) * 8);
                ah = __builtin_amdgcn_mfma_f32_16x16x32_bf16(xa, bh, ah, 0, 0, 0); al = __builtin_amdgcn_mfma_f32_16x16x32_bf16(xa, bl, al, 0, 0, 0); }
#pragma unroll
            for (int sI = 0; sI < 16; ++sI) { if ((sI & 3) == 0) asm volatile("" ::: "memory");
                const int d0 = 32 * (16 * hf + sI) + 8 * q; const v4u w = raw[sI];
                const f32x4 a0 = *(const LAS f32x4*)(AT + d0), a1 = *(const LAS f32x4*)(AT + d0 + 4), b0 = *(const LAS f32x4*)(BT + d0), b1 = *(const LAS f32x4*)(BT + d0 + 4);
                v4u o; o.x = pk2(bflo(w.x) * rs * a0.x + b0.x, bfhi(w.x) * rs * a0.y + b0.y); o.y = pk2(bflo(w.y) * rs * a0.z + b0.z, bfhi(w.y) * rs * a0.w + b0.w);
                o.z = pk2(bflo(w.z) * rs * a1.x + b1.x, bfhi(w.z) * rs * a1.y + b1.y); o.w = pk2(bflo(w.w) * rs * a1.z + b1.z, bfhi(w.w) * rs * a1.w + b1.w);
                *(GAS v4u*)(XN2 + m * 1024 + d0) = o; } }
        const float cb = CB[lane & 15]; float lg[4], mx[4], ex[4], den[4];
#pragma unroll
        for (int i = 0; i < 4; ++i) { const float rsr = __shfl(rs, 4 * q + i); lg[i] = rsr * (ah[i] + al[i]) + cb; mx[i] = lg[i]; }
#pragma unroll
        for (int o = 1; o < 16; o <<= 1)
#pragma unroll
            for (int i = 0; i < 4; ++i) mx[i] = fmaxf(mx[i], __shfl_xor(mx[i], o));
#pragma unroll
        for (int i = 0; i < 4; ++i) { ex[i] = expf(lg[i] - mx[i]); den[i] = ex[i]; }
#pragma unroll
        for (int o = 1; o < 16; o <<= 1)
#pragma unroll
            for (int i = 0; i < 4; ++i) den[i] += __shfl_xor(den[i], o);
        { const int t0 = (tile & 127) * 16 + 4 * q; f32x4 av; av.x = ex[0] / den[0]; av.y = ex[1] / den[1]; av.z = ex[2] / den[2]; av.w = ex[3] / den[3];
          *(GAS f32x4*)(aff + ((size_t)b * 16 + (lane & 15)) * T + t0) = av; } }
}

__device__ __forceinline__ void pk_task(const Frame& F, ArgsP A, int b, int e) {
    unsigned char* ws = A->ws;
    const float* aff = (const float*)(ws + WS_AFF) + ((size_t)b * 16 + e) * T;
    int* slotmap = (int*)(ws + WS_SLOT); float* selaff = (float*)(ws + WS_SELAFF); int* selidx = (int*)(ws + WS_SELIDX);
    const bf16* XN2 = (const bf16*)(ws + WS_XN); bf16* XE = (bf16*)(ws + WS_XE);
    LAS unsigned* cnt = (LAS unsigned*)F.lds;
    LAS int* tokl = (LAS int*)(F.lds + 256);
    const int tid = F.tid, lane = F.lane, wave = F.wave;
    const f32x4 v4 = *(const GAS f32x4*)(aff + 4 * tid);
    const unsigned key[4] = {__float_as_uint(v4.x), __float_as_uint(v4.y), __float_as_uint(v4.z), __float_as_uint(v4.w)};
    unsigned thr = 0u;
#pragma unroll 1
    for (int bit = 31; bit >= 0; --bit) { const unsigned cand = thr | (1u << bit);
        const unsigned c = (unsigned)(__popcll(__ballot(key[0] >= cand)) + __popcll(__ballot(key[1] >= cand)) + __popcll(__ballot(key[2] >= cand)) + __popcll(__ballot(key[3] >= cand)));
        LAS unsigned* slot_ = cnt + 16 + (bit & 1) * 8;
        if (lane == 0) slot_[wave] = c;
        __syncthreads();
        unsigned tot = 0;
#pragma unroll
        for (int w = 0; w < 8; ++w) tot += slot_[w];
        if (tot >= 256u) thr = cand; }
    __syncthreads();
    int ngt = 0, neq = 0;
#pragma unroll
    for (int j = 0; j < 4; ++j) { ngt += key[j] > thr; neq += key[j] == thr; }
    int sg = ngt, se = neq;
#pragma unroll
    for (int o = 1; o < 64; o <<= 1) { const int a = __shfl_up(sg, o), c = __shfl_up(se, o); if (lane >= o) { sg += a; se += c; } }
    if (lane == 63) { cnt[wave] = (unsigned)sg; cnt[8 + wave] = (unsigned)se; }
    __syncthreads();
    int bg = 0, be = 0, totg = 0;
#pragma unroll
    for (int w = 0; w < 8; ++w) { const int a = (int)cnt[w], c = (int)cnt[8 + w]; if (w < wave) { bg += a; be += c; } totg += a; }
    int pg = bg + sg - ngt, pe = be + se - neq;
    const int need_eq = 256 - totg;
    int* smrow = slotmap + ((size_t)b * T + 4 * tid) * 16 + e;
#pragma unroll
    for (int j = 0; j < 4; ++j) { int slot = -1;
        if (key[j] > thr) { slot = pg; ++pg; } else if (key[j] == thr) { if (pe < need_eq) slot = totg + pe; ++pe; }
        smrow[j * 16] = slot;
        if (slot >= 0) { selidx[((size_t)e * 16 + b) * 256 + slot] = b * T + 4 * tid + j; selaff[((size_t)e * 16 + b) * 256 + slot] = __uint_as_float(key[j]); } }
    __syncthreads();
}

__device__ __forceinline__ void pn_rows(const Frame& F, ArgsP A, float* wout) {
    unsigned char* ws = A->ws;
    const int* slotmap = (const int*)(ws + WS_SLOT); const bf16* YE = (const bf16*)(ws + WS_XE); const float* mod = (const float*)(ws + WS_MOD); const bf16* X1 = (const bf16*)(ws + WS_X1);
    const int gw = F.vcu * NWAVES + F.wave, NGW = F.G * NWAVES, lane = F.lane;
#pragma unroll 1
    for (int m0 = gw * 16; m0 < gw * 16 + 16; m0 += 2) {
        int myslot[2]; f32x4 xv[2][4];
#pragma unroll
        for (int i = 0; i < 2; ++i) { const int m = m0 + i; myslot[i] = slotmap[(size_t)m * 16 + (lane & 15)];
#pragma unroll
            for (int hq = 0; hq < 2; ++hq) { const v4u w = *(const GAS v4u*)(X1 + (size_t)m * 1024 + hq * 512 + lane * 8);
                xv[i][2 * hq] = (f32x4){bflo(w.x), bfhi(w.x), bflo(w.y), bfhi(w.y)}; xv[i][2 * hq + 1] = (f32x4){bflo(w.z), bfhi(w.z), bflo(w.w), bfhi(w.w)}; } }
        unsigned long long msk[2]; v4u yw[2][4][2];
#pragma unroll
        for (int i = 0; i < 2; ++i) { const int b = (m0 + i) >> 11; msk[i] = __ballot(myslot[i] >= 0) & 0xffffull;
#pragma unroll
            for (int k = 0; k < 4; ++k) { const bool has = msk[i] != 0ull; const int e = has ? __builtin_ctzll(msk[i]) : 0; if (has) msk[i] &= msk[i] - 1; const int sl = __shfl(myslot[i], e);
                yw[i][k][0] = (v4u){0u, 0u, 0u, 0u}; yw[i][k][1] = (v4u){0u, 0u, 0u, 0u};
                if (has) { const GAS v4u* yr = (const GAS v4u*)(YE + (((size_t)e * 16 + b) * 256 + sl) * 1024); yw[i][k][0] = yr[lane]; yw[i][k][1] = yr[64 + lane]; } } }
#pragma unroll
        for (int i = 0; i < 2; ++i) { const int m = m0 + i, b = m >> 11;
            float acc[16];
#pragma unroll
            for (int j = 0; j < 16; ++j) acc[j] = 0.f;
#pragma unroll
            for (int k = 0; k < 4; ++k)
#pragma unroll
                for (int hlf = 0; hlf < 2; ++hlf) { const v4u w = yw[i][k][hlf];
                    acc[hlf * 8 + 0] += bflo(w.x); acc[hlf * 8 + 1] += bfhi(w.x); acc[hlf * 8 + 2] += bflo(w.y); acc[hlf * 8 + 3] += bfhi(w.y);
                    acc[hlf * 8 + 4] += bflo(w.z); acc[hlf * 8 + 5] += bfhi(w.z); acc[hlf * 8 + 6] += bflo(w.w); acc[hlf * 8 + 7] += bfhi(w.w); }
            unsigned long long mk = msk[i];
            while (mk) { const int e = __builtin_ctzll(mk); mk &= mk - 1; const int sl = __shfl(myslot[i], e);
                const GAS v4u* yr = (const GAS v4u*)(YE + (((size_t)e * 16 + b) * 256 + sl) * 1024);
#pragma unroll
                for (int hlf = 0; hlf < 2; ++hlf) { const v4u w = yr[hlf * 64 + lane];
                    acc[hlf * 8 + 0] += bflo(w.x); acc[hlf * 8 + 1] += bfhi(w.x); acc[hlf * 8 + 2] += bflo(w.y); acc[hlf * 8 + 3] += bfhi(w.y);
                    acc[hlf * 8 + 4] += bflo(w.z); acc[hlf * 8 + 5] += bfhi(w.z); acc[hlf * 8 + 6] += bflo(w.w); acc[hlf * 8 + 7] += bfhi(w.w); } }
            const float* gt2 = mod + (size_t)b * 6144 + 5120; float* orow = wout + (size_t)m * 1024;
#pragma unroll
            for (int q = 0; q < 4; ++q) { const int c = (q >> 1) * 512 + lane * 8 + (q & 1) * 4; const f32x4 g = *(const GAS f32x4*)(gt2 + c);
                f32x4 a; a.x = acc[(q >> 1) * 8 + (q & 1) * 4 + 0]; a.y = acc[(q >> 1) * 8 + (q & 1) * 4 + 1]; a.z = acc[(q >> 1) * 8 + (q & 1) * 4 + 2]; a.w = acc[(q >> 1) * 8 + (q & 1) * 4 + 3];
                *(GAS f32x4*)(orow + c) = xv[i][q] + g * a; } } }
}

__device__ __forceinline__ void mk_frame(Frame& F, LAS unsigned char* lds, int wave_s) {
    int bx = blockIdx.x, G = gridDim.x; LAUNDER(bx); LAUNDER(G);
    F.lds = lds; F.MISC = (volatile LAS unsigned*)(lds + MISC_OFF); F.ctl = nullptr;
    unsigned ones_ = ~0u; asm volatile("" : "+s"(ones_));
    int lane_ = (int)__builtin_amdgcn_mbcnt_hi(ones_, __builtin_amdgcn_mbcnt_lo(ones_, 0u)); asm volatile("" : "+v"(lane_));
    F.lane = lane_; F.wave = wave_s; F.tid = wave_s * 64 + lane_;
    F.G = G; F.vcu = (G % 8 == 0) ? (bx % 8) * (G / 8) + bx / 8 : bx;
}
__global__ void __launch_bounds__(NWAVES * 64, 2) fwd_kernel(Args args) {
    extern __shared__ __attribute__((aligned(16))) unsigned char lds[];
    LAS unsigned char* const ldsb = (LAS unsigned char*)lds;
    ArgsP ap0 = (ArgsP)__builtin_amdgcn_kernarg_segment_ptr();
    int wave_s = __builtin_amdgcn_readfirstlane((int)threadIdx.x >> 6); asm volatile("" : "+s"(wave_s));
    for (int u = threadIdx.x; u < (LDS_BYTES - LDSCTL_OFF) / 4; u += NWAVES * 64) ((LAS unsigned*)(ldsb + LDSCTL_OFF))[u] = 0u;
    __syncthreads();
#define MKBAR XcdBarrier bar; { ArgsP a_ = ap0; LAUNDER(a_); bar.bar = (unsigned*)(a_->ws + WS_CTL) + CW_BAR; bar.x = xb_xcc_id(); bar.st = (volatile LAS unsigned*)(ldsb + MISC_OFF) + 8; }
#if ONE_LAUNCH
    { MKBAR; if (threadIdx.x == 0) (void)xb_add(&bar.bar[XB_XCNT(bar.x)], 1u); }
#ifndef PHM
#define PHM 0x3fff
#endif
#define IN(k) ((PHM >> (k)) & 1)
#define GRIDBAR() do { MKBAR; { unsigned o_ = ~0u; asm volatile("" : "+s"(o_)); xcd_barrier(bar, wave_s == 0 && __builtin_amdgcn_mbcnt_hi(o_, __builtin_amdgcn_mbcnt_lo(o_, 0u)) == 0u); } } while (0)
#define GRIDBARC(slot) do { MKBAR; { unsigned o_ = ~0u; asm volatile("" : "+s"(o_)); ArgsP a2_ = ap0; LAUNDER(a2_); xcd_barrier_shadow(bar, wave_s == 0 && __builtin_amdgcn_mbcnt_hi(o_, __builtin_amdgcn_mbcnt_lo(o_, 0u)) == 0u, wave_s, ldsb, a2_, slot); } } while (0)
#define SEAMC(k, slot) do { if (IN(k) && IN((k) + 1)) { MKBAR; { unsigned o_ = ~0u; asm volatile("" : "+s"(o_)); ArgsP a2_ = ap0; LAUNDER(a2_); xcd_barrier_shadow(bar, wave_s == 0 && __builtin_amdgcn_mbcnt_hi(o_, __builtin_amdgcn_mbcnt_lo(o_, 0u)) == 0u, wave_s, ldsb, a2_, slot); } } } while (0)
#define SEAM(k) do { if (IN(k) && IN((k) + 1)) { MKBAR; { unsigned o_ = ~0u; asm volatile("" : "+s"(o_)); xcd_barrier(bar, wave_s == 0 && __builtin_amdgcn_mbcnt_hi(o_, __builtin_amdgcn_mbcnt_lo(o_, 0u)) == 0u); } } } while (0)
#else
    int lo, hi; { ArgsP a = ap0; LAUNDER(a); lo = a->ph_lo; hi = a->ph_hi; }
#define IN(k) (lo <= (k) && (k) < hi)
#define SEAM(k) do { } while (0)
#define SEAMC(k, slot) do { } while (0)
#define GRIDBARC(slot) do { } while (0)
#define GRIDBAR() do { } while (0)
#endif
    typedef pg8::bf16_t pb;
#ifndef REPMASK
#define REPMASK 0
#endif
#define PHASE_ARGS ArgsP ap = ap0; LAUNDER(ap); unsigned char* ws = ap->ws; (void)ws; Frame F; mk_frame(F, ldsb, wave_s); const int gw = F.vcu * NWAVES + F.wave, NGW = F.G * NWAVES; (void)gw; (void)NGW
    if (IN(0)) _Pragma("unroll 1") for (int rep_ = 0; rep_ <= ((REPMASK >> 0) & 1); ++rep_) { PHASE_ARGS; p0_prologue(F, ap); } SEAMC(0, 0);
    if (IN(1)) _Pragma("unroll 1") for (int rep_ = 0; rep_ <= ((REPMASK >> 1) & 1); ++rep_) { PHASE_ARGS; const float* x = (const float*)ap->in[0]; const float* g1 = (const float*)ap->in[5]; const float* mod = (const float*)(ws + WS_MOD); bf16* XN = (bf16*)(ws + WS_XN);
#pragma unroll 1
        for (int wv = gw; wv < M / 16; wv += NGW) {
#pragma unroll 1
          for (int k4 = 0; k4 < 4; ++k4) { const int m = wv * 16 + 4 * k4; f32x4 u[4][4]; modnorm_rows<4, false>(x, m, 1, g1, mod, 0, 1024, XN, F.lane, u);
            if (F.lane < 32) { const int mm = m + (F.lane >> 3), j = F.lane & 7; const float pos = (float)((const int*)ap->in[2])[mm];
                const float ang = pos * __expf(-(float)j * 0.125f * 13.122363377404328f); const float sn = __sinf(ang), cs = __cosf(ang);
                bf16* rt = (bf16*)(ws + WS_ROPE) + (size_t)mm * 16; rt[j] = (bf16)(pk2(cs, 0.f) & 0xffffu); rt[8 + j] = (bf16)(pk2(sn, 0.f) & 0xffffu); } } } } SEAMC(1, 1);
    if (IN(2)) _Pragma("unroll 1") for (int rep_ = 0; rep_ <= ((REPMASK >> 2) & 1); ++rep_) { PHASE_ARGS; pg8::Gemm g{(const pb*)(ws + WS_XN), (const pb*)(ws + WS_WINT), M, NZP, D}; pg8::StaticOrder S; S.init(M, NZP, F.G, (int)blockIdx.x);
        pg8::EpiZ E{(pb*)(ws + WS_Z)}; pg8::gemm_phase<pg8::EpiZ, pg8::StaticOrder, true, true>(F.lds, g, S, E, F.tid); }
    if (IN(2)) { PHASE_ARGS; const int c0 = conv_idle_first(F.G);
        if ((int)blockIdx.x >= c0 && c0 < F.G) { __syncthreads(); conv_items(F, ap, 0, CONV_EARLY, ((int)blockIdx.x - c0) * NWAVES + F.wave, (F.G - c0) * NWAVES); } }
    SEAMC(2, 2);
    if (IN(3)) {
#ifndef REP_SCAN
#define REP_SCAN 1
#endif
#ifndef REP_ATTN
#define REP_ATTN 1
#endif
      { PHASE_ARGS; const ScanArgs SP{(const GAS bf16*)(ws + WS_Z), (const GAS float*)ap->in[7], (const GAS float*)ap->in[8], nullptr, nullptr, nullptr, nullptr, nullptr, nullptr, nullptr, (GAS unsigned char*)(ws + WS_SGD)};
#pragma unroll 1
        for (int task = F.vcu * NWAVES + F.wave; task < 2048; task += F.G * NWAVES) scan2_prep(SP, task >> 7, (task >> 6) & 1, task & 63, F.lane); }
      GRIDBARC(3);
      { int c0_, G_; { Frame F0; mk_frame(F0, ldsb, wave_s); c0_ = F0.vcu; G_ = F0.G; }
#pragma unroll 1
        for (int c = c0_; c < 256 * REP_SCAN; c += G_) { PHASE_ARGS; const int b = (c >> 4) & 15, h = (c >> 1) & 7, dir = c & 1;
            scan2_setup(F.lds, (const GAS float*)ap->in[10], (const GAS float*)ap->in[12], h, dir, F.tid); __syncthreads();
            const ScanArgs SA{(const GAS bf16*)(ws + WS_Z), (const GAS float*)ap->in[7], (const GAS float*)ap->in[8], (const GAS float*)ap->in[9], (const GAS float*)ap->in[11], (const GAS float*)ap->in[14], (const GAS float*)ap->in[15], (const GAS float*)ap->in[16],
                              (GAS bf16*)(ws + WS_XN) + (size_t)dir * M * 512, (GAS float*)(ws + WS_BONUS) + (size_t)dir * M * 8, (GAS unsigned char*)(ws + WS_SGD)};
#pragma unroll 1
            for (int cc = F.wave; cc < T / 32; cc += 8) scan2_chunk(F.lds, SA, b, h, dir, cc, F.lane, F.wave);
            __syncthreads(); } }
      { PHASE_ARGS;
#pragma unroll 1
        for (int u = F.vcu; u < 512 * REP_ATTN; u += F.G) { attn_unit(F, ap, (u >> 5) & 15, (u >> 4) & 1, u & 15); } }
      { PHASE_ARGS;
        const bf16* Z = (const bf16*)(ws + WS_Z); bf16* SGD = (bf16*)(ws + WS_SGD); const float* mu_prev = (const float*)ap->in[7]; const float* mu_next = (const float*)ap->in[8];
          const int c = ZGD + 2 * F.lane; const float mp0 = mu_prev[c], mp1 = mu_prev[c + 1], mn0 = mu_next[c], mn1 = mu_next[c + 1];
#ifndef REP_SGD
#define REP_SGD 1
#endif
          const int tile = F.vcu;
          if (tile < 256) { const int pm = tile >> 1, pn = tile & 1; constexpr int RS = 136;
              LAS bf16* SG = (LAS bf16*)F.lds; LAS bf16* GT = (LAS bf16*)(F.lds + 256 * RS * 2);
              __syncthreads();
              const int mt0 = pm * 256 + F.wave * 32;
#pragma unroll 1
              for (int m0 = 0; m0 < 32; m0 += 4) { unsigned z0[4], zm[4], zq[4];
#pragma unroll
                  for (int i = 0; i < 4; ++i) { const int m = mt0 + m0 + i, t = m & (T - 1);
                      z0[i] = *(const GAS unsigned*)(Z + (size_t)m * NZ + c); zm[i] = t > 0 ? *(const GAS unsigned*)(Z + (size_t)(m - 1) * NZ + c) : 0u; zq[i] = t < T - 1 ? *(const GAS unsigned*)(Z + (size_t)(m + 1) * NZ + c) : 0u; }
#pragma unroll
                  for (int i = 0; i < 4; ++i) { const float a0 = bflo(z0[i]), a1 = bfhi(z0[i]); const float s0 = a0 + mp0 * (bflo(zm[i]) - a0) + mn0 * (bflo(zq[i]) - a0), s1 = a1 + mp1 * (bfhi(zm[i]) - a1) + mn1 * (bfhi(zq[i]) - a1);
                      *(LAS unsigned*)(SG + (F.wave * 32 + m0 + i) * RS + 2 * F.lane) = pk2(sigm(s0), sigm(s1)); } }
              __syncthreads();
              const int r32 = F.lane & 31, hh = F.lane >> 5; bf16x8 af[8];
#pragma unroll
              for (int sI = 0; sI < 8; ++sI) af[sI] = *(const LAS bf16x8*)(SG + (F.wave * 32 + r32) * RS + 16 * sI + 8 * hh);
              bf16* Gout = (bf16*)(ws + WS_G); const bf16* G2T = (const bf16*)(ws + WS_G2T);
#pragma unroll 1
              for (int hf = 0; hf < 2; ++hf) {
#pragma unroll
                  for (int i = 0; i < 4; ++i) { const int e = F.tid + 512 * i, rr = e >> 4, ch = e & 15; *(LAS v4u*)(GT + rr * RS + ch * 8) = *(const GAS v4u*)(G2T + (size_t)(256 * pn + 128 * hf + rr) * 256 + ch * 8); }
                  __syncthreads();
#pragma unroll 1
                  for (int ct = 0; ct < 4; ++ct) { f32x16 acc = {};
#pragma unroll
                      for (int sI = 0; sI < 8; ++sI) { const bf16x8 bfr = *(const LAS bf16x8*)(GT + (32 * ct + r32) * RS + 16 * sI + 8 * hh); acc = __builtin_amdgcn_mfma_f32_32x32x16_bf16(af[sI], bfr, acc, 0, 0, 0); }
#pragma unroll
                      for (int g = 0; g < 16; ++g) { const int row = (g & 3) + 8 * (g >> 2) + 4 * hh;
                          Gout[(size_t)(mt0 + row) * 512 + 256 * pn + 128 * hf + 32 * ct + r32] = (bf16)(pk2(acc[g], 0.f) & 0xffffu); } }
                  __syncthreads(); } } }
    } SEAMC(4, 4);
#ifndef REP_PG
#define REP_PG 0
#endif
    if (IN(5)) { PHASE_ARGS; if (REP_PG) pg_rows(F, ap, (bf16*)ap->out); pg_rows(F, ap, (bf16*)(ws + WS_G)); } SEAMC(5, 5);
    if (IN(6)) { PHASE_ARGS; static_assert(WS_G == WS_OATT + (size_t)M * 512 * 2 && WS_PAT == WS_PRT + (size_t)1024 * 512 * 2, "merged operand views need adjacent buffers");
        pg8::Gemm g{(const pb*)(ws + WS_OATT), (const pb*)(ws + WS_PRT), 2 * M, 2048, 512}; pg8::MergeOrder S; S.init(F.G, (int)blockIdx.x);
        pg8::EpiGate2 E{(pb*)(ws + WS_XN), (const pb*)(ws + WS_Z)}; pg8::gemm_phase<pg8::EpiGate2, pg8::MergeOrder, true, true>(F.lds, g, S, E, F.tid); } SEAMC(7, 6);
    if (IN(8)) _Pragma("unroll 1") for (int rep_ = 0; rep_ <= ((REPMASK >> 8) & 1); ++rep_) { PHASE_ARGS; pg8::Gemm g{(const pb*)(ws + WS_XN), (const pb*)(ws + WS_WOT), M, 1024, 1024}; pg8::StaticOrder S; S.init(M, 1024, F.G, (int)blockIdx.x);
        pg8::EpiRes E{(const float*)ap->in[0], (const float*)(ws + WS_MOD), (pb*)(ws + WS_X1)}; pg8::gemm_phase<pg8::EpiRes, pg8::StaticOrder, true, true>(F.lds, g, S, E, F.tid); } SEAMC(8, 7);
    if (IN(9)) _Pragma("unroll 1") for (int rep_ = 0; rep_ <= ((REPMASK >> 9) & 1); ++rep_) { PHASE_ARGS; pj_phase(F, ap); } SEAMC(9, 8);
    if (IN(10)) _Pragma("unroll 1") for (int rep_ = 0; rep_ <= ((REPMASK >> 10) & 1); ++rep_) { PHASE_ARGS; for (int p = F.vcu; p < 256; p += F.G) pk_task(F, ap, p >> 4, p & 15); } SEAM(10);
    if (IN(11)) _Pragma("unroll 1") for (int rep_ = 0; rep_ <= ((REPMASK >> 11) & 1); ++rep_) { PHASE_ARGS; pg8::Gemm g{(const pb*)(ws + WS_XN), (const pb*)((unsigned char*)ap->out + OUT_WGUT), ME, 16 * 2048, 1024}; pg8::GroupOrder<8> S{F.G, (int)blockIdx.x};
        pg8::EpiSwiglu E{(pb*)(ws + WS_H)}; pg8::gemm_phase<pg8::EpiSwiglu, pg8::GroupOrder<8>, true, true, true>(F.lds, g, S, E, F.tid, (const int*)(ws + WS_SELIDX)); } SEAM(11);
    if (IN(12)) _Pragma("unroll 1") for (int rep_ = 0; rep_ <= ((REPMASK >> 12) & 1); ++rep_) { PHASE_ARGS; pg8::Gemm g{(const pb*)(ws + WS_H), (const pb*)((unsigned char*)ap->out + OUT_WDT), ME, 16 * 1024, 1024}; pg8::GroupOrder<4> S{F.G, (int)blockIdx.x};
        pg8::EpiDown E{(pb*)(ws + WS_XE), (const float*)(ws + WS_SELAFF)}; pg8::gemm_phase<pg8::EpiDown, pg8::GroupOrder<4>, true, true>(F.lds, g, S, E, F.tid); } SEAM(12);
#ifndef EXTRA_BARS
#define EXTRA_BARS 0
#endif
#if ONE_LAUNCH
    _Pragma("unroll 1") for (int xb_ = 0; xb_ < EXTRA_BARS; ++xb_) { MKBAR; { unsigned o_ = ~0u; asm volatile("" : "+s"(o_)); xcd_barrier(bar, wave_s == 0 && __builtin_amdgcn_mbcnt_hi(o_, __builtin_amdgcn_mbcnt_lo(o_, 0u)) == 0u); } }
#endif
#ifndef REP_PN
#define REP_PN 0
#endif
    if (IN(13)) { PHASE_ARGS; if (REP_PN) pn_rows(F, ap, (float*)(ws + WS_H)); pn_rows(F, ap, ap->out); }
#undef IN
#undef SEAM
}

extern "C" void kernel_launch(void* const* d_in, const int* in_sizes, int n_in, void* d_out, int out_size, void* d_ws, size_t ws_size, hipStream_t stream) {
    static int grid = 0;
    if (grid == 0) {
        if (n_in != 30 || out_size != M * D || ws_size < WS_END) { fprintf(stderr, "kernel_launch: unexpected shapes n_in %d out %d ws %zu\n", n_in, out_size, ws_size); grid = -1; return; }
        int dev = 0, cus = 0, per_cu = 0;
        if (hipGetDevice(&dev) != hipSuccess || hipDeviceGetAttribute(&cus, hipDeviceAttributeMultiprocessorCount, dev) != hipSuccess) { grid = -1; return; }
        if (hipFuncSetAttribute((const void*)fwd_kernel, hipFuncAttributeMaxDynamicSharedMemorySize, LDS_BYTES) != hipSuccess) { fprintf(stderr, "kernel_launch: hipFuncSetAttribute failed\n"); grid = -1; return; }
        if (hipOccupancyMaxActiveBlocksPerMultiprocessor(&per_cu, (const void*)fwd_kernel, NWAVES * 64, LDS_BYTES) != hipSuccess || per_cu < 1) fprintf(stderr, "kernel_launch: occupancy query reports %d\n", per_cu);
        (void)hipGetLastError();
        grid = cus;
    }
    if (grid < 0) return;
    if (hipMemsetAsync((char*)d_ws + WS_CTL, 0, CTL_ZERO_BYTES, stream) != hipSuccess) return;
    Args a{};
    for (int i = 0; i < 30; ++i) a.in[i] = d_in[i];
    a.out = (float*)d_out; a.ws = (unsigned char*)d_ws;
#if ONE_LAUNCH
    a.ph_lo = 0; a.ph_hi = NPHASE;
    hipLaunchKernelGGL(fwd_kernel, dim3(grid), dim3(NWAVES * 64), LDS_BYTES, stream, a);
#else
    for (int p = 0; p < NPHASE; ++p) { a.ph_lo = p; a.ph_hi = p + 1; hipLaunchKernelGGL(fwd_kernel, dim3(grid), dim3(NWAVES * 64), LDS_BYTES, stream, a); }
#endif
}
```

```cpp
#include <hip/hip_runtime.h>
#include <cstdio>
#include <cstdint>
#include <cmath>
namespace pg8 {
#define PG8_LAS __attribute__((address_space(3)))
typedef unsigned short bf16_t;
typedef short bf16x8 __attribute__((ext_vector_type(8)));
typedef float f32x4 __attribute__((ext_vector_type(4)));
typedef unsigned u32x4 __attribute__((ext_vector_type(4)));
constexpr int BM = 256, BK = 64, HALF = 128, HTB = HALF * BK * 2  , STAGE_BYTES = 8 * HTB, NXCD = 8, WGM = 4;

__host__ __device__ __forceinline__ int lds_byte(int r, int c) { const int st = (r >> 4) * 2 + (c >> 5), rr = r & 15, cc = c & 31, ob = rr * 64 + cc * 2; return st * 1024 + (ob ^ (((ob >> 9) & 1) << 5)); }
__host__ __device__ __forceinline__ void stage_rc(int b, int& R, int& C) { const int st = b / 1024, sb = b % 1024, swz = sb ^ (((sb >> 9) & 1) << 5); R = (st >> 1) * 16 + swz / 64; C = (st & 1) * 32 + (swz % 64) / 2; }
__host__ __device__ __forceinline__ int perm32(int rho) { const int n = rho >> 4, i = rho & 15; return 8 * (i >> 2) + 4 * n + (i & 3); }

struct Unit { int pm, pn; };
struct Gemm { const bf16_t* A; const bf16_t* Bt; int M, N, K; };

struct StaticOrder {
    int nM, nN, nwg, G, c;
    __host__ __device__ void init(int M, int N, int G_, int c_) { nM = M / BM; nN = N / BM; nwg = nM * nN; G = G_; c = c_; }
    __host__ __device__ bool next(int i, Unit& u) const {
        const long L = (long)i * G + c; if (L >= nwg) return false;
        int wgid = (int)L; { const int q = nwg / NXCD, r = nwg % NXCD, xcd = wgid % NXCD, off = wgid / NXCD; wgid = (xcd < r ? xcd * (q + 1) : r * (q + 1) + (xcd - r) * q) + off; }
        const int nig = WGM * nN, gid = wgid / nig, fm = gid * WGM, gsz = (nM - fm) < WGM ? (nM - fm) : WGM;
        u.pm = fm + ((wgid % nig) % gsz); u.pn = (wgid % nig) / gsz; return true;
    }
    __device__ __forceinline__ void a_ready(const Unit&) const {}
    __device__ __forceinline__ void done(const Unit&) const {}
};

__device__ __forceinline__ unsigned cvt_pk_bf16(float lo, float hi) { unsigned r; asm volatile("v_cvt_pk_bf16_f32 %0, %1, %2" : "=v"(r) : "v"(lo), "v"(hi)); return r; }
typedef float f32x2 __attribute__((ext_vector_type(2)));
template <class Epi, class Sched, bool ALIGN_EPI = false, bool SP2 = false, bool GATHER = false>
__device__ __forceinline__ void gemm_phase(PG8_LAS unsigned char* lds, const Gemm g, const Sched& S, const Epi& E, int tid_in, const int* gidx = nullptr) {
    static_assert(!GATHER || SP2, "the gather variant is written for the SP2 loop");
    int tid_ = tid_in; asm volatile("" : "+v"(tid_));
    const int tid = tid_, wid = __builtin_amdgcn_readfirstlane(tid >> 6), lane = tid & 63, wr = wid >> 2, wc = wid & 3, fr = lane & 15, fq = lane >> 4;
    const int K = g.K, nt = K / BK;
    unsigned voffA[2], voffB[2];
#pragma unroll
    for (int i = 0; i < 2; ++i) { int R, C; stage_rc(tid * 16 + i * 8192, R, C); const int Rb = Epi::PERM ? ((R & ~31) + perm32(R & 31)) : R;
        voffA[i] = (unsigned)(R * K + C) * 2u; voffB[i] = (unsigned)(Rb * K + C) * 2u; }
    int gRA[2] = {0, 0}; unsigned gCA[2] = {0u, 0u}; unsigned gc[2][2] = {{0u, 0u}, {0u, 0u}}, gn[2][2] = {{0u, 0u}, {0u, 0u}};
    if constexpr (GATHER) {
#pragma unroll
        for (int i = 0; i < 2; ++i) { int R, C; stage_rc(tid * 16 + i * 8192, R, C); gRA[i] = R; gCA[i] = (unsigned)C * 2u; } }
#define PG8_GLOAD(dst, un) do { _Pragma("unroll") for (int h_ = 0; h_ < 2; ++h_) _Pragma("unroll") for (int i_ = 0; i_ < 2; ++i_) \
        dst[h_][i_] = (unsigned)gidx[(un).pm * 256 + h_ * 128 + gRA[i_]] * (unsigned)(K * 2) + gCA[i_]; } while (0)
#define PG8_STAGE_G(bufoff, gbase, nx, h) do { unsigned vo_[2] = {(nx) ? gn[h][0] : gc[h][0], (nx) ? gn[h][1] : gc[h][1]}; PG8_STAGE(bufoff, gbase, vo_); } while (0)
    const size_t kstep = (size_t)(BK * 2);
    const size_t hstep = (size_t)HALF * K * 2;
    const size_t tstep = 2 * hstep;
    const unsigned ldsw = (unsigned)wid * 1024u;
    const int aoff = lds_byte(wr * 64 + fr, fq * 8), boff = lds_byte(wc * 32 + fr, fq * 8);
#define PG8_SA(b, h) (((b) * 2 + (h)) * HTB)
#define PG8_SB(b, h) ((4 + (b) * 2 + (h)) * HTB)
#define PG8_STAGE(bufoff, gbase, voff) do { _Pragma("unroll") for (int _i = 0; _i < 2; ++_i) \
        __builtin_amdgcn_global_load_lds((const unsigned*)((const char*)(gbase) + (voff)[_i]), (PG8_LAS unsigned*)(lds + (bufoff) + ldsw + _i * 8192), 16, 0, 0); } while (0)
#define PG8_LDA(dst, b, h) do { _Pragma("unroll") for (int m = 0; m < 4; ++m) _Pragma("unroll") for (int k = 0; k < 2; ++k) dst[m][k] = *(const PG8_LAS bf16x8*)(lds + PG8_SA(b, h) + aoff + m * 2048 + k * 1024); } while (0)
#define PG8_LDB(dst, b, h) do { _Pragma("unroll") for (int n = 0; n < 2; ++n) _Pragma("unroll") for (int k = 0; k < 2; ++k) dst[n][k] = *(const PG8_LAS bf16x8*)(lds + PG8_SB(b, h) + boff + n * 2048 + k * 1024); } while (0)
#define PG8_MMA(ai, bj, At, Bt) do { __builtin_amdgcn_s_setprio(1); _Pragma("unroll") for (int m = 0; m < 4; ++m) _Pragma("unroll") for (int n = 0; n < 2; ++n) _Pragma("unroll") for (int k = 0; k < 2; ++k) \
        acc[ai][bj][m][n] = __builtin_amdgcn_mfma_f32_16x16x32_bf16(Bt[n][k], At[m][k], acc[ai][bj][m][n], 0, 0, 0); __builtin_amdgcn_s_setprio(0); } while (0)
#define PG8_WAIT_V(n) asm volatile("s_waitcnt vmcnt(" #n ")" ::: "memory")
#define PG8_WAIT_L(n) asm volatile("s_waitcnt lgkmcnt(" #n ")" ::: "memory")
#define PG8_BAR __builtin_amdgcn_s_barrier()
#define PG8_SCHED __builtin_amdgcn_sched_barrier(0)
    Unit cur, nxt; int ui = 0;
    if (!S.next(0, cur)) return;
    f32x4 acc[2][2][4][2];
#pragma unroll
    for (int a = 0; a < 2; ++a)
#pragma unroll
        for (int b = 0; b < 2; ++b)
#pragma unroll
            for (int m = 0; m < 4; ++m)
#pragma unroll
                for (int n = 0; n < 2; ++n) acc[a][b][m][n] = (f32x4){0.f, 0.f, 0.f, 0.f};
    bf16x8 At[4][2], B0[2][2], B1[2][2];
    const char* cA = GATHER ? (const char*)g.A : (const char*)g.A + (size_t)cur.pm * tstep; const char* cB = (const char*)g.Bt + (size_t)cur.pn * tstep;
    if constexpr (GATHER) { PG8_GLOAD(gc, cur); Unit n1_; if (S.next(1, n1_)) PG8_GLOAD(gn, n1_); else { gn[0][0] = gc[0][0]; gn[0][1] = gc[0][1]; gn[1][0] = gc[1][0]; gn[1][1] = gc[1][1]; } }
    S.a_ready(cur);
    if constexpr (SP2) {
        PG8_STAGE(PG8_SB(0, 0), cB, voffB); PG8_STAGE(PG8_SB(0, 1), cB + hstep, voffB);
        if constexpr (GATHER) { PG8_STAGE_G(PG8_SA(0, 0), cA, false, 0); PG8_STAGE_G(PG8_SA(0, 1), cA, false, 1); } else { PG8_STAGE(PG8_SA(0, 0), cA, voffA); PG8_STAGE(PG8_SA(0, 1), cA + hstep, voffA); }
        if (wr == 1) PG8_BAR;
        PG8_WAIT_V(2); PG8_BAR;
        PG8_STAGE(PG8_SB(1, 0), cB + kstep, voffB); if constexpr (GATHER) PG8_STAGE_G(PG8_SA(1, 0), cA + kstep, false, 0); else PG8_STAGE(PG8_SA(1, 0), cA + kstep, voffA); PG8_STAGE(PG8_SB(1, 1), cB + hstep + kstep, voffB);
        PG8_WAIT_V(6); PG8_BAR;
    } else {
        PG8_STAGE(PG8_SB(0, 0), cB, voffB); PG8_STAGE(PG8_SA(0, 0), cA, voffA); PG8_STAGE(PG8_SB(0, 1), cB + hstep, voffB); PG8_STAGE(PG8_SA(0, 1), cA + hstep, voffA);
        if (wr == 1) PG8_BAR;
        PG8_WAIT_V(4); PG8_BAR;
        PG8_STAGE(PG8_SB(1, 0), cB + kstep, voffB); PG8_STAGE(PG8_SA(1, 0), cA + kstep, voffA); PG8_STAGE(PG8_SB(1, 1), cB + hstep + kstep, voffB);
        PG8_WAIT_V(6); PG8_BAR;
    }
    for (;;) {
        const bool has_next = S.next(ui + 1, nxt);
        if constexpr (GATHER) { if (!has_next) { gn[0][0] = gc[0][0]; gn[0][1] = gc[0][1]; gn[1][0] = gc[1][0]; gn[1][1] = gc[1][1]; } }
        const char* nA = (has_next && !GATHER) ? (const char*)g.A + (size_t)nxt.pm * tstep : cA; const char* nB = has_next ? (const char*)g.Bt + (size_t)nxt.pn * tstep : cB;
        for (int t = 0; t < nt; t += 2) {
            const bool last = (t == nt - 2);
            const char* a1 = cA + (size_t)(t + 1) * kstep;
            const char* a2 = last ? nA : cA + (size_t)(t + 2) * kstep; const char* b2 = last ? nB : cB + (size_t)(t + 2) * kstep;
            const char* a3 = a2 + kstep; const char* b3 = b2 + kstep;
            if (last && has_next) S.a_ready(nxt);
            if constexpr (SP2) {
            PG8_LDB(B0, 0, 0); PG8_LDB(B1, 0, 1); PG8_SCHED; PG8_LDA(At, 0, 0); if constexpr (GATHER) PG8_STAGE_G(PG8_SA(1, 1), a1, false, 1); else PG8_STAGE(PG8_SA(1, 1), a1 + hstep, voffA);
            PG8_WAIT_V(8); PG8_WAIT_L(0); PG8_BAR; PG8_MMA(0, 0, At, B0); PG8_MMA(0, 1, At, B1); PG8_BAR; PG8_SCHED;
            PG8_LDA(At, 0, 1); PG8_STAGE(PG8_SB(0, 0), b2, voffB); PG8_STAGE(PG8_SB(0, 1), b2 + hstep, voffB); if constexpr (GATHER) PG8_STAGE_G(PG8_SA(0, 0), a2, last, 0); else PG8_STAGE(PG8_SA(0, 0), a2, voffA);
            PG8_WAIT_V(8); PG8_WAIT_L(0); PG8_BAR; PG8_MMA(1, 0, At, B0); PG8_MMA(1, 1, At, B1); PG8_BAR; PG8_SCHED;
            PG8_LDB(B0, 1, 0); PG8_LDB(B1, 1, 1); PG8_SCHED; PG8_LDA(At, 1, 0); if constexpr (GATHER) PG8_STAGE_G(PG8_SA(0, 1), a2, last, 1); else PG8_STAGE(PG8_SA(0, 1), a2 + hstep, voffA);
            PG8_WAIT_V(8); PG8_WAIT_L(0); PG8_BAR; PG8_MMA(0, 0, At, B0); PG8_MMA(0, 1, At, B1); PG8_BAR; PG8_SCHED;
            PG8_LDA(At, 1, 1); PG8_STAGE(PG8_SB(1, 0), b3, voffB); PG8_STAGE(PG8_SB(1, 1), b3 + hstep, voffB); if constexpr (GATHER) PG8_STAGE_G(PG8_SA(1, 0), a3, last, 0); else PG8_STAGE(PG8_SA(1, 0), a3, voffA);
            PG8_WAIT_V(8); PG8_WAIT_L(0); PG8_BAR; PG8_MMA(1, 0, At, B0); PG8_MMA(1, 1, At, B1); PG8_BAR; PG8_SCHED;
            } else {
            PG8_LDB(B0, 0, 0); PG8_SCHED; PG8_LDA(At, 0, 0); PG8_STAGE(PG8_SA(1, 1), a1 + hstep, voffA);
            PG8_WAIT_L(8); PG8_BAR; PG8_WAIT_L(0); PG8_MMA(0, 0, At, B0); PG8_BAR; PG8_SCHED;
            PG8_LDB(B1, 0, 1); PG8_STAGE(PG8_SB(0, 0), b2, voffB);
            PG8_BAR; PG8_WAIT_L(0); PG8_MMA(0, 1, At, B1); PG8_BAR;
            PG8_LDA(At, 0, 1); PG8_STAGE(PG8_SA(0, 0), a2, voffA);
            PG8_BAR; PG8_WAIT_L(0); PG8_MMA(1, 0, At, B0); PG8_BAR; PG8_SCHED;
            PG8_STAGE(PG8_SB(0, 1), b2 + hstep, voffB);
            PG8_WAIT_V(6); PG8_BAR; PG8_MMA(1, 1, At, B1); PG8_BAR;
            PG8_LDB(B0, 1, 0); PG8_SCHED; PG8_LDA(At, 1, 0); PG8_STAGE(PG8_SA(0, 1), a2 + hstep, voffA);
            PG8_WAIT_L(8); PG8_BAR; PG8_WAIT_L(0); PG8_MMA(0, 0, At, B0); PG8_BAR; PG8_SCHED;
            PG8_LDB(B1, 1, 1); PG8_STAGE(PG8_SB(1, 0), b3, voffB);
            PG8_BAR; PG8_WAIT_L(0); PG8_MMA(0, 1, At, B1); PG8_BAR;
            PG8_LDA(At, 1, 1); PG8_STAGE(PG8_SA(1, 0), a3, voffA);
            PG8_BAR; PG8_WAIT_L(0); PG8_MMA(1, 0, At, B0); PG8_BAR; PG8_SCHED;
            PG8_STAGE(PG8_SB(1, 1), b3 + hstep, voffB);
            PG8_WAIT_V(6); PG8_BAR; PG8_MMA(1, 1, At, B1); PG8_BAR;
            }
        }
        if constexpr (ALIGN_EPI) { if (wr == 0) PG8_BAR; }
#ifdef REP_EPI
        if constexpr (!Epi::AFTER_DRAIN) { E(acc, cur, wr, wc, fr, fq); asm volatile("" ::: "memory"); }
#endif
        if constexpr (!Epi::AFTER_DRAIN) { E(acc, cur, wr, wc, fr, fq); S.done(cur); }
        unsigned g2_[2][2] = {{0u, 0u}, {0u, 0u}};
        if constexpr (GATHER) { Unit nn_; if (has_next && S.next(ui + 2, nn_)) PG8_GLOAD(g2_, nn_); else { g2_[0][0] = gn[0][0]; g2_[0][1] = gn[0][1]; g2_[1][0] = gn[1][0]; g2_[1][1] = gn[1][1]; } }
        if (!has_next) break;
#pragma unroll
        for (int a = 0; a < 2; ++a)
#pragma unroll
            for (int b = 0; b < 2; ++b)
#pragma unroll
                for (int m = 0; m < 4; ++m)
#pragma unroll
                    for (int n = 0; n < 2; ++n) acc[a][b][m][n] = (f32x4){0.f, 0.f, 0.f, 0.f};
        cur = nxt; cA = nA; cB = nB; ++ui;
        if constexpr (GATHER) { gc[0][0] = gn[0][0]; gc[0][1] = gn[0][1]; gc[1][0] = gn[1][0]; gc[1][1] = gn[1][1]; gn[0][0] = g2_[0][0]; gn[0][1] = g2_[0][1]; gn[1][0] = g2_[1][0]; gn[1][1] = g2_[1][1]; }
        if constexpr (ALIGN_EPI) { if (wr == 1) PG8_BAR; }
    }
    PG8_WAIT_V(0);
    if constexpr (!ALIGN_EPI) { if (wr == 0) PG8_BAR; }
    PG8_BAR;
    if constexpr (Epi::AFTER_DRAIN) { E.fused(acc, cur, wr, wc, fr, fq, lds, wid, lane); S.done(cur); }
#undef PG8_SA
#undef PG8_SB
#undef PG8_STAGE
#undef PG8_STAGE_G
#undef PG8_GLOAD
#undef PG8_LDA
#undef PG8_LDB
#undef PG8_MMA
#undef PG8_WAIT_V
#undef PG8_WAIT_L
#undef PG8_BAR
#undef PG8_SCHED
}
}

#ifndef ONE_LAUNCH
#define ONE_LAUNCH 1
#endif
constexpr int NB = 16, T = 2048, D = 1024, M = NB * T;
constexpr int NZ = 4736, NZP = 4864;
constexpr int RW = 512, NE = 16, CAP = 256, ME = NE * NB * CAP;
constexpr int ZR = 0, ZK = 512, ZV = 1024, ZWD = 1536, ZAD = 1664, ZGD = 1792, ZQ = 1920, ZKA = 2432, ZVA = 2560, ZGA = 2688, ZGB = 3712;
constexpr int NWAVES = 8, NPHASE = 14;
constexpr size_t MiB = 1u << 20;
constexpr size_t WS_CTL = 0, CTL_ZERO_BYTES = 64 * 1024 + 16 * 6144 * 4;
constexpr size_t WS_MOD = 64 * 1024, WS_BONUS = 2 * MiB, WS_AFF = 4 * MiB, WS_SELAFF = 6 * MiB, WS_SLOT = 7 * MiB, WS_G2T = 9 * MiB;
constexpr size_t WS_WINT = 10 * MiB, WS_PRT = 20 * MiB, WS_PAT = 21 * MiB, WS_WOT = 22 * MiB, WS_SGD = 24 * MiB;
constexpr size_t WS_XN = 40 * MiB;
constexpr size_t WS_OATT = 104 * MiB;
constexpr size_t WS_G = 136 * MiB;
constexpr size_t WS_Z = 168 * MiB;
constexpr size_t WS_X1 = 104 * MiB;
constexpr size_t OUT_WGUT = 0;
constexpr size_t OUT_WDT = 64 * MiB;
constexpr size_t WS_XE = 200 * MiB;
constexpr size_t WS_H = 328 * MiB;
constexpr size_t WS_END = 464 * MiB;
constexpr size_t WS_ROPE = WS_AFF;
constexpr size_t WS_SELIDX = WS_SELAFF + 512 * 1024;
constexpr int CW_BAR = 4096;
constexpr int RING_BYTES = 131072, LDSCTL_OFF = RING_BYTES, MISC_OFF = LDSCTL_OFF + 320, LDS_BYTES = 147456;

#define GAS __attribute__((address_space(1)))
#define LAS __attribute__((address_space(3)))
typedef unsigned short bf16;
typedef unsigned v4u __attribute__((ext_vector_type(4)));
typedef float f32x4 __attribute__((ext_vector_type(4)));
typedef short bf16x8 __attribute__((ext_vector_type(8)));
typedef GAS unsigned gu32;
typedef GAS unsigned long long gu64;
#define RLX_AGENT __ATOMIC_RELAXED, __HIP_MEMORY_SCOPE_AGENT
#define LDS_WAIT() asm volatile("s_waitcnt lgkmcnt(0)" ::: "memory")
#define VM_WAIT() asm volatile("s_waitcnt vmcnt(0)" ::: "memory")
__device__ __forceinline__ unsigned long long rt() { return __builtin_amdgcn_s_memrealtime(); }
__device__ __forceinline__ unsigned f2bf(float f) { unsigned u = __builtin_bit_cast(unsigned, f); return (u + 0x7fffu + ((u >> 16) & 1u)) >> 16; }
typedef float f32x2hw __attribute__((ext_vector_type(2))); typedef __bf16 bf16x2hw __attribute__((ext_vector_type(2)));
__device__ __forceinline__ unsigned pk2(float lo, float hi) { f32x2hw v = {lo, hi}; bf16x2hw b = __builtin_convertvector(v, bf16x2hw); return __builtin_bit_cast(unsigned, b); }

#define XB_TMO      128
#define XB_XCNT(j)  (256  + 64 * (j))
#define XB_XSUB(j)  (1280 + 64 * (j))
#define XB_XGEN(j)  (2304 + 64 * (j))
#define XB_TOP      3328
#define XB_TOPGEN   3392
#define XCD_BAR_WORDS 3456
#define XB_SPIN_CAP (1u << 18)

__device__ __forceinline__ unsigned xb_ld(unsigned* p)              { return __hip_atomic_load(p, __ATOMIC_RELAXED, __HIP_MEMORY_SCOPE_AGENT); }
__device__ __forceinline__ unsigned xb_add(unsigned* p, unsigned v) { return __hip_atomic_fetch_add(p, v, __ATOMIC_RELAXED, __HIP_MEMORY_SCOPE_AGENT); }
__device__ __forceinline__ unsigned xb_xcc_id() { return (unsigned)__builtin_amdgcn_s_getreg((3 << 11) | 20) & 0xFu; }
#define XB_SPIN(cond, bar) do { unsigned _sp = 0; while (cond) { __builtin_amdgcn_s_sleep(1); \
    if ((++_sp & 255u) == 0u) { if (xb_ld(&(bar)[XB_TMO])) break; if (_sp > XB_SPIN_CAP) { atomicAdd(&(bar)[XB_TMO], 1u); break; } } } } while (0)

struct XcdBarrier {
    unsigned* bar; unsigned x;
    volatile LAS unsigned* st;
};

__device__ __forceinline__ XcdBarrier xcd_barrier_post(unsigned* bar, volatile LAS unsigned* st) {
    XcdBarrier b; b.bar = bar; b.x = xb_xcc_id(); b.st = st;
    if (threadIdx.x == 0) (void)xb_add(&bar[XB_XCNT(b.x)], 1u);
    return b;
}
__device__ __forceinline__ void xcd_barrier_complete(unsigned* bar, unsigned x, unsigned& nloc, unsigned& nx) {
    const unsigned G = gridDim.x * gridDim.y * gridDim.z;
    unsigned sum, cnt, mine, sp = 0u;
    for (;;) {
        sum = 0u; cnt = 0u; mine = 0u;
#pragma unroll
        for (unsigned j = 0; j < 16; ++j) { const unsigned c = xb_ld(&bar[XB_XCNT(j)]); sum += c; cnt += (c > 0u) ? 1u : 0u; mine = (j == x) ? c : mine; }
        if (sum == G) break;
        __builtin_amdgcn_s_sleep(1);
        if ((++sp & 255u) == 0u) { if (xb_ld(&bar[XB_TMO])) break; if (sp > XB_SPIN_CAP) { atomicAdd(&bar[XB_TMO], 1u); break; } }
    }
    nloc = mine > 0u ? mine : 1u; nx = cnt > 0u ? cnt : 1u;
}

__device__ __forceinline__ void xcd_barrier_t0(const XcdBarrier& b) {
    {
        unsigned* bar = b.bar;
        __builtin_amdgcn_s_waitcnt(0);
        unsigned nloc = b.st[0], nx = b.st[1];
        if (nloc == 0u) { xcd_barrier_complete(bar, b.x, nloc, nx); b.st[0] = nloc; b.st[1] = nx; }
        const unsigned old = xb_add(&bar[XB_XSUB(b.x)], 1u);
        const unsigned gen = old / nloc;
        if (old + 1u == (gen + 1u) * nloc) {
            __builtin_amdgcn_fence(__ATOMIC_RELEASE, "agent");
            asm volatile("s_waitcnt vmcnt(0)" ::: "memory");
            const unsigned og = xb_add(&bar[XB_TOP], 1u);
            const unsigned tg = og / nx;
            if (og + 1u == (tg + 1u) * nx) xb_add(&bar[XB_TOPGEN], 1u);
            else XB_SPIN(xb_ld(&bar[XB_TOPGEN]) == tg, bar);
            __builtin_amdgcn_fence(__ATOMIC_ACQUIRE, "agent");
            xb_add(&bar[XB_XGEN(b.x)], 1u);
            asm volatile("s_waitcnt vmcnt(0)" ::: "memory");
        } else {
            XB_SPIN(xb_ld(&bar[XB_XGEN(b.x)]) == gen, bar);
            __builtin_amdgcn_fence(__ATOMIC_ACQUIRE, "agent");
            asm volatile("s_waitcnt vmcnt(0)" ::: "memory");
        }
    }
}
__device__ __forceinline__ void xcd_barrier(const XcdBarrier& b, bool is_thread0) {
    asm volatile("s_waitcnt vmcnt(0)" ::: "memory");
    __syncthreads();
    if (is_thread0) xcd_barrier_t0(b);
    __syncthreads();
}
namespace pg8 {
__device__ __forceinline__ float bf2f(unsigned short h) { return __uint_as_float(((unsigned)h) << 16); }
__device__ __forceinline__ float bflo(unsigned w) { return __uint_as_float(w << 16); }
__device__ __forceinline__ float bfhi(unsigned w) { return __uint_as_float(w & 0xffff0000u); }
__device__ __forceinline__ float sigm(float x) { return __builtin_amdgcn_rcpf(1.0f + __expf(-x)); }
struct EpiZ { static constexpr bool PERM = true, AFTER_DRAIN = false; bf16_t* O;
    __device__ __forceinline__ void operator()(const f32x4 (&acc)[2][2][4][2], const Unit& u, int wr, int wc, int fr, int fq) const {
        const int row0 = u.pm * BM + wr * 64 + fr, col0 = u.pn * BM + wc * 32 + 8 * fq;
#pragma unroll
        for (int ai = 0; ai < 2; ++ai)
#pragma unroll
            for (int m = 0; m < 4; ++m) { bf16_t* rowp = O + (size_t)(row0 + ai * HALF + m * 16) * 4736 + col0;
#pragma unroll
                for (int bj = 0; bj < 2; ++bj) { if (u.pn * BM + bj * HALF < 4736) { const f32x4 v0 = acc[ai][bj][m][0], v1 = acc[ai][bj][m][1];
                    u32x4 w; w.x = cvt_pk_bf16(v0[0], v0[1]); w.y = cvt_pk_bf16(v0[2], v0[3]); w.z = cvt_pk_bf16(v1[0], v1[1]); w.w = cvt_pk_bf16(v1[2], v1[3]);
                    *(u32x4*)(rowp + bj * HALF) = w; } } }
    }
};
struct EpiPlain { static constexpr bool PERM = true, AFTER_DRAIN = false; bf16_t* O; int ldc;
    __device__ __forceinline__ void operator()(const f32x4 (&acc)[2][2][4][2], const Unit& u, int wr, int wc, int fr, int fq) const {
        const int row0 = u.pm * BM + wr * 64 + fr, col0 = u.pn * BM + wc * 32 + 8 * fq;
#pragma unroll
        for (int ai = 0; ai < 2; ++ai)
#pragma unroll
            for (int m = 0; m < 4; ++m) { bf16_t* rowp = O + (size_t)(row0 + ai * HALF + m * 16) * ldc + col0;
#pragma unroll
                for (int bj = 0; bj < 2; ++bj) { const f32x4 v0 = acc[ai][bj][m][0], v1 = acc[ai][bj][m][1];
                    u32x4 w; w.x = cvt_pk_bf16(v0[0], v0[1]); w.y = cvt_pk_bf16(v0[2], v0[3]); w.z = cvt_pk_bf16(v1[0], v1[1]); w.w = cvt_pk_bf16(v1[2], v1[3]);
                    *(u32x4*)(rowp + bj * HALF) = w; } }
    }
};
template <bool ADD> struct EpiGate { static constexpr bool PERM = true, AFTER_DRAIN = false; bf16_t* O; const bf16_t* Z; int zc0;
    __device__ __forceinline__ void operator()(const f32x4 (&acc)[2][2][4][2], const Unit& u, int wr, int wc, int fr, int fq) const {
        const int row0 = u.pm * BM + wr * 64 + fr, col0 = u.pn * BM + wc * 32 + 8 * fq;
#pragma unroll
        for (int ai = 0; ai < 2; ++ai)
#pragma unroll
            for (int m = 0; m < 4; ++m) { const size_t row = (size_t)(row0 + ai * HALF + m * 16); bf16_t* rowp = O + row * 1024 + col0; const bf16_t* zp = Z + row * 4736 + zc0 + col0;
#pragma unroll
                for (int bj = 0; bj < 2; ++bj) { const f32x4 v0 = acc[ai][bj][m][0], v1 = acc[ai][bj][m][1];
                    const u32x4 zg = *(const u32x4*)(zp + bj * HALF);
                    float r0 = sigm(bflo(zg.x)) * v0[0], r1 = sigm(bfhi(zg.x)) * v0[1], r2 = sigm(bflo(zg.y)) * v0[2], r3 = sigm(bfhi(zg.y)) * v0[3];
                    float r4 = sigm(bflo(zg.z)) * v1[0], r5 = sigm(bfhi(zg.z)) * v1[1], r6 = sigm(bflo(zg.w)) * v1[2], r7 = sigm(bfhi(zg.w)) * v1[3];
                    if (ADD) { const u32x4 p = *(const u32x4*)(rowp + bj * HALF);
                        r0 += bflo(p.x); r1 += bfhi(p.x); r2 += bflo(p.y); r3 += bfhi(p.y); r4 += bflo(p.z); r5 += bfhi(p.z); r6 += bflo(p.w); r7 += bfhi(p.w); }
                    u32x4 w; w.x = cvt_pk_bf16(r0, r1); w.y = cvt_pk_bf16(r2, r3); w.z = cvt_pk_bf16(r4, r5); w.w = cvt_pk_bf16(r6, r7);
                    *(u32x4*)(rowp + bj * HALF) = w; } }
    }
};
struct EpiGate2 { static constexpr bool PERM = true, AFTER_DRAIN = false; bf16_t* O; const bf16_t* Z;
    __device__ __forceinline__ void operator()(const f32x4 (&acc)[2][2][4][2], const Unit& u, int wr, int wc, int fr, int fq) const {
        const bool add = u.pm < 128; const int zc0 = add ? 3712 : 2688;
        const int row0 = (u.pm & 127) * BM + wr * 64 + fr, col0 = (u.pn & 3) * BM + wc * 32 + 8 * fq;
#pragma unroll
        for (int ai = 0; ai < 2; ++ai) {
            u32x4 zg[4][2], pv[4][2];
#pragma unroll
            for (int m = 0; m < 4; ++m) { const size_t row = (size_t)(row0 + ai * HALF + m * 16);
#pragma unroll
                for (int bj = 0; bj < 2; ++bj) { zg[m][bj] = *(const u32x4*)(Z + row * 4736 + zc0 + col0 + bj * HALF); pv[m][bj] = (u32x4){0u, 0u, 0u, 0u}; if (add) pv[m][bj] = *(const u32x4*)(O + row * 1024 + col0 + bj * HALF); } }
#pragma unroll
            for (int m = 0; m < 4; ++m) { const size_t row = (size_t)(row0 + ai * HALF + m * 16); bf16_t* rowp = O + row * 1024 + col0;
#pragma unroll
                for (int bj = 0; bj < 2; ++bj) { const f32x4 v0 = acc[ai][bj][m][0], v1 = acc[ai][bj][m][1]; const u32x4 g = zg[m][bj], p = pv[m][bj];
                    const float r0 = sigm(bflo(g.x)) * v0[0] + bflo(p.x), r1 = sigm(bfhi(g.x)) * v0[1] + bfhi(p.x), r2 = sigm(bflo(g.y)) * v0[2] + bflo(p.y), r3 = sigm(bfhi(g.y)) * v0[3] + bfhi(p.y);
                    const float r4 = sigm(bflo(g.z)) * v1[0] + bflo(p.z), r5 = sigm(bfhi(g.z)) * v1[1] + bfhi(p.z), r6 = sigm(bflo(g.w)) * v1[2] + bflo(p.w), r7 = sigm(bfhi(g.w)) * v1[3] + bfhi(p.w);
                    u32x4 w; w.x = cvt_pk_bf16(r0, r1); w.y = cvt_pk_bf16(r2, r3); w.z = cvt_pk_bf16(r4, r5); w.w = cvt_pk_bf16(r6, r7);
                    *(u32x4*)(rowp + bj * HALF) = w; } } }
    }
};
struct MergeOrder { StaticOrder S; int nu;
    __device__ __forceinline__ void init(int G, int c) { S.init(32768, 1024, G, c); nu = (512 - c + G - 1) / G; }
    __device__ __forceinline__ bool next(int i, Unit& u) const { if (i >= 2 * nu) return false; Unit t; S.next(i < nu ? i : i - nu, t);
        if (i < nu) { u.pm = 128 + t.pm; u.pn = t.pn; } else { u.pm = t.pm; u.pn = 4 + t.pn; } return true; }
    __device__ __forceinline__ void a_ready(const Unit&) const {}
    __device__ __forceinline__ void done(const Unit&) const {}
};
struct EpiRes { static constexpr bool PERM = true, AFTER_DRAIN = false; const float* X; const float* mod; bf16_t* O;
    __device__ __forceinline__ void operator()(const f32x4 (&acc)[2][2][4][2], const Unit& u, int wr, int wc, int fr, int fq) const {
        const int row0 = u.pm * BM + wr * 64 + fr, col0 = u.pn * BM + wc * 32 + 8 * fq; const int b = (u.pm * BM) >> 11;
        f32x4 gt[2][2];
#pragma unroll
        for (int bj = 0; bj < 2; ++bj)
#pragma unroll
            for (int n = 0; n < 2; ++n) gt[bj][n] = *(const f32x4*)(mod + (size_t)b * 6144 + 2048 + col0 + bj * HALF + n * 4);
#pragma unroll
        for (int ai = 0; ai < 2; ++ai) { f32x4 xv[4][2][2];
#pragma unroll
            for (int m = 0; m < 4; ++m) { const size_t off = (size_t)(row0 + ai * HALF + m * 16) * 1024 + col0;
#pragma unroll
                for (int bj = 0; bj < 2; ++bj) { xv[m][bj][0] = *(const f32x4*)(X + off + bj * HALF); xv[m][bj][1] = *(const f32x4*)(X + off + bj * HALF + 4); } }
#pragma unroll
            for (int m = 0; m < 4; ++m) { const size_t off = (size_t)(row0 + ai * HALF + m * 16) * 1024 + col0;
#pragma unroll
                for (int bj = 0; bj < 2; ++bj) { const f32x4 v0 = xv[m][bj][0] + gt[bj][0] * acc[ai][bj][m][0], v1 = xv[m][bj][1] + gt[bj][1] * acc[ai][bj][m][1];
                    u32x4 w; w.x = cvt_pk_bf16(v0[0], v0[1]); w.y = cvt_pk_bf16(v0[2], v0[3]); w.z = cvt_pk_bf16(v1[0], v1[1]); w.w = cvt_pk_bf16(v1[2], v1[3]);
                    *(u32x4*)(O + off + bj * HALF) = w; } } }
    }
};
template <int NPL> struct GroupOrder { int G, c;
    __device__ __forceinline__ bool next(int i, Unit& u) const { const int L = i * G + c; if (L >= 256 * NPL) return false;
        if (G == 256) {
            const int q = i * 32 + (c >> 3), e = (c & 7) * 2 + q / (16 * NPL), r = q % (16 * NPL), rho = r >> 5, j = r & 31;
            u.pm = e * 16 + (rho & 1) * 8 + (j & 7); u.pn = e * NPL + (rho >> 1) * 4 + (j >> 3); return true; }
        const int e = L / (16 * NPL), r = L % (16 * NPL); u.pm = e * 16 + (r % 16); u.pn = e * NPL + r / 16; return true; }
    __device__ __forceinline__ void a_ready(const Unit&) const {}
    __device__ __forceinline__ void done(const Unit&) const {}
};
struct EpiSwiglu { static constexpr bool PERM = true, AFTER_DRAIN = false; bf16_t* O;
    __device__ __forceinline__ void operator()(const f32x4 (&acc)[2][2][4][2], const Unit& u, int wr, int wc, int fr, int fq) const {
        const int row0 = u.pm * BM + wr * 64 + fr, col0 = (u.pn & 7) * 128 + wc * 32 + 8 * fq;
#pragma unroll
        for (int ai = 0; ai < 2; ++ai)
#pragma unroll
            for (int m = 0; m < 4; ++m) { bf16_t* rowp = O + (size_t)(row0 + ai * HALF + m * 16) * 1024 + col0;
                float r[8];
#pragma unroll
                for (int n = 0; n < 2; ++n)
#pragma unroll
                    for (int i = 0; i < 4; ++i) { const float g = acc[ai][0][m][n][i], up = acc[ai][1][m][n][i]; r[n * 4 + i] = g * sigm(g) * up; }
                u32x4 w; w.x = cvt_pk_bf16(r[0], r[1]); w.y = cvt_pk_bf16(r[2], r[3]); w.z = cvt_pk_bf16(r[4], r[5]); w.w = cvt_pk_bf16(r[6], r[7]);
                *(u32x4*)rowp = w; }
    }
};
struct EpiDown { static constexpr bool PERM = true, AFTER_DRAIN = false; bf16_t* O; const float* aff;
    __device__ __forceinline__ void operator()(const f32x4 (&acc)[2][2][4][2], const Unit& u, int wr, int wc, int fr, int fq) const {
        const int row0 = u.pm * BM + wr * 64 + fr, col0 = (u.pn & 3) * BM + wc * 32 + 8 * fq;
        float av[2][4];
#pragma unroll
        for (int ai = 0; ai < 2; ++ai)
#pragma unroll
            for (int m = 0; m < 4; ++m) av[ai][m] = aff[row0 + ai * HALF + m * 16];
#pragma unroll
        for (int ai = 0; ai < 2; ++ai)
#pragma unroll
            for (int m = 0; m < 4; ++m) { const int row = row0 + ai * HALF + m * 16; const float a = av[ai][m]; bf16_t* rowp = O + (size_t)row * 1024 + col0;
#pragma unroll
                for (int bj = 0; bj < 2; ++bj) { const f32x4 v0 = acc[ai][bj][m][0] * a, v1 = acc[ai][bj][m][1] * a;
                    u32x4 w; w.x = cvt_pk_bf16(v0[0], v0[1]); w.y = cvt_pk_bf16(v0[2], v0[3]); w.z = cvt_pk_bf16(v1[0], v1[1]); w.w = cvt_pk_bf16(v1[2], v1[3]);
                    *(u32x4*)(rowp + bj * HALF) = w; } }
    }
};
}

struct Frame { LAS unsigned char* lds; volatile LAS unsigned* MISC; gu32* ctl; int tid, lane, wave, vcu, G; };
struct Args { const void* in[30]; float* out; unsigned char* ws; int ph_lo, ph_hi; };
typedef const __attribute__((address_space(4))) Args* ArgsP;
#define LAUNDER(p) asm volatile("" : "+s"(p))
typedef float f32x16 __attribute__((ext_vector_type(16)));
typedef unsigned u32x2 __attribute__((ext_vector_type(2)));

__device__ __forceinline__ float wave_sum(float v) {
#pragma unroll
    for (int o = 1; o < 64; o <<= 1) v += __shfl_xor(v, o);
    return v;
}
__device__ __forceinline__ float bf2f(bf16 h) { return __uint_as_float(((unsigned)h) << 16); }
__device__ __forceinline__ float bflo(unsigned w) { return __uint_as_float(w << 16); }
__device__ __forceinline__ float bfhi(unsigned w) { return __uint_as_float(w & 0xffff0000u); }
__device__ __forceinline__ float sigm(float x) { return __builtin_amdgcn_rcpf(1.0f + __expf(-x)); }

__device__ __forceinline__ void tr_load(f32x4 (&v)[8], const float* W, int N, int k0, int n0, int lane) {
#pragma unroll
    for (int i = 0; i < 8; ++i) v[i] = *(const GAS f32x4*)(W + (size_t)(k0 + 8 * i + (lane >> 3)) * N + n0 + 4 * (lane & 7));
}
__device__ __forceinline__ void tr_store(const f32x4 (&v)[8], int k0, bf16* WT, int KD, int dst_row0, LAS float* scr, int lane) {
#pragma unroll
    for (int i = 0; i < 8; ++i) { LAS float* d = scr + (8 * i + (lane >> 3)) * 33 + 4 * (lane & 7); d[0] = v[i].x; d[1] = v[i].y; d[2] = v[i].z; d[3] = v[i].w; }
    LDS_WAIT(); asm volatile("" ::: "memory");
    const int c = lane & 7;
#pragma unroll
    for (int j = 0; j < 4; ++j) { const int n = (lane >> 3) + 8 * j; const LAS float* s = scr + (8 * c) * 33 + n;
        v4u o; o.x = pk2(s[0 * 33], s[1 * 33]); o.y = pk2(s[2 * 33], s[3 * 33]); o.z = pk2(s[4 * 33], s[5 * 33]); o.w = pk2(s[6 * 33], s[7 * 33]);
        *(GAS v4u*)(WT + (size_t)(dst_row0 + n) * KD + k0 + 8 * c) = o; }
    LDS_WAIT(); asm volatile("" ::: "memory");
}
__device__ __forceinline__ void tr_item(const float* W, int N, int k0, int n0, bf16* WT, int KD, int dst_row0, LAS float* scr, int lane) {
    f32x4 v[8]; tr_load(v, W, N, k0, n0, lane); tr_store(v, k0, WT, KD, dst_row0, scr, lane);
}

__device__ __forceinline__ void p0_prologue(const Frame& F, ArgsP A) {
    unsigned char* ws = A->ws;
    LAS float* scr = (LAS float*)(F.lds + F.wave * 16384);
    const int gw = F.vcu * NWAVES + F.wave, NGW = F.G * NWAVES;
    const float* w_in = (const float*)A->in[6]; const float* p_rwkv = (const float*)A->in[22]; const float* p_attn = (const float*)A->in[23];
    const float* w_out = (const float*)A->in[24]; const float* g2 = (const float*)A->in[13];
    bf16* WinT = (bf16*)(ws + WS_WINT); bf16* PrT = (bf16*)(ws + WS_PRT); bf16* PaT = (bf16*)(ws + WS_PAT); bf16* WoT = (bf16*)(ws + WS_WOT); bf16* G2T = (bf16*)(ws + WS_G2T);
    constexpr int I_IN = 16 * 148, I_P = 8 * 32, I_O = 16 * 32, I_G = 2 * 16, NIT = I_IN + 2 * I_P + I_O + I_G;
    for (int it = gw; it < NIT; it += NGW) {
        int r = it;
        if (r < I_IN) { tr_item(w_in, NZ, 64 * (r / 148), 32 * (r % 148), WinT, 1024, 32 * (r % 148), scr, F.lane); continue; } r -= I_IN;
        if (r < I_P) { tr_item(p_rwkv, 1024, 64 * (r / 32), 32 * (r % 32), PrT, 512, 32 * (r % 32), scr, F.lane); continue; } r -= I_P;
        if (r < I_P) { tr_item(p_attn, 1024, 64 * (r / 32), 32 * (r % 32), PaT, 512, 32 * (r % 32), scr, F.lane); continue; } r -= I_P;
        if (r < I_O) { tr_item(w_out, 1024, 64 * (r / 32), 32 * (r % 32), WoT, 1024, 32 * (r % 32), scr, F.lane); continue; } r -= I_O;
        tr_item(g2, 512, 64 * (r / 16), 32 * (r % 16), G2T, 256, 32 * (r % 16), scr, F.lane);
    }
    { const int gt = (F.vcu * NWAVES + F.wave) * 64 + F.lane, NT = F.G * NWAVES * 64; const v4u z4 = {0u, 0u, 0u, 0u};
      for (int i = gt; i < 128 * 128; i += NT) *(GAS v4u*)(WinT + (size_t)4736 * 1024 + (size_t)i * 8) = z4;
      for (int i = gt; i < 512 * 16; i += NT) *(GAS v4u*)(G2T + (size_t)(i >> 4) * 256 + 128 + (i & 15) * 8) = z4; }
    __syncthreads();
    const float* cvec = (const float*)A->in[1]; const float* w_ada = (const float*)A->in[3]; const float* b_ada = (const float*)A->in[4];
    float* mod = (float*)(ws + WS_MOD);
    for (int task = F.vcu; task < 192; task += F.G) { const int cg = task % 96, dh = task / 96;
        LAS float* ca = (LAS float*)F.lds;
        LAS float* red = (LAS float*)(F.lds + 65536);
        for (int i = F.tid; i < 16 * 1024; i += 512) { const int b = i >> 10, d = i & 1023; const float cv = cvec[i]; ca[d * 16 + b] = cv / (1.0f + __expf(-cv)); }
        __syncthreads();
        float acc[16];
#pragma unroll
        for (int b = 0; b < 16; ++b) acc[b] = 0.f;
        const int col = cg * 64 + F.lane;
#pragma unroll 8
        for (int dd = 0; dd < 64; ++dd) { const int d = dh * 512 + F.wave * 64 + dd; const float w = w_ada[(size_t)d * 6144 + col];
            const LAS f32x4* cp = (const LAS f32x4*)(ca + d * 16);
#pragma unroll
            for (int q = 0; q < 4; ++q) { const f32x4 cv = cp[q]; acc[q * 4 + 0] += cv[0] * w; acc[q * 4 + 1] += cv[1] * w; acc[q * 4 + 2] += cv[2] * w; acc[q * 4 + 3] += cv[3] * w; } }
#pragma unroll
        for (int b = 0; b < 16; ++b) red[(F.wave * 16 + b) * 64 + F.lane] = acc[b];
        __syncthreads();
        for (int o = F.tid; o < 1024; o += 512) { const int b = o >> 6, cl = o & 63; float sacc = 0.f;
#pragma unroll
            for (int w = 0; w < 8; ++w) sacc += red[(w * 16 + b) * 64 + cl];
            atomicAdd(&mod[b * 6144 + cg * 64 + cl], sacc + (dh == 0 ? b_ada[cg * 64 + cl] : 0.f)); }
        __syncthreads();
    }
}


__device__ __forceinline__ float dpp_wave_sum(float v) {
    v += __int_as_float(__builtin_amdgcn_update_dpp(0, __float_as_int(v), 0xB1, 0xf, 0xf, false));
    v += __int_as_float(__builtin_amdgcn_update_dpp(0, __float_as_int(v), 0x4E, 0xf, 0xf, false));
    v += __int_as_float(__builtin_amdgcn_update_dpp(0, __float_as_int(v), 0x141, 0xf, 0xf, false));
    v += __int_as_float(__builtin_amdgcn_update_dpp(0, __float_as_int(v), 0x140, 0xf, 0xf, false));
    v += __int_as_float(__builtin_amdgcn_ds_swizzle(__float_as_int(v), 0x401F));
    auto r_ = __builtin_amdgcn_permlane32_swap(__float_as_uint(v), __float_as_uint(v), false, false);
    return __uint_as_float(r_[0]) + __uint_as_float(r_[1]); }

template <int R, bool XBF> __device__ __forceinline__ void modnorm_rows(const void* x, int m0, int mstride, const float* g, const float* mod, int sh_off, int sc_off, bf16* out, int lane, f32x4 (&u)[R][4]) {
    f32x4 v[R][4];
#pragma unroll
    for (int i = 0; i < R; ++i) {
        if (XBF) { const GAS u32x2* xr = (const GAS u32x2*)((const bf16*)x + (size_t)(m0 + i * mstride) * 1024) + lane;
#pragma unroll
            for (int j = 0; j < 4; ++j) { const u32x2 w = xr[64 * j]; v[i][j] = (f32x4){bflo(w.x), bfhi(w.x), bflo(w.y), bfhi(w.y)}; } }
        else { const GAS f32x4* xr = (const GAS f32x4*)((const float*)x + (size_t)(m0 + i * mstride) * 1024) + lane;
#pragma unroll
            for (int j = 0; j < 4; ++j) v[i][j] = xr[64 * j]; } }
    f32x4 gg[4];
#pragma unroll
    for (int j = 0; j < 4; ++j) gg[j] = ((const GAS f32x4*)g)[lane + 64 * j];
#pragma unroll
    for (int i = 0; i < R; ++i) { const int m = m0 + i * mstride, b = m >> 11; float s = 0.f;
#pragma unroll
        for (int j = 0; j < 4; ++j) s += (v[i][j].x * v[i][j].x + v[i][j].y * v[i][j].y) + (v[i][j].z * v[i][j].z + v[i][j].w * v[i][j].w);
        const float rs = rsqrtf(dpp_wave_sum(s) * (1.0f / 1024.0f) + 1e-6f);
        const float* sh = mod + (size_t)b * 6144 + sh_off; const float* sc = mod + (size_t)b * 6144 + sc_off;
        GAS unsigned long long* o8 = (GAS unsigned long long*)(out + (size_t)m * 1024) + lane;
#pragma unroll
        for (int j = 0; j < 4; ++j) { const f32x4 s1 = ((const GAS f32x4*)sc)[lane + 64 * j], s0 = ((const GAS f32x4*)sh)[lane + 64 * j];
            f32x4 y = (v[i][j] * rs) * gg[j]; y = y * (s1 + 1.0f) + s0; u[i][j] = y;
            o8[64 * j] = (unsigned long long)pk2(y.x, y.y) | ((unsigned long long)pk2(y.z, y.w) << 32); } }
}

template <int R> __device__ __forceinline__ void load_rows_bf16(const bf16* x, int m0, int mstride, int lane_in, u32x2 (&raw)[R][4]) {
    int lane = lane_in; asm volatile("" : "+v"(lane));
#pragma unroll
    for (int i = 0; i < R; ++i) { const GAS u32x2* xr = (const GAS u32x2*)(x + (size_t)(m0 + i * mstride) * 1024) + lane;
#pragma unroll
        for (int j = 0; j < 4; ++j) raw[i][j] = xr[64 * j]; }
}
template <int R> __device__ __forceinline__ void modnorm_rows_pre(const u32x2 (&raw)[R][4], int m0, int mstride, const float* g, const float* mod, int sh_off, int sc_off, bf16* out, int lane, f32x4 (&u)[R][4]) {
    f32x4 gg[4];
#pragma unroll
    for (int j = 0; j < 4; ++j) gg[j] = ((const GAS f32x4*)g)[lane + 64 * j];
#pragma unroll
    for (int i = 0; i < R; ++i) { const int m = m0 + i * mstride, b = m >> 11; float s = 0.f; f32x4 v[4];
#pragma unroll
        for (int j = 0; j < 4; ++j) { const u32x2 w = raw[i][j]; v[j] = (f32x4){bflo(w.x), bfhi(w.x), bflo(w.y), bfhi(w.y)}; s += (v[j].x * v[j].x + v[j].y * v[j].y) + (v[j].z * v[j].z + v[j].w * v[j].w); }
        const float rs = rsqrtf(dpp_wave_sum(s) * (1.0f / 1024.0f) + 1e-6f);
        const float* sh = mod + (size_t)b * 6144 + sh_off; const float* sc = mod + (size_t)b * 6144 + sc_off;
        GAS unsigned long long* o8 = (GAS unsigned long long*)(out + (size_t)m * 1024) + lane;
#pragma unroll
        for (int j = 0; j < 4; ++j) { const f32x4 s1 = ((const GAS f32x4*)sc)[lane + 64 * j], s0 = ((const GAS f32x4*)sh)[lane + 64 * j];
            f32x4 y = (v[j] * rs) * gg[j]; y = y * (s1 + 1.0f) + s0; u[i][j] = y;
            o8[64 * j] = (unsigned long long)pk2(y.x, y.y) | ((unsigned long long)pk2(y.z, y.w) << 32); } }
}

__device__ __forceinline__ void modnorm_row(const float* xrow, const float* g, const float* sh, const float* sc, bf16* orow, int lane, f32x4 (&u)[4]) {
    const GAS f32x4* xr = (const GAS f32x4*)xrow + lane;
    f32x4 v[4]; float s = 0.f;
#pragma unroll
    for (int j = 0; j < 4; ++j) { v[j] = xr[64 * j]; s += (v[j].x * v[j].x + v[j].y * v[j].y) + (v[j].z * v[j].z + v[j].w * v[j].w); }
    const float rs = rsqrtf(wave_sum(s) * (1.0f / 1024.0f) + 1e-6f);
    GAS unsigned long long* o8 = (GAS unsigned long long*)orow + lane;
#pragma unroll
    for (int j = 0; j < 4; ++j) { const f32x4 gg = ((const GAS f32x4*)g)[lane + 64 * j], s1 = ((const GAS f32x4*)sc)[lane + 64 * j], s0 = ((const GAS f32x4*)sh)[lane + 64 * j];
        f32x4 y = (v[j] * rs) * gg; y = y * (s1 + 1.0f) + s0; u[j] = y;
        o8[64 * j] = (unsigned long long)pk2(y.x, y.y) | ((unsigned long long)pk2(y.z, y.w) << 32); }
}

__device__ __forceinline__ float softplusf(float x) { return x > 20.f ? x : log1pf(__expf(x)); }
__device__ __forceinline__ void scan_chain(const Frame& F, ArgsP A, int b, int h, int dir) {
    constexpr int CT = 32;
    LAS float* L = (LAS float*)F.lds;
    LAS float* W2S = L; LAS float* A2S = L + 4096; LAS float* ZRs = L + 8192; LAS float* ZKs = ZRs + 2048; LAS float* ZVs = ZKs + 2048; LAS float* TWs = ZVs + 2048; LAS float* ZAs = TWs + 2048;
    LAS float* DEC = ZAs + 2048; LAS float* KD = DEC + 2048; LAS float* AV = KD + 2048; LAS float* BV = AV + 2048; LAS float* YB = BV + 2048; LAS float* BON = YB + 2048;
    const bf16* Z = (const bf16*)(A->ws + WS_Z);
    const float* mu_prev = (const float*)A->in[7]; const float* mu_next = (const float*)A->in[8];
    const float* w0 = (const float*)A->in[9]; const float* w2 = (const float*)A->in[10]; const float* a0 = (const float*)A->in[11]; const float* a2 = (const float*)A->in[12];
    const float* k_k = (const float*)A->in[14]; const float* k_a = (const float*)A->in[15]; const float* r_k = (const float*)A->in[16];
    bf16* ydir = (bf16*)(A->ws + WS_XN) + (size_t)dir * M * 512; float* bonus = (float*)(A->ws + WS_BONUS) + (size_t)dir * M * 8;
    const int tid = F.tid, lane = F.lane, wave = F.wave;
    for (int i = tid; i < 4096; i += 512) { const int l = i >> 6, j = i & 63; W2S[i] = w2[((size_t)dir * 64 + l) * 512 + h * 64 + j]; A2S[i] = a2[((size_t)dir * 64 + l) * 512 + h * 64 + j]; }
    const int ch = h * 64 + lane;
    const float w0j = w0[dir * 512 + ch], a0j = a0[dir * 512 + ch], kkj = k_k[ch], kaj = k_a[ch], rkj = r_k[ch];
    float s[8];
#pragma unroll
    for (int q = 0; q < 8; ++q) s[q] = 0.f;
    const int ri = tid >> 3, jg = tid & 7;
    for (int ci = 0; ci < T / CT; ++ci) {
        const int t0 = (dir ? (T / CT - 1 - ci) : ci) * CT;
#pragma unroll 4
        for (int i = 0; i < 20; ++i) { const int e = tid + 512 * i, arr = e >> 11, rem = e & 2047, tl = rem >> 6, j = rem & 63;
            const int col = (arr == 0 ? ZR + h * 64 : arr == 1 ? ZK + h * 64 : arr == 2 ? ZV + h * 64 : arr == 3 ? ZWD + dir * 64 : ZAD + dir * 64) + j;
            const int t = t0 + tl; const bf16* zp = Z + ((size_t)b * T + t) * NZ + col;
            const float z0 = bf2f(zp[0]), zm = t > 0 ? bf2f(zp[-NZ]) : 0.f, zq = t < T - 1 ? bf2f(zp[NZ]) : 0.f;
            float zs = z0 + mu_prev[col] * (zm - z0) + mu_next[col] * (zq - z0);
            if (arr == 3) zs = tanhf(zs);
            ZRs[arr * 2048 + rem] = zs; }
        __syncthreads();
#pragma unroll 1
        for (int q = 0; q < 4; ++q) { const int tl = wave + 8 * q;
            float wraw = w0j, araw = a0j;
#pragma unroll 8
            for (int l = 0; l < 64; ++l) { wraw += TWs[tl * 64 + l] * W2S[l * 64 + lane]; araw += ZAs[tl * 64 + l] * A2S[l * 64 + lane]; }
            const float w = -softplusf(-wraw) - 0.5f, dec = __expf(-__expf(w)), ad = sigm(araw);
            const float k = ZKs[tl * 64 + lane], kkr = k * kkj, nrm = sqrtf(wave_sum(kkr * kkr)), kk = kkr / fmaxf(nrm, 1e-12f);
            const float kd = k * (1.0f + (ad - 1.0f) * kaj);
            DEC[tl * 64 + lane] = dec; KD[tl * 64 + lane] = kd; AV[tl * 64 + lane] = -kk; BV[tl * 64 + lane] = kk * ad;
            const float bon = wave_sum(ZRs[tl * 64 + lane] * kd * rkj); if (lane == 0) BON[tl] = bon; }
        __syncthreads();
#pragma unroll 1
        for (int st = 0; st < CT; ++st) { const int tl = dir ? (CT - 1 - st) : st; const int o = tl * 64 + jg * 8;
            const f32x4 a0v = *(const LAS f32x4*)(AV + o), a1v = *(const LAS f32x4*)(AV + o + 4), d0 = *(const LAS f32x4*)(DEC + o), d1 = *(const LAS f32x4*)(DEC + o + 4);
            const f32x4 b0 = *(const LAS f32x4*)(BV + o), b1 = *(const LAS f32x4*)(BV + o + 4), k0 = *(const LAS f32x4*)(KD + o), k1 = *(const LAS f32x4*)(KD + o + 4);
            const f32x4 r0 = *(const LAS f32x4*)(ZRs + o), r1 = *(const LAS f32x4*)(ZRs + o + 4); const float vi = ZVs[tl * 64 + ri];
            float p = (s[0] * a0v[0] + s[1] * a0v[1]) + (s[2] * a0v[2] + s[3] * a0v[3]) + (s[4] * a1v[0] + s[5] * a1v[1]) + (s[6] * a1v[2] + s[7] * a1v[3]);
            p += __shfl_xor(p, 1); p += __shfl_xor(p, 2); p += __shfl_xor(p, 4);
            s[0] = s[0] * d0[0] + p * b0[0] + vi * k0[0]; s[1] = s[1] * d0[1] + p * b0[1] + vi * k0[1]; s[2] = s[2] * d0[2] + p * b0[2] + vi * k0[2]; s[3] = s[3] * d0[3] + p * b0[3] + vi * k0[3];
            s[4] = s[4] * d1[0] + p * b1[0] + vi * k1[0]; s[5] = s[5] * d1[1] + p * b1[1] + vi * k1[1]; s[6] = s[6] * d1[2] + p * b1[2] + vi * k1[2]; s[7] = s[7] * d1[3] + p * b1[3] + vi * k1[3];
            float y = (s[0] * r0[0] + s[1] * r0[1]) + (s[2] * r0[2] + s[3] * r0[3]) + (s[4] * r1[0] + s[5] * r1[1]) + (s[6] * r1[2] + s[7] * r1[3]);
            y += __shfl_xor(y, 1); y += __shfl_xor(y, 2); y += __shfl_xor(y, 4);
            if (jg == 0) YB[tl * 64 + ri] = y; }
        __syncthreads();
#pragma unroll
        for (int i = 0; i < 4; ++i) { const int e = tid + 512 * i, tl = e >> 6, c = e & 63; ydir[((size_t)b * T + t0 + tl) * 512 + h * 64 + c] = (bf16)f2bf(YB[e]); }
        if (tid < CT) bonus[((size_t)b * T + t0 + tid) * 8 + h] = BON[tid];
        __syncthreads();
    }
}


#define SDEV __device__ __forceinline__
#define S_UNROLL _Pragma("unroll")
#define S_MEMBAR() do { asm volatile("" ::: "memory"); __builtin_amdgcn_sched_barrier(0); } while (0)
#define S_LAUNDER_I(x) asm volatile("" : "+v"(x))
#define S_LAUNDER_S(x) asm volatile("" : "+s"(x))
#define S_PIN(x) asm volatile("" : "+v"(x))
typedef float f32x2s __attribute__((ext_vector_type(2))); typedef __bf16 bf16x2s __attribute__((ext_vector_type(2)));
__device__ __forceinline__ unsigned s_cvtpk(float lo, float hi) { f32x2s v = {lo, hi}; bf16x2s b = __builtin_convertvector(v, bf16x2s); return __builtin_bit_cast(unsigned, b); }
__device__ __forceinline__ float s_rowsum16(float v) {
    v += __int_as_float(__builtin_amdgcn_update_dpp(0, __float_as_int(v), 0xB1, 0xf, 0xf, false));
    v += __int_as_float(__builtin_amdgcn_update_dpp(0, __float_as_int(v), 0x4E, 0xf, 0xf, false));
    v += __int_as_float(__builtin_amdgcn_update_dpp(0, __float_as_int(v), 0x141, 0xf, 0xf, false));
    v += __int_as_float(__builtin_amdgcn_update_dpp(0, __float_as_int(v), 0x140, 0xf, 0xf, false));
    return v; }
#define S_MFMA(a, b, c) __builtin_amdgcn_mfma_f32_32x32x16_bf16(a, b, c, 0, 0, 0)
#define S_PK(lo, hi) s_cvtpk(lo, hi)
#define S_SWAP(x, y) do { auto r_ = __builtin_amdgcn_permlane32_swap(x, y, false, false); x = r_[0]; y = r_[1]; } while (0)
#define S_ROWSUM16(v) s_rowsum16(v)
__device__ __forceinline__ float s_wavesum(float v) { v = s_rowsum16(v);
    v += __int_as_float(__builtin_amdgcn_ds_swizzle(__float_as_int(v), 0x401F));
    auto r_ = __builtin_amdgcn_permlane32_swap(__float_as_uint(v), __float_as_uint(v), false, false);
    return __uint_as_float(r_[0]) + __uint_as_float(r_[1]); }
#define S_WAVESUM(v) s_wavesum(v)
#define S_SWAP16(x, y) do { auto r_ = __builtin_amdgcn_permlane16_swap(x, y, false, false); x = r_[0]; y = r_[1]; } while (0)
#define S_DPPF(v, ctrl) __int_as_float(__builtin_amdgcn_update_dpp(0, __float_as_int(v), ctrl, 0xf, 0xf, false))
__device__ __forceinline__ float s_treesum32(float (&q)[32], int lane) {
    _Pragma("unroll") for (int i = 0; i < 16; ++i) { unsigned x = __float_as_uint(q[i]), y = __float_as_uint(q[i + 16]); S_SWAP(x, y); q[i] = __uint_as_float(x) + __uint_as_float(y); }
    _Pragma("unroll") for (int i = 0; i < 8; ++i) { unsigned x = __float_as_uint(q[i]), y = __float_as_uint(q[i + 8]); S_SWAP16(x, y); q[i] = __uint_as_float(x) + __uint_as_float(y); }
    const bool b3 = (lane & 8) != 0, b2 = (lane & 4) != 0, b1 = (lane & 2) != 0;
    _Pragma("unroll") for (int i = 0; i < 4; ++i) { const float a = q[i], b = q[i + 4]; const float c = b3 ? b : a, d = b3 ? a : b; q[i] = c + S_DPPF(d, 0x140); }
    _Pragma("unroll") for (int i = 0; i < 2; ++i) { const float a = q[i], b = q[i + 2]; const float c = b2 ? b : a, d = b2 ? a : b; q[i] = c + S_DPPF(d, 0x141); }
    { const float a = q[0], b = q[1]; const float c = b1 ? b : a, d = b1 ? a : b; q[0] = c + S_DPPF(d, 0x1B); }
    return q[0] + S_DPPF(q[0], 0xB1); }
#define S_GAS GAS
#define S_READLANE(v, l) __int_as_float(__builtin_amdgcn_readlane(__float_as_int(v), l))
#define S_RCP(x) __builtin_amdgcn_rcpf(x)
#define S_EXP2(x) __builtin_amdgcn_exp2f(x)
#define S_LOG2(x) __builtin_amdgcn_logf(x)
#define S_RSQ(x) __builtin_amdgcn_rsqf(x)
#define S_LDS_WAIT() asm volatile("s_waitcnt lgkmcnt(0)" ::: "memory")
#define S_LDSP LAS unsigned char*
#define S_LDS_BF16P LAS bf16*
#define S_LDS_U32P LAS unsigned*
#define S_LDS_F32P LAS float*
#define S_LDS_CONST_BF16X8P const LAS bf16x8*
#define S_LDS_BF16X8P LAS bf16x8*
#define S_LDS_CONST_F32X4P const LAS f32x4*
#define S_LDS_CONST_F32P const LAS float*
#define S_FLAG_STORE(p, v) do { *(volatile LAS unsigned*)(p) = (v); } while (0)
#define S_FLAG_WAIT(p, v) do { unsigned sp_ = 0; while (*(volatile LAS unsigned*)(p) != (v)) { __builtin_amdgcn_s_sleep(2); if (++sp_ > (1u << 24)) break; } asm volatile("" ::: "memory"); } while (0)
struct SFrag { bf16x8 s[2]; };
struct SMat { SFrag t[2]; };
SDEV f32x16 smm(const SFrag& X, const SFrag& Y, f32x16 acc) { acc = S_MFMA(X.s[0], Y.s[0], acc); acc = S_MFMA(X.s[1], Y.s[1], acc); return acc; }
SDEV f32x16 szero() { f32x16 z; S_UNROLL for (int i = 0; i < 16; ++i) z[i] = 0.f; return z; }
SDEV SFrag spack(const f32x16& d) { SFrag f;
    S_UNROLL for (int s = 0; s < 2; ++s) { v4u w; S_UNROLL for (int q = 0; q < 4; ++q) w[q] = S_PK(d[8 * s + 2 * q], d[8 * s + 2 * q + 1]); f.s[s] = __builtin_bit_cast(bf16x8, w); }
    return f; }
SDEV f32x16 sunpack(const SFrag& f) { f32x16 d;
    S_UNROLL for (int s = 0; s < 2; ++s) { const v4u w = __builtin_bit_cast(v4u, f.s[s]); S_UNROLL for (int q = 0; q < 4; ++q) { d[8 * s + 2 * q] = __uint_as_float(w[q] << 16); d[8 * s + 2 * q + 1] = __uint_as_float(w[q] & 0xffff0000u); } }
    return d; }
SDEV SMat splain2d(const unsigned (&pp)[16]) { unsigned d0[8], d1[8];
    S_UNROLL for (int g = 0; g < 4; ++g) S_UNROLL for (int p = 0; p < 2; ++p) { unsigned x = pp[4 * g + p], y = pp[4 * g + 2 + p]; S_SWAP(x, y); d0[2 * g + p] = x; d1[2 * g + p] = y; }
    SMat m;
    S_UNROLL for (int s = 0; s < 2; ++s) { v4u a, b; S_UNROLL for (int q = 0; q < 4; ++q) { a[q] = d0[4 * s + q]; b[q] = d1[4 * s + q]; } m.t[0].s[s] = __builtin_bit_cast(bf16x8, a); m.t[1].s[s] = __builtin_bit_cast(bf16x8, b); }
    return m; }
SDEV void sd2plain(const f32x16& D0, const f32x16& D1, float (&x)[32]) {
    S_UNROLL for (int r = 0; r < 16; ++r) { unsigned a = __float_as_uint(D0[r]), b = __float_as_uint(D1[r]); S_SWAP(a, b); const int ta = (r & 3) + 8 * (r >> 2); x[ta] = __uint_as_float(a); x[ta + 4] = __uint_as_float(b); } }
SDEV SFrag sident(int n_in, int hh_in) { int n1 = n_in, r1 = 4 * hh_in; S_LAUNDER_I(n1); S_LAUNDER_I(r1); f32x16 id; S_UNROLL for (int g = 0; g < 16; ++g) id[g] = (((g & 3) + 8 * (g >> 2) + r1) == n1) ? 1.f : 0.f; return spack(id); }
SDEV void sd2plain_pk(const f32x16& D0, const f32x16& D1, unsigned (&xp)[16]) {
    S_UNROLL for (int m = 0; m < 8; ++m) { unsigned a = S_PK(D0[2 * m], D0[2 * m + 1]), b = S_PK(D1[2 * m], D1[2 * m + 1]); S_SWAP(a, b); const int qa = 4 * (m >> 1) + (m & 1); xp[qa] = a; xp[qa + 2] = b; } }
SDEV float swave_sum(float v) { return S_WAVESUM(v); }

struct ScanArgs { const S_GAS bf16* Z; const S_GAS float* mu_prev; const S_GAS float* mu_next; const S_GAS float* w0; const S_GAS float* a0; const S_GAS float* k_k; const S_GAS float* k_a; const S_GAS float* r_k; S_GAS bf16* ydir; S_GAS float* bonus; S_GAS unsigned char* prep; };

#define SC_W2F 0
#define SC_A2F 8192
#define SC_SIG 16384
#define SC_GTAB 24576
#define SC_FLAG 26624
#define SC_WR 28672
#define SC_AR 94208
#define SC_RSQ 126976
#define SC_LDS_BYTES 128000
#ifndef SB_ILP
#define SB_ILP 8
#endif
#define SC_PF 4

SDEV void scan2_setup(S_LDSP lds, const S_GAS float* w2, const S_GAS float* a2, int h, int dir, int tid) {
    { float wv[16];
      S_UNROLL for (int it = 0; it < 16; ++it) { const int e = tid + 512 * it; const int mat = e >> 12, r = e & 4095, jj = r & 7, ln = (r >> 3) & 63, s = (r >> 9) & 1, jt = (r >> 10) & 1, lt = (r >> 11) & 1;
          const int n = ln & 31, hh = ln >> 5, g = 8 * s + jj, l = 32 * lt + (g & 3) + 8 * (g >> 2) + 4 * hh, j = 32 * jt + n;
          wv[it] = (mat ? a2 : w2)[((size_t)dir * 64 + l) * 512 + h * 64 + j]; }
      S_UNROLL for (int it = 0; it < 16; ++it) { const int e = tid + 512 * it; const int mat = e >> 12, r = e & 4095;
          ((S_LDS_BF16P)(lds + (mat ? SC_A2F : SC_W2F)))[r] = (bf16)(S_PK(wv[it] * -1.442695041f, 0.f) & 0xffffu); } }
    for (int e = tid; e < 2048; e += 512) ((S_LDS_U32P)(lds + SC_SIG))[e] = 0u;
    if (tid == 0) S_FLAG_STORE(lds + SC_FLAG, 0u);
}

SDEV void scan2_prep(const ScanArgs& A_in, int b_in, int dir_in, int c, int lane_in) {
    ScanArgs A = A_in; int b = b_in, dir = dir_in;
    S_LAUNDER_S(A.Z); S_LAUNDER_S(A.mu_prev); S_LAUNDER_S(A.mu_next); S_LAUNDER_S(A.prep); S_LAUNDER_S(b); S_LAUNDER_S(dir);
    int lane = lane_in; S_LAUNDER_I(lane);
    const int n = lane & 31, hh = lane >> 5;
    const int sgn = dir ? -1 : 1, tau0 = dir ? (T - 1 - 32 * c) : 32 * c;
    const S_GAS bf16* zb = A.Z + (size_t)b * T * NZ;
    const ptrdiff_t st = (ptrdiff_t)sgn * NZ; const bool first = (c == 0), last = (c == T / 32 - 1);
    const int cw = ZWD + dir * 64 + lane, ca = ZAD + dir * 64 + lane;
    const SFrag IDF = sident(n, hh); unsigned ppw[16], ppa[16];
    { const float mA = dir ? A.mu_next[cw] : A.mu_prev[cw], mB = dir ? A.mu_prev[cw] : A.mu_next[cw], nA = dir ? A.mu_next[ca] : A.mu_prev[ca], nB = dir ? A.mu_prev[ca] : A.mu_next[ca];
      const S_GAS bf16* pw = zb + (ptrdiff_t)tau0 * NZ + cw - st; const S_GAS bf16* pa = zb + (ptrdiff_t)tau0 * NZ + ca - st;
      float rw[34], ra[34];
      S_UNROLL for (int q = 0; q < 34; ++q) { const bool ok = !((q == 0 && first) || (q == 33 && last)); rw[q] = ok ? bf2f(*pw) : 0.f; ra[q] = ok ? bf2f(*pa) : 0.f; pw += st; pa += st; }
      S_MEMBAR();
      const float mC = 1.f - mA - mB, nC = 1.f - nA - nB; float tprev = 0.f, aprev = 0.f;
      S_UNROLL for (int p = 0; p < 32; ++p) { if ((p & 7) == 0) S_MEMBAR();
          const float ws = mC * rw[p + 1] + mA * rw[p] + mB * rw[p + 2], as = nC * ra[p + 1] + nA * ra[p] + nB * ra[p + 2];
          const float tw = 1.f - 2.f * S_RCP(1.f + S_EXP2(ws * 2.885390082f));
          if (p & 1) { ppw[p >> 1] = S_PK(tprev, tw); ppa[p >> 1] = S_PK(aprev, as); S_PIN(ppw[p >> 1]); S_PIN(ppa[p >> 1]); } else { tprev = tw; aprev = as; } } }
    S_MEMBAR();
    const SMat TW = splain2d(ppw), AD = splain2d(ppa);
    S_GAS bf16x8* pf = (S_GAS bf16x8*)(A.prep + (size_t)((b * 2 + dir) * 64 + c) * 8192) + lane;
    S_UNROLL for (int lt = 0; lt < 2; ++lt) { const SFrag tw_ = spack(smm(TW.t[lt], IDF, szero())), ad_ = spack(smm(AD.t[lt], IDF, szero()));
        S_UNROLL for (int s = 0; s < 2; ++s) { pf[(lt * 2 + s) * 64] = tw_.s[s]; pf[256 + (lt * 2 + s) * 64] = ad_.s[s]; } }
}

SDEV void scan2_chunk(S_LDSP lds, const ScanArgs& A_in, int b_in, int h_in, int dir_in, int c, int lane_in, int wave) {
    ScanArgs A = A_in; int b = b_in, h = h_in, dir = dir_in;
    S_LAUNDER_S(A.Z); S_LAUNDER_S(A.mu_prev); S_LAUNDER_S(A.mu_next); S_LAUNDER_S(A.w0); S_LAUNDER_S(A.a0); S_LAUNDER_S(A.k_k); S_LAUNDER_S(A.k_a); S_LAUNDER_S(A.r_k); S_LAUNDER_S(A.ydir); S_LAUNDER_S(A.bonus); S_LAUNDER_S(A.prep);
    S_LAUNDER_S(b); S_LAUNDER_S(h); S_LAUNDER_S(dir);
    int lane = lane_in; S_LAUNDER_I(lane);
    const int n = lane & 31, hh = lane >> 5;
    const int sgn = dir ? -1 : 1, tau0 = dir ? (T - 1 - 32 * c) : 32 * c;
    const S_GAS bf16* zb = A.Z + (size_t)b * T * NZ;
    const ptrdiff_t st = (ptrdiff_t)sgn * NZ; const bool first = (c == 0), last = (c == T / 32 - 1);
    const int cr = ZR + h * 64 + lane, ck = ZK + h * 64 + lane, cv = ZV + h * 64 + lane, chn = h * 64 + lane;
    unsigned rr[34], rk[34], rv[34];
    {   SFrag TWT[2], ADT[2];
        { const S_GAS bf16x8* pf = (const S_GAS bf16x8*)(A.prep + (size_t)((b * 2 + dir) * 64 + c) * 8192) + lane;
          S_UNROLL for (int lt = 0; lt < 2; ++lt) S_UNROLL for (int s = 0; s < 2; ++s) { TWT[lt].s[s] = pf[(lt * 2 + s) * 64]; ADT[lt].s[s] = pf[256 + (lt * 2 + s) * 64]; } }
        { const S_GAS bf16* pr = zb + (ptrdiff_t)tau0 * NZ + cr - st; const S_GAS bf16* pk = zb + (ptrdiff_t)tau0 * NZ + ck - st; const S_GAS bf16* pv = zb + (ptrdiff_t)tau0 * NZ + cv - st;
          const ptrdiff_t o0 = first ? st : 0, o33 = last ? -st : 0;
          S_UNROLL for (int q = 0; q < 34; ++q) { const ptrdiff_t oo = (q == 0) ? o0 : (q == 33) ? o33 : 0; rr[q] = (unsigned)pr[oo]; rk[q] = (unsigned)pk[oo]; rv[q] = (unsigned)pv[oo]; pr += st; pk += st; pv += st; } }
        S_MEMBAR();
        f32x16 dw[2], da[2];
        S_UNROLL for (int jt = 0; jt < 2; ++jt) { const float w0s = A.w0[dir * 512 + h * 64 + 32 * jt + n] * -1.442695041f, a0s = A.a0[dir * 512 + h * 64 + 32 * jt + n] * -1.442695041f;
            S_UNROLL for (int g = 0; g < 16; ++g) { dw[jt][g] = w0s; da[jt][g] = a0s; }
            S_UNROLL for (int lt = 0; lt < 2; ++lt) { SFrag wf, af;
                S_UNROLL for (int s = 0; s < 2; ++s) { wf.s[s] = *(S_LDS_CONST_BF16X8P)(lds + SC_W2F + ((((lt * 2 + jt) * 2 + s) * 64 + lane) * 16)); af.s[s] = *(S_LDS_CONST_BF16X8P)(lds + SC_A2F + ((((lt * 2 + jt) * 2 + s) * 64 + lane) * 16)); }
                dw[jt] = smm(TWT[lt], wf, dw[jt]); da[jt] = smm(ADT[lt], af, da[jt]); } }
        S_UNROLL for (int jt = 0; jt < 2; ++jt) S_UNROLL for (int g = 0; g < 16; ++g) { const int t = (g & 3) + 8 * (g >> 2) + 4 * hh;
            ((S_LDS_F32P)(lds + SC_WR + wave * 8192))[t * 64 + 32 * jt + n] = dw[jt][g]; ((S_LDS_BF16P)(lds + SC_AR + wave * 4096))[t * 64 + 32 * jt + n] = (bf16)(S_PK(da[jt][g], 0.f) & 0xffffu); }
        S_LDS_WAIT();
    }
    S_MEMBAR();
    unsigned ppA[16], ppR[16], ppB[16], ppK[16], ppV[16], ppQ[16]; float gamC;
    {   const float mAr = dir ? A.mu_next[cr] : A.mu_prev[cr], mBr = dir ? A.mu_prev[cr] : A.mu_next[cr], mAk = dir ? A.mu_next[ck] : A.mu_prev[ck], mBk = dir ? A.mu_prev[ck] : A.mu_next[ck];
        const float mAv = dir ? A.mu_next[cv] : A.mu_prev[cv], mBv = dir ? A.mu_prev[cv] : A.mu_next[cv];
        const float kkj = A.k_k[chn], kaj = A.k_a[chn], rkj = A.r_k[chn];
        const float mCr = 1.f - mAr - mBr, mCk = 1.f - mAk - mBk, mCv = 1.f - mAv - mBv;
        float cs = 0.f, gprev = 1.f; float eA = 0.f, eR = 0.f, eB = 0.f, eK = 0.f, eV = 0.f, eQ = 0.f;
        float zf = first ? 0.f : 1.f, zl = last ? 0.f : 1.f; S_PIN(zf); S_PIN(zl);
        {
            float sq[32];
            float k_a = zf * __uint_as_float(rk[0] << 16), k_b = __uint_as_float(rk[1] << 16);
            S_UNROLL for (int p = 0; p < 32; ++p) { const float k_c = ((p == 31) ? zl : 1.f) * __uint_as_float(rk[p + 2] << 16); const float km = mCk * k_b + mAk * k_a + mBk * k_c; k_a = k_b; k_b = k_c;
                rk[p] = __float_as_uint(km); const float t_ = km * kkj; sq[p] = t_ * t_; }
            const float tot = s_treesum32(sq, lane);
            ((S_LDS_F32P)(lds + SC_RSQ + wave * 128))[lane >> 1] = S_RSQ(fmaxf(tot, 1e-24f)); }
        S_MEMBAR();
        float r_a = zf * __uint_as_float(rr[0] << 16), r_b = __uint_as_float(rr[1] << 16), v_a = zf * __uint_as_float(rv[0] << 16), v_b = __uint_as_float(rv[1] << 16);
        S_UNROLL for (int p = 0; p < 32; ++p) { if ((p & (SB_ILP - 1)) == 0) S_MEMBAR();
            const float zz = (p == 31) ? zl : 1.f; const float r_c = zz * __uint_as_float(rr[p + 2] << 16), v_c = zz * __uint_as_float(rv[p + 2] << 16);
            const float r = mCr * r_b + mAr * r_a + mBr * r_c, k = __uint_as_float(rk[p]), v = mCv * v_b + mAv * v_a + mBv * v_c; r_a = r_b; r_b = r_c; v_a = v_b; v_b = v_c;
            const float wraw = ((S_LDS_F32P)(lds + SC_WR + wave * 8192))[p * 64 + lane], araw = bf2f(((S_LDS_BF16P)(lds + SC_AR + wave * 4096))[p * 64 + lane]);
            const float lw2 = -0.8750387749f * S_RCP(1.f + S_EXP2(wraw));
            const float al = S_RCP(1.f + S_EXP2(araw));
            const float kk = k * kkj * ((S_LDS_CONST_F32P)(lds + SC_RSQ + wave * 128))[p];
            const float kd = k * (1.f + (al - 1.f) * kaj);
            cs += lw2; const float gam = S_EXP2(cs), ig = S_EXP2(-cs);
            const float xa = -kk * gprev, xr = r * gam, xb = kk * al * ig, xk = kd * ig, xq = xr * rkj; gprev = gam;
            if (p & 1) { ppA[p >> 1] = S_PK(eA, xa); ppR[p >> 1] = S_PK(eR, xr); ppB[p >> 1] = S_PK(eB, xb); ppK[p >> 1] = S_PK(eK, xk); ppV[p >> 1] = S_PK(eV, v); ppQ[p >> 1] = S_PK(eQ, xq);
                         S_PIN(ppQ[p >> 1]); S_PIN(ppA[p >> 1]); S_PIN(ppR[p >> 1]); S_PIN(ppB[p >> 1]); S_PIN(ppK[p >> 1]); S_PIN(ppV[p >> 1]); }
            else { eA = xa; eR = xr; eB = xb; eK = xk; eV = v; eQ = xq; } }
        gamC = gprev;
    }
    S_MEMBAR();
    float gc0, gc1; { unsigned x = __float_as_uint(gamC), y = x; S_SWAP(x, y); gc0 = __uint_as_float(x); gc1 = __uint_as_float(y); }
    ((S_LDS_F32P)(lds + SC_GTAB + wave * 256))[lane] = gamC;
    const SMat FA = splain2d(ppA), FB = splain2d(ppB), FK = splain2d(ppK), FV = splain2d(ppV);
    SFrag RT[2], MrbT, MrkT, LakT, Pf, PTf; f32x16 TT;
    {   const SFrag IDF = sident(n, hh); SFrag AT[2], BT[2], KT[2];
        { const SMat FR = splain2d(ppR); S_UNROLL for (int dt = 0; dt < 2; ++dt) RT[dt] = spack(smm(FR.t[dt], IDF, szero())); }
        SFrag QT[2]; { const SMat FQ = splain2d(ppQ); S_UNROLL for (int dt = 0; dt < 2; ++dt) QT[dt] = spack(smm(FQ.t[dt], IDF, szero())); }
        S_UNROLL for (int dt = 0; dt < 2; ++dt) { AT[dt] = spack(smm(FA.t[dt], IDF, szero())); BT[dt] = spack(smm(FB.t[dt], IDF, szero())); KT[dt] = spack(smm(FK.t[dt], IDF, szero())); }
        f32x16 L = szero(), LT = szero(), lak = szero(), mrb = szero(), mrk = szero();
        { f32x16 bq = szero(); S_UNROLL for (int dt = 0; dt < 2; ++dt) bq = smm(KT[dt], QT[dt], bq);
          int nb = n, rb = 4 * hh; S_LAUNDER_I(nb); S_LAUNDER_I(rb); float dsum = 0.f; S_UNROLL for (int g = 0; g < 16; ++g) dsum += (((g & 3) + 8 * (g >> 2) + rb) == nb) ? bq[g] : 0.f;
          if (((nb >> 2) & 1) == (rb >> 2)) A.bonus[((size_t)b * T + (tau0 + sgn * nb)) * 8 + h] = dsum; }
        S_UNROLL for (int dt = 0; dt < 2; ++dt) { L = smm(AT[dt], BT[dt], L); LT = smm(BT[dt], AT[dt], LT); lak = smm(KT[dt], AT[dt], lak); mrb = smm(BT[dt], RT[dt], mrb); mrk = smm(KT[dt], RT[dt], mrk); }
        int n2 = n, r2 = 4 * hh; S_LAUNDER_I(n2); S_LAUNDER_I(r2);
        S_UNROLL for (int g = 0; g < 16; ++g) { const int row = (g & 3) + 8 * (g >> 2) + r2;
            L[g] = (row > n2) ? L[g] : 0.f; LT[g] = (row < n2) ? LT[g] : 0.f; lak[g] = (row < n2) ? lak[g] : 0.f; mrb[g] = (row <= n2) ? mrb[g] : 0.f; mrk[g] = (row <= n2) ? mrk[g] : 0.f; }
        Pf = spack(L); PTf = spack(LT); LakT = spack(lak); MrbT = spack(mrb); MrkT = spack(mrk);
        TT = LT; S_UNROLL for (int g = 0; g < 16; ++g) TT[g] += (((g & 3) + 8 * (g >> 2) + r2) == n2) ? 1.f : 0.f;
    }
    S_MEMBAR();
    SFrag TTf = spack(TT);
    S_UNROLL for (int i = 1; i <= 4; ++i) { const f32x16 P2 = smm(PTf, Pf, szero()); SFrag P2Tf; if (i < 4) P2Tf = spack(smm(Pf, PTf, szero()));
        Pf = spack(P2); TT = smm(Pf, TTf, TT); TTf = spack(TT); if (i < 4) PTf = P2Tf; }
    S_MEMBAR();
    SFrag U0[2], Ap[2], RpT[2], Y0[2], GTf[2][2], Hf[2][2];
    S_UNROLL for (int vt = 0; vt < 2; ++vt) { const SFrag W = spack(smm(LakT, FV.t[vt], szero())); U0[vt] = spack(smm(TTf, W, szero())); }
    S_UNROLL for (int kt = 0; kt < 2; ++kt) Ap[kt] = spack(smm(TTf, FA.t[kt], szero()));
    S_UNROLL for (int kt = 0; kt < 2; ++kt) RpT[kt] = spack(smm(Ap[kt], MrbT, sunpack(RT[kt])));
    S_UNROLL for (int vt = 0; vt < 2; ++vt) Y0[vt] = spack(smm(MrkT, FV.t[vt], smm(MrbT, U0[vt], szero())));
    int n3 = n, r3 = 4 * hh; S_LAUNDER_I(n3); S_LAUNDER_I(r3);
    S_UNROLL for (int nt = 0; nt < 2; ++nt) S_UNROLL for (int mt = 0; mt < 2; ++mt) { f32x16 gt = smm(Ap[nt], FB.t[mt], szero()); const float gcv = mt ? gc1 : gc0;
        S_UNROLL for (int g = 0; g < 16; ++g) { const float idv = (nt == mt && ((g & 3) + 8 * (g >> 2) + r3) == n3) ? 1.f : 0.f; gt[g] = (gt[g] + idv) * gcv; }
        GTf[nt][mt] = spack(gt); }
    S_LDS_WAIT();
    S_UNROLL for (int mt = 0; mt < 2; ++mt) { float gr[16];
        S_UNROLL for (int q = 0; q < 4; ++q) { const f32x4 t4 = *(S_LDS_CONST_F32X4P)(lds + SC_GTAB + wave * 256 + (32 * mt + 8 * q + 4 * hh) * 4); S_UNROLL for (int i = 0; i < 4; ++i) gr[4 * q + i] = t4[i]; }
        S_UNROLL for (int vt = 0; vt < 2; ++vt) { f32x16 hm = smm(FK.t[mt], FV.t[vt], smm(FB.t[mt], U0[vt], szero())); S_UNROLL for (int g = 0; g < 16; ++g) hm[g] *= gr[g]; Hf[mt][vt] = spack(hm); } }
    S_MEMBAR();
    S_FLAG_WAIT(lds + SC_FLAG, (unsigned)c);
    SFrag SG[2][2];
    S_UNROLL for (int kt = 0; kt < 2; ++kt) S_UNROLL for (int vt = 0; vt < 2; ++vt) S_UNROLL for (int s = 0; s < 2; ++s) SG[kt][vt].s[s] = *(S_LDS_CONST_BF16X8P)(lds + SC_SIG + ((((kt * 2 + vt) * 2 + s) * 64 + lane) * 16));
    S_LDS_WAIT();
    S_UNROLL for (int mt = 0; mt < 2; ++mt) S_UNROLL for (int vt = 0; vt < 2; ++vt) { f32x16 sn = sunpack(Hf[mt][vt]); S_UNROLL for (int nt = 0; nt < 2; ++nt) sn = smm(GTf[nt][mt], SG[nt][vt], sn);
        const SFrag f = spack(sn); S_UNROLL for (int s = 0; s < 2; ++s) *(S_LDS_BF16X8P)(lds + SC_SIG + ((((mt * 2 + vt) * 2 + s) * 64 + lane) * 16)) = f.s[s]; }
    S_LDS_WAIT();
    S_FLAG_STORE(lds + SC_FLAG, (unsigned)(c + 1));
    S_UNROLL for (int vt = 0; vt < 2; ++vt) { f32x16 y = sunpack(Y0[vt]); S_UNROLL for (int kt = 0; kt < 2; ++kt) y = smm(RpT[kt], SG[kt][vt], y);
        S_UNROLL for (int g = 0; g < 16; ++g) { const int p = (g & 3) + 8 * (g >> 2) + 4 * hh; A.ydir[((size_t)b * T + (tau0 + sgn * p)) * 512 + h * 64 + 32 * vt + n] = (bf16)(S_PK(y[g], 0.f) & 0xffffu); } }
}

__device__ __forceinline__ void attn_unit(const Frame& F, ArgsP A, int b, int kvh, int qb) {
    constexpr int KST = 72, VST = 388;
    LAS bf16* KS = (LAS bf16*)F.lds;
    LAS bf16* VT = (LAS bf16*)(F.lds + 384 * KST * 2);
    LAS float* wsf = (LAS float*)(F.lds + 384 * KST * 2 + 64 * VST * 2);
    const bf16* Z = (const bf16*)(A->ws + WS_Z); bf16* OA = (bf16*)(A->ws + WS_OATT);
    const int* positions = (const int*)A->in[2]; const float* qg = (const float*)A->in[19]; const float* kg = (const float*)A->in[20]; const float* sink = (const float*)A->in[21];
    const int tid = F.tid, lane = F.lane, wave = F.wave;
    const float LN_THETA = 13.122363377404328f;
    v4u kwa[6], vwa[6], rca[6], rsa[6];
    v4u qn[4], qnc, qns;
    { const size_t tok0 = (size_t)b * T + qb * 128 + (wave & 1) * 64 + (lane & 31); const int hq0 = kvh * 4 + (wave >> 1);
#pragma unroll
      for (int sI = 0; sI < 4; ++sI) qn[sI] = *(const GAS v4u*)(Z + tok0 * NZ + ZQ + hq0 * 64 + 16 * sI + 8 * (lane >> 5));
      const GAS v4u* qrt0 = (const GAS v4u*)((const bf16*)(A->ws + WS_ROPE) + tok0 * 16); qnc = qrt0[0]; qns = qrt0[1]; }
#pragma unroll
    for (int i = 0; i < 6; ++i) { const int ct = tid + 512 * i, key = ct >> 3, ch = ct & 7; const int kp = qb * 128 - 128 + key; const bool valid = (kp >= 0) && (kp < T);
        const size_t rowoff = ((size_t)b * T + (valid ? kp : 0)) * NZ;
        kwa[i] = *(const GAS v4u*)(Z + rowoff + ZKA + kvh * 64 + ch * 8); vwa[i] = *(const GAS v4u*)(Z + rowoff + ZVA + kvh * 64 + ch * 8);
        const GAS v4u* rt = (const GAS v4u*)((const bf16*)(A->ws + WS_ROPE) + ((size_t)b * T + (valid ? kp : 0)) * 16); rca[i] = rt[0]; rsa[i] = rt[1]; }
#pragma unroll
    for (int i = 0; i < 6; ++i) { const int ct = tid + 512 * i, key = ct >> 3, ch = ct & 7; const int kp = qb * 128 - 128 + key; const bool valid = (kp >= 0) && (kp < T);
        v4u kw = kwa[i], vw = vwa[i];
        if (!valid) { kw = (v4u){0u, 0u, 0u, 0u}; vw = kw; }
        float kf[8] = {bflo(kw.x), bfhi(kw.x), bflo(kw.y), bfhi(kw.y), bflo(kw.z), bfhi(kw.z), bflo(kw.w), bfhi(kw.w)};
        float ss = 0.f;
#pragma unroll
        for (int j = 0; j < 8; ++j) ss += kf[j] * kf[j];
        ss += __shfl_xor(ss, 1); ss += __shfl_xor(ss, 2); ss += __shfl_xor(ss, 4);
        const float rs = rsqrtf(ss * (1.0f / 64.0f) + 1e-6f);
#pragma unroll
        for (int j = 0; j < 8; ++j) kf[j] = kf[j] * rs * kg[ch * 8 + j];
        float oth[8];
#pragma unroll
        for (int j = 0; j < 8; ++j) oth[j] = __shfl_xor(kf[j], 1);
        if (ch < 2) { const v4u cw = rca[i], sw = rsa[i];
            const float cs[8] = {bflo(cw.x), bfhi(cw.x), bflo(cw.y), bfhi(cw.y), bflo(cw.z), bfhi(cw.z), bflo(cw.w), bfhi(cw.w)};
            const float sn[8] = {bflo(sw.x), bfhi(sw.x), bflo(sw.y), bfhi(sw.y), bflo(sw.z), bfhi(sw.z), bflo(sw.w), bfhi(sw.w)};
#pragma unroll
            for (int j = 0; j < 8; ++j) kf[j] = (ch == 0) ? (kf[j] * cs[j] - oth[j] * sn[j]) : (kf[j] * cs[j] + oth[j] * sn[j]); }
        v4u ko; ko.x = pk2(kf[0], kf[1]); ko.y = pk2(kf[2], kf[3]); ko.z = pk2(kf[4], kf[5]); ko.w = pk2(kf[6], kf[7]);
        *(LAS v4u*)(KS + key * KST + ch * 8) = ko;
        const unsigned vv[4] = {vw.x, vw.y, vw.z, vw.w};
#pragma unroll
        for (int j = 0; j < 4; ++j) { VT[(ch * 8 + 2 * j) * VST + key] = (bf16)(vv[j] & 0xffffu); VT[(ch * 8 + 2 * j + 1) * VST + key] = (bf16)(vv[j] >> 16); } }
    __syncthreads();
    const int g = wave >> 1, hq = kvh * 4 + g, r32 = lane & 31, hh = lane >> 5;
    const float snk = sink[hq];
    float kbound; { float gm = fabsf(kg[lane]);
#pragma unroll
        for (int o = 1; o < 64; o <<= 1) gm = fmaxf(gm, __shfl_xor(gm, o));
        kbound = 8.0f * gm; }
#pragma unroll 1
    for (int qt = 0; qt < 2; ++qt) { const int qo = (wave & 1) * 64 + qt * 32, qrel = qo + r32; const size_t tok = (size_t)b * T + qb * 128 + qrel;
        float qf[4][8]; float ss = 0.f; v4u qraw[4];
#pragma unroll
        for (int sI = 0; sI < 4; ++sI) qraw[sI] = qn[sI];
        const v4u qrc = qnc, qrs = qns;
        if (qt == 0) { const size_t tok1 = tok + 32;
#pragma unroll
            for (int sI = 0; sI < 4; ++sI) qn[sI] = *(const GAS v4u*)(Z + tok1 * NZ + ZQ + hq * 64 + 16 * sI + 8 * hh);
            const GAS v4u* qrt1 = (const GAS v4u*)((const bf16*)(A->ws + WS_ROPE) + tok1 * 16); qnc = qrt1[0]; qns = qrt1[1]; }
#pragma unroll
        for (int sI = 0; sI < 4; ++sI) { const v4u qw = qraw[sI];
            qf[sI][0] = bflo(qw.x); qf[sI][1] = bfhi(qw.x); qf[sI][2] = bflo(qw.y); qf[sI][3] = bfhi(qw.y); qf[sI][4] = bflo(qw.z); qf[sI][5] = bfhi(qw.z); qf[sI][6] = bflo(qw.w); qf[sI][7] = bfhi(qw.w);
#pragma unroll
            for (int j = 0; j < 8; ++j) ss += qf[sI][j] * qf[sI][j]; }
        ss += __shfl_xor(ss, 32);
        const float rs = rsqrtf(ss * (1.0f / 64.0f) + 1e-6f) * 0.125f;
#pragma unroll
        for (int sI = 0; sI < 4; ++sI)
#pragma unroll
            for (int j = 0; j < 8; ++j) qf[sI][j] = qf[sI][j] * rs * qg[16 * sI + 8 * hh + j];
        { const v4u cw = qrc, sw = qrs;
          const float cs[8] = {bflo(cw.x), bfhi(cw.x), bflo(cw.y), bfhi(cw.y), bflo(cw.z), bfhi(cw.z), bflo(cw.w), bfhi(cw.w)}, sn[8] = {bflo(sw.x), bfhi(sw.x), bflo(sw.y), bfhi(sw.y), bflo(sw.z), bfhi(sw.z), bflo(sw.w), bfhi(sw.w)};
#pragma unroll
          for (int j = 0; j < 8; ++j) { const float oth = __shfl_xor(qf[0][j], 32); qf[0][j] = (hh == 0) ? (qf[0][j] * cs[j] - oth * sn[j]) : (qf[0][j] * cs[j] + oth * sn[j]); } }
        bf16x8 qr[4];
#pragma unroll
        for (int sI = 0; sI < 4; ++sI) { v4u w; w.x = pk2(qf[sI][0], qf[sI][1]); w.y = pk2(qf[sI][2], qf[sI][3]); w.z = pk2(qf[sI][4], qf[sI][5]); w.w = pk2(qf[sI][6], qf[sI][7]); qr[sI] = __builtin_bit_cast(bf16x8, w); }
        const int kt0 = qo >> 5;
        float qn2 = 0.f;
#pragma unroll
        for (int sI = 0; sI < 4; ++sI)
#pragma unroll
            for (int j = 0; j < 8; ++j) qn2 += qf[sI][j] * qf[sI][j];
        qn2 += __shfl_xor(qn2, 32);
        float mrun = sqrtf(qn2) * kbound * 1.02f;
        if (__any(mrun > 40.f)) { mrun = -1e30f;
#pragma unroll 1
            for (int kt = 0; kt < 9; ++kt) { const int kbase = (kt0 + kt) * 32;
                f32x16 acc = {};
#pragma unroll
                for (int sI = 0; sI < 4; ++sI) { const bf16x8 kfr = *(const LAS bf16x8*)(KS + (kbase + r32) * KST + 16 * sI + 8 * hh); acc = __builtin_amdgcn_mfma_f32_32x32x16_bf16(kfr, qr[sI], acc, 0, 0, 0); }
#pragma unroll
                for (int r = 0; r < 16; ++r) { const int ki = kbase + (r & 3) + 8 * (r >> 2) + 4 * hh; const int dq = ki - 128 - qrel, kp = qb * 128 - 128 + ki;
                    const bool ok = (dq >= -128) && (dq <= 128) && (kp >= 0) && (kp < T); mrun = fmaxf(mrun, ok ? acc[r] : -1e30f); } }
            mrun = fmaxf(mrun, __shfl_xor(mrun, 32)); }
        const float mx = fmaxf(mrun, snk);
        float lrun = 0.f; f32x16 o0 = {}, o1 = {}; const float mxl = mx * 1.442695041f; const bool edge = (qb == 0) || (qb == T / 128 - 1);
#pragma unroll 1
        for (int kt = 0; kt < 9; ++kt) { const int kbase = (kt0 + kt) * 32;
            f32x16 acc = {};
#pragma unroll
            for (int sI = 0; sI < 4; ++sI) { const bf16x8 kfr = *(const LAS bf16x8*)(KS + (kbase + r32) * KST + 16 * sI + 8 * hh); acc = __builtin_amdgcn_mfma_f32_32x32x16_bf16(kfr, qr[sI], acc, 0, 0, 0); }
            float p[16];
            if (edge || kt == 0 || kt == 8) {
#pragma unroll
                for (int r = 0; r < 16; ++r) { const int ki = kbase + (r & 3) + 8 * (r >> 2) + 4 * hh; const int dq = ki - 128 - qrel, kp = qb * 128 - 128 + ki;
                    const bool ok = (dq >= -128) && (dq <= 128) && (kp >= 0) && (kp < T); p[r] = ok ? __builtin_amdgcn_exp2f(acc[r] * 1.442695041f - mxl) : 0.f; lrun += p[r]; }
            } else {
#pragma unroll
                for (int r = 0; r < 16; ++r) { p[r] = __builtin_amdgcn_exp2f(acc[r] * 1.442695041f - mxl); lrun += p[r]; } }
#pragma unroll
            for (int sI = 0; sI < 2; ++sI) { v4u pw; pw.x = pk2(p[8 * sI + 0], p[8 * sI + 1]); pw.y = pk2(p[8 * sI + 2], p[8 * sI + 3]); pw.z = pk2(p[8 * sI + 4], p[8 * sI + 5]); pw.w = pk2(p[8 * sI + 6], p[8 * sI + 7]);
                const bf16x8 pa = __builtin_bit_cast(bf16x8, pw); const int key0 = kbase + 16 * sI + 4 * hh;
                { const u32x2 lo = *(const LAS u32x2*)(VT + r32 * VST + key0), hi = *(const LAS u32x2*)(VT + r32 * VST + key0 + 8); v4u vw; vw.x = lo.x; vw.y = lo.y; vw.z = hi.x; vw.w = hi.y;
                  o0 = __builtin_amdgcn_mfma_f32_32x32x16_bf16(pa, __builtin_bit_cast(bf16x8, vw), o0, 0, 0, 0); }
                { const u32x2 lo = *(const LAS u32x2*)(VT + (32 + r32) * VST + key0), hi = *(const LAS u32x2*)(VT + (32 + r32) * VST + key0 + 8); v4u vw; vw.x = lo.x; vw.y = lo.y; vw.z = hi.x; vw.w = hi.y;
                  o1 = __builtin_amdgcn_mfma_f32_32x32x16_bf16(pa, __builtin_bit_cast(bf16x8, vw), o1, 0, 0, 0); } } }
        lrun += __shfl_xor(lrun, 32);
        const float linv = 1.0f / (lrun + __expf(snk - mx));
        if (hh == 0) wsf[wave * 64 + r32] = linv;
        LDS_WAIT(); asm volatile("" ::: "memory");
#pragma unroll
        for (int r = 0; r < 16; ++r) { const int row = (r & 3) + 8 * (r >> 2) + 4 * hh; const float li = wsf[wave * 64 + row];
            bf16* op = OA + ((size_t)b * T + qb * 128 + qo + row) * 512 + hq * 64;
            op[r32] = (bf16)f2bf(o0[r] * li); op[32 + r32] = (bf16)f2bf(o1[r] * li); }
        LDS_WAIT(); asm volatile("" ::: "memory");
    }
    __syncthreads();
}

__device__ __forceinline__ void pg_rows(const Frame& F, ArgsP A, bf16* wout) {
    const bf16* Z = (const bf16*)(A->ws + WS_Z); const bf16* Y0 = (const bf16*)(A->ws + WS_XN); const bf16* Y1 = Y0 + (size_t)M * 512;
    bf16* Gb = (bf16*)(A->ws + WS_G); const float* bonus = (const float*)(A->ws + WS_BONUS);
    const float* mu_prev = (const float*)A->in[7]; const float* mu_next = (const float*)A->in[8]; const float* gn_w = (const float*)A->in[17]; const float* gn_b = (const float*)A->in[18];
    const int gw = F.vcu * NWAVES + F.wave, NGW = F.G * NWAVES, lane = F.lane, c0 = lane * 8, h = lane >> 3;
    float mp[8], mn[8], gw_[8], gb_[8];
#pragma unroll
    for (int j = 0; j < 8; ++j) { mp[j] = mu_prev[ZV + c0 + j]; mn[j] = mu_next[ZV + c0 + j]; gw_[j] = gn_w[c0 + j]; gb_[j] = gn_b[c0 + j]; }
#pragma unroll 1
    for (int m0 = gw; m0 < M; m0 += 4 * NGW) {
        v4u y0[4], y1[4], gv[4], z0[4], zm[4], zq[4]; float bon[4];
#pragma unroll
        for (int i = 0; i < 4; ++i) { const int m = m0 + i * NGW, t = m & (T - 1);
            y0[i] = *(const GAS v4u*)(Y0 + (size_t)m * 512 + c0); y1[i] = *(const GAS v4u*)(Y1 + (size_t)m * 512 + c0); gv[i] = *(const GAS v4u*)(Gb + (size_t)m * 512 + c0);
            z0[i] = *(const GAS v4u*)(Z + (size_t)m * NZ + ZV + c0);
            zm[i] = (v4u){0u, 0u, 0u, 0u}; zq[i] = (v4u){0u, 0u, 0u, 0u};
            if (t > 0) zm[i] = *(const GAS v4u*)(Z + (size_t)(m - 1) * NZ + ZV + c0);
            if (t < T - 1) zq[i] = *(const GAS v4u*)(Z + (size_t)(m + 1) * NZ + ZV + c0);
            bon[i] = bonus[(size_t)m * 8 + h] + bonus[(size_t)M * 8 + (size_t)m * 8 + h]; }
#pragma unroll
        for (int i = 0; i < 4; ++i) { const int m = m0 + i * NGW;
            const unsigned y0w[4] = {y0[i].x, y0[i].y, y0[i].z, y0[i].w}, y1w[4] = {y1[i].x, y1[i].y, y1[i].z, y1[i].w}, gvw[4] = {gv[i].x, gv[i].y, gv[i].z, gv[i].w};
            const unsigned z0w[4] = {z0[i].x, z0[i].y, z0[i].z, z0[i].w}, zmw[4] = {zm[i].x, zm[i].y, zm[i].z, zm[i].w}, zqw[4] = {zq[i].x, zq[i].y, zq[i].z, zq[i].w};
            float y[8], gg[8], vv[8]; float sacc = 0.f;
#pragma unroll
            for (int j = 0; j < 4; ++j) { y[2 * j] = bflo(y0w[j]) + bflo(y1w[j]); y[2 * j + 1] = bfhi(y0w[j]) + bfhi(y1w[j]); gg[2 * j] = bflo(gvw[j]); gg[2 * j + 1] = bfhi(gvw[j]);
                const float a0 = bflo(z0w[j]), a1 = bfhi(z0w[j]);
                vv[2 * j] = a0 + mp[2 * j] * (bflo(zmw[j]) - a0) + mn[2 * j] * (bflo(zqw[j]) - a0); vv[2 * j + 1] = a1 + mp[2 * j + 1] * (bfhi(zmw[j]) - a1) + mn[2 * j + 1] * (bfhi(zqw[j]) - a1);
                sacc += y[2 * j] + y[2 * j + 1]; }
            sacc += __shfl_xor(sacc, 1); sacc += __shfl_xor(sacc, 2); sacc += __shfl_xor(sacc, 4);
            const float mu = sacc * (1.0f / 64.0f); float q = 0.f;
#pragma unroll
            for (int j = 0; j < 8; ++j) { const float d = y[j] - mu; q += d * d; }
            q += __shfl_xor(q, 1); q += __shfl_xor(q, 2); q += __shfl_xor(q, 4);
            const float rstd = rsqrtf(q * (1.0f / 64.0f) + 64e-5f);
            float o[8];
#pragma unroll
            for (int j = 0; j < 8; ++j) o[j] = ((y[j] - mu) * rstd * gw_[j] + gb_[j] + bon[i] * vv[j]) * gg[j];
            v4u w; w.x = pk2(o[0], o[1]); w.y = pk2(o[2], o[3]); w.z = pk2(o[4], o[5]); w.w = pk2(o[6], o[7]);
            *(GAS v4u*)(wout + (size_t)m * 512 + c0) = w; } }
}

constexpr int CONV_PER = 512, CONV_NIT = 16 * 3 * CONV_PER, CONV_EARLY = 6144;
__device__ __forceinline__ void conv_items(const Frame& F, ArgsP A, int it0, int it1, int widx, int nw) {
    LAS float* scr = (LAS float*)(F.lds + F.wave * 16384); const int lane = F.lane;
    const float* w_gate = (const float*)A->in[27]; const float* w_up = (const float*)A->in[28]; const float* w_down = (const float*)A->in[29];
    bf16* WguT = (bf16*)((unsigned char*)A->out + OUT_WGUT); bf16* WdT = (bf16*)((unsigned char*)A->out + OUT_WDT);
    auto src_of = [&](int it, const float*& W, int& k0, int& n0, bf16*& WT, int& row0) { const int e = it / (3 * CONV_PER), r = it % (3 * CONV_PER), which = r / CONV_PER, q = r % CONV_PER, kb = q >> 5, nb = q & 31; k0 = 64 * kb; n0 = 32 * nb;
        if (which == 0) { W = w_gate + (size_t)e * 1048576; WT = WguT; row0 = e * 2048 + (n0 >> 7) * 256 + (n0 & 127); }
        else if (which == 1) { W = w_up + (size_t)e * 1048576; WT = WguT; row0 = e * 2048 + (n0 >> 7) * 256 + 128 + (n0 & 127); }
        else { W = w_down + (size_t)e * 1048576; WT = WdT; row0 = e * 1024 + n0; } };
    int it = it0 + widx; if (it >= it1) return;
    f32x4 va[8], vb[8]; const float* W; int k0, n0, row0; bf16* WT; src_of(it, W, k0, n0, WT, row0); tr_load(va, W, 1024, k0, n0, lane);
#pragma unroll 1
    for (;;) { const int itn = it + nw; const float* W2; int k2 = 0, n2 = 0, row2 = 0; bf16* WT2 = WT;
        if (itn < it1) { src_of(itn, W2, k2, n2, WT2, row2); tr_load(vb, W2, 1024, k2, n2, lane); }
        tr_store(va, k0, WT, 1024, row0, scr, lane);
        if (itn >= it1) break;
#pragma unroll
        for (int i = 0; i < 8; ++i) va[i] = vb[i];
        it = itn; k0 = k2; WT = WT2; row0 = row2; }
}
__device__ __forceinline__ int conv_idle_first(int G);
__device__ __forceinline__ void conv_one(LAS unsigned char* lds, int wave, int lane, ArgsP A, int it) {
    LAS float* scr = (LAS float*)(lds + wave * 16384);
    const float* w_gate = (const float*)A->in[27]; const float* w_up = (const float*)A->in[28]; const float* w_down = (const float*)A->in[29];
    bf16* WguT = (bf16*)((unsigned char*)A->out + OUT_WGUT); bf16* WdT = (bf16*)((unsigned char*)A->out + OUT_WDT);
    const int e = it / (3 * CONV_PER), r = it % (3 * CONV_PER), which = r / CONV_PER, q = r % CONV_PER, kb = q >> 5, nb = q & 31, n0 = 32 * nb;
    if (which == 0) tr_item(w_gate + (size_t)e * 1048576, 1024, 64 * kb, n0, WguT, 1024, e * 2048 + (n0 >> 7) * 256 + (n0 & 127), scr, lane);
    else if (which == 1) tr_item(w_up + (size_t)e * 1048576, 1024, 64 * kb, n0, WguT, 1024, e * 2048 + (n0 >> 7) * 256 + 128 + (n0 & 127), scr, lane);
    else tr_item(w_down + (size_t)e * 1048576, 1024, 64 * kb, n0, WdT, 1024, e * 1024 + n0, scr, lane);
}
#ifndef SHADOW_WAVES
#define SHADOW_WAVES 3
#endif
constexpr int CONV_SLOTS = 9, CONV_SW = SHADOW_WAVES;
__device__ __forceinline__ int conv_base(int G) { return conv_idle_first(G) < G ? CONV_EARLY : 0; }
__device__ __forceinline__ void xcd_barrier_shadow(const XcdBarrier& b, bool is_thread0, int wave, LAS unsigned char* lds, ArgsP A, int slot) {
    asm volatile("s_waitcnt vmcnt(0)" ::: "memory");
    __syncthreads();
    if (wave == 0) { if (is_thread0) xcd_barrier_t0(b); }
    else if (wave <= CONV_SW) { const int G = (int)gridDim.x; const int it = conv_base(G) + (slot * G + (int)blockIdx.x) * CONV_SW + (wave - 1);
        if (it < CONV_NIT) { unsigned o_ = ~0u; asm volatile("" : "+s"(o_)); const int lane = (int)__builtin_amdgcn_mbcnt_hi(o_, __builtin_amdgcn_mbcnt_lo(o_, 0u)); conv_one(lds, wave, lane, A, it); } }
    __syncthreads();
}
__device__ __forceinline__ int conv_idle_first(int G) { const int nwg = (M / 256) * (NZP / 256), mx = (nwg + G - 1) / G; return nwg - (mx - 1) * G; }
__device__ __forceinline__ void pj_phase(const Frame& F, ArgsP A) {
    unsigned char* ws = A->ws;
    const int gw = F.vcu * NWAVES + F.wave, NGW = F.G * NWAVES, lane = F.lane;
    { const int first = conv_base(F.G) + CONV_SLOTS * F.G * CONV_SW; if (first < CONV_NIT) conv_items(F, A, first, CONV_NIT, gw, NGW); }
    __syncthreads();
    const float* w_router = (const float*)A->in[26]; const bf16* x1 = (const bf16*)(ws + WS_X1); const float* g2n = (const float*)A->in[25]; const float* mod = (const float*)(ws + WS_MOD);
    bf16* XN2 = (bf16*)(ws + WS_XN); float* aff = (float*)(ws + WS_AFF);
    LAS bf16* WF = (LAS bf16*)F.lds;
    LAS float* AT = (LAS float*)(F.lds + 65536); LAS float* BT = AT + 1024; LAS float* CB = BT + 1024;
    const int tile = gw, b = tile >> 7;
    for (int d = F.tid; d < 1024; d += 512) { AT[d] = g2n[d] * (1.0f + mod[(size_t)b * 6144 + 4096 + d]); BT[d] = mod[(size_t)b * 6144 + 3072 + d]; }
    __syncthreads();
#pragma unroll 4
    for (int k = 0; k < 32; ++k) { const int it = F.tid + 512 * k, jj = it & 7, ln = (it >> 3) & 63, sI = it >> 9, q = ln >> 4, e = ln & 15, d = 32 * sI + 8 * q + jj;
        const float v = AT[d] * w_router[d * 16 + e]; const unsigned hi = pk2(v, 0.f) & 0xffffu; const float lo = v - __uint_as_float(hi << 16);
        WF[it] = (bf16)hi; WF[16384 + it] = (bf16)(pk2(lo, 0.f) & 0xffffu); }
    { float c0 = 0.f, c1 = 0.f;
#pragma unroll 4
      for (int k = 0; k < 16; ++k) { const int d = lane + 64 * k; c0 += BT[d] * w_router[d * 16 + 2 * F.wave]; c1 += BT[d] * w_router[d * 16 + 2 * F.wave + 1]; }
      c0 = dpp_wave_sum(c0); c1 = dpp_wave_sum(c1); if (lane == 0) { CB[2 * F.wave] = c0; CB[2 * F.wave + 1] = c1; } }
    __syncthreads();
    if (tile < M / 16) { const int r = lane & 15, q = lane >> 4; const size_t m = (size_t)tile * 16 + r;
        float ss = 0.f;
#pragma unroll 1
        for (int hf = 0; hf < 2; ++hf) { v4u raw[16];
#pragma unroll
            for (int sI = 0; sI < 16; ++sI) raw[sI] = *(const GAS v4u*)(x1 + m * 1024 + 32 * (16 * hf + sI) + 8 * q);
#pragma unroll
            for (int sI = 0; sI < 16; ++sI) { const v4u w = raw[sI]; const float a0 = bflo(w.x), a1 = bfhi(w.x), a2 = bflo(w.y), a3 = bfhi(w.y), a4 = bflo(w.z), a5 = bfhi(w.z), a6 = bflo(w.w), a7 = bfhi(w.w);
                ss += (a0 * a0 + a1 * a1) + (a2 * a2 + a3 * a3) + (a4 * a4 + a5 * a5) + (a6 * a6 + a7 * a7); } }
        ss += __shfl_xor(ss, 16); ss += __shfl_xor(ss, 32);
        const float rs = rsqrtf(ss * (1.0f / 1024.0f) + 1e-6f);
        f32x4 ah = {0.f, 0.f, 0.f, 0.f}, al = {0.f, 0.f, 0.f, 0.f};
#pragma unroll 1
        for (int hf = 0; hf < 2; ++hf) { v4u raw[16];
#pragma unroll
            for (int sI = 0; sI < 16; ++sI) raw[sI] = *(const GAS v4u*)(x1 + m * 1024 + 32 * (16 * hf + sI) + 8 * q);
#pragma unroll
            for (int sI = 0; sI < 16; ++sI) { const int sg = 16 * hf + sI; const bf16x8 xa = __builtin_bit_cast(bf16x8, raw[sI]);
                const bf16x8 bh = *(const LAS bf16x8*)(WF + (sg * 64 + lane) * 8), bl = *(const LAS bf16x8*)(WF + 16384 + (sg * 64 + lane) * 8);
                ah = __builtin_amdgcn_mfma_f32_16x16x32_bf16(xa, bh, ah, 0, 0, 0); al = __builtin_amdgcn_mfma_f32_16x16x32_bf16(xa, bl, al, 0, 0, 0); }
#pragma unroll
            for (int sI = 0; sI < 16; ++sI) { if ((sI & 3) == 0) asm volatile("" ::: "memory");
                const int d0 = 32 * (16 * hf + sI) + 8 * q; const v4u w = raw[sI];
                const f32x4 a0 = *(const LAS f32x4*)(AT + d0), a1 = *(const LAS f32x4*)(AT + d0 + 4), b0 = *(const LAS f32x4*)(BT + d0), b1 = *(const LAS f32x4*)(BT + d0 + 4);
                v4u o; o.x = pk2(bflo(w.x) * rs * a0.x + b0.x, bfhi(w.x) * rs * a0.y + b0.y); o.y = pk2(bflo(w.y) * rs * a0.z + b0.z, bfhi(w.y) * rs * a0.w + b0.w);
                o.z = pk2(bflo(w.z) * rs * a1.x + b1.x, bfhi(w.z) * rs * a1.y + b1.y); o.w = pk2(bflo(w.w) * rs * a1.z + b1.z, bfhi(w.w) * rs * a1.w + b1.w);
                *(GAS v4u*)(XN2 + m * 1024 + d0) = o; } }
        const float cb = CB[lane & 15]; float lg[4], mx[4], ex[4], den[4];
#pragma unroll
        for (int i = 0; i < 4; ++i) { const float rsr = __shfl(rs, 4 * q + i); lg[i] = rsr * (ah[i] + al[i]) + cb; mx[i] = lg[i]; }
#pragma unroll
        for (int o = 1; o < 16; o <<= 1)
#pragma unroll
            for (int i = 0; i < 4; ++i) mx[i] = fmaxf(mx[i], __shfl_xor(mx[i], o));
#pragma unroll
        for (int i = 0; i < 4; ++i) { ex[i] = expf(lg[i] - mx[i]); den[i] = ex[i]; }
#pragma unroll
        for (int o = 1; o < 16; o <<= 1)
#pragma unroll
            for (int i = 0; i < 4; ++i) den[i] += __shfl_xor(den[i], o);
        { const int t0 = (tile & 127) * 16 + 4 * q; f32x4 av; av.x = ex[0] / den[0]; av.y = ex[1] / den[1]; av.z = ex[2] / den[2]; av.w = ex[3] / den[3];
          *(GAS f32x4*)(aff + ((size_t)b * 16 + (lane & 15)) * T + t0) = av; } }
}

__device__ __forceinline__ void pk_task(const Frame& F, ArgsP A, int b, int e) {
    unsigned char* ws = A->ws;
    const float* aff = (const float*)(ws + WS_AFF) + ((size_t)b * 16 + e) * T;
    int* slotmap = (int*)(ws + WS_SLOT); float* selaff = (float*)(ws + WS_SELAFF); int* selidx = (int*)(ws + WS_SELIDX);
    const bf16* XN2 = (const bf16*)(ws + WS_XN); bf16* XE = (bf16*)(ws + WS_XE);
    LAS unsigned* cnt = (LAS unsigned*)F.lds;
    LAS int* tokl = (LAS int*)(F.lds + 256);
    const int tid = F.tid, lane = F.lane, wave = F.wave;
    const f32x4 v4 = *(const GAS f32x4*)(aff + 4 * tid);
    const unsigned key[4] = {__float_as_uint(v4.x), __float_as_uint(v4.y), __float_as_uint(v4.z), __float_as_uint(v4.w)};
    unsigned thr = 0u;
#pragma unroll 1
    for (int bit = 31; bit >= 0; --bit) { const unsigned cand = thr | (1u << bit);
        const unsigned c = (unsigned)(__popcll(__ballot(key[0] >= cand)) + __popcll(__ballot(key[1] >= cand)) + __popcll(__ballot(key[2] >= cand)) + __popcll(__ballot(key[3] >= cand)));
        LAS unsigned* slot_ = cnt + 16 + (bit & 1) * 8;
        if (lane == 0) slot_[wave] = c;
        __syncthreads();
        unsigned tot = 0;
#pragma unroll
        for (int w = 0; w < 8; ++w) tot += slot_[w];
        if (tot >= 256u) thr = cand; }
    __syncthreads();
    int ngt = 0, neq = 0;
#pragma unroll
    for (int j = 0; j < 4; ++j) { ngt += key[j] > thr; neq += key[j] == thr; }
    int sg = ngt, se = neq;
#pragma unroll
    for (int o = 1; o < 64; o <<= 1) { const int a = __shfl_up(sg, o), c = __shfl_up(se, o); if (lane >= o) { sg += a; se += c; } }
    if (lane == 63) { cnt[wave] = (unsigned)sg; cnt[8 + wave] = (unsigned)se; }
    __syncthreads();
    int bg = 0, be = 0, totg = 0;
#pragma unroll
    for (int w = 0; w < 8; ++w) { const int a = (int)cnt[w], c = (int)cnt[8 + w]; if (w < wave) { bg += a; be += c; } totg += a; }
    int pg = bg + sg - ngt, pe = be + se - neq;
    const int need_eq = 256 - totg;
    int* smrow = slotmap + ((size_t)b * T + 4 * tid) * 16 + e;
#pragma unroll
    for (int j = 0; j < 4; ++j) { int slot = -1;
        if (key[j] > thr) { slot = pg; ++pg; } else if (key[j] == thr) { if (pe < need_eq) slot = totg + pe; ++pe; }
        smrow[j * 16] = slot;
        if (slot >= 0) { selidx[((size_t)e * 16 + b) * 256 + slot] = b * T + 4 * tid + j; selaff[((size_t)e * 16 + b) * 256 + slot] = __uint_as_float(key[j]); } }
    __syncthreads();
}

__device__ __forceinline__ void pn_rows(const Frame& F, ArgsP A, float* wout) {
    unsigned char* ws = A->ws;
    const int* slotmap = (const int*)(ws + WS_SLOT); const bf16* YE = (const bf16*)(ws + WS_XE); const float* mod = (const float*)(ws + WS_MOD); const bf16* X1 = (const bf16*)(ws + WS_X1);
    const int gw = F.vcu * NWAVES + F.wave, NGW = F.G * NWAVES, lane = F.lane;
#pragma unroll 1
    for (int m0 = gw * 16; m0 < gw * 16 + 16; m0 += 2) {
        int myslot[2]; f32x4 xv[2][4];
#pragma unroll
        for (int i = 0; i < 2; ++i) { const int m = m0 + i; myslot[i] = slotmap[(size_t)m * 16 + (lane & 15)];
#pragma unroll
            for (int hq = 0; hq < 2; ++hq) { const v4u w = *(const GAS v4u*)(X1 + (size_t)m * 1024 + hq * 512 + lane * 8);
                xv[i][2 * hq] = (f32x4){bflo(w.x), bfhi(w.x), bflo(w.y), bfhi(w.y)}; xv[i][2 * hq + 1] = (f32x4){bflo(w.z), bfhi(w.z), bflo(w.w), bfhi(w.w)}; } }
        unsigned long long msk[2]; v4u yw[2][4][2];
#pragma unroll
        for (int i = 0; i < 2; ++i) { const int b = (m0 + i) >> 11; msk[i] = __ballot(myslot[i] >= 0) & 0xffffull;
#pragma unroll
            for (int k = 0; k < 4; ++k) { const bool has = msk[i] != 0ull; const int e = has ? __builtin_ctzll(msk[i]) : 0; if (has) msk[i] &= msk[i] - 1; const int sl = __shfl(myslot[i], e);
                yw[i][k][0] = (v4u){0u, 0u, 0u, 0u}; yw[i][k][1] = (v4u){0u, 0u, 0u, 0u};
                if (has) { const GAS v4u* yr = (const GAS v4u*)(YE + (((size_t)e * 16 + b) * 256 + sl) * 1024); yw[i][k][0] = yr[lane]; yw[i][k][1] = yr[64 + lane]; } } }
#pragma unroll
        for (int i = 0; i < 2; ++i) { const int m = m0 + i, b = m >> 11;
            float acc[16];
#pragma unroll
            for (int j = 0; j < 16; ++j) acc[j] = 0.f;
#pragma unroll
            for (int k = 0; k < 4; ++k)
#pragma unroll
                for (int hlf = 0; hlf < 2; ++hlf) { const v4u w = yw[i][k][hlf];
                    acc[hlf * 8 + 0] += bflo(w.x); acc[hlf * 8 + 1] += bfhi(w.x); acc[hlf * 8 + 2] += bflo(w.y); acc[hlf * 8 + 3] += bfhi(w.y);
                    acc[hlf * 8 + 4] += bflo(w.z); acc[hlf * 8 + 5] += bfhi(w.z); acc[hlf * 8 + 6] += bflo(w.w); acc[hlf * 8 + 7] += bfhi(w.w); }
            unsigned long long mk = msk[i];
            while (mk) { const int e = __builtin_ctzll(mk); mk &= mk - 1; const int sl = __shfl(myslot[i], e);
                const GAS v4u* yr = (const GAS v4u*)(YE + (((size_t)e * 16 + b) * 256 + sl) * 1024);
#pragma unroll
                for (int hlf = 0; hlf < 2; ++hlf) { const v4u w = yr[hlf * 64 + lane];
                    acc[hlf * 8 + 0] += bflo(w.x); acc[hlf * 8 + 1] += bfhi(w.x); acc[hlf * 8 + 2] += bflo(w.y); acc[hlf * 8 + 3] += bfhi(w.y);
                    acc[hlf * 8 + 4] += bflo(w.z); acc[hlf * 8 + 5] += bfhi(w.z); acc[hlf * 8 + 6] += bflo(w.w); acc[hlf * 8 + 7] += bfhi(w.w); } }
            const float* gt2 = mod + (size_t)b * 6144 + 5120; float* orow = wout + (size_t)m * 1024;
#pragma unroll
            for (int q = 0; q < 4; ++q) { const int c = (q >> 1) * 512 + lane * 8 + (q & 1) * 4; const f32x4 g = *(const GAS f32x4*)(gt2 + c);
                f32x4 a; a.x = acc[(q >> 1) * 8 + (q & 1) * 4 + 0]; a.y = acc[(q >> 1) * 8 + (q & 1) * 4 + 1]; a.z = acc[(q >> 1) * 8 + (q & 1) * 4 + 2]; a.w = acc[(q >> 1) * 8 + (q & 1) * 4 + 3];
                *(GAS f32x4*)(orow + c) = xv[i][q] + g * a; } } }
}

__device__ __forceinline__ void mk_frame(Frame& F, LAS unsigned char* lds, int wave_s) {
    int bx = blockIdx.x, G = gridDim.x; LAUNDER(bx); LAUNDER(G);
    F.lds = lds; F.MISC = (volatile LAS unsigned*)(lds + MISC_OFF); F.ctl = nullptr;
    unsigned ones_ = ~0u; asm volatile("" : "+s"(ones_));
    int lane_ = (int)__builtin_amdgcn_mbcnt_hi(ones_, __builtin_amdgcn_mbcnt_lo(ones_, 0u)); asm volatile("" : "+v"(lane_));
    F.lane = lane_; F.wave = wave_s; F.tid = wave_s * 64 + lane_;
    F.G = G; F.vcu = (G % 8 == 0) ? (bx % 8) * (G / 8) + bx / 8 : bx;
}
__global__ void __launch_bounds__(NWAVES * 64, 2) fwd_kernel(Args args) {
    extern __shared__ __attribute__((aligned(16))) unsigned char lds[];
    LAS unsigned char* const ldsb = (LAS unsigned char*)lds;
    ArgsP ap0 = (ArgsP)__builtin_amdgcn_kernarg_segment_ptr();
    int wave_s = __builtin_amdgcn_readfirstlane((int)threadIdx.x >> 6); asm volatile("" : "+s"(wave_s));
    for (int u = threadIdx.x; u < (LDS_BYTES - LDSCTL_OFF) / 4; u += NWAVES * 64) ((LAS unsigned*)(ldsb + LDSCTL_OFF))[u] = 0u;
    __syncthreads();
#define MKBAR XcdBarrier bar; { ArgsP a_ = ap0; LAUNDER(a_); bar.bar = (unsigned*)(a_->ws + WS_CTL) + CW_BAR; bar.x = xb_xcc_id(); bar.st = (volatile LAS unsigned*)(ldsb + MISC_OFF) + 8; }
#if ONE_LAUNCH
    { MKBAR; if (threadIdx.x == 0) (void)xb_add(&bar.bar[XB_XCNT(bar.x)], 1u); }
#ifndef PHM
#define PHM 0x3fff
#endif
#define IN(k) ((PHM >> (k)) & 1)
#define GRIDBAR() do { MKBAR; { unsigned o_ = ~0u; asm volatile("" : "+s"(o_)); xcd_barrier(bar, wave_s == 0 && __builtin_amdgcn_mbcnt_hi(o_, __builtin_amdgcn_mbcnt_lo(o_, 0u)) == 0u); } } while (0)
#define GRIDBARC(slot) do { MKBAR; { unsigned o_ = ~0u; asm volatile("" : "+s"(o_)); ArgsP a2_ = ap0; LAUNDER(a2_); xcd_barrier_shadow(bar, wave_s == 0 && __builtin_amdgcn_mbcnt_hi(o_, __builtin_amdgcn_mbcnt_lo(o_, 0u)) == 0u, wave_s, ldsb, a2_, slot); } } while (0)
#define SEAMC(k, slot) do { if (IN(k) && IN((k) + 1)) { MKBAR; { unsigned o_ = ~0u; asm volatile("" : "+s"(o_)); ArgsP a2_ = ap0; LAUNDER(a2_); xcd_barrier_shadow(bar, wave_s == 0 && __builtin_amdgcn_mbcnt_hi(o_, __builtin_amdgcn_mbcnt_lo(o_, 0u)) == 0u, wave_s, ldsb, a2_, slot); } } } while (0)
#define SEAM(k) do { if (IN(k) && IN((k) + 1)) { MKBAR; { unsigned o_ = ~0u; asm volatile("" : "+s"(o_)); xcd_barrier(bar, wave_s == 0 && __builtin_amdgcn_mbcnt_hi(o_, __builtin_amdgcn_mbcnt_lo(o_, 0u)) == 0u); } } } while (0)
#else
    int lo, hi; { ArgsP a = ap0; LAUNDER(a); lo = a->ph_lo; hi = a->ph_hi; }
#define IN(k) (lo <= (k) && (k) < hi)
#define SEAM(k) do { } while (0)
#define SEAMC(k, slot) do { } while (0)
#define GRIDBARC(slot) do { } while (0)
#define GRIDBAR() do { } while (0)
#endif
    typedef pg8::bf16_t pb;
#ifndef REPMASK
#define REPMASK 0
#endif
#define PHASE_ARGS ArgsP ap = ap0; LAUNDER(ap); unsigned char* ws = ap->ws; (void)ws; Frame F; mk_frame(F, ldsb, wave_s); const int gw = F.vcu * NWAVES + F.wave, NGW = F.G * NWAVES; (void)gw; (void)NGW
    if (IN(0)) _Pragma("unroll 1") for (int rep_ = 0; rep_ <= ((REPMASK >> 0) & 1); ++rep_) { PHASE_ARGS; p0_prologue(F, ap); } SEAMC(0, 0);
    if (IN(1)) _Pragma("unroll 1") for (int rep_ = 0; rep_ <= ((REPMASK >> 1) & 1); ++rep_) { PHASE_ARGS; const float* x = (const float*)ap->in[0]; const float* g1 = (const float*)ap->in[5]; const float* mod = (const float*)(ws + WS_MOD); bf16* XN = (bf16*)(ws + WS_XN);
#pragma unroll 1
        for (int wv = gw; wv < M / 16; wv += NGW) {
#pragma unroll 1
          for (int k4 = 0; k4 < 4; ++k4) { const int m = wv * 16 + 4 * k4; f32x4 u[4][4]; modnorm_rows<4, false>(x, m, 1, g1, mod, 0, 1024, XN, F.lane, u);
            if (F.lane < 32) { const int mm = m + (F.lane >> 3), j = F.lane & 7; const float pos = (float)((const int*)ap->in[2])[mm];
                const float ang = pos * __expf(-(float)j * 0.125f * 13.122363377404328f); const float sn = __sinf(ang), cs = __cosf(ang);
                bf16* rt = (bf16*)(ws + WS_ROPE) + (size_t)mm * 16; rt[j] = (bf16)(pk2(cs, 0.f) & 0xffffu); rt[8 + j] = (bf16)(pk2(sn, 0.f) & 0xffffu); } } } } SEAMC(1, 1);
    if (IN(2)) _Pragma("unroll 1") for (int rep_ = 0; rep_ <= ((REPMASK >> 2) & 1); ++rep_) { PHASE_ARGS; pg8::Gemm g{(const pb*)(ws + WS_XN), (const pb*)(ws + WS_WINT), M, NZP, D}; pg8::StaticOrder S; S.init(M, NZP, F.G, (int)blockIdx.x);
        pg8::EpiZ E{(pb*)(ws + WS_Z)}; pg8::gemm_phase<pg8::EpiZ, pg8::StaticOrder, true, true>(F.lds, g, S, E, F.tid); }
    if (IN(2)) { PHASE_ARGS; const int c0 = conv_idle_first(F.G);
        if ((int)blockIdx.x >= c0 && c0 < F.G) { __syncthreads(); conv_items(F, ap, 0, CONV_EARLY, ((int)blockIdx.x - c0) * NWAVES + F.wave, (F.G - c0) * NWAVES); } }
    SEAMC(2, 2);
    if (IN(3)) {
#ifndef REP_SCAN
#define REP_SCAN 1
#endif
#ifndef REP_ATTN
#define REP_ATTN 1
#endif
      { PHASE_ARGS; const ScanArgs SP{(const GAS bf16*)(ws + WS_Z), (const GAS float*)ap->in[7], (const GAS float*)ap->in[8], nullptr, nullptr, nullptr, nullptr, nullptr, nullptr, nullptr, (GAS unsigned char*)(ws + WS_SGD)};
#pragma unroll 1
        for (int task = F.vcu * NWAVES + F.wave; task < 2048; task += F.G * NWAVES) scan2_prep(SP, task >> 7, (task >> 6) & 1, task & 63, F.lane); }
      GRIDBARC(3);
      { int c0_, G_; { Frame F0; mk_frame(F0, ldsb, wave_s); c0_ = F0.vcu; G_ = F0.G; }
#pragma unroll 1
        for (int c = c0_; c < 256 * REP_SCAN; c += G_) { PHASE_ARGS; const int b = (c >> 4) & 15, h = (c >> 1) & 7, dir = c & 1;
            scan2_setup(F.lds, (const GAS float*)ap->in[10], (const GAS float*)ap->in[12], h, dir, F.tid); __syncthreads();
            const ScanArgs SA{(const GAS bf16*)(ws + WS_Z), (const GAS float*)ap->in[7], (const GAS float*)ap->in[8], (const GAS float*)ap->in[9], (const GAS float*)ap->in[11], (const GAS float*)ap->in[14], (const GAS float*)ap->in[15], (const GAS float*)ap->in[16],
                              (GAS bf16*)(ws + WS_XN) + (size_t)dir * M * 512, (GAS float*)(ws + WS_BONUS) + (size_t)dir * M * 8, (GAS unsigned char*)(ws + WS_SGD)};
#pragma unroll 1
            for (int cc = F.wave; cc < T / 32; cc += 8) scan2_chunk(F.lds, SA, b, h, dir, cc, F.lane, F.wave);
            __syncthreads(); } }
      { PHASE_ARGS;
#pragma unroll 1
        for (int u = F.vcu; u < 512 * REP_ATTN; u += F.G) { attn_unit(F, ap, (u >> 5) & 15, (u >> 4) & 1, u & 15); } }
      { PHASE_ARGS;
        const bf16* Z = (const bf16*)(ws + WS_Z); bf16* SGD = (bf16*)(ws + WS_SGD); const float* mu_prev = (const float*)ap->in[7]; const float* mu_next = (const float*)ap->in[8];
          const int c = ZGD + 2 * F.lane; const float mp0 = mu_prev[c], mp1 = mu_prev[c + 1], mn0 = mu_next[c], mn1 = mu_next[c + 1];
#ifndef REP_SGD
#define REP_SGD 1
#endif
          const int tile = F.vcu;
          if (tile < 256) { const int pm = tile >> 1, pn = tile & 1; constexpr int RS = 136;
              LAS bf16* SG = (LAS bf16*)F.lds; LAS bf16* GT = (LAS bf16*)(F.lds + 256 * RS * 2);
              __syncthreads();
              const int mt0 = pm * 256 + F.wave * 32;
#pragma unroll 1
              for (int m0 = 0; m0 < 32; m0 += 4) { unsigned z0[4], zm[4], zq[4];
#pragma unroll
                  for (int i = 0; i < 4; ++i) { const int m = mt0 + m0 + i, t = m & (T - 1);
                      z0[i] = *(const GAS unsigned*)(Z + (size_t)m * NZ + c); zm[i] = t > 0 ? *(const GAS unsigned*)(Z + (size_t)(m - 1) * NZ + c) : 0u; zq[i] = t < T - 1 ? *(const GAS unsigned*)(Z + (size_t)(m + 1) * NZ + c) : 0u; }
#pragma unroll
                  for (int i = 0; i < 4; ++i) { const float a0 = bflo(z0[i]), a1 = bfhi(z0[i]); const float s0 = a0 + mp0 * (bflo(zm[i]) - a0) + mn0 * (bflo(zq[i]) - a0), s1 = a1 + mp1 * (bfhi(zm[i]) - a1) + mn1 * (bfhi(zq[i]) - a1);
                      *(LAS unsigned*)(SG + (F.wave * 32 + m0 + i) * RS + 2 * F.lane) = pk2(sigm(s0), sigm(s1)); } }
              __syncthreads();
              const int r32 = F.lane & 31, hh = F.lane >> 5; bf16x8 af[8];
#pragma unroll
              for (int sI = 0; sI < 8; ++sI) af[sI] = *(const LAS bf16x8*)(SG + (F.wave * 32 + r32) * RS + 16 * sI + 8 * hh);
              bf16* Gout = (bf16*)(ws + WS_G); const bf16* G2T = (const bf16*)(ws + WS_G2T);
#pragma unroll 1
              for (int hf = 0; hf < 2; ++hf) {
#pragma unroll
                  for (int i = 0; i < 4; ++i) { const int e = F.tid + 512 * i, rr = e >> 4, ch = e & 15; *(LAS v4u*)(GT + rr * RS + ch * 8) = *(const GAS v4u*)(G2T + (size_t)(256 * pn + 128 * hf + rr) * 256 + ch * 8); }
                  __syncthreads();
#pragma unroll 1
                  for (int ct = 0; ct < 4; ++ct) { f32x16 acc = {};
#pragma unroll
                      for (int sI = 0; sI < 8; ++sI) { const bf16x8 bfr = *(const LAS bf16x8*)(GT + (32 * ct + r32) * RS + 16 * sI + 8 * hh); acc = __builtin_amdgcn_mfma_f32_32x32x16_bf16(af[sI], bfr, acc, 0, 0, 0); }
#pragma unroll
                      for (int g = 0; g < 16; ++g) { const int row = (g & 3) + 8 * (g >> 2) + 4 * hh;
                          Gout[(size_t)(mt0 + row) * 512 + 256 * pn + 128 * hf + 32 * ct + r32] = (bf16)(pk2(acc[g], 0.f) & 0xffffu); } }
                  __syncthreads(); } } }
    } SEAMC(4, 4);
#ifndef REP_PG
#define REP_PG 0
#endif
    if (IN(5)) { PHASE_ARGS; if (REP_PG) pg_rows(F, ap, (bf16*)ap->out); pg_rows(F, ap, (bf16*)(ws + WS_G)); } SEAMC(5, 5);
    if (IN(6)) { PHASE_ARGS; static_assert(WS_G == WS_OATT + (size_t)M * 512 * 2 && WS_PAT == WS_PRT + (size_t)1024 * 512 * 2, "merged operand views need adjacent buffers");
        pg8::Gemm g{(const pb*)(ws + WS_OATT), (const pb*)(ws + WS_PRT), 2 * M, 2048, 512}; pg8::MergeOrder S; S.init(F.G, (int)blockIdx.x);
        pg8::EpiGate2 E{(pb*)(ws + WS_XN), (const pb*)(ws + WS_Z)}; pg8::gemm_phase<pg8::EpiGate2, pg8::MergeOrder, true, true>(F.lds, g, S, E, F.tid); } SEAMC(7, 6);
    if (IN(8)) _Pragma("unroll 1") for (int rep_ = 0; rep_ <= ((REPMASK >> 8) & 1); ++rep_) { PHASE_ARGS; pg8::Gemm g{(const pb*)(ws + WS_XN), (const pb*)(ws + WS_WOT), M, 1024, 1024}; pg8::StaticOrder S; S.init(M, 1024, F.G, (int)blockIdx.x);
        pg8::EpiRes E{(const float*)ap->in[0], (const float*)(ws + WS_MOD), (pb*)(ws + WS_X1)}; pg8::gemm_phase<pg8::EpiRes, pg8::StaticOrder, true, true>(F.lds, g, S, E, F.tid); } SEAMC(8, 7);
    if (IN(9)) _Pragma("unroll 1") for (int rep_ = 0; rep_ <= ((REPMASK >> 9) & 1); ++rep_) { PHASE_ARGS; pj_phase(F, ap); } SEAMC(9, 8);
    if (IN(10)) _Pragma("unroll 1") for (int rep_ = 0; rep_ <= ((REPMASK >> 10) & 1); ++rep_) { PHASE_ARGS; for (int p = F.vcu; p < 256; p += F.G) pk_task(F, ap, p >> 4, p & 15); } SEAM(10);
    if (IN(11)) _Pragma("unroll 1") for (int rep_ = 0; rep_ <= ((REPMASK >> 11) & 1); ++rep_) { PHASE_ARGS; pg8::Gemm g{(const pb*)(ws + WS_XN), (const pb*)((unsigned char*)ap->out + OUT_WGUT), ME, 16 * 2048, 1024}; pg8::GroupOrder<8> S{F.G, (int)blockIdx.x};
        pg8::EpiSwiglu E{(pb*)(ws + WS_H)}; pg8::gemm_phase<pg8::EpiSwiglu, pg8::GroupOrder<8>, true, true, true>(F.lds, g, S, E, F.tid, (const int*)(ws + WS_SELIDX)); } SEAM(11);
    if (IN(12)) _Pragma("unroll 1") for (int rep_ = 0; rep_ <= ((REPMASK >> 12) & 1); ++rep_) { PHASE_ARGS; pg8::Gemm g{(const pb*)(ws + WS_H), (const pb*)((unsigned char*)ap->out + OUT_WDT), ME, 16 * 1024, 1024}; pg8::GroupOrder<4> S{F.G, (int)blockIdx.x};
        pg8::EpiDown E{(pb*)(ws + WS_XE), (const float*)(ws + WS_SELAFF)}; pg8::gemm_phase<pg8::EpiDown, pg8::GroupOrder<4>, true, true>(F.lds, g, S, E, F.tid); } SEAM(12);
#ifndef EXTRA_BARS
#define EXTRA_BARS 0
#endif
#if ONE_LAUNCH
    _Pragma("unroll 1") for (int xb_ = 0; xb_ < EXTRA_BARS; ++xb_) { MKBAR; { unsigned o_ = ~0u; asm volatile("" : "+s"(o_)); xcd_barrier(bar, wave_s == 0 && __builtin_amdgcn_mbcnt_hi(o_, __builtin_amdgcn_mbcnt_lo(o_, 0u)) == 0u); } }
#endif
#ifndef REP_PN
#define REP_PN 0
#endif
    if (IN(13)) { PHASE_ARGS; if (REP_PN) pn_rows(F, ap, (float*)(ws + WS_H)); pn_rows(F, ap, ap->out); }
#undef IN
#undef SEAM
}

extern "C" void kernel_launch(void* const* d_in, const int* in_sizes, int n_in, void* d_out, int out_size, void* d_ws, size_t ws_size, hipStream_t stream) {
    static int grid = 0;
    if (grid == 0) {
        if (n_in != 30 || out_size != M * D || ws_size < WS_END) { fprintf(stderr, "kernel_launch: unexpected shapes n_in %d out %d ws %zu\n", n_in, out_size, ws_size); grid = -1; return; }
        int dev = 0, cus = 0, per_cu = 0;
        if (hipGetDevice(&dev) != hipSuccess || hipDeviceGetAttribute(&cus, hipDeviceAttributeMultiprocessorCount, dev) != hipSuccess) { grid = -1; return; }
        if (hipFuncSetAttribute((const void*)fwd_kernel, hipFuncAttributeMaxDynamicSharedMemorySize, LDS_BYTES) != hipSuccess) { fprintf(stderr, "kernel_launch: hipFuncSetAttribute failed\n"); grid = -1; return; }
        if (hipOccupancyMaxActiveBlocksPerMultiprocessor(&per_cu, (const void*)fwd_kernel, NWAVES * 64, LDS_BYTES) != hipSuccess || per_cu < 1) fprintf(stderr, "kernel_launch: occupancy query reports %d\n", per_cu);
        (void)hipGetLastError();
        grid = cus;
    }
    if (grid < 0) return;
    if (hipMemsetAsync((char*)d_ws + WS_CTL, 0, CTL_ZERO_BYTES, stream) != hipSuccess) return;
    Args a{};
    for (int i = 0; i < 30; ++i) a.in[i] = d_in[i];
    a.out = (float*)d_out; a.ws = (unsigned char*)d_ws;
#if ONE_LAUNCH
    a.ph_lo = 0; a.ph_hi = NPHASE;
    hipLaunchKernelGGL(fwd_kernel, dim3(grid), dim3(NWAVES * 64), LDS_BYTES, stream, a);
#else
    for (int p = 0; p < NPHASE; ++p) { a.ph_lo = p; a.ph_hi = p + 1; hipLaunchKernelGGL(fwd_kernel, dim3(grid), dim3(NWAVES * 64), LDS_BYTES, stream, a); }
#endif
}
```
